# Optimizing an MI355X kernel written in HIP

```python
import jax, jax.numpy as jnp
from jax import lax
import numpy as np

D_MODEL = 1024
BATCH = 8
SEQ = 4096
DEPTH = 4

MEM_LEN = 256
BLK = 128
ROPE_THETA = 10000.0
EPS = 1e-6
NEG_INF = -1e30

A_HEADS = 8
A_KV_HEADS = 2
A_HEAD_DIM = 64
A_WINDOW = 128

B_HEADS = 8
B_Q_RANK = 256
B_KV_RANK = 128
B_NOPE = 64
B_ROPE = 32
B_V = 64

M_HEADS = 4
M_HEAD_DIM = 128

D_FF = 3584
N_EXPERTS = 8
TOP_K = 2

N_BRANCHES = 3
BRANCH_WIDTH = 512

IN_SIZES = (A_HEADS * A_HEAD_DIM,
            A_KV_HEADS * A_HEAD_DIM,
            A_KV_HEADS * A_HEAD_DIM,
            B_Q_RANK,
            B_KV_RANK,
            B_ROPE,
            M_HEADS * M_HEAD_DIM,
            N_BRANCHES * D_MODEL)
IN_WIDTH = 512 + 128 + 128 + 256 + 128 + 32 + 512 + 3 * 1024

kernel_name = "hybrid_gated_swa_mla_mem_moe_encoder"


def rms_norm(x, g):
    xf = x.astype(jnp.float32)
    y = xf * lax.rsqrt(jnp.mean(xf * xf, axis=-1, keepdims=True) + EPS)
    return (y * g.astype(jnp.float32)).astype(x.dtype)


def rotary(x, pos):
    d = x.shape[-1]
    half = d // 2
    inv_freq = jnp.power(jnp.float32(ROPE_THETA), -jnp.arange(half, dtype=jnp.float32) * (2.0 / d))
    ang = pos.astype(jnp.float32)[:, :, None, None] * inv_freq
    cos, sin = jnp.cos(ang), jnp.sin(ang)
    xf = x.astype(jnp.float32)
    x1, x2 = xf[..., :half], xf[..., half:]
    return jnp.concatenate([x1 * cos - x2 * sin, x2 * cos + x1 * sin], axis=-1).astype(x.dtype)


def window_gqa(q, k, v, sink):
    b, s_len = q.shape[0], q.shape[1]
    nb = s_len // BLK
    grp = A_HEADS // A_KV_HEADS
    qb = q.reshape(b, nb, BLK, A_KV_HEADS, grp, A_HEAD_DIM)

    def band(t):
        tp = jnp.pad(t, ((0, 0), (BLK, BLK), (0, 0), (0, 0))).reshape(b, nb + 2, BLK, A_KV_HEADS, A_HEAD_DIM)
        return jnp.concatenate([tp[:, :-2], tp[:, 1:-1], tp[:, 2:]], axis=2)

    kw, vw = band(k), band(v)
    rel = jnp.arange(3 * BLK)[None, :] - BLK - jnp.arange(BLK)[:, None]
    k_abs = (jnp.arange(nb)[:, None] - 1) * BLK + jnp.arange(3 * BLK)[None, :]
    mask = (jnp.abs(rel) <= A_WINDOW)[None] & ((k_abs >= 0) & (k_abs < s_len))[:, None, :]
    sc = jnp.einsum('bnqkgd,bnjkd->bkgnqj', qb, kw, preferred_element_type=jnp.float32) * (A_HEAD_DIM ** -0.5)
    sc = jnp.where(mask, sc, NEG_INF)
    sk = sink.astype(jnp.float32).reshape(1, A_KV_HEADS, grp, 1, 1, 1)
    m = jnp.maximum(sc.max(axis=-1, keepdims=True), sk)
    e = jnp.exp(sc - m)
    p = e / (e.sum(axis=-1, keepdims=True) + jnp.exp(sk - m))
    o = jnp.einsum('bkgnqj,bnjkd->bnqkgd', p.astype(v.dtype), vw)
    return o.reshape(b, s_len, A_HEADS * A_HEAD_DIM)


def latent_attention(c_q, c_kv, k_rope_raw, pos, g_q, w_uq, g_kv, w_ukv):
    b, s_len = c_q.shape[0], c_q.shape[1]
    q = (rms_norm(c_q, g_q) @ w_uq).reshape(b, s_len, B_HEADS, B_NOPE + B_ROPE)
    q_nope, q_rope = q[..., :B_NOPE], rotary(q[..., B_NOPE:], pos)
    kv = (rms_norm(c_kv, g_kv) @ w_ukv).reshape(b, s_len, B_HEADS, B_NOPE + B_V)
    k_nope, v = kv[..., :B_NOPE], kv[..., B_NOPE:]
    k_rope = rotary(k_rope_raw[:, :, None, :], pos)[:, :, 0]
    scale = (B_NOPE + B_ROPE) ** -0.5
    nb = s_len // BLK

    def to_blocks(t):
        return jnp.moveaxis(t.reshape(b, nb, BLK, *t.shape[2:]), 1, 0)

    def attend(blk):
        qn, qr = blk
        sc = (jnp.einsum('bqhd,bkhd->bhqk', qn, k_nope, preferred_element_type=jnp.float32)
              + jnp.einsum('bqhd,bkd->bhqk', qr, k_rope, preferred_element_type=jnp.float32)) * scale
        p = jax.nn.softmax(sc, axis=-1)
        return jnp.einsum('bhqk,bkhd->bqhd', p.astype(v.dtype), v)

    o = lax.map(attend, (to_blocks(q_nope), to_blocks(q_rope)))
    return jnp.moveaxis(o, 0, 1).reshape(b, s_len, B_HEADS * B_V)


def memory_attention(q_flat, mem_n, w_kv):
    b, s_len = q_flat.shape[0], q_flat.shape[1]
    n_mem = mem_n.shape[1]
    kv = (mem_n @ w_kv).reshape(b, n_mem, 2, M_HEADS, M_HEAD_DIM)
    k, v = kv[:, :, 0], kv[:, :, 1]
    q = q_flat.reshape(b, s_len, M_HEADS, M_HEAD_DIM)
    sc = jnp.einsum('bqhd,bkhd->bhqk', q, k, preferred_element_type=jnp.float32) * (M_HEAD_DIM ** -0.5)
    p = jax.nn.softmax(sc, axis=-1)
    o = jnp.einsum('bhqk,bkhd->bqhd', p.astype(v.dtype), v)
    return o.reshape(b, s_len, M_HEADS * M_HEAD_DIM)


def swiglu(h, w_gate, w_up, w_down):
    return (jax.nn.silu(h @ w_gate) * (h @ w_up)) @ w_down


def moe_swiglu(h, w_router, w_gate, w_up, w_down):
    b, s_len, d = h.shape
    n_tok = b * s_len
    n_asg = n_tok * TOP_K
    ht = h.reshape(n_tok, d)
    logits = jnp.matmul(ht, w_router, preferred_element_type=jnp.float32)
    top_v, top_i = lax.top_k(logits, TOP_K)
    top_w = jax.nn.softmax(top_v, axis=-1)
    flat_e = top_i.reshape(n_asg)
    flat_tok = jnp.repeat(jnp.arange(n_tok, dtype=jnp.int32), TOP_K)
    flat_w = top_w.reshape(n_asg)
    order = jnp.argsort(flat_e)
    sorted_e = flat_e[order]
    counts = jnp.bincount(flat_e, length=N_EXPERTS)
    padded = (counts + BLK - 1) // BLK * BLK
    start = jnp.cumsum(counts) - counts
    pad_end = jnp.cumsum(padded)
    pad_start = pad_end - padded
    dest = pad_start[sorted_e] + jnp.arange(n_asg) - start[sorted_e]
    n_slots = n_asg + N_EXPERTS * BLK
    n_blk = n_slots // BLK
    tok_buf = jnp.full((n_slots,), n_tok, jnp.int32).at[dest].set(flat_tok[order])
    w_buf = jnp.zeros((n_slots,), jnp.float32).at[dest].set(flat_w[order])
    blk_e = jnp.minimum(jnp.searchsorted(pad_end, jnp.arange(n_blk) * BLK, side='right'), N_EXPERTS - 1)
    h_pad = jnp.concatenate([ht, jnp.zeros((1, d), ht.dtype)], axis=0)

    def expert_block(args):
        tok, wt, e = args
        xb = h_pad[tok]
        y = (jax.nn.silu(xb @ w_gate[e]) * (xb @ w_up[e])) @ w_down[e]
        return y * wt[:, None].astype(h.dtype)

    y = lax.map(expert_block, (tok_buf.reshape(n_blk, BLK), w_buf.reshape(n_blk, BLK), blk_e))
    out = jnp.zeros((n_tok + 1, d), h.dtype).at[tok_buf].add(y.reshape(n_slots, d))
    return out[:n_tok].reshape(b, s_len, d)


def setup_inputs(seed: int = 0) -> dict:
    key = jax.random.key(seed)
    ks = jax.random.split(key, 24)
    n_dense = (DEPTH + 1) // 2
    n_moe = DEPTH // 2

    def w(k, shape, fan_in):
        return jax.random.normal(k, shape, jnp.float32) * (fan_in ** -0.5)

    def gain(k, shape):
        return 1.0 + 0.02 * jax.random.normal(k, shape, jnp.float32)

    x = jax.random.normal(ks[0], (BATCH, SEQ, D_MODEL), jnp.float32)
    mem = jax.random.normal(ks[1], (BATCH, MEM_LEN, D_MODEL), jnp.float32)
    positions = (jax.random.randint(ks[2], (BATCH, 1), 0, SEQ, dtype=jnp.int32)
                 + jnp.arange(SEQ, dtype=jnp.int32)[None, :])
    return {
        "x": x,
        "mem": mem,
        "positions": positions,
        "g_mix": gain(ks[3], (DEPTH, D_MODEL)),
        "w_in": w(ks[4], (DEPTH, D_MODEL, IN_WIDTH), D_MODEL),
        "g_q_lat": gain(ks[5], (DEPTH, B_Q_RANK)),
        "w_uq": w(ks[6], (DEPTH, B_Q_RANK, B_HEADS * (B_NOPE + B_ROPE)), B_Q_RANK),
        "g_kv_lat": gain(ks[7], (DEPTH, B_KV_RANK)),
        "w_ukv": w(ks[8], (DEPTH, B_KV_RANK, B_HEADS * (B_NOPE + B_V)), B_KV_RANK),
        "sink": 0.5 * jax.random.normal(ks[9], (DEPTH, A_HEADS), jnp.float32),
        "w_mem_kv": w(ks[10], (DEPTH, D_MODEL, 2 * M_HEADS * M_HEAD_DIM), D_MODEL),
        "w_branch": w(ks[11], (DEPTH, N_BRANCHES, BRANCH_WIDTH, D_MODEL), BRANCH_WIDTH),
        "w_out": w(ks[12], (DEPTH, D_MODEL, D_MODEL), D_MODEL),
        "g_ffn": gain(ks[13], (DEPTH, D_MODEL)),
        "w_gate_dense": w(ks[14], (n_dense, D_MODEL, D_FF), D_MODEL),
        "w_up_dense": w(ks[15], (n_dense, D_MODEL, D_FF), D_MODEL),
        "w_down_dense": w(ks[16], (n_dense, D_FF, D_MODEL), D_FF),
        "w_router": w(ks[17], (n_moe, D_MODEL, N_EXPERTS), D_MODEL),
        "w_gate_exp": w(ks[18], (n_moe, N_EXPERTS, D_MODEL, D_FF), D_MODEL),
        "w_up_exp": w(ks[19], (n_moe, N_EXPERTS, D_MODEL, D_FF), D_MODEL),
        "w_down_exp": w(ks[20], (n_moe, N_EXPERTS, D_FF, D_MODEL), D_FF),
        "g_mem": gain(ks[21], (D_MODEL,)),
        "g_final": gain(ks[22], (D_MODEL,)),
    }


def reference(x, mem, positions, g_mix, w_in, g_q_lat, w_uq, g_kv_lat, w_ukv, sink, w_mem_kv,
              w_branch, w_out, g_ffn, w_gate_dense, w_up_dense, w_down_dense, w_router,
              w_gate_exp, w_up_exp, w_down_exp, g_mem, g_final):
    b, s_len, _ = x.shape
    mem_n = rms_norm(mem, g_mem)
    split_points = [int(p) for p in np.cumsum(IN_SIZES)[:-1]]
    for l in range(DEPTH):
        h = rms_norm(x, g_mix[l])
        qa, ka, va, cq, ckv, kr, qm, gates = jnp.split(h @ w_in[l], split_points, axis=-1)
        y_a = window_gqa(rotary(qa.reshape(b, s_len, A_HEADS, A_HEAD_DIM), positions),
                         rotary(ka.reshape(b, s_len, A_KV_HEADS, A_HEAD_DIM), positions),
                         va.reshape(b, s_len, A_KV_HEADS, A_HEAD_DIM), sink[l])
        y_b = latent_attention(cq, ckv, kr, positions, g_q_lat[l], w_uq[l], g_kv_lat[l], w_ukv[l])
        y_m = memory_attention(qm, mem_n, w_mem_kv[l])
        g = jax.nn.sigmoid(gates.astype(jnp.float32)).astype(x.dtype).reshape(b, s_len, N_BRANCHES, D_MODEL)
        mixed = (g[:, :, 0] * (y_a @ w_branch[l, 0])
                 + g[:, :, 1] * (y_b @ w_branch[l, 1])
                 + g[:, :, 2] * (y_m @ w_branch[l, 2]))
        x = x + mixed @ w_out[l]
        h = rms_norm(x, g_ffn[l])
        if l % 2 == 0:
            i = l // 2
            x = x + swiglu(h, w_gate_dense[i], w_up_dense[i], w_down_dense[i])
        else:
            i = l // 2
            x = x + moe_swiglu(h, w_router[i], w_gate_exp[i], w_up_exp[i], w_down_exp[i])
    return rms_norm(x, g_final)
```

```cpp
#include <hip/hip_runtime.h>
#include <cstdio>
#include <cstdint>

#ifndef SELFCHECK
#define SELFCHECK 0
#endif

#define GAS __attribute__((address_space(1)))
#define LAS __attribute__((address_space(3)))
typedef unsigned short bf16_t;
typedef short bf16x8 __attribute__((ext_vector_type(8)));
typedef short s16x4 __attribute__((ext_vector_type(4)));
typedef short v4i16_t __attribute__((ext_vector_type(4)));
typedef float f32x2 __attribute__((ext_vector_type(2)));
typedef float f32x4 __attribute__((ext_vector_type(4)));
typedef float f32x16 __attribute__((ext_vector_type(16)));
typedef unsigned u32x2 __attribute__((ext_vector_type(2)));
typedef unsigned u32x4 __attribute__((ext_vector_type(4)));
typedef int i32x4 __attribute__((ext_vector_type(4)));
typedef GAS unsigned gu32;
#define RLX_AGENT __ATOMIC_RELAXED, __HIP_MEMORY_SCOPE_AGENT

constexpr int NB = 8, SEQ = 4096, T = NB * SEQ, DM = 1024, DEPTH = 4, MEML = 256, DFF = 3584, NE = 8;
constexpr int INW = 4768;
constexpr int PW = 1792;
constexpr int GW = 3072;
constexpr int QBW = 768, KVW = 1024, YW = 1536;
constexpr int NT_IN = 19;
constexpr int P_QA = 0, P_KA = 512, P_VA = 640, P_CQ = 768, P_CKV = 1024, P_KR = 1152, P_QM = 1280;
constexpr int UPK = 384, UPN = 1792;
constexpr int MAXSLOT = 67584;
constexpr int MAXRT = MAXSLOT / 256;
constexpr int HALF_RT = 132;
constexpr float EPS = 1e-6f;
constexpr float LOG2E = 1.4426950408889634f;
constexpr float C_A = 0.125f * LOG2E;
constexpr float C_B = 0.10206207261596575f * LOG2E;
constexpr float C_M = 0.08838834764831845f * LOG2E;

constexpr size_t MiB = 1u << 20;
constexpr size_t WS_CTL = 0, CTL_ZERO_BYTES = 1 * MiB;
constexpr size_t WS_MISC = 1 * MiB;
constexpr size_t WL_IN = 0, WL_UP = (size_t)NT_IN * 256 * DM * 2, WL_BR = WL_UP + (size_t)UPN * UPK * 2, WL_OUT = WL_BR + (size_t)3 * DM * 512 * 2, WL_SIZE = WL_OUT + (size_t)DM * DM * 2;
constexpr size_t WS_WMIX = 8 * MiB;
constexpr size_t WS_WMKV = WS_WMIX + 4 * ((WL_SIZE + MiB - 1) / MiB) * MiB;
constexpr size_t WL_STRIDE = ((WL_SIZE + MiB - 1) / MiB) * MiB;
constexpr size_t WS_WFFN = WS_WMKV + 8 * MiB;
constexpr size_t WF_GU = 0, WF_D = (size_t)2 * DFF * DM * 2, WF_STRIDE = WF_D + (size_t)DM * DFF * 2;
constexpr size_t WS_H = WS_WFFN + 8 * WF_STRIDE;
constexpr size_t WS_MEMN = WS_H + (size_t)T * DM * 2;
constexpr size_t WS_MEMKV = WS_MEMN + (size_t)NB * MEML * DM * 2;
constexpr size_t WS_R = WS_MEMKV + (size_t)NB * MEML * 4096 * 2;
constexpr size_t R_P = 0, R_G = R_P + (size_t)T * PW * 2, R_QB = R_G + (size_t)T * GW * 2, R_KVB = R_QB + (size_t)T * QBW * 2, R_Y = R_KVB + (size_t)T * KVW * 2, R_END_MIX = R_Y + (size_t)T * YW * 2;
constexpr size_t R_BRS = R_P;
constexpr size_t R_ACT = 0;
constexpr size_t R_ASORT = (size_t)HALF_RT * 256 * DFF * 2;
constexpr size_t R_YOUT = R_ASORT + (size_t)MAXSLOT * DM * 2;
constexpr size_t R_END_FFN = R_YOUT + (size_t)MAXSLOT * DM * 2;
constexpr size_t R_SIZE = R_END_MIX > R_END_FFN ? R_END_MIX : R_END_FFN;
constexpr size_t WS_END = WS_R + R_SIZE;
static_assert((size_t)HALF_RT * 256 >= (size_t)T, "dense ACT fits the MoE ACT half area");
static_assert(WS_END < 1040ull * MiB, "workspace budget");
constexpr size_t MS_TOKE = 0;
constexpr size_t MS_TOKW = MS_TOKE + (size_t)T * 8;
constexpr size_t MS_SLOT = MS_TOKW + (size_t)T * 8;
constexpr size_t MS_CNT = MS_SLOT + (size_t)T * 8;
constexpr size_t MS_TEXP = MS_CNT + 256 * 8 * 4;
constexpr size_t MS_SSQ = MS_TEXP + 2048;
constexpr size_t MS_SNAP = MS_SSQ + (size_t)T * 32;
constexpr size_t MS_END = MS_SNAP + 64 * 1024 * 4;
static_assert(MS_END <= 7 * MiB, "misc map");
constexpr int CW_BAR = 4096;
constexpr int CW_DIAG = 16384;
constexpr int CW_CODE = 16384 + 512;

constexpr int RING_BYTES = 131072;
constexpr int LDSCTL_OFF = RING_BYTES;
constexpr int LDS_BYTES = 147456;
constexpr int NWAVES = 8;

#define LDS_WAIT() asm volatile("s_waitcnt lgkmcnt(0)" ::: "memory")
#define VM_WAIT() asm volatile("s_waitcnt vmcnt(0)" ::: "memory")

__device__ __forceinline__ unsigned f2bf(float f) { unsigned u = __builtin_bit_cast(unsigned, f); return (u + 0x7fffu + ((u >> 16) & 1u)) >> 16; }
__device__ __forceinline__ unsigned pk2(float lo, float hi) { return f2bf(lo) | (f2bf(hi) << 16); }
__device__ __forceinline__ float bf2f(unsigned short b) { return __builtin_bit_cast(float, (unsigned)b << 16); }
__device__ __forceinline__ float bflo(unsigned w) { return __builtin_bit_cast(float, w << 16); }
__device__ __forceinline__ float bfhi(unsigned w) { return __builtin_bit_cast(float, w & 0xffff0000u); }
typedef __bf16 bf16x2_t __attribute__((ext_vector_type(2)));
__device__ __forceinline__ unsigned cvtpk(float lo, float hi) { f32x2 v = {lo, hi}; bf16x2_t b = __builtin_convertvector(v, bf16x2_t); return __builtin_bit_cast(unsigned, b); }
__device__ __forceinline__ float wave_sum(float v) {
#pragma unroll
    for (int o = 1; o < 64; o <<= 1) v += __shfl_xor(v, o);
    return v;
}
__device__ __forceinline__ float fast_sigmoid(float x) { return __builtin_amdgcn_rcpf(1.0f + __builtin_amdgcn_exp2f(-x * LOG2E)); }


__device__ __forceinline__ int opq_v(int x) { asm volatile("" : "+v"(x)); return x; }
__device__ __forceinline__ int opq_s(int x) { asm volatile("" : "+s"(x)); return x; }
template <class Tp> __device__ __forceinline__ Tp* opq_p(Tp* p) { const unsigned long long u = (unsigned long long)p; unsigned lo = __builtin_amdgcn_readfirstlane((unsigned)u), hi = __builtin_amdgcn_readfirstlane((unsigned)(u >> 32)); asm volatile("" : "+s"(lo), "+s"(hi)); return (Tp*)(((unsigned long long)hi << 32) | lo); }

__constant__ float IFR_HI[32] = {1.591549367e-01f, 1.193493679e-01f, 8.949939907e-02f, 6.711508334e-02f, 5.032921210e-02f, 3.774158657e-02f, 2.830219641e-02f, 2.122365311e-02f, 1.591549441e-02f, 1.193493698e-02f, 8.949940093e-03f, 6.711508147e-03f, 5.032921210e-03f, 3.774158424e-03f, 2.830219688e-03f, 2.122365171e-03f, 1.591549488e-03f, 1.193493721e-03f, 8.949940093e-04f, 6.711508031e-04f, 5.032921326e-04f, 3.774158540e-04f, 2.830219455e-04f, 2.122365258e-04f, 1.591549371e-04f, 1.193493736e-04f, 8.949940093e-05f, 6.711508468e-05f, 5.032921035e-05f, 3.774158540e-05f, 2.830219637e-05f, 2.122365186e-05f};
__constant__ float IFR_LO[32] = {6.420638243e-09f, 2.294664903e-09f, 2.542919653e-09f, -3.316028840e-10f, 5.173299289e-12f, -1.848551645e-09f, -5.826552019e-10f, -3.431038786e-10f, -1.029942243e-10f, 4.320196978e-11f, 6.802745173e-11f, 1.531042237e-10f, 5.173301024e-13f, 4.797548470e-11f, -1.048316434e-10f, 1.053879969e-10f, -5.686555046e-11f, -1.896286773e-11f, 6.802744999e-12f, 2.695195456e-11f, -1.158979943e-11f, -6.843983713e-12f, 1.279990003e-11f, 1.807650600e-12f, 5.954976963e-12f, -3.351478166e-12f, 6.802745216e-13f, -1.670379113e-12f, 1.751403167e-12f, -6.843983930e-13f, -5.389994549e-13f, 9.083608431e-13f};
__device__ __forceinline__ void rot_cs(float posf, int idx, float& c, float& s) {
    const float ch = IFR_HI[idx], cl = IFR_LO[idx];
    const float p = posf * ch, e = __builtin_fmaf(posf, ch, -p);
    const float fr = __builtin_amdgcn_fractf(p) + (e + posf * cl);
    s = __builtin_amdgcn_sinf(fr); c = __builtin_amdgcn_cosf(fr);
}

#define XB_TMO      128
#define XB_XCNT(j)  (256  + 64 * (j))
#define XB_XSUB(j)  (1280 + 64 * (j))
#define XB_XGEN(j)  (2304 + 64 * (j))
#define XB_TOP      3328
#define XB_TOPGEN   3392
#define XCD_BAR_WORDS 3456
#define XB_SPIN_CAP (1u << 20)

__device__ __forceinline__ unsigned xb_ld(unsigned* p)              { return __hip_atomic_load(p, __ATOMIC_RELAXED, __HIP_MEMORY_SCOPE_AGENT); }
__device__ __forceinline__ unsigned xb_add(unsigned* p, unsigned v) { return __hip_atomic_fetch_add(p, v, __ATOMIC_RELAXED, __HIP_MEMORY_SCOPE_AGENT); }
__device__ __forceinline__ unsigned xb_xcc_id() { return (unsigned)__builtin_amdgcn_s_getreg((3 << 11) | 20) & 0xFu; }
#define XB_SPIN(cond, bar) do { unsigned _sp = 0; while (cond) { __builtin_amdgcn_s_sleep(1); \
    if ((++_sp & 255u) == 0u) { if (xb_ld(&(bar)[XB_TMO])) break; if (_sp > XB_SPIN_CAP) { atomicAdd(&(bar)[XB_TMO], 1u); break; } } } } while (0)

struct XcdBarrier { unsigned* bar; unsigned x; volatile LAS unsigned* st; };

__device__ __forceinline__ XcdBarrier xcd_barrier_post(unsigned* bar, volatile LAS unsigned* st) {
    XcdBarrier b; b.bar = bar; b.x = xb_xcc_id(); b.st = st;
    if (threadIdx.x == 0) (void)xb_add(&bar[XB_XCNT(b.x)], 1u);
    return b;
}
__device__ __forceinline__ void xcd_barrier_complete(unsigned* bar, unsigned x, unsigned& nloc, unsigned& nx) {
    const unsigned G = gridDim.x * gridDim.y * gridDim.z;
    unsigned sum, cnt, mine, sp = 0u;
    for (;;) {
        sum = 0u; cnt = 0u; mine = 0u;
#pragma unroll
        for (unsigned j = 0; j < 16; ++j) { const unsigned c = xb_ld(&bar[XB_XCNT(j)]); sum += c; cnt += (c > 0u) ? 1u : 0u; mine = (j == x) ? c : mine; }
        if (sum == G) break;
        __builtin_amdgcn_s_sleep(1);
        if ((++sp & 255u) == 0u) { if (xb_ld(&bar[XB_TMO])) break; if (sp > XB_SPIN_CAP) { atomicAdd(&bar[XB_TMO], 1u); break; } }
    }
    nloc = mine > 0u ? mine : 1u; nx = cnt > 0u ? cnt : 1u;
}
__device__ __forceinline__ void xcd_barrier(const XcdBarrier& b) {
    asm volatile("s_waitcnt vmcnt(0)" ::: "memory");
    __syncthreads();
    if (threadIdx.x == 0) {
        unsigned* bar = b.bar;
        __builtin_amdgcn_s_waitcnt(0);
        unsigned nloc = b.st[0], nx = b.st[1];
        if (nloc == 0u) { xcd_barrier_complete(bar, b.x, nloc, nx); b.st[0] = nloc; b.st[1] = nx; }
        const unsigned old = xb_add(&bar[XB_XSUB(b.x)], 1u);
        const unsigned gen = old / nloc;
        if (old + 1u == (gen + 1u) * nloc) {
            __builtin_amdgcn_fence(__ATOMIC_RELEASE, "agent");
            asm volatile("s_waitcnt vmcnt(0)" ::: "memory");
            const unsigned og = xb_add(&bar[XB_TOP], 1u);
            const unsigned tg = og / nx;
            if (og + 1u == (tg + 1u) * nx) xb_add(&bar[XB_TOPGEN], 1u);
            else XB_SPIN(xb_ld(&bar[XB_TOPGEN]) == tg, bar);
            __builtin_amdgcn_fence(__ATOMIC_ACQUIRE, "agent");
            xb_add(&bar[XB_XGEN(b.x)], 1u);
            asm volatile("s_waitcnt vmcnt(0)" ::: "memory");
        } else {
            XB_SPIN(xb_ld(&bar[XB_XGEN(b.x)]) == gen, bar);
            __builtin_amdgcn_fence(__ATOMIC_ACQUIRE, "agent");
            asm volatile("s_waitcnt vmcnt(0)" ::: "memory");
        }
    }
    __syncthreads();
}

namespace pg8 {
constexpr int BM = 256, BK = 64, HALF = 128, HTB = HALF * BK * 2, STAGE_BYTES = 8 * HTB, NXCD = 8, WGM = 8;
__host__ __device__ __forceinline__ int lds_byte(int r, int c) { const int st = (r >> 4) * 2 + (c >> 5), rr = r & 15, cc = c & 31, ob = rr * 64 + cc * 2; return st * 1024 + (ob ^ (((ob >> 9) & 1) << 5)); }
__host__ __device__ __forceinline__ void stage_rc(int b, int& R, int& C) { const int st = b / 1024, sb = b % 1024, swz = sb ^ (((sb >> 9) & 1) << 5); R = (st >> 1) * 16 + swz / 64; C = (st & 1) * 32 + (swz % 64) / 2; }

struct Unit { int pm, pn, aux; };

struct StaticOrder {
    int nM, nN, nwg, G, c;
    __device__ void init(int nM_, int nN_, int G_, int c_) { nM = nM_; nN = nN_; nwg = nM * nN; G = G_; c = c_; }
    __device__ bool next(int i, Unit& u) const {
        const long L = (long)i * G + c; if (L >= nwg) return false;
        int wgid = (int)L; { const int q = nwg / NXCD, r = nwg % NXCD, xcd = wgid % NXCD, off = wgid / NXCD; wgid = (xcd < r ? xcd * (q + 1) : r * (q + 1) + (xcd - r) * q) + off; }
        const int nig = WGM * nN, gid = wgid / nig, fm = gid * WGM, gsz = (nM - fm) < WGM ? (nM - fm) : WGM;
        u.pm = fm + ((wgid % nig) % gsz); u.pn = (wgid % nig) / gsz; u.aux = 0; return true;
    }
};

template <class Prob, class Sched, class Epi>
__device__ __forceinline__ void gemm_phase(LAS unsigned char* lds, const Prob& P, const Sched& S, const Epi& E) {
    const int tid = opq_v((int)threadIdx.x), wid = __builtin_amdgcn_readfirstlane(tid >> 6), lane = tid & 63, wr = wid >> 2, wc = wid & 3, fr = lane & 15, fq = lane >> 4;
    const int K = P.K, nt = K / BK;
    unsigned voffA[2], voffB[2];
#pragma unroll
    for (int i = 0; i < 2; ++i) { int R, C; stage_rc(tid * 16 + i * 8192, R, C); voffA[i] = (unsigned)R * P.lda + (unsigned)C * 2u; voffB[i] = (unsigned)R * P.ldb + (unsigned)C * 2u; }
    const size_t kstep = (size_t)(BK * 2);
    const size_t hstepA = (size_t)HALF * P.lda, hstepB = (size_t)HALF * P.ldb;
    const unsigned ldsw = (unsigned)wid * 1024u;
    const int aoff = lds_byte(wr * 64 + fr, fq * 8), boff = lds_byte(wc * 32 + fr, fq * 8);
#define PG8_SA(b, h) (((b) * 2 + (h)) * HTB)
#define PG8_SB(b, h) ((4 + (b) * 2 + (h)) * HTB)
#define PG8_STAGE(bufoff, gbase, voff) do { _Pragma("unroll") for (int _i = 0; _i < 2; ++_i) \
        __builtin_amdgcn_global_load_lds((const unsigned*)((const char*)(gbase) + (voff)[_i]), (LAS unsigned*)(lds + (bufoff) + ldsw + _i * 8192), 16, 0, 0); } while (0)
#define PG8_LDA(dst, b, h) do { _Pragma("unroll") for (int m = 0; m < 4; ++m) _Pragma("unroll") for (int k = 0; k < 2; ++k) dst[m][k] = *(const LAS bf16x8*)(lds + PG8_SA(b, h) + aoff + m * 2048 + k * 1024); } while (0)
#define PG8_LDB(dst, b, h) do { _Pragma("unroll") for (int n = 0; n < 2; ++n) _Pragma("unroll") for (int k = 0; k < 2; ++k) dst[n][k] = *(const LAS bf16x8*)(lds + PG8_SB(b, h) + boff + n * 2048 + k * 1024); } while (0)
#define PG8_MMA(ai, bj, At, Bt) do { __builtin_amdgcn_s_setprio(1); _Pragma("unroll") for (int m = 0; m < 4; ++m) _Pragma("unroll") for (int n = 0; n < 2; ++n) _Pragma("unroll") for (int k = 0; k < 2; ++k) \
        acc[ai][bj][m][n] = __builtin_amdgcn_mfma_f32_16x16x32_bf16(Bt[n][k], At[m][k], acc[ai][bj][m][n], 0, 0, 0); __builtin_amdgcn_s_setprio(0); } while (0)
#define PG8_WAIT_V(n) asm volatile("s_waitcnt vmcnt(" #n ")" ::: "memory")
#define PG8_WAIT_L(n) asm volatile("s_waitcnt lgkmcnt(" #n ")" ::: "memory")
#define PG8_BAR __builtin_amdgcn_s_barrier()
#define PG8_SCHED __builtin_amdgcn_sched_barrier(0)
    Unit cur, nxt; int ui = 0;
    if (!S.next(0, cur)) return;
    f32x4 acc[2][2][4][2];
#pragma unroll
    for (int a = 0; a < 2; ++a)
#pragma unroll
        for (int b = 0; b < 2; ++b)
#pragma unroll
            for (int m = 0; m < 4; ++m)
#pragma unroll
                for (int n = 0; n < 2; ++n) acc[a][b][m][n] = (f32x4){0.f, 0.f, 0.f, 0.f};
    bf16x8 At[4][2], B0[2][2], B1[2][2];
    const char* cA = P.a_ptr(cur); const char* cB = P.b_ptr(cur);
    PG8_STAGE(PG8_SB(0, 0), cB, voffB); PG8_STAGE(PG8_SB(0, 1), cB + hstepB, voffB); PG8_STAGE(PG8_SA(0, 0), cA, voffA); PG8_STAGE(PG8_SA(0, 1), cA + hstepA, voffA);
    if (wr == 1) PG8_BAR;
    PG8_WAIT_V(2); PG8_BAR;
    PG8_STAGE(PG8_SB(1, 0), cB + kstep, voffB); PG8_STAGE(PG8_SA(1, 0), cA + kstep, voffA); PG8_STAGE(PG8_SB(1, 1), cB + hstepB + kstep, voffB);
    PG8_WAIT_V(6); PG8_BAR;
    for (;;) {
        const bool has_next = S.next(ui + 1, nxt);
        const char* nA = has_next ? P.a_ptr(nxt) : cA; const char* nB = has_next ? P.b_ptr(nxt) : cB;
        for (int t = 0; t < nt; t += 2) {
            const bool last = (t == nt - 2);
            const char* a1 = cA + (size_t)(t + 1) * kstep;
            const char* a2 = last ? nA : cA + (size_t)(t + 2) * kstep; const char* b2 = last ? nB : cB + (size_t)(t + 2) * kstep;
            const char* a3 = a2 + kstep; const char* b3 = b2 + kstep;
            PG8_LDB(B0, 0, 0); PG8_LDB(B1, 0, 1); PG8_SCHED; PG8_LDA(At, 0, 0); PG8_STAGE(PG8_SA(1, 1), a1 + hstepA, voffA);
            PG8_WAIT_V(8); PG8_WAIT_L(0); PG8_BAR; PG8_MMA(0, 0, At, B0); PG8_MMA(0, 1, At, B1); PG8_BAR; PG8_SCHED;
            PG8_LDA(At, 0, 1); PG8_STAGE(PG8_SB(0, 0), b2, voffB); PG8_STAGE(PG8_SB(0, 1), b2 + hstepB, voffB); PG8_STAGE(PG8_SA(0, 0), a2, voffA);
            PG8_WAIT_V(8); PG8_WAIT_L(0); PG8_BAR; PG8_MMA(1, 0, At, B0); PG8_MMA(1, 1, At, B1); PG8_BAR; PG8_SCHED;
            PG8_LDB(B0, 1, 0); PG8_LDB(B1, 1, 1); PG8_SCHED; PG8_LDA(At, 1, 0); PG8_STAGE(PG8_SA(0, 1), a2 + hstepA, voffA);
            PG8_WAIT_V(8); PG8_WAIT_L(0); PG8_BAR; PG8_MMA(0, 0, At, B0); PG8_MMA(0, 1, At, B1); PG8_BAR; PG8_SCHED;
            PG8_LDA(At, 1, 1); PG8_STAGE(PG8_SB(1, 0), b3, voffB); PG8_STAGE(PG8_SB(1, 1), b3 + hstepB, voffB); PG8_STAGE(PG8_SA(1, 0), a3, voffA);
            PG8_WAIT_V(8); PG8_WAIT_L(0); PG8_BAR; PG8_MMA(1, 0, At, B0); PG8_MMA(1, 1, At, B1); PG8_BAR; PG8_SCHED;
        }
        if (wr == 0) PG8_BAR;
        E(acc, cur, wr, wc, fr, fq);
        if (!has_next) break;
#pragma unroll
        for (int a = 0; a < 2; ++a)
#pragma unroll
            for (int b = 0; b < 2; ++b)
#pragma unroll
                for (int m = 0; m < 4; ++m)
#pragma unroll
                    for (int n = 0; n < 2; ++n) acc[a][b][m][n] = (f32x4){0.f, 0.f, 0.f, 0.f};
        cur = nxt; cA = nA; cB = nB; ++ui;
        if (wr == 1) PG8_BAR;
    }
    PG8_WAIT_V(0);
    PG8_BAR;
#undef PG8_SA
#undef PG8_SB
#undef PG8_STAGE
#undef PG8_LDA
#undef PG8_LDB
#undef PG8_MMA
#undef PG8_WAIT_V
#undef PG8_WAIT_L
#undef PG8_BAR
#undef PG8_SCHED
}
}

struct Frame {
    LAS unsigned char* lds;
    volatile LAS unsigned* MISC;
    gu32* ctl;
    unsigned char* ws;
    int tid, lane, wave, vcu, G;
    const float* const* in; float* out;
};
enum { I_X = 0, I_MEM, I_POS, I_GMIX, I_WIN, I_GQ, I_WUQ, I_GKV, I_WUKV, I_SINK, I_WMKV, I_WBR, I_WOUT, I_GFFN, I_WGD, I_WUD, I_WDD, I_WR, I_WGE, I_WUE, I_WDE, I_GMEM, I_GFIN };

__device__ __forceinline__ int sem_plain(int g) { return (g & ~31) + 8 * ((g >> 2) & 3) + 4 * ((g >> 4) & 1) + (g & 3); }
__device__ __forceinline__ int sem_rot64(int g) { return (g & ~63) + 32 * ((g >> 4) & 1) + 16 * ((g >> 5) & 1) + 4 * ((g >> 2) & 3) + (g & 3); }
__device__ __forceinline__ int inproj_src(int n) {
    const int pn = n >> 8, c = n & 255;
    if (pn < 2) return pn * 256 + sem_rot64(c);
    if (pn == 2) return c < 128 ? 512 + sem_rot64(c) : 640 + sem_plain(c - 128);
    if (pn == 3) return 768 + sem_plain(c);
    if (pn == 4) return c < 128 ? 1024 + sem_plain(c) : (c < 160 ? 1152 + (c - 128) : -1);
    if (pn < 7) return 1184 + (pn - 5) * 256 + sem_plain(c);
    return 1696 + (pn - 7) * 256 + sem_plain(c);
}

struct MapInproj { const float* W; __device__ __forceinline__ float load(int k, int n) const { const int s = inproj_src(n); return s >= 0 ? W[(size_t)k * INW + s] : 0.f; } };
struct MapUp { const float *Wq, *Wkv, *gq, *gkv;
    __device__ __forceinline__ float load(int k, int n) const {
        if (n < 768) { if (k >= 256) return 0.f; const int gg = n >> 5; const int s = (gg % 3 == 2) ? n : sem_plain(n); return gq[k] * Wq[(size_t)k * 768 + s]; }
        if (k < 256) return 0.f; const int s = sem_plain(n - 768); return gkv[k - 256] * Wkv[(size_t)(k - 256) * 1024 + s]; } };
struct MapPlain { const float* W; int ldw; __device__ __forceinline__ float load(int k, int n) const { return W[(size_t)k * ldw + sem_plain(n)]; } };
struct MapNat { const float* W; int ldw; __device__ __forceinline__ float load(int k, int n) const { return W[(size_t)k * ldw + n]; } };
struct MapMemkv { const float* W; __device__ __forceinline__ float load(int k, int n) const { const int l = n >> 10, c = n & 1023; return W[((size_t)l * DM + k) * 1024 + sem_plain(c)]; } };
struct MapGU { const float *Wg, *Wu; __device__ __forceinline__ float load(int k, int n) const { const int pn = n >> 8, c = n & 255; const int ch = 128 * pn + sem_plain(c & 127);
    const unsigned long long a = (unsigned long long)Wg, b = (unsigned long long)Wu, w = a ^ ((a ^ b) & (0ull - (unsigned long long)(c >> 7))); return ((const float*)w)[(size_t)k * DFF + ch]; } };

template <class M> __device__ __forceinline__ void prep_item(const M& m, bf16_t* dst, int Kd, int nblk, LAS float* scr, int item, int lane) {
    const int kb = item / nblk, nb = item % nblk, k0 = 64 * kb, n0 = 32 * nb;
#pragma unroll 8
    for (int i = 0; i < 32; ++i) { const int kk = 2 * i + (lane >> 5); scr[kk * 33 + (lane & 31)] = m.load(k0 + kk, n0 + (lane & 31)); }
    LDS_WAIT(); asm volatile("" ::: "memory");
    const int c = lane & 7;
#pragma unroll
    for (int j = 0; j < 4; ++j) { const int n = (lane >> 3) + 8 * j; const LAS float* s = scr + (8 * c) * 33 + n;
        u32x4 o; o.x = pk2(s[0 * 33], s[1 * 33]); o.y = pk2(s[2 * 33], s[3 * 33]); o.z = pk2(s[4 * 33], s[5 * 33]); o.w = pk2(s[6 * 33], s[7 * 33]);
        *(u32x4*)(dst + (size_t)(n0 + n) * Kd + k0 + 8 * c) = o; }
    LDS_WAIT(); asm volatile("" ::: "memory");
}
template <class M> __device__ __forceinline__ void prep_matrix(Frame& F, const M& m, bf16_t* dst, int N, int K) {
    LAS float* scr = (LAS float*)(F.lds + F.wave * 16384);
    const int gw = F.vcu * NWAVES + F.wave, NGW = F.G * NWAVES, nblk = N / 32, nitems = (K / 64) * nblk;
    for (int it = gw; it < nitems; it += NGW) prep_item(m, dst, K, nblk, scr, it, F.lane);
}
__device__ __forceinline__ bf16_t* wmix(Frame& F, int l, size_t off) { return (bf16_t*)(F.ws + WS_WMIX + (size_t)l * WL_STRIDE + off); }

__device__ __forceinline__ void prep_mixer_weights(Frame& F) {
    for (int l = 0; l < DEPTH; ++l) {
        { MapInproj m{F.in[I_WIN] + (size_t)l * DM * INW}; prep_matrix(F, m, wmix(F, l, WL_IN), NT_IN * 256, DM); }
        { MapUp m{F.in[I_WUQ] + (size_t)l * 256 * 768, F.in[I_WUKV] + (size_t)l * 128 * 1024, F.in[I_GQ] + l * 256, F.in[I_GKV] + l * 128}; prep_matrix(F, m, wmix(F, l, WL_UP), UPN, UPK); }
        for (int i = 0; i < 3; ++i) { MapPlain m{F.in[I_WBR] + ((size_t)l * 3 + i) * 512 * DM, DM}; prep_matrix(F, m, wmix(F, l, WL_BR) + (size_t)i * DM * 512, DM, 512); }
        { MapNat m{F.in[I_WOUT] + (size_t)l * DM * DM, DM}; prep_matrix(F, m, wmix(F, l, WL_OUT), DM, DM); }
    }
    { MapMemkv m{F.in[I_WMKV]}; prep_matrix(F, m, (bf16_t*)(F.ws + WS_WMKV), 4096, DM); }
}
__device__ __forceinline__ void prep_ffn_weights(Frame& F, int l) {
    const int i = l >> 1;
    LAS float* scr = (LAS float*)(F.lds + F.wave * 16384);
    const int gw = F.vcu * NWAVES + F.wave, NGW = F.G * NWAVES;
    constexpr int IGU = (DM / 64) * (2 * DFF / 32), ID = (DFF / 64) * (DM / 32), IE = IGU + ID;
    const int ne = (l & 1) ? NE : 1;
    for (int it = gw; it < ne * IE; it += NGW) {
        const int e = it / IE, r = it % IE;
        bf16_t* base = (bf16_t*)(F.ws + WS_WFFN + (size_t)e * WF_STRIDE);
        if (l & 1) {
            const size_t eo = ((size_t)i * NE + e) * DM * DFF;
            if (r < IGU) { MapGU m{F.in[I_WGE] + eo, F.in[I_WUE] + eo}; prep_item(m, base, DM, 2 * DFF / 32, scr, r, F.lane); }
            else { MapNat m{F.in[I_WDE] + eo, DM}; prep_item(m, base + WF_D / 2, DFF, DM / 32, scr, r - IGU, F.lane); }
        } else {
            const size_t eo = (size_t)i * DM * DFF;
            if (r < IGU) { MapGU m{F.in[I_WGD] + eo, F.in[I_WUD] + eo}; prep_item(m, base, DM, 2 * DFF / 32, scr, r, F.lane); }
            else { MapNat m{F.in[I_WDD] + eo, DM}; prep_item(m, base + WF_D / 2, DFF, DM / 32, scr, r - IGU, F.lane); }
        }
    }
}

struct RowV { f32x4 v[4]; };
__device__ __forceinline__ void row_load(RowV& r, const float* p, int lane) { const f32x4* x = (const f32x4*)p + lane;
#pragma unroll
    for (int j = 0; j < 4; ++j) r.v[j] = x[64 * j]; }
__device__ __forceinline__ void row_store(const RowV& r, float* p, int lane) { f32x4* x = (f32x4*)p + lane;
#pragma unroll
    for (int j = 0; j < 4; ++j) x[64 * j] = r.v[j]; }
__device__ __forceinline__ void row_add_bf16(RowV& r, const bf16_t* p, float w, int lane) { const u32x2* x = (const u32x2*)p + lane;
#pragma unroll
    for (int j = 0; j < 4; ++j) { const u32x2 q = x[64 * j]; r.v[j].x += w * bflo(q.x); r.v[j].y += w * bfhi(q.x); r.v[j].z += w * bflo(q.y); r.v[j].w += w * bfhi(q.y); } }
__device__ __forceinline__ float row_rstd(const RowV& r) { float s = 0.f;
#pragma unroll
    for (int j = 0; j < 4; ++j) s += (r.v[j].x * r.v[j].x + r.v[j].y * r.v[j].y) + (r.v[j].z * r.v[j].z + r.v[j].w * r.v[j].w);
    return 1.0f / sqrtf(wave_sum(s) * (1.0f / DM) + EPS); }
__device__ __forceinline__ void row_scale(RowV& r, float rstd, const float* g, int lane) { const f32x4* gg = (const f32x4*)g + lane;
#pragma unroll
    for (int j = 0; j < 4; ++j) r.v[j] = r.v[j] * rstd * gg[64 * j]; }
__device__ __forceinline__ void row_store_bf16(const RowV& r, bf16_t* p, int lane) { u32x2* o = (u32x2*)p + lane;
#pragma unroll
    for (int j = 0; j < 4; ++j) { u32x2 w; w.x = pk2(r.v[j].x, r.v[j].y); w.y = pk2(r.v[j].z, r.v[j].w); o[64 * j] = w; } }

__device__ __forceinline__ void row_combine(Frame& F, RowV& r, int t) {
    const int* sl = (const int*)(F.ws + WS_MISC + MS_SLOT) + 2 * t; const float* tw = (const float*)(F.ws + WS_MISC + MS_TOKW) + 2 * t;
    const bf16_t* Y = (const bf16_t*)(F.ws + WS_R + R_YOUT);
    const int s0 = sl[0], s1 = sl[1]; const float w0 = tw[0], w1 = tw[1];
    row_add_bf16(r, Y + (size_t)s0 * DM, w0, F.lane); row_add_bf16(r, Y + (size_t)s1 * DM, w1, F.lane);
}

__device__ __forceinline__ void norm_phase(Frame& F, const float* src, float* X, const float* g, bool combine) {
    bf16_t* H = (bf16_t*)(F.ws + WS_H);
    const int gw = F.vcu * NWAVES + F.wave, NGW = F.G * NWAVES;
    for (int t = gw; t < T; t += NGW) {
        RowV r; row_load(r, src + (size_t)t * DM, F.lane);
        if (combine) { row_combine(F, r, t); row_store(r, X + (size_t)t * DM, F.lane); }
        const float rstd = row_rstd(r); row_scale(r, rstd, g, F.lane);
        row_store_bf16(r, H + (size_t)t * DM, F.lane);
    }
}
__device__ __forceinline__ void final_norm_phase(Frame& F, float* X, const float* g, bool combine) {
    const int gw = F.vcu * NWAVES + F.wave, NGW = F.G * NWAVES;
    for (int t = gw; t < T; t += NGW) {
        RowV r; row_load(r, X + (size_t)t * DM, F.lane);
        if (combine) row_combine(F, r, t);
        const float rstd = row_rstd(r); row_scale(r, rstd, g, F.lane);
        row_store(r, X + (size_t)t * DM, F.lane);
    }
}
__device__ __forceinline__ void memnorm_phase(Frame& F) {
    bf16_t* MN = (bf16_t*)(F.ws + WS_MEMN);
    const int gw = F.vcu * NWAVES + F.wave, NGW = F.G * NWAVES;
    for (int t = gw; t < NB * MEML; t += NGW) {
        RowV r; row_load(r, F.in[I_MEM] + (size_t)t * DM, F.lane);
        const float rstd = row_rstd(r); row_scale(r, rstd, F.in[I_GMEM], F.lane);
        row_store_bf16(r, MN + (size_t)t * DM, F.lane);
    }
}

__device__ __forceinline__ void norm_router_phase(Frame& F, const float* X, const float* g, const float* Wr  ) {
    bf16_t* H = (bf16_t*)(F.ws + WS_H);
    int* toke = (int*)(F.ws + WS_MISC + MS_TOKE); float* tokw = (float*)(F.ws + WS_MISC + MS_TOKW); int* cntg = (int*)(F.ws + WS_MISC + MS_CNT);
    volatile LAS int* hist = (volatile LAS int*)(F.lds + LDSCTL_OFF + 1024);
    for (int c = F.vcu; c < T / 128; c += F.G) {
        if (F.tid < 8) hist[F.tid] = 0;
        __syncthreads();
        for (int q = 0; q < 16; ++q) {
            const int t = c * 128 + F.wave * 16 + q;
            RowV r; row_load(r, X + (size_t)t * DM, F.lane);
            const float rstd = row_rstd(r); row_scale(r, rstd, g, F.lane);
            row_store_bf16(r, H + (size_t)t * DM, F.lane);
            float lg[8];
#pragma unroll
            for (int e = 0; e < 8; ++e) lg[e] = 0.f;
#pragma unroll
            for (int j = 0; j < 4; ++j) {
#pragma unroll
                for (int k = 0; k < 4; ++k) { const int d = 256 * j + 4 * F.lane + k; const f32x4 wa = *(const f32x4*)(Wr + (size_t)d * 8), wb = *(const f32x4*)(Wr + (size_t)d * 8 + 4); const float x = r.v[j][k];
                    lg[0] += x * wa.x; lg[1] += x * wa.y; lg[2] += x * wa.z; lg[3] += x * wa.w; lg[4] += x * wb.x; lg[5] += x * wb.y; lg[6] += x * wb.z; lg[7] += x * wb.w; } }
#pragma unroll
            for (int e = 0; e < 8; ++e) lg[e] = wave_sum(lg[e]);
            int e0 = 0; float v0 = lg[0];
#pragma unroll
            for (int e = 1; e < 8; ++e) if (lg[e] > v0) { v0 = lg[e]; e0 = e; }
            int e1 = -1; float v1 = -INFINITY;
#pragma unroll
            for (int e = 0; e < 8; ++e) if (e != e0 && lg[e] > v1) { v1 = lg[e]; e1 = e; }
            if (F.lane == 0) {
                const float w0 = 1.0f / (1.0f + __expf(v1 - v0));
                toke[2 * t] = e0; toke[2 * t + 1] = e1; tokw[2 * t] = w0; tokw[2 * t + 1] = 1.0f - w0;
                __hip_atomic_fetch_add((LAS int*)&hist[e0], 1, __ATOMIC_RELAXED, __HIP_MEMORY_SCOPE_WORKGROUP); __hip_atomic_fetch_add((LAS int*)&hist[e1], 1, __ATOMIC_RELAXED, __HIP_MEMORY_SCOPE_WORKGROUP);
            }
        }
        __syncthreads();
        if (F.tid < 8) cntg[c * 8 + F.tid] = hist[F.tid];
        __syncthreads();
    }
}
__device__ __forceinline__ void moe_assign_phase(Frame& F) {
    const bf16_t* H = (const bf16_t*)(F.ws + WS_H); bf16_t* AS = (bf16_t*)(F.ws + WS_R + R_ASORT);
    const int* toke = (const int*)(F.ws + WS_MISC + MS_TOKE); int* slot = (int*)(F.ws + WS_MISC + MS_SLOT); const int* cntg = (const int*)(F.ws + WS_MISC + MS_CNT);
    int* texp = (int*)(F.ws + WS_MISC + MS_TEXP);
    volatile LAS int* tot = (volatile LAS int*)(F.lds + LDSCTL_OFF + 1024);
    volatile LAS int* pre = tot + 8;
    volatile LAS int* wcnt = tot + 16;
    for (int c = F.vcu; c < T / 128; c += F.G) {
        if (F.tid < 16) tot[F.tid] = 0;
        __syncthreads();
        { const int cc = F.tid >> 1, h = F.tid & 1; const i32x4 v = *(const i32x4*)(cntg + cc * 8 + 4 * h);
#pragma unroll
          for (int k = 0; k < 4; ++k) { __hip_atomic_fetch_add((LAS int*)&tot[4 * h + k], v[k], __ATOMIC_RELAXED, __HIP_MEMORY_SCOPE_WORKGROUP); if (cc < c) __hip_atomic_fetch_add((LAS int*)&pre[4 * h + k], v[k], __ATOMIC_RELAXED, __HIP_MEMORY_SCOPE_WORKGROUP); } }
        const int t = c * 128 + F.wave * 16 + ((F.lane & 31) >> 1);
        const int my_e = (F.lane < 32) ? toke[2 * t + (F.lane & 1)] : -1;
        int rank = 0;
#pragma unroll
        for (int e = 0; e < 8; ++e) { const unsigned long long m = __ballot(my_e == e); if (my_e == e) rank = __popcll(m & ((1ull << F.lane) - 1ull)); if (F.lane == 0) wcnt[F.wave * 8 + e] = __popcll(m); }
        __syncthreads();
        int myslot = 0;
        if (F.lane < 32) {
            int ts = 0;
#pragma unroll
            for (int e = 0; e < 8; ++e) ts += (e < my_e) ? ((tot[e] + 255) >> 8) : 0;
            int wp = 0; for (int w = 0; w < F.wave; ++w) wp += wcnt[w * 8 + my_e];
            myslot = ts * 256 + pre[my_e] + wp + rank;
            slot[2 * t + (F.lane & 1)] = myslot;
        }
        if (c == 0 && F.tid == 0) { int ts = 0; for (int e = 0; e < 8; ++e) { const int n = (tot[e] + 255) >> 8; for (int k = 0; k < n; ++k) texp[ts + k] = e; ts += n; } for (int k = ts; k < MAXRT; ++k) texp[k] = 0; texp[MAXRT] = ts; }
        for (int a = 0; a < 32; ++a) {
            const int s = __builtin_amdgcn_readlane(myslot, a); const int ta = c * 128 + F.wave * 16 + (a >> 1);
            const u32x4* srcp = (const u32x4*)(H + (size_t)ta * DM) + F.lane; u32x4* dstp = (u32x4*)(AS + (size_t)s * DM) + F.lane;
            const u32x4 x0 = srcp[0], x1 = srcp[64]; dstp[0] = x0; dstp[64] = x1;
        }
        __syncthreads();
    }
}

using pg8::Unit;
typedef f32x4 AccT[2][2][4][2];

struct ProbSimple { int K; unsigned lda, ldb; const char* A; const char* B;
    __device__ __forceinline__ const char* a_ptr(const Unit& u) const { return A + (size_t)u.pm * 256 * lda; }
    __device__ __forceinline__ const char* b_ptr(const Unit& u) const { return B + (size_t)u.pn * 256 * ldb; } };
struct ProbBranch { int K; unsigned lda, ldb; const char* A; const char* B;
    __device__ __forceinline__ const char* a_ptr(const Unit& u) const { return A + (size_t)u.pm * 256 * lda + (size_t)u.aux * 1024; }
    __device__ __forceinline__ const char* b_ptr(const Unit& u) const { return B + (size_t)u.aux * ((size_t)DM * 512 * 2) + (size_t)u.pn * 256 * ldb; } };
struct ProbMoe { int K; unsigned lda, ldb; const char* A; const char* B; int a_lo;
    __device__ __forceinline__ const char* a_ptr(const Unit& u) const { return A + (size_t)(u.pm - a_lo) * 256 * lda; }
    __device__ __forceinline__ const char* b_ptr(const Unit& u) const { return B + (size_t)u.aux * WF_STRIDE + (size_t)u.pn * 256 * ldb; } };

struct SegOrder { pg8::StaticOrder base;
    __device__ bool next(int i, Unit& u) const { if (!base.next(i / 3, u)) return false; u.aux = i % 3; return true; } };
struct MoeOrder { pg8::StaticOrder base; int lo; const int* texp;
    __device__ bool next(int i, Unit& u) const { if (!base.next(i, u)) return false; u.pm += lo; u.aux = texp[u.pm]; return true; } };

__device__ __forceinline__ u32x4 pack8(const f32x4 a, const f32x4 b) { u32x4 w; w.x = cvtpk(a[0], a[1]); w.y = cvtpk(a[2], a[3]); w.z = cvtpk(b[0], b[1]); w.w = cvtpk(b[2], b[3]); return w; }
__device__ __forceinline__ u32x2 pack4(const f32x4 a) { u32x2 w; w.x = cvtpk(a[0], a[1]); w.y = cvtpk(a[2], a[3]); return w; }

struct EpiInproj {
    bf16_t* P; bf16_t* G; float* ssq; const int* pos;
    __device__ __forceinline__ void operator()(const AccT& acc, const Unit& u, int wr, int wc, int fr, int fq) const {
        const int pn = u.pn, row0 = u.pm * 256 + wr * 64 + fr;
        if (pn >= 7) {
#pragma unroll
            for (int ai = 0; ai < 2; ++ai)
#pragma unroll
                for (int m = 0; m < 4; ++m) { const int row = row0 + ai * 128 + m * 16;
#pragma unroll
                    for (int bj = 0; bj < 2; ++bj) { f32x4 a = acc[ai][bj][m][0], b = acc[ai][bj][m][1];
#pragma unroll
                        for (int j = 0; j < 4; ++j) { a[j] = fast_sigmoid(a[j]); b[j] = fast_sigmoid(b[j]); }
                        *(u32x4*)(G + (size_t)row * GW + (pn - 7) * 256 + bj * 128 + wc * 32 + fq * 8) = pack8(a, b); } }
        } else if (pn >= 5 || pn == 3) {
            const float sc = (pn == 3) ? 1.0f : C_M;
#pragma unroll
            for (int ai = 0; ai < 2; ++ai)
#pragma unroll
                for (int m = 0; m < 4; ++m) { const int row = row0 + ai * 128 + m * 16; float s = 0.f;
#pragma unroll
                    for (int bj = 0; bj < 2; ++bj) { const f32x4 a = acc[ai][bj][m][0] * sc, b = acc[ai][bj][m][1] * sc;
                        s += (a[0] * a[0] + a[1] * a[1]) + (a[2] * a[2] + a[3] * a[3]) + (b[0] * b[0] + b[1] * b[1]) + (b[2] * b[2] + b[3] * b[3]);
                        *(u32x4*)(P + (size_t)row * PW + pn * 256 + bj * 128 + wc * 32 + fq * 8) = pack8(a, b); }
                    if (pn == 3) { s += __shfl_xor(s, 16); s += __shfl_xor(s, 32); if (fq == 0) ssq[(size_t)row * 8 + wc] = s; } }
        } else if (pn == 4) {
#pragma unroll
            for (int ai = 0; ai < 2; ++ai)
#pragma unroll
                for (int m = 0; m < 4; ++m) { const int row = row0 + ai * 128 + m * 16;
                    { const f32x4 a = acc[ai][0][m][0], b = acc[ai][0][m][1];
                      float s = (a[0] * a[0] + a[1] * a[1]) + (a[2] * a[2] + a[3] * a[3]) + (b[0] * b[0] + b[1] * b[1]) + (b[2] * b[2] + b[3] * b[3]);
                      *(u32x4*)(P + (size_t)row * PW + P_CKV + wc * 32 + fq * 8) = pack8(a, b);
                      s += __shfl_xor(s, 16); s += __shfl_xor(s, 32); if (fq == 0) ssq[(size_t)row * 8 + 4 + wc] = s; }
                    if (wc == 0) { const f32x4 x1 = acc[ai][1][m][0], x2 = acc[ai][1][m][1]; const float pf = (float)pos[row]; f32x4 o1, o2;
#pragma unroll
                        for (int j = 0; j < 4; ++j) { float c, s; rot_cs(pf, 2 * (4 * fq + j), c, s); o1[j] = x1[j] * c - x2[j] * s; o2[j] = x2[j] * c + x1[j] * s; }
                        *(u32x2*)(P + (size_t)row * PW + P_KR + 4 * fq) = pack4(o1); *(u32x2*)(P + (size_t)row * PW + P_KR + 16 + 4 * fq) = pack4(o2); } }
        } else {
            const float sc = (pn < 2) ? C_A : 1.0f; const int i0 = 16 * (wc & 1) + 4 * fq;
#pragma unroll
            for (int ai = 0; ai < 2; ++ai)
#pragma unroll
                for (int m = 0; m < 4; ++m) { const int row = row0 + ai * 128 + m * 16; const float pf = (float)pos[row]; f32x4 c, s;
#pragma unroll
                    for (int j = 0; j < 4; ++j) { float cc, ss; rot_cs(pf, i0 + j, cc, ss); c[j] = cc * sc; s[j] = ss * sc; }
#pragma unroll
                    for (int bj = 0; bj < 2; ++bj) { const f32x4 x1 = acc[ai][bj][m][0], x2 = acc[ai][bj][m][1];
                        if (pn == 2 && bj == 1) { *(u32x4*)(P + (size_t)row * PW + P_VA + wc * 32 + fq * 8) = pack8(x1, x2); }
                        else { const f32x4 o1 = x1 * c - x2 * s, o2 = x2 * c + x1 * s; bf16_t* d = P + (size_t)row * PW + pn * 256 + 64 * (2 * bj + (wc >> 1)) + i0;
                            *(u32x2*)d = pack4(o1); *(u32x2*)(d + 32) = pack4(o2); } } }
        }
    }
};
struct EpiUp {
    bf16_t* QB; bf16_t* KVB; const float* ssq; const int* pos;
    __device__ __forceinline__ void operator()(const AccT& acc, const Unit& u, int wr, int wc, int fr, int fq) const {
        const int pn = u.pn, row0 = u.pm * 256 + wr * 64 + fr;
#pragma unroll
        for (int ai = 0; ai < 2; ++ai)
#pragma unroll
            for (int m = 0; m < 4; ++m) { const int row = row0 + ai * 128 + m * 16;
                const f32x4 sa = *(const f32x4*)(ssq + (size_t)row * 8), sb = *(const f32x4*)(ssq + (size_t)row * 8 + 4);
                if (pn < 3) {
                    const float rs = C_B / sqrtf(((sa[0] + sa[1]) + (sa[2] + sa[3])) * (1.0f / 256.0f) + EPS);
#pragma unroll
                    for (int bj = 0; bj < 2; ++bj) { const int gg = 8 * pn + 4 * bj + wc; const f32x4 x1 = acc[ai][bj][m][0] * rs, x2 = acc[ai][bj][m][1] * rs;
                        if (gg % 3 == 2) { const float pf = (float)pos[row]; f32x4 o1, o2;
#pragma unroll
                            for (int j = 0; j < 4; ++j) { float c, s; rot_cs(pf, 2 * (4 * fq + j), c, s); o1[j] = x1[j] * c - x2[j] * s; o2[j] = x2[j] * c + x1[j] * s; }
                            bf16_t* d = QB + (size_t)row * QBW + 32 * gg + 4 * fq; *(u32x2*)d = pack4(o1); *(u32x2*)(d + 16) = pack4(o2); }
                        else *(u32x4*)(QB + (size_t)row * QBW + 32 * gg + 8 * fq) = pack8(x1, x2); }
                } else {
                    const float rs = 1.0f / sqrtf(((sb[0] + sb[1]) + (sb[2] + sb[3])) * (1.0f / 128.0f) + EPS);
#pragma unroll
                    for (int bj = 0; bj < 2; ++bj) *(u32x4*)(KVB + (size_t)row * KVW + (pn - 3) * 256 + bj * 128 + wc * 32 + fq * 8) = pack8(acc[ai][bj][m][0] * rs, acc[ai][bj][m][1] * rs);
                } }
    }
};
struct EpiPlain {
    bf16_t* O; int ldo;
    __device__ __forceinline__ void operator()(const AccT& acc, const Unit& u, int wr, int wc, int fr, int fq) const {
        const int row0 = u.pm * 256 + wr * 64 + fr;
#pragma unroll
        for (int ai = 0; ai < 2; ++ai)
#pragma unroll
            for (int m = 0; m < 4; ++m)
#pragma unroll
                for (int bj = 0; bj < 2; ++bj) *(u32x4*)(O + (size_t)(row0 + ai * 128 + m * 16) * ldo + u.pn * 256 + bj * 128 + wc * 32 + fq * 8) = pack8(acc[ai][bj][m][0], acc[ai][bj][m][1]);
    }
};
struct EpiBranch {
    const bf16_t* G; float* scr; bf16_t* MIXED;
    __device__ __forceinline__ void operator()(const AccT& acc, const Unit& u, int wr, int wc, int fr, int fq) const {
        const int seg = u.aux, row0 = u.pm * 256 + wr * 64 + fr; unsigned long long spb = (unsigned long long)((f32x4*)scr + threadIdx.x); asm volatile("" : "+v"(spb)); f32x4* sp = (f32x4*)spb;
#pragma unroll
        for (int ai = 0; ai < 2; ++ai)
#pragma unroll
            for (int m = 0; m < 4; ++m) { const int row = row0 + ai * 128 + m * 16;
#pragma unroll
                for (int bj = 0; bj < 2; ++bj) { const int col = u.pn * 256 + bj * 128 + wc * 32 + fq * 8; const int si = ((ai * 4 + m) * 2 + bj) * 2;
                    const u32x4 gw = *(const u32x4*)(G + (size_t)row * GW + seg * 1024 + col);
                    f32x4 a = acc[ai][bj][m][0], b = acc[ai][bj][m][1];
                    a[0] *= bflo(gw.x); a[1] *= bfhi(gw.x); a[2] *= bflo(gw.y); a[3] *= bfhi(gw.y); b[0] *= bflo(gw.z); b[1] *= bfhi(gw.z); b[2] *= bflo(gw.w); b[3] *= bfhi(gw.w);
                    if (seg > 0) { a += sp[(size_t)si * 512]; b += sp[(size_t)(si + 1) * 512]; }
                    if (seg < 2) { sp[(size_t)si * 512] = a; sp[(size_t)(si + 1) * 512] = b; }
                    else *(u32x4*)(MIXED + (size_t)row * DM + col) = pack8(a, b); }
                asm volatile("" ::: "memory"); }
    }
};
struct EpiResid {
    const float* Xin; float* Xout;
    __device__ __forceinline__ void operator()(const AccT& acc, const Unit& u, int wr, int wc, int fr, int fq) const {
        const int row0 = u.pm * 256 + wr * 64 + fr;
#pragma unroll
        for (int ai = 0; ai < 2; ++ai)
#pragma unroll
            for (int m = 0; m < 4; ++m) {
#pragma unroll
                for (int bj = 0; bj < 2; ++bj)
#pragma unroll
                    for (int n = 0; n < 2; ++n) { const size_t o = (size_t)(row0 + ai * 128 + m * 16) * DM + u.pn * 256 + bj * 128 + wc * 32 + n * 16 + fq * 4;
                        *(f32x4*)(Xout + o) = *(const f32x4*)(Xin + o) + acc[ai][bj][m][n]; }
                asm volatile("" ::: "memory"); }
    }
};
struct EpiSwiglu {
    bf16_t* ACT; int lo;
    __device__ __forceinline__ void operator()(const AccT& acc, const Unit& u, int wr, int wc, int fr, int fq) const {
        const int row0 = (u.pm - lo) * 256 + wr * 64 + fr;
#pragma unroll
        for (int ai = 0; ai < 2; ++ai)
#pragma unroll
            for (int m = 0; m < 4; ++m) { f32x4 a, b;
#pragma unroll
                for (int j = 0; j < 4; ++j) { const float g0 = acc[ai][0][m][0][j], g1 = acc[ai][0][m][1][j]; a[j] = g0 * fast_sigmoid(g0) * acc[ai][1][m][0][j]; b[j] = g1 * fast_sigmoid(g1) * acc[ai][1][m][1][j]; }
                *(u32x4*)(ACT + (size_t)(row0 + ai * 128 + m * 16) * DFF + u.pn * 128 + wc * 32 + fq * 8) = pack8(a, b); }
    }
};
struct EpiYout {
    bf16_t* Y;
    __device__ __forceinline__ void operator()(const AccT& acc, const Unit& u, int wr, int wc, int fr, int fq) const {
        const int row0 = u.pm * 256 + wr * 64 + fr;
#pragma unroll
        for (int ai = 0; ai < 2; ++ai)
#pragma unroll
            for (int m = 0; m < 4; ++m)
#pragma unroll
                for (int bj = 0; bj < 2; ++bj)
#pragma unroll
                    for (int n = 0; n < 2; ++n) *(u32x2*)(Y + (size_t)(row0 + ai * 128 + m * 16) * DM + u.pn * 256 + bj * 128 + wc * 32 + n * 16 + fq * 4) = pack4(acc[ai][bj][m][n]);
    }
};

namespace att {
__device__ __forceinline__ int crow(int r, int hi) { return (r & 3) + 8 * (r >> 2) + 4 * hi; }
__device__ __forceinline__ void glds16(const void* gsrc, unsigned lds_dst) { unsigned keep;
    asm volatile("s_mov_b32 %0, m0\n\ts_mov_b32 m0, %2\n\ts_nop 0\n\tglobal_load_lds_dwordx4 %1, off\n\ts_mov_b32 m0, %0" : "=&s"(keep) : "v"(gsrc), "s"(lds_dst) : "memory"); }
__device__ __forceinline__ float swapmax(float m) { auto rr = __builtin_amdgcn_permlane32_swap(__float_as_uint(m), __float_as_uint(m), false, false); return fmaxf(__uint_as_float(rr[0]), __uint_as_float(rr[1])); }
__device__ __forceinline__ float swapsum(float m) { auto rr = __builtin_amdgcn_permlane32_swap(__float_as_uint(m), __float_as_uint(m), false, false); return __uint_as_float(rr[0]) + __uint_as_float(rr[1]); }
__device__ __forceinline__ s16x4 vtr(unsigned addr) { s16x4 r; asm volatile("ds_read_b64_tr_b16 %0, %1" : "=&v"(r) : "v"(addr) : "memory"); return r; }

struct Src {
    const bf16_t* q; int qpitch;
    const bf16_t* k0; int k0pitch;
    const bf16_t* k1; int k1pitch;
    const bf16_t* v; int vpitch;
    bf16_t* o; int opitch;
};
template <int NKC, int NVB>
__device__ __forceinline__ void dma_tile(const Src& S, int t, int slot, unsigned lds0, int wid, int lane) {
    constexpr int KS = NKC * 1024, VS = NVB * 4096, LDS_K = 0, LDS_V = 2 * KS;
#pragma unroll
    for (int c = 0; c < (NKC + 7) / 8; ++c) { const int ch = wid + 8 * c; if (ch < NKC) {
        const bf16_t* src = (ch < 8) ? S.k0 + (size_t)(t * 64 + lane) * S.k0pitch + ch * 8 : S.k1 + (size_t)(t * 64 + lane) * S.k1pitch + (ch - 8) * 8;
        glds16(src, (unsigned)__builtin_amdgcn_readfirstlane(lds0 + LDS_K + slot * KS + ch * 1024)); } }
#pragma unroll
    for (int c = 0; c < (NVB * 4 + 7) / 8; ++c) { const int p = wid + 8 * c; if (p < NVB * 4) {
        const bf16_t* src = S.v + (size_t)(t * 64 + 16 * (p & 3) + (lane >> 2)) * S.vpitch + (p >> 2) * 32 + (lane & 3) * 8;
        glds16(src, (unsigned)__builtin_amdgcn_readfirstlane(lds0 + LDS_V + slot * VS + p * 1024)); } }
}
template <int NKC, int NVB, int MODE>
__device__ __forceinline__ void unit(LAS unsigned char* lds, const Src& S, int t_lo, int t_hi, int qpos0  , float sink_l2) {
    constexpr int KS = NKC * 1024, VS = NVB * 4096, LDS_K = 0, LDS_V = 2 * KS;
    const int tid = opq_v((int)threadIdx.x), lane = tid & 63, r32 = lane & 31, hi = lane >> 5; const int wid = __builtin_amdgcn_readfirstlane(tid >> 6);
    const unsigned lds0 = (unsigned)(uintptr_t)lds;
    bf16x8 qr[NKC / 2];
#pragma unroll
    for (int d0 = 0; d0 < NKC / 2; ++d0) qr[d0] = *(const bf16x8*)(S.q + (size_t)r32 * S.qpitch + d0 * 16 + hi * 8);
    float m_run = (MODE == 0) ? sink_l2 : -INFINITY, l_run = (MODE == 0 && hi == 0) ? 1.0f : 0.0f;
    f32x16 o[NVB];
#pragma unroll
    for (int d = 0; d < NVB; ++d) o[d] = f32x16{};
    const int qi = qpos0 + wid * 32 + r32;
    const int qw0 = qpos0 + wid * 32;
    dma_tile<NKC, NVB>(S, t_lo, 0, lds0, wid, lane);
    for (int t = t_lo; t < t_hi; ++t) {
        const int slot = (t - t_lo) & 1;
        asm volatile("s_waitcnt vmcnt(0) lgkmcnt(0)\n\ts_barrier" ::: "memory");
        if (t + 1 < t_hi) dma_tile<NKC, NVB>(S, t + 1, slot ^ 1, lds0, wid, lane);
        bool active = true;
        if (MODE == 0) active = (64 * t + 63 >= qw0 - 128) && (64 * t <= qw0 + 31 + 128);
        if (active) {
            const LAS unsigned char* kb = lds + LDS_K + slot * KS + hi * 1024 + r32 * 16;
            f32x16 p0 = f32x16{}, p1 = f32x16{};
#pragma unroll
            for (int d0 = 0; d0 < NKC / 2; ++d0) {
                const bf16x8 b0 = *(const LAS bf16x8*)(kb + d0 * 2048), b1 = *(const LAS bf16x8*)(kb + d0 * 2048 + 512);
                p0 = __builtin_amdgcn_mfma_f32_32x32x16_bf16(b0, qr[d0], p0, 0, 0, 0); p1 = __builtin_amdgcn_mfma_f32_32x32x16_bf16(b1, qr[d0], p1, 0, 0, 0); }
            if (MODE == 0) {
#pragma unroll
                for (int r = 0; r < 16; ++r) { const int kv = 64 * t + crow(r, hi); int d0 = kv - qi; d0 = d0 < 0 ? -d0 : d0; int d1 = kv + 32 - qi; d1 = d1 < 0 ? -d1 : d1;
                    if (d0 > 128) p0[r] = -INFINITY; if (d1 > 128) p1[r] = -INFINITY; }
            }
            float rm = fmaxf(p0[0], p1[0]);
#pragma unroll
            for (int r = 1; r < 16; ++r) rm = fmaxf(rm, fmaxf(p0[r], p1[r]));
            rm = swapmax(rm);
            const float mn = fmaxf(m_run, rm), alpha = __builtin_amdgcn_exp2f(m_run - mn); m_run = mn;
            float sum = 0.f;
#pragma unroll
            for (int r = 0; r < 16; ++r) { p0[r] = __builtin_amdgcn_exp2f(p0[r] - mn); p1[r] = __builtin_amdgcn_exp2f(p1[r] - mn); sum += p0[r] + p1[r]; }
            l_run = l_run * alpha + sum;
#pragma unroll
            for (int d = 0; d < NVB; ++d)
#pragma unroll
                for (int r = 0; r < 16; ++r) o[d][r] *= alpha;
            u32x4 pw[4];
            pw[0] = (u32x4){cvtpk(p0[0], p0[1]), cvtpk(p0[2], p0[3]), cvtpk(p0[4], p0[5]), cvtpk(p0[6], p0[7])};
            pw[1] = (u32x4){cvtpk(p0[8], p0[9]), cvtpk(p0[10], p0[11]), cvtpk(p0[12], p0[13]), cvtpk(p0[14], p0[15])};
            pw[2] = (u32x4){cvtpk(p1[0], p1[1]), cvtpk(p1[2], p1[3]), cvtpk(p1[4], p1[5]), cvtpk(p1[6], p1[7])};
            pw[3] = (u32x4){cvtpk(p1[8], p1[9]), cvtpk(p1[10], p1[11]), cvtpk(p1[12], p1[13]), cvtpk(p1[14], p1[15])};
            const unsigned vb = lds0 + LDS_V + slot * VS + ((lane >> 4) & 1) * 32 + (lane & 3) * 8 + (4 * hi + ((lane & 15) >> 2)) * 64;
#pragma unroll
            for (int d = 0; d < NVB; ++d) {
                s16x4 lo[4], hh[4];
#pragma unroll
                for (int ks = 0; ks < 4; ++ks) { lo[ks] = vtr(vb + d * 4096 + ks * 1024); hh[ks] = vtr(vb + d * 4096 + ks * 1024 + 512); }
                asm volatile("s_waitcnt lgkmcnt(0)" ::: "memory"); __builtin_amdgcn_sched_barrier(0);
#pragma unroll
                for (int ks = 0; ks < 4; ++ks) { const bf16x8 vf = (bf16x8){lo[ks][0], lo[ks][1], lo[ks][2], lo[ks][3], hh[ks][0], hh[ks][1], hh[ks][2], hh[ks][3]};
                    o[d] = __builtin_amdgcn_mfma_f32_32x32x16_bf16(vf, __builtin_bit_cast(bf16x8, pw[ks]), o[d], 0, 0, 0); }
            }
        }
    }
    const float linv = 1.0f / swapsum(l_run);
#pragma unroll
    for (int d = 0; d < NVB; ++d)
#pragma unroll
        for (int r4 = 0; r4 < 4; ++r4) { f32x4 v = {o[d][4 * r4] * linv, o[d][4 * r4 + 1] * linv, o[d][4 * r4 + 2] * linv, o[d][4 * r4 + 3] * linv};
            *(u32x2*)(S.o + (size_t)r32 * S.opitch + 32 * d + 8 * r4 + 4 * hi) = pack4(v); }
    asm volatile("s_waitcnt lgkmcnt(0)\n\ts_barrier" ::: "memory");
}
}
#define SC_AFTER_PROLOGUE() do {} while (0)
#define SC_AFTER_INPROJ(l) do {} while (0)
#define SC_AFTER_UP(l) do {} while (0)
#define SC_AFTER_MLA(l) do {} while (0)
#define SC_AFTER_BRANCH(l) do {} while (0)
#define SC_AFTER_WOUT(l) do {} while (0)
#define SC_AFTER_NORM2(l) do {} while (0)
#define SC_AFTER_GU(l) do {} while (0)
#define SC_AFTER_DOWN(l) do {} while (0)
#define SC_AFTER_ROUTE(l) do {} while (0)
#define SC_AFTER_MOEGU(l, h) do {} while (0)
#define SC_AFTER_MOED(l, h) do {} while (0)
#define SC_FINAL() do {} while (0)

struct Args { const float* in[23]; float* out; unsigned char* ws; };
#define WSP(type, off) ((type*)(F.ws + (off)))
#define PHASE() Frame Fp = F; Fp.ws = opq_p(F.ws); Fp.in = opq_p(F.in); Fp.out = opq_p(F.out); Fp.tid = opq_v((int)threadIdx.x); Fp.lane = Fp.tid & 63; Fp.wave = __builtin_amdgcn_readfirstlane(Fp.tid >> 6); (void)Fp
#define FWS(type, off) ((type*)(Fp.ws + (off)))
#define X_ (Fp.out)
#define H_ FWS(bf16_t, WS_H)
#define Pb_ FWS(bf16_t, WS_R + R_P)
#define Gb_ FWS(bf16_t, WS_R + R_G)
#define QB_ FWS(bf16_t, WS_R + R_QB)
#define KVB_ FWS(bf16_t, WS_R + R_KVB)
#define Yb_ FWS(bf16_t, WS_R + R_Y)
#define MEMN_ FWS(bf16_t, WS_MEMN)
#define MEMKV_ FWS(bf16_t, WS_MEMKV)
#define ACT_ FWS(bf16_t, WS_R + R_ACT)
#define ASORT_ FWS(bf16_t, WS_R + R_ASORT)
#define YOUT_ FWS(bf16_t, WS_R + R_YOUT)
#define SSQ_ FWS(float, WS_MISC + MS_SSQ)
#define TEXP_ FWS(const int, WS_MISC + MS_TEXP)
#define POS_ ((const int*)Fp.in[I_POS])

#define GRID_BAR() xcd_barrier(bar)
template <int l> __device__ __forceinline__ void layer_body(const Frame& F, const XcdBarrier& bar, const int bx) {
        if (l > 0) {
            PHASE();
            prep_ffn_weights(Fp, l);
            norm_phase(Fp, X_, X_, Fp.in[I_GMIX] + l * DM, (l & 1) == 0);
            GRID_BAR();
        }
        {   PHASE();
            ProbSimple p{DM, DM * 2, DM * 2, (const char*)H_, (const char*)wmix(Fp, l, WL_IN)}; pg8::StaticOrder S; S.init(T / 256, NT_IN, Fp.G, bx);
            EpiInproj E{Pb_, Gb_, SSQ_, POS_}; pg8::gemm_phase(Fp.lds, p, S, E); }
        if (l == 0) { PHASE();
            ProbSimple p{DM, DM * 2, DM * 2, (const char*)MEMN_, (const char*)FWS(bf16_t, WS_WMKV)}; pg8::StaticOrder S; S.init(NB * MEML / 256, 16, Fp.G, bx);
            EpiPlain E{MEMKV_, 4096}; pg8::gemm_phase(Fp.lds, p, S, E); }
        GRID_BAR();
        SC_AFTER_INPROJ(l);
        {   PHASE();
            ProbSimple p{UPK, PW * 2, UPK * 2, (const char*)(Pb_ + P_CQ), (const char*)wmix(Fp, l, WL_UP)}; pg8::StaticOrder S; S.init(T / 256, UPN / 256, Fp.G, bx);
            EpiUp E{QB_, KVB_, SSQ_, POS_}; pg8::gemm_phase(Fp.lds, p, S, E); }
        {   PHASE();
            for (int i = Fp.vcu; i < 1024; i += Fp.G) {
                const int hl = i & 3, qb = (i >> 2) & 15, kvh = (i >> 6) & 1, b = i >> 7, h = kvh * 4 + hl; const size_t rowb = (size_t)b * SEQ; const int q0 = qb * 256;
                att::Src s; s.q = Pb_ + (rowb + q0 + Fp.wave * 32) * PW + P_QA + h * 64; s.qpitch = PW; s.k0 = Pb_ + rowb * PW + P_KA + kvh * 64; s.k0pitch = PW; s.k1 = s.k0; s.k1pitch = PW;
                s.v = Pb_ + rowb * PW + P_VA + kvh * 64; s.vpitch = PW; s.o = Yb_ + (rowb + q0 + Fp.wave * 32) * YW + h * 64; s.opitch = YW;
                const int t_lo = (q0 / 64 - 2) < 0 ? 0 : (q0 / 64 - 2), t_hi = (q0 / 64 + 6) > SEQ / 64 ? SEQ / 64 : (q0 / 64 + 6);
                att::unit<8, 2, 0>(Fp.lds, s, t_lo, t_hi, q0, Fp.in[I_SINK][l * 8 + h] * LOG2E);
            } }
        {   PHASE();
            for (int i = Fp.vcu; i < 512; i += Fp.G) {
                const int qb = i & 15, h = (i >> 4) & 3, b = i >> 6; const size_t rowq = (size_t)b * SEQ + qb * 256 + Fp.wave * 32;
                att::Src s; s.q = Pb_ + rowq * PW + P_QM + h * 128; s.qpitch = PW; s.k0 = MEMKV_ + (size_t)b * MEML * 4096 + l * 1024 + h * 128; s.k0pitch = 4096; s.k1 = s.k0 + 64; s.k1pitch = 4096;
                s.v = MEMKV_ + (size_t)b * MEML * 4096 + l * 1024 + 512 + h * 128; s.vpitch = 4096; s.o = Yb_ + rowq * YW + 1024 + h * 128; s.opitch = YW;
                att::unit<16, 4, 1>(Fp.lds, s, 0, MEML / 64, 0, 0.f);
            } }
        GRID_BAR();
        SC_AFTER_UP(l);
        {   PHASE();
            for (int i = Fp.vcu; i < 1024; i += Fp.G) {
                const int qb = i & 15, h = (i >> 4) & 7, b = i >> 7; const size_t rowb = (size_t)b * SEQ, rowq = rowb + qb * 256 + Fp.wave * 32;
                att::Src s; s.q = QB_ + rowq * QBW + h * 96; s.qpitch = QBW; s.k0 = KVB_ + rowb * KVW + h * 128; s.k0pitch = KVW; s.k1 = Pb_ + rowb * PW + P_KR; s.k1pitch = PW;
                s.v = KVB_ + rowb * KVW + h * 128 + 64; s.vpitch = KVW; s.o = Yb_ + rowq * YW + 512 + h * 64; s.opitch = YW;
                att::unit<12, 2, 1>(Fp.lds, s, 0, SEQ / 64, 0, 0.f);
            } }
        GRID_BAR();
        SC_AFTER_MLA(l);
        {   PHASE();
            ProbBranch p{512, YW * 2, 512 * 2, (const char*)Yb_, (const char*)wmix(Fp, l, WL_BR)}; SegOrder S; S.base.init(T / 256, DM / 256, Fp.G, bx);
            EpiBranch E{Gb_, FWS(float, WS_R + R_BRS) + (size_t)bx * 65536, H_}; pg8::gemm_phase(Fp.lds, p, S, E); }
        GRID_BAR();
        SC_AFTER_BRANCH(l);
        {   PHASE();
            ProbSimple p{DM, DM * 2, DM * 2, (const char*)H_, (const char*)wmix(Fp, l, WL_OUT)}; pg8::StaticOrder S; S.init(T / 256, DM / 256, Fp.G, bx);
            EpiResid E{l == 0 ? Fp.in[I_X] : X_, X_}; pg8::gemm_phase(Fp.lds, p, S, E); }
        GRID_BAR();
        SC_AFTER_WOUT(l);
        if ((l & 1) == 0) {
            {   PHASE(); norm_phase(Fp, X_, nullptr, Fp.in[I_GFFN] + l * DM, false); }
            GRID_BAR();
            SC_AFTER_NORM2(l);
            {   PHASE();
                ProbSimple p{DM, DM * 2, DM * 2, (const char*)H_, (const char*)FWS(bf16_t, WS_WFFN + WF_GU)}; pg8::StaticOrder S; S.init(T / 256, 2 * DFF / 256, Fp.G, bx);
                EpiSwiglu E{ACT_, 0}; pg8::gemm_phase(Fp.lds, p, S, E); }
            GRID_BAR();
            SC_AFTER_GU(l);
            {   PHASE();
                ProbSimple p{DFF, DFF * 2, DFF * 2, (const char*)ACT_, (const char*)FWS(bf16_t, WS_WFFN + WF_D)}; pg8::StaticOrder S; S.init(T / 256, DM / 256, Fp.G, bx);
                EpiResid E{X_, X_}; pg8::gemm_phase(Fp.lds, p, S, E); }
            GRID_BAR();
            SC_AFTER_DOWN(l);
        } else {
            {   PHASE(); norm_router_phase(Fp, X_, Fp.in[I_GFFN] + l * DM, Fp.in[I_WR] + (size_t)(l >> 1) * DM * NE); }
            GRID_BAR();
            {   PHASE(); moe_assign_phase(Fp); }
            GRID_BAR();
            SC_AFTER_ROUTE(l);
#pragma unroll
            for (int half = 0; half < 2; ++half) {
                {   PHASE();
                    const int nrt = TEXP_[MAXRT]; const int lo = half * HALF_RT; int n = nrt - lo; n = n < 0 ? 0 : (n > HALF_RT ? HALF_RT : n);
                    ProbMoe p{DM, DM * 2, DM * 2, (const char*)ASORT_, (const char*)FWS(bf16_t, WS_WFFN + WF_GU), 0}; MoeOrder S; S.base.init(n, 2 * DFF / 256, Fp.G, bx); S.lo = lo; S.texp = TEXP_;
                    EpiSwiglu E{ACT_, lo}; pg8::gemm_phase(Fp.lds, p, S, E); }
                GRID_BAR();
                SC_AFTER_MOEGU(l, half);
                {   PHASE();
                    const int nrt = TEXP_[MAXRT]; const int lo = half * HALF_RT; int n = nrt - lo; n = n < 0 ? 0 : (n > HALF_RT ? HALF_RT : n);
                    ProbMoe p{DFF, DFF * 2, DFF * 2, (const char*)ACT_, (const char*)FWS(bf16_t, WS_WFFN + WF_D), lo}; MoeOrder S; S.base.init(n, DM / 256, Fp.G, bx); S.lo = lo; S.texp = TEXP_;
                    EpiYout E{YOUT_}; pg8::gemm_phase(Fp.lds, p, S, E); }
                GRID_BAR();
                SC_AFTER_MOED(l, half);
            }
        }
    }

__global__ void __launch_bounds__(NWAVES * 64, 2) fwd(Args args) {
    extern __shared__ __attribute__((aligned(16))) unsigned char lds_raw[];
    Frame F;
    F.lds = (LAS unsigned char*)lds_raw;
    F.MISC = (volatile LAS unsigned*)(F.lds + LDSCTL_OFF);
    F.tid = threadIdx.x; F.lane = F.tid & 63; F.wave = __builtin_amdgcn_readfirstlane(F.tid >> 6);
    F.G = gridDim.x; { const int bx = blockIdx.x; F.vcu = (F.G % 8 == 0) ? (bx % 8) * (F.G / 8) + bx / 8 : bx; }
    F.ws = args.ws; F.ctl = (gu32*)(args.ws + WS_CTL); F.out = args.out;
    F.in = (const float* const*)__builtin_amdgcn_kernarg_segment_ptr();
    for (int u = F.tid; u < (LDS_BYTES - LDSCTL_OFF) / 4; u += NWAVES * 64) ((LAS unsigned*)(F.lds + LDSCTL_OFF))[u] = 0u;
    __syncthreads();
    XcdBarrier bar = xcd_barrier_post((unsigned*)(F.ctl + CW_BAR), F.MISC + 8);

    const int bx = (int)blockIdx.x;

    {   PHASE();
        prep_mixer_weights(Fp);
        memnorm_phase(Fp);
        prep_ffn_weights(Fp, 0);
        norm_phase(Fp, Fp.in[I_X], nullptr, Fp.in[I_GMIX], false); }
    GRID_BAR();
    SC_AFTER_PROLOGUE();

    layer_body<0>(F, bar, bx); layer_body<1>(F, bar, bx); layer_body<2>(F, bar, bx); layer_body<3>(F, bar, bx);
    {   PHASE(); final_norm_phase(Fp, X_, Fp.in[I_GFIN], true); }
    SC_FINAL();
}

extern "C" void kernel_launch(void* const* d_in, const int* in_sizes, int n_in, void* d_out, int out_size, void* d_ws, size_t ws_size, hipStream_t stream) {
    static int grid = 0;
    if (grid == 0) {
        if (n_in != 23 || out_size != T * DM || ws_size < WS_END) { fprintf(stderr, "kernel_launch: unexpected problem (n_in %d, out %d, ws %zu < %zu)\n", n_in, out_size, ws_size, (size_t)WS_END); grid = -1; return; }
        int dev = 0, cus = 0;
        if (hipGetDevice(&dev) != hipSuccess || hipDeviceGetAttribute(&cus, hipDeviceAttributeMultiprocessorCount, dev) != hipSuccess) { grid = -1; return; }
        if (hipFuncSetAttribute((const void*)fwd, hipFuncAttributeMaxDynamicSharedMemorySize, LDS_BYTES) != hipSuccess) { fprintf(stderr, "kernel_launch: hipFuncSetAttribute failed\n"); grid = -1; return; }
        int per_cu = 0;
        if (hipOccupancyMaxActiveBlocksPerMultiprocessor(&per_cu, (const void*)fwd, NWAVES * 64, LDS_BYTES) != hipSuccess || per_cu < 1) fprintf(stderr, "kernel_launch: occupancy query says %d\n", per_cu);
        (void)hipGetLastError();
        grid = cus;
    }
    if (grid < 0) return;
    if (hipMemsetAsync((char*)d_ws + WS_CTL, 0, CTL_ZERO_BYTES, stream) != hipSuccess) return;
    Args a{};
    for (int i = 0; i < 23; ++i) a.in[i] = (const float*)d_in[i];
    a.out = (float*)d_out; a.ws = (unsigned char*)d_ws;
    hipLaunchKernelGGL(fwd, dim3(grid), dim3(NWAVES * 64), LDS_BYTES, stream, a);
}
```

```cpp
#include <hip/hip_runtime.h>
#include <cstdio>
#include <cstdint>

#ifndef SELFCHECK
#define SELFCHECK 0
#endif
#ifndef GU_I8_MASK
#define GU_I8_MASK 0xF
#endif
#define GU_I8(l) ((((unsigned)GU_I8_MASK) >> (l)) & 1u)

#define GAS __attribute__((address_space(1)))
#define LAS __attribute__((address_space(3)))
typedef unsigned short bf16_t;
typedef short bf16x8 __attribute__((ext_vector_type(8)));
typedef short s16x4 __attribute__((ext_vector_type(4)));
typedef short v4i16_t __attribute__((ext_vector_type(4)));
typedef float f32x2 __attribute__((ext_vector_type(2)));
typedef float f32x4 __attribute__((ext_vector_type(4)));
typedef float f32x16 __attribute__((ext_vector_type(16)));
typedef unsigned u32x2 __attribute__((ext_vector_type(2)));
typedef unsigned u32x4 __attribute__((ext_vector_type(4)));
typedef int i32x4 __attribute__((ext_vector_type(4)));
typedef GAS unsigned gu32;
#define RLX_AGENT __ATOMIC_RELAXED, __HIP_MEMORY_SCOPE_AGENT

constexpr int NB = 8, SEQ = 4096, T = NB * SEQ, DM = 1024, DEPTH = 4, MEML = 256, DFF = 3584, NE = 8;
constexpr int INW = 4768;
constexpr int PW = 1792;
constexpr int GW = 3072;
constexpr int QBW = 768, KVW = 1024, YW = 1536;
constexpr int NT_IN = 19;
constexpr int P_QA = 0, P_KA = 512, P_VA = 640, P_CQ = 768, P_CKV = 1024, P_KR = 1152, P_QM = 1280;
constexpr int UPK = 384, UPN = 1792;
constexpr int MAXSLOT = 67584;
constexpr int MAXRT = MAXSLOT / 256;
constexpr int HALF_RT = 132;
constexpr float EPS = 1e-6f;
constexpr float LOG2E = 1.4426950408889634f;
constexpr float C_A = 0.125f * LOG2E;
constexpr float C_B = 0.10206207261596575f * LOG2E;
constexpr float C_M = 0.08838834764831845f * LOG2E;

constexpr size_t MiB = 1u << 20;
constexpr size_t WS_CTL = 0, CTL_ZERO_BYTES = 1 * MiB;
constexpr size_t WS_MISC = 1 * MiB;
constexpr size_t WL_IN = 0, WL_UP = (size_t)NT_IN * 256 * DM * 2, WL_BR = WL_UP + (size_t)UPN * UPK * 2, WL_OUT = WL_BR + (size_t)3 * DM * 512 * 2, WL_SIZE = WL_OUT + (size_t)DM * DM * 2;
constexpr size_t WS_WMIX = 8 * MiB;
constexpr size_t WS_WMKV = WS_WMIX + 4 * ((WL_SIZE + MiB - 1) / MiB) * MiB;
constexpr size_t WL_STRIDE = ((WL_SIZE + MiB - 1) / MiB) * MiB;
constexpr size_t WS_WFFN = WS_WMKV + 8 * MiB;
constexpr size_t WF_GU = 0, WF_D = (size_t)2 * DFF * DM * 2, WF_STRIDE = WF_D + (size_t)DM * DFF * 2;
constexpr size_t WS_H = WS_WFFN + 8 * WF_STRIDE;
constexpr size_t WS_MEMN = WS_H + (size_t)T * DM * 2;
constexpr size_t WS_MEMKV = WS_MEMN + (size_t)NB * MEML * DM * 2;
constexpr size_t WS_R = WS_MEMKV + (size_t)NB * MEML * 4096 * 2;
constexpr size_t R_P = 0, R_G = R_P + (size_t)T * PW * 2, R_QB = R_G + (size_t)T * GW * 2, R_KVB = R_QB + (size_t)T * QBW * 2, R_Y = R_KVB + (size_t)T * KVW * 2, R_END_MIX = R_Y + (size_t)T * YW * 2;
constexpr size_t R_BRS = R_P;
constexpr size_t R_ACT = 0;
constexpr size_t R_ASORT = (size_t)MAXSLOT * DFF * 2;
constexpr size_t R_YOUT = R_ASORT;
constexpr size_t R_END_FFN = R_YOUT + (size_t)MAXSLOT * DM * 2;
constexpr size_t R_SIZE = R_END_MIX > R_END_FFN ? R_END_MIX : R_END_FFN;
constexpr size_t WS_END = WS_R + R_SIZE;
static_assert(WS_END < 1020ull * MiB, "workspace budget");
constexpr size_t MS_TOKE = 0;
constexpr size_t MS_TOKW = MS_TOKE + (size_t)T * 8;
constexpr size_t MS_SLOT = MS_TOKW + (size_t)T * 8;
constexpr size_t MS_CNT = MS_SLOT + (size_t)T * 8;
constexpr size_t MS_TEXP = MS_CNT + 256 * 8 * 4;
constexpr size_t MS_SSQ = MS_TEXP + 2048;
constexpr size_t MS_SNAP = MS_SSQ + (size_t)T * 32;
constexpr size_t MS_HSC = MS_SNAP + 64 * 1024 * 4;
constexpr size_t MS_ASC = MS_HSC + (size_t)T * 4;
constexpr size_t MS_WSIN = MS_ASC + (size_t)MAXSLOT * 4;
constexpr size_t MS_WSGU = MS_WSIN + (size_t)4 * NT_IN * 256 * 4;
constexpr size_t MS_END = MS_WSGU + (size_t)8 * 2 * DFF * 4;
static_assert(MS_END <= 7 * MiB, "misc map");
constexpr int CW_BAR = 4096;
constexpr int CW_DIAG = 16384;
constexpr int CW_CODE = 16384 + 512;

constexpr int RING_BYTES = 131072;
constexpr int LDSCTL_OFF = RING_BYTES;
constexpr int LDS_BYTES = 147456;
constexpr int NWAVES = 8;

#define LDS_WAIT() asm volatile("s_waitcnt lgkmcnt(0)" ::: "memory")
#define VM_WAIT() asm volatile("s_waitcnt vmcnt(0)" ::: "memory")

__device__ __forceinline__ unsigned f2bf(float f) { unsigned u = __builtin_bit_cast(unsigned, f); return (u + 0x7fffu + ((u >> 16) & 1u)) >> 16; }
__device__ __forceinline__ unsigned pk2(float lo, float hi) { return f2bf(lo) | (f2bf(hi) << 16); }
__device__ __forceinline__ float bf2f(unsigned short b) { return __builtin_bit_cast(float, (unsigned)b << 16); }
__device__ __forceinline__ float bflo(unsigned w) { return __builtin_bit_cast(float, w << 16); }
__device__ __forceinline__ float bfhi(unsigned w) { return __builtin_bit_cast(float, w & 0xffff0000u); }
typedef __bf16 bf16x2_t __attribute__((ext_vector_type(2)));
__device__ __forceinline__ unsigned cvtpk(float lo, float hi) { f32x2 v = {lo, hi}; bf16x2_t b = __builtin_convertvector(v, bf16x2_t); return __builtin_bit_cast(unsigned, b); }
__device__ __forceinline__ float wave_sum(float v) {
#pragma unroll
    for (int o = 1; o < 64; o <<= 1) v += __shfl_xor(v, o);
    return v;
}
__device__ __forceinline__ float fast_sigmoid(float x) { return __builtin_amdgcn_rcpf(1.0f + __builtin_amdgcn_exp2f(-x * LOG2E)); }


__device__ __forceinline__ int opq_v(int x) { asm volatile("" : "+v"(x)); return x; }
__device__ __forceinline__ int opq_s(int x) { asm volatile("" : "+s"(x)); return x; }
template <class Tp> __device__ __forceinline__ Tp* opq_p(Tp* p) { const unsigned long long u = (unsigned long long)p; unsigned lo = __builtin_amdgcn_readfirstlane((unsigned)u), hi = __builtin_amdgcn_readfirstlane((unsigned)(u >> 32)); asm volatile("" : "+s"(lo), "+s"(hi)); return (Tp*)(((unsigned long long)hi << 32) | lo); }

__constant__ float IFR_HI[32] = {1.591549367e-01f, 1.193493679e-01f, 8.949939907e-02f, 6.711508334e-02f, 5.032921210e-02f, 3.774158657e-02f, 2.830219641e-02f, 2.122365311e-02f, 1.591549441e-02f, 1.193493698e-02f, 8.949940093e-03f, 6.711508147e-03f, 5.032921210e-03f, 3.774158424e-03f, 2.830219688e-03f, 2.122365171e-03f, 1.591549488e-03f, 1.193493721e-03f, 8.949940093e-04f, 6.711508031e-04f, 5.032921326e-04f, 3.774158540e-04f, 2.830219455e-04f, 2.122365258e-04f, 1.591549371e-04f, 1.193493736e-04f, 8.949940093e-05f, 6.711508468e-05f, 5.032921035e-05f, 3.774158540e-05f, 2.830219637e-05f, 2.122365186e-05f};
__constant__ float IFR_LO[32] = {6.420638243e-09f, 2.294664903e-09f, 2.542919653e-09f, -3.316028840e-10f, 5.173299289e-12f, -1.848551645e-09f, -5.826552019e-10f, -3.431038786e-10f, -1.029942243e-10f, 4.320196978e-11f, 6.802745173e-11f, 1.531042237e-10f, 5.173301024e-13f, 4.797548470e-11f, -1.048316434e-10f, 1.053879969e-10f, -5.686555046e-11f, -1.896286773e-11f, 6.802744999e-12f, 2.695195456e-11f, -1.158979943e-11f, -6.843983713e-12f, 1.279990003e-11f, 1.807650600e-12f, 5.954976963e-12f, -3.351478166e-12f, 6.802745216e-13f, -1.670379113e-12f, 1.751403167e-12f, -6.843983930e-13f, -5.389994549e-13f, 9.083608431e-13f};
__device__ __forceinline__ void rot_cs(float posf, int idx, float& c, float& s) {
    const float ch = IFR_HI[idx], cl = IFR_LO[idx];
    const float p = posf * ch, e = __builtin_fmaf(posf, ch, -p);
    const float fr = __builtin_amdgcn_fractf(p) + (e + posf * cl);
    s = __builtin_amdgcn_sinf(fr); c = __builtin_amdgcn_cosf(fr);
}

#define XB_TMO      128
#define XB_XCNT(j)  (256  + 64 * (j))
#define XB_XSUB(j)  (1280 + 64 * (j))
#define XB_XGEN(j)  (2304 + 64 * (j))
#define XB_TOP      3328
#define XB_TOPGEN   3392
#define XCD_BAR_WORDS 3456
#define XB_SPIN_CAP (1u << 20)

__device__ __forceinline__ unsigned xb_ld(unsigned* p)              { return __hip_atomic_load(p, __ATOMIC_RELAXED, __HIP_MEMORY_SCOPE_AGENT); }
__device__ __forceinline__ unsigned xb_add(unsigned* p, unsigned v) { return __hip_atomic_fetch_add(p, v, __ATOMIC_RELAXED, __HIP_MEMORY_SCOPE_AGENT); }
__device__ __forceinline__ unsigned xb_xcc_id() { return (unsigned)__builtin_amdgcn_s_getreg((3 << 11) | 20) & 0xFu; }
#define XB_SPIN(cond, bar) do { unsigned _sp = 0; while (cond) { __builtin_amdgcn_s_sleep(1); \
    if ((++_sp & 255u) == 0u) { if (xb_ld(&(bar)[XB_TMO])) break; if (_sp > XB_SPIN_CAP) { atomicAdd(&(bar)[XB_TMO], 1u); break; } } } } while (0)

struct XcdBarrier { unsigned* bar; unsigned x; volatile LAS unsigned* st; };

__device__ __forceinline__ XcdBarrier xcd_barrier_post(unsigned* bar, volatile LAS unsigned* st) {
    XcdBarrier b; b.bar = bar; b.x = xb_xcc_id(); b.st = st;
    if (threadIdx.x == 0) (void)xb_add(&bar[XB_XCNT(b.x)], 1u);
    return b;
}
__device__ __forceinline__ void xcd_barrier_complete(unsigned* bar, unsigned x, unsigned& nloc, unsigned& nx) {
    const unsigned G = gridDim.x * gridDim.y * gridDim.z;
    unsigned sum, cnt, mine, sp = 0u;
    for (;;) {
        sum = 0u; cnt = 0u; mine = 0u;
#pragma unroll
        for (unsigned j = 0; j < 16; ++j) { const unsigned c = xb_ld(&bar[XB_XCNT(j)]); sum += c; cnt += (c > 0u) ? 1u : 0u; mine = (j == x) ? c : mine; }
        if (sum == G) break;
        __builtin_amdgcn_s_sleep(1);
        if ((++sp & 255u) == 0u) { if (xb_ld(&bar[XB_TMO])) break; if (sp > XB_SPIN_CAP) { atomicAdd(&bar[XB_TMO], 1u); break; } }
    }
    nloc = mine > 0u ? mine : 1u; nx = cnt > 0u ? cnt : 1u;
}
__device__ __forceinline__ void xcd_barrier(const XcdBarrier& b) {
    asm volatile("s_waitcnt vmcnt(0)" ::: "memory");
    __syncthreads();
    if (threadIdx.x == 0) {
        unsigned* bar = b.bar;
        __builtin_amdgcn_s_waitcnt(0);
        unsigned nloc = b.st[0], nx = b.st[1];
        if (nloc == 0u) { xcd_barrier_complete(bar, b.x, nloc, nx); b.st[0] = nloc; b.st[1] = nx; }
        const unsigned old = xb_add(&bar[XB_XSUB(b.x)], 1u);
        const unsigned gen = old / nloc;
        if (old + 1u == (gen + 1u) * nloc) {
            __builtin_amdgcn_fence(__ATOMIC_RELEASE, "agent");
            asm volatile("s_waitcnt vmcnt(0)" ::: "memory");
            const unsigned og = xb_add(&bar[XB_TOP], 1u);
            const unsigned tg = og / nx;
            if (og + 1u == (tg + 1u) * nx) xb_add(&bar[XB_TOPGEN], 1u);
            else XB_SPIN(xb_ld(&bar[XB_TOPGEN]) == tg, bar);
            __builtin_amdgcn_fence(__ATOMIC_ACQUIRE, "agent");
            xb_add(&bar[XB_XGEN(b.x)], 1u);
            asm volatile("s_waitcnt vmcnt(0)" ::: "memory");
        } else {
            XB_SPIN(xb_ld(&bar[XB_XGEN(b.x)]) == gen, bar);
            __builtin_amdgcn_fence(__ATOMIC_ACQUIRE, "agent");
            asm volatile("s_waitcnt vmcnt(0)" ::: "memory");
        }
    }
    __syncthreads();
}

namespace pg8 {
constexpr int BM = 256, BK = 64, HALF = 128, HTB = HALF * BK * 2, STAGE_BYTES = 8 * HTB, NXCD = 8, WGM = 8;
__host__ __device__ __forceinline__ int lds_byte(int r, int c) { const int st = (r >> 4) * 2 + (c >> 5), rr = r & 15, cc = c & 31, ob = rr * 64 + cc * 2; return st * 1024 + (ob ^ (((ob >> 9) & 1) << 5)); }
__host__ __device__ __forceinline__ void stage_rc(int b, int& R, int& C) { const int st = b / 1024, sb = b % 1024, swz = sb ^ (((sb >> 9) & 1) << 5); R = (st >> 1) * 16 + swz / 64; C = (st & 1) * 32 + (swz % 64) / 2; }

struct Unit { int pm, pn, aux; };

struct StaticOrder {
    int nM, nN, nwg, G, c;
    __device__ void init(int nM_, int nN_, int G_, int c_) { nM = nM_; nN = nN_; nwg = nM * nN; G = G_; c = c_; }
    __device__ bool next(int i, Unit& u) const {
        const long L = (long)i * G + c; if (L >= nwg) return false;
        int wgid = (int)L; { const int q = nwg / NXCD, r = nwg % NXCD, xcd = wgid % NXCD, off = wgid / NXCD; wgid = (xcd < r ? xcd * (q + 1) : r * (q + 1) + (xcd - r) * q) + off; }
        const int nig = WGM * nN, gid = wgid / nig, fm = gid * WGM, gsz = (nM - fm) < WGM ? (nM - fm) : WGM;
        u.pm = fm + ((wgid % nig) % gsz); u.pn = (wgid % nig) / gsz; u.aux = 0; return true;
    }
};

template <bool I8> struct AccVec { typedef f32x4 type; };
template <> struct AccVec<true> { typedef i32x4 type; };
template <bool I8 = false, class Prob, class Sched, class Epi>
__device__ __forceinline__ void gemm_phase(LAS unsigned char* lds, const Prob& P, const Sched& S, const Epi& E) {
    const int tid = opq_v((int)threadIdx.x), wid = __builtin_amdgcn_readfirstlane(tid >> 6), lane = tid & 63, wr = wid >> 2, wc = wid & 3, fr = lane & 15, fq = lane >> 4;
    typedef typename AccVec<I8>::type accv_t;
    const int K = P.K, nt = K / (I8 ? 2 * BK : BK);
    unsigned voffA[2], voffB[2];
#pragma unroll
    for (int i = 0; i < 2; ++i) { int R, C; stage_rc(tid * 16 + i * 8192, R, C); voffA[i] = (unsigned)R * P.lda + (unsigned)C * 2u; voffB[i] = (unsigned)R * P.ldb + (unsigned)C * 2u; }
    const size_t kstep = (size_t)(BK * 2);
    const size_t hstepA = (size_t)HALF * P.lda, hstepB = (size_t)HALF * P.ldb;
    const unsigned ldsw = (unsigned)wid * 1024u;
    const int aoff = lds_byte(wr * 64 + fr, fq * 8), boff = lds_byte(wc * 32 + fr, fq * 8);
#define PG8_SA(b, h) (((b) * 2 + (h)) * HTB)
#define PG8_SB(b, h) ((4 + (b) * 2 + (h)) * HTB)
#define PG8_STAGE(bufoff, gbase, voff) do { _Pragma("unroll") for (int _i = 0; _i < 2; ++_i) \
        __builtin_amdgcn_global_load_lds((const unsigned*)((const char*)(gbase) + (voff)[_i]), (LAS unsigned*)(lds + (bufoff) + ldsw + _i * 8192), 16, 0, 0); } while (0)
#define PG8_LDA(dst, b, h) do { _Pragma("unroll") for (int m = 0; m < 4; ++m) _Pragma("unroll") for (int k = 0; k < 2; ++k) dst[m][k] = *(const LAS bf16x8*)(lds + PG8_SA(b, h) + aoff + m * 2048 + k * 1024); } while (0)
#define PG8_LDB(dst, b, h) do { _Pragma("unroll") for (int n = 0; n < 2; ++n) _Pragma("unroll") for (int k = 0; k < 2; ++k) dst[n][k] = *(const LAS bf16x8*)(lds + PG8_SB(b, h) + boff + n * 2048 + k * 1024); } while (0)
#define PG8_MMA(ai, bj, At, Bt) do { __builtin_amdgcn_s_setprio(1); _Pragma("unroll") for (int m = 0; m < 4; ++m) _Pragma("unroll") for (int n = 0; n < 2; ++n) _Pragma("unroll") for (int k = 0; k < 2; ++k) \
        { if constexpr (I8) acc[ai][bj][m][n] = __builtin_amdgcn_mfma_i32_16x16x64_i8(__builtin_bit_cast(i32x4, Bt[n][k]), __builtin_bit_cast(i32x4, At[m][k]), acc[ai][bj][m][n], 0, 0, 0); \
          else acc[ai][bj][m][n] = __builtin_amdgcn_mfma_f32_16x16x32_bf16(Bt[n][k], At[m][k], acc[ai][bj][m][n], 0, 0, 0); } __builtin_amdgcn_s_setprio(0); } while (0)
#define PG8_WAIT_V(n) asm volatile("s_waitcnt vmcnt(" #n ")" ::: "memory")
#define PG8_WAIT_L(n) asm volatile("s_waitcnt lgkmcnt(" #n ")" ::: "memory")
#define PG8_BAR __builtin_amdgcn_s_barrier()
#define PG8_SCHED __builtin_amdgcn_sched_barrier(0)
    Unit cur, nxt; int ui = 0;
    if (!S.next(0, cur)) return;
    accv_t acc[2][2][4][2];
#pragma unroll
    for (int a = 0; a < 2; ++a)
#pragma unroll
        for (int b = 0; b < 2; ++b)
#pragma unroll
            for (int m = 0; m < 4; ++m)
#pragma unroll
                for (int n = 0; n < 2; ++n) acc[a][b][m][n] = accv_t{};
    bf16x8 At[4][2], B0[2][2], B1[2][2];
    const char* cA = P.a_ptr(cur); const char* cB = P.b_ptr(cur);
    PG8_STAGE(PG8_SB(0, 0), cB, voffB); PG8_STAGE(PG8_SB(0, 1), cB + hstepB, voffB); PG8_STAGE(PG8_SA(0, 0), cA, voffA); PG8_STAGE(PG8_SA(0, 1), cA + hstepA, voffA);
    if (wr == 1) PG8_BAR;
    PG8_WAIT_V(2); PG8_BAR;
    PG8_STAGE(PG8_SB(1, 0), cB + kstep, voffB); PG8_STAGE(PG8_SA(1, 0), cA + kstep, voffA); PG8_STAGE(PG8_SB(1, 1), cB + hstepB + kstep, voffB);
    PG8_WAIT_V(6); PG8_BAR;
    for (;;) {
        const bool has_next = S.next(ui + 1, nxt);
        const char* nA = has_next ? P.a_ptr(nxt) : cA; const char* nB = has_next ? P.b_ptr(nxt) : cB;
        for (int t = 0; t < nt; t += 2) {
            const bool last = (t == nt - 2);
            const char* a1 = cA + (size_t)(t + 1) * kstep;
            const char* a2 = last ? nA : cA + (size_t)(t + 2) * kstep; const char* b2 = last ? nB : cB + (size_t)(t + 2) * kstep;
            const char* a3 = a2 + kstep; const char* b3 = b2 + kstep;
            PG8_LDB(B0, 0, 0); PG8_LDB(B1, 0, 1); PG8_SCHED; PG8_LDA(At, 0, 0); PG8_STAGE(PG8_SA(1, 1), a1 + hstepA, voffA);
            PG8_WAIT_V(8); PG8_WAIT_L(0); PG8_BAR; PG8_MMA(0, 0, At, B0); PG8_MMA(0, 1, At, B1); PG8_BAR; PG8_SCHED;
            PG8_LDA(At, 0, 1); PG8_STAGE(PG8_SB(0, 0), b2, voffB); PG8_STAGE(PG8_SB(0, 1), b2 + hstepB, voffB); PG8_STAGE(PG8_SA(0, 0), a2, voffA);
            PG8_WAIT_V(8); PG8_WAIT_L(0); PG8_BAR; PG8_MMA(1, 0, At, B0); PG8_MMA(1, 1, At, B1); PG8_BAR; PG8_SCHED;
            PG8_LDB(B0, 1, 0); PG8_LDB(B1, 1, 1); PG8_SCHED; PG8_LDA(At, 1, 0); PG8_STAGE(PG8_SA(0, 1), a2 + hstepA, voffA);
            PG8_WAIT_V(8); PG8_WAIT_L(0); PG8_BAR; PG8_MMA(0, 0, At, B0); PG8_MMA(0, 1, At, B1); PG8_BAR; PG8_SCHED;
            PG8_LDA(At, 1, 1); PG8_STAGE(PG8_SB(1, 0), b3, voffB); PG8_STAGE(PG8_SB(1, 1), b3 + hstepB, voffB); PG8_STAGE(PG8_SA(1, 0), a3, voffA);
            PG8_WAIT_V(8); PG8_WAIT_L(0); PG8_BAR; PG8_MMA(1, 0, At, B0); PG8_MMA(1, 1, At, B1); PG8_BAR; PG8_SCHED;
        }
        if (wr == 0) PG8_BAR;
        E(acc, cur, wr, wc, fr, fq);
        if (!has_next) break;
#pragma unroll
        for (int a = 0; a < 2; ++a)
#pragma unroll
            for (int b = 0; b < 2; ++b)
#pragma unroll
                for (int m = 0; m < 4; ++m)
#pragma unroll
                    for (int n = 0; n < 2; ++n) acc[a][b][m][n] = accv_t{};
        cur = nxt; cA = nA; cB = nB; ++ui;
        if (wr == 1) PG8_BAR;
    }
    PG8_WAIT_V(0);
    PG8_BAR;
#undef PG8_SA
#undef PG8_SB
#undef PG8_STAGE
#undef PG8_LDA
#undef PG8_LDB
#undef PG8_MMA
#undef PG8_WAIT_V
#undef PG8_WAIT_L
#undef PG8_BAR
#undef PG8_SCHED
}
}

struct Frame {
    LAS unsigned char* lds;
    volatile LAS unsigned* MISC;
    gu32* ctl;
    unsigned char* ws;
    int tid, lane, wave, vcu, G;
    const float* const* in; float* out;
};
enum { I_X = 0, I_MEM, I_POS, I_GMIX, I_WIN, I_GQ, I_WUQ, I_GKV, I_WUKV, I_SINK, I_WMKV, I_WBR, I_WOUT, I_GFFN, I_WGD, I_WUD, I_WDD, I_WR, I_WGE, I_WUE, I_WDE, I_GMEM, I_GFIN };

__device__ __forceinline__ int sem_plain(int g) { return (g & ~31) + 8 * ((g >> 2) & 3) + 4 * ((g >> 4) & 1) + (g & 3); }
__device__ __forceinline__ int sem_rot64(int g) { return (g & ~63) + 32 * ((g >> 4) & 1) + 16 * ((g >> 5) & 1) + 4 * ((g >> 2) & 3) + (g & 3); }
__device__ __forceinline__ int inproj_src(int n) {
    const int pn = n >> 8, c = n & 255;
    if (pn < 2) return pn * 256 + sem_rot64(c);
    if (pn == 2) return c < 128 ? 512 + sem_rot64(c) : 640 + sem_plain(c - 128);
    if (pn == 3) return 768 + sem_plain(c);
    if (pn == 4) return c < 128 ? 1024 + sem_plain(c) : (c < 160 ? 1152 + (c - 128) : -1);
    if (pn < 7) return 1184 + (pn - 5) * 256 + sem_plain(c);
    return 1696 + (pn - 7) * 256 + sem_plain(c);
}

struct MapInproj { const float* W; __device__ __forceinline__ float load(int k, int n) const { const int s = inproj_src(n); return s >= 0 ? W[(size_t)k * INW + s] : 0.f; }
    __device__ __forceinline__ f32x4 load4(int k, int n) const { const int s = inproj_src(n); return s >= 0 ? *(const f32x4*)(W + (size_t)k * INW + s) : (f32x4){0.f, 0.f, 0.f, 0.f}; } };
struct MapUp { const float *Wq, *Wkv, *gq, *gkv;
    __device__ __forceinline__ float load(int k, int n) const {
        if (n < 768) { if (k >= 256) return 0.f; const int gg = n >> 5; const int s = (gg % 3 == 2) ? n : sem_plain(n); return gq[k] * Wq[(size_t)k * 768 + s]; }
        if (k < 256) return 0.f; const int s = sem_plain(n - 768); return gkv[k - 256] * Wkv[(size_t)(k - 256) * 1024 + s]; } };
struct MapPlain { const float* W; int ldw; __device__ __forceinline__ float load(int k, int n) const { return W[(size_t)k * ldw + sem_plain(n)]; } };
struct MapNat { const float* W; int ldw; __device__ __forceinline__ float load(int k, int n) const { return W[(size_t)k * ldw + n]; } };
struct MapMemkv { const float* W; __device__ __forceinline__ float load(int k, int n) const { const int l = n >> 10, c = n & 1023; return W[((size_t)l * DM + k) * 1024 + sem_plain(c)]; } };
struct MapGU { const float *Wg, *Wu; __device__ __forceinline__ float load(int k, int n) const { const int pn = n >> 8, c = n & 255; const int ch = 128 * pn + sem_plain(c & 127);
    const unsigned long long a = (unsigned long long)Wg, b = (unsigned long long)Wu, w = a ^ ((a ^ b) & (0ull - (unsigned long long)(c >> 7))); return ((const float*)w)[(size_t)k * DFF + ch]; }
    __device__ __forceinline__ f32x4 load4(int k, int n) const { const int pn = n >> 8, c = n & 255; const int ch = 128 * pn + sem_plain(c & 127);
        const unsigned long long a = (unsigned long long)Wg, b = (unsigned long long)Wu, w = a ^ ((a ^ b) & (0ull - (unsigned long long)(c >> 7))); return *(const f32x4*)((const float*)w + (size_t)k * DFF + ch); } };

template <class M> __device__ __forceinline__ void prep_item(const M& m, bf16_t* dst, int Kd, int nblk, LAS float* scr, int item, int lane) {
    const int kb = item / nblk, nb = item % nblk, k0 = 64 * kb, n0 = 32 * nb;
#pragma unroll 8
    for (int i = 0; i < 32; ++i) { const int kk = 2 * i + (lane >> 5); scr[kk * 33 + (lane & 31)] = m.load(k0 + kk, n0 + (lane & 31)); }
    LDS_WAIT(); asm volatile("" ::: "memory");
    const int c = lane & 7;
#pragma unroll
    for (int j = 0; j < 4; ++j) { const int n = (lane >> 3) + 8 * j; const LAS float* s = scr + (8 * c) * 33 + n;
        u32x4 o; o.x = pk2(s[0 * 33], s[1 * 33]); o.y = pk2(s[2 * 33], s[3 * 33]); o.z = pk2(s[4 * 33], s[5 * 33]); o.w = pk2(s[6 * 33], s[7 * 33]);
        *(u32x4*)(dst + (size_t)(n0 + n) * Kd + k0 + 8 * c) = o; }
    LDS_WAIT(); asm volatile("" ::: "memory");
}
template <class M> __device__ __forceinline__ void prep_matrix(Frame& F, const M& m, bf16_t* dst, int N, int K) {
    LAS float* scr = (LAS float*)(F.lds + F.wave * 16384);
    const int gw = F.vcu * NWAVES + F.wave, NGW = F.G * NWAVES, nblk = N / 32, nitems = (K / 64) * nblk;
    for (int it = gw; it < nitems; it += NGW) prep_item(m, dst, K, nblk, scr, it, F.lane);
}

template <class M> __device__ __forceinline__ void prep_strip_i8(Frame& F, const M& m, signed char* dst, float* scl, int strip) {
    const int lane = F.lane, w = F.wave, n0 = strip * 32, k0 = w * 128, ng = lane & 7, kr = lane >> 3;
    LAS unsigned char* tile = F.lds + w * 16384;
    LAS float* amt = (LAS float*)(F.lds + LDSCTL_OFF + 2048);
    f32x4 v[16];
#pragma unroll
    for (int i = 0; i < 16; ++i) v[i] = m.load4(k0 + 8 * i + kr, n0 + 4 * ng);
    f32x4 am = __builtin_elementwise_abs(v[0]);
#pragma unroll
    for (int i = 1; i < 16; ++i) am = __builtin_elementwise_max(am, __builtin_elementwise_abs(v[i]));
#pragma unroll
    for (int c = 0; c < 4; ++c) { float a = am[c]; a = fmaxf(a, __shfl_xor(a, 8)); a = fmaxf(a, __shfl_xor(a, 16)); a = fmaxf(a, __shfl_xor(a, 32)); am[c] = a; }
    if (kr == 0) *(LAS f32x4*)(amt + w * 32 + 4 * ng) = am;
    __syncthreads();
    f32x4 cm = *(const LAS f32x4*)(amt + 4 * ng);
#pragma unroll
    for (int ww = 1; ww < 8; ++ww) cm = __builtin_elementwise_max(cm, *(const LAS f32x4*)(amt + ww * 32 + 4 * ng));
    f32x4 inv;
#pragma unroll
    for (int c = 0; c < 4; ++c) inv[c] = cm[c] > 0.f ? 127.0f / cm[c] : 0.f;
    if (w == 0 && kr == 0) *(f32x4*)(scl + n0 + 4 * ng) = cm * (1.0f / 127.0f);
#pragma unroll
    for (int i = 0; i < 16; ++i)
#pragma unroll
        for (int c = 0; c < 4; ++c) tile[(4 * ng + c) * 144 + 8 * i + kr] = (unsigned char)(signed char)__float2int_rn(v[i][c] * inv[c]);
    LDS_WAIT(); asm volatile("" ::: "memory");
#pragma unroll
    for (int j = 0; j < 4; ++j) { const int p = lane + 64 * j, n = p >> 3, kc = p & 7;
        *(u32x4*)(dst + (size_t)(n0 + n) * DM + k0 + 16 * kc) = *(const LAS u32x4*)(tile + n * 144 + 16 * kc); }
    LDS_WAIT();
    __syncthreads();
}
__device__ __forceinline__ bf16_t* wmix(Frame& F, int l, size_t off) { return (bf16_t*)(F.ws + WS_WMIX + (size_t)l * WL_STRIDE + off); }

__device__ __forceinline__ void prep_mixer_weights(Frame& F) {
    for (int l = 0; l < DEPTH; ++l) {
        { MapInproj m{F.in[I_WIN] + (size_t)l * DM * INW}; for (int s = F.vcu; s < NT_IN * 8; s += F.G) prep_strip_i8(F, m, (signed char*)wmix(F, l, WL_IN), (float*)(F.ws + WS_MISC + MS_WSIN) + l * NT_IN * 256, s); }
        { MapUp m{F.in[I_WUQ] + (size_t)l * 256 * 768, F.in[I_WUKV] + (size_t)l * 128 * 1024, F.in[I_GQ] + l * 256, F.in[I_GKV] + l * 128}; prep_matrix(F, m, wmix(F, l, WL_UP), UPN, UPK); }
        for (int i = 0; i < 3; ++i) { MapPlain m{F.in[I_WBR] + ((size_t)l * 3 + i) * 512 * DM, DM}; prep_matrix(F, m, wmix(F, l, WL_BR) + (size_t)i * DM * 512, DM, 512); }
        { MapNat m{F.in[I_WOUT] + (size_t)l * DM * DM, DM}; prep_matrix(F, m, wmix(F, l, WL_OUT), DM, DM); }
    }
    { MapMemkv m{F.in[I_WMKV]}; prep_matrix(F, m, (bf16_t*)(F.ws + WS_WMKV), 4096, DM); }
}
__device__ __forceinline__ void prep_ffn_weights(Frame& F, int l) {
    const int i = l >> 1; const bool moe = (l & 1) != 0;
    LAS float* scr = (LAS float*)(F.lds + F.wave * 16384);
    const int gw = F.vcu * NWAVES + F.wave, NGW = F.G * NWAVES;
    constexpr int IGU = (DM / 64) * (2 * DFF / 32), ID = (DFF / 64) * (DM / 32), NSTRIP = 2 * DFF / 32;
    const int ne = moe ? NE : 1;
    const float* Wg = moe ? F.in[I_WGE] : F.in[I_WGD]; const float* Wu = moe ? F.in[I_WUE] : F.in[I_WUD]; const float* Wd = moe ? F.in[I_WDE] : F.in[I_WDD];
    if (GU_I8(l)) {
        for (int s = F.vcu; s < ne * NSTRIP; s += F.G) { const int e = s / NSTRIP, ss = s % NSTRIP; const size_t eo = ((size_t)i * ne + e) * DM * DFF;
            MapGU m{Wg + eo, Wu + eo}; prep_strip_i8(F, m, (signed char*)(F.ws + WS_WFFN + (size_t)e * WF_STRIDE), (float*)(F.ws + WS_MISC + MS_WSGU) + e * 2 * DFF, ss); }
    } else {
        for (int it = gw; it < ne * IGU; it += NGW) { const int e = it / IGU, r = it % IGU; const size_t eo = ((size_t)i * ne + e) * DM * DFF;
            MapGU m{Wg + eo, Wu + eo}; prep_item(m, (bf16_t*)(F.ws + WS_WFFN + (size_t)e * WF_STRIDE), DM, 2 * DFF / 32, scr, r, F.lane); }
    }
    for (int it = gw; it < ne * ID; it += NGW) { const int e = it / ID, r = it % ID; const size_t eo = ((size_t)i * ne + e) * DM * DFF;
        MapNat m{Wd + eo, DM}; prep_item(m, (bf16_t*)(F.ws + WS_WFFN + (size_t)e * WF_STRIDE + WF_D), DFF, DM / 32, scr, r, F.lane); }
}

struct RowV { f32x4 v[4]; };
__device__ __forceinline__ void row_load(RowV& r, const float* p, int lane) { const f32x4* x = (const f32x4*)p + lane;
#pragma unroll
    for (int j = 0; j < 4; ++j) r.v[j] = x[64 * j]; }
__device__ __forceinline__ void row_store(const RowV& r, float* p, int lane) { f32x4* x = (f32x4*)p + lane;
#pragma unroll
    for (int j = 0; j < 4; ++j) x[64 * j] = r.v[j]; }
__device__ __forceinline__ void row_add_bf16(RowV& r, const bf16_t* p, float w, int lane) { const u32x2* x = (const u32x2*)p + lane;
#pragma unroll
    for (int j = 0; j < 4; ++j) { const u32x2 q = x[64 * j]; r.v[j].x += w * bflo(q.x); r.v[j].y += w * bfhi(q.x); r.v[j].z += w * bflo(q.y); r.v[j].w += w * bfhi(q.y); } }
__device__ __forceinline__ float row_rstd(const RowV& r) { float s = 0.f;
#pragma unroll
    for (int j = 0; j < 4; ++j) s += (r.v[j].x * r.v[j].x + r.v[j].y * r.v[j].y) + (r.v[j].z * r.v[j].z + r.v[j].w * r.v[j].w);
    return 1.0f / sqrtf(wave_sum(s) * (1.0f / DM) + EPS); }
__device__ __forceinline__ void row_scale(RowV& r, float rstd, const float* g, int lane) { const f32x4* gg = (const f32x4*)g + lane;
#pragma unroll
    for (int j = 0; j < 4; ++j) r.v[j] = r.v[j] * rstd * gg[64 * j]; }
__device__ __forceinline__ void row_store_bf16(const RowV& r, bf16_t* p, int lane) { u32x2* o = (u32x2*)p + lane;
#pragma unroll
    for (int j = 0; j < 4; ++j) { u32x2 w; w.x = pk2(r.v[j].x, r.v[j].y); w.y = pk2(r.v[j].z, r.v[j].w); o[64 * j] = w; } }

__device__ __forceinline__ float row_store_i8(const RowV& r, signed char* p, int lane) {
    float am = 0.f;
#pragma unroll
    for (int j = 0; j < 4; ++j) am = fmaxf(am, fmaxf(fmaxf(fabsf(r.v[j].x), fabsf(r.v[j].y)), fmaxf(fabsf(r.v[j].z), fabsf(r.v[j].w))));
#pragma unroll
    for (int o = 1; o < 64; o <<= 1) am = fmaxf(am, __shfl_xor(am, o));
    const float inv = am > 0.f ? 127.0f / am : 0.f; unsigned* o4 = (unsigned*)p + lane;
#pragma unroll
    for (int j = 0; j < 4; ++j) { const unsigned a = (unsigned)__float2int_rn(r.v[j].x * inv) & 255u, b = (unsigned)__float2int_rn(r.v[j].y * inv) & 255u, c = (unsigned)__float2int_rn(r.v[j].z * inv) & 255u, d = (unsigned)__float2int_rn(r.v[j].w * inv) & 255u;
        o4[64 * j] = a | (b << 8) | (c << 16) | (d << 24); }
    return am * (1.0f / 127.0f);
}
__device__ __forceinline__ void row_combine(Frame& F, RowV& r, int t) {
    const int* sl = (const int*)(F.ws + WS_MISC + MS_SLOT) + 2 * t; const float* tw = (const float*)(F.ws + WS_MISC + MS_TOKW) + 2 * t;
    const bf16_t* Y = (const bf16_t*)(F.ws + WS_R + R_YOUT);
    const int s0 = sl[0], s1 = sl[1]; const float w0 = tw[0], w1 = tw[1];
    row_add_bf16(r, Y + (size_t)s0 * DM, w0, F.lane); row_add_bf16(r, Y + (size_t)s1 * DM, w1, F.lane);
}

__device__ __forceinline__ void norm_phase(Frame& F, const float* src, float* X, const float* g, bool combine, bool out_i8) {
    bf16_t* H = (bf16_t*)(F.ws + WS_H); signed char* Hq = (signed char*)(F.ws + WS_H); float* hsc = (float*)(F.ws + WS_MISC + MS_HSC);
    const int gw = F.vcu * NWAVES + F.wave, NGW = F.G * NWAVES;
    for (int t = gw; t < T; t += NGW) {
        RowV r; row_load(r, src + (size_t)t * DM, F.lane);
        if (combine) { row_combine(F, r, t); row_store(r, X + (size_t)t * DM, F.lane); }
        const float rstd = row_rstd(r); row_scale(r, rstd, g, F.lane);
        if (out_i8) { const float sc = row_store_i8(r, Hq + (size_t)t * DM, F.lane); if (F.lane == 0) hsc[t] = sc; }
        else row_store_bf16(r, H + (size_t)t * DM, F.lane);
    }
}
__device__ __forceinline__ void final_norm_phase(Frame& F, float* X, const float* g, bool combine) {
    const int gw = F.vcu * NWAVES + F.wave, NGW = F.G * NWAVES;
    for (int t = gw; t < T; t += NGW) {
        RowV r; row_load(r, X + (size_t)t * DM, F.lane);
        if (combine) row_combine(F, r, t);
        const float rstd = row_rstd(r); row_scale(r, rstd, g, F.lane);
        row_store(r, X + (size_t)t * DM, F.lane);
    }
}
__device__ __forceinline__ void memnorm_phase(Frame& F) {
    bf16_t* MN = (bf16_t*)(F.ws + WS_MEMN);
    const int gw = F.vcu * NWAVES + F.wave, NGW = F.G * NWAVES;
    for (int t = gw; t < NB * MEML; t += NGW) {
        RowV r; row_load(r, F.in[I_MEM] + (size_t)t * DM, F.lane);
        const float rstd = row_rstd(r); row_scale(r, rstd, F.in[I_GMEM], F.lane);
        row_store_bf16(r, MN + (size_t)t * DM, F.lane);
    }
}

__device__ __forceinline__ void norm_router_phase(Frame& F, const float* X, const float* g, const float* Wr  , bool out_i8) {
    bf16_t* H = (bf16_t*)(F.ws + WS_H); signed char* Hq = (signed char*)(F.ws + WS_H); float* hsc = (float*)(F.ws + WS_MISC + MS_HSC);
    int* toke = (int*)(F.ws + WS_MISC + MS_TOKE); float* tokw = (float*)(F.ws + WS_MISC + MS_TOKW); int* cntg = (int*)(F.ws + WS_MISC + MS_CNT);
    volatile LAS int* hist = (volatile LAS int*)(F.lds + LDSCTL_OFF + 1024);
    for (int c = F.vcu; c < T / 128; c += F.G) {
        if (F.tid < 8) hist[F.tid] = 0;
        __syncthreads();
        for (int q = 0; q < 16; ++q) {
            const int t = c * 128 + F.wave * 16 + q;
            RowV r; row_load(r, X + (size_t)t * DM, F.lane);
            const float rstd = row_rstd(r); row_scale(r, rstd, g, F.lane);
            if (out_i8) { const float sc = row_store_i8(r, Hq + (size_t)t * DM, F.lane); if (F.lane == 0) hsc[t] = sc; }
            else row_store_bf16(r, H + (size_t)t * DM, F.lane);
            float lg[8];
#pragma unroll
            for (int e = 0; e < 8; ++e) lg[e] = 0.f;
#pragma unroll
            for (int j = 0; j < 4; ++j) {
#pragma unroll
                for (int k = 0; k < 4; ++k) { const int d = 256 * j + 4 * F.lane + k; const f32x4 wa = *(const f32x4*)(Wr + (size_t)d * 8), wb = *(const f32x4*)(Wr + (size_t)d * 8 + 4); const float x = r.v[j][k];
                    lg[0] += x * wa.x; lg[1] += x * wa.y; lg[2] += x * wa.z; lg[3] += x * wa.w; lg[4] += x * wb.x; lg[5] += x * wb.y; lg[6] += x * wb.z; lg[7] += x * wb.w; } }
#pragma unroll
            for (int e = 0; e < 8; ++e) lg[e] = wave_sum(lg[e]);
            int e0 = 0; float v0 = lg[0];
#pragma unroll
            for (int e = 1; e < 8; ++e) if (lg[e] > v0) { v0 = lg[e]; e0 = e; }
            int e1 = -1; float v1 = -INFINITY;
#pragma unroll
            for (int e = 0; e < 8; ++e) if (e != e0 && lg[e] > v1) { v1 = lg[e]; e1 = e; }
            if (F.lane == 0) {
                const float w0 = 1.0f / (1.0f + __expf(v1 - v0));
                toke[2 * t] = e0; toke[2 * t + 1] = e1; tokw[2 * t] = w0; tokw[2 * t + 1] = 1.0f - w0;
                __hip_atomic_fetch_add((LAS int*)&hist[e0], 1, __ATOMIC_RELAXED, __HIP_MEMORY_SCOPE_WORKGROUP); __hip_atomic_fetch_add((LAS int*)&hist[e1], 1, __ATOMIC_RELAXED, __HIP_MEMORY_SCOPE_WORKGROUP);
            }
        }
        __syncthreads();
        if (F.tid < 8) cntg[c * 8 + F.tid] = hist[F.tid];
        __syncthreads();
    }
}
__device__ __forceinline__ void moe_assign_phase(Frame& F, bool i8) {
    const bf16_t* H = (const bf16_t*)(F.ws + WS_H); bf16_t* AS = (bf16_t*)(F.ws + WS_R + R_ASORT);
    const float* hsc = (const float*)(F.ws + WS_MISC + MS_HSC); float* asc = (float*)(F.ws + WS_MISC + MS_ASC);
    const int* toke = (const int*)(F.ws + WS_MISC + MS_TOKE); int* slot = (int*)(F.ws + WS_MISC + MS_SLOT); const int* cntg = (const int*)(F.ws + WS_MISC + MS_CNT);
    int* texp = (int*)(F.ws + WS_MISC + MS_TEXP);
    volatile LAS int* tot = (volatile LAS int*)(F.lds + LDSCTL_OFF + 1024);
    volatile LAS int* pre = tot + 8;
    volatile LAS int* wcnt = tot + 16;
    for (int c = F.vcu; c < T / 128; c += F.G) {
        if (F.tid < 16) tot[F.tid] = 0;
        __syncthreads();
        { const int cc = F.tid >> 1, h = F.tid & 1; const i32x4 v = *(const i32x4*)(cntg + cc * 8 + 4 * h);
#pragma unroll
          for (int k = 0; k < 4; ++k) { __hip_atomic_fetch_add((LAS int*)&tot[4 * h + k], v[k], __ATOMIC_RELAXED, __HIP_MEMORY_SCOPE_WORKGROUP); if (cc < c) __hip_atomic_fetch_add((LAS int*)&pre[4 * h + k], v[k], __ATOMIC_RELAXED, __HIP_MEMORY_SCOPE_WORKGROUP); } }
        const int t = c * 128 + F.wave * 16 + ((F.lane & 31) >> 1);
        const int my_e = (F.lane < 32) ? toke[2 * t + (F.lane & 1)] : -1;
        int rank = 0;
#pragma unroll
        for (int e = 0; e < 8; ++e) { const unsigned long long m = __ballot(my_e == e); if (my_e == e) rank = __popcll(m & ((1ull << F.lane) - 1ull)); if (F.lane == 0) wcnt[F.wave * 8 + e] = __popcll(m); }
        __syncthreads();
        int myslot = 0;
        if (F.lane < 32) {
            int ts = 0;
#pragma unroll
            for (int e = 0; e < 8; ++e) ts += (e < my_e) ? ((tot[e] + 255) >> 8) : 0;
            int wp = 0; for (int w = 0; w < F.wave; ++w) wp += wcnt[w * 8 + my_e];
            myslot = ts * 256 + pre[my_e] + wp + rank;
            slot[2 * t + (F.lane & 1)] = myslot;
        }
        if (c == 0 && F.tid == 0) { int ts = 0; for (int e = 0; e < 8; ++e) { const int n = (tot[e] + 255) >> 8; for (int k = 0; k < n; ++k) texp[ts + k] = e; ts += n; } for (int k = ts; k < MAXRT; ++k) texp[k] = 0; texp[MAXRT] = ts; }
        for (int a = 0; a < 32; ++a) {
            const int s = __builtin_amdgcn_readlane(myslot, a); const int ta = c * 128 + F.wave * 16 + (a >> 1);
            if (i8) { const u32x4* srcp = (const u32x4*)((const signed char*)H + (size_t)ta * DM) + F.lane; u32x4* dstp = (u32x4*)((signed char*)AS + (size_t)s * DM) + F.lane; dstp[0] = srcp[0]; if (F.lane == 0) asc[s] = hsc[ta]; }
            else { const u32x4* srcp = (const u32x4*)(H + (size_t)ta * DM) + F.lane; u32x4* dstp = (u32x4*)(AS + (size_t)s * DM) + F.lane;
                const u32x4 x0 = srcp[0], x1 = srcp[64]; dstp[0] = x0; dstp[64] = x1; }
        }
        __syncthreads();
    }
}

using pg8::Unit;
typedef f32x4 AccT[2][2][4][2];

struct ProbSimple { int K; unsigned lda, ldb; const char* A; const char* B;
    __device__ __forceinline__ const char* a_ptr(const Unit& u) const { return A + (size_t)u.pm * 256 * lda; }
    __device__ __forceinline__ const char* b_ptr(const Unit& u) const { return B + (size_t)u.pn * 256 * ldb; } };
struct ProbBranch { int K; unsigned lda, ldb; const char* A; const char* B;
    __device__ __forceinline__ const char* a_ptr(const Unit& u) const { return A + (size_t)u.pm * 256 * lda + (size_t)u.aux * 1024; }
    __device__ __forceinline__ const char* b_ptr(const Unit& u) const { return B + (size_t)u.aux * ((size_t)DM * 512 * 2) + (size_t)u.pn * 256 * ldb; } };
struct ProbMoe { int K; unsigned lda, ldb; const char* A; const char* B; int a_lo;
    __device__ __forceinline__ const char* a_ptr(const Unit& u) const { return A + (size_t)(u.pm - a_lo) * 256 * lda; }
    __device__ __forceinline__ const char* b_ptr(const Unit& u) const { return B + (size_t)u.aux * WF_STRIDE + (size_t)u.pn * 256 * ldb; } };

struct SegOrder { pg8::StaticOrder base;
    __device__ bool next(int i, Unit& u) const { if (!base.next(i / 3, u)) return false; u.aux = i % 3; return true; } };
struct MoeOrder { pg8::StaticOrder base; int lo; const int* texp;
    __device__ bool next(int i, Unit& u) const { if (!base.next(i, u)) return false; u.pm += lo; u.aux = texp[u.pm]; return true; } };

__device__ __forceinline__ u32x4 pack8(const f32x4 a, const f32x4 b) { u32x4 w; w.x = cvtpk(a[0], a[1]); w.y = cvtpk(a[2], a[3]); w.z = cvtpk(b[0], b[1]); w.w = cvtpk(b[2], b[3]); return w; }
__device__ __forceinline__ u32x2 pack4(const f32x4 a) { u32x2 w; w.x = cvtpk(a[0], a[1]); w.y = cvtpk(a[2], a[3]); return w; }

__device__ __forceinline__ f32x4 deq(const f32x4& a, float, const f32x4&) { return a; }
__device__ __forceinline__ f32x4 deq(const i32x4& a, float rs, const f32x4& cs) { return __builtin_convertvector(a, f32x4) * rs * cs; }
struct EpiInproj {
    bf16_t* P; bf16_t* G; float* ssq; const int* pos; const float* rsc; const float* csc;
    template <class AV> __device__ __forceinline__ void operator()(const AV (&acc)[2][2][4][2], const Unit& u, int wr, int wc, int fr, int fq) const {
        const int pn = u.pn, row0 = u.pm * 256 + wr * 64 + fr;
        f32x4 cs[2][2];
#pragma unroll
        for (int bj = 0; bj < 2; ++bj)
#pragma unroll
            for (int n = 0; n < 2; ++n) cs[bj][n] = *(const f32x4*)(csc + pn * 256 + bj * 128 + wc * 32 + n * 16 + fq * 4);
#define DQ(ai, bj, m, n) deq(acc[ai][bj][m][n], rs, cs[bj][n])
        if (pn >= 7) {
#pragma unroll
            for (int ai = 0; ai < 2; ++ai)
#pragma unroll
                for (int m = 0; m < 4; ++m) { const int row = row0 + ai * 128 + m * 16; const float rs = rsc[row];
#pragma unroll
                    for (int bj = 0; bj < 2; ++bj) { f32x4 a = DQ(ai, bj, m, 0), b = DQ(ai, bj, m, 1);
#pragma unroll
                        for (int j = 0; j < 4; ++j) { a[j] = fast_sigmoid(a[j]); b[j] = fast_sigmoid(b[j]); }
                        *(u32x4*)(G + (size_t)row * GW + (pn - 7) * 256 + bj * 128 + wc * 32 + fq * 8) = pack8(a, b); } }
        } else if (pn >= 5 || pn == 3) {
            const float sc = (pn == 3) ? 1.0f : C_M;
#pragma unroll
            for (int ai = 0; ai < 2; ++ai)
#pragma unroll
                for (int m = 0; m < 4; ++m) { const int row = row0 + ai * 128 + m * 16; const float rs = rsc[row]; float s = 0.f;
#pragma unroll
                    for (int bj = 0; bj < 2; ++bj) { const f32x4 a = DQ(ai, bj, m, 0) * sc, b = DQ(ai, bj, m, 1) * sc;
                        s += (a[0] * a[0] + a[1] * a[1]) + (a[2] * a[2] + a[3] * a[3]) + (b[0] * b[0] + b[1] * b[1]) + (b[2] * b[2] + b[3] * b[3]);
                        *(u32x4*)(P + (size_t)row * PW + pn * 256 + bj * 128 + wc * 32 + fq * 8) = pack8(a, b); }
                    if (pn == 3) { s += __shfl_xor(s, 16); s += __shfl_xor(s, 32); if (fq == 0) ssq[(size_t)row * 8 + wc] = s; } }
        } else if (pn == 4) {
#pragma unroll
            for (int ai = 0; ai < 2; ++ai)
#pragma unroll
                for (int m = 0; m < 4; ++m) { const int row = row0 + ai * 128 + m * 16; const float rs = rsc[row];
                    { const f32x4 a = DQ(ai, 0, m, 0), b = DQ(ai, 0, m, 1);
                      float s = (a[0] * a[0] + a[1] * a[1]) + (a[2] * a[2] + a[3] * a[3]) + (b[0] * b[0] + b[1] * b[1]) + (b[2] * b[2] + b[3] * b[3]);
                      *(u32x4*)(P + (size_t)row * PW + P_CKV + wc * 32 + fq * 8) = pack8(a, b);
                      s += __shfl_xor(s, 16); s += __shfl_xor(s, 32); if (fq == 0) ssq[(size_t)row * 8 + 4 + wc] = s; }
                    if (wc == 0) { const f32x4 x1 = DQ(ai, 1, m, 0), x2 = DQ(ai, 1, m, 1); const float pf = (float)pos[row]; f32x4 o1, o2;
#pragma unroll
                        for (int j = 0; j < 4; ++j) { float c, s; rot_cs(pf, 2 * (4 * fq + j), c, s); o1[j] = x1[j] * c - x2[j] * s; o2[j] = x2[j] * c + x1[j] * s; }
                        *(u32x2*)(P + (size_t)row * PW + P_KR + 4 * fq) = pack4(o1); *(u32x2*)(P + (size_t)row * PW + P_KR + 16 + 4 * fq) = pack4(o2); } }
        } else {
            const float sc = (pn < 2) ? C_A : 1.0f; const int i0 = 16 * (wc & 1) + 4 * fq;
#pragma unroll
            for (int ai = 0; ai < 2; ++ai)
#pragma unroll
                for (int m = 0; m < 4; ++m) { const int row = row0 + ai * 128 + m * 16; const float rs = rsc[row]; const float pf = (float)pos[row]; f32x4 c, s;
#pragma unroll
                    for (int j = 0; j < 4; ++j) { float cc, ss; rot_cs(pf, i0 + j, cc, ss); c[j] = cc * sc; s[j] = ss * sc; }
#pragma unroll
                    for (int bj = 0; bj < 2; ++bj) { const f32x4 x1 = DQ(ai, bj, m, 0), x2 = DQ(ai, bj, m, 1);
                        if (pn == 2 && bj == 1) { *(u32x4*)(P + (size_t)row * PW + P_VA + wc * 32 + fq * 8) = pack8(x1, x2); }
                        else { const f32x4 o1 = x1 * c - x2 * s, o2 = x2 * c + x1 * s; bf16_t* d = P + (size_t)row * PW + pn * 256 + 64 * (2 * bj + (wc >> 1)) + i0;
                            *(u32x2*)d = pack4(o1); *(u32x2*)(d + 32) = pack4(o2); } } }
        }
#undef DQ
    }
};
struct EpiUp {
    bf16_t* QB; bf16_t* KVB; const float* ssq; const int* pos;
    __device__ __forceinline__ void operator()(const AccT& acc, const Unit& u, int wr, int wc, int fr, int fq) const {
        const int pn = u.pn, row0 = u.pm * 256 + wr * 64 + fr;
#pragma unroll
        for (int ai = 0; ai < 2; ++ai)
#pragma unroll
            for (int m = 0; m < 4; ++m) { const int row = row0 + ai * 128 + m * 16;
                const f32x4 sa = *(const f32x4*)(ssq + (size_t)row * 8), sb = *(const f32x4*)(ssq + (size_t)row * 8 + 4);
                if (pn < 3) {
                    const float rs = C_B / sqrtf(((sa[0] + sa[1]) + (sa[2] + sa[3])) * (1.0f / 256.0f) + EPS);
#pragma unroll
                    for (int bj = 0; bj < 2; ++bj) { const int gg = 8 * pn + 4 * bj + wc; const f32x4 x1 = acc[ai][bj][m][0] * rs, x2 = acc[ai][bj][m][1] * rs;
                        if (gg % 3 == 2) { const float pf = (float)pos[row]; f32x4 o1, o2;
#pragma unroll
                            for (int j = 0; j < 4; ++j) { float c, s; rot_cs(pf, 2 * (4 * fq + j), c, s); o1[j] = x1[j] * c - x2[j] * s; o2[j] = x2[j] * c + x1[j] * s; }
                            bf16_t* d = QB + (size_t)row * QBW + 32 * gg + 4 * fq; *(u32x2*)d = pack4(o1); *(u32x2*)(d + 16) = pack4(o2); }
                        else *(u32x4*)(QB + (size_t)row * QBW + 32 * gg + 8 * fq) = pack8(x1, x2); }
                } else {
                    const float rs = 1.0f / sqrtf(((sb[0] + sb[1]) + (sb[2] + sb[3])) * (1.0f / 128.0f) + EPS);
#pragma unroll
                    for (int bj = 0; bj < 2; ++bj) *(u32x4*)(KVB + (size_t)row * KVW + (pn - 3) * 256 + bj * 128 + wc * 32 + fq * 8) = pack8(acc[ai][bj][m][0] * rs, acc[ai][bj][m][1] * rs);
                } }
    }
};
struct EpiPlain {
    bf16_t* O; int ldo;
    __device__ __forceinline__ void operator()(const AccT& acc, const Unit& u, int wr, int wc, int fr, int fq) const {
        const int row0 = u.pm * 256 + wr * 64 + fr;
#pragma unroll
        for (int ai = 0; ai < 2; ++ai)
#pragma unroll
            for (int m = 0; m < 4; ++m)
#pragma unroll
                for (int bj = 0; bj < 2; ++bj) *(u32x4*)(O + (size_t)(row0 + ai * 128 + m * 16) * ldo + u.pn * 256 + bj * 128 + wc * 32 + fq * 8) = pack8(acc[ai][bj][m][0], acc[ai][bj][m][1]);
    }
};
struct EpiBranch {
    const bf16_t* G; float* scr; bf16_t* MIXED;
    __device__ __forceinline__ void operator()(const AccT& acc, const Unit& u, int wr, int wc, int fr, int fq) const {
        const int seg = u.aux, row0 = u.pm * 256 + wr * 64 + fr; unsigned long long spb = (unsigned long long)((f32x4*)scr + threadIdx.x); asm volatile("" : "+v"(spb)); f32x4* sp = (f32x4*)spb;
#pragma unroll
        for (int ai = 0; ai < 2; ++ai)
#pragma unroll
            for (int m = 0; m < 4; ++m) { const int row = row0 + ai * 128 + m * 16;
#pragma unroll
                for (int bj = 0; bj < 2; ++bj) { const int col = u.pn * 256 + bj * 128 + wc * 32 + fq * 8; const int si = ((ai * 4 + m) * 2 + bj) * 2;
                    const u32x4 gw = *(const u32x4*)(G + (size_t)row * GW + seg * 1024 + col);
                    f32x4 a = acc[ai][bj][m][0], b = acc[ai][bj][m][1];
                    a[0] *= bflo(gw.x); a[1] *= bfhi(gw.x); a[2] *= bflo(gw.y); a[3] *= bfhi(gw.y); b[0] *= bflo(gw.z); b[1] *= bfhi(gw.z); b[2] *= bflo(gw.w); b[3] *= bfhi(gw.w);
                    if (seg > 0) { a += sp[(size_t)si * 512]; b += sp[(size_t)(si + 1) * 512]; }
                    if (seg < 2) { sp[(size_t)si * 512] = a; sp[(size_t)(si + 1) * 512] = b; }
                    else *(u32x4*)(MIXED + (size_t)row * DM + col) = pack8(a, b); }
                asm volatile("" ::: "memory"); }
    }
};
struct EpiResid {
    const float* Xin; float* Xout;
    __device__ __forceinline__ void operator()(const AccT& acc, const Unit& u, int wr, int wc, int fr, int fq) const {
        const int row0 = u.pm * 256 + wr * 64 + fr;
#pragma unroll
        for (int ai = 0; ai < 2; ++ai)
#pragma unroll
            for (int m = 0; m < 4; ++m) {
#pragma unroll
                for (int bj = 0; bj < 2; ++bj)
#pragma unroll
                    for (int n = 0; n < 2; ++n) { const size_t o = (size_t)(row0 + ai * 128 + m * 16) * DM + u.pn * 256 + bj * 128 + wc * 32 + n * 16 + fq * 4;
                        *(f32x4*)(Xout + o) = *(const f32x4*)(Xin + o) + acc[ai][bj][m][n]; }
                asm volatile("" ::: "memory"); }
    }
};
struct EpiSwiglu {
    bf16_t* ACT; int lo; const float* rsc; const float* csc;
    template <class AV> __device__ __forceinline__ void operator()(const AV (&acc)[2][2][4][2], const Unit& u, int wr, int wc, int fr, int fq) const {
        const int row0 = (u.pm - lo) * 256 + wr * 64 + fr, arow0 = u.pm * 256 + wr * 64 + fr;
        f32x4 cs[2][2];
#pragma unroll
        for (int bj = 0; bj < 2; ++bj)
#pragma unroll
            for (int n = 0; n < 2; ++n) cs[bj][n] = *(const f32x4*)(csc + (size_t)u.aux * 2 * DFF + u.pn * 256 + bj * 128 + wc * 32 + n * 16 + fq * 4);
#pragma unroll
        for (int ai = 0; ai < 2; ++ai)
#pragma unroll
            for (int m = 0; m < 4; ++m) { const float rs = rsc[arow0 + ai * 128 + m * 16]; f32x4 a, b;
                const f32x4 g0 = deq(acc[ai][0][m][0], rs, cs[0][0]), g1 = deq(acc[ai][0][m][1], rs, cs[0][1]), u0 = deq(acc[ai][1][m][0], rs, cs[1][0]), u1 = deq(acc[ai][1][m][1], rs, cs[1][1]);
#pragma unroll
                for (int j = 0; j < 4; ++j) { a[j] = g0[j] * fast_sigmoid(g0[j]) * u0[j]; b[j] = g1[j] * fast_sigmoid(g1[j]) * u1[j]; }
                *(u32x4*)(ACT + (size_t)(row0 + ai * 128 + m * 16) * DFF + u.pn * 128 + wc * 32 + fq * 8) = pack8(a, b); }
    }
};
struct EpiYout {
    bf16_t* Y;
    __device__ __forceinline__ void operator()(const AccT& acc, const Unit& u, int wr, int wc, int fr, int fq) const {
        const int row0 = u.pm * 256 + wr * 64 + fr;
#pragma unroll
        for (int ai = 0; ai < 2; ++ai)
#pragma unroll
            for (int m = 0; m < 4; ++m)
#pragma unroll
                for (int bj = 0; bj < 2; ++bj)
#pragma unroll
                    for (int n = 0; n < 2; ++n) *(u32x2*)(Y + (size_t)(row0 + ai * 128 + m * 16) * DM + u.pn * 256 + bj * 128 + wc * 32 + n * 16 + fq * 4) = pack4(acc[ai][bj][m][n]);
    }
};

namespace att {
__device__ __forceinline__ int crow(int r, int hi) { return (r & 3) + 8 * (r >> 2) + 4 * hi; }
__device__ __forceinline__ void glds16(const void* gsrc, unsigned lds_dst) { unsigned keep;
    asm volatile("s_mov_b32 %0, m0\n\ts_mov_b32 m0, %2\n\ts_nop 0\n\tglobal_load_lds_dwordx4 %1, off\n\ts_mov_b32 m0, %0" : "=&s"(keep) : "v"(gsrc), "s"(lds_dst) : "memory"); }
__device__ __forceinline__ float swapmax(float m) { auto rr = __builtin_amdgcn_permlane32_swap(__float_as_uint(m), __float_as_uint(m), false, false); return fmaxf(__uint_as_float(rr[0]), __uint_as_float(rr[1])); }
__device__ __forceinline__ float swapsum(float m) { auto rr = __builtin_amdgcn_permlane32_swap(__float_as_uint(m), __float_as_uint(m), false, false); return __uint_as_float(rr[0]) + __uint_as_float(rr[1]); }
__device__ __forceinline__ s16x4 vtr(unsigned addr) { s16x4 r; asm volatile("ds_read_b64_tr_b16 %0, %1" : "=&v"(r) : "v"(addr) : "memory"); return r; }

struct Src {
    const bf16_t* q; int qpitch;
    const bf16_t* k0; int k0pitch;
    const bf16_t* k1; int k1pitch;
    const bf16_t* v; int vpitch;
    bf16_t* o; int opitch;
};
template <int NKC, int NVB>
__device__ __forceinline__ void dma_tile(const Src& S, int t, int slot, unsigned lds0, int wid, int lane) {
    constexpr int KS = NKC * 1024, VS = NVB * 4096, LDS_K = 0, LDS_V = 3 * KS;
#pragma unroll
    for (int c = 0; c < (NKC + 7) / 8; ++c) { const int ch = wid + 8 * c; if (ch < NKC) {
        const bf16_t* src = (ch < 8) ? S.k0 + (size_t)(t * 64 + lane) * S.k0pitch + ch * 8 : S.k1 + (size_t)(t * 64 + lane) * S.k1pitch + (ch - 8) * 8;
        glds16(src, (unsigned)__builtin_amdgcn_readfirstlane(lds0 + LDS_K + slot * KS + ch * 1024)); } }
#pragma unroll
    for (int c = 0; c < (NVB * 4 + 7) / 8; ++c) { const int p = wid + 8 * c; if (p < NVB * 4) {
        const bf16_t* src = S.v + (size_t)(t * 64 + 16 * (p & 3) + (lane >> 2)) * S.vpitch + (p >> 2) * 32 + (lane & 3) * 8;
        glds16(src, (unsigned)__builtin_amdgcn_readfirstlane(lds0 + LDS_V + slot * VS + p * 1024)); } }
}
__device__ __forceinline__ void wait_vm_bar(int n) {
    if (n >= 4) asm volatile("s_waitcnt vmcnt(4) lgkmcnt(0)\n\ts_barrier" ::: "memory");
    else if (n == 3) asm volatile("s_waitcnt vmcnt(3) lgkmcnt(0)\n\ts_barrier" ::: "memory");
    else if (n == 2) asm volatile("s_waitcnt vmcnt(2) lgkmcnt(0)\n\ts_barrier" ::: "memory");
    else if (n == 1) asm volatile("s_waitcnt vmcnt(1) lgkmcnt(0)\n\ts_barrier" ::: "memory");
    else asm volatile("s_waitcnt vmcnt(0) lgkmcnt(0)\n\ts_barrier" ::: "memory");
}
template <int NKC, int NVB, int MODE>
__device__ __forceinline__ void unit(LAS unsigned char* lds, const Src& S, int t_lo, int t_hi, int qpos0  , float sink_l2) {
    constexpr int KS = NKC * 1024, VS = NVB * 4096, RD = 3, LDS_K = 0, LDS_V = RD * KS;
    const int tid = opq_v((int)threadIdx.x), lane = tid & 63, r32 = lane & 31, hi = lane >> 5; const int wid = __builtin_amdgcn_readfirstlane(tid >> 6);
    const unsigned lds0 = (unsigned)(uintptr_t)lds;
    const int ops = (NKC + 7 - wid) / 8 + (NVB * 4) / 8;
    bf16x8 qr[NKC / 2];
#pragma unroll
    for (int d0 = 0; d0 < NKC / 2; ++d0) qr[d0] = *(const bf16x8*)(S.q + (size_t)r32 * S.qpitch + d0 * 16 + hi * 8);
    float m_run = (MODE == 0) ? sink_l2 : -INFINITY, l_run = (MODE == 0 && hi == 0) ? 1.0f : 0.0f;
    f32x16 o[NVB];
#pragma unroll
    for (int d = 0; d < NVB; ++d) o[d] = f32x16{};
    const int qi = qpos0 + wid * 32 + r32;
    const int qw0 = qpos0 + wid * 32;
    dma_tile<NKC, NVB>(S, t_lo, 0, lds0, wid, lane);
    if (t_lo + 1 < t_hi) dma_tile<NKC, NVB>(S, t_lo + 1, 1, lds0, wid, lane);
    for (int t = t_lo; t < t_hi; ++t) {
        const int slot = (t - t_lo) % RD;
        wait_vm_bar((t + 1 < t_hi) ? ops : 0);
        if (t + 2 < t_hi) dma_tile<NKC, NVB>(S, t + 2, (t + 2 - t_lo) % RD, lds0, wid, lane);
        bool active = true;
        if (MODE == 0) active = (64 * t + 63 >= qw0 - 128) && (64 * t <= qw0 + 31 + 128);
        if (active) {
            const LAS unsigned char* kb = lds + LDS_K + slot * KS + hi * 1024 + r32 * 16;
            f32x16 p0 = f32x16{}, p1 = f32x16{};
#pragma unroll
            for (int d0 = 0; d0 < NKC / 2; ++d0) {
                const bf16x8 b0 = *(const LAS bf16x8*)(kb + d0 * 2048), b1 = *(const LAS bf16x8*)(kb + d0 * 2048 + 512);
                p0 = __builtin_amdgcn_mfma_f32_32x32x16_bf16(b0, qr[d0], p0, 0, 0, 0); p1 = __builtin_amdgcn_mfma_f32_32x32x16_bf16(b1, qr[d0], p1, 0, 0, 0); }
            if (MODE == 0) {
#pragma unroll
                for (int r = 0; r < 16; ++r) { const int kv = 64 * t + crow(r, hi); int d0 = kv - qi; d0 = d0 < 0 ? -d0 : d0; int d1 = kv + 32 - qi; d1 = d1 < 0 ? -d1 : d1;
                    if (d0 > 128) p0[r] = -INFINITY; if (d1 > 128) p1[r] = -INFINITY; }
            }
            float mx[8];
#pragma unroll
            for (int r = 0; r < 8; ++r) mx[r] = fmaxf(fmaxf(p0[r], p0[r + 8]), fmaxf(p1[r], p1[r + 8]));
            float rm = fmaxf(fmaxf(fmaxf(mx[0], mx[1]), fmaxf(mx[2], mx[3])), fmaxf(fmaxf(mx[4], mx[5]), fmaxf(mx[6], mx[7])));
            rm = swapmax(rm);
            if (__any(rm > m_run)) {
                const float mn = fmaxf(m_run, rm), alpha = __builtin_amdgcn_exp2f(m_run - mn); m_run = mn; l_run *= alpha;
#pragma unroll
                for (int d = 0; d < NVB; ++d)
#pragma unroll
                    for (int r = 0; r < 16; ++r) o[d][r] *= alpha;
            }
            float sm[4] = {0.f, 0.f, 0.f, 0.f};
#pragma unroll
            for (int r = 0; r < 16; ++r) { p0[r] = __builtin_amdgcn_exp2f(p0[r] - m_run); p1[r] = __builtin_amdgcn_exp2f(p1[r] - m_run); sm[r & 3] += p0[r] + p1[r]; }
            l_run += (sm[0] + sm[1]) + (sm[2] + sm[3]);
            u32x4 pw[4];
            pw[0] = (u32x4){cvtpk(p0[0], p0[1]), cvtpk(p0[2], p0[3]), cvtpk(p0[4], p0[5]), cvtpk(p0[6], p0[7])};
            pw[1] = (u32x4){cvtpk(p0[8], p0[9]), cvtpk(p0[10], p0[11]), cvtpk(p0[12], p0[13]), cvtpk(p0[14], p0[15])};
            pw[2] = (u32x4){cvtpk(p1[0], p1[1]), cvtpk(p1[2], p1[3]), cvtpk(p1[4], p1[5]), cvtpk(p1[6], p1[7])};
            pw[3] = (u32x4){cvtpk(p1[8], p1[9]), cvtpk(p1[10], p1[11]), cvtpk(p1[12], p1[13]), cvtpk(p1[14], p1[15])};
            const unsigned vb = lds0 + LDS_V + slot * VS + ((lane >> 4) & 1) * 32 + (lane & 3) * 8 + (4 * hi + ((lane & 15) >> 2)) * 64;
#pragma unroll
            for (int dp = 0; dp < NVB; dp += 2) {
                s16x4 lo[2][4], hh[2][4];
#pragma unroll
                for (int dd = 0; dd < 2; ++dd)
#pragma unroll
                    for (int ks = 0; ks < 4; ++ks) { lo[dd][ks] = vtr(vb + (dp + dd) * 4096 + ks * 1024); hh[dd][ks] = vtr(vb + (dp + dd) * 4096 + ks * 1024 + 512); }
                asm volatile("s_waitcnt lgkmcnt(0)" ::: "memory"); __builtin_amdgcn_sched_barrier(0);
#pragma unroll
                for (int ks = 0; ks < 4; ++ks)
#pragma unroll
                    for (int dd = 0; dd < 2; ++dd) { const bf16x8 vf = (bf16x8){lo[dd][ks][0], lo[dd][ks][1], lo[dd][ks][2], lo[dd][ks][3], hh[dd][ks][0], hh[dd][ks][1], hh[dd][ks][2], hh[dd][ks][3]};
                        o[dp + dd] = __builtin_amdgcn_mfma_f32_32x32x16_bf16(vf, __builtin_bit_cast(bf16x8, pw[ks]), o[dp + dd], 0, 0, 0); }
            }
        }
    }
    const float linv = 1.0f / swapsum(l_run);
#pragma unroll
    for (int d = 0; d < NVB; ++d)
#pragma unroll
        for (int r4 = 0; r4 < 4; ++r4) { f32x4 v = {o[d][4 * r4] * linv, o[d][4 * r4 + 1] * linv, o[d][4 * r4 + 2] * linv, o[d][4 * r4 + 3] * linv};
            *(u32x2*)(S.o + (size_t)r32 * S.opitch + 32 * d + 8 * r4 + 4 * hi) = pack4(v); }
    asm volatile("s_waitcnt lgkmcnt(0)\n\ts_barrier" ::: "memory");
}

template <int NKC, int NVB, int MODE>
__device__ __forceinline__ void unit_pp(LAS unsigned char* lds, const Src& S, int t_lo, int t_hi, int qpos0, float sink_l2) {
    constexpr int KS = NKC * 1024, VS = NVB * 4096, RD = 3, LDS_K = 0, LDS_V = RD * KS;
    const int tid = opq_v((int)threadIdx.x), lane = tid & 63, r32 = lane & 31, hi = lane >> 5; const int wid = __builtin_amdgcn_readfirstlane(tid >> 6), grp = wid >> 2;
    const unsigned lds0 = (unsigned)(uintptr_t)lds;
    const int n = t_hi - t_lo;
    const int kops = (NKC + 7 - wid) / 8, vops = (NVB * 4) / 8;
    bf16x8 qr[NKC / 2];
#pragma unroll
    for (int d0 = 0; d0 < NKC / 2; ++d0) qr[d0] = *(const bf16x8*)(S.q + (size_t)r32 * S.qpitch + d0 * 16 + hi * 8);
#define PP_DMA_K(j) do { _Pragma("unroll") for (int c_ = 0; c_ < (NKC + 7) / 8; ++c_) { const int ch_ = wid + 8 * c_; if (ch_ < NKC) { \
        const bf16_t* src_ = (ch_ < 8) ? S.k0 + (size_t)((t_lo + (j)) * 64 + lane) * S.k0pitch + ch_ * 8 : S.k1 + (size_t)((t_lo + (j)) * 64 + lane) * S.k1pitch + (ch_ - 8) * 8; \
        glds16(src_, (unsigned)__builtin_amdgcn_readfirstlane(lds0 + LDS_K + ((j) % RD) * KS + ch_ * 1024)); } } } while (0)
#define PP_DMA_V(j) do { _Pragma("unroll") for (int c_ = 0; c_ < (NVB * 4 + 7) / 8; ++c_) { const int p_ = wid + 8 * c_; if (p_ < NVB * 4) { \
        const bf16_t* src_ = S.v + (size_t)((t_lo + (j)) * 64 + 16 * (p_ & 3) + (lane >> 2)) * S.vpitch + (p_ >> 2) * 32 + (lane & 3) * 8; \
        glds16(src_, (unsigned)__builtin_amdgcn_readfirstlane(lds0 + LDS_V + ((j) % RD) * VS + p_ * 1024)); } } } while (0)
#define PP_BATCH(b, cnt) do { cnt = 0; if ((b) + 3 < n) { PP_DMA_K((b) + 3); cnt += kops; } if ((b) + 2 < n) { PP_DMA_V((b) + 2); cnt += vops; } } while (0)
    float m_run = (MODE == 0) ? sink_l2 : -INFINITY, l_run = (MODE == 0 && hi == 0) ? 1.0f : 0.0f;
    f32x16 o[NVB];
#pragma unroll
    for (int d = 0; d < NVB; ++d) o[d] = f32x16{};
    const int qi = qpos0 + wid * 32 + r32, qw0 = qpos0 + wid * 32;
#define PP_ACTIVE(j) ((MODE != 0) || ((64 * (t_lo + (j)) + 63 >= qw0 - 128) && (64 * (t_lo + (j)) <= qw0 + 31 + 128)))
    f32x16 p0 = f32x16{}, p1 = f32x16{}; u32x4 pw[4] = {};
#define PP_QK(j) do { const LAS unsigned char* kb_ = lds + LDS_K + ((j) % RD) * KS + hi * 1024 + r32 * 16; p0 = f32x16{}; p1 = f32x16{}; \
        _Pragma("unroll") for (int d0 = 0; d0 < NKC / 2; ++d0) { const bf16x8 b0_ = *(const LAS bf16x8*)(kb_ + d0 * 2048), b1_ = *(const LAS bf16x8*)(kb_ + d0 * 2048 + 512); \
            p0 = __builtin_amdgcn_mfma_f32_32x32x16_bf16(b0_, qr[d0], p0, 0, 0, 0); p1 = __builtin_amdgcn_mfma_f32_32x32x16_bf16(b1_, qr[d0], p1, 0, 0, 0); } } while (0)
#define PP_SOFTMAX(j) do { \
        if (MODE == 0) { _Pragma("unroll") for (int r = 0; r < 16; ++r) { const int kv_ = 64 * (t_lo + (j)) + crow(r, hi); int e0_ = kv_ - qi; e0_ = e0_ < 0 ? -e0_ : e0_; int e1_ = kv_ + 32 - qi; e1_ = e1_ < 0 ? -e1_ : e1_; \
            if (e0_ > 128) p0[r] = -INFINITY; if (e1_ > 128) p1[r] = -INFINITY; } } \
        float rm_ = fmaxf(p0[0], p1[0]); _Pragma("unroll") for (int r = 1; r < 16; ++r) rm_ = fmaxf(rm_, fmaxf(p0[r], p1[r])); rm_ = swapmax(rm_); \
        const float mn_ = fmaxf(m_run, rm_), alpha_ = __builtin_amdgcn_exp2f(m_run - mn_); m_run = mn_; float sum_ = 0.f; \
        _Pragma("unroll") for (int r = 0; r < 16; ++r) { p0[r] = __builtin_amdgcn_exp2f(p0[r] - mn_); p1[r] = __builtin_amdgcn_exp2f(p1[r] - mn_); sum_ += p0[r] + p1[r]; } \
        l_run = l_run * alpha_ + sum_; \
        _Pragma("unroll") for (int d = 0; d < NVB; ++d) _Pragma("unroll") for (int r = 0; r < 16; ++r) o[d][r] *= alpha_; \
        pw[0] = (u32x4){cvtpk(p0[0], p0[1]), cvtpk(p0[2], p0[3]), cvtpk(p0[4], p0[5]), cvtpk(p0[6], p0[7])}; pw[1] = (u32x4){cvtpk(p0[8], p0[9]), cvtpk(p0[10], p0[11]), cvtpk(p0[12], p0[13]), cvtpk(p0[14], p0[15])}; \
        pw[2] = (u32x4){cvtpk(p1[0], p1[1]), cvtpk(p1[2], p1[3]), cvtpk(p1[4], p1[5]), cvtpk(p1[6], p1[7])}; pw[3] = (u32x4){cvtpk(p1[8], p1[9]), cvtpk(p1[10], p1[11]), cvtpk(p1[12], p1[13]), cvtpk(p1[14], p1[15])}; } while (0)
#define PP_PV(j) do { const unsigned vb_ = lds0 + LDS_V + ((j) % RD) * VS + ((lane >> 4) & 1) * 32 + (lane & 3) * 8 + (4 * hi + ((lane & 15) >> 2)) * 64; \
        _Pragma("unroll") for (int d = 0; d < NVB; ++d) { s16x4 lo_[4], hh_[4]; \
            _Pragma("unroll") for (int ks = 0; ks < 4; ++ks) { lo_[ks] = vtr(vb_ + d * 4096 + ks * 1024); hh_[ks] = vtr(vb_ + d * 4096 + ks * 1024 + 512); } \
            asm volatile("s_waitcnt lgkmcnt(0)" ::: "memory"); __builtin_amdgcn_sched_barrier(0); \
            _Pragma("unroll") for (int ks = 0; ks < 4; ++ks) { const bf16x8 vf_ = (bf16x8){lo_[ks][0], lo_[ks][1], lo_[ks][2], lo_[ks][3], hh_[ks][0], hh_[ks][1], hh_[ks][2], hh_[ks][3]}; \
                o[d] = __builtin_amdgcn_mfma_f32_32x32x16_bf16(vf_, __builtin_bit_cast(bf16x8, pw[ks]), o[d], 0, 0, 0); } } } while (0)
    PP_DMA_K(0); PP_DMA_V(0); if (n > 1) { PP_DMA_K(1); PP_DMA_V(1); } if (n > 2) PP_DMA_K(2);
    asm volatile("s_waitcnt vmcnt(0) lgkmcnt(0)\n\ts_barrier" ::: "memory");
    if (grp == 1) asm volatile("s_barrier" ::: "memory");
    int infl = 0;
    if (PP_ACTIVE(0)) PP_QK(0);
    wait_vm_bar(infl);
    if (grp == 1) PP_BATCH(0, infl);
    if (PP_ACTIVE(0)) PP_SOFTMAX(0);
    wait_vm_bar(infl);
    for (int j = 0; j < n; ++j) {
        if (grp == 0) PP_BATCH(j, infl);
        const bool act = PP_ACTIVE(j), actn = (j + 1 < n) && PP_ACTIVE(j + 1);
        if (act) PP_PV(j);
        if (actn) PP_QK(j + 1);
        wait_vm_bar(infl);
        if (j + 1 < n) {
            if (grp == 1) PP_BATCH(j + 1, infl);
            if (actn) PP_SOFTMAX(j + 1);
            wait_vm_bar(infl);
        }
    }
    if (grp == 0) asm volatile("s_barrier" ::: "memory");
    const float linv = 1.0f / swapsum(l_run);
#pragma unroll
    for (int d = 0; d < NVB; ++d)
#pragma unroll
        for (int r4 = 0; r4 < 4; ++r4) { f32x4 v = {o[d][4 * r4] * linv, o[d][4 * r4 + 1] * linv, o[d][4 * r4 + 2] * linv, o[d][4 * r4 + 3] * linv};
            *(u32x2*)(S.o + (size_t)r32 * S.opitch + 32 * d + 8 * r4 + 4 * hi) = pack4(v); }
    asm volatile("s_waitcnt lgkmcnt(0)\n\ts_barrier" ::: "memory");
#undef PP_DMA_K
#undef PP_DMA_V
#undef PP_BATCH
#undef PP_ACTIVE
#undef PP_QK
#undef PP_SOFTMAX
#undef PP_PV
}
}
#define SC_AFTER_PROLOGUE() do {} while (0)
#define SC_AFTER_INPROJ(l) do {} while (0)
#define SC_AFTER_UP(l) do {} while (0)
#define SC_AFTER_MLA(l) do {} while (0)
#define SC_AFTER_BRANCH(l) do {} while (0)
#define SC_AFTER_WOUT(l) do {} while (0)
#define SC_AFTER_NORM2(l) do {} while (0)
#define SC_AFTER_GU(l) do {} while (0)
#define SC_AFTER_DOWN(l) do {} while (0)
#define SC_AFTER_ROUTE(l) do {} while (0)
#define SC_AFTER_MOEGU(l, h) do {} while (0)
#define SC_AFTER_MOED(l, h) do {} while (0)
#define SC_FINAL() do {} while (0)

struct Args { const float* in[23]; float* out; unsigned char* ws; };
#define WSP(type, off) ((type*)(F.ws + (off)))
#define PHASE() Frame Fp = F; Fp.ws = opq_p(F.ws); Fp.in = opq_p(F.in); Fp.out = opq_p(F.out); Fp.tid = opq_v((int)threadIdx.x); Fp.lane = Fp.tid & 63; Fp.wave = __builtin_amdgcn_readfirstlane(Fp.tid >> 6); (void)Fp
#define FWS(type, off) ((type*)(Fp.ws + (off)))
#define X_ (Fp.out)
#define H_ FWS(bf16_t, WS_H)
#define Pb_ FWS(bf16_t, WS_R + R_P)
#define Gb_ FWS(bf16_t, WS_R + R_G)
#define QB_ FWS(bf16_t, WS_R + R_QB)
#define KVB_ FWS(bf16_t, WS_R + R_KVB)
#define Yb_ FWS(bf16_t, WS_R + R_Y)
#define MEMN_ FWS(bf16_t, WS_MEMN)
#define MEMKV_ FWS(bf16_t, WS_MEMKV)
#define ACT_ FWS(bf16_t, WS_R + R_ACT)
#define ASORT_ FWS(bf16_t, WS_R + R_ASORT)
#define YOUT_ FWS(bf16_t, WS_R + R_YOUT)
#define SSQ_ FWS(float, WS_MISC + MS_SSQ)
#define TEXP_ FWS(const int, WS_MISC + MS_TEXP)
#define POS_ ((const int*)Fp.in[I_POS])
#define HSC_ FWS(float, WS_MISC + MS_HSC)
#define ASC_ FWS(float, WS_MISC + MS_ASC)
#define WSIN_ FWS(float, WS_MISC + MS_WSIN)
#define WSGU_ FWS(float, WS_MISC + MS_WSGU)

#define GRID_BAR() xcd_barrier(bar)
template <int l> __device__ __forceinline__ void layer_body(const Frame& F, const XcdBarrier& bar, const int bx) {
        if (l > 0) {
            PHASE();
            prep_ffn_weights(Fp, l);
            norm_phase(Fp, X_, X_, Fp.in[I_GMIX] + l * DM, (l & 1) == 0, true);
            GRID_BAR();
        }
        {   PHASE();
            ProbSimple p{DM, DM, DM, (const char*)H_, (const char*)wmix(Fp, l, WL_IN)}; pg8::StaticOrder S; S.init(T / 256, NT_IN, Fp.G, bx);
            EpiInproj E{Pb_, Gb_, SSQ_, POS_, HSC_, WSIN_ + l * NT_IN * 256}; pg8::gemm_phase<true>(Fp.lds, p, S, E); }
        if (l == 0) { PHASE();
            ProbSimple p{DM, DM * 2, DM * 2, (const char*)MEMN_, (const char*)FWS(bf16_t, WS_WMKV)}; pg8::StaticOrder S; S.init(NB * MEML / 256, 16, Fp.G, bx);
            EpiPlain E{MEMKV_, 4096}; pg8::gemm_phase(Fp.lds, p, S, E); }
        GRID_BAR();
        SC_AFTER_INPROJ(l);
        {   PHASE();
            ProbSimple p{UPK, PW * 2, UPK * 2, (const char*)(Pb_ + P_CQ), (const char*)wmix(Fp, l, WL_UP)}; pg8::StaticOrder S; S.init(T / 256, UPN / 256, Fp.G, bx);
            EpiUp E{QB_, KVB_, SSQ_, POS_}; pg8::gemm_phase(Fp.lds, p, S, E); }
        {   PHASE();
            for (int i = Fp.vcu; i < 1024; i += Fp.G) {
                const int hl = i & 3, qb = (i >> 2) & 15, kvh = (i >> 6) & 1, b = i >> 7, h = kvh * 4 + hl; const size_t rowb = (size_t)b * SEQ; const int q0 = qb * 256;
                att::Src s; s.q = Pb_ + (rowb + q0 + Fp.wave * 32) * PW + P_QA + h * 64; s.qpitch = PW; s.k0 = Pb_ + rowb * PW + P_KA + kvh * 64; s.k0pitch = PW; s.k1 = s.k0; s.k1pitch = PW;
                s.v = Pb_ + rowb * PW + P_VA + kvh * 64; s.vpitch = PW; s.o = Yb_ + (rowb + q0 + Fp.wave * 32) * YW + h * 64; s.opitch = YW;
                const int t_lo = (q0 / 64 - 2) < 0 ? 0 : (q0 / 64 - 2), t_hi = (q0 / 64 + 6) > SEQ / 64 ? SEQ / 64 : (q0 / 64 + 6);
                att::unit<8, 2, 0>(Fp.lds, s, t_lo, t_hi, q0, Fp.in[I_SINK][l * 8 + h] * LOG2E);
            } }
        {   PHASE();
            for (int i = Fp.vcu; i < 512; i += Fp.G) {
                const int qb = i & 15, h = (i >> 4) & 3, b = i >> 6; const size_t rowq = (size_t)b * SEQ + qb * 256 + Fp.wave * 32;
                att::Src s; s.q = Pb_ + rowq * PW + P_QM + h * 128; s.qpitch = PW; s.k0 = MEMKV_ + (size_t)b * MEML * 4096 + l * 1024 + h * 128; s.k0pitch = 4096; s.k1 = s.k0 + 64; s.k1pitch = 4096;
                s.v = MEMKV_ + (size_t)b * MEML * 4096 + l * 1024 + 512 + h * 128; s.vpitch = 4096; s.o = Yb_ + rowq * YW + 1024 + h * 128; s.opitch = YW;
                att::unit<16, 4, 1>(Fp.lds, s, 0, MEML / 64, 0, 0.f);
            } }
        GRID_BAR();
        SC_AFTER_UP(l);
        {   PHASE();
            for (int i = Fp.vcu; i < 1024; i += Fp.G) {
                const int qb = i & 15, h = (i >> 4) & 7, b = i >> 7; const size_t rowb = (size_t)b * SEQ, rowq = rowb + qb * 256 + Fp.wave * 32;
                att::Src s; s.q = QB_ + rowq * QBW + h * 96; s.qpitch = QBW; s.k0 = KVB_ + rowb * KVW + h * 128; s.k0pitch = KVW; s.k1 = Pb_ + rowb * PW + P_KR; s.k1pitch = PW;
                s.v = KVB_ + rowb * KVW + h * 128 + 64; s.vpitch = KVW; s.o = Yb_ + rowq * YW + 512 + h * 64; s.opitch = YW;
                att::unit<12, 2, 1>(Fp.lds, s, 0, SEQ / 64, 0, 0.f);
            } }
        GRID_BAR();
        SC_AFTER_MLA(l);
        {   PHASE();
            ProbBranch p{512, YW * 2, 512 * 2, (const char*)Yb_, (const char*)wmix(Fp, l, WL_BR)}; SegOrder S; S.base.init(T / 256, DM / 256, Fp.G, bx);
            EpiBranch E{Gb_, FWS(float, WS_R + R_BRS) + (size_t)bx * 65536, H_}; pg8::gemm_phase(Fp.lds, p, S, E); }
        GRID_BAR();
        SC_AFTER_BRANCH(l);
        {   PHASE();
            ProbSimple p{DM, DM * 2, DM * 2, (const char*)H_, (const char*)wmix(Fp, l, WL_OUT)}; pg8::StaticOrder S; S.init(T / 256, DM / 256, Fp.G, bx);
            EpiResid E{l == 0 ? Fp.in[I_X] : X_, X_}; pg8::gemm_phase(Fp.lds, p, S, E); }
        GRID_BAR();
        SC_AFTER_WOUT(l);
        if ((l & 1) == 0) {
            {   PHASE(); norm_phase(Fp, X_, nullptr, Fp.in[I_GFFN] + l * DM, false, GU_I8(l) != 0); }
            GRID_BAR();
            SC_AFTER_NORM2(l);
            {   PHASE();
                constexpr bool i8 = GU_I8(l) != 0; constexpr unsigned eb = i8 ? 1 : 2;
                ProbSimple p{DM, DM * eb, DM * eb, (const char*)H_, (const char*)FWS(bf16_t, WS_WFFN + WF_GU)}; pg8::StaticOrder S; S.init(T / 256, 2 * DFF / 256, Fp.G, bx);
                EpiSwiglu E{ACT_, 0, HSC_, WSGU_}; pg8::gemm_phase<i8>(Fp.lds, p, S, E); }
            GRID_BAR();
            SC_AFTER_GU(l);
            {   PHASE();
                ProbSimple p{DFF, DFF * 2, DFF * 2, (const char*)ACT_, (const char*)FWS(bf16_t, WS_WFFN + WF_D)}; pg8::StaticOrder S; S.init(T / 256, DM / 256, Fp.G, bx);
                EpiResid E{X_, X_}; pg8::gemm_phase(Fp.lds, p, S, E); }
            GRID_BAR();
            SC_AFTER_DOWN(l);
        } else {
            {   PHASE(); norm_router_phase(Fp, X_, Fp.in[I_GFFN] + l * DM, Fp.in[I_WR] + (size_t)(l >> 1) * DM * NE, GU_I8(l) != 0); }
            GRID_BAR();
            {   PHASE(); moe_assign_phase(Fp, GU_I8(l) != 0); }
            GRID_BAR();
            SC_AFTER_ROUTE(l);
            {   constexpr int half = 0; (void)half;
                {   PHASE();
                    const int nrt = TEXP_[MAXRT];
                    constexpr bool i8 = GU_I8(l) != 0; constexpr unsigned eb = i8 ? 1 : 2;
                    ProbMoe p{DM, DM * eb, DM * eb, (const char*)ASORT_, (const char*)FWS(bf16_t, WS_WFFN + WF_GU), 0}; MoeOrder S; S.base.init(nrt, 2 * DFF / 256, Fp.G, bx); S.lo = 0; S.texp = TEXP_;
                    EpiSwiglu E{ACT_, 0, ASC_, WSGU_}; pg8::gemm_phase<i8>(Fp.lds, p, S, E); }
                GRID_BAR();
                SC_AFTER_MOEGU(l, half);
                {   PHASE();
                    const int nrt = TEXP_[MAXRT];
                    ProbMoe p{DFF, DFF * 2, DFF * 2, (const char*)ACT_, (const char*)FWS(bf16_t, WS_WFFN + WF_D), 0}; MoeOrder S; S.base.init(nrt, DM / 256, Fp.G, bx); S.lo = 0; S.texp = TEXP_;
                    EpiYout E{YOUT_}; pg8::gemm_phase(Fp.lds, p, S, E); }
                GRID_BAR();
                SC_AFTER_MOED(l, half);
            }
        }
    }

__global__ void __launch_bounds__(NWAVES * 64, 2) fwd(Args args) {
    extern __shared__ __attribute__((aligned(16))) unsigned char lds_raw[];
    Frame F;
    F.lds = (LAS unsigned char*)lds_raw;
    F.MISC = (volatile LAS unsigned*)(F.lds + LDSCTL_OFF);
    F.tid = threadIdx.x; F.lane = F.tid & 63; F.wave = __builtin_amdgcn_readfirstlane(F.tid >> 6);
    F.G = gridDim.x; { const int bx = blockIdx.x; F.vcu = (F.G % 8 == 0) ? (bx % 8) * (F.G / 8) + bx / 8 : bx; }
    F.ws = args.ws; F.ctl = (gu32*)(args.ws + WS_CTL); F.out = args.out;
    F.in = (const float* const*)__builtin_amdgcn_kernarg_segment_ptr();
    for (int u = F.tid; u < (LDS_BYTES - LDSCTL_OFF) / 4; u += NWAVES * 64) ((LAS unsigned*)(F.lds + LDSCTL_OFF))[u] = 0u;
    __syncthreads();
    XcdBarrier bar = xcd_barrier_post((unsigned*)(F.ctl + CW_BAR), F.MISC + 8);

    const int bx = (int)blockIdx.x;

    {   PHASE();
        prep_mixer_weights(Fp);
        memnorm_phase(Fp);
        prep_ffn_weights(Fp, 0);
        norm_phase(Fp, Fp.in[I_X], nullptr, Fp.in[I_GMIX], false, true); }
    GRID_BAR();
    SC_AFTER_PROLOGUE();

    layer_body<0>(F, bar, bx); layer_body<1>(F, bar, bx); layer_body<2>(F, bar, bx); layer_body<3>(F, bar, bx);
    {   PHASE(); final_norm_phase(Fp, X_, Fp.in[I_GFIN], true); }
    SC_FINAL();
}

extern "C" void kernel_launch(void* const* d_in, const int* in_sizes, int n_in, void* d_out, int out_size, void* d_ws, size_t ws_size, hipStream_t stream) {
    static int grid = 0;
    if (grid == 0) {
        if (n_in != 23 || out_size != T * DM || ws_size < WS_END) { fprintf(stderr, "kernel_launch: unexpected problem (n_in %d, out %d, ws %zu < %zu)\n", n_in, out_size, ws_size, (size_t)WS_END); grid = -1; return; }
        int dev = 0, cus = 0;
        if (hipGetDevice(&dev) != hipSuccess || hipDeviceGetAttribute(&cus, hipDeviceAttributeMultiprocessorCount, dev) != hipSuccess) { grid = -1; return; }
        if (hipFuncSetAttribute((const void*)fwd, hipFuncAttributeMaxDynamicSharedMemorySize, LDS_BYTES) != hipSuccess) { fprintf(stderr, "kernel_launch: hipFuncSetAttribute failed\n"); grid = -1; return; }
        int per_cu = 0;
        if (hipOccupancyMaxActiveBlocksPerMultiprocessor(&per_cu, (const void*)fwd, NWAVES * 64, LDS_BYTES) != hipSuccess || per_cu < 1) fprintf(stderr, "kernel_launch: occupancy query says %d\n", per_cu);
        (void)hipGetLastError();
        grid = cus;
    }
    if (grid < 0) return;
    if (hipMemsetAsync((char*)d_ws + WS_CTL, 0, CTL_ZERO_BYTES, stream) != hipSuccess) return;
    Args a{};
    for (int i = 0; i < 23; ++i) a.in[i] = (const float*)d_in[i];
    a.out = (float*)d_out; a.ws = (unsigned char*)d_ws;
    hipLaunchKernelGGL(fwd, dim3(grid), dim3(NWAVES * 64), LDS_BYTES, stream, a);
}
```

```cpp
#include <hip/hip_runtime.h>
#include <cstdio>
#include <cstdint>

#ifndef SELFCHECK
#define SELFCHECK 0
#endif
#ifndef GU_I8_MASK
#define GU_I8_MASK 0xF
#endif
#define GU_I8(l) ((((unsigned)GU_I8_MASK) >> (l)) & 1u)

#define GAS __attribute__((address_space(1)))
#define LAS __attribute__((address_space(3)))
typedef unsigned short bf16_t;
typedef short bf16x8 __attribute__((ext_vector_type(8)));
typedef short s16x4 __attribute__((ext_vector_type(4)));
typedef short v4i16_t __attribute__((ext_vector_type(4)));
typedef float f32x2 __attribute__((ext_vector_type(2)));
typedef float f32x4 __attribute__((ext_vector_type(4)));
typedef float f32x16 __attribute__((ext_vector_type(16)));
typedef unsigned u32x2 __attribute__((ext_vector_type(2)));
typedef unsigned u32x4 __attribute__((ext_vector_type(4)));
typedef int i32x4 __attribute__((ext_vector_type(4)));
typedef GAS unsigned gu32;
#define RLX_AGENT __ATOMIC_RELAXED, __HIP_MEMORY_SCOPE_AGENT

constexpr int NB = 8, SEQ = 4096, T = NB * SEQ, DM = 1024, DEPTH = 4, MEML = 256, DFF = 3584, NE = 8;
constexpr int INW = 4768;
constexpr int PW = 1792;
constexpr int GW = 3072;
constexpr int QBW = 768, KVW = 1024, YW = 1536;
constexpr int NT_IN = 19;
constexpr int P_QA = 0, P_KA = 512, P_VA = 640, P_CQ = 768, P_CKV = 1024, P_KR = 1152, P_QM = 1280;
constexpr int UPK = 384, UPN = 1792;
constexpr int MAXSLOT = 67584;
constexpr int MAXRT = MAXSLOT / 256;
constexpr int HALF_RT = 132;
constexpr float EPS = 1e-6f;
constexpr float LOG2E = 1.4426950408889634f;
constexpr float C_A = 0.125f * LOG2E;
constexpr float C_B = 0.10206207261596575f * LOG2E;
constexpr float C_M = 0.08838834764831845f * LOG2E;

constexpr size_t MiB = 1u << 20;
constexpr size_t WS_CTL = 0, CTL_ZERO_BYTES = 1 * MiB;
constexpr size_t WS_MISC = 1 * MiB;
constexpr size_t WL_IN = 0, WL_UP = (size_t)NT_IN * 256 * DM * 2, WL_BR = WL_UP + (size_t)UPN * UPK * 2, WL_OUT = WL_BR + (size_t)3 * DM * 512 * 2, WL_SIZE = WL_OUT + (size_t)DM * DM * 2;
constexpr size_t WS_WMIX = 8 * MiB;
constexpr size_t WS_WMKV = WS_WMIX + 4 * ((WL_SIZE + MiB - 1) / MiB) * MiB;
constexpr size_t WL_STRIDE = ((WL_SIZE + MiB - 1) / MiB) * MiB;
constexpr size_t WS_WFFN = WS_WMKV + 8 * MiB;
constexpr size_t WF_GU = 0, WF_D = (size_t)2 * DFF * DM * 2, WF_STRIDE = WF_D + (size_t)DM * DFF * 2;
constexpr size_t WS_H = WS_WFFN + 8 * WF_STRIDE;
constexpr size_t WS_MEMN = WS_H + (size_t)T * DM * 2;
constexpr size_t WS_MEMKV = WS_MEMN + (size_t)NB * MEML * DM * 2;
constexpr size_t WS_R = WS_MEMKV + (size_t)NB * MEML * 4096 * 2;
constexpr size_t R_P = 0, R_G = R_P + (size_t)T * PW * 2, R_QB = R_G + (size_t)T * GW * 2, R_KVB = R_QB + (size_t)T * QBW * 2, R_Y = R_KVB + (size_t)T * KVW * 2, R_END_MIX = R_Y + (size_t)T * YW * 2;
constexpr size_t R_BRS = R_P;
constexpr size_t R_ACT = 0;
constexpr size_t R_ASORT = (size_t)MAXSLOT * DFF * 2;
constexpr size_t R_YOUT = R_ASORT;
constexpr size_t R_END_FFN = R_YOUT + (size_t)MAXSLOT * DM * 2;
constexpr size_t R_SIZE = R_END_MIX > R_END_FFN ? R_END_MIX : R_END_FFN;
constexpr size_t WS_END = WS_R + R_SIZE;
static_assert(WS_END < 1020ull * MiB, "workspace budget");
constexpr size_t MS_TOKE = 0;
constexpr size_t MS_TOKW = MS_TOKE + (size_t)T * 8;
constexpr size_t MS_SLOT = MS_TOKW + (size_t)T * 8;
constexpr size_t MS_CNT = MS_SLOT + (size_t)T * 8;
constexpr size_t MS_TEXP = MS_CNT + 256 * 8 * 4;
constexpr size_t MS_SSQ = MS_TEXP + 2048;
constexpr size_t MS_SNAP = MS_SSQ + (size_t)T * 32;
constexpr size_t MS_HSC = MS_SNAP + 64 * 1024 * 4;
constexpr size_t MS_ASC = MS_HSC + (size_t)T * 4;
constexpr size_t MS_WSIN = MS_ASC + (size_t)MAXSLOT * 4;
constexpr size_t MS_WSGU = MS_WSIN + (size_t)4 * NT_IN * 256 * 4;
constexpr size_t MS_END = MS_WSGU + (size_t)8 * 2 * DFF * 4;
static_assert(MS_END <= 7 * MiB, "misc map");
constexpr int CW_BAR = 4096;
constexpr int CW_DIAG = 16384;
constexpr int CW_CODE = 16384 + 512;

constexpr int RING_BYTES = 131072;
constexpr int LDSCTL_OFF = RING_BYTES;
constexpr int LDS_BYTES = 147456;
constexpr int NWAVES = 8;

#define LDS_WAIT() asm volatile("s_waitcnt lgkmcnt(0)" ::: "memory")
#define VM_WAIT() asm volatile("s_waitcnt vmcnt(0)" ::: "memory")

__device__ __forceinline__ unsigned f2bf(float f) { unsigned u = __builtin_bit_cast(unsigned, f); return (u + 0x7fffu + ((u >> 16) & 1u)) >> 16; }
__device__ __forceinline__ unsigned pk2(float lo, float hi) { return f2bf(lo) | (f2bf(hi) << 16); }
__device__ __forceinline__ float bf2f(unsigned short b) { return __builtin_bit_cast(float, (unsigned)b << 16); }
__device__ __forceinline__ float bflo(unsigned w) { return __builtin_bit_cast(float, w << 16); }
__device__ __forceinline__ float bfhi(unsigned w) { return __builtin_bit_cast(float, w & 0xffff0000u); }
typedef __bf16 bf16x2_t __attribute__((ext_vector_type(2)));
__device__ __forceinline__ unsigned cvtpk(float lo, float hi) { f32x2 v = {lo, hi}; bf16x2_t b = __builtin_convertvector(v, bf16x2_t); return __builtin_bit_cast(unsigned, b); }
__device__ __forceinline__ float wave_sum(float v) {
#pragma unroll
    for (int o = 1; o < 64; o <<= 1) v += __shfl_xor(v, o);
    return v;
}
__device__ __forceinline__ float fast_sigmoid(float x) { return __builtin_amdgcn_rcpf(1.0f + __builtin_amdgcn_exp2f(-x * LOG2E)); }


__device__ __forceinline__ int opq_v(int x) { asm volatile("" : "+v"(x)); return x; }
__device__ __forceinline__ int opq_s(int x) { asm volatile("" : "+s"(x)); return x; }
template <class Tp> __device__ __forceinline__ Tp* opq_p(Tp* p) { const unsigned long long u = (unsigned long long)p; unsigned lo = __builtin_amdgcn_readfirstlane((unsigned)u), hi = __builtin_amdgcn_readfirstlane((unsigned)(u >> 32)); asm volatile("" : "+s"(lo), "+s"(hi)); return (Tp*)(((unsigned long long)hi << 32) | lo); }

__constant__ float IFR_HI[32] = {1.591549367e-01f, 1.193493679e-01f, 8.949939907e-02f, 6.711508334e-02f, 5.032921210e-02f, 3.774158657e-02f, 2.830219641e-02f, 2.122365311e-02f, 1.591549441e-02f, 1.193493698e-02f, 8.949940093e-03f, 6.711508147e-03f, 5.032921210e-03f, 3.774158424e-03f, 2.830219688e-03f, 2.122365171e-03f, 1.591549488e-03f, 1.193493721e-03f, 8.949940093e-04f, 6.711508031e-04f, 5.032921326e-04f, 3.774158540e-04f, 2.830219455e-04f, 2.122365258e-04f, 1.591549371e-04f, 1.193493736e-04f, 8.949940093e-05f, 6.711508468e-05f, 5.032921035e-05f, 3.774158540e-05f, 2.830219637e-05f, 2.122365186e-05f};
__constant__ float IFR_LO[32] = {6.420638243e-09f, 2.294664903e-09f, 2.542919653e-09f, -3.316028840e-10f, 5.173299289e-12f, -1.848551645e-09f, -5.826552019e-10f, -3.431038786e-10f, -1.029942243e-10f, 4.320196978e-11f, 6.802745173e-11f, 1.531042237e-10f, 5.173301024e-13f, 4.797548470e-11f, -1.048316434e-10f, 1.053879969e-10f, -5.686555046e-11f, -1.896286773e-11f, 6.802744999e-12f, 2.695195456e-11f, -1.158979943e-11f, -6.843983713e-12f, 1.279990003e-11f, 1.807650600e-12f, 5.954976963e-12f, -3.351478166e-12f, 6.802745216e-13f, -1.670379113e-12f, 1.751403167e-12f, -6.843983930e-13f, -5.389994549e-13f, 9.083608431e-13f};
__device__ __forceinline__ void rot_cs(float posf, int idx, float& c, float& s) {
    const float ch = IFR_HI[idx], cl = IFR_LO[idx];
    const float p = posf * ch, e = __builtin_fmaf(posf, ch, -p);
    const float fr = __builtin_amdgcn_fractf(p) + (e + posf * cl);
    s = __builtin_amdgcn_sinf(fr); c = __builtin_amdgcn_cosf(fr);
}

#define XB_TMO      128
#define XB_XCNT(j)  (256  + 64 * (j))
#define XB_XSUB(j)  (1280 + 64 * (j))
#define XB_XGEN(j)  (2304 + 64 * (j))
#define XB_TOP      3328
#define XB_TOPGEN   3392
#define XCD_BAR_WORDS 3456
#define XB_SPIN_CAP (1u << 20)

__device__ __forceinline__ unsigned xb_ld(unsigned* p)              { return __hip_atomic_load(p, __ATOMIC_RELAXED, __HIP_MEMORY_SCOPE_AGENT); }
__device__ __forceinline__ unsigned xb_add(unsigned* p, unsigned v) { return __hip_atomic_fetch_add(p, v, __ATOMIC_RELAXED, __HIP_MEMORY_SCOPE_AGENT); }
__device__ __forceinline__ unsigned xb_xcc_id() { return (unsigned)__builtin_amdgcn_s_getreg((3 << 11) | 20) & 0xFu; }
#define XB_SPIN(cond, bar) do { unsigned _sp = 0; while (cond) { __builtin_amdgcn_s_sleep(1); \
    if ((++_sp & 255u) == 0u) { if (xb_ld(&(bar)[XB_TMO])) break; if (_sp > XB_SPIN_CAP) { atomicAdd(&(bar)[XB_TMO], 1u); break; } } } } while (0)

struct XcdBarrier { unsigned* bar; unsigned x; volatile LAS unsigned* st; };

__device__ __forceinline__ XcdBarrier xcd_barrier_post(unsigned* bar, volatile LAS unsigned* st) {
    XcdBarrier b; b.bar = bar; b.x = xb_xcc_id(); b.st = st;
    if (threadIdx.x == 0) (void)xb_add(&bar[XB_XCNT(b.x)], 1u);
    return b;
}
__device__ __forceinline__ void xcd_barrier_complete(unsigned* bar, unsigned x, unsigned& nloc, unsigned& nx) {
    const unsigned G = gridDim.x * gridDim.y * gridDim.z;
    unsigned sum, cnt, mine, sp = 0u;
    for (;;) {
        sum = 0u; cnt = 0u; mine = 0u;
#pragma unroll
        for (unsigned j = 0; j < 16; ++j) { const unsigned c = xb_ld(&bar[XB_XCNT(j)]); sum += c; cnt += (c > 0u) ? 1u : 0u; mine = (j == x) ? c : mine; }
        if (sum == G) break;
        __builtin_amdgcn_s_sleep(1);
        if ((++sp & 255u) == 0u) { if (xb_ld(&bar[XB_TMO])) break; if (sp > XB_SPIN_CAP) { atomicAdd(&bar[XB_TMO], 1u); break; } }
    }
    nloc = mine > 0u ? mine : 1u; nx = cnt > 0u ? cnt : 1u;
}
__device__ __forceinline__ void xcd_barrier(const XcdBarrier& b) {
    asm volatile("s_waitcnt vmcnt(0)" ::: "memory");
    __syncthreads();
    if (threadIdx.x == 0) {
        unsigned* bar = b.bar;
        __builtin_amdgcn_s_waitcnt(0);
        unsigned nloc = b.st[0], nx = b.st[1];
        if (nloc == 0u) { xcd_barrier_complete(bar, b.x, nloc, nx); b.st[0] = nloc; b.st[1] = nx; }
        const unsigned old = xb_add(&bar[XB_XSUB(b.x)], 1u);
        const unsigned gen = old / nloc;
        if (old + 1u == (gen + 1u) * nloc) {
            __builtin_amdgcn_fence(__ATOMIC_RELEASE, "agent");
            asm volatile("s_waitcnt vmcnt(0)" ::: "memory");
            const unsigned og = xb_add(&bar[XB_TOP], 1u);
            const unsigned tg = og / nx;
            if (og + 1u == (tg + 1u) * nx) xb_add(&bar[XB_TOPGEN], 1u);
            else XB_SPIN(xb_ld(&bar[XB_TOPGEN]) == tg, bar);
            __builtin_amdgcn_fence(__ATOMIC_ACQUIRE, "agent");
            xb_add(&bar[XB_XGEN(b.x)], 1u);
            asm volatile("s_waitcnt vmcnt(0)" ::: "memory");
        } else {
            XB_SPIN(xb_ld(&bar[XB_XGEN(b.x)]) == gen, bar);
            __builtin_amdgcn_fence(__ATOMIC_ACQUIRE, "agent");
            asm volatile("s_waitcnt vmcnt(0)" ::: "memory");
        }
    }
    __syncthreads();
}

namespace pg8 {
constexpr int BM = 256, BK = 64, HALF = 128, HTB = HALF * BK * 2, STAGE_BYTES = 8 * HTB, NXCD = 8, WGM = 8;
__host__ __device__ __forceinline__ int lds_byte(int r, int c) { const int st = (r >> 4) * 2 + (c >> 5), rr = r & 15, cc = c & 31, ob = rr * 64 + cc * 2; return st * 1024 + (ob ^ (((ob >> 9) & 1) << 5)); }
__host__ __device__ __forceinline__ void stage_rc(int b, int& R, int& C) { const int st = b / 1024, sb = b % 1024, swz = sb ^ (((sb >> 9) & 1) << 5); R = (st >> 1) * 16 + swz / 64; C = (st & 1) * 32 + (swz % 64) / 2; }

struct Unit { int pm, pn, aux; };

struct StaticOrder {
    int nM, nN, nwg, G, c;
    __device__ void init(int nM_, int nN_, int G_, int c_) { nM = nM_; nN = nN_; nwg = nM * nN; G = G_; c = c_; }
    __device__ bool next(int i, Unit& u) const {
        const long L = (long)i * G + c; if (L >= nwg) return false;
        int wgid = (int)L; { const int q = nwg / NXCD, r = nwg % NXCD, xcd = wgid % NXCD, off = wgid / NXCD; wgid = (xcd < r ? xcd * (q + 1) : r * (q + 1) + (xcd - r) * q) + off; }
        const int nig = WGM * nN, gid = wgid / nig, fm = gid * WGM, gsz = (nM - fm) < WGM ? (nM - fm) : WGM;
        u.pm = fm + ((wgid % nig) % gsz); u.pn = (wgid % nig) / gsz; u.aux = 0; return true;
    }
};

template <bool I8> struct AccVec { typedef f32x4 type; };
template <> struct AccVec<true> { typedef i32x4 type; };
template <bool I8 = false, class Prob, class Sched, class Epi>
__device__ __forceinline__ void gemm_phase(LAS unsigned char* lds, const Prob& P, const Sched& S, const Epi& E) {
    const int tid = opq_v((int)threadIdx.x), wid = __builtin_amdgcn_readfirstlane(tid >> 6), lane = tid & 63, wr = wid >> 2, wc = wid & 3, fr = lane & 15, fq = lane >> 4;
    typedef typename AccVec<I8>::type accv_t;
    const int K = P.K, nt = K / (I8 ? 2 * BK : BK);
    unsigned voffA[2], voffB[2];
#pragma unroll
    for (int i = 0; i < 2; ++i) { int R, C; stage_rc(tid * 16 + i * 8192, R, C); voffA[i] = (unsigned)R * P.lda + (unsigned)C * 2u; voffB[i] = (unsigned)R * P.ldb + (unsigned)C * 2u; }
    const size_t kstep = (size_t)(BK * 2);
    const size_t hstepA = (size_t)HALF * P.lda, hstepB = (size_t)HALF * P.ldb;
    const unsigned ldsw = (unsigned)wid * 1024u;
    const int aoff = lds_byte(wr * 64 + fr, fq * 8), boff = lds_byte(wc * 32 + fr, fq * 8);
#define PG8_SA(b, h) (((b) * 2 + (h)) * HTB)
#define PG8_SB(b, h) ((4 + (b) * 2 + (h)) * HTB)
#define PG8_STAGE(bufoff, gbase, voff) do { _Pragma("unroll") for (int _i = 0; _i < 2; ++_i) \
        __builtin_amdgcn_global_load_lds((const unsigned*)((const char*)(gbase) + (voff)[_i]), (LAS unsigned*)(lds + (bufoff) + ldsw + _i * 8192), 16, 0, 0); } while (0)
#define PG8_LDA(dst, b, h) do { _Pragma("unroll") for (int m = 0; m < 4; ++m) _Pragma("unroll") for (int k = 0; k < 2; ++k) dst[m][k] = *(const LAS bf16x8*)(lds + PG8_SA(b, h) + aoff + m * 2048 + k * 1024); } while (0)
#define PG8_LDB(dst, b, h) do { _Pragma("unroll") for (int n = 0; n < 2; ++n) _Pragma("unroll") for (int k = 0; k < 2; ++k) dst[n][k] = *(const LAS bf16x8*)(lds + PG8_SB(b, h) + boff + n * 2048 + k * 1024); } while (0)
#define PG8_MMA(ai, bj, At, Bt) do { __builtin_amdgcn_s_setprio(1); _Pragma("unroll") for (int m = 0; m < 4; ++m) _Pragma("unroll") for (int n = 0; n < 2; ++n) _Pragma("unroll") for (int k = 0; k < 2; ++k) \
        { if constexpr (I8) acc[ai][bj][m][n] = __builtin_amdgcn_mfma_i32_16x16x64_i8(__builtin_bit_cast(i32x4, Bt[n][k]), __builtin_bit_cast(i32x4, At[m][k]), acc[ai][bj][m][n], 0, 0, 0); \
          else acc[ai][bj][m][n] = __builtin_amdgcn_mfma_f32_16x16x32_bf16(Bt[n][k], At[m][k], acc[ai][bj][m][n], 0, 0, 0); } __builtin_amdgcn_s_setprio(0); } while (0)
#define PG8_WAIT_V(n) asm volatile("s_waitcnt vmcnt(" #n ")" ::: "memory")
#define PG8_WAIT_L(n) asm volatile("s_waitcnt lgkmcnt(" #n ")" ::: "memory")
#define PG8_BAR __builtin_amdgcn_s_barrier()
#define PG8_SCHED __builtin_amdgcn_sched_barrier(0)
    Unit cur, nxt; int ui = 0;
    if (!S.next(0, cur)) return;
    accv_t acc[2][2][4][2];
#pragma unroll
    for (int a = 0; a < 2; ++a)
#pragma unroll
        for (int b = 0; b < 2; ++b)
#pragma unroll
            for (int m = 0; m < 4; ++m)
#pragma unroll
                for (int n = 0; n < 2; ++n) acc[a][b][m][n] = accv_t{};
    bf16x8 At[4][2], B0[2][2], B1[2][2];
    const char* cA = P.a_ptr(cur); const char* cB = P.b_ptr(cur);
    PG8_STAGE(PG8_SB(0, 0), cB, voffB); PG8_STAGE(PG8_SB(0, 1), cB + hstepB, voffB); PG8_STAGE(PG8_SA(0, 0), cA, voffA); PG8_STAGE(PG8_SA(0, 1), cA + hstepA, voffA);
    if (wr == 1) PG8_BAR;
    PG8_WAIT_V(2); PG8_BAR;
    PG8_STAGE(PG8_SB(1, 0), cB + kstep, voffB); PG8_STAGE(PG8_SA(1, 0), cA + kstep, voffA); PG8_STAGE(PG8_SB(1, 1), cB + hstepB + kstep, voffB);
    PG8_WAIT_V(6); PG8_BAR;
    for (;;) {
        const bool has_next = S.next(ui + 1, nxt);
        const char* nA = has_next ? P.a_ptr(nxt) : cA; const char* nB = has_next ? P.b_ptr(nxt) : cB;
        for (int t = 0; t < nt; t += 2) {
            const bool last = (t == nt - 2);
            const char* a1 = cA + (size_t)(t + 1) * kstep;
            const char* a2 = last ? nA : cA + (size_t)(t + 2) * kstep; const char* b2 = last ? nB : cB + (size_t)(t + 2) * kstep;
            const char* a3 = a2 + kstep; const char* b3 = b2 + kstep;
            PG8_LDB(B0, 0, 0); PG8_LDB(B1, 0, 1); PG8_SCHED; PG8_LDA(At, 0, 0); PG8_STAGE(PG8_SA(1, 1), a1 + hstepA, voffA);
            PG8_WAIT_V(8); PG8_WAIT_L(0); PG8_BAR; PG8_MMA(0, 0, At, B0); PG8_MMA(0, 1, At, B1); PG8_BAR; PG8_SCHED;
            PG8_LDA(At, 0, 1); PG8_STAGE(PG8_SB(0, 0), b2, voffB); PG8_STAGE(PG8_SB(0, 1), b2 + hstepB, voffB); PG8_STAGE(PG8_SA(0, 0), a2, voffA);
            PG8_WAIT_V(8); PG8_WAIT_L(0); PG8_BAR; PG8_MMA(1, 0, At, B0); PG8_MMA(1, 1, At, B1); PG8_BAR; PG8_SCHED;
            PG8_LDB(B0, 1, 0); PG8_LDB(B1, 1, 1); PG8_SCHED; PG8_LDA(At, 1, 0); PG8_STAGE(PG8_SA(0, 1), a2 + hstepA, voffA);
            PG8_WAIT_V(8); PG8_WAIT_L(0); PG8_BAR; PG8_MMA(0, 0, At, B0); PG8_MMA(0, 1, At, B1); PG8_BAR; PG8_SCHED;
            PG8_LDA(At, 1, 1); PG8_STAGE(PG8_SB(1, 0), b3, voffB); PG8_STAGE(PG8_SB(1, 1), b3 + hstepB, voffB); PG8_STAGE(PG8_SA(1, 0), a3, voffA);
            PG8_WAIT_V(8); PG8_WAIT_L(0); PG8_BAR; PG8_MMA(1, 0, At, B0); PG8_MMA(1, 1, At, B1); PG8_BAR; PG8_SCHED;
        }
        if (wr == 0) PG8_BAR;
        E(acc, cur, wr, wc, fr, fq);
        if (!has_next) break;
#pragma unroll
        for (int a = 0; a < 2; ++a)
#pragma unroll
            for (int b = 0; b < 2; ++b)
#pragma unroll
                for (int m = 0; m < 4; ++m)
#pragma unroll
                    for (int n = 0; n < 2; ++n) acc[a][b][m][n] = accv_t{};
        cur = nxt; cA = nA; cB = nB; ++ui;
        if (wr == 1) PG8_BAR;
    }
    PG8_WAIT_V(0);
    PG8_BAR;
#undef PG8_SA
#undef PG8_SB
#undef PG8_STAGE
#undef PG8_LDA
#undef PG8_LDB
#undef PG8_MMA
#undef PG8_WAIT_V
#undef PG8_WAIT_L
#undef PG8_BAR
#undef PG8_SCHED
}
}

struct Frame {
    LAS unsigned char* lds;
    volatile LAS unsigned* MISC;
    gu32* ctl;
    unsigned char* ws;
    int tid, lane, wave, vcu, G;
    const float* const* in; float* out;
};
enum { I_X = 0, I_MEM, I_POS, I_GMIX, I_WIN, I_GQ, I_WUQ, I_GKV, I_WUKV, I_SINK, I_WMKV, I_WBR, I_WOUT, I_GFFN, I_WGD, I_WUD, I_WDD, I_WR, I_WGE, I_WUE, I_WDE, I_GMEM, I_GFIN };

__device__ __forceinline__ int sem_plain(int g) { return (g & ~31) + 8 * ((g >> 2) & 3) + 4 * ((g >> 4) & 1) + (g & 3); }
__device__ __forceinline__ int sem_rot64(int g) { return (g & ~63) + 32 * ((g >> 4) & 1) + 16 * ((g >> 5) & 1) + 4 * ((g >> 2) & 3) + (g & 3); }
__device__ __forceinline__ int inproj_src(int n) {
    const int pn = n >> 8, c = n & 255;
    if (pn < 2) return pn * 256 + sem_rot64(c);
    if (pn == 2) return c < 128 ? 512 + sem_rot64(c) : 640 + sem_plain(c - 128);
    if (pn == 3) return 768 + sem_plain(c);
    if (pn == 4) return c < 128 ? 1024 + sem_plain(c) : (c < 160 ? 1152 + (c - 128) : -1);
    if (pn < 7) return 1184 + (pn - 5) * 256 + sem_plain(c);
    return 1696 + (pn - 7) * 256 + sem_plain(c);
}

struct MapInproj { const float* W; __device__ __forceinline__ float load(int k, int n) const { const int s = inproj_src(n); return s >= 0 ? W[(size_t)k * INW + s] : 0.f; }
    __device__ __forceinline__ f32x4 load4(int k, int n) const { const int s = inproj_src(n); return s >= 0 ? *(const f32x4*)(W + (size_t)k * INW + s) : (f32x4){0.f, 0.f, 0.f, 0.f}; } };
struct MapUp { const float *Wq, *Wkv, *gq, *gkv;
    __device__ __forceinline__ f32x4 load4(int k, int n) const {
        if (n < 768) { if (k >= 256) return (f32x4){0.f, 0.f, 0.f, 0.f}; const int gg = n >> 5; const int s = (gg % 3 == 2) ? n : sem_plain(n); return *(const f32x4*)(Wq + (size_t)k * 768 + s) * gq[k]; }
        if (k < 256) return (f32x4){0.f, 0.f, 0.f, 0.f}; const int s = sem_plain(n - 768); return *(const f32x4*)(Wkv + (size_t)(k - 256) * 1024 + s) * gkv[k - 256]; }
    __device__ __forceinline__ float load(int k, int n) const {
        if (n < 768) { if (k >= 256) return 0.f; const int gg = n >> 5; const int s = (gg % 3 == 2) ? n : sem_plain(n); return gq[k] * Wq[(size_t)k * 768 + s]; }
        if (k < 256) return 0.f; const int s = sem_plain(n - 768); return gkv[k - 256] * Wkv[(size_t)(k - 256) * 1024 + s]; } };
struct MapPlain { const float* W; int ldw; __device__ __forceinline__ float load(int k, int n) const { return W[(size_t)k * ldw + sem_plain(n)]; }
    __device__ __forceinline__ f32x4 load4(int k, int n) const { return *(const f32x4*)(W + (size_t)k * ldw + sem_plain(n)); } };
struct MapNat { const float* W; int ldw; __device__ __forceinline__ float load(int k, int n) const { return W[(size_t)k * ldw + n]; }
    __device__ __forceinline__ f32x4 load4(int k, int n) const { return *(const f32x4*)(W + (size_t)k * ldw + n); } };
struct MapMemkv { const float* W; __device__ __forceinline__ float load(int k, int n) const { const int l = n >> 10, c = n & 1023; return W[((size_t)l * DM + k) * 1024 + sem_plain(c)]; }
    __device__ __forceinline__ f32x4 load4(int k, int n) const { const int l = n >> 10, c = n & 1023; return *(const f32x4*)(W + ((size_t)l * DM + k) * 1024 + sem_plain(c)); } };
struct MapGU { const float *Wg, *Wu; __device__ __forceinline__ float load(int k, int n) const { const int pn = n >> 8, c = n & 255; const int ch = 128 * pn + sem_plain(c & 127);
    const unsigned long long a = (unsigned long long)Wg, b = (unsigned long long)Wu, w = a ^ ((a ^ b) & (0ull - (unsigned long long)(c >> 7))); return ((const float*)w)[(size_t)k * DFF + ch]; }
    __device__ __forceinline__ f32x4 load4(int k, int n) const { const int pn = n >> 8, c = n & 255; const int ch = 128 * pn + sem_plain(c & 127);
        const unsigned long long a = (unsigned long long)Wg, b = (unsigned long long)Wu, w = a ^ ((a ^ b) & (0ull - (unsigned long long)(c >> 7))); return *(const f32x4*)((const float*)w + (size_t)k * DFF + ch); } };

template <class M> __device__ __forceinline__ void prep_item(const M& m, bf16_t* dst, int Kd, int nblk, LAS float* scr, int item, int lane) {
    const int kb = item / nblk, nb = item % nblk, k0 = 64 * kb, n0 = 32 * nb;
#pragma unroll 8
    for (int i = 0; i < 32; ++i) { const int kk = 2 * i + (lane >> 5); scr[kk * 33 + (lane & 31)] = m.load(k0 + kk, n0 + (lane & 31)); }
    LDS_WAIT(); asm volatile("" ::: "memory");
    const int c = lane & 7;
#pragma unroll
    for (int j = 0; j < 4; ++j) { const int n = (lane >> 3) + 8 * j; const LAS float* s = scr + (8 * c) * 33 + n;
        u32x4 o; o.x = pk2(s[0 * 33], s[1 * 33]); o.y = pk2(s[2 * 33], s[3 * 33]); o.z = pk2(s[4 * 33], s[5 * 33]); o.w = pk2(s[6 * 33], s[7 * 33]);
        *(u32x4*)(dst + (size_t)(n0 + n) * Kd + k0 + 8 * c) = o; }
    LDS_WAIT(); asm volatile("" ::: "memory");
}
template <class M> __device__ __forceinline__ void prep_tile(const M& m, bf16_t* dst, int Kd, int nblk, LAS unsigned char* tile, int item, int lane) {
    const int kb = item / nblk, nb = item % nblk, k0 = 128 * kb, n0 = 32 * nb, ng = lane & 7, kr = lane >> 3;
    f32x4 v[16];
#pragma unroll
    for (int i = 0; i < 16; ++i) v[i] = m.load4(k0 + 8 * i + kr, n0 + 4 * ng);
#pragma unroll
    for (int i = 0; i < 16; ++i)
#pragma unroll
        for (int c = 0; c < 4; ++c) *(LAS unsigned short*)(tile + (4 * ng + c) * 272 + (8 * i + kr) * 2) = (unsigned short)f2bf(v[i][c]);
    LDS_WAIT(); asm volatile("" ::: "memory");
#pragma unroll
    for (int j = 0; j < 8; ++j) { const int p = lane + 64 * j, n = p >> 4, kc = p & 15;
        *(u32x4*)(dst + (size_t)(n0 + n) * Kd + k0 + 8 * kc) = *(const LAS u32x4*)(tile + n * 272 + 16 * kc); }
    LDS_WAIT(); asm volatile("" ::: "memory");
}
template <class M> __device__ __forceinline__ void prep_matrix(Frame& F, const M& m, bf16_t* dst, int N, int K) {
    LAS unsigned char* tile = F.lds + F.wave * 16384;
    const int gw = F.vcu * NWAVES + F.wave, NGW = F.G * NWAVES, nblk = N / 32, nitems = (K / 128) * nblk;
    for (int it = gw; it < nitems; it += NGW) prep_tile(m, dst, K, nblk, tile, it, F.lane);
}

template <class M> __device__ __forceinline__ void prep_strip_i8(Frame& F, const M& m, signed char* dst, float* scl, int strip) {
    const int lane = F.lane, w = F.wave, n0 = strip * 32, k0 = w * 128, ng = lane & 7, kr = lane >> 3;
    LAS unsigned char* tile = F.lds + w * 16384;
    LAS float* amt = (LAS float*)(F.lds + LDSCTL_OFF + 2048);
    f32x4 v[16];
#pragma unroll
    for (int i = 0; i < 16; ++i) v[i] = m.load4(k0 + 8 * i + kr, n0 + 4 * ng);
    f32x4 am = __builtin_elementwise_abs(v[0]);
#pragma unroll
    for (int i = 1; i < 16; ++i) am = __builtin_elementwise_max(am, __builtin_elementwise_abs(v[i]));
#pragma unroll
    for (int c = 0; c < 4; ++c) { float a = am[c]; a = fmaxf(a, __shfl_xor(a, 8)); a = fmaxf(a, __shfl_xor(a, 16)); a = fmaxf(a, __shfl_xor(a, 32)); am[c] = a; }
    if (kr == 0) *(LAS f32x4*)(amt + w * 32 + 4 * ng) = am;
    __syncthreads();
    f32x4 cm = *(const LAS f32x4*)(amt + 4 * ng);
#pragma unroll
    for (int ww = 1; ww < 8; ++ww) cm = __builtin_elementwise_max(cm, *(const LAS f32x4*)(amt + ww * 32 + 4 * ng));
    f32x4 inv;
#pragma unroll
    for (int c = 0; c < 4; ++c) inv[c] = cm[c] > 0.f ? 127.0f / cm[c] : 0.f;
    if (w == 0 && kr == 0) *(f32x4*)(scl + n0 + 4 * ng) = cm * (1.0f / 127.0f);
#pragma unroll
    for (int i = 0; i < 16; ++i)
#pragma unroll
        for (int c = 0; c < 4; ++c) tile[(4 * ng + c) * 144 + 8 * i + kr] = (unsigned char)(signed char)__float2int_rn(v[i][c] * inv[c]);
    LDS_WAIT(); asm volatile("" ::: "memory");
#pragma unroll
    for (int j = 0; j < 4; ++j) { const int p = lane + 64 * j, n = p >> 3, kc = p & 7;
        *(u32x4*)(dst + (size_t)(n0 + n) * DM + k0 + 16 * kc) = *(const LAS u32x4*)(tile + n * 144 + 16 * kc); }
    LDS_WAIT();
    __syncthreads();
}
__device__ __forceinline__ bf16_t* wmix(Frame& F, int l, size_t off) { return (bf16_t*)(F.ws + WS_WMIX + (size_t)l * WL_STRIDE + off); }

__device__ __forceinline__ void prep_mixer_weights(Frame& F) {
    for (int l = 0; l < DEPTH; ++l) {
        { MapInproj m{F.in[I_WIN] + (size_t)l * DM * INW}; for (int s = F.vcu; s < NT_IN * 8; s += F.G) prep_strip_i8(F, m, (signed char*)wmix(F, l, WL_IN), (float*)(F.ws + WS_MISC + MS_WSIN) + l * NT_IN * 256, s); }
        { MapUp m{F.in[I_WUQ] + (size_t)l * 256 * 768, F.in[I_WUKV] + (size_t)l * 128 * 1024, F.in[I_GQ] + l * 256, F.in[I_GKV] + l * 128}; prep_matrix(F, m, wmix(F, l, WL_UP), UPN, UPK); }
        for (int i = 0; i < 3; ++i) { MapPlain m{F.in[I_WBR] + ((size_t)l * 3 + i) * 512 * DM, DM}; prep_matrix(F, m, wmix(F, l, WL_BR) + (size_t)i * DM * 512, DM, 512); }
        { MapNat m{F.in[I_WOUT] + (size_t)l * DM * DM, DM}; prep_matrix(F, m, wmix(F, l, WL_OUT), DM, DM); }
    }
    { MapMemkv m{F.in[I_WMKV]}; prep_matrix(F, m, (bf16_t*)(F.ws + WS_WMKV), 4096, DM); }
}
__device__ __forceinline__ void prep_ffn_weights(Frame& F, int l) {
    const int i = l >> 1; const bool moe = (l & 1) != 0;
    LAS float* scr = (LAS float*)(F.lds + F.wave * 16384);
    const int gw = F.vcu * NWAVES + F.wave, NGW = F.G * NWAVES;
    constexpr int IGU = (DM / 64) * (2 * DFF / 32), ID = (DFF / 64) * (DM / 32), NSTRIP = 2 * DFF / 32;
    const int ne = moe ? NE : 1;
    const float* Wg = moe ? F.in[I_WGE] : F.in[I_WGD]; const float* Wu = moe ? F.in[I_WUE] : F.in[I_WUD]; const float* Wd = moe ? F.in[I_WDE] : F.in[I_WDD];
    if (GU_I8(l)) {
        for (int s = F.vcu; s < ne * NSTRIP; s += F.G) { const int e = s / NSTRIP, ss = s % NSTRIP; const size_t eo = ((size_t)i * ne + e) * DM * DFF;
            MapGU m{Wg + eo, Wu + eo}; prep_strip_i8(F, m, (signed char*)(F.ws + WS_WFFN + (size_t)e * WF_STRIDE), (float*)(F.ws + WS_MISC + MS_WSGU) + e * 2 * DFF, ss); }
    } else {
        for (int it = gw; it < ne * IGU; it += NGW) { const int e = it / IGU, r = it % IGU; const size_t eo = ((size_t)i * ne + e) * DM * DFF;
            MapGU m{Wg + eo, Wu + eo}; prep_item(m, (bf16_t*)(F.ws + WS_WFFN + (size_t)e * WF_STRIDE), DM, 2 * DFF / 32, scr, r, F.lane); }
    }
    constexpr int IDT = (DFF / 128) * (DM / 32);
    for (int it = gw; it < ne * IDT; it += NGW) { const int e = it / IDT, r = it % IDT; const size_t eo = ((size_t)i * ne + e) * DM * DFF;
        MapNat m{Wd + eo, DM}; prep_tile(m, (bf16_t*)(F.ws + WS_WFFN + (size_t)e * WF_STRIDE + WF_D), DFF, DM / 32, F.lds + F.wave * 16384, r, F.lane); }
}

struct RowV { f32x4 v[4]; };
__device__ __forceinline__ void row_load(RowV& r, const float* p, int lane) { const f32x4* x = (const f32x4*)p + lane;
#pragma unroll
    for (int j = 0; j < 4; ++j) r.v[j] = x[64 * j]; }
__device__ __forceinline__ void row_store(const RowV& r, float* p, int lane) { f32x4* x = (f32x4*)p + lane;
#pragma unroll
    for (int j = 0; j < 4; ++j) x[64 * j] = r.v[j]; }
__device__ __forceinline__ void row_add_bf16(RowV& r, const bf16_t* p, float w, int lane) { const u32x2* x = (const u32x2*)p + lane;
#pragma unroll
    for (int j = 0; j < 4; ++j) { const u32x2 q = x[64 * j]; r.v[j].x += w * bflo(q.x); r.v[j].y += w * bfhi(q.x); r.v[j].z += w * bflo(q.y); r.v[j].w += w * bfhi(q.y); } }
__device__ __forceinline__ float row_rstd(const RowV& r) { float s = 0.f;
#pragma unroll
    for (int j = 0; j < 4; ++j) s += (r.v[j].x * r.v[j].x + r.v[j].y * r.v[j].y) + (r.v[j].z * r.v[j].z + r.v[j].w * r.v[j].w);
    return 1.0f / sqrtf(wave_sum(s) * (1.0f / DM) + EPS); }
__device__ __forceinline__ void row_scale(RowV& r, float rstd, const float* g, int lane) { const f32x4* gg = (const f32x4*)g + lane;
#pragma unroll
    for (int j = 0; j < 4; ++j) r.v[j] = r.v[j] * rstd * gg[64 * j]; }
__device__ __forceinline__ void row_store_bf16(const RowV& r, bf16_t* p, int lane) { u32x2* o = (u32x2*)p + lane;
#pragma unroll
    for (int j = 0; j < 4; ++j) { u32x2 w; w.x = pk2(r.v[j].x, r.v[j].y); w.y = pk2(r.v[j].z, r.v[j].w); o[64 * j] = w; } }

__device__ __forceinline__ float row_store_i8(const RowV& r, signed char* p, int lane) {
    float am = 0.f;
#pragma unroll
    for (int j = 0; j < 4; ++j) am = fmaxf(am, fmaxf(fmaxf(fabsf(r.v[j].x), fabsf(r.v[j].y)), fmaxf(fabsf(r.v[j].z), fabsf(r.v[j].w))));
#pragma unroll
    for (int o = 1; o < 64; o <<= 1) am = fmaxf(am, __shfl_xor(am, o));
    const float inv = am > 0.f ? 127.0f / am : 0.f; unsigned* o4 = (unsigned*)p + lane;
#pragma unroll
    for (int j = 0; j < 4; ++j) { const unsigned a = (unsigned)__float2int_rn(r.v[j].x * inv) & 255u, b = (unsigned)__float2int_rn(r.v[j].y * inv) & 255u, c = (unsigned)__float2int_rn(r.v[j].z * inv) & 255u, d = (unsigned)__float2int_rn(r.v[j].w * inv) & 255u;
        o4[64 * j] = a | (b << 8) | (c << 16) | (d << 24); }
    return am * (1.0f / 127.0f);
}
__device__ __forceinline__ void row_combine(Frame& F, RowV& r, int t) {
    const int* sl = (const int*)(F.ws + WS_MISC + MS_SLOT) + 2 * t; const float* tw = (const float*)(F.ws + WS_MISC + MS_TOKW) + 2 * t;
    const bf16_t* Y = (const bf16_t*)(F.ws + WS_R + R_YOUT);
    const int s0 = sl[0], s1 = sl[1]; const float w0 = tw[0], w1 = tw[1];
    row_add_bf16(r, Y + (size_t)s0 * DM, w0, F.lane); row_add_bf16(r, Y + (size_t)s1 * DM, w1, F.lane);
}

__device__ __forceinline__ void norm_phase(Frame& F, const float* src, float* X, const float* g, bool combine, bool out_i8) {
    bf16_t* H = (bf16_t*)(F.ws + WS_H); signed char* Hq = (signed char*)(F.ws + WS_H); float* hsc = (float*)(F.ws + WS_MISC + MS_HSC);
    const int gw = F.vcu * NWAVES + F.wave, NGW = F.G * NWAVES;
    for (int t = gw; t < T; t += NGW) {
        RowV r; row_load(r, src + (size_t)t * DM, F.lane);
        if (combine) { row_combine(F, r, t); row_store(r, X + (size_t)t * DM, F.lane); }
        const float rstd = row_rstd(r); row_scale(r, rstd, g, F.lane);
        if (out_i8) { const float sc = row_store_i8(r, Hq + (size_t)t * DM, F.lane); if (F.lane == 0) hsc[t] = sc; }
        else row_store_bf16(r, H + (size_t)t * DM, F.lane);
    }
}
__device__ __forceinline__ void final_norm_phase(Frame& F, float* X, const float* g, bool combine) {
    const int gw = F.vcu * NWAVES + F.wave, NGW = F.G * NWAVES;
    for (int t = gw; t < T; t += NGW) {
        RowV r; row_load(r, X + (size_t)t * DM, F.lane);
        if (combine) row_combine(F, r, t);
        const float rstd = row_rstd(r); row_scale(r, rstd, g, F.lane);
        row_store(r, X + (size_t)t * DM, F.lane);
    }
}
__device__ __forceinline__ void memnorm_phase(Frame& F) {
    bf16_t* MN = (bf16_t*)(F.ws + WS_MEMN);
    const int gw = F.vcu * NWAVES + F.wave, NGW = F.G * NWAVES;
    for (int t = gw; t < NB * MEML; t += NGW) {
        RowV r; row_load(r, F.in[I_MEM] + (size_t)t * DM, F.lane);
        const float rstd = row_rstd(r); row_scale(r, rstd, F.in[I_GMEM], F.lane);
        row_store_bf16(r, MN + (size_t)t * DM, F.lane);
    }
}

__device__ __forceinline__ void norm_router_phase(Frame& F, const float* X, const float* g, const float* Wr  , bool out_i8) {
    bf16_t* H = (bf16_t*)(F.ws + WS_H); signed char* Hq = (signed char*)(F.ws + WS_H); float* hsc = (float*)(F.ws + WS_MISC + MS_HSC);
    int* toke = (int*)(F.ws + WS_MISC + MS_TOKE); float* tokw = (float*)(F.ws + WS_MISC + MS_TOKW); int* cntg = (int*)(F.ws + WS_MISC + MS_CNT);
    volatile LAS int* hist = (volatile LAS int*)(F.lds + LDSCTL_OFF + 1024);
    for (int c = F.vcu; c < T / 128; c += F.G) {
        if (F.tid < 8) hist[F.tid] = 0;
        __syncthreads();
        for (int q = 0; q < 16; ++q) {
            const int t = c * 128 + F.wave * 16 + q;
            RowV r; row_load(r, X + (size_t)t * DM, F.lane);
            const float rstd = row_rstd(r); row_scale(r, rstd, g, F.lane);
            if (out_i8) { const float sc = row_store_i8(r, Hq + (size_t)t * DM, F.lane); if (F.lane == 0) hsc[t] = sc; }
            else row_store_bf16(r, H + (size_t)t * DM, F.lane);
            float lg[8];
#pragma unroll
            for (int e = 0; e < 8; ++e) lg[e] = 0.f;
#pragma unroll
            for (int j = 0; j < 4; ++j) {
#pragma unroll
                for (int k = 0; k < 4; ++k) { const int d = 256 * j + 4 * F.lane + k; const f32x4 wa = *(const f32x4*)(Wr + (size_t)d * 8), wb = *(const f32x4*)(Wr + (size_t)d * 8 + 4); const float x = r.v[j][k];
                    lg[0] += x * wa.x; lg[1] += x * wa.y; lg[2] += x * wa.z; lg[3] += x * wa.w; lg[4] += x * wb.x; lg[5] += x * wb.y; lg[6] += x * wb.z; lg[7] += x * wb.w; } }
#pragma unroll
            for (int e = 0; e < 8; ++e) lg[e] = wave_sum(lg[e]);
            int e0 = 0; float v0 = lg[0];
#pragma unroll
            for (int e = 1; e < 8; ++e) if (lg[e] > v0) { v0 = lg[e]; e0 = e; }
            int e1 = -1; float v1 = -INFINITY;
#pragma unroll
            for (int e = 0; e < 8; ++e) if (e != e0 && lg[e] > v1) { v1 = lg[e]; e1 = e; }
            if (F.lane == 0) {
                const float w0 = 1.0f / (1.0f + __expf(v1 - v0));
                toke[2 * t] = e0; toke[2 * t + 1] = e1; tokw[2 * t] = w0; tokw[2 * t + 1] = 1.0f - w0;
                __hip_atomic_fetch_add((LAS int*)&hist[e0], 1, __ATOMIC_RELAXED, __HIP_MEMORY_SCOPE_WORKGROUP); __hip_atomic_fetch_add((LAS int*)&hist[e1], 1, __ATOMIC_RELAXED, __HIP_MEMORY_SCOPE_WORKGROUP);
            }
        }
        __syncthreads();
        if (F.tid < 8) cntg[c * 8 + F.tid] = hist[F.tid];
        __syncthreads();
    }
}
__device__ __forceinline__ void moe_assign_phase(Frame& F, bool i8) {
    const bf16_t* H = (const bf16_t*)(F.ws + WS_H); bf16_t* AS = (bf16_t*)(F.ws + WS_R + R_ASORT);
    const float* hsc = (const float*)(F.ws + WS_MISC + MS_HSC); float* asc = (float*)(F.ws + WS_MISC + MS_ASC);
    const int* toke = (const int*)(F.ws + WS_MISC + MS_TOKE); int* slot = (int*)(F.ws + WS_MISC + MS_SLOT); const int* cntg = (const int*)(F.ws + WS_MISC + MS_CNT);
    int* texp = (int*)(F.ws + WS_MISC + MS_TEXP);
    volatile LAS int* tot = (volatile LAS int*)(F.lds + LDSCTL_OFF + 1024);
    volatile LAS int* pre = tot + 8;
    volatile LAS int* wcnt = tot + 16;
    for (int c = F.vcu; c < T / 128; c += F.G) {
        if (F.tid < 16) tot[F.tid] = 0;
        __syncthreads();
        { const int cc = F.tid >> 1, h = F.tid & 1; const i32x4 v = *(const i32x4*)(cntg + cc * 8 + 4 * h);
#pragma unroll
          for (int k = 0; k < 4; ++k) { __hip_atomic_fetch_add((LAS int*)&tot[4 * h + k], v[k], __ATOMIC_RELAXED, __HIP_MEMORY_SCOPE_WORKGROUP); if (cc < c) __hip_atomic_fetch_add((LAS int*)&pre[4 * h + k], v[k], __ATOMIC_RELAXED, __HIP_MEMORY_SCOPE_WORKGROUP); } }
        const int t = c * 128 + F.wave * 16 + ((F.lane & 31) >> 1);
        const int my_e = (F.lane < 32) ? toke[2 * t + (F.lane & 1)] : -1;
        int rank = 0;
#pragma unroll
        for (int e = 0; e < 8; ++e) { const unsigned long long m = __ballot(my_e == e); if (my_e == e) rank = __popcll(m & ((1ull << F.lane) - 1ull)); if (F.lane == 0) wcnt[F.wave * 8 + e] = __popcll(m); }
        __syncthreads();
        int myslot = 0;
        if (F.lane < 32) {
            int ts = 0;
#pragma unroll
            for (int e = 0; e < 8; ++e) ts += (e < my_e) ? ((tot[e] + 255) >> 8) : 0;
            int wp = 0; for (int w = 0; w < F.wave; ++w) wp += wcnt[w * 8 + my_e];
            myslot = ts * 256 + pre[my_e] + wp + rank;
            slot[2 * t + (F.lane & 1)] = myslot;
        }
        if (c == 0 && F.tid == 0) { int ts = 0; for (int e = 0; e < 8; ++e) { const int n = (tot[e] + 255) >> 8; for (int k = 0; k < n; ++k) texp[ts + k] = e; ts += n; } for (int k = ts; k < MAXRT; ++k) texp[k] = 0; texp[MAXRT] = ts; }
        for (int a = 0; a < 32; ++a) {
            const int s = __builtin_amdgcn_readlane(myslot, a); const int ta = c * 128 + F.wave * 16 + (a >> 1);
            if (i8) { const u32x4* srcp = (const u32x4*)((const signed char*)H + (size_t)ta * DM) + F.lane; u32x4* dstp = (u32x4*)((signed char*)AS + (size_t)s * DM) + F.lane; dstp[0] = srcp[0]; if (F.lane == 0) asc[s] = hsc[ta]; }
            else { const u32x4* srcp = (const u32x4*)(H + (size_t)ta * DM) + F.lane; u32x4* dstp = (u32x4*)(AS + (size_t)s * DM) + F.lane;
                const u32x4 x0 = srcp[0], x1 = srcp[64]; dstp[0] = x0; dstp[64] = x1; }
        }
        __syncthreads();
    }
}

using pg8::Unit;
typedef f32x4 AccT[2][2][4][2];

struct ProbSimple { int K; unsigned lda, ldb; const char* A; const char* B;
    __device__ __forceinline__ const char* a_ptr(const Unit& u) const { return A + (size_t)u.pm * 256 * lda; }
    __device__ __forceinline__ const char* b_ptr(const Unit& u) const { return B + (size_t)u.pn * 256 * ldb; } };
struct ProbBranch { int K; unsigned lda, ldb; const char* A; const char* B;
    __device__ __forceinline__ const char* a_ptr(const Unit& u) const { return A + (size_t)u.pm * 256 * lda + (size_t)u.aux * 1024; }
    __device__ __forceinline__ const char* b_ptr(const Unit& u) const { return B + (size_t)u.aux * ((size_t)DM * 512 * 2) + (size_t)u.pn * 256 * ldb; } };
struct ProbMoe { int K; unsigned lda, ldb; const char* A; const char* B; int a_lo;
    __device__ __forceinline__ const char* a_ptr(const Unit& u) const { return A + (size_t)(u.pm - a_lo) * 256 * lda; }
    __device__ __forceinline__ const char* b_ptr(const Unit& u) const { return B + (size_t)u.aux * WF_STRIDE + (size_t)u.pn * 256 * ldb; } };

struct SegOrder { pg8::StaticOrder base;
    __device__ bool next(int i, Unit& u) const { if (!base.next(i / 3, u)) return false; u.aux = i % 3; return true; } };
struct MoeOrder { pg8::StaticOrder base; int lo; const int* texp;
    __device__ bool next(int i, Unit& u) const { if (!base.next(i, u)) return false; u.pm += lo; u.aux = texp[u.pm]; return true; } };

__device__ __forceinline__ u32x4 pack8(const f32x4 a, const f32x4 b) { u32x4 w; w.x = cvtpk(a[0], a[1]); w.y = cvtpk(a[2], a[3]); w.z = cvtpk(b[0], b[1]); w.w = cvtpk(b[2], b[3]); return w; }
__device__ __forceinline__ u32x2 pack4(const f32x4 a) { u32x2 w; w.x = cvtpk(a[0], a[1]); w.y = cvtpk(a[2], a[3]); return w; }

__device__ __forceinline__ f32x4 deq(const f32x4& a, float, const f32x4&) { return a; }
__device__ __forceinline__ f32x4 deq(const i32x4& a, float rs, const f32x4& cs) { return __builtin_convertvector(a, f32x4) * rs * cs; }
struct EpiInproj {
    bf16_t* P; bf16_t* G; float* ssq; const int* pos; const float* rsc; const float* csc;
    template <class AV> __device__ __forceinline__ void operator()(const AV (&acc)[2][2][4][2], const Unit& u, int wr, int wc, int fr, int fq) const {
        const int pn = u.pn, row0 = u.pm * 256 + wr * 64 + fr;
        f32x4 cs[2][2];
#pragma unroll
        for (int bj = 0; bj < 2; ++bj)
#pragma unroll
            for (int n = 0; n < 2; ++n) cs[bj][n] = *(const f32x4*)(csc + pn * 256 + bj * 128 + wc * 32 + n * 16 + fq * 4);
        float rs8[2][4], pf8[2][4];
#pragma unroll
        for (int ai = 0; ai < 2; ++ai)
#pragma unroll
            for (int m = 0; m < 4; ++m) { rs8[ai][m] = rsc[row0 + ai * 128 + m * 16]; pf8[ai][m] = (pn <= 4) ? (float)pos[row0 + ai * 128 + m * 16] : 0.f; }
#define DQ(ai, bj, m, n) deq(acc[ai][bj][m][n], rs, cs[bj][n])
        if (pn >= 7) {
#pragma unroll
            for (int ai = 0; ai < 2; ++ai)
#pragma unroll
                for (int m = 0; m < 4; ++m) { const int row = row0 + ai * 128 + m * 16; const float rs = rs8[ai][m];
#pragma unroll
                    for (int bj = 0; bj < 2; ++bj) { f32x4 a = DQ(ai, bj, m, 0), b = DQ(ai, bj, m, 1);
#pragma unroll
                        for (int j = 0; j < 4; ++j) { a[j] = fast_sigmoid(a[j]); b[j] = fast_sigmoid(b[j]); }
                        *(u32x4*)(G + (size_t)row * GW + (pn - 7) * 256 + bj * 128 + wc * 32 + fq * 8) = pack8(a, b); } }
        } else if (pn >= 5 || pn == 3) {
            const float sc = (pn == 3) ? 1.0f : C_M;
#pragma unroll
            for (int ai = 0; ai < 2; ++ai)
#pragma unroll
                for (int m = 0; m < 4; ++m) { const int row = row0 + ai * 128 + m * 16; const float rs = rs8[ai][m]; float s = 0.f;
#pragma unroll
                    for (int bj = 0; bj < 2; ++bj) { const f32x4 a = DQ(ai, bj, m, 0) * sc, b = DQ(ai, bj, m, 1) * sc;
                        s += (a[0] * a[0] + a[1] * a[1]) + (a[2] * a[2] + a[3] * a[3]) + (b[0] * b[0] + b[1] * b[1]) + (b[2] * b[2] + b[3] * b[3]);
                        *(u32x4*)(P + (size_t)row * PW + pn * 256 + bj * 128 + wc * 32 + fq * 8) = pack8(a, b); }
                    if (pn == 3) { s += __shfl_xor(s, 16); s += __shfl_xor(s, 32); if (fq == 0) ssq[(size_t)row * 8 + wc] = s; } }
        } else if (pn == 4) {
#pragma unroll
            for (int ai = 0; ai < 2; ++ai)
#pragma unroll
                for (int m = 0; m < 4; ++m) { const int row = row0 + ai * 128 + m * 16; const float rs = rs8[ai][m];
                    { const f32x4 a = DQ(ai, 0, m, 0), b = DQ(ai, 0, m, 1);
                      float s = (a[0] * a[0] + a[1] * a[1]) + (a[2] * a[2] + a[3] * a[3]) + (b[0] * b[0] + b[1] * b[1]) + (b[2] * b[2] + b[3] * b[3]);
                      *(u32x4*)(P + (size_t)row * PW + P_CKV + wc * 32 + fq * 8) = pack8(a, b);
                      s += __shfl_xor(s, 16); s += __shfl_xor(s, 32); if (fq == 0) ssq[(size_t)row * 8 + 4 + wc] = s; }
                    if (wc == 0) { const f32x4 x1 = DQ(ai, 1, m, 0), x2 = DQ(ai, 1, m, 1); const float pf = pf8[ai][m]; f32x4 o1, o2;
#pragma unroll
                        for (int j = 0; j < 4; ++j) { float c, s; rot_cs(pf, 2 * (4 * fq + j), c, s); o1[j] = x1[j] * c - x2[j] * s; o2[j] = x2[j] * c + x1[j] * s; }
                        *(u32x2*)(P + (size_t)row * PW + P_KR + 4 * fq) = pack4(o1); *(u32x2*)(P + (size_t)row * PW + P_KR + 16 + 4 * fq) = pack4(o2); } }
        } else {
            const float sc = (pn < 2) ? C_A : 1.0f; const int i0 = 16 * (wc & 1) + 4 * fq;
#pragma unroll
            for (int ai = 0; ai < 2; ++ai)
#pragma unroll
                for (int m = 0; m < 4; ++m) { const int row = row0 + ai * 128 + m * 16; const float rs = rs8[ai][m]; const float pf = pf8[ai][m]; f32x4 c, s;
#pragma unroll
                    for (int j = 0; j < 4; ++j) { float cc, ss; rot_cs(pf, i0 + j, cc, ss); c[j] = cc * sc; s[j] = ss * sc; }
#pragma unroll
                    for (int bj = 0; bj < 2; ++bj) { const f32x4 x1 = DQ(ai, bj, m, 0), x2 = DQ(ai, bj, m, 1);
                        if (pn == 2 && bj == 1) { *(u32x4*)(P + (size_t)row * PW + P_VA + wc * 32 + fq * 8) = pack8(x1, x2); }
                        else { const f32x4 o1 = x1 * c - x2 * s, o2 = x2 * c + x1 * s; bf16_t* d = P + (size_t)row * PW + pn * 256 + 64 * (2 * bj + (wc >> 1)) + i0;
                            *(u32x2*)d = pack4(o1); *(u32x2*)(d + 32) = pack4(o2); } } }
        }
#undef DQ
    }
};
struct EpiUp {
    bf16_t* QB; bf16_t* KVB; const float* ssq; const int* pos;
    __device__ __forceinline__ void operator()(const AccT& acc, const Unit& u, int wr, int wc, int fr, int fq) const {
        const int pn = u.pn, row0 = u.pm * 256 + wr * 64 + fr;
        float rs8[2][4], pf8[2][4];
#pragma unroll
        for (int ai = 0; ai < 2; ++ai)
#pragma unroll
            for (int m = 0; m < 4; ++m) { const int row = row0 + ai * 128 + m * 16; const f32x4 sv = *(const f32x4*)(ssq + (size_t)row * 8 + (pn < 3 ? 0 : 4));
                rs8[ai][m] = (pn < 3 ? C_B : 1.0f) / sqrtf(((sv[0] + sv[1]) + (sv[2] + sv[3])) * (pn < 3 ? 1.0f / 256.0f : 1.0f / 128.0f) + EPS); pf8[ai][m] = (pn < 3) ? (float)pos[row] : 0.f; }
#pragma unroll
        for (int ai = 0; ai < 2; ++ai)
#pragma unroll
            for (int m = 0; m < 4; ++m) { const int row = row0 + ai * 128 + m * 16; const float rs = rs8[ai][m];
                if (pn < 3) {
#pragma unroll
                    for (int bj = 0; bj < 2; ++bj) { const int gg = 8 * pn + 4 * bj + wc; const f32x4 x1 = acc[ai][bj][m][0] * rs, x2 = acc[ai][bj][m][1] * rs;
                        if (gg % 3 == 2) { const float pf = pf8[ai][m]; f32x4 o1, o2;
#pragma unroll
                            for (int j = 0; j < 4; ++j) { float c, s; rot_cs(pf, 2 * (4 * fq + j), c, s); o1[j] = x1[j] * c - x2[j] * s; o2[j] = x2[j] * c + x1[j] * s; }
                            bf16_t* d = QB + (size_t)row * QBW + 32 * gg + 4 * fq; *(u32x2*)d = pack4(o1); *(u32x2*)(d + 16) = pack4(o2); }
                        else *(u32x4*)(QB + (size_t)row * QBW + 32 * gg + 8 * fq) = pack8(x1, x2); }
                } else {
#pragma unroll
                    for (int bj = 0; bj < 2; ++bj) *(u32x4*)(KVB + (size_t)row * KVW + (pn - 3) * 256 + bj * 128 + wc * 32 + fq * 8) = pack8(acc[ai][bj][m][0] * rs, acc[ai][bj][m][1] * rs);
                } }
    }
};
struct EpiPlain {
    bf16_t* O; int ldo;
    __device__ __forceinline__ void operator()(const AccT& acc, const Unit& u, int wr, int wc, int fr, int fq) const {
        const int row0 = u.pm * 256 + wr * 64 + fr;
#pragma unroll
        for (int ai = 0; ai < 2; ++ai)
#pragma unroll
            for (int m = 0; m < 4; ++m)
#pragma unroll
                for (int bj = 0; bj < 2; ++bj) *(u32x4*)(O + (size_t)(row0 + ai * 128 + m * 16) * ldo + u.pn * 256 + bj * 128 + wc * 32 + fq * 8) = pack8(acc[ai][bj][m][0], acc[ai][bj][m][1]);
    }
};
struct EpiBranch {
    const bf16_t* G; float* scr; bf16_t* MIXED;
    __device__ __forceinline__ void operator()(const AccT& acc, const Unit& u, int wr, int wc, int fr, int fq) const {
        const int seg = u.aux, row0 = u.pm * 256 + wr * 64 + fr; unsigned long long spb = (unsigned long long)((f32x4*)scr + threadIdx.x); asm volatile("" : "+v"(spb)); f32x4* sp = (f32x4*)spb;
#pragma unroll
        for (int ai = 0; ai < 2; ++ai)
#pragma unroll
            for (int mp = 0; mp < 2; ++mp) {
                u32x4 gw[2][2]; f32x4 pa[2][2], pb[2][2];
#pragma unroll
                for (int mm = 0; mm < 2; ++mm)
#pragma unroll
                    for (int bj = 0; bj < 2; ++bj) { const int m = 2 * mp + mm, row = row0 + ai * 128 + m * 16, col = u.pn * 256 + bj * 128 + wc * 32 + fq * 8, si = ((ai * 4 + m) * 2 + bj) * 2;
                        gw[mm][bj] = *(const u32x4*)(G + (size_t)row * GW + seg * 1024 + col);
                        if (seg > 0) { pa[mm][bj] = sp[(size_t)si * 512]; pb[mm][bj] = sp[(size_t)(si + 1) * 512]; } else { pa[mm][bj] = (f32x4){0.f, 0.f, 0.f, 0.f}; pb[mm][bj] = (f32x4){0.f, 0.f, 0.f, 0.f}; } }
#pragma unroll
                for (int mm = 0; mm < 2; ++mm)
#pragma unroll
                    for (int bj = 0; bj < 2; ++bj) { const int m = 2 * mp + mm, row = row0 + ai * 128 + m * 16, col = u.pn * 256 + bj * 128 + wc * 32 + fq * 8, si = ((ai * 4 + m) * 2 + bj) * 2;
                        const u32x4 g4 = gw[mm][bj]; f32x4 a = acc[ai][bj][m][0], b = acc[ai][bj][m][1];
                        a[0] *= bflo(g4.x); a[1] *= bfhi(g4.x); a[2] *= bflo(g4.y); a[3] *= bfhi(g4.y); b[0] *= bflo(g4.z); b[1] *= bfhi(g4.z); b[2] *= bflo(g4.w); b[3] *= bfhi(g4.w);
                        a += pa[mm][bj]; b += pb[mm][bj];
                        if (seg < 2) { sp[(size_t)si * 512] = a; sp[(size_t)(si + 1) * 512] = b; }
                        else *(u32x4*)(MIXED + (size_t)row * DM + col) = pack8(a, b); }
                asm volatile("" ::: "memory"); }
    }
};
struct EpiResid {
    const float* Xin; float* Xout;
    __device__ __forceinline__ void operator()(const AccT& acc, const Unit& u, int wr, int wc, int fr, int fq) const {
        const int row0 = u.pm * 256 + wr * 64 + fr;
#pragma unroll
        for (int ai = 0; ai < 2; ++ai)
#pragma unroll
            for (int mp = 0; mp < 2; ++mp) {
                f32x4 xv[2][2][2];
#pragma unroll
                for (int mm = 0; mm < 2; ++mm)
#pragma unroll
                    for (int bj = 0; bj < 2; ++bj)
#pragma unroll
                        for (int n = 0; n < 2; ++n) xv[mm][bj][n] = *(const f32x4*)(Xin + (size_t)(row0 + ai * 128 + (2 * mp + mm) * 16) * DM + u.pn * 256 + bj * 128 + wc * 32 + n * 16 + fq * 4);
#pragma unroll
                for (int mm = 0; mm < 2; ++mm)
#pragma unroll
                    for (int bj = 0; bj < 2; ++bj)
#pragma unroll
                        for (int n = 0; n < 2; ++n) *(f32x4*)(Xout + (size_t)(row0 + ai * 128 + (2 * mp + mm) * 16) * DM + u.pn * 256 + bj * 128 + wc * 32 + n * 16 + fq * 4) = xv[mm][bj][n] + acc[ai][bj][2 * mp + mm][n];
                asm volatile("" ::: "memory"); }
    }
};
struct EpiSwiglu {
    bf16_t* ACT; int lo; const float* rsc; const float* csc;
    template <class AV> __device__ __forceinline__ void operator()(const AV (&acc)[2][2][4][2], const Unit& u, int wr, int wc, int fr, int fq) const {
        const int row0 = (u.pm - lo) * 256 + wr * 64 + fr, arow0 = u.pm * 256 + wr * 64 + fr;
        f32x4 cs[2][2];
#pragma unroll
        for (int bj = 0; bj < 2; ++bj)
#pragma unroll
            for (int n = 0; n < 2; ++n) cs[bj][n] = *(const f32x4*)(csc + (size_t)u.aux * 2 * DFF + u.pn * 256 + bj * 128 + wc * 32 + n * 16 + fq * 4);
        float rs8[2][4];
#pragma unroll
        for (int ai = 0; ai < 2; ++ai)
#pragma unroll
            for (int m = 0; m < 4; ++m) rs8[ai][m] = rsc[arow0 + ai * 128 + m * 16];
#pragma unroll
        for (int ai = 0; ai < 2; ++ai)
#pragma unroll
            for (int m = 0; m < 4; ++m) { const float rs = rs8[ai][m]; f32x4 a, b;
                const f32x4 g0 = deq(acc[ai][0][m][0], rs, cs[0][0]), g1 = deq(acc[ai][0][m][1], rs, cs[0][1]), u0 = deq(acc[ai][1][m][0], rs, cs[1][0]), u1 = deq(acc[ai][1][m][1], rs, cs[1][1]);
#pragma unroll
                for (int j = 0; j < 4; ++j) { a[j] = g0[j] * fast_sigmoid(g0[j]) * u0[j]; b[j] = g1[j] * fast_sigmoid(g1[j]) * u1[j]; }
                *(u32x4*)(ACT + (size_t)(row0 + ai * 128 + m * 16) * DFF + u.pn * 128 + wc * 32 + fq * 8) = pack8(a, b); }
    }
};
struct EpiYout {
    bf16_t* Y;
    __device__ __forceinline__ void operator()(const AccT& acc, const Unit& u, int wr, int wc, int fr, int fq) const {
        const int row0 = u.pm * 256 + wr * 64 + fr;
#pragma unroll
        for (int ai = 0; ai < 2; ++ai)
#pragma unroll
            for (int m = 0; m < 4; ++m)
#pragma unroll
                for (int bj = 0; bj < 2; ++bj)
#pragma unroll
                    for (int n = 0; n < 2; ++n) *(u32x2*)(Y + (size_t)(row0 + ai * 128 + m * 16) * DM + u.pn * 256 + bj * 128 + wc * 32 + n * 16 + fq * 4) = pack4(acc[ai][bj][m][n]);
    }
};

namespace att {
__device__ __forceinline__ int crow(int r, int hi) { return (r & 3) + 8 * (r >> 2) + 4 * hi; }
__device__ __forceinline__ void glds16(const void* gsrc, unsigned lds_dst) { unsigned keep;
    asm volatile("s_mov_b32 %0, m0\n\ts_mov_b32 m0, %2\n\ts_nop 0\n\tglobal_load_lds_dwordx4 %1, off\n\ts_mov_b32 m0, %0" : "=&s"(keep) : "v"(gsrc), "s"(lds_dst) : "memory"); }
__device__ __forceinline__ float swapmax(float m) { auto rr = __builtin_amdgcn_permlane32_swap(__float_as_uint(m), __float_as_uint(m), false, false); return fmaxf(__uint_as_float(rr[0]), __uint_as_float(rr[1])); }
__device__ __forceinline__ float swapsum(float m) { auto rr = __builtin_amdgcn_permlane32_swap(__float_as_uint(m), __float_as_uint(m), false, false); return __uint_as_float(rr[0]) + __uint_as_float(rr[1]); }
__device__ __forceinline__ s16x4 vtr(unsigned addr) { s16x4 r; asm volatile("ds_read_b64_tr_b16 %0, %1" : "=&v"(r) : "v"(addr) : "memory"); return r; }
#define VTRO(dst, base, off) asm volatile("ds_read_b64_tr_b16 %0, %1 offset:%c2" : "=&v"(dst) : "v"(base), "i"(off) : "memory")

struct Src {
    const bf16_t* q; int qpitch;
    const bf16_t* k0; int k0pitch;
    const bf16_t* k1; int k1pitch;
    const bf16_t* v; int vpitch;
    bf16_t* o; int opitch;
};
template <int NKC, int NVB, int RD = 4>
__device__ __forceinline__ void dma_tile(const Src& S, int t, int slot, unsigned lds0, int wid, int lane) {
    constexpr int KS = NKC * 1024, VS = NVB * 4096, LDS_K = 0, LDS_V = RD * KS;
#pragma unroll
    for (int c = 0; c < (NKC + 7) / 8; ++c) { const int ch = wid + 8 * c; if (ch < NKC) {
        const bf16_t* src = (ch < 8) ? S.k0 + (size_t)(t * 64 + lane) * S.k0pitch + ch * 8 : S.k1 + (size_t)(t * 64 + lane) * S.k1pitch + (ch - 8) * 8;
        glds16(src, (unsigned)__builtin_amdgcn_readfirstlane(lds0 + LDS_K + slot * KS + ch * 1024)); } }
#pragma unroll
    for (int c = 0; c < (NVB * 4 + 7) / 8; ++c) { const int p = wid + 8 * c; if (p < NVB * 4) {
        const bf16_t* src = S.v + (size_t)(t * 64 + 16 * (p & 3) + (lane >> 2)) * S.vpitch + (p >> 2) * 32 + (lane & 3) * 8;
        glds16(src, (unsigned)__builtin_amdgcn_readfirstlane(lds0 + LDS_V + slot * VS + p * 1024)); } }
}
__device__ __forceinline__ void wait_vm_bar(int n) {
    if (n >= 4) asm volatile("s_waitcnt vmcnt(4) lgkmcnt(0)\n\ts_barrier" ::: "memory");
    else if (n == 3) asm volatile("s_waitcnt vmcnt(3) lgkmcnt(0)\n\ts_barrier" ::: "memory");
    else if (n == 2) asm volatile("s_waitcnt vmcnt(2) lgkmcnt(0)\n\ts_barrier" ::: "memory");
    else if (n == 1) asm volatile("s_waitcnt vmcnt(1) lgkmcnt(0)\n\ts_barrier" ::: "memory");
    else asm volatile("s_waitcnt vmcnt(0) lgkmcnt(0)\n\ts_barrier" ::: "memory");
}
template <int NKC, int NVB, int MODE>
__device__ __forceinline__ void unit(LAS unsigned char* lds, const Src& S, int t_lo, int t_hi, int qpos0  , float sink_l2) {
    constexpr int KS = NKC * 1024, VS = NVB * 4096, RD = 4, LDS_K = 0, LDS_V = RD * KS;
    const int tid = opq_v((int)threadIdx.x), lane = tid & 63, r32 = lane & 31, hi = lane >> 5; const int wid = __builtin_amdgcn_readfirstlane(tid >> 6), grp = wid >> 2;
    const unsigned lds0 = (unsigned)(uintptr_t)lds;
    const int ops = (NKC + 7 - wid) / 8 + (NVB * 4) / 8;
    bf16x8 qr[NKC / 2];
#pragma unroll
    for (int d0 = 0; d0 < NKC / 2; ++d0) qr[d0] = *(const bf16x8*)(S.q + (size_t)r32 * S.qpitch + d0 * 16 + hi * 8);
    float m_run = (MODE == 0) ? sink_l2 : -INFINITY, l_run = (MODE == 0 && hi == 0) ? 1.0f : 0.0f;
    f32x16 o[NVB];
#pragma unroll
    for (int d = 0; d < NVB; ++d) o[d] = f32x16{};
    const int qi = qpos0 + wid * 32 + r32, qw0 = qpos0 + wid * 32;
    f32x16 p0 = f32x16{}, p1 = f32x16{};
#define AT_ACTIVE(t) ((MODE != 0) || ((64 * (t) + 63 >= qw0 - 128) && (64 * (t) <= qw0 + 31 + 128)))
#define AT_QK(t) do { const LAS unsigned char* kb_ = lds + LDS_K + (((t) - t_lo) % RD) * KS + hi * 1024 + r32 * 16; p0 = f32x16{}; p1 = f32x16{}; \
        _Pragma("unroll") for (int d0 = 0; d0 < NKC / 2; ++d0) { const bf16x8 b0_ = *(const LAS bf16x8*)(kb_ + d0 * 2048), b1_ = *(const LAS bf16x8*)(kb_ + d0 * 2048 + 512); \
            p0 = __builtin_amdgcn_mfma_f32_32x32x16_bf16(b0_, qr[d0], p0, 0, 0, 0); p1 = __builtin_amdgcn_mfma_f32_32x32x16_bf16(b1_, qr[d0], p1, 0, 0, 0); } } while (0)
#define AT_SMPV(t) do { \
        if (MODE == 0) { _Pragma("unroll") for (int r = 0; r < 16; ++r) { const int kv_ = 64 * (t) + crow(r, hi); int e0_ = kv_ - qi; e0_ = e0_ < 0 ? -e0_ : e0_; int e1_ = kv_ + 32 - qi; e1_ = e1_ < 0 ? -e1_ : e1_; \
            if (e0_ > 128) p0[r] = -INFINITY; if (e1_ > 128) p1[r] = -INFINITY; } } \
        float mx_[8]; _Pragma("unroll") for (int r = 0; r < 8; ++r) mx_[r] = fmaxf(fmaxf(p0[r], p0[r + 8]), fmaxf(p1[r], p1[r + 8])); \
        float rm_ = fmaxf(fmaxf(fmaxf(mx_[0], mx_[1]), fmaxf(mx_[2], mx_[3])), fmaxf(fmaxf(mx_[4], mx_[5]), fmaxf(mx_[6], mx_[7]))); rm_ = swapmax(rm_); \
        if (__any(rm_ > m_run)) { const float mn_ = fmaxf(m_run, rm_), alpha_ = __builtin_amdgcn_exp2f(m_run - mn_); m_run = mn_; l_run *= alpha_; \
            _Pragma("unroll") for (int d = 0; d < NVB; ++d) _Pragma("unroll") for (int r = 0; r < 16; ++r) o[d][r] *= alpha_; } \
        float sm_[4] = {0.f, 0.f, 0.f, 0.f}; \
        _Pragma("unroll") for (int r = 0; r < 16; ++r) { p0[r] = __builtin_amdgcn_exp2f(p0[r] - m_run); p1[r] = __builtin_amdgcn_exp2f(p1[r] - m_run); sm_[r & 3] += p0[r] + p1[r]; } \
        l_run += (sm_[0] + sm_[1]) + (sm_[2] + sm_[3]); \
        u32x4 pw_[4]; \
        pw_[0] = (u32x4){cvtpk(p0[0], p0[1]), cvtpk(p0[2], p0[3]), cvtpk(p0[4], p0[5]), cvtpk(p0[6], p0[7])}; pw_[1] = (u32x4){cvtpk(p0[8], p0[9]), cvtpk(p0[10], p0[11]), cvtpk(p0[12], p0[13]), cvtpk(p0[14], p0[15])}; \
        pw_[2] = (u32x4){cvtpk(p1[0], p1[1]), cvtpk(p1[2], p1[3]), cvtpk(p1[4], p1[5]), cvtpk(p1[6], p1[7])}; pw_[3] = (u32x4){cvtpk(p1[8], p1[9]), cvtpk(p1[10], p1[11]), cvtpk(p1[12], p1[13]), cvtpk(p1[14], p1[15])}; \
        const unsigned vb_ = lds0 + LDS_V + (((t) - t_lo) % RD) * VS + ((lane >> 4) & 1) * 32 + (lane & 3) * 8 + (4 * hi + ((lane & 15) >> 2)) * 64; \
        _Pragma("unroll") for (int dp = 0; dp < NVB; dp += 2) { s16x4 lo_[2][4], hh_[2][4]; \
            _Pragma("unroll") for (int dd = 0; dd < 2; ++dd) _Pragma("unroll") for (int ks = 0; ks < 4; ++ks) { lo_[dd][ks] = vtr(vb_ + (dp + dd) * 4096 + ks * 1024); hh_[dd][ks] = vtr(vb_ + (dp + dd) * 4096 + ks * 1024 + 512); } \
            asm volatile("s_waitcnt lgkmcnt(0)" ::: "memory"); __builtin_amdgcn_sched_barrier(0); \
            _Pragma("unroll") for (int ks = 0; ks < 4; ++ks) _Pragma("unroll") for (int dd = 0; dd < 2; ++dd) { \
                const bf16x8 vf_ = (bf16x8){lo_[dd][ks][0], lo_[dd][ks][1], lo_[dd][ks][2], lo_[dd][ks][3], hh_[dd][ks][0], hh_[dd][ks][1], hh_[dd][ks][2], hh_[dd][ks][3]}; \
                o[dp + dd] = __builtin_amdgcn_mfma_f32_32x32x16_bf16(vf_, __builtin_bit_cast(bf16x8, pw_[ks]), o[dp + dd], 0, 0, 0); } } } while (0)
    dma_tile<NKC, NVB>(S, t_lo, 0, lds0, wid, lane);
    if (t_lo + 1 < t_hi) dma_tile<NKC, NVB>(S, t_lo + 1, 1, lds0, wid, lane);
    for (int t = t_lo; t < t_hi; ++t) {
        wait_vm_bar((t + 1 < t_hi) ? ops : 0);
        if (t + 2 < t_hi) dma_tile<NKC, NVB>(S, t + 2, (t + 2 - t_lo) % RD, lds0, wid, lane);
        if (grp == 0) { if (AT_ACTIVE(t)) { AT_QK(t); AT_SMPV(t); } }
        else { if (t > t_lo && AT_ACTIVE(t - 1)) AT_SMPV(t - 1); if (AT_ACTIVE(t)) AT_QK(t); }
    }
    if (grp == 1 && AT_ACTIVE(t_hi - 1)) AT_SMPV(t_hi - 1);
    const float linv = 1.0f / swapsum(l_run);
#pragma unroll
    for (int d = 0; d < NVB; ++d)
#pragma unroll
        for (int r4 = 0; r4 < 4; ++r4) { f32x4 v = {o[d][4 * r4] * linv, o[d][4 * r4 + 1] * linv, o[d][4 * r4 + 2] * linv, o[d][4 * r4 + 3] * linv};
            *(u32x2*)(S.o + (size_t)r32 * S.opitch + 32 * d + 8 * r4 + 4 * hi) = pack4(v); }
    asm volatile("s_waitcnt lgkmcnt(0)\n\ts_barrier" ::: "memory");
#undef AT_ACTIVE
#undef AT_QK
#undef AT_SMPV
}

template <int NKC, int NVB, bool STAG>
__device__ __forceinline__ void unit_pf(LAS unsigned char* lds, const Src& S, int t_lo, int t_hi) {
    constexpr int KS = NKC * 1024, VS = NVB * 4096, RD = 5, LDS_K = 0, LDS_V = RD * KS;
    static_assert(RD * (KS + VS) <= RING_BYTES, "attention rings fit the LDS stage region");
    const int tid = opq_v((int)threadIdx.x), lane = tid & 63, r32 = lane & 31, hi = lane >> 5; const int wid = __builtin_amdgcn_readfirstlane(tid >> 6), grp = STAG ? (wid >> 2) : 0;
    const unsigned lds0 = (unsigned)(uintptr_t)lds;
    const int ops = (NKC + 7 - wid) / 8 + (NVB * 4) / 8;
    bf16x8 qr[NKC / 2];
#pragma unroll
    for (int d0 = 0; d0 < NKC / 2; ++d0) qr[d0] = *(const bf16x8*)(S.q + (size_t)r32 * S.qpitch + d0 * 16 + hi * 8);
    float m_run = -INFINITY, l_run = 0.0f;
    f32x16 o[NVB];
#pragma unroll
    for (int d = 0; d < NVB; ++d) o[d] = f32x16{};
    bf16x8 kf[NKC];
    f32x16 p0 = f32x16{}, p1 = f32x16{};
    s16x4 lo[NVB][4], hh[NVB][4];
#define PF_KLOAD(t) do { const LAS unsigned char* kb_ = lds + LDS_K + (((t) - t_lo) % RD) * KS + hi * 1024 + r32 * 16; \
        _Pragma("unroll") for (int d0 = 0; d0 < NKC / 2; ++d0) { kf[2 * d0] = *(const LAS bf16x8*)(kb_ + d0 * 2048); kf[2 * d0 + 1] = *(const LAS bf16x8*)(kb_ + d0 * 2048 + 512); } } while (0)
#define PF_VLOAD(t) do { const unsigned vb_ = lds0 + LDS_V + (((t) - t_lo) % RD) * VS + ((lane >> 4) & 1) * 32 + (lane & 3) * 8 + (4 * hi + ((lane & 15) >> 2)) * 64; \
        _Pragma("unroll") for (int d = 0; d < NVB; ++d) _Pragma("unroll") for (int ks = 0; ks < 4; ++ks) { VTRO(lo[d][ks], vb_, d * 4096 + ks * 1024); VTRO(hh[d][ks], vb_, d * 4096 + ks * 1024 + 512); } \
        __builtin_amdgcn_sched_barrier(0); } while (0)
#define PF_QK() do { p0 = f32x16{}; p1 = f32x16{}; \
        _Pragma("unroll") for (int d0 = 0; d0 < NKC / 2; ++d0) { p0 = __builtin_amdgcn_mfma_f32_32x32x16_bf16(kf[2 * d0], qr[d0], p0, 0, 0, 0); p1 = __builtin_amdgcn_mfma_f32_32x32x16_bf16(kf[2 * d0 + 1], qr[d0], p1, 0, 0, 0); } \
        __builtin_amdgcn_sched_barrier(0); } while (0)
    u32x4 pw[4] = {};
#define PF_SM() do { \
        float mx_[8]; _Pragma("unroll") for (int r = 0; r < 8; ++r) mx_[r] = fmaxf(fmaxf(p0[r], p0[r + 8]), fmaxf(p1[r], p1[r + 8])); \
        float rm_ = fmaxf(fmaxf(fmaxf(mx_[0], mx_[1]), fmaxf(mx_[2], mx_[3])), fmaxf(fmaxf(mx_[4], mx_[5]), fmaxf(mx_[6], mx_[7]))); rm_ = swapmax(rm_); \
        if (__any(rm_ > m_run)) { const float mn_ = fmaxf(m_run, rm_), alpha_ = __builtin_amdgcn_exp2f(m_run - mn_); m_run = mn_; l_run *= alpha_; \
            _Pragma("unroll") for (int d = 0; d < NVB; ++d) _Pragma("unroll") for (int r = 0; r < 16; ++r) o[d][r] *= alpha_; } \
        float sm_[4] = {0.f, 0.f, 0.f, 0.f}; \
        _Pragma("unroll") for (int r = 0; r < 16; ++r) { p0[r] = __builtin_amdgcn_exp2f(p0[r] - m_run); p1[r] = __builtin_amdgcn_exp2f(p1[r] - m_run); sm_[r & 3] += p0[r] + p1[r]; } \
        l_run += (sm_[0] + sm_[1]) + (sm_[2] + sm_[3]); \
        pw[0] = (u32x4){cvtpk(p0[0], p0[1]), cvtpk(p0[2], p0[3]), cvtpk(p0[4], p0[5]), cvtpk(p0[6], p0[7])}; pw[1] = (u32x4){cvtpk(p0[8], p0[9]), cvtpk(p0[10], p0[11]), cvtpk(p0[12], p0[13]), cvtpk(p0[14], p0[15])}; \
        pw[2] = (u32x4){cvtpk(p1[0], p1[1]), cvtpk(p1[2], p1[3]), cvtpk(p1[4], p1[5]), cvtpk(p1[6], p1[7])}; pw[3] = (u32x4){cvtpk(p1[8], p1[9]), cvtpk(p1[10], p1[11]), cvtpk(p1[12], p1[13]), cvtpk(p1[14], p1[15])}; \
        __builtin_amdgcn_sched_barrier(0); } while (0)
#define PF_PV() do { asm volatile("s_waitcnt lgkmcnt(0)" ::: "memory"); __builtin_amdgcn_sched_barrier(0); \
        _Pragma("unroll") for (int ks = 0; ks < 4; ++ks) _Pragma("unroll") for (int d = 0; d < NVB; ++d) { \
            const bf16x8 vf_ = (bf16x8){lo[d][ks][0], lo[d][ks][1], lo[d][ks][2], lo[d][ks][3], hh[d][ks][0], hh[d][ks][1], hh[d][ks][2], hh[d][ks][3]}; \
            o[d] = __builtin_amdgcn_mfma_f32_32x32x16_bf16(vf_, __builtin_bit_cast(bf16x8, pw[ks]), o[d], 0, 0, 0); } \
        __builtin_amdgcn_sched_barrier(0); } while (0)
    dma_tile<NKC, NVB, RD>(S, t_lo, 0, lds0, wid, lane);
    if (t_lo + 1 < t_hi) dma_tile<NKC, NVB, RD>(S, t_lo + 1, 1, lds0, wid, lane);
    wait_vm_bar(0);
    if (t_lo + 2 < t_hi) dma_tile<NKC, NVB, RD>(S, t_lo + 2, 2, lds0, wid, lane);
#define PF_TOP(t) do { if ((t) > t_lo) wait_vm_bar(((t) + 2 < t_hi) ? ops : 0); \
        if ((t) + 3 < t_hi) dma_tile<NKC, NVB, RD>(S, (t) + 3, ((t) + 3 - t_lo) % RD, lds0, wid, lane); } while (0)
    if (grp == 0) {
        PF_KLOAD(t_lo);
        for (int t = t_lo; t < t_hi; ++t) {
            PF_TOP(t);
            PF_VLOAD(t);
            PF_QK();
            if (t + 1 < t_hi) PF_KLOAD(t + 1);
            __builtin_amdgcn_sched_barrier(0);
            PF_SM();
            PF_PV();
        }
    } else {
        PF_TOP(t_lo); PF_KLOAD(t_lo); __builtin_amdgcn_sched_barrier(0); PF_QK();
        for (int t = t_lo + 1; t < t_hi; ++t) {
            PF_TOP(t);
            PF_VLOAD(t - 1); PF_SM(); PF_KLOAD(t); __builtin_amdgcn_sched_barrier(0); PF_PV();
            PF_QK();
        }
        PF_VLOAD(t_hi - 1); PF_SM(); PF_PV();
    }
    const float linv = 1.0f / swapsum(l_run);
#pragma unroll
    for (int d = 0; d < NVB; ++d)
#pragma unroll
        for (int r4 = 0; r4 < 4; ++r4) { f32x4 v = {o[d][4 * r4] * linv, o[d][4 * r4 + 1] * linv, o[d][4 * r4 + 2] * linv, o[d][4 * r4 + 3] * linv};
            *(u32x2*)(S.o + (size_t)r32 * S.opitch + 32 * d + 8 * r4 + 4 * hi) = pack4(v); }
    asm volatile("s_waitcnt lgkmcnt(0)\n\ts_barrier" ::: "memory");
#undef PF_KLOAD
#undef PF_VLOAD
#undef PF_QK
#undef PF_SM
#undef PF_PV
#undef PF_TOP
}

template <int NKC, int NVB, int MODE>
__device__ __forceinline__ void unit_pp(LAS unsigned char* lds, const Src& S, int t_lo, int t_hi, int qpos0, float sink_l2) {
    constexpr int KS = NKC * 1024, VS = NVB * 4096, RD = 3, LDS_K = 0, LDS_V = RD * KS;
    const int tid = opq_v((int)threadIdx.x), lane = tid & 63, r32 = lane & 31, hi = lane >> 5; const int wid = __builtin_amdgcn_readfirstlane(tid >> 6), grp = wid >> 2;
    const unsigned lds0 = (unsigned)(uintptr_t)lds;
    const int n = t_hi - t_lo;
    const int kops = (NKC + 7 - wid) / 8, vops = (NVB * 4) / 8;
    bf16x8 qr[NKC / 2];
#pragma unroll
    for (int d0 = 0; d0 < NKC / 2; ++d0) qr[d0] = *(const bf16x8*)(S.q + (size_t)r32 * S.qpitch + d0 * 16 + hi * 8);
#define PP_DMA_K(j) do { _Pragma("unroll") for (int c_ = 0; c_ < (NKC + 7) / 8; ++c_) { const int ch_ = wid + 8 * c_; if (ch_ < NKC) { \
        const bf16_t* src_ = (ch_ < 8) ? S.k0 + (size_t)((t_lo + (j)) * 64 + lane) * S.k0pitch + ch_ * 8 : S.k1 + (size_t)((t_lo + (j)) * 64 + lane) * S.k1pitch + (ch_ - 8) * 8; \
        glds16(src_, (unsigned)__builtin_amdgcn_readfirstlane(lds0 + LDS_K + ((j) % RD) * KS + ch_ * 1024)); } } } while (0)
#define PP_DMA_V(j) do { _Pragma("unroll") for (int c_ = 0; c_ < (NVB * 4 + 7) / 8; ++c_) { const int p_ = wid + 8 * c_; if (p_ < NVB * 4) { \
        const bf16_t* src_ = S.v + (size_t)((t_lo + (j)) * 64 + 16 * (p_ & 3) + (lane >> 2)) * S.vpitch + (p_ >> 2) * 32 + (lane & 3) * 8; \
        glds16(src_, (unsigned)__builtin_amdgcn_readfirstlane(lds0 + LDS_V + ((j) % RD) * VS + p_ * 1024)); } } } while (0)
#define PP_BATCH(b, cnt) do { cnt = 0; if ((b) + 3 < n) { PP_DMA_K((b) + 3); cnt += kops; } if ((b) + 2 < n) { PP_DMA_V((b) + 2); cnt += vops; } } while (0)
    float m_run = (MODE == 0) ? sink_l2 : -INFINITY, l_run = (MODE == 0 && hi == 0) ? 1.0f : 0.0f;
    f32x16 o[NVB];
#pragma unroll
    for (int d = 0; d < NVB; ++d) o[d] = f32x16{};
    const int qi = qpos0 + wid * 32 + r32, qw0 = qpos0 + wid * 32;
#define PP_ACTIVE(j) ((MODE != 0) || ((64 * (t_lo + (j)) + 63 >= qw0 - 128) && (64 * (t_lo + (j)) <= qw0 + 31 + 128)))
    f32x16 p0 = f32x16{}, p1 = f32x16{}; u32x4 pw[4] = {};
#define PP_QK(j) do { const LAS unsigned char* kb_ = lds + LDS_K + ((j) % RD) * KS + hi * 1024 + r32 * 16; p0 = f32x16{}; p1 = f32x16{}; \
        _Pragma("unroll") for (int d0 = 0; d0 < NKC / 2; ++d0) { const bf16x8 b0_ = *(const LAS bf16x8*)(kb_ + d0 * 2048), b1_ = *(const LAS bf16x8*)(kb_ + d0 * 2048 + 512); \
            p0 = __builtin_amdgcn_mfma_f32_32x32x16_bf16(b0_, qr[d0], p0, 0, 0, 0); p1 = __builtin_amdgcn_mfma_f32_32x32x16_bf16(b1_, qr[d0], p1, 0, 0, 0); } } while (0)
#define PP_SOFTMAX(j) do { \
        if (MODE == 0) { _Pragma("unroll") for (int r = 0; r < 16; ++r) { const int kv_ = 64 * (t_lo + (j)) + crow(r, hi); int e0_ = kv_ - qi; e0_ = e0_ < 0 ? -e0_ : e0_; int e1_ = kv_ + 32 - qi; e1_ = e1_ < 0 ? -e1_ : e1_; \
            if (e0_ > 128) p0[r] = -INFINITY; if (e1_ > 128) p1[r] = -INFINITY; } } \
        float rm_ = fmaxf(p0[0], p1[0]); _Pragma("unroll") for (int r = 1; r < 16; ++r) rm_ = fmaxf(rm_, fmaxf(p0[r], p1[r])); rm_ = swapmax(rm_); \
        const float mn_ = fmaxf(m_run, rm_), alpha_ = __builtin_amdgcn_exp2f(m_run - mn_); m_run = mn_; float sum_ = 0.f; \
        _Pragma("unroll") for (int r = 0; r < 16; ++r) { p0[r] = __builtin_amdgcn_exp2f(p0[r] - mn_); p1[r] = __builtin_amdgcn_exp2f(p1[r] - mn_); sum_ += p0[r] + p1[r]; } \
        l_run = l_run * alpha_ + sum_; \
        _Pragma("unroll") for (int d = 0; d < NVB; ++d) _Pragma("unroll") for (int r = 0; r < 16; ++r) o[d][r] *= alpha_; \
        pw[0] = (u32x4){cvtpk(p0[0], p0[1]), cvtpk(p0[2], p0[3]), cvtpk(p0[4], p0[5]), cvtpk(p0[6], p0[7])}; pw[1] = (u32x4){cvtpk(p0[8], p0[9]), cvtpk(p0[10], p0[11]), cvtpk(p0[12], p0[13]), cvtpk(p0[14], p0[15])}; \
        pw[2] = (u32x4){cvtpk(p1[0], p1[1]), cvtpk(p1[2], p1[3]), cvtpk(p1[4], p1[5]), cvtpk(p1[6], p1[7])}; pw[3] = (u32x4){cvtpk(p1[8], p1[9]), cvtpk(p1[10], p1[11]), cvtpk(p1[12], p1[13]), cvtpk(p1[14], p1[15])}; } while (0)
#define PP_PV(j) do { const unsigned vb_ = lds0 + LDS_V + ((j) % RD) * VS + ((lane >> 4) & 1) * 32 + (lane & 3) * 8 + (4 * hi + ((lane & 15) >> 2)) * 64; \
        _Pragma("unroll") for (int d = 0; d < NVB; ++d) { s16x4 lo_[4], hh_[4]; \
            _Pragma("unroll") for (int ks = 0; ks < 4; ++ks) { lo_[ks] = vtr(vb_ + d * 4096 + ks * 1024); hh_[ks] = vtr(vb_ + d * 4096 + ks * 1024 + 512); } \
            asm volatile("s_waitcnt lgkmcnt(0)" ::: "memory"); __builtin_amdgcn_sched_barrier(0); \
            _Pragma("unroll") for (int ks = 0; ks < 4; ++ks) { const bf16x8 vf_ = (bf16x8){lo_[ks][0], lo_[ks][1], lo_[ks][2], lo_[ks][3], hh_[ks][0], hh_[ks][1], hh_[ks][2], hh_[ks][3]}; \
                o[d] = __builtin_amdgcn_mfma_f32_32x32x16_bf16(vf_, __builtin_bit_cast(bf16x8, pw[ks]), o[d], 0, 0, 0); } } } while (0)
    PP_DMA_K(0); PP_DMA_V(0); if (n > 1) { PP_DMA_K(1); PP_DMA_V(1); } if (n > 2) PP_DMA_K(2);
    asm volatile("s_waitcnt vmcnt(0) lgkmcnt(0)\n\ts_barrier" ::: "memory");
    if (grp == 1) asm volatile("s_barrier" ::: "memory");
    int infl = 0;
    if (PP_ACTIVE(0)) PP_QK(0);
    wait_vm_bar(infl);
    if (grp == 1) PP_BATCH(0, infl);
    if (PP_ACTIVE(0)) PP_SOFTMAX(0);
    wait_vm_bar(infl);
    for (int j = 0; j < n; ++j) {
        if (grp == 0) PP_BATCH(j, infl);
        const bool act = PP_ACTIVE(j), actn = (j + 1 < n) && PP_ACTIVE(j + 1);
        if (act) PP_PV(j);
        if (actn) PP_QK(j + 1);
        wait_vm_bar(infl);
        if (j + 1 < n) {
            if (grp == 1) PP_BATCH(j + 1, infl);
            if (actn) PP_SOFTMAX(j + 1);
            wait_vm_bar(infl);
        }
    }
    if (grp == 0) asm volatile("s_barrier" ::: "memory");
    const float linv = 1.0f / swapsum(l_run);
#pragma unroll
    for (int d = 0; d < NVB; ++d)
#pragma unroll
        for (int r4 = 0; r4 < 4; ++r4) { f32x4 v = {o[d][4 * r4] * linv, o[d][4 * r4 + 1] * linv, o[d][4 * r4 + 2] * linv, o[d][4 * r4 + 3] * linv};
            *(u32x2*)(S.o + (size_t)r32 * S.opitch + 32 * d + 8 * r4 + 4 * hi) = pack4(v); }
    asm volatile("s_waitcnt lgkmcnt(0)\n\ts_barrier" ::: "memory");
#undef PP_DMA_K
#undef PP_DMA_V
#undef PP_BATCH
#undef PP_ACTIVE
#undef PP_QK
#undef PP_SOFTMAX
#undef PP_PV
}
}
#define SC_AFTER_PROLOGUE() do {} while (0)
#define SC_AFTER_INPROJ(l) do {} while (0)
#define SC_AFTER_UP(l) do {} while (0)
#define SC_AFTER_MLA(l) do {} while (0)
#define SC_AFTER_BRANCH(l) do {} while (0)
#define SC_AFTER_WOUT(l) do {} while (0)
#define SC_AFTER_NORM2(l) do {} while (0)
#define SC_AFTER_GU(l) do {} while (0)
#define SC_AFTER_DOWN(l) do {} while (0)
#define SC_AFTER_ROUTE(l) do {} while (0)
#define SC_AFTER_MOEGU(l, h) do {} while (0)
#define SC_AFTER_MOED(l, h) do {} while (0)
#define SC_FINAL() do {} while (0)

struct Args { const float* in[23]; float* out; unsigned char* ws; };
#define WSP(type, off) ((type*)(F.ws + (off)))
#define PHASE() Frame Fp = F; Fp.ws = opq_p(F.ws); Fp.in = opq_p(F.in); Fp.out = opq_p(F.out); Fp.tid = opq_v((int)threadIdx.x); Fp.lane = Fp.tid & 63; Fp.wave = __builtin_amdgcn_readfirstlane(Fp.tid >> 6); (void)Fp
#define FWS(type, off) ((type*)(Fp.ws + (off)))
#define X_ (Fp.out)
#define H_ FWS(bf16_t, WS_H)
#define Pb_ FWS(bf16_t, WS_R + R_P)
#define Gb_ FWS(bf16_t, WS_R + R_G)
#define QB_ FWS(bf16_t, WS_R + R_QB)
#define KVB_ FWS(bf16_t, WS_R + R_KVB)
#define Yb_ FWS(bf16_t, WS_R + R_Y)
#define MEMN_ FWS(bf16_t, WS_MEMN)
#define MEMKV_ FWS(bf16_t, WS_MEMKV)
#define ACT_ FWS(bf16_t, WS_R + R_ACT)
#define ASORT_ FWS(bf16_t, WS_R + R_ASORT)
#define YOUT_ FWS(bf16_t, WS_R + R_YOUT)
#define SSQ_ FWS(float, WS_MISC + MS_SSQ)
#define TEXP_ FWS(const int, WS_MISC + MS_TEXP)
#define POS_ ((const int*)Fp.in[I_POS])
#define HSC_ FWS(float, WS_MISC + MS_HSC)
#define ASC_ FWS(float, WS_MISC + MS_ASC)
#define WSIN_ FWS(float, WS_MISC + MS_WSIN)
#define WSGU_ FWS(float, WS_MISC + MS_WSGU)

#define GRID_BAR() xcd_barrier(bar)
#ifndef MLA_STAG
#define MLA_STAG false
#endif
template <int l> __device__ __forceinline__ void layer_body(const Frame& F, const XcdBarrier& bar, const int bx) {
        if (l > 0) {
            PHASE();
            prep_ffn_weights(Fp, l);
            norm_phase(Fp, X_, X_, Fp.in[I_GMIX] + l * DM, (l & 1) == 0, true);
            GRID_BAR();
        }
        {   PHASE();
            ProbSimple p{DM, DM, DM, (const char*)H_, (const char*)wmix(Fp, l, WL_IN)}; pg8::StaticOrder S; S.init(T / 256, NT_IN, Fp.G, bx);
            EpiInproj E{Pb_, Gb_, SSQ_, POS_, HSC_, WSIN_ + l * NT_IN * 256}; pg8::gemm_phase<true>(Fp.lds, p, S, E); }
        if (l == 0) { PHASE();
            ProbSimple p{DM, DM * 2, DM * 2, (const char*)MEMN_, (const char*)FWS(bf16_t, WS_WMKV)}; pg8::StaticOrder S; S.init(NB * MEML / 256, 16, Fp.G, bx);
            EpiPlain E{MEMKV_, 4096}; pg8::gemm_phase(Fp.lds, p, S, E); }
        GRID_BAR();
        SC_AFTER_INPROJ(l);
        {   PHASE();
            ProbSimple p{UPK, PW * 2, UPK * 2, (const char*)(Pb_ + P_CQ), (const char*)wmix(Fp, l, WL_UP)}; pg8::StaticOrder S; S.init(T / 256, UPN / 256, Fp.G, bx);
            EpiUp E{QB_, KVB_, SSQ_, POS_}; pg8::gemm_phase(Fp.lds, p, S, E); }
        {   PHASE();
            for (int i = Fp.vcu; i < 1024; i += Fp.G) {
                const int hl = i & 3, qb = (i >> 2) & 15, kvh = (i >> 6) & 1, b = i >> 7, h = kvh * 4 + hl; const size_t rowb = (size_t)b * SEQ; const int q0 = qb * 256;
                att::Src s; s.q = Pb_ + (rowb + q0 + Fp.wave * 32) * PW + P_QA + h * 64; s.qpitch = PW; s.k0 = Pb_ + rowb * PW + P_KA + kvh * 64; s.k0pitch = PW; s.k1 = s.k0; s.k1pitch = PW;
                s.v = Pb_ + rowb * PW + P_VA + kvh * 64; s.vpitch = PW; s.o = Yb_ + (rowb + q0 + Fp.wave * 32) * YW + h * 64; s.opitch = YW;
                const int t_lo = (q0 / 64 - 2) < 0 ? 0 : (q0 / 64 - 2), t_hi = (q0 / 64 + 6) > SEQ / 64 ? SEQ / 64 : (q0 / 64 + 6);
                att::unit<8, 2, 0>(Fp.lds, s, t_lo, t_hi, q0, Fp.in[I_SINK][l * 8 + h] * LOG2E);
            } }
        {   PHASE();
            for (int i = Fp.vcu; i < 512; i += Fp.G) {
                const int qb = i & 15, h = (i >> 4) & 3, b = i >> 6; const size_t rowq = (size_t)b * SEQ + qb * 256 + Fp.wave * 32;
                att::Src s; s.q = Pb_ + rowq * PW + P_QM + h * 128; s.qpitch = PW; s.k0 = MEMKV_ + (size_t)b * MEML * 4096 + l * 1024 + h * 128; s.k0pitch = 4096; s.k1 = s.k0 + 64; s.k1pitch = 4096;
                s.v = MEMKV_ + (size_t)b * MEML * 4096 + l * 1024 + 512 + h * 128; s.vpitch = 4096; s.o = Yb_ + rowq * YW + 1024 + h * 128; s.opitch = YW;
                att::unit<16, 4, 1>(Fp.lds, s, 0, MEML / 64, 0, 0.f);
            } }
        GRID_BAR();
        SC_AFTER_UP(l);
        {   PHASE();
            for (int i = Fp.vcu; i < 1024; i += Fp.G) {
                const int qb = i & 15, h = (i >> 4) & 7, b = i >> 7; const size_t rowb = (size_t)b * SEQ, rowq = rowb + qb * 256 + Fp.wave * 32;
                att::Src s; s.q = QB_ + rowq * QBW + h * 96; s.qpitch = QBW; s.k0 = KVB_ + rowb * KVW + h * 128; s.k0pitch = KVW; s.k1 = Pb_ + rowb * PW + P_KR; s.k1pitch = PW;
                s.v = KVB_ + rowb * KVW + h * 128 + 64; s.vpitch = KVW; s.o = Yb_ + rowq * YW + 512 + h * 64; s.opitch = YW;
                att::unit_pf<12, 2, MLA_STAG>(Fp.lds, s, 0, SEQ / 64);
            } }
        GRID_BAR();
        SC_AFTER_MLA(l);
        {   PHASE();
            ProbBranch p{512, YW * 2, 512 * 2, (const char*)Yb_, (const char*)wmix(Fp, l, WL_BR)}; SegOrder S; S.base.init(T / 256, DM / 256, Fp.G, bx);
            EpiBranch E{Gb_, FWS(float, WS_R + R_BRS) + (size_t)bx * 65536, H_}; pg8::gemm_phase(Fp.lds, p, S, E); }
        GRID_BAR();
        SC_AFTER_BRANCH(l);
        {   PHASE();
            ProbSimple p{DM, DM * 2, DM * 2, (const char*)H_, (const char*)wmix(Fp, l, WL_OUT)}; pg8::StaticOrder S; S.init(T / 256, DM / 256, Fp.G, bx);
            EpiResid E{l == 0 ? Fp.in[I_X] : X_, X_}; pg8::gemm_phase(Fp.lds, p, S, E); }
        GRID_BAR();
        SC_AFTER_WOUT(l);
        if ((l & 1) == 0) {
            {   PHASE(); norm_phase(Fp, X_, nullptr, Fp.in[I_GFFN] + l * DM, false, GU_I8(l) != 0); }
            GRID_BAR();
            SC_AFTER_NORM2(l);
            {   PHASE();
                constexpr bool i8 = GU_I8(l) != 0; constexpr unsigned eb = i8 ? 1 : 2;
                ProbSimple p{DM, DM * eb, DM * eb, (const char*)H_, (const char*)FWS(bf16_t, WS_WFFN + WF_GU)}; pg8::StaticOrder S; S.init(T / 256, 2 * DFF / 256, Fp.G, bx);
                EpiSwiglu E{ACT_, 0, HSC_, WSGU_}; pg8::gemm_phase<i8>(Fp.lds, p, S, E); }
            GRID_BAR();
            SC_AFTER_GU(l);
            {   PHASE();
                ProbSimple p{DFF, DFF * 2, DFF * 2, (const char*)ACT_, (const char*)FWS(bf16_t, WS_WFFN + WF_D)}; pg8::StaticOrder S; S.init(T / 256, DM / 256, Fp.G, bx);
                EpiResid E{X_, X_}; pg8::gemm_phase(Fp.lds, p, S, E); }
            GRID_BAR();
            SC_AFTER_DOWN(l);
        } else {
            {   PHASE(); norm_router_phase(Fp, X_, Fp.in[I_GFFN] + l * DM, Fp.in[I_WR] + (size_t)(l >> 1) * DM * NE, GU_I8(l) != 0); }
            GRID_BAR();
            {   PHASE(); moe_assign_phase(Fp, GU_I8(l) != 0); }
            GRID_BAR();
            SC_AFTER_ROUTE(l);
            {   constexpr int half = 0; (void)half;
                {   PHASE();
                    const int nrt = TEXP_[MAXRT];
                    constexpr bool i8 = GU_I8(l) != 0; constexpr unsigned eb = i8 ? 1 : 2;
                    ProbMoe p{DM, DM * eb, DM * eb, (const char*)ASORT_, (const char*)FWS(bf16_t, WS_WFFN + WF_GU), 0}; MoeOrder S; S.base.init(nrt, 2 * DFF / 256, Fp.G, bx); S.lo = 0; S.texp = TEXP_;
                    EpiSwiglu E{ACT_, 0, ASC_, WSGU_}; pg8::gemm_phase<i8>(Fp.lds, p, S, E); }
                GRID_BAR();
                SC_AFTER_MOEGU(l, half);
                {   PHASE();
                    const int nrt = TEXP_[MAXRT];
                    ProbMoe p{DFF, DFF * 2, DFF * 2, (const char*)ACT_, (const char*)FWS(bf16_t, WS_WFFN + WF_D), 0}; MoeOrder S; S.base.init(nrt, DM / 256, Fp.G, bx); S.lo = 0; S.texp = TEXP_;
                    EpiYout E{YOUT_}; pg8::gemm_phase(Fp.lds, p, S, E); }
                GRID_BAR();
                SC_AFTER_MOED(l, half);
            }
        }
    }

__global__ void __launch_bounds__(NWAVES * 64, 2) fwd(Args args) {
    extern __shared__ __attribute__((aligned(16))) unsigned char lds_raw[];
    Frame F;
    F.lds = (LAS unsigned char*)lds_raw;
    F.MISC = (volatile LAS unsigned*)(F.lds + LDSCTL_OFF);
    F.tid = threadIdx.x; F.lane = F.tid & 63; F.wave = __builtin_amdgcn_readfirstlane(F.tid >> 6);
    F.G = gridDim.x; { const int bx = blockIdx.x; F.vcu = (F.G % 8 == 0) ? (bx % 8) * (F.G / 8) + bx / 8 : bx; }
    F.ws = args.ws; F.ctl = (gu32*)(args.ws + WS_CTL); F.out = args.out;
    F.in = (const float* const*)__builtin_amdgcn_kernarg_segment_ptr();
    for (int u = F.tid; u < (LDS_BYTES - LDSCTL_OFF) / 4; u += NWAVES * 64) ((LAS unsigned*)(F.lds + LDSCTL_OFF))[u] = 0u;
    __syncthreads();
    XcdBarrier bar = xcd_barrier_post((unsigned*)(F.ctl + CW_BAR), F.MISC + 8);

    const int bx = (int)blockIdx.x;

    {   PHASE();
        prep_mixer_weights(Fp);
        memnorm_phase(Fp);
        prep_ffn_weights(Fp, 0);
        norm_phase(Fp, Fp.in[I_X], nullptr, Fp.in[I_GMIX], false, true); }
    GRID_BAR();
    SC_AFTER_PROLOGUE();

    layer_body<0>(F, bar, bx); layer_body<1>(F, bar, bx); layer_body<2>(F, bar, bx); layer_body<3>(F, bar, bx);
    {   PHASE(); final_norm_phase(Fp, X_, Fp.in[I_GFIN], true); }
    SC_FINAL();
}

extern "C" void kernel_launch(void* const* d_in, const int* in_sizes, int n_in, void* d_out, int out_size, void* d_ws, size_t ws_size, hipStream_t stream) {
    static int grid = 0;
    if (grid == 0) {
        if (n_in != 23 || out_size != T * DM || ws_size < WS_END) { fprintf(stderr, "kernel_launch: unexpected problem (n_in %d, out %d, ws %zu < %zu)\n", n_in, out_size, ws_size, (size_t)WS_END); grid = -1; return; }
        int dev = 0, cus = 0;
        if (hipGetDevice(&dev) != hipSuccess || hipDeviceGetAttribute(&cus, hipDeviceAttributeMultiprocessorCount, dev) != hipSuccess) { grid = -1; return; }
        if (hipFuncSetAttribute((const void*)fwd, hipFuncAttributeMaxDynamicSharedMemorySize, LDS_BYTES) != hipSuccess) { fprintf(stderr, "kernel_launch: hipFuncSetAttribute failed\n"); grid = -1; return; }
        int per_cu = 0;
        if (hipOccupancyMaxActiveBlocksPerMultiprocessor(&per_cu, (const void*)fwd, NWAVES * 64, LDS_BYTES) != hipSuccess || per_cu < 1) fprintf(stderr, "kernel_launch: occupancy query says %d\n", per_cu);
        (void)hipGetLastError();
        grid = cus;
    }
    if (grid < 0) return;
    if (hipMemsetAsync((char*)d_ws + WS_CTL, 0, CTL_ZERO_BYTES, stream) != hipSuccess) return;
    Args a{};
    for (int i = 0; i < 23; ++i) a.in[i] = (const float*)d_in[i];
    a.out = (float*)d_out; a.ws = (unsigned char*)d_ws;
    hipLaunchKernelGGL(fwd, dim3(grid), dim3(NWAVES * 64), LDS_BYTES, stream, a);
}
```

```cpp
#include <hip/hip_runtime.h>
#include <cstdio>
#include <cstdint>

#ifndef SELFCHECK
#define SELFCHECK 0
#endif
#ifndef GU_I8_MASK
#define GU_I8_MASK 0xF
#endif
#define GU_I8(l) ((((unsigned)GU_I8_MASK) >> (l)) & 1u)

#define GAS __attribute__((address_space(1)))
#define LAS __attribute__((address_space(3)))
typedef unsigned short bf16_t;
typedef short bf16x8 __attribute__((ext_vector_type(8)));
typedef short s16x4 __attribute__((ext_vector_type(4)));
typedef short v4i16_t __attribute__((ext_vector_type(4)));
typedef float f32x2 __attribute__((ext_vector_type(2)));
typedef float f32x4 __attribute__((ext_vector_type(4)));
typedef float f32x16 __attribute__((ext_vector_type(16)));
typedef unsigned u32x2 __attribute__((ext_vector_type(2)));
typedef unsigned u32x4 __attribute__((ext_vector_type(4)));
typedef int i32x4 __attribute__((ext_vector_type(4)));
typedef GAS unsigned gu32;
#define RLX_AGENT __ATOMIC_RELAXED, __HIP_MEMORY_SCOPE_AGENT

constexpr int NB = 8, SEQ = 4096, T = NB * SEQ, DM = 1024, DEPTH = 4, MEML = 256, DFF = 3584, NE = 8;
constexpr int INW = 4768;
constexpr int PW = 1792;
constexpr int GW = 3072;
constexpr int QBW = 768, KVW = 1024, YW = 1536;
constexpr int NT_IN = 19;
constexpr int P_QA = 0, P_KA = 512, P_VA = 640, P_CQ = 768, P_CKV = 1024, P_KR = 1152, P_QM = 1280;
constexpr int UPK = 384, UPN = 1792;
constexpr int MAXSLOT = 67584;
constexpr int MAXRT = MAXSLOT / 256;
constexpr int HALF_RT = 132;
constexpr float EPS = 1e-6f;
constexpr float LOG2E = 1.4426950408889634f;
constexpr float C_A = 0.125f * LOG2E;
constexpr float C_B = 0.10206207261596575f * LOG2E;
constexpr float C_M = 0.08838834764831845f * LOG2E;

constexpr size_t MiB = 1u << 20;
constexpr size_t WS_CTL = 0, CTL_ZERO_BYTES = 1 * MiB;
constexpr size_t WS_MISC = 1 * MiB;
constexpr size_t WL_IN = 0, WL_UP = (size_t)NT_IN * 256 * DM * 2, WL_BR = WL_UP + (size_t)UPN * UPK * 2, WL_OUT = WL_BR + (size_t)3 * DM * 512 * 2, WL_SIZE = WL_OUT + (size_t)DM * DM * 2;
constexpr size_t WS_WMIX = 8 * MiB;
constexpr size_t WS_WMKV = WS_WMIX + 4 * ((WL_SIZE + MiB - 1) / MiB) * MiB;
constexpr size_t WL_STRIDE = ((WL_SIZE + MiB - 1) / MiB) * MiB;
constexpr size_t WS_WFFN = WS_WMKV + 8 * MiB;
constexpr size_t WF_GU = 0, WF_D = (size_t)2 * DFF * DM * 2, WF_STRIDE = WF_D + (size_t)DM * DFF * 2;
constexpr size_t WS_H = WS_WFFN + 8 * WF_STRIDE;
constexpr size_t WS_MEMN = WS_H + (size_t)T * DM * 2;
constexpr size_t WS_MEMKV = WS_MEMN + (size_t)NB * MEML * DM * 2;
constexpr size_t WS_R = WS_MEMKV + (size_t)NB * MEML * 4096 * 2;
constexpr size_t R_P = 0, R_G = R_P + (size_t)T * PW * 2, R_QB = R_G + (size_t)T * GW * 2, R_KVB = R_QB + (size_t)T * QBW * 2, R_Y = R_KVB + (size_t)T * KVW * 2, R_END_MIX = R_Y + (size_t)T * YW * 2;
constexpr size_t R_BRS = R_P;
constexpr size_t R_ACT = 0;
constexpr size_t R_ASORT = (size_t)MAXSLOT * DFF * 2;
constexpr size_t R_YOUT = R_ASORT;
constexpr size_t R_END_FFN = R_YOUT + (size_t)MAXSLOT * DM * 2;
constexpr size_t R_SIZE = R_END_MIX > R_END_FFN ? R_END_MIX : R_END_FFN;
constexpr size_t WS_END = WS_R + R_SIZE;
static_assert(WS_END < 1020ull * MiB, "workspace budget");
constexpr size_t MS_TOKE = 0;
constexpr size_t MS_TOKW = MS_TOKE + (size_t)T * 8;
constexpr size_t MS_SLOT = MS_TOKW + (size_t)T * 8;
constexpr size_t MS_CNT = MS_SLOT + (size_t)T * 8;
constexpr size_t MS_TEXP = MS_CNT + 256 * 8 * 4;
constexpr size_t MS_SSQ = MS_TEXP + 2048;
constexpr size_t MS_SNAP = MS_SSQ + (size_t)T * 32;
constexpr size_t MS_HSC = MS_SNAP + 64 * 1024 * 4;
constexpr size_t MS_ASC = MS_HSC + (size_t)T * 4;
constexpr size_t MS_WSIN = MS_ASC + (size_t)MAXSLOT * 4;
constexpr size_t MS_WSGU = MS_WSIN + (size_t)4 * NT_IN * 256 * 4;
constexpr size_t MS_END = MS_WSGU + (size_t)8 * 2 * DFF * 4;
static_assert(MS_END <= 7 * MiB, "misc map");
constexpr int CW_BAR = 4096;
constexpr int CW_DIAG = 16384;
constexpr int CW_CODE = 16384 + 512;

constexpr int RING_BYTES = 131072;
constexpr int LDSCTL_OFF = RING_BYTES;
constexpr int LDS_BYTES = 147456;
constexpr int NWAVES = 8;

#define LDS_WAIT() asm volatile("s_waitcnt lgkmcnt(0)" ::: "memory")
#define VM_WAIT() asm volatile("s_waitcnt vmcnt(0)" ::: "memory")

__device__ __forceinline__ unsigned f2bf(float f) { unsigned u = __builtin_bit_cast(unsigned, f); return (u + 0x7fffu + ((u >> 16) & 1u)) >> 16; }
__device__ __forceinline__ unsigned pk2(float lo, float hi) { return f2bf(lo) | (f2bf(hi) << 16); }
__device__ __forceinline__ float bf2f(unsigned short b) { return __builtin_bit_cast(float, (unsigned)b << 16); }
__device__ __forceinline__ float bflo(unsigned w) { return __builtin_bit_cast(float, w << 16); }
__device__ __forceinline__ float bfhi(unsigned w) { return __builtin_bit_cast(float, w & 0xffff0000u); }
typedef __bf16 bf16x2_t __attribute__((ext_vector_type(2)));
__device__ __forceinline__ unsigned cvtpk(float lo, float hi) { f32x2 v = {lo, hi}; bf16x2_t b = __builtin_convertvector(v, bf16x2_t); return __builtin_bit_cast(unsigned, b); }
__device__ __forceinline__ float wave_sum(float v) {
#pragma unroll
    for (int o = 1; o < 64; o <<= 1) v += __shfl_xor(v, o);
    return v;
}
__device__ __forceinline__ float fast_sigmoid(float x) { return __builtin_amdgcn_rcpf(1.0f + __builtin_amdgcn_exp2f(-x * LOG2E)); }


__device__ __forceinline__ int opq_v(int x) { asm volatile("" : "+v"(x)); return x; }
__device__ __forceinline__ int opq_s(int x) { asm volatile("" : "+s"(x)); return x; }
template <class Tp> __device__ __forceinline__ Tp* opq_p(Tp* p) { const unsigned long long u = (unsigned long long)p; unsigned lo = __builtin_amdgcn_readfirstlane((unsigned)u), hi = __builtin_amdgcn_readfirstlane((unsigned)(u >> 32)); asm volatile("" : "+s"(lo), "+s"(hi)); return (Tp*)(((unsigned long long)hi << 32) | lo); }

__constant__ float IFR_HI[32] = {1.591549367e-01f, 1.193493679e-01f, 8.949939907e-02f, 6.711508334e-02f, 5.032921210e-02f, 3.774158657e-02f, 2.830219641e-02f, 2.122365311e-02f, 1.591549441e-02f, 1.193493698e-02f, 8.949940093e-03f, 6.711508147e-03f, 5.032921210e-03f, 3.774158424e-03f, 2.830219688e-03f, 2.122365171e-03f, 1.591549488e-03f, 1.193493721e-03f, 8.949940093e-04f, 6.711508031e-04f, 5.032921326e-04f, 3.774158540e-04f, 2.830219455e-04f, 2.122365258e-04f, 1.591549371e-04f, 1.193493736e-04f, 8.949940093e-05f, 6.711508468e-05f, 5.032921035e-05f, 3.774158540e-05f, 2.830219637e-05f, 2.122365186e-05f};
__constant__ float IFR_LO[32] = {6.420638243e-09f, 2.294664903e-09f, 2.542919653e-09f, -3.316028840e-10f, 5.173299289e-12f, -1.848551645e-09f, -5.826552019e-10f, -3.431038786e-10f, -1.029942243e-10f, 4.320196978e-11f, 6.802745173e-11f, 1.531042237e-10f, 5.173301024e-13f, 4.797548470e-11f, -1.048316434e-10f, 1.053879969e-10f, -5.686555046e-11f, -1.896286773e-11f, 6.802744999e-12f, 2.695195456e-11f, -1.158979943e-11f, -6.843983713e-12f, 1.279990003e-11f, 1.807650600e-12f, 5.954976963e-12f, -3.351478166e-12f, 6.802745216e-13f, -1.670379113e-12f, 1.751403167e-12f, -6.843983930e-13f, -5.389994549e-13f, 9.083608431e-13f};
__device__ __forceinline__ void rot_cs(float posf, int idx, float& c, float& s) {
    const float ch = IFR_HI[idx], cl = IFR_LO[idx];
    const float p = posf * ch, e = __builtin_fmaf(posf, ch, -p);
    const float fr = __builtin_amdgcn_fractf(p) + (e + posf * cl);
    s = __builtin_amdgcn_sinf(fr); c = __builtin_amdgcn_cosf(fr);
}

#define XB_TMO      128
#define XB_XCNT(j)  (256  + 64 * (j))
#define XB_XSUB(j)  (1280 + 64 * (j))
#define XB_XGEN(j)  (2304 + 64 * (j))
#define XB_TOP      3328
#define XB_TOPGEN   3392
#define XCD_BAR_WORDS 3456
#define XB_SPIN_CAP (1u << 20)

__device__ __forceinline__ unsigned xb_ld(unsigned* p)              { return __hip_atomic_load(p, __ATOMIC_RELAXED, __HIP_MEMORY_SCOPE_AGENT); }
__device__ __forceinline__ unsigned xb_add(unsigned* p, unsigned v) { return __hip_atomic_fetch_add(p, v, __ATOMIC_RELAXED, __HIP_MEMORY_SCOPE_AGENT); }
__device__ __forceinline__ unsigned xb_xcc_id() { return (unsigned)__builtin_amdgcn_s_getreg((3 << 11) | 20) & 0xFu; }
#define XB_SPIN(cond, bar) do { unsigned _sp = 0; while (cond) { __builtin_amdgcn_s_sleep(1); \
    if ((++_sp & 255u) == 0u) { if (xb_ld(&(bar)[XB_TMO])) break; if (_sp > XB_SPIN_CAP) { atomicAdd(&(bar)[XB_TMO], 1u); break; } } } } while (0)

struct XcdBarrier { unsigned* bar; unsigned x; volatile LAS unsigned* st; };

__device__ __forceinline__ XcdBarrier xcd_barrier_post(unsigned* bar, volatile LAS unsigned* st) {
    XcdBarrier b; b.bar = bar; b.x = xb_xcc_id(); b.st = st;
    if (threadIdx.x == 0) (void)xb_add(&bar[XB_XCNT(b.x)], 1u);
    return b;
}
__device__ __forceinline__ void xcd_barrier_complete(unsigned* bar, unsigned x, unsigned& nloc, unsigned& nx) {
    const unsigned G = gridDim.x * gridDim.y * gridDim.z;
    unsigned sum, cnt, mine, sp = 0u;
    for (;;) {
        sum = 0u; cnt = 0u; mine = 0u;
#pragma unroll
        for (unsigned j = 0; j < 16; ++j) { const unsigned c = xb_ld(&bar[XB_XCNT(j)]); sum += c; cnt += (c > 0u) ? 1u : 0u; mine = (j == x) ? c : mine; }
        if (sum == G) break;
        __builtin_amdgcn_s_sleep(1);
        if ((++sp & 255u) == 0u) { if (xb_ld(&bar[XB_TMO])) break; if (sp > XB_SPIN_CAP) { atomicAdd(&bar[XB_TMO], 1u); break; } }
    }
    nloc = mine > 0u ? mine : 1u; nx = cnt > 0u ? cnt : 1u;
}
__device__ __forceinline__ void xcd_barrier(const XcdBarrier& b) {
    asm volatile("s_waitcnt vmcnt(0)" ::: "memory");
    __syncthreads();
    if (threadIdx.x == 0) {
        unsigned* bar = b.bar;
        __builtin_amdgcn_s_waitcnt(0);
        unsigned nloc = b.st[0], nx = b.st[1];
        if (nloc == 0u) { xcd_barrier_complete(bar, b.x, nloc, nx); b.st[0] = nloc; b.st[1] = nx; }
        const unsigned old = xb_add(&bar[XB_XSUB(b.x)], 1u);
        const unsigned gen = old / nloc;
        if (old + 1u == (gen + 1u) * nloc) {
            __builtin_amdgcn_fence(__ATOMIC_RELEASE, "agent");
            asm volatile("s_waitcnt vmcnt(0)" ::: "memory");
            const unsigned og = xb_add(&bar[XB_TOP], 1u);
            const unsigned tg = og / nx;
            if (og + 1u == (tg + 1u) * nx) xb_add(&bar[XB_TOPGEN], 1u);
            else XB_SPIN(xb_ld(&bar[XB_TOPGEN]) == tg, bar);
            __builtin_amdgcn_fence(__ATOMIC_ACQUIRE, "agent");
            xb_add(&bar[XB_XGEN(b.x)], 1u);
            asm volatile("s_waitcnt vmcnt(0)" ::: "memory");
        } else {
            XB_SPIN(xb_ld(&bar[XB_XGEN(b.x)]) == gen, bar);
            __builtin_amdgcn_fence(__ATOMIC_ACQUIRE, "agent");
            asm volatile("s_waitcnt vmcnt(0)" ::: "memory");
        }
    }
    __syncthreads();
}

namespace pg8 {
constexpr int BM = 256, BK = 64, HALF = 128, HTB = HALF * BK * 2, STAGE_BYTES = 8 * HTB, NXCD = 8, WGM = 4;
constexpr int ESC_OFF = 131072 + 4096, ESC_SLOT = 3072;
__host__ __device__ __forceinline__ int lds_byte(int r, int c) { const int st = (r >> 4) * 2 + (c >> 5), rr = r & 15, cc = c & 31, ob = rr * 64 + cc * 2; return st * 1024 + (ob ^ (((ob >> 9) & 1) << 5)); }
__host__ __device__ __forceinline__ void stage_rc(int b, int& R, int& C) { const int st = b / 1024, sb = b % 1024, swz = sb ^ (((sb >> 9) & 1) << 5); R = (st >> 1) * 16 + swz / 64; C = (st & 1) * 32 + (swz % 64) / 2; }

struct Unit { int pm, pn, aux; };

struct StaticOrder {
    int nM, nN, nwg, G, c;
    __device__ void init(int nM_, int nN_, int G_, int c_) { nM = nM_; nN = nN_; nwg = nM * nN; G = G_; c = c_; }
    __device__ bool next(int i, Unit& u) const {
        const long L = (long)i * G + c; if (L >= nwg) return false;
        int wgid = (int)L; { const int q = nwg / NXCD, r = nwg % NXCD, xcd = wgid % NXCD, off = wgid / NXCD; wgid = (xcd < r ? xcd * (q + 1) : r * (q + 1) + (xcd - r) * q) + off; }
        const int nig = WGM * nN, gid = wgid / nig, fm = gid * WGM, gsz = (nM - fm) < WGM ? (nM - fm) : WGM;
        u.pm = fm + ((wgid % nig) % gsz); u.pn = (wgid % nig) / gsz; u.aux = 0; return true;
    }
};

template <bool I8> struct AccVec { typedef f32x4 type; };
template <> struct AccVec<true> { typedef i32x4 type; };
template <bool I8 = false, class Prob, class Sched, class Epi>
__device__ __forceinline__ void gemm_phase(LAS unsigned char* lds, const Prob& P, const Sched& S, const Epi& E) {
    const int tid = opq_v((int)threadIdx.x), wid = __builtin_amdgcn_readfirstlane(tid >> 6), lane = tid & 63, wr = wid >> 2, wc = wid & 3, fr = lane & 15, fq = lane >> 4;
    typedef typename AccVec<I8>::type accv_t;
    const int K = P.K, nt = K / (I8 ? 2 * BK : BK);
    unsigned voffA[2], voffB[2];
#pragma unroll
    for (int i = 0; i < 2; ++i) { int R, C; stage_rc(tid * 16 + i * 8192, R, C); voffA[i] = (unsigned)R * P.lda + (unsigned)C * 2u; voffB[i] = (unsigned)R * P.ldb + (unsigned)C * 2u; }
    const size_t kstep = (size_t)(BK * 2);
    const size_t hstepA = (size_t)HALF * P.lda, hstepB = (size_t)HALF * P.ldb;
    const unsigned ldsw = (unsigned)wid * 1024u;
    const int aoff = lds_byte(wr * 64 + fr, fq * 8), boff = lds_byte(wc * 32 + fr, fq * 8);
#define PG8_SA(b, h) (((b) * 2 + (h)) * HTB)
#define PG8_SB(b, h) ((4 + (b) * 2 + (h)) * HTB)
#define PG8_STAGE(bufoff, gbase, voff) do { _Pragma("unroll") for (int _i = 0; _i < 2; ++_i) \
        __builtin_amdgcn_global_load_lds((const unsigned*)((const char*)(gbase) + (voff)[_i]), (LAS unsigned*)(lds + (bufoff) + ldsw + _i * 8192), 16, 0, 0); } while (0)
#define PG8_LDA(dst, b, h) do { _Pragma("unroll") for (int m = 0; m < 4; ++m) _Pragma("unroll") for (int k = 0; k < 2; ++k) dst[m][k] = *(const LAS bf16x8*)(lds + PG8_SA(b, h) + aoff + m * 2048 + k * 1024); } while (0)
#define PG8_LDB(dst, b, h) do { _Pragma("unroll") for (int n = 0; n < 2; ++n) _Pragma("unroll") for (int k = 0; k < 2; ++k) dst[n][k] = *(const LAS bf16x8*)(lds + PG8_SB(b, h) + boff + n * 2048 + k * 1024); } while (0)
#define PG8_MMA(ai, bj, At, Bt) do { __builtin_amdgcn_s_setprio(1); _Pragma("unroll") for (int m = 0; m < 4; ++m) _Pragma("unroll") for (int n = 0; n < 2; ++n) _Pragma("unroll") for (int k = 0; k < 2; ++k) \
        { if constexpr (I8) acc[ai][bj][m][n] = __builtin_amdgcn_mfma_i32_16x16x64_i8(__builtin_bit_cast(i32x4, Bt[n][k]), __builtin_bit_cast(i32x4, At[m][k]), acc[ai][bj][m][n], 0, 0, 0); \
          else acc[ai][bj][m][n] = __builtin_amdgcn_mfma_f32_16x16x32_bf16(Bt[n][k], At[m][k], acc[ai][bj][m][n], 0, 0, 0); } __builtin_amdgcn_s_setprio(0); } while (0)
#define PG8_WAIT_V(n) asm volatile("s_waitcnt vmcnt(" #n ")" ::: "memory")
#define PG8_WAIT_L(n) asm volatile("s_waitcnt lgkmcnt(" #n ")" ::: "memory")
#define PG8_BAR __builtin_amdgcn_s_barrier()
#define PG8_SCHED __builtin_amdgcn_sched_barrier(0)
    Unit cur, nxt; int ui = 0;
    if (!S.next(0, cur)) return;
    accv_t acc[2][2][4][2];
#pragma unroll
    for (int a = 0; a < 2; ++a)
#pragma unroll
        for (int b = 0; b < 2; ++b)
#pragma unroll
            for (int m = 0; m < 4; ++m)
#pragma unroll
                for (int n = 0; n < 2; ++n) acc[a][b][m][n] = accv_t{};
    bf16x8 At[4][2], B0[2][2], B1[2][2];
    const char* cA = P.a_ptr(cur); const char* cB = P.b_ptr(cur);
    int eslot = 0;
    E.stage(lds + ESC_OFF, cur, wid, lane);
    PG8_STAGE(PG8_SB(0, 0), cB, voffB); PG8_STAGE(PG8_SB(0, 1), cB + hstepB, voffB); PG8_STAGE(PG8_SA(0, 0), cA, voffA); PG8_STAGE(PG8_SA(0, 1), cA + hstepA, voffA);
    if (wr == 1) PG8_BAR;
    PG8_WAIT_V(2); PG8_BAR;
    PG8_STAGE(PG8_SB(1, 0), cB + kstep, voffB); PG8_STAGE(PG8_SA(1, 0), cA + kstep, voffA); PG8_STAGE(PG8_SB(1, 1), cB + hstepB + kstep, voffB);
    PG8_WAIT_V(6); PG8_BAR;
    for (;;) {
        const bool has_next = S.next(ui + 1, nxt);
        const char* nA = has_next ? P.a_ptr(nxt) : cA; const char* nB = has_next ? P.b_ptr(nxt) : cB;
        for (int t = 0; t < nt; t += 2) {
            if constexpr (Epi::MID) { if (t == 8 || t == 16) E.mid(acc, cur, t >> 3, wr, wc, fr, fq); }
            const bool last = (t == nt - 2);
            if (last && has_next) E.stage(lds + ESC_OFF + (eslot ^ 1) * ESC_SLOT, nxt, wid, lane);
            const char* a1 = cA + (size_t)(t + 1) * kstep;
            const char* a2 = last ? nA : cA + (size_t)(t + 2) * kstep; const char* b2 = last ? nB : cB + (size_t)(t + 2) * kstep;
            const char* a3 = a2 + kstep; const char* b3 = b2 + kstep;
            PG8_LDB(B0, 0, 0); PG8_LDB(B1, 0, 1); PG8_SCHED; PG8_LDA(At, 0, 0); PG8_STAGE(PG8_SA(1, 1), a1 + hstepA, voffA);
            PG8_WAIT_V(8); PG8_WAIT_L(0); PG8_BAR; PG8_MMA(0, 0, At, B0); PG8_MMA(0, 1, At, B1); PG8_BAR; PG8_SCHED;
            PG8_LDA(At, 0, 1); PG8_STAGE(PG8_SB(0, 0), b2, voffB); PG8_STAGE(PG8_SB(0, 1), b2 + hstepB, voffB); PG8_STAGE(PG8_SA(0, 0), a2, voffA);
            PG8_WAIT_V(8); PG8_WAIT_L(0); PG8_BAR; PG8_MMA(1, 0, At, B0); PG8_MMA(1, 1, At, B1); PG8_BAR; PG8_SCHED;
            PG8_LDB(B0, 1, 0); PG8_LDB(B1, 1, 1); PG8_SCHED; PG8_LDA(At, 1, 0); PG8_STAGE(PG8_SA(0, 1), a2 + hstepA, voffA);
            PG8_WAIT_V(8); PG8_WAIT_L(0); PG8_BAR; PG8_MMA(0, 0, At, B0); PG8_MMA(0, 1, At, B1); PG8_BAR; PG8_SCHED;
            PG8_LDA(At, 1, 1); PG8_STAGE(PG8_SB(1, 0), b3, voffB); PG8_STAGE(PG8_SB(1, 1), b3 + hstepB, voffB); PG8_STAGE(PG8_SA(1, 0), a3, voffA);
            PG8_WAIT_V(8); PG8_WAIT_L(0); PG8_BAR; PG8_MMA(1, 0, At, B0); PG8_MMA(1, 1, At, B1); PG8_BAR; PG8_SCHED;
        }
        if (wr == 0) PG8_BAR;
        E(acc, cur, wr, wc, fr, fq, lds + ESC_OFF + eslot * ESC_SLOT);
        if (!has_next) break;
#pragma unroll
        for (int a = 0; a < 2; ++a)
#pragma unroll
            for (int b = 0; b < 2; ++b)
#pragma unroll
                for (int m = 0; m < 4; ++m)
#pragma unroll
                    for (int n = 0; n < 2; ++n) acc[a][b][m][n] = accv_t{};
        cur = nxt; cA = nA; cB = nB; ++ui; eslot ^= 1;
        if (wr == 1) PG8_BAR;
    }
    PG8_WAIT_V(0);
    PG8_BAR;
#undef PG8_SA
#undef PG8_SB
#undef PG8_STAGE
#undef PG8_LDA
#undef PG8_LDB
#undef PG8_MMA
#undef PG8_WAIT_V
#undef PG8_WAIT_L
#undef PG8_BAR
#undef PG8_SCHED
}
}

struct Frame {
    LAS unsigned char* lds;
    volatile LAS unsigned* MISC;
    gu32* ctl;
    unsigned char* ws;
    int tid, lane, wave, vcu, G;
    const float* const* in; float* out;
};
enum { I_X = 0, I_MEM, I_POS, I_GMIX, I_WIN, I_GQ, I_WUQ, I_GKV, I_WUKV, I_SINK, I_WMKV, I_WBR, I_WOUT, I_GFFN, I_WGD, I_WUD, I_WDD, I_WR, I_WGE, I_WUE, I_WDE, I_GMEM, I_GFIN };

__device__ __forceinline__ int sem_plain(int g) { return (g & ~31) + 8 * ((g >> 2) & 3) + 4 * ((g >> 4) & 1) + (g & 3); }
__device__ __forceinline__ int sem_rot64(int g) { return (g & ~63) + 32 * ((g >> 4) & 1) + 16 * ((g >> 5) & 1) + 4 * ((g >> 2) & 3) + (g & 3); }
__device__ __forceinline__ int inproj_src(int n) {
    const int pn = n >> 8, c = n & 255;
    if (pn < 2) return pn * 256 + sem_rot64(c);
    if (pn == 2) return c < 128 ? 512 + sem_rot64(c) : 640 + sem_plain(c - 128);
    if (pn == 3) return 768 + sem_plain(c);
    if (pn == 4) return c < 128 ? 1024 + sem_plain(c) : (c < 160 ? 1152 + (c - 128) : -1);
    if (pn < 7) return 1184 + (pn - 5) * 256 + sem_plain(c);
    return 1696 + (pn - 7) * 256 + sem_plain(c);
}

struct MapInproj { const float* W; __device__ __forceinline__ float load(int k, int n) const { const int s = inproj_src(n); return s >= 0 ? W[(size_t)k * INW + s] : 0.f; }
    __device__ __forceinline__ f32x4 load4(int k, int n) const { const int s = inproj_src(n); return s >= 0 ? *(const f32x4*)(W + (size_t)k * INW + s) : (f32x4){0.f, 0.f, 0.f, 0.f}; } };
struct MapUp { const float *Wq, *Wkv, *gq, *gkv;
    __device__ __forceinline__ f32x4 load4(int k, int n) const {
        if (n < 768) { if (k >= 256) return (f32x4){0.f, 0.f, 0.f, 0.f}; const int gg = n >> 5; const int s = (gg % 3 == 2) ? n : sem_plain(n); return *(const f32x4*)(Wq + (size_t)k * 768 + s) * gq[k]; }
        if (k < 256) return (f32x4){0.f, 0.f, 0.f, 0.f}; const int s = sem_plain(n - 768); return *(const f32x4*)(Wkv + (size_t)(k - 256) * 1024 + s) * gkv[k - 256]; }
    __device__ __forceinline__ float load(int k, int n) const {
        if (n < 768) { if (k >= 256) return 0.f; const int gg = n >> 5; const int s = (gg % 3 == 2) ? n : sem_plain(n); return gq[k] * Wq[(size_t)k * 768 + s]; }
        if (k < 256) return 0.f; const int s = sem_plain(n - 768); return gkv[k - 256] * Wkv[(size_t)(k - 256) * 1024 + s]; } };
struct MapPlain { const float* W; int ldw; __device__ __forceinline__ float load(int k, int n) const { return W[(size_t)k * ldw + sem_plain(n)]; }
    __device__ __forceinline__ f32x4 load4(int k, int n) const { return *(const f32x4*)(W + (size_t)k * ldw + sem_plain(n)); } };
struct MapNat { const float* W; int ldw; __device__ __forceinline__ float load(int k, int n) const { return W[(size_t)k * ldw + n]; }
    __device__ __forceinline__ f32x4 load4(int k, int n) const { return *(const f32x4*)(W + (size_t)k * ldw + n); } };
struct MapBr { const float* W;
    __device__ __forceinline__ float load(int k, int n) const { return W[(size_t)k * DM + sem_plain(n)]; }
    __device__ __forceinline__ f32x4 load4(int k, int n) const { return *(const f32x4*)(W + (size_t)k * DM + sem_plain(n)); } };
struct MapMemkv { const float* W; __device__ __forceinline__ float load(int k, int n) const { const int l = n >> 10, c = n & 1023; return W[((size_t)l * DM + k) * 1024 + sem_plain(c)]; }
    __device__ __forceinline__ f32x4 load4(int k, int n) const { const int l = n >> 10, c = n & 1023; return *(const f32x4*)(W + ((size_t)l * DM + k) * 1024 + sem_plain(c)); } };
struct MapGU { const float *Wg, *Wu; __device__ __forceinline__ float load(int k, int n) const { const int pn = n >> 8, c = n & 255; const int ch = 128 * pn + sem_plain(c & 127);
    const unsigned long long a = (unsigned long long)Wg, b = (unsigned long long)Wu, w = a ^ ((a ^ b) & (0ull - (unsigned long long)(c >> 7))); return ((const float*)w)[(size_t)k * DFF + ch]; }
    __device__ __forceinline__ f32x4 load4(int k, int n) const { const int pn = n >> 8, c = n & 255; const int ch = 128 * pn + sem_plain(c & 127);
        const unsigned long long a = (unsigned long long)Wg, b = (unsigned long long)Wu, w = a ^ ((a ^ b) & (0ull - (unsigned long long)(c >> 7))); return *(const f32x4*)((const float*)w + (size_t)k * DFF + ch); } };

template <class M> __device__ __forceinline__ void prep_item(const M& m, bf16_t* dst, int Kd, int nblk, LAS float* scr, int item, int lane) {
    const int kb = item / nblk, nb = item % nblk, k0 = 64 * kb, n0 = 32 * nb;
#pragma unroll 8
    for (int i = 0; i < 32; ++i) { const int kk = 2 * i + (lane >> 5); scr[kk * 33 + (lane & 31)] = m.load(k0 + kk, n0 + (lane & 31)); }
    LDS_WAIT(); asm volatile("" ::: "memory");
    const int c = lane & 7;
#pragma unroll
    for (int j = 0; j < 4; ++j) { const int n = (lane >> 3) + 8 * j; const LAS float* s = scr + (8 * c) * 33 + n;
        u32x4 o; o.x = pk2(s[0 * 33], s[1 * 33]); o.y = pk2(s[2 * 33], s[3 * 33]); o.z = pk2(s[4 * 33], s[5 * 33]); o.w = pk2(s[6 * 33], s[7 * 33]);
        *(u32x4*)(dst + (size_t)(n0 + n) * Kd + k0 + 8 * c) = o; }
    LDS_WAIT(); asm volatile("" ::: "memory");
}
template <class M> __device__ __forceinline__ void prep_tile(const M& m, bf16_t* dst, int Kd, int nblk, LAS unsigned char* tile, int item, int lane) {
    const int kb = item / nblk, nb = item % nblk, k0 = 128 * kb, n0 = 32 * nb, ng = lane & 7, kr = lane >> 3;
    f32x4 v[16];
#pragma unroll
    for (int i = 0; i < 16; ++i) v[i] = m.load4(k0 + 8 * i + kr, n0 + 4 * ng);
#pragma unroll
    for (int i = 0; i < 16; ++i)
#pragma unroll
        for (int c = 0; c < 4; ++c) *(LAS unsigned short*)(tile + (4 * ng + c) * 272 + (8 * i + kr) * 2) = (unsigned short)f2bf(v[i][c]);
    LDS_WAIT(); asm volatile("" ::: "memory");
#pragma unroll
    for (int j = 0; j < 8; ++j) { const int p = lane + 64 * j, n = p >> 4, kc = p & 15;
        *(u32x4*)(dst + (size_t)(n0 + n) * Kd + k0 + 8 * kc) = *(const LAS u32x4*)(tile + n * 272 + 16 * kc); }
    LDS_WAIT(); asm volatile("" ::: "memory");
}
template <class M> __device__ __forceinline__ void prep_matrix(Frame& F, const M& m, bf16_t* dst, int N, int K) {
    LAS unsigned char* tile = F.lds + F.wave * 16384;
    const int gw = F.vcu * NWAVES + F.wave, NGW = F.G * NWAVES, nblk = N / 32, nitems = (K / 128) * nblk;
    for (int it = gw; it < nitems; it += NGW) prep_tile(m, dst, K, nblk, tile, it, F.lane);
}

template <class M> __device__ __forceinline__ void prep_strip_i8(Frame& F, const M& m, signed char* dst, float* scl, int strip) {
    const int lane = F.lane, w = F.wave, n0 = strip * 32, k0 = w * 128, ng = lane & 7, kr = lane >> 3;
    LAS unsigned char* tile = F.lds + w * 16384;
    LAS float* amt = (LAS float*)(F.lds + LDSCTL_OFF + 2048);
    f32x4 v[16];
#pragma unroll
    for (int i = 0; i < 16; ++i) v[i] = m.load4(k0 + 8 * i + kr, n0 + 4 * ng);
    f32x4 am = __builtin_elementwise_abs(v[0]);
#pragma unroll
    for (int i = 1; i < 16; ++i) am = __builtin_elementwise_max(am, __builtin_elementwise_abs(v[i]));
#pragma unroll
    for (int c = 0; c < 4; ++c) { float a = am[c]; a = fmaxf(a, __shfl_xor(a, 8)); a = fmaxf(a, __shfl_xor(a, 16)); a = fmaxf(a, __shfl_xor(a, 32)); am[c] = a; }
    if (kr == 0) *(LAS f32x4*)(amt + w * 32 + 4 * ng) = am;
    __syncthreads();
    f32x4 cm = *(const LAS f32x4*)(amt + 4 * ng);
#pragma unroll
    for (int ww = 1; ww < 8; ++ww) cm = __builtin_elementwise_max(cm, *(const LAS f32x4*)(amt + ww * 32 + 4 * ng));
    f32x4 inv;
#pragma unroll
    for (int c = 0; c < 4; ++c) inv[c] = cm[c] > 0.f ? 127.0f / cm[c] : 0.f;
    if (w == 0 && kr == 0) *(f32x4*)(scl + n0 + 4 * ng) = cm * (1.0f / 127.0f);
#pragma unroll
    for (int i = 0; i < 16; ++i)
#pragma unroll
        for (int c = 0; c < 4; ++c) tile[(4 * ng + c) * 144 + 8 * i + kr] = (unsigned char)(signed char)__float2int_rn(v[i][c] * inv[c]);
    LDS_WAIT(); asm volatile("" ::: "memory");
#pragma unroll
    for (int j = 0; j < 4; ++j) { const int p = lane + 64 * j, n = p >> 3, kc = p & 7;
        *(u32x4*)(dst + (size_t)(n0 + n) * DM + k0 + 16 * kc) = *(const LAS u32x4*)(tile + n * 144 + 16 * kc); }
    LDS_WAIT();
    __syncthreads();
}
__device__ __forceinline__ bf16_t* wmix(Frame& F, int l, size_t off) { return (bf16_t*)(F.ws + WS_WMIX + (size_t)l * WL_STRIDE + off); }

__device__ __forceinline__ void prep_mixer_weights(Frame& F) {
    for (int l = 0; l < DEPTH; ++l) {
        { MapInproj m{F.in[I_WIN] + (size_t)l * DM * INW}; for (int s = F.vcu; s < NT_IN * 8; s += F.G) prep_strip_i8(F, m, (signed char*)wmix(F, l, WL_IN), (float*)(F.ws + WS_MISC + MS_WSIN) + l * NT_IN * 256, s); }
        { MapUp m{F.in[I_WUQ] + (size_t)l * 256 * 768, F.in[I_WUKV] + (size_t)l * 128 * 1024, F.in[I_GQ] + l * 256, F.in[I_GKV] + l * 128}; prep_matrix(F, m, wmix(F, l, WL_UP), UPN, UPK); }
        { MapBr m{F.in[I_WBR] + (size_t)l * 3 * 512 * DM}; prep_matrix(F, m, wmix(F, l, WL_BR), DM, 1536); }
        { MapNat m{F.in[I_WOUT] + (size_t)l * DM * DM, DM}; prep_matrix(F, m, wmix(F, l, WL_OUT), DM, DM); }
    }
    { MapMemkv m{F.in[I_WMKV]}; prep_matrix(F, m, (bf16_t*)(F.ws + WS_WMKV), 4096, DM); }
}
__device__ __forceinline__ void prep_ffn_weights(Frame& F, int l) {
    const int i = l >> 1; const bool moe = (l & 1) != 0;
    LAS float* scr = (LAS float*)(F.lds + F.wave * 16384);
    const int gw = F.vcu * NWAVES + F.wave, NGW = F.G * NWAVES;
    constexpr int IGU = (DM / 64) * (2 * DFF / 32), ID = (DFF / 64) * (DM / 32), NSTRIP = 2 * DFF / 32;
    const int ne = moe ? NE : 1;
    const float* Wg = moe ? F.in[I_WGE] : F.in[I_WGD]; const float* Wu = moe ? F.in[I_WUE] : F.in[I_WUD]; const float* Wd = moe ? F.in[I_WDE] : F.in[I_WDD];
    if (GU_I8(l)) {
        for (int s = F.vcu; s < ne * NSTRIP; s += F.G) { const int e = s / NSTRIP, ss = s % NSTRIP; const size_t eo = ((size_t)i * ne + e) * DM * DFF;
            MapGU m{Wg + eo, Wu + eo}; prep_strip_i8(F, m, (signed char*)(F.ws + WS_WFFN + (size_t)e * WF_STRIDE), (float*)(F.ws + WS_MISC + MS_WSGU) + e * 2 * DFF, ss); }
    } else {
        for (int it = gw; it < ne * IGU; it += NGW) { const int e = it / IGU, r = it % IGU; const size_t eo = ((size_t)i * ne + e) * DM * DFF;
            MapGU m{Wg + eo, Wu + eo}; prep_item(m, (bf16_t*)(F.ws + WS_WFFN + (size_t)e * WF_STRIDE), DM, 2 * DFF / 32, scr, r, F.lane); }
    }
    constexpr int IDT = (DFF / 128) * (DM / 32);
    for (int it = gw; it < ne * IDT; it += NGW) { const int e = it / IDT, r = it % IDT; const size_t eo = ((size_t)i * ne + e) * DM * DFF;
        MapNat m{Wd + eo, DM}; prep_tile(m, (bf16_t*)(F.ws + WS_WFFN + (size_t)e * WF_STRIDE + WF_D), DFF, DM / 32, F.lds + F.wave * 16384, r, F.lane); }
}

struct RowV { f32x4 v[4]; };
__device__ __forceinline__ void row_load(RowV& r, const float* p, int lane) { const f32x4* x = (const f32x4*)p + lane;
#pragma unroll
    for (int j = 0; j < 4; ++j) r.v[j] = x[64 * j]; }
__device__ __forceinline__ void row_store(const RowV& r, float* p, int lane) { f32x4* x = (f32x4*)p + lane;
#pragma unroll
    for (int j = 0; j < 4; ++j) x[64 * j] = r.v[j]; }
__device__ __forceinline__ void row_add_bf16(RowV& r, const bf16_t* p, float w, int lane) { const u32x2* x = (const u32x2*)p + lane;
#pragma unroll
    for (int j = 0; j < 4; ++j) { const u32x2 q = x[64 * j]; r.v[j].x += w * bflo(q.x); r.v[j].y += w * bfhi(q.x); r.v[j].z += w * bflo(q.y); r.v[j].w += w * bfhi(q.y); } }
__device__ __forceinline__ float row_rstd(const RowV& r) { float s = 0.f;
#pragma unroll
    for (int j = 0; j < 4; ++j) s += (r.v[j].x * r.v[j].x + r.v[j].y * r.v[j].y) + (r.v[j].z * r.v[j].z + r.v[j].w * r.v[j].w);
    return 1.0f / sqrtf(wave_sum(s) * (1.0f / DM) + EPS); }
__device__ __forceinline__ void row_scale(RowV& r, float rstd, const float* g, int lane) { const f32x4* gg = (const f32x4*)g + lane;
#pragma unroll
    for (int j = 0; j < 4; ++j) r.v[j] = r.v[j] * rstd * gg[64 * j]; }
__device__ __forceinline__ void row_store_bf16(const RowV& r, bf16_t* p, int lane) { u32x2* o = (u32x2*)p + lane;
#pragma unroll
    for (int j = 0; j < 4; ++j) { u32x2 w; w.x = pk2(r.v[j].x, r.v[j].y); w.y = pk2(r.v[j].z, r.v[j].w); o[64 * j] = w; } }

__device__ __forceinline__ float row_store_i8(const RowV& r, signed char* p, int lane) {
    float am = 0.f;
#pragma unroll
    for (int j = 0; j < 4; ++j) am = fmaxf(am, fmaxf(fmaxf(fabsf(r.v[j].x), fabsf(r.v[j].y)), fmaxf(fabsf(r.v[j].z), fabsf(r.v[j].w))));
#pragma unroll
    for (int o = 1; o < 64; o <<= 1) am = fmaxf(am, __shfl_xor(am, o));
    const float inv = am > 0.f ? 127.0f / am : 0.f; unsigned* o4 = (unsigned*)p + lane;
#pragma unroll
    for (int j = 0; j < 4; ++j) { const unsigned a = (unsigned)__float2int_rn(r.v[j].x * inv) & 255u, b = (unsigned)__float2int_rn(r.v[j].y * inv) & 255u, c = (unsigned)__float2int_rn(r.v[j].z * inv) & 255u, d = (unsigned)__float2int_rn(r.v[j].w * inv) & 255u;
        o4[64 * j] = a | (b << 8) | (c << 16) | (d << 24); }
    return am * (1.0f / 127.0f);
}
__device__ __forceinline__ void row_combine(Frame& F, RowV& r, int t) {
    const int* sl = (const int*)(F.ws + WS_MISC + MS_SLOT) + 2 * t; const float* tw = (const float*)(F.ws + WS_MISC + MS_TOKW) + 2 * t;
    const bf16_t* Y = (const bf16_t*)(F.ws + WS_R + R_YOUT);
    const int s0 = sl[0], s1 = sl[1]; const float w0 = tw[0], w1 = tw[1];
    row_add_bf16(r, Y + (size_t)s0 * DM, w0, F.lane); row_add_bf16(r, Y + (size_t)s1 * DM, w1, F.lane);
}

__device__ __forceinline__ void norm_phase(Frame& F, const float* src, float* X, const float* g, bool combine, bool out_i8) {
    bf16_t* H = (bf16_t*)(F.ws + WS_H); signed char* Hq = (signed char*)(F.ws + WS_H); float* hsc = (float*)(F.ws + WS_MISC + MS_HSC);
    const int gw = F.vcu * NWAVES + F.wave, NGW = F.G * NWAVES;
    for (int t = gw; t < T; t += 2 * NGW) {
        const int t2 = t + NGW;
        RowV r, q; row_load(r, src + (size_t)t * DM, F.lane); row_load(q, src + (size_t)t2 * DM, F.lane);
        if (combine) { row_combine(F, r, t); row_combine(F, q, t2); row_store(r, X + (size_t)t * DM, F.lane); row_store(q, X + (size_t)t2 * DM, F.lane); }
        const float rstd = row_rstd(r), qstd = row_rstd(q); row_scale(r, rstd, g, F.lane); row_scale(q, qstd, g, F.lane);
        if (out_i8) { const float sc = row_store_i8(r, Hq + (size_t)t * DM, F.lane), sq = row_store_i8(q, Hq + (size_t)t2 * DM, F.lane); if (F.lane == 0) { hsc[t] = sc; hsc[t2] = sq; } }
        else { row_store_bf16(r, H + (size_t)t * DM, F.lane); row_store_bf16(q, H + (size_t)t2 * DM, F.lane); }
    }
}
__device__ __forceinline__ void final_norm_phase(Frame& F, float* X, const float* g, bool combine) {
    const int gw = F.vcu * NWAVES + F.wave, NGW = F.G * NWAVES;
    for (int t = gw; t < T; t += 2 * NGW) {
        const int t2 = t + NGW;
        RowV r, q; row_load(r, X + (size_t)t * DM, F.lane); row_load(q, X + (size_t)t2 * DM, F.lane);
        if (combine) { row_combine(F, r, t); row_combine(F, q, t2); }
        const float rstd = row_rstd(r), qstd = row_rstd(q); row_scale(r, rstd, g, F.lane); row_scale(q, qstd, g, F.lane);
        row_store(r, X + (size_t)t * DM, F.lane); row_store(q, X + (size_t)t2 * DM, F.lane);
    }
}
__device__ __forceinline__ void memnorm_phase(Frame& F) {
    bf16_t* MN = (bf16_t*)(F.ws + WS_MEMN);
    const int gw = F.vcu * NWAVES + F.wave, NGW = F.G * NWAVES;
    for (int t = gw; t < NB * MEML; t += NGW) {
        RowV r; row_load(r, F.in[I_MEM] + (size_t)t * DM, F.lane);
        const float rstd = row_rstd(r); row_scale(r, rstd, F.in[I_GMEM], F.lane);
        row_store_bf16(r, MN + (size_t)t * DM, F.lane);
    }
}

__device__ __forceinline__ void norm_router_phase(Frame& F, const float* X, const float* g, const float* Wr  , bool out_i8) {
    bf16_t* H = (bf16_t*)(F.ws + WS_H); signed char* Hq = (signed char*)(F.ws + WS_H); float* hsc = (float*)(F.ws + WS_MISC + MS_HSC);
    int* toke = (int*)(F.ws + WS_MISC + MS_TOKE); float* tokw = (float*)(F.ws + WS_MISC + MS_TOKW); int* cntg = (int*)(F.ws + WS_MISC + MS_CNT);
    volatile LAS int* hist = (volatile LAS int*)(F.lds + LDSCTL_OFF + 1024);
    for (int c = F.vcu; c < T / 128; c += F.G) {
        if (F.tid < 8) hist[F.tid] = 0;
        __syncthreads();
        for (int q = 0; q < 16; ++q) {
            const int t = c * 128 + F.wave * 16 + q;
            RowV r; row_load(r, X + (size_t)t * DM, F.lane);
            const float rstd = row_rstd(r); row_scale(r, rstd, g, F.lane);
            if (out_i8) { const float sc = row_store_i8(r, Hq + (size_t)t * DM, F.lane); if (F.lane == 0) hsc[t] = sc; }
            else row_store_bf16(r, H + (size_t)t * DM, F.lane);
            float lg[8];
#pragma unroll
            for (int e = 0; e < 8; ++e) lg[e] = 0.f;
#pragma unroll
            for (int j = 0; j < 4; ++j) {
#pragma unroll
                for (int k = 0; k < 4; ++k) { const int d = 256 * j + 4 * F.lane + k; const f32x4 wa = *(const f32x4*)(Wr + (size_t)d * 8), wb = *(const f32x4*)(Wr + (size_t)d * 8 + 4); const float x = r.v[j][k];
                    lg[0] += x * wa.x; lg[1] += x * wa.y; lg[2] += x * wa.z; lg[3] += x * wa.w; lg[4] += x * wb.x; lg[5] += x * wb.y; lg[6] += x * wb.z; lg[7] += x * wb.w; } }
#pragma unroll
            for (int e = 0; e < 8; ++e) lg[e] = wave_sum(lg[e]);
            int e0 = 0; float v0 = lg[0];
#pragma unroll
            for (int e = 1; e < 8; ++e) if (lg[e] > v0) { v0 = lg[e]; e0 = e; }
            int e1 = -1; float v1 = -INFINITY;
#pragma unroll
            for (int e = 0; e < 8; ++e) if (e != e0 && lg[e] > v1) { v1 = lg[e]; e1 = e; }
            if (F.lane == 0) {
                const float w0 = 1.0f / (1.0f + __expf(v1 - v0));
                toke[2 * t] = e0; toke[2 * t + 1] = e1; tokw[2 * t] = w0; tokw[2 * t + 1] = 1.0f - w0;
                __hip_atomic_fetch_add((LAS int*)&hist[e0], 1, __ATOMIC_RELAXED, __HIP_MEMORY_SCOPE_WORKGROUP); __hip_atomic_fetch_add((LAS int*)&hist[e1], 1, __ATOMIC_RELAXED, __HIP_MEMORY_SCOPE_WORKGROUP);
            }
        }
        __syncthreads();
        if (F.tid < 8) cntg[c * 8 + F.tid] = hist[F.tid];
        __syncthreads();
    }
}
__device__ __forceinline__ void moe_assign_phase(Frame& F, bool i8) {
    const bf16_t* H = (const bf16_t*)(F.ws + WS_H); bf16_t* AS = (bf16_t*)(F.ws + WS_R + R_ASORT);
    const float* hsc = (const float*)(F.ws + WS_MISC + MS_HSC); float* asc = (float*)(F.ws + WS_MISC + MS_ASC);
    const int* toke = (const int*)(F.ws + WS_MISC + MS_TOKE); int* slot = (int*)(F.ws + WS_MISC + MS_SLOT); const int* cntg = (const int*)(F.ws + WS_MISC + MS_CNT);
    int* texp = (int*)(F.ws + WS_MISC + MS_TEXP);
    volatile LAS int* tot = (volatile LAS int*)(F.lds + LDSCTL_OFF + 1024);
    volatile LAS int* pre = tot + 8;
    volatile LAS int* wcnt = tot + 16;
    for (int c = F.vcu; c < T / 128; c += F.G) {
        if (F.tid < 16) tot[F.tid] = 0;
        __syncthreads();
        { const int cc = F.tid >> 1, h = F.tid & 1; const i32x4 v = *(const i32x4*)(cntg + cc * 8 + 4 * h);
#pragma unroll
          for (int k = 0; k < 4; ++k) { __hip_atomic_fetch_add((LAS int*)&tot[4 * h + k], v[k], __ATOMIC_RELAXED, __HIP_MEMORY_SCOPE_WORKGROUP); if (cc < c) __hip_atomic_fetch_add((LAS int*)&pre[4 * h + k], v[k], __ATOMIC_RELAXED, __HIP_MEMORY_SCOPE_WORKGROUP); } }
        const int t = c * 128 + F.wave * 16 + ((F.lane & 31) >> 1);
        const int my_e = (F.lane < 32) ? toke[2 * t + (F.lane & 1)] : -1;
        int rank = 0;
#pragma unroll
        for (int e = 0; e < 8; ++e) { const unsigned long long m = __ballot(my_e == e); if (my_e == e) rank = __popcll(m & ((1ull << F.lane) - 1ull)); if (F.lane == 0) wcnt[F.wave * 8 + e] = __popcll(m); }
        __syncthreads();
        int myslot = 0;
        if (F.lane < 32) {
            int ts = 0;
#pragma unroll
            for (int e = 0; e < 8; ++e) ts += (e < my_e) ? ((tot[e] + 255) >> 8) : 0;
            int wp = 0; for (int w = 0; w < F.wave; ++w) wp += wcnt[w * 8 + my_e];
            myslot = ts * 256 + pre[my_e] + wp + rank;
            slot[2 * t + (F.lane & 1)] = myslot;
        }
        if (c == 0 && F.tid == 0) { int ts = 0; for (int e = 0; e < 8; ++e) { const int n = (tot[e] + 255) >> 8; for (int k = 0; k < n; ++k) texp[ts + k] = e; ts += n; } for (int k = ts; k < MAXRT; ++k) texp[k] = 0; texp[MAXRT] = ts; }
        for (int a = 0; a < 32; ++a) {
            const int s = __builtin_amdgcn_readlane(myslot, a); const int ta = c * 128 + F.wave * 16 + (a >> 1);
            if (i8) { const u32x4* srcp = (const u32x4*)((const signed char*)H + (size_t)ta * DM) + F.lane; u32x4* dstp = (u32x4*)((signed char*)AS + (size_t)s * DM) + F.lane; dstp[0] = srcp[0]; if (F.lane == 0) asc[s] = hsc[ta]; }
            else { const u32x4* srcp = (const u32x4*)(H + (size_t)ta * DM) + F.lane; u32x4* dstp = (u32x4*)(AS + (size_t)s * DM) + F.lane;
                const u32x4 x0 = srcp[0], x1 = srcp[64]; dstp[0] = x0; dstp[64] = x1; }
        }
        __syncthreads();
    }
}

using pg8::Unit;
typedef f32x4 AccT[2][2][4][2];

struct ProbSimple { int K; unsigned lda, ldb; const char* A; const char* B;
    __device__ __forceinline__ const char* a_ptr(const Unit& u) const { return A + (size_t)u.pm * 256 * lda; }
    __device__ __forceinline__ const char* b_ptr(const Unit& u) const { return B + (size_t)u.pn * 256 * ldb; } };
struct ProbBranch { int K; unsigned lda, ldb; const char* A; const char* B;
    __device__ __forceinline__ const char* a_ptr(const Unit& u) const { return A + (size_t)u.pm * 256 * lda + (size_t)u.aux * 1024; }
    __device__ __forceinline__ const char* b_ptr(const Unit& u) const { return B + (size_t)u.aux * ((size_t)DM * 512 * 2) + (size_t)u.pn * 256 * ldb; } };
struct ProbMoe { int K; unsigned lda, ldb; const char* A; const char* B; int a_lo;
    __device__ __forceinline__ const char* a_ptr(const Unit& u) const { return A + (size_t)(u.pm - a_lo) * 256 * lda; }
    __device__ __forceinline__ const char* b_ptr(const Unit& u) const { return B + (size_t)u.aux * WF_STRIDE + (size_t)u.pn * 256 * ldb; } };

struct SegOrder { pg8::StaticOrder base;
    __device__ bool next(int i, Unit& u) const { if (!base.next(i / 3, u)) return false; u.aux = i % 3; return true; } };
struct MoeOrder { pg8::StaticOrder base; int lo; const int* texp;
    __device__ bool next(int i, Unit& u) const { if (!base.next(i, u)) return false; u.pm += lo; u.aux = texp[u.pm]; return true; } };

__device__ __forceinline__ u32x4 pack8(const f32x4 a, const f32x4 b) { u32x4 w; w.x = cvtpk(a[0], a[1]); w.y = cvtpk(a[2], a[3]); w.z = cvtpk(b[0], b[1]); w.w = cvtpk(b[2], b[3]); return w; }
__device__ __forceinline__ u32x2 pack4(const f32x4 a) { u32x2 w; w.x = cvtpk(a[0], a[1]); w.y = cvtpk(a[2], a[3]); return w; }

struct EpiNoStage { __device__ __forceinline__ void stage(LAS unsigned char*, const Unit&, int, int) const {} };
__device__ __forceinline__ void stage1k(const void* src, LAS unsigned char* dst, int lane) { __builtin_amdgcn_global_load_lds((const unsigned*)((const char*)src + lane * 16), (LAS unsigned*)dst, 16, 0, 0); }
__device__ __forceinline__ f32x4 deq(const f32x4& a, float, const f32x4&) { return a; }
__device__ __forceinline__ f32x4 deq(const i32x4& a, float rs, const f32x4& cs) { return __builtin_convertvector(a, f32x4) * rs * cs; }
struct EpiInproj {
    static constexpr bool MID = false;
    bf16_t* P; bf16_t* G; float* ssq; const int* pos; const float* rsc; const float* csc;
    __device__ __forceinline__ void stage(LAS unsigned char* d, const Unit& u, int wid, int lane) const {
        if (wid == 0) { stage1k(rsc + u.pm * 256, d, lane); stage1k(csc + u.pn * 256, d + 1024, lane); stage1k(pos + u.pm * 256, d + 2048, lane); } }
    template <class AV> __device__ __forceinline__ void operator()(const AV (&acc)[2][2][4][2], const Unit& u, int wr, int wc, int fr, int fq, const LAS unsigned char* esc) const {
        const int pn = u.pn, row0 = u.pm * 256 + wr * 64 + fr;
        f32x4 cs[2][2];
#pragma unroll
        for (int bj = 0; bj < 2; ++bj)
#pragma unroll
            for (int n = 0; n < 2; ++n) cs[bj][n] = *(const LAS f32x4*)(esc + 1024 + (bj * 128 + wc * 32 + n * 16 + fq * 4) * 4);
        float rs8[2][4], pf8[2][4];
#pragma unroll
        for (int ai = 0; ai < 2; ++ai)
#pragma unroll
            for (int m = 0; m < 4; ++m) { const int rl = ai * 128 + wr * 64 + m * 16 + fr; rs8[ai][m] = *(const LAS float*)(esc + rl * 4); pf8[ai][m] = (float)*(const LAS int*)(esc + 2048 + rl * 4); }
#define DQ(ai, bj, m, n) deq(acc[ai][bj][m][n], rs, cs[bj][n])
        if (pn >= 7) {
#pragma unroll
            for (int ai = 0; ai < 2; ++ai)
#pragma unroll
                for (int m = 0; m < 4; ++m) { const int row = row0 + ai * 128 + m * 16; const float rs = rs8[ai][m];
#pragma unroll
                    for (int bj = 0; bj < 2; ++bj) { f32x4 a = DQ(ai, bj, m, 0), b = DQ(ai, bj, m, 1);
#pragma unroll
                        for (int j = 0; j < 4; ++j) { a[j] = fast_sigmoid(a[j]); b[j] = fast_sigmoid(b[j]); }
                        *(u32x4*)(G + (size_t)row * GW + (pn - 7) * 256 + bj * 128 + wc * 32 + fq * 8) = pack8(a, b); } }
        } else if (pn >= 5 || pn == 3) {
            const float sc = (pn == 3) ? 1.0f : C_M;
#pragma unroll
            for (int ai = 0; ai < 2; ++ai)
#pragma unroll
                for (int m = 0; m < 4; ++m) { const int row = row0 + ai * 128 + m * 16; const float rs = rs8[ai][m]; float s = 0.f;
#pragma unroll
                    for (int bj = 0; bj < 2; ++bj) { const f32x4 a = DQ(ai, bj, m, 0) * sc, b = DQ(ai, bj, m, 1) * sc;
                        s += (a[0] * a[0] + a[1] * a[1]) + (a[2] * a[2] + a[3] * a[3]) + (b[0] * b[0] + b[1] * b[1]) + (b[2] * b[2] + b[3] * b[3]);
                        *(u32x4*)(P + (size_t)row * PW + pn * 256 + bj * 128 + wc * 32 + fq * 8) = pack8(a, b); }
                    if (pn == 3) { s += __shfl_xor(s, 16); s += __shfl_xor(s, 32); if (fq == 0) ssq[(size_t)row * 8 + wc] = s; } }
        } else if (pn == 4) {
#pragma unroll
            for (int ai = 0; ai < 2; ++ai)
#pragma unroll
                for (int m = 0; m < 4; ++m) { const int row = row0 + ai * 128 + m * 16; const float rs = rs8[ai][m];
                    { const f32x4 a = DQ(ai, 0, m, 0), b = DQ(ai, 0, m, 1);
                      float s = (a[0] * a[0] + a[1] * a[1]) + (a[2] * a[2] + a[3] * a[3]) + (b[0] * b[0] + b[1] * b[1]) + (b[2] * b[2] + b[3] * b[3]);
                      *(u32x4*)(P + (size_t)row * PW + P_CKV + wc * 32 + fq * 8) = pack8(a, b);
                      s += __shfl_xor(s, 16); s += __shfl_xor(s, 32); if (fq == 0) ssq[(size_t)row * 8 + 4 + wc] = s; }
                    if (wc == 0) { const f32x4 x1 = DQ(ai, 1, m, 0), x2 = DQ(ai, 1, m, 1); const float pf = pf8[ai][m]; f32x4 o1, o2;
#pragma unroll
                        for (int j = 0; j < 4; ++j) { float c, s; rot_cs(pf, 2 * (4 * fq + j), c, s); o1[j] = x1[j] * c - x2[j] * s; o2[j] = x2[j] * c + x1[j] * s; }
                        *(u32x2*)(P + (size_t)row * PW + P_KR + 4 * fq) = pack4(o1); *(u32x2*)(P + (size_t)row * PW + P_KR + 16 + 4 * fq) = pack4(o2); } }
        } else {
            const float sc = (pn < 2) ? C_A : 1.0f; const int i0 = 16 * (wc & 1) + 4 * fq;
#pragma unroll
            for (int ai = 0; ai < 2; ++ai)
#pragma unroll
                for (int m = 0; m < 4; ++m) { const int row = row0 + ai * 128 + m * 16; const float rs = rs8[ai][m]; const float pf = pf8[ai][m]; f32x4 c, s;
#pragma unroll
                    for (int j = 0; j < 4; ++j) { float cc, ss; rot_cs(pf, i0 + j, cc, ss); c[j] = cc * sc; s[j] = ss * sc; }
#pragma unroll
                    for (int bj = 0; bj < 2; ++bj) { const f32x4 x1 = DQ(ai, bj, m, 0), x2 = DQ(ai, bj, m, 1);
                        if (pn == 2 && bj == 1) { *(u32x4*)(P + (size_t)row * PW + P_VA + wc * 32 + fq * 8) = pack8(x1, x2); }
                        else { const f32x4 o1 = x1 * c - x2 * s, o2 = x2 * c + x1 * s; bf16_t* d = P + (size_t)row * PW + pn * 256 + 64 * (2 * bj + (wc >> 1)) + i0;
                            *(u32x2*)d = pack4(o1); *(u32x2*)(d + 32) = pack4(o2); } } }
        }
#undef DQ
    }
};
struct EpiUp {
    static constexpr bool MID = false;
    __device__ __forceinline__ void stage(LAS unsigned char*, const Unit&, int, int) const {}
    bf16_t* QB; bf16_t* KVB; const float* ssq; const int* pos;
    __device__ __forceinline__ void operator()(const AccT& acc, const Unit& u, int wr, int wc, int fr, int fq, const LAS unsigned char*) const {
        const int pn = u.pn, row0 = u.pm * 256 + wr * 64 + fr;
        float rs8[2][4], pf8[2][4];
#pragma unroll
        for (int ai = 0; ai < 2; ++ai)
#pragma unroll
            for (int m = 0; m < 4; ++m) { const int row = row0 + ai * 128 + m * 16; const f32x4 sv = *(const f32x4*)(ssq + (size_t)row * 8 + (pn < 3 ? 0 : 4));
                rs8[ai][m] = (pn < 3 ? C_B : 1.0f) / sqrtf(((sv[0] + sv[1]) + (sv[2] + sv[3])) * (pn < 3 ? 1.0f / 256.0f : 1.0f / 128.0f) + EPS); pf8[ai][m] = (pn < 3) ? (float)pos[row] : 0.f; }
#pragma unroll
        for (int ai = 0; ai < 2; ++ai)
#pragma unroll
            for (int m = 0; m < 4; ++m) { const int row = row0 + ai * 128 + m * 16; const float rs = rs8[ai][m];
                if (pn < 3) {
#pragma unroll
                    for (int bj = 0; bj < 2; ++bj) { const int gg = 8 * pn + 4 * bj + wc; const f32x4 x1 = acc[ai][bj][m][0] * rs, x2 = acc[ai][bj][m][1] * rs;
                        if (gg % 3 == 2) { const float pf = pf8[ai][m]; f32x4 o1, o2;
#pragma unroll
                            for (int j = 0; j < 4; ++j) { float c, s; rot_cs(pf, 2 * (4 * fq + j), c, s); o1[j] = x1[j] * c - x2[j] * s; o2[j] = x2[j] * c + x1[j] * s; }
                            bf16_t* d = QB + (size_t)row * QBW + 32 * gg + 4 * fq; *(u32x2*)d = pack4(o1); *(u32x2*)(d + 16) = pack4(o2); }
                        else *(u32x4*)(QB + (size_t)row * QBW + 32 * gg + 8 * fq) = pack8(x1, x2); }
                } else {
#pragma unroll
                    for (int bj = 0; bj < 2; ++bj) *(u32x4*)(KVB + (size_t)row * KVW + (pn - 3) * 256 + bj * 128 + wc * 32 + fq * 8) = pack8(acc[ai][bj][m][0] * rs, acc[ai][bj][m][1] * rs);
                } }
    }
};
struct EpiPlain {
    static constexpr bool MID = false;
    __device__ __forceinline__ void stage(LAS unsigned char*, const Unit&, int, int) const {}
    bf16_t* O; int ldo;
    __device__ __forceinline__ void operator()(const AccT& acc, const Unit& u, int wr, int wc, int fr, int fq, const LAS unsigned char*) const {
        const int row0 = u.pm * 256 + wr * 64 + fr;
#pragma unroll
        for (int ai = 0; ai < 2; ++ai)
#pragma unroll
            for (int m = 0; m < 4; ++m)
#pragma unroll
                for (int bj = 0; bj < 2; ++bj) *(u32x4*)(O + (size_t)(row0 + ai * 128 + m * 16) * ldo + u.pn * 256 + bj * 128 + wc * 32 + fq * 8) = pack8(acc[ai][bj][m][0], acc[ai][bj][m][1]);
    }
};
struct EpiBranch {
    static constexpr bool MID = true;
    const bf16_t* G; bf16_t* MIXED;
    __device__ __forceinline__ void stage(LAS unsigned char*, const Unit&, int, int) const {}
    __device__ __forceinline__ void mid(AccT& acc, const Unit& u, int seg  , int wr, int wc, int fr, int fq) const {
        const int row0 = opq_v(u.pm * 256 + wr * 64 + fr);
#pragma unroll
        for (int ai = 0; ai < 2; ++ai)
#pragma unroll
            for (int mp = 0; mp < 2; ++mp) {
                u32x4 ga[2][2], gb[2][2];
#pragma unroll
                for (int mm = 0; mm < 2; ++mm)
#pragma unroll
                    for (int bj = 0; bj < 2; ++bj) { const bf16_t* gp = G + (size_t)(row0 + ai * 128 + (2 * mp + mm) * 16) * GW + u.pn * 256 + bj * 128 + wc * 32 + fq * 8;
                        ga[mm][bj] = *(const u32x4*)(gp + (seg - 1) * 1024); gb[mm][bj] = *(const u32x4*)(gp + seg * 1024); }
#pragma unroll
                for (int mm = 0; mm < 2; ++mm)
#pragma unroll
                    for (int bj = 0; bj < 2; ++bj) { const int m = 2 * mp + mm; const u32x4 a4 = ga[mm][bj], b4 = gb[mm][bj];
#define GR(lo_hi, w) (fmaxf(lo_hi(a4.w), 1e-6f) * __builtin_amdgcn_rcpf(fmaxf(lo_hi(b4.w), 1e-6f)))
                        acc[ai][bj][m][0][0] *= GR(bflo, x); acc[ai][bj][m][0][1] *= GR(bfhi, x); acc[ai][bj][m][0][2] *= GR(bflo, y); acc[ai][bj][m][0][3] *= GR(bfhi, y);
                        acc[ai][bj][m][1][0] *= GR(bflo, z); acc[ai][bj][m][1][1] *= GR(bfhi, z); acc[ai][bj][m][1][2] *= GR(bflo, w); acc[ai][bj][m][1][3] *= GR(bfhi, w);
#undef GR
                    }
                asm volatile("" ::: "memory"); }
    }
    __device__ __forceinline__ void operator()(const AccT& acc, const Unit& u, int wr, int wc, int fr, int fq, const LAS unsigned char*) const {
        const int row0 = u.pm * 256 + wr * 64 + fr;
#pragma unroll
        for (int ai = 0; ai < 2; ++ai)
#pragma unroll
            for (int mp = 0; mp < 2; ++mp) {
                u32x4 gw[2][2];
#pragma unroll
                for (int mm = 0; mm < 2; ++mm)
#pragma unroll
                    for (int bj = 0; bj < 2; ++bj) gw[mm][bj] = *(const u32x4*)(G + (size_t)(row0 + ai * 128 + (2 * mp + mm) * 16) * GW + 2048 + u.pn * 256 + bj * 128 + wc * 32 + fq * 8);
#pragma unroll
                for (int mm = 0; mm < 2; ++mm)
#pragma unroll
                    for (int bj = 0; bj < 2; ++bj) { const int m = 2 * mp + mm; const u32x4 g4 = gw[mm][bj]; f32x4 a = acc[ai][bj][m][0], b = acc[ai][bj][m][1];
                        a[0] *= fmaxf(bflo(g4.x), 1e-6f); a[1] *= fmaxf(bfhi(g4.x), 1e-6f); a[2] *= fmaxf(bflo(g4.y), 1e-6f); a[3] *= fmaxf(bfhi(g4.y), 1e-6f);
                        b[0] *= fmaxf(bflo(g4.z), 1e-6f); b[1] *= fmaxf(bfhi(g4.z), 1e-6f); b[2] *= fmaxf(bflo(g4.w), 1e-6f); b[3] *= fmaxf(bfhi(g4.w), 1e-6f);
                        *(u32x4*)(MIXED + (size_t)(row0 + ai * 128 + m * 16) * DM + u.pn * 256 + bj * 128 + wc * 32 + fq * 8) = pack8(a, b); }
                asm volatile("" ::: "memory"); }
    }
};
struct EpiResid {
    static constexpr bool MID = false;
    __device__ __forceinline__ void stage(LAS unsigned char*, const Unit&, int, int) const {}
    const float* Xin; float* Xout;
    __device__ __forceinline__ void operator()(const AccT& acc, const Unit& u, int wr, int wc, int fr, int fq, const LAS unsigned char*) const {
        const int row0 = u.pm * 256 + wr * 64 + fr;
#pragma unroll
        for (int ai = 0; ai < 2; ++ai)
#pragma unroll
            for (int mp = 0; mp < 2; ++mp) {
                f32x4 xv[2][2][2];
#pragma unroll
                for (int mm = 0; mm < 2; ++mm)
#pragma unroll
                    for (int bj = 0; bj < 2; ++bj)
#pragma unroll
                        for (int n = 0; n < 2; ++n) xv[mm][bj][n] = *(const f32x4*)(Xin + (size_t)(row0 + ai * 128 + (2 * mp + mm) * 16) * DM + u.pn * 256 + bj * 128 + wc * 32 + n * 16 + fq * 4);
#pragma unroll
                for (int mm = 0; mm < 2; ++mm)
#pragma unroll
                    for (int bj = 0; bj < 2; ++bj)
#pragma unroll
                        for (int n = 0; n < 2; ++n) *(f32x4*)(Xout + (size_t)(row0 + ai * 128 + (2 * mp + mm) * 16) * DM + u.pn * 256 + bj * 128 + wc * 32 + n * 16 + fq * 4) = xv[mm][bj][n] + acc[ai][bj][2 * mp + mm][n];
                asm volatile("" ::: "memory"); }
    }
};
struct EpiSwiglu {
    static constexpr bool MID = false;
    bf16_t* ACT; int lo; const float* rsc; const float* csc;
    __device__ __forceinline__ void stage(LAS unsigned char* d, const Unit& u, int wid, int lane) const {
        if (wid == 0) { stage1k(rsc + u.pm * 256, d, lane); stage1k(csc + (size_t)u.aux * 2 * DFF + u.pn * 256, d + 1024, lane); } }
    template <class AV> __device__ __forceinline__ void operator()(const AV (&acc)[2][2][4][2], const Unit& u, int wr, int wc, int fr, int fq, const LAS unsigned char* esc) const {
        const int row0 = (u.pm - lo) * 256 + wr * 64 + fr;
        f32x4 cs[2][2];
#pragma unroll
        for (int bj = 0; bj < 2; ++bj)
#pragma unroll
            for (int n = 0; n < 2; ++n) cs[bj][n] = *(const LAS f32x4*)(esc + 1024 + (bj * 128 + wc * 32 + n * 16 + fq * 4) * 4);
        float rs8[2][4];
#pragma unroll
        for (int ai = 0; ai < 2; ++ai)
#pragma unroll
            for (int m = 0; m < 4; ++m) rs8[ai][m] = *(const LAS float*)(esc + (ai * 128 + wr * 64 + m * 16 + fr) * 4);
#pragma unroll
        for (int ai = 0; ai < 2; ++ai)
#pragma unroll
            for (int m = 0; m < 4; ++m) { const float rs = rs8[ai][m]; f32x4 a, b;
                const f32x4 g0 = deq(acc[ai][0][m][0], rs, cs[0][0]), g1 = deq(acc[ai][0][m][1], rs, cs[0][1]), u0 = deq(acc[ai][1][m][0], rs, cs[1][0]), u1 = deq(acc[ai][1][m][1], rs, cs[1][1]);
#pragma unroll
                for (int j = 0; j < 4; ++j) { a[j] = g0[j] * fast_sigmoid(g0[j]) * u0[j]; b[j] = g1[j] * fast_sigmoid(g1[j]) * u1[j]; }
                *(u32x4*)(ACT + (size_t)(row0 + ai * 128 + m * 16) * DFF + u.pn * 128 + wc * 32 + fq * 8) = pack8(a, b); }
    }
};
struct EpiYout {
    static constexpr bool MID = false;
    __device__ __forceinline__ void stage(LAS unsigned char*, const Unit&, int, int) const {}
    bf16_t* Y;
    __device__ __forceinline__ void operator()(const AccT& acc, const Unit& u, int wr, int wc, int fr, int fq, const LAS unsigned char*) const {
        const int row0 = u.pm * 256 + wr * 64 + fr;
#pragma unroll
        for (int ai = 0; ai < 2; ++ai)
#pragma unroll
            for (int m = 0; m < 4; ++m)
#pragma unroll
                for (int bj = 0; bj < 2; ++bj)
#pragma unroll
                    for (int n = 0; n < 2; ++n) *(u32x2*)(Y + (size_t)(row0 + ai * 128 + m * 16) * DM + u.pn * 256 + bj * 128 + wc * 32 + n * 16 + fq * 4) = pack4(acc[ai][bj][m][n]);
    }
};

namespace att {
__device__ __forceinline__ int crow(int r, int hi) { return (r & 3) + 8 * (r >> 2) + 4 * hi; }
__device__ __forceinline__ void glds16(const void* gsrc, unsigned lds_dst) { unsigned keep;
    asm volatile("s_mov_b32 %0, m0\n\ts_mov_b32 m0, %2\n\ts_nop 0\n\tglobal_load_lds_dwordx4 %1, off\n\ts_mov_b32 m0, %0" : "=&s"(keep) : "v"(gsrc), "s"(lds_dst) : "memory"); }
__device__ __forceinline__ float swapmax(float m) { auto rr = __builtin_amdgcn_permlane32_swap(__float_as_uint(m), __float_as_uint(m), false, false); return fmaxf(__uint_as_float(rr[0]), __uint_as_float(rr[1])); }
__device__ __forceinline__ float swapsum(float m) { auto rr = __builtin_amdgcn_permlane32_swap(__float_as_uint(m), __float_as_uint(m), false, false); return __uint_as_float(rr[0]) + __uint_as_float(rr[1]); }
__device__ __forceinline__ s16x4 vtr(unsigned addr) { s16x4 r; asm volatile("ds_read_b64_tr_b16 %0, %1" : "=&v"(r) : "v"(addr) : "memory"); return r; }
#define VTRO(dst, base, off) asm volatile("ds_read_b64_tr_b16 %0, %1 offset:%c2" : "=&v"(dst) : "v"(base), "i"(off) : "memory")

struct Src {
    const bf16_t* q; int qpitch;
    const bf16_t* k0; int k0pitch;
    const bf16_t* k1; int k1pitch;
    const bf16_t* v; int vpitch;
    bf16_t* o; int opitch;
};
template <int NKC, int NVB, int RD = 4>
__device__ __forceinline__ void dma_tile(const Src& S, int t, int slot, unsigned lds0, int wid, int lane) {
    constexpr int KS = NKC * 1024, VS = NVB * 4096, LDS_K = 0, LDS_V = RD * KS;
#pragma unroll
    for (int c = 0; c < (NKC + 7) / 8; ++c) { const int ch = wid + 8 * c; if (ch < NKC) {
        const bf16_t* src = (ch < 8) ? S.k0 + (size_t)(t * 64 + lane) * S.k0pitch + ch * 8 : S.k1 + (size_t)(t * 64 + lane) * S.k1pitch + (ch - 8) * 8;
        glds16(src, (unsigned)__builtin_amdgcn_readfirstlane(lds0 + LDS_K + slot * KS + ch * 1024)); } }
#pragma unroll
    for (int c = 0; c < (NVB * 4 + 7) / 8; ++c) { const int p = wid + 8 * c; if (p < NVB * 4) {
        const bf16_t* src = S.v + (size_t)(t * 64 + 16 * (p & 3) + (lane >> 2)) * S.vpitch + (p >> 2) * 32 + (lane & 3) * 8;
        glds16(src, (unsigned)__builtin_amdgcn_readfirstlane(lds0 + LDS_V + slot * VS + p * 1024)); } }
}
__device__ __forceinline__ void wait_vm_bar(int n) {
    if (n >= 4) asm volatile("s_waitcnt vmcnt(4) lgkmcnt(0)\n\ts_barrier" ::: "memory");
    else if (n == 3) asm volatile("s_waitcnt vmcnt(3) lgkmcnt(0)\n\ts_barrier" ::: "memory");
    else if (n == 2) asm volatile("s_waitcnt vmcnt(2) lgkmcnt(0)\n\ts_barrier" ::: "memory");
    else if (n == 1) asm volatile("s_waitcnt vmcnt(1) lgkmcnt(0)\n\ts_barrier" ::: "memory");
    else asm volatile("s_waitcnt vmcnt(0) lgkmcnt(0)\n\ts_barrier" ::: "memory");
}
template <int NKC, int NVB, int MODE>
__device__ __forceinline__ void unit(LAS unsigned char* lds, const Src& S, int t_lo, int t_hi, int qpos0  , float sink_l2) {
    constexpr int KS = NKC * 1024, VS = NVB * 4096, RD = 4, LDS_K = 0, LDS_V = RD * KS;
    const int tid = opq_v((int)threadIdx.x), lane = tid & 63, r32 = lane & 31, hi = lane >> 5; const int wid = __builtin_amdgcn_readfirstlane(tid >> 6), grp = wid >> 2;
    const unsigned lds0 = (unsigned)(uintptr_t)lds;
    const int ops = (NKC + 7 - wid) / 8 + (NVB * 4) / 8;
    bf16x8 qr[NKC / 2];
#pragma unroll
    for (int d0 = 0; d0 < NKC / 2; ++d0) qr[d0] = *(const bf16x8*)(S.q + (size_t)r32 * S.qpitch + d0 * 16 + hi * 8);
    float m_run = (MODE == 0) ? sink_l2 : -INFINITY, l_run = (MODE == 0 && hi == 0) ? 1.0f : 0.0f;
    f32x16 o[NVB];
#pragma unroll
    for (int d = 0; d < NVB; ++d) o[d] = f32x16{};
    const int qi = qpos0 + wid * 32 + r32, qw0 = qpos0 + wid * 32;
    f32x16 p0 = f32x16{}, p1 = f32x16{};
#define AT_ACTIVE(t) ((MODE != 0) || ((64 * (t) + 63 >= qw0 - 128) && (64 * (t) <= qw0 + 31 + 128)))
#define AT_QK(t) do { const LAS unsigned char* kb_ = lds + LDS_K + (((t) - t_lo) % RD) * KS + hi * 1024 + r32 * 16; p0 = f32x16{}; p1 = f32x16{}; \
        _Pragma("unroll") for (int d0 = 0; d0 < NKC / 2; ++d0) { const bf16x8 b0_ = *(const LAS bf16x8*)(kb_ + d0 * 2048), b1_ = *(const LAS bf16x8*)(kb_ + d0 * 2048 + 512); \
            p0 = __builtin_amdgcn_mfma_f32_32x32x16_bf16(b0_, qr[d0], p0, 0, 0, 0); p1 = __builtin_amdgcn_mfma_f32_32x32x16_bf16(b1_, qr[d0], p1, 0, 0, 0); } } while (0)
#define AT_SMPV(t) do { \
        if (MODE == 0) { _Pragma("unroll") for (int r = 0; r < 16; ++r) { const int kv_ = 64 * (t) + crow(r, hi); int e0_ = kv_ - qi; e0_ = e0_ < 0 ? -e0_ : e0_; int e1_ = kv_ + 32 - qi; e1_ = e1_ < 0 ? -e1_ : e1_; \
            if (e0_ > 128) p0[r] = -INFINITY; if (e1_ > 128) p1[r] = -INFINITY; } } \
        float mx_[8]; _Pragma("unroll") for (int r = 0; r < 8; ++r) mx_[r] = fmaxf(fmaxf(p0[r], p0[r + 8]), fmaxf(p1[r], p1[r + 8])); \
        float rm_ = fmaxf(fmaxf(fmaxf(mx_[0], mx_[1]), fmaxf(mx_[2], mx_[3])), fmaxf(fmaxf(mx_[4], mx_[5]), fmaxf(mx_[6], mx_[7]))); rm_ = swapmax(rm_); \
        if (__any(rm_ > m_run)) { const float mn_ = fmaxf(m_run, rm_), alpha_ = __builtin_amdgcn_exp2f(m_run - mn_); m_run = mn_; l_run *= alpha_; \
            _Pragma("unroll") for (int d = 0; d < NVB; ++d) _Pragma("unroll") for (int r = 0; r < 16; ++r) o[d][r] *= alpha_; } \
        float sm_[4] = {0.f, 0.f, 0.f, 0.f}; \
        _Pragma("unroll") for (int r = 0; r < 16; ++r) { p0[r] = __builtin_amdgcn_exp2f(p0[r] - m_run); p1[r] = __builtin_amdgcn_exp2f(p1[r] - m_run); sm_[r & 3] += p0[r] + p1[r]; } \
        l_run += (sm_[0] + sm_[1]) + (sm_[2] + sm_[3]); \
        u32x4 pw_[4]; \
        pw_[0] = (u32x4){cvtpk(p0[0], p0[1]), cvtpk(p0[2], p0[3]), cvtpk(p0[4], p0[5]), cvtpk(p0[6], p0[7])}; pw_[1] = (u32x4){cvtpk(p0[8], p0[9]), cvtpk(p0[10], p0[11]), cvtpk(p0[12], p0[13]), cvtpk(p0[14], p0[15])}; \
        pw_[2] = (u32x4){cvtpk(p1[0], p1[1]), cvtpk(p1[2], p1[3]), cvtpk(p1[4], p1[5]), cvtpk(p1[6], p1[7])}; pw_[3] = (u32x4){cvtpk(p1[8], p1[9]), cvtpk(p1[10], p1[11]), cvtpk(p1[12], p1[13]), cvtpk(p1[14], p1[15])}; \
        const unsigned vb_ = lds0 + LDS_V + (((t) - t_lo) % RD) * VS + ((lane >> 4) & 1) * 32 + (lane & 3) * 8 + (4 * hi + ((lane & 15) >> 2)) * 64; \
        _Pragma("unroll") for (int dp = 0; dp < NVB; dp += 2) { s16x4 lo_[2][4], hh_[2][4]; \
            _Pragma("unroll") for (int dd = 0; dd < 2; ++dd) _Pragma("unroll") for (int ks = 0; ks < 4; ++ks) { lo_[dd][ks] = vtr(vb_ + (dp + dd) * 4096 + ks * 1024); hh_[dd][ks] = vtr(vb_ + (dp + dd) * 4096 + ks * 1024 + 512); } \
            asm volatile("s_waitcnt lgkmcnt(0)" ::: "memory"); __builtin_amdgcn_sched_barrier(0); \
            _Pragma("unroll") for (int ks = 0; ks < 4; ++ks) _Pragma("unroll") for (int dd = 0; dd < 2; ++dd) { \
                const bf16x8 vf_ = (bf16x8){lo_[dd][ks][0], lo_[dd][ks][1], lo_[dd][ks][2], lo_[dd][ks][3], hh_[dd][ks][0], hh_[dd][ks][1], hh_[dd][ks][2], hh_[dd][ks][3]}; \
                o[dp + dd] = __builtin_amdgcn_mfma_f32_32x32x16_bf16(vf_, __builtin_bit_cast(bf16x8, pw_[ks]), o[dp + dd], 0, 0, 0); } } } while (0)
    dma_tile<NKC, NVB>(S, t_lo, 0, lds0, wid, lane);
    if (t_lo + 1 < t_hi) dma_tile<NKC, NVB>(S, t_lo + 1, 1, lds0, wid, lane);
    for (int t = t_lo; t < t_hi; ++t) {
        wait_vm_bar((t + 1 < t_hi) ? ops : 0);
        if (t + 2 < t_hi) dma_tile<NKC, NVB>(S, t + 2, (t + 2 - t_lo) % RD, lds0, wid, lane);
        if (grp == 0) { if (AT_ACTIVE(t)) { AT_QK(t); AT_SMPV(t); } }
        else { if (t > t_lo && AT_ACTIVE(t - 1)) AT_SMPV(t - 1); if (AT_ACTIVE(t)) AT_QK(t); }
    }
    if (grp == 1 && AT_ACTIVE(t_hi - 1)) AT_SMPV(t_hi - 1);
    const float linv = 1.0f / swapsum(l_run);
#pragma unroll
    for (int d = 0; d < NVB; ++d)
#pragma unroll
        for (int r4 = 0; r4 < 4; ++r4) { f32x4 v = {o[d][4 * r4] * linv, o[d][4 * r4 + 1] * linv, o[d][4 * r4 + 2] * linv, o[d][4 * r4 + 3] * linv};
            *(u32x2*)(S.o + (size_t)r32 * S.opitch + 32 * d + 8 * r4 + 4 * hi) = pack4(v); }
    asm volatile("s_waitcnt lgkmcnt(0)\n\ts_barrier" ::: "memory");
#undef AT_ACTIVE
#undef AT_QK
#undef AT_SMPV
}

template <int NKC, int NVB, bool STAG, int MODE = 1>
__device__ __forceinline__ void unit_pf(LAS unsigned char* lds, const Src& S, int t_lo, int t_hi, int qpos0 = 0, float sink_l2 = 0.f) {
    constexpr int KS = NKC * 1024, VS = NVB * 4096, RD = 5, LDS_K = 0, LDS_V = RD * KS;
    static_assert(RD * (KS + VS) <= RING_BYTES, "attention rings fit the LDS stage region");
    const int tid = opq_v((int)threadIdx.x), lane = tid & 63, r32 = lane & 31, hi = lane >> 5; const int wid = __builtin_amdgcn_readfirstlane(tid >> 6), grp = STAG ? (wid >> 2) : 0;
    const unsigned lds0 = (unsigned)(uintptr_t)lds;
    const int ops = (NKC + 7 - wid) / 8 + (NVB * 4) / 8;
    bf16x8 qr[NKC / 2];
#pragma unroll
    for (int d0 = 0; d0 < NKC / 2; ++d0) qr[d0] = *(const bf16x8*)(S.q + (size_t)r32 * S.qpitch + d0 * 16 + hi * 8);
    float m_run = (MODE == 0) ? sink_l2 : -INFINITY, l_run = (MODE == 0 && hi == 0) ? 1.0f : 0.0f;
    const int qi = qpos0 + wid * 32 + r32; (void)qi;
    f32x16 o[NVB];
#pragma unroll
    for (int d = 0; d < NVB; ++d) o[d] = f32x16{};
    bf16x8 kf[NKC];
    f32x16 p0 = f32x16{}, p1 = f32x16{};
    s16x4 lo[NVB][4], hh[NVB][4];
#define PF_KLOAD(t) do { const LAS unsigned char* kb_ = lds + LDS_K + (((t) - t_lo) % RD) * KS + hi * 1024 + r32 * 16; \
        _Pragma("unroll") for (int d0 = 0; d0 < NKC / 2; ++d0) { kf[2 * d0] = *(const LAS bf16x8*)(kb_ + d0 * 2048); kf[2 * d0 + 1] = *(const LAS bf16x8*)(kb_ + d0 * 2048 + 512); } } while (0)
#define PF_VLOAD(t) do { const unsigned vb_ = lds0 + LDS_V + (((t) - t_lo) % RD) * VS + ((lane >> 4) & 1) * 32 + (lane & 3) * 8 + (4 * hi + ((lane & 15) >> 2)) * 64; \
        _Pragma("unroll") for (int d = 0; d < NVB; ++d) _Pragma("unroll") for (int ks = 0; ks < 4; ++ks) { VTRO(lo[d][ks], vb_, d * 4096 + ks * 1024); VTRO(hh[d][ks], vb_, d * 4096 + ks * 1024 + 512); } \
        __builtin_amdgcn_sched_barrier(0); } while (0)
#define PF_QK() do { p0 = f32x16{}; p1 = f32x16{}; \
        _Pragma("unroll") for (int d0 = 0; d0 < NKC / 2; ++d0) { p0 = __builtin_amdgcn_mfma_f32_32x32x16_bf16(kf[2 * d0], qr[d0], p0, 0, 0, 0); p1 = __builtin_amdgcn_mfma_f32_32x32x16_bf16(kf[2 * d0 + 1], qr[d0], p1, 0, 0, 0); } \
        __builtin_amdgcn_sched_barrier(0); } while (0)
    u32x4 pw[4] = {};
#define PF_SM(t) do { \
        if (MODE == 0) { _Pragma("unroll") for (int r = 0; r < 16; ++r) { const int kv_ = 64 * (t) + crow(r, hi); int e0_ = kv_ - qi; e0_ = e0_ < 0 ? -e0_ : e0_; int e1_ = kv_ + 32 - qi; e1_ = e1_ < 0 ? -e1_ : e1_; \
            if (e0_ > 128) p0[r] = -INFINITY; if (e1_ > 128) p1[r] = -INFINITY; } } \
        float mx_[8]; _Pragma("unroll") for (int r = 0; r < 8; ++r) mx_[r] = fmaxf(fmaxf(p0[r], p0[r + 8]), fmaxf(p1[r], p1[r + 8])); \
        float rm_ = fmaxf(fmaxf(fmaxf(mx_[0], mx_[1]), fmaxf(mx_[2], mx_[3])), fmaxf(fmaxf(mx_[4], mx_[5]), fmaxf(mx_[6], mx_[7]))); rm_ = swapmax(rm_); \
        if (__any(rm_ > m_run)) { const float mn_ = fmaxf(m_run, rm_), alpha_ = __builtin_amdgcn_exp2f(m_run - mn_); m_run = mn_; l_run *= alpha_; \
            _Pragma("unroll") for (int d = 0; d < NVB; ++d) _Pragma("unroll") for (int r = 0; r < 16; ++r) o[d][r] *= alpha_; } \
        float sm_[4] = {0.f, 0.f, 0.f, 0.f}; \
        _Pragma("unroll") for (int r = 0; r < 16; ++r) { p0[r] = __builtin_amdgcn_exp2f(p0[r] - m_run); p1[r] = __builtin_amdgcn_exp2f(p1[r] - m_run); sm_[r & 3] += p0[r] + p1[r]; } \
        l_run += (sm_[0] + sm_[1]) + (sm_[2] + sm_[3]); \
        pw[0] = (u32x4){cvtpk(p0[0], p0[1]), cvtpk(p0[2], p0[3]), cvtpk(p0[4], p0[5]), cvtpk(p0[6], p0[7])}; pw[1] = (u32x4){cvtpk(p0[8], p0[9]), cvtpk(p0[10], p0[11]), cvtpk(p0[12], p0[13]), cvtpk(p0[14], p0[15])}; \
        pw[2] = (u32x4){cvtpk(p1[0], p1[1]), cvtpk(p1[2], p1[3]), cvtpk(p1[4], p1[5]), cvtpk(p1[6], p1[7])}; pw[3] = (u32x4){cvtpk(p1[8], p1[9]), cvtpk(p1[10], p1[11]), cvtpk(p1[12], p1[13]), cvtpk(p1[14], p1[15])}; \
        __builtin_amdgcn_sched_barrier(0); } while (0)
#define PF_PV() do { asm volatile("s_waitcnt lgkmcnt(0)" ::: "memory"); __builtin_amdgcn_sched_barrier(0); \
        _Pragma("unroll") for (int ks = 0; ks < 4; ++ks) _Pragma("unroll") for (int d = 0; d < NVB; ++d) { \
            const bf16x8 vf_ = (bf16x8){lo[d][ks][0], lo[d][ks][1], lo[d][ks][2], lo[d][ks][3], hh[d][ks][0], hh[d][ks][1], hh[d][ks][2], hh[d][ks][3]}; \
            o[d] = __builtin_amdgcn_mfma_f32_32x32x16_bf16(vf_, __builtin_bit_cast(bf16x8, pw[ks]), o[d], 0, 0, 0); } \
        __builtin_amdgcn_sched_barrier(0); } while (0)
    dma_tile<NKC, NVB, RD>(S, t_lo, 0, lds0, wid, lane);
    if (t_lo + 1 < t_hi) dma_tile<NKC, NVB, RD>(S, t_lo + 1, 1, lds0, wid, lane);
    wait_vm_bar(0);
    if (t_lo + 2 < t_hi) dma_tile<NKC, NVB, RD>(S, t_lo + 2, 2, lds0, wid, lane);
#define PF_TOP(t) do { if ((t) > t_lo) wait_vm_bar(((t) + 2 < t_hi) ? ops : 0); \
        if ((t) + 3 < t_hi) dma_tile<NKC, NVB, RD>(S, (t) + 3, ((t) + 3 - t_lo) % RD, lds0, wid, lane); } while (0)
    if (grp == 0) {
        PF_KLOAD(t_lo);
        for (int t = t_lo; t < t_hi; ++t) {
            PF_TOP(t);
            PF_VLOAD(t);
            PF_QK();
            if (t + 1 < t_hi) PF_KLOAD(t + 1);
            __builtin_amdgcn_sched_barrier(0);
            PF_SM(t);
            PF_PV();
        }
    } else {
        PF_TOP(t_lo); PF_KLOAD(t_lo); __builtin_amdgcn_sched_barrier(0); PF_QK();
        for (int t = t_lo + 1; t < t_hi; ++t) {
            PF_TOP(t);
            PF_VLOAD(t - 1); PF_SM(t - 1); PF_KLOAD(t); __builtin_amdgcn_sched_barrier(0); PF_PV();
            PF_QK();
        }
        PF_VLOAD(t_hi - 1); PF_SM(t_hi - 1); PF_PV();
    }
    const float linv = 1.0f / swapsum(l_run);
#pragma unroll
    for (int d = 0; d < NVB; ++d)
#pragma unroll
        for (int r4 = 0; r4 < 4; ++r4) { f32x4 v = {o[d][4 * r4] * linv, o[d][4 * r4 + 1] * linv, o[d][4 * r4 + 2] * linv, o[d][4 * r4 + 3] * linv};
            *(u32x2*)(S.o + (size_t)r32 * S.opitch + 32 * d + 8 * r4 + 4 * hi) = pack4(v); }
    asm volatile("s_waitcnt lgkmcnt(0)\n\ts_barrier" ::: "memory");
#undef PF_KLOAD
#undef PF_VLOAD
#undef PF_QK
#undef PF_SM
#undef PF_PV
#undef PF_TOP
}

template <int NKC, int NVB, int MODE>
__device__ __forceinline__ void unit_pp(LAS unsigned char* lds, const Src& S, int t_lo, int t_hi, int qpos0, float sink_l2) {
    constexpr int KS = NKC * 1024, VS = NVB * 4096, RD = 3, LDS_K = 0, LDS_V = RD * KS;
    const int tid = opq_v((int)threadIdx.x), lane = tid & 63, r32 = lane & 31, hi = lane >> 5; const int wid = __builtin_amdgcn_readfirstlane(tid >> 6), grp = wid >> 2;
    const unsigned lds0 = (unsigned)(uintptr_t)lds;
    const int n = t_hi - t_lo;
    const int kops = (NKC + 7 - wid) / 8, vops = (NVB * 4) / 8;
    bf16x8 qr[NKC / 2];
#pragma unroll
    for (int d0 = 0; d0 < NKC / 2; ++d0) qr[d0] = *(const bf16x8*)(S.q + (size_t)r32 * S.qpitch + d0 * 16 + hi * 8);
#define PP_DMA_K(j) do { _Pragma("unroll") for (int c_ = 0; c_ < (NKC + 7) / 8; ++c_) { const int ch_ = wid + 8 * c_; if (ch_ < NKC) { \
        const bf16_t* src_ = (ch_ < 8) ? S.k0 + (size_t)((t_lo + (j)) * 64 + lane) * S.k0pitch + ch_ * 8 : S.k1 + (size_t)((t_lo + (j)) * 64 + lane) * S.k1pitch + (ch_ - 8) * 8; \
        glds16(src_, (unsigned)__builtin_amdgcn_readfirstlane(lds0 + LDS_K + ((j) % RD) * KS + ch_ * 1024)); } } } while (0)
#define PP_DMA_V(j) do { _Pragma("unroll") for (int c_ = 0; c_ < (NVB * 4 + 7) / 8; ++c_) { const int p_ = wid + 8 * c_; if (p_ < NVB * 4) { \
        const bf16_t* src_ = S.v + (size_t)((t_lo + (j)) * 64 + 16 * (p_ & 3) + (lane >> 2)) * S.vpitch + (p_ >> 2) * 32 + (lane & 3) * 8; \
        glds16(src_, (unsigned)__builtin_amdgcn_readfirstlane(lds0 + LDS_V + ((j) % RD) * VS + p_ * 1024)); } } } while (0)
#define PP_BATCH(b, cnt) do { cnt = 0; if ((b) + 3 < n) { PP_DMA_K((b) + 3); cnt += kops; } if ((b) + 2 < n) { PP_DMA_V((b) + 2); cnt += vops; } } while (0)
    float m_run = (MODE == 0) ? sink_l2 : -INFINITY, l_run = (MODE == 0 && hi == 0) ? 1.0f : 0.0f;
    f32x16 o[NVB];
#pragma unroll
    for (int d = 0; d < NVB; ++d) o[d] = f32x16{};
    const int qi = qpos0 + wid * 32 + r32, qw0 = qpos0 + wid * 32;
#define PP_ACTIVE(j) ((MODE != 0) || ((64 * (t_lo + (j)) + 63 >= qw0 - 128) && (64 * (t_lo + (j)) <= qw0 + 31 + 128)))
    f32x16 p0 = f32x16{}, p1 = f32x16{}; u32x4 pw[4] = {};
#define PP_QK(j) do { const LAS unsigned char* kb_ = lds + LDS_K + ((j) % RD) * KS + hi * 1024 + r32 * 16; p0 = f32x16{}; p1 = f32x16{}; \
        _Pragma("unroll") for (int d0 = 0; d0 < NKC / 2; ++d0) { const bf16x8 b0_ = *(const LAS bf16x8*)(kb_ + d0 * 2048), b1_ = *(const LAS bf16x8*)(kb_ + d0 * 2048 + 512); \
            p0 = __builtin_amdgcn_mfma_f32_32x32x16_bf16(b0_, qr[d0], p0, 0, 0, 0); p1 = __builtin_amdgcn_mfma_f32_32x32x16_bf16(b1_, qr[d0], p1, 0, 0, 0); } } while (0)
#define PP_SOFTMAX(j) do { \
        if (MODE == 0) { _Pragma("unroll") for (int r = 0; r < 16; ++r) { const int kv_ = 64 * (t_lo + (j)) + crow(r, hi); int e0_ = kv_ - qi; e0_ = e0_ < 0 ? -e0_ : e0_; int e1_ = kv_ + 32 - qi; e1_ = e1_ < 0 ? -e1_ : e1_; \
            if (e0_ > 128) p0[r] = -INFINITY; if (e1_ > 128) p1[r] = -INFINITY; } } \
        float rm_ = fmaxf(p0[0], p1[0]); _Pragma("unroll") for (int r = 1; r < 16; ++r) rm_ = fmaxf(rm_, fmaxf(p0[r], p1[r])); rm_ = swapmax(rm_); \
        const float mn_ = fmaxf(m_run, rm_), alpha_ = __builtin_amdgcn_exp2f(m_run - mn_); m_run = mn_; float sum_ = 0.f; \
        _Pragma("unroll") for (int r = 0; r < 16; ++r) { p0[r] = __builtin_amdgcn_exp2f(p0[r] - mn_); p1[r] = __builtin_amdgcn_exp2f(p1[r] - mn_); sum_ += p0[r] + p1[r]; } \
        l_run = l_run * alpha_ + sum_; \
        _Pragma("unroll") for (int d = 0; d < NVB; ++d) _Pragma("unroll") for (int r = 0; r < 16; ++r) o[d][r] *= alpha_; \
        pw[0] = (u32x4){cvtpk(p0[0], p0[1]), cvtpk(p0[2], p0[3]), cvtpk(p0[4], p0[5]), cvtpk(p0[6], p0[7])}; pw[1] = (u32x4){cvtpk(p0[8], p0[9]), cvtpk(p0[10], p0[11]), cvtpk(p0[12], p0[13]), cvtpk(p0[14], p0[15])}; \
        pw[2] = (u32x4){cvtpk(p1[0], p1[1]), cvtpk(p1[2], p1[3]), cvtpk(p1[4], p1[5]), cvtpk(p1[6], p1[7])}; pw[3] = (u32x4){cvtpk(p1[8], p1[9]), cvtpk(p1[10], p1[11]), cvtpk(p1[12], p1[13]), cvtpk(p1[14], p1[15])}; } while (0)
#define PP_PV(j) do { const unsigned vb_ = lds0 + LDS_V + ((j) % RD) * VS + ((lane >> 4) & 1) * 32 + (lane & 3) * 8 + (4 * hi + ((lane & 15) >> 2)) * 64; \
        _Pragma("unroll") for (int d = 0; d < NVB; ++d) { s16x4 lo_[4], hh_[4]; \
            _Pragma("unroll") for (int ks = 0; ks < 4; ++ks) { lo_[ks] = vtr(vb_ + d * 4096 + ks * 1024); hh_[ks] = vtr(vb_ + d * 4096 + ks * 1024 + 512); } \
            asm volatile("s_waitcnt lgkmcnt(0)" ::: "memory"); __builtin_amdgcn_sched_barrier(0); \
            _Pragma("unroll") for (int ks = 0; ks < 4; ++ks) { const bf16x8 vf_ = (bf16x8){lo_[ks][0], lo_[ks][1], lo_[ks][2], lo_[ks][3], hh_[ks][0], hh_[ks][1], hh_[ks][2], hh_[ks][3]}; \
                o[d] = __builtin_amdgcn_mfma_f32_32x32x16_bf16(vf_, __builtin_bit_cast(bf16x8, pw[ks]), o[d], 0, 0, 0); } } } while (0)
    PP_DMA_K(0); PP_DMA_V(0); if (n > 1) { PP_DMA_K(1); PP_DMA_V(1); } if (n > 2) PP_DMA_K(2);
    asm volatile("s_waitcnt vmcnt(0) lgkmcnt(0)\n\ts_barrier" ::: "memory");
    if (grp == 1) asm volatile("s_barrier" ::: "memory");
    int infl = 0;
    if (PP_ACTIVE(0)) PP_QK(0);
    wait_vm_bar(infl);
    if (grp == 1) PP_BATCH(0, infl);
    if (PP_ACTIVE(0)) PP_SOFTMAX(0);
    wait_vm_bar(infl);
    for (int j = 0; j < n; ++j) {
        if (grp == 0) PP_BATCH(j, infl);
        const bool act = PP_ACTIVE(j), actn = (j + 1 < n) && PP_ACTIVE(j + 1);
        if (act) PP_PV(j);
        if (actn) PP_QK(j + 1);
        wait_vm_bar(infl);
        if (j + 1 < n) {
            if (grp == 1) PP_BATCH(j + 1, infl);
            if (actn) PP_SOFTMAX(j + 1);
            wait_vm_bar(infl);
        }
    }
    if (grp == 0) asm volatile("s_barrier" ::: "memory");
    const float linv = 1.0f / swapsum(l_run);
#pragma unroll
    for (int d = 0; d < NVB; ++d)
#pragma unroll
        for (int r4 = 0; r4 < 4; ++r4) { f32x4 v = {o[d][4 * r4] * linv, o[d][4 * r4 + 1] * linv, o[d][4 * r4 + 2] * linv, o[d][4 * r4 + 3] * linv};
            *(u32x2*)(S.o + (size_t)r32 * S.opitch + 32 * d + 8 * r4 + 4 * hi) = pack4(v); }
    asm volatile("s_waitcnt lgkmcnt(0)\n\ts_barrier" ::: "memory");
#undef PP_DMA_K
#undef PP_DMA_V
#undef PP_BATCH
#undef PP_ACTIVE
#undef PP_QK
#undef PP_SOFTMAX
#undef PP_PV
}
}
#define SC_AFTER_PROLOGUE() do {} while (0)
#define SC_AFTER_INPROJ(l) do {} while (0)
#define SC_AFTER_UP(l) do {} while (0)
#define SC_AFTER_MLA(l) do {} while (0)
#define SC_AFTER_BRANCH(l) do {} while (0)
#define SC_AFTER_WOUT(l) do {} while (0)
#define SC_AFTER_NORM2(l) do {} while (0)
#define SC_AFTER_GU(l) do {} while (0)
#define SC_AFTER_DOWN(l) do {} while (0)
#define SC_AFTER_ROUTE(l) do {} while (0)
#define SC_AFTER_MOEGU(l, h) do {} while (0)
#define SC_AFTER_MOED(l, h) do {} while (0)
#define SC_FINAL() do {} while (0)

struct Args { const float* in[23]; float* out; unsigned char* ws; };
#define WSP(type, off) ((type*)(F.ws + (off)))
#define PHASE() Frame Fp = F; Fp.ws = opq_p(F.ws); Fp.in = opq_p(F.in); Fp.out = opq_p(F.out); Fp.tid = opq_v((int)threadIdx.x); Fp.lane = Fp.tid & 63; Fp.wave = __builtin_amdgcn_readfirstlane(Fp.tid >> 6); (void)Fp
#define FWS(type, off) ((type*)(Fp.ws + (off)))
#define X_ (Fp.out)
#define H_ FWS(bf16_t, WS_H)
#define Pb_ FWS(bf16_t, WS_R + R_P)
#define Gb_ FWS(bf16_t, WS_R + R_G)
#define QB_ FWS(bf16_t, WS_R + R_QB)
#define KVB_ FWS(bf16_t, WS_R + R_KVB)
#define Yb_ FWS(bf16_t, WS_R + R_Y)
#define MEMN_ FWS(bf16_t, WS_MEMN)
#define MEMKV_ FWS(bf16_t, WS_MEMKV)
#define ACT_ FWS(bf16_t, WS_R + R_ACT)
#define ASORT_ FWS(bf16_t, WS_R + R_ASORT)
#define YOUT_ FWS(bf16_t, WS_R + R_YOUT)
#define SSQ_ FWS(float, WS_MISC + MS_SSQ)
#define TEXP_ FWS(const int, WS_MISC + MS_TEXP)
#define POS_ ((const int*)Fp.in[I_POS])
#define HSC_ FWS(float, WS_MISC + MS_HSC)
#define ASC_ FWS(float, WS_MISC + MS_ASC)
#define WSIN_ FWS(float, WS_MISC + MS_WSIN)
#define WSGU_ FWS(float, WS_MISC + MS_WSGU)

#define GRID_BAR() xcd_barrier(bar)
#ifndef MLA_STAG
#define MLA_STAG false
#endif
template <int l> __device__ __forceinline__ void layer_body(const Frame& F, const XcdBarrier& bar, const int bx) {
        if (l > 0) {
            PHASE();
            prep_ffn_weights(Fp, l);
            norm_phase(Fp, X_, X_, Fp.in[I_GMIX] + l * DM, (l & 1) == 0, true);
            GRID_BAR();
        }
        {   PHASE();
            ProbSimple p{DM, DM, DM, (const char*)H_, (const char*)wmix(Fp, l, WL_IN)}; pg8::StaticOrder S; S.init(T / 256, NT_IN, Fp.G, bx);
            EpiInproj E{Pb_, Gb_, SSQ_, POS_, HSC_, WSIN_ + l * NT_IN * 256}; pg8::gemm_phase<true>(Fp.lds, p, S, E); }
        if (l == 0) { PHASE();
            ProbSimple p{DM, DM * 2, DM * 2, (const char*)MEMN_, (const char*)FWS(bf16_t, WS_WMKV)}; pg8::StaticOrder S; S.init(NB * MEML / 256, 16, Fp.G, bx);
            EpiPlain E{MEMKV_, 4096}; pg8::gemm_phase(Fp.lds, p, S, E); }
        GRID_BAR();
        SC_AFTER_INPROJ(l);
        {   PHASE();
            ProbSimple p{UPK, PW * 2, UPK * 2, (const char*)(Pb_ + P_CQ), (const char*)wmix(Fp, l, WL_UP)}; pg8::StaticOrder S; S.init(T / 256, UPN / 256, Fp.G, bx);
            EpiUp E{QB_, KVB_, SSQ_, POS_}; pg8::gemm_phase(Fp.lds, p, S, E); }
        {   PHASE();
            for (int i = Fp.vcu; i < 1024; i += Fp.G) {
                const int hl = i & 3, qb = (i >> 2) & 15, kvh = (i >> 6) & 1, b = i >> 7, h = kvh * 4 + hl; const size_t rowb = (size_t)b * SEQ; const int q0 = qb * 256;
                att::Src s; s.q = Pb_ + (rowb + q0 + Fp.wave * 32) * PW + P_QA + h * 64; s.qpitch = PW; s.k0 = Pb_ + rowb * PW + P_KA + kvh * 64; s.k0pitch = PW; s.k1 = s.k0; s.k1pitch = PW;
                s.v = Pb_ + rowb * PW + P_VA + kvh * 64; s.vpitch = PW; s.o = Yb_ + (rowb + q0 + Fp.wave * 32) * YW + h * 64; s.opitch = YW;
                const int t_lo = (q0 / 64 - 2) < 0 ? 0 : (q0 / 64 - 2), t_hi = (q0 / 64 + 6) > SEQ / 64 ? SEQ / 64 : (q0 / 64 + 6);
                att::unit<8, 2, 0>(Fp.lds, s, t_lo, t_hi, q0, Fp.in[I_SINK][l * 8 + h] * LOG2E);
            } }
        {   PHASE();
            for (int i = Fp.vcu; i < 512; i += Fp.G) {
                const int qb = i & 15, h = (i >> 4) & 3, b = i >> 6; const size_t rowq = (size_t)b * SEQ + qb * 256 + Fp.wave * 32;
                att::Src s; s.q = Pb_ + rowq * PW + P_QM + h * 128; s.qpitch = PW; s.k0 = MEMKV_ + (size_t)b * MEML * 4096 + l * 1024 + h * 128; s.k0pitch = 4096; s.k1 = s.k0 + 64; s.k1pitch = 4096;
                s.v = MEMKV_ + (size_t)b * MEML * 4096 + l * 1024 + 512 + h * 128; s.vpitch = 4096; s.o = Yb_ + rowq * YW + 1024 + h * 128; s.opitch = YW;
                att::unit<16, 4, 1>(Fp.lds, s, 0, MEML / 64, 0, 0.f);
            } }
        GRID_BAR();
        SC_AFTER_UP(l);
        {   PHASE();
            for (int i = Fp.vcu; i < 1024; i += Fp.G) {
                const int qb = i & 15, h = (i >> 4) & 7, b = i >> 7; const size_t rowb = (size_t)b * SEQ, rowq = rowb + qb * 256 + Fp.wave * 32;
                att::Src s; s.q = QB_ + rowq * QBW + h * 96; s.qpitch = QBW; s.k0 = KVB_ + rowb * KVW + h * 128; s.k0pitch = KVW; s.k1 = Pb_ + rowb * PW + P_KR; s.k1pitch = PW;
                s.v = KVB_ + rowb * KVW + h * 128 + 64; s.vpitch = KVW; s.o = Yb_ + rowq * YW + 512 + h * 64; s.opitch = YW;
                att::unit_pf<12, 2, MLA_STAG>(Fp.lds, s, 0, SEQ / 64);
            } }
        GRID_BAR();
        SC_AFTER_MLA(l);
        {   PHASE();
            ProbSimple p{1536, YW * 2, 1536 * 2, (const char*)Yb_, (const char*)wmix(Fp, l, WL_BR)}; pg8::StaticOrder S; S.init(T / 256, DM / 256, Fp.G, bx);
            EpiBranch E{Gb_, H_}; pg8::gemm_phase(Fp.lds, p, S, E); }
        GRID_BAR();
        SC_AFTER_BRANCH(l);
        {   PHASE();
            ProbSimple p{DM, DM * 2, DM * 2, (const char*)H_, (const char*)wmix(Fp, l, WL_OUT)}; pg8::StaticOrder S; S.init(T / 256, DM / 256, Fp.G, bx);
            EpiResid E{l == 0 ? Fp.in[I_X] : X_, X_}; pg8::gemm_phase(Fp.lds, p, S, E); }
        GRID_BAR();
        SC_AFTER_WOUT(l);
        if ((l & 1) == 0) {
            {   PHASE(); norm_phase(Fp, X_, nullptr, Fp.in[I_GFFN] + l * DM, false, GU_I8(l) != 0); }
            GRID_BAR();
            SC_AFTER_NORM2(l);
            {   PHASE();
                constexpr bool i8 = GU_I8(l) != 0; constexpr unsigned eb = i8 ? 1 : 2;
                ProbSimple p{DM, DM * eb, DM * eb, (const char*)H_, (const char*)FWS(bf16_t, WS_WFFN + WF_GU)}; pg8::StaticOrder S; S.init(T / 256, 2 * DFF / 256, Fp.G, bx);
                EpiSwiglu E{ACT_, 0, HSC_, WSGU_}; pg8::gemm_phase<i8>(Fp.lds, p, S, E); }
            GRID_BAR();
            SC_AFTER_GU(l);
            {   PHASE();
                ProbSimple p{DFF, DFF * 2, DFF * 2, (const char*)ACT_, (const char*)FWS(bf16_t, WS_WFFN + WF_D)}; pg8::StaticOrder S; S.init(T / 256, DM / 256, Fp.G, bx);
                EpiResid E{X_, X_}; pg8::gemm_phase(Fp.lds, p, S, E); }
            GRID_BAR();
            SC_AFTER_DOWN(l);
        } else {
            {   PHASE(); norm_router_phase(Fp, X_, Fp.in[I_GFFN] + l * DM, Fp.in[I_WR] + (size_t)(l >> 1) * DM * NE, GU_I8(l) != 0); }
            GRID_BAR();
            {   PHASE(); moe_assign_phase(Fp, GU_I8(l) != 0); }
            GRID_BAR();
            SC_AFTER_ROUTE(l);
            {   constexpr int half = 0; (void)half;
                {   PHASE();
                    const int nrt = TEXP_[MAXRT];
                    constexpr bool i8 = GU_I8(l) != 0; constexpr unsigned eb = i8 ? 1 : 2;
                    ProbMoe p{DM, DM * eb, DM * eb, (const char*)ASORT_, (const char*)FWS(bf16_t, WS_WFFN + WF_GU), 0}; MoeOrder S; S.base.init(nrt, 2 * DFF / 256, Fp.G, bx); S.lo = 0; S.texp = TEXP_;
                    EpiSwiglu E{ACT_, 0, ASC_, WSGU_}; pg8::gemm_phase<i8>(Fp.lds, p, S, E); }
                GRID_BAR();
                SC_AFTER_MOEGU(l, half);
                {   PHASE();
                    const int nrt = TEXP_[MAXRT];
                    ProbMoe p{DFF, DFF * 2, DFF * 2, (const char*)ACT_, (const char*)FWS(bf16_t, WS_WFFN + WF_D), 0}; MoeOrder S; S.base.init(nrt, DM / 256, Fp.G, bx); S.lo = 0; S.texp = TEXP_;
                    EpiYout E{YOUT_}; pg8::gemm_phase(Fp.lds, p, S, E); }
                GRID_BAR();
                SC_AFTER_MOED(l, half);
            }
        }
    }

__global__ void __launch_bounds__(NWAVES * 64, 2) fwd(Args args) {
    extern __shared__ __attribute__((aligned(16))) unsigned char lds_raw[];
    Frame F;
    F.lds = (LAS unsigned char*)lds_raw;
    F.MISC = (volatile LAS unsigned*)(F.lds + LDSCTL_OFF);
    F.tid = threadIdx.x; F.lane = F.tid & 63; F.wave = __builtin_amdgcn_readfirstlane(F.tid >> 6);
    F.G = gridDim.x; { const int bx = blockIdx.x; F.vcu = (F.G % 8 == 0) ? (bx % 8) * (F.G / 8) + bx / 8 : bx; }
    F.ws = args.ws; F.ctl = (gu32*)(args.ws + WS_CTL); F.out = args.out;
    F.in = (const float* const*)__builtin_amdgcn_kernarg_segment_ptr();
    for (int u = F.tid; u < (LDS_BYTES - LDSCTL_OFF) / 4; u += NWAVES * 64) ((LAS unsigned*)(F.lds + LDSCTL_OFF))[u] = 0u;
    __syncthreads();
    XcdBarrier bar = xcd_barrier_post((unsigned*)(F.ctl + CW_BAR), F.MISC + 8);

    const int bx = (int)blockIdx.x;

    {   PHASE();
        prep_mixer_weights(Fp);
        memnorm_phase(Fp);
        prep_ffn_weights(Fp, 0);
        norm_phase(Fp, Fp.in[I_X], nullptr, Fp.in[I_GMIX], false, true); }
    GRID_BAR();
    SC_AFTER_PROLOGUE();

    layer_body<0>(F, bar, bx); layer_body<1>(F, bar, bx); layer_body<2>(F, bar, bx); layer_body<3>(F, bar, bx);
    {   PHASE(); final_norm_phase(Fp, X_, Fp.in[I_GFIN], true); }
    SC_FINAL();
}

extern "C" void kernel_launch(void* const* d_in, const int* in_sizes, int n_in, void* d_out, int out_size, void* d_ws, size_t ws_size, hipStream_t stream) {
    static int grid = 0;
    if (grid == 0) {
        if (n_in != 23 || out_size != T * DM || ws_size < WS_END) { fprintf(stderr, "kernel_launch: unexpected problem (n_in %d, out %d, ws %zu < %zu)\n", n_in, out_size, ws_size, (size_t)WS_END); grid = -1; return; }
        int dev = 0, cus = 0;
        if (hipGetDevice(&dev) != hipSuccess || hipDeviceGetAttribute(&cus, hipDeviceAttributeMultiprocessorCount, dev) != hipSuccess) { grid = -1; return; }
        if (hipFuncSetAttribute((const void*)fwd, hipFuncAttributeMaxDynamicSharedMemorySize, LDS_BYTES) != hipSuccess) { fprintf(stderr, "kernel_launch: hipFuncSetAttribute failed\n"); grid = -1; return; }
        int per_cu = 0;
        if (hipOccupancyMaxActiveBlocksPerMultiprocessor(&per_cu, (const void*)fwd, NWAVES * 64, LDS_BYTES) != hipSuccess || per_cu < 1) fprintf(stderr, "kernel_launch: occupancy query says %d\n", per_cu);
        (void)hipGetLastError();
        grid = cus;
    }
    if (grid < 0) return;
    if (hipMemsetAsync((char*)d_ws + WS_CTL, 0, CTL_ZERO_BYTES, stream) != hipSuccess) return;
    Args a{};
    for (int i = 0; i < 23; ++i) a.in[i] = (const float*)d_in[i];
    a.out = (float*)d_out; a.ws = (unsigned char*)d_ws;
    hipLaunchKernelGGL(fwd, dim3(grid), dim3(NWAVES * 64), LDS_BYTES, stream, a);
}
```

```cpp
#include <hip/hip_runtime.h>
#include <cstdio>
#include <cstdint>

#ifndef SELFCHECK
#define SELFCHECK 0
#endif
#ifndef GU_I8_MASK
#define GU_I8_MASK 0xF
#endif
#define GU_I8(l) ((((unsigned)GU_I8_MASK) >> (l)) & 1u)

#define GAS __attribute__((address_space(1)))
#define LAS __attribute__((address_space(3)))
typedef unsigned short bf16_t;
typedef short bf16x8 __attribute__((ext_vector_type(8)));
typedef short s16x4 __attribute__((ext_vector_type(4)));
typedef short v4i16_t __attribute__((ext_vector_type(4)));
typedef float f32x2 __attribute__((ext_vector_type(2)));
typedef float f32x4 __attribute__((ext_vector_type(4)));
typedef float f32x16 __attribute__((ext_vector_type(16)));
typedef unsigned u32x2 __attribute__((ext_vector_type(2)));
typedef unsigned u32x4 __attribute__((ext_vector_type(4)));
typedef int i32x4 __attribute__((ext_vector_type(4)));
typedef GAS unsigned gu32;
#define RLX_AGENT __ATOMIC_RELAXED, __HIP_MEMORY_SCOPE_AGENT

constexpr int NB = 8, SEQ = 4096, T = NB * SEQ, DM = 1024, DEPTH = 4, MEML = 256, DFF = 3584, NE = 8;
constexpr int INW = 4768;
constexpr int PW = 1792;
constexpr int GW = 3072;
constexpr int QBW = 768, KVW = 1024, YW = 1536;
constexpr int NT_IN = 19;
constexpr int P_QA = 0, P_KA = 512, P_VA = 640, P_CQ = 768, P_CKV = 1024, P_KR = 1152, P_QM = 1280;
constexpr int UPK = 384, UPN = 1792;
constexpr int MAXSLOT = 67584;
constexpr int MAXRT = MAXSLOT / 256;
constexpr int HALF_RT = 132;
constexpr float EPS = 1e-6f;
constexpr float LOG2E = 1.4426950408889634f;
constexpr float C_A = 0.125f * LOG2E;
constexpr float C_B = 0.10206207261596575f * LOG2E;
constexpr float C_M = 0.08838834764831845f * LOG2E;

constexpr size_t MiB = 1u << 20;
constexpr size_t WS_CTL = 0, CTL_ZERO_BYTES = 1 * MiB;
constexpr size_t WS_MISC = 1 * MiB;
constexpr size_t WL_IN = 0, WL_UP = (size_t)NT_IN * 256 * DM * 2, WL_BR = WL_UP + (size_t)UPN * UPK * 2, WL_OUT = WL_BR + (size_t)3 * DM * 512 * 2, WL_SIZE = WL_OUT + (size_t)DM * DM * 2;
constexpr size_t WS_WMIX = 8 * MiB;
constexpr size_t WS_WMKV = WS_WMIX + 4 * ((WL_SIZE + MiB - 1) / MiB) * MiB;
constexpr size_t WL_STRIDE = ((WL_SIZE + MiB - 1) / MiB) * MiB;
constexpr size_t WS_WFFN = WS_WMKV + 8 * MiB;
constexpr size_t WF_GU = 0, WF_D = (size_t)2 * DFF * DM * 2, WF_STRIDE = WF_D + (size_t)DM * DFF * 2;
constexpr size_t WS_H = WS_WFFN + 8 * WF_STRIDE;
constexpr size_t WS_MEMN = WS_H + (size_t)T * DM * 2;
constexpr size_t WS_MEMKV = WS_MEMN + (size_t)NB * MEML * DM * 2;
constexpr size_t WS_R = WS_MEMKV + (size_t)NB * MEML * 4096 * 2;
constexpr size_t R_P = 0, R_G = R_P + (size_t)T * PW * 2, R_QB = R_G + (size_t)T * GW * 2, R_KVB = R_QB + (size_t)T * QBW * 2, R_Y = R_KVB + (size_t)T * KVW * 2, R_END_MIX = R_Y + (size_t)T * YW * 2;
constexpr size_t R_BRS = R_P;
constexpr size_t R_ACT = 0;
constexpr size_t R_ASORT = (size_t)MAXSLOT * DFF * 2;
constexpr size_t R_YOUT = R_ASORT;
constexpr size_t R_END_FFN = R_YOUT + (size_t)MAXSLOT * DM * 2;
constexpr size_t R_SIZE = R_END_MIX > R_END_FFN ? R_END_MIX : R_END_FFN;
constexpr size_t WS_END = WS_R + R_SIZE;
static_assert(WS_END < 1020ull * MiB, "workspace budget");
constexpr size_t MS_TOKE = 0;
constexpr size_t MS_TOKW = MS_TOKE + (size_t)T * 8;
constexpr size_t MS_SLOT = MS_TOKW + (size_t)T * 8;
constexpr size_t MS_CNT = MS_SLOT + (size_t)T * 8;
constexpr size_t MS_TEXP = MS_CNT + 256 * 8 * 4;
constexpr size_t MS_SSQ = MS_TEXP + 2048;
constexpr size_t MS_SNAP = MS_SSQ + (size_t)T * 32;
constexpr size_t MS_HSC = MS_SNAP + 64 * 1024 * 4;
constexpr size_t MS_ASC = MS_HSC + (size_t)T * 4;
constexpr size_t MS_WSIN = MS_ASC + (size_t)MAXSLOT * 4;
constexpr size_t MS_WSGU = MS_WSIN + (size_t)4 * NT_IN * 256 * 4;
constexpr size_t MS_END = MS_WSGU + (size_t)8 * 2 * DFF * 4;
static_assert(MS_END <= 7 * MiB, "misc map");
constexpr int CW_BAR = 4096;
constexpr int CW_DIAG = 16384;
constexpr int CW_CODE = 16384 + 512;

constexpr int RING_BYTES = 131072;
constexpr int LDSCTL_OFF = RING_BYTES;
constexpr int LDS_BYTES = 147456;
constexpr int NWAVES = 8;

#define LDS_WAIT() asm volatile("s_waitcnt lgkmcnt(0)" ::: "memory")
#define VM_WAIT() asm volatile("s_waitcnt vmcnt(0)" ::: "memory")

__device__ __forceinline__ unsigned f2bf(float f) { unsigned u = __builtin_bit_cast(unsigned, f); return (u + 0x7fffu + ((u >> 16) & 1u)) >> 16; }
__device__ __forceinline__ unsigned pk2(float lo, float hi) { return f2bf(lo) | (f2bf(hi) << 16); }
__device__ __forceinline__ float bf2f(unsigned short b) { return __builtin_bit_cast(float, (unsigned)b << 16); }
__device__ __forceinline__ float bflo(unsigned w) { return __builtin_bit_cast(float, w << 16); }
__device__ __forceinline__ float bfhi(unsigned w) { return __builtin_bit_cast(float, w & 0xffff0000u); }
typedef __bf16 bf16x2_t __attribute__((ext_vector_type(2)));
__device__ __forceinline__ unsigned cvtpk(float lo, float hi) { f32x2 v = {lo, hi}; bf16x2_t b = __builtin_convertvector(v, bf16x2_t); return __builtin_bit_cast(unsigned, b); }
__device__ __forceinline__ float wave_sum(float v) {
#pragma unroll
    for (int o = 1; o < 64; o <<= 1) v += __shfl_xor(v, o);
    return v;
}
__device__ __forceinline__ float fast_sigmoid(float x) { return __builtin_amdgcn_rcpf(1.0f + __builtin_amdgcn_exp2f(-x * LOG2E)); }


__device__ __forceinline__ int opq_v(int x) { asm volatile("" : "+v"(x)); return x; }
__device__ __forceinline__ int opq_s(int x) { asm volatile("" : "+s"(x)); return x; }
template <class Tp> __device__ __forceinline__ Tp* opq_p(Tp* p) { const unsigned long long u = (unsigned long long)p; unsigned lo = __builtin_amdgcn_readfirstlane((unsigned)u), hi = __builtin_amdgcn_readfirstlane((unsigned)(u >> 32)); asm volatile("" : "+s"(lo), "+s"(hi)); return (Tp*)(((unsigned long long)hi << 32) | lo); }

__constant__ float IFR_HI[32] = {1.591549367e-01f, 1.193493679e-01f, 8.949939907e-02f, 6.711508334e-02f, 5.032921210e-02f, 3.774158657e-02f, 2.830219641e-02f, 2.122365311e-02f, 1.591549441e-02f, 1.193493698e-02f, 8.949940093e-03f, 6.711508147e-03f, 5.032921210e-03f, 3.774158424e-03f, 2.830219688e-03f, 2.122365171e-03f, 1.591549488e-03f, 1.193493721e-03f, 8.949940093e-04f, 6.711508031e-04f, 5.032921326e-04f, 3.774158540e-04f, 2.830219455e-04f, 2.122365258e-04f, 1.591549371e-04f, 1.193493736e-04f, 8.949940093e-05f, 6.711508468e-05f, 5.032921035e-05f, 3.774158540e-05f, 2.830219637e-05f, 2.122365186e-05f};
__constant__ float IFR_LO[32] = {6.420638243e-09f, 2.294664903e-09f, 2.542919653e-09f, -3.316028840e-10f, 5.173299289e-12f, -1.848551645e-09f, -5.826552019e-10f, -3.431038786e-10f, -1.029942243e-10f, 4.320196978e-11f, 6.802745173e-11f, 1.531042237e-10f, 5.173301024e-13f, 4.797548470e-11f, -1.048316434e-10f, 1.053879969e-10f, -5.686555046e-11f, -1.896286773e-11f, 6.802744999e-12f, 2.695195456e-11f, -1.158979943e-11f, -6.843983713e-12f, 1.279990003e-11f, 1.807650600e-12f, 5.954976963e-12f, -3.351478166e-12f, 6.802745216e-13f, -1.670379113e-12f, 1.751403167e-12f, -6.843983930e-13f, -5.389994549e-13f, 9.083608431e-13f};
__device__ __forceinline__ void rot_cs(float posf, int idx, float& c, float& s) {
    const float ch = IFR_HI[idx], cl = IFR_LO[idx];
    const float p = posf * ch, e = __builtin_fmaf(posf, ch, -p);
    const float fr = __builtin_amdgcn_fractf(p) + (e + posf * cl);
    s = __builtin_amdgcn_sinf(fr); c = __builtin_amdgcn_cosf(fr);
}

#define XB_TMO      128
#define XB_XCNT(j)  (256  + 64 * (j))
#define XB_XSUB(j)  (1280 + 64 * (j))
#define XB_XGEN(j)  (2304 + 64 * (j))
#define XB_TOP      3328
#define XB_TOPGEN   3392
#define XCD_BAR_WORDS 3456
#define XB_SPIN_CAP (1u << 20)

__device__ __forceinline__ unsigned xb_ld(unsigned* p)              { return __hip_atomic_load(p, __ATOMIC_RELAXED, __HIP_MEMORY_SCOPE_AGENT); }
__device__ __forceinline__ unsigned xb_add(unsigned* p, unsigned v) { return __hip_atomic_fetch_add(p, v, __ATOMIC_RELAXED, __HIP_MEMORY_SCOPE_AGENT); }
__device__ __forceinline__ unsigned xb_xcc_id() { return (unsigned)__builtin_amdgcn_s_getreg((3 << 11) | 20) & 0xFu; }
#define XB_SPIN(cond, bar) do { unsigned _sp = 0; while (cond) { __builtin_amdgcn_s_sleep(1); \
    if ((++_sp & 255u) == 0u) { if (xb_ld(&(bar)[XB_TMO])) break; if (_sp > XB_SPIN_CAP) { atomicAdd(&(bar)[XB_TMO], 1u); break; } } } } while (0)

struct XcdBarrier { unsigned* bar; unsigned x; volatile LAS unsigned* st; };

__device__ __forceinline__ XcdBarrier xcd_barrier_post(unsigned* bar, volatile LAS unsigned* st) {
    XcdBarrier b; b.bar = bar; b.x = xb_xcc_id(); b.st = st;
    if (threadIdx.x == 0) (void)xb_add(&bar[XB_XCNT(b.x)], 1u);
    return b;
}
__device__ __forceinline__ void xcd_barrier_complete(unsigned* bar, unsigned x, unsigned& nloc, unsigned& nx) {
    const unsigned G = gridDim.x * gridDim.y * gridDim.z;
    unsigned sum, cnt, mine, sp = 0u;
    for (;;) {
        sum = 0u; cnt = 0u; mine = 0u;
#pragma unroll
        for (unsigned j = 0; j < 16; ++j) { const unsigned c = xb_ld(&bar[XB_XCNT(j)]); sum += c; cnt += (c > 0u) ? 1u : 0u; mine = (j == x) ? c : mine; }
        if (sum == G) break;
        __builtin_amdgcn_s_sleep(1);
        if ((++sp & 255u) == 0u) { if (xb_ld(&bar[XB_TMO])) break; if (sp > XB_SPIN_CAP) { atomicAdd(&bar[XB_TMO], 1u); break; } }
    }
    nloc = mine > 0u ? mine : 1u; nx = cnt > 0u ? cnt : 1u;
}
__device__ __forceinline__ void xcd_barrier(const XcdBarrier& b) {
    asm volatile("s_waitcnt vmcnt(0)" ::: "memory");
    __syncthreads();
    if (threadIdx.x == 0) {
        unsigned* bar = b.bar;
        __builtin_amdgcn_s_waitcnt(0);
        unsigned nloc = b.st[0], nx = b.st[1];
        if (nloc == 0u) { xcd_barrier_complete(bar, b.x, nloc, nx); b.st[0] = nloc; b.st[1] = nx; }
        const unsigned old = xb_add(&bar[XB_XSUB(b.x)], 1u);
        const unsigned gen = old / nloc;
        if (old + 1u == (gen + 1u) * nloc) {
            __builtin_amdgcn_fence(__ATOMIC_RELEASE, "agent");
            asm volatile("s_waitcnt vmcnt(0)" ::: "memory");
            const unsigned og = xb_add(&bar[XB_TOP], 1u);
            const unsigned tg = og / nx;
            if (og + 1u == (tg + 1u) * nx) xb_add(&bar[XB_TOPGEN], 1u);
            else XB_SPIN(xb_ld(&bar[XB_TOPGEN]) == tg, bar);
            __builtin_amdgcn_fence(__ATOMIC_ACQUIRE, "agent");
            xb_add(&bar[XB_XGEN(b.x)], 1u);
            asm volatile("s_waitcnt vmcnt(0)" ::: "memory");
        } else {
            XB_SPIN(xb_ld(&bar[XB_XGEN(b.x)]) == gen, bar);
            __builtin_amdgcn_fence(__ATOMIC_ACQUIRE, "agent");
            asm volatile("s_waitcnt vmcnt(0)" ::: "memory");
        }
    }
    __syncthreads();
}

namespace pg8 {
constexpr int BM = 256, BK = 64, HALF = 128, HTB = HALF * BK * 2, STAGE_BYTES = 8 * HTB, NXCD = 8, WGM = 4;
constexpr int ESC_OFF = 131072 + 4096, ESC_SLOT = 3072;
__host__ __device__ __forceinline__ int lds_byte(int r, int c) { const int st = (r >> 4) * 2 + (c >> 5), rr = r & 15, cc = c & 31, ob = rr * 64 + cc * 2; return st * 1024 + (ob ^ (((ob >> 9) & 1) << 5)); }
__host__ __device__ __forceinline__ void stage_rc(int b, int& R, int& C) { const int st = b / 1024, sb = b % 1024, swz = sb ^ (((sb >> 9) & 1) << 5); R = (st >> 1) * 16 + swz / 64; C = (st & 1) * 32 + (swz % 64) / 2; }

struct Unit { int pm, pn, aux; };

struct StaticOrder {
    int nM, nN, nwg, G, c;
    __device__ void init(int nM_, int nN_, int G_, int c_) { nM = nM_; nN = nN_; nwg = nM * nN; G = G_; c = c_; }
    __device__ bool next(int i, Unit& u) const {
        const long L = (long)i * G + c; if (L >= nwg) return false;
        int wgid = (int)L; { const int q = nwg / NXCD, r = nwg % NXCD, xcd = wgid % NXCD, off = wgid / NXCD; wgid = (xcd < r ? xcd * (q + 1) : r * (q + 1) + (xcd - r) * q) + off; }
        const int nig = WGM * nN, gid = wgid / nig, fm = gid * WGM, gsz = (nM - fm) < WGM ? (nM - fm) : WGM;
        u.pm = fm + ((wgid % nig) % gsz); u.pn = (wgid % nig) / gsz; u.aux = 0; return true;
    }
};

struct RowOrder {
    int nN, nwg, G, c, q;
    __device__ void init(int nM_, int nN_, int G_, int c_) { nN = nN_; nwg = nM_ * nN_; G = G_; c = c_; q = nwg / G_; }
    __device__ bool next(int i, Unit& u) const {
        const int L = (i < q) ? c * q + i : G * q + (i - q) * G + c; if (L >= nwg) return false;
        u.pm = L / nN; u.pn = L % nN; u.aux = 0; return true;
    }
};

template <bool I8> struct AccVec { typedef f32x4 type; };
template <> struct AccVec<true> { typedef i32x4 type; };
template <bool I8 = false, class Prob, class Sched, class Epi>
__device__ __forceinline__ void gemm_phase(LAS unsigned char* lds, const Prob& P, const Sched& S, const Epi& E) {
    const int tid = opq_v((int)threadIdx.x), wid = __builtin_amdgcn_readfirstlane(tid >> 6), lane = tid & 63, wr = wid >> 2, wc = wid & 3, fr = lane & 15, fq = lane >> 4;
    typedef typename AccVec<I8>::type accv_t;
    const int K = P.K, nt = K / (I8 ? 2 * BK : BK);
    unsigned voffA[2], voffB[2];
#pragma unroll
    for (int i = 0; i < 2; ++i) { int R, C; stage_rc(tid * 16 + i * 8192, R, C); voffA[i] = (unsigned)R * P.lda + (unsigned)C * 2u; voffB[i] = (unsigned)R * P.ldb + (unsigned)C * 2u; }
    const size_t kstep = (size_t)(BK * 2);
    const size_t hstepA = (size_t)HALF * P.lda, hstepB = (size_t)HALF * P.ldb;
    const unsigned ldsw = (unsigned)wid * 1024u;
    const int aoff = lds_byte(wr * 64 + fr, fq * 8), boff = lds_byte(wc * 32 + fr, fq * 8);
#define PG8_SA(b, h) (((b) * 2 + (h)) * HTB)
#define PG8_SB(b, h) ((4 + (b) * 2 + (h)) * HTB)
#define PG8_STAGE(bufoff, gbase, voff) do { _Pragma("unroll") for (int _i = 0; _i < 2; ++_i) \
        __builtin_amdgcn_global_load_lds((const unsigned*)((const char*)(gbase) + (voff)[_i]), (LAS unsigned*)(lds + (bufoff) + ldsw + _i * 8192), 16, 0, 0); } while (0)
#define PG8_LDA(dst, b, h) do { _Pragma("unroll") for (int m = 0; m < 4; ++m) _Pragma("unroll") for (int k = 0; k < 2; ++k) dst[m][k] = *(const LAS bf16x8*)(lds + PG8_SA(b, h) + aoff + m * 2048 + k * 1024); } while (0)
#define PG8_LDB(dst, b, h) do { _Pragma("unroll") for (int n = 0; n < 2; ++n) _Pragma("unroll") for (int k = 0; k < 2; ++k) dst[n][k] = *(const LAS bf16x8*)(lds + PG8_SB(b, h) + boff + n * 2048 + k * 1024); } while (0)
#define PG8_MMA(ai, bj, At, Bt) do { __builtin_amdgcn_s_setprio(1); _Pragma("unroll") for (int m = 0; m < 4; ++m) _Pragma("unroll") for (int n = 0; n < 2; ++n) _Pragma("unroll") for (int k = 0; k < 2; ++k) \
        { if constexpr (I8) acc[ai][bj][m][n] = __builtin_amdgcn_mfma_i32_16x16x64_i8(__builtin_bit_cast(i32x4, Bt[n][k]), __builtin_bit_cast(i32x4, At[m][k]), acc[ai][bj][m][n], 0, 0, 0); \
          else acc[ai][bj][m][n] = __builtin_amdgcn_mfma_f32_16x16x32_bf16(Bt[n][k], At[m][k], acc[ai][bj][m][n], 0, 0, 0); } __builtin_amdgcn_s_setprio(0); } while (0)
#define PG8_WAIT_V(n) asm volatile("s_waitcnt vmcnt(" #n ")" ::: "memory")
#define PG8_WAIT_L(n) asm volatile("s_waitcnt lgkmcnt(" #n ")" ::: "memory")
#define PG8_BAR __builtin_amdgcn_s_barrier()
#define PG8_SCHED __builtin_amdgcn_sched_barrier(0)
    Unit cur, nxt; int ui = 0;
    if (!S.next(0, cur)) return;
    accv_t acc[2][2][4][2];
#pragma unroll
    for (int a = 0; a < 2; ++a)
#pragma unroll
        for (int b = 0; b < 2; ++b)
#pragma unroll
            for (int m = 0; m < 4; ++m)
#pragma unroll
                for (int n = 0; n < 2; ++n) acc[a][b][m][n] = accv_t{};
    bf16x8 At[4][2], B0[2][2], B1[2][2];
    const char* cA = P.a_ptr(cur); const char* cB = P.b_ptr(cur);
    int eslot = 0;
    E.stage(lds + ESC_OFF, cur, wid, lane);
    PG8_STAGE(PG8_SB(0, 0), cB, voffB); PG8_STAGE(PG8_SB(0, 1), cB + hstepB, voffB); PG8_STAGE(PG8_SA(0, 0), cA, voffA); PG8_STAGE(PG8_SA(0, 1), cA + hstepA, voffA);
    if (wr == 1) PG8_BAR;
    PG8_WAIT_V(2); PG8_BAR;
    PG8_STAGE(PG8_SB(1, 0), cB + kstep, voffB); PG8_STAGE(PG8_SA(1, 0), cA + kstep, voffA); PG8_STAGE(PG8_SB(1, 1), cB + hstepB + kstep, voffB);
    PG8_WAIT_V(6); PG8_BAR;
    for (;;) {
        const bool has_next = S.next(ui + 1, nxt);
        const char* nA = has_next ? P.a_ptr(nxt) : cA; const char* nB = has_next ? P.b_ptr(nxt) : cB;
        for (int t = 0; t < nt; t += 2) {
            if constexpr (Epi::MID) { if (t == 8 || t == 16) E.mid(acc, cur, t >> 3, wr, wc, fr, fq); }
            const bool last = (t == nt - 2);
            if (last && has_next) E.stage(lds + ESC_OFF + (eslot ^ 1) * ESC_SLOT, nxt, wid, lane);
            const char* a1 = cA + (size_t)(t + 1) * kstep;
            const char* a2 = last ? nA : cA + (size_t)(t + 2) * kstep; const char* b2 = last ? nB : cB + (size_t)(t + 2) * kstep;
            const char* a3 = a2 + kstep; const char* b3 = b2 + kstep;
            PG8_LDB(B0, 0, 0); PG8_LDB(B1, 0, 1); PG8_SCHED; PG8_LDA(At, 0, 0); PG8_STAGE(PG8_SA(1, 1), a1 + hstepA, voffA);
            PG8_WAIT_V(8); PG8_WAIT_L(0); PG8_BAR; PG8_MMA(0, 0, At, B0); PG8_MMA(0, 1, At, B1); PG8_BAR; PG8_SCHED;
            PG8_LDA(At, 0, 1); PG8_STAGE(PG8_SB(0, 0), b2, voffB); PG8_STAGE(PG8_SB(0, 1), b2 + hstepB, voffB); PG8_STAGE(PG8_SA(0, 0), a2, voffA);
            PG8_WAIT_V(8); PG8_WAIT_L(0); PG8_BAR; PG8_MMA(1, 0, At, B0); PG8_MMA(1, 1, At, B1); PG8_BAR; PG8_SCHED;
            PG8_LDB(B0, 1, 0); PG8_LDB(B1, 1, 1); PG8_SCHED; PG8_LDA(At, 1, 0); PG8_STAGE(PG8_SA(0, 1), a2 + hstepA, voffA);
            PG8_WAIT_V(8); PG8_WAIT_L(0); PG8_BAR; PG8_MMA(0, 0, At, B0); PG8_MMA(0, 1, At, B1); PG8_BAR; PG8_SCHED;
            PG8_LDA(At, 1, 1); PG8_STAGE(PG8_SB(1, 0), b3, voffB); PG8_STAGE(PG8_SB(1, 1), b3 + hstepB, voffB); PG8_STAGE(PG8_SA(1, 0), a3, voffA);
            PG8_WAIT_V(8); PG8_WAIT_L(0); PG8_BAR; PG8_MMA(1, 0, At, B0); PG8_MMA(1, 1, At, B1); PG8_BAR; PG8_SCHED;
        }
        if (wr == 0) PG8_BAR;
        E(acc, cur, wr, wc, fr, fq, lds + ESC_OFF + eslot * ESC_SLOT);
        if (!has_next) break;
#pragma unroll
        for (int a = 0; a < 2; ++a)
#pragma unroll
            for (int b = 0; b < 2; ++b)
#pragma unroll
                for (int m = 0; m < 4; ++m)
#pragma unroll
                    for (int n = 0; n < 2; ++n) acc[a][b][m][n] = accv_t{};
        cur = nxt; cA = nA; cB = nB; ++ui; eslot ^= 1;
        if (wr == 1) PG8_BAR;
    }
    PG8_WAIT_V(0);
    PG8_BAR;
#undef PG8_SA
#undef PG8_SB
#undef PG8_STAGE
#undef PG8_LDA
#undef PG8_LDB
#undef PG8_MMA
#undef PG8_WAIT_V
#undef PG8_WAIT_L
#undef PG8_BAR
#undef PG8_SCHED
}
}

struct Frame {
    LAS unsigned char* lds;
    volatile LAS unsigned* MISC;
    gu32* ctl;
    unsigned char* ws;
    int tid, lane, wave, vcu, G;
    const float* const* in; float* out;
};
enum { I_X = 0, I_MEM, I_POS, I_GMIX, I_WIN, I_GQ, I_WUQ, I_GKV, I_WUKV, I_SINK, I_WMKV, I_WBR, I_WOUT, I_GFFN, I_WGD, I_WUD, I_WDD, I_WR, I_WGE, I_WUE, I_WDE, I_GMEM, I_GFIN };

__device__ __forceinline__ int sem_plain(int g) { return (g & ~31) + 8 * ((g >> 2) & 3) + 4 * ((g >> 4) & 1) + (g & 3); }
__device__ __forceinline__ int sem_rot64(int g) { return (g & ~63) + 32 * ((g >> 4) & 1) + 16 * ((g >> 5) & 1) + 4 * ((g >> 2) & 3) + (g & 3); }
__device__ __forceinline__ int inproj_src(int n) {
    const int pn = n >> 8, c = n & 255;
    if (pn < 2) return pn * 256 + sem_rot64(c);
    if (pn == 2) return c < 128 ? 512 + sem_rot64(c) : 640 + sem_plain(c - 128);
    if (pn == 3) return 768 + sem_plain(c);
    if (pn == 4) return c < 128 ? 1024 + sem_plain(c) : (c < 160 ? 1152 + (c - 128) : -1);
    if (pn < 7) return 1184 + (pn - 5) * 256 + sem_plain(c);
    return 1696 + (pn - 7) * 256 + sem_plain(c);
}

struct MapInproj { const float* W; __device__ __forceinline__ float load(int k, int n) const { const int s = inproj_src(n); return s >= 0 ? W[(size_t)k * INW + s] : 0.f; }
    __device__ __forceinline__ f32x4 load4(int k, int n) const { const int s = inproj_src(n); return s >= 0 ? *(const f32x4*)(W + (size_t)k * INW + s) : (f32x4){0.f, 0.f, 0.f, 0.f}; } };
struct MapUp { const float *Wq, *Wkv, *gq, *gkv;
    __device__ __forceinline__ f32x4 load4(int k, int n) const {
        if (n < 768) { if (k >= 256) return (f32x4){0.f, 0.f, 0.f, 0.f}; const int gg = n >> 5; const int s = (gg % 3 == 2) ? n : sem_plain(n); return *(const f32x4*)(Wq + (size_t)k * 768 + s) * gq[k]; }
        if (k < 256) return (f32x4){0.f, 0.f, 0.f, 0.f}; const int s = sem_plain(n - 768); return *(const f32x4*)(Wkv + (size_t)(k - 256) * 1024 + s) * gkv[k - 256]; }
    __device__ __forceinline__ float load(int k, int n) const {
        if (n < 768) { if (k >= 256) return 0.f; const int gg = n >> 5; const int s = (gg % 3 == 2) ? n : sem_plain(n); return gq[k] * Wq[(size_t)k * 768 + s]; }
        if (k < 256) return 0.f; const int s = sem_plain(n - 768); return gkv[k - 256] * Wkv[(size_t)(k - 256) * 1024 + s]; } };
struct MapPlain { const float* W; int ldw; __device__ __forceinline__ float load(int k, int n) const { return W[(size_t)k * ldw + sem_plain(n)]; }
    __device__ __forceinline__ f32x4 load4(int k, int n) const { return *(const f32x4*)(W + (size_t)k * ldw + sem_plain(n)); } };
struct MapNat { const float* W; int ldw; __device__ __forceinline__ float load(int k, int n) const { return W[(size_t)k * ldw + n]; }
    __device__ __forceinline__ f32x4 load4(int k, int n) const { return *(const f32x4*)(W + (size_t)k * ldw + n); } };
struct MapBr { const float* W;
    __device__ __forceinline__ float load(int k, int n) const { return W[(size_t)k * DM + sem_plain(n)]; }
    __device__ __forceinline__ f32x4 load4(int k, int n) const { return *(const f32x4*)(W + (size_t)k * DM + sem_plain(n)); } };
struct MapMemkv { const float* W; __device__ __forceinline__ float load(int k, int n) const { const int l = n >> 10, c = n & 1023; return W[((size_t)l * DM + k) * 1024 + sem_plain(c)]; }
    __device__ __forceinline__ f32x4 load4(int k, int n) const { const int l = n >> 10, c = n & 1023; return *(const f32x4*)(W + ((size_t)l * DM + k) * 1024 + sem_plain(c)); } };
struct MapGU { const float *Wg, *Wu; __device__ __forceinline__ float load(int k, int n) const { const int pn = n >> 8, c = n & 255; const int ch = 128 * pn + sem_plain(c & 127);
    const unsigned long long a = (unsigned long long)Wg, b = (unsigned long long)Wu, w = a ^ ((a ^ b) & (0ull - (unsigned long long)(c >> 7))); return ((const float*)w)[(size_t)k * DFF + ch]; }
    __device__ __forceinline__ f32x4 load4(int k, int n) const { const int pn = n >> 8, c = n & 255; const int ch = 128 * pn + sem_plain(c & 127);
        const unsigned long long a = (unsigned long long)Wg, b = (unsigned long long)Wu, w = a ^ ((a ^ b) & (0ull - (unsigned long long)(c >> 7))); return *(const f32x4*)((const float*)w + (size_t)k * DFF + ch); } };

template <class M> __device__ __forceinline__ void prep_item(const M& m, bf16_t* dst, int Kd, int nblk, LAS float* scr, int item, int lane) {
    const int kb = item / nblk, nb = item % nblk, k0 = 64 * kb, n0 = 32 * nb;
#pragma unroll 8
    for (int i = 0; i < 32; ++i) { const int kk = 2 * i + (lane >> 5); scr[kk * 33 + (lane & 31)] = m.load(k0 + kk, n0 + (lane & 31)); }
    LDS_WAIT(); asm volatile("" ::: "memory");
    const int c = lane & 7;
#pragma unroll
    for (int j = 0; j < 4; ++j) { const int n = (lane >> 3) + 8 * j; const LAS float* s = scr + (8 * c) * 33 + n;
        u32x4 o; o.x = pk2(s[0 * 33], s[1 * 33]); o.y = pk2(s[2 * 33], s[3 * 33]); o.z = pk2(s[4 * 33], s[5 * 33]); o.w = pk2(s[6 * 33], s[7 * 33]);
        *(u32x4*)(dst + (size_t)(n0 + n) * Kd + k0 + 8 * c) = o; }
    LDS_WAIT(); asm volatile("" ::: "memory");
}
template <class M> __device__ __forceinline__ void prep_tile(const M& m, bf16_t* dst, int Kd, int nblk, LAS unsigned char* tile, int item, int lane) {
    const int kb = item / nblk, nb = item % nblk, k0 = 128 * kb, n0 = 32 * nb, ng = lane & 7, kr = lane >> 3;
    f32x4 v[16];
#pragma unroll
    for (int i = 0; i < 16; ++i) v[i] = m.load4(k0 + 8 * i + kr, n0 + 4 * ng);
#pragma unroll
    for (int i = 0; i < 16; ++i)
#pragma unroll
        for (int c = 0; c < 4; ++c) *(LAS unsigned short*)(tile + (4 * ng + c) * 272 + (8 * i + kr) * 2) = (unsigned short)f2bf(v[i][c]);
    LDS_WAIT(); asm volatile("" ::: "memory");
#pragma unroll
    for (int j = 0; j < 8; ++j) { const int p = lane + 64 * j, n = p >> 4, kc = p & 15;
        *(u32x4*)(dst + (size_t)(n0 + n) * Kd + k0 + 8 * kc) = *(const LAS u32x4*)(tile + n * 272 + 16 * kc); }
    LDS_WAIT(); asm volatile("" ::: "memory");
}
template <class M> __device__ __forceinline__ void prep_matrix(Frame& F, const M& m, bf16_t* dst, int N, int K) {
    LAS unsigned char* tile = F.lds + F.wave * 16384;
    const int gw = F.vcu * NWAVES + F.wave, NGW = F.G * NWAVES, nblk = N / 32, nitems = (K / 128) * nblk;
    for (int it = gw; it < nitems; it += NGW) prep_tile(m, dst, K, nblk, tile, it, F.lane);
}

template <class M> __device__ __forceinline__ void prep_strip_i8(Frame& F, const M& m, signed char* dst, float* scl, int strip) {
    const int lane = F.lane, w = F.wave, n0 = strip * 32, k0 = w * 128, ng = lane & 7, kr = lane >> 3;
    LAS unsigned char* tile = F.lds + w * 16384;
    LAS float* amt = (LAS float*)(F.lds + LDSCTL_OFF + 2048);
    f32x4 v[16];
#pragma unroll
    for (int i = 0; i < 16; ++i) v[i] = m.load4(k0 + 8 * i + kr, n0 + 4 * ng);
    f32x4 am = __builtin_elementwise_abs(v[0]);
#pragma unroll
    for (int i = 1; i < 16; ++i) am = __builtin_elementwise_max(am, __builtin_elementwise_abs(v[i]));
#pragma unroll
    for (int c = 0; c < 4; ++c) { float a = am[c]; a = fmaxf(a, __shfl_xor(a, 8)); a = fmaxf(a, __shfl_xor(a, 16)); a = fmaxf(a, __shfl_xor(a, 32)); am[c] = a; }
    if (kr == 0) *(LAS f32x4*)(amt + w * 32 + 4 * ng) = am;
    __syncthreads();
    f32x4 cm = *(const LAS f32x4*)(amt + 4 * ng);
#pragma unroll
    for (int ww = 1; ww < 8; ++ww) cm = __builtin_elementwise_max(cm, *(const LAS f32x4*)(amt + ww * 32 + 4 * ng));
    f32x4 inv;
#pragma unroll
    for (int c = 0; c < 4; ++c) inv[c] = cm[c] > 0.f ? 127.0f / cm[c] : 0.f;
    if (w == 0 && kr == 0) *(f32x4*)(scl + n0 + 4 * ng) = cm * (1.0f / 127.0f);
#pragma unroll
    for (int i = 0; i < 16; ++i)
#pragma unroll
        for (int c = 0; c < 4; ++c) tile[(4 * ng + c) * 144 + 8 * i + kr] = (unsigned char)(signed char)__float2int_rn(v[i][c] * inv[c]);
    LDS_WAIT(); asm volatile("" ::: "memory");
#pragma unroll
    for (int j = 0; j < 4; ++j) { const int p = lane + 64 * j, n = p >> 3, kc = p & 7;
        *(u32x4*)(dst + (size_t)(n0 + n) * DM + k0 + 16 * kc) = *(const LAS u32x4*)(tile + n * 144 + 16 * kc); }
    LDS_WAIT();
    __syncthreads();
}
__device__ __forceinline__ bf16_t* wmix(Frame& F, int l, size_t off) { return (bf16_t*)(F.ws + WS_WMIX + (size_t)l * WL_STRIDE + off); }

__device__ __forceinline__ void prep_mixer_weights(Frame& F) {
    for (int l = 0; l < DEPTH; ++l) {
        { MapInproj m{F.in[I_WIN] + (size_t)l * DM * INW}; for (int s = F.vcu; s < NT_IN * 8; s += F.G) prep_strip_i8(F, m, (signed char*)wmix(F, l, WL_IN), (float*)(F.ws + WS_MISC + MS_WSIN) + l * NT_IN * 256, s); }
        { MapUp m{F.in[I_WUQ] + (size_t)l * 256 * 768, F.in[I_WUKV] + (size_t)l * 128 * 1024, F.in[I_GQ] + l * 256, F.in[I_GKV] + l * 128}; prep_matrix(F, m, wmix(F, l, WL_UP), UPN, UPK); }
        { MapBr m{F.in[I_WBR] + (size_t)l * 3 * 512 * DM}; prep_matrix(F, m, wmix(F, l, WL_BR), DM, 1536); }
        { MapNat m{F.in[I_WOUT] + (size_t)l * DM * DM, DM}; prep_matrix(F, m, wmix(F, l, WL_OUT), DM, DM); }
    }
    { MapMemkv m{F.in[I_WMKV]}; prep_matrix(F, m, (bf16_t*)(F.ws + WS_WMKV), 4096, DM); }
}
__device__ __forceinline__ void prep_ffn_weights(Frame& F, int l) {
    const int i = l >> 1; const bool moe = (l & 1) != 0;
    LAS float* scr = (LAS float*)(F.lds + F.wave * 16384);
    const int gw = F.vcu * NWAVES + F.wave, NGW = F.G * NWAVES;
    constexpr int IGU = (DM / 64) * (2 * DFF / 32), ID = (DFF / 64) * (DM / 32), NSTRIP = 2 * DFF / 32;
    const int ne = moe ? NE : 1;
    const float* Wg = moe ? F.in[I_WGE] : F.in[I_WGD]; const float* Wu = moe ? F.in[I_WUE] : F.in[I_WUD]; const float* Wd = moe ? F.in[I_WDE] : F.in[I_WDD];
    if (GU_I8(l)) {
        for (int s = F.vcu; s < ne * NSTRIP; s += F.G) { const int e = s / NSTRIP, ss = s % NSTRIP; const size_t eo = ((size_t)i * ne + e) * DM * DFF;
            MapGU m{Wg + eo, Wu + eo}; prep_strip_i8(F, m, (signed char*)(F.ws + WS_WFFN + (size_t)e * WF_STRIDE), (float*)(F.ws + WS_MISC + MS_WSGU) + e * 2 * DFF, ss); }
    } else {
        for (int it = gw; it < ne * IGU; it += NGW) { const int e = it / IGU, r = it % IGU; const size_t eo = ((size_t)i * ne + e) * DM * DFF;
            MapGU m{Wg + eo, Wu + eo}; prep_item(m, (bf16_t*)(F.ws + WS_WFFN + (size_t)e * WF_STRIDE), DM, 2 * DFF / 32, scr, r, F.lane); }
    }
    constexpr int IDT = (DFF / 128) * (DM / 32);
    for (int it = gw; it < ne * IDT; it += NGW) { const int e = it / IDT, r = it % IDT; const size_t eo = ((size_t)i * ne + e) * DM * DFF;
        MapNat m{Wd + eo, DM}; prep_tile(m, (bf16_t*)(F.ws + WS_WFFN + (size_t)e * WF_STRIDE + WF_D), DFF, DM / 32, F.lds + F.wave * 16384, r, F.lane); }
}

struct RowV { f32x4 v[4]; };
__device__ __forceinline__ void row_load(RowV& r, const float* p, int lane) { const f32x4* x = (const f32x4*)p + lane;
#pragma unroll
    for (int j = 0; j < 4; ++j) r.v[j] = x[64 * j]; }
__device__ __forceinline__ void row_store(const RowV& r, float* p, int lane) { f32x4* x = (f32x4*)p + lane;
#pragma unroll
    for (int j = 0; j < 4; ++j) x[64 * j] = r.v[j]; }
__device__ __forceinline__ void row_add_bf16(RowV& r, const bf16_t* p, float w, int lane) { const u32x2* x = (const u32x2*)p + lane;
#pragma unroll
    for (int j = 0; j < 4; ++j) { const u32x2 q = x[64 * j]; r.v[j].x += w * bflo(q.x); r.v[j].y += w * bfhi(q.x); r.v[j].z += w * bflo(q.y); r.v[j].w += w * bfhi(q.y); } }
__device__ __forceinline__ float row_rstd(const RowV& r) { float s = 0.f;
#pragma unroll
    for (int j = 0; j < 4; ++j) s += (r.v[j].x * r.v[j].x + r.v[j].y * r.v[j].y) + (r.v[j].z * r.v[j].z + r.v[j].w * r.v[j].w);
    return 1.0f / sqrtf(wave_sum(s) * (1.0f / DM) + EPS); }
__device__ __forceinline__ void row_scale(RowV& r, float rstd, const float* g, int lane) { const f32x4* gg = (const f32x4*)g + lane;
#pragma unroll
    for (int j = 0; j < 4; ++j) r.v[j] = r.v[j] * rstd * gg[64 * j]; }
__device__ __forceinline__ void row_store_bf16(const RowV& r, bf16_t* p, int lane) { u32x2* o = (u32x2*)p + lane;
#pragma unroll
    for (int j = 0; j < 4; ++j) { u32x2 w; w.x = pk2(r.v[j].x, r.v[j].y); w.y = pk2(r.v[j].z, r.v[j].w); o[64 * j] = w; } }

__device__ __forceinline__ float row_store_i8(const RowV& r, signed char* p, int lane) {
    float am = 0.f;
#pragma unroll
    for (int j = 0; j < 4; ++j) am = fmaxf(am, fmaxf(fmaxf(fabsf(r.v[j].x), fabsf(r.v[j].y)), fmaxf(fabsf(r.v[j].z), fabsf(r.v[j].w))));
#pragma unroll
    for (int o = 1; o < 64; o <<= 1) am = fmaxf(am, __shfl_xor(am, o));
    const float inv = am > 0.f ? 127.0f / am : 0.f; unsigned* o4 = (unsigned*)p + lane;
#pragma unroll
    for (int j = 0; j < 4; ++j) { const unsigned a = (unsigned)__float2int_rn(r.v[j].x * inv) & 255u, b = (unsigned)__float2int_rn(r.v[j].y * inv) & 255u, c = (unsigned)__float2int_rn(r.v[j].z * inv) & 255u, d = (unsigned)__float2int_rn(r.v[j].w * inv) & 255u;
        o4[64 * j] = a | (b << 8) | (c << 16) | (d << 24); }
    return am * (1.0f / 127.0f);
}
__device__ __forceinline__ void row_combine(Frame& F, RowV& r, int t) {
    const int* sl = (const int*)(F.ws + WS_MISC + MS_SLOT) + 2 * t; const float* tw = (const float*)(F.ws + WS_MISC + MS_TOKW) + 2 * t;
    const bf16_t* Y = (const bf16_t*)(F.ws + WS_R + R_YOUT);
    const int s0 = sl[0], s1 = sl[1]; const float w0 = tw[0], w1 = tw[1];
    row_add_bf16(r, Y + (size_t)s0 * DM, w0, F.lane); row_add_bf16(r, Y + (size_t)s1 * DM, w1, F.lane);
}

__device__ __forceinline__ void norm_phase(Frame& F, const float* src, float* X, const float* g, bool combine, bool out_i8) {
    bf16_t* H = (bf16_t*)(F.ws + WS_H); signed char* Hq = (signed char*)(F.ws + WS_H); float* hsc = (float*)(F.ws + WS_MISC + MS_HSC);
    const int gw = F.vcu * NWAVES + F.wave, NGW = F.G * NWAVES;
    for (int t = gw; t < T; t += 2 * NGW) {
        const int t2 = t + NGW;
        RowV r, q; row_load(r, src + (size_t)t * DM, F.lane); row_load(q, src + (size_t)t2 * DM, F.lane);
        if (combine) { row_combine(F, r, t); row_combine(F, q, t2); row_store(r, X + (size_t)t * DM, F.lane); row_store(q, X + (size_t)t2 * DM, F.lane); }
        const float rstd = row_rstd(r), qstd = row_rstd(q); row_scale(r, rstd, g, F.lane); row_scale(q, qstd, g, F.lane);
        if (out_i8) { const float sc = row_store_i8(r, Hq + (size_t)t * DM, F.lane), sq = row_store_i8(q, Hq + (size_t)t2 * DM, F.lane); if (F.lane == 0) { hsc[t] = sc; hsc[t2] = sq; } }
        else { row_store_bf16(r, H + (size_t)t * DM, F.lane); row_store_bf16(q, H + (size_t)t2 * DM, F.lane); }
    }
}
__device__ __forceinline__ void final_norm_phase(Frame& F, float* X, const float* g, bool combine) {
    const int gw = F.vcu * NWAVES + F.wave, NGW = F.G * NWAVES;
    for (int t = gw; t < T; t += 2 * NGW) {
        const int t2 = t + NGW;
        RowV r, q; row_load(r, X + (size_t)t * DM, F.lane); row_load(q, X + (size_t)t2 * DM, F.lane);
        if (combine) { row_combine(F, r, t); row_combine(F, q, t2); }
        const float rstd = row_rstd(r), qstd = row_rstd(q); row_scale(r, rstd, g, F.lane); row_scale(q, qstd, g, F.lane);
        row_store(r, X + (size_t)t * DM, F.lane); row_store(q, X + (size_t)t2 * DM, F.lane);
    }
}
__device__ __forceinline__ void memnorm_phase(Frame& F) {
    bf16_t* MN = (bf16_t*)(F.ws + WS_MEMN);
    const int gw = F.vcu * NWAVES + F.wave, NGW = F.G * NWAVES;
    for (int t = gw; t < NB * MEML; t += NGW) {
        RowV r; row_load(r, F.in[I_MEM] + (size_t)t * DM, F.lane);
        const float rstd = row_rstd(r); row_scale(r, rstd, F.in[I_GMEM], F.lane);
        row_store_bf16(r, MN + (size_t)t * DM, F.lane);
    }
}

__device__ __forceinline__ void norm_router_phase(Frame& F, const float* X, const float* g, const float* Wr  , bool out_i8) {
    bf16_t* H = (bf16_t*)(F.ws + WS_H); signed char* Hq = (signed char*)(F.ws + WS_H); float* hsc = (float*)(F.ws + WS_MISC + MS_HSC);
    int* toke = (int*)(F.ws + WS_MISC + MS_TOKE); float* tokw = (float*)(F.ws + WS_MISC + MS_TOKW); int* cntg = (int*)(F.ws + WS_MISC + MS_CNT);
    volatile LAS int* hist = (volatile LAS int*)(F.lds + LDSCTL_OFF + 1024);
    for (int c = F.vcu; c < T / 128; c += F.G) {
        if (F.tid < 8) hist[F.tid] = 0;
        __syncthreads();
        for (int q = 0; q < 16; ++q) {
            const int t = c * 128 + F.wave * 16 + q;
            RowV r; row_load(r, X + (size_t)t * DM, F.lane);
            const float rstd = row_rstd(r); row_scale(r, rstd, g, F.lane);
            if (out_i8) { const float sc = row_store_i8(r, Hq + (size_t)t * DM, F.lane); if (F.lane == 0) hsc[t] = sc; }
            else row_store_bf16(r, H + (size_t)t * DM, F.lane);
            float lg[8];
#pragma unroll
            for (int e = 0; e < 8; ++e) lg[e] = 0.f;
#pragma unroll
            for (int j = 0; j < 4; ++j) {
#pragma unroll
                for (int k = 0; k < 4; ++k) { const int d = 256 * j + 4 * F.lane + k; const f32x4 wa = *(const f32x4*)(Wr + (size_t)d * 8), wb = *(const f32x4*)(Wr + (size_t)d * 8 + 4); const float x = r.v[j][k];
                    lg[0] += x * wa.x; lg[1] += x * wa.y; lg[2] += x * wa.z; lg[3] += x * wa.w; lg[4] += x * wb.x; lg[5] += x * wb.y; lg[6] += x * wb.z; lg[7] += x * wb.w; } }
#pragma unroll
            for (int e = 0; e < 8; ++e) lg[e] = wave_sum(lg[e]);
            int e0 = 0; float v0 = lg[0];
#pragma unroll
            for (int e = 1; e < 8; ++e) if (lg[e] > v0) { v0 = lg[e]; e0 = e; }
            int e1 = -1; float v1 = -INFINITY;
#pragma unroll
            for (int e = 0; e < 8; ++e) if (e != e0 && lg[e] > v1) { v1 = lg[e]; e1 = e; }
            if (F.lane == 0) {
                const float w0 = 1.0f / (1.0f + __expf(v1 - v0));
                toke[2 * t] = e0; toke[2 * t + 1] = e1; tokw[2 * t] = w0; tokw[2 * t + 1] = 1.0f - w0;
                __hip_atomic_fetch_add((LAS int*)&hist[e0], 1, __ATOMIC_RELAXED, __HIP_MEMORY_SCOPE_WORKGROUP); __hip_atomic_fetch_add((LAS int*)&hist[e1], 1, __ATOMIC_RELAXED, __HIP_MEMORY_SCOPE_WORKGROUP);
            }
        }
        __syncthreads();
        if (F.tid < 8) cntg[c * 8 + F.tid] = hist[F.tid];
        __syncthreads();
    }
}
__device__ __forceinline__ void moe_assign_phase(Frame& F, bool i8) {
    const bf16_t* H = (const bf16_t*)(F.ws + WS_H); bf16_t* AS = (bf16_t*)(F.ws + WS_R + R_ASORT);
    const float* hsc = (const float*)(F.ws + WS_MISC + MS_HSC); float* asc = (float*)(F.ws + WS_MISC + MS_ASC);
    const int* toke = (const int*)(F.ws + WS_MISC + MS_TOKE); int* slot = (int*)(F.ws + WS_MISC + MS_SLOT); const int* cntg = (const int*)(F.ws + WS_MISC + MS_CNT);
    int* texp = (int*)(F.ws + WS_MISC + MS_TEXP);
    volatile LAS int* tot = (volatile LAS int*)(F.lds + LDSCTL_OFF + 1024);
    volatile LAS int* pre = tot + 8;
    volatile LAS int* wcnt = tot + 16;
    for (int c = F.vcu; c < T / 128; c += F.G) {
        if (F.tid < 16) tot[F.tid] = 0;
        __syncthreads();
        { const int cc = F.tid >> 1, h = F.tid & 1; const i32x4 v = *(const i32x4*)(cntg + cc * 8 + 4 * h);
#pragma unroll
          for (int k = 0; k < 4; ++k) { __hip_atomic_fetch_add((LAS int*)&tot[4 * h + k], v[k], __ATOMIC_RELAXED, __HIP_MEMORY_SCOPE_WORKGROUP); if (cc < c) __hip_atomic_fetch_add((LAS int*)&pre[4 * h + k], v[k], __ATOMIC_RELAXED, __HIP_MEMORY_SCOPE_WORKGROUP); } }
        const int t = c * 128 + F.wave * 16 + ((F.lane & 31) >> 1);
        const int my_e = (F.lane < 32) ? toke[2 * t + (F.lane & 1)] : -1;
        int rank = 0;
#pragma unroll
        for (int e = 0; e < 8; ++e) { const unsigned long long m = __ballot(my_e == e); if (my_e == e) rank = __popcll(m & ((1ull << F.lane) - 1ull)); if (F.lane == 0) wcnt[F.wave * 8 + e] = __popcll(m); }
        __syncthreads();
        int myslot = 0;
        if (F.lane < 32) {
            int ts = 0;
#pragma unroll
            for (int e = 0; e < 8; ++e) ts += (e < my_e) ? ((tot[e] + 255) >> 8) : 0;
            int wp = 0; for (int w = 0; w < F.wave; ++w) wp += wcnt[w * 8 + my_e];
            myslot = ts * 256 + pre[my_e] + wp + rank;
            slot[2 * t + (F.lane & 1)] = myslot;
        }
        if (c == 0 && F.tid == 0) { int ts = 0; for (int e = 0; e < 8; ++e) { const int n = (tot[e] + 255) >> 8; for (int k = 0; k < n; ++k) texp[ts + k] = e; ts += n; } for (int k = ts; k < MAXRT; ++k) texp[k] = 0; texp[MAXRT] = ts; }
        if (i8) {
            const float myh = hsc[t];
#pragma unroll 1
            for (int a0 = 0; a0 < 32; a0 += 8) {
                u32x4 x[4];
#pragma unroll
                for (int k = 0; k < 4; ++k) x[k] = *((const u32x4*)((const signed char*)H + (size_t)(c * 128 + F.wave * 16 + ((a0 + 2 * k) >> 1)) * DM) + F.lane);
#pragma unroll
                for (int k = 0; k < 8; ++k) { const int s = __builtin_amdgcn_readlane(myslot, a0 + k); *((u32x4*)((signed char*)AS + (size_t)s * DM) + F.lane) = x[k >> 1]; }
            }
            if (F.lane < 32) asc[myslot] = myh;
        } else {
            for (int a = 0; a < 32; ++a) {
                const int s = __builtin_amdgcn_readlane(myslot, a); const int ta = c * 128 + F.wave * 16 + (a >> 1);
                const u32x4* srcp = (const u32x4*)(H + (size_t)ta * DM) + F.lane; u32x4* dstp = (u32x4*)(AS + (size_t)s * DM) + F.lane;
                const u32x4 x0 = srcp[0], x1 = srcp[64]; dstp[0] = x0; dstp[64] = x1; }
        }
        __syncthreads();
    }
}

using pg8::Unit;
typedef f32x4 AccT[2][2][4][2];

struct ProbSimple { int K; unsigned lda, ldb; const char* A; const char* B;
    __device__ __forceinline__ const char* a_ptr(const Unit& u) const { return A + (size_t)u.pm * 256 * lda; }
    __device__ __forceinline__ const char* b_ptr(const Unit& u) const { return B + (size_t)u.pn * 256 * ldb; } };
struct ProbBranch { int K; unsigned lda, ldb; const char* A; const char* B;
    __device__ __forceinline__ const char* a_ptr(const Unit& u) const { return A + (size_t)u.pm * 256 * lda + (size_t)u.aux * 1024; }
    __device__ __forceinline__ const char* b_ptr(const Unit& u) const { return B + (size_t)u.aux * ((size_t)DM * 512 * 2) + (size_t)u.pn * 256 * ldb; } };
struct ProbMoe { int K; unsigned lda, ldb; const char* A; const char* B; int a_lo;
    __device__ __forceinline__ const char* a_ptr(const Unit& u) const { return A + (size_t)(u.pm - a_lo) * 256 * lda; }
    __device__ __forceinline__ const char* b_ptr(const Unit& u) const { return B + (size_t)u.aux * WF_STRIDE + (size_t)u.pn * 256 * ldb; } };

struct SegOrder { pg8::StaticOrder base;
    __device__ bool next(int i, Unit& u) const { if (!base.next(i / 3, u)) return false; u.aux = i % 3; return true; } };
struct MoeRowOrder { pg8::RowOrder base; const int* texp;
    __device__ bool next(int i, Unit& u) const { if (!base.next(i, u)) return false; u.aux = texp[u.pm]; return true; } };
struct MoeOrder { pg8::StaticOrder base; int lo; const int* texp;
    __device__ bool next(int i, Unit& u) const { if (!base.next(i, u)) return false; u.pm += lo; u.aux = texp[u.pm]; return true; } };

__device__ __forceinline__ u32x4 pack8(const f32x4 a, const f32x4 b) { u32x4 w; w.x = cvtpk(a[0], a[1]); w.y = cvtpk(a[2], a[3]); w.z = cvtpk(b[0], b[1]); w.w = cvtpk(b[2], b[3]); return w; }
__device__ __forceinline__ u32x2 pack4(const f32x4 a) { u32x2 w; w.x = cvtpk(a[0], a[1]); w.y = cvtpk(a[2], a[3]); return w; }

struct EpiNoStage { __device__ __forceinline__ void stage(LAS unsigned char*, const Unit&, int, int) const {} };
__device__ __forceinline__ void stage1k(const void* src, LAS unsigned char* dst, int lane) { __builtin_amdgcn_global_load_lds((const unsigned*)((const char*)src + lane * 16), (LAS unsigned*)dst, 16, 0, 0); }
__device__ __forceinline__ f32x4 deq(const f32x4& a, float, const f32x4&) { return a; }
__device__ __forceinline__ f32x4 deq(const i32x4& a, float rs, const f32x4& cs) { return __builtin_convertvector(a, f32x4) * rs * cs; }
struct EpiInproj {
    static constexpr bool MID = false;
    bf16_t* P; bf16_t* G; float* ssq; const int* pos; const float* rsc; const float* csc;
    __device__ __forceinline__ void stage(LAS unsigned char* d, const Unit& u, int wid, int lane) const {
        if (wid == 0) { stage1k(rsc + u.pm * 256, d, lane); stage1k(csc + u.pn * 256, d + 1024, lane); stage1k(pos + u.pm * 256, d + 2048, lane); } }
    template <class AV> __device__ __forceinline__ void operator()(const AV (&acc)[2][2][4][2], const Unit& u, int wr, int wc, int fr, int fq, const LAS unsigned char* esc) const {
        const int pn = u.pn, row0 = u.pm * 256 + wr * 64 + fr;
        f32x4 cs[2][2];
#pragma unroll
        for (int bj = 0; bj < 2; ++bj)
#pragma unroll
            for (int n = 0; n < 2; ++n) cs[bj][n] = *(const LAS f32x4*)(esc + 1024 + (bj * 128 + wc * 32 + n * 16 + fq * 4) * 4);
        float rs8[2][4], pf8[2][4];
#pragma unroll
        for (int ai = 0; ai < 2; ++ai)
#pragma unroll
            for (int m = 0; m < 4; ++m) { const int rl = ai * 128 + wr * 64 + m * 16 + fr; rs8[ai][m] = *(const LAS float*)(esc + rl * 4); pf8[ai][m] = (float)*(const LAS int*)(esc + 2048 + rl * 4); }
#define DQ(ai, bj, m, n) deq(acc[ai][bj][m][n], rs, cs[bj][n])
        if (pn >= 7) {
#pragma unroll
            for (int ai = 0; ai < 2; ++ai)
#pragma unroll
                for (int m = 0; m < 4; ++m) { const int row = row0 + ai * 128 + m * 16; const float rs = rs8[ai][m];
#pragma unroll
                    for (int bj = 0; bj < 2; ++bj) { f32x4 a = DQ(ai, bj, m, 0), b = DQ(ai, bj, m, 1);
#pragma unroll
                        for (int j = 0; j < 4; ++j) { a[j] = fast_sigmoid(a[j]); b[j] = fast_sigmoid(b[j]); }
                        *(u32x4*)(G + (size_t)row * GW + (pn - 7) * 256 + bj * 128 + wc * 32 + fq * 8) = pack8(a, b); } }
        } else if (pn >= 5 || pn == 3) {
            const float sc = (pn == 3) ? 1.0f : C_M;
#pragma unroll
            for (int ai = 0; ai < 2; ++ai)
#pragma unroll
                for (int m = 0; m < 4; ++m) { const int row = row0 + ai * 128 + m * 16; const float rs = rs8[ai][m]; float s = 0.f;
#pragma unroll
                    for (int bj = 0; bj < 2; ++bj) { const f32x4 a = DQ(ai, bj, m, 0) * sc, b = DQ(ai, bj, m, 1) * sc;
                        s += (a[0] * a[0] + a[1] * a[1]) + (a[2] * a[2] + a[3] * a[3]) + (b[0] * b[0] + b[1] * b[1]) + (b[2] * b[2] + b[3] * b[3]);
                        *(u32x4*)(P + (size_t)row * PW + pn * 256 + bj * 128 + wc * 32 + fq * 8) = pack8(a, b); }
                    if (pn == 3) { s += __shfl_xor(s, 16); s += __shfl_xor(s, 32); if (fq == 0) ssq[(size_t)row * 8 + wc] = s; } }
        } else if (pn == 4) {
#pragma unroll
            for (int ai = 0; ai < 2; ++ai)
#pragma unroll
                for (int m = 0; m < 4; ++m) { const int row = row0 + ai * 128 + m * 16; const float rs = rs8[ai][m];
                    { const f32x4 a = DQ(ai, 0, m, 0), b = DQ(ai, 0, m, 1);
                      float s = (a[0] * a[0] + a[1] * a[1]) + (a[2] * a[2] + a[3] * a[3]) + (b[0] * b[0] + b[1] * b[1]) + (b[2] * b[2] + b[3] * b[3]);
                      *(u32x4*)(P + (size_t)row * PW + P_CKV + wc * 32 + fq * 8) = pack8(a, b);
                      s += __shfl_xor(s, 16); s += __shfl_xor(s, 32); if (fq == 0) ssq[(size_t)row * 8 + 4 + wc] = s; }
                    if (wc == 0) { const f32x4 x1 = DQ(ai, 1, m, 0), x2 = DQ(ai, 1, m, 1); const float pf = pf8[ai][m]; f32x4 o1, o2;
#pragma unroll
                        for (int j = 0; j < 4; ++j) { float c, s; rot_cs(pf, 2 * (4 * fq + j), c, s); o1[j] = x1[j] * c - x2[j] * s; o2[j] = x2[j] * c + x1[j] * s; }
                        *(u32x2*)(P + (size_t)row * PW + P_KR + 4 * fq) = pack4(o1); *(u32x2*)(P + (size_t)row * PW + P_KR + 16 + 4 * fq) = pack4(o2); } }
        } else {
            const float sc = (pn < 2) ? C_A : 1.0f; const int i0 = 16 * (wc & 1) + 4 * fq;
#pragma unroll
            for (int ai = 0; ai < 2; ++ai)
#pragma unroll
                for (int m = 0; m < 4; ++m) { const int row = row0 + ai * 128 + m * 16; const float rs = rs8[ai][m]; const float pf = pf8[ai][m]; f32x4 c, s;
#pragma unroll
                    for (int j = 0; j < 4; ++j) { float cc, ss; rot_cs(pf, i0 + j, cc, ss); c[j] = cc * sc; s[j] = ss * sc; }
#pragma unroll
                    for (int bj = 0; bj < 2; ++bj) { const f32x4 x1 = DQ(ai, bj, m, 0), x2 = DQ(ai, bj, m, 1);
                        if (pn == 2 && bj == 1) { *(u32x4*)(P + (size_t)row * PW + P_VA + wc * 32 + fq * 8) = pack8(x1, x2); }
                        else { const f32x4 o1 = x1 * c - x2 * s, o2 = x2 * c + x1 * s; bf16_t* d = P + (size_t)row * PW + pn * 256 + 64 * (2 * bj + (wc >> 1)) + i0;
                            *(u32x2*)d = pack4(o1); *(u32x2*)(d + 32) = pack4(o2); } } }
        }
#undef DQ
    }
};
struct EpiUp {
    static constexpr bool MID = false;
    __device__ __forceinline__ void stage(LAS unsigned char*, const Unit&, int, int) const {}
    bf16_t* QB; bf16_t* KVB; const float* ssq; const int* pos;
    __device__ __forceinline__ void operator()(const AccT& acc, const Unit& u, int wr, int wc, int fr, int fq, const LAS unsigned char*) const {
        const int pn = u.pn, row0 = u.pm * 256 + wr * 64 + fr;
        float rs8[2][4], pf8[2][4];
#pragma unroll
        for (int ai = 0; ai < 2; ++ai)
#pragma unroll
            for (int m = 0; m < 4; ++m) { const int row = row0 + ai * 128 + m * 16; const f32x4 sv = *(const f32x4*)(ssq + (size_t)row * 8 + (pn < 3 ? 0 : 4));
                rs8[ai][m] = (pn < 3 ? C_B : 1.0f) / sqrtf(((sv[0] + sv[1]) + (sv[2] + sv[3])) * (pn < 3 ? 1.0f / 256.0f : 1.0f / 128.0f) + EPS); pf8[ai][m] = (pn < 3) ? (float)pos[row] : 0.f; }
#pragma unroll
        for (int ai = 0; ai < 2; ++ai)
#pragma unroll
            for (int m = 0; m < 4; ++m) { const int row = row0 + ai * 128 + m * 16; const float rs = rs8[ai][m];
                if (pn < 3) {
#pragma unroll
                    for (int bj = 0; bj < 2; ++bj) { const int gg = 8 * pn + 4 * bj + wc; const f32x4 x1 = acc[ai][bj][m][0] * rs, x2 = acc[ai][bj][m][1] * rs;
                        if (gg % 3 == 2) { const float pf = pf8[ai][m]; f32x4 o1, o2;
#pragma unroll
                            for (int j = 0; j < 4; ++j) { float c, s; rot_cs(pf, 2 * (4 * fq + j), c, s); o1[j] = x1[j] * c - x2[j] * s; o2[j] = x2[j] * c + x1[j] * s; }
                            bf16_t* d = QB + (size_t)row * QBW + 32 * gg + 4 * fq; *(u32x2*)d = pack4(o1); *(u32x2*)(d + 16) = pack4(o2); }
                        else *(u32x4*)(QB + (size_t)row * QBW + 32 * gg + 8 * fq) = pack8(x1, x2); }
                } else {
#pragma unroll
                    for (int bj = 0; bj < 2; ++bj) *(u32x4*)(KVB + (size_t)row * KVW + (pn - 3) * 256 + bj * 128 + wc * 32 + fq * 8) = pack8(acc[ai][bj][m][0] * rs, acc[ai][bj][m][1] * rs);
                } }
    }
};
struct EpiPlain {
    static constexpr bool MID = false;
    __device__ __forceinline__ void stage(LAS unsigned char*, const Unit&, int, int) const {}
    bf16_t* O; int ldo;
    __device__ __forceinline__ void operator()(const AccT& acc, const Unit& u, int wr, int wc, int fr, int fq, const LAS unsigned char*) const {
        const int row0 = u.pm * 256 + wr * 64 + fr;
#pragma unroll
        for (int ai = 0; ai < 2; ++ai)
#pragma unroll
            for (int m = 0; m < 4; ++m)
#pragma unroll
                for (int bj = 0; bj < 2; ++bj) *(u32x4*)(O + (size_t)(row0 + ai * 128 + m * 16) * ldo + u.pn * 256 + bj * 128 + wc * 32 + fq * 8) = pack8(acc[ai][bj][m][0], acc[ai][bj][m][1]);
    }
};
struct EpiBranch {
    static constexpr bool MID = true;
    const bf16_t* G; bf16_t* MIXED;
    __device__ __forceinline__ void stage(LAS unsigned char*, const Unit&, int, int) const {}
    __device__ __forceinline__ void mid(AccT& acc, const Unit& u, int seg  , int wr, int wc, int fr, int fq) const {
        const int row0 = opq_v(u.pm * 256 + wr * 64 + fr);
#pragma unroll
        for (int ai = 0; ai < 2; ++ai) {
            u32x4 ga[4][2], gb[4][2];
#pragma unroll
            for (int m = 0; m < 4; ++m)
#pragma unroll
                for (int bj = 0; bj < 2; ++bj) { const bf16_t* gp = G + (size_t)(row0 + ai * 128 + m * 16) * GW + u.pn * 256 + bj * 128 + wc * 32 + fq * 8;
                    ga[m][bj] = *(const u32x4*)(gp + (seg - 1) * 1024); gb[m][bj] = *(const u32x4*)(gp + seg * 1024); }
#pragma unroll
            for (int m = 0; m < 4; ++m)
#pragma unroll
                for (int bj = 0; bj < 2; ++bj) { const u32x4 a4 = ga[m][bj], b4 = gb[m][bj];
#define GR(lo_hi, w) (fmaxf(lo_hi(a4.w), 1e-6f) * __builtin_amdgcn_rcpf(fmaxf(lo_hi(b4.w), 1e-6f)))
                    acc[ai][bj][m][0][0] *= GR(bflo, x); acc[ai][bj][m][0][1] *= GR(bfhi, x); acc[ai][bj][m][0][2] *= GR(bflo, y); acc[ai][bj][m][0][3] *= GR(bfhi, y);
                    acc[ai][bj][m][1][0] *= GR(bflo, z); acc[ai][bj][m][1][1] *= GR(bfhi, z); acc[ai][bj][m][1][2] *= GR(bflo, w); acc[ai][bj][m][1][3] *= GR(bfhi, w);
#undef GR
                }
            asm volatile("" ::: "memory"); }
    }
    __device__ __forceinline__ void operator()(const AccT& acc, const Unit& u, int wr, int wc, int fr, int fq, const LAS unsigned char*) const {
        const int row0 = u.pm * 256 + wr * 64 + fr;
#pragma unroll
        for (int ai = 0; ai < 2; ++ai) {
            u32x4 gw[4][2];
#pragma unroll
            for (int m = 0; m < 4; ++m)
#pragma unroll
                for (int bj = 0; bj < 2; ++bj) gw[m][bj] = *(const u32x4*)(G + (size_t)(row0 + ai * 128 + m * 16) * GW + 2048 + u.pn * 256 + bj * 128 + wc * 32 + fq * 8);
#pragma unroll
            for (int m = 0; m < 4; ++m)
#pragma unroll
                for (int bj = 0; bj < 2; ++bj) { const u32x4 g4 = gw[m][bj]; f32x4 a = acc[ai][bj][m][0], b = acc[ai][bj][m][1];
                    a[0] *= fmaxf(bflo(g4.x), 1e-6f); a[1] *= fmaxf(bfhi(g4.x), 1e-6f); a[2] *= fmaxf(bflo(g4.y), 1e-6f); a[3] *= fmaxf(bfhi(g4.y), 1e-6f);
                    b[0] *= fmaxf(bflo(g4.z), 1e-6f); b[1] *= fmaxf(bfhi(g4.z), 1e-6f); b[2] *= fmaxf(bflo(g4.w), 1e-6f); b[3] *= fmaxf(bfhi(g4.w), 1e-6f);
                    *(u32x4*)(MIXED + (size_t)(row0 + ai * 128 + m * 16) * DM + u.pn * 256 + bj * 128 + wc * 32 + fq * 8) = pack8(a, b); }
            asm volatile("" ::: "memory"); }
    }
};
struct EpiResid {
    static constexpr bool MID = false;
    __device__ __forceinline__ void stage(LAS unsigned char*, const Unit&, int, int) const {}
    const float* Xin; float* Xout;
    __device__ __forceinline__ void operator()(const AccT& acc, const Unit& u, int wr, int wc, int fr, int fq, const LAS unsigned char*) const {
        const int row0 = u.pm * 256 + wr * 64 + fr;
#pragma unroll
        for (int ai = 0; ai < 2; ++ai)
#pragma unroll
            for (int mp = 0; mp < 2; ++mp) {
                f32x4 xv[2][2][2];
#pragma unroll
                for (int mm = 0; mm < 2; ++mm)
#pragma unroll
                    for (int bj = 0; bj < 2; ++bj)
#pragma unroll
                        for (int n = 0; n < 2; ++n) xv[mm][bj][n] = *(const f32x4*)(Xin + (size_t)(row0 + ai * 128 + (2 * mp + mm) * 16) * DM + u.pn * 256 + bj * 128 + wc * 32 + n * 16 + fq * 4);
#pragma unroll
                for (int mm = 0; mm < 2; ++mm)
#pragma unroll
                    for (int bj = 0; bj < 2; ++bj)
#pragma unroll
                        for (int n = 0; n < 2; ++n) *(f32x4*)(Xout + (size_t)(row0 + ai * 128 + (2 * mp + mm) * 16) * DM + u.pn * 256 + bj * 128 + wc * 32 + n * 16 + fq * 4) = xv[mm][bj][n] + acc[ai][bj][2 * mp + mm][n];
                asm volatile("" ::: "memory"); }
    }
};
struct EpiSwiglu {
    static constexpr bool MID = false;
    bf16_t* ACT; int lo; const float* rsc; const float* csc;
    __device__ __forceinline__ void stage(LAS unsigned char* d, const Unit& u, int wid, int lane) const {
        if (wid == 0) { stage1k(rsc + u.pm * 256, d, lane); stage1k(csc + (size_t)u.aux * 2 * DFF + u.pn * 256, d + 1024, lane); } }
    template <class AV> __device__ __forceinline__ void operator()(const AV (&acc)[2][2][4][2], const Unit& u, int wr, int wc, int fr, int fq, const LAS unsigned char* esc) const {
        const int row0 = (u.pm - lo) * 256 + wr * 64 + fr;
        f32x4 cs[2][2];
#pragma unroll
        for (int bj = 0; bj < 2; ++bj)
#pragma unroll
            for (int n = 0; n < 2; ++n) cs[bj][n] = *(const LAS f32x4*)(esc + 1024 + (bj * 128 + wc * 32 + n * 16 + fq * 4) * 4);
        float rs8[2][4];
#pragma unroll
        for (int ai = 0; ai < 2; ++ai)
#pragma unroll
            for (int m = 0; m < 4; ++m) rs8[ai][m] = *(const LAS float*)(esc + (ai * 128 + wr * 64 + m * 16 + fr) * 4);
#pragma unroll
        for (int ai = 0; ai < 2; ++ai)
#pragma unroll
            for (int m = 0; m < 4; ++m) { const float rs = rs8[ai][m]; f32x4 a, b;
                const f32x4 g0 = deq(acc[ai][0][m][0], rs, cs[0][0]), g1 = deq(acc[ai][0][m][1], rs, cs[0][1]), u0 = deq(acc[ai][1][m][0], rs, cs[1][0]), u1 = deq(acc[ai][1][m][1], rs, cs[1][1]);
#pragma unroll
                for (int j = 0; j < 4; ++j) { a[j] = g0[j] * fast_sigmoid(g0[j]) * u0[j]; b[j] = g1[j] * fast_sigmoid(g1[j]) * u1[j]; }
                *(u32x4*)(ACT + (size_t)(row0 + ai * 128 + m * 16) * DFF + u.pn * 128 + wc * 32 + fq * 8) = pack8(a, b); }
    }
};
struct EpiYout {
    static constexpr bool MID = false;
    __device__ __forceinline__ void stage(LAS unsigned char*, const Unit&, int, int) const {}
    bf16_t* Y;
    __device__ __forceinline__ void operator()(const AccT& acc, const Unit& u, int wr, int wc, int fr, int fq, const LAS unsigned char*) const {
        const int row0 = u.pm * 256 + wr * 64 + fr;
#pragma unroll
        for (int ai = 0; ai < 2; ++ai)
#pragma unroll
            for (int m = 0; m < 4; ++m)
#pragma unroll
                for (int bj = 0; bj < 2; ++bj)
#pragma unroll
                    for (int n = 0; n < 2; ++n) *(u32x2*)(Y + (size_t)(row0 + ai * 128 + m * 16) * DM + u.pn * 256 + bj * 128 + wc * 32 + n * 16 + fq * 4) = pack4(acc[ai][bj][m][n]);
    }
};

namespace att {
__device__ __forceinline__ int crow(int r, int hi) { return (r & 3) + 8 * (r >> 2) + 4 * hi; }
__device__ __forceinline__ void glds16(const void* gsrc, unsigned lds_dst) { unsigned keep;
    asm volatile("s_mov_b32 %0, m0\n\ts_mov_b32 m0, %2\n\ts_nop 0\n\tglobal_load_lds_dwordx4 %1, off\n\ts_mov_b32 m0, %0" : "=&s"(keep) : "v"(gsrc), "s"(lds_dst) : "memory"); }
__device__ __forceinline__ float swapmax(float m) { auto rr = __builtin_amdgcn_permlane32_swap(__float_as_uint(m), __float_as_uint(m), false, false); return fmaxf(__uint_as_float(rr[0]), __uint_as_float(rr[1])); }
__device__ __forceinline__ float swapsum(float m) { auto rr = __builtin_amdgcn_permlane32_swap(__float_as_uint(m), __float_as_uint(m), false, false); return __uint_as_float(rr[0]) + __uint_as_float(rr[1]); }
__device__ __forceinline__ s16x4 vtr(unsigned addr) { s16x4 r; asm volatile("ds_read_b64_tr_b16 %0, %1" : "=&v"(r) : "v"(addr) : "memory"); return r; }
#define VTRO(dst, base, off) asm volatile("ds_read_b64_tr_b16 %0, %1 offset:%c2" : "=&v"(dst) : "v"(base), "i"(off) : "memory")

struct Src {
    const bf16_t* q; int qpitch;
    const bf16_t* k0; int k0pitch;
    const bf16_t* k1; int k1pitch;
    const bf16_t* v; int vpitch;
    bf16_t* o; int opitch;
};
template <int NKC, int NVB, int RD = 4>
__device__ __forceinline__ void dma_tile(const Src& S, int t, int slot, unsigned lds0, int wid, int lane) {
    constexpr int KS = NKC * 1024, VS = NVB * 4096, LDS_K = 0, LDS_V = RD * KS;
#pragma unroll
    for (int c = 0; c < (NKC + 7) / 8; ++c) { const int ch = wid + 8 * c; if (ch < NKC) {
        const bf16_t* src = (ch < 8) ? S.k0 + (size_t)(t * 64 + lane) * S.k0pitch + ch * 8 : S.k1 + (size_t)(t * 64 + lane) * S.k1pitch + (ch - 8) * 8;
        glds16(src, (unsigned)__builtin_amdgcn_readfirstlane(lds0 + LDS_K + slot * KS + ch * 1024)); } }
#pragma unroll
    for (int c = 0; c < (NVB * 4 + 7) / 8; ++c) { const int p = wid + 8 * c; if (p < NVB * 4) {
        const bf16_t* src = S.v + (size_t)(t * 64 + 16 * (p & 3) + (lane >> 2)) * S.vpitch + (p >> 2) * 32 + (lane & 3) * 8;
        glds16(src, (unsigned)__builtin_amdgcn_readfirstlane(lds0 + LDS_V + slot * VS + p * 1024)); } }
}
__device__ __forceinline__ void wait_vm_bar(int n) {
    if (n >= 4) asm volatile("s_waitcnt vmcnt(4) lgkmcnt(0)\n\ts_barrier" ::: "memory");
    else if (n == 3) asm volatile("s_waitcnt vmcnt(3) lgkmcnt(0)\n\ts_barrier" ::: "memory");
    else if (n == 2) asm volatile("s_waitcnt vmcnt(2) lgkmcnt(0)\n\ts_barrier" ::: "memory");
    else if (n == 1) asm volatile("s_waitcnt vmcnt(1) lgkmcnt(0)\n\ts_barrier" ::: "memory");
    else asm volatile("s_waitcnt vmcnt(0) lgkmcnt(0)\n\ts_barrier" ::: "memory");
}
template <int NKC, int NVB, int MODE>
__device__ __forceinline__ void unit(LAS unsigned char* lds, const Src& S, int t_lo, int t_hi, int qpos0  , float sink_l2) {
    constexpr int KS = NKC * 1024, VS = NVB * 4096, RD = 4, LDS_K = 0, LDS_V = RD * KS;
    const int tid = opq_v((int)threadIdx.x), lane = tid & 63, r32 = lane & 31, hi = lane >> 5; const int wid = __builtin_amdgcn_readfirstlane(tid >> 6), grp = wid >> 2;
    const unsigned lds0 = (unsigned)(uintptr_t)lds;
    const int ops = (NKC + 7 - wid) / 8 + (NVB * 4) / 8;
    bf16x8 qr[NKC / 2];
#pragma unroll
    for (int d0 = 0; d0 < NKC / 2; ++d0) qr[d0] = *(const bf16x8*)(S.q + (size_t)r32 * S.qpitch + d0 * 16 + hi * 8);
    float m_run = (MODE == 0) ? sink_l2 : -INFINITY, l_run = (MODE == 0 && hi == 0) ? 1.0f : 0.0f;
    f32x16 o[NVB];
#pragma unroll
    for (int d = 0; d < NVB; ++d) o[d] = f32x16{};
    const int qi = qpos0 + wid * 32 + r32, qw0 = qpos0 + wid * 32;
    f32x16 p0 = f32x16{}, p1 = f32x16{};
#define AT_ACTIVE(t) ((MODE != 0) || ((64 * (t) + 63 >= qw0 - 128) && (64 * (t) <= qw0 + 31 + 128)))
#define AT_QK(t) do { const LAS unsigned char* kb_ = lds + LDS_K + (((t) - t_lo) % RD) * KS + hi * 1024 + r32 * 16; p0 = f32x16{}; p1 = f32x16{}; \
        _Pragma("unroll") for (int d0 = 0; d0 < NKC / 2; ++d0) { const bf16x8 b0_ = *(const LAS bf16x8*)(kb_ + d0 * 2048), b1_ = *(const LAS bf16x8*)(kb_ + d0 * 2048 + 512); \
            p0 = __builtin_amdgcn_mfma_f32_32x32x16_bf16(b0_, qr[d0], p0, 0, 0, 0); p1 = __builtin_amdgcn_mfma_f32_32x32x16_bf16(b1_, qr[d0], p1, 0, 0, 0); } } while (0)
#define AT_SMPV(t) do { \
        if (MODE == 0) { _Pragma("unroll") for (int r = 0; r < 16; ++r) { const int kv_ = 64 * (t) + crow(r, hi); int e0_ = kv_ - qi; e0_ = e0_ < 0 ? -e0_ : e0_; int e1_ = kv_ + 32 - qi; e1_ = e1_ < 0 ? -e1_ : e1_; \
            if (e0_ > 128) p0[r] = -INFINITY; if (e1_ > 128) p1[r] = -INFINITY; } } \
        float mx_[8]; _Pragma("unroll") for (int r = 0; r < 8; ++r) mx_[r] = fmaxf(fmaxf(p0[r], p0[r + 8]), fmaxf(p1[r], p1[r + 8])); \
        float rm_ = fmaxf(fmaxf(fmaxf(mx_[0], mx_[1]), fmaxf(mx_[2], mx_[3])), fmaxf(fmaxf(mx_[4], mx_[5]), fmaxf(mx_[6], mx_[7]))); rm_ = swapmax(rm_); \
        if (__any(rm_ > m_run)) { const float mn_ = fmaxf(m_run, rm_), alpha_ = __builtin_amdgcn_exp2f(m_run - mn_); m_run = mn_; l_run *= alpha_; \
            _Pragma("unroll") for (int d = 0; d < NVB; ++d) _Pragma("unroll") for (int r = 0; r < 16; ++r) o[d][r] *= alpha_; } \
        float sm_[4] = {0.f, 0.f, 0.f, 0.f}; \
        _Pragma("unroll") for (int r = 0; r < 16; ++r) { p0[r] = __builtin_amdgcn_exp2f(p0[r] - m_run); p1[r] = __builtin_amdgcn_exp2f(p1[r] - m_run); sm_[r & 3] += p0[r] + p1[r]; } \
        l_run += (sm_[0] + sm_[1]) + (sm_[2] + sm_[3]); \
        u32x4 pw_[4]; \
        pw_[0] = (u32x4){cvtpk(p0[0], p0[1]), cvtpk(p0[2], p0[3]), cvtpk(p0[4], p0[5]), cvtpk(p0[6], p0[7])}; pw_[1] = (u32x4){cvtpk(p0[8], p0[9]), cvtpk(p0[10], p0[11]), cvtpk(p0[12], p0[13]), cvtpk(p0[14], p0[15])}; \
        pw_[2] = (u32x4){cvtpk(p1[0], p1[1]), cvtpk(p1[2], p1[3]), cvtpk(p1[4], p1[5]), cvtpk(p1[6], p1[7])}; pw_[3] = (u32x4){cvtpk(p1[8], p1[9]), cvtpk(p1[10], p1[11]), cvtpk(p1[12], p1[13]), cvtpk(p1[14], p1[15])}; \
        const unsigned vb_ = lds0 + LDS_V + (((t) - t_lo) % RD) * VS + ((lane >> 4) & 1) * 32 + (lane & 3) * 8 + (4 * hi + ((lane & 15) >> 2)) * 64; \
        _Pragma("unroll") for (int dp = 0; dp < NVB; dp += 2) { s16x4 lo_[2][4], hh_[2][4]; \
            _Pragma("unroll") for (int dd = 0; dd < 2; ++dd) _Pragma("unroll") for (int ks = 0; ks < 4; ++ks) { lo_[dd][ks] = vtr(vb_ + (dp + dd) * 4096 + ks * 1024); hh_[dd][ks] = vtr(vb_ + (dp + dd) * 4096 + ks * 1024 + 512); } \
            asm volatile("s_waitcnt lgkmcnt(0)" ::: "memory"); __builtin_amdgcn_sched_barrier(0); \
            _Pragma("unroll") for (int ks = 0; ks < 4; ++ks) _Pragma("unroll") for (int dd = 0; dd < 2; ++dd) { \
                const bf16x8 vf_ = (bf16x8){lo_[dd][ks][0], lo_[dd][ks][1], lo_[dd][ks][2], lo_[dd][ks][3], hh_[dd][ks][0], hh_[dd][ks][1], hh_[dd][ks][2], hh_[dd][ks][3]}; \
                o[dp + dd] = __builtin_amdgcn_mfma_f32_32x32x16_bf16(vf_, __builtin_bit_cast(bf16x8, pw_[ks]), o[dp + dd], 0, 0, 0); } } } while (0)
    dma_tile<NKC, NVB>(S, t_lo, 0, lds0, wid, lane);
    if (t_lo + 1 < t_hi) dma_tile<NKC, NVB>(S, t_lo + 1, 1, lds0, wid, lane);
    for (int t = t_lo; t < t_hi; ++t) {
        wait_vm_bar((t + 1 < t_hi) ? ops : 0);
        if (t + 2 < t_hi) dma_tile<NKC, NVB>(S, t + 2, (t + 2 - t_lo) % RD, lds0, wid, lane);
        if (grp == 0) { if (AT_ACTIVE(t)) { AT_QK(t); AT_SMPV(t); } }
        else { if (t > t_lo && AT_ACTIVE(t - 1)) AT_SMPV(t - 1); if (AT_ACTIVE(t)) AT_QK(t); }
    }
    if (grp == 1 && AT_ACTIVE(t_hi - 1)) AT_SMPV(t_hi - 1);
    const float linv = 1.0f / swapsum(l_run);
#pragma unroll
    for (int d = 0; d < NVB; ++d)
#pragma unroll
        for (int r4 = 0; r4 < 4; ++r4) { f32x4 v = {o[d][4 * r4] * linv, o[d][4 * r4 + 1] * linv, o[d][4 * r4 + 2] * linv, o[d][4 * r4 + 3] * linv};
            *(u32x2*)(S.o + (size_t)r32 * S.opitch + 32 * d + 8 * r4 + 4 * hi) = pack4(v); }
    asm volatile("s_waitcnt lgkmcnt(0)\n\ts_barrier" ::: "memory");
#undef AT_ACTIVE
#undef AT_QK
#undef AT_SMPV
}

template <int NKC, int NVB, bool STAG, int MODE = 1>
__device__ __forceinline__ void unit_pf(LAS unsigned char* lds, const Src& S, int t_lo, int t_hi, int qpos0 = 0, float sink_l2 = 0.f) {
    constexpr int KS = NKC * 1024, VS = NVB * 4096, RD = 5, LDS_K = 0, LDS_V = RD * KS;
    static_assert(RD * (KS + VS) <= RING_BYTES, "attention rings fit the LDS stage region");
    const int tid = opq_v((int)threadIdx.x), lane = tid & 63, r32 = lane & 31, hi = lane >> 5; const int wid = __builtin_amdgcn_readfirstlane(tid >> 6), grp = STAG ? (wid >> 2) : 0;
    const unsigned lds0 = (unsigned)(uintptr_t)lds;
    const int ops = (NKC + 7 - wid) / 8 + (NVB * 4) / 8;
    bf16x8 qr[NKC / 2];
#pragma unroll
    for (int d0 = 0; d0 < NKC / 2; ++d0) qr[d0] = *(const bf16x8*)(S.q + (size_t)r32 * S.qpitch + d0 * 16 + hi * 8);
    float m_run = (MODE == 0) ? sink_l2 : -INFINITY, l_run = (MODE == 0 && hi == 0) ? 1.0f : 0.0f;
    const int qi = qpos0 + wid * 32 + r32; (void)qi;
    f32x16 o[NVB];
#pragma unroll
    for (int d = 0; d < NVB; ++d) o[d] = f32x16{};
    bf16x8 kf[NKC];
    f32x16 p0 = f32x16{}, p1 = f32x16{};
    s16x4 lo[NVB][4], hh[NVB][4];
#define PF_KLOAD(t) do { const LAS unsigned char* kb_ = lds + LDS_K + (((t) - t_lo) % RD) * KS + hi * 1024 + r32 * 16; \
        _Pragma("unroll") for (int d0 = 0; d0 < NKC / 2; ++d0) { kf[2 * d0] = *(const LAS bf16x8*)(kb_ + d0 * 2048); kf[2 * d0 + 1] = *(const LAS bf16x8*)(kb_ + d0 * 2048 + 512); } } while (0)
#define PF_VLOAD(t) do { const unsigned vb_ = lds0 + LDS_V + (((t) - t_lo) % RD) * VS + ((lane >> 4) & 1) * 32 + (lane & 3) * 8 + (4 * hi + ((lane & 15) >> 2)) * 64; \
        _Pragma("unroll") for (int d = 0; d < NVB; ++d) _Pragma("unroll") for (int ks = 0; ks < 4; ++ks) { VTRO(lo[d][ks], vb_, d * 4096 + ks * 1024); VTRO(hh[d][ks], vb_, d * 4096 + ks * 1024 + 512); } \
        __builtin_amdgcn_sched_barrier(0); } while (0)
#define PF_QK() do { p0 = f32x16{}; p1 = f32x16{}; \
        _Pragma("unroll") for (int d0 = 0; d0 < NKC / 2; ++d0) { p0 = __builtin_amdgcn_mfma_f32_32x32x16_bf16(kf[2 * d0], qr[d0], p0, 0, 0, 0); p1 = __builtin_amdgcn_mfma_f32_32x32x16_bf16(kf[2 * d0 + 1], qr[d0], p1, 0, 0, 0); } \
        __builtin_amdgcn_sched_barrier(0); } while (0)
    u32x4 pw[4] = {};
#define PF_SM(t) do { \
        if (MODE == 0) { _Pragma("unroll") for (int r = 0; r < 16; ++r) { const int kv_ = 64 * (t) + crow(r, hi); int e0_ = kv_ - qi; e0_ = e0_ < 0 ? -e0_ : e0_; int e1_ = kv_ + 32 - qi; e1_ = e1_ < 0 ? -e1_ : e1_; \
            if (e0_ > 128) p0[r] = -INFINITY; if (e1_ > 128) p1[r] = -INFINITY; } } \
        float mx_[8]; _Pragma("unroll") for (int r = 0; r < 8; ++r) mx_[r] = fmaxf(fmaxf(p0[r], p0[r + 8]), fmaxf(p1[r], p1[r + 8])); \
        float rm_ = fmaxf(fmaxf(fmaxf(mx_[0], mx_[1]), fmaxf(mx_[2], mx_[3])), fmaxf(fmaxf(mx_[4], mx_[5]), fmaxf(mx_[6], mx_[7]))); rm_ = swapmax(rm_); \
        if (__any(rm_ > m_run)) { const float mn_ = fmaxf(m_run, rm_), alpha_ = __builtin_amdgcn_exp2f(m_run - mn_); m_run = mn_; l_run *= alpha_; \
            _Pragma("unroll") for (int d = 0; d < NVB; ++d) _Pragma("unroll") for (int r = 0; r < 16; ++r) o[d][r] *= alpha_; } \
        float sm_[4] = {0.f, 0.f, 0.f, 0.f}; \
        _Pragma("unroll") for (int r = 0; r < 16; ++r) { p0[r] = __builtin_amdgcn_exp2f(p0[r] - m_run); p1[r] = __builtin_amdgcn_exp2f(p1[r] - m_run); sm_[r & 3] += p0[r] + p1[r]; } \
        l_run += (sm_[0] + sm_[1]) + (sm_[2] + sm_[3]); \
        pw[0] = (u32x4){cvtpk(p0[0], p0[1]), cvtpk(p0[2], p0[3]), cvtpk(p0[4], p0[5]), cvtpk(p0[6], p0[7])}; pw[1] = (u32x4){cvtpk(p0[8], p0[9]), cvtpk(p0[10], p0[11]), cvtpk(p0[12], p0[13]), cvtpk(p0[14], p0[15])}; \
        pw[2] = (u32x4){cvtpk(p1[0], p1[1]), cvtpk(p1[2], p1[3]), cvtpk(p1[4], p1[5]), cvtpk(p1[6], p1[7])}; pw[3] = (u32x4){cvtpk(p1[8], p1[9]), cvtpk(p1[10], p1[11]), cvtpk(p1[12], p1[13]), cvtpk(p1[14], p1[15])}; \
        __builtin_amdgcn_sched_barrier(0); } while (0)
#define PF_PV() do { asm volatile("s_waitcnt lgkmcnt(0)" ::: "memory"); __builtin_amdgcn_sched_barrier(0); \
        _Pragma("unroll") for (int ks = 0; ks < 4; ++ks) _Pragma("unroll") for (int d = 0; d < NVB; ++d) { \
            const bf16x8 vf_ = (bf16x8){lo[d][ks][0], lo[d][ks][1], lo[d][ks][2], lo[d][ks][3], hh[d][ks][0], hh[d][ks][1], hh[d][ks][2], hh[d][ks][3]}; \
            o[d] = __builtin_amdgcn_mfma_f32_32x32x16_bf16(vf_, __builtin_bit_cast(bf16x8, pw[ks]), o[d], 0, 0, 0); } \
        __builtin_amdgcn_sched_barrier(0); } while (0)
    dma_tile<NKC, NVB, RD>(S, t_lo, 0, lds0, wid, lane);
    if (t_lo + 1 < t_hi) dma_tile<NKC, NVB, RD>(S, t_lo + 1, 1, lds0, wid, lane);
    wait_vm_bar(0);
    if (t_lo + 2 < t_hi) dma_tile<NKC, NVB, RD>(S, t_lo + 2, 2, lds0, wid, lane);
#define PF_TOP(t) do { if ((t) > t_lo) wait_vm_bar(((t) + 2 < t_hi) ? ops : 0); \
        if ((t) + 3 < t_hi) dma_tile<NKC, NVB, RD>(S, (t) + 3, ((t) + 3 - t_lo) % RD, lds0, wid, lane); } while (0)
    if (grp == 0) {
        PF_KLOAD(t_lo);
        for (int t = t_lo; t < t_hi; ++t) {
            PF_TOP(t);
            PF_VLOAD(t);
            PF_QK();
            if (t + 1 < t_hi) PF_KLOAD(t + 1);
            __builtin_amdgcn_sched_barrier(0);
            PF_SM(t);
            PF_PV();
        }
    } else {
        PF_TOP(t_lo); PF_KLOAD(t_lo); __builtin_amdgcn_sched_barrier(0); PF_QK();
        for (int t = t_lo + 1; t < t_hi; ++t) {
            PF_TOP(t);
            PF_VLOAD(t - 1); PF_SM(t - 1); PF_KLOAD(t); __builtin_amdgcn_sched_barrier(0); PF_PV();
            PF_QK();
        }
        PF_VLOAD(t_hi - 1); PF_SM(t_hi - 1); PF_PV();
    }
    const float linv = 1.0f / swapsum(l_run);
#pragma unroll
    for (int d = 0; d < NVB; ++d)
#pragma unroll
        for (int r4 = 0; r4 < 4; ++r4) { f32x4 v = {o[d][4 * r4] * linv, o[d][4 * r4 + 1] * linv, o[d][4 * r4 + 2] * linv, o[d][4 * r4 + 3] * linv};
            *(u32x2*)(S.o + (size_t)r32 * S.opitch + 32 * d + 8 * r4 + 4 * hi) = pack4(v); }
    asm volatile("s_waitcnt lgkmcnt(0)\n\ts_barrier" ::: "memory");
#undef PF_KLOAD
#undef PF_VLOAD
#undef PF_QK
#undef PF_SM
#undef PF_PV
#undef PF_TOP
}

template <int NKC, int NVB, int MODE>
__device__ __forceinline__ void unit_pp(LAS unsigned char* lds, const Src& S, int t_lo, int t_hi, int qpos0, float sink_l2) {
    constexpr int KS = NKC * 1024, VS = NVB * 4096, RD = 3, LDS_K = 0, LDS_V = RD * KS;
    const int tid = opq_v((int)threadIdx.x), lane = tid & 63, r32 = lane & 31, hi = lane >> 5; const int wid = __builtin_amdgcn_readfirstlane(tid >> 6), grp = wid >> 2;
    const unsigned lds0 = (unsigned)(uintptr_t)lds;
    const int n = t_hi - t_lo;
    const int kops = (NKC + 7 - wid) / 8, vops = (NVB * 4) / 8;
    bf16x8 qr[NKC / 2];
#pragma unroll
    for (int d0 = 0; d0 < NKC / 2; ++d0) qr[d0] = *(const bf16x8*)(S.q + (size_t)r32 * S.qpitch + d0 * 16 + hi * 8);
#define PP_DMA_K(j) do { _Pragma("unroll") for (int c_ = 0; c_ < (NKC + 7) / 8; ++c_) { const int ch_ = wid + 8 * c_; if (ch_ < NKC) { \
        const bf16_t* src_ = (ch_ < 8) ? S.k0 + (size_t)((t_lo + (j)) * 64 + lane) * S.k0pitch + ch_ * 8 : S.k1 + (size_t)((t_lo + (j)) * 64 + lane) * S.k1pitch + (ch_ - 8) * 8; \
        glds16(src_, (unsigned)__builtin_amdgcn_readfirstlane(lds0 + LDS_K + ((j) % RD) * KS + ch_ * 1024)); } } } while (0)
#define PP_DMA_V(j) do { _Pragma("unroll") for (int c_ = 0; c_ < (NVB * 4 + 7) / 8; ++c_) { const int p_ = wid + 8 * c_; if (p_ < NVB * 4) { \
        const bf16_t* src_ = S.v + (size_t)((t_lo + (j)) * 64 + 16 * (p_ & 3) + (lane >> 2)) * S.vpitch + (p_ >> 2) * 32 + (lane & 3) * 8; \
        glds16(src_, (unsigned)__builtin_amdgcn_readfirstlane(lds0 + LDS_V + ((j) % RD) * VS + p_ * 1024)); } } } while (0)
#define PP_BATCH(b, cnt) do { cnt = 0; if ((b) + 3 < n) { PP_DMA_K((b) + 3); cnt += kops; } if ((b) + 2 < n) { PP_DMA_V((b) + 2); cnt += vops; } } while (0)
    float m_run = (MODE == 0) ? sink_l2 : -INFINITY, l_run = (MODE == 0 && hi == 0) ? 1.0f : 0.0f;
    f32x16 o[NVB];
#pragma unroll
    for (int d = 0; d < NVB; ++d) o[d] = f32x16{};
    const int qi = qpos0 + wid * 32 + r32, qw0 = qpos0 + wid * 32;
#define PP_ACTIVE(j) ((MODE != 0) || ((64 * (t_lo + (j)) + 63 >= qw0 - 128) && (64 * (t_lo + (j)) <= qw0 + 31 + 128)))
    f32x16 p0 = f32x16{}, p1 = f32x16{}; u32x4 pw[4] = {};
#define PP_QK(j) do { const LAS unsigned char* kb_ = lds + LDS_K + ((j) % RD) * KS + hi * 1024 + r32 * 16; p0 = f32x16{}; p1 = f32x16{}; \
        _Pragma("unroll") for (int d0 = 0; d0 < NKC / 2; ++d0) { const bf16x8 b0_ = *(const LAS bf16x8*)(kb_ + d0 * 2048), b1_ = *(const LAS bf16x8*)(kb_ + d0 * 2048 + 512); \
            p0 = __builtin_amdgcn_mfma_f32_32x32x16_bf16(b0_, qr[d0], p0, 0, 0, 0); p1 = __builtin_amdgcn_mfma_f32_32x32x16_bf16(b1_, qr[d0], p1, 0, 0, 0); } } while (0)
#define PP_SOFTMAX(j) do { \
        if (MODE == 0) { _Pragma("unroll") for (int r = 0; r < 16; ++r) { const int kv_ = 64 * (t_lo + (j)) + crow(r, hi); int e0_ = kv_ - qi; e0_ = e0_ < 0 ? -e0_ : e0_; int e1_ = kv_ + 32 - qi; e1_ = e1_ < 0 ? -e1_ : e1_; \
            if (e0_ > 128) p0[r] = -INFINITY; if (e1_ > 128) p1[r] = -INFINITY; } } \
        float rm_ = fmaxf(p0[0], p1[0]); _Pragma("unroll") for (int r = 1; r < 16; ++r) rm_ = fmaxf(rm_, fmaxf(p0[r], p1[r])); rm_ = swapmax(rm_); \
        const float mn_ = fmaxf(m_run, rm_), alpha_ = __builtin_amdgcn_exp2f(m_run - mn_); m_run = mn_; float sum_ = 0.f; \
        _Pragma("unroll") for (int r = 0; r < 16; ++r) { p0[r] = __builtin_amdgcn_exp2f(p0[r] - mn_); p1[r] = __builtin_amdgcn_exp2f(p1[r] - mn_); sum_ += p0[r] + p1[r]; } \
        l_run = l_run * alpha_ + sum_; \
        _Pragma("unroll") for (int d = 0; d < NVB; ++d) _Pragma("unroll") for (int r = 0; r < 16; ++r) o[d][r] *= alpha_; \
        pw[0] = (u32x4){cvtpk(p0[0], p0[1]), cvtpk(p0[2], p0[3]), cvtpk(p0[4], p0[5]), cvtpk(p0[6], p0[7])}; pw[1] = (u32x4){cvtpk(p0[8], p0[9]), cvtpk(p0[10], p0[11]), cvtpk(p0[12], p0[13]), cvtpk(p0[14], p0[15])}; \
        pw[2] = (u32x4){cvtpk(p1[0], p1[1]), cvtpk(p1[2], p1[3]), cvtpk(p1[4], p1[5]), cvtpk(p1[6], p1[7])}; pw[3] = (u32x4){cvtpk(p1[8], p1[9]), cvtpk(p1[10], p1[11]), cvtpk(p1[12], p1[13]), cvtpk(p1[14], p1[15])}; } while (0)
#define PP_PV(j) do { const unsigned vb_ = lds0 + LDS_V + ((j) % RD) * VS + ((lane >> 4) & 1) * 32 + (lane & 3) * 8 + (4 * hi + ((lane & 15) >> 2)) * 64; \
        _Pragma("unroll") for (int d = 0; d < NVB; ++d) { s16x4 lo_[4], hh_[4]; \
            _Pragma("unroll") for (int ks = 0; ks < 4; ++ks) { lo_[ks] = vtr(vb_ + d * 4096 + ks * 1024); hh_[ks] = vtr(vb_ + d * 4096 + ks * 1024 + 512); } \
            asm volatile("s_waitcnt lgkmcnt(0)" ::: "memory"); __builtin_amdgcn_sched_barrier(0); \
            _Pragma("unroll") for (int ks = 0; ks < 4; ++ks) { const bf16x8 vf_ = (bf16x8){lo_[ks][0], lo_[ks][1], lo_[ks][2], lo_[ks][3], hh_[ks][0], hh_[ks][1], hh_[ks][2], hh_[ks][3]}; \
                o[d] = __builtin_amdgcn_mfma_f32_32x32x16_bf16(vf_, __builtin_bit_cast(bf16x8, pw[ks]), o[d], 0, 0, 0); } } } while (0)
    PP_DMA_K(0); PP_DMA_V(0); if (n > 1) { PP_DMA_K(1); PP_DMA_V(1); } if (n > 2) PP_DMA_K(2);
    asm volatile("s_waitcnt vmcnt(0) lgkmcnt(0)\n\ts_barrier" ::: "memory");
    if (grp == 1) asm volatile("s_barrier" ::: "memory");
    int infl = 0;
    if (PP_ACTIVE(0)) PP_QK(0);
    wait_vm_bar(infl);
    if (grp == 1) PP_BATCH(0, infl);
    if (PP_ACTIVE(0)) PP_SOFTMAX(0);
    wait_vm_bar(infl);
    for (int j = 0; j < n; ++j) {
        if (grp == 0) PP_BATCH(j, infl);
        const bool act = PP_ACTIVE(j), actn = (j + 1 < n) && PP_ACTIVE(j + 1);
        if (act) PP_PV(j);
        if (actn) PP_QK(j + 1);
        wait_vm_bar(infl);
        if (j + 1 < n) {
            if (grp == 1) PP_BATCH(j + 1, infl);
            if (actn) PP_SOFTMAX(j + 1);
            wait_vm_bar(infl);
        }
    }
    if (grp == 0) asm volatile("s_barrier" ::: "memory");
    const float linv = 1.0f / swapsum(l_run);
#pragma unroll
    for (int d = 0; d < NVB; ++d)
#pragma unroll
        for (int r4 = 0; r4 < 4; ++r4) { f32x4 v = {o[d][4 * r4] * linv, o[d][4 * r4 + 1] * linv, o[d][4 * r4 + 2] * linv, o[d][4 * r4 + 3] * linv};
            *(u32x2*)(S.o + (size_t)r32 * S.opitch + 32 * d + 8 * r4 + 4 * hi) = pack4(v); }
    asm volatile("s_waitcnt lgkmcnt(0)\n\ts_barrier" ::: "memory");
#undef PP_DMA_K
#undef PP_DMA_V
#undef PP_BATCH
#undef PP_ACTIVE
#undef PP_QK
#undef PP_SOFTMAX
#undef PP_PV
}
}
#define SC_AFTER_PROLOGUE() do {} while (0)
#define SC_AFTER_INPROJ(l) do {} while (0)
#define SC_AFTER_UP(l) do {} while (0)
#define SC_AFTER_MLA(l) do {} while (0)
#define SC_AFTER_BRANCH(l) do {} while (0)
#define SC_AFTER_WOUT(l) do {} while (0)
#define SC_AFTER_NORM2(l) do {} while (0)
#define SC_AFTER_GU(l) do {} while (0)
#define SC_AFTER_DOWN(l) do {} while (0)
#define SC_AFTER_ROUTE(l) do {} while (0)
#define SC_AFTER_MOEGU(l, h) do {} while (0)
#define SC_AFTER_MOED(l, h) do {} while (0)
#define SC_FINAL() do {} while (0)

struct Args { const float* in[23]; float* out; unsigned char* ws; };
#define WSP(type, off) ((type*)(F.ws + (off)))
#define PHASE() Frame Fp = F; Fp.ws = opq_p(F.ws); Fp.in = opq_p(F.in); Fp.out = opq_p(F.out); Fp.tid = opq_v((int)threadIdx.x); Fp.lane = Fp.tid & 63; Fp.wave = __builtin_amdgcn_readfirstlane(Fp.tid >> 6); (void)Fp
#define FWS(type, off) ((type*)(Fp.ws + (off)))
#define X_ (Fp.out)
#define H_ FWS(bf16_t, WS_H)
#define Pb_ FWS(bf16_t, WS_R + R_P)
#define Gb_ FWS(bf16_t, WS_R + R_G)
#define QB_ FWS(bf16_t, WS_R + R_QB)
#define KVB_ FWS(bf16_t, WS_R + R_KVB)
#define Yb_ FWS(bf16_t, WS_R + R_Y)
#define MEMN_ FWS(bf16_t, WS_MEMN)
#define MEMKV_ FWS(bf16_t, WS_MEMKV)
#define ACT_ FWS(bf16_t, WS_R + R_ACT)
#define ASORT_ FWS(bf16_t, WS_R + R_ASORT)
#define YOUT_ FWS(bf16_t, WS_R + R_YOUT)
#define SSQ_ FWS(float, WS_MISC + MS_SSQ)
#define TEXP_ FWS(const int, WS_MISC + MS_TEXP)
#define POS_ ((const int*)Fp.in[I_POS])
#define HSC_ FWS(float, WS_MISC + MS_HSC)
#define ASC_ FWS(float, WS_MISC + MS_ASC)
#define WSIN_ FWS(float, WS_MISC + MS_WSIN)
#define WSGU_ FWS(float, WS_MISC + MS_WSGU)

#define GRID_BAR() xcd_barrier(bar)
#ifndef MLA_STAG
#define MLA_STAG false
#endif
template <int l> __device__ __forceinline__ void layer_body(const Frame& F, const XcdBarrier& bar, const int bx) {
        if (l > 0) {
            PHASE();
            prep_ffn_weights(Fp, l);
            norm_phase(Fp, X_, X_, Fp.in[I_GMIX] + l * DM, (l & 1) == 0, true);
            GRID_BAR();
        }
        {   PHASE();
            ProbSimple p{DM, DM, DM, (const char*)H_, (const char*)wmix(Fp, l, WL_IN)}; pg8::StaticOrder S; S.init(T / 256, NT_IN, Fp.G, bx);
            EpiInproj E{Pb_, Gb_, SSQ_, POS_, HSC_, WSIN_ + l * NT_IN * 256}; pg8::gemm_phase<true>(Fp.lds, p, S, E); }
        if (l == 0) { PHASE();
            ProbSimple p{DM, DM * 2, DM * 2, (const char*)MEMN_, (const char*)FWS(bf16_t, WS_WMKV)}; pg8::StaticOrder S; S.init(NB * MEML / 256, 16, Fp.G, bx);
            EpiPlain E{MEMKV_, 4096}; pg8::gemm_phase(Fp.lds, p, S, E); }
        GRID_BAR();
        SC_AFTER_INPROJ(l);
        {   PHASE();
            ProbSimple p{UPK, PW * 2, UPK * 2, (const char*)(Pb_ + P_CQ), (const char*)wmix(Fp, l, WL_UP)}; pg8::StaticOrder S; S.init(T / 256, UPN / 256, Fp.G, bx);
            EpiUp E{QB_, KVB_, SSQ_, POS_}; pg8::gemm_phase(Fp.lds, p, S, E); }
        {   PHASE();
            for (int i = Fp.vcu; i < 1024; i += Fp.G) {
                const int hl = i & 3, qb = (i >> 2) & 15, kvh = (i >> 6) & 1, b = i >> 7, h = kvh * 4 + hl; const size_t rowb = (size_t)b * SEQ; const int q0 = qb * 256;
                att::Src s; s.q = Pb_ + (rowb + q0 + Fp.wave * 32) * PW + P_QA + h * 64; s.qpitch = PW; s.k0 = Pb_ + rowb * PW + P_KA + kvh * 64; s.k0pitch = PW; s.k1 = s.k0; s.k1pitch = PW;
                s.v = Pb_ + rowb * PW + P_VA + kvh * 64; s.vpitch = PW; s.o = Yb_ + (rowb + q0 + Fp.wave * 32) * YW + h * 64; s.opitch = YW;
                const int t_lo = (q0 / 64 - 2) < 0 ? 0 : (q0 / 64 - 2), t_hi = (q0 / 64 + 6) > SEQ / 64 ? SEQ / 64 : (q0 / 64 + 6);
                att::unit<8, 2, 0>(Fp.lds, s, t_lo, t_hi, q0, Fp.in[I_SINK][l * 8 + h] * LOG2E);
            } }
        {   PHASE();
            for (int i = Fp.vcu; i < 512; i += Fp.G) {
                const int qb = i & 15, h = (i >> 4) & 3, b = i >> 6; const size_t rowq = (size_t)b * SEQ + qb * 256 + Fp.wave * 32;
                att::Src s; s.q = Pb_ + rowq * PW + P_QM + h * 128; s.qpitch = PW; s.k0 = MEMKV_ + (size_t)b * MEML * 4096 + l * 1024 + h * 128; s.k0pitch = 4096; s.k1 = s.k0 + 64; s.k1pitch = 4096;
                s.v = MEMKV_ + (size_t)b * MEML * 4096 + l * 1024 + 512 + h * 128; s.vpitch = 4096; s.o = Yb_ + rowq * YW + 1024 + h * 128; s.opitch = YW;
                att::unit<16, 4, 1>(Fp.lds, s, 0, MEML / 64, 0, 0.f);
            } }
        GRID_BAR();
        SC_AFTER_UP(l);
        {   PHASE();
            for (int i = Fp.vcu; i < 1024; i += Fp.G) {
                const int qb = i & 15, h = (i >> 4) & 7, b = i >> 7; const size_t rowb = (size_t)b * SEQ, rowq = rowb + qb * 256 + Fp.wave * 32;
                att::Src s; s.q = QB_ + rowq * QBW + h * 96; s.qpitch = QBW; s.k0 = KVB_ + rowb * KVW + h * 128; s.k0pitch = KVW; s.k1 = Pb_ + rowb * PW + P_KR; s.k1pitch = PW;
                s.v = KVB_ + rowb * KVW + h * 128 + 64; s.vpitch = KVW; s.o = Yb_ + rowq * YW + 512 + h * 64; s.opitch = YW;
                att::unit_pf<12, 2, MLA_STAG>(Fp.lds, s, 0, SEQ / 64);
            } }
        GRID_BAR();
        SC_AFTER_MLA(l);
        {   PHASE();
            ProbSimple p{1536, YW * 2, 1536 * 2, (const char*)Yb_, (const char*)wmix(Fp, l, WL_BR)}; pg8::StaticOrder S; S.init(T / 256, DM / 256, Fp.G, bx);
            EpiBranch E{Gb_, H_}; pg8::gemm_phase(Fp.lds, p, S, E); }
        GRID_BAR();
        SC_AFTER_BRANCH(l);
        {   PHASE();
            ProbSimple p{DM, DM * 2, DM * 2, (const char*)H_, (const char*)wmix(Fp, l, WL_OUT)}; pg8::StaticOrder S; S.init(T / 256, DM / 256, Fp.G, bx);
            EpiResid E{l == 0 ? Fp.in[I_X] : X_, X_}; pg8::gemm_phase(Fp.lds, p, S, E); }
        GRID_BAR();
        SC_AFTER_WOUT(l);
        if ((l & 1) == 0) {
            {   PHASE(); norm_phase(Fp, X_, nullptr, Fp.in[I_GFFN] + l * DM, false, GU_I8(l) != 0); }
            GRID_BAR();
            SC_AFTER_NORM2(l);
            {   PHASE();
                constexpr bool i8 = GU_I8(l) != 0; constexpr unsigned eb = i8 ? 1 : 2;
                ProbSimple p{DM, DM * eb, DM * eb, (const char*)H_, (const char*)FWS(bf16_t, WS_WFFN + WF_GU)}; pg8::StaticOrder S; S.init(T / 256, 2 * DFF / 256, Fp.G, bx);
                EpiSwiglu E{ACT_, 0, HSC_, WSGU_}; pg8::gemm_phase<i8>(Fp.lds, p, S, E); }
            GRID_BAR();
            SC_AFTER_GU(l);
            {   PHASE();
                ProbSimple p{DFF, DFF * 2, DFF * 2, (const char*)ACT_, (const char*)FWS(bf16_t, WS_WFFN + WF_D)}; pg8::StaticOrder S; S.init(T / 256, DM / 256, Fp.G, bx);
                EpiResid E{X_, X_}; pg8::gemm_phase(Fp.lds, p, S, E); }
            GRID_BAR();
            SC_AFTER_DOWN(l);
        } else {
            {   PHASE(); norm_router_phase(Fp, X_, Fp.in[I_GFFN] + l * DM, Fp.in[I_WR] + (size_t)(l >> 1) * DM * NE, GU_I8(l) != 0); }
            GRID_BAR();
            {   PHASE(); moe_assign_phase(Fp, GU_I8(l) != 0); }
            GRID_BAR();
            SC_AFTER_ROUTE(l);
            {   constexpr int half = 0; (void)half;
                {   PHASE();
                    const int nrt = TEXP_[MAXRT];
                    constexpr bool i8 = GU_I8(l) != 0; constexpr unsigned eb = i8 ? 1 : 2;
                    ProbMoe p{DM, DM * eb, DM * eb, (const char*)ASORT_, (const char*)FWS(bf16_t, WS_WFFN + WF_GU), 0}; MoeOrder S; S.base.init(nrt, 2 * DFF / 256, Fp.G, bx); S.lo = 0; S.texp = TEXP_;
                    EpiSwiglu E{ACT_, 0, ASC_, WSGU_}; pg8::gemm_phase<i8>(Fp.lds, p, S, E); }
                GRID_BAR();
                SC_AFTER_MOEGU(l, half);
                {   PHASE();
                    const int nrt = TEXP_[MAXRT];
                    ProbMoe p{DFF, DFF * 2, DFF * 2, (const char*)ACT_, (const char*)FWS(bf16_t, WS_WFFN + WF_D), 0}; MoeOrder S; S.base.init(nrt, DM / 256, Fp.G, bx); S.lo = 0; S.texp = TEXP_;
                    EpiYout E{YOUT_}; pg8::gemm_phase(Fp.lds, p, S, E); }
                GRID_BAR();
                SC_AFTER_MOED(l, half);
            }
        }
    }

__global__ void __launch_bounds__(NWAVES * 64, 2) fwd(Args args) {
    extern __shared__ __attribute__((aligned(16))) unsigned char lds_raw[];
    Frame F;
    F.lds = (LAS unsigned char*)lds_raw;
    F.MISC = (volatile LAS unsigned*)(F.lds + LDSCTL_OFF);
    F.tid = threadIdx.x; F.lane = F.tid & 63; F.wave = __builtin_amdgcn_readfirstlane(F.tid >> 6);
    F.G = gridDim.x; { const int bx = blockIdx.x; F.vcu = (F.G % 8 == 0) ? (bx % 8) * (F.G / 8) + bx / 8 : bx; }
    F.ws = args.ws; F.ctl = (gu32*)(args.ws + WS_CTL); F.out = args.out;
    F.in = (const float* const*)__builtin_amdgcn_kernarg_segment_ptr();
    for (int u = F.tid; u < (LDS_BYTES - LDSCTL_OFF) / 4; u += NWAVES * 64) ((LAS unsigned*)(F.lds + LDSCTL_OFF))[u] = 0u;
    __syncthreads();
    XcdBarrier bar = xcd_barrier_post((unsigned*)(F.ctl + CW_BAR), F.MISC + 8);

    const int bx = (int)blockIdx.x;

    {   PHASE();
        prep_mixer_weights(Fp);
        memnorm_phase(Fp);
        prep_ffn_weights(Fp, 0);
        norm_phase(Fp, Fp.in[I_X], nullptr, Fp.in[I_GMIX], false, true); }
    GRID_BAR();
    SC_AFTER_PROLOGUE();

    layer_body<0>(F, bar, bx); layer_body<1>(F, bar, bx); layer_body<2>(F, bar, bx); layer_body<3>(F, bar, bx);
    {   PHASE(); final_norm_phase(Fp, X_, Fp.in[I_GFIN], true); }
    SC_FINAL();
}

extern "C" void kernel_launch(void* const* d_in, const int* in_sizes, int n_in, void* d_out, int out_size, void* d_ws, size_t ws_size, hipStream_t stream) {
    static int grid = 0;
    if (grid == 0) {
        if (n_in != 23 || out_size != T * DM || ws_size < WS_END) { fprintf(stderr, "kernel_launch: unexpected problem (n_in %d, out %d, ws %zu < %zu)\n", n_in, out_size, ws_size, (size_t)WS_END); grid = -1; return; }
        int dev = 0, cus = 0;
        if (hipGetDevice(&dev) != hipSuccess || hipDeviceGetAttribute(&cus, hipDeviceAttributeMultiprocessorCount, dev) != hipSuccess) { grid = -1; return; }
        if (hipFuncSetAttribute((const void*)fwd, hipFuncAttributeMaxDynamicSharedMemorySize, LDS_BYTES) != hipSuccess) { fprintf(stderr, "kernel_launch: hipFuncSetAttribute failed\n"); grid = -1; return; }
        int per_cu = 0;
        if (hipOccupancyMaxActiveBlocksPerMultiprocessor(&per_cu, (const void*)fwd, NWAVES * 64, LDS_BYTES) != hipSuccess || per_cu < 1) fprintf(stderr, "kernel_launch: occupancy query says %d\n", per_cu);
        (void)hipGetLastError();
        grid = cus;
    }
    if (grid < 0) return;
    if (hipMemsetAsync((char*)d_ws + WS_CTL, 0, CTL_ZERO_BYTES, stream) != hipSuccess) return;
    Args a{};
    for (int i = 0; i < 23; ++i) a.in[i] = (const float*)d_in[i];
    a.out = (float*)d_out; a.ws = (unsigned char*)d_ws;
    hipLaunchKernelGGL(fwd, dim3(grid), dim3(NWAVES * 64), LDS_BYTES, stream, a);
}
```

```cpp
#include <hip/hip_runtime.h>
#include <cstdio>
#include <cstdint>

#ifndef SELFCHECK
#define SELFCHECK 0
#endif
#ifndef GU_I8_MASK
#define GU_I8_MASK 0xF
#endif
#define GU_I8(l) ((((unsigned)GU_I8_MASK) >> (l)) & 1u)

#define GAS __attribute__((address_space(1)))
#define LAS __attribute__((address_space(3)))
typedef unsigned short bf16_t;
typedef short bf16x8 __attribute__((ext_vector_type(8)));
typedef short s16x4 __attribute__((ext_vector_type(4)));
typedef short v4i16_t __attribute__((ext_vector_type(4)));
typedef float f32x2 __attribute__((ext_vector_type(2)));
typedef float f32x4 __attribute__((ext_vector_type(4)));
typedef float f32x16 __attribute__((ext_vector_type(16)));
typedef unsigned u32x2 __attribute__((ext_vector_type(2)));
typedef unsigned u32x4 __attribute__((ext_vector_type(4)));
typedef int i32x4 __attribute__((ext_vector_type(4)));
typedef GAS unsigned gu32;
#define RLX_AGENT __ATOMIC_RELAXED, __HIP_MEMORY_SCOPE_AGENT

constexpr int NB = 8, SEQ = 4096, T = NB * SEQ, DM = 1024, DEPTH = 4, MEML = 256, DFF = 3584, NE = 8;
constexpr int INW = 4768;
constexpr int PW = 1792;
constexpr int GW = 3072;
constexpr int QBW = 768, KVW = 1024, YW = 1536;
constexpr int NT_IN = 19;
constexpr int P_QA = 0, P_KA = 512, P_VA = 640, P_CQ = 768, P_CKV = 1024, P_KR = 1152, P_QM = 1280;
constexpr int UPK = 384, UPN = 1792;
constexpr int MAXSLOT = 67584;
constexpr int MAXRT = MAXSLOT / 256;
constexpr int HALF_RT = 132;
constexpr float EPS = 1e-6f;
constexpr float LOG2E = 1.4426950408889634f;
constexpr float C_A = 0.125f * LOG2E;
constexpr float C_B = 0.10206207261596575f * LOG2E;
constexpr float C_M = 0.08838834764831845f * LOG2E;

constexpr size_t MiB = 1u << 20;
constexpr size_t WS_CTL = 0, CTL_ZERO_BYTES = 1 * MiB;
constexpr size_t WS_MISC = 1 * MiB;
constexpr size_t WL_IN = 0, WL_UP = (size_t)NT_IN * 256 * DM * 2, WL_BR = WL_UP + (size_t)UPN * UPK * 2, WL_OUT = WL_BR + (size_t)3 * DM * 512 * 2, WL_SIZE = WL_OUT + (size_t)DM * DM * 2;
constexpr size_t WS_WMIX = 8 * MiB;
constexpr size_t WS_WMKV = WS_WMIX + 4 * ((WL_SIZE + MiB - 1) / MiB) * MiB;
constexpr size_t WL_STRIDE = ((WL_SIZE + MiB - 1) / MiB) * MiB;
constexpr size_t WS_WFFN = WS_WMKV + 8 * MiB;
constexpr size_t WF_GU = 0, WF_D = (size_t)2 * DFF * DM * 2, WF_STRIDE = WF_D + (size_t)DM * DFF * 2;
constexpr size_t WS_H = WS_WFFN + 8 * WF_STRIDE;
constexpr size_t WS_MEMN = WS_H + (size_t)T * DM * 2;
constexpr size_t WS_MEMKV = WS_MEMN + (size_t)NB * MEML * DM * 2;
constexpr size_t WS_R = WS_MEMKV + (size_t)NB * MEML * 4096 * 2;
constexpr size_t R_P = 0, R_G = R_P + (size_t)T * PW * 2, R_QB = R_G + (size_t)T * GW * 2, R_KVB = R_QB + (size_t)T * QBW * 2, R_Y = R_KVB + (size_t)T * KVW * 2, R_END_MIX = R_Y + (size_t)T * YW * 2;
constexpr size_t R_BRS = R_P;
constexpr size_t R_ACT = 0;
constexpr size_t R_ASORT = (size_t)MAXSLOT * DFF * 2;
constexpr size_t R_YOUT = R_ASORT;
constexpr size_t R_END_FFN = R_YOUT + (size_t)MAXSLOT * DM * 2;
constexpr size_t R_SIZE = R_END_MIX > R_END_FFN ? R_END_MIX : R_END_FFN;
constexpr size_t WS_END = WS_R + R_SIZE;
static_assert(WS_END < 1020ull * MiB, "workspace budget");
constexpr size_t MS_TOKE = 0;
constexpr size_t MS_TOKW = MS_TOKE + (size_t)T * 8;
constexpr size_t MS_SLOT = MS_TOKW + (size_t)T * 8;
constexpr size_t MS_CNT = MS_SLOT + (size_t)T * 8;
constexpr size_t MS_TEXP = MS_CNT + 256 * 8 * 4;
constexpr size_t MS_SSQ = MS_TEXP + 2048;
constexpr size_t MS_SNAP = MS_SSQ + (size_t)T * 32;
constexpr size_t MS_HSC = MS_SNAP + 64 * 1024 * 4;
constexpr size_t MS_ASC = MS_HSC + (size_t)T * 4;
constexpr size_t MS_WSIN = MS_ASC + (size_t)MAXSLOT * 4;
constexpr size_t MS_WSGU = MS_WSIN + (size_t)4 * NT_IN * 256 * 4;
constexpr size_t MS_END = MS_WSGU + (size_t)8 * 2 * DFF * 4;
static_assert(MS_END <= 7 * MiB, "misc map");
constexpr int CW_BAR = 4096;
constexpr int CW_DIAG = 16384;
constexpr int CW_CODE = 16384 + 512;

constexpr int RING_BYTES = 131072;
constexpr int LDSCTL_OFF = RING_BYTES;
constexpr int LDS_BYTES = 147456;
constexpr int NWAVES = 8;

#define LDS_WAIT() asm volatile("s_waitcnt lgkmcnt(0)" ::: "memory")
#define VM_WAIT() asm volatile("s_waitcnt vmcnt(0)" ::: "memory")

__device__ __forceinline__ unsigned f2bf(float f) { unsigned u = __builtin_bit_cast(unsigned, f); return (u + 0x7fffu + ((u >> 16) & 1u)) >> 16; }
__device__ __forceinline__ unsigned pk2(float lo, float hi) { return f2bf(lo) | (f2bf(hi) << 16); }
__device__ __forceinline__ float bf2f(unsigned short b) { return __builtin_bit_cast(float, (unsigned)b << 16); }
__device__ __forceinline__ float bflo(unsigned w) { return __builtin_bit_cast(float, w << 16); }
__device__ __forceinline__ float bfhi(unsigned w) { return __builtin_bit_cast(float, w & 0xffff0000u); }
typedef __bf16 bf16x2_t __attribute__((ext_vector_type(2)));
__device__ __forceinline__ unsigned cvtpk(float lo, float hi) { f32x2 v = {lo, hi}; bf16x2_t b = __builtin_convertvector(v, bf16x2_t); return __builtin_bit_cast(unsigned, b); }
__device__ __forceinline__ float wave_sum(float v) {
#pragma unroll
    for (int o = 1; o < 64; o <<= 1) v += __shfl_xor(v, o);
    return v;
}
__device__ __forceinline__ float fast_sigmoid(float x) { return __builtin_amdgcn_rcpf(1.0f + __builtin_amdgcn_exp2f(-x * LOG2E)); }


__device__ __forceinline__ int opq_v(int x) { asm volatile("" : "+v"(x)); return x; }
__device__ __forceinline__ int opq_s(int x) { asm volatile("" : "+s"(x)); return x; }
template <class Tp> __device__ __forceinline__ Tp* opq_p(Tp* p) { const unsigned long long u = (unsigned long long)p; unsigned lo = __builtin_amdgcn_readfirstlane((unsigned)u), hi = __builtin_amdgcn_readfirstlane((unsigned)(u >> 32)); asm volatile("" : "+s"(lo), "+s"(hi)); return (Tp*)(((unsigned long long)hi << 32) | lo); }

__constant__ float IFR_HI[32] = {1.591549367e-01f, 1.193493679e-01f, 8.949939907e-02f, 6.711508334e-02f, 5.032921210e-02f, 3.774158657e-02f, 2.830219641e-02f, 2.122365311e-02f, 1.591549441e-02f, 1.193493698e-02f, 8.949940093e-03f, 6.711508147e-03f, 5.032921210e-03f, 3.774158424e-03f, 2.830219688e-03f, 2.122365171e-03f, 1.591549488e-03f, 1.193493721e-03f, 8.949940093e-04f, 6.711508031e-04f, 5.032921326e-04f, 3.774158540e-04f, 2.830219455e-04f, 2.122365258e-04f, 1.591549371e-04f, 1.193493736e-04f, 8.949940093e-05f, 6.711508468e-05f, 5.032921035e-05f, 3.774158540e-05f, 2.830219637e-05f, 2.122365186e-05f};
__constant__ float IFR_LO[32] = {6.420638243e-09f, 2.294664903e-09f, 2.542919653e-09f, -3.316028840e-10f, 5.173299289e-12f, -1.848551645e-09f, -5.826552019e-10f, -3.431038786e-10f, -1.029942243e-10f, 4.320196978e-11f, 6.802745173e-11f, 1.531042237e-10f, 5.173301024e-13f, 4.797548470e-11f, -1.048316434e-10f, 1.053879969e-10f, -5.686555046e-11f, -1.896286773e-11f, 6.802744999e-12f, 2.695195456e-11f, -1.158979943e-11f, -6.843983713e-12f, 1.279990003e-11f, 1.807650600e-12f, 5.954976963e-12f, -3.351478166e-12f, 6.802745216e-13f, -1.670379113e-12f, 1.751403167e-12f, -6.843983930e-13f, -5.389994549e-13f, 9.083608431e-13f};
__device__ __forceinline__ void rot_cs(float posf, int idx, float& c, float& s) {
    const float ch = IFR_HI[idx], cl = IFR_LO[idx];
    const float p = posf * ch, e = __builtin_fmaf(posf, ch, -p);
    const float fr = __builtin_amdgcn_fractf(p) + (e + posf * cl);
    s = __builtin_amdgcn_sinf(fr); c = __builtin_amdgcn_cosf(fr);
}

#define XB_TMO      128
#define XB_XCNT(j)  (256  + 64 * (j))
#define XB_XSUB(j)  (1280 + 64 * (j))
#define XB_XGEN(j)  (2304 + 64 * (j))
#define XB_TOP      3328
#define XB_TOPGEN   3392
#define XCD_BAR_WORDS 3456
#define XB_SPIN_CAP (1u << 20)

__device__ __forceinline__ unsigned xb_ld(unsigned* p)              { return __hip_atomic_load(p, __ATOMIC_RELAXED, __HIP_MEMORY_SCOPE_AGENT); }
__device__ __forceinline__ unsigned xb_add(unsigned* p, unsigned v) { return __hip_atomic_fetch_add(p, v, __ATOMIC_RELAXED, __HIP_MEMORY_SCOPE_AGENT); }
__device__ __forceinline__ unsigned xb_xcc_id() { return (unsigned)__builtin_amdgcn_s_getreg((3 << 11) | 20) & 0xFu; }
#define XB_SPIN(cond, bar) do { unsigned _sp = 0; while (cond) { __builtin_amdgcn_s_sleep(1); \
    if ((++_sp & 255u) == 0u) { if (xb_ld(&(bar)[XB_TMO])) break; if (_sp > XB_SPIN_CAP) { atomicAdd(&(bar)[XB_TMO], 1u); break; } } } } while (0)

struct XcdBarrier { unsigned* bar; unsigned x; volatile LAS unsigned* st; };

__device__ __forceinline__ XcdBarrier xcd_barrier_post(unsigned* bar, volatile LAS unsigned* st) {
    XcdBarrier b; b.bar = bar; b.x = xb_xcc_id(); b.st = st;
    if (threadIdx.x == 0) (void)xb_add(&bar[XB_XCNT(b.x)], 1u);
    return b;
}
__device__ __forceinline__ void xcd_barrier_complete(unsigned* bar, unsigned x, unsigned& nloc, unsigned& nx) {
    const unsigned G = gridDim.x * gridDim.y * gridDim.z;
    unsigned sum, cnt, mine, sp = 0u;
    for (;;) {
        sum = 0u; cnt = 0u; mine = 0u;
#pragma unroll
        for (unsigned j = 0; j < 16; ++j) { const unsigned c = xb_ld(&bar[XB_XCNT(j)]); sum += c; cnt += (c > 0u) ? 1u : 0u; mine = (j == x) ? c : mine; }
        if (sum == G) break;
        __builtin_amdgcn_s_sleep(1);
        if ((++sp & 255u) == 0u) { if (xb_ld(&bar[XB_TMO])) break; if (sp > XB_SPIN_CAP) { atomicAdd(&bar[XB_TMO], 1u); break; } }
    }
    nloc = mine > 0u ? mine : 1u; nx = cnt > 0u ? cnt : 1u;
}
__device__ __forceinline__ void xcd_barrier(const XcdBarrier& b) {
    asm volatile("s_waitcnt vmcnt(0)" ::: "memory");
    __syncthreads();
    if (threadIdx.x == 0) {
        unsigned* bar = b.bar;
        __builtin_amdgcn_s_waitcnt(0);
        unsigned nloc = b.st[0], nx = b.st[1];
        if (nloc == 0u) { xcd_barrier_complete(bar, b.x, nloc, nx); b.st[0] = nloc; b.st[1] = nx; }
        const unsigned old = xb_add(&bar[XB_XSUB(b.x)], 1u);
        const unsigned gen = old / nloc;
        if (old + 1u == (gen + 1u) * nloc) {
            __builtin_amdgcn_fence(__ATOMIC_RELEASE, "agent");
            asm volatile("s_waitcnt vmcnt(0)" ::: "memory");
            const unsigned og = xb_add(&bar[XB_TOP], 1u);
            const unsigned tg = og / nx;
            if (og + 1u == (tg + 1u) * nx) xb_add(&bar[XB_TOPGEN], 1u);
            else XB_SPIN(xb_ld(&bar[XB_TOPGEN]) == tg, bar);
            __builtin_amdgcn_fence(__ATOMIC_ACQUIRE, "agent");
            xb_add(&bar[XB_XGEN(b.x)], 1u);
            asm volatile("s_waitcnt vmcnt(0)" ::: "memory");
        } else {
            XB_SPIN(xb_ld(&bar[XB_XGEN(b.x)]) == gen, bar);
            __builtin_amdgcn_fence(__ATOMIC_ACQUIRE, "agent");
            asm volatile("s_waitcnt vmcnt(0)" ::: "memory");
        }
    }
    __syncthreads();
}

namespace pg8 {
constexpr int BM = 256, BK = 64, HALF = 128, HTB = HALF * BK * 2, STAGE_BYTES = 8 * HTB, NXCD = 8, WGM = 4;
constexpr int ESC_OFF = 131072 + 4096, ESC_SLOT = 3072;
__host__ __device__ __forceinline__ int lds_byte(int r, int c) { const int st = (r >> 4) * 2 + (c >> 5), rr = r & 15, cc = c & 31, ob = rr * 64 + cc * 2; return st * 1024 + (ob ^ (((ob >> 9) & 1) << 5)); }
__host__ __device__ __forceinline__ void stage_rc(int b, int& R, int& C) { const int st = b / 1024, sb = b % 1024, swz = sb ^ (((sb >> 9) & 1) << 5); R = (st >> 1) * 16 + swz / 64; C = (st & 1) * 32 + (swz % 64) / 2; }

struct Unit { int pm, pn, aux; };

struct StaticOrder {
    int nM, nN, nwg, G, c;
    __device__ void init(int nM_, int nN_, int G_, int c_) { nM = nM_; nN = nN_; nwg = nM * nN; G = G_; c = c_; }
    __device__ bool next(int i, Unit& u) const {
        const long L = (long)i * G + c; if (L >= nwg) return false;
        int wgid = (int)L; { const int q = nwg / NXCD, r = nwg % NXCD, xcd = wgid % NXCD, off = wgid / NXCD; wgid = (xcd < r ? xcd * (q + 1) : r * (q + 1) + (xcd - r) * q) + off; }
        const int nig = WGM * nN, gid = wgid / nig, fm = gid * WGM, gsz = (nM - fm) < WGM ? (nM - fm) : WGM;
        u.pm = fm + ((wgid % nig) % gsz); u.pn = (wgid % nig) / gsz; u.aux = 0; return true;
    }
};

struct RowOrder {
    int nN, nwg, G, c, q;
    __device__ void init(int nM_, int nN_, int G_, int c_) { nN = nN_; nwg = nM_ * nN_; G = G_; c = c_; q = nwg / G_; }
    __device__ bool next(int i, Unit& u) const {
        const int L = (i < q) ? c * q + i : G * q + (i - q) * G + c; if (L >= nwg) return false;
        u.pm = L / nN; u.pn = L % nN; u.aux = 0; return true;
    }
};

template <bool I8> struct AccVec { typedef f32x4 type; };
template <> struct AccVec<true> { typedef i32x4 type; };
template <bool I8 = false, class Prob, class Sched, class Epi>
__device__ __forceinline__ void gemm_phase(LAS unsigned char* lds, const Prob& P, const Sched& S, const Epi& E) {
    const int tid = opq_v((int)threadIdx.x), wid = __builtin_amdgcn_readfirstlane(tid >> 6), lane = tid & 63, wr = wid >> 2, wc = wid & 3, fr = lane & 15, fq = lane >> 4;
    typedef typename AccVec<I8>::type accv_t;
    const int K = P.K, nt = K / (I8 ? 2 * BK : BK);
    unsigned voffA[2], voffB[2];
#pragma unroll
    for (int i = 0; i < 2; ++i) { int R, C; stage_rc(tid * 16 + i * 8192, R, C); voffA[i] = (unsigned)R * P.lda + (unsigned)C * 2u; voffB[i] = (unsigned)R * P.ldb + (unsigned)C * 2u; }
    const size_t kstep = (size_t)(BK * 2);
    const size_t hstepA = (size_t)HALF * P.lda, hstepB = (size_t)HALF * P.ldb;
    const unsigned ldsw = (unsigned)wid * 1024u;
    const int aoff = lds_byte(wr * 64 + fr, fq * 8), boff = lds_byte(wc * 32 + fr, fq * 8);
#define PG8_SA(b, h) (((b) * 2 + (h)) * HTB)
#define PG8_SB(b, h) ((4 + (b) * 2 + (h)) * HTB)
#define PG8_STAGE(bufoff, gbase, voff) do { _Pragma("unroll") for (int _i = 0; _i < 2; ++_i) \
        __builtin_amdgcn_global_load_lds((const unsigned*)((const char*)(gbase) + (voff)[_i]), (LAS unsigned*)(lds + (bufoff) + ldsw + _i * 8192), 16, 0, 0); } while (0)
#define PG8_LDA(dst, b, h) do { _Pragma("unroll") for (int m = 0; m < 4; ++m) _Pragma("unroll") for (int k = 0; k < 2; ++k) dst[m][k] = *(const LAS bf16x8*)(lds + PG8_SA(b, h) + aoff + m * 2048 + k * 1024); } while (0)
#define PG8_LDB(dst, b, h) do { _Pragma("unroll") for (int n = 0; n < 2; ++n) _Pragma("unroll") for (int k = 0; k < 2; ++k) dst[n][k] = *(const LAS bf16x8*)(lds + PG8_SB(b, h) + boff + n * 2048 + k * 1024); } while (0)
#define PG8_MMA(ai, bj, At, Bt) do { __builtin_amdgcn_s_setprio(1); _Pragma("unroll") for (int m = 0; m < 4; ++m) _Pragma("unroll") for (int n = 0; n < 2; ++n) _Pragma("unroll") for (int k = 0; k < 2; ++k) \
        { if constexpr (I8) acc[ai][bj][m][n] = __builtin_amdgcn_mfma_i32_16x16x64_i8(__builtin_bit_cast(i32x4, Bt[n][k]), __builtin_bit_cast(i32x4, At[m][k]), acc[ai][bj][m][n], 0, 0, 0); \
          else acc[ai][bj][m][n] = __builtin_amdgcn_mfma_f32_16x16x32_bf16(Bt[n][k], At[m][k], acc[ai][bj][m][n], 0, 0, 0); } __builtin_amdgcn_s_setprio(0); } while (0)
#define PG8_WAIT_V(n) asm volatile("s_waitcnt vmcnt(" #n ")" ::: "memory")
#define PG8_WAIT_L(n) asm volatile("s_waitcnt lgkmcnt(" #n ")" ::: "memory")
#define PG8_BAR __builtin_amdgcn_s_barrier()
#define PG8_SCHED __builtin_amdgcn_sched_barrier(0)
    Unit cur, nxt; int ui = 0;
    if (!S.next(0, cur)) return;
    accv_t acc[2][2][4][2];
#pragma unroll
    for (int a = 0; a < 2; ++a)
#pragma unroll
        for (int b = 0; b < 2; ++b)
#pragma unroll
            for (int m = 0; m < 4; ++m)
#pragma unroll
                for (int n = 0; n < 2; ++n) acc[a][b][m][n] = accv_t{};
    bf16x8 At[4][2], B0[2][2], B1[2][2];
    const char* cA = P.a_ptr(cur); const char* cB = P.b_ptr(cur);
    int eslot = 0;
    E.stage(lds + ESC_OFF, cur, wid, lane);
    PG8_STAGE(PG8_SB(0, 0), cB, voffB); PG8_STAGE(PG8_SB(0, 1), cB + hstepB, voffB); PG8_STAGE(PG8_SA(0, 0), cA, voffA); PG8_STAGE(PG8_SA(0, 1), cA + hstepA, voffA);
    if (wr == 1) PG8_BAR;
    PG8_WAIT_V(2); PG8_BAR;
    PG8_STAGE(PG8_SB(1, 0), cB + kstep, voffB); PG8_STAGE(PG8_SA(1, 0), cA + kstep, voffA); PG8_STAGE(PG8_SB(1, 1), cB + hstepB + kstep, voffB);
    PG8_WAIT_V(6); PG8_BAR;
    for (;;) {
        const bool has_next = S.next(ui + 1, nxt);
        const char* nA = has_next ? P.a_ptr(nxt) : cA; const char* nB = has_next ? P.b_ptr(nxt) : cB;
        for (int t = 0; t < nt; t += 2) {
            if constexpr (Epi::MID) { if (t == 8 || t == 16) E.mid(acc, cur, t >> 3, wr, wc, fr, fq); }
            const bool last = (t == nt - 2);
            if (last && has_next) E.stage(lds + ESC_OFF + (eslot ^ 1) * ESC_SLOT, nxt, wid, lane);
            const char* a1 = cA + (size_t)(t + 1) * kstep;
            const char* a2 = last ? nA : cA + (size_t)(t + 2) * kstep; const char* b2 = last ? nB : cB + (size_t)(t + 2) * kstep;
            const char* a3 = a2 + kstep; const char* b3 = b2 + kstep;
            PG8_LDB(B0, 0, 0); PG8_LDB(B1, 0, 1); PG8_SCHED; PG8_LDA(At, 0, 0); PG8_STAGE(PG8_SA(1, 1), a1 + hstepA, voffA);
            PG8_WAIT_V(8); PG8_WAIT_L(0); PG8_BAR; PG8_MMA(0, 0, At, B0); PG8_MMA(0, 1, At, B1); PG8_BAR; PG8_SCHED;
            PG8_LDA(At, 0, 1); PG8_STAGE(PG8_SB(0, 0), b2, voffB); PG8_STAGE(PG8_SB(0, 1), b2 + hstepB, voffB); PG8_STAGE(PG8_SA(0, 0), a2, voffA);
            PG8_WAIT_V(8); PG8_WAIT_L(0); PG8_BAR; PG8_MMA(1, 0, At, B0); PG8_MMA(1, 1, At, B1); PG8_BAR; PG8_SCHED;
            PG8_LDB(B0, 1, 0); PG8_LDB(B1, 1, 1); PG8_SCHED; PG8_LDA(At, 1, 0); PG8_STAGE(PG8_SA(0, 1), a2 + hstepA, voffA);
            PG8_WAIT_V(8); PG8_WAIT_L(0); PG8_BAR; PG8_MMA(0, 0, At, B0); PG8_MMA(0, 1, At, B1); PG8_BAR; PG8_SCHED;
            PG8_LDA(At, 1, 1); PG8_STAGE(PG8_SB(1, 0), b3, voffB); PG8_STAGE(PG8_SB(1, 1), b3 + hstepB, voffB); PG8_STAGE(PG8_SA(1, 0), a3, voffA);
            PG8_WAIT_V(8); PG8_WAIT_L(0); PG8_BAR; PG8_MMA(1, 0, At, B0); PG8_MMA(1, 1, At, B1); PG8_BAR; PG8_SCHED;
        }
        if (wr == 0) PG8_BAR;
        E(acc, cur, wr, wc, fr, fq, lds + ESC_OFF + eslot * ESC_SLOT);
        if (!has_next) break;
#pragma unroll
        for (int a = 0; a < 2; ++a)
#pragma unroll
            for (int b = 0; b < 2; ++b)
#pragma unroll
                for (int m = 0; m < 4; ++m)
#pragma unroll
                    for (int n = 0; n < 2; ++n) acc[a][b][m][n] = accv_t{};
        cur = nxt; cA = nA; cB = nB; ++ui; eslot ^= 1;
        if (wr == 1) PG8_BAR;
    }
    PG8_WAIT_V(0);
    PG8_BAR;
#undef PG8_SA
#undef PG8_SB
#undef PG8_STAGE
#undef PG8_LDA
#undef PG8_LDB
#undef PG8_MMA
#undef PG8_WAIT_V
#undef PG8_WAIT_L
#undef PG8_BAR
#undef PG8_SCHED
}
}

struct Frame {
    LAS unsigned char* lds;
    volatile LAS unsigned* MISC;
    gu32* ctl;
    unsigned char* ws;
    int tid, lane, wave, vcu, G;
    const float* const* in; float* out;
};
enum { I_X = 0, I_MEM, I_POS, I_GMIX, I_WIN, I_GQ, I_WUQ, I_GKV, I_WUKV, I_SINK, I_WMKV, I_WBR, I_WOUT, I_GFFN, I_WGD, I_WUD, I_WDD, I_WR, I_WGE, I_WUE, I_WDE, I_GMEM, I_GFIN };

__device__ __forceinline__ int sem_plain(int g) { return (g & ~31) + 8 * ((g >> 2) & 3) + 4 * ((g >> 4) & 1) + (g & 3); }
__device__ __forceinline__ int sem_rot64(int g) { return (g & ~63) + 32 * ((g >> 4) & 1) + 16 * ((g >> 5) & 1) + 4 * ((g >> 2) & 3) + (g & 3); }
__device__ __forceinline__ int inproj_src(int n) {
    const int pn = n >> 8, c = n & 255;
    if (pn < 2) return pn * 256 + sem_rot64(c);
    if (pn == 2) return c < 128 ? 512 + sem_rot64(c) : 640 + sem_plain(c - 128);
    if (pn == 3) return 768 + sem_plain(c);
    if (pn == 4) return c < 128 ? 1024 + sem_plain(c) : (c < 160 ? 1152 + (c - 128) : -1);
    if (pn < 7) return 1184 + (pn - 5) * 256 + sem_plain(c);
    return 1696 + (pn - 7) * 256 + sem_plain(c);
}

struct MapInproj { const float* W; __device__ __forceinline__ float load(int k, int n) const { const int s = inproj_src(n); return s >= 0 ? W[(size_t)k * INW + s] : 0.f; }
    __device__ __forceinline__ f32x4 load4(int k, int n) const { const int s = inproj_src(n); return s >= 0 ? *(const f32x4*)(W + (size_t)k * INW + s) : (f32x4){0.f, 0.f, 0.f, 0.f}; } };
struct MapUp { const float *Wq, *Wkv, *gq, *gkv;
    __device__ __forceinline__ f32x4 load4(int k, int n) const {
        if (n < 768) { if (k >= 256) return (f32x4){0.f, 0.f, 0.f, 0.f}; const int gg = n >> 5; const int s = (gg % 3 == 2) ? n : sem_plain(n); return *(const f32x4*)(Wq + (size_t)k * 768 + s) * gq[k]; }
        if (k < 256) return (f32x4){0.f, 0.f, 0.f, 0.f}; const int s = sem_plain(n - 768); return *(const f32x4*)(Wkv + (size_t)(k - 256) * 1024 + s) * gkv[k - 256]; }
    __device__ __forceinline__ float load(int k, int n) const {
        if (n < 768) { if (k >= 256) return 0.f; const int gg = n >> 5; const int s = (gg % 3 == 2) ? n : sem_plain(n); return gq[k] * Wq[(size_t)k * 768 + s]; }
        if (k < 256) return 0.f; const int s = sem_plain(n - 768); return gkv[k - 256] * Wkv[(size_t)(k - 256) * 1024 + s]; } };
struct MapPlain { const float* W; int ldw; __device__ __forceinline__ float load(int k, int n) const { return W[(size_t)k * ldw + sem_plain(n)]; }
    __device__ __forceinline__ f32x4 load4(int k, int n) const { return *(const f32x4*)(W + (size_t)k * ldw + sem_plain(n)); } };
struct MapNat { const float* W; int ldw; __device__ __forceinline__ float load(int k, int n) const { return W[(size_t)k * ldw + n]; }
    __device__ __forceinline__ f32x4 load4(int k, int n) const { return *(const f32x4*)(W + (size_t)k * ldw + n); } };
struct MapBr { const float* W;
    __device__ __forceinline__ float load(int k, int n) const { return W[(size_t)k * DM + sem_plain(n)]; }
    __device__ __forceinline__ f32x4 load4(int k, int n) const { return *(const f32x4*)(W + (size_t)k * DM + sem_plain(n)); } };
struct MapMemkv { const float* W; __device__ __forceinline__ float load(int k, int n) const { const int l = n >> 10, c = n & 1023; return W[((size_t)l * DM + k) * 1024 + sem_plain(c)]; }
    __device__ __forceinline__ f32x4 load4(int k, int n) const { const int l = n >> 10, c = n & 1023; return *(const f32x4*)(W + ((size_t)l * DM + k) * 1024 + sem_plain(c)); } };
struct MapGU { const float *Wg, *Wu; __device__ __forceinline__ float load(int k, int n) const { const int pn = n >> 8, c = n & 255; const int ch = 128 * pn + sem_plain(c & 127);
    const unsigned long long a = (unsigned long long)Wg, b = (unsigned long long)Wu, w = a ^ ((a ^ b) & (0ull - (unsigned long long)(c >> 7))); return ((const float*)w)[(size_t)k * DFF + ch]; }
    __device__ __forceinline__ f32x4 load4(int k, int n) const { const int pn = n >> 8, c = n & 255; const int ch = 128 * pn + sem_plain(c & 127);
        const unsigned long long a = (unsigned long long)Wg, b = (unsigned long long)Wu, w = a ^ ((a ^ b) & (0ull - (unsigned long long)(c >> 7))); return *(const f32x4*)((const float*)w + (size_t)k * DFF + ch); } };

template <class M> __device__ __forceinline__ void prep_item(const M& m, bf16_t* dst, int Kd, int nblk, LAS float* scr, int item, int lane) {
    const int kb = item / nblk, nb = item % nblk, k0 = 64 * kb, n0 = 32 * nb;
#pragma unroll 8
    for (int i = 0; i < 32; ++i) { const int kk = 2 * i + (lane >> 5); scr[kk * 33 + (lane & 31)] = m.load(k0 + kk, n0 + (lane & 31)); }
    LDS_WAIT(); asm volatile("" ::: "memory");
    const int c = lane & 7;
#pragma unroll
    for (int j = 0; j < 4; ++j) { const int n = (lane >> 3) + 8 * j; const LAS float* s = scr + (8 * c) * 33 + n;
        u32x4 o; o.x = pk2(s[0 * 33], s[1 * 33]); o.y = pk2(s[2 * 33], s[3 * 33]); o.z = pk2(s[4 * 33], s[5 * 33]); o.w = pk2(s[6 * 33], s[7 * 33]);
        *(u32x4*)(dst + (size_t)(n0 + n) * Kd + k0 + 8 * c) = o; }
    LDS_WAIT(); asm volatile("" ::: "memory");
}
template <class M> __device__ __forceinline__ void prep_tile(const M& m, bf16_t* dst, int Kd, int nblk, LAS unsigned char* tile, int item, int lane) {
    const int kb = item / nblk, nb = item % nblk, k0 = 128 * kb, n0 = 32 * nb, ng = lane & 7, kr = lane >> 3;
    f32x4 v[16];
#pragma unroll
    for (int i = 0; i < 16; ++i) v[i] = m.load4(k0 + 8 * i + kr, n0 + 4 * ng);
#pragma unroll
    for (int i = 0; i < 16; ++i)
#pragma unroll
        for (int c = 0; c < 4; ++c) *(LAS unsigned short*)(tile + (4 * ng + c) * 272 + (8 * i + kr) * 2) = (unsigned short)f2bf(v[i][c]);
    LDS_WAIT(); asm volatile("" ::: "memory");
#pragma unroll
    for (int j = 0; j < 8; ++j) { const int p = lane + 64 * j, n = p >> 4, kc = p & 15;
        *(u32x4*)(dst + (size_t)(n0 + n) * Kd + k0 + 8 * kc) = *(const LAS u32x4*)(tile + n * 272 + 16 * kc); }
    LDS_WAIT(); asm volatile("" ::: "memory");
}
template <class M> __device__ __forceinline__ void prep_matrix(Frame& F, const M& m, bf16_t* dst, int N, int K) {
    LAS unsigned char* tile = F.lds + F.wave * 16384;
    const int gw = F.vcu * NWAVES + F.wave, NGW = F.G * NWAVES, nblk = N / 32, nitems = (K / 128) * nblk;
    for (int it = gw; it < nitems; it += NGW) prep_tile(m, dst, K, nblk, tile, it, F.lane);
}

template <class M> __device__ __forceinline__ void prep_strip_i8(Frame& F, const M& m, signed char* dst, float* scl, int strip) {
    const int lane = F.lane, w = F.wave, n0 = strip * 32, k0 = w * 128, ng = lane & 7, kr = lane >> 3;
    LAS unsigned char* tile = F.lds + w * 16384;
    LAS float* amt = (LAS float*)(F.lds + LDSCTL_OFF + 2048);
    f32x4 v[16];
#pragma unroll
    for (int i = 0; i < 16; ++i) v[i] = m.load4(k0 + 8 * i + kr, n0 + 4 * ng);
    f32x4 am = __builtin_elementwise_abs(v[0]);
#pragma unroll
    for (int i = 1; i < 16; ++i) am = __builtin_elementwise_max(am, __builtin_elementwise_abs(v[i]));
#pragma unroll
    for (int c = 0; c < 4; ++c) { float a = am[c]; a = fmaxf(a, __shfl_xor(a, 8)); a = fmaxf(a, __shfl_xor(a, 16)); a = fmaxf(a, __shfl_xor(a, 32)); am[c] = a; }
    if (kr == 0) *(LAS f32x4*)(amt + w * 32 + 4 * ng) = am;
    __syncthreads();
    f32x4 cm = *(const LAS f32x4*)(amt + 4 * ng);
#pragma unroll
    for (int ww = 1; ww < 8; ++ww) cm = __builtin_elementwise_max(cm, *(const LAS f32x4*)(amt + ww * 32 + 4 * ng));
    f32x4 inv;
#pragma unroll
    for (int c = 0; c < 4; ++c) inv[c] = cm[c] > 0.f ? 127.0f / cm[c] : 0.f;
    if (w == 0 && kr == 0) *(f32x4*)(scl + n0 + 4 * ng) = cm * (1.0f / 127.0f);
#pragma unroll
    for (int i = 0; i < 16; ++i)
#pragma unroll
        for (int c = 0; c < 4; ++c) tile[(4 * ng + c) * 144 + 8 * i + kr] = (unsigned char)(signed char)__float2int_rn(v[i][c] * inv[c]);
    LDS_WAIT(); asm volatile("" ::: "memory");
#pragma unroll
    for (int j = 0; j < 4; ++j) { const int p = lane + 64 * j, n = p >> 3, kc = p & 7;
        *(u32x4*)(dst + (size_t)(n0 + n) * DM + k0 + 16 * kc) = *(const LAS u32x4*)(tile + n * 144 + 16 * kc); }
    LDS_WAIT();
    __syncthreads();
}
__device__ __forceinline__ bf16_t* wmix(Frame& F, int l, size_t off) { return (bf16_t*)(F.ws + WS_WMIX + (size_t)l * WL_STRIDE + off); }

__device__ __forceinline__ void prep_mixer_weights(Frame& F) {
    for (int l = 0; l < DEPTH; ++l) {
        { MapInproj m{F.in[I_WIN] + (size_t)l * DM * INW}; for (int s = F.vcu; s < NT_IN * 8; s += F.G) prep_strip_i8(F, m, (signed char*)wmix(F, l, WL_IN), (float*)(F.ws + WS_MISC + MS_WSIN) + l * NT_IN * 256, s); }
        { MapUp m{F.in[I_WUQ] + (size_t)l * 256 * 768, F.in[I_WUKV] + (size_t)l * 128 * 1024, F.in[I_GQ] + l * 256, F.in[I_GKV] + l * 128}; prep_matrix(F, m, wmix(F, l, WL_UP), UPN, UPK); }
        { MapBr m{F.in[I_WBR] + (size_t)l * 3 * 512 * DM}; prep_matrix(F, m, wmix(F, l, WL_BR), DM, 1536); }
        { MapNat m{F.in[I_WOUT] + (size_t)l * DM * DM, DM}; prep_matrix(F, m, wmix(F, l, WL_OUT), DM, DM); }
    }
    { MapMemkv m{F.in[I_WMKV]}; prep_matrix(F, m, (bf16_t*)(F.ws + WS_WMKV), 4096, DM); }
}
__device__ __forceinline__ void prep_ffn_weights(Frame& F, int l) {
    const int i = l >> 1; const bool moe = (l & 1) != 0;
    LAS float* scr = (LAS float*)(F.lds + F.wave * 16384);
    const int gw = F.vcu * NWAVES + F.wave, NGW = F.G * NWAVES;
    constexpr int IGU = (DM / 64) * (2 * DFF / 32), ID = (DFF / 64) * (DM / 32), NSTRIP = 2 * DFF / 32;
    const int ne = moe ? NE : 1;
    const float* Wg = moe ? F.in[I_WGE] : F.in[I_WGD]; const float* Wu = moe ? F.in[I_WUE] : F.in[I_WUD]; const float* Wd = moe ? F.in[I_WDE] : F.in[I_WDD];
    if (GU_I8(l)) {
        for (int s = F.vcu; s < ne * NSTRIP; s += F.G) { const int e = s / NSTRIP, ss = s % NSTRIP; const size_t eo = ((size_t)i * ne + e) * DM * DFF;
            MapGU m{Wg + eo, Wu + eo}; prep_strip_i8(F, m, (signed char*)(F.ws + WS_WFFN + (size_t)e * WF_STRIDE), (float*)(F.ws + WS_MISC + MS_WSGU) + e * 2 * DFF, ss); }
    } else {
        for (int it = gw; it < ne * IGU; it += NGW) { const int e = it / IGU, r = it % IGU; const size_t eo = ((size_t)i * ne + e) * DM * DFF;
            MapGU m{Wg + eo, Wu + eo}; prep_item(m, (bf16_t*)(F.ws + WS_WFFN + (size_t)e * WF_STRIDE), DM, 2 * DFF / 32, scr, r, F.lane); }
    }
    constexpr int IDT = (DFF / 128) * (DM / 32);
    for (int it = gw; it < ne * IDT; it += NGW) { const int e = it / IDT, r = it % IDT; const size_t eo = ((size_t)i * ne + e) * DM * DFF;
        MapNat m{Wd + eo, DM}; prep_tile(m, (bf16_t*)(F.ws + WS_WFFN + (size_t)e * WF_STRIDE + WF_D), DFF, DM / 32, F.lds + F.wave * 16384, r, F.lane); }
}

struct RowV { f32x4 v[4]; };
__device__ __forceinline__ void row_load(RowV& r, const float* p, int lane) { const f32x4* x = (const f32x4*)p + lane;
#pragma unroll
    for (int j = 0; j < 4; ++j) r.v[j] = x[64 * j]; }
__device__ __forceinline__ void row_store(const RowV& r, float* p, int lane) { f32x4* x = (f32x4*)p + lane;
#pragma unroll
    for (int j = 0; j < 4; ++j) x[64 * j] = r.v[j]; }
__device__ __forceinline__ void row_add_bf16(RowV& r, const bf16_t* p, float w, int lane) { const u32x2* x = (const u32x2*)p + lane;
#pragma unroll
    for (int j = 0; j < 4; ++j) { const u32x2 q = x[64 * j]; r.v[j].x += w * bflo(q.x); r.v[j].y += w * bfhi(q.x); r.v[j].z += w * bflo(q.y); r.v[j].w += w * bfhi(q.y); } }
__device__ __forceinline__ float row_rstd(const RowV& r) { float s = 0.f;
#pragma unroll
    for (int j = 0; j < 4; ++j) s += (r.v[j].x * r.v[j].x + r.v[j].y * r.v[j].y) + (r.v[j].z * r.v[j].z + r.v[j].w * r.v[j].w);
    return 1.0f / sqrtf(wave_sum(s) * (1.0f / DM) + EPS); }
__device__ __forceinline__ void row_scale(RowV& r, float rstd, const float* g, int lane) { const f32x4* gg = (const f32x4*)g + lane;
#pragma unroll
    for (int j = 0; j < 4; ++j) r.v[j] = r.v[j] * rstd * gg[64 * j]; }
__device__ __forceinline__ void row_store_bf16(const RowV& r, bf16_t* p, int lane) { u32x2* o = (u32x2*)p + lane;
#pragma unroll
    for (int j = 0; j < 4; ++j) { u32x2 w; w.x = pk2(r.v[j].x, r.v[j].y); w.y = pk2(r.v[j].z, r.v[j].w); o[64 * j] = w; } }

__device__ __forceinline__ float row_store_i8(const RowV& r, signed char* p, int lane) {
    float am = 0.f;
#pragma unroll
    for (int j = 0; j < 4; ++j) am = fmaxf(am, fmaxf(fmaxf(fabsf(r.v[j].x), fabsf(r.v[j].y)), fmaxf(fabsf(r.v[j].z), fabsf(r.v[j].w))));
#pragma unroll
    for (int o = 1; o < 64; o <<= 1) am = fmaxf(am, __shfl_xor(am, o));
    const float inv = am > 0.f ? 127.0f / am : 0.f; unsigned* o4 = (unsigned*)p + lane;
#pragma unroll
    for (int j = 0; j < 4; ++j) { const unsigned a = (unsigned)__float2int_rn(r.v[j].x * inv) & 255u, b = (unsigned)__float2int_rn(r.v[j].y * inv) & 255u, c = (unsigned)__float2int_rn(r.v[j].z * inv) & 255u, d = (unsigned)__float2int_rn(r.v[j].w * inv) & 255u;
        o4[64 * j] = a | (b << 8) | (c << 16) | (d << 24); }
    return am * (1.0f / 127.0f);
}
__device__ __forceinline__ void row_combine(Frame& F, RowV& r, int t) {
    const int* sl = (const int*)(F.ws + WS_MISC + MS_SLOT) + 2 * t; const float* tw = (const float*)(F.ws + WS_MISC + MS_TOKW) + 2 * t;
    const bf16_t* Y = (const bf16_t*)(F.ws + WS_R + R_YOUT);
    const int s0 = sl[0], s1 = sl[1]; const float w0 = tw[0], w1 = tw[1];
    row_add_bf16(r, Y + (size_t)s0 * DM, w0, F.lane); row_add_bf16(r, Y + (size_t)s1 * DM, w1, F.lane);
}

__device__ __forceinline__ void norm_phase(Frame& F, const float* src, float* X, const float* g, bool combine, bool out_i8) {
    bf16_t* H = (bf16_t*)(F.ws + WS_H); signed char* Hq = (signed char*)(F.ws + WS_H); float* hsc = (float*)(F.ws + WS_MISC + MS_HSC);
    const int gw = F.vcu * NWAVES + F.wave, NGW = F.G * NWAVES;
    for (int t = gw; t < T; t += 2 * NGW) {
        const int t2 = t + NGW;
        RowV r, q; row_load(r, src + (size_t)t * DM, F.lane); row_load(q, src + (size_t)t2 * DM, F.lane);
        if (combine) { row_combine(F, r, t); row_combine(F, q, t2); row_store(r, X + (size_t)t * DM, F.lane); row_store(q, X + (size_t)t2 * DM, F.lane); }
        const float rstd = row_rstd(r), qstd = row_rstd(q); row_scale(r, rstd, g, F.lane); row_scale(q, qstd, g, F.lane);
        if (out_i8) { const float sc = row_store_i8(r, Hq + (size_t)t * DM, F.lane), sq = row_store_i8(q, Hq + (size_t)t2 * DM, F.lane); if (F.lane == 0) { hsc[t] = sc; hsc[t2] = sq; } }
        else { row_store_bf16(r, H + (size_t)t * DM, F.lane); row_store_bf16(q, H + (size_t)t2 * DM, F.lane); }
    }
}
__device__ __forceinline__ void final_norm_phase(Frame& F, float* X, const float* g, bool combine) {
    const int gw = F.vcu * NWAVES + F.wave, NGW = F.G * NWAVES;
    for (int t = gw; t < T; t += 2 * NGW) {
        const int t2 = t + NGW;
        RowV r, q; row_load(r, X + (size_t)t * DM, F.lane); row_load(q, X + (size_t)t2 * DM, F.lane);
        if (combine) { row_combine(F, r, t); row_combine(F, q, t2); }
        const float rstd = row_rstd(r), qstd = row_rstd(q); row_scale(r, rstd, g, F.lane); row_scale(q, qstd, g, F.lane);
        row_store(r, X + (size_t)t * DM, F.lane); row_store(q, X + (size_t)t2 * DM, F.lane);
    }
}
__device__ __forceinline__ void memnorm_phase(Frame& F) {
    bf16_t* MN = (bf16_t*)(F.ws + WS_MEMN);
    const int gw = F.vcu * NWAVES + F.wave, NGW = F.G * NWAVES;
    for (int t = gw; t < NB * MEML; t += NGW) {
        RowV r; row_load(r, F.in[I_MEM] + (size_t)t * DM, F.lane);
        const float rstd = row_rstd(r); row_scale(r, rstd, F.in[I_GMEM], F.lane);
        row_store_bf16(r, MN + (size_t)t * DM, F.lane);
    }
}

__device__ __forceinline__ void norm_router_phase(Frame& F, const float* X, const float* g, const float* Wr  , bool out_i8) {
    bf16_t* H = (bf16_t*)(F.ws + WS_H); signed char* Hq = (signed char*)(F.ws + WS_H); float* hsc = (float*)(F.ws + WS_MISC + MS_HSC);
    int* toke = (int*)(F.ws + WS_MISC + MS_TOKE); float* tokw = (float*)(F.ws + WS_MISC + MS_TOKW); int* cntg = (int*)(F.ws + WS_MISC + MS_CNT);
    volatile LAS int* hist = (volatile LAS int*)(F.lds + LDSCTL_OFF + 1024);
    for (int c = F.vcu; c < T / 128; c += F.G) {
        if (F.tid < 8) hist[F.tid] = 0;
        __syncthreads();
        for (int q = 0; q < 16; ++q) {
            const int t = c * 128 + F.wave * 16 + q;
            RowV r; row_load(r, X + (size_t)t * DM, F.lane);
            const float rstd = row_rstd(r); row_scale(r, rstd, g, F.lane);
            if (out_i8) { const float sc = row_store_i8(r, Hq + (size_t)t * DM, F.lane); if (F.lane == 0) hsc[t] = sc; }
            else row_store_bf16(r, H + (size_t)t * DM, F.lane);
            float lg[8];
#pragma unroll
            for (int e = 0; e < 8; ++e) lg[e] = 0.f;
#pragma unroll
            for (int j = 0; j < 4; ++j) {
#pragma unroll
                for (int k = 0; k < 4; ++k) { const int d = 256 * j + 4 * F.lane + k; const f32x4 wa = *(const f32x4*)(Wr + (size_t)d * 8), wb = *(const f32x4*)(Wr + (size_t)d * 8 + 4); const float x = r.v[j][k];
                    lg[0] += x * wa.x; lg[1] += x * wa.y; lg[2] += x * wa.z; lg[3] += x * wa.w; lg[4] += x * wb.x; lg[5] += x * wb.y; lg[6] += x * wb.z; lg[7] += x * wb.w; } }
#pragma unroll
            for (int e = 0; e < 8; ++e) lg[e] = wave_sum(lg[e]);
            int e0 = 0; float v0 = lg[0];
#pragma unroll
            for (int e = 1; e < 8; ++e) if (lg[e] > v0) { v0 = lg[e]; e0 = e; }
            int e1 = -1; float v1 = -INFINITY;
#pragma unroll
            for (int e = 0; e < 8; ++e) if (e != e0 && lg[e] > v1) { v1 = lg[e]; e1 = e; }
            if (F.lane == 0) {
                const float w0 = 1.0f / (1.0f + __expf(v1 - v0));
                toke[2 * t] = e0; toke[2 * t + 1] = e1; tokw[2 * t] = w0; tokw[2 * t + 1] = 1.0f - w0;
                __hip_atomic_fetch_add((LAS int*)&hist[e0], 1, __ATOMIC_RELAXED, __HIP_MEMORY_SCOPE_WORKGROUP); __hip_atomic_fetch_add((LAS int*)&hist[e1], 1, __ATOMIC_RELAXED, __HIP_MEMORY_SCOPE_WORKGROUP);
            }
        }
        __syncthreads();
        if (F.tid < 8) cntg[c * 8 + F.tid] = hist[F.tid];
        __syncthreads();
    }
}
__device__ __forceinline__ void moe_assign_phase(Frame& F, bool i8) {
    const bf16_t* H = (const bf16_t*)(F.ws + WS_H); bf16_t* AS = (bf16_t*)(F.ws + WS_R + R_ASORT);
    const float* hsc = (const float*)(F.ws + WS_MISC + MS_HSC); float* asc = (float*)(F.ws + WS_MISC + MS_ASC);
    const int* toke = (const int*)(F.ws + WS_MISC + MS_TOKE); int* slot = (int*)(F.ws + WS_MISC + MS_SLOT); const int* cntg = (const int*)(F.ws + WS_MISC + MS_CNT);
    int* texp = (int*)(F.ws + WS_MISC + MS_TEXP);
    volatile LAS int* tot = (volatile LAS int*)(F.lds + LDSCTL_OFF + 1024);
    volatile LAS int* pre = tot + 8;
    volatile LAS int* wcnt = tot + 16;
    for (int c = F.vcu; c < T / 128; c += F.G) {
        if (F.tid < 16) tot[F.tid] = 0;
        __syncthreads();
        { const int cc = F.tid >> 1, h = F.tid & 1; const i32x4 v = *(const i32x4*)(cntg + cc * 8 + 4 * h);
#pragma unroll
          for (int k = 0; k < 4; ++k) { __hip_atomic_fetch_add((LAS int*)&tot[4 * h + k], v[k], __ATOMIC_RELAXED, __HIP_MEMORY_SCOPE_WORKGROUP); if (cc < c) __hip_atomic_fetch_add((LAS int*)&pre[4 * h + k], v[k], __ATOMIC_RELAXED, __HIP_MEMORY_SCOPE_WORKGROUP); } }
        const int t = c * 128 + F.wave * 16 + ((F.lane & 31) >> 1);
        const int my_e = (F.lane < 32) ? toke[2 * t + (F.lane & 1)] : -1;
        int rank = 0;
#pragma unroll
        for (int e = 0; e < 8; ++e) { const unsigned long long m = __ballot(my_e == e); if (my_e == e) rank = __popcll(m & ((1ull << F.lane) - 1ull)); if (F.lane == 0) wcnt[F.wave * 8 + e] = __popcll(m); }
        __syncthreads();
        int myslot = 0;
        if (F.lane < 32) {
            int ts = 0;
#pragma unroll
            for (int e = 0; e < 8; ++e) ts += (e < my_e) ? ((tot[e] + 255) >> 8) : 0;
            int wp = 0; for (int w = 0; w < F.wave; ++w) wp += wcnt[w * 8 + my_e];
            myslot = ts * 256 + pre[my_e] + wp + rank;
            slot[2 * t + (F.lane & 1)] = myslot;
        }
        if (c == 0 && F.tid == 0) { int ts = 0; for (int e = 0; e < 8; ++e) { const int n = (tot[e] + 255) >> 8; for (int k = 0; k < n; ++k) texp[ts + k] = e; ts += n; } for (int k = ts; k < MAXRT; ++k) texp[k] = 0; texp[MAXRT] = ts; }
        if (i8) {
            const float myh = hsc[t];
#pragma unroll 1
            for (int a0 = 0; a0 < 32; a0 += 8) {
                u32x4 x[4];
#pragma unroll
                for (int k = 0; k < 4; ++k) x[k] = *((const u32x4*)((const signed char*)H + (size_t)(c * 128 + F.wave * 16 + ((a0 + 2 * k) >> 1)) * DM) + F.lane);
#pragma unroll
                for (int k = 0; k < 8; ++k) { const int s = __builtin_amdgcn_readlane(myslot, a0 + k); *((u32x4*)((signed char*)AS + (size_t)s * DM) + F.lane) = x[k >> 1]; }
            }
            if (F.lane < 32) asc[myslot] = myh;
        } else {
            for (int a = 0; a < 32; ++a) {
                const int s = __builtin_amdgcn_readlane(myslot, a); const int ta = c * 128 + F.wave * 16 + (a >> 1);
                const u32x4* srcp = (const u32x4*)(H + (size_t)ta * DM) + F.lane; u32x4* dstp = (u32x4*)(AS + (size_t)s * DM) + F.lane;
                const u32x4 x0 = srcp[0], x1 = srcp[64]; dstp[0] = x0; dstp[64] = x1; }
        }
        __syncthreads();
    }
}

using pg8::Unit;
typedef f32x4 AccT[2][2][4][2];

struct ProbSimple { int K; unsigned lda, ldb; const char* A; const char* B;
    __device__ __forceinline__ const char* a_ptr(const Unit& u) const { return A + (size_t)u.pm * 256 * lda; }
    __device__ __forceinline__ const char* b_ptr(const Unit& u) const { return B + (size_t)u.pn * 256 * ldb; } };
struct ProbBranch { int K; unsigned lda, ldb; const char* A; const char* B;
    __device__ __forceinline__ const char* a_ptr(const Unit& u) const { return A + (size_t)u.pm * 256 * lda + (size_t)u.aux * 1024; }
    __device__ __forceinline__ const char* b_ptr(const Unit& u) const { return B + (size_t)u.aux * ((size_t)DM * 512 * 2) + (size_t)u.pn * 256 * ldb; } };
struct ProbMoe { int K; unsigned lda, ldb; const char* A; const char* B; int a_lo;
    __device__ __forceinline__ const char* a_ptr(const Unit& u) const { return A + (size_t)(u.pm - a_lo) * 256 * lda; }
    __device__ __forceinline__ const char* b_ptr(const Unit& u) const { return B + (size_t)u.aux * WF_STRIDE + (size_t)u.pn * 256 * ldb; } };

struct SegOrder { pg8::StaticOrder base;
    __device__ bool next(int i, Unit& u) const { if (!base.next(i / 3, u)) return false; u.aux = i % 3; return true; } };
struct MoeRowOrder { pg8::RowOrder base; const int* texp;
    __device__ bool next(int i, Unit& u) const { if (!base.next(i, u)) return false; u.aux = texp[u.pm]; return true; } };
struct MoeOrder { pg8::StaticOrder base; int lo; const int* texp;
    __device__ bool next(int i, Unit& u) const { if (!base.next(i, u)) return false; u.pm += lo; u.aux = texp[u.pm]; return true; } };

__device__ __forceinline__ u32x4 pack8(const f32x4 a, const f32x4 b) { u32x4 w; w.x = cvtpk(a[0], a[1]); w.y = cvtpk(a[2], a[3]); w.z = cvtpk(b[0], b[1]); w.w = cvtpk(b[2], b[3]); return w; }
__device__ __forceinline__ u32x2 pack4(const f32x4 a) { u32x2 w; w.x = cvtpk(a[0], a[1]); w.y = cvtpk(a[2], a[3]); return w; }

struct EpiNoStage { __device__ __forceinline__ void stage(LAS unsigned char*, const Unit&, int, int) const {} };
__device__ __forceinline__ void stage1k(const void* src, LAS unsigned char* dst, int lane) { __builtin_amdgcn_global_load_lds((const unsigned*)((const char*)src + lane * 16), (LAS unsigned*)dst, 16, 0, 0); }
__device__ __forceinline__ f32x4 deq(const f32x4& a, float, const f32x4&) { return a; }
__device__ __forceinline__ f32x4 deq(const i32x4& a, float rs, const f32x4& cs) { return __builtin_convertvector(a, f32x4) * rs * cs; }
struct EpiInproj {
    static constexpr bool MID = false;
    bf16_t* P; bf16_t* G; float* ssq; const int* pos; const float* rsc; const float* csc;
    __device__ __forceinline__ void stage(LAS unsigned char* d, const Unit& u, int wid, int lane) const {
        if (wid == 0) { stage1k(rsc + u.pm * 256, d, lane); stage1k(csc + u.pn * 256, d + 1024, lane); stage1k(pos + u.pm * 256, d + 2048, lane); } }
    template <class AV> __device__ __forceinline__ void operator()(const AV (&acc)[2][2][4][2], const Unit& u, int wr, int wc, int fr, int fq, const LAS unsigned char* esc) const {
        const int pn = u.pn, row0 = u.pm * 256 + wr * 64 + fr;
        f32x4 cs[2][2];
#pragma unroll
        for (int bj = 0; bj < 2; ++bj)
#pragma unroll
            for (int n = 0; n < 2; ++n) cs[bj][n] = *(const LAS f32x4*)(esc + 1024 + (bj * 128 + wc * 32 + n * 16 + fq * 4) * 4);
        float rs8[2][4], pf8[2][4];
#pragma unroll
        for (int ai = 0; ai < 2; ++ai)
#pragma unroll
            for (int m = 0; m < 4; ++m) { const int rl = ai * 128 + wr * 64 + m * 16 + fr; rs8[ai][m] = *(const LAS float*)(esc + rl * 4); pf8[ai][m] = (float)*(const LAS int*)(esc + 2048 + rl * 4); }
#define DQ(ai, bj, m, n) deq(acc[ai][bj][m][n], rs, cs[bj][n])
        if (pn >= 7) {
#pragma unroll
            for (int ai = 0; ai < 2; ++ai)
#pragma unroll
                for (int m = 0; m < 4; ++m) { const int row = row0 + ai * 128 + m * 16; const float rs = rs8[ai][m];
#pragma unroll
                    for (int bj = 0; bj < 2; ++bj) { f32x4 a = DQ(ai, bj, m, 0), b = DQ(ai, bj, m, 1);
#pragma unroll
                        for (int j = 0; j < 4; ++j) { a[j] = fast_sigmoid(a[j]) * 255.0f; b[j] = fast_sigmoid(b[j]) * 255.0f; }
                        u32x2 w; w.x = (unsigned)__float2int_rn(a[0]) | ((unsigned)__float2int_rn(a[1]) << 8) | ((unsigned)__float2int_rn(a[2]) << 16) | ((unsigned)__float2int_rn(a[3]) << 24);
                        w.y = (unsigned)__float2int_rn(b[0]) | ((unsigned)__float2int_rn(b[1]) << 8) | ((unsigned)__float2int_rn(b[2]) << 16) | ((unsigned)__float2int_rn(b[3]) << 24);
                        *(u32x2*)((unsigned char*)G + (size_t)row * GW + (pn - 7) * 256 + bj * 128 + wc * 32 + fq * 8) = w; } }
        } else if (pn >= 5 || pn == 3) {
            const float sc = (pn == 3) ? 1.0f : C_M;
#pragma unroll
            for (int ai = 0; ai < 2; ++ai)
#pragma unroll
                for (int m = 0; m < 4; ++m) { const int row = row0 + ai * 128 + m * 16; const float rs = rs8[ai][m]; float s = 0.f;
#pragma unroll
                    for (int bj = 0; bj < 2; ++bj) { const f32x4 a = DQ(ai, bj, m, 0) * sc, b = DQ(ai, bj, m, 1) * sc;
                        s += (a[0] * a[0] + a[1] * a[1]) + (a[2] * a[2] + a[3] * a[3]) + (b[0] * b[0] + b[1] * b[1]) + (b[2] * b[2] + b[3] * b[3]);
                        *(u32x4*)(P + (size_t)row * PW + pn * 256 + bj * 128 + wc * 32 + fq * 8) = pack8(a, b); }
                    if (pn == 3) { s += __shfl_xor(s, 16); s += __shfl_xor(s, 32); if (fq == 0) ssq[(size_t)row * 8 + wc] = s; } }
        } else if (pn == 4) {
#pragma unroll
            for (int ai = 0; ai < 2; ++ai)
#pragma unroll
                for (int m = 0; m < 4; ++m) { const int row = row0 + ai * 128 + m * 16; const float rs = rs8[ai][m];
                    { const f32x4 a = DQ(ai, 0, m, 0), b = DQ(ai, 0, m, 1);
                      float s = (a[0] * a[0] + a[1] * a[1]) + (a[2] * a[2] + a[3] * a[3]) + (b[0] * b[0] + b[1] * b[1]) + (b[2] * b[2] + b[3] * b[3]);
                      *(u32x4*)(P + (size_t)row * PW + P_CKV + wc * 32 + fq * 8) = pack8(a, b);
                      s += __shfl_xor(s, 16); s += __shfl_xor(s, 32); if (fq == 0) ssq[(size_t)row * 8 + 4 + wc] = s; }
                    if (wc == 0) { const f32x4 x1 = DQ(ai, 1, m, 0), x2 = DQ(ai, 1, m, 1); const float pf = pf8[ai][m]; f32x4 o1, o2;
#pragma unroll
                        for (int j = 0; j < 4; ++j) { float c, s; rot_cs(pf, 2 * (4 * fq + j), c, s); o1[j] = x1[j] * c - x2[j] * s; o2[j] = x2[j] * c + x1[j] * s; }
                        *(u32x2*)(P + (size_t)row * PW + P_KR + 4 * fq) = pack4(o1); *(u32x2*)(P + (size_t)row * PW + P_KR + 16 + 4 * fq) = pack4(o2); } }
        } else {
            const float sc = (pn < 2) ? C_A : 1.0f; const int i0 = 16 * (wc & 1) + 4 * fq;
#pragma unroll
            for (int ai = 0; ai < 2; ++ai)
#pragma unroll
                for (int m = 0; m < 4; ++m) { const int row = row0 + ai * 128 + m * 16; const float rs = rs8[ai][m]; const float pf = pf8[ai][m]; f32x4 c, s;
#pragma unroll
                    for (int j = 0; j < 4; ++j) { float cc, ss; rot_cs(pf, i0 + j, cc, ss); c[j] = cc * sc; s[j] = ss * sc; }
#pragma unroll
                    for (int bj = 0; bj < 2; ++bj) { const f32x4 x1 = DQ(ai, bj, m, 0), x2 = DQ(ai, bj, m, 1);
                        if (pn == 2 && bj == 1) { *(u32x4*)(P + (size_t)row * PW + P_VA + wc * 32 + fq * 8) = pack8(x1, x2); }
                        else { const f32x4 o1 = x1 * c - x2 * s, o2 = x2 * c + x1 * s; bf16_t* d = P + (size_t)row * PW + pn * 256 + 64 * (2 * bj + (wc >> 1)) + i0;
                            *(u32x2*)d = pack4(o1); *(u32x2*)(d + 32) = pack4(o2); } } }
        }
#undef DQ
    }
};
struct EpiUp {
    static constexpr bool MID = false;
    __device__ __forceinline__ void stage(LAS unsigned char*, const Unit&, int, int) const {}
    bf16_t* QB; bf16_t* KVB; const float* ssq; const int* pos;
    __device__ __forceinline__ void operator()(const AccT& acc, const Unit& u, int wr, int wc, int fr, int fq, const LAS unsigned char*) const {
        const int pn = u.pn, row0 = u.pm * 256 + wr * 64 + fr;
        float rs8[2][4], pf8[2][4];
#pragma unroll
        for (int ai = 0; ai < 2; ++ai)
#pragma unroll
            for (int m = 0; m < 4; ++m) { const int row = row0 + ai * 128 + m * 16; const f32x4 sv = *(const f32x4*)(ssq + (size_t)row * 8 + (pn < 3 ? 0 : 4));
                rs8[ai][m] = (pn < 3 ? C_B : 1.0f) / sqrtf(((sv[0] + sv[1]) + (sv[2] + sv[3])) * (pn < 3 ? 1.0f / 256.0f : 1.0f / 128.0f) + EPS); pf8[ai][m] = (pn < 3) ? (float)pos[row] : 0.f; }
#pragma unroll
        for (int ai = 0; ai < 2; ++ai)
#pragma unroll
            for (int m = 0; m < 4; ++m) { const int row = row0 + ai * 128 + m * 16; const float rs = rs8[ai][m];
                if (pn < 3) {
#pragma unroll
                    for (int bj = 0; bj < 2; ++bj) { const int gg = 8 * pn + 4 * bj + wc; const f32x4 x1 = acc[ai][bj][m][0] * rs, x2 = acc[ai][bj][m][1] * rs;
                        if (gg % 3 == 2) { const float pf = pf8[ai][m]; f32x4 o1, o2;
#pragma unroll
                            for (int j = 0; j < 4; ++j) { float c, s; rot_cs(pf, 2 * (4 * fq + j), c, s); o1[j] = x1[j] * c - x2[j] * s; o2[j] = x2[j] * c + x1[j] * s; }
                            bf16_t* d = QB + (size_t)row * QBW + 32 * gg + 4 * fq; *(u32x2*)d = pack4(o1); *(u32x2*)(d + 16) = pack4(o2); }
                        else *(u32x4*)(QB + (size_t)row * QBW + 32 * gg + 8 * fq) = pack8(x1, x2); }
                } else {
#pragma unroll
                    for (int bj = 0; bj < 2; ++bj) *(u32x4*)(KVB + (size_t)row * KVW + (pn - 3) * 256 + bj * 128 + wc * 32 + fq * 8) = pack8(acc[ai][bj][m][0] * rs, acc[ai][bj][m][1] * rs);
                } }
    }
};
struct EpiPlain {
    static constexpr bool MID = false;
    __device__ __forceinline__ void stage(LAS unsigned char*, const Unit&, int, int) const {}
    bf16_t* O; int ldo;
    __device__ __forceinline__ void operator()(const AccT& acc, const Unit& u, int wr, int wc, int fr, int fq, const LAS unsigned char*) const {
        const int row0 = u.pm * 256 + wr * 64 + fr;
#pragma unroll
        for (int ai = 0; ai < 2; ++ai)
#pragma unroll
            for (int m = 0; m < 4; ++m)
#pragma unroll
                for (int bj = 0; bj < 2; ++bj) *(u32x4*)(O + (size_t)(row0 + ai * 128 + m * 16) * ldo + u.pn * 256 + bj * 128 + wc * 32 + fq * 8) = pack8(acc[ai][bj][m][0], acc[ai][bj][m][1]);
    }
};
struct EpiBranch {
    static constexpr bool MID = true;
    const unsigned char* G; bf16_t* MIXED;
    __device__ __forceinline__ void stage(LAS unsigned char*, const Unit&, int, int) const {}
    static __device__ __forceinline__ float gq(unsigned w, int b) { const float f = (float)((w >> (8 * b)) & 255u); return fmaxf(f, 2.55e-4f); }
    __device__ __forceinline__ void mid(AccT& acc, const Unit& u, int seg  , int wr, int wc, int fr, int fq) const {
        const int row0 = opq_v(u.pm * 256 + wr * 64 + fr);
#pragma unroll
        for (int ai = 0; ai < 2; ++ai) {
            u32x2 ga[4][2], gb[4][2];
#pragma unroll
            for (int m = 0; m < 4; ++m)
#pragma unroll
                for (int bj = 0; bj < 2; ++bj) { const unsigned char* gp = G + (size_t)(row0 + ai * 128 + m * 16) * GW + u.pn * 256 + bj * 128 + wc * 32 + fq * 8;
                    ga[m][bj] = *(const u32x2*)(gp + (seg - 1) * 1024); gb[m][bj] = *(const u32x2*)(gp + seg * 1024); }
#pragma unroll
            for (int m = 0; m < 4; ++m)
#pragma unroll
                for (int bj = 0; bj < 2; ++bj) { const u32x2 a2 = ga[m][bj], b2 = gb[m][bj];
#pragma unroll
                    for (int j = 0; j < 4; ++j) { acc[ai][bj][m][0][j] *= gq(a2.x, j) * __builtin_amdgcn_rcpf(gq(b2.x, j)); acc[ai][bj][m][1][j] *= gq(a2.y, j) * __builtin_amdgcn_rcpf(gq(b2.y, j)); } }
            asm volatile("" ::: "memory"); }
    }
    __device__ __forceinline__ void operator()(const AccT& acc, const Unit& u, int wr, int wc, int fr, int fq, const LAS unsigned char*) const {
        const int row0 = u.pm * 256 + wr * 64 + fr;
#pragma unroll
        for (int ai = 0; ai < 2; ++ai) {
            u32x2 gw[4][2];
#pragma unroll
            for (int m = 0; m < 4; ++m)
#pragma unroll
                for (int bj = 0; bj < 2; ++bj) gw[m][bj] = *(const u32x2*)(G + (size_t)(row0 + ai * 128 + m * 16) * GW + 2048 + u.pn * 256 + bj * 128 + wc * 32 + fq * 8);
#pragma unroll
            for (int m = 0; m < 4; ++m)
#pragma unroll
                for (int bj = 0; bj < 2; ++bj) { const u32x2 g2 = gw[m][bj]; f32x4 a = acc[ai][bj][m][0], b = acc[ai][bj][m][1];
#pragma unroll
                    for (int j = 0; j < 4; ++j) { a[j] *= gq(g2.x, j) * (1.0f / 255.0f); b[j] *= gq(g2.y, j) * (1.0f / 255.0f); }
                    *(u32x4*)(MIXED + (size_t)(row0 + ai * 128 + m * 16) * DM + u.pn * 256 + bj * 128 + wc * 32 + fq * 8) = pack8(a, b); }
            asm volatile("" ::: "memory"); }
    }
};
struct EpiResid {
    static constexpr bool MID = false;
    __device__ __forceinline__ void stage(LAS unsigned char*, const Unit&, int, int) const {}
    const float* Xin; float* Xout;
    __device__ __forceinline__ void operator()(const AccT& acc, const Unit& u, int wr, int wc, int fr, int fq, const LAS unsigned char*) const {
        const int row0 = u.pm * 256 + wr * 64 + fr;
#pragma unroll
        for (int ai = 0; ai < 2; ++ai)
#pragma unroll
            for (int mp = 0; mp < 2; ++mp) {
                f32x4 xv[2][2][2];
#pragma unroll
                for (int mm = 0; mm < 2; ++mm)
#pragma unroll
                    for (int bj = 0; bj < 2; ++bj)
#pragma unroll
                        for (int n = 0; n < 2; ++n) xv[mm][bj][n] = *(const f32x4*)(Xin + (size_t)(row0 + ai * 128 + (2 * mp + mm) * 16) * DM + u.pn * 256 + bj * 128 + wc * 32 + n * 16 + fq * 4);
#pragma unroll
                for (int mm = 0; mm < 2; ++mm)
#pragma unroll
                    for (int bj = 0; bj < 2; ++bj)
#pragma unroll
                        for (int n = 0; n < 2; ++n) *(f32x4*)(Xout + (size_t)(row0 + ai * 128 + (2 * mp + mm) * 16) * DM + u.pn * 256 + bj * 128 + wc * 32 + n * 16 + fq * 4) = xv[mm][bj][n] + acc[ai][bj][2 * mp + mm][n];
                asm volatile("" ::: "memory"); }
    }
};
struct EpiSwiglu {
    static constexpr bool MID = false;
    bf16_t* ACT; int lo; const float* rsc; const float* csc;
    __device__ __forceinline__ void stage(LAS unsigned char* d, const Unit& u, int wid, int lane) const {
        if (wid == 0) { stage1k(rsc + u.pm * 256, d, lane); stage1k(csc + (size_t)u.aux * 2 * DFF + u.pn * 256, d + 1024, lane); } }
    template <class AV> __device__ __forceinline__ void operator()(const AV (&acc)[2][2][4][2], const Unit& u, int wr, int wc, int fr, int fq, const LAS unsigned char* esc) const {
        const int row0 = (u.pm - lo) * 256 + wr * 64 + fr;
        f32x4 cs[2][2];
#pragma unroll
        for (int bj = 0; bj < 2; ++bj)
#pragma unroll
            for (int n = 0; n < 2; ++n) cs[bj][n] = *(const LAS f32x4*)(esc + 1024 + (bj * 128 + wc * 32 + n * 16 + fq * 4) * 4);
        float rs8[2][4];
#pragma unroll
        for (int ai = 0; ai < 2; ++ai)
#pragma unroll
            for (int m = 0; m < 4; ++m) rs8[ai][m] = *(const LAS float*)(esc + (ai * 128 + wr * 64 + m * 16 + fr) * 4);
#pragma unroll
        for (int ai = 0; ai < 2; ++ai)
#pragma unroll
            for (int m = 0; m < 4; ++m) { const float rs = rs8[ai][m]; f32x4 a, b;
                const f32x4 g0 = deq(acc[ai][0][m][0], rs, cs[0][0]), g1 = deq(acc[ai][0][m][1], rs, cs[0][1]), u0 = deq(acc[ai][1][m][0], rs, cs[1][0]), u1 = deq(acc[ai][1][m][1], rs, cs[1][1]);
#pragma unroll
                for (int j = 0; j < 4; ++j) { a[j] = g0[j] * fast_sigmoid(g0[j]) * u0[j]; b[j] = g1[j] * fast_sigmoid(g1[j]) * u1[j]; }
                *(u32x4*)(ACT + (size_t)(row0 + ai * 128 + m * 16) * DFF + u.pn * 128 + wc * 32 + fq * 8) = pack8(a, b); }
    }
};
struct EpiYout {
    static constexpr bool MID = false;
    __device__ __forceinline__ void stage(LAS unsigned char*, const Unit&, int, int) const {}
    bf16_t* Y;
    __device__ __forceinline__ void operator()(const AccT& acc, const Unit& u, int wr, int wc, int fr, int fq, const LAS unsigned char*) const {
        const int row0 = u.pm * 256 + wr * 64 + fr;
#pragma unroll
        for (int ai = 0; ai < 2; ++ai)
#pragma unroll
            for (int m = 0; m < 4; ++m)
#pragma unroll
                for (int bj = 0; bj < 2; ++bj)
#pragma unroll
                    for (int n = 0; n < 2; ++n) *(u32x2*)(Y + (size_t)(row0 + ai * 128 + m * 16) * DM + u.pn * 256 + bj * 128 + wc * 32 + n * 16 + fq * 4) = pack4(acc[ai][bj][m][n]);
    }
};

namespace att {
__device__ __forceinline__ int crow(int r, int hi) { return (r & 3) + 8 * (r >> 2) + 4 * hi; }
__device__ __forceinline__ void glds16(const void* gsrc, unsigned lds_dst) { unsigned keep;
    asm volatile("s_mov_b32 %0, m0\n\ts_mov_b32 m0, %2\n\ts_nop 0\n\tglobal_load_lds_dwordx4 %1, off\n\ts_mov_b32 m0, %0" : "=&s"(keep) : "v"(gsrc), "s"(lds_dst) : "memory"); }
__device__ __forceinline__ float swapmax(float m) { auto rr = __builtin_amdgcn_permlane32_swap(__float_as_uint(m), __float_as_uint(m), false, false); return fmaxf(__uint_as_float(rr[0]), __uint_as_float(rr[1])); }
__device__ __forceinline__ float swapsum(float m) { auto rr = __builtin_amdgcn_permlane32_swap(__float_as_uint(m), __float_as_uint(m), false, false); return __uint_as_float(rr[0]) + __uint_as_float(rr[1]); }
__device__ __forceinline__ s16x4 vtr(unsigned addr) { s16x4 r; asm volatile("ds_read_b64_tr_b16 %0, %1" : "=&v"(r) : "v"(addr) : "memory"); return r; }
#define VTRO(dst, base, off) asm volatile("ds_read_b64_tr_b16 %0, %1 offset:%c2" : "=&v"(dst) : "v"(base), "i"(off) : "memory")

struct Src {
    const bf16_t* q; int qpitch;
    const bf16_t* k0; int k0pitch;
    const bf16_t* k1; int k1pitch;
    const bf16_t* v; int vpitch;
    bf16_t* o; int opitch;
};
template <int NKC, int NVB, int RD = 4>
__device__ __forceinline__ void dma_tile(const Src& S, int t, int slot, unsigned lds0, int wid, int lane) {
    constexpr int KS = NKC * 1024, VS = NVB * 4096, LDS_K = 0, LDS_V = RD * KS;
#pragma unroll
    for (int c = 0; c < (NKC + 7) / 8; ++c) { const int ch = wid + 8 * c; if (ch < NKC) {
        const bf16_t* src = (ch < 8) ? S.k0 + (size_t)(t * 64 + lane) * S.k0pitch + ch * 8 : S.k1 + (size_t)(t * 64 + lane) * S.k1pitch + (ch - 8) * 8;
        glds16(src, (unsigned)__builtin_amdgcn_readfirstlane(lds0 + LDS_K + slot * KS + ch * 1024)); } }
#pragma unroll
    for (int c = 0; c < (NVB * 4 + 7) / 8; ++c) { const int p = wid + 8 * c; if (p < NVB * 4) {
        const bf16_t* src = S.v + (size_t)(t * 64 + 16 * (p & 3) + (lane >> 2)) * S.vpitch + (p >> 2) * 32 + (lane & 3) * 8;
        glds16(src, (unsigned)__builtin_amdgcn_readfirstlane(lds0 + LDS_V + slot * VS + p * 1024)); } }
}
__device__ __forceinline__ void wait_vm_bar(int n) {
    if (n >= 4) asm volatile("s_waitcnt vmcnt(4) lgkmcnt(0)\n\ts_barrier" ::: "memory");
    else if (n == 3) asm volatile("s_waitcnt vmcnt(3) lgkmcnt(0)\n\ts_barrier" ::: "memory");
    else if (n == 2) asm volatile("s_waitcnt vmcnt(2) lgkmcnt(0)\n\ts_barrier" ::: "memory");
    else if (n == 1) asm volatile("s_waitcnt vmcnt(1) lgkmcnt(0)\n\ts_barrier" ::: "memory");
    else asm volatile("s_waitcnt vmcnt(0) lgkmcnt(0)\n\ts_barrier" ::: "memory");
}
template <int NKC, int NVB, int MODE>
__device__ __forceinline__ void unit(LAS unsigned char* lds, const Src& S, int t_lo, int t_hi, int qpos0  , float sink_l2) {
    constexpr int KS = NKC * 1024, VS = NVB * 4096, RD = 4, LDS_K = 0, LDS_V = RD * KS;
    const int tid = opq_v((int)threadIdx.x), lane = tid & 63, r32 = lane & 31, hi = lane >> 5; const int wid = __builtin_amdgcn_readfirstlane(tid >> 6), grp = wid >> 2;
    const unsigned lds0 = (unsigned)(uintptr_t)lds;
    const int ops = (NKC + 7 - wid) / 8 + (NVB * 4) / 8;
    bf16x8 qr[NKC / 2];
#pragma unroll
    for (int d0 = 0; d0 < NKC / 2; ++d0) qr[d0] = *(const bf16x8*)(S.q + (size_t)r32 * S.qpitch + d0 * 16 + hi * 8);
    float m_run = (MODE == 0) ? sink_l2 : -INFINITY, l_run = (MODE == 0 && hi == 0) ? 1.0f : 0.0f;
    f32x16 o[NVB];
#pragma unroll
    for (int d = 0; d < NVB; ++d) o[d] = f32x16{};
    const int qi = qpos0 + wid * 32 + r32, qw0 = qpos0 + wid * 32;
    f32x16 p0 = f32x16{}, p1 = f32x16{};
#define AT_ACTIVE(t) ((MODE != 0) || ((64 * (t) + 63 >= qw0 - 128) && (64 * (t) <= qw0 + 31 + 128)))
#define AT_QK(t) do { const LAS unsigned char* kb_ = lds + LDS_K + (((t) - t_lo) % RD) * KS + hi * 1024 + r32 * 16; p0 = f32x16{}; p1 = f32x16{}; \
        _Pragma("unroll") for (int d0 = 0; d0 < NKC / 2; ++d0) { const bf16x8 b0_ = *(const LAS bf16x8*)(kb_ + d0 * 2048), b1_ = *(const LAS bf16x8*)(kb_ + d0 * 2048 + 512); \
            p0 = __builtin_amdgcn_mfma_f32_32x32x16_bf16(b0_, qr[d0], p0, 0, 0, 0); p1 = __builtin_amdgcn_mfma_f32_32x32x16_bf16(b1_, qr[d0], p1, 0, 0, 0); } } while (0)
#define AT_SMPV(t) do { \
        if (MODE == 0) { _Pragma("unroll") for (int r = 0; r < 16; ++r) { const int kv_ = 64 * (t) + crow(r, hi); int e0_ = kv_ - qi; e0_ = e0_ < 0 ? -e0_ : e0_; int e1_ = kv_ + 32 - qi; e1_ = e1_ < 0 ? -e1_ : e1_; \
            if (e0_ > 128) p0[r] = -INFINITY; if (e1_ > 128) p1[r] = -INFINITY; } } \
        float mx_[8]; _Pragma("unroll") for (int r = 0; r < 8; ++r) mx_[r] = fmaxf(fmaxf(p0[r], p0[r + 8]), fmaxf(p1[r], p1[r + 8])); \
        float rm_ = fmaxf(fmaxf(fmaxf(mx_[0], mx_[1]), fmaxf(mx_[2], mx_[3])), fmaxf(fmaxf(mx_[4], mx_[5]), fmaxf(mx_[6], mx_[7]))); rm_ = swapmax(rm_); \
        if (__any(rm_ > m_run)) { const float mn_ = fmaxf(m_run, rm_), alpha_ = __builtin_amdgcn_exp2f(m_run - mn_); m_run = mn_; l_run *= alpha_; \
            _Pragma("unroll") for (int d = 0; d < NVB; ++d) _Pragma("unroll") for (int r = 0; r < 16; ++r) o[d][r] *= alpha_; } \
        float sm_[4] = {0.f, 0.f, 0.f, 0.f}; \
        _Pragma("unroll") for (int r = 0; r < 16; ++r) { p0[r] = __builtin_amdgcn_exp2f(p0[r] - m_run); p1[r] = __builtin_amdgcn_exp2f(p1[r] - m_run); sm_[r & 3] += p0[r] + p1[r]; } \
        l_run += (sm_[0] + sm_[1]) + (sm_[2] + sm_[3]); \
        u32x4 pw_[4]; \
        pw_[0] = (u32x4){cvtpk(p0[0], p0[1]), cvtpk(p0[2], p0[3]), cvtpk(p0[4], p0[5]), cvtpk(p0[6], p0[7])}; pw_[1] = (u32x4){cvtpk(p0[8], p0[9]), cvtpk(p0[10], p0[11]), cvtpk(p0[12], p0[13]), cvtpk(p0[14], p0[15])}; \
        pw_[2] = (u32x4){cvtpk(p1[0], p1[1]), cvtpk(p1[2], p1[3]), cvtpk(p1[4], p1[5]), cvtpk(p1[6], p1[7])}; pw_[3] = (u32x4){cvtpk(p1[8], p1[9]), cvtpk(p1[10], p1[11]), cvtpk(p1[12], p1[13]), cvtpk(p1[14], p1[15])}; \
        const unsigned vb_ = lds0 + LDS_V + (((t) - t_lo) % RD) * VS + ((lane >> 4) & 1) * 32 + (lane & 3) * 8 + (4 * hi + ((lane & 15) >> 2)) * 64; \
        _Pragma("unroll") for (int dp = 0; dp < NVB; dp += 2) { s16x4 lo_[2][4], hh_[2][4]; \
            _Pragma("unroll") for (int dd = 0; dd < 2; ++dd) _Pragma("unroll") for (int ks = 0; ks < 4; ++ks) { lo_[dd][ks] = vtr(vb_ + (dp + dd) * 4096 + ks * 1024); hh_[dd][ks] = vtr(vb_ + (dp + dd) * 4096 + ks * 1024 + 512); } \
            asm volatile("s_waitcnt lgkmcnt(0)" ::: "memory"); __builtin_amdgcn_sched_barrier(0); \
            _Pragma("unroll") for (int ks = 0; ks < 4; ++ks) _Pragma("unroll") for (int dd = 0; dd < 2; ++dd) { \
                const bf16x8 vf_ = (bf16x8){lo_[dd][ks][0], lo_[dd][ks][1], lo_[dd][ks][2], lo_[dd][ks][3], hh_[dd][ks][0], hh_[dd][ks][1], hh_[dd][ks][2], hh_[dd][ks][3]}; \
                o[dp + dd] = __builtin_amdgcn_mfma_f32_32x32x16_bf16(vf_, __builtin_bit_cast(bf16x8, pw_[ks]), o[dp + dd], 0, 0, 0); } } } while (0)
    dma_tile<NKC, NVB>(S, t_lo, 0, lds0, wid, lane);
    if (t_lo + 1 < t_hi) dma_tile<NKC, NVB>(S, t_lo + 1, 1, lds0, wid, lane);
    for (int t = t_lo; t < t_hi; ++t) {
        wait_vm_bar((t + 1 < t_hi) ? ops : 0);
        if (t + 2 < t_hi) dma_tile<NKC, NVB>(S, t + 2, (t + 2 - t_lo) % RD, lds0, wid, lane);
        if (grp == 0) { if (AT_ACTIVE(t)) { AT_QK(t); AT_SMPV(t); } }
        else { if (t > t_lo && AT_ACTIVE(t - 1)) AT_SMPV(t - 1); if (AT_ACTIVE(t)) AT_QK(t); }
    }
    if (grp == 1 && AT_ACTIVE(t_hi - 1)) AT_SMPV(t_hi - 1);
    const float linv = 1.0f / swapsum(l_run);
#pragma unroll
    for (int d = 0; d < NVB; ++d)
#pragma unroll
        for (int r4 = 0; r4 < 4; ++r4) { f32x4 v = {o[d][4 * r4] * linv, o[d][4 * r4 + 1] * linv, o[d][4 * r4 + 2] * linv, o[d][4 * r4 + 3] * linv};
            *(u32x2*)(S.o + (size_t)r32 * S.opitch + 32 * d + 8 * r4 + 4 * hi) = pack4(v); }
    asm volatile("s_waitcnt lgkmcnt(0)\n\ts_barrier" ::: "memory");
#undef AT_ACTIVE
#undef AT_QK
#undef AT_SMPV
}

template <int NKC, int NVB, bool STAG, int MODE = 1>
__device__ __forceinline__ void unit_pf(LAS unsigned char* lds, const Src& S, int t_lo, int t_hi, int qpos0 = 0, float sink_l2 = 0.f) {
    constexpr int KS = NKC * 1024, VS = NVB * 4096, RD = 5, LDS_K = 0, LDS_V = RD * KS;
    static_assert(RD * (KS + VS) <= RING_BYTES, "attention rings fit the LDS stage region");
    const int tid = opq_v((int)threadIdx.x), lane = tid & 63, r32 = lane & 31, hi = lane >> 5; const int wid = __builtin_amdgcn_readfirstlane(tid >> 6), grp = STAG ? (wid >> 2) : 0;
    const unsigned lds0 = (unsigned)(uintptr_t)lds;
    const int ops = (NKC + 7 - wid) / 8 + (NVB * 4) / 8;
    bf16x8 qr[NKC / 2];
#pragma unroll
    for (int d0 = 0; d0 < NKC / 2; ++d0) qr[d0] = *(const bf16x8*)(S.q + (size_t)r32 * S.qpitch + d0 * 16 + hi * 8);
    float m_run = (MODE == 0) ? sink_l2 : -INFINITY, l_run = (MODE == 0 && hi == 0) ? 1.0f : 0.0f;
    const int qi = qpos0 + wid * 32 + r32; (void)qi;
    f32x16 o[NVB];
#pragma unroll
    for (int d = 0; d < NVB; ++d) o[d] = f32x16{};
    bf16x8 kf[NKC];
    f32x16 p0 = f32x16{}, p1 = f32x16{};
    s16x4 lo[NVB][4], hh[NVB][4];
#define PF_KLOAD(t) do { const LAS unsigned char* kb_ = lds + LDS_K + (((t) - t_lo) % RD) * KS + hi * 1024 + r32 * 16; \
        _Pragma("unroll") for (int d0 = 0; d0 < NKC / 2; ++d0) { kf[2 * d0] = *(const LAS bf16x8*)(kb_ + d0 * 2048); kf[2 * d0 + 1] = *(const LAS bf16x8*)(kb_ + d0 * 2048 + 512); } } while (0)
#define PF_VLOAD(t) do { const unsigned vb_ = lds0 + LDS_V + (((t) - t_lo) % RD) * VS + ((lane >> 4) & 1) * 32 + (lane & 3) * 8 + (4 * hi + ((lane & 15) >> 2)) * 64; \
        _Pragma("unroll") for (int d = 0; d < NVB; ++d) _Pragma("unroll") for (int ks = 0; ks < 4; ++ks) { VTRO(lo[d][ks], vb_, d * 4096 + ks * 1024); VTRO(hh[d][ks], vb_, d * 4096 + ks * 1024 + 512); } \
        __builtin_amdgcn_sched_barrier(0); } while (0)
#define PF_QK() do { p0 = f32x16{}; p1 = f32x16{}; \
        _Pragma("unroll") for (int d0 = 0; d0 < NKC / 2; ++d0) { p0 = __builtin_amdgcn_mfma_f32_32x32x16_bf16(kf[2 * d0], qr[d0], p0, 0, 0, 0); p1 = __builtin_amdgcn_mfma_f32_32x32x16_bf16(kf[2 * d0 + 1], qr[d0], p1, 0, 0, 0); } \
        __builtin_amdgcn_sched_barrier(0); } while (0)
    u32x4 pw[4] = {};
#define PF_SM(t) do { \
        if (MODE == 0) { _Pragma("unroll") for (int r = 0; r < 16; ++r) { const int kv_ = 64 * (t) + crow(r, hi); int e0_ = kv_ - qi; e0_ = e0_ < 0 ? -e0_ : e0_; int e1_ = kv_ + 32 - qi; e1_ = e1_ < 0 ? -e1_ : e1_; \
            if (e0_ > 128) p0[r] = -INFINITY; if (e1_ > 128) p1[r] = -INFINITY; } } \
        float mx_[8]; _Pragma("unroll") for (int r = 0; r < 8; ++r) mx_[r] = fmaxf(fmaxf(p0[r], p0[r + 8]), fmaxf(p1[r], p1[r + 8])); \
        float rm_ = fmaxf(fmaxf(fmaxf(mx_[0], mx_[1]), fmaxf(mx_[2], mx_[3])), fmaxf(fmaxf(mx_[4], mx_[5]), fmaxf(mx_[6], mx_[7]))); rm_ = swapmax(rm_); \
        if (__any(rm_ > m_run)) { const float mn_ = fmaxf(m_run, rm_), alpha_ = __builtin_amdgcn_exp2f(m_run - mn_); m_run = mn_; l_run *= alpha_; \
            _Pragma("unroll") for (int d = 0; d < NVB; ++d) _Pragma("unroll") for (int r = 0; r < 16; ++r) o[d][r] *= alpha_; } \
        float sm_[4] = {0.f, 0.f, 0.f, 0.f}; \
        _Pragma("unroll") for (int r = 0; r < 16; ++r) { p0[r] = __builtin_amdgcn_exp2f(p0[r] - m_run); p1[r] = __builtin_amdgcn_exp2f(p1[r] - m_run); sm_[r & 3] += p0[r] + p1[r]; } \
        l_run += (sm_[0] + sm_[1]) + (sm_[2] + sm_[3]); \
        pw[0] = (u32x4){cvtpk(p0[0], p0[1]), cvtpk(p0[2], p0[3]), cvtpk(p0[4], p0[5]), cvtpk(p0[6], p0[7])}; pw[1] = (u32x4){cvtpk(p0[8], p0[9]), cvtpk(p0[10], p0[11]), cvtpk(p0[12], p0[13]), cvtpk(p0[14], p0[15])}; \
        pw[2] = (u32x4){cvtpk(p1[0], p1[1]), cvtpk(p1[2], p1[3]), cvtpk(p1[4], p1[5]), cvtpk(p1[6], p1[7])}; pw[3] = (u32x4){cvtpk(p1[8], p1[9]), cvtpk(p1[10], p1[11]), cvtpk(p1[12], p1[13]), cvtpk(p1[14], p1[15])}; \
        __builtin_amdgcn_sched_barrier(0); } while (0)
#define PF_PV() do { asm volatile("s_waitcnt lgkmcnt(0)" ::: "memory"); __builtin_amdgcn_sched_barrier(0); \
        _Pragma("unroll") for (int ks = 0; ks < 4; ++ks) _Pragma("unroll") for (int d = 0; d < NVB; ++d) { \
            const bf16x8 vf_ = (bf16x8){lo[d][ks][0], lo[d][ks][1], lo[d][ks][2], lo[d][ks][3], hh[d][ks][0], hh[d][ks][1], hh[d][ks][2], hh[d][ks][3]}; \
            o[d] = __builtin_amdgcn_mfma_f32_32x32x16_bf16(vf_, __builtin_bit_cast(bf16x8, pw[ks]), o[d], 0, 0, 0); } \
        __builtin_amdgcn_sched_barrier(0); } while (0)
    dma_tile<NKC, NVB, RD>(S, t_lo, 0, lds0, wid, lane);
    if (t_lo + 1 < t_hi) dma_tile<NKC, NVB, RD>(S, t_lo + 1, 1, lds0, wid, lane);
    wait_vm_bar(0);
    if (t_lo + 2 < t_hi) dma_tile<NKC, NVB, RD>(S, t_lo + 2, 2, lds0, wid, lane);
#define PF_TOP(t) do { if ((t) > t_lo) wait_vm_bar(((t) + 2 < t_hi) ? ops : 0); \
        if ((t) + 3 < t_hi) dma_tile<NKC, NVB, RD>(S, (t) + 3, ((t) + 3 - t_lo) % RD, lds0, wid, lane); } while (0)
    if (grp == 0) {
        PF_KLOAD(t_lo);
        for (int t = t_lo; t < t_hi; ++t) {
            PF_TOP(t);
            PF_VLOAD(t);
            PF_QK();
            if (t + 1 < t_hi) PF_KLOAD(t + 1);
            __builtin_amdgcn_sched_barrier(0);
            PF_SM(t);
            PF_PV();
        }
    } else {
        PF_TOP(t_lo); PF_KLOAD(t_lo); __builtin_amdgcn_sched_barrier(0); PF_QK();
        for (int t = t_lo + 1; t < t_hi; ++t) {
            PF_TOP(t);
            PF_VLOAD(t - 1); PF_SM(t - 1); PF_KLOAD(t); __builtin_amdgcn_sched_barrier(0); PF_PV();
            PF_QK();
        }
        PF_VLOAD(t_hi - 1); PF_SM(t_hi - 1); PF_PV();
    }
    const float linv = 1.0f / swapsum(l_run);
#pragma unroll
    for (int d = 0; d < NVB; ++d)
#pragma unroll
        for (int r4 = 0; r4 < 4; ++r4) { f32x4 v = {o[d][4 * r4] * linv, o[d][4 * r4 + 1] * linv, o[d][4 * r4 + 2] * linv, o[d][4 * r4 + 3] * linv};
            *(u32x2*)(S.o + (size_t)r32 * S.opitch + 32 * d + 8 * r4 + 4 * hi) = pack4(v); }
    asm volatile("s_waitcnt lgkmcnt(0)\n\ts_barrier" ::: "memory");
#undef PF_KLOAD
#undef PF_VLOAD
#undef PF_QK
#undef PF_SM
#undef PF_PV
#undef PF_TOP
}

template <int NKC, int NVB, int MODE>
__device__ __forceinline__ void unit_pp(LAS unsigned char* lds, const Src& S, int t_lo, int t_hi, int qpos0, float sink_l2) {
    constexpr int KS = NKC * 1024, VS = NVB * 4096, RD = 3, LDS_K = 0, LDS_V = RD * KS;
    const int tid = opq_v((int)threadIdx.x), lane = tid & 63, r32 = lane & 31, hi = lane >> 5; const int wid = __builtin_amdgcn_readfirstlane(tid >> 6), grp = wid >> 2;
    const unsigned lds0 = (unsigned)(uintptr_t)lds;
    const int n = t_hi - t_lo;
    const int kops = (NKC + 7 - wid) / 8, vops = (NVB * 4) / 8;
    bf16x8 qr[NKC / 2];
#pragma unroll
    for (int d0 = 0; d0 < NKC / 2; ++d0) qr[d0] = *(const bf16x8*)(S.q + (size_t)r32 * S.qpitch + d0 * 16 + hi * 8);
#define PP_DMA_K(j) do { _Pragma("unroll") for (int c_ = 0; c_ < (NKC + 7) / 8; ++c_) { const int ch_ = wid + 8 * c_; if (ch_ < NKC) { \
        const bf16_t* src_ = (ch_ < 8) ? S.k0 + (size_t)((t_lo + (j)) * 64 + lane) * S.k0pitch + ch_ * 8 : S.k1 + (size_t)((t_lo + (j)) * 64 + lane) * S.k1pitch + (ch_ - 8) * 8; \
        glds16(src_, (unsigned)__builtin_amdgcn_readfirstlane(lds0 + LDS_K + ((j) % RD) * KS + ch_ * 1024)); } } } while (0)
#define PP_DMA_V(j) do { _Pragma("unroll") for (int c_ = 0; c_ < (NVB * 4 + 7) / 8; ++c_) { const int p_ = wid + 8 * c_; if (p_ < NVB * 4) { \
        const bf16_t* src_ = S.v + (size_t)((t_lo + (j)) * 64 + 16 * (p_ & 3) + (lane >> 2)) * S.vpitch + (p_ >> 2) * 32 + (lane & 3) * 8; \
        glds16(src_, (unsigned)__builtin_amdgcn_readfirstlane(lds0 + LDS_V + ((j) % RD) * VS + p_ * 1024)); } } } while (0)
#define PP_BATCH(b, cnt) do { cnt = 0; if ((b) + 3 < n) { PP_DMA_K((b) + 3); cnt += kops; } if ((b) + 2 < n) { PP_DMA_V((b) + 2); cnt += vops; } } while (0)
    float m_run = (MODE == 0) ? sink_l2 : -INFINITY, l_run = (MODE == 0 && hi == 0) ? 1.0f : 0.0f;
    f32x16 o[NVB];
#pragma unroll
    for (int d = 0; d < NVB; ++d) o[d] = f32x16{};
    const int qi = qpos0 + wid * 32 + r32, qw0 = qpos0 + wid * 32;
#define PP_ACTIVE(j) ((MODE != 0) || ((64 * (t_lo + (j)) + 63 >= qw0 - 128) && (64 * (t_lo + (j)) <= qw0 + 31 + 128)))
    f32x16 p0 = f32x16{}, p1 = f32x16{}; u32x4 pw[4] = {};
#define PP_QK(j) do { const LAS unsigned char* kb_ = lds + LDS_K + ((j) % RD) * KS + hi * 1024 + r32 * 16; p0 = f32x16{}; p1 = f32x16{}; \
        _Pragma("unroll") for (int d0 = 0; d0 < NKC / 2; ++d0) { const bf16x8 b0_ = *(const LAS bf16x8*)(kb_ + d0 * 2048), b1_ = *(const LAS bf16x8*)(kb_ + d0 * 2048 + 512); \
            p0 = __builtin_amdgcn_mfma_f32_32x32x16_bf16(b0_, qr[d0], p0, 0, 0, 0); p1 = __builtin_amdgcn_mfma_f32_32x32x16_bf16(b1_, qr[d0], p1, 0, 0, 0); } } while (0)
#define PP_SOFTMAX(j) do { \
        if (MODE == 0) { _Pragma("unroll") for (int r = 0; r < 16; ++r) { const int kv_ = 64 * (t_lo + (j)) + crow(r, hi); int e0_ = kv_ - qi; e0_ = e0_ < 0 ? -e0_ : e0_; int e1_ = kv_ + 32 - qi; e1_ = e1_ < 0 ? -e1_ : e1_; \
            if (e0_ > 128) p0[r] = -INFINITY; if (e1_ > 128) p1[r] = -INFINITY; } } \
        float rm_ = fmaxf(p0[0], p1[0]); _Pragma("unroll") for (int r = 1; r < 16; ++r) rm_ = fmaxf(rm_, fmaxf(p0[r], p1[r])); rm_ = swapmax(rm_); \
        const float mn_ = fmaxf(m_run, rm_), alpha_ = __builtin_amdgcn_exp2f(m_run - mn_); m_run = mn_; float sum_ = 0.f; \
        _Pragma("unroll") for (int r = 0; r < 16; ++r) { p0[r] = __builtin_amdgcn_exp2f(p0[r] - mn_); p1[r] = __builtin_amdgcn_exp2f(p1[r] - mn_); sum_ += p0[r] + p1[r]; } \
        l_run = l_run * alpha_ + sum_; \
        _Pragma("unroll") for (int d = 0; d < NVB; ++d) _Pragma("unroll") for (int r = 0; r < 16; ++r) o[d][r] *= alpha_; \
        pw[0] = (u32x4){cvtpk(p0[0], p0[1]), cvtpk(p0[2], p0[3]), cvtpk(p0[4], p0[5]), cvtpk(p0[6], p0[7])}; pw[1] = (u32x4){cvtpk(p0[8], p0[9]), cvtpk(p0[10], p0[11]), cvtpk(p0[12], p0[13]), cvtpk(p0[14], p0[15])}; \
        pw[2] = (u32x4){cvtpk(p1[0], p1[1]), cvtpk(p1[2], p1[3]), cvtpk(p1[4], p1[5]), cvtpk(p1[6], p1[7])}; pw[3] = (u32x4){cvtpk(p1[8], p1[9]), cvtpk(p1[10], p1[11]), cvtpk(p1[12], p1[13]), cvtpk(p1[14], p1[15])}; } while (0)
#define PP_PV(j) do { const unsigned vb_ = lds0 + LDS_V + ((j) % RD) * VS + ((lane >> 4) & 1) * 32 + (lane & 3) * 8 + (4 * hi + ((lane & 15) >> 2)) * 64; \
        _Pragma("unroll") for (int d = 0; d < NVB; ++d) { s16x4 lo_[4], hh_[4]; \
            _Pragma("unroll") for (int ks = 0; ks < 4; ++ks) { lo_[ks] = vtr(vb_ + d * 4096 + ks * 1024); hh_[ks] = vtr(vb_ + d * 4096 + ks * 1024 + 512); } \
            asm volatile("s_waitcnt lgkmcnt(0)" ::: "memory"); __builtin_amdgcn_sched_barrier(0); \
            _Pragma("unroll") for (int ks = 0; ks < 4; ++ks) { const bf16x8 vf_ = (bf16x8){lo_[ks][0], lo_[ks][1], lo_[ks][2], lo_[ks][3], hh_[ks][0], hh_[ks][1], hh_[ks][2], hh_[ks][3]}; \
                o[d] = __builtin_amdgcn_mfma_f32_32x32x16_bf16(vf_, __builtin_bit_cast(bf16x8, pw[ks]), o[d], 0, 0, 0); } } } while (0)
    PP_DMA_K(0); PP_DMA_V(0); if (n > 1) { PP_DMA_K(1); PP_DMA_V(1); } if (n > 2) PP_DMA_K(2);
    asm volatile("s_waitcnt vmcnt(0) lgkmcnt(0)\n\ts_barrier" ::: "memory");
    if (grp == 1) asm volatile("s_barrier" ::: "memory");
    int infl = 0;
    if (PP_ACTIVE(0)) PP_QK(0);
    wait_vm_bar(infl);
    if (grp == 1) PP_BATCH(0, infl);
    if (PP_ACTIVE(0)) PP_SOFTMAX(0);
    wait_vm_bar(infl);
    for (int j = 0; j < n; ++j) {
        if (grp == 0) PP_BATCH(j, infl);
        const bool act = PP_ACTIVE(j), actn = (j + 1 < n) && PP_ACTIVE(j + 1);
        if (act) PP_PV(j);
        if (actn) PP_QK(j + 1);
        wait_vm_bar(infl);
        if (j + 1 < n) {
            if (grp == 1) PP_BATCH(j + 1, infl);
            if (actn) PP_SOFTMAX(j + 1);
            wait_vm_bar(infl);
        }
    }
    if (grp == 0) asm volatile("s_barrier" ::: "memory");
    const float linv = 1.0f / swapsum(l_run);
#pragma unroll
    for (int d = 0; d < NVB; ++d)
#pragma unroll
        for (int r4 = 0; r4 < 4; ++r4) { f32x4 v = {o[d][4 * r4] * linv, o[d][4 * r4 + 1] * linv, o[d][4 * r4 + 2] * linv, o[d][4 * r4 + 3] * linv};
            *(u32x2*)(S.o + (size_t)r32 * S.opitch + 32 * d + 8 * r4 + 4 * hi) = pack4(v); }
    asm volatile("s_waitcnt lgkmcnt(0)\n\ts_barrier" ::: "memory");
#undef PP_DMA_K
#undef PP_DMA_V
#undef PP_BATCH
#undef PP_ACTIVE
#undef PP_QK
#undef PP_SOFTMAX
#undef PP_PV
}
}
#define SC_AFTER_PROLOGUE() do {} while (0)
#define SC_AFTER_INPROJ(l) do {} while (0)
#define SC_AFTER_UP(l) do {} while (0)
#define SC_AFTER_MLA(l) do {} while (0)
#define SC_AFTER_BRANCH(l) do {} while (0)
#define SC_AFTER_WOUT(l) do {} while (0)
#define SC_AFTER_NORM2(l) do {} while (0)
#define SC_AFTER_GU(l) do {} while (0)
#define SC_AFTER_DOWN(l) do {} while (0)
#define SC_AFTER_ROUTE(l) do {} while (0)
#define SC_AFTER_MOEGU(l, h) do {} while (0)
#define SC_AFTER_MOED(l, h) do {} while (0)
#define SC_FINAL() do {} while (0)

struct Args { const float* in[23]; float* out; unsigned char* ws; };
#define WSP(type, off) ((type*)(F.ws + (off)))
#define PHASE() Frame Fp = F; Fp.ws = opq_p(F.ws); Fp.in = opq_p(F.in); Fp.out = opq_p(F.out); Fp.tid = opq_v((int)threadIdx.x); Fp.lane = Fp.tid & 63; Fp.wave = __builtin_amdgcn_readfirstlane(Fp.tid >> 6); (void)Fp
#define FWS(type, off) ((type*)(Fp.ws + (off)))
#define X_ (Fp.out)
#define H_ FWS(bf16_t, WS_H)
#define Pb_ FWS(bf16_t, WS_R + R_P)
#define Gb_ FWS(bf16_t, WS_R + R_G)
#define QB_ FWS(bf16_t, WS_R + R_QB)
#define KVB_ FWS(bf16_t, WS_R + R_KVB)
#define Yb_ FWS(bf16_t, WS_R + R_Y)
#define MEMN_ FWS(bf16_t, WS_MEMN)
#define MEMKV_ FWS(bf16_t, WS_MEMKV)
#define ACT_ FWS(bf16_t, WS_R + R_ACT)
#define ASORT_ FWS(bf16_t, WS_R + R_ASORT)
#define YOUT_ FWS(bf16_t, WS_R + R_YOUT)
#define SSQ_ FWS(float, WS_MISC + MS_SSQ)
#define TEXP_ FWS(const int, WS_MISC + MS_TEXP)
#define POS_ ((const int*)Fp.in[I_POS])
#define HSC_ FWS(float, WS_MISC + MS_HSC)
#define ASC_ FWS(float, WS_MISC + MS_ASC)
#define WSIN_ FWS(float, WS_MISC + MS_WSIN)
#define WSGU_ FWS(float, WS_MISC + MS_WSGU)

#define GRID_BAR() xcd_barrier(bar)
#ifndef MLA_STAG
#define MLA_STAG false
#endif
template <int l> __device__ __forceinline__ void layer_body(const Frame& F, const XcdBarrier& bar, const int bx) {
        if (l > 0) {
            PHASE();
            prep_ffn_weights(Fp, l);
            norm_phase(Fp, X_, X_, Fp.in[I_GMIX] + l * DM, (l & 1) == 0, true);
            GRID_BAR();
        }
        {   PHASE();
            ProbSimple p{DM, DM, DM, (const char*)H_, (const char*)wmix(Fp, l, WL_IN)}; pg8::StaticOrder S; S.init(T / 256, NT_IN, Fp.G, bx);
            EpiInproj E{Pb_, Gb_, SSQ_, POS_, HSC_, WSIN_ + l * NT_IN * 256}; pg8::gemm_phase<true>(Fp.lds, p, S, E); }
        if (l == 0) { PHASE();
            ProbSimple p{DM, DM * 2, DM * 2, (const char*)MEMN_, (const char*)FWS(bf16_t, WS_WMKV)}; pg8::StaticOrder S; S.init(NB * MEML / 256, 16, Fp.G, bx);
            EpiPlain E{MEMKV_, 4096}; pg8::gemm_phase(Fp.lds, p, S, E); }
        GRID_BAR();
        SC_AFTER_INPROJ(l);
        {   PHASE();
            ProbSimple p{UPK, PW * 2, UPK * 2, (const char*)(Pb_ + P_CQ), (const char*)wmix(Fp, l, WL_UP)}; pg8::StaticOrder S; S.init(T / 256, UPN / 256, Fp.G, bx);
            EpiUp E{QB_, KVB_, SSQ_, POS_}; pg8::gemm_phase(Fp.lds, p, S, E); }
        {   PHASE();
            for (int i = Fp.vcu; i < 1024; i += Fp.G) {
                const int hl = i & 3, qb = (i >> 2) & 15, kvh = (i >> 6) & 1, b = i >> 7, h = kvh * 4 + hl; const size_t rowb = (size_t)b * SEQ; const int q0 = qb * 256;
                att::Src s; s.q = Pb_ + (rowb + q0 + Fp.wave * 32) * PW + P_QA + h * 64; s.qpitch = PW; s.k0 = Pb_ + rowb * PW + P_KA + kvh * 64; s.k0pitch = PW; s.k1 = s.k0; s.k1pitch = PW;
                s.v = Pb_ + rowb * PW + P_VA + kvh * 64; s.vpitch = PW; s.o = Yb_ + (rowb + q0 + Fp.wave * 32) * YW + h * 64; s.opitch = YW;
                const int t_lo = (q0 / 64 - 2) < 0 ? 0 : (q0 / 64 - 2), t_hi = (q0 / 64 + 6) > SEQ / 64 ? SEQ / 64 : (q0 / 64 + 6);
                att::unit<8, 2, 0>(Fp.lds, s, t_lo, t_hi, q0, Fp.in[I_SINK][l * 8 + h] * LOG2E);
            } }
        {   PHASE();
            for (int i = Fp.vcu; i < 512; i += Fp.G) {
                const int qb = i & 15, h = (i >> 4) & 3, b = i >> 6; const size_t rowq = (size_t)b * SEQ + qb * 256 + Fp.wave * 32;
                att::Src s; s.q = Pb_ + rowq * PW + P_QM + h * 128; s.qpitch = PW; s.k0 = MEMKV_ + (size_t)b * MEML * 4096 + l * 1024 + h * 128; s.k0pitch = 4096; s.k1 = s.k0 + 64; s.k1pitch = 4096;
                s.v = MEMKV_ + (size_t)b * MEML * 4096 + l * 1024 + 512 + h * 128; s.vpitch = 4096; s.o = Yb_ + rowq * YW + 1024 + h * 128; s.opitch = YW;
                att::unit<16, 4, 1>(Fp.lds, s, 0, MEML / 64, 0, 0.f);
            } }
        GRID_BAR();
        SC_AFTER_UP(l);
        {   PHASE();
            for (int i = Fp.vcu; i < 1024; i += Fp.G) {
                const int qb = i & 15, h = (i >> 4) & 7, b = i >> 7; const size_t rowb = (size_t)b * SEQ, rowq = rowb + qb * 256 + Fp.wave * 32;
                att::Src s; s.q = QB_ + rowq * QBW + h * 96; s.qpitch = QBW; s.k0 = KVB_ + rowb * KVW + h * 128; s.k0pitch = KVW; s.k1 = Pb_ + rowb * PW + P_KR; s.k1pitch = PW;
                s.v = KVB_ + rowb * KVW + h * 128 + 64; s.vpitch = KVW; s.o = Yb_ + rowq * YW + 512 + h * 64; s.opitch = YW;
                att::unit_pf<12, 2, MLA_STAG>(Fp.lds, s, 0, SEQ / 64);
            } }
        GRID_BAR();
        SC_AFTER_MLA(l);
        {   PHASE();
            ProbSimple p{1536, YW * 2, 1536 * 2, (const char*)Yb_, (const char*)wmix(Fp, l, WL_BR)}; pg8::StaticOrder S; S.init(T / 256, DM / 256, Fp.G, bx);
            EpiBranch E{(const unsigned char*)Gb_, H_}; pg8::gemm_phase(Fp.lds, p, S, E); }
        GRID_BAR();
        SC_AFTER_BRANCH(l);
        {   PHASE();
            ProbSimple p{DM, DM * 2, DM * 2, (const char*)H_, (const char*)wmix(Fp, l, WL_OUT)}; pg8::StaticOrder S; S.init(T / 256, DM / 256, Fp.G, bx);
            EpiResid E{l == 0 ? Fp.in[I_X] : X_, X_}; pg8::gemm_phase(Fp.lds, p, S, E); }
        GRID_BAR();
        SC_AFTER_WOUT(l);
        if ((l & 1) == 0) {
            {   PHASE(); norm_phase(Fp, X_, nullptr, Fp.in[I_GFFN] + l * DM, false, GU_I8(l) != 0); }
            GRID_BAR();
            SC_AFTER_NORM2(l);
            {   PHASE();
                constexpr bool i8 = GU_I8(l) != 0; constexpr unsigned eb = i8 ? 1 : 2;
                ProbSimple p{DM, DM * eb, DM * eb, (const char*)H_, (const char*)FWS(bf16_t, WS_WFFN + WF_GU)}; pg8::StaticOrder S; S.init(T / 256, 2 * DFF / 256, Fp.G, bx);
                EpiSwiglu E{ACT_, 0, HSC_, WSGU_}; pg8::gemm_phase<i8>(Fp.lds, p, S, E); }
            GRID_BAR();
            SC_AFTER_GU(l);
            {   PHASE();
                ProbSimple p{DFF, DFF * 2, DFF * 2, (const char*)ACT_, (const char*)FWS(bf16_t, WS_WFFN + WF_D)}; pg8::StaticOrder S; S.init(T / 256, DM / 256, Fp.G, bx);
                EpiResid E{X_, X_}; pg8::gemm_phase(Fp.lds, p, S, E); }
            GRID_BAR();
            SC_AFTER_DOWN(l);
        } else {
            {   PHASE(); norm_router_phase(Fp, X_, Fp.in[I_GFFN] + l * DM, Fp.in[I_WR] + (size_t)(l >> 1) * DM * NE, GU_I8(l) != 0); }
            GRID_BAR();
            {   PHASE(); moe_assign_phase(Fp, GU_I8(l) != 0); }
            GRID_BAR();
            SC_AFTER_ROUTE(l);
            {   constexpr int half = 0; (void)half;
                {   PHASE();
                    const int nrt = TEXP_[MAXRT];
                    constexpr bool i8 = GU_I8(l) != 0; constexpr unsigned eb = i8 ? 1 : 2;
                    ProbMoe p{DM, DM * eb, DM * eb, (const char*)ASORT_, (const char*)FWS(bf16_t, WS_WFFN + WF_GU), 0}; MoeOrder S; S.base.init(nrt, 2 * DFF / 256, Fp.G, bx); S.lo = 0; S.texp = TEXP_;
                    EpiSwiglu E{ACT_, 0, ASC_, WSGU_}; pg8::gemm_phase<i8>(Fp.lds, p, S, E); }
                GRID_BAR();
                SC_AFTER_MOEGU(l, half);
                {   PHASE();
                    const int nrt = TEXP_[MAXRT];
                    ProbMoe p{DFF, DFF * 2, DFF * 2, (const char*)ACT_, (const char*)FWS(bf16_t, WS_WFFN + WF_D), 0}; MoeOrder S; S.base.init(nrt, DM / 256, Fp.G, bx); S.lo = 0; S.texp = TEXP_;
                    EpiYout E{YOUT_}; pg8::gemm_phase(Fp.lds, p, S, E); }
                GRID_BAR();
                SC_AFTER_MOED(l, half);
            }
        }
    }

__global__ void __launch_bounds__(NWAVES * 64, 2) fwd(Args args) {
    extern __shared__ __attribute__((aligned(16))) unsigned char lds_raw[];
    Frame F;
    F.lds = (LAS unsigned char*)lds_raw;
    F.MISC = (volatile LAS unsigned*)(F.lds + LDSCTL_OFF);
    F.tid = threadIdx.x; F.lane = F.tid & 63; F.wave = __builtin_amdgcn_readfirstlane(F.tid >> 6);
    F.G = gridDim.x; { const int bx = blockIdx.x; F.vcu = (F.G % 8 == 0) ? (bx % 8) * (F.G / 8) + bx / 8 : bx; }
    F.ws = args.ws; F.ctl = (gu32*)(args.ws + WS_CTL); F.out = args.out;
    F.in = (const float* const*)__builtin_amdgcn_kernarg_segment_ptr();
    for (int u = F.tid; u < (LDS_BYTES - LDSCTL_OFF) / 4; u += NWAVES * 64) ((LAS unsigned*)(F.lds + LDSCTL_OFF))[u] = 0u;
    __syncthreads();
    XcdBarrier bar = xcd_barrier_post((unsigned*)(F.ctl + CW_BAR), F.MISC + 8);

    const int bx = (int)blockIdx.x;

    {   PHASE();
        prep_mixer_weights(Fp);
        memnorm_phase(Fp);
        prep_ffn_weights(Fp, 0);
        norm_phase(Fp, Fp.in[I_X], nullptr, Fp.in[I_GMIX], false, true); }
    GRID_BAR();
    SC_AFTER_PROLOGUE();

    layer_body<0>(F, bar, bx); layer_body<1>(F, bar, bx); layer_body<2>(F, bar, bx); layer_body<3>(F, bar, bx);
    {   PHASE(); final_norm_phase(Fp, X_, Fp.in[I_GFIN], true); }
    SC_FINAL();
}

extern "C" void kernel_launch(void* const* d_in, const int* in_sizes, int n_in, void* d_out, int out_size, void* d_ws, size_t ws_size, hipStream_t stream) {
    static int grid = 0;
    if (grid == 0) {
        if (n_in != 23 || out_size != T * DM || ws_size < WS_END) { fprintf(stderr, "kernel_launch: unexpected problem (n_in %d, out %d, ws %zu < %zu)\n", n_in, out_size, ws_size, (size_t)WS_END); grid = -1; return; }
        int dev = 0, cus = 0;
        if (hipGetDevice(&dev) != hipSuccess || hipDeviceGetAttribute(&cus, hipDeviceAttributeMultiprocessorCount, dev) != hipSuccess) { grid = -1; return; }
        if (hipFuncSetAttribute((const void*)fwd, hipFuncAttributeMaxDynamicSharedMemorySize, LDS_BYTES) != hipSuccess) { fprintf(stderr, "kernel_launch: hipFuncSetAttribute failed\n"); grid = -1; return; }
        int per_cu = 0;
        if (hipOccupancyMaxActiveBlocksPerMultiprocessor(&per_cu, (const void*)fwd, NWAVES * 64, LDS_BYTES) != hipSuccess || per_cu < 1) fprintf(stderr, "kernel_launch: occupancy query says %d\n", per_cu);
        (void)hipGetLastError();
        grid = cus;
    }
    if (grid < 0) return;
    if (hipMemsetAsync((char*)d_ws + WS_CTL, 0, CTL_ZERO_BYTES, stream) != hipSuccess) return;
    Args a{};
    for (int i = 0; i < 23; ++i) a.in[i] = (const float*)d_in[i];
    a.out = (float*)d_out; a.ws = (unsigned char*)d_ws;
    hipLaunchKernelGGL(fwd, dim3(grid), dim3(NWAVES * 64), LDS_BYTES, stream, a);
}
```

```cpp
#include <hip/hip_runtime.h>
#include <cstdio>
#include <cstdint>

#ifndef SELFCHECK
#define SELFCHECK 0
#endif
#ifndef GU_I8_MASK
#define GU_I8_MASK 0xF
#endif
#define GU_I8(l) ((((unsigned)GU_I8_MASK) >> (l)) & 1u)

#define GAS __attribute__((address_space(1)))
#define LAS __attribute__((address_space(3)))
typedef unsigned short bf16_t;
typedef short bf16x8 __attribute__((ext_vector_type(8)));
typedef short s16x4 __attribute__((ext_vector_type(4)));
typedef short v4i16_t __attribute__((ext_vector_type(4)));
typedef float f32x2 __attribute__((ext_vector_type(2)));
typedef float f32x4 __attribute__((ext_vector_type(4)));
typedef float f32x16 __attribute__((ext_vector_type(16)));
typedef unsigned u32x2 __attribute__((ext_vector_type(2)));
typedef unsigned u32x4 __attribute__((ext_vector_type(4)));
typedef int i32x4 __attribute__((ext_vector_type(4)));
typedef GAS unsigned gu32;
#define RLX_AGENT __ATOMIC_RELAXED, __HIP_MEMORY_SCOPE_AGENT

constexpr int NB = 8, SEQ = 4096, T = NB * SEQ, DM = 1024, DEPTH = 4, MEML = 256, DFF = 3584, NE = 8;
constexpr int INW = 4768;
constexpr int PW = 1792;
constexpr int GW = 3072;
constexpr int QBW = 768, KVW = 1024, YW = 1536;
constexpr int NT_IN = 19;
constexpr int P_QA = 0, P_KA = 512, P_VA = 640, P_CQ = 768, P_CKV = 1024, P_KR = 1152, P_QM = 1280;
constexpr int UPK = 384, UPN = 1792;
constexpr int MAXSLOT = 67584;
constexpr int MAXRT = MAXSLOT / 256;
constexpr int HALF_RT = 132;
constexpr float EPS = 1e-6f;
constexpr float LOG2E = 1.4426950408889634f;
constexpr float C_A = 0.125f * LOG2E;
constexpr float C_B = 0.10206207261596575f * LOG2E;
constexpr float C_M = 0.08838834764831845f * LOG2E;

constexpr size_t MiB = 1u << 20;
constexpr size_t WS_CTL = 0, CTL_ZERO_BYTES = 1 * MiB;
constexpr size_t WS_MISC = 1 * MiB;
constexpr size_t WL_IN = 0, WL_UP = (size_t)NT_IN * 256 * DM * 2, WL_BR = WL_UP + (size_t)UPN * UPK * 2, WL_OUT = WL_BR + (size_t)3 * DM * 512 * 2, WL_SIZE = WL_OUT + (size_t)DM * DM * 2;
constexpr size_t WS_WMIX = 8 * MiB;
constexpr size_t WS_WMKV = WS_WMIX + 4 * ((WL_SIZE + MiB - 1) / MiB) * MiB;
constexpr size_t WL_STRIDE = ((WL_SIZE + MiB - 1) / MiB) * MiB;
constexpr size_t WS_WFFN = WS_WMKV + 8 * MiB;
constexpr size_t WF_GU = 0, WF_D = (size_t)2 * DFF * DM * 2, WF_STRIDE = WF_D + (size_t)DM * DFF * 2;
constexpr size_t WS_H = WS_WFFN + 8 * WF_STRIDE;
constexpr size_t WS_MEMN = WS_H + (size_t)T * DM * 2;
constexpr size_t WS_MEMKV = WS_MEMN + (size_t)NB * MEML * DM * 2;
constexpr size_t WS_R = WS_MEMKV + (size_t)NB * MEML * 4096 * 2;
constexpr size_t R_P = 0, R_G = R_P + (size_t)T * PW * 2, R_QB = R_G + (size_t)T * GW * 2, R_KVB = R_QB + (size_t)T * QBW * 2, R_Y = R_KVB + (size_t)T * KVW * 2, R_END_MIX = R_Y + (size_t)T * YW * 2;
constexpr size_t R_BRS = R_P;
constexpr size_t R_ACT = 0;
constexpr size_t R_ASORT = (size_t)MAXSLOT * DFF * 2;
constexpr size_t R_YOUT = R_ASORT;
constexpr size_t R_END_FFN = R_YOUT + (size_t)MAXSLOT * DM * 2;
constexpr size_t R_SIZE = R_END_MIX > R_END_FFN ? R_END_MIX : R_END_FFN;
constexpr size_t WS_END = WS_R + R_SIZE;
static_assert(WS_END < 1020ull * MiB, "workspace budget");
constexpr size_t MS_TOKE = 0;
constexpr size_t MS_TOKW = MS_TOKE + (size_t)T * 8;
constexpr size_t MS_SLOT = MS_TOKW + (size_t)T * 8;
constexpr size_t MS_CNT = MS_SLOT + (size_t)T * 8;
constexpr size_t MS_TEXP = MS_CNT + 256 * 8 * 4;
constexpr size_t MS_SSQ = MS_TEXP + 2048;
constexpr size_t MS_SNAP = MS_SSQ + (size_t)T * 32;
constexpr size_t MS_HSC = MS_SNAP + 64 * 1024 * 4;
constexpr size_t MS_ASC = MS_HSC + (size_t)T * 4;
constexpr size_t MS_WSIN = MS_ASC + (size_t)MAXSLOT * 4;
constexpr size_t MS_WSGU = MS_WSIN + (size_t)4 * NT_IN * 256 * 4;
constexpr size_t MS_END = MS_WSGU + (size_t)8 * 2 * DFF * 4;
static_assert(MS_END <= 7 * MiB, "misc map");
constexpr int CW_BAR = 4096;
constexpr int CW_DIAG = 16384;
constexpr int CW_CODE = 16384 + 512;

constexpr int RING_BYTES = 131072;
constexpr int LDSCTL_OFF = RING_BYTES;
constexpr int LDS_BYTES = 147456;
constexpr int NWAVES = 8;

#define LDS_WAIT() asm volatile("s_waitcnt lgkmcnt(0)" ::: "memory")
#define VM_WAIT() asm volatile("s_waitcnt vmcnt(0)" ::: "memory")

__device__ __forceinline__ unsigned f2bf(float f) { unsigned u = __builtin_bit_cast(unsigned, f); return (u + 0x7fffu + ((u >> 16) & 1u)) >> 16; }
__device__ __forceinline__ unsigned pk2(float lo, float hi) { return f2bf(lo) | (f2bf(hi) << 16); }
__device__ __forceinline__ float bf2f(unsigned short b) { return __builtin_bit_cast(float, (unsigned)b << 16); }
__device__ __forceinline__ float bflo(unsigned w) { return __builtin_bit_cast(float, w << 16); }
__device__ __forceinline__ float bfhi(unsigned w) { return __builtin_bit_cast(float, w & 0xffff0000u); }
typedef __bf16 bf16x2_t __attribute__((ext_vector_type(2)));
__device__ __forceinline__ unsigned cvtpk(float lo, float hi) { f32x2 v = {lo, hi}; bf16x2_t b = __builtin_convertvector(v, bf16x2_t); return __builtin_bit_cast(unsigned, b); }
__device__ __forceinline__ float wave_sum(float v) {
#pragma unroll
    for (int o = 1; o < 64; o <<= 1) v += __shfl_xor(v, o);
    return v;
}
__device__ __forceinline__ float fast_sigmoid(float x) { return __builtin_amdgcn_rcpf(1.0f + __builtin_amdgcn_exp2f(-x * LOG2E)); }


__device__ __forceinline__ int opq_v(int x) { asm volatile("" : "+v"(x)); return x; }
__device__ __forceinline__ int opq_s(int x) { asm volatile("" : "+s"(x)); return x; }
template <class Tp> __device__ __forceinline__ Tp* opq_p(Tp* p) { const unsigned long long u = (unsigned long long)p; unsigned lo = __builtin_amdgcn_readfirstlane((unsigned)u), hi = __builtin_amdgcn_readfirstlane((unsigned)(u >> 32)); asm volatile("" : "+s"(lo), "+s"(hi)); return (Tp*)(((unsigned long long)hi << 32) | lo); }

__constant__ float IFR_HI[32] = {1.591549367e-01f, 1.193493679e-01f, 8.949939907e-02f, 6.711508334e-02f, 5.032921210e-02f, 3.774158657e-02f, 2.830219641e-02f, 2.122365311e-02f, 1.591549441e-02f, 1.193493698e-02f, 8.949940093e-03f, 6.711508147e-03f, 5.032921210e-03f, 3.774158424e-03f, 2.830219688e-03f, 2.122365171e-03f, 1.591549488e-03f, 1.193493721e-03f, 8.949940093e-04f, 6.711508031e-04f, 5.032921326e-04f, 3.774158540e-04f, 2.830219455e-04f, 2.122365258e-04f, 1.591549371e-04f, 1.193493736e-04f, 8.949940093e-05f, 6.711508468e-05f, 5.032921035e-05f, 3.774158540e-05f, 2.830219637e-05f, 2.122365186e-05f};
__constant__ float IFR_LO[32] = {6.420638243e-09f, 2.294664903e-09f, 2.542919653e-09f, -3.316028840e-10f, 5.173299289e-12f, -1.848551645e-09f, -5.826552019e-10f, -3.431038786e-10f, -1.029942243e-10f, 4.320196978e-11f, 6.802745173e-11f, 1.531042237e-10f, 5.173301024e-13f, 4.797548470e-11f, -1.048316434e-10f, 1.053879969e-10f, -5.686555046e-11f, -1.896286773e-11f, 6.802744999e-12f, 2.695195456e-11f, -1.158979943e-11f, -6.843983713e-12f, 1.279990003e-11f, 1.807650600e-12f, 5.954976963e-12f, -3.351478166e-12f, 6.802745216e-13f, -1.670379113e-12f, 1.751403167e-12f, -6.843983930e-13f, -5.389994549e-13f, 9.083608431e-13f};
__device__ __forceinline__ void rot_cs(float posf, int idx, float& c, float& s) {
    const float ch = IFR_HI[idx], cl = IFR_LO[idx];
    const float p = posf * ch, e = __builtin_fmaf(posf, ch, -p);
    const float fr = __builtin_amdgcn_fractf(p) + (e + posf * cl);
    s = __builtin_amdgcn_sinf(fr); c = __builtin_amdgcn_cosf(fr);
}

#define XB_TMO      128
#define XB_XCNT(j)  (256  + 64 * (j))
#define XB_XSUB(j)  (1280 + 64 * (j))
#define XB_XGEN(j)  (2304 + 64 * (j))
#define XB_TOP      3328
#define XB_TOPGEN   3392
#define XCD_BAR_WORDS 3456
#define XB_SPIN_CAP (1u << 20)

__device__ __forceinline__ unsigned xb_ld(unsigned* p)              { return __hip_atomic_load(p, __ATOMIC_RELAXED, __HIP_MEMORY_SCOPE_AGENT); }
__device__ __forceinline__ unsigned xb_add(unsigned* p, unsigned v) { return __hip_atomic_fetch_add(p, v, __ATOMIC_RELAXED, __HIP_MEMORY_SCOPE_AGENT); }
__device__ __forceinline__ unsigned xb_xcc_id() { return (unsigned)__builtin_amdgcn_s_getreg((3 << 11) | 20) & 0xFu; }
#define XB_SPIN(cond, bar) do { unsigned _sp = 0; while (cond) { __builtin_amdgcn_s_sleep(1); \
    if ((++_sp & 255u) == 0u) { if (xb_ld(&(bar)[XB_TMO])) break; if (_sp > XB_SPIN_CAP) { atomicAdd(&(bar)[XB_TMO], 1u); break; } } } } while (0)

struct XcdBarrier { unsigned* bar; unsigned x; volatile LAS unsigned* st; };

__device__ __forceinline__ XcdBarrier xcd_barrier_post(unsigned* bar, volatile LAS unsigned* st) {
    XcdBarrier b; b.bar = bar; b.x = xb_xcc_id(); b.st = st;
    if (threadIdx.x == 0) (void)xb_add(&bar[XB_XCNT(b.x)], 1u);
    return b;
}
__device__ __forceinline__ void xcd_barrier_complete(unsigned* bar, unsigned x, unsigned& nloc, unsigned& nx) {
    const unsigned G = gridDim.x * gridDim.y * gridDim.z;
    unsigned sum, cnt, mine, sp = 0u;
    for (;;) {
        sum = 0u; cnt = 0u; mine = 0u;
#pragma unroll
        for (unsigned j = 0; j < 16; ++j) { const unsigned c = xb_ld(&bar[XB_XCNT(j)]); sum += c; cnt += (c > 0u) ? 1u : 0u; mine = (j == x) ? c : mine; }
        if (sum == G) break;
        __builtin_amdgcn_s_sleep(1);
        if ((++sp & 255u) == 0u) { if (xb_ld(&bar[XB_TMO])) break; if (sp > XB_SPIN_CAP) { atomicAdd(&bar[XB_TMO], 1u); break; } }
    }
    nloc = mine > 0u ? mine : 1u; nx = cnt > 0u ? cnt : 1u;
}
__device__ __forceinline__ void xcd_barrier(const XcdBarrier& b) {
    asm volatile("s_waitcnt vmcnt(0)" ::: "memory");
    __syncthreads();
    if (threadIdx.x == 0) {
        unsigned* bar = b.bar;
        __builtin_amdgcn_s_waitcnt(0);
        unsigned nloc = b.st[0], nx = b.st[1];
        if (nloc == 0u) { xcd_barrier_complete(bar, b.x, nloc, nx); b.st[0] = nloc; b.st[1] = nx; }
        const unsigned old = xb_add(&bar[XB_XSUB(b.x)], 1u);
        const unsigned gen = old / nloc;
        if (old + 1u == (gen + 1u) * nloc) {
            __builtin_amdgcn_fence(__ATOMIC_RELEASE, "agent");
            asm volatile("s_waitcnt vmcnt(0)" ::: "memory");
            const unsigned og = xb_add(&bar[XB_TOP], 1u);
            const unsigned tg = og / nx;
            if (og + 1u == (tg + 1u) * nx) xb_add(&bar[XB_TOPGEN], 1u);
            else XB_SPIN(xb_ld(&bar[XB_TOPGEN]) == tg, bar);
            __builtin_amdgcn_fence(__ATOMIC_ACQUIRE, "agent");
            xb_add(&bar[XB_XGEN(b.x)], 1u);
            asm volatile("s_waitcnt vmcnt(0)" ::: "memory");
        } else {
            XB_SPIN(xb_ld(&bar[XB_XGEN(b.x)]) == gen, bar);
            __builtin_amdgcn_fence(__ATOMIC_ACQUIRE, "agent");
            asm volatile("s_waitcnt vmcnt(0)" ::: "memory");
        }
    }
    __syncthreads();
}

namespace pg8 {
constexpr int BM = 256, BK = 64, HALF = 128, HTB = HALF * BK * 2, STAGE_BYTES = 8 * HTB, NXCD = 8, WGM = 4;
constexpr int ESC_OFF = 131072 + 4096, ESC_SLOT = 3072;
__host__ __device__ __forceinline__ int lds_byte(int r, int c) { const int st = (r >> 4) * 2 + (c >> 5), rr = r & 15, cc = c & 31, ob = rr * 64 + cc * 2; return st * 1024 + (ob ^ (((ob >> 9) & 1) << 5)); }
__host__ __device__ __forceinline__ void stage_rc(int b, int& R, int& C) { const int st = b / 1024, sb = b % 1024, swz = sb ^ (((sb >> 9) & 1) << 5); R = (st >> 1) * 16 + swz / 64; C = (st & 1) * 32 + (swz % 64) / 2; }

struct Unit { int pm, pn, aux; };

struct StaticOrder {
    int nM, nN, nwg, G, c;
    __device__ void init(int nM_, int nN_, int G_, int c_) { nM = nM_; nN = nN_; nwg = nM * nN; G = G_; c = c_; }
    __device__ bool next(int i, Unit& u) const {
        const long L = (long)i * G + c; if (L >= nwg) return false;
        int wgid = (int)L; { const int q = nwg / NXCD, r = nwg % NXCD, xcd = wgid % NXCD, off = wgid / NXCD; wgid = (xcd < r ? xcd * (q + 1) : r * (q + 1) + (xcd - r) * q) + off; }
        const int nig = WGM * nN, gid = wgid / nig, fm = gid * WGM, gsz = (nM - fm) < WGM ? (nM - fm) : WGM;
        u.pm = fm + ((wgid % nig) % gsz); u.pn = (wgid % nig) / gsz; u.aux = 0; return true;
    }
};

struct RowOrder {
    int nN, nwg, G, c, q;
    __device__ void init(int nM_, int nN_, int G_, int c_) { nN = nN_; nwg = nM_ * nN_; G = G_; c = c_; q = nwg / G_; }
    __device__ bool next(int i, Unit& u) const {
        const int L = (i < q) ? c * q + i : G * q + (i - q) * G + c; if (L >= nwg) return false;
        u.pm = L / nN; u.pn = L % nN; u.aux = 0; return true;
    }
};

template <bool I8> struct AccVec { typedef f32x4 type; };
template <> struct AccVec<true> { typedef i32x4 type; };
template <bool I8 = false, class Prob, class Sched, class Epi>
__device__ __forceinline__ void gemm_phase(LAS unsigned char* lds, const Prob& P, const Sched& S, const Epi& E) {
    const int tid = opq_v((int)threadIdx.x), wid = __builtin_amdgcn_readfirstlane(tid >> 6), lane = tid & 63, wr = wid >> 2, wc = wid & 3, fr = lane & 15, fq = lane >> 4;
    typedef typename AccVec<I8>::type accv_t;
    const int K = P.K, nt = K / (I8 ? 2 * BK : BK);
    unsigned voffA[2], voffB[2];
#pragma unroll
    for (int i = 0; i < 2; ++i) { int R, C; stage_rc(tid * 16 + i * 8192, R, C); voffA[i] = (unsigned)R * P.lda + (unsigned)C * 2u; voffB[i] = (unsigned)R * P.ldb + (unsigned)C * 2u; }
    const size_t kstep = (size_t)(BK * 2);
    const size_t hstepA = (size_t)HALF * P.lda, hstepB = (size_t)HALF * P.ldb;
    const unsigned ldsw = (unsigned)wid * 1024u;
    const int aoff = lds_byte(wr * 64 + fr, fq * 8), boff = lds_byte(wc * 32 + fr, fq * 8);
#define PG8_SA(b, h) (((b) * 2 + (h)) * HTB)
#define PG8_SB(b, h) ((4 + (b) * 2 + (h)) * HTB)
#define PG8_STAGE(bufoff, gbase, voff) do { _Pragma("unroll") for (int _i = 0; _i < 2; ++_i) \
        __builtin_amdgcn_global_load_lds((const unsigned*)((const char*)(gbase) + (voff)[_i]), (LAS unsigned*)(lds + (bufoff) + ldsw + _i * 8192), 16, 0, 0); } while (0)
#define PG8_LDA(dst, b, h) do { _Pragma("unroll") for (int m = 0; m < 4; ++m) _Pragma("unroll") for (int k = 0; k < 2; ++k) dst[m][k] = *(const LAS bf16x8*)(lds + PG8_SA(b, h) + aoff + m * 2048 + k * 1024); } while (0)
#define PG8_LDB(dst, b, h) do { _Pragma("unroll") for (int n = 0; n < 2; ++n) _Pragma("unroll") for (int k = 0; k < 2; ++k) dst[n][k] = *(const LAS bf16x8*)(lds + PG8_SB(b, h) + boff + n * 2048 + k * 1024); } while (0)
#define PG8_MMA(ai, bj, At, Bt) do { __builtin_amdgcn_s_setprio(1); _Pragma("unroll") for (int m = 0; m < 4; ++m) _Pragma("unroll") for (int n = 0; n < 2; ++n) _Pragma("unroll") for (int k = 0; k < 2; ++k) \
        { if constexpr (I8) acc[ai][bj][m][n] = __builtin_amdgcn_mfma_i32_16x16x64_i8(__builtin_bit_cast(i32x4, Bt[n][k]), __builtin_bit_cast(i32x4, At[m][k]), acc[ai][bj][m][n], 0, 0, 0); \
          else acc[ai][bj][m][n] = __builtin_amdgcn_mfma_f32_16x16x32_bf16(Bt[n][k], At[m][k], acc[ai][bj][m][n], 0, 0, 0); } __builtin_amdgcn_s_setprio(0); } while (0)
#define PG8_WAIT_V(n) asm volatile("s_waitcnt vmcnt(" #n ")" ::: "memory")
#define PG8_WAIT_L(n) asm volatile("s_waitcnt lgkmcnt(" #n ")" ::: "memory")
#define PG8_BAR __builtin_amdgcn_s_barrier()
#define PG8_SCHED __builtin_amdgcn_sched_barrier(0)
    Unit cur, nxt; int ui = 0;
    if (!S.next(0, cur)) return;
    accv_t acc[2][2][4][2];
#pragma unroll
    for (int a = 0; a < 2; ++a)
#pragma unroll
        for (int b = 0; b < 2; ++b)
#pragma unroll
            for (int m = 0; m < 4; ++m)
#pragma unroll
                for (int n = 0; n < 2; ++n) acc[a][b][m][n] = accv_t{};
    bf16x8 At[4][2], B0[2][2], B1[2][2];
    const char* cA = P.a_ptr(cur); const char* cB = P.b_ptr(cur);
    int eslot = 0;
    E.stage(lds + ESC_OFF, cur, wid, lane);
    PG8_STAGE(PG8_SB(0, 0), cB, voffB); PG8_STAGE(PG8_SB(0, 1), cB + hstepB, voffB); PG8_STAGE(PG8_SA(0, 0), cA, voffA); PG8_STAGE(PG8_SA(0, 1), cA + hstepA, voffA);
    if (wr == 1) PG8_BAR;
    PG8_WAIT_V(2); PG8_BAR;
    PG8_STAGE(PG8_SB(1, 0), cB + kstep, voffB); PG8_STAGE(PG8_SA(1, 0), cA + kstep, voffA); PG8_STAGE(PG8_SB(1, 1), cB + hstepB + kstep, voffB);
    PG8_WAIT_V(6); PG8_BAR;
    for (;;) {
        const bool has_next = S.next(ui + 1, nxt);
        const char* nA = has_next ? P.a_ptr(nxt) : cA; const char* nB = has_next ? P.b_ptr(nxt) : cB;
        for (int t = 0; t < nt; t += 2) {
            if constexpr (Epi::MID) { if (t == 8 || t == 16) E.mid(acc, cur, t >> 3, wr, wc, fr, fq); }
            const bool last = (t == nt - 2);
            if (last && has_next) E.stage(lds + ESC_OFF + (eslot ^ 1) * ESC_SLOT, nxt, wid, lane);
            const char* a1 = cA + (size_t)(t + 1) * kstep;
            const char* a2 = last ? nA : cA + (size_t)(t + 2) * kstep; const char* b2 = last ? nB : cB + (size_t)(t + 2) * kstep;
            const char* a3 = a2 + kstep; const char* b3 = b2 + kstep;
            PG8_LDB(B0, 0, 0); PG8_LDB(B1, 0, 1); PG8_SCHED; PG8_LDA(At, 0, 0); PG8_STAGE(PG8_SA(1, 1), a1 + hstepA, voffA);
            PG8_WAIT_V(8); PG8_WAIT_L(0); PG8_BAR; PG8_MMA(0, 0, At, B0); PG8_MMA(0, 1, At, B1); PG8_BAR; PG8_SCHED;
            PG8_LDA(At, 0, 1); PG8_STAGE(PG8_SB(0, 0), b2, voffB); PG8_STAGE(PG8_SB(0, 1), b2 + hstepB, voffB); PG8_STAGE(PG8_SA(0, 0), a2, voffA);
            PG8_WAIT_V(8); PG8_WAIT_L(0); PG8_BAR; PG8_MMA(1, 0, At, B0); PG8_MMA(1, 1, At, B1); PG8_BAR; PG8_SCHED;
            PG8_LDB(B0, 1, 0); PG8_LDB(B1, 1, 1); PG8_SCHED; PG8_LDA(At, 1, 0); PG8_STAGE(PG8_SA(0, 1), a2 + hstepA, voffA);
            PG8_WAIT_V(8); PG8_WAIT_L(0); PG8_BAR; PG8_MMA(0, 0, At, B0); PG8_MMA(0, 1, At, B1); PG8_BAR; PG8_SCHED;
            PG8_LDA(At, 1, 1); PG8_STAGE(PG8_SB(1, 0), b3, voffB); PG8_STAGE(PG8_SB(1, 1), b3 + hstepB, voffB); PG8_STAGE(PG8_SA(1, 0), a3, voffA);
            PG8_WAIT_V(8); PG8_WAIT_L(0); PG8_BAR; PG8_MMA(1, 0, At, B0); PG8_MMA(1, 1, At, B1); PG8_BAR; PG8_SCHED;
        }
        if (wr == 0) PG8_BAR;
        E(acc, cur, wr, wc, fr, fq, lds + ESC_OFF + eslot * ESC_SLOT);
        if (!has_next) break;
#pragma unroll
        for (int a = 0; a < 2; ++a)
#pragma unroll
            for (int b = 0; b < 2; ++b)
#pragma unroll
                for (int m = 0; m < 4; ++m)
#pragma unroll
                    for (int n = 0; n < 2; ++n) acc[a][b][m][n] = accv_t{};
        cur = nxt; cA = nA; cB = nB; ++ui; eslot ^= 1;
        if (wr == 1) PG8_BAR;
    }
    PG8_WAIT_V(0);
    PG8_BAR;
#undef PG8_SA
#undef PG8_SB
#undef PG8_STAGE
#undef PG8_LDA
#undef PG8_LDB
#undef PG8_MMA
#undef PG8_WAIT_V
#undef PG8_WAIT_L
#undef PG8_BAR
#undef PG8_SCHED
}
}

struct Frame {
    LAS unsigned char* lds;
    volatile LAS unsigned* MISC;
    gu32* ctl;
    unsigned char* ws;
    int tid, lane, wave, vcu, G;
    const float* const* in; float* out;
};
enum { I_X = 0, I_MEM, I_POS, I_GMIX, I_WIN, I_GQ, I_WUQ, I_GKV, I_WUKV, I_SINK, I_WMKV, I_WBR, I_WOUT, I_GFFN, I_WGD, I_WUD, I_WDD, I_WR, I_WGE, I_WUE, I_WDE, I_GMEM, I_GFIN };

__device__ __forceinline__ int sem_plain(int g) { return (g & ~31) + 8 * ((g >> 2) & 3) + 4 * ((g >> 4) & 1) + (g & 3); }
__device__ __forceinline__ int sem_rot64(int g) { return (g & ~63) + 32 * ((g >> 4) & 1) + 16 * ((g >> 5) & 1) + 4 * ((g >> 2) & 3) + (g & 3); }
__device__ __forceinline__ int inproj_src(int n) {
    const int pn = n >> 8, c = n & 255;
    if (pn < 2) return pn * 256 + sem_rot64(c);
    if (pn == 2) return c < 128 ? 512 + sem_rot64(c) : 640 + sem_plain(c - 128);
    if (pn == 3) return 768 + sem_plain(c);
    if (pn == 4) return c < 128 ? 1024 + sem_plain(c) : (c < 160 ? 1152 + (c - 128) : -1);
    if (pn < 7) return 1184 + (pn - 5) * 256 + sem_plain(c);
    return 1696 + (pn - 7) * 256 + sem_plain(c);
}

struct MapInproj { const float* W; __device__ __forceinline__ float load(int k, int n) const { const int s = inproj_src(n); return s >= 0 ? W[(size_t)k * INW + s] : 0.f; }
    __device__ __forceinline__ f32x4 load4(int k, int n) const { const int s = inproj_src(n); return s >= 0 ? *(const f32x4*)(W + (size_t)k * INW + s) : (f32x4){0.f, 0.f, 0.f, 0.f}; } };
struct MapUp { const float *Wq, *Wkv, *gq, *gkv;
    __device__ __forceinline__ f32x4 load4(int k, int n) const {
        if (n < 768) { if (k >= 256) return (f32x4){0.f, 0.f, 0.f, 0.f}; const int gg = n >> 5; const int s = (gg % 3 == 2) ? n : sem_plain(n); return *(const f32x4*)(Wq + (size_t)k * 768 + s) * gq[k]; }
        if (k < 256) return (f32x4){0.f, 0.f, 0.f, 0.f}; const int s = sem_plain(n - 768); return *(const f32x4*)(Wkv + (size_t)(k - 256) * 1024 + s) * gkv[k - 256]; }
    __device__ __forceinline__ float load(int k, int n) const {
        if (n < 768) { if (k >= 256) return 0.f; const int gg = n >> 5; const int s = (gg % 3 == 2) ? n : sem_plain(n); return gq[k] * Wq[(size_t)k * 768 + s]; }
        if (k < 256) return 0.f; const int s = sem_plain(n - 768); return gkv[k - 256] * Wkv[(size_t)(k - 256) * 1024 + s]; } };
struct MapPlain { const float* W; int ldw; __device__ __forceinline__ float load(int k, int n) const { return W[(size_t)k * ldw + sem_plain(n)]; }
    __device__ __forceinline__ f32x4 load4(int k, int n) const { return *(const f32x4*)(W + (size_t)k * ldw + sem_plain(n)); } };
struct MapNat { const float* W; int ldw; __device__ __forceinline__ float load(int k, int n) const { return W[(size_t)k * ldw + n]; }
    __device__ __forceinline__ f32x4 load4(int k, int n) const { return *(const f32x4*)(W + (size_t)k * ldw + n); } };
struct MapBr { const float* W;
    __device__ __forceinline__ float load(int k, int n) const { return W[(size_t)k * DM + sem_plain(n)]; }
    __device__ __forceinline__ f32x4 load4(int k, int n) const { return *(const f32x4*)(W + (size_t)k * DM + sem_plain(n)); } };
struct MapMemkv { const float* W; __device__ __forceinline__ float load(int k, int n) const { const int l = n >> 10, c = n & 1023; return W[((size_t)l * DM + k) * 1024 + sem_plain(c)]; }
    __device__ __forceinline__ f32x4 load4(int k, int n) const { const int l = n >> 10, c = n & 1023; return *(const f32x4*)(W + ((size_t)l * DM + k) * 1024 + sem_plain(c)); } };
struct MapGU { const float *Wg, *Wu; __device__ __forceinline__ float load(int k, int n) const { const int pn = n >> 8, c = n & 255; const int ch = 128 * pn + sem_plain(c & 127);
    const unsigned long long a = (unsigned long long)Wg, b = (unsigned long long)Wu, w = a ^ ((a ^ b) & (0ull - (unsigned long long)(c >> 7))); return ((const float*)w)[(size_t)k * DFF + ch]; }
    __device__ __forceinline__ f32x4 load4(int k, int n) const { const int pn = n >> 8, c = n & 255; const int ch = 128 * pn + sem_plain(c & 127);
        const unsigned long long a = (unsigned long long)Wg, b = (unsigned long long)Wu, w = a ^ ((a ^ b) & (0ull - (unsigned long long)(c >> 7))); return *(const f32x4*)((const float*)w + (size_t)k * DFF + ch); } };

template <class M> __device__ __forceinline__ void prep_item(const M& m, bf16_t* dst, int Kd, int nblk, LAS float* scr, int item, int lane) {
    const int kb = item / nblk, nb = item % nblk, k0 = 64 * kb, n0 = 32 * nb;
#pragma unroll 8
    for (int i = 0; i < 32; ++i) { const int kk = 2 * i + (lane >> 5); scr[kk * 33 + (lane & 31)] = m.load(k0 + kk, n0 + (lane & 31)); }
    LDS_WAIT(); asm volatile("" ::: "memory");
    const int c = lane & 7;
#pragma unroll
    for (int j = 0; j < 4; ++j) { const int n = (lane >> 3) + 8 * j; const LAS float* s = scr + (8 * c) * 33 + n;
        u32x4 o; o.x = pk2(s[0 * 33], s[1 * 33]); o.y = pk2(s[2 * 33], s[3 * 33]); o.z = pk2(s[4 * 33], s[5 * 33]); o.w = pk2(s[6 * 33], s[7 * 33]);
        *(u32x4*)(dst + (size_t)(n0 + n) * Kd + k0 + 8 * c) = o; }
    LDS_WAIT(); asm volatile("" ::: "memory");
}
template <class M> __device__ __forceinline__ void prep_tile(const M& m, bf16_t* dst, int Kd, int nblk, LAS unsigned char* tile, int item, int lane) {
    const int kb = item / nblk, nb = item % nblk, k0 = 128 * kb, n0 = 32 * nb, ng = lane & 7, kr = lane >> 3;
    f32x4 v[16];
#pragma unroll
    for (int i = 0; i < 16; ++i) v[i] = m.load4(k0 + 8 * i + kr, n0 + 4 * ng);
#pragma unroll
    for (int i = 0; i < 16; ++i)
#pragma unroll
        for (int c = 0; c < 4; ++c) *(LAS unsigned short*)(tile + (4 * ng + c) * 272 + (8 * i + kr) * 2) = (unsigned short)f2bf(v[i][c]);
    LDS_WAIT(); asm volatile("" ::: "memory");
#pragma unroll
    for (int j = 0; j < 8; ++j) { const int p = lane + 64 * j, n = p >> 4, kc = p & 15;
        *(u32x4*)(dst + (size_t)(n0 + n) * Kd + k0 + 8 * kc) = *(const LAS u32x4*)(tile + n * 272 + 16 * kc); }
    LDS_WAIT(); asm volatile("" ::: "memory");
}
template <class M> __device__ __forceinline__ void prep_matrix(Frame& F, const M& m, bf16_t* dst, int N, int K) {
    LAS unsigned char* tile = F.lds + F.wave * 16384;
    const int gw = F.vcu * NWAVES + F.wave, NGW = F.G * NWAVES, nblk = N / 32, nitems = (K / 128) * nblk;
    for (int it = gw; it < nitems; it += NGW) prep_tile(m, dst, K, nblk, tile, it, F.lane);
}

template <class M> __device__ __forceinline__ void prep_strip_i8(Frame& F, const M& m, signed char* dst, float* scl, int strip) {
    const int lane = F.lane, w = F.wave, n0 = strip * 32, k0 = w * 128, ng = lane & 7, kr = lane >> 3;
    LAS unsigned char* tile = F.lds + w * 16384;
    LAS float* amt = (LAS float*)(F.lds + LDSCTL_OFF + 2048);
    f32x4 v[16];
#pragma unroll
    for (int i = 0; i < 16; ++i) v[i] = m.load4(k0 + 8 * i + kr, n0 + 4 * ng);
    f32x4 am = __builtin_elementwise_abs(v[0]);
#pragma unroll
    for (int i = 1; i < 16; ++i) am = __builtin_elementwise_max(am, __builtin_elementwise_abs(v[i]));
#pragma unroll
    for (int c = 0; c < 4; ++c) { float a = am[c]; a = fmaxf(a, __shfl_xor(a, 8)); a = fmaxf(a, __shfl_xor(a, 16)); a = fmaxf(a, __shfl_xor(a, 32)); am[c] = a; }
    if (kr == 0) *(LAS f32x4*)(amt + w * 32 + 4 * ng) = am;
    __syncthreads();
    f32x4 cm = *(const LAS f32x4*)(amt + 4 * ng);
#pragma unroll
    for (int ww = 1; ww < 8; ++ww) cm = __builtin_elementwise_max(cm, *(const LAS f32x4*)(amt + ww * 32 + 4 * ng));
    f32x4 inv;
#pragma unroll
    for (int c = 0; c < 4; ++c) inv[c] = cm[c] > 0.f ? 127.0f / cm[c] : 0.f;
    if (w == 0 && kr == 0) *(f32x4*)(scl + n0 + 4 * ng) = cm * (1.0f / 127.0f);
#pragma unroll
    for (int i = 0; i < 16; ++i)
#pragma unroll
        for (int c = 0; c < 4; ++c) tile[(4 * ng + c) * 144 + 8 * i + kr] = (unsigned char)(signed char)__float2int_rn(v[i][c] * inv[c]);
    LDS_WAIT(); asm volatile("" ::: "memory");
#pragma unroll
    for (int j = 0; j < 4; ++j) { const int p = lane + 64 * j, n = p >> 3, kc = p & 7;
        *(u32x4*)(dst + (size_t)(n0 + n) * DM + k0 + 16 * kc) = *(const LAS u32x4*)(tile + n * 144 + 16 * kc); }
    LDS_WAIT();
    __syncthreads();
}
__device__ __forceinline__ bf16_t* wmix(Frame& F, int l, size_t off) { return (bf16_t*)(F.ws + WS_WMIX + (size_t)l * WL_STRIDE + off); }

__device__ __forceinline__ void prep_mixer_weights(Frame& F) {
    for (int l = 0; l < DEPTH; ++l) {
        { MapInproj m{F.in[I_WIN] + (size_t)l * DM * INW}; for (int s = F.vcu; s < NT_IN * 8; s += F.G) prep_strip_i8(F, m, (signed char*)wmix(F, l, WL_IN), (float*)(F.ws + WS_MISC + MS_WSIN) + l * NT_IN * 256, s); }
        { MapUp m{F.in[I_WUQ] + (size_t)l * 256 * 768, F.in[I_WUKV] + (size_t)l * 128 * 1024, F.in[I_GQ] + l * 256, F.in[I_GKV] + l * 128}; prep_matrix(F, m, wmix(F, l, WL_UP), UPN, UPK); }
        { MapBr m{F.in[I_WBR] + (size_t)l * 3 * 512 * DM}; prep_matrix(F, m, wmix(F, l, WL_BR), DM, 1536); }
        { MapNat m{F.in[I_WOUT] + (size_t)l * DM * DM, DM}; prep_matrix(F, m, wmix(F, l, WL_OUT), DM, DM); }
    }
    { MapMemkv m{F.in[I_WMKV]}; prep_matrix(F, m, (bf16_t*)(F.ws + WS_WMKV), 4096, DM); }
}
__device__ __forceinline__ void prep_ffn_weights(Frame& F, int l) {
    const int i = l >> 1; const bool moe = (l & 1) != 0;
    LAS float* scr = (LAS float*)(F.lds + F.wave * 16384);
    const int gw = F.vcu * NWAVES + F.wave, NGW = F.G * NWAVES;
    constexpr int IGU = (DM / 64) * (2 * DFF / 32), ID = (DFF / 64) * (DM / 32), NSTRIP = 2 * DFF / 32;
    const int ne = moe ? NE : 1;
    const float* Wg = moe ? F.in[I_WGE] : F.in[I_WGD]; const float* Wu = moe ? F.in[I_WUE] : F.in[I_WUD]; const float* Wd = moe ? F.in[I_WDE] : F.in[I_WDD];
    if (GU_I8(l)) {
        for (int s = F.vcu; s < ne * NSTRIP; s += F.G) { const int e = s / NSTRIP, ss = s % NSTRIP; const size_t eo = ((size_t)i * ne + e) * DM * DFF;
            MapGU m{Wg + eo, Wu + eo}; prep_strip_i8(F, m, (signed char*)(F.ws + WS_WFFN + (size_t)e * WF_STRIDE), (float*)(F.ws + WS_MISC + MS_WSGU) + e * 2 * DFF, ss); }
    } else {
        for (int it = gw; it < ne * IGU; it += NGW) { const int e = it / IGU, r = it % IGU; const size_t eo = ((size_t)i * ne + e) * DM * DFF;
            MapGU m{Wg + eo, Wu + eo}; prep_item(m, (bf16_t*)(F.ws + WS_WFFN + (size_t)e * WF_STRIDE), DM, 2 * DFF / 32, scr, r, F.lane); }
    }
    constexpr int IDT = (DFF / 128) * (DM / 32);
    for (int it = gw; it < ne * IDT; it += NGW) { const int e = it / IDT, r = it % IDT; const size_t eo = ((size_t)i * ne + e) * DM * DFF;
        MapNat m{Wd + eo, DM}; prep_tile(m, (bf16_t*)(F.ws + WS_WFFN + (size_t)e * WF_STRIDE + WF_D), DFF, DM / 32, F.lds + F.wave * 16384, r, F.lane); }
}

struct RowV { f32x4 v[4]; };
__device__ __forceinline__ void row_load(RowV& r, const float* p, int lane) { const f32x4* x = (const f32x4*)p + lane;
#pragma unroll
    for (int j = 0; j < 4; ++j) r.v[j] = x[64 * j]; }
__device__ __forceinline__ void row_store(const RowV& r, float* p, int lane) { f32x4* x = (f32x4*)p + lane;
#pragma unroll
    for (int j = 0; j < 4; ++j) x[64 * j] = r.v[j]; }
__device__ __forceinline__ void row_add_bf16(RowV& r, const bf16_t* p, float w, int lane) { const u32x2* x = (const u32x2*)p + lane;
#pragma unroll
    for (int j = 0; j < 4; ++j) { const u32x2 q = x[64 * j]; r.v[j].x += w * bflo(q.x); r.v[j].y += w * bfhi(q.x); r.v[j].z += w * bflo(q.y); r.v[j].w += w * bfhi(q.y); } }
__device__ __forceinline__ float row_rstd(const RowV& r) { float s = 0.f;
#pragma unroll
    for (int j = 0; j < 4; ++j) s += (r.v[j].x * r.v[j].x + r.v[j].y * r.v[j].y) + (r.v[j].z * r.v[j].z + r.v[j].w * r.v[j].w);
    return 1.0f / sqrtf(wave_sum(s) * (1.0f / DM) + EPS); }
__device__ __forceinline__ void row_scale(RowV& r, float rstd, const float* g, int lane) { const f32x4* gg = (const f32x4*)g + lane;
#pragma unroll
    for (int j = 0; j < 4; ++j) r.v[j] = r.v[j] * rstd * gg[64 * j]; }
__device__ __forceinline__ void row_store_bf16(const RowV& r, bf16_t* p, int lane) { u32x2* o = (u32x2*)p + lane;
#pragma unroll
    for (int j = 0; j < 4; ++j) { u32x2 w; w.x = pk2(r.v[j].x, r.v[j].y); w.y = pk2(r.v[j].z, r.v[j].w); o[64 * j] = w; } }

__device__ __forceinline__ float row_store_i8(const RowV& r, signed char* p, int lane) {
    float am = 0.f;
#pragma unroll
    for (int j = 0; j < 4; ++j) am = fmaxf(am, fmaxf(fmaxf(fabsf(r.v[j].x), fabsf(r.v[j].y)), fmaxf(fabsf(r.v[j].z), fabsf(r.v[j].w))));
#pragma unroll
    for (int o = 1; o < 64; o <<= 1) am = fmaxf(am, __shfl_xor(am, o));
    const float inv = am > 0.f ? 127.0f / am : 0.f; unsigned* o4 = (unsigned*)p + lane;
#pragma unroll
    for (int j = 0; j < 4; ++j) { const unsigned a = (unsigned)__float2int_rn(r.v[j].x * inv) & 255u, b = (unsigned)__float2int_rn(r.v[j].y * inv) & 255u, c = (unsigned)__float2int_rn(r.v[j].z * inv) & 255u, d = (unsigned)__float2int_rn(r.v[j].w * inv) & 255u;
        o4[64 * j] = a | (b << 8) | (c << 16) | (d << 24); }
    return am * (1.0f / 127.0f);
}
__device__ __forceinline__ void row_combine(Frame& F, RowV& r, int t) {
    const int* sl = (const int*)(F.ws + WS_MISC + MS_SLOT) + 2 * t; const float* tw = (const float*)(F.ws + WS_MISC + MS_TOKW) + 2 * t;
    const bf16_t* Y = (const bf16_t*)(F.ws + WS_R + R_YOUT);
    const int s0 = sl[0], s1 = sl[1]; const float w0 = tw[0], w1 = tw[1];
    row_add_bf16(r, Y + (size_t)s0 * DM, w0, F.lane); row_add_bf16(r, Y + (size_t)s1 * DM, w1, F.lane);
}

__device__ __forceinline__ void norm_phase(Frame& F, const float* src, float* X, const float* g, bool combine, bool out_i8) {
    bf16_t* H = (bf16_t*)(F.ws + WS_H); signed char* Hq = (signed char*)(F.ws + WS_H); float* hsc = (float*)(F.ws + WS_MISC + MS_HSC);
    const int gw = F.vcu * NWAVES + F.wave, NGW = F.G * NWAVES;
    for (int t = gw; t < T; t += 2 * NGW) {
        const int t2 = t + NGW;
        RowV r, q; row_load(r, src + (size_t)t * DM, F.lane); row_load(q, src + (size_t)t2 * DM, F.lane);
        if (combine) { row_combine(F, r, t); row_combine(F, q, t2); row_store(r, X + (size_t)t * DM, F.lane); row_store(q, X + (size_t)t2 * DM, F.lane); }
        const float rstd = row_rstd(r), qstd = row_rstd(q); row_scale(r, rstd, g, F.lane); row_scale(q, qstd, g, F.lane);
        if (out_i8) { const float sc = row_store_i8(r, Hq + (size_t)t * DM, F.lane), sq = row_store_i8(q, Hq + (size_t)t2 * DM, F.lane); if (F.lane == 0) { hsc[t] = sc; hsc[t2] = sq; } }
        else { row_store_bf16(r, H + (size_t)t * DM, F.lane); row_store_bf16(q, H + (size_t)t2 * DM, F.lane); }
    }
}
__device__ __forceinline__ void final_norm_phase(Frame& F, float* X, const float* g, bool combine) {
    const int gw = F.vcu * NWAVES + F.wave, NGW = F.G * NWAVES;
    for (int t = gw; t < T; t += 2 * NGW) {
        const int t2 = t + NGW;
        RowV r, q; row_load(r, X + (size_t)t * DM, F.lane); row_load(q, X + (size_t)t2 * DM, F.lane);
        if (combine) { row_combine(F, r, t); row_combine(F, q, t2); }
        const float rstd = row_rstd(r), qstd = row_rstd(q); row_scale(r, rstd, g, F.lane); row_scale(q, qstd, g, F.lane);
        row_store(r, X + (size_t)t * DM, F.lane); row_store(q, X + (size_t)t2 * DM, F.lane);
    }
}
__device__ __forceinline__ void memnorm_phase(Frame& F) {
    bf16_t* MN = (bf16_t*)(F.ws + WS_MEMN);
    const int gw = F.vcu * NWAVES + F.wave, NGW = F.G * NWAVES;
    for (int t = gw; t < NB * MEML; t += NGW) {
        RowV r; row_load(r, F.in[I_MEM] + (size_t)t * DM, F.lane);
        const float rstd = row_rstd(r); row_scale(r, rstd, F.in[I_GMEM], F.lane);
        row_store_bf16(r, MN + (size_t)t * DM, F.lane);
    }
}

__device__ __forceinline__ void norm_router_phase(Frame& F, const float* X, const float* g, const float* Wr  , bool out_i8) {
    bf16_t* H = (bf16_t*)(F.ws + WS_H); signed char* Hq = (signed char*)(F.ws + WS_H); float* hsc = (float*)(F.ws + WS_MISC + MS_HSC);
    int* toke = (int*)(F.ws + WS_MISC + MS_TOKE); float* tokw = (float*)(F.ws + WS_MISC + MS_TOKW); int* cntg = (int*)(F.ws + WS_MISC + MS_CNT);
    volatile LAS int* hist = (volatile LAS int*)(F.lds + LDSCTL_OFF + 1024);
    for (int c = F.vcu; c < T / 128; c += F.G) {
        if (F.tid < 8) hist[F.tid] = 0;
        __syncthreads();
        for (int q = 0; q < 16; ++q) {
            const int t = c * 128 + F.wave * 16 + q;
            RowV r; row_load(r, X + (size_t)t * DM, F.lane);
            const float rstd = row_rstd(r); row_scale(r, rstd, g, F.lane);
            if (out_i8) { const float sc = row_store_i8(r, Hq + (size_t)t * DM, F.lane); if (F.lane == 0) hsc[t] = sc; }
            else row_store_bf16(r, H + (size_t)t * DM, F.lane);
            float lg[8];
#pragma unroll
            for (int e = 0; e < 8; ++e) lg[e] = 0.f;
#pragma unroll
            for (int j = 0; j < 4; ++j) {
#pragma unroll
                for (int k = 0; k < 4; ++k) { const int d = 256 * j + 4 * F.lane + k; const f32x4 wa = *(const f32x4*)(Wr + (size_t)d * 8), wb = *(const f32x4*)(Wr + (size_t)d * 8 + 4); const float x = r.v[j][k];
                    lg[0] += x * wa.x; lg[1] += x * wa.y; lg[2] += x * wa.z; lg[3] += x * wa.w; lg[4] += x * wb.x; lg[5] += x * wb.y; lg[6] += x * wb.z; lg[7] += x * wb.w; } }
#pragma unroll
            for (int e = 0; e < 8; ++e) lg[e] = wave_sum(lg[e]);
            int e0 = 0; float v0 = lg[0];
#pragma unroll
            for (int e = 1; e < 8; ++e) if (lg[e] > v0) { v0 = lg[e]; e0 = e; }
            int e1 = -1; float v1 = -INFINITY;
#pragma unroll
            for (int e = 0; e < 8; ++e) if (e != e0 && lg[e] > v1) { v1 = lg[e]; e1 = e; }
            if (F.lane == 0) {
                const float w0 = 1.0f / (1.0f + __expf(v1 - v0));
                toke[2 * t] = e0; toke[2 * t + 1] = e1; tokw[2 * t] = w0; tokw[2 * t + 1] = 1.0f - w0;
                __hip_atomic_fetch_add((LAS int*)&hist[e0], 1, __ATOMIC_RELAXED, __HIP_MEMORY_SCOPE_WORKGROUP); __hip_atomic_fetch_add((LAS int*)&hist[e1], 1, __ATOMIC_RELAXED, __HIP_MEMORY_SCOPE_WORKGROUP);
            }
        }
        __syncthreads();
        if (F.tid < 8) cntg[c * 8 + F.tid] = hist[F.tid];
        __syncthreads();
    }
}
__device__ __forceinline__ void moe_assign_phase(Frame& F, bool i8) {
    const bf16_t* H = (const bf16_t*)(F.ws + WS_H); bf16_t* AS = (bf16_t*)(F.ws + WS_R + R_ASORT);
    const float* hsc = (const float*)(F.ws + WS_MISC + MS_HSC); float* asc = (float*)(F.ws + WS_MISC + MS_ASC);
    const int* toke = (const int*)(F.ws + WS_MISC + MS_TOKE); int* slot = (int*)(F.ws + WS_MISC + MS_SLOT); const int* cntg = (const int*)(F.ws + WS_MISC + MS_CNT);
    int* texp = (int*)(F.ws + WS_MISC + MS_TEXP);
    volatile LAS int* tot = (volatile LAS int*)(F.lds + LDSCTL_OFF + 1024);
    volatile LAS int* pre = tot + 8;
    volatile LAS int* wcnt = tot + 16;
    for (int c = F.vcu; c < T / 128; c += F.G) {
        if (F.tid < 16) tot[F.tid] = 0;
        __syncthreads();
        { const int cc = F.tid >> 1, h = F.tid & 1; const i32x4 v = *(const i32x4*)(cntg + cc * 8 + 4 * h);
#pragma unroll
          for (int k = 0; k < 4; ++k) { __hip_atomic_fetch_add((LAS int*)&tot[4 * h + k], v[k], __ATOMIC_RELAXED, __HIP_MEMORY_SCOPE_WORKGROUP); if (cc < c) __hip_atomic_fetch_add((LAS int*)&pre[4 * h + k], v[k], __ATOMIC_RELAXED, __HIP_MEMORY_SCOPE_WORKGROUP); } }
        const int t = c * 128 + F.wave * 16 + ((F.lane & 31) >> 1);
        const int my_e = (F.lane < 32) ? toke[2 * t + (F.lane & 1)] : -1;
        int rank = 0;
#pragma unroll
        for (int e = 0; e < 8; ++e) { const unsigned long long m = __ballot(my_e == e); if (my_e == e) rank = __popcll(m & ((1ull << F.lane) - 1ull)); if (F.lane == 0) wcnt[F.wave * 8 + e] = __popcll(m); }
        __syncthreads();
        int myslot = 0;
        if (F.lane < 32) {
            int ts = 0;
#pragma unroll
            for (int e = 0; e < 8; ++e) ts += (e < my_e) ? ((tot[e] + 255) >> 8) : 0;
            int wp = 0; for (int w = 0; w < F.wave; ++w) wp += wcnt[w * 8 + my_e];
            myslot = ts * 256 + pre[my_e] + wp + rank;
            slot[2 * t + (F.lane & 1)] = myslot;
        }
        if (c == 0 && F.tid == 0) { int ts = 0; for (int e = 0; e < 8; ++e) { const int n = (tot[e] + 255) >> 8; for (int k = 0; k < n; ++k) texp[ts + k] = e; ts += n; } for (int k = ts; k < MAXRT; ++k) texp[k] = 0; texp[MAXRT] = ts; }
        if (i8) {
            const float myh = hsc[t];
#pragma unroll 1
            for (int a0 = 0; a0 < 32; a0 += 8) {
                u32x4 x[4];
#pragma unroll
                for (int k = 0; k < 4; ++k) x[k] = *((const u32x4*)((const signed char*)H + (size_t)(c * 128 + F.wave * 16 + ((a0 + 2 * k) >> 1)) * DM) + F.lane);
#pragma unroll
                for (int k = 0; k < 8; ++k) { const int s = __builtin_amdgcn_readlane(myslot, a0 + k); *((u32x4*)((signed char*)AS + (size_t)s * DM) + F.lane) = x[k >> 1]; }
            }
            if (F.lane < 32) asc[myslot] = myh;
        } else {
            for (int a = 0; a < 32; ++a) {
                const int s = __builtin_amdgcn_readlane(myslot, a); const int ta = c * 128 + F.wave * 16 + (a >> 1);
                const u32x4* srcp = (const u32x4*)(H + (size_t)ta * DM) + F.lane; u32x4* dstp = (u32x4*)(AS + (size_t)s * DM) + F.lane;
                const u32x4 x0 = srcp[0], x1 = srcp[64]; dstp[0] = x0; dstp[64] = x1; }
        }
        __syncthreads();
    }
}

using pg8::Unit;
typedef f32x4 AccT[2][2][4][2];

struct ProbSimple { int K; unsigned lda, ldb; const char* A; const char* B;
    __device__ __forceinline__ const char* a_ptr(const Unit& u) const { return A + (size_t)u.pm * 256 * lda; }
    __device__ __forceinline__ const char* b_ptr(const Unit& u) const { return B + (size_t)u.pn * 256 * ldb; } };
struct ProbBranch { int K; unsigned lda, ldb; const char* A; const char* B;
    __device__ __forceinline__ const char* a_ptr(const Unit& u) const { return A + (size_t)u.pm * 256 * lda + (size_t)u.aux * 1024; }
    __device__ __forceinline__ const char* b_ptr(const Unit& u) const { return B + (size_t)u.aux * ((size_t)DM * 512 * 2) + (size_t)u.pn * 256 * ldb; } };
struct ProbMoe { int K; unsigned lda, ldb; const char* A; const char* B; int a_lo;
    __device__ __forceinline__ const char* a_ptr(const Unit& u) const { return A + (size_t)(u.pm - a_lo) * 256 * lda; }
    __device__ __forceinline__ const char* b_ptr(const Unit& u) const { return B + (size_t)u.aux * WF_STRIDE + (size_t)u.pn * 256 * ldb; } };

struct SegOrder { pg8::StaticOrder base;
    __device__ bool next(int i, Unit& u) const { if (!base.next(i / 3, u)) return false; u.aux = i % 3; return true; } };
struct MoeRowOrder { pg8::RowOrder base; const int* texp;
    __device__ bool next(int i, Unit& u) const { if (!base.next(i, u)) return false; u.aux = texp[u.pm]; return true; } };
struct MoeOrder { pg8::StaticOrder base; int lo; const int* texp;
    __device__ bool next(int i, Unit& u) const { if (!base.next(i, u)) return false; u.pm += lo; u.aux = texp[u.pm]; return true; } };

__device__ __forceinline__ u32x4 pack8(const f32x4 a, const f32x4 b) { u32x4 w; w.x = cvtpk(a[0], a[1]); w.y = cvtpk(a[2], a[3]); w.z = cvtpk(b[0], b[1]); w.w = cvtpk(b[2], b[3]); return w; }
__device__ __forceinline__ u32x2 pack4(const f32x4 a) { u32x2 w; w.x = cvtpk(a[0], a[1]); w.y = cvtpk(a[2], a[3]); return w; }

struct EpiNoStage { __device__ __forceinline__ void stage(LAS unsigned char*, const Unit&, int, int) const {} };
__device__ __forceinline__ void stage1k(const void* src, LAS unsigned char* dst, int lane) { __builtin_amdgcn_global_load_lds((const unsigned*)((const char*)src + lane * 16), (LAS unsigned*)dst, 16, 0, 0); }
__device__ __forceinline__ f32x4 deq(const f32x4& a, float, const f32x4&) { return a; }
__device__ __forceinline__ f32x4 deq(const i32x4& a, float rs, const f32x4& cs) { return __builtin_convertvector(a, f32x4) * rs * cs; }
struct EpiInproj {
    static constexpr bool MID = false;
    bf16_t* P; bf16_t* G; float* ssq; const int* pos; const float* rsc; const float* csc;
    __device__ __forceinline__ void stage(LAS unsigned char* d, const Unit& u, int wid, int lane) const {
        if (wid == 0) { stage1k(rsc + u.pm * 256, d, lane); stage1k(csc + u.pn * 256, d + 1024, lane); stage1k(pos + u.pm * 256, d + 2048, lane); } }
    template <class AV> __device__ __forceinline__ void operator()(const AV (&acc)[2][2][4][2], const Unit& u, int wr, int wc, int fr, int fq, const LAS unsigned char* esc) const {
        const int pn = u.pn, row0 = u.pm * 256 + wr * 64 + fr;
        f32x4 cs[2][2];
#pragma unroll
        for (int bj = 0; bj < 2; ++bj)
#pragma unroll
            for (int n = 0; n < 2; ++n) cs[bj][n] = *(const LAS f32x4*)(esc + 1024 + (bj * 128 + wc * 32 + n * 16 + fq * 4) * 4);
        float rs8[2][4], pf8[2][4];
#pragma unroll
        for (int ai = 0; ai < 2; ++ai)
#pragma unroll
            for (int m = 0; m < 4; ++m) { const int rl = ai * 128 + wr * 64 + m * 16 + fr; rs8[ai][m] = *(const LAS float*)(esc + rl * 4); pf8[ai][m] = (float)*(const LAS int*)(esc + 2048 + rl * 4); }
#define DQ(ai, bj, m, n) deq(acc[ai][bj][m][n], rs, cs[bj][n])
        if (pn >= 7) {
#pragma unroll
            for (int ai = 0; ai < 2; ++ai)
#pragma unroll
                for (int m = 0; m < 4; ++m) { const int row = row0 + ai * 128 + m * 16; const float rs = rs8[ai][m];
#pragma unroll
                    for (int bj = 0; bj < 2; ++bj) { f32x4 a = DQ(ai, bj, m, 0), b = DQ(ai, bj, m, 1);
#pragma unroll
                        for (int j = 0; j < 4; ++j) { a[j] = fast_sigmoid(a[j]) * 255.0f; b[j] = fast_sigmoid(b[j]) * 255.0f; }
                        u32x2 w; w.x = (unsigned)__float2int_rn(a[0]) | ((unsigned)__float2int_rn(a[1]) << 8) | ((unsigned)__float2int_rn(a[2]) << 16) | ((unsigned)__float2int_rn(a[3]) << 24);
                        w.y = (unsigned)__float2int_rn(b[0]) | ((unsigned)__float2int_rn(b[1]) << 8) | ((unsigned)__float2int_rn(b[2]) << 16) | ((unsigned)__float2int_rn(b[3]) << 24);
                        *(u32x2*)((unsigned char*)G + (size_t)row * GW + (pn - 7) * 256 + bj * 128 + wc * 32 + fq * 8) = w; } }
        } else if (pn >= 5 || pn == 3) {
            const float sc = (pn == 3) ? 1.0f : C_M;
#pragma unroll
            for (int ai = 0; ai < 2; ++ai)
#pragma unroll
                for (int m = 0; m < 4; ++m) { const int row = row0 + ai * 128 + m * 16; const float rs = rs8[ai][m]; float s = 0.f;
#pragma unroll
                    for (int bj = 0; bj < 2; ++bj) { const f32x4 a = DQ(ai, bj, m, 0) * sc, b = DQ(ai, bj, m, 1) * sc;
                        s += (a[0] * a[0] + a[1] * a[1]) + (a[2] * a[2] + a[3] * a[3]) + (b[0] * b[0] + b[1] * b[1]) + (b[2] * b[2] + b[3] * b[3]);
                        *(u32x4*)(P + (size_t)row * PW + pn * 256 + bj * 128 + wc * 32 + fq * 8) = pack8(a, b); }
                    if (pn == 3) { s += __shfl_xor(s, 16); s += __shfl_xor(s, 32); if (fq == 0) ssq[(size_t)row * 8 + wc] = s; } }
        } else if (pn == 4) {
#pragma unroll
            for (int ai = 0; ai < 2; ++ai)
#pragma unroll
                for (int m = 0; m < 4; ++m) { const int row = row0 + ai * 128 + m * 16; const float rs = rs8[ai][m];
                    { const f32x4 a = DQ(ai, 0, m, 0), b = DQ(ai, 0, m, 1);
                      float s = (a[0] * a[0] + a[1] * a[1]) + (a[2] * a[2] + a[3] * a[3]) + (b[0] * b[0] + b[1] * b[1]) + (b[2] * b[2] + b[3] * b[3]);
                      *(u32x4*)(P + (size_t)row * PW + P_CKV + wc * 32 + fq * 8) = pack8(a, b);
                      s += __shfl_xor(s, 16); s += __shfl_xor(s, 32); if (fq == 0) ssq[(size_t)row * 8 + 4 + wc] = s; }
                    if (wc == 0) { const f32x4 x1 = DQ(ai, 1, m, 0), x2 = DQ(ai, 1, m, 1); const float pf = pf8[ai][m]; f32x4 o1, o2;
#pragma unroll
                        for (int j = 0; j < 4; ++j) { float c, s; rot_cs(pf, 2 * (4 * fq + j), c, s); o1[j] = x1[j] * c - x2[j] * s; o2[j] = x2[j] * c + x1[j] * s; }
                        *(u32x2*)(P + (size_t)row * PW + P_KR + 4 * fq) = pack4(o1); *(u32x2*)(P + (size_t)row * PW + P_KR + 16 + 4 * fq) = pack4(o2); } }
        } else {
            const float sc = (pn < 2) ? C_A : 1.0f; const int i0 = 16 * (wc & 1) + 4 * fq;
#pragma unroll
            for (int ai = 0; ai < 2; ++ai)
#pragma unroll
                for (int m = 0; m < 4; ++m) { const int row = row0 + ai * 128 + m * 16; const float rs = rs8[ai][m]; const float pf = pf8[ai][m]; f32x4 c, s;
#pragma unroll
                    for (int j = 0; j < 4; ++j) { float cc, ss; rot_cs(pf, i0 + j, cc, ss); c[j] = cc * sc; s[j] = ss * sc; }
#pragma unroll
                    for (int bj = 0; bj < 2; ++bj) { const f32x4 x1 = DQ(ai, bj, m, 0), x2 = DQ(ai, bj, m, 1);
                        if (pn == 2 && bj == 1) { *(u32x4*)(P + (size_t)row * PW + P_VA + wc * 32 + fq * 8) = pack8(x1, x2); }
                        else { const f32x4 o1 = x1 * c - x2 * s, o2 = x2 * c + x1 * s; bf16_t* d = P + (size_t)row * PW + pn * 256 + 64 * (2 * bj + (wc >> 1)) + i0;
                            *(u32x2*)d = pack4(o1); *(u32x2*)(d + 32) = pack4(o2); } } }
        }
#undef DQ
    }
};
struct EpiUp {
    static constexpr bool MID = false;
    __device__ __forceinline__ void stage(LAS unsigned char*, const Unit&, int, int) const {}
    bf16_t* QB; bf16_t* KVB; const float* ssq; const int* pos;
    __device__ __forceinline__ void operator()(const AccT& acc, const Unit& u, int wr, int wc, int fr, int fq, const LAS unsigned char*) const {
        const int pn = u.pn, row0 = u.pm * 256 + wr * 64 + fr;
        float rs8[2][4], pf8[2][4];
#pragma unroll
        for (int ai = 0; ai < 2; ++ai)
#pragma unroll
            for (int m = 0; m < 4; ++m) { const int row = row0 + ai * 128 + m * 16; const f32x4 sv = *(const f32x4*)(ssq + (size_t)row * 8 + (pn < 3 ? 0 : 4));
                rs8[ai][m] = (pn < 3 ? C_B : 1.0f) / sqrtf(((sv[0] + sv[1]) + (sv[2] + sv[3])) * (pn < 3 ? 1.0f / 256.0f : 1.0f / 128.0f) + EPS); pf8[ai][m] = (pn < 3) ? (float)pos[row] : 0.f; }
#pragma unroll
        for (int ai = 0; ai < 2; ++ai)
#pragma unroll
            for (int m = 0; m < 4; ++m) { const int row = row0 + ai * 128 + m * 16; const float rs = rs8[ai][m];
                if (pn < 3) {
#pragma unroll
                    for (int bj = 0; bj < 2; ++bj) { const int gg = 8 * pn + 4 * bj + wc; const f32x4 x1 = acc[ai][bj][m][0] * rs, x2 = acc[ai][bj][m][1] * rs;
                        if (gg % 3 == 2) { const float pf = pf8[ai][m]; f32x4 o1, o2;
#pragma unroll
                            for (int j = 0; j < 4; ++j) { float c, s; rot_cs(pf, 2 * (4 * fq + j), c, s); o1[j] = x1[j] * c - x2[j] * s; o2[j] = x2[j] * c + x1[j] * s; }
                            bf16_t* d = QB + (size_t)row * QBW + 32 * gg + 4 * fq; *(u32x2*)d = pack4(o1); *(u32x2*)(d + 16) = pack4(o2); }
                        else *(u32x4*)(QB + (size_t)row * QBW + 32 * gg + 8 * fq) = pack8(x1, x2); }
                } else {
#pragma unroll
                    for (int bj = 0; bj < 2; ++bj) *(u32x4*)(KVB + (size_t)row * KVW + (pn - 3) * 256 + bj * 128 + wc * 32 + fq * 8) = pack8(acc[ai][bj][m][0] * rs, acc[ai][bj][m][1] * rs);
                } }
    }
};
struct EpiPlain {
    static constexpr bool MID = false;
    __device__ __forceinline__ void stage(LAS unsigned char*, const Unit&, int, int) const {}
    bf16_t* O; int ldo;
    __device__ __forceinline__ void operator()(const AccT& acc, const Unit& u, int wr, int wc, int fr, int fq, const LAS unsigned char*) const {
        const int row0 = u.pm * 256 + wr * 64 + fr;
#pragma unroll
        for (int ai = 0; ai < 2; ++ai)
#pragma unroll
            for (int m = 0; m < 4; ++m)
#pragma unroll
                for (int bj = 0; bj < 2; ++bj) *(u32x4*)(O + (size_t)(row0 + ai * 128 + m * 16) * ldo + u.pn * 256 + bj * 128 + wc * 32 + fq * 8) = pack8(acc[ai][bj][m][0], acc[ai][bj][m][1]);
    }
};
struct EpiBranch {
    static constexpr bool MID = true;
    const unsigned char* G; bf16_t* MIXED;
    __device__ __forceinline__ void stage(LAS unsigned char*, const Unit&, int, int) const {}
    static __device__ __forceinline__ float gq(unsigned w, int b) { const float f = (float)((w >> (8 * b)) & 255u); return fmaxf(f, 2.55e-4f); }
    __device__ __forceinline__ void mid(AccT& acc, const Unit& u, int seg  , int wr, int wc, int fr, int fq) const {
        const int row0 = opq_v(u.pm * 256 + wr * 64 + fr);
#pragma unroll
        for (int ai = 0; ai < 2; ++ai) {
            u32x2 ga[4][2], gb[4][2];
#pragma unroll
            for (int m = 0; m < 4; ++m)
#pragma unroll
                for (int bj = 0; bj < 2; ++bj) { const unsigned char* gp = G + (size_t)(row0 + ai * 128 + m * 16) * GW + u.pn * 256 + bj * 128 + wc * 32 + fq * 8;
                    ga[m][bj] = *(const u32x2*)(gp + (seg - 1) * 1024); gb[m][bj] = *(const u32x2*)(gp + seg * 1024); }
#pragma unroll
            for (int m = 0; m < 4; ++m)
#pragma unroll
                for (int bj = 0; bj < 2; ++bj) { const u32x2 a2 = ga[m][bj], b2 = gb[m][bj];
#pragma unroll
                    for (int j = 0; j < 4; ++j) { acc[ai][bj][m][0][j] *= gq(a2.x, j) * __builtin_amdgcn_rcpf(gq(b2.x, j)); acc[ai][bj][m][1][j] *= gq(a2.y, j) * __builtin_amdgcn_rcpf(gq(b2.y, j)); } }
            asm volatile("" ::: "memory"); }
    }
    __device__ __forceinline__ void operator()(const AccT& acc, const Unit& u, int wr, int wc, int fr, int fq, const LAS unsigned char*) const {
        const int row0 = u.pm * 256 + wr * 64 + fr;
#pragma unroll
        for (int ai = 0; ai < 2; ++ai) {
            u32x2 gw[4][2];
#pragma unroll
            for (int m = 0; m < 4; ++m)
#pragma unroll
                for (int bj = 0; bj < 2; ++bj) gw[m][bj] = *(const u32x2*)(G + (size_t)(row0 + ai * 128 + m * 16) * GW + 2048 + u.pn * 256 + bj * 128 + wc * 32 + fq * 8);
#pragma unroll
            for (int m = 0; m < 4; ++m)
#pragma unroll
                for (int bj = 0; bj < 2; ++bj) { const u32x2 g2 = gw[m][bj]; f32x4 a = acc[ai][bj][m][0], b = acc[ai][bj][m][1];
#pragma unroll
                    for (int j = 0; j < 4; ++j) { a[j] *= gq(g2.x, j) * (1.0f / 255.0f); b[j] *= gq(g2.y, j) * (1.0f / 255.0f); }
                    *(u32x4*)(MIXED + (size_t)(row0 + ai * 128 + m * 16) * DM + u.pn * 256 + bj * 128 + wc * 32 + fq * 8) = pack8(a, b); }
            asm volatile("" ::: "memory"); }
    }
};
struct EpiResid {
    static constexpr bool MID = false;
    __device__ __forceinline__ void stage(LAS unsigned char*, const Unit&, int, int) const {}
    const float* Xin; float* Xout;
    __device__ __forceinline__ void operator()(const AccT& acc, const Unit& u, int wr, int wc, int fr, int fq, const LAS unsigned char*) const {
        const int row0 = u.pm * 256 + wr * 64 + fr;
#pragma unroll
        for (int ai = 0; ai < 2; ++ai)
#pragma unroll
            for (int mp = 0; mp < 2; ++mp) {
                f32x4 xv[2][2][2];
#pragma unroll
                for (int mm = 0; mm < 2; ++mm)
#pragma unroll
                    for (int bj = 0; bj < 2; ++bj)
#pragma unroll
                        for (int n = 0; n < 2; ++n) xv[mm][bj][n] = *(const f32x4*)(Xin + (size_t)(row0 + ai * 128 + (2 * mp + mm) * 16) * DM + u.pn * 256 + bj * 128 + wc * 32 + n * 16 + fq * 4);
#pragma unroll
                for (int mm = 0; mm < 2; ++mm)
#pragma unroll
                    for (int bj = 0; bj < 2; ++bj)
#pragma unroll
                        for (int n = 0; n < 2; ++n) *(f32x4*)(Xout + (size_t)(row0 + ai * 128 + (2 * mp + mm) * 16) * DM + u.pn * 256 + bj * 128 + wc * 32 + n * 16 + fq * 4) = xv[mm][bj][n] + acc[ai][bj][2 * mp + mm][n];
                asm volatile("" ::: "memory"); }
    }
};
struct EpiSwiglu {
    static constexpr bool MID = false;
    bf16_t* ACT; int lo; const float* rsc; const float* csc;
    __device__ __forceinline__ void stage(LAS unsigned char* d, const Unit& u, int wid, int lane) const {
        if (wid == 0) { stage1k(rsc + u.pm * 256, d, lane); stage1k(csc + (size_t)u.aux * 2 * DFF + u.pn * 256, d + 1024, lane); } }
    template <class AV> __device__ __forceinline__ void operator()(const AV (&acc)[2][2][4][2], const Unit& u, int wr, int wc, int fr, int fq, const LAS unsigned char* esc) const {
        const int row0 = (u.pm - lo) * 256 + wr * 64 + fr;
        f32x4 cs[2][2];
#pragma unroll
        for (int bj = 0; bj < 2; ++bj)
#pragma unroll
            for (int n = 0; n < 2; ++n) cs[bj][n] = *(const LAS f32x4*)(esc + 1024 + (bj * 128 + wc * 32 + n * 16 + fq * 4) * 4);
        float rs8[2][4];
#pragma unroll
        for (int ai = 0; ai < 2; ++ai)
#pragma unroll
            for (int m = 0; m < 4; ++m) rs8[ai][m] = *(const LAS float*)(esc + (ai * 128 + wr * 64 + m * 16 + fr) * 4);
#pragma unroll
        for (int ai = 0; ai < 2; ++ai)
#pragma unroll
            for (int m = 0; m < 4; ++m) { const float rs = rs8[ai][m]; f32x4 a, b;
                const f32x4 g0 = deq(acc[ai][0][m][0], rs, cs[0][0]), g1 = deq(acc[ai][0][m][1], rs, cs[0][1]), u0 = deq(acc[ai][1][m][0], rs, cs[1][0]), u1 = deq(acc[ai][1][m][1], rs, cs[1][1]);
#pragma unroll
                for (int j = 0; j < 4; ++j) { a[j] = g0[j] * fast_sigmoid(g0[j]) * u0[j]; b[j] = g1[j] * fast_sigmoid(g1[j]) * u1[j]; }
                *(u32x4*)(ACT + (size_t)(row0 + ai * 128 + m * 16) * DFF + u.pn * 128 + wc * 32 + fq * 8) = pack8(a, b); }
    }
};
struct EpiYout {
    static constexpr bool MID = false;
    __device__ __forceinline__ void stage(LAS unsigned char*, const Unit&, int, int) const {}
    bf16_t* Y;
    __device__ __forceinline__ void operator()(const AccT& acc, const Unit& u, int wr, int wc, int fr, int fq, const LAS unsigned char*) const {
        const int row0 = u.pm * 256 + wr * 64 + fr;
#pragma unroll
        for (int ai = 0; ai < 2; ++ai)
#pragma unroll
            for (int m = 0; m < 4; ++m)
#pragma unroll
                for (int bj = 0; bj < 2; ++bj)
#pragma unroll
                    for (int n = 0; n < 2; ++n) *(u32x2*)(Y + (size_t)(row0 + ai * 128 + m * 16) * DM + u.pn * 256 + bj * 128 + wc * 32 + n * 16 + fq * 4) = pack4(acc[ai][bj][m][n]);
    }
};

namespace att {
__device__ __forceinline__ int crow(int r, int hi) { return (r & 3) + 8 * (r >> 2) + 4 * hi; }
__device__ __forceinline__ void glds16(const void* gsrc, unsigned lds_dst) { unsigned keep;
    asm volatile("s_mov_b32 %0, m0\n\ts_mov_b32 m0, %2\n\ts_nop 0\n\tglobal_load_lds_dwordx4 %1, off\n\ts_mov_b32 m0, %0" : "=&s"(keep) : "v"(gsrc), "s"(lds_dst) : "memory"); }
__device__ __forceinline__ float swapmax(float m) { auto rr = __builtin_amdgcn_permlane32_swap(__float_as_uint(m), __float_as_uint(m), false, false); return fmaxf(__uint_as_float(rr[0]), __uint_as_float(rr[1])); }
__device__ __forceinline__ float swapsum(float m) { auto rr = __builtin_amdgcn_permlane32_swap(__float_as_uint(m), __float_as_uint(m), false, false); return __uint_as_float(rr[0]) + __uint_as_float(rr[1]); }
__device__ __forceinline__ s16x4 vtr(unsigned addr) { s16x4 r; asm volatile("ds_read_b64_tr_b16 %0, %1" : "=&v"(r) : "v"(addr) : "memory"); return r; }
#define VTRO(dst, base, off) asm volatile("ds_read_b64_tr_b16 %0, %1 offset:%c2" : "=&v"(dst) : "v"(base), "i"(off) : "memory")

struct Src {
    const bf16_t* q; int qpitch;
    const bf16_t* k0; int k0pitch;
    const bf16_t* k1; int k1pitch;
    const bf16_t* v; int vpitch;
    bf16_t* o; int opitch;
};
template <int NKC, int NVB, int RD = 4>
__device__ __forceinline__ void dma_tile(const Src& S, int t, int slot, unsigned lds0, int wid, int lane) {
    constexpr int KS = NKC * 1024, VS = NVB * 4096, LDS_K = 0, LDS_V = RD * KS;
#pragma unroll
    for (int c = 0; c < (NKC + 7) / 8; ++c) { const int ch = wid + 8 * c; if (ch < NKC) {
        const bf16_t* src = (ch < 8) ? S.k0 + (size_t)(t * 64 + lane) * S.k0pitch + ch * 8 : S.k1 + (size_t)(t * 64 + lane) * S.k1pitch + (ch - 8) * 8;
        glds16(src, (unsigned)__builtin_amdgcn_readfirstlane(lds0 + LDS_K + slot * KS + ch * 1024)); } }
#pragma unroll
    for (int c = 0; c < (NVB * 4 + 7) / 8; ++c) { const int p = wid + 8 * c; if (p < NVB * 4) {
        const bf16_t* src = S.v + (size_t)(t * 64 + 16 * (p & 3) + (lane >> 2)) * S.vpitch + (p >> 2) * 32 + (lane & 3) * 8;
        glds16(src, (unsigned)__builtin_amdgcn_readfirstlane(lds0 + LDS_V + slot * VS + p * 1024)); } }
}
__device__ __forceinline__ void wait_vm_bar(int n) {
    if (n >= 4) asm volatile("s_waitcnt vmcnt(4) lgkmcnt(0)\n\ts_barrier" ::: "memory");
    else if (n == 3) asm volatile("s_waitcnt vmcnt(3) lgkmcnt(0)\n\ts_barrier" ::: "memory");
    else if (n == 2) asm volatile("s_waitcnt vmcnt(2) lgkmcnt(0)\n\ts_barrier" ::: "memory");
    else if (n == 1) asm volatile("s_waitcnt vmcnt(1) lgkmcnt(0)\n\ts_barrier" ::: "memory");
    else asm volatile("s_waitcnt vmcnt(0) lgkmcnt(0)\n\ts_barrier" ::: "memory");
}
template <int NKC, int NVB, int MODE>
__device__ __forceinline__ void unit(LAS unsigned char* lds, const Src& S, int t_lo, int t_hi, int qpos0  , float sink_l2) {
    constexpr int KS = NKC * 1024, VS = NVB * 4096, RD = 4, LDS_K = 0, LDS_V = RD * KS;
    const int tid = opq_v((int)threadIdx.x), lane = tid & 63, r32 = lane & 31, hi = lane >> 5; const int wid = __builtin_amdgcn_readfirstlane(tid >> 6), grp = wid >> 2;
    const unsigned lds0 = (unsigned)(uintptr_t)lds;
    const int ops = (NKC + 7 - wid) / 8 + (NVB * 4) / 8;
    bf16x8 qr[NKC / 2];
#pragma unroll
    for (int d0 = 0; d0 < NKC / 2; ++d0) qr[d0] = *(const bf16x8*)(S.q + (size_t)r32 * S.qpitch + d0 * 16 + hi * 8);
    float m_run = (MODE == 0) ? sink_l2 : -INFINITY, l_run = (MODE == 0 && hi == 0) ? 1.0f : 0.0f;
    f32x16 o[NVB];
#pragma unroll
    for (int d = 0; d < NVB; ++d) o[d] = f32x16{};
    const int qi = qpos0 + wid * 32 + r32, qw0 = qpos0 + wid * 32;
    f32x16 p0 = f32x16{}, p1 = f32x16{};
#define AT_ACTIVE(t) ((MODE != 0) || ((64 * (t) + 63 >= qw0 - 128) && (64 * (t) <= qw0 + 31 + 128)))
#define AT_QK(t) do { const LAS unsigned char* kb_ = lds + LDS_K + (((t) - t_lo) % RD) * KS + hi * 1024 + r32 * 16; p0 = f32x16{}; p1 = f32x16{}; \
        _Pragma("unroll") for (int d0 = 0; d0 < NKC / 2; ++d0) { const bf16x8 b0_ = *(const LAS bf16x8*)(kb_ + d0 * 2048), b1_ = *(const LAS bf16x8*)(kb_ + d0 * 2048 + 512); \
            p0 = __builtin_amdgcn_mfma_f32_32x32x16_bf16(b0_, qr[d0], p0, 0, 0, 0); p1 = __builtin_amdgcn_mfma_f32_32x32x16_bf16(b1_, qr[d0], p1, 0, 0, 0); } } while (0)
#define AT_SMPV(t) do { \
        if (MODE == 0) { _Pragma("unroll") for (int r = 0; r < 16; ++r) { const int kv_ = 64 * (t) + crow(r, hi); int e0_ = kv_ - qi; e0_ = e0_ < 0 ? -e0_ : e0_; int e1_ = kv_ + 32 - qi; e1_ = e1_ < 0 ? -e1_ : e1_; \
            if (e0_ > 128) p0[r] = -INFINITY; if (e1_ > 128) p1[r] = -INFINITY; } } \
        float mx_[8]; _Pragma("unroll") for (int r = 0; r < 8; ++r) mx_[r] = fmaxf(fmaxf(p0[r], p0[r + 8]), fmaxf(p1[r], p1[r + 8])); \
        float rm_ = fmaxf(fmaxf(fmaxf(mx_[0], mx_[1]), fmaxf(mx_[2], mx_[3])), fmaxf(fmaxf(mx_[4], mx_[5]), fmaxf(mx_[6], mx_[7]))); rm_ = swapmax(rm_); \
        if (__any(rm_ > m_run)) { const float mn_ = fmaxf(m_run, rm_), alpha_ = __builtin_amdgcn_exp2f(m_run - mn_); m_run = mn_; l_run *= alpha_; \
            _Pragma("unroll") for (int d = 0; d < NVB; ++d) _Pragma("unroll") for (int r = 0; r < 16; ++r) o[d][r] *= alpha_; } \
        float sm_[4] = {0.f, 0.f, 0.f, 0.f}; \
        _Pragma("unroll") for (int r = 0; r < 16; ++r) { p0[r] = __builtin_amdgcn_exp2f(p0[r] - m_run); p1[r] = __builtin_amdgcn_exp2f(p1[r] - m_run); sm_[r & 3] += p0[r] + p1[r]; } \
        l_run += (sm_[0] + sm_[1]) + (sm_[2] + sm_[3]); \
        u32x4 pw_[4]; \
        pw_[0] = (u32x4){cvtpk(p0[0], p0[1]), cvtpk(p0[2], p0[3]), cvtpk(p0[4], p0[5]), cvtpk(p0[6], p0[7])}; pw_[1] = (u32x4){cvtpk(p0[8], p0[9]), cvtpk(p0[10], p0[11]), cvtpk(p0[12], p0[13]), cvtpk(p0[14], p0[15])}; \
        pw_[2] = (u32x4){cvtpk(p1[0], p1[1]), cvtpk(p1[2], p1[3]), cvtpk(p1[4], p1[5]), cvtpk(p1[6], p1[7])}; pw_[3] = (u32x4){cvtpk(p1[8], p1[9]), cvtpk(p1[10], p1[11]), cvtpk(p1[12], p1[13]), cvtpk(p1[14], p1[15])}; \
        const unsigned vb_ = lds0 + LDS_V + (((t) - t_lo) % RD) * VS + ((lane >> 4) & 1) * 32 + (lane & 3) * 8 + (4 * hi + ((lane & 15) >> 2)) * 64; \
        _Pragma("unroll") for (int dp = 0; dp < NVB; dp += 2) { s16x4 lo_[2][4], hh_[2][4]; \
            _Pragma("unroll") for (int dd = 0; dd < 2; ++dd) _Pragma("unroll") for (int ks = 0; ks < 4; ++ks) { lo_[dd][ks] = vtr(vb_ + (dp + dd) * 4096 + ks * 1024); hh_[dd][ks] = vtr(vb_ + (dp + dd) * 4096 + ks * 1024 + 512); } \
            asm volatile("s_waitcnt lgkmcnt(0)" ::: "memory"); __builtin_amdgcn_sched_barrier(0); \
            _Pragma("unroll") for (int ks = 0; ks < 4; ++ks) _Pragma("unroll") for (int dd = 0; dd < 2; ++dd) { \
                const bf16x8 vf_ = (bf16x8){lo_[dd][ks][0], lo_[dd][ks][1], lo_[dd][ks][2], lo_[dd][ks][3], hh_[dd][ks][0], hh_[dd][ks][1], hh_[dd][ks][2], hh_[dd][ks][3]}; \
                o[dp + dd] = __builtin_amdgcn_mfma_f32_32x32x16_bf16(vf_, __builtin_bit_cast(bf16x8, pw_[ks]), o[dp + dd], 0, 0, 0); } } } while (0)
    dma_tile<NKC, NVB>(S, t_lo, 0, lds0, wid, lane);
    if (t_lo + 1 < t_hi) dma_tile<NKC, NVB>(S, t_lo + 1, 1, lds0, wid, lane);
    for (int t = t_lo; t < t_hi; ++t) {
        wait_vm_bar((t + 1 < t_hi) ? ops : 0);
        if (t + 2 < t_hi) dma_tile<NKC, NVB>(S, t + 2, (t + 2 - t_lo) % RD, lds0, wid, lane);
        if (grp == 0) { if (AT_ACTIVE(t)) { AT_QK(t); AT_SMPV(t); } }
        else { if (t > t_lo && AT_ACTIVE(t - 1)) AT_SMPV(t - 1); if (AT_ACTIVE(t)) AT_QK(t); }
    }
    if (grp == 1 && AT_ACTIVE(t_hi - 1)) AT_SMPV(t_hi - 1);
    const float linv = 1.0f / swapsum(l_run);
#pragma unroll
    for (int d = 0; d < NVB; ++d)
#pragma unroll
        for (int r4 = 0; r4 < 4; ++r4) { f32x4 v = {o[d][4 * r4] * linv, o[d][4 * r4 + 1] * linv, o[d][4 * r4 + 2] * linv, o[d][4 * r4 + 3] * linv};
            *(u32x2*)(S.o + (size_t)r32 * S.opitch + 32 * d + 8 * r4 + 4 * hi) = pack4(v); }
    asm volatile("s_waitcnt lgkmcnt(0)\n\ts_barrier" ::: "memory");
#undef AT_ACTIVE
#undef AT_QK
#undef AT_SMPV
}

template <int NKC, int NVB, bool STAG, int MODE = 1>
__device__ __forceinline__ void unit_pf(LAS unsigned char* lds, const Src& S, int t_lo, int t_hi, int qpos0 = 0, float sink_l2 = 0.f) {
    constexpr int KS = NKC * 1024, VS = NVB * 4096, RD = 5, LDS_K = 0, LDS_V = RD * KS;
    static_assert(RD * (KS + VS) <= RING_BYTES, "attention rings fit the LDS stage region");
    const int tid = opq_v((int)threadIdx.x), lane = tid & 63, r32 = lane & 31, hi = lane >> 5; const int wid = __builtin_amdgcn_readfirstlane(tid >> 6), grp = STAG ? (wid >> 2) : 0;
    const unsigned lds0 = (unsigned)(uintptr_t)lds;
    const int ops = (NKC + 7 - wid) / 8 + (NVB * 4) / 8;
    bf16x8 qr[NKC / 2];
#pragma unroll
    for (int d0 = 0; d0 < NKC / 2; ++d0) qr[d0] = *(const bf16x8*)(S.q + (size_t)r32 * S.qpitch + d0 * 16 + hi * 8);
    float m_run = (MODE == 0) ? sink_l2 : -INFINITY, l_run = (MODE == 0 && hi == 0) ? 1.0f : 0.0f;
    const int qi = qpos0 + wid * 32 + r32; (void)qi;
    f32x16 o[NVB];
#pragma unroll
    for (int d = 0; d < NVB; ++d) o[d] = f32x16{};
    bf16x8 kf[NKC];
    f32x16 p0 = f32x16{}, p1 = f32x16{};
    s16x4 lo[NVB][4], hh[NVB][4];
#define PF_KLOAD(t) do { const LAS unsigned char* kb_ = lds + LDS_K + (((t) - t_lo) % RD) * KS + hi * 1024 + r32 * 16; \
        _Pragma("unroll") for (int d0 = 0; d0 < NKC / 2; ++d0) { kf[2 * d0] = *(const LAS bf16x8*)(kb_ + d0 * 2048); kf[2 * d0 + 1] = *(const LAS bf16x8*)(kb_ + d0 * 2048 + 512); } } while (0)
#define PF_VLOAD(t) do { const unsigned vb_ = lds0 + LDS_V + (((t) - t_lo) % RD) * VS + ((lane >> 4) & 1) * 32 + (lane & 3) * 8 + (4 * hi + ((lane & 15) >> 2)) * 64; \
        _Pragma("unroll") for (int d = 0; d < NVB; ++d) _Pragma("unroll") for (int ks = 0; ks < 4; ++ks) { VTRO(lo[d][ks], vb_, d * 4096 + ks * 1024); VTRO(hh[d][ks], vb_, d * 4096 + ks * 1024 + 512); } \
        __builtin_amdgcn_sched_barrier(0); } while (0)
#define PF_QK() do { p0 = f32x16{}; p1 = f32x16{}; \
        _Pragma("unroll") for (int d0 = 0; d0 < NKC / 2; ++d0) { p0 = __builtin_amdgcn_mfma_f32_32x32x16_bf16(kf[2 * d0], qr[d0], p0, 0, 0, 0); p1 = __builtin_amdgcn_mfma_f32_32x32x16_bf16(kf[2 * d0 + 1], qr[d0], p1, 0, 0, 0); } \
        __builtin_amdgcn_sched_barrier(0); } while (0)
    u32x4 pw[4] = {};
#define PF_SM(t) do { \
        if (MODE == 0) { _Pragma("unroll") for (int r = 0; r < 16; ++r) { const int kv_ = 64 * (t) + crow(r, hi); int e0_ = kv_ - qi; e0_ = e0_ < 0 ? -e0_ : e0_; int e1_ = kv_ + 32 - qi; e1_ = e1_ < 0 ? -e1_ : e1_; \
            if (e0_ > 128) p0[r] = -INFINITY; if (e1_ > 128) p1[r] = -INFINITY; } } \
        float mx_[8]; _Pragma("unroll") for (int r = 0; r < 8; ++r) mx_[r] = fmaxf(fmaxf(p0[r], p0[r + 8]), fmaxf(p1[r], p1[r + 8])); \
        float rm_ = fmaxf(fmaxf(fmaxf(mx_[0], mx_[1]), fmaxf(mx_[2], mx_[3])), fmaxf(fmaxf(mx_[4], mx_[5]), fmaxf(mx_[6], mx_[7]))); rm_ = swapmax(rm_); \
        if (__any(rm_ > m_run)) { const float mn_ = fmaxf(m_run, rm_), alpha_ = __builtin_amdgcn_exp2f(m_run - mn_); m_run = mn_; l_run *= alpha_; \
            _Pragma("unroll") for (int d = 0; d < NVB; ++d) _Pragma("unroll") for (int r = 0; r < 16; ++r) o[d][r] *= alpha_; } \
        float sm_[4] = {0.f, 0.f, 0.f, 0.f}; \
        _Pragma("unroll") for (int r = 0; r < 16; ++r) { p0[r] = __builtin_amdgcn_exp2f(p0[r] - m_run); p1[r] = __builtin_amdgcn_exp2f(p1[r] - m_run); sm_[r & 3] += p0[r] + p1[r]; } \
        l_run += (sm_[0] + sm_[1]) + (sm_[2] + sm_[3]); \
        pw[0] = (u32x4){cvtpk(p0[0], p0[1]), cvtpk(p0[2], p0[3]), cvtpk(p0[4], p0[5]), cvtpk(p0[6], p0[7])}; pw[1] = (u32x4){cvtpk(p0[8], p0[9]), cvtpk(p0[10], p0[11]), cvtpk(p0[12], p0[13]), cvtpk(p0[14], p0[15])}; \
        pw[2] = (u32x4){cvtpk(p1[0], p1[1]), cvtpk(p1[2], p1[3]), cvtpk(p1[4], p1[5]), cvtpk(p1[6], p1[7])}; pw[3] = (u32x4){cvtpk(p1[8], p1[9]), cvtpk(p1[10], p1[11]), cvtpk(p1[12], p1[13]), cvtpk(p1[14], p1[15])}; \
        __builtin_amdgcn_sched_barrier(0); } while (0)
#define PF_PV() do { asm volatile("s_waitcnt lgkmcnt(0)" ::: "memory"); __builtin_amdgcn_sched_barrier(0); \
        _Pragma("unroll") for (int ks = 0; ks < 4; ++ks) _Pragma("unroll") for (int d = 0; d < NVB; ++d) { \
            const bf16x8 vf_ = (bf16x8){lo[d][ks][0], lo[d][ks][1], lo[d][ks][2], lo[d][ks][3], hh[d][ks][0], hh[d][ks][1], hh[d][ks][2], hh[d][ks][3]}; \
            o[d] = __builtin_amdgcn_mfma_f32_32x32x16_bf16(vf_, __builtin_bit_cast(bf16x8, pw[ks]), o[d], 0, 0, 0); } \
        __builtin_amdgcn_sched_barrier(0); } while (0)
    dma_tile<NKC, NVB, RD>(S, t_lo, 0, lds0, wid, lane);
    if (t_lo + 1 < t_hi) dma_tile<NKC, NVB, RD>(S, t_lo + 1, 1, lds0, wid, lane);
    wait_vm_bar(0);
    if (t_lo + 2 < t_hi) dma_tile<NKC, NVB, RD>(S, t_lo + 2, 2, lds0, wid, lane);
#define PF_TOP(t) do { if ((t) > t_lo) wait_vm_bar(((t) + 2 < t_hi) ? ops : 0); \
        if ((t) + 3 < t_hi) dma_tile<NKC, NVB, RD>(S, (t) + 3, ((t) + 3 - t_lo) % RD, lds0, wid, lane); } while (0)
    if (grp == 0) {
        PF_KLOAD(t_lo);
        for (int t = t_lo; t < t_hi; ++t) {
            PF_TOP(t);
            PF_VLOAD(t);
            PF_QK();
            if (t + 1 < t_hi) PF_KLOAD(t + 1);
            __builtin_amdgcn_sched_barrier(0);
            PF_SM(t);
            PF_PV();
        }
    } else {
        PF_TOP(t_lo); PF_KLOAD(t_lo); __builtin_amdgcn_sched_barrier(0); PF_QK();
        for (int t = t_lo + 1; t < t_hi; ++t) {
            PF_TOP(t);
            PF_VLOAD(t - 1); PF_SM(t - 1); PF_KLOAD(t); __builtin_amdgcn_sched_barrier(0); PF_PV();
            PF_QK();
        }
        PF_VLOAD(t_hi - 1); PF_SM(t_hi - 1); PF_PV();
    }
    const float linv = 1.0f / swapsum(l_run);
#pragma unroll
    for (int d = 0; d < NVB; ++d)
#pragma unroll
        for (int r4 = 0; r4 < 4; ++r4) { f32x4 v = {o[d][4 * r4] * linv, o[d][4 * r4 + 1] * linv, o[d][4 * r4 + 2] * linv, o[d][4 * r4 + 3] * linv};
            *(u32x2*)(S.o + (size_t)r32 * S.opitch + 32 * d + 8 * r4 + 4 * hi) = pack4(v); }
    asm volatile("s_waitcnt lgkmcnt(0)\n\ts_barrier" ::: "memory");
#undef PF_KLOAD
#undef PF_VLOAD
#undef PF_QK
#undef PF_SM
#undef PF_PV
#undef PF_TOP
}


template <int NKC, int NVB>
__device__ __forceinline__ void unit_q64(LAS unsigned char* lds, const Src& S, int t_lo, int t_hi) {
    constexpr int KS = NKC * 1024, VS = NVB * 4096, RD = 4, LDS_K = 0, LDS_V = RD * KS;
    const int tid = opq_v((int)threadIdx.x), lane = tid & 63, r32 = lane & 31, hi = lane >> 5; const int wid = __builtin_amdgcn_readfirstlane(tid >> 6);
    const unsigned lds0 = (unsigned)(uintptr_t)lds;
    const int ops = (NKC + 7 - wid) / 8 + (NVB * 4) / 8;
    bf16x8 qa[NKC / 2], qb[NKC / 2];
#pragma unroll
    for (int d0 = 0; d0 < NKC / 2; ++d0) { qa[d0] = *(const bf16x8*)(S.q + (size_t)r32 * S.qpitch + d0 * 16 + hi * 8); qb[d0] = *(const bf16x8*)(S.q + (size_t)(32 + r32) * S.qpitch + d0 * 16 + hi * 8); }
    float ma = -INFINITY, la = 0.f, mb = -INFINITY, lb = 0.f;
    f32x16 oa[NVB], ob[NVB];
#pragma unroll
    for (int d = 0; d < NVB; ++d) { oa[d] = f32x16{}; ob[d] = f32x16{}; }
#define Q64_SM(P0, P1, M, L, O, PW) do { \
        float mx_[8]; _Pragma("unroll") for (int r = 0; r < 8; ++r) mx_[r] = fmaxf(fmaxf(P0[r], P0[r + 8]), fmaxf(P1[r], P1[r + 8])); \
        float rm_ = fmaxf(fmaxf(fmaxf(mx_[0], mx_[1]), fmaxf(mx_[2], mx_[3])), fmaxf(fmaxf(mx_[4], mx_[5]), fmaxf(mx_[6], mx_[7]))); rm_ = swapmax(rm_); \
        if (__any(rm_ > M)) { const float mn_ = fmaxf(M, rm_), alpha_ = __builtin_amdgcn_exp2f(M - mn_); M = mn_; L *= alpha_; \
            _Pragma("unroll") for (int d = 0; d < NVB; ++d) _Pragma("unroll") for (int r = 0; r < 16; ++r) O[d][r] *= alpha_; } \
        float sm_[4] = {0.f, 0.f, 0.f, 0.f}; \
        _Pragma("unroll") for (int r = 0; r < 16; ++r) { P0[r] = __builtin_amdgcn_exp2f(P0[r] - M); P1[r] = __builtin_amdgcn_exp2f(P1[r] - M); sm_[r & 3] += P0[r] + P1[r]; } \
        L += (sm_[0] + sm_[1]) + (sm_[2] + sm_[3]); \
        PW[0] = (u32x4){cvtpk(P0[0], P0[1]), cvtpk(P0[2], P0[3]), cvtpk(P0[4], P0[5]), cvtpk(P0[6], P0[7])}; PW[1] = (u32x4){cvtpk(P0[8], P0[9]), cvtpk(P0[10], P0[11]), cvtpk(P0[12], P0[13]), cvtpk(P0[14], P0[15])}; \
        PW[2] = (u32x4){cvtpk(P1[0], P1[1]), cvtpk(P1[2], P1[3]), cvtpk(P1[4], P1[5]), cvtpk(P1[6], P1[7])}; PW[3] = (u32x4){cvtpk(P1[8], P1[9]), cvtpk(P1[10], P1[11]), cvtpk(P1[12], P1[13]), cvtpk(P1[14], P1[15])}; \
        __builtin_amdgcn_sched_barrier(0); } while (0)
#define Q64_SM_NB(P0, P1, M, L, O, PW) do { \
        float mx_[8]; _Pragma("unroll") for (int r = 0; r < 8; ++r) mx_[r] = fmaxf(fmaxf(P0[r], P0[r + 8]), fmaxf(P1[r], P1[r + 8])); \
        float rm_ = fmaxf(fmaxf(fmaxf(mx_[0], mx_[1]), fmaxf(mx_[2], mx_[3])), fmaxf(fmaxf(mx_[4], mx_[5]), fmaxf(mx_[6], mx_[7]))); rm_ = swapmax(rm_); \
        if (__any(rm_ > M)) { const float mn_ = fmaxf(M, rm_), alpha_ = __builtin_amdgcn_exp2f(M - mn_); M = mn_; L *= alpha_; \
            _Pragma("unroll") for (int d = 0; d < NVB; ++d) _Pragma("unroll") for (int r = 0; r < 16; ++r) O[d][r] *= alpha_; } \
        float sm_[4] = {0.f, 0.f, 0.f, 0.f}; \
        _Pragma("unroll") for (int r = 0; r < 16; ++r) { P0[r] = __builtin_amdgcn_exp2f(P0[r] - M); P1[r] = __builtin_amdgcn_exp2f(P1[r] - M); sm_[r & 3] += P0[r] + P1[r]; } \
        L += (sm_[0] + sm_[1]) + (sm_[2] + sm_[3]); \
        PW[0] = (u32x4){cvtpk(P0[0], P0[1]), cvtpk(P0[2], P0[3]), cvtpk(P0[4], P0[5]), cvtpk(P0[6], P0[7])}; PW[1] = (u32x4){cvtpk(P0[8], P0[9]), cvtpk(P0[10], P0[11]), cvtpk(P0[12], P0[13]), cvtpk(P0[14], P0[15])}; \
        PW[2] = (u32x4){cvtpk(P1[0], P1[1]), cvtpk(P1[2], P1[3]), cvtpk(P1[4], P1[5]), cvtpk(P1[6], P1[7])}; PW[3] = (u32x4){cvtpk(P1[8], P1[9]), cvtpk(P1[10], P1[11]), cvtpk(P1[12], P1[13]), cvtpk(P1[14], P1[15])}; \
        } while (0)
    dma_tile<NKC, NVB, RD>(S, t_lo, 0, lds0, wid, lane);
    if (t_lo + 1 < t_hi) dma_tile<NKC, NVB, RD>(S, t_lo + 1, 1, lds0, wid, lane);
    for (int t = t_lo; t < t_hi; ++t) {
        const int slot = (t - t_lo) % RD;
        wait_vm_bar((t + 1 < t_hi) ? ops : 0);
        if (t + 2 < t_hi) dma_tile<NKC, NVB, RD>(S, t + 2, (t + 2 - t_lo) % RD, lds0, wid, lane);
        const LAS unsigned char* kb = lds + LDS_K + slot * KS + hi * 1024 + r32 * 16;
        f32x16 s0a = f32x16{}, s0b = f32x16{}, s1a = f32x16{}, s1b = f32x16{};
#pragma unroll
        for (int d0 = 0; d0 < NKC / 2; ++d0) {
            const bf16x8 b0 = *(const LAS bf16x8*)(kb + d0 * 2048), b1 = *(const LAS bf16x8*)(kb + d0 * 2048 + 512);
            s0a = __builtin_amdgcn_mfma_f32_32x32x16_bf16(b0, qa[d0], s0a, 0, 0, 0); s0b = __builtin_amdgcn_mfma_f32_32x32x16_bf16(b1, qa[d0], s0b, 0, 0, 0);
            s1a = __builtin_amdgcn_mfma_f32_32x32x16_bf16(b0, qb[d0], s1a, 0, 0, 0); s1b = __builtin_amdgcn_mfma_f32_32x32x16_bf16(b1, qb[d0], s1b, 0, 0, 0); }
        __builtin_amdgcn_sched_barrier(0);
        u32x4 pwa[4], pwb[4];
        const unsigned vb = lds0 + LDS_V + slot * VS + ((lane >> 4) & 1) * 32 + (lane & 3) * 8 + (4 * hi + ((lane & 15) >> 2)) * 64;
        s16x4 lo[NVB][4], hh[NVB][4];
#pragma unroll
        for (int d = 0; d < NVB; ++d)
#pragma unroll
            for (int ks = 0; ks < 4; ++ks) { VTRO(lo[d][ks], vb, d * 4096 + ks * 1024); VTRO(hh[d][ks], vb, d * 4096 + ks * 1024 + 512); }
        __builtin_amdgcn_sched_barrier(0);
        Q64_SM(s0a, s0b, ma, la, oa, pwa);
        asm volatile("s_waitcnt lgkmcnt(0)" ::: "memory"); __builtin_amdgcn_sched_barrier(0);
#pragma unroll
        for (int ks = 0; ks < 4; ++ks)
#pragma unroll
            for (int d = 0; d < NVB; ++d) { const bf16x8 vf = (bf16x8){lo[d][ks][0], lo[d][ks][1], lo[d][ks][2], lo[d][ks][3], hh[d][ks][0], hh[d][ks][1], hh[d][ks][2], hh[d][ks][3]};
                oa[d] = __builtin_amdgcn_mfma_f32_32x32x16_bf16(vf, __builtin_bit_cast(bf16x8, pwa[ks]), oa[d], 0, 0, 0); }
        Q64_SM_NB(s1a, s1b, mb, lb, ob, pwb);
#pragma unroll
        for (int i = 0; i < 8; ++i) { __builtin_amdgcn_sched_group_barrier(0x008, 1, 0); __builtin_amdgcn_sched_group_barrier(0x002, 12, 0); }
        __builtin_amdgcn_sched_barrier(0);
#pragma unroll
        for (int ks = 0; ks < 4; ++ks)
#pragma unroll
            for (int d = 0; d < NVB; ++d) { const bf16x8 vf = (bf16x8){lo[d][ks][0], lo[d][ks][1], lo[d][ks][2], lo[d][ks][3], hh[d][ks][0], hh[d][ks][1], hh[d][ks][2], hh[d][ks][3]};
                ob[d] = __builtin_amdgcn_mfma_f32_32x32x16_bf16(vf, __builtin_bit_cast(bf16x8, pwb[ks]), ob[d], 0, 0, 0); }
        __builtin_amdgcn_sched_barrier(0);
    }
    const float lia = 1.0f / swapsum(la), lib = 1.0f / swapsum(lb);
#pragma unroll
    for (int d = 0; d < NVB; ++d)
#pragma unroll
        for (int r4 = 0; r4 < 4; ++r4) {
            f32x4 va = {oa[d][4 * r4] * lia, oa[d][4 * r4 + 1] * lia, oa[d][4 * r4 + 2] * lia, oa[d][4 * r4 + 3] * lia}, vb4 = {ob[d][4 * r4] * lib, ob[d][4 * r4 + 1] * lib, ob[d][4 * r4 + 2] * lib, ob[d][4 * r4 + 3] * lib};
            *(u32x2*)(S.o + (size_t)r32 * S.opitch + 32 * d + 8 * r4 + 4 * hi) = pack4(va); *(u32x2*)(S.o + (size_t)(32 + r32) * S.opitch + 32 * d + 8 * r4 + 4 * hi) = pack4(vb4); }
    asm volatile("s_waitcnt lgkmcnt(0)\n\ts_barrier" ::: "memory");
#undef Q64_SM
#undef Q64_SM_NB
}

template <int NKC, int NVB, int MODE>
__device__ __forceinline__ void unit_pp(LAS unsigned char* lds, const Src& S, int t_lo, int t_hi, int qpos0, float sink_l2) {
    constexpr int KS = NKC * 1024, VS = NVB * 4096, RD = 3, LDS_K = 0, LDS_V = RD * KS;
    const int tid = opq_v((int)threadIdx.x), lane = tid & 63, r32 = lane & 31, hi = lane >> 5; const int wid = __builtin_amdgcn_readfirstlane(tid >> 6), grp = wid >> 2;
    const unsigned lds0 = (unsigned)(uintptr_t)lds;
    const int n = t_hi - t_lo;
    const int kops = (NKC + 7 - wid) / 8, vops = (NVB * 4) / 8;
    bf16x8 qr[NKC / 2];
#pragma unroll
    for (int d0 = 0; d0 < NKC / 2; ++d0) qr[d0] = *(const bf16x8*)(S.q + (size_t)r32 * S.qpitch + d0 * 16 + hi * 8);
#define PP_DMA_K(j) do { _Pragma("unroll") for (int c_ = 0; c_ < (NKC + 7) / 8; ++c_) { const int ch_ = wid + 8 * c_; if (ch_ < NKC) { \
        const bf16_t* src_ = (ch_ < 8) ? S.k0 + (size_t)((t_lo + (j)) * 64 + lane) * S.k0pitch + ch_ * 8 : S.k1 + (size_t)((t_lo + (j)) * 64 + lane) * S.k1pitch + (ch_ - 8) * 8; \
        glds16(src_, (unsigned)__builtin_amdgcn_readfirstlane(lds0 + LDS_K + ((j) % RD) * KS + ch_ * 1024)); } } } while (0)
#define PP_DMA_V(j) do { _Pragma("unroll") for (int c_ = 0; c_ < (NVB * 4 + 7) / 8; ++c_) { const int p_ = wid + 8 * c_; if (p_ < NVB * 4) { \
        const bf16_t* src_ = S.v + (size_t)((t_lo + (j)) * 64 + 16 * (p_ & 3) + (lane >> 2)) * S.vpitch + (p_ >> 2) * 32 + (lane & 3) * 8; \
        glds16(src_, (unsigned)__builtin_amdgcn_readfirstlane(lds0 + LDS_V + ((j) % RD) * VS + p_ * 1024)); } } } while (0)
#define PP_BATCH(b, cnt) do { cnt = 0; if ((b) + 3 < n) { PP_DMA_K((b) + 3); cnt += kops; } if ((b) + 2 < n) { PP_DMA_V((b) + 2); cnt += vops; } } while (0)
    float m_run = (MODE == 0) ? sink_l2 : -INFINITY, l_run = (MODE == 0 && hi == 0) ? 1.0f : 0.0f;
    f32x16 o[NVB];
#pragma unroll
    for (int d = 0; d < NVB; ++d) o[d] = f32x16{};
    const int qi = qpos0 + wid * 32 + r32, qw0 = qpos0 + wid * 32;
#define PP_ACTIVE(j) ((MODE != 0) || ((64 * (t_lo + (j)) + 63 >= qw0 - 128) && (64 * (t_lo + (j)) <= qw0 + 31 + 128)))
    f32x16 p0 = f32x16{}, p1 = f32x16{}; u32x4 pw[4] = {};
#define PP_QK(j) do { const LAS unsigned char* kb_ = lds + LDS_K + ((j) % RD) * KS + hi * 1024 + r32 * 16; p0 = f32x16{}; p1 = f32x16{}; \
        _Pragma("unroll") for (int d0 = 0; d0 < NKC / 2; ++d0) { const bf16x8 b0_ = *(const LAS bf16x8*)(kb_ + d0 * 2048), b1_ = *(const LAS bf16x8*)(kb_ + d0 * 2048 + 512); \
            p0 = __builtin_amdgcn_mfma_f32_32x32x16_bf16(b0_, qr[d0], p0, 0, 0, 0); p1 = __builtin_amdgcn_mfma_f32_32x32x16_bf16(b1_, qr[d0], p1, 0, 0, 0); } } while (0)
#define PP_SOFTMAX(j) do { \
        if (MODE == 0) { _Pragma("unroll") for (int r = 0; r < 16; ++r) { const int kv_ = 64 * (t_lo + (j)) + crow(r, hi); int e0_ = kv_ - qi; e0_ = e0_ < 0 ? -e0_ : e0_; int e1_ = kv_ + 32 - qi; e1_ = e1_ < 0 ? -e1_ : e1_; \
            if (e0_ > 128) p0[r] = -INFINITY; if (e1_ > 128) p1[r] = -INFINITY; } } \
        float rm_ = fmaxf(p0[0], p1[0]); _Pragma("unroll") for (int r = 1; r < 16; ++r) rm_ = fmaxf(rm_, fmaxf(p0[r], p1[r])); rm_ = swapmax(rm_); \
        const float mn_ = fmaxf(m_run, rm_), alpha_ = __builtin_amdgcn_exp2f(m_run - mn_); m_run = mn_; float sum_ = 0.f; \
        _Pragma("unroll") for (int r = 0; r < 16; ++r) { p0[r] = __builtin_amdgcn_exp2f(p0[r] - mn_); p1[r] = __builtin_amdgcn_exp2f(p1[r] - mn_); sum_ += p0[r] + p1[r]; } \
        l_run = l_run * alpha_ + sum_; \
        _Pragma("unroll") for (int d = 0; d < NVB; ++d) _Pragma("unroll") for (int r = 0; r < 16; ++r) o[d][r] *= alpha_; \
        pw[0] = (u32x4){cvtpk(p0[0], p0[1]), cvtpk(p0[2], p0[3]), cvtpk(p0[4], p0[5]), cvtpk(p0[6], p0[7])}; pw[1] = (u32x4){cvtpk(p0[8], p0[9]), cvtpk(p0[10], p0[11]), cvtpk(p0[12], p0[13]), cvtpk(p0[14], p0[15])}; \
        pw[2] = (u32x4){cvtpk(p1[0], p1[1]), cvtpk(p1[2], p1[3]), cvtpk(p1[4], p1[5]), cvtpk(p1[6], p1[7])}; pw[3] = (u32x4){cvtpk(p1[8], p1[9]), cvtpk(p1[10], p1[11]), cvtpk(p1[12], p1[13]), cvtpk(p1[14], p1[15])}; } while (0)
#define PP_PV(j) do { const unsigned vb_ = lds0 + LDS_V + ((j) % RD) * VS + ((lane >> 4) & 1) * 32 + (lane & 3) * 8 + (4 * hi + ((lane & 15) >> 2)) * 64; \
        _Pragma("unroll") for (int d = 0; d < NVB; ++d) { s16x4 lo_[4], hh_[4]; \
            _Pragma("unroll") for (int ks = 0; ks < 4; ++ks) { lo_[ks] = vtr(vb_ + d * 4096 + ks * 1024); hh_[ks] = vtr(vb_ + d * 4096 + ks * 1024 + 512); } \
            asm volatile("s_waitcnt lgkmcnt(0)" ::: "memory"); __builtin_amdgcn_sched_barrier(0); \
            _Pragma("unroll") for (int ks = 0; ks < 4; ++ks) { const bf16x8 vf_ = (bf16x8){lo_[ks][0], lo_[ks][1], lo_[ks][2], lo_[ks][3], hh_[ks][0], hh_[ks][1], hh_[ks][2], hh_[ks][3]}; \
                o[d] = __builtin_amdgcn_mfma_f32_32x32x16_bf16(vf_, __builtin_bit_cast(bf16x8, pw[ks]), o[d], 0, 0, 0); } } } while (0)
    PP_DMA_K(0); PP_DMA_V(0); if (n > 1) { PP_DMA_K(1); PP_DMA_V(1); } if (n > 2) PP_DMA_K(2);
    asm volatile("s_waitcnt vmcnt(0) lgkmcnt(0)\n\ts_barrier" ::: "memory");
    if (grp == 1) asm volatile("s_barrier" ::: "memory");
    int infl = 0;
    if (PP_ACTIVE(0)) PP_QK(0);
    wait_vm_bar(infl);
    if (grp == 1) PP_BATCH(0, infl);
    if (PP_ACTIVE(0)) PP_SOFTMAX(0);
    wait_vm_bar(infl);
    for (int j = 0; j < n; ++j) {
        if (grp == 0) PP_BATCH(j, infl);
        const bool act = PP_ACTIVE(j), actn = (j + 1 < n) && PP_ACTIVE(j + 1);
        if (act) PP_PV(j);
        if (actn) PP_QK(j + 1);
        wait_vm_bar(infl);
        if (j + 1 < n) {
            if (grp == 1) PP_BATCH(j + 1, infl);
            if (actn) PP_SOFTMAX(j + 1);
            wait_vm_bar(infl);
        }
    }
    if (grp == 0) asm volatile("s_barrier" ::: "memory");
    const float linv = 1.0f / swapsum(l_run);
#pragma unroll
    for (int d = 0; d < NVB; ++d)
#pragma unroll
        for (int r4 = 0; r4 < 4; ++r4) { f32x4 v = {o[d][4 * r4] * linv, o[d][4 * r4 + 1] * linv, o[d][4 * r4 + 2] * linv, o[d][4 * r4 + 3] * linv};
            *(u32x2*)(S.o + (size_t)r32 * S.opitch + 32 * d + 8 * r4 + 4 * hi) = pack4(v); }
    asm volatile("s_waitcnt lgkmcnt(0)\n\ts_barrier" ::: "memory");
#undef PP_DMA_K
#undef PP_DMA_V
#undef PP_BATCH
#undef PP_ACTIVE
#undef PP_QK
#undef PP_SOFTMAX
#undef PP_PV
}
}
#define SC_AFTER_PROLOGUE() do {} while (0)
#define SC_AFTER_INPROJ(l) do {} while (0)
#define SC_AFTER_UP(l) do {} while (0)
#define SC_AFTER_MLA(l) do {} while (0)
#define SC_AFTER_BRANCH(l) do {} while (0)
#define SC_AFTER_WOUT(l) do {} while (0)
#define SC_AFTER_NORM2(l) do {} while (0)
#define SC_AFTER_GU(l) do {} while (0)
#define SC_AFTER_DOWN(l) do {} while (0)
#define SC_AFTER_ROUTE(l) do {} while (0)
#define SC_AFTER_MOEGU(l, h) do {} while (0)
#define SC_AFTER_MOED(l, h) do {} while (0)
#define SC_FINAL() do {} while (0)

struct Args { const float* in[23]; float* out; unsigned char* ws; };
#define WSP(type, off) ((type*)(F.ws + (off)))
#define PHASE() Frame Fp = F; Fp.ws = opq_p(F.ws); Fp.in = opq_p(F.in); Fp.out = opq_p(F.out); Fp.tid = opq_v((int)threadIdx.x); Fp.lane = Fp.tid & 63; Fp.wave = __builtin_amdgcn_readfirstlane(Fp.tid >> 6); (void)Fp
#define FWS(type, off) ((type*)(Fp.ws + (off)))
#define X_ (Fp.out)
#define H_ FWS(bf16_t, WS_H)
#define Pb_ FWS(bf16_t, WS_R + R_P)
#define Gb_ FWS(bf16_t, WS_R + R_G)
#define QB_ FWS(bf16_t, WS_R + R_QB)
#define KVB_ FWS(bf16_t, WS_R + R_KVB)
#define Yb_ FWS(bf16_t, WS_R + R_Y)
#define MEMN_ FWS(bf16_t, WS_MEMN)
#define MEMKV_ FWS(bf16_t, WS_MEMKV)
#define ACT_ FWS(bf16_t, WS_R + R_ACT)
#define ASORT_ FWS(bf16_t, WS_R + R_ASORT)
#define YOUT_ FWS(bf16_t, WS_R + R_YOUT)
#define SSQ_ FWS(float, WS_MISC + MS_SSQ)
#define TEXP_ FWS(const int, WS_MISC + MS_TEXP)
#define POS_ ((const int*)Fp.in[I_POS])
#define HSC_ FWS(float, WS_MISC + MS_HSC)
#define ASC_ FWS(float, WS_MISC + MS_ASC)
#define WSIN_ FWS(float, WS_MISC + MS_WSIN)
#define WSGU_ FWS(float, WS_MISC + MS_WSGU)

#define GRID_BAR() xcd_barrier(bar)
#ifndef MLA_STAG
#define MLA_STAG false
#endif
template <int l> __device__ __forceinline__ void layer_body(const Frame& F, const XcdBarrier& bar, const int bx) {
        if (l > 0) {
            PHASE();
            prep_ffn_weights(Fp, l);
            norm_phase(Fp, X_, X_, Fp.in[I_GMIX] + l * DM, (l & 1) == 0, true);
            GRID_BAR();
        }
        {   PHASE();
            ProbSimple p{DM, DM, DM, (const char*)H_, (const char*)wmix(Fp, l, WL_IN)}; pg8::StaticOrder S; S.init(T / 256, NT_IN, Fp.G, bx);
            EpiInproj E{Pb_, Gb_, SSQ_, POS_, HSC_, WSIN_ + l * NT_IN * 256}; pg8::gemm_phase<true>(Fp.lds, p, S, E); }
        if (l == 0) { PHASE();
            ProbSimple p{DM, DM * 2, DM * 2, (const char*)MEMN_, (const char*)FWS(bf16_t, WS_WMKV)}; pg8::StaticOrder S; S.init(NB * MEML / 256, 16, Fp.G, bx);
            EpiPlain E{MEMKV_, 4096}; pg8::gemm_phase(Fp.lds, p, S, E); }
        GRID_BAR();
        SC_AFTER_INPROJ(l);
        {   PHASE();
            ProbSimple p{UPK, PW * 2, UPK * 2, (const char*)(Pb_ + P_CQ), (const char*)wmix(Fp, l, WL_UP)}; pg8::StaticOrder S; S.init(T / 256, UPN / 256, Fp.G, bx);
            EpiUp E{QB_, KVB_, SSQ_, POS_}; pg8::gemm_phase(Fp.lds, p, S, E); }
        {   PHASE();
            for (int i = Fp.vcu; i < 1024; i += Fp.G) {
                const int hl = i & 3, qb = (i >> 2) & 15, kvh = (i >> 6) & 1, b = i >> 7, h = kvh * 4 + hl; const size_t rowb = (size_t)b * SEQ; const int q0 = qb * 256;
                att::Src s; s.q = Pb_ + (rowb + q0 + Fp.wave * 32) * PW + P_QA + h * 64; s.qpitch = PW; s.k0 = Pb_ + rowb * PW + P_KA + kvh * 64; s.k0pitch = PW; s.k1 = s.k0; s.k1pitch = PW;
                s.v = Pb_ + rowb * PW + P_VA + kvh * 64; s.vpitch = PW; s.o = Yb_ + (rowb + q0 + Fp.wave * 32) * YW + h * 64; s.opitch = YW;
                const int t_lo = (q0 / 64 - 2) < 0 ? 0 : (q0 / 64 - 2), t_hi = (q0 / 64 + 6) > SEQ / 64 ? SEQ / 64 : (q0 / 64 + 6);
                att::unit<8, 2, 0>(Fp.lds, s, t_lo, t_hi, q0, Fp.in[I_SINK][l * 8 + h] * LOG2E);
            } }
        {   PHASE();
            for (int i = Fp.vcu; i < 512; i += Fp.G) {
                const int qb = i & 15, h = (i >> 4) & 3, b = i >> 6; const size_t rowq = (size_t)b * SEQ + qb * 256 + Fp.wave * 32;
                att::Src s; s.q = Pb_ + rowq * PW + P_QM + h * 128; s.qpitch = PW; s.k0 = MEMKV_ + (size_t)b * MEML * 4096 + l * 1024 + h * 128; s.k0pitch = 4096; s.k1 = s.k0 + 64; s.k1pitch = 4096;
                s.v = MEMKV_ + (size_t)b * MEML * 4096 + l * 1024 + 512 + h * 128; s.vpitch = 4096; s.o = Yb_ + rowq * YW + 1024 + h * 128; s.opitch = YW;
                att::unit<16, 4, 1>(Fp.lds, s, 0, MEML / 64, 0, 0.f);
            } }
        GRID_BAR();
        SC_AFTER_UP(l);
        {   PHASE();
            for (int i = Fp.vcu; i < 512; i += Fp.G) {
                const int qb = i & 7, h = (i >> 3) & 7, b = i >> 6; const size_t rowb = (size_t)b * SEQ, rowq = rowb + qb * 512 + Fp.wave * 64;
                att::Src s; s.q = QB_ + rowq * QBW + h * 96; s.qpitch = QBW; s.k0 = KVB_ + rowb * KVW + h * 128; s.k0pitch = KVW; s.k1 = Pb_ + rowb * PW + P_KR; s.k1pitch = PW;
                s.v = KVB_ + rowb * KVW + h * 128 + 64; s.vpitch = KVW; s.o = Yb_ + rowq * YW + 512 + h * 64; s.opitch = YW;
                att::unit_q64<12, 2>(Fp.lds, s, 0, SEQ / 64);
            } }
        GRID_BAR();
        SC_AFTER_MLA(l);
        {   PHASE();
            ProbSimple p{1536, YW * 2, 1536 * 2, (const char*)Yb_, (const char*)wmix(Fp, l, WL_BR)}; pg8::StaticOrder S; S.init(T / 256, DM / 256, Fp.G, bx);
            EpiBranch E{(const unsigned char*)Gb_, H_}; pg8::gemm_phase(Fp.lds, p, S, E); }
        GRID_BAR();
        SC_AFTER_BRANCH(l);
        {   PHASE();
            ProbSimple p{DM, DM * 2, DM * 2, (const char*)H_, (const char*)wmix(Fp, l, WL_OUT)}; pg8::StaticOrder S; S.init(T / 256, DM / 256, Fp.G, bx);
            EpiResid E{l == 0 ? Fp.in[I_X] : X_, X_}; pg8::gemm_phase(Fp.lds, p, S, E); }
        GRID_BAR();
        SC_AFTER_WOUT(l);
        if ((l & 1) == 0) {
            {   PHASE(); norm_phase(Fp, X_, nullptr, Fp.in[I_GFFN] + l * DM, false, GU_I8(l) != 0); }
            GRID_BAR();
            SC_AFTER_NORM2(l);
            {   PHASE();
                constexpr bool i8 = GU_I8(l) != 0; constexpr unsigned eb = i8 ? 1 : 2;
                ProbSimple p{DM, DM * eb, DM * eb, (const char*)H_, (const char*)FWS(bf16_t, WS_WFFN + WF_GU)}; pg8::StaticOrder S; S.init(T / 256, 2 * DFF / 256, Fp.G, bx);
                EpiSwiglu E{ACT_, 0, HSC_, WSGU_}; pg8::gemm_phase<i8>(Fp.lds, p, S, E); }
            GRID_BAR();
            SC_AFTER_GU(l);
            {   PHASE();
                ProbSimple p{DFF, DFF * 2, DFF * 2, (const char*)ACT_, (const char*)FWS(bf16_t, WS_WFFN + WF_D)}; pg8::StaticOrder S; S.init(T / 256, DM / 256, Fp.G, bx);
                EpiResid E{X_, X_}; pg8::gemm_phase(Fp.lds, p, S, E); }
            GRID_BAR();
            SC_AFTER_DOWN(l);
        } else {
            {   PHASE(); norm_router_phase(Fp, X_, Fp.in[I_GFFN] + l * DM, Fp.in[I_WR] + (size_t)(l >> 1) * DM * NE, GU_I8(l) != 0); }
            GRID_BAR();
            {   PHASE(); moe_assign_phase(Fp, GU_I8(l) != 0); }
            GRID_BAR();
            SC_AFTER_ROUTE(l);
            {   constexpr int half = 0; (void)half;
                {   PHASE();
                    const int nrt = TEXP_[MAXRT];
                    constexpr bool i8 = GU_I8(l) != 0; constexpr unsigned eb = i8 ? 1 : 2;
                    ProbMoe p{DM, DM * eb, DM * eb, (const char*)ASORT_, (const char*)FWS(bf16_t, WS_WFFN + WF_GU), 0}; MoeOrder S; S.base.init(nrt, 2 * DFF / 256, Fp.G, bx); S.lo = 0; S.texp = TEXP_;
                    EpiSwiglu E{ACT_, 0, ASC_, WSGU_}; pg8::gemm_phase<i8>(Fp.lds, p, S, E); }
                GRID_BAR();
                SC_AFTER_MOEGU(l, half);
                {   PHASE();
                    const int nrt = TEXP_[MAXRT];
                    ProbMoe p{DFF, DFF * 2, DFF * 2, (const char*)ACT_, (const char*)FWS(bf16_t, WS_WFFN + WF_D), 0}; MoeOrder S; S.base.init(nrt, DM / 256, Fp.G, bx); S.lo = 0; S.texp = TEXP_;
                    EpiYout E{YOUT_}; pg8::gemm_phase(Fp.lds, p, S, E); }
                GRID_BAR();
                SC_AFTER_MOED(l, half);
            }
        }
    }

__global__ void __launch_bounds__(NWAVES * 64, 2) fwd(Args args) {
    extern __shared__ __attribute__((aligned(16))) unsigned char lds_raw[];
    Frame F;
    F.lds = (LAS unsigned char*)lds_raw;
    F.MISC = (volatile LAS unsigned*)(F.lds + LDSCTL_OFF);
    F.tid = threadIdx.x; F.lane = F.tid & 63; F.wave = __builtin_amdgcn_readfirstlane(F.tid >> 6);
    F.G = gridDim.x; { const int bx = blockIdx.x; F.vcu = (F.G % 8 == 0) ? (bx % 8) * (F.G / 8) + bx / 8 : bx; }
    F.ws = args.ws; F.ctl = (gu32*)(args.ws + WS_CTL); F.out = args.out;
    F.in = (const float* const*)__builtin_amdgcn_kernarg_segment_ptr();
    for (int u = F.tid; u < (LDS_BYTES - LDSCTL_OFF) / 4; u += NWAVES * 64) ((LAS unsigned*)(F.lds + LDSCTL_OFF))[u] = 0u;
    __syncthreads();
    XcdBarrier bar = xcd_barrier_post((unsigned*)(F.ctl + CW_BAR), F.MISC + 8);

    const int bx = (int)blockIdx.x;

    {   PHASE();
        prep_mixer_weights(Fp);
        memnorm_phase(Fp);
        prep_ffn_weights(Fp, 0);
        norm_phase(Fp, Fp.in[I_X], nullptr, Fp.in[I_GMIX], false, true); }
    GRID_BAR();
    SC_AFTER_PROLOGUE();

    layer_body<0>(F, bar, bx); layer_body<1>(F, bar, bx); layer_body<2>(F, bar, bx); layer_body<3>(F, bar, bx);
    {   PHASE(); final_norm_phase(Fp, X_, Fp.in[I_GFIN], true); }
    SC_FINAL();
}

extern "C" void kernel_launch(void* const* d_in, const int* in_sizes, int n_in, void* d_out, int out_size, void* d_ws, size_t ws_size, hipStream_t stream) {
    static int grid = 0;
    if (grid == 0) {
        if (n_in != 23 || out_size != T * DM || ws_size < WS_END) { fprintf(stderr, "kernel_launch: unexpected problem (n_in %d, out %d, ws %zu < %zu)\n", n_in, out_size, ws_size, (size_t)WS_END); grid = -1; return; }
        int dev = 0, cus = 0;
        if (hipGetDevice(&dev) != hipSuccess || hipDeviceGetAttribute(&cus, hipDeviceAttributeMultiprocessorCount, dev) != hipSuccess) { grid = -1; return; }
        if (hipFuncSetAttribute((const void*)fwd, hipFuncAttributeMaxDynamicSharedMemorySize, LDS_BYTES) != hipSuccess) { fprintf(stderr, "kernel_launch: hipFuncSetAttribute failed\n"); grid = -1; return; }
        int per_cu = 0;
        if (hipOccupancyMaxActiveBlocksPerMultiprocessor(&per_cu, (const void*)fwd, NWAVES * 64, LDS_BYTES) != hipSuccess || per_cu < 1) fprintf(stderr, "kernel_launch: occupancy query says %d\n", per_cu);
        (void)hipGetLastError();
        grid = cus;
    }
    if (grid < 0) return;
    if (hipMemsetAsync((char*)d_ws + WS_CTL, 0, CTL_ZERO_BYTES, stream) != hipSuccess) return;
    Args a{};
    for (int i = 0; i < 23; ++i) a.in[i] = (const float*)d_in[i];
    a.out = (float*)d_out; a.ws = (unsigned char*)d_ws;
    hipLaunchKernelGGL(fwd, dim3(grid), dim3(NWAVES * 64), LDS_BYTES, stream, a);
}
```

```cpp
#include <hip/hip_runtime.h>
#include <cstdio>
#include <cstdint>

#ifndef SELFCHECK
#define SELFCHECK 0
#endif
#ifndef GU_I8_MASK
#define GU_I8_MASK 0xF
#endif
#define GU_I8(l) ((((unsigned)GU_I8_MASK) >> (l)) & 1u)

#define GAS __attribute__((address_space(1)))
#define LAS __attribute__((address_space(3)))
typedef unsigned short bf16_t;
typedef short bf16x8 __attribute__((ext_vector_type(8)));
typedef short s16x4 __attribute__((ext_vector_type(4)));
typedef short v4i16_t __attribute__((ext_vector_type(4)));
typedef float f32x2 __attribute__((ext_vector_type(2)));
typedef float f32x4 __attribute__((ext_vector_type(4)));
typedef float f32x16 __attribute__((ext_vector_type(16)));
typedef unsigned u32x2 __attribute__((ext_vector_type(2)));
typedef unsigned u32x4 __attribute__((ext_vector_type(4)));
typedef int i32x4 __attribute__((ext_vector_type(4)));
typedef GAS unsigned gu32;
#define RLX_AGENT __ATOMIC_RELAXED, __HIP_MEMORY_SCOPE_AGENT

constexpr int NB = 8, SEQ = 4096, T = NB * SEQ, DM = 1024, DEPTH = 4, MEML = 256, DFF = 3584, NE = 8;
constexpr int INW = 4768;
constexpr int PW = 1792;
constexpr int GW = 3072;
constexpr int QBW = 768, KVW = 1024, YW = 1536;
constexpr int NT_IN = 19;
constexpr int P_QA = 0, P_KA = 512, P_VA = 640, P_CQ = 768, P_CKV = 1024, P_KR = 1152, P_QM = 1280;
constexpr int UPK = 256, UPN = 1792;
constexpr int MAXSLOT = 67584;
constexpr int MAXRT = MAXSLOT / 256;
constexpr float EPS = 1e-6f;
constexpr float LOG2E = 1.4426950408889634f;
constexpr float C_A = 0.125f * LOG2E;
constexpr float C_B = 0.10206207261596575f * LOG2E;
constexpr float C_M = 0.08838834764831845f * LOG2E;

constexpr size_t MiB = 1u << 20;
constexpr size_t WS_CTL = 0, CTL_ZERO_BYTES = 1 * MiB;
constexpr size_t WS_MISC = 1 * MiB;
constexpr size_t WL_IN = 0, WL_UP = (size_t)NT_IN * 256 * DM * 2, WL_BR = WL_UP + (size_t)UPN * UPK * 2, WL_OUT = WL_BR + (size_t)3 * DM * 512 * 2, WL_SIZE = WL_OUT + (size_t)DM * DM * 2;
constexpr size_t WS_WMIX = 8 * MiB;
constexpr size_t WS_WMKV = WS_WMIX + 4 * ((WL_SIZE + MiB - 1) / MiB) * MiB;
constexpr size_t WL_STRIDE = ((WL_SIZE + MiB - 1) / MiB) * MiB;
constexpr size_t WS_WFFN = WS_WMKV + 8 * MiB;
constexpr size_t WF_GU = 0, WF_D = (size_t)2 * DFF * DM * 2, WF_STRIDE = WF_D + (size_t)DM * DFF * 2;
constexpr size_t WS_H = WS_WFFN + 8 * WF_STRIDE;
constexpr size_t WS_MEMN = WS_H + (size_t)T * DM * 2;
constexpr size_t WS_MEMKV = WS_MEMN + (size_t)NB * MEML * DM * 2;
constexpr size_t WS_R = WS_MEMKV + (size_t)NB * MEML * 4096 * 2;
constexpr size_t R_P = 0, R_G = R_P + (size_t)T * PW * 2, R_QB = R_G + (size_t)T * GW * 2, R_KVB = R_QB + (size_t)T * QBW * 2, R_Y = R_KVB + (size_t)T * KVW * 2, R_END_MIX = R_Y + (size_t)T * YW * 2;
constexpr size_t R_ACT = 0;
constexpr size_t R_ASORT = (size_t)MAXSLOT * DFF * 2;
constexpr size_t R_YOUT = R_ASORT;
constexpr size_t R_END_FFN = R_YOUT + (size_t)MAXSLOT * DM * 2;
constexpr size_t R_SIZE = R_END_MIX > R_END_FFN ? R_END_MIX : R_END_FFN;
constexpr size_t WS_END = WS_R + R_SIZE;
static_assert(WS_END < 1020ull * MiB, "workspace budget");
constexpr size_t MS_TOKE = 0;
constexpr size_t MS_TOKW = MS_TOKE + (size_t)T * 8;
constexpr size_t MS_SLOT = MS_TOKW + (size_t)T * 8;
constexpr size_t MS_CNT = MS_SLOT + (size_t)T * 8;
constexpr size_t MS_TEXP = MS_CNT + 256 * 8 * 4;
constexpr size_t MS_SSQ = MS_TEXP + 2048;
constexpr size_t MS_SNAP = MS_SSQ + (size_t)T * 32;
constexpr size_t MS_HSC = MS_SNAP + 64 * 1024 * 4;
constexpr size_t MS_ASC = MS_HSC + (size_t)T * 4;
constexpr size_t MS_WSIN = MS_ASC + (size_t)MAXSLOT * 4;
constexpr size_t MS_WSGU = MS_WSIN + (size_t)4 * NT_IN * 256 * 4;
constexpr size_t MS_END = MS_WSGU + (size_t)8 * 2 * DFF * 4;
static_assert(MS_END <= 7 * MiB, "misc map");
constexpr int CW_BAR = 4096;
constexpr int CW_DIAG = 16384;
constexpr int CW_CODE = 16384 + 512;

constexpr int RING_BYTES = 131072;
constexpr int LDSCTL_OFF = RING_BYTES;
constexpr int LDS_BYTES = 147456;
constexpr int NWAVES = 8;

#define LDS_WAIT() asm volatile("s_waitcnt lgkmcnt(0)" ::: "memory")
#define VM_WAIT() asm volatile("s_waitcnt vmcnt(0)" ::: "memory")

__device__ __forceinline__ unsigned f2bf(float f) { unsigned u = __builtin_bit_cast(unsigned, f); return (u + 0x7fffu + ((u >> 16) & 1u)) >> 16; }
__device__ __forceinline__ unsigned pk2(float lo, float hi) { return f2bf(lo) | (f2bf(hi) << 16); }
__device__ __forceinline__ float bf2f(unsigned short b) { return __builtin_bit_cast(float, (unsigned)b << 16); }
__device__ __forceinline__ float bflo(unsigned w) { return __builtin_bit_cast(float, w << 16); }
__device__ __forceinline__ float bfhi(unsigned w) { return __builtin_bit_cast(float, w & 0xffff0000u); }
typedef __bf16 bf16x2_t __attribute__((ext_vector_type(2)));
__device__ __forceinline__ unsigned cvtpk(float lo, float hi) { f32x2 v = {lo, hi}; bf16x2_t b = __builtin_convertvector(v, bf16x2_t); return __builtin_bit_cast(unsigned, b); }
__device__ __forceinline__ float wave_sum(float v) {
#pragma unroll
    for (int o = 1; o < 64; o <<= 1) v += __shfl_xor(v, o);
    return v;
}
__device__ __forceinline__ float fast_sigmoid(float x) { return __builtin_amdgcn_rcpf(1.0f + __builtin_amdgcn_exp2f(-x * LOG2E)); }


__device__ __forceinline__ int opq_v(int x) { asm volatile("" : "+v"(x)); return x; }
__device__ __forceinline__ int opq_s(int x) { asm volatile("" : "+s"(x)); return x; }
template <class Tp> __device__ __forceinline__ Tp* opq_p(Tp* p) { const unsigned long long u = (unsigned long long)p; unsigned lo = __builtin_amdgcn_readfirstlane((unsigned)u), hi = __builtin_amdgcn_readfirstlane((unsigned)(u >> 32)); asm volatile("" : "+s"(lo), "+s"(hi)); return (Tp*)(((unsigned long long)hi << 32) | lo); }

__constant__ float IFR_HI[32] = {1.591549367e-01f, 1.193493679e-01f, 8.949939907e-02f, 6.711508334e-02f, 5.032921210e-02f, 3.774158657e-02f, 2.830219641e-02f, 2.122365311e-02f, 1.591549441e-02f, 1.193493698e-02f, 8.949940093e-03f, 6.711508147e-03f, 5.032921210e-03f, 3.774158424e-03f, 2.830219688e-03f, 2.122365171e-03f, 1.591549488e-03f, 1.193493721e-03f, 8.949940093e-04f, 6.711508031e-04f, 5.032921326e-04f, 3.774158540e-04f, 2.830219455e-04f, 2.122365258e-04f, 1.591549371e-04f, 1.193493736e-04f, 8.949940093e-05f, 6.711508468e-05f, 5.032921035e-05f, 3.774158540e-05f, 2.830219637e-05f, 2.122365186e-05f};
__constant__ float IFR_LO[32] = {6.420638243e-09f, 2.294664903e-09f, 2.542919653e-09f, -3.316028840e-10f, 5.173299289e-12f, -1.848551645e-09f, -5.826552019e-10f, -3.431038786e-10f, -1.029942243e-10f, 4.320196978e-11f, 6.802745173e-11f, 1.531042237e-10f, 5.173301024e-13f, 4.797548470e-11f, -1.048316434e-10f, 1.053879969e-10f, -5.686555046e-11f, -1.896286773e-11f, 6.802744999e-12f, 2.695195456e-11f, -1.158979943e-11f, -6.843983713e-12f, 1.279990003e-11f, 1.807650600e-12f, 5.954976963e-12f, -3.351478166e-12f, 6.802745216e-13f, -1.670379113e-12f, 1.751403167e-12f, -6.843983930e-13f, -5.389994549e-13f, 9.083608431e-13f};
__device__ __forceinline__ void rot_cs(float posf, int idx, float& c, float& s) {
    const float ch = IFR_HI[idx], cl = IFR_LO[idx];
    const float p = posf * ch, e = __builtin_fmaf(posf, ch, -p);
    const float fr = __builtin_amdgcn_fractf(p) + (e + posf * cl);
    s = __builtin_amdgcn_sinf(fr); c = __builtin_amdgcn_cosf(fr);
}

#define XB_TMO      128
#define XB_XCNT(j)  (256  + 64 * (j))
#define XB_XSUB(j)  (1280 + 64 * (j))
#define XB_XGEN(j)  (2304 + 64 * (j))
#define XB_TOP      3328
#define XB_TOPGEN   3392
#define XCD_BAR_WORDS 3456
#define XB_SPIN_CAP (1u << 20)

__device__ __forceinline__ unsigned xb_ld(unsigned* p)              { return __hip_atomic_load(p, __ATOMIC_RELAXED, __HIP_MEMORY_SCOPE_AGENT); }
__device__ __forceinline__ unsigned xb_add(unsigned* p, unsigned v) { return __hip_atomic_fetch_add(p, v, __ATOMIC_RELAXED, __HIP_MEMORY_SCOPE_AGENT); }
__device__ __forceinline__ unsigned xb_xcc_id() { return (unsigned)__builtin_amdgcn_s_getreg((3 << 11) | 20) & 0xFu; }
#define XB_SPIN(cond, bar) do { unsigned _sp = 0; while (cond) { __builtin_amdgcn_s_sleep(1); \
    if ((++_sp & 255u) == 0u) { if (xb_ld(&(bar)[XB_TMO])) break; if (_sp > XB_SPIN_CAP) { atomicAdd(&(bar)[XB_TMO], 1u); break; } } } } while (0)

struct XcdBarrier { unsigned* bar; unsigned x; volatile LAS unsigned* st; };

__device__ __forceinline__ XcdBarrier xcd_barrier_post(unsigned* bar, volatile LAS unsigned* st) {
    XcdBarrier b; b.bar = bar; b.x = xb_xcc_id(); b.st = st;
    if (threadIdx.x == 0) (void)xb_add(&bar[XB_XCNT(b.x)], 1u);
    return b;
}
__device__ __forceinline__ void xcd_barrier_complete(unsigned* bar, unsigned x, unsigned& nloc, unsigned& nx) {
    const unsigned G = gridDim.x * gridDim.y * gridDim.z;
    unsigned sum, cnt, mine, sp = 0u;
    for (;;) {
        sum = 0u; cnt = 0u; mine = 0u;
#pragma unroll
        for (unsigned j = 0; j < 16; ++j) { const unsigned c = xb_ld(&bar[XB_XCNT(j)]); sum += c; cnt += (c > 0u) ? 1u : 0u; mine = (j == x) ? c : mine; }
        if (sum == G) break;
        __builtin_amdgcn_s_sleep(1);
        if ((++sp & 255u) == 0u) { if (xb_ld(&bar[XB_TMO])) break; if (sp > XB_SPIN_CAP) { atomicAdd(&bar[XB_TMO], 1u); break; } }
    }
    nloc = mine > 0u ? mine : 1u; nx = cnt > 0u ? cnt : 1u;
}
__device__ __forceinline__ void xcd_barrier(const XcdBarrier& b) {
    asm volatile("s_waitcnt vmcnt(0)" ::: "memory");
    __syncthreads();
    if (threadIdx.x == 0) {
        unsigned* bar = b.bar;
        __builtin_amdgcn_s_waitcnt(0);
        unsigned nloc = b.st[0], nx = b.st[1];
        if (nloc == 0u) { xcd_barrier_complete(bar, b.x, nloc, nx); b.st[0] = nloc; b.st[1] = nx; }
        const unsigned old = xb_add(&bar[XB_XSUB(b.x)], 1u);
        const unsigned gen = old / nloc;
        if (old + 1u == (gen + 1u) * nloc) {
            __builtin_amdgcn_fence(__ATOMIC_RELEASE, "agent");
            asm volatile("s_waitcnt vmcnt(0)" ::: "memory");
            const unsigned og = xb_add(&bar[XB_TOP], 1u);
            const unsigned tg = og / nx;
            if (og + 1u == (tg + 1u) * nx) xb_add(&bar[XB_TOPGEN], 1u);
            else XB_SPIN(xb_ld(&bar[XB_TOPGEN]) == tg, bar);
            __builtin_amdgcn_fence(__ATOMIC_ACQUIRE, "agent");
            xb_add(&bar[XB_XGEN(b.x)], 1u);
            asm volatile("s_waitcnt vmcnt(0)" ::: "memory");
        } else {
            XB_SPIN(xb_ld(&bar[XB_XGEN(b.x)]) == gen, bar);
            __builtin_amdgcn_fence(__ATOMIC_ACQUIRE, "agent");
            asm volatile("s_waitcnt vmcnt(0)" ::: "memory");
        }
    }
    __syncthreads();
}

namespace pg8 {
constexpr int BM = 256, BK = 64, HALF = 128, HTB = HALF * BK * 2, STAGE_BYTES = 8 * HTB, NXCD = 8, WGM = 4;
constexpr int ESC_OFF = 131072 + 4096, ESC_SLOT = 3072;
__host__ __device__ __forceinline__ int lds_byte(int r, int c) { const int st = (r >> 4) * 2 + (c >> 5), rr = r & 15, cc = c & 31, ob = rr * 64 + cc * 2; return st * 1024 + (ob ^ (((ob >> 9) & 1) << 5)); }
__host__ __device__ __forceinline__ void stage_rc(int b, int& R, int& C) { const int st = b / 1024, sb = b % 1024, swz = sb ^ (((sb >> 9) & 1) << 5); R = (st >> 1) * 16 + swz / 64; C = (st & 1) * 32 + (swz % 64) / 2; }

struct Unit { int pm, pn, aux; };

struct StaticOrder {
    int nM, nN, nwg, G, c, rev, wgm;
    __device__ void init(int nM_, int nN_, int G_, int c_, int rev_ = 0, int wgm_ = WGM) { nM = nM_; nN = nN_; nwg = nM * nN; G = G_; c = c_; rev = rev_; wgm = wgm_; }
    __device__ bool next(int i, Unit& u) const {
        const long L = (long)i * G + c; if (L >= nwg) return false;
        int wgid = (int)L; { const int q = nwg / NXCD, r = nwg % NXCD, xcd = wgid % NXCD, off = wgid / NXCD; wgid = (xcd < r ? xcd * (q + 1) : r * (q + 1) + (xcd - r) * q) + off; }
        const int nig = wgm * nN, gid = wgid / nig, fm = gid * wgm, gsz = (nM - fm) < wgm ? (nM - fm) : wgm;
        u.pm = fm + ((wgid % nig) % gsz); u.pn = (wgid % nig) / gsz; u.aux = 0; if (rev) u.pm = nM - 1 - u.pm; return true;
    }
};

template <bool I8> struct AccVec { typedef f32x4 type; };
template <> struct AccVec<true> { typedef i32x4 type; };
template <bool I8 = false, class Prob, class Sched, class Epi>
__device__ __forceinline__ void gemm_phase(LAS unsigned char* lds, const Prob& P, const Sched& S, const Epi& E) {
    const int tid = opq_v((int)threadIdx.x), wid = __builtin_amdgcn_readfirstlane(tid >> 6), lane = tid & 63, wr = wid >> 2, wc = wid & 3, fr = lane & 15, fq = lane >> 4;
    typedef typename AccVec<I8>::type accv_t;
    const int K = P.K, nt = K / (I8 ? 2 * BK : BK);
    unsigned voffA[2], voffB[2];
#pragma unroll
    for (int i = 0; i < 2; ++i) { int R, C; stage_rc(tid * 16 + i * 8192, R, C); voffA[i] = (unsigned)R * P.lda + (unsigned)C * 2u; voffB[i] = (unsigned)R * P.ldb + (unsigned)C * 2u; }
    const size_t kstep = (size_t)(BK * 2);
    const size_t hstepA = (size_t)HALF * P.lda, hstepB = (size_t)HALF * P.ldb;
    const unsigned ldsw = (unsigned)wid * 1024u;
    const int aoff = lds_byte(wr * 64 + fr, fq * 8), boff = lds_byte(wc * 32 + fr, fq * 8);
#define PG8_SA(b, h) (((b) * 2 + (h)) * HTB)
#define PG8_SB(b, h) ((4 + (b) * 2 + (h)) * HTB)
#define PG8_STAGE(bufoff, gbase, voff) do { _Pragma("unroll") for (int _i = 0; _i < 2; ++_i) \
        __builtin_amdgcn_global_load_lds((const unsigned*)((const char*)(gbase) + (voff)[_i]), (LAS unsigned*)(lds + (bufoff) + ldsw + _i * 8192), 16, 0, 0); } while (0)
#define PG8_LDA(dst, b, h) do { _Pragma("unroll") for (int m = 0; m < 4; ++m) _Pragma("unroll") for (int k = 0; k < 2; ++k) dst[m][k] = *(const LAS bf16x8*)(lds + PG8_SA(b, h) + aoff + m * 2048 + k * 1024); } while (0)
#define PG8_LDB(dst, b, h) do { _Pragma("unroll") for (int n = 0; n < 2; ++n) _Pragma("unroll") for (int k = 0; k < 2; ++k) dst[n][k] = *(const LAS bf16x8*)(lds + PG8_SB(b, h) + boff + n * 2048 + k * 1024); } while (0)
#define PG8_MMA(ai, bj, At, Bt) do { __builtin_amdgcn_s_setprio(1); _Pragma("unroll") for (int m = 0; m < 4; ++m) _Pragma("unroll") for (int n = 0; n < 2; ++n) _Pragma("unroll") for (int k = 0; k < 2; ++k) \
        { if constexpr (I8) acc[ai][bj][m][n] = __builtin_amdgcn_mfma_i32_16x16x64_i8(__builtin_bit_cast(i32x4, Bt[n][k]), __builtin_bit_cast(i32x4, At[m][k]), acc[ai][bj][m][n], 0, 0, 0); \
          else acc[ai][bj][m][n] = __builtin_amdgcn_mfma_f32_16x16x32_bf16(Bt[n][k], At[m][k], acc[ai][bj][m][n], 0, 0, 0); } __builtin_amdgcn_s_setprio(0); } while (0)
#define PG8_WAIT_V(n) asm volatile("s_waitcnt vmcnt(" #n ")" ::: "memory")
#define PG8_WAIT_L(n) asm volatile("s_waitcnt lgkmcnt(" #n ")" ::: "memory")
#define PG8_BAR __builtin_amdgcn_s_barrier()
#define PG8_SCHED __builtin_amdgcn_sched_barrier(0)
    Unit cur, nxt; int ui = 0;
    if (!S.next(0, cur)) return;
    accv_t acc[2][2][4][2];
#pragma unroll
    for (int a = 0; a < 2; ++a)
#pragma unroll
        for (int b = 0; b < 2; ++b)
#pragma unroll
            for (int m = 0; m < 4; ++m)
#pragma unroll
                for (int n = 0; n < 2; ++n) acc[a][b][m][n] = accv_t{};
    bf16x8 At[4][2], B0[2][2], B1[2][2];
    const char* cA = P.a_ptr(cur); const char* cB = P.b_ptr(cur);
    int eslot = 0;
    E.stage(lds + ESC_OFF, cur, wid, lane);
    PG8_STAGE(PG8_SB(0, 0), cB, voffB); PG8_STAGE(PG8_SB(0, 1), cB + hstepB, voffB); PG8_STAGE(PG8_SA(0, 0), cA, voffA); PG8_STAGE(PG8_SA(0, 1), cA + hstepA, voffA);
    if (wr == 1) PG8_BAR;
    PG8_WAIT_V(2); PG8_BAR;
    PG8_STAGE(PG8_SB(1, 0), cB + kstep, voffB); PG8_STAGE(PG8_SA(1, 0), cA + kstep, voffA); PG8_STAGE(PG8_SB(1, 1), cB + hstepB + kstep, voffB);
    PG8_WAIT_V(6); PG8_BAR;
    for (;;) {
        const bool has_next = S.next(ui + 1, nxt);
        const char* nA = has_next ? P.a_ptr(nxt) : cA; const char* nB = has_next ? P.b_ptr(nxt) : cB;
        for (int t = 0; t < nt; t += 2) {
            if constexpr (Epi::MID) { if (t == 8 || t == 16) E.mid(acc, cur, t >> 3, wr, wc, fr, fq); }
            const bool last = (t == nt - 2);
            if (last && has_next) E.stage(lds + ESC_OFF + (eslot ^ 1) * ESC_SLOT, nxt, wid, lane);
            const char* a1 = cA + (size_t)(t + 1) * kstep;
            const char* a2 = last ? nA : cA + (size_t)(t + 2) * kstep; const char* b2 = last ? nB : cB + (size_t)(t + 2) * kstep;
            const char* a3 = a2 + kstep; const char* b3 = b2 + kstep;
            PG8_LDB(B0, 0, 0); PG8_LDB(B1, 0, 1); PG8_SCHED; PG8_LDA(At, 0, 0); PG8_STAGE(PG8_SA(1, 1), a1 + hstepA, voffA);
            PG8_WAIT_V(8); PG8_WAIT_L(0); PG8_BAR; PG8_MMA(0, 0, At, B0); PG8_MMA(0, 1, At, B1); PG8_BAR; PG8_SCHED;
            PG8_LDA(At, 0, 1); PG8_STAGE(PG8_SB(0, 0), b2, voffB); PG8_STAGE(PG8_SB(0, 1), b2 + hstepB, voffB); PG8_STAGE(PG8_SA(0, 0), a2, voffA);
            PG8_WAIT_V(8); PG8_WAIT_L(0); PG8_BAR; PG8_MMA(1, 0, At, B0); PG8_MMA(1, 1, At, B1); PG8_BAR; PG8_SCHED;
            PG8_LDB(B0, 1, 0); PG8_LDB(B1, 1, 1); PG8_SCHED; PG8_LDA(At, 1, 0); PG8_STAGE(PG8_SA(0, 1), a2 + hstepA, voffA);
            PG8_WAIT_V(8); PG8_WAIT_L(0); PG8_BAR; PG8_MMA(0, 0, At, B0); PG8_MMA(0, 1, At, B1); PG8_BAR; PG8_SCHED;
            PG8_LDA(At, 1, 1); PG8_STAGE(PG8_SB(1, 0), b3, voffB); PG8_STAGE(PG8_SB(1, 1), b3 + hstepB, voffB); PG8_STAGE(PG8_SA(1, 0), a3, voffA);
            PG8_WAIT_V(8); PG8_WAIT_L(0); PG8_BAR; PG8_MMA(1, 0, At, B0); PG8_MMA(1, 1, At, B1); PG8_BAR; PG8_SCHED;
        }
        if (wr == 0) PG8_BAR;
        E(acc, cur, wr, wc, fr, fq, lds + ESC_OFF + eslot * ESC_SLOT);
        if (!has_next) break;
#pragma unroll
        for (int a = 0; a < 2; ++a)
#pragma unroll
            for (int b = 0; b < 2; ++b)
#pragma unroll
                for (int m = 0; m < 4; ++m)
#pragma unroll
                    for (int n = 0; n < 2; ++n) acc[a][b][m][n] = accv_t{};
        cur = nxt; cA = nA; cB = nB; ++ui; eslot ^= 1;
        if (wr == 1) PG8_BAR;
    }
    PG8_WAIT_V(0);
    PG8_BAR;
#undef PG8_SA
#undef PG8_SB
#undef PG8_STAGE
#undef PG8_LDA
#undef PG8_LDB
#undef PG8_MMA
#undef PG8_WAIT_V
#undef PG8_WAIT_L
#undef PG8_BAR
#undef PG8_SCHED
}
}

struct Frame {
    LAS unsigned char* lds;
    volatile LAS unsigned* MISC;
    gu32* ctl;
    unsigned char* ws;
    int tid, lane, wave, vcu, G;
    const float* const* in; float* out;
};
enum { I_X = 0, I_MEM, I_POS, I_GMIX, I_WIN, I_GQ, I_WUQ, I_GKV, I_WUKV, I_SINK, I_WMKV, I_WBR, I_WOUT, I_GFFN, I_WGD, I_WUD, I_WDD, I_WR, I_WGE, I_WUE, I_WDE, I_GMEM, I_GFIN };

__device__ __forceinline__ int sem_plain(int g) { return (g & ~31) + 8 * ((g >> 2) & 3) + 4 * ((g >> 4) & 1) + (g & 3); }
__device__ __forceinline__ int sem_rot64(int g) { return (g & ~63) + 32 * ((g >> 4) & 1) + 16 * ((g >> 5) & 1) + 4 * ((g >> 2) & 3) + (g & 3); }
__device__ __forceinline__ int inproj_src(int n) {
    const int pn = n >> 8, c = n & 255;
    if (pn < 2) return pn * 256 + sem_rot64(c);
    if (pn == 2) return c < 128 ? 512 + sem_rot64(c) : 640 + sem_plain(c - 128);
    if (pn == 3) return 768 + sem_plain(c);
    if (pn == 4) return c < 128 ? 1024 + sem_plain(c) : (c < 160 ? 1152 + (c - 128) : -1);
    if (pn < 7) return 1184 + (pn - 5) * 256 + sem_plain(c);
    return 1696 + (pn - 7) * 256 + sem_plain(c);
}

struct MapInproj { const float* W; __device__ __forceinline__ float load(int k, int n) const { const int s = inproj_src(n); return s >= 0 ? W[(size_t)k * INW + s] : 0.f; }
    __device__ __forceinline__ f32x4 load4(int k, int n) const { const int s = inproj_src(n); return s >= 0 ? *(const f32x4*)(W + (size_t)k * INW + s) : (f32x4){0.f, 0.f, 0.f, 0.f}; } };
struct MapUp { const float *Wq, *Wkv, *gq, *gkv;
    __device__ __forceinline__ f32x4 load4(int k, int n) const {
        if (n < 768) { const int gg = n >> 5; const int s = (gg % 3 == 2) ? n : sem_plain(n); return *(const f32x4*)(Wq + (size_t)k * 768 + s) * gq[k]; }
        if (k < 128) return (f32x4){0.f, 0.f, 0.f, 0.f}; const int s = sem_plain(n - 768); return *(const f32x4*)(Wkv + (size_t)(k - 128) * 1024 + s) * gkv[k - 128]; }
    __device__ __forceinline__ float load(int k, int n) const {
        if (n < 768) { const int gg = n >> 5; const int s = (gg % 3 == 2) ? n : sem_plain(n); return gq[k] * Wq[(size_t)k * 768 + s]; }
        if (k < 128) return 0.f; const int s = sem_plain(n - 768); return gkv[k - 128] * Wkv[(size_t)(k - 128) * 1024 + s]; } };
struct MapPlain { const float* W; int ldw; __device__ __forceinline__ float load(int k, int n) const { return W[(size_t)k * ldw + sem_plain(n)]; }
    __device__ __forceinline__ f32x4 load4(int k, int n) const { return *(const f32x4*)(W + (size_t)k * ldw + sem_plain(n)); } };
struct MapNat { const float* W; int ldw; __device__ __forceinline__ float load(int k, int n) const { return W[(size_t)k * ldw + n]; }
    __device__ __forceinline__ f32x4 load4(int k, int n) const { return *(const f32x4*)(W + (size_t)k * ldw + n); } };
struct MapBr { const float* W;
    __device__ __forceinline__ float load(int k, int n) const { return W[(size_t)k * DM + sem_plain(n)]; }
    __device__ __forceinline__ f32x4 load4(int k, int n) const { return *(const f32x4*)(W + (size_t)k * DM + sem_plain(n)); } };
struct MapMemkv { const float* W; __device__ __forceinline__ float load(int k, int n) const { const int l = n >> 10, c = n & 1023; return W[((size_t)l * DM + k) * 1024 + sem_plain(c)]; }
    __device__ __forceinline__ f32x4 load4(int k, int n) const { const int l = n >> 10, c = n & 1023; return *(const f32x4*)(W + ((size_t)l * DM + k) * 1024 + sem_plain(c)); } };
struct MapGU { const float *Wg, *Wu; __device__ __forceinline__ float load(int k, int n) const { const int pn = n >> 8, c = n & 255; const int ch = 128 * pn + sem_plain(c & 127);
    const unsigned long long a = (unsigned long long)Wg, b = (unsigned long long)Wu, w = a ^ ((a ^ b) & (0ull - (unsigned long long)(c >> 7))); return ((const float*)w)[(size_t)k * DFF + ch]; }
    __device__ __forceinline__ f32x4 load4(int k, int n) const { const int pn = n >> 8, c = n & 255; const int ch = 128 * pn + sem_plain(c & 127);
        const unsigned long long a = (unsigned long long)Wg, b = (unsigned long long)Wu, w = a ^ ((a ^ b) & (0ull - (unsigned long long)(c >> 7))); return *(const f32x4*)((const float*)w + (size_t)k * DFF + ch); } };

template <class M> __device__ __forceinline__ void prep_item(const M& m, bf16_t* dst, int Kd, int nblk, LAS float* scr, int item, int lane) {
    const int kb = item / nblk, nb = item % nblk, k0 = 64 * kb, n0 = 32 * nb;
#pragma unroll 8
    for (int i = 0; i < 32; ++i) { const int kk = 2 * i + (lane >> 5); scr[kk * 33 + (lane & 31)] = m.load(k0 + kk, n0 + (lane & 31)); }
    LDS_WAIT(); asm volatile("" ::: "memory");
    const int c = lane & 7;
#pragma unroll
    for (int j = 0; j < 4; ++j) { const int n = (lane >> 3) + 8 * j; const LAS float* s = scr + (8 * c) * 33 + n;
        u32x4 o; o.x = pk2(s[0 * 33], s[1 * 33]); o.y = pk2(s[2 * 33], s[3 * 33]); o.z = pk2(s[4 * 33], s[5 * 33]); o.w = pk2(s[6 * 33], s[7 * 33]);
        *(u32x4*)(dst + (size_t)(n0 + n) * Kd + k0 + 8 * c) = o; }
    LDS_WAIT(); asm volatile("" ::: "memory");
}
template <class M> __device__ __forceinline__ void prep_tile(const M& m, bf16_t* dst, int Kd, int nblk, LAS unsigned char* tile, int item, int lane) {
    const int kb = item / nblk, nb = item % nblk, k0 = 128 * kb, n0 = 32 * nb, ng = lane & 7, kr = lane >> 3;
    f32x4 v[16];
#pragma unroll
    for (int i = 0; i < 16; ++i) v[i] = m.load4(k0 + 8 * i + kr, n0 + 4 * ng);
#pragma unroll
    for (int i = 0; i < 16; ++i)
#pragma unroll
        for (int c = 0; c < 4; ++c) *(LAS unsigned short*)(tile + (4 * ng + c) * 272 + (8 * i + kr) * 2) = (unsigned short)f2bf(v[i][c]);
    LDS_WAIT(); asm volatile("" ::: "memory");
#pragma unroll
    for (int j = 0; j < 8; ++j) { const int p = lane + 64 * j, n = p >> 4, kc = p & 15;
        *(u32x4*)(dst + (size_t)(n0 + n) * Kd + k0 + 8 * kc) = *(const LAS u32x4*)(tile + n * 272 + 16 * kc); }
    LDS_WAIT(); asm volatile("" ::: "memory");
}
template <class M> __device__ __forceinline__ void prep_matrix(Frame& F, const M& m, bf16_t* dst, int N, int K) {
    LAS unsigned char* tile = F.lds + F.wave * 16384;
    const int gw = F.vcu * NWAVES + F.wave, NGW = F.G * NWAVES, nblk = N / 32, nitems = (K / 128) * nblk;
    for (int it = gw; it < nitems; it += NGW) prep_tile(m, dst, K, nblk, tile, it, F.lane);
}

template <class M> __device__ __forceinline__ void prep_strip_i8(Frame& F, const M& m, signed char* dst, float* scl, int strip) {
    const int lane = F.lane, w = F.wave, n0 = strip * 32, k0 = w * 128, ng = lane & 7, kr = lane >> 3;
    LAS unsigned char* tile = F.lds + w * 16384;
    LAS float* amt = (LAS float*)(F.lds + LDSCTL_OFF + 2048);
    f32x4 v[16];
#pragma unroll
    for (int i = 0; i < 16; ++i) v[i] = m.load4(k0 + 8 * i + kr, n0 + 4 * ng);
    f32x4 am = __builtin_elementwise_abs(v[0]);
#pragma unroll
    for (int i = 1; i < 16; ++i) am = __builtin_elementwise_max(am, __builtin_elementwise_abs(v[i]));
#pragma unroll
    for (int c = 0; c < 4; ++c) { float a = am[c]; a = fmaxf(a, __shfl_xor(a, 8)); a = fmaxf(a, __shfl_xor(a, 16)); a = fmaxf(a, __shfl_xor(a, 32)); am[c] = a; }
    if (kr == 0) *(LAS f32x4*)(amt + w * 32 + 4 * ng) = am;
    __syncthreads();
    f32x4 cm = *(const LAS f32x4*)(amt + 4 * ng);
#pragma unroll
    for (int ww = 1; ww < 8; ++ww) cm = __builtin_elementwise_max(cm, *(const LAS f32x4*)(amt + ww * 32 + 4 * ng));
    f32x4 inv;
#pragma unroll
    for (int c = 0; c < 4; ++c) inv[c] = cm[c] > 0.f ? 127.0f / cm[c] : 0.f;
    if (w == 0 && kr == 0) *(f32x4*)(scl + n0 + 4 * ng) = cm * (1.0f / 127.0f);
#pragma unroll
    for (int i = 0; i < 16; ++i)
#pragma unroll
        for (int c = 0; c < 4; ++c) tile[(4 * ng + c) * 144 + 8 * i + kr] = (unsigned char)(signed char)__float2int_rn(v[i][c] * inv[c]);
    LDS_WAIT(); asm volatile("" ::: "memory");
#pragma unroll
    for (int j = 0; j < 4; ++j) { const int p = lane + 64 * j, n = p >> 3, kc = p & 7;
        *(u32x4*)(dst + (size_t)(n0 + n) * DM + k0 + 16 * kc) = *(const LAS u32x4*)(tile + n * 144 + 16 * kc); }
    LDS_WAIT();
    __syncthreads();
}
__device__ __forceinline__ bf16_t* wmix(Frame& F, int l, size_t off) { return (bf16_t*)(F.ws + WS_WMIX + (size_t)l * WL_STRIDE + off); }

__device__ __forceinline__ void prep_mixer_weights(Frame& F) {
    for (int l = 0; l < DEPTH; ++l) {
        { MapInproj m{F.in[I_WIN] + (size_t)l * DM * INW}; for (int s = F.vcu; s < NT_IN * 8; s += F.G) prep_strip_i8(F, m, (signed char*)wmix(F, l, WL_IN), (float*)(F.ws + WS_MISC + MS_WSIN) + l * NT_IN * 256, s); }
        { MapUp m{F.in[I_WUQ] + (size_t)l * 256 * 768, F.in[I_WUKV] + (size_t)l * 128 * 1024, F.in[I_GQ] + l * 256, F.in[I_GKV] + l * 128}; prep_matrix(F, m, wmix(F, l, WL_UP), UPN, UPK); }
        { MapBr m{F.in[I_WBR] + (size_t)l * 3 * 512 * DM}; prep_matrix(F, m, wmix(F, l, WL_BR), DM, 1536); }
        { MapNat m{F.in[I_WOUT] + (size_t)l * DM * DM, DM}; prep_matrix(F, m, wmix(F, l, WL_OUT), DM, DM); }
    }
    { MapMemkv m{F.in[I_WMKV]}; prep_matrix(F, m, (bf16_t*)(F.ws + WS_WMKV), 4096, DM); }
}
__device__ __forceinline__ void prep_ffn_weights(Frame& F, int l) {
    const int i = l >> 1; const bool moe = (l & 1) != 0;
    LAS float* scr = (LAS float*)(F.lds + F.wave * 16384);
    const int gw = F.vcu * NWAVES + F.wave, NGW = F.G * NWAVES;
    constexpr int IGU = (DM / 64) * (2 * DFF / 32), ID = (DFF / 64) * (DM / 32), NSTRIP = 2 * DFF / 32;
    const int ne = moe ? NE : 1;
    const float* Wg = moe ? F.in[I_WGE] : F.in[I_WGD]; const float* Wu = moe ? F.in[I_WUE] : F.in[I_WUD]; const float* Wd = moe ? F.in[I_WDE] : F.in[I_WDD];
    if (GU_I8(l)) {
        for (int s = F.vcu; s < ne * NSTRIP; s += F.G) { const int e = s / NSTRIP, ss = s % NSTRIP; const size_t eo = ((size_t)i * ne + e) * DM * DFF;
            MapGU m{Wg + eo, Wu + eo}; prep_strip_i8(F, m, (signed char*)(F.ws + WS_WFFN + (size_t)e * WF_STRIDE), (float*)(F.ws + WS_MISC + MS_WSGU) + e * 2 * DFF, ss); }
    } else {
        for (int it = gw; it < ne * IGU; it += NGW) { const int e = it / IGU, r = it % IGU; const size_t eo = ((size_t)i * ne + e) * DM * DFF;
            MapGU m{Wg + eo, Wu + eo}; prep_item(m, (bf16_t*)(F.ws + WS_WFFN + (size_t)e * WF_STRIDE), DM, 2 * DFF / 32, scr, r, F.lane); }
    }
    constexpr int IDT = (DFF / 128) * (DM / 32);
    for (int it = gw; it < ne * IDT; it += NGW) { const int e = it / IDT, r = it % IDT; const size_t eo = ((size_t)i * ne + e) * DM * DFF;
        MapNat m{Wd + eo, DM}; prep_tile(m, (bf16_t*)(F.ws + WS_WFFN + (size_t)e * WF_STRIDE + WF_D), DFF, DM / 32, F.lds + F.wave * 16384, r, F.lane); }
}

struct RowV { f32x4 v[4]; };
__device__ __forceinline__ void row_load(RowV& r, const float* p, int lane) { const f32x4* x = (const f32x4*)p + lane;
#pragma unroll
    for (int j = 0; j < 4; ++j) r.v[j] = x[64 * j]; }
__device__ __forceinline__ void row_store(const RowV& r, float* p, int lane) { f32x4* x = (f32x4*)p + lane;
#pragma unroll
    for (int j = 0; j < 4; ++j) x[64 * j] = r.v[j]; }
__device__ __forceinline__ void row_add_bf16(RowV& r, const bf16_t* p, float w, int lane) { const u32x2* x = (const u32x2*)p + lane;
#pragma unroll
    for (int j = 0; j < 4; ++j) { const u32x2 q = x[64 * j]; r.v[j].x += w * bflo(q.x); r.v[j].y += w * bfhi(q.x); r.v[j].z += w * bflo(q.y); r.v[j].w += w * bfhi(q.y); } }
__device__ __forceinline__ float row_rstd(const RowV& r) { float s = 0.f;
#pragma unroll
    for (int j = 0; j < 4; ++j) s += (r.v[j].x * r.v[j].x + r.v[j].y * r.v[j].y) + (r.v[j].z * r.v[j].z + r.v[j].w * r.v[j].w);
    return 1.0f / sqrtf(wave_sum(s) * (1.0f / DM) + EPS); }
__device__ __forceinline__ void row_scale(RowV& r, float rstd, const float* g, int lane) { const f32x4* gg = (const f32x4*)g + lane;
#pragma unroll
    for (int j = 0; j < 4; ++j) r.v[j] = r.v[j] * rstd * gg[64 * j]; }
__device__ __forceinline__ void row_store_bf16(const RowV& r, bf16_t* p, int lane) { u32x2* o = (u32x2*)p + lane;
#pragma unroll
    for (int j = 0; j < 4; ++j) { u32x2 w; w.x = pk2(r.v[j].x, r.v[j].y); w.y = pk2(r.v[j].z, r.v[j].w); o[64 * j] = w; } }

__device__ __forceinline__ float row_store_i8(const RowV& r, signed char* p, int lane) {
    float am = 0.f;
#pragma unroll
    for (int j = 0; j < 4; ++j) am = fmaxf(am, fmaxf(fmaxf(fabsf(r.v[j].x), fabsf(r.v[j].y)), fmaxf(fabsf(r.v[j].z), fabsf(r.v[j].w))));
#pragma unroll
    for (int o = 1; o < 64; o <<= 1) am = fmaxf(am, __shfl_xor(am, o));
    const float inv = am > 0.f ? 127.0f / am : 0.f; unsigned* o4 = (unsigned*)p + lane;
#pragma unroll
    for (int j = 0; j < 4; ++j) { const unsigned a = (unsigned)__float2int_rn(r.v[j].x * inv) & 255u, b = (unsigned)__float2int_rn(r.v[j].y * inv) & 255u, c = (unsigned)__float2int_rn(r.v[j].z * inv) & 255u, d = (unsigned)__float2int_rn(r.v[j].w * inv) & 255u;
        o4[64 * j] = a | (b << 8) | (c << 16) | (d << 24); }
    return am * (1.0f / 127.0f);
}
__device__ __forceinline__ void row_combine(Frame& F, RowV& r, int t) {
    const int* sl = (const int*)(F.ws + WS_MISC + MS_SLOT) + 2 * t; const float* tw = (const float*)(F.ws + WS_MISC + MS_TOKW) + 2 * t;
    const bf16_t* Y = (const bf16_t*)(F.ws + WS_R + R_YOUT);
    const int s0 = sl[0], s1 = sl[1]; const float w0 = tw[0], w1 = tw[1];
    row_add_bf16(r, Y + (size_t)s0 * DM, w0, F.lane); row_add_bf16(r, Y + (size_t)s1 * DM, w1, F.lane);
}

__device__ __forceinline__ void norm_phase(Frame& F, const float* src, float* X, const float* g, bool combine, bool out_i8) {
    bf16_t* H = (bf16_t*)(F.ws + WS_H); signed char* Hq = (signed char*)(F.ws + WS_H); float* hsc = (float*)(F.ws + WS_MISC + MS_HSC);
    const int gw = F.vcu * NWAVES + F.wave, NGW = F.G * NWAVES;
    for (int t = gw; t < T; t += 2 * NGW) {
        const int t2 = t + NGW;
        RowV r, q; row_load(r, src + (size_t)t * DM, F.lane); row_load(q, src + (size_t)t2 * DM, F.lane);
        if (combine) { row_combine(F, r, t); row_combine(F, q, t2); row_store(r, X + (size_t)t * DM, F.lane); row_store(q, X + (size_t)t2 * DM, F.lane); }
        const float rstd = row_rstd(r), qstd = row_rstd(q); row_scale(r, rstd, g, F.lane); row_scale(q, qstd, g, F.lane);
        if (out_i8) { const float sc = row_store_i8(r, Hq + (size_t)t * DM, F.lane), sq = row_store_i8(q, Hq + (size_t)t2 * DM, F.lane); if (F.lane == 0) { hsc[t] = sc; hsc[t2] = sq; } }
        else { row_store_bf16(r, H + (size_t)t * DM, F.lane); row_store_bf16(q, H + (size_t)t2 * DM, F.lane); }
    }
}
__device__ __forceinline__ void final_norm_phase(Frame& F, float* X, const float* g, bool combine) {
    const int gw = F.vcu * NWAVES + F.wave, NGW = F.G * NWAVES;
    for (int t = gw; t < T; t += 2 * NGW) {
        const int t2 = t + NGW;
        RowV r, q; row_load(r, X + (size_t)t * DM, F.lane); row_load(q, X + (size_t)t2 * DM, F.lane);
        if (combine) { row_combine(F, r, t); row_combine(F, q, t2); }
        const float rstd = row_rstd(r), qstd = row_rstd(q); row_scale(r, rstd, g, F.lane); row_scale(q, qstd, g, F.lane);
        row_store(r, X + (size_t)t * DM, F.lane); row_store(q, X + (size_t)t2 * DM, F.lane);
    }
}
__device__ __forceinline__ void memnorm_phase(Frame& F) {
    bf16_t* MN = (bf16_t*)(F.ws + WS_MEMN);
    const int gw = F.vcu * NWAVES + F.wave, NGW = F.G * NWAVES;
    for (int t = gw; t < NB * MEML; t += NGW) {
        RowV r; row_load(r, F.in[I_MEM] + (size_t)t * DM, F.lane);
        const float rstd = row_rstd(r); row_scale(r, rstd, F.in[I_GMEM], F.lane);
        row_store_bf16(r, MN + (size_t)t * DM, F.lane);
    }
}

__device__ __forceinline__ void norm_router_phase(Frame& F, const float* X, const float* g, const float* Wr  , bool out_i8) {
    bf16_t* H = (bf16_t*)(F.ws + WS_H); signed char* Hq = (signed char*)(F.ws + WS_H); float* hsc = (float*)(F.ws + WS_MISC + MS_HSC);
    int* toke = (int*)(F.ws + WS_MISC + MS_TOKE); float* tokw = (float*)(F.ws + WS_MISC + MS_TOKW); int* cntg = (int*)(F.ws + WS_MISC + MS_CNT);
    volatile LAS int* hist = (volatile LAS int*)(F.lds + LDSCTL_OFF + 1024);
    for (int c = F.vcu; c < T / 128; c += F.G) {
        if (F.tid < 8) hist[F.tid] = 0;
        __syncthreads();
        for (int q = 0; q < 16; ++q) {
            const int t = c * 128 + F.wave * 16 + q;
            RowV r; row_load(r, X + (size_t)t * DM, F.lane);
            const float rstd = row_rstd(r); row_scale(r, rstd, g, F.lane);
            if (out_i8) { const float sc = row_store_i8(r, Hq + (size_t)t * DM, F.lane); if (F.lane == 0) hsc[t] = sc; }
            else row_store_bf16(r, H + (size_t)t * DM, F.lane);
            float lg[8];
#pragma unroll
            for (int e = 0; e < 8; ++e) lg[e] = 0.f;
#pragma unroll
            for (int j = 0; j < 4; ++j) {
#pragma unroll
                for (int k = 0; k < 4; ++k) { const int d = 256 * j + 4 * F.lane + k; const f32x4 wa = *(const f32x4*)(Wr + (size_t)d * 8), wb = *(const f32x4*)(Wr + (size_t)d * 8 + 4); const float x = r.v[j][k];
                    lg[0] += x * wa.x; lg[1] += x * wa.y; lg[2] += x * wa.z; lg[3] += x * wa.w; lg[4] += x * wb.x; lg[5] += x * wb.y; lg[6] += x * wb.z; lg[7] += x * wb.w; } }
#pragma unroll
            for (int e = 0; e < 8; ++e) lg[e] = wave_sum(lg[e]);
            int e0 = 0; float v0 = lg[0];
#pragma unroll
            for (int e = 1; e < 8; ++e) if (lg[e] > v0) { v0 = lg[e]; e0 = e; }
            int e1 = -1; float v1 = -INFINITY;
#pragma unroll
            for (int e = 0; e < 8; ++e) if (e != e0 && lg[e] > v1) { v1 = lg[e]; e1 = e; }
            if (F.lane == 0) {
                const float w0 = 1.0f / (1.0f + __expf(v1 - v0));
                toke[2 * t] = e0; toke[2 * t + 1] = e1; tokw[2 * t] = w0; tokw[2 * t + 1] = 1.0f - w0;
                __hip_atomic_fetch_add((LAS int*)&hist[e0], 1, __ATOMIC_RELAXED, __HIP_MEMORY_SCOPE_WORKGROUP); __hip_atomic_fetch_add((LAS int*)&hist[e1], 1, __ATOMIC_RELAXED, __HIP_MEMORY_SCOPE_WORKGROUP);
            }
        }
        __syncthreads();
        if (F.tid < 8) cntg[c * 8 + F.tid] = hist[F.tid];
        __syncthreads();
    }
}
__device__ __forceinline__ void moe_assign_phase(Frame& F, bool i8) {
    const bf16_t* H = (const bf16_t*)(F.ws + WS_H); bf16_t* AS = (bf16_t*)(F.ws + WS_R + R_ASORT);
    const float* hsc = (const float*)(F.ws + WS_MISC + MS_HSC); float* asc = (float*)(F.ws + WS_MISC + MS_ASC);
    const int* toke = (const int*)(F.ws + WS_MISC + MS_TOKE); int* slot = (int*)(F.ws + WS_MISC + MS_SLOT); const int* cntg = (const int*)(F.ws + WS_MISC + MS_CNT);
    int* texp = (int*)(F.ws + WS_MISC + MS_TEXP);
    volatile LAS int* tot = (volatile LAS int*)(F.lds + LDSCTL_OFF + 1024);
    volatile LAS int* pre = tot + 8;
    volatile LAS int* wcnt = tot + 16;
    for (int c = F.vcu; c < T / 128; c += F.G) {
        if (F.tid < 16) tot[F.tid] = 0;
        __syncthreads();
        { const int cc = F.tid >> 1, h = F.tid & 1; const i32x4 v = *(const i32x4*)(cntg + cc * 8 + 4 * h);
#pragma unroll
          for (int k = 0; k < 4; ++k) { __hip_atomic_fetch_add((LAS int*)&tot[4 * h + k], v[k], __ATOMIC_RELAXED, __HIP_MEMORY_SCOPE_WORKGROUP); if (cc < c) __hip_atomic_fetch_add((LAS int*)&pre[4 * h + k], v[k], __ATOMIC_RELAXED, __HIP_MEMORY_SCOPE_WORKGROUP); } }
        const int t = c * 128 + F.wave * 16 + ((F.lane & 31) >> 1);
        const int my_e = (F.lane < 32) ? toke[2 * t + (F.lane & 1)] : -1;
        int rank = 0;
#pragma unroll
        for (int e = 0; e < 8; ++e) { const unsigned long long m = __ballot(my_e == e); if (my_e == e) rank = __popcll(m & ((1ull << F.lane) - 1ull)); if (F.lane == 0) wcnt[F.wave * 8 + e] = __popcll(m); }
        __syncthreads();
        int myslot = 0;
        if (F.lane < 32) {
            int ts = 0;
#pragma unroll
            for (int e = 0; e < 8; ++e) ts += (e < my_e) ? ((tot[e] + 255) >> 8) : 0;
            int wp = 0; for (int w = 0; w < F.wave; ++w) wp += wcnt[w * 8 + my_e];
            myslot = ts * 256 + pre[my_e] + wp + rank;
            slot[2 * t + (F.lane & 1)] = myslot;
        }
        if (c == 0 && F.tid == 0) { int ts = 0; for (int e = 0; e < 8; ++e) { const int n = (tot[e] + 255) >> 8; for (int k = 0; k < n; ++k) texp[ts + k] = e; ts += n; } for (int k = ts; k < MAXRT; ++k) texp[k] = 0; texp[MAXRT] = ts; }
        if (i8) {
            const float myh = hsc[t];
#pragma unroll 1
            for (int a0 = 0; a0 < 32; a0 += 8) {
                u32x4 x[4];
#pragma unroll
                for (int k = 0; k < 4; ++k) x[k] = *((const u32x4*)((const signed char*)H + (size_t)(c * 128 + F.wave * 16 + ((a0 + 2 * k) >> 1)) * DM) + F.lane);
#pragma unroll
                for (int k = 0; k < 8; ++k) { const int s = __builtin_amdgcn_readlane(myslot, a0 + k); *((u32x4*)((signed char*)AS + (size_t)s * DM) + F.lane) = x[k >> 1]; }
            }
            if (F.lane < 32) asc[myslot] = myh;
        } else {
            for (int a = 0; a < 32; ++a) {
                const int s = __builtin_amdgcn_readlane(myslot, a); const int ta = c * 128 + F.wave * 16 + (a >> 1);
                const u32x4* srcp = (const u32x4*)(H + (size_t)ta * DM) + F.lane; u32x4* dstp = (u32x4*)(AS + (size_t)s * DM) + F.lane;
                const u32x4 x0 = srcp[0], x1 = srcp[64]; dstp[0] = x0; dstp[64] = x1; }
        }
        __syncthreads();
    }
}

using pg8::Unit;
typedef f32x4 AccT[2][2][4][2];

struct ProbSimple { int K; unsigned lda, ldb; const char* A; const char* B;
    __device__ __forceinline__ const char* a_ptr(const Unit& u) const { return A + (size_t)u.pm * 256 * lda; }
    __device__ __forceinline__ const char* b_ptr(const Unit& u) const { return B + (size_t)u.pn * 256 * ldb; } };
struct ProbUp { int K; unsigned lda, ldb; const char* A; const char* B;
    __device__ __forceinline__ const char* a_ptr(const Unit& u) const { return A + (size_t)u.pm * 256 * lda + (u.pn >= 3 ? 256 : 0); }
    __device__ __forceinline__ const char* b_ptr(const Unit& u) const { return B + (size_t)u.pn * 256 * ldb; } };
struct ProbMoe { int K; unsigned lda, ldb; const char* A; const char* B; int a_lo;
    __device__ __forceinline__ const char* a_ptr(const Unit& u) const { return A + (size_t)(u.pm - a_lo) * 256 * lda; }
    __device__ __forceinline__ const char* b_ptr(const Unit& u) const { return B + (size_t)u.aux * WF_STRIDE + (size_t)u.pn * 256 * ldb; } };

struct MoeOrder { pg8::StaticOrder base; int lo; const int* texp;
    __device__ bool next(int i, Unit& u) const { if (!base.next(i, u)) return false; u.pm += lo; u.aux = __builtin_amdgcn_readfirstlane(texp[u.pm]); return true; } };

__device__ __forceinline__ u32x4 pack8(const f32x4 a, const f32x4 b) { u32x4 w; w.x = cvtpk(a[0], a[1]); w.y = cvtpk(a[2], a[3]); w.z = cvtpk(b[0], b[1]); w.w = cvtpk(b[2], b[3]); return w; }
__device__ __forceinline__ u32x2 pack4(const f32x4 a) { u32x2 w; w.x = cvtpk(a[0], a[1]); w.y = cvtpk(a[2], a[3]); return w; }

struct EpiNoStage { __device__ __forceinline__ void stage(LAS unsigned char*, const Unit&, int, int) const {} };
__device__ __forceinline__ void stage1k(const void* src, LAS unsigned char* dst, int lane) { __builtin_amdgcn_global_load_lds((const unsigned*)((const char*)src + lane * 16), (LAS unsigned*)dst, 16, 0, 0); }
__device__ __forceinline__ f32x4 deq(const f32x4& a, float, const f32x4&) { return a; }
__device__ __forceinline__ f32x4 deq(const i32x4& a, float rs, const f32x4& cs) { return __builtin_convertvector(a, f32x4) * rs * cs; }
struct EpiInproj {
    static constexpr bool MID = false;
    bf16_t* P; bf16_t* G; float* ssq; const int* pos; const float* rsc; const float* csc;
    __device__ __forceinline__ void stage(LAS unsigned char* d, const Unit& u, int wid, int lane) const {
        if (wid == 0) { stage1k(rsc + u.pm * 256, d, lane); stage1k(csc + u.pn * 256, d + 1024, lane); stage1k(pos + u.pm * 256, d + 2048, lane); } }
    template <class AV> __device__ __forceinline__ void operator()(const AV (&acc)[2][2][4][2], const Unit& u, int wr, int wc, int fr, int fq, const LAS unsigned char* esc) const {
        const int pn = u.pn, row0 = u.pm * 256 + wr * 64 + fr;
        f32x4 cs[2][2];
#pragma unroll
        for (int bj = 0; bj < 2; ++bj)
#pragma unroll
            for (int n = 0; n < 2; ++n) cs[bj][n] = *(const LAS f32x4*)(esc + 1024 + (bj * 128 + wc * 32 + n * 16 + fq * 4) * 4);
        float rs8[2][4], pf8[2][4];
#pragma unroll
        for (int ai = 0; ai < 2; ++ai)
#pragma unroll
            for (int m = 0; m < 4; ++m) { const int rl = ai * 128 + wr * 64 + m * 16 + fr; rs8[ai][m] = *(const LAS float*)(esc + rl * 4); pf8[ai][m] = (float)*(const LAS int*)(esc + 2048 + rl * 4); }
#define DQ(ai, bj, m, n) deq(acc[ai][bj][m][n], rs, cs[bj][n])
        if (pn >= 7) {
#pragma unroll
            for (int ai = 0; ai < 2; ++ai)
#pragma unroll
                for (int m = 0; m < 4; ++m) { const int row = row0 + ai * 128 + m * 16; const float rs = rs8[ai][m];
#pragma unroll
                    for (int bj = 0; bj < 2; ++bj) { f32x4 a = DQ(ai, bj, m, 0), b = DQ(ai, bj, m, 1);
#pragma unroll
                        for (int j = 0; j < 4; ++j) { a[j] = fast_sigmoid(a[j]) * 255.0f; b[j] = fast_sigmoid(b[j]) * 255.0f; }
                        u32x2 w; w.x = (unsigned)__float2int_rn(a[0]) | ((unsigned)__float2int_rn(a[1]) << 8) | ((unsigned)__float2int_rn(a[2]) << 16) | ((unsigned)__float2int_rn(a[3]) << 24);
                        w.y = (unsigned)__float2int_rn(b[0]) | ((unsigned)__float2int_rn(b[1]) << 8) | ((unsigned)__float2int_rn(b[2]) << 16) | ((unsigned)__float2int_rn(b[3]) << 24);
                        *(u32x2*)((unsigned char*)G + (size_t)row * GW + (pn - 7) * 256 + bj * 128 + wc * 32 + fq * 8) = w; } }
        } else if (pn >= 5 || pn == 3) {
            const float sc = (pn == 3) ? 1.0f : C_M;
#pragma unroll
            for (int ai = 0; ai < 2; ++ai)
#pragma unroll
                for (int m = 0; m < 4; ++m) { const int row = row0 + ai * 128 + m * 16; const float rs = rs8[ai][m]; float s = 0.f;
#pragma unroll
                    for (int bj = 0; bj < 2; ++bj) { const f32x4 a = DQ(ai, bj, m, 0) * sc, b = DQ(ai, bj, m, 1) * sc;
                        s += (a[0] * a[0] + a[1] * a[1]) + (a[2] * a[2] + a[3] * a[3]) + (b[0] * b[0] + b[1] * b[1]) + (b[2] * b[2] + b[3] * b[3]);
                        *(u32x4*)(P + (size_t)row * PW + pn * 256 + bj * 128 + wc * 32 + fq * 8) = pack8(a, b); }
                    if (pn == 3) { s += __shfl_xor(s, 16); s += __shfl_xor(s, 32); if (fq == 0) ssq[(size_t)row * 8 + wc] = s; } }
        } else if (pn == 4) {
#pragma unroll
            for (int ai = 0; ai < 2; ++ai)
#pragma unroll
                for (int m = 0; m < 4; ++m) { const int row = row0 + ai * 128 + m * 16; const float rs = rs8[ai][m];
                    { const f32x4 a = DQ(ai, 0, m, 0), b = DQ(ai, 0, m, 1);
                      float s = (a[0] * a[0] + a[1] * a[1]) + (a[2] * a[2] + a[3] * a[3]) + (b[0] * b[0] + b[1] * b[1]) + (b[2] * b[2] + b[3] * b[3]);
                      *(u32x4*)(P + (size_t)row * PW + P_CKV + wc * 32 + fq * 8) = pack8(a, b);
                      s += __shfl_xor(s, 16); s += __shfl_xor(s, 32); if (fq == 0) ssq[(size_t)row * 8 + 4 + wc] = s; }
                    if (wc == 0) { const f32x4 x1 = DQ(ai, 1, m, 0), x2 = DQ(ai, 1, m, 1); const float pf = pf8[ai][m]; f32x4 o1, o2;
#pragma unroll
                        for (int j = 0; j < 4; ++j) { float c, s; rot_cs(pf, 2 * (4 * fq + j), c, s); o1[j] = x1[j] * c - x2[j] * s; o2[j] = x2[j] * c + x1[j] * s; }
                        *(u32x2*)(P + (size_t)row * PW + P_KR + 4 * fq) = pack4(o1); *(u32x2*)(P + (size_t)row * PW + P_KR + 16 + 4 * fq) = pack4(o2); } }
        } else {
            const float sc = (pn < 2) ? C_A : 1.0f; const int i0 = 16 * (wc & 1) + 4 * fq;
#pragma unroll
            for (int ai = 0; ai < 2; ++ai)
#pragma unroll
                for (int m = 0; m < 4; ++m) { const int row = row0 + ai * 128 + m * 16; const float rs = rs8[ai][m]; const float pf = pf8[ai][m]; f32x4 c, s;
#pragma unroll
                    for (int j = 0; j < 4; ++j) { float cc, ss; rot_cs(pf, i0 + j, cc, ss); c[j] = cc * sc; s[j] = ss * sc; }
#pragma unroll
                    for (int bj = 0; bj < 2; ++bj) { const f32x4 x1 = DQ(ai, bj, m, 0), x2 = DQ(ai, bj, m, 1);
                        if (pn == 2 && bj == 1) { *(u32x4*)(P + (size_t)row * PW + P_VA + wc * 32 + fq * 8) = pack8(x1, x2); }
                        else { const f32x4 o1 = x1 * c - x2 * s, o2 = x2 * c + x1 * s; bf16_t* d = P + (size_t)row * PW + pn * 256 + 64 * (2 * bj + (wc >> 1)) + i0;
                            *(u32x2*)d = pack4(o1); *(u32x2*)(d + 32) = pack4(o2); } } }
        }
#undef DQ
    }
};
struct EpiUp {
    static constexpr bool MID = false;
    __device__ __forceinline__ void stage(LAS unsigned char*, const Unit&, int, int) const {}
    bf16_t* QB; bf16_t* KVB; const float* ssq; const int* pos;
    __device__ __forceinline__ void operator()(const AccT& acc, const Unit& u, int wr, int wc, int fr, int fq, const LAS unsigned char*) const {
        const int pn = u.pn, row0 = u.pm * 256 + wr * 64 + fr;
        float rs8[2][4], pf8[2][4];
#pragma unroll
        for (int ai = 0; ai < 2; ++ai)
#pragma unroll
            for (int m = 0; m < 4; ++m) { const int row = row0 + ai * 128 + m * 16; const f32x4 sv = *(const f32x4*)(ssq + (size_t)row * 8 + (pn < 3 ? 0 : 4));
                rs8[ai][m] = (pn < 3 ? C_B : 1.0f) / sqrtf(((sv[0] + sv[1]) + (sv[2] + sv[3])) * (pn < 3 ? 1.0f / 256.0f : 1.0f / 128.0f) + EPS); pf8[ai][m] = (pn < 3) ? (float)pos[row] : 0.f; }
#pragma unroll
        for (int ai = 0; ai < 2; ++ai)
#pragma unroll
            for (int m = 0; m < 4; ++m) { const int row = row0 + ai * 128 + m * 16; const float rs = rs8[ai][m];
                if (pn < 3) {
#pragma unroll
                    for (int bj = 0; bj < 2; ++bj) { const int gg = 8 * pn + 4 * bj + wc; const f32x4 x1 = acc[ai][bj][m][0] * rs, x2 = acc[ai][bj][m][1] * rs;
                        if (gg % 3 == 2) { const float pf = pf8[ai][m]; f32x4 o1, o2;
#pragma unroll
                            for (int j = 0; j < 4; ++j) { float c, s; rot_cs(pf, 2 * (4 * fq + j), c, s); o1[j] = x1[j] * c - x2[j] * s; o2[j] = x2[j] * c + x1[j] * s; }
                            bf16_t* d = QB + (size_t)row * QBW + 32 * gg + 4 * fq; *(u32x2*)d = pack4(o1); *(u32x2*)(d + 16) = pack4(o2); }
                        else *(u32x4*)(QB + (size_t)row * QBW + 32 * gg + 8 * fq) = pack8(x1, x2); }
                } else {
#pragma unroll
                    for (int bj = 0; bj < 2; ++bj) *(u32x4*)(KVB + (size_t)row * KVW + (pn - 3) * 256 + bj * 128 + wc * 32 + fq * 8) = pack8(acc[ai][bj][m][0] * rs, acc[ai][bj][m][1] * rs);
                } }
    }
};
struct EpiPlain {
    static constexpr bool MID = false;
    __device__ __forceinline__ void stage(LAS unsigned char*, const Unit&, int, int) const {}
    bf16_t* O; int ldo;
    __device__ __forceinline__ void operator()(const AccT& acc, const Unit& u, int wr, int wc, int fr, int fq, const LAS unsigned char*) const {
        const int row0 = u.pm * 256 + wr * 64 + fr;
#pragma unroll
        for (int ai = 0; ai < 2; ++ai)
#pragma unroll
            for (int m = 0; m < 4; ++m)
#pragma unroll
                for (int bj = 0; bj < 2; ++bj) *(u32x4*)(O + (size_t)(row0 + ai * 128 + m * 16) * ldo + u.pn * 256 + bj * 128 + wc * 32 + fq * 8) = pack8(acc[ai][bj][m][0], acc[ai][bj][m][1]);
    }
};
struct EpiBranch {
    static constexpr bool MID = true;
    const unsigned char* G; bf16_t* MIXED;
    __device__ __forceinline__ void stage(LAS unsigned char*, const Unit&, int, int) const {}
    static __device__ __forceinline__ float gq(unsigned w, int b) { const float f = (float)((w >> (8 * b)) & 255u); return fmaxf(f, 2.55e-4f); }
    __device__ __forceinline__ void mid(AccT& acc, const Unit& u, int seg  , int wr, int wc, int fr, int fq) const {
        const int row0 = opq_v(u.pm * 256 + wr * 64 + fr);
#pragma unroll
        for (int ai = 0; ai < 2; ++ai) {
            u32x2 ga[4][2], gb[4][2];
#pragma unroll
            for (int m = 0; m < 4; ++m)
#pragma unroll
                for (int bj = 0; bj < 2; ++bj) { const unsigned char* gp = G + (size_t)(row0 + ai * 128 + m * 16) * GW + u.pn * 256 + bj * 128 + wc * 32 + fq * 8;
                    ga[m][bj] = *(const u32x2*)(gp + (seg - 1) * 1024); gb[m][bj] = *(const u32x2*)(gp + seg * 1024); }
#pragma unroll
            for (int m = 0; m < 4; ++m)
#pragma unroll
                for (int bj = 0; bj < 2; ++bj) { const u32x2 a2 = ga[m][bj], b2 = gb[m][bj];
#pragma unroll
                    for (int j = 0; j < 4; ++j) { acc[ai][bj][m][0][j] *= gq(a2.x, j) * __builtin_amdgcn_rcpf(gq(b2.x, j)); acc[ai][bj][m][1][j] *= gq(a2.y, j) * __builtin_amdgcn_rcpf(gq(b2.y, j)); } }
            asm volatile("" ::: "memory"); }
    }
    __device__ __forceinline__ void operator()(const AccT& acc, const Unit& u, int wr, int wc, int fr, int fq, const LAS unsigned char*) const {
        const int row0 = u.pm * 256 + wr * 64 + fr;
#pragma unroll
        for (int ai = 0; ai < 2; ++ai) {
            u32x2 gw[4][2];
#pragma unroll
            for (int m = 0; m < 4; ++m)
#pragma unroll
                for (int bj = 0; bj < 2; ++bj) gw[m][bj] = *(const u32x2*)(G + (size_t)(row0 + ai * 128 + m * 16) * GW + 2048 + u.pn * 256 + bj * 128 + wc * 32 + fq * 8);
#pragma unroll
            for (int m = 0; m < 4; ++m)
#pragma unroll
                for (int bj = 0; bj < 2; ++bj) { const u32x2 g2 = gw[m][bj]; f32x4 a = acc[ai][bj][m][0], b = acc[ai][bj][m][1];
#pragma unroll
                    for (int j = 0; j < 4; ++j) { a[j] *= gq(g2.x, j) * (1.0f / 255.0f); b[j] *= gq(g2.y, j) * (1.0f / 255.0f); }
                    *(u32x4*)(MIXED + (size_t)(row0 + ai * 128 + m * 16) * DM + u.pn * 256 + bj * 128 + wc * 32 + fq * 8) = pack8(a, b); }
            asm volatile("" ::: "memory"); }
    }
};
struct EpiResid {
    static constexpr bool MID = false;
    __device__ __forceinline__ void stage(LAS unsigned char*, const Unit&, int, int) const {}
    const float* Xin; float* Xout;
    __device__ __forceinline__ void operator()(const AccT& acc, const Unit& u, int wr, int wc, int fr, int fq, const LAS unsigned char*) const {
        const int row0 = u.pm * 256 + wr * 64 + fr;
#pragma unroll
        for (int ai = 0; ai < 2; ++ai)
#pragma unroll
            for (int mp = 0; mp < 2; ++mp) {
                f32x4 xv[2][2][2];
#pragma unroll
                for (int mm = 0; mm < 2; ++mm)
#pragma unroll
                    for (int bj = 0; bj < 2; ++bj)
#pragma unroll
                        for (int n = 0; n < 2; ++n) xv[mm][bj][n] = *(const f32x4*)(Xin + (size_t)(row0 + ai * 128 + (2 * mp + mm) * 16) * DM + u.pn * 256 + bj * 128 + wc * 32 + n * 16 + fq * 4);
#pragma unroll
                for (int mm = 0; mm < 2; ++mm)
#pragma unroll
                    for (int bj = 0; bj < 2; ++bj)
#pragma unroll
                        for (int n = 0; n < 2; ++n) *(f32x4*)(Xout + (size_t)(row0 + ai * 128 + (2 * mp + mm) * 16) * DM + u.pn * 256 + bj * 128 + wc * 32 + n * 16 + fq * 4) = xv[mm][bj][n] + acc[ai][bj][2 * mp + mm][n];
                asm volatile("" ::: "memory"); }
    }
};
struct EpiSwiglu {
    static constexpr bool MID = false;
    bf16_t* ACT; int lo; const float* rsc; const float* csc;
    __device__ __forceinline__ void stage(LAS unsigned char* d, const Unit& u, int wid, int lane) const {
        if (wid == 0) { stage1k(rsc + u.pm * 256, d, lane); stage1k(csc + (size_t)u.aux * 2 * DFF + u.pn * 256, d + 1024, lane); } }
    template <class AV> __device__ __forceinline__ void operator()(const AV (&acc)[2][2][4][2], const Unit& u, int wr, int wc, int fr, int fq, const LAS unsigned char* esc) const {
        const int row0 = (u.pm - lo) * 256 + wr * 64 + fr;
        f32x4 cs[2][2];
#pragma unroll
        for (int bj = 0; bj < 2; ++bj)
#pragma unroll
            for (int n = 0; n < 2; ++n) cs[bj][n] = *(const LAS f32x4*)(esc + 1024 + (bj * 128 + wc * 32 + n * 16 + fq * 4) * 4);
        float rs8[2][4];
#pragma unroll
        for (int ai = 0; ai < 2; ++ai)
#pragma unroll
            for (int m = 0; m < 4; ++m) rs8[ai][m] = *(const LAS float*)(esc + (ai * 128 + wr * 64 + m * 16 + fr) * 4);
#pragma unroll
        for (int ai = 0; ai < 2; ++ai)
#pragma unroll
            for (int m = 0; m < 4; ++m) { const float rs = rs8[ai][m]; f32x4 a, b;
                const f32x4 g0 = deq(acc[ai][0][m][0], rs, cs[0][0]), g1 = deq(acc[ai][0][m][1], rs, cs[0][1]), u0 = deq(acc[ai][1][m][0], rs, cs[1][0]), u1 = deq(acc[ai][1][m][1], rs, cs[1][1]);
#pragma unroll
                for (int j = 0; j < 4; ++j) { a[j] = g0[j] * fast_sigmoid(g0[j]) * u0[j]; b[j] = g1[j] * fast_sigmoid(g1[j]) * u1[j]; }
                *(u32x4*)(ACT + (size_t)(row0 + ai * 128 + m * 16) * DFF + u.pn * 128 + wc * 32 + fq * 8) = pack8(a, b); }
    }
};
struct EpiYout {
    static constexpr bool MID = false;
    __device__ __forceinline__ void stage(LAS unsigned char*, const Unit&, int, int) const {}
    bf16_t* Y;
    __device__ __forceinline__ void operator()(const AccT& acc, const Unit& u, int wr, int wc, int fr, int fq, const LAS unsigned char*) const {
        const int row0 = u.pm * 256 + wr * 64 + fr;
#pragma unroll
        for (int ai = 0; ai < 2; ++ai)
#pragma unroll
            for (int m = 0; m < 4; ++m)
#pragma unroll
                for (int bj = 0; bj < 2; ++bj)
#pragma unroll
                    for (int n = 0; n < 2; ++n) *(u32x2*)(Y + (size_t)(row0 + ai * 128 + m * 16) * DM + u.pn * 256 + bj * 128 + wc * 32 + n * 16 + fq * 4) = pack4(acc[ai][bj][m][n]);
    }
};

namespace att {
__device__ __forceinline__ int crow(int r, int hi) { return (r & 3) + 8 * (r >> 2) + 4 * hi; }
__device__ __forceinline__ void glds16(const void* gsrc, unsigned lds_dst) { unsigned keep;
    asm volatile("s_mov_b32 %0, m0\n\ts_mov_b32 m0, %2\n\ts_nop 0\n\tglobal_load_lds_dwordx4 %1, off\n\ts_mov_b32 m0, %0" : "=&s"(keep) : "v"(gsrc), "s"(lds_dst) : "memory"); }
__device__ __forceinline__ float swapmax(float m) { auto rr = __builtin_amdgcn_permlane32_swap(__float_as_uint(m), __float_as_uint(m), false, false); return fmaxf(__uint_as_float(rr[0]), __uint_as_float(rr[1])); }
__device__ __forceinline__ float swapsum(float m) { auto rr = __builtin_amdgcn_permlane32_swap(__float_as_uint(m), __float_as_uint(m), false, false); return __uint_as_float(rr[0]) + __uint_as_float(rr[1]); }
__device__ __forceinline__ s16x4 vtr(unsigned addr) { s16x4 r; asm volatile("ds_read_b64_tr_b16 %0, %1" : "=&v"(r) : "v"(addr) : "memory"); return r; }
#define VTRO(dst, base, off) asm volatile("ds_read_b64_tr_b16 %0, %1 offset:%c2" : "=&v"(dst) : "v"(base), "i"(off) : "memory")

struct Src {
    const bf16_t* q; int qpitch;
    const bf16_t* k0; int k0pitch;
    const bf16_t* k1; int k1pitch;
    const bf16_t* v; int vpitch;
    bf16_t* o; int opitch;
};
template <int NKC, int NVB, int RD = 4>
__device__ __forceinline__ void dma_tile(const Src& S, int t, int slot, unsigned lds0, int wid, int lane) {
    constexpr int KS = NKC * 1024, VS = NVB * 4096, LDS_K = 0, LDS_V = RD * KS;
#pragma unroll
    for (int c = 0; c < (NKC + 7) / 8; ++c) { const int ch = wid + 8 * c; if (ch < NKC) {
        const bf16_t* src = (ch < 8) ? S.k0 + (size_t)(t * 64 + lane) * S.k0pitch + ch * 8 : S.k1 + (size_t)(t * 64 + lane) * S.k1pitch + (ch - 8) * 8;
        glds16(src, (unsigned)__builtin_amdgcn_readfirstlane(lds0 + LDS_K + slot * KS + ch * 1024)); } }
#pragma unroll
    for (int c = 0; c < (NVB * 4 + 7) / 8; ++c) { const int p = wid + 8 * c; if (p < NVB * 4) {
        const bf16_t* src = S.v + (size_t)(t * 64 + 16 * (p & 3) + (lane >> 2)) * S.vpitch + (p >> 2) * 32 + (lane & 3) * 8;
        glds16(src, (unsigned)__builtin_amdgcn_readfirstlane(lds0 + LDS_V + slot * VS + p * 1024)); } }
}
__device__ __forceinline__ void wait_vm_bar(int n) {
    if (n >= 4) asm volatile("s_waitcnt vmcnt(4) lgkmcnt(0)\n\ts_barrier" ::: "memory");
    else if (n == 3) asm volatile("s_waitcnt vmcnt(3) lgkmcnt(0)\n\ts_barrier" ::: "memory");
    else if (n == 2) asm volatile("s_waitcnt vmcnt(2) lgkmcnt(0)\n\ts_barrier" ::: "memory");
    else if (n == 1) asm volatile("s_waitcnt vmcnt(1) lgkmcnt(0)\n\ts_barrier" ::: "memory");
    else asm volatile("s_waitcnt vmcnt(0) lgkmcnt(0)\n\ts_barrier" ::: "memory");
}
template <int NKC, int NVB, int MODE>
__device__ __forceinline__ void unit(LAS unsigned char* lds, const Src& S, int t_lo, int t_hi, int qpos0  , float sink_l2) {
    constexpr int KS = NKC * 1024, VS = NVB * 4096, RD = 4, LDS_K = 0, LDS_V = RD * KS;
    const int tid = opq_v((int)threadIdx.x), lane = tid & 63, r32 = lane & 31, hi = lane >> 5; const int wid = __builtin_amdgcn_readfirstlane(tid >> 6), grp = wid >> 2;
    const unsigned lds0 = (unsigned)(uintptr_t)lds;
    const int ops = (NKC + 7 - wid) / 8 + (NVB * 4) / 8;
    bf16x8 qr[NKC / 2];
#pragma unroll
    for (int d0 = 0; d0 < NKC / 2; ++d0) qr[d0] = *(const bf16x8*)(S.q + (size_t)r32 * S.qpitch + d0 * 16 + hi * 8);
    float m_run = (MODE == 0) ? sink_l2 : -INFINITY, l_run = (MODE == 0 && hi == 0) ? 1.0f : 0.0f;
    f32x16 o[NVB];
#pragma unroll
    for (int d = 0; d < NVB; ++d) o[d] = f32x16{};
    const int qi = qpos0 + wid * 32 + r32, qw0 = qpos0 + wid * 32;
    f32x16 p0 = f32x16{}, p1 = f32x16{};
#define AT_ACTIVE(t) ((MODE != 0) || ((64 * (t) + 63 >= qw0 - 128) && (64 * (t) <= qw0 + 31 + 128)))
#define AT_QK(t) do { const LAS unsigned char* kb_ = lds + LDS_K + (((t) - t_lo) % RD) * KS + hi * 1024 + r32 * 16; p0 = f32x16{}; p1 = f32x16{}; \
        _Pragma("unroll") for (int d0 = 0; d0 < NKC / 2; ++d0) { const bf16x8 b0_ = *(const LAS bf16x8*)(kb_ + d0 * 2048), b1_ = *(const LAS bf16x8*)(kb_ + d0 * 2048 + 512); \
            p0 = __builtin_amdgcn_mfma_f32_32x32x16_bf16(b0_, qr[d0], p0, 0, 0, 0); p1 = __builtin_amdgcn_mfma_f32_32x32x16_bf16(b1_, qr[d0], p1, 0, 0, 0); } } while (0)
#define AT_SMPV(t) do { \
        if (MODE == 0) { _Pragma("unroll") for (int r = 0; r < 16; ++r) { const int kv_ = 64 * (t) + crow(r, hi); int e0_ = kv_ - qi; e0_ = e0_ < 0 ? -e0_ : e0_; int e1_ = kv_ + 32 - qi; e1_ = e1_ < 0 ? -e1_ : e1_; \
            if (e0_ > 128) p0[r] = -INFINITY; if (e1_ > 128) p1[r] = -INFINITY; } } \
        float mx_[8]; _Pragma("unroll") for (int r = 0; r < 8; ++r) mx_[r] = fmaxf(fmaxf(p0[r], p0[r + 8]), fmaxf(p1[r], p1[r + 8])); \
        float rm_ = fmaxf(fmaxf(fmaxf(mx_[0], mx_[1]), fmaxf(mx_[2], mx_[3])), fmaxf(fmaxf(mx_[4], mx_[5]), fmaxf(mx_[6], mx_[7]))); rm_ = swapmax(rm_); \
        if (__any(rm_ > m_run)) { const float mn_ = fmaxf(m_run, rm_), alpha_ = __builtin_amdgcn_exp2f(m_run - mn_); m_run = mn_; l_run *= alpha_; \
            _Pragma("unroll") for (int d = 0; d < NVB; ++d) _Pragma("unroll") for (int r = 0; r < 16; ++r) o[d][r] *= alpha_; } \
        float sm_[4] = {0.f, 0.f, 0.f, 0.f}; \
        _Pragma("unroll") for (int r = 0; r < 16; ++r) { p0[r] = __builtin_amdgcn_exp2f(p0[r] - m_run); p1[r] = __builtin_amdgcn_exp2f(p1[r] - m_run); sm_[r & 3] += p0[r] + p1[r]; } \
        l_run += (sm_[0] + sm_[1]) + (sm_[2] + sm_[3]); \
        u32x4 pw_[4]; \
        pw_[0] = (u32x4){cvtpk(p0[0], p0[1]), cvtpk(p0[2], p0[3]), cvtpk(p0[4], p0[5]), cvtpk(p0[6], p0[7])}; pw_[1] = (u32x4){cvtpk(p0[8], p0[9]), cvtpk(p0[10], p0[11]), cvtpk(p0[12], p0[13]), cvtpk(p0[14], p0[15])}; \
        pw_[2] = (u32x4){cvtpk(p1[0], p1[1]), cvtpk(p1[2], p1[3]), cvtpk(p1[4], p1[5]), cvtpk(p1[6], p1[7])}; pw_[3] = (u32x4){cvtpk(p1[8], p1[9]), cvtpk(p1[10], p1[11]), cvtpk(p1[12], p1[13]), cvtpk(p1[14], p1[15])}; \
        const unsigned vb_ = lds0 + LDS_V + (((t) - t_lo) % RD) * VS + ((lane >> 4) & 1) * 32 + (lane & 3) * 8 + (4 * hi + ((lane & 15) >> 2)) * 64; \
        _Pragma("unroll") for (int dp = 0; dp < NVB; dp += 2) { s16x4 lo_[2][4], hh_[2][4]; \
            _Pragma("unroll") for (int dd = 0; dd < 2; ++dd) _Pragma("unroll") for (int ks = 0; ks < 4; ++ks) { lo_[dd][ks] = vtr(vb_ + (dp + dd) * 4096 + ks * 1024); hh_[dd][ks] = vtr(vb_ + (dp + dd) * 4096 + ks * 1024 + 512); } \
            asm volatile("s_waitcnt lgkmcnt(0)" ::: "memory"); __builtin_amdgcn_sched_barrier(0); \
            _Pragma("unroll") for (int ks = 0; ks < 4; ++ks) _Pragma("unroll") for (int dd = 0; dd < 2; ++dd) { \
                const bf16x8 vf_ = (bf16x8){lo_[dd][ks][0], lo_[dd][ks][1], lo_[dd][ks][2], lo_[dd][ks][3], hh_[dd][ks][0], hh_[dd][ks][1], hh_[dd][ks][2], hh_[dd][ks][3]}; \
                o[dp + dd] = __builtin_amdgcn_mfma_f32_32x32x16_bf16(vf_, __builtin_bit_cast(bf16x8, pw_[ks]), o[dp + dd], 0, 0, 0); } } } while (0)
    dma_tile<NKC, NVB>(S, t_lo, 0, lds0, wid, lane);
    if (t_lo + 1 < t_hi) dma_tile<NKC, NVB>(S, t_lo + 1, 1, lds0, wid, lane);
    for (int t = t_lo; t < t_hi; ++t) {
        wait_vm_bar((t + 1 < t_hi) ? ops : 0);
        if (t + 2 < t_hi) dma_tile<NKC, NVB>(S, t + 2, (t + 2 - t_lo) % RD, lds0, wid, lane);
        if (grp == 0) { if (AT_ACTIVE(t)) { AT_QK(t); AT_SMPV(t); } }
        else { if (t > t_lo && AT_ACTIVE(t - 1)) AT_SMPV(t - 1); if (AT_ACTIVE(t)) AT_QK(t); }
    }
    if (grp == 1 && AT_ACTIVE(t_hi - 1)) AT_SMPV(t_hi - 1);
    const float linv = 1.0f / swapsum(l_run);
#pragma unroll
    for (int d = 0; d < NVB; ++d)
#pragma unroll
        for (int r4 = 0; r4 < 4; ++r4) { f32x4 v = {o[d][4 * r4] * linv, o[d][4 * r4 + 1] * linv, o[d][4 * r4 + 2] * linv, o[d][4 * r4 + 3] * linv};
            *(u32x2*)(S.o + (size_t)r32 * S.opitch + 32 * d + 8 * r4 + 4 * hi) = pack4(v); }
    asm volatile("s_waitcnt lgkmcnt(0)\n\ts_barrier" ::: "memory");
#undef AT_ACTIVE
#undef AT_QK
#undef AT_SMPV
}

template <int NKC, int NVB>
__device__ __forceinline__ void unit_q64(LAS unsigned char* lds, const Src& S, int t_lo, int t_hi) {
    constexpr int KS = NKC * 1024, VS = NVB * 4096, RD = 4, LDS_K = 0, LDS_V = RD * KS;
    const int tid = opq_v((int)threadIdx.x), lane = tid & 63, r32 = lane & 31, hi = lane >> 5; const int wid = __builtin_amdgcn_readfirstlane(tid >> 6);
    const unsigned lds0 = (unsigned)(uintptr_t)lds;
    const int ops = (NKC + 7 - wid) / 8 + (NVB * 4) / 8;
    bf16x8 qa[NKC / 2], qb[NKC / 2];
#pragma unroll
    for (int d0 = 0; d0 < NKC / 2; ++d0) { qa[d0] = *(const bf16x8*)(S.q + (size_t)r32 * S.qpitch + d0 * 16 + hi * 8); qb[d0] = *(const bf16x8*)(S.q + (size_t)(32 + r32) * S.qpitch + d0 * 16 + hi * 8); }
    float ma = -INFINITY, la = 0.f, mb = -INFINITY, lb = 0.f;
    f32x16 oa[NVB], ob[NVB];
#pragma unroll
    for (int d = 0; d < NVB; ++d) { oa[d] = f32x16{}; ob[d] = f32x16{}; }
#define Q64_SM(P0, P1, M, L, O, PW) do { \
        float mx_[8]; _Pragma("unroll") for (int r = 0; r < 8; ++r) mx_[r] = fmaxf(fmaxf(P0[r], P0[r + 8]), fmaxf(P1[r], P1[r + 8])); \
        float rm_ = fmaxf(fmaxf(fmaxf(mx_[0], mx_[1]), fmaxf(mx_[2], mx_[3])), fmaxf(fmaxf(mx_[4], mx_[5]), fmaxf(mx_[6], mx_[7]))); rm_ = swapmax(rm_); \
        if (__any(rm_ > M)) { const float mn_ = fmaxf(M, rm_), alpha_ = __builtin_amdgcn_exp2f(M - mn_); M = mn_; L *= alpha_; \
            _Pragma("unroll") for (int d = 0; d < NVB; ++d) _Pragma("unroll") for (int r = 0; r < 16; ++r) O[d][r] *= alpha_; } \
        float sm_[4] = {0.f, 0.f, 0.f, 0.f}; \
        _Pragma("unroll") for (int r = 0; r < 16; ++r) { P0[r] = __builtin_amdgcn_exp2f(P0[r] - M); P1[r] = __builtin_amdgcn_exp2f(P1[r] - M); sm_[r & 3] += P0[r] + P1[r]; } \
        L += (sm_[0] + sm_[1]) + (sm_[2] + sm_[3]); \
        PW[0] = (u32x4){cvtpk(P0[0], P0[1]), cvtpk(P0[2], P0[3]), cvtpk(P0[4], P0[5]), cvtpk(P0[6], P0[7])}; PW[1] = (u32x4){cvtpk(P0[8], P0[9]), cvtpk(P0[10], P0[11]), cvtpk(P0[12], P0[13]), cvtpk(P0[14], P0[15])}; \
        PW[2] = (u32x4){cvtpk(P1[0], P1[1]), cvtpk(P1[2], P1[3]), cvtpk(P1[4], P1[5]), cvtpk(P1[6], P1[7])}; PW[3] = (u32x4){cvtpk(P1[8], P1[9]), cvtpk(P1[10], P1[11]), cvtpk(P1[12], P1[13]), cvtpk(P1[14], P1[15])}; \
        __builtin_amdgcn_sched_barrier(0); } while (0)
#define Q64_SM_NB(P0, P1, M, L, O, PW) do { \
        float mx_[8]; _Pragma("unroll") for (int r = 0; r < 8; ++r) mx_[r] = fmaxf(fmaxf(P0[r], P0[r + 8]), fmaxf(P1[r], P1[r + 8])); \
        float rm_ = fmaxf(fmaxf(fmaxf(mx_[0], mx_[1]), fmaxf(mx_[2], mx_[3])), fmaxf(fmaxf(mx_[4], mx_[5]), fmaxf(mx_[6], mx_[7]))); rm_ = swapmax(rm_); \
        if (__any(rm_ > M)) { const float mn_ = fmaxf(M, rm_), alpha_ = __builtin_amdgcn_exp2f(M - mn_); M = mn_; L *= alpha_; \
            _Pragma("unroll") for (int d = 0; d < NVB; ++d) _Pragma("unroll") for (int r = 0; r < 16; ++r) O[d][r] *= alpha_; } \
        float sm_[4] = {0.f, 0.f, 0.f, 0.f}; \
        _Pragma("unroll") for (int r = 0; r < 16; ++r) { P0[r] = __builtin_amdgcn_exp2f(P0[r] - M); P1[r] = __builtin_amdgcn_exp2f(P1[r] - M); sm_[r & 3] += P0[r] + P1[r]; } \
        L += (sm_[0] + sm_[1]) + (sm_[2] + sm_[3]); \
        PW[0] = (u32x4){cvtpk(P0[0], P0[1]), cvtpk(P0[2], P0[3]), cvtpk(P0[4], P0[5]), cvtpk(P0[6], P0[7])}; PW[1] = (u32x4){cvtpk(P0[8], P0[9]), cvtpk(P0[10], P0[11]), cvtpk(P0[12], P0[13]), cvtpk(P0[14], P0[15])}; \
        PW[2] = (u32x4){cvtpk(P1[0], P1[1]), cvtpk(P1[2], P1[3]), cvtpk(P1[4], P1[5]), cvtpk(P1[6], P1[7])}; PW[3] = (u32x4){cvtpk(P1[8], P1[9]), cvtpk(P1[10], P1[11]), cvtpk(P1[12], P1[13]), cvtpk(P1[14], P1[15])}; \
        } while (0)
    dma_tile<NKC, NVB, RD>(S, t_lo, 0, lds0, wid, lane);
    if (t_lo + 1 < t_hi) dma_tile<NKC, NVB, RD>(S, t_lo + 1, 1, lds0, wid, lane);
    for (int t = t_lo; t < t_hi; ++t) {
        const int slot = (t - t_lo) % RD;
        wait_vm_bar((t + 1 < t_hi) ? ops : 0);
        if (t + 2 < t_hi) dma_tile<NKC, NVB, RD>(S, t + 2, (t + 2 - t_lo) % RD, lds0, wid, lane);
        const LAS unsigned char* kb = lds + LDS_K + slot * KS + hi * 1024 + r32 * 16;
        f32x16 s0a = f32x16{}, s0b = f32x16{}, s1a = f32x16{}, s1b = f32x16{};
#pragma unroll
        for (int d0 = 0; d0 < NKC / 2; ++d0) {
            const bf16x8 b0 = *(const LAS bf16x8*)(kb + d0 * 2048), b1 = *(const LAS bf16x8*)(kb + d0 * 2048 + 512);
            s0a = __builtin_amdgcn_mfma_f32_32x32x16_bf16(b0, qa[d0], s0a, 0, 0, 0); s0b = __builtin_amdgcn_mfma_f32_32x32x16_bf16(b1, qa[d0], s0b, 0, 0, 0);
            s1a = __builtin_amdgcn_mfma_f32_32x32x16_bf16(b0, qb[d0], s1a, 0, 0, 0); s1b = __builtin_amdgcn_mfma_f32_32x32x16_bf16(b1, qb[d0], s1b, 0, 0, 0); }
        __builtin_amdgcn_sched_barrier(0);
        u32x4 pwa[4], pwb[4];
        const unsigned vb = lds0 + LDS_V + slot * VS + ((lane >> 4) & 1) * 32 + (lane & 3) * 8 + (4 * hi + ((lane & 15) >> 2)) * 64;
        s16x4 lo[NVB][4], hh[NVB][4];
#pragma unroll
        for (int d = 0; d < NVB; ++d)
#pragma unroll
            for (int ks = 0; ks < 4; ++ks) { VTRO(lo[d][ks], vb, d * 4096 + ks * 1024); VTRO(hh[d][ks], vb, d * 4096 + ks * 1024 + 512); }
        __builtin_amdgcn_sched_barrier(0);
        Q64_SM(s0a, s0b, ma, la, oa, pwa);
        asm volatile("s_waitcnt lgkmcnt(0)" ::: "memory"); __builtin_amdgcn_sched_barrier(0);
#pragma unroll
        for (int ks = 0; ks < 4; ++ks)
#pragma unroll
            for (int d = 0; d < NVB; ++d) { const bf16x8 vf = (bf16x8){lo[d][ks][0], lo[d][ks][1], lo[d][ks][2], lo[d][ks][3], hh[d][ks][0], hh[d][ks][1], hh[d][ks][2], hh[d][ks][3]};
                oa[d] = __builtin_amdgcn_mfma_f32_32x32x16_bf16(vf, __builtin_bit_cast(bf16x8, pwa[ks]), oa[d], 0, 0, 0); }
        Q64_SM_NB(s1a, s1b, mb, lb, ob, pwb);
#pragma unroll
        for (int i = 0; i < 8; ++i) { __builtin_amdgcn_sched_group_barrier(0x008, 1, 0); __builtin_amdgcn_sched_group_barrier(0x002, 12, 0); }
        __builtin_amdgcn_sched_barrier(0);
#pragma unroll
        for (int ks = 0; ks < 4; ++ks)
#pragma unroll
            for (int d = 0; d < NVB; ++d) { const bf16x8 vf = (bf16x8){lo[d][ks][0], lo[d][ks][1], lo[d][ks][2], lo[d][ks][3], hh[d][ks][0], hh[d][ks][1], hh[d][ks][2], hh[d][ks][3]};
                ob[d] = __builtin_amdgcn_mfma_f32_32x32x16_bf16(vf, __builtin_bit_cast(bf16x8, pwb[ks]), ob[d], 0, 0, 0); }
        __builtin_amdgcn_sched_barrier(0);
    }
    const float lia = 1.0f / swapsum(la), lib = 1.0f / swapsum(lb);
#pragma unroll
    for (int d = 0; d < NVB; ++d)
#pragma unroll
        for (int r4 = 0; r4 < 4; ++r4) {
            f32x4 va = {oa[d][4 * r4] * lia, oa[d][4 * r4 + 1] * lia, oa[d][4 * r4 + 2] * lia, oa[d][4 * r4 + 3] * lia}, vb4 = {ob[d][4 * r4] * lib, ob[d][4 * r4 + 1] * lib, ob[d][4 * r4 + 2] * lib, ob[d][4 * r4 + 3] * lib};
            *(u32x2*)(S.o + (size_t)r32 * S.opitch + 32 * d + 8 * r4 + 4 * hi) = pack4(va); *(u32x2*)(S.o + (size_t)(32 + r32) * S.opitch + 32 * d + 8 * r4 + 4 * hi) = pack4(vb4); }
    asm volatile("s_waitcnt lgkmcnt(0)\n\ts_barrier" ::: "memory");
#undef Q64_SM
#undef Q64_SM_NB
}

}
#define SC_AFTER_PROLOGUE() do {} while (0)
#define SC_AFTER_INPROJ(l) do {} while (0)
#define SC_AFTER_UP(l) do {} while (0)
#define SC_AFTER_MLA(l) do {} while (0)
#define SC_AFTER_BRANCH(l) do {} while (0)
#define SC_AFTER_WOUT(l) do {} while (0)
#define SC_AFTER_NORM2(l) do {} while (0)
#define SC_AFTER_GU(l) do {} while (0)
#define SC_AFTER_DOWN(l) do {} while (0)
#define SC_AFTER_ROUTE(l) do {} while (0)
#define SC_AFTER_MOEGU(l, h) do {} while (0)
#define SC_AFTER_MOED(l, h) do {} while (0)
#define SC_FINAL() do {} while (0)

struct Args { const float* in[23]; float* out; unsigned char* ws; };
#define WSP(type, off) ((type*)(F.ws + (off)))
#define PHASE() Frame Fp = F; Fp.ws = opq_p(F.ws); Fp.in = opq_p(F.in); Fp.out = opq_p(F.out); Fp.tid = opq_v((int)threadIdx.x); Fp.lane = Fp.tid & 63; Fp.wave = __builtin_amdgcn_readfirstlane(Fp.tid >> 6); (void)Fp
#define FWS(type, off) ((type*)(Fp.ws + (off)))
#define X_ (Fp.out)
#define H_ FWS(bf16_t, WS_H)
#define Pb_ FWS(bf16_t, WS_R + R_P)
#define Gb_ FWS(bf16_t, WS_R + R_G)
#define QB_ FWS(bf16_t, WS_R + R_QB)
#define KVB_ FWS(bf16_t, WS_R + R_KVB)
#define Yb_ FWS(bf16_t, WS_R + R_Y)
#define MEMN_ FWS(bf16_t, WS_MEMN)
#define MEMKV_ FWS(bf16_t, WS_MEMKV)
#define ACT_ FWS(bf16_t, WS_R + R_ACT)
#define ASORT_ FWS(bf16_t, WS_R + R_ASORT)
#define YOUT_ FWS(bf16_t, WS_R + R_YOUT)
#define SSQ_ FWS(float, WS_MISC + MS_SSQ)
#define TEXP_ FWS(const int, WS_MISC + MS_TEXP)
#define POS_ ((const int*)Fp.in[I_POS])
#define HSC_ FWS(float, WS_MISC + MS_HSC)
#define ASC_ FWS(float, WS_MISC + MS_ASC)
#define WSIN_ FWS(float, WS_MISC + MS_WSIN)
#define WSGU_ FWS(float, WS_MISC + MS_WSGU)

#define GRID_BAR() xcd_barrier(bar)
#ifndef WGM_GU
#define WGM_GU 4
#endif
#ifndef WGM_IN
#define WGM_IN 4
#endif
template <int l> __device__ __forceinline__ void layer_body(const Frame& F, const XcdBarrier& bar, const int bx) {
        if (l > 0) {
            PHASE();
            prep_ffn_weights(Fp, l);
            norm_phase(Fp, X_, X_, Fp.in[I_GMIX] + l * DM, (l & 1) == 0, true);
            GRID_BAR();
        }
        {   PHASE();
            ProbSimple p{DM, DM, DM, (const char*)H_, (const char*)wmix(Fp, l, WL_IN)}; pg8::StaticOrder S; S.init(T / 256, NT_IN, Fp.G, bx, 0, WGM_IN);
            EpiInproj E{Pb_, Gb_, SSQ_, POS_, HSC_, WSIN_ + l * NT_IN * 256}; pg8::gemm_phase<true>(Fp.lds, p, S, E); }
        if (l == 0) { PHASE();
            ProbSimple p{DM, DM * 2, DM * 2, (const char*)MEMN_, (const char*)FWS(bf16_t, WS_WMKV)}; pg8::StaticOrder S; S.init(NB * MEML / 256, 16, Fp.G, bx);
            EpiPlain E{MEMKV_, 4096}; pg8::gemm_phase(Fp.lds, p, S, E); }
        GRID_BAR();
        SC_AFTER_INPROJ(l);
        {   PHASE();
            ProbUp p{UPK, PW * 2, UPK * 2, (const char*)(Pb_ + P_CQ), (const char*)wmix(Fp, l, WL_UP)}; pg8::StaticOrder S; S.init(T / 256, UPN / 256, Fp.G, bx);
            EpiUp E{QB_, KVB_, SSQ_, POS_}; pg8::gemm_phase(Fp.lds, p, S, E); }
        {   PHASE();
            for (int i = Fp.vcu; i < 1024; i += Fp.G) {
                const int hl = i & 3, qb = (i >> 2) & 15, kvh = (i >> 6) & 1, b = i >> 7, h = kvh * 4 + hl; const size_t rowb = (size_t)b * SEQ; const int q0 = qb * 256;
                att::Src s; s.q = Pb_ + (rowb + q0 + Fp.wave * 32) * PW + P_QA + h * 64; s.qpitch = PW; s.k0 = Pb_ + rowb * PW + P_KA + kvh * 64; s.k0pitch = PW; s.k1 = s.k0; s.k1pitch = PW;
                s.v = Pb_ + rowb * PW + P_VA + kvh * 64; s.vpitch = PW; s.o = Yb_ + (rowb + q0 + Fp.wave * 32) * YW + h * 64; s.opitch = YW;
                const int t_lo = (q0 / 64 - 2) < 0 ? 0 : (q0 / 64 - 2), t_hi = (q0 / 64 + 6) > SEQ / 64 ? SEQ / 64 : (q0 / 64 + 6);
                att::unit<8, 2, 0>(Fp.lds, s, t_lo, t_hi, q0, Fp.in[I_SINK][l * 8 + h] * LOG2E);
            } }
        {   PHASE();
            for (int i = Fp.vcu; i < 512; i += Fp.G) {
                const int qb = i & 15, h = (i >> 4) & 3, b = i >> 6; const size_t rowq = (size_t)b * SEQ + qb * 256 + Fp.wave * 32;
                att::Src s; s.q = Pb_ + rowq * PW + P_QM + h * 128; s.qpitch = PW; s.k0 = MEMKV_ + (size_t)b * MEML * 4096 + l * 1024 + h * 128; s.k0pitch = 4096; s.k1 = s.k0 + 64; s.k1pitch = 4096;
                s.v = MEMKV_ + (size_t)b * MEML * 4096 + l * 1024 + 512 + h * 128; s.vpitch = 4096; s.o = Yb_ + rowq * YW + 1024 + h * 128; s.opitch = YW;
                att::unit<16, 4, 1>(Fp.lds, s, 0, MEML / 64, 0, 0.f);
            } }
        GRID_BAR();
        SC_AFTER_UP(l);
        {   PHASE();
            for (int i = Fp.vcu; i < 512; i += Fp.G) {
                const int qb = i & 7, h = (i >> 3) & 7, b = i >> 6; const size_t rowb = (size_t)b * SEQ, rowq = rowb + qb * 512 + Fp.wave * 64;
                att::Src s; s.q = QB_ + rowq * QBW + h * 96; s.qpitch = QBW; s.k0 = KVB_ + rowb * KVW + h * 128; s.k0pitch = KVW; s.k1 = Pb_ + rowb * PW + P_KR; s.k1pitch = PW;
                s.v = KVB_ + rowb * KVW + h * 128 + 64; s.vpitch = KVW; s.o = Yb_ + rowq * YW + 512 + h * 64; s.opitch = YW;
                att::unit_q64<12, 2>(Fp.lds, s, 0, SEQ / 64);
            } }
        GRID_BAR();
        SC_AFTER_MLA(l);
        {   PHASE();
            ProbSimple p{1536, YW * 2, 1536 * 2, (const char*)Yb_, (const char*)wmix(Fp, l, WL_BR)}; pg8::StaticOrder S; S.init(T / 256, DM / 256, Fp.G, bx);
            EpiBranch E{(const unsigned char*)Gb_, H_}; pg8::gemm_phase(Fp.lds, p, S, E); }
        GRID_BAR();
        SC_AFTER_BRANCH(l);
        {   PHASE();
            ProbSimple p{DM, DM * 2, DM * 2, (const char*)H_, (const char*)wmix(Fp, l, WL_OUT)}; pg8::StaticOrder S; S.init(T / 256, DM / 256, Fp.G, bx);
            EpiResid E{l == 0 ? Fp.in[I_X] : X_, X_}; pg8::gemm_phase(Fp.lds, p, S, E); }
        GRID_BAR();
        SC_AFTER_WOUT(l);
        if ((l & 1) == 0) {
            {   PHASE(); norm_phase(Fp, X_, nullptr, Fp.in[I_GFFN] + l * DM, false, GU_I8(l) != 0); }
            GRID_BAR();
            SC_AFTER_NORM2(l);
            {   PHASE();
                constexpr bool i8 = GU_I8(l) != 0; constexpr unsigned eb = i8 ? 1 : 2;
                ProbSimple p{DM, DM * eb, DM * eb, (const char*)H_, (const char*)FWS(bf16_t, WS_WFFN + WF_GU)}; pg8::StaticOrder S; S.init(T / 256, 2 * DFF / 256, Fp.G, bx, 0, WGM_GU);
                EpiSwiglu E{ACT_, 0, HSC_, WSGU_}; pg8::gemm_phase<i8>(Fp.lds, p, S, E); }
            GRID_BAR();
            SC_AFTER_GU(l);
            {   PHASE();
                ProbSimple p{DFF, DFF * 2, DFF * 2, (const char*)ACT_, (const char*)FWS(bf16_t, WS_WFFN + WF_D)}; pg8::StaticOrder S; S.init(T / 256, DM / 256, Fp.G, bx, 1);
                EpiResid E{X_, X_}; pg8::gemm_phase(Fp.lds, p, S, E); }
            GRID_BAR();
            SC_AFTER_DOWN(l);
        } else {
            {   PHASE(); norm_router_phase(Fp, X_, Fp.in[I_GFFN] + l * DM, Fp.in[I_WR] + (size_t)(l >> 1) * DM * NE, GU_I8(l) != 0); }
            GRID_BAR();
            {   PHASE(); moe_assign_phase(Fp, GU_I8(l) != 0); }
            GRID_BAR();
            SC_AFTER_ROUTE(l);
            {   constexpr int half = 0; (void)half;
                {   PHASE();
                    const int nrt = __builtin_amdgcn_readfirstlane(TEXP_[MAXRT]);
                    constexpr bool i8 = GU_I8(l) != 0; constexpr unsigned eb = i8 ? 1 : 2;
                    ProbMoe p{DM, DM * eb, DM * eb, (const char*)ASORT_, (const char*)FWS(bf16_t, WS_WFFN + WF_GU), 0}; MoeOrder S; S.base.init(nrt, 2 * DFF / 256, Fp.G, bx, 0, WGM_GU); S.lo = 0; S.texp = TEXP_;
                    EpiSwiglu E{ACT_, 0, ASC_, WSGU_}; pg8::gemm_phase<i8>(Fp.lds, p, S, E); }
                GRID_BAR();
                SC_AFTER_MOEGU(l, half);
                {   PHASE();
                    const int nrt = __builtin_amdgcn_readfirstlane(TEXP_[MAXRT]);
                    ProbMoe p{DFF, DFF * 2, DFF * 2, (const char*)ACT_, (const char*)FWS(bf16_t, WS_WFFN + WF_D), 0}; MoeOrder S; S.base.init(nrt, DM / 256, Fp.G, bx, 1); S.lo = 0; S.texp = TEXP_;
                    EpiYout E{YOUT_}; pg8::gemm_phase(Fp.lds, p, S, E); }
                GRID_BAR();
                SC_AFTER_MOED(l, half);
            }
        }
    }

__global__ void __launch_bounds__(NWAVES * 64, 2) fwd(Args args) {
    extern __shared__ __attribute__((aligned(16))) unsigned char lds_raw[];
    Frame F;
    F.lds = (LAS unsigned char*)lds_raw;
    F.MISC = (volatile LAS unsigned*)(F.lds + LDSCTL_OFF);
    F.tid = threadIdx.x; F.lane = F.tid & 63; F.wave = __builtin_amdgcn_readfirstlane(F.tid >> 6);
    F.G = gridDim.x; { const int bx = blockIdx.x; F.vcu = (F.G % 8 == 0) ? (bx % 8) * (F.G / 8) + bx / 8 : bx; }
    F.ws = args.ws; F.ctl = (gu32*)(args.ws + WS_CTL); F.out = args.out;
    F.in = (const float* const*)__builtin_amdgcn_kernarg_segment_ptr();
    for (int u = F.tid; u < (LDS_BYTES - LDSCTL_OFF) / 4; u += NWAVES * 64) ((LAS unsigned*)(F.lds + LDSCTL_OFF))[u] = 0u;
    __syncthreads();
    XcdBarrier bar = xcd_barrier_post((unsigned*)(F.ctl + CW_BAR), F.MISC + 8);

    const int bx = (int)blockIdx.x;

    {   PHASE();
        prep_mixer_weights(Fp);
        memnorm_phase(Fp);
        prep_ffn_weights(Fp, 0);
        norm_phase(Fp, Fp.in[I_X], nullptr, Fp.in[I_GMIX], false, true); }
    GRID_BAR();
    SC_AFTER_PROLOGUE();

    layer_body<0>(F, bar, bx); layer_body<1>(F, bar, bx); layer_body<2>(F, bar, bx); layer_body<3>(F, bar, bx);
    {   PHASE(); final_norm_phase(Fp, X_, Fp.in[I_GFIN], true); }
    SC_FINAL();
}

extern "C" void kernel_launch(void* const* d_in, const int* in_sizes, int n_in, void* d_out, int out_size, void* d_ws, size_t ws_size, hipStream_t stream) {
    static int grid = 0;
    if (grid == 0) {
        if (n_in != 23 || out_size != T * DM || ws_size < WS_END) { fprintf(stderr, "kernel_launch: unexpected problem (n_in %d, out %d, ws %zu < %zu)\n", n_in, out_size, ws_size, (size_t)WS_END); grid = -1; return; }
        int dev = 0, cus = 0;
        if (hipGetDevice(&dev) != hipSuccess || hipDeviceGetAttribute(&cus, hipDeviceAttributeMultiprocessorCount, dev) != hipSuccess) { grid = -1; return; }
        if (hipFuncSetAttribute((const void*)fwd, hipFuncAttributeMaxDynamicSharedMemorySize, LDS_BYTES) != hipSuccess) { fprintf(stderr, "kernel_launch: hipFuncSetAttribute failed\n"); grid = -1; return; }
        int per_cu = 0;
        if (hipOccupancyMaxActiveBlocksPerMultiprocessor(&per_cu, (const void*)fwd, NWAVES * 64, LDS_BYTES) != hipSuccess || per_cu < 1) fprintf(stderr, "kernel_launch: occupancy query says %d\n", per_cu);
        (void)hipGetLastError();
        grid = cus;
    }
    if (grid < 0) return;
    if (hipMemsetAsync((char*)d_ws + WS_CTL, 0, CTL_ZERO_BYTES, stream) != hipSuccess) return;
    Args a{};
    for (int i = 0; i < 23; ++i) a.in[i] = (const float*)d_in[i];
    a.out = (float*)d_out; a.ws = (unsigned char*)d_ws;
    hipLaunchKernelGGL(fwd, dim3(grid), dim3(NWAVES * 64), LDS_BYTES, stream, a);
}
```

```cpp
#include <hip/hip_runtime.h>
#include <cstdio>
#include <cstdint>

#ifndef SELFCHECK
#define SELFCHECK 0
#endif
#ifndef GU_I8_MASK
#define GU_I8_MASK 0xF
#endif
#define GU_I8(l) ((((unsigned)GU_I8_MASK) >> (l)) & 1u)

#define GAS __attribute__((address_space(1)))
#define LAS __attribute__((address_space(3)))
typedef unsigned short bf16_t;
typedef short bf16x8 __attribute__((ext_vector_type(8)));
typedef short s16x4 __attribute__((ext_vector_type(4)));
typedef short v4i16_t __attribute__((ext_vector_type(4)));
typedef float f32x2 __attribute__((ext_vector_type(2)));
typedef float f32x4 __attribute__((ext_vector_type(4)));
typedef float f32x16 __attribute__((ext_vector_type(16)));
typedef unsigned u32x2 __attribute__((ext_vector_type(2)));
typedef unsigned u32x4 __attribute__((ext_vector_type(4)));
typedef int i32x4 __attribute__((ext_vector_type(4)));
typedef GAS unsigned gu32;
#define RLX_AGENT __ATOMIC_RELAXED, __HIP_MEMORY_SCOPE_AGENT

constexpr int NB = 8, SEQ = 4096, T = NB * SEQ, DM = 1024, DEPTH = 4, MEML = 256, DFF = 3584, NE = 8;
constexpr int INW = 4768;
constexpr int PW = 1792;
constexpr int GW = 3072;
constexpr int QBW = 768, KVW = 1024, YW = 1536;
constexpr int NT_IN = 19;
constexpr int P_QA = 0, P_KA = 512, P_VA = 640, P_CQ = 768, P_CKV = 1024, P_KR = 1152, P_QM = 1280;
constexpr int UPK = 256, UPN = 1792;
constexpr int MAXSLOT = 67584;
constexpr int MAXRT = MAXSLOT / 256;
constexpr float EPS = 1e-6f;
constexpr float LOG2E = 1.4426950408889634f;
constexpr float C_A = 0.125f * LOG2E;
constexpr float C_B = 0.10206207261596575f * LOG2E;
constexpr float C_M = 0.08838834764831845f * LOG2E;

constexpr size_t MiB = 1u << 20;
constexpr size_t WS_CTL = 0, CTL_ZERO_BYTES = 1 * MiB;
constexpr size_t WS_MISC = 1 * MiB;
constexpr size_t WL_IN = 0, WL_UP = (size_t)NT_IN * 256 * DM * 2, WL_BR = WL_UP + (size_t)UPN * UPK * 2, WL_OUT = WL_BR + (size_t)3 * DM * 512 * 2, WL_SIZE = WL_OUT + (size_t)DM * DM * 2;
constexpr size_t WS_WMIX = 8 * MiB;
constexpr size_t WS_WMKV = WS_WMIX + 4 * ((WL_SIZE + MiB - 1) / MiB) * MiB;
constexpr size_t WL_STRIDE = ((WL_SIZE + MiB - 1) / MiB) * MiB;
constexpr size_t WS_WFFN = WS_WMKV + 8 * MiB;
constexpr size_t WF_GU = 0, WF_D = (size_t)2 * DFF * DM * 2, WF_STRIDE = WF_D + (size_t)DM * DFF * 2;
constexpr size_t WS_H = WS_WFFN + 8 * WF_STRIDE;
constexpr size_t WS_MEMN = WS_H + (size_t)T * DM * 2;
constexpr size_t WS_MEMKV = WS_MEMN + (size_t)NB * MEML * DM * 2;
constexpr size_t WS_R = WS_MEMKV + (size_t)NB * MEML * 4096 * 2;
constexpr size_t R_P = 0, R_G = R_P + (size_t)T * PW * 2, R_QB = R_G + (size_t)T * GW * 2, R_KVB = R_QB + (size_t)T * QBW * 2, R_Y = R_KVB + (size_t)T * KVW * 2, R_END_MIX = R_Y + (size_t)T * YW * 2;
constexpr size_t R_ACT = 0;
constexpr size_t R_ASORT = (size_t)MAXSLOT * DFF * 2;
constexpr size_t R_YOUT = R_ASORT;
constexpr size_t R_END_FFN = R_YOUT + (size_t)MAXSLOT * DM * 2;
constexpr size_t R_SIZE = R_END_MIX > R_END_FFN ? R_END_MIX : R_END_FFN;
constexpr size_t WS_XB = WS_R + R_SIZE;
constexpr size_t WS_END = WS_XB + (size_t)T * DM * 2;
static_assert(WS_END < 1020ull * MiB, "workspace budget");
constexpr size_t MS_TOKE = 0;
constexpr size_t MS_TOKW = MS_TOKE + (size_t)T * 8;
constexpr size_t MS_SLOT = MS_TOKW + (size_t)T * 8;
constexpr size_t MS_CNT = MS_SLOT + (size_t)T * 8;
constexpr size_t MS_TEXP = MS_CNT + 256 * 8 * 4;
constexpr size_t MS_SSQ = MS_TEXP + 2048;
constexpr size_t MS_SNAP = MS_SSQ + (size_t)T * 32;
constexpr size_t MS_HSC = MS_SNAP + 64 * 1024 * 4;
constexpr size_t MS_ASC = MS_HSC + (size_t)T * 4;
constexpr size_t MS_WSIN = MS_ASC + (size_t)MAXSLOT * 4;
constexpr size_t MS_WSGU = MS_WSIN + (size_t)4 * NT_IN * 256 * 4;
constexpr size_t MS_END = MS_WSGU + (size_t)8 * 2 * DFF * 4;
static_assert(MS_END <= 7 * MiB, "misc map");
constexpr int CW_BAR = 4096;
constexpr int CW_DIAG = 16384;
constexpr int CW_CODE = 16384 + 512;

constexpr int RING_BYTES = 131072;
constexpr int LDSCTL_OFF = RING_BYTES;
constexpr int LDS_BYTES = 147456;
constexpr int NWAVES = 8;

#define LDS_WAIT() asm volatile("s_waitcnt lgkmcnt(0)" ::: "memory")
#define VM_WAIT() asm volatile("s_waitcnt vmcnt(0)" ::: "memory")

__device__ __forceinline__ unsigned f2bf(float f) { unsigned u = __builtin_bit_cast(unsigned, f); return (u + 0x7fffu + ((u >> 16) & 1u)) >> 16; }
__device__ __forceinline__ unsigned pk2(float lo, float hi) { return f2bf(lo) | (f2bf(hi) << 16); }
__device__ __forceinline__ float bf2f(unsigned short b) { return __builtin_bit_cast(float, (unsigned)b << 16); }
__device__ __forceinline__ float bflo(unsigned w) { return __builtin_bit_cast(float, w << 16); }
__device__ __forceinline__ float bfhi(unsigned w) { return __builtin_bit_cast(float, w & 0xffff0000u); }
typedef __bf16 bf16x2_t __attribute__((ext_vector_type(2)));
__device__ __forceinline__ unsigned cvtpk(float lo, float hi) { f32x2 v = {lo, hi}; bf16x2_t b = __builtin_convertvector(v, bf16x2_t); return __builtin_bit_cast(unsigned, b); }
__device__ __forceinline__ float wave_sum(float v) {
#pragma unroll
    for (int o = 1; o < 64; o <<= 1) v += __shfl_xor(v, o);
    return v;
}
__device__ __forceinline__ float fast_sigmoid(float x) { return __builtin_amdgcn_rcpf(1.0f + __builtin_amdgcn_exp2f(-x * LOG2E)); }


__device__ __forceinline__ int opq_v(int x) { asm volatile("" : "+v"(x)); return x; }
__device__ __forceinline__ int opq_s(int x) { asm volatile("" : "+s"(x)); return x; }
template <class Tp> __device__ __forceinline__ Tp* opq_p(Tp* p) { const unsigned long long u = (unsigned long long)p; unsigned lo = __builtin_amdgcn_readfirstlane((unsigned)u), hi = __builtin_amdgcn_readfirstlane((unsigned)(u >> 32)); asm volatile("" : "+s"(lo), "+s"(hi)); return (Tp*)(((unsigned long long)hi << 32) | lo); }

__constant__ float IFR_HI[32] = {1.591549367e-01f, 1.193493679e-01f, 8.949939907e-02f, 6.711508334e-02f, 5.032921210e-02f, 3.774158657e-02f, 2.830219641e-02f, 2.122365311e-02f, 1.591549441e-02f, 1.193493698e-02f, 8.949940093e-03f, 6.711508147e-03f, 5.032921210e-03f, 3.774158424e-03f, 2.830219688e-03f, 2.122365171e-03f, 1.591549488e-03f, 1.193493721e-03f, 8.949940093e-04f, 6.711508031e-04f, 5.032921326e-04f, 3.774158540e-04f, 2.830219455e-04f, 2.122365258e-04f, 1.591549371e-04f, 1.193493736e-04f, 8.949940093e-05f, 6.711508468e-05f, 5.032921035e-05f, 3.774158540e-05f, 2.830219637e-05f, 2.122365186e-05f};
__constant__ float IFR_LO[32] = {6.420638243e-09f, 2.294664903e-09f, 2.542919653e-09f, -3.316028840e-10f, 5.173299289e-12f, -1.848551645e-09f, -5.826552019e-10f, -3.431038786e-10f, -1.029942243e-10f, 4.320196978e-11f, 6.802745173e-11f, 1.531042237e-10f, 5.173301024e-13f, 4.797548470e-11f, -1.048316434e-10f, 1.053879969e-10f, -5.686555046e-11f, -1.896286773e-11f, 6.802744999e-12f, 2.695195456e-11f, -1.158979943e-11f, -6.843983713e-12f, 1.279990003e-11f, 1.807650600e-12f, 5.954976963e-12f, -3.351478166e-12f, 6.802745216e-13f, -1.670379113e-12f, 1.751403167e-12f, -6.843983930e-13f, -5.389994549e-13f, 9.083608431e-13f};
__device__ __forceinline__ void rot_cs(float posf, int idx, float& c, float& s) {
    const float ch = IFR_HI[idx], cl = IFR_LO[idx];
    const float p = posf * ch, e = __builtin_fmaf(posf, ch, -p);
    const float fr = __builtin_amdgcn_fractf(p) + (e + posf * cl);
    s = __builtin_amdgcn_sinf(fr); c = __builtin_amdgcn_cosf(fr);
}

#define XB_TMO      128
#define XB_XCNT(j)  (256  + 64 * (j))
#define XB_XSUB(j)  (1280 + 64 * (j))
#define XB_XGEN(j)  (2304 + 64 * (j))
#define XB_TOP      3328
#define XB_TOPGEN   3392
#define XCD_BAR_WORDS 3456
#define XB_SPIN_CAP (1u << 20)

__device__ __forceinline__ unsigned xb_ld(unsigned* p)              { return __hip_atomic_load(p, __ATOMIC_RELAXED, __HIP_MEMORY_SCOPE_AGENT); }
__device__ __forceinline__ unsigned xb_add(unsigned* p, unsigned v) { return __hip_atomic_fetch_add(p, v, __ATOMIC_RELAXED, __HIP_MEMORY_SCOPE_AGENT); }
__device__ __forceinline__ unsigned xb_xcc_id() { return (unsigned)__builtin_amdgcn_s_getreg((3 << 11) | 20) & 0xFu; }
#define XB_SPIN(cond, bar) do { unsigned _sp = 0; while (cond) { __builtin_amdgcn_s_sleep(1); \
    if ((++_sp & 255u) == 0u) { if (xb_ld(&(bar)[XB_TMO])) break; if (_sp > XB_SPIN_CAP) { atomicAdd(&(bar)[XB_TMO], 1u); break; } } } } while (0)

struct XcdBarrier { unsigned* bar; unsigned x; volatile LAS unsigned* st; };

__device__ __forceinline__ XcdBarrier xcd_barrier_post(unsigned* bar, volatile LAS unsigned* st) {
    XcdBarrier b; b.bar = bar; b.x = xb_xcc_id(); b.st = st;
    if (threadIdx.x == 0) (void)xb_add(&bar[XB_XCNT(b.x)], 1u);
    return b;
}
__device__ __forceinline__ void xcd_barrier_complete(unsigned* bar, unsigned x, unsigned& nloc, unsigned& nx) {
    const unsigned G = gridDim.x * gridDim.y * gridDim.z;
    unsigned sum, cnt, mine, sp = 0u;
    for (;;) {
        sum = 0u; cnt = 0u; mine = 0u;
#pragma unroll
        for (unsigned j = 0; j < 16; ++j) { const unsigned c = xb_ld(&bar[XB_XCNT(j)]); sum += c; cnt += (c > 0u) ? 1u : 0u; mine = (j == x) ? c : mine; }
        if (sum == G) break;
        __builtin_amdgcn_s_sleep(1);
        if ((++sp & 255u) == 0u) { if (xb_ld(&bar[XB_TMO])) break; if (sp > XB_SPIN_CAP) { atomicAdd(&bar[XB_TMO], 1u); break; } }
    }
    nloc = mine > 0u ? mine : 1u; nx = cnt > 0u ? cnt : 1u;
}
__device__ __forceinline__ void xcd_barrier(const XcdBarrier& b) {
    asm volatile("s_waitcnt vmcnt(0)" ::: "memory");
    __syncthreads();
    if (threadIdx.x == 0) {
        unsigned* bar = b.bar;
        __builtin_amdgcn_s_waitcnt(0);
        unsigned nloc = b.st[0], nx = b.st[1];
        if (nloc == 0u) { xcd_barrier_complete(bar, b.x, nloc, nx); b.st[0] = nloc; b.st[1] = nx; }
        const unsigned old = xb_add(&bar[XB_XSUB(b.x)], 1u);
        const unsigned gen = old / nloc;
        if (old + 1u == (gen + 1u) * nloc) {
            __builtin_amdgcn_fence(__ATOMIC_RELEASE, "agent");
            asm volatile("s_waitcnt vmcnt(0)" ::: "memory");
            const unsigned og = xb_add(&bar[XB_TOP], 1u);
            const unsigned tg = og / nx;
            if (og + 1u == (tg + 1u) * nx) xb_add(&bar[XB_TOPGEN], 1u);
            else XB_SPIN(xb_ld(&bar[XB_TOPGEN]) == tg, bar);
            __builtin_amdgcn_fence(__ATOMIC_ACQUIRE, "agent");
            xb_add(&bar[XB_XGEN(b.x)], 1u);
            asm volatile("s_waitcnt vmcnt(0)" ::: "memory");
        } else {
            XB_SPIN(xb_ld(&bar[XB_XGEN(b.x)]) == gen, bar);
            __builtin_amdgcn_fence(__ATOMIC_ACQUIRE, "agent");
            asm volatile("s_waitcnt vmcnt(0)" ::: "memory");
        }
    }
    __syncthreads();
}

namespace pg8 {
constexpr int BM = 256, BK = 64, HALF = 128, HTB = HALF * BK * 2, STAGE_BYTES = 8 * HTB, NXCD = 8, WGM = 4;
constexpr int ESC_OFF = 131072 + 4096, ESC_SLOT = 3072;
__host__ __device__ __forceinline__ int lds_byte(int r, int c) { const int st = (r >> 4) * 2 + (c >> 5), rr = r & 15, cc = c & 31, ob = rr * 64 + cc * 2; return st * 1024 + (ob ^ (((ob >> 9) & 1) << 5)); }
__host__ __device__ __forceinline__ void stage_rc(int b, int& R, int& C) { const int st = b / 1024, sb = b % 1024, swz = sb ^ (((sb >> 9) & 1) << 5); R = (st >> 1) * 16 + swz / 64; C = (st & 1) * 32 + (swz % 64) / 2; }

struct Unit { int pm, pn, aux; };

struct StaticOrder {
    int nM, nN, nwg, G, c, rev, wgm;
    __device__ void init(int nM_, int nN_, int G_, int c_, int rev_ = 0, int wgm_ = WGM) { nM = nM_; nN = nN_; nwg = nM * nN; G = G_; c = c_; rev = rev_; wgm = wgm_; }
    __device__ bool next(int i, Unit& u) const {
        const long L = (long)i * G + c; if (L >= nwg) return false;
        int wgid = (int)L; { const int q = nwg / NXCD, r = nwg % NXCD, xcd = wgid % NXCD, off = wgid / NXCD; wgid = (xcd < r ? xcd * (q + 1) : r * (q + 1) + (xcd - r) * q) + off; }
        const int nig = wgm * nN, gid = wgid / nig, fm = gid * wgm, gsz = (nM - fm) < wgm ? (nM - fm) : wgm;
        u.pm = fm + ((wgid % nig) % gsz); u.pn = (wgid % nig) / gsz; u.aux = 0; if (rev) u.pm = nM - 1 - u.pm; return true;
    }
};

template <bool I8> struct AccVec { typedef f32x4 type; };
template <> struct AccVec<true> { typedef i32x4 type; };
template <bool I8 = false, class Prob, class Sched, class Epi>
__device__ __forceinline__ void gemm_phase(LAS unsigned char* lds, const Prob& P, const Sched& S, const Epi& E) {
    const int tid = opq_v((int)threadIdx.x), wid = __builtin_amdgcn_readfirstlane(tid >> 6), lane = tid & 63, wr = wid >> 2, wc = wid & 3, fr = lane & 15, fq = lane >> 4;
    typedef typename AccVec<I8>::type accv_t;
    const int K = P.K, nt = K / (I8 ? 2 * BK : BK);
    unsigned voffA[2], voffB[2];
#pragma unroll
    for (int i = 0; i < 2; ++i) { int R, C; stage_rc(tid * 16 + i * 8192, R, C); voffA[i] = (unsigned)R * P.lda + (unsigned)C * 2u; voffB[i] = (unsigned)R * P.ldb + (unsigned)C * 2u; }
    const size_t kstep = (size_t)(BK * 2);
    const size_t hstepA = (size_t)HALF * P.lda, hstepB = (size_t)HALF * P.ldb;
    const unsigned ldsw = (unsigned)wid * 1024u;
    const int aoff = lds_byte(wr * 64 + fr, fq * 8), boff = lds_byte(wc * 32 + fr, fq * 8);
#define PG8_SA(b, h) (((b) * 2 + (h)) * HTB)
#define PG8_SB(b, h) ((4 + (b) * 2 + (h)) * HTB)
#define PG8_STAGE(bufoff, gbase, voff) do { _Pragma("unroll") for (int _i = 0; _i < 2; ++_i) \
        __builtin_amdgcn_global_load_lds((const unsigned*)((const char*)(gbase) + (voff)[_i]), (LAS unsigned*)(lds + (bufoff) + ldsw + _i * 8192), 16, 0, 0); } while (0)
#define PG8_LDA(dst, b, h) do { _Pragma("unroll") for (int m = 0; m < 4; ++m) _Pragma("unroll") for (int k = 0; k < 2; ++k) dst[m][k] = *(const LAS bf16x8*)(lds + PG8_SA(b, h) + aoff + m * 2048 + k * 1024); } while (0)
#define PG8_LDB(dst, b, h) do { _Pragma("unroll") for (int n = 0; n < 2; ++n) _Pragma("unroll") for (int k = 0; k < 2; ++k) dst[n][k] = *(const LAS bf16x8*)(lds + PG8_SB(b, h) + boff + n * 2048 + k * 1024); } while (0)
#define PG8_MMA(ai, bj, At, Bt) do { __builtin_amdgcn_s_setprio(1); _Pragma("unroll") for (int m = 0; m < 4; ++m) _Pragma("unroll") for (int n = 0; n < 2; ++n) _Pragma("unroll") for (int k = 0; k < 2; ++k) \
        { if constexpr (I8) acc[ai][bj][m][n] = __builtin_amdgcn_mfma_i32_16x16x64_i8(__builtin_bit_cast(i32x4, Bt[n][k]), __builtin_bit_cast(i32x4, At[m][k]), acc[ai][bj][m][n], 0, 0, 0); \
          else acc[ai][bj][m][n] = __builtin_amdgcn_mfma_f32_16x16x32_bf16(Bt[n][k], At[m][k], acc[ai][bj][m][n], 0, 0, 0); } __builtin_amdgcn_s_setprio(0); } while (0)
#define PG8_WAIT_V(n) asm volatile("s_waitcnt vmcnt(" #n ")" ::: "memory")
#define PG8_WAIT_L(n) asm volatile("s_waitcnt lgkmcnt(" #n ")" ::: "memory")
#define PG8_BAR __builtin_amdgcn_s_barrier()
#define PG8_SCHED __builtin_amdgcn_sched_barrier(0)
    Unit cur, nxt; int ui = 0;
    if (!S.next(0, cur)) return;
    accv_t acc[2][2][4][2];
#pragma unroll
    for (int a = 0; a < 2; ++a)
#pragma unroll
        for (int b = 0; b < 2; ++b)
#pragma unroll
            for (int m = 0; m < 4; ++m)
#pragma unroll
                for (int n = 0; n < 2; ++n) acc[a][b][m][n] = accv_t{};
    bf16x8 At[4][2], B0[2][2], B1[2][2];
    const char* cA = P.a_ptr(cur); const char* cB = P.b_ptr(cur);
    int eslot = 0;
    E.stage(lds + ESC_OFF, cur, wid, lane);
    PG8_STAGE(PG8_SB(0, 0), cB, voffB); PG8_STAGE(PG8_SB(0, 1), cB + hstepB, voffB); PG8_STAGE(PG8_SA(0, 0), cA, voffA); PG8_STAGE(PG8_SA(0, 1), cA + hstepA, voffA);
    if (wr == 1) PG8_BAR;
    PG8_WAIT_V(2); PG8_BAR;
    PG8_STAGE(PG8_SB(1, 0), cB + kstep, voffB); PG8_STAGE(PG8_SA(1, 0), cA + kstep, voffA); PG8_STAGE(PG8_SB(1, 1), cB + hstepB + kstep, voffB);
    PG8_WAIT_V(6); PG8_BAR;
    for (;;) {
        const bool has_next = S.next(ui + 1, nxt);
        const char* nA = has_next ? P.a_ptr(nxt) : cA; const char* nB = has_next ? P.b_ptr(nxt) : cB;
        for (int t = 0; t < nt; t += 2) {
            if constexpr (Epi::MID) { if (t == 8 || t == 16) E.mid(acc, cur, t >> 3, wr, wc, fr, fq); }
            const bool last = (t == nt - 2);
            if (last && has_next) E.stage(lds + ESC_OFF + (eslot ^ 1) * ESC_SLOT, nxt, wid, lane);
            const char* a1 = cA + (size_t)(t + 1) * kstep;
            const char* a2 = last ? nA : cA + (size_t)(t + 2) * kstep; const char* b2 = last ? nB : cB + (size_t)(t + 2) * kstep;
            const char* a3 = a2 + kstep; const char* b3 = b2 + kstep;
            PG8_LDB(B0, 0, 0); PG8_LDB(B1, 0, 1); PG8_SCHED; PG8_LDA(At, 0, 0); PG8_STAGE(PG8_SA(1, 1), a1 + hstepA, voffA);
            PG8_WAIT_V(8); PG8_WAIT_L(0); PG8_BAR; PG8_MMA(0, 0, At, B0); PG8_MMA(0, 1, At, B1); PG8_BAR; PG8_SCHED;
            PG8_LDA(At, 0, 1); PG8_STAGE(PG8_SB(0, 0), b2, voffB); PG8_STAGE(PG8_SB(0, 1), b2 + hstepB, voffB); PG8_STAGE(PG8_SA(0, 0), a2, voffA);
            PG8_WAIT_V(8); PG8_WAIT_L(0); PG8_BAR; PG8_MMA(1, 0, At, B0); PG8_MMA(1, 1, At, B1); PG8_BAR; PG8_SCHED;
            PG8_LDB(B0, 1, 0); PG8_LDB(B1, 1, 1); PG8_SCHED; PG8_LDA(At, 1, 0); PG8_STAGE(PG8_SA(0, 1), a2 + hstepA, voffA);
            PG8_WAIT_V(8); PG8_WAIT_L(0); PG8_BAR; PG8_MMA(0, 0, At, B0); PG8_MMA(0, 1, At, B1); PG8_BAR; PG8_SCHED;
            PG8_LDA(At, 1, 1); PG8_STAGE(PG8_SB(1, 0), b3, voffB); PG8_STAGE(PG8_SB(1, 1), b3 + hstepB, voffB); PG8_STAGE(PG8_SA(1, 0), a3, voffA);
            PG8_WAIT_V(8); PG8_WAIT_L(0); PG8_BAR; PG8_MMA(1, 0, At, B0); PG8_MMA(1, 1, At, B1); PG8_BAR; PG8_SCHED;
        }
        if (wr == 0) PG8_BAR;
        E(acc, cur, wr, wc, fr, fq, lds + ESC_OFF + eslot * ESC_SLOT);
        if (!has_next) break;
#pragma unroll
        for (int a = 0; a < 2; ++a)
#pragma unroll
            for (int b = 0; b < 2; ++b)
#pragma unroll
                for (int m = 0; m < 4; ++m)
#pragma unroll
                    for (int n = 0; n < 2; ++n) acc[a][b][m][n] = accv_t{};
        cur = nxt; cA = nA; cB = nB; ++ui; eslot ^= 1;
        if (wr == 1) PG8_BAR;
    }
    PG8_WAIT_V(0);
    PG8_BAR;
#undef PG8_SA
#undef PG8_SB
#undef PG8_STAGE
#undef PG8_LDA
#undef PG8_LDB
#undef PG8_MMA
#undef PG8_WAIT_V
#undef PG8_WAIT_L
#undef PG8_BAR
#undef PG8_SCHED
}
}

struct Frame {
    LAS unsigned char* lds;
    volatile LAS unsigned* MISC;
    gu32* ctl;
    unsigned char* ws;
    int tid, lane, wave, vcu, G;
    const float* const* in; float* out;
};
enum { I_X = 0, I_MEM, I_POS, I_GMIX, I_WIN, I_GQ, I_WUQ, I_GKV, I_WUKV, I_SINK, I_WMKV, I_WBR, I_WOUT, I_GFFN, I_WGD, I_WUD, I_WDD, I_WR, I_WGE, I_WUE, I_WDE, I_GMEM, I_GFIN };

__device__ __forceinline__ int sem_plain(int g) { return (g & ~31) + 8 * ((g >> 2) & 3) + 4 * ((g >> 4) & 1) + (g & 3); }
__device__ __forceinline__ int sem_rot64(int g) { return (g & ~63) + 32 * ((g >> 4) & 1) + 16 * ((g >> 5) & 1) + 4 * ((g >> 2) & 3) + (g & 3); }
__device__ __forceinline__ int inproj_src(int n) {
    const int pn = n >> 8, c = n & 255;
    if (pn < 2) return pn * 256 + sem_rot64(c);
    if (pn == 2) return c < 128 ? 512 + sem_rot64(c) : 640 + sem_plain(c - 128);
    if (pn == 3) return 768 + sem_plain(c);
    if (pn == 4) return c < 128 ? 1024 + sem_plain(c) : (c < 160 ? 1152 + (c - 128) : -1);
    if (pn < 7) return 1184 + (pn - 5) * 256 + sem_plain(c);
    return 1696 + (pn - 7) * 256 + sem_plain(c);
}

struct MapInproj { const float* W; __device__ __forceinline__ float load(int k, int n) const { const int s = inproj_src(n); return s >= 0 ? W[(size_t)k * INW + s] : 0.f; }
    __device__ __forceinline__ f32x4 load4(int k, int n) const { const int s = inproj_src(n); return s >= 0 ? *(const f32x4*)(W + (size_t)k * INW + s) : (f32x4){0.f, 0.f, 0.f, 0.f}; } };
struct MapUp { const float *Wq, *Wkv, *gq, *gkv;
    __device__ __forceinline__ f32x4 load4(int k, int n) const {
        if (n < 768) { const int gg = n >> 5; const int s = (gg % 3 == 2) ? n : sem_plain(n); return *(const f32x4*)(Wq + (size_t)k * 768 + s) * gq[k]; }
        if (k < 128) return (f32x4){0.f, 0.f, 0.f, 0.f}; const int s = sem_plain(n - 768); return *(const f32x4*)(Wkv + (size_t)(k - 128) * 1024 + s) * gkv[k - 128]; }
    __device__ __forceinline__ float load(int k, int n) const {
        if (n < 768) { const int gg = n >> 5; const int s = (gg % 3 == 2) ? n : sem_plain(n); return gq[k] * Wq[(size_t)k * 768 + s]; }
        if (k < 128) return 0.f; const int s = sem_plain(n - 768); return gkv[k - 128] * Wkv[(size_t)(k - 128) * 1024 + s]; } };
struct MapPlain { const float* W; int ldw; __device__ __forceinline__ float load(int k, int n) const { return W[(size_t)k * ldw + sem_plain(n)]; }
    __device__ __forceinline__ f32x4 load4(int k, int n) const { return *(const f32x4*)(W + (size_t)k * ldw + sem_plain(n)); } };
struct MapNat { const float* W; int ldw; __device__ __forceinline__ float load(int k, int n) const { return W[(size_t)k * ldw + n]; }
    __device__ __forceinline__ f32x4 load4(int k, int n) const { return *(const f32x4*)(W + (size_t)k * ldw + n); } };
struct MapBr { const float* W;
    __device__ __forceinline__ float load(int k, int n) const { return W[(size_t)k * DM + sem_plain(n)]; }
    __device__ __forceinline__ f32x4 load4(int k, int n) const { return *(const f32x4*)(W + (size_t)k * DM + sem_plain(n)); } };
struct MapMemkv { const float* W; __device__ __forceinline__ float load(int k, int n) const { const int l = n >> 10, c = n & 1023; return W[((size_t)l * DM + k) * 1024 + sem_plain(c)]; }
    __device__ __forceinline__ f32x4 load4(int k, int n) const { const int l = n >> 10, c = n & 1023; return *(const f32x4*)(W + ((size_t)l * DM + k) * 1024 + sem_plain(c)); } };
struct MapGU { const float *Wg, *Wu; __device__ __forceinline__ float load(int k, int n) const { const int pn = n >> 8, c = n & 255; const int ch = 128 * pn + sem_plain(c & 127);
    const unsigned long long a = (unsigned long long)Wg, b = (unsigned long long)Wu, w = a ^ ((a ^ b) & (0ull - (unsigned long long)(c >> 7))); return ((const float*)w)[(size_t)k * DFF + ch]; }
    __device__ __forceinline__ f32x4 load4(int k, int n) const { const int pn = n >> 8, c = n & 255; const int ch = 128 * pn + sem_plain(c & 127);
        const unsigned long long a = (unsigned long long)Wg, b = (unsigned long long)Wu, w = a ^ ((a ^ b) & (0ull - (unsigned long long)(c >> 7))); return *(const f32x4*)((const float*)w + (size_t)k * DFF + ch); } };

template <class M> __device__ __forceinline__ void prep_item(const M& m, bf16_t* dst, int Kd, int nblk, LAS float* scr, int item, int lane) {
    const int kb = item / nblk, nb = item % nblk, k0 = 64 * kb, n0 = 32 * nb;
#pragma unroll 8
    for (int i = 0; i < 32; ++i) { const int kk = 2 * i + (lane >> 5); scr[kk * 33 + (lane & 31)] = m.load(k0 + kk, n0 + (lane & 31)); }
    LDS_WAIT(); asm volatile("" ::: "memory");
    const int c = lane & 7;
#pragma unroll
    for (int j = 0; j < 4; ++j) { const int n = (lane >> 3) + 8 * j; const LAS float* s = scr + (8 * c) * 33 + n;
        u32x4 o; o.x = pk2(s[0 * 33], s[1 * 33]); o.y = pk2(s[2 * 33], s[3 * 33]); o.z = pk2(s[4 * 33], s[5 * 33]); o.w = pk2(s[6 * 33], s[7 * 33]);
        *(u32x4*)(dst + (size_t)(n0 + n) * Kd + k0 + 8 * c) = o; }
    LDS_WAIT(); asm volatile("" ::: "memory");
}
template <class M> __device__ __forceinline__ void prep_tile(const M& m, bf16_t* dst, int Kd, int nblk, LAS unsigned char* tile, int item, int lane) {
    const int kb = item / nblk, nb = item % nblk, k0 = 128 * kb, n0 = 32 * nb, ng = lane & 7, kr = lane >> 3;
    f32x4 v[16];
#pragma unroll
    for (int i = 0; i < 16; ++i) v[i] = m.load4(k0 + 8 * i + kr, n0 + 4 * ng);
#pragma unroll
    for (int i = 0; i < 16; ++i)
#pragma unroll
        for (int c = 0; c < 4; ++c) *(LAS unsigned short*)(tile + (4 * ng + c) * 272 + (8 * i + kr) * 2) = (unsigned short)f2bf(v[i][c]);
    LDS_WAIT(); asm volatile("" ::: "memory");
#pragma unroll
    for (int j = 0; j < 8; ++j) { const int p = lane + 64 * j, n = p >> 4, kc = p & 15;
        *(u32x4*)(dst + (size_t)(n0 + n) * Kd + k0 + 8 * kc) = *(const LAS u32x4*)(tile + n * 272 + 16 * kc); }
    LDS_WAIT(); asm volatile("" ::: "memory");
}
template <class M> __device__ __forceinline__ void prep_matrix(Frame& F, const M& m, bf16_t* dst, int N, int K) {
    LAS unsigned char* tile = F.lds + F.wave * 16384;
    const int gw = F.vcu * NWAVES + F.wave, NGW = F.G * NWAVES, nblk = N / 32, nitems = (K / 128) * nblk;
    for (int it = gw; it < nitems; it += NGW) prep_tile(m, dst, K, nblk, tile, it, F.lane);
}

template <class M> __device__ __forceinline__ void prep_strip_i8(Frame& F, const M& m, signed char* dst, float* scl, int strip) {
    const int lane = F.lane, w = F.wave, n0 = strip * 32, k0 = w * 128, ng = lane & 7, kr = lane >> 3;
    LAS unsigned char* tile = F.lds + w * 16384;
    LAS float* amt = (LAS float*)(F.lds + LDSCTL_OFF + 2048);
    f32x4 v[16];
#pragma unroll
    for (int i = 0; i < 16; ++i) v[i] = m.load4(k0 + 8 * i + kr, n0 + 4 * ng);
    f32x4 am = __builtin_elementwise_abs(v[0]);
#pragma unroll
    for (int i = 1; i < 16; ++i) am = __builtin_elementwise_max(am, __builtin_elementwise_abs(v[i]));
#pragma unroll
    for (int c = 0; c < 4; ++c) { float a = am[c]; a = fmaxf(a, __shfl_xor(a, 8)); a = fmaxf(a, __shfl_xor(a, 16)); a = fmaxf(a, __shfl_xor(a, 32)); am[c] = a; }
    if (kr == 0) *(LAS f32x4*)(amt + w * 32 + 4 * ng) = am;
    __syncthreads();
    f32x4 cm = *(const LAS f32x4*)(amt + 4 * ng);
#pragma unroll
    for (int ww = 1; ww < 8; ++ww) cm = __builtin_elementwise_max(cm, *(const LAS f32x4*)(amt + ww * 32 + 4 * ng));
    f32x4 inv;
#pragma unroll
    for (int c = 0; c < 4; ++c) inv[c] = cm[c] > 0.f ? 127.0f / cm[c] : 0.f;
    if (w == 0 && kr == 0) *(f32x4*)(scl + n0 + 4 * ng) = cm * (1.0f / 127.0f);
#pragma unroll
    for (int i = 0; i < 16; ++i)
#pragma unroll
        for (int c = 0; c < 4; ++c) tile[(4 * ng + c) * 144 + 8 * i + kr] = (unsigned char)(signed char)__float2int_rn(v[i][c] * inv[c]);
    LDS_WAIT(); asm volatile("" ::: "memory");
#pragma unroll
    for (int j = 0; j < 4; ++j) { const int p = lane + 64 * j, n = p >> 3, kc = p & 7;
        *(u32x4*)(dst + (size_t)(n0 + n) * DM + k0 + 16 * kc) = *(const LAS u32x4*)(tile + n * 144 + 16 * kc); }
    LDS_WAIT();
    __syncthreads();
}
__device__ __forceinline__ bf16_t* wmix(Frame& F, int l, size_t off) { return (bf16_t*)(F.ws + WS_WMIX + (size_t)l * WL_STRIDE + off); }

__device__ __forceinline__ void prep_mixer_weights(Frame& F) {
    for (int l = 0; l < DEPTH; ++l) {
        { MapInproj m{F.in[I_WIN] + (size_t)l * DM * INW}; for (int s = F.vcu; s < NT_IN * 8; s += F.G) prep_strip_i8(F, m, (signed char*)wmix(F, l, WL_IN), (float*)(F.ws + WS_MISC + MS_WSIN) + l * NT_IN * 256, s); }
        { MapUp m{F.in[I_WUQ] + (size_t)l * 256 * 768, F.in[I_WUKV] + (size_t)l * 128 * 1024, F.in[I_GQ] + l * 256, F.in[I_GKV] + l * 128}; prep_matrix(F, m, wmix(F, l, WL_UP), UPN, UPK); }
        { MapBr m{F.in[I_WBR] + (size_t)l * 3 * 512 * DM}; prep_matrix(F, m, wmix(F, l, WL_BR), DM, 1536); }
        { MapNat m{F.in[I_WOUT] + (size_t)l * DM * DM, DM}; prep_matrix(F, m, wmix(F, l, WL_OUT), DM, DM); }
    }
    { MapMemkv m{F.in[I_WMKV]}; prep_matrix(F, m, (bf16_t*)(F.ws + WS_WMKV), 4096, DM); }
}
__device__ __forceinline__ void prep_ffn_weights(Frame& F, int l) {
    const int i = l >> 1; const bool moe = (l & 1) != 0;
    LAS float* scr = (LAS float*)(F.lds + F.wave * 16384);
    const int gw = F.vcu * NWAVES + F.wave, NGW = F.G * NWAVES;
    constexpr int IGU = (DM / 64) * (2 * DFF / 32), ID = (DFF / 64) * (DM / 32), NSTRIP = 2 * DFF / 32;
    const int ne = moe ? NE : 1;
    const float* Wg = moe ? F.in[I_WGE] : F.in[I_WGD]; const float* Wu = moe ? F.in[I_WUE] : F.in[I_WUD]; const float* Wd = moe ? F.in[I_WDE] : F.in[I_WDD];
    if (GU_I8(l)) {
        for (int s = F.vcu; s < ne * NSTRIP; s += F.G) { const int e = s / NSTRIP, ss = s % NSTRIP; const size_t eo = ((size_t)i * ne + e) * DM * DFF;
            MapGU m{Wg + eo, Wu + eo}; prep_strip_i8(F, m, (signed char*)(F.ws + WS_WFFN + (size_t)e * WF_STRIDE), (float*)(F.ws + WS_MISC + MS_WSGU) + e * 2 * DFF, ss); }
    } else {
        for (int it = gw; it < ne * IGU; it += NGW) { const int e = it / IGU, r = it % IGU; const size_t eo = ((size_t)i * ne + e) * DM * DFF;
            MapGU m{Wg + eo, Wu + eo}; prep_item(m, (bf16_t*)(F.ws + WS_WFFN + (size_t)e * WF_STRIDE), DM, 2 * DFF / 32, scr, r, F.lane); }
    }
    constexpr int IDT = (DFF / 128) * (DM / 32);
    for (int it = gw; it < ne * IDT; it += NGW) { const int e = it / IDT, r = it % IDT; const size_t eo = ((size_t)i * ne + e) * DM * DFF;
        MapNat m{Wd + eo, DM}; prep_tile(m, (bf16_t*)(F.ws + WS_WFFN + (size_t)e * WF_STRIDE + WF_D), DFF, DM / 32, F.lds + F.wave * 16384, r, F.lane); }
}

struct RowV { f32x4 v[4]; };
__device__ __forceinline__ void row_load(RowV& r, const float* p, int lane) { const f32x4* x = (const f32x4*)p + lane;
#pragma unroll
    for (int j = 0; j < 4; ++j) r.v[j] = x[64 * j]; }
__device__ __forceinline__ void row_store(const RowV& r, float* p, int lane) { f32x4* x = (f32x4*)p + lane;
#pragma unroll
    for (int j = 0; j < 4; ++j) x[64 * j] = r.v[j]; }
__device__ __forceinline__ void row_add_bf16(RowV& r, const bf16_t* p, float w, int lane) { const u32x2* x = (const u32x2*)p + lane;
#pragma unroll
    for (int j = 0; j < 4; ++j) { const u32x2 q = x[64 * j]; r.v[j].x += w * bflo(q.x); r.v[j].y += w * bfhi(q.x); r.v[j].z += w * bflo(q.y); r.v[j].w += w * bfhi(q.y); } }
__device__ __forceinline__ void row_load_bf16(RowV& r, const bf16_t* p, int lane) { const u32x2* x = (const u32x2*)p + lane;
#pragma unroll
    for (int j = 0; j < 4; ++j) { const u32x2 q = x[64 * j]; r.v[j].x = bflo(q.x); r.v[j].y = bfhi(q.x); r.v[j].z = bflo(q.y); r.v[j].w = bfhi(q.y); } }
__device__ __forceinline__ void row_round_bf16(RowV& r) {
#pragma unroll
    for (int j = 0; j < 4; ++j) { r.v[j].x = bf2f((unsigned short)f2bf(r.v[j].x)); r.v[j].y = bf2f((unsigned short)f2bf(r.v[j].y)); r.v[j].z = bf2f((unsigned short)f2bf(r.v[j].z)); r.v[j].w = bf2f((unsigned short)f2bf(r.v[j].w)); } }
__device__ __forceinline__ float row_rstd(const RowV& r) { float s = 0.f;
#pragma unroll
    for (int j = 0; j < 4; ++j) s += (r.v[j].x * r.v[j].x + r.v[j].y * r.v[j].y) + (r.v[j].z * r.v[j].z + r.v[j].w * r.v[j].w);
    return 1.0f / sqrtf(wave_sum(s) * (1.0f / DM) + EPS); }
__device__ __forceinline__ void row_scale(RowV& r, float rstd, const float* g, int lane) { const f32x4* gg = (const f32x4*)g + lane;
#pragma unroll
    for (int j = 0; j < 4; ++j) r.v[j] = r.v[j] * rstd * gg[64 * j]; }
__device__ __forceinline__ void row_store_bf16(const RowV& r, bf16_t* p, int lane) { u32x2* o = (u32x2*)p + lane;
#pragma unroll
    for (int j = 0; j < 4; ++j) { u32x2 w; w.x = pk2(r.v[j].x, r.v[j].y); w.y = pk2(r.v[j].z, r.v[j].w); o[64 * j] = w; } }

__device__ __forceinline__ float row_store_i8(const RowV& r, signed char* p, int lane) {
    float am = 0.f;
#pragma unroll
    for (int j = 0; j < 4; ++j) am = fmaxf(am, fmaxf(fmaxf(fabsf(r.v[j].x), fabsf(r.v[j].y)), fmaxf(fabsf(r.v[j].z), fabsf(r.v[j].w))));
#pragma unroll
    for (int o = 1; o < 64; o <<= 1) am = fmaxf(am, __shfl_xor(am, o));
    const float inv = am > 0.f ? 127.0f / am : 0.f; unsigned* o4 = (unsigned*)p + lane;
#pragma unroll
    for (int j = 0; j < 4; ++j) { const unsigned a = (unsigned)__float2int_rn(r.v[j].x * inv) & 255u, b = (unsigned)__float2int_rn(r.v[j].y * inv) & 255u, c = (unsigned)__float2int_rn(r.v[j].z * inv) & 255u, d = (unsigned)__float2int_rn(r.v[j].w * inv) & 255u;
        o4[64 * j] = a | (b << 8) | (c << 16) | (d << 24); }
    return am * (1.0f / 127.0f);
}
__device__ __forceinline__ void row_combine(Frame& F, RowV& r, int t) {
    const int* sl = (const int*)(F.ws + WS_MISC + MS_SLOT) + 2 * t; const float* tw = (const float*)(F.ws + WS_MISC + MS_TOKW) + 2 * t;
    const bf16_t* Y = (const bf16_t*)(F.ws + WS_R + R_YOUT);
    const int s0 = sl[0], s1 = sl[1]; const float w0 = tw[0], w1 = tw[1];
    row_add_bf16(r, Y + (size_t)s0 * DM, w0, F.lane); row_add_bf16(r, Y + (size_t)s1 * DM, w1, F.lane);
}

__device__ __forceinline__ void norm_phase(Frame& F, const float* srcf, bf16_t* X, const float* g, bool combine, bool out_i8) {
    bf16_t* H = (bf16_t*)(F.ws + WS_H); signed char* Hq = (signed char*)(F.ws + WS_H); float* hsc = (float*)(F.ws + WS_MISC + MS_HSC);
    const int gw = F.vcu * NWAVES + F.wave, NGW = F.G * NWAVES;
    for (int t = gw; t < T; t += 2 * NGW) {
        const int t2 = t + NGW;
        RowV r, q;
        if (srcf) { row_load(r, srcf + (size_t)t * DM, F.lane); row_load(q, srcf + (size_t)t2 * DM, F.lane); }
        else { row_load_bf16(r, X + (size_t)t * DM, F.lane); row_load_bf16(q, X + (size_t)t2 * DM, F.lane); }
        if (combine) { row_combine(F, r, t); row_combine(F, q, t2); row_store_bf16(r, X + (size_t)t * DM, F.lane); row_store_bf16(q, X + (size_t)t2 * DM, F.lane);
            row_round_bf16(r); row_round_bf16(q); }
        const float rstd = row_rstd(r), qstd = row_rstd(q); row_scale(r, rstd, g, F.lane); row_scale(q, qstd, g, F.lane);
        if (out_i8) { const float sc = row_store_i8(r, Hq + (size_t)t * DM, F.lane), sq = row_store_i8(q, Hq + (size_t)t2 * DM, F.lane); if (F.lane == 0) { hsc[t] = sc; hsc[t2] = sq; } }
        else { row_store_bf16(r, H + (size_t)t * DM, F.lane); row_store_bf16(q, H + (size_t)t2 * DM, F.lane); }
    }
}
__device__ __forceinline__ void final_norm_phase(Frame& F, const bf16_t* X, float* out, const float* g, bool combine) {
    const int gw = F.vcu * NWAVES + F.wave, NGW = F.G * NWAVES;
    for (int t = gw; t < T; t += 2 * NGW) {
        const int t2 = t + NGW;
        RowV r, q; row_load_bf16(r, X + (size_t)t * DM, F.lane); row_load_bf16(q, X + (size_t)t2 * DM, F.lane);
        if (combine) { row_combine(F, r, t); row_combine(F, q, t2); }
        const float rstd = row_rstd(r), qstd = row_rstd(q); row_scale(r, rstd, g, F.lane); row_scale(q, qstd, g, F.lane);
        row_store(r, out + (size_t)t * DM, F.lane); row_store(q, out + (size_t)t2 * DM, F.lane);
    }
}
__device__ __forceinline__ void memnorm_phase(Frame& F) {
    bf16_t* MN = (bf16_t*)(F.ws + WS_MEMN);
    const int gw = F.vcu * NWAVES + F.wave, NGW = F.G * NWAVES;
    for (int t = gw; t < NB * MEML; t += NGW) {
        RowV r; row_load(r, F.in[I_MEM] + (size_t)t * DM, F.lane);
        const float rstd = row_rstd(r); row_scale(r, rstd, F.in[I_GMEM], F.lane);
        row_store_bf16(r, MN + (size_t)t * DM, F.lane);
    }
}

__device__ __forceinline__ void norm_router_phase(Frame& F, const bf16_t* X, const float* g, const float* Wr  , bool out_i8) {
    bf16_t* H = (bf16_t*)(F.ws + WS_H); signed char* Hq = (signed char*)(F.ws + WS_H); float* hsc = (float*)(F.ws + WS_MISC + MS_HSC);
    int* toke = (int*)(F.ws + WS_MISC + MS_TOKE); float* tokw = (float*)(F.ws + WS_MISC + MS_TOKW); int* cntg = (int*)(F.ws + WS_MISC + MS_CNT);
    volatile LAS int* hist = (volatile LAS int*)(F.lds + LDSCTL_OFF + 1024);
    f32x4 wa[4][4], wb[4][4];
#pragma unroll
    for (int j = 0; j < 4; ++j)
#pragma unroll
        for (int k = 0; k < 4; ++k) { const int d = 256 * j + 4 * F.lane + k; wa[j][k] = *(const f32x4*)(Wr + (size_t)d * 8); wb[j][k] = *(const f32x4*)(Wr + (size_t)d * 8 + 4); }
    const bool up32 = (F.lane & 32) != 0, up16 = (F.lane & 16) != 0, up8 = (F.lane & 8) != 0;
    for (int c = F.vcu; c < T / 128; c += F.G) {
        if (F.tid < 8) hist[F.tid] = 0;
        __syncthreads();
        for (int q = 0; q < 16; ++q) {
            const int t = c * 128 + F.wave * 16 + q;
            RowV r; row_load_bf16(r, X + (size_t)t * DM, F.lane);
            const float rstd = row_rstd(r); row_scale(r, rstd, g, F.lane);
            if (out_i8) { const float sc = row_store_i8(r, Hq + (size_t)t * DM, F.lane); if (F.lane == 0) hsc[t] = sc; }
            else row_store_bf16(r, H + (size_t)t * DM, F.lane);
            f32x4 la = {0.f, 0.f, 0.f, 0.f}, lb = {0.f, 0.f, 0.f, 0.f};
#pragma unroll
            for (int j = 0; j < 4; ++j)
#pragma unroll
                for (int k = 0; k < 4; ++k) { const float x = r.v[j][k]; la += wa[j][k] * x; lb += wb[j][k] * x; }
            f32x4 h4; { const f32x4 keep = up32 ? lb : la, send = up32 ? la : lb;
#pragma unroll
                for (int i = 0; i < 4; ++i) h4[i] = keep[i] + __shfl_xor(send[i], 32); }
            f32x2 h2; { const float k0 = up16 ? h4[2] : h4[0], k1 = up16 ? h4[3] : h4[1], s0 = up16 ? h4[0] : h4[2], s1 = up16 ? h4[1] : h4[3]; h2.x = k0 + __shfl_xor(s0, 16); h2.y = k1 + __shfl_xor(s1, 16); }
            float h1 = (up8 ? h2.y : h2.x) + __shfl_xor(up8 ? h2.x : h2.y, 8);
            h1 += __shfl_xor(h1, 4); h1 += __shfl_xor(h1, 2); h1 += __shfl_xor(h1, 1);
            float lg[8];
#pragma unroll
            for (int e = 0; e < 8; ++e) lg[e] = __builtin_bit_cast(float, __builtin_amdgcn_readlane(__builtin_bit_cast(int, h1), 8 * e));
            int e0 = 0; float v0 = lg[0];
#pragma unroll
            for (int e = 1; e < 8; ++e) if (lg[e] > v0) { v0 = lg[e]; e0 = e; }
            int e1 = -1; float v1 = -INFINITY;
#pragma unroll
            for (int e = 0; e < 8; ++e) if (e != e0 && lg[e] > v1) { v1 = lg[e]; e1 = e; }
            if (F.lane == 0) {
                const float w0 = 1.0f / (1.0f + __expf(v1 - v0));
                toke[2 * t] = e0; toke[2 * t + 1] = e1; tokw[2 * t] = w0; tokw[2 * t + 1] = 1.0f - w0;
                __hip_atomic_fetch_add((LAS int*)&hist[e0], 1, __ATOMIC_RELAXED, __HIP_MEMORY_SCOPE_WORKGROUP); __hip_atomic_fetch_add((LAS int*)&hist[e1], 1, __ATOMIC_RELAXED, __HIP_MEMORY_SCOPE_WORKGROUP);
            }
        }
        __syncthreads();
        if (F.tid < 8) cntg[c * 8 + F.tid] = hist[F.tid];
        __syncthreads();
    }
}
__device__ __forceinline__ void moe_assign_phase(Frame& F, bool i8) {
    const bf16_t* H = (const bf16_t*)(F.ws + WS_H); bf16_t* AS = (bf16_t*)(F.ws + WS_R + R_ASORT);
    const float* hsc = (const float*)(F.ws + WS_MISC + MS_HSC); float* asc = (float*)(F.ws + WS_MISC + MS_ASC);
    const int* toke = (const int*)(F.ws + WS_MISC + MS_TOKE); int* slot = (int*)(F.ws + WS_MISC + MS_SLOT); const int* cntg = (const int*)(F.ws + WS_MISC + MS_CNT);
    int* texp = (int*)(F.ws + WS_MISC + MS_TEXP);
    volatile LAS int* tot = (volatile LAS int*)(F.lds + LDSCTL_OFF + 1024);
    volatile LAS int* pre = tot + 8;
    volatile LAS int* wcnt = tot + 16;
    for (int c = F.vcu; c < T / 128; c += F.G) {
        if (F.tid < 16) tot[F.tid] = 0;
        __syncthreads();
        { const int cc = F.tid >> 1, h = F.tid & 1; const i32x4 v = *(const i32x4*)(cntg + cc * 8 + 4 * h);
#pragma unroll
          for (int k = 0; k < 4; ++k) { __hip_atomic_fetch_add((LAS int*)&tot[4 * h + k], v[k], __ATOMIC_RELAXED, __HIP_MEMORY_SCOPE_WORKGROUP); if (cc < c) __hip_atomic_fetch_add((LAS int*)&pre[4 * h + k], v[k], __ATOMIC_RELAXED, __HIP_MEMORY_SCOPE_WORKGROUP); } }
        const int t = c * 128 + F.wave * 16 + ((F.lane & 31) >> 1);
        const int my_e = (F.lane < 32) ? toke[2 * t + (F.lane & 1)] : -1;
        int rank = 0;
#pragma unroll
        for (int e = 0; e < 8; ++e) { const unsigned long long m = __ballot(my_e == e); if (my_e == e) rank = __popcll(m & ((1ull << F.lane) - 1ull)); if (F.lane == 0) wcnt[F.wave * 8 + e] = __popcll(m); }
        __syncthreads();
        int myslot = 0;
        if (F.lane < 32) {
            int ts = 0;
#pragma unroll
            for (int e = 0; e < 8; ++e) ts += (e < my_e) ? ((tot[e] + 255) >> 8) : 0;
            int wp = 0; for (int w = 0; w < F.wave; ++w) wp += wcnt[w * 8 + my_e];
            myslot = ts * 256 + pre[my_e] + wp + rank;
            slot[2 * t + (F.lane & 1)] = myslot;
        }
        if (c == 0 && F.tid == 0) { int ts = 0; for (int e = 0; e < 8; ++e) { const int n = (tot[e] + 255) >> 8; for (int k = 0; k < n; ++k) texp[ts + k] = e; ts += n; } for (int k = ts; k < MAXRT; ++k) texp[k] = 0; texp[MAXRT] = ts; }
        if (i8) {
            const float myh = hsc[t];
#pragma unroll 1
            for (int a0 = 0; a0 < 32; a0 += 8) {
                u32x4 x[4];
#pragma unroll
                for (int k = 0; k < 4; ++k) x[k] = *((const u32x4*)((const signed char*)H + (size_t)(c * 128 + F.wave * 16 + ((a0 + 2 * k) >> 1)) * DM) + F.lane);
#pragma unroll
                for (int k = 0; k < 8; ++k) { const int s = __builtin_amdgcn_readlane(myslot, a0 + k); *((u32x4*)((signed char*)AS + (size_t)s * DM) + F.lane) = x[k >> 1]; }
            }
            if (F.lane < 32) asc[myslot] = myh;
        } else {
            for (int a = 0; a < 32; ++a) {
                const int s = __builtin_amdgcn_readlane(myslot, a); const int ta = c * 128 + F.wave * 16 + (a >> 1);
                const u32x4* srcp = (const u32x4*)(H + (size_t)ta * DM) + F.lane; u32x4* dstp = (u32x4*)(AS + (size_t)s * DM) + F.lane;
                const u32x4 x0 = srcp[0], x1 = srcp[64]; dstp[0] = x0; dstp[64] = x1; }
        }
        __syncthreads();
    }
}

using pg8::Unit;
typedef f32x4 AccT[2][2][4][2];

struct ProbSimple { int K; unsigned lda, ldb; const char* A; const char* B;
    __device__ __forceinline__ const char* a_ptr(const Unit& u) const { return A + (size_t)u.pm * 256 * lda; }
    __device__ __forceinline__ const char* b_ptr(const Unit& u) const { return B + (size_t)u.pn * 256 * ldb; } };
struct ProbUp { int K; unsigned lda, ldb; const char* A; const char* B;
    __device__ __forceinline__ const char* a_ptr(const Unit& u) const { return A + (size_t)u.pm * 256 * lda + (u.pn >= 3 ? 256 : 0); }
    __device__ __forceinline__ const char* b_ptr(const Unit& u) const { return B + (size_t)u.pn * 256 * ldb; } };
struct ProbMoe { int K; unsigned lda, ldb; const char* A; const char* B; int a_lo;
    __device__ __forceinline__ const char* a_ptr(const Unit& u) const { return A + (size_t)(u.pm - a_lo) * 256 * lda; }
    __device__ __forceinline__ const char* b_ptr(const Unit& u) const { return B + (size_t)u.aux * WF_STRIDE + (size_t)u.pn * 256 * ldb; } };

struct MoeOrder { pg8::StaticOrder base; int lo; const int* texp;
    __device__ bool next(int i, Unit& u) const { if (!base.next(i, u)) return false; u.pm += lo; u.aux = __builtin_amdgcn_readfirstlane(texp[u.pm]); return true; } };

__device__ __forceinline__ u32x4 pack8(const f32x4 a, const f32x4 b) { u32x4 w; w.x = cvtpk(a[0], a[1]); w.y = cvtpk(a[2], a[3]); w.z = cvtpk(b[0], b[1]); w.w = cvtpk(b[2], b[3]); return w; }
__device__ __forceinline__ u32x2 pack4(const f32x4 a) { u32x2 w; w.x = cvtpk(a[0], a[1]); w.y = cvtpk(a[2], a[3]); return w; }

struct EpiNoStage { __device__ __forceinline__ void stage(LAS unsigned char*, const Unit&, int, int) const {} };
__device__ __forceinline__ void stage1k(const void* src, LAS unsigned char* dst, int lane) { __builtin_amdgcn_global_load_lds((const unsigned*)((const char*)src + lane * 16), (LAS unsigned*)dst, 16, 0, 0); }
__device__ __forceinline__ f32x4 deq(const f32x4& a, float, const f32x4&) { return a; }
__device__ __forceinline__ f32x4 deq(const i32x4& a, float rs, const f32x4& cs) { return __builtin_convertvector(a, f32x4) * rs * cs; }
struct EpiInproj {
    static constexpr bool MID = false;
    bf16_t* P; bf16_t* G; float* ssq; const int* pos; const float* rsc; const float* csc;
    __device__ __forceinline__ void stage(LAS unsigned char* d, const Unit& u, int wid, int lane) const {
        if (wid == 0) { stage1k(rsc + u.pm * 256, d, lane); stage1k(csc + u.pn * 256, d + 1024, lane); stage1k(pos + u.pm * 256, d + 2048, lane); } }
    template <class AV> __device__ __forceinline__ void operator()(const AV (&acc)[2][2][4][2], const Unit& u, int wr, int wc, int fr, int fq, const LAS unsigned char* esc) const {
        const int pn = u.pn, row0 = u.pm * 256 + wr * 64 + fr;
        f32x4 cs[2][2];
#pragma unroll
        for (int bj = 0; bj < 2; ++bj)
#pragma unroll
            for (int n = 0; n < 2; ++n) cs[bj][n] = *(const LAS f32x4*)(esc + 1024 + (bj * 128 + wc * 32 + n * 16 + fq * 4) * 4);
        float rs8[2][4], pf8[2][4];
#pragma unroll
        for (int ai = 0; ai < 2; ++ai)
#pragma unroll
            for (int m = 0; m < 4; ++m) { const int rl = ai * 128 + wr * 64 + m * 16 + fr; rs8[ai][m] = *(const LAS float*)(esc + rl * 4); pf8[ai][m] = (float)*(const LAS int*)(esc + 2048 + rl * 4); }
#define DQ(ai, bj, m, n) deq(acc[ai][bj][m][n], rs, cs[bj][n])
        if (pn >= 7) {
#pragma unroll
            for (int ai = 0; ai < 2; ++ai)
#pragma unroll
                for (int m = 0; m < 4; ++m) { const int row = row0 + ai * 128 + m * 16; const float rs = rs8[ai][m];
#pragma unroll
                    for (int bj = 0; bj < 2; ++bj) { f32x4 a = DQ(ai, bj, m, 0), b = DQ(ai, bj, m, 1);
#pragma unroll
                        for (int j = 0; j < 4; ++j) { a[j] = fast_sigmoid(a[j]) * 255.0f; b[j] = fast_sigmoid(b[j]) * 255.0f; }
                        u32x2 w; w.x = (unsigned)__float2int_rn(a[0]) | ((unsigned)__float2int_rn(a[1]) << 8) | ((unsigned)__float2int_rn(a[2]) << 16) | ((unsigned)__float2int_rn(a[3]) << 24);
                        w.y = (unsigned)__float2int_rn(b[0]) | ((unsigned)__float2int_rn(b[1]) << 8) | ((unsigned)__float2int_rn(b[2]) << 16) | ((unsigned)__float2int_rn(b[3]) << 24);
                        *(u32x2*)((unsigned char*)G + (size_t)row * GW + (pn - 7) * 256 + bj * 128 + wc * 32 + fq * 8) = w; } }
        } else if (pn >= 5 || pn == 3) {
            const float sc = (pn == 3) ? 1.0f : C_M;
#pragma unroll
            for (int ai = 0; ai < 2; ++ai)
#pragma unroll
                for (int m = 0; m < 4; ++m) { const int row = row0 + ai * 128 + m * 16; const float rs = rs8[ai][m]; float s = 0.f;
#pragma unroll
                    for (int bj = 0; bj < 2; ++bj) { const f32x4 a = DQ(ai, bj, m, 0) * sc, b = DQ(ai, bj, m, 1) * sc;
                        s += (a[0] * a[0] + a[1] * a[1]) + (a[2] * a[2] + a[3] * a[3]) + (b[0] * b[0] + b[1] * b[1]) + (b[2] * b[2] + b[3] * b[3]);
                        *(u32x4*)(P + (size_t)row * PW + pn * 256 + bj * 128 + wc * 32 + fq * 8) = pack8(a, b); }
                    if (pn == 3) { s += __shfl_xor(s, 16); s += __shfl_xor(s, 32); if (fq == 0) ssq[(size_t)row * 8 + wc] = s; } }
        } else if (pn == 4) {
#pragma unroll
            for (int ai = 0; ai < 2; ++ai)
#pragma unroll
                for (int m = 0; m < 4; ++m) { const int row = row0 + ai * 128 + m * 16; const float rs = rs8[ai][m];
                    { const f32x4 a = DQ(ai, 0, m, 0), b = DQ(ai, 0, m, 1);
                      float s = (a[0] * a[0] + a[1] * a[1]) + (a[2] * a[2] + a[3] * a[3]) + (b[0] * b[0] + b[1] * b[1]) + (b[2] * b[2] + b[3] * b[3]);
                      *(u32x4*)(P + (size_t)row * PW + P_CKV + wc * 32 + fq * 8) = pack8(a, b);
                      s += __shfl_xor(s, 16); s += __shfl_xor(s, 32); if (fq == 0) ssq[(size_t)row * 8 + 4 + wc] = s; }
                    if (wc == 0) { const f32x4 x1 = DQ(ai, 1, m, 0), x2 = DQ(ai, 1, m, 1); const float pf = pf8[ai][m]; f32x4 o1, o2;
#pragma unroll
                        for (int j = 0; j < 4; ++j) { float c, s; rot_cs(pf, 2 * (4 * fq + j), c, s); o1[j] = x1[j] * c - x2[j] * s; o2[j] = x2[j] * c + x1[j] * s; }
                        *(u32x2*)(P + (size_t)row * PW + P_KR + 4 * fq) = pack4(o1); *(u32x2*)(P + (size_t)row * PW + P_KR + 16 + 4 * fq) = pack4(o2); } }
        } else {
            const float sc = (pn < 2) ? C_A : 1.0f; const int i0 = 16 * (wc & 1) + 4 * fq;
#pragma unroll
            for (int ai = 0; ai < 2; ++ai)
#pragma unroll
                for (int m = 0; m < 4; ++m) { const int row = row0 + ai * 128 + m * 16; const float rs = rs8[ai][m]; const float pf = pf8[ai][m]; f32x4 c, s;
#pragma unroll
                    for (int j = 0; j < 4; ++j) { float cc, ss; rot_cs(pf, i0 + j, cc, ss); c[j] = cc * sc; s[j] = ss * sc; }
#pragma unroll
                    for (int bj = 0; bj < 2; ++bj) { const f32x4 x1 = DQ(ai, bj, m, 0), x2 = DQ(ai, bj, m, 1);
                        if (pn == 2 && bj == 1) { *(u32x4*)(P + (size_t)row * PW + P_VA + wc * 32 + fq * 8) = pack8(x1, x2); }
                        else { const f32x4 o1 = x1 * c - x2 * s, o2 = x2 * c + x1 * s; bf16_t* d = P + (size_t)row * PW + pn * 256 + 64 * (2 * bj + (wc >> 1)) + i0;
                            *(u32x2*)d = pack4(o1); *(u32x2*)(d + 32) = pack4(o2); } } }
        }
#undef DQ
    }
};
struct EpiUp {
    static constexpr bool MID = false;
    __device__ __forceinline__ void stage(LAS unsigned char*, const Unit&, int, int) const {}
    bf16_t* QB; bf16_t* KVB; const float* ssq; const int* pos;
    __device__ __forceinline__ void operator()(const AccT& acc, const Unit& u, int wr, int wc, int fr, int fq, const LAS unsigned char*) const {
        const int pn = u.pn, row0 = u.pm * 256 + wr * 64 + fr;
        float rs8[2][4], pf8[2][4];
#pragma unroll
        for (int ai = 0; ai < 2; ++ai)
#pragma unroll
            for (int m = 0; m < 4; ++m) { const int row = row0 + ai * 128 + m * 16; const f32x4 sv = *(const f32x4*)(ssq + (size_t)row * 8 + (pn < 3 ? 0 : 4));
                rs8[ai][m] = (pn < 3 ? C_B : 1.0f) / sqrtf(((sv[0] + sv[1]) + (sv[2] + sv[3])) * (pn < 3 ? 1.0f / 256.0f : 1.0f / 128.0f) + EPS); pf8[ai][m] = (pn < 3) ? (float)pos[row] : 0.f; }
#pragma unroll
        for (int ai = 0; ai < 2; ++ai)
#pragma unroll
            for (int m = 0; m < 4; ++m) { const int row = row0 + ai * 128 + m * 16; const float rs = rs8[ai][m];
                if (pn < 3) {
#pragma unroll
                    for (int bj = 0; bj < 2; ++bj) { const int gg = 8 * pn + 4 * bj + wc; const f32x4 x1 = acc[ai][bj][m][0] * rs, x2 = acc[ai][bj][m][1] * rs;
                        if (gg % 3 == 2) { const float pf = pf8[ai][m]; f32x4 o1, o2;
#pragma unroll
                            for (int j = 0; j < 4; ++j) { float c, s; rot_cs(pf, 2 * (4 * fq + j), c, s); o1[j] = x1[j] * c - x2[j] * s; o2[j] = x2[j] * c + x1[j] * s; }
                            bf16_t* d = QB + (size_t)row * QBW + 32 * gg + 4 * fq; *(u32x2*)d = pack4(o1); *(u32x2*)(d + 16) = pack4(o2); }
                        else *(u32x4*)(QB + (size_t)row * QBW + 32 * gg + 8 * fq) = pack8(x1, x2); }
                } else {
#pragma unroll
                    for (int bj = 0; bj < 2; ++bj) *(u32x4*)(KVB + (size_t)row * KVW + (pn - 3) * 256 + bj * 128 + wc * 32 + fq * 8) = pack8(acc[ai][bj][m][0] * rs, acc[ai][bj][m][1] * rs);
                } }
    }
};
struct EpiPlain {
    static constexpr bool MID = false;
    __device__ __forceinline__ void stage(LAS unsigned char*, const Unit&, int, int) const {}
    bf16_t* O; int ldo;
    __device__ __forceinline__ void operator()(const AccT& acc, const Unit& u, int wr, int wc, int fr, int fq, const LAS unsigned char*) const {
        const int row0 = u.pm * 256 + wr * 64 + fr;
#pragma unroll
        for (int ai = 0; ai < 2; ++ai)
#pragma unroll
            for (int m = 0; m < 4; ++m)
#pragma unroll
                for (int bj = 0; bj < 2; ++bj) *(u32x4*)(O + (size_t)(row0 + ai * 128 + m * 16) * ldo + u.pn * 256 + bj * 128 + wc * 32 + fq * 8) = pack8(acc[ai][bj][m][0], acc[ai][bj][m][1]);
    }
};
struct EpiBranch {
    static constexpr bool MID = true;
    const unsigned char* G; bf16_t* MIXED;
    __device__ __forceinline__ void stage(LAS unsigned char*, const Unit&, int, int) const {}
    static __device__ __forceinline__ float gq(unsigned w, int b) { const float f = (float)((w >> (8 * b)) & 255u); return fmaxf(f, 2.55e-4f); }
    __device__ __forceinline__ void mid(AccT& acc, const Unit& u, int seg  , int wr, int wc, int fr, int fq) const {
        const int row0 = opq_v(u.pm * 256 + wr * 64 + fr);
#pragma unroll
        for (int ai = 0; ai < 2; ++ai) {
            u32x2 ga[4][2], gb[4][2];
#pragma unroll
            for (int m = 0; m < 4; ++m)
#pragma unroll
                for (int bj = 0; bj < 2; ++bj) { const unsigned char* gp = G + (size_t)(row0 + ai * 128 + m * 16) * GW + u.pn * 256 + bj * 128 + wc * 32 + fq * 8;
                    ga[m][bj] = *(const u32x2*)(gp + (seg - 1) * 1024); gb[m][bj] = *(const u32x2*)(gp + seg * 1024); }
#pragma unroll
            for (int m = 0; m < 4; ++m)
#pragma unroll
                for (int bj = 0; bj < 2; ++bj) { const u32x2 a2 = ga[m][bj], b2 = gb[m][bj];
#pragma unroll
                    for (int j = 0; j < 4; ++j) { acc[ai][bj][m][0][j] *= gq(a2.x, j) * __builtin_amdgcn_rcpf(gq(b2.x, j)); acc[ai][bj][m][1][j] *= gq(a2.y, j) * __builtin_amdgcn_rcpf(gq(b2.y, j)); } }
            asm volatile("" ::: "memory"); }
    }
    __device__ __forceinline__ void operator()(const AccT& acc, const Unit& u, int wr, int wc, int fr, int fq, const LAS unsigned char*) const {
        const int row0 = u.pm * 256 + wr * 64 + fr;
#pragma unroll
        for (int ai = 0; ai < 2; ++ai) {
            u32x2 gw[4][2];
#pragma unroll
            for (int m = 0; m < 4; ++m)
#pragma unroll
                for (int bj = 0; bj < 2; ++bj) gw[m][bj] = *(const u32x2*)(G + (size_t)(row0 + ai * 128 + m * 16) * GW + 2048 + u.pn * 256 + bj * 128 + wc * 32 + fq * 8);
#pragma unroll
            for (int m = 0; m < 4; ++m)
#pragma unroll
                for (int bj = 0; bj < 2; ++bj) { const u32x2 g2 = gw[m][bj]; f32x4 a = acc[ai][bj][m][0], b = acc[ai][bj][m][1];
#pragma unroll
                    for (int j = 0; j < 4; ++j) { a[j] *= gq(g2.x, j) * (1.0f / 255.0f); b[j] *= gq(g2.y, j) * (1.0f / 255.0f); }
                    *(u32x4*)(MIXED + (size_t)(row0 + ai * 128 + m * 16) * DM + u.pn * 256 + bj * 128 + wc * 32 + fq * 8) = pack8(a, b); }
            asm volatile("" ::: "memory"); }
    }
};
struct EpiResid {
    static constexpr bool MID = false;
    __device__ __forceinline__ void stage(LAS unsigned char*, const Unit&, int, int) const {}
    const float* Xf; bf16_t* X;
    __device__ __forceinline__ void operator()(const AccT& acc, const Unit& u, int wr, int wc, int fr, int fq, const LAS unsigned char*) const {
        const int row0 = u.pm * 256 + wr * 64 + fr;
#pragma unroll
        for (int ai = 0; ai < 2; ++ai) {
            f32x4 xv[4][2][2];
#pragma unroll
            for (int m = 0; m < 4; ++m)
#pragma unroll
                for (int bj = 0; bj < 2; ++bj)
#pragma unroll
                    for (int n = 0; n < 2; ++n) { const size_t o = (size_t)(row0 + ai * 128 + m * 16) * DM + u.pn * 256 + bj * 128 + wc * 32 + n * 16 + fq * 4;
                        if (Xf) xv[m][bj][n] = *(const f32x4*)(Xf + o);
                        else { const u32x2 q = *(const u32x2*)(X + o); xv[m][bj][n] = (f32x4){bflo(q.x), bfhi(q.x), bflo(q.y), bfhi(q.y)}; } }
#pragma unroll
            for (int m = 0; m < 4; ++m)
#pragma unroll
                for (int bj = 0; bj < 2; ++bj)
#pragma unroll
                    for (int n = 0; n < 2; ++n) *(u32x2*)(X + (size_t)(row0 + ai * 128 + m * 16) * DM + u.pn * 256 + bj * 128 + wc * 32 + n * 16 + fq * 4) = pack4(xv[m][bj][n] + acc[ai][bj][m][n]);
            asm volatile("" ::: "memory"); }
    }
};
struct EpiSwiglu {
    static constexpr bool MID = false;
    bf16_t* ACT; int lo; const float* rsc; const float* csc;
    __device__ __forceinline__ void stage(LAS unsigned char* d, const Unit& u, int wid, int lane) const {
        if (wid == 0) { stage1k(rsc + u.pm * 256, d, lane); stage1k(csc + (size_t)u.aux * 2 * DFF + u.pn * 256, d + 1024, lane); } }
    template <class AV> __device__ __forceinline__ void operator()(const AV (&acc)[2][2][4][2], const Unit& u, int wr, int wc, int fr, int fq, const LAS unsigned char* esc) const {
        const int row0 = (u.pm - lo) * 256 + wr * 64 + fr;
        f32x4 cs[2][2];
#pragma unroll
        for (int bj = 0; bj < 2; ++bj)
#pragma unroll
            for (int n = 0; n < 2; ++n) cs[bj][n] = *(const LAS f32x4*)(esc + 1024 + (bj * 128 + wc * 32 + n * 16 + fq * 4) * 4);
        float rs8[2][4];
#pragma unroll
        for (int ai = 0; ai < 2; ++ai)
#pragma unroll
            for (int m = 0; m < 4; ++m) rs8[ai][m] = *(const LAS float*)(esc + (ai * 128 + wr * 64 + m * 16 + fr) * 4);
#pragma unroll
        for (int ai = 0; ai < 2; ++ai)
#pragma unroll
            for (int m = 0; m < 4; ++m) { const float rs = rs8[ai][m]; f32x4 a, b;
                const f32x4 g0 = deq(acc[ai][0][m][0], rs, cs[0][0]), g1 = deq(acc[ai][0][m][1], rs, cs[0][1]), u0 = deq(acc[ai][1][m][0], rs, cs[1][0]), u1 = deq(acc[ai][1][m][1], rs, cs[1][1]);
#pragma unroll
                for (int j = 0; j < 4; ++j) { a[j] = g0[j] * fast_sigmoid(g0[j]) * u0[j]; b[j] = g1[j] * fast_sigmoid(g1[j]) * u1[j]; }
                *(u32x4*)(ACT + (size_t)(row0 + ai * 128 + m * 16) * DFF + u.pn * 128 + wc * 32 + fq * 8) = pack8(a, b); }
    }
};
struct EpiYout {
    static constexpr bool MID = false;
    __device__ __forceinline__ void stage(LAS unsigned char*, const Unit&, int, int) const {}
    bf16_t* Y;
    __device__ __forceinline__ void operator()(const AccT& acc, const Unit& u, int wr, int wc, int fr, int fq, const LAS unsigned char*) const {
        const int row0 = u.pm * 256 + wr * 64 + fr;
#pragma unroll
        for (int ai = 0; ai < 2; ++ai)
#pragma unroll
            for (int m = 0; m < 4; ++m)
#pragma unroll
                for (int bj = 0; bj < 2; ++bj)
#pragma unroll
                    for (int n = 0; n < 2; ++n) *(u32x2*)(Y + (size_t)(row0 + ai * 128 + m * 16) * DM + u.pn * 256 + bj * 128 + wc * 32 + n * 16 + fq * 4) = pack4(acc[ai][bj][m][n]);
    }
};

namespace att {
__device__ __forceinline__ int crow(int r, int hi) { return (r & 3) + 8 * (r >> 2) + 4 * hi; }
__device__ __forceinline__ void glds16(const void* gsrc, unsigned lds_dst) { unsigned keep;
    asm volatile("s_mov_b32 %0, m0\n\ts_mov_b32 m0, %2\n\ts_nop 0\n\tglobal_load_lds_dwordx4 %1, off\n\ts_mov_b32 m0, %0" : "=&s"(keep) : "v"(gsrc), "s"(lds_dst) : "memory"); }
__device__ __forceinline__ float swapmax(float m) { auto rr = __builtin_amdgcn_permlane32_swap(__float_as_uint(m), __float_as_uint(m), false, false); return fmaxf(__uint_as_float(rr[0]), __uint_as_float(rr[1])); }
__device__ __forceinline__ float swapsum(float m) { auto rr = __builtin_amdgcn_permlane32_swap(__float_as_uint(m), __float_as_uint(m), false, false); return __uint_as_float(rr[0]) + __uint_as_float(rr[1]); }
__device__ __forceinline__ s16x4 vtr(unsigned addr) { s16x4 r; asm volatile("ds_read_b64_tr_b16 %0, %1" : "=&v"(r) : "v"(addr) : "memory"); return r; }
#define VTRO(dst, base, off) asm volatile("ds_read_b64_tr_b16 %0, %1 offset:%c2" : "=&v"(dst) : "v"(base), "i"(off) : "memory")

struct Src {
    const bf16_t* q; int qpitch;
    const bf16_t* k0; int k0pitch;
    const bf16_t* k1; int k1pitch;
    const bf16_t* v; int vpitch;
    bf16_t* o; int opitch;
};
template <int NKC, int NVB, int RD = 4>
__device__ __forceinline__ void dma_tile(const Src& S, int t, int slot, unsigned lds0, int wid, int lane) {
    constexpr int KS = NKC * 1024, VS = NVB * 4096, LDS_K = 0, LDS_V = RD * KS;
#pragma unroll
    for (int c = 0; c < (NKC + 7) / 8; ++c) { const int ch = wid + 8 * c; if (ch < NKC) {
        const bf16_t* src = (ch < 8) ? S.k0 + (size_t)(t * 64 + lane) * S.k0pitch + ch * 8 : S.k1 + (size_t)(t * 64 + lane) * S.k1pitch + (ch - 8) * 8;
        glds16(src, (unsigned)__builtin_amdgcn_readfirstlane(lds0 + LDS_K + slot * KS + ch * 1024)); } }
#pragma unroll
    for (int c = 0; c < (NVB * 4 + 7) / 8; ++c) { const int p = wid + 8 * c; if (p < NVB * 4) {
        const bf16_t* src = S.v + (size_t)(t * 64 + 16 * (p & 3) + (lane >> 2)) * S.vpitch + (p >> 2) * 32 + (lane & 3) * 8;
        glds16(src, (unsigned)__builtin_amdgcn_readfirstlane(lds0 + LDS_V + slot * VS + p * 1024)); } }
}
__device__ __forceinline__ void wait_vm_bar(int n) {
    if (n >= 4) asm volatile("s_waitcnt vmcnt(4) lgkmcnt(0)\n\ts_barrier" ::: "memory");
    else if (n == 3) asm volatile("s_waitcnt vmcnt(3) lgkmcnt(0)\n\ts_barrier" ::: "memory");
    else if (n == 2) asm volatile("s_waitcnt vmcnt(2) lgkmcnt(0)\n\ts_barrier" ::: "memory");
    else if (n == 1) asm volatile("s_waitcnt vmcnt(1) lgkmcnt(0)\n\ts_barrier" ::: "memory");
    else asm volatile("s_waitcnt vmcnt(0) lgkmcnt(0)\n\ts_barrier" ::: "memory");
}
template <int NKC, int NVB, int MODE>
__device__ __forceinline__ void unit(LAS unsigned char* lds, const Src& S, int t_lo, int t_hi, int qpos0  , float sink_l2) {
    constexpr int KS = NKC * 1024, VS = NVB * 4096, RD = 4, LDS_K = 0, LDS_V = RD * KS;
    const int tid = opq_v((int)threadIdx.x), lane = tid & 63, r32 = lane & 31, hi = lane >> 5; const int wid = __builtin_amdgcn_readfirstlane(tid >> 6), grp = wid >> 2;
    const unsigned lds0 = (unsigned)(uintptr_t)lds;
    const int ops = (NKC + 7 - wid) / 8 + (NVB * 4) / 8;
    bf16x8 qr[NKC / 2];
#pragma unroll
    for (int d0 = 0; d0 < NKC / 2; ++d0) qr[d0] = *(const bf16x8*)(S.q + (size_t)r32 * S.qpitch + d0 * 16 + hi * 8);
    float m_run = (MODE == 0) ? sink_l2 : -INFINITY, l_run = (MODE == 0 && hi == 0) ? 1.0f : 0.0f;
    f32x16 o[NVB];
#pragma unroll
    for (int d = 0; d < NVB; ++d) o[d] = f32x16{};
    const int qi = qpos0 + wid * 32 + r32, qw0 = qpos0 + wid * 32;
    f32x16 p0 = f32x16{}, p1 = f32x16{};
#define AT_ACTIVE(t) ((MODE != 0) || ((64 * (t) + 63 >= qw0 - 128) && (64 * (t) <= qw0 + 31 + 128)))
#define AT_QK(t) do { const LAS unsigned char* kb_ = lds + LDS_K + (((t) - t_lo) % RD) * KS + hi * 1024 + r32 * 16; p0 = f32x16{}; p1 = f32x16{}; \
        _Pragma("unroll") for (int d0 = 0; d0 < NKC / 2; ++d0) { const bf16x8 b0_ = *(const LAS bf16x8*)(kb_ + d0 * 2048), b1_ = *(const LAS bf16x8*)(kb_ + d0 * 2048 + 512); \
            p0 = __builtin_amdgcn_mfma_f32_32x32x16_bf16(b0_, qr[d0], p0, 0, 0, 0); p1 = __builtin_amdgcn_mfma_f32_32x32x16_bf16(b1_, qr[d0], p1, 0, 0, 0); } } while (0)
#define AT_SMPV(t) do { \
        if (MODE == 0) { _Pragma("unroll") for (int r = 0; r < 16; ++r) { const int kv_ = 64 * (t) + crow(r, hi); int e0_ = kv_ - qi; e0_ = e0_ < 0 ? -e0_ : e0_; int e1_ = kv_ + 32 - qi; e1_ = e1_ < 0 ? -e1_ : e1_; \
            if (e0_ > 128) p0[r] = -INFINITY; if (e1_ > 128) p1[r] = -INFINITY; } } \
        float mx_[8]; _Pragma("unroll") for (int r = 0; r < 8; ++r) mx_[r] = fmaxf(fmaxf(p0[r], p0[r + 8]), fmaxf(p1[r], p1[r + 8])); \
        float rm_ = fmaxf(fmaxf(fmaxf(mx_[0], mx_[1]), fmaxf(mx_[2], mx_[3])), fmaxf(fmaxf(mx_[4], mx_[5]), fmaxf(mx_[6], mx_[7]))); rm_ = swapmax(rm_); \
        if (__any(rm_ > m_run)) { const float mn_ = fmaxf(m_run, rm_), alpha_ = __builtin_amdgcn_exp2f(m_run - mn_); m_run = mn_; l_run *= alpha_; \
            _Pragma("unroll") for (int d = 0; d < NVB; ++d) _Pragma("unroll") for (int r = 0; r < 16; ++r) o[d][r] *= alpha_; } \
        float sm_[4] = {0.f, 0.f, 0.f, 0.f}; \
        _Pragma("unroll") for (int r = 0; r < 16; ++r) { p0[r] = __builtin_amdgcn_exp2f(p0[r] - m_run); p1[r] = __builtin_amdgcn_exp2f(p1[r] - m_run); sm_[r & 3] += p0[r] + p1[r]; } \
        l_run += (sm_[0] + sm_[1]) + (sm_[2] + sm_[3]); \
        u32x4 pw_[4]; \
        pw_[0] = (u32x4){cvtpk(p0[0], p0[1]), cvtpk(p0[2], p0[3]), cvtpk(p0[4], p0[5]), cvtpk(p0[6], p0[7])}; pw_[1] = (u32x4){cvtpk(p0[8], p0[9]), cvtpk(p0[10], p0[11]), cvtpk(p0[12], p0[13]), cvtpk(p0[14], p0[15])}; \
        pw_[2] = (u32x4){cvtpk(p1[0], p1[1]), cvtpk(p1[2], p1[3]), cvtpk(p1[4], p1[5]), cvtpk(p1[6], p1[7])}; pw_[3] = (u32x4){cvtpk(p1[8], p1[9]), cvtpk(p1[10], p1[11]), cvtpk(p1[12], p1[13]), cvtpk(p1[14], p1[15])}; \
        const unsigned vb_ = lds0 + LDS_V + (((t) - t_lo) % RD) * VS + ((lane >> 4) & 1) * 32 + (lane & 3) * 8 + (4 * hi + ((lane & 15) >> 2)) * 64; \
        _Pragma("unroll") for (int dp = 0; dp < NVB; dp += 2) { s16x4 lo_[2][4], hh_[2][4]; \
            _Pragma("unroll") for (int dd = 0; dd < 2; ++dd) _Pragma("unroll") for (int ks = 0; ks < 4; ++ks) { lo_[dd][ks] = vtr(vb_ + (dp + dd) * 4096 + ks * 1024); hh_[dd][ks] = vtr(vb_ + (dp + dd) * 4096 + ks * 1024 + 512); } \
            asm volatile("s_waitcnt lgkmcnt(0)" ::: "memory"); __builtin_amdgcn_sched_barrier(0); \
            _Pragma("unroll") for (int ks = 0; ks < 4; ++ks) _Pragma("unroll") for (int dd = 0; dd < 2; ++dd) { \
                const bf16x8 vf_ = (bf16x8){lo_[dd][ks][0], lo_[dd][ks][1], lo_[dd][ks][2], lo_[dd][ks][3], hh_[dd][ks][0], hh_[dd][ks][1], hh_[dd][ks][2], hh_[dd][ks][3]}; \
                o[dp + dd] = __builtin_amdgcn_mfma_f32_32x32x16_bf16(vf_, __builtin_bit_cast(bf16x8, pw_[ks]), o[dp + dd], 0, 0, 0); } } } while (0)
    dma_tile<NKC, NVB>(S, t_lo, 0, lds0, wid, lane);
    if (t_lo + 1 < t_hi) dma_tile<NKC, NVB>(S, t_lo + 1, 1, lds0, wid, lane);
    for (int t = t_lo; t < t_hi; ++t) {
        wait_vm_bar((t + 1 < t_hi) ? ops : 0);
        if (t + 2 < t_hi) dma_tile<NKC, NVB>(S, t + 2, (t + 2 - t_lo) % RD, lds0, wid, lane);
        if (grp == 0) { if (AT_ACTIVE(t)) { AT_QK(t); AT_SMPV(t); } }
        else { if (t > t_lo && AT_ACTIVE(t - 1)) AT_SMPV(t - 1); if (AT_ACTIVE(t)) AT_QK(t); }
    }
    if (grp == 1 && AT_ACTIVE(t_hi - 1)) AT_SMPV(t_hi - 1);
    const float linv = 1.0f / swapsum(l_run);
#pragma unroll
    for (int d = 0; d < NVB; ++d)
#pragma unroll
        for (int r4 = 0; r4 < 4; ++r4) { f32x4 v = {o[d][4 * r4] * linv, o[d][4 * r4 + 1] * linv, o[d][4 * r4 + 2] * linv, o[d][4 * r4 + 3] * linv};
            *(u32x2*)(S.o + (size_t)r32 * S.opitch + 32 * d + 8 * r4 + 4 * hi) = pack4(v); }
    asm volatile("s_waitcnt lgkmcnt(0)\n\ts_barrier" ::: "memory");
#undef AT_ACTIVE
#undef AT_QK
#undef AT_SMPV
}

template <int NKC, int NVB>
__device__ __forceinline__ void unit_q64(LAS unsigned char* lds, const Src& S, int t_lo, int t_hi) {
    constexpr int KS = NKC * 1024, VS = NVB * 4096, RD = 4, LDS_K = 0, LDS_V = RD * KS;
    const int tid = opq_v((int)threadIdx.x), lane = tid & 63, r32 = lane & 31, hi = lane >> 5; const int wid = __builtin_amdgcn_readfirstlane(tid >> 6);
    const unsigned lds0 = (unsigned)(uintptr_t)lds;
    const int ops = (NKC + 7 - wid) / 8 + (NVB * 4) / 8;
    bf16x8 qa[NKC / 2], qb[NKC / 2];
#pragma unroll
    for (int d0 = 0; d0 < NKC / 2; ++d0) { qa[d0] = *(const bf16x8*)(S.q + (size_t)r32 * S.qpitch + d0 * 16 + hi * 8); qb[d0] = *(const bf16x8*)(S.q + (size_t)(32 + r32) * S.qpitch + d0 * 16 + hi * 8); }
    float ma = -INFINITY, la = 0.f, mb = -INFINITY, lb = 0.f;
    f32x16 oa[NVB], ob[NVB];
#pragma unroll
    for (int d = 0; d < NVB; ++d) { oa[d] = f32x16{}; ob[d] = f32x16{}; }
#define Q64_SM(P0, P1, M, L, O, PW) do { \
        float mx_[8]; _Pragma("unroll") for (int r = 0; r < 8; ++r) mx_[r] = fmaxf(fmaxf(P0[r], P0[r + 8]), fmaxf(P1[r], P1[r + 8])); \
        float rm_ = fmaxf(fmaxf(fmaxf(mx_[0], mx_[1]), fmaxf(mx_[2], mx_[3])), fmaxf(fmaxf(mx_[4], mx_[5]), fmaxf(mx_[6], mx_[7]))); rm_ = swapmax(rm_); \
        if (__any(rm_ > M)) { const float mn_ = fmaxf(M, rm_), alpha_ = __builtin_amdgcn_exp2f(M - mn_); M = mn_; L *= alpha_; \
            _Pragma("unroll") for (int d = 0; d < NVB; ++d) _Pragma("unroll") for (int r = 0; r < 16; ++r) O[d][r] *= alpha_; } \
        float sm_[4] = {0.f, 0.f, 0.f, 0.f}; \
        _Pragma("unroll") for (int r = 0; r < 16; ++r) { P0[r] = __builtin_amdgcn_exp2f(P0[r] - M); P1[r] = __builtin_amdgcn_exp2f(P1[r] - M); sm_[r & 3] += P0[r] + P1[r]; } \
        L += (sm_[0] + sm_[1]) + (sm_[2] + sm_[3]); \
        PW[0] = (u32x4){cvtpk(P0[0], P0[1]), cvtpk(P0[2], P0[3]), cvtpk(P0[4], P0[5]), cvtpk(P0[6], P0[7])}; PW[1] = (u32x4){cvtpk(P0[8], P0[9]), cvtpk(P0[10], P0[11]), cvtpk(P0[12], P0[13]), cvtpk(P0[14], P0[15])}; \
        PW[2] = (u32x4){cvtpk(P1[0], P1[1]), cvtpk(P1[2], P1[3]), cvtpk(P1[4], P1[5]), cvtpk(P1[6], P1[7])}; PW[3] = (u32x4){cvtpk(P1[8], P1[9]), cvtpk(P1[10], P1[11]), cvtpk(P1[12], P1[13]), cvtpk(P1[14], P1[15])}; \
        __builtin_amdgcn_sched_barrier(0); } while (0)
#define Q64_SM_NB(P0, P1, M, L, O, PW) do { \
        float mx_[8]; _Pragma("unroll") for (int r = 0; r < 8; ++r) mx_[r] = fmaxf(fmaxf(P0[r], P0[r + 8]), fmaxf(P1[r], P1[r + 8])); \
        float rm_ = fmaxf(fmaxf(fmaxf(mx_[0], mx_[1]), fmaxf(mx_[2], mx_[3])), fmaxf(fmaxf(mx_[4], mx_[5]), fmaxf(mx_[6], mx_[7]))); rm_ = swapmax(rm_); \
        if (__any(rm_ > M)) { const float mn_ = fmaxf(M, rm_), alpha_ = __builtin_amdgcn_exp2f(M - mn_); M = mn_; L *= alpha_; \
            _Pragma("unroll") for (int d = 0; d < NVB; ++d) _Pragma("unroll") for (int r = 0; r < 16; ++r) O[d][r] *= alpha_; } \
        float sm_[4] = {0.f, 0.f, 0.f, 0.f}; \
        _Pragma("unroll") for (int r = 0; r < 16; ++r) { P0[r] = __builtin_amdgcn_exp2f(P0[r] - M); P1[r] = __builtin_amdgcn_exp2f(P1[r] - M); sm_[r & 3] += P0[r] + P1[r]; } \
        L += (sm_[0] + sm_[1]) + (sm_[2] + sm_[3]); \
        PW[0] = (u32x4){cvtpk(P0[0], P0[1]), cvtpk(P0[2], P0[3]), cvtpk(P0[4], P0[5]), cvtpk(P0[6], P0[7])}; PW[1] = (u32x4){cvtpk(P0[8], P0[9]), cvtpk(P0[10], P0[11]), cvtpk(P0[12], P0[13]), cvtpk(P0[14], P0[15])}; \
        PW[2] = (u32x4){cvtpk(P1[0], P1[1]), cvtpk(P1[2], P1[3]), cvtpk(P1[4], P1[5]), cvtpk(P1[6], P1[7])}; PW[3] = (u32x4){cvtpk(P1[8], P1[9]), cvtpk(P1[10], P1[11]), cvtpk(P1[12], P1[13]), cvtpk(P1[14], P1[15])}; \
        } while (0)
    dma_tile<NKC, NVB, RD>(S, t_lo, 0, lds0, wid, lane);
    if (t_lo + 1 < t_hi) dma_tile<NKC, NVB, RD>(S, t_lo + 1, 1, lds0, wid, lane);
    for (int t = t_lo; t < t_hi; ++t) {
        const int slot = (t - t_lo) % RD;
        wait_vm_bar((t + 1 < t_hi) ? ops : 0);
        if (t + 2 < t_hi) dma_tile<NKC, NVB, RD>(S, t + 2, (t + 2 - t_lo) % RD, lds0, wid, lane);
        const LAS unsigned char* kb = lds + LDS_K + slot * KS + hi * 1024 + r32 * 16;
        f32x16 s0a = f32x16{}, s0b = f32x16{}, s1a = f32x16{}, s1b = f32x16{};
#pragma unroll
        for (int d0 = 0; d0 < NKC / 2; ++d0) {
            const bf16x8 b0 = *(const LAS bf16x8*)(kb + d0 * 2048), b1 = *(const LAS bf16x8*)(kb + d0 * 2048 + 512);
            s0a = __builtin_amdgcn_mfma_f32_32x32x16_bf16(b0, qa[d0], s0a, 0, 0, 0); s0b = __builtin_amdgcn_mfma_f32_32x32x16_bf16(b1, qa[d0], s0b, 0, 0, 0);
            s1a = __builtin_amdgcn_mfma_f32_32x32x16_bf16(b0, qb[d0], s1a, 0, 0, 0); s1b = __builtin_amdgcn_mfma_f32_32x32x16_bf16(b1, qb[d0], s1b, 0, 0, 0); }
        __builtin_amdgcn_sched_barrier(0);
        u32x4 pwa[4], pwb[4];
        const unsigned vb = lds0 + LDS_V + slot * VS + ((lane >> 4) & 1) * 32 + (lane & 3) * 8 + (4 * hi + ((lane & 15) >> 2)) * 64;
        s16x4 lo[NVB][4], hh[NVB][4];
#pragma unroll
        for (int d = 0; d < NVB; ++d)
#pragma unroll
            for (int ks = 0; ks < 4; ++ks) { VTRO(lo[d][ks], vb, d * 4096 + ks * 1024); VTRO(hh[d][ks], vb, d * 4096 + ks * 1024 + 512); }
        __builtin_amdgcn_sched_barrier(0);
        Q64_SM(s0a, s0b, ma, la, oa, pwa);
        asm volatile("s_waitcnt lgkmcnt(0)" ::: "memory"); __builtin_amdgcn_sched_barrier(0);
#pragma unroll
        for (int ks = 0; ks < 4; ++ks)
#pragma unroll
            for (int d = 0; d < NVB; ++d) { const bf16x8 vf = (bf16x8){lo[d][ks][0], lo[d][ks][1], lo[d][ks][2], lo[d][ks][3], hh[d][ks][0], hh[d][ks][1], hh[d][ks][2], hh[d][ks][3]};
                oa[d] = __builtin_amdgcn_mfma_f32_32x32x16_bf16(vf, __builtin_bit_cast(bf16x8, pwa[ks]), oa[d], 0, 0, 0); }
        Q64_SM_NB(s1a, s1b, mb, lb, ob, pwb);
#pragma unroll
        for (int i = 0; i < 8; ++i) { __builtin_amdgcn_sched_group_barrier(0x008, 1, 0); __builtin_amdgcn_sched_group_barrier(0x002, 12, 0); }
        __builtin_amdgcn_sched_barrier(0);
#pragma unroll
        for (int ks = 0; ks < 4; ++ks)
#pragma unroll
            for (int d = 0; d < NVB; ++d) { const bf16x8 vf = (bf16x8){lo[d][ks][0], lo[d][ks][1], lo[d][ks][2], lo[d][ks][3], hh[d][ks][0], hh[d][ks][1], hh[d][ks][2], hh[d][ks][3]};
                ob[d] = __builtin_amdgcn_mfma_f32_32x32x16_bf16(vf, __builtin_bit_cast(bf16x8, pwb[ks]), ob[d], 0, 0, 0); }
        __builtin_amdgcn_sched_barrier(0);
    }
    const float lia = 1.0f / swapsum(la), lib = 1.0f / swapsum(lb);
#pragma unroll
    for (int d = 0; d < NVB; ++d)
#pragma unroll
        for (int r4 = 0; r4 < 4; ++r4) {
            f32x4 va = {oa[d][4 * r4] * lia, oa[d][4 * r4 + 1] * lia, oa[d][4 * r4 + 2] * lia, oa[d][4 * r4 + 3] * lia}, vb4 = {ob[d][4 * r4] * lib, ob[d][4 * r4 + 1] * lib, ob[d][4 * r4 + 2] * lib, ob[d][4 * r4 + 3] * lib};
            *(u32x2*)(S.o + (size_t)r32 * S.opitch + 32 * d + 8 * r4 + 4 * hi) = pack4(va); *(u32x2*)(S.o + (size_t)(32 + r32) * S.opitch + 32 * d + 8 * r4 + 4 * hi) = pack4(vb4); }
    asm volatile("s_waitcnt lgkmcnt(0)\n\ts_barrier" ::: "memory");
#undef Q64_SM
#undef Q64_SM_NB
}

}
#define SC_AFTER_PROLOGUE() do {} while (0)
#define SC_AFTER_INPROJ(l) do {} while (0)
#define SC_AFTER_UP(l) do {} while (0)
#define SC_AFTER_MLA(l) do {} while (0)
#define SC_AFTER_BRANCH(l) do {} while (0)
#define SC_AFTER_WOUT(l) do {} while (0)
#define SC_AFTER_NORM2(l) do {} while (0)
#define SC_AFTER_GU(l) do {} while (0)
#define SC_AFTER_DOWN(l) do {} while (0)
#define SC_AFTER_ROUTE(l) do {} while (0)
#define SC_AFTER_MOEGU(l, h) do {} while (0)
#define SC_AFTER_MOED(l, h) do {} while (0)
#define SC_FINAL() do {} while (0)

struct Args { const float* in[23]; float* out; unsigned char* ws; };
#define WSP(type, off) ((type*)(F.ws + (off)))
#define PHASE() Frame Fp = F; Fp.ws = opq_p(F.ws); Fp.in = opq_p(F.in); Fp.out = opq_p(F.out); Fp.tid = opq_v((int)threadIdx.x); Fp.lane = Fp.tid & 63; Fp.wave = __builtin_amdgcn_readfirstlane(Fp.tid >> 6); (void)Fp
#define FWS(type, off) ((type*)(Fp.ws + (off)))
#define X_ FWS(bf16_t, WS_XB)
#define H_ FWS(bf16_t, WS_H)
#define Pb_ FWS(bf16_t, WS_R + R_P)
#define Gb_ FWS(bf16_t, WS_R + R_G)
#define QB_ FWS(bf16_t, WS_R + R_QB)
#define KVB_ FWS(bf16_t, WS_R + R_KVB)
#define Yb_ FWS(bf16_t, WS_R + R_Y)
#define MEMN_ FWS(bf16_t, WS_MEMN)
#define MEMKV_ FWS(bf16_t, WS_MEMKV)
#define ACT_ FWS(bf16_t, WS_R + R_ACT)
#define ASORT_ FWS(bf16_t, WS_R + R_ASORT)
#define YOUT_ FWS(bf16_t, WS_R + R_YOUT)
#define SSQ_ FWS(float, WS_MISC + MS_SSQ)
#define TEXP_ FWS(const int, WS_MISC + MS_TEXP)
#define POS_ ((const int*)Fp.in[I_POS])
#define HSC_ FWS(float, WS_MISC + MS_HSC)
#define ASC_ FWS(float, WS_MISC + MS_ASC)
#define WSIN_ FWS(float, WS_MISC + MS_WSIN)
#define WSGU_ FWS(float, WS_MISC + MS_WSGU)

#define GRID_BAR() xcd_barrier(bar)
#ifndef WGM_GU
#define WGM_GU 4
#endif
#ifndef WGM_IN
#define WGM_IN 4
#endif
template <int l> __device__ __forceinline__ void layer_body(const Frame& F, const XcdBarrier& bar, const int bx) {
        if (l > 0) {
            PHASE();
            prep_ffn_weights(Fp, l);
            if ((l & 1) != 0) norm_phase(Fp, nullptr, X_, Fp.in[I_GMIX] + l * DM, false, true);
            if ((l & 1) == 0) norm_phase(Fp, nullptr, X_, Fp.in[I_GMIX] + l * DM, true, true);
            GRID_BAR();
        }
        {   PHASE();
            ProbSimple p{DM, DM, DM, (const char*)H_, (const char*)wmix(Fp, l, WL_IN)}; pg8::StaticOrder S; S.init(T / 256, NT_IN, Fp.G, bx, 0, WGM_IN);
            EpiInproj E{Pb_, Gb_, SSQ_, POS_, HSC_, WSIN_ + l * NT_IN * 256}; pg8::gemm_phase<true>(Fp.lds, p, S, E); }
        if (l == 0) { PHASE();
            ProbSimple p{DM, DM * 2, DM * 2, (const char*)MEMN_, (const char*)FWS(bf16_t, WS_WMKV)}; pg8::StaticOrder S; S.init(NB * MEML / 256, 16, Fp.G, bx);
            EpiPlain E{MEMKV_, 4096}; pg8::gemm_phase(Fp.lds, p, S, E); }
        GRID_BAR();
        SC_AFTER_INPROJ(l);
        {   PHASE();
            ProbUp p{UPK, PW * 2, UPK * 2, (const char*)(Pb_ + P_CQ), (const char*)wmix(Fp, l, WL_UP)}; pg8::StaticOrder S; S.init(T / 256, UPN / 256, Fp.G, bx);
            EpiUp E{QB_, KVB_, SSQ_, POS_}; pg8::gemm_phase(Fp.lds, p, S, E); }
        {   PHASE();
            for (int i = Fp.vcu; i < 1024; i += Fp.G) {
                const int hl = i & 3, qb = (i >> 2) & 15, kvh = (i >> 6) & 1, b = i >> 7, h = kvh * 4 + hl; const size_t rowb = (size_t)b * SEQ; const int q0 = qb * 256;
                att::Src s; s.q = Pb_ + (rowb + q0 + Fp.wave * 32) * PW + P_QA + h * 64; s.qpitch = PW; s.k0 = Pb_ + rowb * PW + P_KA + kvh * 64; s.k0pitch = PW; s.k1 = s.k0; s.k1pitch = PW;
                s.v = Pb_ + rowb * PW + P_VA + kvh * 64; s.vpitch = PW; s.o = Yb_ + (rowb + q0 + Fp.wave * 32) * YW + h * 64; s.opitch = YW;
                const int t_lo = (q0 / 64 - 2) < 0 ? 0 : (q0 / 64 - 2), t_hi = (q0 / 64 + 6) > SEQ / 64 ? SEQ / 64 : (q0 / 64 + 6);
                att::unit<8, 2, 0>(Fp.lds, s, t_lo, t_hi, q0, Fp.in[I_SINK][l * 8 + h] * LOG2E);
            } }
        {   PHASE();
            for (int i = Fp.vcu; i < 512; i += Fp.G) {
                const int qb = i & 15, h = (i >> 4) & 3, b = i >> 6; const size_t rowq = (size_t)b * SEQ + qb * 256 + Fp.wave * 32;
                att::Src s; s.q = Pb_ + rowq * PW + P_QM + h * 128; s.qpitch = PW; s.k0 = MEMKV_ + (size_t)b * MEML * 4096 + l * 1024 + h * 128; s.k0pitch = 4096; s.k1 = s.k0 + 64; s.k1pitch = 4096;
                s.v = MEMKV_ + (size_t)b * MEML * 4096 + l * 1024 + 512 + h * 128; s.vpitch = 4096; s.o = Yb_ + rowq * YW + 1024 + h * 128; s.opitch = YW;
                att::unit<16, 4, 1>(Fp.lds, s, 0, MEML / 64, 0, 0.f);
            } }
        GRID_BAR();
        SC_AFTER_UP(l);
        {   PHASE();
            for (int i = Fp.vcu; i < 512; i += Fp.G) {
                const int qb = i & 7, h = (i >> 3) & 7, b = i >> 6; const size_t rowb = (size_t)b * SEQ, rowq = rowb + qb * 512 + Fp.wave * 64;
                att::Src s; s.q = QB_ + rowq * QBW + h * 96; s.qpitch = QBW; s.k0 = KVB_ + rowb * KVW + h * 128; s.k0pitch = KVW; s.k1 = Pb_ + rowb * PW + P_KR; s.k1pitch = PW;
                s.v = KVB_ + rowb * KVW + h * 128 + 64; s.vpitch = KVW; s.o = Yb_ + rowq * YW + 512 + h * 64; s.opitch = YW;
                att::unit_q64<12, 2>(Fp.lds, s, 0, SEQ / 64);
            } }
        GRID_BAR();
        SC_AFTER_MLA(l);
        {   PHASE();
            ProbSimple p{1536, YW * 2, 1536 * 2, (const char*)Yb_, (const char*)wmix(Fp, l, WL_BR)}; pg8::StaticOrder S; S.init(T / 256, DM / 256, Fp.G, bx);
            EpiBranch E{(const unsigned char*)Gb_, H_}; pg8::gemm_phase(Fp.lds, p, S, E); }
        GRID_BAR();
        SC_AFTER_BRANCH(l);
        if (l == 0) {   PHASE();
            ProbSimple p{DM, DM * 2, DM * 2, (const char*)H_, (const char*)wmix(Fp, l, WL_OUT)}; pg8::StaticOrder S; S.init(T / 256, DM / 256, Fp.G, bx);
            EpiResid E{Fp.in[I_X], X_}; pg8::gemm_phase(Fp.lds, p, S, E); }
        if (l != 0) {   PHASE();
            ProbSimple p{DM, DM * 2, DM * 2, (const char*)H_, (const char*)wmix(Fp, l, WL_OUT)}; pg8::StaticOrder S; S.init(T / 256, DM / 256, Fp.G, bx);
            EpiResid E{nullptr, X_}; pg8::gemm_phase(Fp.lds, p, S, E); }
        GRID_BAR();
        SC_AFTER_WOUT(l);
        if ((l & 1) == 0) {
            {   PHASE(); norm_phase(Fp, nullptr, X_, Fp.in[I_GFFN] + l * DM, false, GU_I8(l) != 0); }
            GRID_BAR();
            SC_AFTER_NORM2(l);
            {   PHASE();
                constexpr bool i8 = GU_I8(l) != 0; constexpr unsigned eb = i8 ? 1 : 2;
                ProbSimple p{DM, DM * eb, DM * eb, (const char*)H_, (const char*)FWS(bf16_t, WS_WFFN + WF_GU)}; pg8::StaticOrder S; S.init(T / 256, 2 * DFF / 256, Fp.G, bx, 0, WGM_GU);
                EpiSwiglu E{ACT_, 0, HSC_, WSGU_}; pg8::gemm_phase<i8>(Fp.lds, p, S, E); }
            GRID_BAR();
            SC_AFTER_GU(l);
            {   PHASE();
                ProbSimple p{DFF, DFF * 2, DFF * 2, (const char*)ACT_, (const char*)FWS(bf16_t, WS_WFFN + WF_D)}; pg8::StaticOrder S; S.init(T / 256, DM / 256, Fp.G, bx, 1);
                EpiResid E{nullptr, X_}; pg8::gemm_phase(Fp.lds, p, S, E); }
            GRID_BAR();
            SC_AFTER_DOWN(l);
        } else {
            {   PHASE(); norm_router_phase(Fp, X_, Fp.in[I_GFFN] + l * DM, Fp.in[I_WR] + (size_t)(l >> 1) * DM * NE, GU_I8(l) != 0); }
            GRID_BAR();
            {   PHASE(); moe_assign_phase(Fp, GU_I8(l) != 0); }
            GRID_BAR();
            SC_AFTER_ROUTE(l);
            {   constexpr int half = 0; (void)half;
                {   PHASE();
                    const int nrt = __builtin_amdgcn_readfirstlane(TEXP_[MAXRT]);
                    constexpr bool i8 = GU_I8(l) != 0; constexpr unsigned eb = i8 ? 1 : 2;
                    ProbMoe p{DM, DM * eb, DM * eb, (const char*)ASORT_, (const char*)FWS(bf16_t, WS_WFFN + WF_GU), 0}; MoeOrder S; S.base.init(nrt, 2 * DFF / 256, Fp.G, bx, 0, WGM_GU); S.lo = 0; S.texp = TEXP_;
                    EpiSwiglu E{ACT_, 0, ASC_, WSGU_}; pg8::gemm_phase<i8>(Fp.lds, p, S, E); }
                GRID_BAR();
                SC_AFTER_MOEGU(l, half);
                {   PHASE();
                    const int nrt = __builtin_amdgcn_readfirstlane(TEXP_[MAXRT]);
                    ProbMoe p{DFF, DFF * 2, DFF * 2, (const char*)ACT_, (const char*)FWS(bf16_t, WS_WFFN + WF_D), 0}; MoeOrder S; S.base.init(nrt, DM / 256, Fp.G, bx, 1); S.lo = 0; S.texp = TEXP_;
                    EpiYout E{YOUT_}; pg8::gemm_phase(Fp.lds, p, S, E); }
                GRID_BAR();
                SC_AFTER_MOED(l, half);
            }
        }
    }

__global__ void __launch_bounds__(NWAVES * 64, 2) fwd(Args args) {
    extern __shared__ __attribute__((aligned(16))) unsigned char lds_raw[];
    Frame F;
    F.lds = (LAS unsigned char*)lds_raw;
    F.MISC = (volatile LAS unsigned*)(F.lds + LDSCTL_OFF);
    F.tid = threadIdx.x; F.lane = F.tid & 63; F.wave = __builtin_amdgcn_readfirstlane(F.tid >> 6);
    F.G = gridDim.x; { const int bx = blockIdx.x; F.vcu = (F.G % 8 == 0) ? (bx % 8) * (F.G / 8) + bx / 8 : bx; }
    F.ws = args.ws; F.ctl = (gu32*)(args.ws + WS_CTL); F.out = args.out;
    F.in = (const float* const*)__builtin_amdgcn_kernarg_segment_ptr();
    for (int u = F.tid; u < (LDS_BYTES - LDSCTL_OFF) / 4; u += NWAVES * 64) ((LAS unsigned*)(F.lds + LDSCTL_OFF))[u] = 0u;
    __syncthreads();
    XcdBarrier bar = xcd_barrier_post((unsigned*)(F.ctl + CW_BAR), F.MISC + 8);

    const int bx = (int)blockIdx.x;

    {   PHASE();
        prep_mixer_weights(Fp);
        memnorm_phase(Fp);
        prep_ffn_weights(Fp, 0);
        norm_phase(Fp, Fp.in[I_X], nullptr, Fp.in[I_GMIX], false, true); }
    GRID_BAR();
    SC_AFTER_PROLOGUE();

    layer_body<0>(F, bar, bx); layer_body<1>(F, bar, bx); layer_body<2>(F, bar, bx); layer_body<3>(F, bar, bx);
    {   PHASE(); final_norm_phase(Fp, X_, Fp.out, Fp.in[I_GFIN], true); }
    SC_FINAL();
}

extern "C" void kernel_launch(void* const* d_in, const int* in_sizes, int n_in, void* d_out, int out_size, void* d_ws, size_t ws_size, hipStream_t stream) {
    static int grid = 0;
    if (grid == 0) {
        if (n_in != 23 || out_size != T * DM || ws_size < WS_END) { fprintf(stderr, "kernel_launch: unexpected problem (n_in %d, out %d, ws %zu < %zu)\n", n_in, out_size, ws_size, (size_t)WS_END); grid = -1; return; }
        int dev = 0, cus = 0;
        if (hipGetDevice(&dev) != hipSuccess || hipDeviceGetAttribute(&cus, hipDeviceAttributeMultiprocessorCount, dev) != hipSuccess) { grid = -1; return; }
        if (hipFuncSetAttribute((const void*)fwd, hipFuncAttributeMaxDynamicSharedMemorySize, LDS_BYTES) != hipSuccess) { fprintf(stderr, "kernel_launch: hipFuncSetAttribute failed\n"); grid = -1; return; }
        int per_cu = 0;
        if (hipOccupancyMaxActiveBlocksPerMultiprocessor(&per_cu, (const void*)fwd, NWAVES * 64, LDS_BYTES) != hipSuccess || per_cu < 1) fprintf(stderr, "kernel_launch: occupancy query says %d\n", per_cu);
        (void)hipGetLastError();
        grid = cus;
    }
    if (grid < 0) return;
    if (hipMemsetAsync((char*)d_ws + WS_CTL, 0, CTL_ZERO_BYTES, stream) != hipSuccess) return;
    Args a{};
    for (int i = 0; i < 23; ++i) a.in[i] = (const float*)d_in[i];
    a.out = (float*)d_out; a.ws = (unsigned char*)d_ws;
    hipLaunchKernelGGL(fwd, dim3(grid), dim3(NWAVES * 64), LDS_BYTES, stream, a);
}
```

```cpp
#include <hip/hip_runtime.h>
#include <cstdio>
#include <cstdint>

#ifndef SELFCHECK
#define SELFCHECK 0
#endif
#ifndef GU_I8_MASK
#define GU_I8_MASK 0xF
#endif
#define GU_I8(l) ((((unsigned)GU_I8_MASK) >> (l)) & 1u)

#define GAS __attribute__((address_space(1)))
#define LAS __attribute__((address_space(3)))
typedef unsigned short bf16_t;
typedef short bf16x8 __attribute__((ext_vector_type(8)));
typedef short s16x4 __attribute__((ext_vector_type(4)));
typedef short v4i16_t __attribute__((ext_vector_type(4)));
typedef float f32x2 __attribute__((ext_vector_type(2)));
typedef float f32x4 __attribute__((ext_vector_type(4)));
typedef float f32x16 __attribute__((ext_vector_type(16)));
typedef unsigned u32x2 __attribute__((ext_vector_type(2)));
typedef unsigned u32x4 __attribute__((ext_vector_type(4)));
typedef int i32x4 __attribute__((ext_vector_type(4)));
typedef GAS unsigned gu32;
#define RLX_AGENT __ATOMIC_RELAXED, __HIP_MEMORY_SCOPE_AGENT

constexpr int NB = 8, SEQ = 4096, T = NB * SEQ, DM = 1024, DEPTH = 4, MEML = 256, DFF = 3584, NE = 8;
constexpr int INW = 4768;
constexpr int PW = 1792;
constexpr int GW = 3072;
constexpr int QBW = 768, KVW = 1024, YW = 1536;
constexpr int NT_IN = 19;
constexpr int P_QA = 0, P_KA = 512, P_VA = 640, P_CQ = 768, P_CKV = 1024, P_KR = 1152, P_QM = 1280;
constexpr int UPK = 256, UPN = 1792;
constexpr int MAXSLOT = 67584;
constexpr int MAXRT = MAXSLOT / 256;
constexpr float EPS = 1e-6f;
constexpr float LOG2E = 1.4426950408889634f;
constexpr float C_A = 0.125f * LOG2E;
constexpr float C_B = 0.10206207261596575f * LOG2E;
constexpr float C_M = 0.08838834764831845f * LOG2E;

constexpr size_t MiB = 1u << 20;
constexpr size_t WS_CTL = 0, CTL_ZERO_BYTES = 1 * MiB;
constexpr size_t WS_MISC = 1 * MiB;
constexpr size_t WL_IN = 0, WL_UP = (size_t)NT_IN * 256 * DM * 2, WL_BR = WL_UP + (size_t)UPN * UPK * 2, WL_OUT = WL_BR + (size_t)3 * DM * 512 * 2, WL_SIZE = WL_OUT + (size_t)DM * DM * 2;
constexpr size_t WS_WMIX = 8 * MiB;
constexpr size_t WS_WMKV = WS_WMIX + 4 * ((WL_SIZE + MiB - 1) / MiB) * MiB;
constexpr size_t WL_STRIDE = ((WL_SIZE + MiB - 1) / MiB) * MiB;
constexpr size_t WS_WFFN = WS_WMKV + 8 * MiB;
constexpr size_t WF_GU = 0, WF_D = (size_t)2 * DFF * DM * 2, WF_STRIDE = WF_D + (size_t)DM * DFF * 2;
constexpr size_t WS_H = WS_WFFN + 8 * WF_STRIDE;
constexpr size_t WS_MEMN = WS_H + (size_t)T * DM * 2;
constexpr size_t WS_MEMKV = WS_MEMN + (size_t)NB * MEML * DM * 2;
constexpr size_t WS_R = WS_MEMKV + (size_t)NB * MEML * 4096 * 2;
constexpr size_t R_P = 0, R_G = R_P + (size_t)T * PW * 2, R_QB = R_G + (size_t)T * GW * 2, R_KVB = R_QB + (size_t)T * QBW * 2, R_Y = R_KVB + (size_t)T * KVW * 2, R_END_MIX = R_Y + (size_t)T * YW * 2;
constexpr size_t R_ACT = 0;
constexpr size_t R_ASORT = (size_t)MAXSLOT * DFF * 2;
constexpr size_t R_YOUT = R_ASORT;
constexpr size_t R_END_FFN = R_YOUT + (size_t)MAXSLOT * DM * 2;
constexpr size_t R_SIZE = R_END_MIX > R_END_FFN ? R_END_MIX : R_END_FFN;
constexpr size_t WS_XB = WS_R + R_SIZE;
constexpr size_t WS_END = WS_XB + (size_t)T * DM * 2;
static_assert(WS_END < 1020ull * MiB, "workspace budget");
constexpr size_t MS_TOKE = 0;
constexpr size_t MS_TOKW = MS_TOKE + (size_t)T * 8;
constexpr size_t MS_SLOT = MS_TOKW + (size_t)T * 8;
constexpr size_t MS_CNT = MS_SLOT + (size_t)T * 8;
constexpr size_t MS_TEXP = MS_CNT + 256 * 8 * 4;
constexpr size_t MS_SSQ = MS_TEXP + 2048;
constexpr size_t MS_SNAP = MS_SSQ + (size_t)T * 32;
constexpr size_t MS_HSC = MS_SNAP + 64 * 1024 * 4;
constexpr size_t MS_ASC = MS_HSC + (size_t)T * 4;
constexpr size_t MS_WSIN = MS_ASC + (size_t)MAXSLOT * 4;
constexpr size_t MS_WSGU = MS_WSIN + (size_t)4 * NT_IN * 256 * 4;
constexpr size_t MS_END = MS_WSGU + (size_t)8 * 2 * DFF * 4;
static_assert(MS_END <= 7 * MiB, "misc map");
constexpr int CW_BAR = 4096;
constexpr int CW_DIAG = 16384;
constexpr int CW_CODE = 16384 + 512;

constexpr int RING_BYTES = 131072;
constexpr int LDSCTL_OFF = RING_BYTES;
constexpr int LDS_BYTES = 147456;
constexpr int NWAVES = 8;

#define LDS_WAIT() asm volatile("s_waitcnt lgkmcnt(0)" ::: "memory")
#define VM_WAIT() asm volatile("s_waitcnt vmcnt(0)" ::: "memory")

__device__ __forceinline__ unsigned f2bf(float f) { unsigned u = __builtin_bit_cast(unsigned, f); return (u + 0x7fffu + ((u >> 16) & 1u)) >> 16; }
__device__ __forceinline__ unsigned pk2(float lo, float hi) { return f2bf(lo) | (f2bf(hi) << 16); }
__device__ __forceinline__ float bf2f(unsigned short b) { return __builtin_bit_cast(float, (unsigned)b << 16); }
__device__ __forceinline__ float bflo(unsigned w) { return __builtin_bit_cast(float, w << 16); }
__device__ __forceinline__ float bfhi(unsigned w) { return __builtin_bit_cast(float, w & 0xffff0000u); }
typedef __bf16 bf16x2_t __attribute__((ext_vector_type(2)));
__device__ __forceinline__ unsigned cvtpk(float lo, float hi) { f32x2 v = {lo, hi}; bf16x2_t b = __builtin_convertvector(v, bf16x2_t); return __builtin_bit_cast(unsigned, b); }
__device__ __forceinline__ float wave_sum(float v) {
#pragma unroll
    for (int o = 1; o < 64; o <<= 1) v += __shfl_xor(v, o);
    return v;
}
__device__ __forceinline__ float fast_sigmoid(float x) { return __builtin_amdgcn_rcpf(1.0f + __builtin_amdgcn_exp2f(-x * LOG2E)); }


__device__ __forceinline__ int opq_v(int x) { asm volatile("" : "+v"(x)); return x; }
__device__ __forceinline__ int opq_s(int x) { asm volatile("" : "+s"(x)); return x; }
template <class Tp> __device__ __forceinline__ Tp* opq_p(Tp* p) { const unsigned long long u = (unsigned long long)p; unsigned lo = __builtin_amdgcn_readfirstlane((unsigned)u), hi = __builtin_amdgcn_readfirstlane((unsigned)(u >> 32)); asm volatile("" : "+s"(lo), "+s"(hi)); return (Tp*)(((unsigned long long)hi << 32) | lo); }

__constant__ float IFR_HI[32] = {1.591549367e-01f, 1.193493679e-01f, 8.949939907e-02f, 6.711508334e-02f, 5.032921210e-02f, 3.774158657e-02f, 2.830219641e-02f, 2.122365311e-02f, 1.591549441e-02f, 1.193493698e-02f, 8.949940093e-03f, 6.711508147e-03f, 5.032921210e-03f, 3.774158424e-03f, 2.830219688e-03f, 2.122365171e-03f, 1.591549488e-03f, 1.193493721e-03f, 8.949940093e-04f, 6.711508031e-04f, 5.032921326e-04f, 3.774158540e-04f, 2.830219455e-04f, 2.122365258e-04f, 1.591549371e-04f, 1.193493736e-04f, 8.949940093e-05f, 6.711508468e-05f, 5.032921035e-05f, 3.774158540e-05f, 2.830219637e-05f, 2.122365186e-05f};
__constant__ float IFR_LO[32] = {6.420638243e-09f, 2.294664903e-09f, 2.542919653e-09f, -3.316028840e-10f, 5.173299289e-12f, -1.848551645e-09f, -5.826552019e-10f, -3.431038786e-10f, -1.029942243e-10f, 4.320196978e-11f, 6.802745173e-11f, 1.531042237e-10f, 5.173301024e-13f, 4.797548470e-11f, -1.048316434e-10f, 1.053879969e-10f, -5.686555046e-11f, -1.896286773e-11f, 6.802744999e-12f, 2.695195456e-11f, -1.158979943e-11f, -6.843983713e-12f, 1.279990003e-11f, 1.807650600e-12f, 5.954976963e-12f, -3.351478166e-12f, 6.802745216e-13f, -1.670379113e-12f, 1.751403167e-12f, -6.843983930e-13f, -5.389994549e-13f, 9.083608431e-13f};
__device__ __forceinline__ void rot_cs(float posf, int idx, float& c, float& s) {
    const float ch = IFR_HI[idx], cl = IFR_LO[idx];
    const float p = posf * ch, e = __builtin_fmaf(posf, ch, -p);
    const float fr = __builtin_amdgcn_fractf(p) + (e + posf * cl);
    s = __builtin_amdgcn_sinf(fr); c = __builtin_amdgcn_cosf(fr);
}

#define XB_TMO      128
#define XB_XCNT(j)  (256  + 64 * (j))
#define XB_XSUB(j)  (1280 + 64 * (j))
#define XB_XGEN(j)  (2304 + 64 * (j))
#define XB_TOP      3328
#define XB_TOPGEN   3392
#define XCD_BAR_WORDS 3456
#define XB_SPIN_CAP (1u << 20)

__device__ __forceinline__ unsigned xb_ld(unsigned* p)              { return __hip_atomic_load(p, __ATOMIC_RELAXED, __HIP_MEMORY_SCOPE_AGENT); }
__device__ __forceinline__ unsigned xb_add(unsigned* p, unsigned v) { return __hip_atomic_fetch_add(p, v, __ATOMIC_RELAXED, __HIP_MEMORY_SCOPE_AGENT); }
__device__ __forceinline__ unsigned xb_xcc_id() { return (unsigned)__builtin_amdgcn_s_getreg((3 << 11) | 20) & 0xFu; }
#define XB_SPIN(cond, bar) do { unsigned _sp = 0; while (cond) { __builtin_amdgcn_s_sleep(1); \
    if ((++_sp & 255u) == 0u) { if (xb_ld(&(bar)[XB_TMO])) break; if (_sp > XB_SPIN_CAP) { atomicAdd(&(bar)[XB_TMO], 1u); break; } } } } while (0)

struct XcdBarrier { unsigned* bar; unsigned x; volatile LAS unsigned* st; };

__device__ __forceinline__ XcdBarrier xcd_barrier_post(unsigned* bar, volatile LAS unsigned* st) {
    XcdBarrier b; b.bar = bar; b.x = xb_xcc_id(); b.st = st;
    if (threadIdx.x == 0) (void)xb_add(&bar[XB_XCNT(b.x)], 1u);
    return b;
}
__device__ __forceinline__ void xcd_barrier_complete(unsigned* bar, unsigned x, unsigned& nloc, unsigned& nx) {
    const unsigned G = gridDim.x * gridDim.y * gridDim.z;
    unsigned sum, cnt, mine, sp = 0u;
    for (;;) {
        sum = 0u; cnt = 0u; mine = 0u;
#pragma unroll
        for (unsigned j = 0; j < 16; ++j) { const unsigned c = xb_ld(&bar[XB_XCNT(j)]); sum += c; cnt += (c > 0u) ? 1u : 0u; mine = (j == x) ? c : mine; }
        if (sum == G) break;
        __builtin_amdgcn_s_sleep(1);
        if ((++sp & 255u) == 0u) { if (xb_ld(&bar[XB_TMO])) break; if (sp > XB_SPIN_CAP) { atomicAdd(&bar[XB_TMO], 1u); break; } }
    }
    nloc = mine > 0u ? mine : 1u; nx = cnt > 0u ? cnt : 1u;
}
__device__ __forceinline__ void xcd_barrier(const XcdBarrier& b) {
    asm volatile("s_waitcnt vmcnt(0)" ::: "memory");
    __syncthreads();
    if (threadIdx.x == 0) {
        unsigned* bar = b.bar;
        __builtin_amdgcn_s_waitcnt(0);
        unsigned nloc = b.st[0], nx = b.st[1];
        if (nloc == 0u) { xcd_barrier_complete(bar, b.x, nloc, nx); b.st[0] = nloc; b.st[1] = nx; }
        const unsigned old = xb_add(&bar[XB_XSUB(b.x)], 1u);
        const unsigned gen = old / nloc;
        if (old + 1u == (gen + 1u) * nloc) {
            __builtin_amdgcn_fence(__ATOMIC_RELEASE, "agent");
            asm volatile("s_waitcnt vmcnt(0)" ::: "memory");
            const unsigned og = xb_add(&bar[XB_TOP], 1u);
            const unsigned tg = og / nx;
            if (og + 1u == (tg + 1u) * nx) xb_add(&bar[XB_TOPGEN], 1u);
            else XB_SPIN(xb_ld(&bar[XB_TOPGEN]) == tg, bar);
            __builtin_amdgcn_fence(__ATOMIC_ACQUIRE, "agent");
            xb_add(&bar[XB_XGEN(b.x)], 1u);
            asm volatile("s_waitcnt vmcnt(0)" ::: "memory");
        } else {
            XB_SPIN(xb_ld(&bar[XB_XGEN(b.x)]) == gen, bar);
            __builtin_amdgcn_fence(__ATOMIC_ACQUIRE, "agent");
            asm volatile("s_waitcnt vmcnt(0)" ::: "memory");
        }
    }
    __syncthreads();
}

namespace pg8 {
constexpr int BM = 256, BK = 64, HALF = 128, HTB = HALF * BK * 2, STAGE_BYTES = 8 * HTB, NXCD = 8, WGM = 4;
constexpr int ESC_OFF = 131072 + 4096, ESC_SLOT = 3072;
__host__ __device__ __forceinline__ int lds_byte(int r, int c) { const int st = (r >> 4) * 2 + (c >> 5), rr = r & 15, cc = c & 31, ob = rr * 64 + cc * 2; return st * 1024 + (ob ^ (((ob >> 9) & 1) << 5)); }
__host__ __device__ __forceinline__ void stage_rc(int b, int& R, int& C) { const int st = b / 1024, sb = b % 1024, swz = sb ^ (((sb >> 9) & 1) << 5); R = (st >> 1) * 16 + swz / 64; C = (st & 1) * 32 + (swz % 64) / 2; }

struct Unit { int pm, pn, aux; };

struct StaticOrder {
    int nM, nN, nwg, G, c, rev, wgm;
    __device__ void init(int nM_, int nN_, int G_, int c_, int rev_ = 0, int wgm_ = WGM) { nM = nM_; nN = nN_; nwg = nM * nN; G = G_; c = c_; rev = rev_; wgm = wgm_; }
    __device__ bool next(int i, Unit& u) const {
        const long L = (long)i * G + c; if (L >= nwg) return false;
        int wgid = (int)L; { const int q = nwg / NXCD, r = nwg % NXCD, xcd = wgid % NXCD, off = wgid / NXCD; wgid = (xcd < r ? xcd * (q + 1) : r * (q + 1) + (xcd - r) * q) + off; }
        const int nig = wgm * nN, gid = wgid / nig, fm = gid * wgm, gsz = (nM - fm) < wgm ? (nM - fm) : wgm;
        u.pm = fm + ((wgid % nig) % gsz); u.pn = (wgid % nig) / gsz; u.aux = 0; if (rev) u.pm = nM - 1 - u.pm; return true;
    }
};

template <bool I8> struct AccVec { typedef f32x4 type; };
template <> struct AccVec<true> { typedef i32x4 type; };
template <bool I8 = false, class Prob, class Sched, class Epi>
__device__ __forceinline__ void gemm_phase(LAS unsigned char* lds, const Prob& P, const Sched& S, const Epi& E) {
    const int tid = opq_v((int)threadIdx.x), wid = __builtin_amdgcn_readfirstlane(tid >> 6), lane = tid & 63, wr = wid >> 2, wc = wid & 3, fr = lane & 15, fq = lane >> 4;
    typedef typename AccVec<I8>::type accv_t;
    const int K = P.K, nt = K / (I8 ? 2 * BK : BK);
    unsigned voffA[2], voffB[2];
#pragma unroll
    for (int i = 0; i < 2; ++i) { int R, C; stage_rc(tid * 16 + i * 8192, R, C); voffA[i] = (unsigned)R * P.lda + (unsigned)C * 2u; voffB[i] = (unsigned)R * P.ldb + (unsigned)C * 2u; }
    const size_t kstep = (size_t)(BK * 2);
    const size_t hstepA = (size_t)HALF * P.lda, hstepB = (size_t)HALF * P.ldb;
    const unsigned ldsw = (unsigned)wid * 1024u;
    const int aoff = lds_byte(wr * 64 + fr, fq * 8), boff = lds_byte(wc * 32 + fr, fq * 8);
#define PG8_SA(b, h) (((b) * 2 + (h)) * HTB)
#define PG8_SB(b, h) ((4 + (b) * 2 + (h)) * HTB)
#define PG8_STAGE(bufoff, gbase, voff) do { _Pragma("unroll") for (int _i = 0; _i < 2; ++_i) \
        __builtin_amdgcn_global_load_lds((const unsigned*)((const char*)(gbase) + (voff)[_i]), (LAS unsigned*)(lds + (bufoff) + ldsw + _i * 8192), 16, 0, 0); } while (0)
#define PG8_LDA(dst, b, h) do { _Pragma("unroll") for (int m = 0; m < 4; ++m) _Pragma("unroll") for (int k = 0; k < 2; ++k) dst[m][k] = *(const LAS bf16x8*)(lds + PG8_SA(b, h) + aoff + m * 2048 + k * 1024); } while (0)
#define PG8_LDB(dst, b, h) do { _Pragma("unroll") for (int n = 0; n < 2; ++n) _Pragma("unroll") for (int k = 0; k < 2; ++k) dst[n][k] = *(const LAS bf16x8*)(lds + PG8_SB(b, h) + boff + n * 2048 + k * 1024); } while (0)
#define PG8_MMA(ai, bj, At, Bt) do { __builtin_amdgcn_s_setprio(1); _Pragma("unroll") for (int m = 0; m < 4; ++m) _Pragma("unroll") for (int n = 0; n < 2; ++n) _Pragma("unroll") for (int k = 0; k < 2; ++k) \
        { if constexpr (I8) acc[ai][bj][m][n] = __builtin_amdgcn_mfma_i32_16x16x64_i8(__builtin_bit_cast(i32x4, Bt[n][k]), __builtin_bit_cast(i32x4, At[m][k]), acc[ai][bj][m][n], 0, 0, 0); \
          else acc[ai][bj][m][n] = __builtin_amdgcn_mfma_f32_16x16x32_bf16(Bt[n][k], At[m][k], acc[ai][bj][m][n], 0, 0, 0); } __builtin_amdgcn_s_setprio(0); } while (0)
#define PG8_WAIT_V(n) asm volatile("s_waitcnt vmcnt(" #n ")" ::: "memory")
#define PG8_WAIT_L(n) asm volatile("s_waitcnt lgkmcnt(" #n ")" ::: "memory")
#define PG8_BAR __builtin_amdgcn_s_barrier()
#define PG8_SCHED __builtin_amdgcn_sched_barrier(0)
    Unit cur, nxt; int ui = 0;
    if (!S.next(0, cur)) return;
    accv_t acc[2][2][4][2];
#pragma unroll
    for (int a = 0; a < 2; ++a)
#pragma unroll
        for (int b = 0; b < 2; ++b)
#pragma unroll
            for (int m = 0; m < 4; ++m)
#pragma unroll
                for (int n = 0; n < 2; ++n) acc[a][b][m][n] = accv_t{};
    bf16x8 At[4][2], B0[2][2], B1[2][2];
    const char* cA = P.a_ptr(cur); const char* cB = P.b_ptr(cur);
    int eslot = 0;
    E.stage(lds + ESC_OFF, cur, wid, lane);
    PG8_STAGE(PG8_SB(0, 0), cB, voffB); PG8_STAGE(PG8_SB(0, 1), cB + hstepB, voffB); PG8_STAGE(PG8_SA(0, 0), cA, voffA); PG8_STAGE(PG8_SA(0, 1), cA + hstepA, voffA);
    if (wr == 1) PG8_BAR;
    PG8_WAIT_V(2); PG8_BAR;
    PG8_STAGE(PG8_SB(1, 0), cB + kstep, voffB); PG8_STAGE(PG8_SA(1, 0), cA + kstep, voffA); PG8_STAGE(PG8_SB(1, 1), cB + hstepB + kstep, voffB);
    PG8_WAIT_V(6); PG8_BAR;
    for (;;) {
        const bool has_next = S.next(ui + 1, nxt);
        const char* nA = has_next ? P.a_ptr(nxt) : cA; const char* nB = has_next ? P.b_ptr(nxt) : cB;
        for (int t = 0; t < nt; t += 2) {
            if constexpr (Epi::MID) { if (t == 8 || t == 16) E.mid(acc, cur, t >> 3, wr, wc, fr, fq); }
            const bool last = (t == nt - 2);
            if (last && has_next) E.stage(lds + ESC_OFF + (eslot ^ 1) * ESC_SLOT, nxt, wid, lane);
            const char* a1 = cA + (size_t)(t + 1) * kstep;
            const char* a2 = last ? nA : cA + (size_t)(t + 2) * kstep; const char* b2 = last ? nB : cB + (size_t)(t + 2) * kstep;
            const char* a3 = a2 + kstep; const char* b3 = b2 + kstep;
            PG8_LDB(B0, 0, 0); PG8_LDB(B1, 0, 1); PG8_SCHED; PG8_LDA(At, 0, 0); PG8_STAGE(PG8_SA(1, 1), a1 + hstepA, voffA);
            PG8_WAIT_V(8); PG8_WAIT_L(0); PG8_BAR; PG8_MMA(0, 0, At, B0); PG8_MMA(0, 1, At, B1); PG8_BAR; PG8_SCHED;
            PG8_LDA(At, 0, 1); PG8_STAGE(PG8_SB(0, 0), b2, voffB); PG8_STAGE(PG8_SB(0, 1), b2 + hstepB, voffB); PG8_STAGE(PG8_SA(0, 0), a2, voffA);
            PG8_WAIT_V(8); PG8_WAIT_L(0); PG8_BAR; PG8_MMA(1, 0, At, B0); PG8_MMA(1, 1, At, B1); PG8_BAR; PG8_SCHED;
            PG8_LDB(B0, 1, 0); PG8_LDB(B1, 1, 1); PG8_SCHED; PG8_LDA(At, 1, 0); PG8_STAGE(PG8_SA(0, 1), a2 + hstepA, voffA);
            PG8_WAIT_V(8); PG8_WAIT_L(0); PG8_BAR; PG8_MMA(0, 0, At, B0); PG8_MMA(0, 1, At, B1); PG8_BAR; PG8_SCHED;
            PG8_LDA(At, 1, 1); PG8_STAGE(PG8_SB(1, 0), b3, voffB); PG8_STAGE(PG8_SB(1, 1), b3 + hstepB, voffB); PG8_STAGE(PG8_SA(1, 0), a3, voffA);
            PG8_WAIT_V(8); PG8_WAIT_L(0); PG8_BAR; PG8_MMA(1, 0, At, B0); PG8_MMA(1, 1, At, B1); PG8_BAR; PG8_SCHED;
        }
        if (wr == 0) PG8_BAR;
        E(acc, cur, wr, wc, fr, fq, lds + ESC_OFF + eslot * ESC_SLOT);
        if (!has_next) break;
#pragma unroll
        for (int a = 0; a < 2; ++a)
#pragma unroll
            for (int b = 0; b < 2; ++b)
#pragma unroll
                for (int m = 0; m < 4; ++m)
#pragma unroll
                    for (int n = 0; n < 2; ++n) acc[a][b][m][n] = accv_t{};
        cur = nxt; cA = nA; cB = nB; ++ui; eslot ^= 1;
        if (wr == 1) PG8_BAR;
    }
    PG8_WAIT_V(0);
    PG8_BAR;
#undef PG8_SA
#undef PG8_SB
#undef PG8_STAGE
#undef PG8_LDA
#undef PG8_LDB
#undef PG8_MMA
#undef PG8_WAIT_V
#undef PG8_WAIT_L
#undef PG8_BAR
#undef PG8_SCHED
}
}

struct Frame {
    LAS unsigned char* lds;
    volatile LAS unsigned* MISC;
    gu32* ctl;
    unsigned char* ws;
    int tid, lane, wave, vcu, G;
    const float* const* in; float* out;
};
enum { I_X = 0, I_MEM, I_POS, I_GMIX, I_WIN, I_GQ, I_WUQ, I_GKV, I_WUKV, I_SINK, I_WMKV, I_WBR, I_WOUT, I_GFFN, I_WGD, I_WUD, I_WDD, I_WR, I_WGE, I_WUE, I_WDE, I_GMEM, I_GFIN };

__device__ __forceinline__ int sem_plain(int g) { return (g & ~31) + 8 * ((g >> 2) & 3) + 4 * ((g >> 4) & 1) + (g & 3); }
__device__ __forceinline__ int sem_rot64(int g) { return (g & ~63) + 32 * ((g >> 4) & 1) + 16 * ((g >> 5) & 1) + 4 * ((g >> 2) & 3) + (g & 3); }
__device__ __forceinline__ int inproj_src(int n) {
    const int pn = n >> 8, c = n & 255;
    if (pn < 2) return pn * 256 + sem_rot64(c);
    if (pn == 2) return c < 128 ? 512 + sem_rot64(c) : 640 + sem_plain(c - 128);
    if (pn == 3) return 768 + sem_plain(c);
    if (pn == 4) return c < 128 ? 1024 + sem_plain(c) : (c < 160 ? 1152 + (c - 128) : -1);
    if (pn < 7) return 1184 + (pn - 5) * 256 + sem_plain(c);
    return 1696 + (pn - 7) * 256 + sem_plain(c);
}

struct MapInproj { const float* W; __device__ __forceinline__ float load(int k, int n) const { const int s = inproj_src(n); return s >= 0 ? W[(size_t)k * INW + s] : 0.f; }
    __device__ __forceinline__ f32x4 load4(int k, int n) const { const int s = inproj_src(n); return s >= 0 ? *(const f32x4*)(W + (size_t)k * INW + s) : (f32x4){0.f, 0.f, 0.f, 0.f}; } };
struct MapUp { const float *Wq, *Wkv, *gq, *gkv;
    __device__ __forceinline__ f32x4 load4(int k, int n) const {
        if (n < 768) { const int gg = n >> 5; const int s = (gg % 3 == 2) ? n : sem_plain(n); return *(const f32x4*)(Wq + (size_t)k * 768 + s) * gq[k]; }
        if (k < 128) return (f32x4){0.f, 0.f, 0.f, 0.f}; const int s = sem_plain(n - 768); return *(const f32x4*)(Wkv + (size_t)(k - 128) * 1024 + s) * gkv[k - 128]; }
    __device__ __forceinline__ float load(int k, int n) const {
        if (n < 768) { const int gg = n >> 5; const int s = (gg % 3 == 2) ? n : sem_plain(n); return gq[k] * Wq[(size_t)k * 768 + s]; }
        if (k < 128) return 0.f; const int s = sem_plain(n - 768); return gkv[k - 128] * Wkv[(size_t)(k - 128) * 1024 + s]; } };
struct MapPlain { const float* W; int ldw; __device__ __forceinline__ float load(int k, int n) const { return W[(size_t)k * ldw + sem_plain(n)]; }
    __device__ __forceinline__ f32x4 load4(int k, int n) const { return *(const f32x4*)(W + (size_t)k * ldw + sem_plain(n)); } };
struct MapNat { const float* W; int ldw; __device__ __forceinline__ float load(int k, int n) const { return W[(size_t)k * ldw + n]; }
    __device__ __forceinline__ f32x4 load4(int k, int n) const { return *(const f32x4*)(W + (size_t)k * ldw + n); } };
struct MapBr { const float* W;
    __device__ __forceinline__ float load(int k, int n) const { return W[(size_t)k * DM + sem_plain(n)]; }
    __device__ __forceinline__ f32x4 load4(int k, int n) const { return *(const f32x4*)(W + (size_t)k * DM + sem_plain(n)); } };
struct MapMemkv { const float* W; __device__ __forceinline__ float load(int k, int n) const { const int l = n >> 10, c = n & 1023; return W[((size_t)l * DM + k) * 1024 + sem_plain(c)]; }
    __device__ __forceinline__ f32x4 load4(int k, int n) const { const int l = n >> 10, c = n & 1023; return *(const f32x4*)(W + ((size_t)l * DM + k) * 1024 + sem_plain(c)); } };
struct MapGU { const float *Wg, *Wu; __device__ __forceinline__ float load(int k, int n) const { const int pn = n >> 8, c = n & 255; const int ch = 128 * pn + sem_plain(c & 127);
    const unsigned long long a = (unsigned long long)Wg, b = (unsigned long long)Wu, w = a ^ ((a ^ b) & (0ull - (unsigned long long)(c >> 7))); return ((const float*)w)[(size_t)k * DFF + ch]; }
    __device__ __forceinline__ f32x4 load4(int k, int n) const { const int pn = n >> 8, c = n & 255; const int ch = 128 * pn + sem_plain(c & 127);
        const unsigned long long a = (unsigned long long)Wg, b = (unsigned long long)Wu, w = a ^ ((a ^ b) & (0ull - (unsigned long long)(c >> 7))); return *(const f32x4*)((const float*)w + (size_t)k * DFF + ch); } };

template <class M> __device__ __forceinline__ void prep_item(const M& m, bf16_t* dst, int Kd, int nblk, LAS float* scr, int item, int lane) {
    const int kb = item / nblk, nb = item % nblk, k0 = 64 * kb, n0 = 32 * nb;
#pragma unroll 8
    for (int i = 0; i < 32; ++i) { const int kk = 2 * i + (lane >> 5); scr[kk * 33 + (lane & 31)] = m.load(k0 + kk, n0 + (lane & 31)); }
    LDS_WAIT(); asm volatile("" ::: "memory");
    const int c = lane & 7;
#pragma unroll
    for (int j = 0; j < 4; ++j) { const int n = (lane >> 3) + 8 * j; const LAS float* s = scr + (8 * c) * 33 + n;
        u32x4 o; o.x = pk2(s[0 * 33], s[1 * 33]); o.y = pk2(s[2 * 33], s[3 * 33]); o.z = pk2(s[4 * 33], s[5 * 33]); o.w = pk2(s[6 * 33], s[7 * 33]);
        *(u32x4*)(dst + (size_t)(n0 + n) * Kd + k0 + 8 * c) = o; }
    LDS_WAIT(); asm volatile("" ::: "memory");
}
template <class M> __device__ __forceinline__ void prep_tile(const M& m, bf16_t* dst, int Kd, int nblk, LAS unsigned char* tile, int item, int lane) {
    const int kb = item / nblk, nb = item % nblk, k0 = 128 * kb, n0 = 32 * nb, ng = lane & 7, kr = lane >> 3;
    f32x4 v[16];
#pragma unroll
    for (int i = 0; i < 16; ++i) v[i] = m.load4(k0 + 8 * i + kr, n0 + 4 * ng);
#pragma unroll
    for (int i = 0; i < 16; ++i)
#pragma unroll
        for (int c = 0; c < 4; ++c) *(LAS unsigned short*)(tile + (4 * ng + c) * 272 + (8 * i + kr) * 2) = (unsigned short)f2bf(v[i][c]);
    LDS_WAIT(); asm volatile("" ::: "memory");
#pragma unroll
    for (int j = 0; j < 8; ++j) { const int p = lane + 64 * j, n = p >> 4, kc = p & 15;
        *(u32x4*)(dst + (size_t)(n0 + n) * Kd + k0 + 8 * kc) = *(const LAS u32x4*)(tile + n * 272 + 16 * kc); }
    LDS_WAIT(); asm volatile("" ::: "memory");
}
template <class M> __device__ __forceinline__ void prep_matrix(Frame& F, const M& m, bf16_t* dst, int N, int K) {
    LAS unsigned char* tile = F.lds + F.wave * 16384;
    const int gw = F.vcu * NWAVES + F.wave, NGW = F.G * NWAVES, nblk = N / 32, nitems = (K / 128) * nblk;
    for (int it = gw; it < nitems; it += NGW) prep_tile(m, dst, K, nblk, tile, it, F.lane);
}

template <class M> __device__ __forceinline__ void prep_strip_i8(Frame& F, const M& m, signed char* dst, float* scl, int strip) {
    const int lane = F.lane, w = F.wave, n0 = strip * 32, k0 = w * 128, ng = lane & 7, kr = lane >> 3;
    LAS unsigned char* tile = F.lds + w * 16384;
    LAS float* amt = (LAS float*)(F.lds + LDSCTL_OFF + 2048);
    f32x4 v[16];
#pragma unroll
    for (int i = 0; i < 16; ++i) v[i] = m.load4(k0 + 8 * i + kr, n0 + 4 * ng);
    f32x4 am = __builtin_elementwise_abs(v[0]);
#pragma unroll
    for (int i = 1; i < 16; ++i) am = __builtin_elementwise_max(am, __builtin_elementwise_abs(v[i]));
#pragma unroll
    for (int c = 0; c < 4; ++c) { float a = am[c]; a = fmaxf(a, __shfl_xor(a, 8)); a = fmaxf(a, __shfl_xor(a, 16)); a = fmaxf(a, __shfl_xor(a, 32)); am[c] = a; }
    if (kr == 0) *(LAS f32x4*)(amt + w * 32 + 4 * ng) = am;
    __syncthreads();
    f32x4 cm = *(const LAS f32x4*)(amt + 4 * ng);
#pragma unroll
    for (int ww = 1; ww < 8; ++ww) cm = __builtin_elementwise_max(cm, *(const LAS f32x4*)(amt + ww * 32 + 4 * ng));
    f32x4 inv;
#pragma unroll
    for (int c = 0; c < 4; ++c) inv[c] = cm[c] > 0.f ? 127.0f / cm[c] : 0.f;
    if (w == 0 && kr == 0) *(f32x4*)(scl + n0 + 4 * ng) = cm * (1.0f / 127.0f);
#pragma unroll
    for (int i = 0; i < 16; ++i)
#pragma unroll
        for (int c = 0; c < 4; ++c) tile[(4 * ng + c) * 144 + 8 * i + kr] = (unsigned char)(signed char)__float2int_rn(v[i][c] * inv[c]);
    LDS_WAIT(); asm volatile("" ::: "memory");
#pragma unroll
    for (int j = 0; j < 4; ++j) { const int p = lane + 64 * j, n = p >> 3, kc = p & 7;
        *(u32x4*)(dst + (size_t)(n0 + n) * DM + k0 + 16 * kc) = *(const LAS u32x4*)(tile + n * 144 + 16 * kc); }
    LDS_WAIT();
    __syncthreads();
}
__device__ __forceinline__ bf16_t* wmix(Frame& F, int l, size_t off) { return (bf16_t*)(F.ws + WS_WMIX + (size_t)l * WL_STRIDE + off); }

__device__ __forceinline__ void prep_mixer_weights(Frame& F) {
    for (int l = 0; l < DEPTH; ++l) {
        { MapInproj m{F.in[I_WIN] + (size_t)l * DM * INW}; for (int s = F.vcu; s < NT_IN * 8; s += F.G) prep_strip_i8(F, m, (signed char*)wmix(F, l, WL_IN), (float*)(F.ws + WS_MISC + MS_WSIN) + l * NT_IN * 256, s); }
        { MapUp m{F.in[I_WUQ] + (size_t)l * 256 * 768, F.in[I_WUKV] + (size_t)l * 128 * 1024, F.in[I_GQ] + l * 256, F.in[I_GKV] + l * 128}; prep_matrix(F, m, wmix(F, l, WL_UP), UPN, UPK); }
        { MapBr m{F.in[I_WBR] + (size_t)l * 3 * 512 * DM}; prep_matrix(F, m, wmix(F, l, WL_BR), DM, 1536); }
        { MapPlain m{F.in[I_WOUT] + (size_t)l * DM * DM, DM}; prep_matrix(F, m, wmix(F, l, WL_OUT), DM, DM); }
    }
    { MapMemkv m{F.in[I_WMKV]}; prep_matrix(F, m, (bf16_t*)(F.ws + WS_WMKV), 4096, DM); }
}
__device__ __forceinline__ void prep_ffn_weights(Frame& F, int l) {
    const int i = l >> 1; const bool moe = (l & 1) != 0;
    LAS float* scr = (LAS float*)(F.lds + F.wave * 16384);
    const int gw = F.vcu * NWAVES + F.wave, NGW = F.G * NWAVES;
    constexpr int IGU = (DM / 64) * (2 * DFF / 32), ID = (DFF / 64) * (DM / 32), NSTRIP = 2 * DFF / 32;
    const int ne = moe ? NE : 1;
    const float* Wg = moe ? F.in[I_WGE] : F.in[I_WGD]; const float* Wu = moe ? F.in[I_WUE] : F.in[I_WUD]; const float* Wd = moe ? F.in[I_WDE] : F.in[I_WDD];
    if (GU_I8(l)) {
        for (int s = F.vcu; s < ne * NSTRIP; s += F.G) { const int e = s / NSTRIP, ss = s % NSTRIP; const size_t eo = ((size_t)i * ne + e) * DM * DFF;
            MapGU m{Wg + eo, Wu + eo}; prep_strip_i8(F, m, (signed char*)(F.ws + WS_WFFN + (size_t)e * WF_STRIDE), (float*)(F.ws + WS_MISC + MS_WSGU) + e * 2 * DFF, ss); }
    } else {
        for (int it = gw; it < ne * IGU; it += NGW) { const int e = it / IGU, r = it % IGU; const size_t eo = ((size_t)i * ne + e) * DM * DFF;
            MapGU m{Wg + eo, Wu + eo}; prep_item(m, (bf16_t*)(F.ws + WS_WFFN + (size_t)e * WF_STRIDE), DM, 2 * DFF / 32, scr, r, F.lane); }
    }
    constexpr int IDT = (DFF / 128) * (DM / 32);
    for (int it = gw; it < ne * IDT; it += NGW) { const int e = it / IDT, r = it % IDT; const size_t eo = ((size_t)i * ne + e) * DM * DFF;
        MapPlain m{Wd + eo, DM}; prep_tile(m, (bf16_t*)(F.ws + WS_WFFN + (size_t)e * WF_STRIDE + WF_D), DFF, DM / 32, F.lds + F.wave * 16384, r, F.lane); }
}

struct RowV { f32x4 v[4]; };
__device__ __forceinline__ void row_load(RowV& r, const float* p, int lane) { const f32x4* x = (const f32x4*)p + lane;
#pragma unroll
    for (int j = 0; j < 4; ++j) r.v[j] = x[64 * j]; }
__device__ __forceinline__ void row_store(const RowV& r, float* p, int lane) { f32x4* x = (f32x4*)p + lane;
#pragma unroll
    for (int j = 0; j < 4; ++j) x[64 * j] = r.v[j]; }
__device__ __forceinline__ void row_add_bf16(RowV& r, const bf16_t* p, float w, int lane) { const u32x2* x = (const u32x2*)p + lane;
#pragma unroll
    for (int j = 0; j < 4; ++j) { const u32x2 q = x[64 * j]; r.v[j].x += w * bflo(q.x); r.v[j].y += w * bfhi(q.x); r.v[j].z += w * bflo(q.y); r.v[j].w += w * bfhi(q.y); } }
__device__ __forceinline__ void row_load_bf16(RowV& r, const bf16_t* p, int lane) { const u32x2* x = (const u32x2*)p + lane;
#pragma unroll
    for (int j = 0; j < 4; ++j) { const u32x2 q = x[64 * j]; r.v[j].x = bflo(q.x); r.v[j].y = bfhi(q.x); r.v[j].z = bflo(q.y); r.v[j].w = bfhi(q.y); } }
__device__ __forceinline__ void row_round_bf16(RowV& r) {
#pragma unroll
    for (int j = 0; j < 4; ++j) { r.v[j].x = bf2f((unsigned short)f2bf(r.v[j].x)); r.v[j].y = bf2f((unsigned short)f2bf(r.v[j].y)); r.v[j].z = bf2f((unsigned short)f2bf(r.v[j].z)); r.v[j].w = bf2f((unsigned short)f2bf(r.v[j].w)); } }
__device__ __forceinline__ float row_rstd(const RowV& r) { float s = 0.f;
#pragma unroll
    for (int j = 0; j < 4; ++j) s += (r.v[j].x * r.v[j].x + r.v[j].y * r.v[j].y) + (r.v[j].z * r.v[j].z + r.v[j].w * r.v[j].w);
    return 1.0f / sqrtf(wave_sum(s) * (1.0f / DM) + EPS); }
__device__ __forceinline__ void row_scale(RowV& r, float rstd, const float* g, int lane) { const f32x4* gg = (const f32x4*)g + lane;
#pragma unroll
    for (int j = 0; j < 4; ++j) r.v[j] = r.v[j] * rstd * gg[64 * j]; }
__device__ __forceinline__ void row_store_bf16(const RowV& r, bf16_t* p, int lane) { u32x2* o = (u32x2*)p + lane;
#pragma unroll
    for (int j = 0; j < 4; ++j) { u32x2 w; w.x = pk2(r.v[j].x, r.v[j].y); w.y = pk2(r.v[j].z, r.v[j].w); o[64 * j] = w; } }

__device__ __forceinline__ float row_store_i8(const RowV& r, signed char* p, int lane) {
    float am = 0.f;
#pragma unroll
    for (int j = 0; j < 4; ++j) am = fmaxf(am, fmaxf(fmaxf(fabsf(r.v[j].x), fabsf(r.v[j].y)), fmaxf(fabsf(r.v[j].z), fabsf(r.v[j].w))));
#pragma unroll
    for (int o = 1; o < 64; o <<= 1) am = fmaxf(am, __shfl_xor(am, o));
    const float inv = am > 0.f ? 127.0f / am : 0.f; unsigned* o4 = (unsigned*)p + lane;
#pragma unroll
    for (int j = 0; j < 4; ++j) { const unsigned a = (unsigned)__float2int_rn(r.v[j].x * inv) & 255u, b = (unsigned)__float2int_rn(r.v[j].y * inv) & 255u, c = (unsigned)__float2int_rn(r.v[j].z * inv) & 255u, d = (unsigned)__float2int_rn(r.v[j].w * inv) & 255u;
        o4[64 * j] = a | (b << 8) | (c << 16) | (d << 24); }
    return am * (1.0f / 127.0f);
}
__device__ __forceinline__ void row_combine(Frame& F, RowV& r, int t) {
    const int* sl = (const int*)(F.ws + WS_MISC + MS_SLOT) + 2 * t; const float* tw = (const float*)(F.ws + WS_MISC + MS_TOKW) + 2 * t;
    const bf16_t* Y = (const bf16_t*)(F.ws + WS_R + R_YOUT);
    const int s0 = sl[0], s1 = sl[1]; const float w0 = tw[0], w1 = tw[1];
    row_add_bf16(r, Y + (size_t)s0 * DM, w0, F.lane); row_add_bf16(r, Y + (size_t)s1 * DM, w1, F.lane);
}

__device__ __forceinline__ void norm_phase(Frame& F, const float* srcf, bf16_t* X, const float* g, bool combine, bool out_i8) {
    bf16_t* H = (bf16_t*)(F.ws + WS_H); signed char* Hq = (signed char*)(F.ws + WS_H); float* hsc = (float*)(F.ws + WS_MISC + MS_HSC);
    const int gw = F.vcu * NWAVES + F.wave, NGW = F.G * NWAVES;
    for (int t = gw; t < T; t += 2 * NGW) {
        const int t2 = t + NGW;
        RowV r, q;
        if (srcf) { row_load(r, srcf + (size_t)t * DM, F.lane); row_load(q, srcf + (size_t)t2 * DM, F.lane); }
        else { row_load_bf16(r, X + (size_t)t * DM, F.lane); row_load_bf16(q, X + (size_t)t2 * DM, F.lane); }
        if (combine) { row_combine(F, r, t); row_combine(F, q, t2); row_store_bf16(r, X + (size_t)t * DM, F.lane); row_store_bf16(q, X + (size_t)t2 * DM, F.lane);
            row_round_bf16(r); row_round_bf16(q); }
        const float rstd = row_rstd(r), qstd = row_rstd(q); row_scale(r, rstd, g, F.lane); row_scale(q, qstd, g, F.lane);
        if (out_i8) { const float sc = row_store_i8(r, Hq + (size_t)t * DM, F.lane), sq = row_store_i8(q, Hq + (size_t)t2 * DM, F.lane); if (F.lane == 0) { hsc[t] = sc; hsc[t2] = sq; } }
        else { row_store_bf16(r, H + (size_t)t * DM, F.lane); row_store_bf16(q, H + (size_t)t2 * DM, F.lane); }
    }
}
__device__ __forceinline__ void final_norm_phase(Frame& F, const bf16_t* X, float* out, const float* g, bool combine) {
    const int gw = F.vcu * NWAVES + F.wave, NGW = F.G * NWAVES;
    for (int t = gw; t < T; t += 2 * NGW) {
        const int t2 = t + NGW;
        RowV r, q; row_load_bf16(r, X + (size_t)t * DM, F.lane); row_load_bf16(q, X + (size_t)t2 * DM, F.lane);
        if (combine) { row_combine(F, r, t); row_combine(F, q, t2); }
        const float rstd = row_rstd(r), qstd = row_rstd(q); row_scale(r, rstd, g, F.lane); row_scale(q, qstd, g, F.lane);
        row_store(r, out + (size_t)t * DM, F.lane); row_store(q, out + (size_t)t2 * DM, F.lane);
    }
}
__device__ __forceinline__ void memnorm_phase(Frame& F) {
    bf16_t* MN = (bf16_t*)(F.ws + WS_MEMN);
    const int gw = F.vcu * NWAVES + F.wave, NGW = F.G * NWAVES;
    for (int t = gw; t < NB * MEML; t += NGW) {
        RowV r; row_load(r, F.in[I_MEM] + (size_t)t * DM, F.lane);
        const float rstd = row_rstd(r); row_scale(r, rstd, F.in[I_GMEM], F.lane);
        row_store_bf16(r, MN + (size_t)t * DM, F.lane);
    }
}

__device__ __forceinline__ void norm_router_phase(Frame& F, const bf16_t* X, const float* g, const float* Wr  , bool out_i8) {
    bf16_t* H = (bf16_t*)(F.ws + WS_H); signed char* Hq = (signed char*)(F.ws + WS_H); float* hsc = (float*)(F.ws + WS_MISC + MS_HSC);
    int* toke = (int*)(F.ws + WS_MISC + MS_TOKE); float* tokw = (float*)(F.ws + WS_MISC + MS_TOKW); int* cntg = (int*)(F.ws + WS_MISC + MS_CNT);
    volatile LAS int* hist = (volatile LAS int*)(F.lds + LDSCTL_OFF + 1024);
    f32x4 wa[4][4], wb[4][4];
#pragma unroll
    for (int j = 0; j < 4; ++j)
#pragma unroll
        for (int k = 0; k < 4; ++k) { const int d = 256 * j + 4 * F.lane + k; wa[j][k] = *(const f32x4*)(Wr + (size_t)d * 8); wb[j][k] = *(const f32x4*)(Wr + (size_t)d * 8 + 4); }
    const bool up32 = (F.lane & 32) != 0, up16 = (F.lane & 16) != 0, up8 = (F.lane & 8) != 0;
    for (int c = F.vcu; c < T / 128; c += F.G) {
        if (F.tid < 8) hist[F.tid] = 0;
        __syncthreads();
        for (int q = 0; q < 16; ++q) {
            const int t = c * 128 + F.wave * 16 + q;
            RowV r; row_load_bf16(r, X + (size_t)t * DM, F.lane);
            const float rstd = row_rstd(r); row_scale(r, rstd, g, F.lane);
            if (out_i8) { const float sc = row_store_i8(r, Hq + (size_t)t * DM, F.lane); if (F.lane == 0) hsc[t] = sc; }
            else row_store_bf16(r, H + (size_t)t * DM, F.lane);
            f32x4 la = {0.f, 0.f, 0.f, 0.f}, lb = {0.f, 0.f, 0.f, 0.f};
#pragma unroll
            for (int j = 0; j < 4; ++j)
#pragma unroll
                for (int k = 0; k < 4; ++k) { const float x = r.v[j][k]; la += wa[j][k] * x; lb += wb[j][k] * x; }
            f32x4 h4; { const f32x4 keep = up32 ? lb : la, send = up32 ? la : lb;
#pragma unroll
                for (int i = 0; i < 4; ++i) h4[i] = keep[i] + __shfl_xor(send[i], 32); }
            f32x2 h2; { const float k0 = up16 ? h4[2] : h4[0], k1 = up16 ? h4[3] : h4[1], s0 = up16 ? h4[0] : h4[2], s1 = up16 ? h4[1] : h4[3]; h2.x = k0 + __shfl_xor(s0, 16); h2.y = k1 + __shfl_xor(s1, 16); }
            float h1 = (up8 ? h2.y : h2.x) + __shfl_xor(up8 ? h2.x : h2.y, 8);
            h1 += __shfl_xor(h1, 4); h1 += __shfl_xor(h1, 2); h1 += __shfl_xor(h1, 1);
            float lg[8];
#pragma unroll
            for (int e = 0; e < 8; ++e) lg[e] = __builtin_bit_cast(float, __builtin_amdgcn_readlane(__builtin_bit_cast(int, h1), 8 * e));
            int e0 = 0; float v0 = lg[0];
#pragma unroll
            for (int e = 1; e < 8; ++e) if (lg[e] > v0) { v0 = lg[e]; e0 = e; }
            int e1 = -1; float v1 = -INFINITY;
#pragma unroll
            for (int e = 0; e < 8; ++e) if (e != e0 && lg[e] > v1) { v1 = lg[e]; e1 = e; }
            if (F.lane == 0) {
                const float w0 = 1.0f / (1.0f + __expf(v1 - v0));
                toke[2 * t] = e0; toke[2 * t + 1] = e1; tokw[2 * t] = w0; tokw[2 * t + 1] = 1.0f - w0;
                __hip_atomic_fetch_add((LAS int*)&hist[e0], 1, __ATOMIC_RELAXED, __HIP_MEMORY_SCOPE_WORKGROUP); __hip_atomic_fetch_add((LAS int*)&hist[e1], 1, __ATOMIC_RELAXED, __HIP_MEMORY_SCOPE_WORKGROUP);
            }
        }
        __syncthreads();
        if (F.tid < 8) cntg[c * 8 + F.tid] = hist[F.tid];
        __syncthreads();
    }
}
__device__ __forceinline__ void moe_assign_phase(Frame& F, bool i8) {
    const bf16_t* H = (const bf16_t*)(F.ws + WS_H); bf16_t* AS = (bf16_t*)(F.ws + WS_R + R_ASORT);
    const float* hsc = (const float*)(F.ws + WS_MISC + MS_HSC); float* asc = (float*)(F.ws + WS_MISC + MS_ASC);
    const int* toke = (const int*)(F.ws + WS_MISC + MS_TOKE); int* slot = (int*)(F.ws + WS_MISC + MS_SLOT); const int* cntg = (const int*)(F.ws + WS_MISC + MS_CNT);
    int* texp = (int*)(F.ws + WS_MISC + MS_TEXP);
    volatile LAS int* tot = (volatile LAS int*)(F.lds + LDSCTL_OFF + 1024);
    volatile LAS int* pre = tot + 8;
    volatile LAS int* wcnt = tot + 16;
    for (int c = F.vcu; c < T / 128; c += F.G) {
        if (F.tid < 16) tot[F.tid] = 0;
        __syncthreads();
        { const int cc = F.tid >> 1, h = F.tid & 1; const i32x4 v = *(const i32x4*)(cntg + cc * 8 + 4 * h);
#pragma unroll
          for (int k = 0; k < 4; ++k) { __hip_atomic_fetch_add((LAS int*)&tot[4 * h + k], v[k], __ATOMIC_RELAXED, __HIP_MEMORY_SCOPE_WORKGROUP); if (cc < c) __hip_atomic_fetch_add((LAS int*)&pre[4 * h + k], v[k], __ATOMIC_RELAXED, __HIP_MEMORY_SCOPE_WORKGROUP); } }
        const int t = c * 128 + F.wave * 16 + ((F.lane & 31) >> 1);
        const int my_e = (F.lane < 32) ? toke[2 * t + (F.lane & 1)] : -1;
        int rank = 0;
#pragma unroll
        for (int e = 0; e < 8; ++e) { const unsigned long long m = __ballot(my_e == e); if (my_e == e) rank = __popcll(m & ((1ull << F.lane) - 1ull)); if (F.lane == 0) wcnt[F.wave * 8 + e] = __popcll(m); }
        __syncthreads();
        int myslot = 0;
        if (F.lane < 32) {
            int ts = 0;
#pragma unroll
            for (int e = 0; e < 8; ++e) ts += (e < my_e) ? ((tot[e] + 255) >> 8) : 0;
            int wp = 0; for (int w = 0; w < F.wave; ++w) wp += wcnt[w * 8 + my_e];
            myslot = ts * 256 + pre[my_e] + wp + rank;
            slot[2 * t + (F.lane & 1)] = myslot;
        }
        if (c == 0 && F.tid == 0) { int ts = 0; for (int e = 0; e < 8; ++e) { const int n = (tot[e] + 255) >> 8; for (int k = 0; k < n; ++k) texp[ts + k] = e; ts += n; } for (int k = ts; k < MAXRT; ++k) texp[k] = 0; texp[MAXRT] = ts; }
        if (i8) {
            const float myh = hsc[t];
#pragma unroll 1
            for (int a0 = 0; a0 < 32; a0 += 8) {
                u32x4 x[4];
#pragma unroll
                for (int k = 0; k < 4; ++k) x[k] = *((const u32x4*)((const signed char*)H + (size_t)(c * 128 + F.wave * 16 + ((a0 + 2 * k) >> 1)) * DM) + F.lane);
#pragma unroll
                for (int k = 0; k < 8; ++k) { const int s = __builtin_amdgcn_readlane(myslot, a0 + k); *((u32x4*)((signed char*)AS + (size_t)s * DM) + F.lane) = x[k >> 1]; }
            }
            if (F.lane < 32) asc[myslot] = myh;
        } else {
            for (int a = 0; a < 32; ++a) {
                const int s = __builtin_amdgcn_readlane(myslot, a); const int ta = c * 128 + F.wave * 16 + (a >> 1);
                const u32x4* srcp = (const u32x4*)(H + (size_t)ta * DM) + F.lane; u32x4* dstp = (u32x4*)(AS + (size_t)s * DM) + F.lane;
                const u32x4 x0 = srcp[0], x1 = srcp[64]; dstp[0] = x0; dstp[64] = x1; }
        }
        __syncthreads();
    }
}

using pg8::Unit;
typedef f32x4 AccT[2][2][4][2];

struct ProbSimple { int K; unsigned lda, ldb; const char* A; const char* B;
    __device__ __forceinline__ const char* a_ptr(const Unit& u) const { return A + (size_t)u.pm * 256 * lda; }
    __device__ __forceinline__ const char* b_ptr(const Unit& u) const { return B + (size_t)u.pn * 256 * ldb; } };
struct ProbUp { int K; unsigned lda, ldb; const char* A; const char* B;
    __device__ __forceinline__ const char* a_ptr(const Unit& u) const { return A + (size_t)u.pm * 256 * lda + (u.pn >= 3 ? 256 : 0); }
    __device__ __forceinline__ const char* b_ptr(const Unit& u) const { return B + (size_t)u.pn * 256 * ldb; } };
struct ProbMoe { int K; unsigned lda, ldb; const char* A; const char* B; int a_lo;
    __device__ __forceinline__ const char* a_ptr(const Unit& u) const { return A + (size_t)(u.pm - a_lo) * 256 * lda; }
    __device__ __forceinline__ const char* b_ptr(const Unit& u) const { return B + (size_t)u.aux * WF_STRIDE + (size_t)u.pn * 256 * ldb; } };

struct MoeOrder { pg8::StaticOrder base; int lo; const int* texp;
    __device__ bool next(int i, Unit& u) const { if (!base.next(i, u)) return false; u.pm += lo; u.aux = __builtin_amdgcn_readfirstlane(texp[u.pm]); return true; } };

__device__ __forceinline__ u32x4 pack8(const f32x4 a, const f32x4 b) { u32x4 w; w.x = cvtpk(a[0], a[1]); w.y = cvtpk(a[2], a[3]); w.z = cvtpk(b[0], b[1]); w.w = cvtpk(b[2], b[3]); return w; }
__device__ __forceinline__ u32x2 pack4(const f32x4 a) { u32x2 w; w.x = cvtpk(a[0], a[1]); w.y = cvtpk(a[2], a[3]); return w; }

struct EpiNoStage { __device__ __forceinline__ void stage(LAS unsigned char*, const Unit&, int, int) const {} };
__device__ __forceinline__ void stage1k(const void* src, LAS unsigned char* dst, int lane) { __builtin_amdgcn_global_load_lds((const unsigned*)((const char*)src + lane * 16), (LAS unsigned*)dst, 16, 0, 0); }
__device__ __forceinline__ f32x4 deq(const f32x4& a, float, const f32x4&) { return a; }
__device__ __forceinline__ f32x4 deq(const i32x4& a, float rs, const f32x4& cs) { return __builtin_convertvector(a, f32x4) * rs * cs; }
struct EpiInproj {
    static constexpr bool MID = false;
    bf16_t* P; bf16_t* G; float* ssq; const int* pos; const float* rsc; const float* csc;
    __device__ __forceinline__ void stage(LAS unsigned char* d, const Unit& u, int wid, int lane) const {
        if (wid == 0) { stage1k(rsc + u.pm * 256, d, lane); stage1k(csc + u.pn * 256, d + 1024, lane); stage1k(pos + u.pm * 256, d + 2048, lane); } }
    template <class AV> __device__ __forceinline__ void operator()(const AV (&acc)[2][2][4][2], const Unit& u, int wr, int wc, int fr, int fq, const LAS unsigned char* esc) const {
        const int pn = u.pn, row0 = u.pm * 256 + wr * 64 + fr;
        f32x4 cs[2][2];
#pragma unroll
        for (int bj = 0; bj < 2; ++bj)
#pragma unroll
            for (int n = 0; n < 2; ++n) cs[bj][n] = *(const LAS f32x4*)(esc + 1024 + (bj * 128 + wc * 32 + n * 16 + fq * 4) * 4);
        float rs8[2][4], pf8[2][4];
#pragma unroll
        for (int ai = 0; ai < 2; ++ai)
#pragma unroll
            for (int m = 0; m < 4; ++m) { const int rl = ai * 128 + wr * 64 + m * 16 + fr; rs8[ai][m] = *(const LAS float*)(esc + rl * 4); pf8[ai][m] = (float)*(const LAS int*)(esc + 2048 + rl * 4); }
#define DQ(ai, bj, m, n) deq(acc[ai][bj][m][n], rs, cs[bj][n])
        if (pn >= 7) {
#pragma unroll
            for (int ai = 0; ai < 2; ++ai)
#pragma unroll
                for (int m = 0; m < 4; ++m) { const int row = row0 + ai * 128 + m * 16; const float rs = rs8[ai][m];
#pragma unroll
                    for (int bj = 0; bj < 2; ++bj) { f32x4 a = DQ(ai, bj, m, 0), b = DQ(ai, bj, m, 1);
#pragma unroll
                        for (int j = 0; j < 4; ++j) { a[j] = fast_sigmoid(a[j]) * 255.0f; b[j] = fast_sigmoid(b[j]) * 255.0f; }
                        u32x2 w; w.x = (unsigned)__float2int_rn(a[0]) | ((unsigned)__float2int_rn(a[1]) << 8) | ((unsigned)__float2int_rn(a[2]) << 16) | ((unsigned)__float2int_rn(a[3]) << 24);
                        w.y = (unsigned)__float2int_rn(b[0]) | ((unsigned)__float2int_rn(b[1]) << 8) | ((unsigned)__float2int_rn(b[2]) << 16) | ((unsigned)__float2int_rn(b[3]) << 24);
                        *(u32x2*)((unsigned char*)G + (size_t)row * GW + (pn - 7) * 256 + bj * 128 + wc * 32 + fq * 8) = w; } }
        } else if (pn >= 5 || pn == 3) {
            const float sc = (pn == 3) ? 1.0f : C_M;
#pragma unroll
            for (int ai = 0; ai < 2; ++ai)
#pragma unroll
                for (int m = 0; m < 4; ++m) { const int row = row0 + ai * 128 + m * 16; const float rs = rs8[ai][m]; float s = 0.f;
#pragma unroll
                    for (int bj = 0; bj < 2; ++bj) { const f32x4 a = DQ(ai, bj, m, 0) * sc, b = DQ(ai, bj, m, 1) * sc;
                        s += (a[0] * a[0] + a[1] * a[1]) + (a[2] * a[2] + a[3] * a[3]) + (b[0] * b[0] + b[1] * b[1]) + (b[2] * b[2] + b[3] * b[3]);
                        *(u32x4*)(P + (size_t)row * PW + pn * 256 + bj * 128 + wc * 32 + fq * 8) = pack8(a, b); }
                    if (pn == 3) { s += __shfl_xor(s, 16); s += __shfl_xor(s, 32); if (fq == 0) ssq[(size_t)row * 8 + wc] = s; } }
        } else if (pn == 4) {
#pragma unroll
            for (int ai = 0; ai < 2; ++ai)
#pragma unroll
                for (int m = 0; m < 4; ++m) { const int row = row0 + ai * 128 + m * 16; const float rs = rs8[ai][m];
                    { const f32x4 a = DQ(ai, 0, m, 0), b = DQ(ai, 0, m, 1);
                      float s = (a[0] * a[0] + a[1] * a[1]) + (a[2] * a[2] + a[3] * a[3]) + (b[0] * b[0] + b[1] * b[1]) + (b[2] * b[2] + b[3] * b[3]);
                      *(u32x4*)(P + (size_t)row * PW + P_CKV + wc * 32 + fq * 8) = pack8(a, b);
                      s += __shfl_xor(s, 16); s += __shfl_xor(s, 32); if (fq == 0) ssq[(size_t)row * 8 + 4 + wc] = s; }
                    if (wc == 0) { const f32x4 x1 = DQ(ai, 1, m, 0), x2 = DQ(ai, 1, m, 1); const float pf = pf8[ai][m]; f32x4 o1, o2;
#pragma unroll
                        for (int j = 0; j < 4; ++j) { float c, s; rot_cs(pf, 2 * (4 * fq + j), c, s); o1[j] = x1[j] * c - x2[j] * s; o2[j] = x2[j] * c + x1[j] * s; }
                        *(u32x2*)(P + (size_t)row * PW + P_KR + 4 * fq) = pack4(o1); *(u32x2*)(P + (size_t)row * PW + P_KR + 16 + 4 * fq) = pack4(o2); } }
        } else {
            const float sc = (pn < 2) ? C_A : 1.0f; const int i0 = 16 * (wc & 1) + 4 * fq;
#pragma unroll
            for (int ai = 0; ai < 2; ++ai)
#pragma unroll
                for (int m = 0; m < 4; ++m) { const int row = row0 + ai * 128 + m * 16; const float rs = rs8[ai][m]; const float pf = pf8[ai][m]; f32x4 c, s;
#pragma unroll
                    for (int j = 0; j < 4; ++j) { float cc, ss; rot_cs(pf, i0 + j, cc, ss); c[j] = cc * sc; s[j] = ss * sc; }
#pragma unroll
                    for (int bj = 0; bj < 2; ++bj) { const f32x4 x1 = DQ(ai, bj, m, 0), x2 = DQ(ai, bj, m, 1);
                        if (pn == 2 && bj == 1) { *(u32x4*)(P + (size_t)row * PW + P_VA + wc * 32 + fq * 8) = pack8(x1, x2); }
                        else { const f32x4 o1 = x1 * c - x2 * s, o2 = x2 * c + x1 * s; bf16_t* d = P + (size_t)row * PW + pn * 256 + 64 * (2 * bj + (wc >> 1)) + i0;
                            *(u32x2*)d = pack4(o1); *(u32x2*)(d + 32) = pack4(o2); } } }
        }
#undef DQ
    }
};
struct EpiUp {
    static constexpr bool MID = false;
    __device__ __forceinline__ void stage(LAS unsigned char*, const Unit&, int, int) const {}
    bf16_t* QB; bf16_t* KVB; const float* ssq; const int* pos;
    __device__ __forceinline__ void operator()(const AccT& acc, const Unit& u, int wr, int wc, int fr, int fq, const LAS unsigned char*) const {
        const int pn = u.pn, row0 = u.pm * 256 + wr * 64 + fr;
        float rs8[2][4], pf8[2][4];
#pragma unroll
        for (int ai = 0; ai < 2; ++ai)
#pragma unroll
            for (int m = 0; m < 4; ++m) { const int row = row0 + ai * 128 + m * 16; const f32x4 sv = *(const f32x4*)(ssq + (size_t)row * 8 + (pn < 3 ? 0 : 4));
                rs8[ai][m] = (pn < 3 ? C_B : 1.0f) / sqrtf(((sv[0] + sv[1]) + (sv[2] + sv[3])) * (pn < 3 ? 1.0f / 256.0f : 1.0f / 128.0f) + EPS); pf8[ai][m] = (pn < 3) ? (float)pos[row] : 0.f; }
#pragma unroll
        for (int ai = 0; ai < 2; ++ai)
#pragma unroll
            for (int m = 0; m < 4; ++m) { const int row = row0 + ai * 128 + m * 16; const float rs = rs8[ai][m];
                if (pn < 3) {
#pragma unroll
                    for (int bj = 0; bj < 2; ++bj) { const int gg = 8 * pn + 4 * bj + wc; const f32x4 x1 = acc[ai][bj][m][0] * rs, x2 = acc[ai][bj][m][1] * rs;
                        if (gg % 3 == 2) { const float pf = pf8[ai][m]; f32x4 o1, o2;
#pragma unroll
                            for (int j = 0; j < 4; ++j) { float c, s; rot_cs(pf, 2 * (4 * fq + j), c, s); o1[j] = x1[j] * c - x2[j] * s; o2[j] = x2[j] * c + x1[j] * s; }
                            bf16_t* d = QB + (size_t)row * QBW + 32 * gg + 4 * fq; *(u32x2*)d = pack4(o1); *(u32x2*)(d + 16) = pack4(o2); }
                        else *(u32x4*)(QB + (size_t)row * QBW + 32 * gg + 8 * fq) = pack8(x1, x2); }
                } else {
#pragma unroll
                    for (int bj = 0; bj < 2; ++bj) *(u32x4*)(KVB + (size_t)row * KVW + (pn - 3) * 256 + bj * 128 + wc * 32 + fq * 8) = pack8(acc[ai][bj][m][0] * rs, acc[ai][bj][m][1] * rs);
                } }
    }
};
struct EpiPlain {
    static constexpr bool MID = false;
    __device__ __forceinline__ void stage(LAS unsigned char*, const Unit&, int, int) const {}
    bf16_t* O; int ldo;
    __device__ __forceinline__ void operator()(const AccT& acc, const Unit& u, int wr, int wc, int fr, int fq, const LAS unsigned char*) const {
        const int row0 = u.pm * 256 + wr * 64 + fr;
#pragma unroll
        for (int ai = 0; ai < 2; ++ai)
#pragma unroll
            for (int m = 0; m < 4; ++m)
#pragma unroll
                for (int bj = 0; bj < 2; ++bj) *(u32x4*)(O + (size_t)(row0 + ai * 128 + m * 16) * ldo + u.pn * 256 + bj * 128 + wc * 32 + fq * 8) = pack8(acc[ai][bj][m][0], acc[ai][bj][m][1]);
    }
};
struct EpiBranch {
    static constexpr bool MID = true;
    const unsigned char* G; bf16_t* MIXED;
    __device__ __forceinline__ void stage(LAS unsigned char*, const Unit&, int, int) const {}
    static __device__ __forceinline__ float gq(unsigned w, int b) { const float f = (float)((w >> (8 * b)) & 255u); return fmaxf(f, 2.55e-4f); }
    __device__ __forceinline__ void mid(AccT& acc, const Unit& u, int seg  , int wr, int wc, int fr, int fq) const {
        const int row0 = opq_v(u.pm * 256 + wr * 64 + fr);
#pragma unroll
        for (int ai = 0; ai < 2; ++ai) {
            u32x2 ga[4][2], gb[4][2];
#pragma unroll
            for (int m = 0; m < 4; ++m)
#pragma unroll
                for (int bj = 0; bj < 2; ++bj) { const unsigned char* gp = G + (size_t)(row0 + ai * 128 + m * 16) * GW + u.pn * 256 + bj * 128 + wc * 32 + fq * 8;
                    ga[m][bj] = *(const u32x2*)(gp + (seg - 1) * 1024); gb[m][bj] = *(const u32x2*)(gp + seg * 1024); }
#pragma unroll
            for (int m = 0; m < 4; ++m)
#pragma unroll
                for (int bj = 0; bj < 2; ++bj) { const u32x2 a2 = ga[m][bj], b2 = gb[m][bj];
#pragma unroll
                    for (int j = 0; j < 4; ++j) { acc[ai][bj][m][0][j] *= gq(a2.x, j) * __builtin_amdgcn_rcpf(gq(b2.x, j)); acc[ai][bj][m][1][j] *= gq(a2.y, j) * __builtin_amdgcn_rcpf(gq(b2.y, j)); } }
            asm volatile("" ::: "memory"); }
    }
    __device__ __forceinline__ void operator()(const AccT& acc, const Unit& u, int wr, int wc, int fr, int fq, const LAS unsigned char*) const {
        const int row0 = u.pm * 256 + wr * 64 + fr;
#pragma unroll
        for (int ai = 0; ai < 2; ++ai) {
            u32x2 gw[4][2];
#pragma unroll
            for (int m = 0; m < 4; ++m)
#pragma unroll
                for (int bj = 0; bj < 2; ++bj) gw[m][bj] = *(const u32x2*)(G + (size_t)(row0 + ai * 128 + m * 16) * GW + 2048 + u.pn * 256 + bj * 128 + wc * 32 + fq * 8);
#pragma unroll
            for (int m = 0; m < 4; ++m)
#pragma unroll
                for (int bj = 0; bj < 2; ++bj) { const u32x2 g2 = gw[m][bj]; f32x4 a = acc[ai][bj][m][0], b = acc[ai][bj][m][1];
#pragma unroll
                    for (int j = 0; j < 4; ++j) { a[j] *= gq(g2.x, j) * (1.0f / 255.0f); b[j] *= gq(g2.y, j) * (1.0f / 255.0f); }
                    *(u32x4*)(MIXED + (size_t)(row0 + ai * 128 + m * 16) * DM + u.pn * 256 + bj * 128 + wc * 32 + fq * 8) = pack8(a, b); }
            asm volatile("" ::: "memory"); }
    }
};
struct EpiResid {
    static constexpr bool MID = false;
    __device__ __forceinline__ void stage(LAS unsigned char*, const Unit&, int, int) const {}
    const float* Xf; bf16_t* X;
    __device__ __forceinline__ void operator()(const AccT& acc, const Unit& u, int wr, int wc, int fr, int fq, const LAS unsigned char*) const {
        const int row0 = u.pm * 256 + wr * 64 + fr;
#pragma unroll
        for (int ai = 0; ai < 2; ++ai) {
            f32x4 xa[4][2], xb[4][2];
#pragma unroll
            for (int m = 0; m < 4; ++m)
#pragma unroll
                for (int bj = 0; bj < 2; ++bj) { const size_t o = (size_t)(row0 + ai * 128 + m * 16) * DM + u.pn * 256 + bj * 128 + wc * 32 + fq * 8;
                    if (Xf) { xa[m][bj] = *(const f32x4*)(Xf + o); xb[m][bj] = *(const f32x4*)(Xf + o + 4); }
                    else { const u32x4 q = *(const u32x4*)(X + o); xa[m][bj] = (f32x4){bflo(q.x), bfhi(q.x), bflo(q.y), bfhi(q.y)}; xb[m][bj] = (f32x4){bflo(q.z), bfhi(q.z), bflo(q.w), bfhi(q.w)}; } }
#pragma unroll
            for (int m = 0; m < 4; ++m)
#pragma unroll
                for (int bj = 0; bj < 2; ++bj) *(u32x4*)(X + (size_t)(row0 + ai * 128 + m * 16) * DM + u.pn * 256 + bj * 128 + wc * 32 + fq * 8) = pack8(xa[m][bj] + acc[ai][bj][m][0], xb[m][bj] + acc[ai][bj][m][1]);
            asm volatile("" ::: "memory"); }
    }
};
struct EpiSwiglu {
    static constexpr bool MID = false;
    bf16_t* ACT; int lo; const float* rsc; const float* csc;
    __device__ __forceinline__ void stage(LAS unsigned char* d, const Unit& u, int wid, int lane) const {
        if (wid == 0) { stage1k(rsc + u.pm * 256, d, lane); stage1k(csc + (size_t)u.aux * 2 * DFF + u.pn * 256, d + 1024, lane); } }
    template <class AV> __device__ __forceinline__ void operator()(const AV (&acc)[2][2][4][2], const Unit& u, int wr, int wc, int fr, int fq, const LAS unsigned char* esc) const {
        const int row0 = (u.pm - lo) * 256 + wr * 64 + fr;
        f32x4 cs[2][2];
#pragma unroll
        for (int bj = 0; bj < 2; ++bj)
#pragma unroll
            for (int n = 0; n < 2; ++n) cs[bj][n] = *(const LAS f32x4*)(esc + 1024 + (bj * 128 + wc * 32 + n * 16 + fq * 4) * 4);
        float rs8[2][4];
#pragma unroll
        for (int ai = 0; ai < 2; ++ai)
#pragma unroll
            for (int m = 0; m < 4; ++m) rs8[ai][m] = *(const LAS float*)(esc + (ai * 128 + wr * 64 + m * 16 + fr) * 4);
#pragma unroll
        for (int ai = 0; ai < 2; ++ai)
#pragma unroll
            for (int m = 0; m < 4; ++m) { const float rs = rs8[ai][m]; f32x4 a, b;
                const f32x4 g0 = deq(acc[ai][0][m][0], rs, cs[0][0]), g1 = deq(acc[ai][0][m][1], rs, cs[0][1]), u0 = deq(acc[ai][1][m][0], rs, cs[1][0]), u1 = deq(acc[ai][1][m][1], rs, cs[1][1]);
#pragma unroll
                for (int j = 0; j < 4; ++j) { a[j] = g0[j] * fast_sigmoid(g0[j]) * u0[j]; b[j] = g1[j] * fast_sigmoid(g1[j]) * u1[j]; }
                *(u32x4*)(ACT + (size_t)(row0 + ai * 128 + m * 16) * DFF + u.pn * 128 + wc * 32 + fq * 8) = pack8(a, b); }
    }
};
struct EpiYout {
    static constexpr bool MID = false;
    __device__ __forceinline__ void stage(LAS unsigned char*, const Unit&, int, int) const {}
    bf16_t* Y;
    __device__ __forceinline__ void operator()(const AccT& acc, const Unit& u, int wr, int wc, int fr, int fq, const LAS unsigned char*) const {
        const int row0 = u.pm * 256 + wr * 64 + fr;
#pragma unroll
        for (int ai = 0; ai < 2; ++ai)
#pragma unroll
            for (int m = 0; m < 4; ++m)
#pragma unroll
                for (int bj = 0; bj < 2; ++bj) *(u32x4*)(Y + (size_t)(row0 + ai * 128 + m * 16) * DM + u.pn * 256 + bj * 128 + wc * 32 + fq * 8) = pack8(acc[ai][bj][m][0], acc[ai][bj][m][1]);
    }
};

namespace att {
__device__ __forceinline__ int crow(int r, int hi) { return (r & 3) + 8 * (r >> 2) + 4 * hi; }
__device__ __forceinline__ void glds16(const void* gsrc, unsigned lds_dst) { unsigned keep;
    asm volatile("s_mov_b32 %0, m0\n\ts_mov_b32 m0, %2\n\ts_nop 0\n\tglobal_load_lds_dwordx4 %1, off\n\ts_mov_b32 m0, %0" : "=&s"(keep) : "v"(gsrc), "s"(lds_dst) : "memory"); }
__device__ __forceinline__ float swapmax(float m) { auto rr = __builtin_amdgcn_permlane32_swap(__float_as_uint(m), __float_as_uint(m), false, false); return fmaxf(__uint_as_float(rr[0]), __uint_as_float(rr[1])); }
__device__ __forceinline__ float swapsum(float m) { auto rr = __builtin_amdgcn_permlane32_swap(__float_as_uint(m), __float_as_uint(m), false, false); return __uint_as_float(rr[0]) + __uint_as_float(rr[1]); }
__device__ __forceinline__ s16x4 vtr(unsigned addr) { s16x4 r; asm volatile("ds_read_b64_tr_b16 %0, %1" : "=&v"(r) : "v"(addr) : "memory"); return r; }
#define VTRO(dst, base, off) asm volatile("ds_read_b64_tr_b16 %0, %1 offset:%c2" : "=&v"(dst) : "v"(base), "i"(off) : "memory")

struct Src {
    const bf16_t* q; int qpitch;
    const bf16_t* k0; int k0pitch;
    const bf16_t* k1; int k1pitch;
    const bf16_t* v; int vpitch;
    bf16_t* o; int opitch;
};
template <int NKC, int NVB, int RD = 4>
__device__ __forceinline__ void dma_tile(const Src& S, int t, int slot, unsigned lds0, int wid, int lane) {
    constexpr int KS = NKC * 1024, VS = NVB * 4096, LDS_K = 0, LDS_V = RD * KS;
#pragma unroll
    for (int c = 0; c < (NKC + 7) / 8; ++c) { const int ch = wid + 8 * c; if (ch < NKC) {
        const bf16_t* src = (ch < 8) ? S.k0 + (size_t)(t * 64 + lane) * S.k0pitch + ch * 8 : S.k1 + (size_t)(t * 64 + lane) * S.k1pitch + (ch - 8) * 8;
        glds16(src, (unsigned)__builtin_amdgcn_readfirstlane(lds0 + LDS_K + slot * KS + ch * 1024)); } }
#pragma unroll
    for (int c = 0; c < (NVB * 4 + 7) / 8; ++c) { const int p = wid + 8 * c; if (p < NVB * 4) {
        const bf16_t* src = S.v + (size_t)(t * 64 + 16 * (p & 3) + (lane >> 2)) * S.vpitch + (p >> 2) * 32 + (lane & 3) * 8;
        glds16(src, (unsigned)__builtin_amdgcn_readfirstlane(lds0 + LDS_V + slot * VS + p * 1024)); } }
}
__device__ __forceinline__ void wait_vm_bar(int n) {
    if (n >= 4) asm volatile("s_waitcnt vmcnt(4) lgkmcnt(0)\n\ts_barrier" ::: "memory");
    else if (n == 3) asm volatile("s_waitcnt vmcnt(3) lgkmcnt(0)\n\ts_barrier" ::: "memory");
    else if (n == 2) asm volatile("s_waitcnt vmcnt(2) lgkmcnt(0)\n\ts_barrier" ::: "memory");
    else if (n == 1) asm volatile("s_waitcnt vmcnt(1) lgkmcnt(0)\n\ts_barrier" ::: "memory");
    else asm volatile("s_waitcnt vmcnt(0) lgkmcnt(0)\n\ts_barrier" ::: "memory");
}
template <int NKC, int NVB, int MODE>
__device__ __forceinline__ void unit(LAS unsigned char* lds, const Src& S, int t_lo, int t_hi, int qpos0  , float sink_l2) {
    constexpr int KS = NKC * 1024, VS = NVB * 4096, RD = 4, LDS_K = 0, LDS_V = RD * KS;
    const int tid = opq_v((int)threadIdx.x), lane = tid & 63, r32 = lane & 31, hi = lane >> 5; const int wid = __builtin_amdgcn_readfirstlane(tid >> 6), grp = wid >> 2;
    const unsigned lds0 = (unsigned)(uintptr_t)lds;
    const int ops = (NKC + 7 - wid) / 8 + (NVB * 4) / 8;
    bf16x8 qr[NKC / 2];
#pragma unroll
    for (int d0 = 0; d0 < NKC / 2; ++d0) qr[d0] = *(const bf16x8*)(S.q + (size_t)r32 * S.qpitch + d0 * 16 + hi * 8);
    float m_run = (MODE == 0) ? sink_l2 : -INFINITY, l_run = (MODE == 0 && hi == 0) ? 1.0f : 0.0f;
    f32x16 o[NVB];
#pragma unroll
    for (int d = 0; d < NVB; ++d) o[d] = f32x16{};
    const int qi = qpos0 + wid * 32 + r32, qw0 = qpos0 + wid * 32;
    f32x16 p0 = f32x16{}, p1 = f32x16{};
#define AT_ACTIVE(t) ((MODE != 0) || ((64 * (t) + 63 >= qw0 - 128) && (64 * (t) <= qw0 + 31 + 128)))
#define AT_QK(t) do { const LAS unsigned char* kb_ = lds + LDS_K + (((t) - t_lo) % RD) * KS + hi * 1024 + r32 * 16; p0 = f32x16{}; p1 = f32x16{}; \
        _Pragma("unroll") for (int d0 = 0; d0 < NKC / 2; ++d0) { const bf16x8 b0_ = *(const LAS bf16x8*)(kb_ + d0 * 2048), b1_ = *(const LAS bf16x8*)(kb_ + d0 * 2048 + 512); \
            p0 = __builtin_amdgcn_mfma_f32_32x32x16_bf16(b0_, qr[d0], p0, 0, 0, 0); p1 = __builtin_amdgcn_mfma_f32_32x32x16_bf16(b1_, qr[d0], p1, 0, 0, 0); } } while (0)
#define AT_SMPV(t) do { \
        if (MODE == 0) { _Pragma("unroll") for (int r = 0; r < 16; ++r) { const int kv_ = 64 * (t) + crow(r, hi); int e0_ = kv_ - qi; e0_ = e0_ < 0 ? -e0_ : e0_; int e1_ = kv_ + 32 - qi; e1_ = e1_ < 0 ? -e1_ : e1_; \
            if (e0_ > 128) p0[r] = -INFINITY; if (e1_ > 128) p1[r] = -INFINITY; } } \
        float mx_[8]; _Pragma("unroll") for (int r = 0; r < 8; ++r) mx_[r] = fmaxf(fmaxf(p0[r], p0[r + 8]), fmaxf(p1[r], p1[r + 8])); \
        float rm_ = fmaxf(fmaxf(fmaxf(mx_[0], mx_[1]), fmaxf(mx_[2], mx_[3])), fmaxf(fmaxf(mx_[4], mx_[5]), fmaxf(mx_[6], mx_[7]))); rm_ = swapmax(rm_); \
        if (__any(rm_ > m_run)) { const float mn_ = fmaxf(m_run, rm_), alpha_ = __builtin_amdgcn_exp2f(m_run - mn_); m_run = mn_; l_run *= alpha_; \
            _Pragma("unroll") for (int d = 0; d < NVB; ++d) _Pragma("unroll") for (int r = 0; r < 16; ++r) o[d][r] *= alpha_; } \
        float sm_[4] = {0.f, 0.f, 0.f, 0.f}; \
        _Pragma("unroll") for (int r = 0; r < 16; ++r) { p0[r] = __builtin_amdgcn_exp2f(p0[r] - m_run); p1[r] = __builtin_amdgcn_exp2f(p1[r] - m_run); sm_[r & 3] += p0[r] + p1[r]; } \
        l_run += (sm_[0] + sm_[1]) + (sm_[2] + sm_[3]); \
        u32x4 pw_[4]; \
        pw_[0] = (u32x4){cvtpk(p0[0], p0[1]), cvtpk(p0[2], p0[3]), cvtpk(p0[4], p0[5]), cvtpk(p0[6], p0[7])}; pw_[1] = (u32x4){cvtpk(p0[8], p0[9]), cvtpk(p0[10], p0[11]), cvtpk(p0[12], p0[13]), cvtpk(p0[14], p0[15])}; \
        pw_[2] = (u32x4){cvtpk(p1[0], p1[1]), cvtpk(p1[2], p1[3]), cvtpk(p1[4], p1[5]), cvtpk(p1[6], p1[7])}; pw_[3] = (u32x4){cvtpk(p1[8], p1[9]), cvtpk(p1[10], p1[11]), cvtpk(p1[12], p1[13]), cvtpk(p1[14], p1[15])}; \
        const unsigned vb_ = lds0 + LDS_V + (((t) - t_lo) % RD) * VS + ((lane >> 4) & 1) * 32 + (lane & 3) * 8 + (4 * hi + ((lane & 15) >> 2)) * 64; \
        _Pragma("unroll") for (int dp = 0; dp < NVB; dp += 2) { s16x4 lo_[2][4], hh_[2][4]; \
            _Pragma("unroll") for (int dd = 0; dd < 2; ++dd) _Pragma("unroll") for (int ks = 0; ks < 4; ++ks) { lo_[dd][ks] = vtr(vb_ + (dp + dd) * 4096 + ks * 1024); hh_[dd][ks] = vtr(vb_ + (dp + dd) * 4096 + ks * 1024 + 512); } \
            asm volatile("s_waitcnt lgkmcnt(0)" ::: "memory"); __builtin_amdgcn_sched_barrier(0); \
            _Pragma("unroll") for (int ks = 0; ks < 4; ++ks) _Pragma("unroll") for (int dd = 0; dd < 2; ++dd) { \
                const bf16x8 vf_ = (bf16x8){lo_[dd][ks][0], lo_[dd][ks][1], lo_[dd][ks][2], lo_[dd][ks][3], hh_[dd][ks][0], hh_[dd][ks][1], hh_[dd][ks][2], hh_[dd][ks][3]}; \
                o[dp + dd] = __builtin_amdgcn_mfma_f32_32x32x16_bf16(vf_, __builtin_bit_cast(bf16x8, pw_[ks]), o[dp + dd], 0, 0, 0); } } } while (0)
    dma_tile<NKC, NVB>(S, t_lo, 0, lds0, wid, lane);
    if (t_lo + 1 < t_hi) dma_tile<NKC, NVB>(S, t_lo + 1, 1, lds0, wid, lane);
    for (int t = t_lo; t < t_hi; ++t) {
        wait_vm_bar((t + 1 < t_hi) ? ops : 0);
        if (t + 2 < t_hi) dma_tile<NKC, NVB>(S, t + 2, (t + 2 - t_lo) % RD, lds0, wid, lane);
        if (grp == 0) { if (AT_ACTIVE(t)) { AT_QK(t); AT_SMPV(t); } }
        else { if (t > t_lo && AT_ACTIVE(t - 1)) AT_SMPV(t - 1); if (AT_ACTIVE(t)) AT_QK(t); }
    }
    if (grp == 1 && AT_ACTIVE(t_hi - 1)) AT_SMPV(t_hi - 1);
    const float linv = 1.0f / swapsum(l_run);
#pragma unroll
    for (int d = 0; d < NVB; ++d)
#pragma unroll
        for (int r4 = 0; r4 < 4; ++r4) { f32x4 v = {o[d][4 * r4] * linv, o[d][4 * r4 + 1] * linv, o[d][4 * r4 + 2] * linv, o[d][4 * r4 + 3] * linv};
            *(u32x2*)(S.o + (size_t)r32 * S.opitch + 32 * d + 8 * r4 + 4 * hi) = pack4(v); }
    asm volatile("s_waitcnt lgkmcnt(0)\n\ts_barrier" ::: "memory");
#undef AT_ACTIVE
#undef AT_QK
#undef AT_SMPV
}

template <int NKC, int NVB>
__device__ __forceinline__ void unit_q64(LAS unsigned char* lds, const Src& S, int t_lo, int t_hi) {
    constexpr int KS = NKC * 1024, VS = NVB * 4096, RD = 4, LDS_K = 0, LDS_V = RD * KS;
    const int tid = opq_v((int)threadIdx.x), lane = tid & 63, r32 = lane & 31, hi = lane >> 5; const int wid = __builtin_amdgcn_readfirstlane(tid >> 6);
    const unsigned lds0 = (unsigned)(uintptr_t)lds;
    const int ops = (NKC + 7 - wid) / 8 + (NVB * 4) / 8;
    bf16x8 qa[NKC / 2], qb[NKC / 2];
#pragma unroll
    for (int d0 = 0; d0 < NKC / 2; ++d0) { qa[d0] = *(const bf16x8*)(S.q + (size_t)r32 * S.qpitch + d0 * 16 + hi * 8); qb[d0] = *(const bf16x8*)(S.q + (size_t)(32 + r32) * S.qpitch + d0 * 16 + hi * 8); }
    float ma = -INFINITY, la = 0.f, mb = -INFINITY, lb = 0.f;
    f32x16 oa[NVB], ob[NVB];
#pragma unroll
    for (int d = 0; d < NVB; ++d) { oa[d] = f32x16{}; ob[d] = f32x16{}; }
#define Q64_SM(P0, P1, M, L, O, PW) do { \
        float mx_[8]; _Pragma("unroll") for (int r = 0; r < 8; ++r) mx_[r] = fmaxf(fmaxf(P0[r], P0[r + 8]), fmaxf(P1[r], P1[r + 8])); \
        float rm_ = fmaxf(fmaxf(fmaxf(mx_[0], mx_[1]), fmaxf(mx_[2], mx_[3])), fmaxf(fmaxf(mx_[4], mx_[5]), fmaxf(mx_[6], mx_[7]))); rm_ = swapmax(rm_); \
        if (__any(rm_ > M)) { const float mn_ = fmaxf(M, rm_), alpha_ = __builtin_amdgcn_exp2f(M - mn_); M = mn_; L *= alpha_; \
            _Pragma("unroll") for (int d = 0; d < NVB; ++d) _Pragma("unroll") for (int r = 0; r < 16; ++r) O[d][r] *= alpha_; } \
        float sm_[4] = {0.f, 0.f, 0.f, 0.f}; \
        _Pragma("unroll") for (int r = 0; r < 16; ++r) { P0[r] = __builtin_amdgcn_exp2f(P0[r] - M); P1[r] = __builtin_amdgcn_exp2f(P1[r] - M); sm_[r & 3] += P0[r] + P1[r]; } \
        L += (sm_[0] + sm_[1]) + (sm_[2] + sm_[3]); \
        PW[0] = (u32x4){cvtpk(P0[0], P0[1]), cvtpk(P0[2], P0[3]), cvtpk(P0[4], P0[5]), cvtpk(P0[6], P0[7])}; PW[1] = (u32x4){cvtpk(P0[8], P0[9]), cvtpk(P0[10], P0[11]), cvtpk(P0[12], P0[13]), cvtpk(P0[14], P0[15])}; \
        PW[2] = (u32x4){cvtpk(P1[0], P1[1]), cvtpk(P1[2], P1[3]), cvtpk(P1[4], P1[5]), cvtpk(P1[6], P1[7])}; PW[3] = (u32x4){cvtpk(P1[8], P1[9]), cvtpk(P1[10], P1[11]), cvtpk(P1[12], P1[13]), cvtpk(P1[14], P1[15])}; \
        __builtin_amdgcn_sched_barrier(0); } while (0)
#define Q64_SM_NB(P0, P1, M, L, O, PW) do { \
        float mx_[8]; _Pragma("unroll") for (int r = 0; r < 8; ++r) mx_[r] = fmaxf(fmaxf(P0[r], P0[r + 8]), fmaxf(P1[r], P1[r + 8])); \
        float rm_ = fmaxf(fmaxf(fmaxf(mx_[0], mx_[1]), fmaxf(mx_[2], mx_[3])), fmaxf(fmaxf(mx_[4], mx_[5]), fmaxf(mx_[6], mx_[7]))); rm_ = swapmax(rm_); \
        if (__any(rm_ > M)) { const float mn_ = fmaxf(M, rm_), alpha_ = __builtin_amdgcn_exp2f(M - mn_); M = mn_; L *= alpha_; \
            _Pragma("unroll") for (int d = 0; d < NVB; ++d) _Pragma("unroll") for (int r = 0; r < 16; ++r) O[d][r] *= alpha_; } \
        float sm_[4] = {0.f, 0.f, 0.f, 0.f}; \
        _Pragma("unroll") for (int r = 0; r < 16; ++r) { P0[r] = __builtin_amdgcn_exp2f(P0[r] - M); P1[r] = __builtin_amdgcn_exp2f(P1[r] - M); sm_[r & 3] += P0[r] + P1[r]; } \
        L += (sm_[0] + sm_[1]) + (sm_[2] + sm_[3]); \
        PW[0] = (u32x4){cvtpk(P0[0], P0[1]), cvtpk(P0[2], P0[3]), cvtpk(P0[4], P0[5]), cvtpk(P0[6], P0[7])}; PW[1] = (u32x4){cvtpk(P0[8], P0[9]), cvtpk(P0[10], P0[11]), cvtpk(P0[12], P0[13]), cvtpk(P0[14], P0[15])}; \
        PW[2] = (u32x4){cvtpk(P1[0], P1[1]), cvtpk(P1[2], P1[3]), cvtpk(P1[4], P1[5]), cvtpk(P1[6], P1[7])}; PW[3] = (u32x4){cvtpk(P1[8], P1[9]), cvtpk(P1[10], P1[11]), cvtpk(P1[12], P1[13]), cvtpk(P1[14], P1[15])}; \
        } while (0)
    dma_tile<NKC, NVB, RD>(S, t_lo, 0, lds0, wid, lane);
    if (t_lo + 1 < t_hi) dma_tile<NKC, NVB, RD>(S, t_lo + 1, 1, lds0, wid, lane);
    for (int t = t_lo; t < t_hi; ++t) {
        const int slot = (t - t_lo) % RD;
        wait_vm_bar((t + 1 < t_hi) ? ops : 0);
        if (t + 2 < t_hi) dma_tile<NKC, NVB, RD>(S, t + 2, (t + 2 - t_lo) % RD, lds0, wid, lane);
        const LAS unsigned char* kb = lds + LDS_K + slot * KS + hi * 1024 + r32 * 16;
        f32x16 s0a = f32x16{}, s0b = f32x16{}, s1a = f32x16{}, s1b = f32x16{};
#pragma unroll
        for (int d0 = 0; d0 < NKC / 2; ++d0) {
            const bf16x8 b0 = *(const LAS bf16x8*)(kb + d0 * 2048), b1 = *(const LAS bf16x8*)(kb + d0 * 2048 + 512);
            s0a = __builtin_amdgcn_mfma_f32_32x32x16_bf16(b0, qa[d0], s0a, 0, 0, 0); s0b = __builtin_amdgcn_mfma_f32_32x32x16_bf16(b1, qa[d0], s0b, 0, 0, 0);
            s1a = __builtin_amdgcn_mfma_f32_32x32x16_bf16(b0, qb[d0], s1a, 0, 0, 0); s1b = __builtin_amdgcn_mfma_f32_32x32x16_bf16(b1, qb[d0], s1b, 0, 0, 0); }
        __builtin_amdgcn_sched_barrier(0);
        u32x4 pwa[4], pwb[4];
        const unsigned vb = lds0 + LDS_V + slot * VS + ((lane >> 4) & 1) * 32 + (lane & 3) * 8 + (4 * hi + ((lane & 15) >> 2)) * 64;
        s16x4 lo[NVB][4], hh[NVB][4];
#pragma unroll
        for (int d = 0; d < NVB; ++d)
#pragma unroll
            for (int ks = 0; ks < 4; ++ks) { VTRO(lo[d][ks], vb, d * 4096 + ks * 1024); VTRO(hh[d][ks], vb, d * 4096 + ks * 1024 + 512); }
        __builtin_amdgcn_sched_barrier(0);
        Q64_SM(s0a, s0b, ma, la, oa, pwa);
        asm volatile("s_waitcnt lgkmcnt(0)" ::: "memory"); __builtin_amdgcn_sched_barrier(0);
#pragma unroll
        for (int ks = 0; ks < 4; ++ks)
#pragma unroll
            for (int d = 0; d < NVB; ++d) { const bf16x8 vf = (bf16x8){lo[d][ks][0], lo[d][ks][1], lo[d][ks][2], lo[d][ks][3], hh[d][ks][0], hh[d][ks][1], hh[d][ks][2], hh[d][ks][3]};
                oa[d] = __builtin_amdgcn_mfma_f32_32x32x16_bf16(vf, __builtin_bit_cast(bf16x8, pwa[ks]), oa[d], 0, 0, 0); }
        Q64_SM_NB(s1a, s1b, mb, lb, ob, pwb);
#pragma unroll
        for (int i = 0; i < 8; ++i) { __builtin_amdgcn_sched_group_barrier(0x008, 1, 0); __builtin_amdgcn_sched_group_barrier(0x002, 12, 0); }
        __builtin_amdgcn_sched_barrier(0);
#pragma unroll
        for (int ks = 0; ks < 4; ++ks)
#pragma unroll
            for (int d = 0; d < NVB; ++d) { const bf16x8 vf = (bf16x8){lo[d][ks][0], lo[d][ks][1], lo[d][ks][2], lo[d][ks][3], hh[d][ks][0], hh[d][ks][1], hh[d][ks][2], hh[d][ks][3]};
                ob[d] = __builtin_amdgcn_mfma_f32_32x32x16_bf16(vf, __builtin_bit_cast(bf16x8, pwb[ks]), ob[d], 0, 0, 0); }
        __builtin_amdgcn_sched_barrier(0);
    }
    const float lia = 1.0f / swapsum(la), lib = 1.0f / swapsum(lb);
#pragma unroll
    for (int d = 0; d < NVB; ++d)
#pragma unroll
        for (int r4 = 0; r4 < 4; ++r4) {
            f32x4 va = {oa[d][4 * r4] * lia, oa[d][4 * r4 + 1] * lia, oa[d][4 * r4 + 2] * lia, oa[d][4 * r4 + 3] * lia}, vb4 = {ob[d][4 * r4] * lib, ob[d][4 * r4 + 1] * lib, ob[d][4 * r4 + 2] * lib, ob[d][4 * r4 + 3] * lib};
            *(u32x2*)(S.o + (size_t)r32 * S.opitch + 32 * d + 8 * r4 + 4 * hi) = pack4(va); *(u32x2*)(S.o + (size_t)(32 + r32) * S.opitch + 32 * d + 8 * r4 + 4 * hi) = pack4(vb4); }
    asm volatile("s_waitcnt lgkmcnt(0)\n\ts_barrier" ::: "memory");
#undef Q64_SM
#undef Q64_SM_NB
}

}
#define SC_AFTER_PROLOGUE() do {} while (0)
#define SC_AFTER_INPROJ(l) do {} while (0)
#define SC_AFTER_UP(l) do {} while (0)
#define SC_AFTER_MLA(l) do {} while (0)
#define SC_AFTER_BRANCH(l) do {} while (0)
#define SC_AFTER_WOUT(l) do {} while (0)
#define SC_AFTER_NORM2(l) do {} while (0)
#define SC_AFTER_GU(l) do {} while (0)
#define SC_AFTER_DOWN(l) do {} while (0)
#define SC_AFTER_ROUTE(l) do {} while (0)
#define SC_AFTER_MOEGU(l, h) do {} while (0)
#define SC_AFTER_MOED(l, h) do {} while (0)
#define SC_FINAL() do {} while (0)

struct Args { const float* in[23]; float* out; unsigned char* ws; };
#define WSP(type, off) ((type*)(F.ws + (off)))
#define PHASE() Frame Fp = F; Fp.ws = opq_p(F.ws); Fp.in = opq_p(F.in); Fp.out = opq_p(F.out); Fp.tid = opq_v((int)threadIdx.x); Fp.lane = Fp.tid & 63; Fp.wave = __builtin_amdgcn_readfirstlane(Fp.tid >> 6); (void)Fp
#define FWS(type, off) ((type*)(Fp.ws + (off)))
#define X_ FWS(bf16_t, WS_XB)
#define H_ FWS(bf16_t, WS_H)
#define Pb_ FWS(bf16_t, WS_R + R_P)
#define Gb_ FWS(bf16_t, WS_R + R_G)
#define QB_ FWS(bf16_t, WS_R + R_QB)
#define KVB_ FWS(bf16_t, WS_R + R_KVB)
#define Yb_ FWS(bf16_t, WS_R + R_Y)
#define MEMN_ FWS(bf16_t, WS_MEMN)
#define MEMKV_ FWS(bf16_t, WS_MEMKV)
#define ACT_ FWS(bf16_t, WS_R + R_ACT)
#define ASORT_ FWS(bf16_t, WS_R + R_ASORT)
#define YOUT_ FWS(bf16_t, WS_R + R_YOUT)
#define SSQ_ FWS(float, WS_MISC + MS_SSQ)
#define TEXP_ FWS(const int, WS_MISC + MS_TEXP)
#define POS_ ((const int*)Fp.in[I_POS])
#define HSC_ FWS(float, WS_MISC + MS_HSC)
#define ASC_ FWS(float, WS_MISC + MS_ASC)
#define WSIN_ FWS(float, WS_MISC + MS_WSIN)
#define WSGU_ FWS(float, WS_MISC + MS_WSGU)

#define GRID_BAR() xcd_barrier(bar)
#ifndef WGM_GU
#define WGM_GU 4
#endif
#ifndef WGM_IN
#define WGM_IN 4
#endif
template <int l> __device__ __forceinline__ void layer_body(const Frame& F, const XcdBarrier& bar, const int bx) {
        if (l > 0) {
            PHASE();
            prep_ffn_weights(Fp, l);
            if ((l & 1) != 0) norm_phase(Fp, nullptr, X_, Fp.in[I_GMIX] + l * DM, false, true);
            if ((l & 1) == 0) norm_phase(Fp, nullptr, X_, Fp.in[I_GMIX] + l * DM, true, true);
            GRID_BAR();
        }
        {   PHASE();
            ProbSimple p{DM, DM, DM, (const char*)H_, (const char*)wmix(Fp, l, WL_IN)}; pg8::StaticOrder S; S.init(T / 256, NT_IN, Fp.G, bx, 0, WGM_IN);
            EpiInproj E{Pb_, Gb_, SSQ_, POS_, HSC_, WSIN_ + l * NT_IN * 256}; pg8::gemm_phase<true>(Fp.lds, p, S, E); }
        if (l == 0) { PHASE();
            ProbSimple p{DM, DM * 2, DM * 2, (const char*)MEMN_, (const char*)FWS(bf16_t, WS_WMKV)}; pg8::StaticOrder S; S.init(NB * MEML / 256, 16, Fp.G, bx);
            EpiPlain E{MEMKV_, 4096}; pg8::gemm_phase(Fp.lds, p, S, E); }
        GRID_BAR();
        SC_AFTER_INPROJ(l);
        {   PHASE();
            ProbUp p{UPK, PW * 2, UPK * 2, (const char*)(Pb_ + P_CQ), (const char*)wmix(Fp, l, WL_UP)}; pg8::StaticOrder S; S.init(T / 256, UPN / 256, Fp.G, bx);
            EpiUp E{QB_, KVB_, SSQ_, POS_}; pg8::gemm_phase(Fp.lds, p, S, E); }
        {   PHASE();
            for (int i = Fp.vcu; i < 1024; i += Fp.G) {
                const int hl = i & 3, qb = (i >> 2) & 15, kvh = (i >> 6) & 1, b = i >> 7, h = kvh * 4 + hl; const size_t rowb = (size_t)b * SEQ; const int q0 = qb * 256;
                att::Src s; s.q = Pb_ + (rowb + q0 + Fp.wave * 32) * PW + P_QA + h * 64; s.qpitch = PW; s.k0 = Pb_ + rowb * PW + P_KA + kvh * 64; s.k0pitch = PW; s.k1 = s.k0; s.k1pitch = PW;
                s.v = Pb_ + rowb * PW + P_VA + kvh * 64; s.vpitch = PW; s.o = Yb_ + (rowb + q0 + Fp.wave * 32) * YW + h * 64; s.opitch = YW;
                const int t_lo = (q0 / 64 - 2) < 0 ? 0 : (q0 / 64 - 2), t_hi = (q0 / 64 + 6) > SEQ / 64 ? SEQ / 64 : (q0 / 64 + 6);
                att::unit<8, 2, 0>(Fp.lds, s, t_lo, t_hi, q0, Fp.in[I_SINK][l * 8 + h] * LOG2E);
            } }
        {   PHASE();
            for (int i = Fp.vcu; i < 512; i += Fp.G) {
                const int qb = i & 15, h = (i >> 4) & 3, b = i >> 6; const size_t rowq = (size_t)b * SEQ + qb * 256 + Fp.wave * 32;
                att::Src s; s.q = Pb_ + rowq * PW + P_QM + h * 128; s.qpitch = PW; s.k0 = MEMKV_ + (size_t)b * MEML * 4096 + l * 1024 + h * 128; s.k0pitch = 4096; s.k1 = s.k0 + 64; s.k1pitch = 4096;
                s.v = MEMKV_ + (size_t)b * MEML * 4096 + l * 1024 + 512 + h * 128; s.vpitch = 4096; s.o = Yb_ + rowq * YW + 1024 + h * 128; s.opitch = YW;
                att::unit<16, 4, 1>(Fp.lds, s, 0, MEML / 64, 0, 0.f);
            } }
        GRID_BAR();
        SC_AFTER_UP(l);
        {   PHASE();
            for (int i = Fp.vcu; i < 512; i += Fp.G) {
                const int qb = i & 7, h = (i >> 3) & 7, b = i >> 6; const size_t rowb = (size_t)b * SEQ, rowq = rowb + qb * 512 + Fp.wave * 64;
                att::Src s; s.q = QB_ + rowq * QBW + h * 96; s.qpitch = QBW; s.k0 = KVB_ + rowb * KVW + h * 128; s.k0pitch = KVW; s.k1 = Pb_ + rowb * PW + P_KR; s.k1pitch = PW;
                s.v = KVB_ + rowb * KVW + h * 128 + 64; s.vpitch = KVW; s.o = Yb_ + rowq * YW + 512 + h * 64; s.opitch = YW;
                att::unit_q64<12, 2>(Fp.lds, s, 0, SEQ / 64);
            } }
        GRID_BAR();
        SC_AFTER_MLA(l);
        {   PHASE();
            ProbSimple p{1536, YW * 2, 1536 * 2, (const char*)Yb_, (const char*)wmix(Fp, l, WL_BR)}; pg8::StaticOrder S; S.init(T / 256, DM / 256, Fp.G, bx);
            EpiBranch E{(const unsigned char*)Gb_, H_}; pg8::gemm_phase(Fp.lds, p, S, E); }
        GRID_BAR();
        SC_AFTER_BRANCH(l);
        if (l == 0) {   PHASE();
            ProbSimple p{DM, DM * 2, DM * 2, (const char*)H_, (const char*)wmix(Fp, l, WL_OUT)}; pg8::StaticOrder S; S.init(T / 256, DM / 256, Fp.G, bx);
            EpiResid E{Fp.in[I_X], X_}; pg8::gemm_phase(Fp.lds, p, S, E); }
        if (l != 0) {   PHASE();
            ProbSimple p{DM, DM * 2, DM * 2, (const char*)H_, (const char*)wmix(Fp, l, WL_OUT)}; pg8::StaticOrder S; S.init(T / 256, DM / 256, Fp.G, bx);
            EpiResid E{nullptr, X_}; pg8::gemm_phase(Fp.lds, p, S, E); }
        GRID_BAR();
        SC_AFTER_WOUT(l);
        if ((l & 1) == 0) {
            {   PHASE(); norm_phase(Fp, nullptr, X_, Fp.in[I_GFFN] + l * DM, false, GU_I8(l) != 0); }
            GRID_BAR();
            SC_AFTER_NORM2(l);
            {   PHASE();
                constexpr bool i8 = GU_I8(l) != 0; constexpr unsigned eb = i8 ? 1 : 2;
                ProbSimple p{DM, DM * eb, DM * eb, (const char*)H_, (const char*)FWS(bf16_t, WS_WFFN + WF_GU)}; pg8::StaticOrder S; S.init(T / 256, 2 * DFF / 256, Fp.G, bx, 0, WGM_GU);
                EpiSwiglu E{ACT_, 0, HSC_, WSGU_}; pg8::gemm_phase<i8>(Fp.lds, p, S, E); }
            GRID_BAR();
            SC_AFTER_GU(l);
            {   PHASE();
                ProbSimple p{DFF, DFF * 2, DFF * 2, (const char*)ACT_, (const char*)FWS(bf16_t, WS_WFFN + WF_D)}; pg8::StaticOrder S; S.init(T / 256, DM / 256, Fp.G, bx, 1);
                EpiResid E{nullptr, X_}; pg8::gemm_phase(Fp.lds, p, S, E); }
            GRID_BAR();
            SC_AFTER_DOWN(l);
        } else {
            {   PHASE(); norm_router_phase(Fp, X_, Fp.in[I_GFFN] + l * DM, Fp.in[I_WR] + (size_t)(l >> 1) * DM * NE, GU_I8(l) != 0); }
            GRID_BAR();
            {   PHASE(); moe_assign_phase(Fp, GU_I8(l) != 0); }
            GRID_BAR();
            SC_AFTER_ROUTE(l);
            {   constexpr int half = 0; (void)half;
                {   PHASE();
                    const int nrt = __builtin_amdgcn_readfirstlane(TEXP_[MAXRT]);
                    constexpr bool i8 = GU_I8(l) != 0; constexpr unsigned eb = i8 ? 1 : 2;
                    ProbMoe p{DM, DM * eb, DM * eb, (const char*)ASORT_, (const char*)FWS(bf16_t, WS_WFFN + WF_GU), 0}; MoeOrder S; S.base.init(nrt, 2 * DFF / 256, Fp.G, bx, 0, WGM_GU); S.lo = 0; S.texp = TEXP_;
                    EpiSwiglu E{ACT_, 0, ASC_, WSGU_}; pg8::gemm_phase<i8>(Fp.lds, p, S, E); }
                GRID_BAR();
                SC_AFTER_MOEGU(l, half);
                {   PHASE();
                    const int nrt = __builtin_amdgcn_readfirstlane(TEXP_[MAXRT]);
                    ProbMoe p{DFF, DFF * 2, DFF * 2, (const char*)ACT_, (const char*)FWS(bf16_t, WS_WFFN + WF_D), 0}; MoeOrder S; S.base.init(nrt, DM / 256, Fp.G, bx, 1); S.lo = 0; S.texp = TEXP_;
                    EpiYout E{YOUT_}; pg8::gemm_phase(Fp.lds, p, S, E); }
                GRID_BAR();
                SC_AFTER_MOED(l, half);
            }
        }
    }

__global__ void __launch_bounds__(NWAVES * 64, 2) fwd(Args args) {
    extern __shared__ __attribute__((aligned(16))) unsigned char lds_raw[];
    Frame F;
    F.lds = (LAS unsigned char*)lds_raw;
    F.MISC = (volatile LAS unsigned*)(F.lds + LDSCTL_OFF);
    F.tid = threadIdx.x; F.lane = F.tid & 63; F.wave = __builtin_amdgcn_readfirstlane(F.tid >> 6);
    F.G = gridDim.x; { const int bx = blockIdx.x; F.vcu = (F.G % 8 == 0) ? (bx % 8) * (F.G / 8) + bx / 8 : bx; }
    F.ws = args.ws; F.ctl = (gu32*)(args.ws + WS_CTL); F.out = args.out;
    F.in = (const float* const*)__builtin_amdgcn_kernarg_segment_ptr();
    for (int u = F.tid; u < (LDS_BYTES - LDSCTL_OFF) / 4; u += NWAVES * 64) ((LAS unsigned*)(F.lds + LDSCTL_OFF))[u] = 0u;
    __syncthreads();
    XcdBarrier bar = xcd_barrier_post((unsigned*)(F.ctl + CW_BAR), F.MISC + 8);

    const int bx = (int)blockIdx.x;

    {   PHASE();
        prep_mixer_weights(Fp);
        memnorm_phase(Fp);
        prep_ffn_weights(Fp, 0);
        norm_phase(Fp, Fp.in[I_X], nullptr, Fp.in[I_GMIX], false, true); }
    GRID_BAR();
    SC_AFTER_PROLOGUE();

    layer_body<0>(F, bar, bx); layer_body<1>(F, bar, bx); layer_body<2>(F, bar, bx); layer_body<3>(F, bar, bx);
    {   PHASE(); final_norm_phase(Fp, X_, Fp.out, Fp.in[I_GFIN], true); }
    SC_FINAL();
}

extern "C" void kernel_launch(void* const* d_in, const int* in_sizes, int n_in, void* d_out, int out_size, void* d_ws, size_t ws_size, hipStream_t stream) {
    static int grid = 0;
    if (grid == 0) {
        if (n_in != 23 || out_size != T * DM || ws_size < WS_END) { fprintf(stderr, "kernel_launch: unexpected problem (n_in %d, out %d, ws %zu < %zu)\n", n_in, out_size, ws_size, (size_t)WS_END); grid = -1; return; }
        int dev = 0, cus = 0;
        if (hipGetDevice(&dev) != hipSuccess || hipDeviceGetAttribute(&cus, hipDeviceAttributeMultiprocessorCount, dev) != hipSuccess) { grid = -1; return; }
        if (hipFuncSetAttribute((const void*)fwd, hipFuncAttributeMaxDynamicSharedMemorySize, LDS_BYTES) != hipSuccess) { fprintf(stderr, "kernel_launch: hipFuncSetAttribute failed\n"); grid = -1; return; }
        int per_cu = 0;
        if (hipOccupancyMaxActiveBlocksPerMultiprocessor(&per_cu, (const void*)fwd, NWAVES * 64, LDS_BYTES) != hipSuccess || per_cu < 1) fprintf(stderr, "kernel_launch: occupancy query says %d\n", per_cu);
        (void)hipGetLastError();
        grid = cus;
    }
    if (grid < 0) return;
    if (hipMemsetAsync((char*)d_ws + WS_CTL, 0, CTL_ZERO_BYTES, stream) != hipSuccess) return;
    Args a{};
    for (int i = 0; i < 23; ++i) a.in[i] = (const float*)d_in[i];
    a.out = (float*)d_out; a.ws = (unsigned char*)d_ws;
    hipLaunchKernelGGL(fwd, dim3(grid), dim3(NWAVES * 64), LDS_BYTES, stream, a);
}
```

```cpp
#include <hip/hip_runtime.h>
#include <cstdio>
#include <cstdint>

#ifndef SELFCHECK
#define SELFCHECK 0
#endif
#ifndef GU_I8_MASK
#define GU_I8_MASK 0xF
#endif
#define GU_I8(l) ((((unsigned)GU_I8_MASK) >> (l)) & 1u)

#define GAS __attribute__((address_space(1)))
#define LAS __attribute__((address_space(3)))
typedef unsigned short bf16_t;
typedef short bf16x8 __attribute__((ext_vector_type(8)));
typedef short s16x4 __attribute__((ext_vector_type(4)));
typedef short v4i16_t __attribute__((ext_vector_type(4)));
typedef float f32x2 __attribute__((ext_vector_type(2)));
typedef float f32x4 __attribute__((ext_vector_type(4)));
typedef float f32x16 __attribute__((ext_vector_type(16)));
typedef unsigned u32x2 __attribute__((ext_vector_type(2)));
typedef unsigned u32x4 __attribute__((ext_vector_type(4)));
typedef int i32x4 __attribute__((ext_vector_type(4)));
typedef GAS unsigned gu32;
#define RLX_AGENT __ATOMIC_RELAXED, __HIP_MEMORY_SCOPE_AGENT

constexpr int NB = 8, SEQ = 4096, T = NB * SEQ, DM = 1024, DEPTH = 4, MEML = 256, DFF = 3584, NE = 8;
constexpr int INW = 4768;
constexpr int PW = 1792;
constexpr int GW = 3072;
constexpr int QBW = 768, KVW = 1024, YW = 1536;
constexpr int NT_IN = 19;
constexpr int P_QA = 0, P_KA = 512, P_VA = 640, P_CQ = 768, P_CKV = 1024, P_KR = 1152, P_QM = 1280;
constexpr int UPK = 256, UPN = 1792;
constexpr int MAXSLOT = 67584;
constexpr int MAXRT = MAXSLOT / 256;
constexpr float EPS = 1e-6f;
constexpr float LOG2E = 1.4426950408889634f;
constexpr float C_A = 0.125f * LOG2E;
constexpr float C_B = 0.10206207261596575f * LOG2E;
constexpr float C_M = 0.08838834764831845f * LOG2E;

constexpr size_t MiB = 1u << 20;
constexpr size_t WS_CTL = 0, CTL_ZERO_BYTES = 1 * MiB;
constexpr size_t WS_MISC = 1 * MiB;
constexpr size_t WL_IN = 0, WL_UP = (size_t)NT_IN * 256 * DM * 2, WL_BR = WL_UP + (size_t)UPN * UPK * 2, WL_OUT = WL_BR + (size_t)3 * DM * 512 * 2, WL_SIZE = WL_OUT + (size_t)DM * DM * 2;
constexpr size_t WS_WMIX = 8 * MiB;
constexpr size_t WS_WMKV = WS_WMIX + 4 * ((WL_SIZE + MiB - 1) / MiB) * MiB;
constexpr size_t WL_STRIDE = ((WL_SIZE + MiB - 1) / MiB) * MiB;
constexpr size_t WS_WFFN = WS_WMKV + 8 * MiB;
constexpr size_t WF_GU = 0, WF_D = (size_t)2 * DFF * DM * 2, WF_STRIDE = WF_D + (size_t)DM * DFF * 2;
constexpr size_t WS_H = WS_WFFN + 8 * WF_STRIDE;
constexpr size_t WS_MEMN = WS_H + (size_t)T * DM * 2;
constexpr size_t WS_MEMKV = WS_MEMN + (size_t)NB * MEML * DM * 2;
constexpr size_t WS_R = WS_MEMKV + (size_t)NB * MEML * 4096 * 2;
constexpr size_t R_P = 0, R_G = R_P + (size_t)T * PW * 2, R_QB = R_G + (size_t)T * GW * 2, R_KVB = R_QB + (size_t)T * QBW * 2, R_Y = R_KVB + (size_t)T * KVW * 2, R_END_MIX = R_Y + (size_t)T * YW * 2;
constexpr size_t R_ACT = 0;
constexpr size_t R_ASORT = (size_t)MAXSLOT * DFF * 2;
constexpr size_t R_YOUT = R_ASORT;
constexpr size_t R_END_FFN = R_YOUT + (size_t)MAXSLOT * DM * 2;
constexpr size_t R_SIZE = R_END_MIX > R_END_FFN ? R_END_MIX : R_END_FFN;
constexpr size_t WS_XB = WS_R + R_SIZE;
constexpr size_t WS_END = WS_XB + (size_t)T * DM * 2;
static_assert(WS_END < 1020ull * MiB, "workspace budget");
constexpr size_t MS_TOKE = 0;
constexpr size_t MS_TOKW = MS_TOKE + (size_t)T * 8;
constexpr size_t MS_SLOT = MS_TOKW + (size_t)T * 8;
constexpr size_t MS_CNT = MS_SLOT + (size_t)T * 8;
constexpr size_t MS_TEXP = MS_CNT + 256 * 8 * 4;
constexpr size_t MS_SSQ = MS_TEXP + 2048;
constexpr size_t MS_SNAP = MS_SSQ + (size_t)T * 32;
constexpr size_t MS_HSC = MS_SNAP + 64 * 1024 * 4;
constexpr size_t MS_ASC = MS_HSC + (size_t)T * 4;
constexpr size_t MS_WSIN = MS_ASC + (size_t)MAXSLOT * 4;
constexpr size_t MS_WSGU = MS_WSIN + (size_t)4 * NT_IN * 256 * 4;
constexpr size_t MS_END = MS_WSGU + (size_t)8 * 2 * DFF * 4;
static_assert(MS_END <= 7 * MiB, "misc map");
constexpr int CW_BAR = 4096;
constexpr int CW_DIAG = 16384;
constexpr int CW_CODE = 16384 + 512;

constexpr int RING_BYTES = 131072;
constexpr int LDSCTL_OFF = RING_BYTES;
constexpr int LDS_BYTES = 147456;
constexpr int NWAVES = 8;

#define LDS_WAIT() asm volatile("s_waitcnt lgkmcnt(0)" ::: "memory")
#define VM_WAIT() asm volatile("s_waitcnt vmcnt(0)" ::: "memory")

__device__ __forceinline__ unsigned f2bf(float f) { unsigned u = __builtin_bit_cast(unsigned, f); return (u + 0x7fffu + ((u >> 16) & 1u)) >> 16; }
__device__ __forceinline__ unsigned pk2(float lo, float hi) { return f2bf(lo) | (f2bf(hi) << 16); }
__device__ __forceinline__ float bf2f(unsigned short b) { return __builtin_bit_cast(float, (unsigned)b << 16); }
__device__ __forceinline__ float bflo(unsigned w) { return __builtin_bit_cast(float, w << 16); }
__device__ __forceinline__ float bfhi(unsigned w) { return __builtin_bit_cast(float, w & 0xffff0000u); }
typedef __bf16 bf16x2_t __attribute__((ext_vector_type(2)));
__device__ __forceinline__ unsigned cvtpk(float lo, float hi) { f32x2 v = {lo, hi}; bf16x2_t b = __builtin_convertvector(v, bf16x2_t); return __builtin_bit_cast(unsigned, b); }
__device__ __forceinline__ float wave_sum(float v) {
#pragma unroll
    for (int o = 1; o < 64; o <<= 1) v += __shfl_xor(v, o);
    return v;
}
__device__ __forceinline__ float fast_sigmoid(float x) { return __builtin_amdgcn_rcpf(1.0f + __builtin_amdgcn_exp2f(-x * LOG2E)); }


__device__ __forceinline__ int opq_v(int x) { asm volatile("" : "+v"(x)); return x; }
__device__ __forceinline__ int opq_s(int x) { asm volatile("" : "+s"(x)); return x; }
template <class Tp> __device__ __forceinline__ Tp* opq_p(Tp* p) { const unsigned long long u = (unsigned long long)p; unsigned lo = __builtin_amdgcn_readfirstlane((unsigned)u), hi = __builtin_amdgcn_readfirstlane((unsigned)(u >> 32)); asm volatile("" : "+s"(lo), "+s"(hi)); return (Tp*)(((unsigned long long)hi << 32) | lo); }

__constant__ float IFR_HI[32] = {1.591549367e-01f, 1.193493679e-01f, 8.949939907e-02f, 6.711508334e-02f, 5.032921210e-02f, 3.774158657e-02f, 2.830219641e-02f, 2.122365311e-02f, 1.591549441e-02f, 1.193493698e-02f, 8.949940093e-03f, 6.711508147e-03f, 5.032921210e-03f, 3.774158424e-03f, 2.830219688e-03f, 2.122365171e-03f, 1.591549488e-03f, 1.193493721e-03f, 8.949940093e-04f, 6.711508031e-04f, 5.032921326e-04f, 3.774158540e-04f, 2.830219455e-04f, 2.122365258e-04f, 1.591549371e-04f, 1.193493736e-04f, 8.949940093e-05f, 6.711508468e-05f, 5.032921035e-05f, 3.774158540e-05f, 2.830219637e-05f, 2.122365186e-05f};
__constant__ float IFR_LO[32] = {6.420638243e-09f, 2.294664903e-09f, 2.542919653e-09f, -3.316028840e-10f, 5.173299289e-12f, -1.848551645e-09f, -5.826552019e-10f, -3.431038786e-10f, -1.029942243e-10f, 4.320196978e-11f, 6.802745173e-11f, 1.531042237e-10f, 5.173301024e-13f, 4.797548470e-11f, -1.048316434e-10f, 1.053879969e-10f, -5.686555046e-11f, -1.896286773e-11f, 6.802744999e-12f, 2.695195456e-11f, -1.158979943e-11f, -6.843983713e-12f, 1.279990003e-11f, 1.807650600e-12f, 5.954976963e-12f, -3.351478166e-12f, 6.802745216e-13f, -1.670379113e-12f, 1.751403167e-12f, -6.843983930e-13f, -5.389994549e-13f, 9.083608431e-13f};
__device__ __forceinline__ void rot_cs(float posf, int idx, float& c, float& s) {
    const float ch = IFR_HI[idx], cl = IFR_LO[idx];
    const float p = posf * ch, e = __builtin_fmaf(posf, ch, -p);
    const float fr = __builtin_amdgcn_fractf(p) + (e + posf * cl);
    s = __builtin_amdgcn_sinf(fr); c = __builtin_amdgcn_cosf(fr);
}

#define XB_TMO      128
#define XB_XCNT(j)  (256  + 64 * (j))
#define XB_XSUB(j)  (1280 + 64 * (j))
#define XB_XGEN(j)  (2304 + 64 * (j))
#define XB_TOP      3328
#define XB_TOPGEN   3392
#define XCD_BAR_WORDS 3456
#define XB_SPIN_CAP (1u << 20)

__device__ __forceinline__ unsigned xb_ld(unsigned* p)              { return __hip_atomic_load(p, __ATOMIC_RELAXED, __HIP_MEMORY_SCOPE_AGENT); }
__device__ __forceinline__ unsigned xb_add(unsigned* p, unsigned v) { return __hip_atomic_fetch_add(p, v, __ATOMIC_RELAXED, __HIP_MEMORY_SCOPE_AGENT); }
__device__ __forceinline__ unsigned xb_xcc_id() { return (unsigned)__builtin_amdgcn_s_getreg((3 << 11) | 20) & 0xFu; }
#define XB_SPIN(cond, bar) do { unsigned _sp = 0; while (cond) { __builtin_amdgcn_s_sleep(1); \
    if ((++_sp & 255u) == 0u) { if (xb_ld(&(bar)[XB_TMO])) break; if (_sp > XB_SPIN_CAP) { atomicAdd(&(bar)[XB_TMO], 1u); break; } } } } while (0)

struct XcdBarrier { unsigned* bar; unsigned x; volatile LAS unsigned* st; };

__device__ __forceinline__ XcdBarrier xcd_barrier_post(unsigned* bar, volatile LAS unsigned* st) {
    XcdBarrier b; b.bar = bar; b.x = xb_xcc_id(); b.st = st;
    if (threadIdx.x == 0) (void)xb_add(&bar[XB_XCNT(b.x)], 1u);
    return b;
}
__device__ __forceinline__ void xcd_barrier_complete(unsigned* bar, unsigned x, unsigned& nloc, unsigned& nx) {
    const unsigned G = gridDim.x * gridDim.y * gridDim.z;
    unsigned sum, cnt, mine, sp = 0u;
    for (;;) {
        sum = 0u; cnt = 0u; mine = 0u;
#pragma unroll
        for (unsigned j = 0; j < 16; ++j) { const unsigned c = xb_ld(&bar[XB_XCNT(j)]); sum += c; cnt += (c > 0u) ? 1u : 0u; mine = (j == x) ? c : mine; }
        if (sum == G) break;
        __builtin_amdgcn_s_sleep(1);
        if ((++sp & 255u) == 0u) { if (xb_ld(&bar[XB_TMO])) break; if (sp > XB_SPIN_CAP) { atomicAdd(&bar[XB_TMO], 1u); break; } }
    }
    nloc = mine > 0u ? mine : 1u; nx = cnt > 0u ? cnt : 1u;
}
__device__ __forceinline__ void xcd_barrier(const XcdBarrier& b) {
    asm volatile("s_waitcnt vmcnt(0)" ::: "memory");
    __syncthreads();
    if (threadIdx.x == 0) {
        unsigned* bar = b.bar;
        __builtin_amdgcn_s_waitcnt(0);
        unsigned nloc = b.st[0], nx = b.st[1];
        if (nloc == 0u) { xcd_barrier_complete(bar, b.x, nloc, nx); b.st[0] = nloc; b.st[1] = nx; }
        const unsigned old = xb_add(&bar[XB_XSUB(b.x)], 1u);
        const unsigned gen = old / nloc;
        if (old + 1u == (gen + 1u) * nloc) {
            __builtin_amdgcn_fence(__ATOMIC_RELEASE, "agent");
            asm volatile("s_waitcnt vmcnt(0)" ::: "memory");
            const unsigned og = xb_add(&bar[XB_TOP], 1u);
            const unsigned tg = og / nx;
            if (og + 1u == (tg + 1u) * nx) xb_add(&bar[XB_TOPGEN], 1u);
            else XB_SPIN(xb_ld(&bar[XB_TOPGEN]) == tg, bar);
            __builtin_amdgcn_fence(__ATOMIC_ACQUIRE, "agent");
            xb_add(&bar[XB_XGEN(b.x)], 1u);
            asm volatile("s_waitcnt vmcnt(0)" ::: "memory");
        } else {
            XB_SPIN(xb_ld(&bar[XB_XGEN(b.x)]) == gen, bar);
            __builtin_amdgcn_fence(__ATOMIC_ACQUIRE, "agent");
            asm volatile("s_waitcnt vmcnt(0)" ::: "memory");
        }
    }
    __syncthreads();
}

namespace pg8 {
constexpr int BM = 256, BK = 64, HALF = 128, HTB = HALF * BK * 2, STAGE_BYTES = 8 * HTB, NXCD = 8, WGM = 4;
constexpr int ESC_OFF = 131072 + 4096, ESC_SLOT = 3072;
__host__ __device__ __forceinline__ int lds_byte(int r, int c) { const int st = (r >> 4) * 2 + (c >> 5), rr = r & 15, cc = c & 31, ob = rr * 64 + cc * 2; return st * 1024 + (ob ^ (((ob >> 9) & 1) << 5)); }
__host__ __device__ __forceinline__ void stage_rc(int b, int& R, int& C) { const int st = b / 1024, sb = b % 1024, swz = sb ^ (((sb >> 9) & 1) << 5); R = (st >> 1) * 16 + swz / 64; C = (st & 1) * 32 + (swz % 64) / 2; }

struct Unit { int pm, pn, aux; };

struct StaticOrder {
    int nM, nN, nwg, G, c, rev, wgm;
    __device__ void init(int nM_, int nN_, int G_, int c_, int rev_ = 0, int wgm_ = WGM) { nM = nM_; nN = nN_; nwg = nM * nN; G = G_; c = c_; rev = rev_; wgm = wgm_; }
    __device__ bool next(int i, Unit& u) const {
        const long L = (long)i * G + c; if (L >= nwg) return false;
        int wgid = (int)L; { const int q = nwg / NXCD, r = nwg % NXCD, xcd = wgid % NXCD, off = wgid / NXCD; wgid = (xcd < r ? xcd * (q + 1) : r * (q + 1) + (xcd - r) * q) + off; }
        const int nig = wgm * nN, gid = wgid / nig, fm = gid * wgm, gsz = (nM - fm) < wgm ? (nM - fm) : wgm;
        u.pm = fm + ((wgid % nig) % gsz); u.pn = (wgid % nig) / gsz; u.aux = 0; if (rev) u.pm = nM - 1 - u.pm; return true;
    }
};

template <bool I8> struct AccVec { typedef f32x4 type; };
template <> struct AccVec<true> { typedef i32x4 type; };
template <bool I8 = false, class Prob, class Sched, class Epi>
__device__ __forceinline__ void gemm_phase(LAS unsigned char* lds, const Prob& P, const Sched& S, const Epi& E) {
    const int tid = opq_v((int)threadIdx.x), wid = __builtin_amdgcn_readfirstlane(tid >> 6), lane = tid & 63, wr = wid >> 2, wc = wid & 3, fr = lane & 15, fq = lane >> 4;
    typedef typename AccVec<I8>::type accv_t;
    const int K = P.K, nt = K / (I8 ? 2 * BK : BK);
    unsigned voffA[2], voffB[2];
#pragma unroll
    for (int i = 0; i < 2; ++i) { int R, C; stage_rc(tid * 16 + i * 8192, R, C); voffA[i] = (unsigned)R * P.lda + (unsigned)C * 2u; voffB[i] = (unsigned)R * P.ldb + (unsigned)C * 2u; }
    const size_t kstep = (size_t)(BK * 2);
    const size_t hstepA = (size_t)HALF * P.lda, hstepB = (size_t)HALF * P.ldb;
    const unsigned ldsw = (unsigned)wid * 1024u;
    const int aoff = lds_byte(wr * 64 + fr, fq * 8), boff = lds_byte(wc * 32 + fr, fq * 8);
#define PG8_SA(b, h) (((b) * 2 + (h)) * HTB)
#define PG8_SB(b, h) ((4 + (b) * 2 + (h)) * HTB)
#define PG8_STAGE(bufoff, gbase, voff) do { _Pragma("unroll") for (int _i = 0; _i < 2; ++_i) \
        __builtin_amdgcn_global_load_lds((const unsigned*)((const char*)(gbase) + (voff)[_i]), (LAS unsigned*)(lds + (bufoff) + ldsw + _i * 8192), 16, 0, 0); } while (0)
#define PG8_LDA(dst, b, h) do { _Pragma("unroll") for (int m = 0; m < 4; ++m) _Pragma("unroll") for (int k = 0; k < 2; ++k) dst[m][k] = *(const LAS bf16x8*)(lds + PG8_SA(b, h) + aoff + m * 2048 + k * 1024); } while (0)
#define PG8_LDB(dst, b, h) do { _Pragma("unroll") for (int n = 0; n < 2; ++n) _Pragma("unroll") for (int k = 0; k < 2; ++k) dst[n][k] = *(const LAS bf16x8*)(lds + PG8_SB(b, h) + boff + n * 2048 + k * 1024); } while (0)
#define PG8_MMA(ai, bj, At, Bt) do { __builtin_amdgcn_s_setprio(1); _Pragma("unroll") for (int m = 0; m < 4; ++m) _Pragma("unroll") for (int n = 0; n < 2; ++n) _Pragma("unroll") for (int k = 0; k < 2; ++k) \
        { if constexpr (I8) acc[ai][bj][m][n] = __builtin_amdgcn_mfma_i32_16x16x64_i8(__builtin_bit_cast(i32x4, Bt[n][k]), __builtin_bit_cast(i32x4, At[m][k]), acc[ai][bj][m][n], 0, 0, 0); \
          else acc[ai][bj][m][n] = __builtin_amdgcn_mfma_f32_16x16x32_bf16(Bt[n][k], At[m][k], acc[ai][bj][m][n], 0, 0, 0); } __builtin_amdgcn_s_setprio(0); } while (0)
#define PG8_WAIT_V(n) asm volatile("s_waitcnt vmcnt(" #n ")" ::: "memory")
#define PG8_WAIT_L(n) asm volatile("s_waitcnt lgkmcnt(" #n ")" ::: "memory")
#define PG8_BAR __builtin_amdgcn_s_barrier()
#define PG8_SCHED __builtin_amdgcn_sched_barrier(0)
    Unit cur, nxt; int ui = 0;
    if (!S.next(0, cur)) return;
    accv_t acc[2][2][4][2];
#pragma unroll
    for (int a = 0; a < 2; ++a)
#pragma unroll
        for (int b = 0; b < 2; ++b)
#pragma unroll
            for (int m = 0; m < 4; ++m)
#pragma unroll
                for (int n = 0; n < 2; ++n) acc[a][b][m][n] = accv_t{};
    bf16x8 At[4][2], B0[2][2], B1[2][2];
    const char* cA = P.a_ptr(cur); const char* cB = P.b_ptr(cur);
    int eslot = 0;
    E.stage(lds + ESC_OFF, cur, wid, lane);
    PG8_STAGE(PG8_SB(0, 0), cB, voffB); PG8_STAGE(PG8_SB(0, 1), cB + hstepB, voffB); PG8_STAGE(PG8_SA(0, 0), cA, voffA); PG8_STAGE(PG8_SA(0, 1), cA + hstepA, voffA);
    if (wr == 1) PG8_BAR;
    PG8_WAIT_V(2); PG8_BAR;
    PG8_STAGE(PG8_SB(1, 0), cB + kstep, voffB); PG8_STAGE(PG8_SA(1, 0), cA + kstep, voffA); PG8_STAGE(PG8_SB(1, 1), cB + hstepB + kstep, voffB);
    PG8_WAIT_V(6); PG8_BAR;
    for (;;) {
        const bool has_next = S.next(ui + 1, nxt);
        const char* nA = has_next ? P.a_ptr(nxt) : cA; const char* nB = has_next ? P.b_ptr(nxt) : cB;
        for (int t = 0; t < nt; t += 2) {
            if constexpr (Epi::MID) { if (t == 8 || t == 16) E.mid(acc, cur, t >> 3, wr, wc, fr, fq); }
            const bool last = (t == nt - 2);
            if (last && has_next) E.stage(lds + ESC_OFF + (eslot ^ 1) * ESC_SLOT, nxt, wid, lane);
            const char* a1 = cA + (size_t)(t + 1) * kstep;
            const char* a2 = last ? nA : cA + (size_t)(t + 2) * kstep; const char* b2 = last ? nB : cB + (size_t)(t + 2) * kstep;
            const char* a3 = a2 + kstep; const char* b3 = b2 + kstep;
            PG8_LDB(B0, 0, 0); PG8_LDB(B1, 0, 1); PG8_SCHED; PG8_LDA(At, 0, 0); PG8_STAGE(PG8_SA(1, 1), a1 + hstepA, voffA);
            PG8_WAIT_V(8); PG8_WAIT_L(0); PG8_BAR; PG8_MMA(0, 0, At, B0); PG8_MMA(0, 1, At, B1); PG8_BAR; PG8_SCHED;
            PG8_LDA(At, 0, 1); PG8_STAGE(PG8_SB(0, 0), b2, voffB); PG8_STAGE(PG8_SB(0, 1), b2 + hstepB, voffB); PG8_STAGE(PG8_SA(0, 0), a2, voffA);
            PG8_WAIT_V(8); PG8_WAIT_L(0); PG8_BAR; PG8_MMA(1, 0, At, B0); PG8_MMA(1, 1, At, B1); PG8_BAR; PG8_SCHED;
            PG8_LDB(B0, 1, 0); PG8_LDB(B1, 1, 1); PG8_SCHED; PG8_LDA(At, 1, 0); PG8_STAGE(PG8_SA(0, 1), a2 + hstepA, voffA);
            PG8_WAIT_V(8); PG8_WAIT_L(0); PG8_BAR; PG8_MMA(0, 0, At, B0); PG8_MMA(0, 1, At, B1); PG8_BAR; PG8_SCHED;
            PG8_LDA(At, 1, 1); PG8_STAGE(PG8_SB(1, 0), b3, voffB); PG8_STAGE(PG8_SB(1, 1), b3 + hstepB, voffB); PG8_STAGE(PG8_SA(1, 0), a3, voffA);
            PG8_WAIT_V(8); PG8_WAIT_L(0); PG8_BAR; PG8_MMA(1, 0, At, B0); PG8_MMA(1, 1, At, B1); PG8_BAR; PG8_SCHED;
        }
        if (wr == 0) PG8_BAR;
        E(acc, cur, wr, wc, fr, fq, lds + ESC_OFF + eslot * ESC_SLOT);
        if (!has_next) break;
#pragma unroll
        for (int a = 0; a < 2; ++a)
#pragma unroll
            for (int b = 0; b < 2; ++b)
#pragma unroll
                for (int m = 0; m < 4; ++m)
#pragma unroll
                    for (int n = 0; n < 2; ++n) acc[a][b][m][n] = accv_t{};
        cur = nxt; cA = nA; cB = nB; ++ui; eslot ^= 1;
        if (wr == 1) PG8_BAR;
    }
    PG8_WAIT_V(0);
    PG8_BAR;
#undef PG8_SA
#undef PG8_SB
#undef PG8_STAGE
#undef PG8_LDA
#undef PG8_LDB
#undef PG8_MMA
#undef PG8_WAIT_V
#undef PG8_WAIT_L
#undef PG8_BAR
#undef PG8_SCHED
}
}

struct Frame {
    LAS unsigned char* lds;
    volatile LAS unsigned* MISC;
    gu32* ctl;
    unsigned char* ws;
    int tid, lane, wave, vcu, G;
    const float* const* in; float* out;
};
enum { I_X = 0, I_MEM, I_POS, I_GMIX, I_WIN, I_GQ, I_WUQ, I_GKV, I_WUKV, I_SINK, I_WMKV, I_WBR, I_WOUT, I_GFFN, I_WGD, I_WUD, I_WDD, I_WR, I_WGE, I_WUE, I_WDE, I_GMEM, I_GFIN };

__device__ __forceinline__ int sem_plain(int g) { return (g & ~31) + 8 * ((g >> 2) & 3) + 4 * ((g >> 4) & 1) + (g & 3); }
__device__ __forceinline__ int sem_rot64(int g) { return (g & ~63) + 32 * ((g >> 4) & 1) + 16 * ((g >> 5) & 1) + 4 * ((g >> 2) & 3) + (g & 3); }
__device__ __forceinline__ int sem_p16(int g) { const int c = g & 255; return (g & ~255) + 64 * ((c >> 5) & 3) + 16 * ((c >> 2) & 3) + 8 * (c >> 7) + 4 * ((c >> 4) & 1) + (c & 3); }
__device__ __forceinline__ int inproj_src(int n) {
    const int pn = n >> 8, c = n & 255;
    if (pn < 2) return pn * 256 + sem_rot64(c);
    if (pn == 2) return c < 128 ? 512 + sem_rot64(c) : 640 + sem_plain(c - 128);
    if (pn == 3) return 768 + sem_plain(c);
    if (pn == 4) return c < 128 ? 1024 + sem_plain(c) : (c < 160 ? 1152 + (c - 128) : -1);
    if (pn < 7) return 1184 + (pn - 5) * 256 + sem_plain(c);
    return 1696 + (pn - 7) * 256 + sem_p16(c);
}

struct MapInproj { const float* W; __device__ __forceinline__ float load(int k, int n) const { const int s = inproj_src(n); return s >= 0 ? W[(size_t)k * INW + s] : 0.f; }
    __device__ __forceinline__ f32x4 load4(int k, int n) const { const int s = inproj_src(n); return s >= 0 ? *(const f32x4*)(W + (size_t)k * INW + s) : (f32x4){0.f, 0.f, 0.f, 0.f}; } };
struct MapUp { const float *Wq, *Wkv, *gq, *gkv;
    __device__ __forceinline__ f32x4 load4(int k, int n) const {
        if (n < 768) { const int gg = n >> 5; const int s = (gg % 3 == 2) ? n : sem_plain(n); return *(const f32x4*)(Wq + (size_t)k * 768 + s) * gq[k]; }
        if (k < 128) return (f32x4){0.f, 0.f, 0.f, 0.f}; const int s = sem_plain(n - 768); return *(const f32x4*)(Wkv + (size_t)(k - 128) * 1024 + s) * gkv[k - 128]; }
    __device__ __forceinline__ float load(int k, int n) const {
        if (n < 768) { const int gg = n >> 5; const int s = (gg % 3 == 2) ? n : sem_plain(n); return gq[k] * Wq[(size_t)k * 768 + s]; }
        if (k < 128) return 0.f; const int s = sem_plain(n - 768); return gkv[k - 128] * Wkv[(size_t)(k - 128) * 1024 + s]; } };
struct MapPlain { const float* W; int ldw; __device__ __forceinline__ float load(int k, int n) const { return W[(size_t)k * ldw + sem_plain(n)]; }
    __device__ __forceinline__ f32x4 load4(int k, int n) const { return *(const f32x4*)(W + (size_t)k * ldw + sem_plain(n)); } };
struct MapNat { const float* W; int ldw; __device__ __forceinline__ float load(int k, int n) const { return W[(size_t)k * ldw + n]; }
    __device__ __forceinline__ f32x4 load4(int k, int n) const { return *(const f32x4*)(W + (size_t)k * ldw + n); } };
struct MapBr { const float* W;
    __device__ __forceinline__ float load(int k, int n) const { return W[(size_t)k * DM + sem_p16(n)]; }
    __device__ __forceinline__ f32x4 load4(int k, int n) const { return *(const f32x4*)(W + (size_t)k * DM + sem_p16(n)); } };
struct MapMemkv { const float* W; __device__ __forceinline__ float load(int k, int n) const { const int l = n >> 10, c = n & 1023; return W[((size_t)l * DM + k) * 1024 + sem_plain(c)]; }
    __device__ __forceinline__ f32x4 load4(int k, int n) const { const int l = n >> 10, c = n & 1023; return *(const f32x4*)(W + ((size_t)l * DM + k) * 1024 + sem_plain(c)); } };
struct MapGU { const float *Wg, *Wu; __device__ __forceinline__ float load(int k, int n) const { const int pn = n >> 8, c = n & 255; const int ch = 128 * pn + sem_plain(c & 127);
    const unsigned long long a = (unsigned long long)Wg, b = (unsigned long long)Wu, w = a ^ ((a ^ b) & (0ull - (unsigned long long)(c >> 7))); return ((const float*)w)[(size_t)k * DFF + ch]; }
    __device__ __forceinline__ f32x4 load4(int k, int n) const { const int pn = n >> 8, c = n & 255; const int ch = 128 * pn + sem_plain(c & 127);
        const unsigned long long a = (unsigned long long)Wg, b = (unsigned long long)Wu, w = a ^ ((a ^ b) & (0ull - (unsigned long long)(c >> 7))); return *(const f32x4*)((const float*)w + (size_t)k * DFF + ch); } };

template <class M> __device__ __forceinline__ void prep_item(const M& m, bf16_t* dst, int Kd, int nblk, LAS float* scr, int item, int lane) {
    const int kb = item / nblk, nb = item % nblk, k0 = 64 * kb, n0 = 32 * nb;
#pragma unroll 8
    for (int i = 0; i < 32; ++i) { const int kk = 2 * i + (lane >> 5); scr[kk * 33 + (lane & 31)] = m.load(k0 + kk, n0 + (lane & 31)); }
    LDS_WAIT(); asm volatile("" ::: "memory");
    const int c = lane & 7;
#pragma unroll
    for (int j = 0; j < 4; ++j) { const int n = (lane >> 3) + 8 * j; const LAS float* s = scr + (8 * c) * 33 + n;
        u32x4 o; o.x = pk2(s[0 * 33], s[1 * 33]); o.y = pk2(s[2 * 33], s[3 * 33]); o.z = pk2(s[4 * 33], s[5 * 33]); o.w = pk2(s[6 * 33], s[7 * 33]);
        *(u32x4*)(dst + (size_t)(n0 + n) * Kd + k0 + 8 * c) = o; }
    LDS_WAIT(); asm volatile("" ::: "memory");
}
template <class M> __device__ __forceinline__ void prep_tile(const M& m, bf16_t* dst, int Kd, int nblk, LAS unsigned char* tile, int item, int lane) {
    const int kb = item / nblk, nb = item % nblk, k0 = 128 * kb, n0 = 32 * nb, ng = lane & 7, kr = lane >> 3;
    f32x4 v[16];
#pragma unroll
    for (int i = 0; i < 16; ++i) v[i] = m.load4(k0 + 8 * i + kr, n0 + 4 * ng);
#pragma unroll
    for (int i = 0; i < 16; ++i)
#pragma unroll
        for (int c = 0; c < 4; ++c) *(LAS unsigned short*)(tile + (4 * ng + c) * 272 + (8 * i + kr) * 2) = (unsigned short)f2bf(v[i][c]);
    LDS_WAIT(); asm volatile("" ::: "memory");
#pragma unroll
    for (int j = 0; j < 8; ++j) { const int p = lane + 64 * j, n = p >> 4, kc = p & 15;
        *(u32x4*)(dst + (size_t)(n0 + n) * Kd + k0 + 8 * kc) = *(const LAS u32x4*)(tile + n * 272 + 16 * kc); }
    LDS_WAIT(); asm volatile("" ::: "memory");
}
template <class M> __device__ __forceinline__ void prep_matrix(Frame& F, const M& m, bf16_t* dst, int N, int K) {
    LAS unsigned char* tile = F.lds + F.wave * 16384;
    const int gw = F.vcu * NWAVES + F.wave, NGW = F.G * NWAVES, nblk = N / 32, nitems = (K / 128) * nblk;
    for (int it = gw; it < nitems; it += NGW) prep_tile(m, dst, K, nblk, tile, it, F.lane);
}

template <class M> __device__ __forceinline__ void prep_strip_i8(Frame& F, const M& m, signed char* dst, float* scl, int strip) {
    const int lane = F.lane, w = F.wave, n0 = strip * 32, k0 = w * 128, ng = lane & 7, kr = lane >> 3;
    LAS unsigned char* tile = F.lds + w * 16384;
    LAS float* amt = (LAS float*)(F.lds + LDSCTL_OFF + 2048);
    f32x4 v[16];
#pragma unroll
    for (int i = 0; i < 16; ++i) v[i] = m.load4(k0 + 8 * i + kr, n0 + 4 * ng);
    f32x4 am = __builtin_elementwise_abs(v[0]);
#pragma unroll
    for (int i = 1; i < 16; ++i) am = __builtin_elementwise_max(am, __builtin_elementwise_abs(v[i]));
#pragma unroll
    for (int c = 0; c < 4; ++c) { float a = am[c]; a = fmaxf(a, __shfl_xor(a, 8)); a = fmaxf(a, __shfl_xor(a, 16)); a = fmaxf(a, __shfl_xor(a, 32)); am[c] = a; }
    if (kr == 0) *(LAS f32x4*)(amt + w * 32 + 4 * ng) = am;
    __syncthreads();
    f32x4 cm = *(const LAS f32x4*)(amt + 4 * ng);
#pragma unroll
    for (int ww = 1; ww < 8; ++ww) cm = __builtin_elementwise_max(cm, *(const LAS f32x4*)(amt + ww * 32 + 4 * ng));
    f32x4 inv;
#pragma unroll
    for (int c = 0; c < 4; ++c) inv[c] = cm[c] > 0.f ? 127.0f / cm[c] : 0.f;
    if (w == 0 && kr == 0) *(f32x4*)(scl + n0 + 4 * ng) = cm * (1.0f / 127.0f);
#pragma unroll
    for (int i = 0; i < 16; ++i)
#pragma unroll
        for (int c = 0; c < 4; ++c) tile[(4 * ng + c) * 144 + 8 * i + kr] = (unsigned char)(signed char)__float2int_rn(v[i][c] * inv[c]);
    LDS_WAIT(); asm volatile("" ::: "memory");
#pragma unroll
    for (int j = 0; j < 4; ++j) { const int p = lane + 64 * j, n = p >> 3, kc = p & 7;
        *(u32x4*)(dst + (size_t)(n0 + n) * DM + k0 + 16 * kc) = *(const LAS u32x4*)(tile + n * 144 + 16 * kc); }
    LDS_WAIT();
    __syncthreads();
}
__device__ __forceinline__ bf16_t* wmix(Frame& F, int l, size_t off) { return (bf16_t*)(F.ws + WS_WMIX + (size_t)l * WL_STRIDE + off); }

__device__ __forceinline__ void prep_mixer_weights(Frame& F) {
    for (int l = 0; l < DEPTH; ++l) {
        { MapInproj m{F.in[I_WIN] + (size_t)l * DM * INW}; for (int s = F.vcu; s < NT_IN * 8; s += F.G) prep_strip_i8(F, m, (signed char*)wmix(F, l, WL_IN), (float*)(F.ws + WS_MISC + MS_WSIN) + l * NT_IN * 256, s); }
        { MapUp m{F.in[I_WUQ] + (size_t)l * 256 * 768, F.in[I_WUKV] + (size_t)l * 128 * 1024, F.in[I_GQ] + l * 256, F.in[I_GKV] + l * 128}; prep_matrix(F, m, wmix(F, l, WL_UP), UPN, UPK); }
        { MapBr m{F.in[I_WBR] + (size_t)l * 3 * 512 * DM}; prep_matrix(F, m, wmix(F, l, WL_BR), DM, 1536); }
        { MapPlain m{F.in[I_WOUT] + (size_t)l * DM * DM, DM}; prep_matrix(F, m, wmix(F, l, WL_OUT), DM, DM); }
    }
    { MapMemkv m{F.in[I_WMKV]}; prep_matrix(F, m, (bf16_t*)(F.ws + WS_WMKV), 4096, DM); }
}
__device__ __forceinline__ void prep_ffn_weights(Frame& F, int l) {
    const int i = l >> 1; const bool moe = (l & 1) != 0;
    LAS float* scr = (LAS float*)(F.lds + F.wave * 16384);
    const int gw = F.vcu * NWAVES + F.wave, NGW = F.G * NWAVES;
    constexpr int IGU = (DM / 64) * (2 * DFF / 32), ID = (DFF / 64) * (DM / 32), NSTRIP = 2 * DFF / 32;
    const int ne = moe ? NE : 1;
    const float* Wg = moe ? F.in[I_WGE] : F.in[I_WGD]; const float* Wu = moe ? F.in[I_WUE] : F.in[I_WUD]; const float* Wd = moe ? F.in[I_WDE] : F.in[I_WDD];
    if (GU_I8(l)) {
        for (int s = F.vcu; s < ne * NSTRIP; s += F.G) { const int e = s / NSTRIP, ss = s % NSTRIP; const size_t eo = ((size_t)i * ne + e) * DM * DFF;
            MapGU m{Wg + eo, Wu + eo}; prep_strip_i8(F, m, (signed char*)(F.ws + WS_WFFN + (size_t)e * WF_STRIDE), (float*)(F.ws + WS_MISC + MS_WSGU) + e * 2 * DFF, ss); }
    } else {
        for (int it = gw; it < ne * IGU; it += NGW) { const int e = it / IGU, r = it % IGU; const size_t eo = ((size_t)i * ne + e) * DM * DFF;
            MapGU m{Wg + eo, Wu + eo}; prep_item(m, (bf16_t*)(F.ws + WS_WFFN + (size_t)e * WF_STRIDE), DM, 2 * DFF / 32, scr, r, F.lane); }
    }
    constexpr int IDT = (DFF / 128) * (DM / 32);
    for (int it = gw; it < ne * IDT; it += NGW) { const int e = it / IDT, r = it % IDT; const size_t eo = ((size_t)i * ne + e) * DM * DFF;
        MapPlain m{Wd + eo, DM}; prep_tile(m, (bf16_t*)(F.ws + WS_WFFN + (size_t)e * WF_STRIDE + WF_D), DFF, DM / 32, F.lds + F.wave * 16384, r, F.lane); }
}

struct RowV { f32x4 v[4]; };
__device__ __forceinline__ void row_load(RowV& r, const float* p, int lane) { const f32x4* x = (const f32x4*)p + lane;
#pragma unroll
    for (int j = 0; j < 4; ++j) r.v[j] = x[64 * j]; }
__device__ __forceinline__ void row_store(const RowV& r, float* p, int lane) { f32x4* x = (f32x4*)p + lane;
#pragma unroll
    for (int j = 0; j < 4; ++j) x[64 * j] = r.v[j]; }
__device__ __forceinline__ void row_add_bf16(RowV& r, const bf16_t* p, float w, int lane) { const u32x2* x = (const u32x2*)p + lane;
#pragma unroll
    for (int j = 0; j < 4; ++j) { const u32x2 q = x[64 * j]; r.v[j].x += w * bflo(q.x); r.v[j].y += w * bfhi(q.x); r.v[j].z += w * bflo(q.y); r.v[j].w += w * bfhi(q.y); } }
__device__ __forceinline__ void row_load_bf16(RowV& r, const bf16_t* p, int lane) { const u32x2* x = (const u32x2*)p + lane;
#pragma unroll
    for (int j = 0; j < 4; ++j) { const u32x2 q = x[64 * j]; r.v[j].x = bflo(q.x); r.v[j].y = bfhi(q.x); r.v[j].z = bflo(q.y); r.v[j].w = bfhi(q.y); } }
__device__ __forceinline__ void row_round_bf16(RowV& r) {
#pragma unroll
    for (int j = 0; j < 4; ++j) { r.v[j].x = bf2f((unsigned short)f2bf(r.v[j].x)); r.v[j].y = bf2f((unsigned short)f2bf(r.v[j].y)); r.v[j].z = bf2f((unsigned short)f2bf(r.v[j].z)); r.v[j].w = bf2f((unsigned short)f2bf(r.v[j].w)); } }
__device__ __forceinline__ float row_rstd(const RowV& r) { float s = 0.f;
#pragma unroll
    for (int j = 0; j < 4; ++j) s += (r.v[j].x * r.v[j].x + r.v[j].y * r.v[j].y) + (r.v[j].z * r.v[j].z + r.v[j].w * r.v[j].w);
    return 1.0f / sqrtf(wave_sum(s) * (1.0f / DM) + EPS); }
__device__ __forceinline__ void row_scale(RowV& r, float rstd, const float* g, int lane) { const f32x4* gg = (const f32x4*)g + lane;
#pragma unroll
    for (int j = 0; j < 4; ++j) r.v[j] = r.v[j] * rstd * gg[64 * j]; }
__device__ __forceinline__ void row_store_bf16(const RowV& r, bf16_t* p, int lane) { u32x2* o = (u32x2*)p + lane;
#pragma unroll
    for (int j = 0; j < 4; ++j) { u32x2 w; w.x = pk2(r.v[j].x, r.v[j].y); w.y = pk2(r.v[j].z, r.v[j].w); o[64 * j] = w; } }

__device__ __forceinline__ float row_store_i8(const RowV& r, signed char* p, int lane) {
    float am = 0.f;
#pragma unroll
    for (int j = 0; j < 4; ++j) am = fmaxf(am, fmaxf(fmaxf(fabsf(r.v[j].x), fabsf(r.v[j].y)), fmaxf(fabsf(r.v[j].z), fabsf(r.v[j].w))));
#pragma unroll
    for (int o = 1; o < 64; o <<= 1) am = fmaxf(am, __shfl_xor(am, o));
    const float inv = am > 0.f ? 127.0f / am : 0.f; unsigned* o4 = (unsigned*)p + lane;
#pragma unroll
    for (int j = 0; j < 4; ++j) { const unsigned a = (unsigned)__float2int_rn(r.v[j].x * inv) & 255u, b = (unsigned)__float2int_rn(r.v[j].y * inv) & 255u, c = (unsigned)__float2int_rn(r.v[j].z * inv) & 255u, d = (unsigned)__float2int_rn(r.v[j].w * inv) & 255u;
        o4[64 * j] = a | (b << 8) | (c << 16) | (d << 24); }
    return am * (1.0f / 127.0f);
}
__device__ __forceinline__ void row_combine(Frame& F, RowV& r, int t) {
    const int* sl = (const int*)(F.ws + WS_MISC + MS_SLOT) + 2 * t; const float* tw = (const float*)(F.ws + WS_MISC + MS_TOKW) + 2 * t;
    const bf16_t* Y = (const bf16_t*)(F.ws + WS_R + R_YOUT);
    const int s0 = sl[0], s1 = sl[1]; const float w0 = tw[0], w1 = tw[1];
    row_add_bf16(r, Y + (size_t)s0 * DM, w0, F.lane); row_add_bf16(r, Y + (size_t)s1 * DM, w1, F.lane);
}

__device__ __forceinline__ void norm_phase(Frame& F, const float* srcf, bf16_t* X, const float* g, bool combine, bool out_i8) {
    bf16_t* H = (bf16_t*)(F.ws + WS_H); signed char* Hq = (signed char*)(F.ws + WS_H); float* hsc = (float*)(F.ws + WS_MISC + MS_HSC);
    const int gw = F.vcu * NWAVES + F.wave, NGW = F.G * NWAVES;
    for (int t = gw; t < T; t += 2 * NGW) {
        const int t2 = t + NGW;
        RowV r, q;
        if (srcf) { row_load(r, srcf + (size_t)t * DM, F.lane); row_load(q, srcf + (size_t)t2 * DM, F.lane); }
        else { row_load_bf16(r, X + (size_t)t * DM, F.lane); row_load_bf16(q, X + (size_t)t2 * DM, F.lane); }
        if (combine) { row_combine(F, r, t); row_combine(F, q, t2); row_store_bf16(r, X + (size_t)t * DM, F.lane); row_store_bf16(q, X + (size_t)t2 * DM, F.lane);
            row_round_bf16(r); row_round_bf16(q); }
        const float rstd = row_rstd(r), qstd = row_rstd(q); row_scale(r, rstd, g, F.lane); row_scale(q, qstd, g, F.lane);
        if (out_i8) { const float sc = row_store_i8(r, Hq + (size_t)t * DM, F.lane), sq = row_store_i8(q, Hq + (size_t)t2 * DM, F.lane); if (F.lane == 0) { hsc[t] = sc; hsc[t2] = sq; } }
        else { row_store_bf16(r, H + (size_t)t * DM, F.lane); row_store_bf16(q, H + (size_t)t2 * DM, F.lane); }
    }
}
__device__ __forceinline__ void final_norm_phase(Frame& F, const bf16_t* X, float* out, const float* g, bool combine) {
    const int gw = F.vcu * NWAVES + F.wave, NGW = F.G * NWAVES;
    for (int t = gw; t < T; t += 2 * NGW) {
        const int t2 = t + NGW;
        RowV r, q; row_load_bf16(r, X + (size_t)t * DM, F.lane); row_load_bf16(q, X + (size_t)t2 * DM, F.lane);
        if (combine) { row_combine(F, r, t); row_combine(F, q, t2); }
        const float rstd = row_rstd(r), qstd = row_rstd(q); row_scale(r, rstd, g, F.lane); row_scale(q, qstd, g, F.lane);
        row_store(r, out + (size_t)t * DM, F.lane); row_store(q, out + (size_t)t2 * DM, F.lane);
    }
}
__device__ __forceinline__ void memnorm_phase(Frame& F) {
    bf16_t* MN = (bf16_t*)(F.ws + WS_MEMN);
    const int gw = F.vcu * NWAVES + F.wave, NGW = F.G * NWAVES;
    for (int t = gw; t < NB * MEML; t += NGW) {
        RowV r; row_load(r, F.in[I_MEM] + (size_t)t * DM, F.lane);
        const float rstd = row_rstd(r); row_scale(r, rstd, F.in[I_GMEM], F.lane);
        row_store_bf16(r, MN + (size_t)t * DM, F.lane);
    }
}

__device__ __forceinline__ void norm_router_phase(Frame& F, const bf16_t* X, const float* g, const float* Wr  , bool out_i8) {
    bf16_t* H = (bf16_t*)(F.ws + WS_H); signed char* Hq = (signed char*)(F.ws + WS_H); float* hsc = (float*)(F.ws + WS_MISC + MS_HSC);
    int* toke = (int*)(F.ws + WS_MISC + MS_TOKE); float* tokw = (float*)(F.ws + WS_MISC + MS_TOKW); int* cntg = (int*)(F.ws + WS_MISC + MS_CNT);
    volatile LAS int* hist = (volatile LAS int*)(F.lds + LDSCTL_OFF + 1024);
    f32x4 wa[4][4], wb[4][4];
#pragma unroll
    for (int j = 0; j < 4; ++j)
#pragma unroll
        for (int k = 0; k < 4; ++k) { const int d = 256 * j + 4 * F.lane + k; wa[j][k] = *(const f32x4*)(Wr + (size_t)d * 8); wb[j][k] = *(const f32x4*)(Wr + (size_t)d * 8 + 4); }
    const bool up32 = (F.lane & 32) != 0, up16 = (F.lane & 16) != 0, up8 = (F.lane & 8) != 0;
    for (int c = F.vcu; c < T / 128; c += F.G) {
        if (F.tid < 8) hist[F.tid] = 0;
        __syncthreads();
        for (int q = 0; q < 16; ++q) {
            const int t = c * 128 + F.wave * 16 + q;
            RowV r; row_load_bf16(r, X + (size_t)t * DM, F.lane);
            const float rstd = row_rstd(r); row_scale(r, rstd, g, F.lane);
            if (out_i8) { const float sc = row_store_i8(r, Hq + (size_t)t * DM, F.lane); if (F.lane == 0) hsc[t] = sc; }
            else row_store_bf16(r, H + (size_t)t * DM, F.lane);
            f32x4 la = {0.f, 0.f, 0.f, 0.f}, lb = {0.f, 0.f, 0.f, 0.f};
#pragma unroll
            for (int j = 0; j < 4; ++j)
#pragma unroll
                for (int k = 0; k < 4; ++k) { const float x = r.v[j][k]; la += wa[j][k] * x; lb += wb[j][k] * x; }
            f32x4 h4; { const f32x4 keep = up32 ? lb : la, send = up32 ? la : lb;
#pragma unroll
                for (int i = 0; i < 4; ++i) h4[i] = keep[i] + __shfl_xor(send[i], 32); }
            f32x2 h2; { const float k0 = up16 ? h4[2] : h4[0], k1 = up16 ? h4[3] : h4[1], s0 = up16 ? h4[0] : h4[2], s1 = up16 ? h4[1] : h4[3]; h2.x = k0 + __shfl_xor(s0, 16); h2.y = k1 + __shfl_xor(s1, 16); }
            float h1 = (up8 ? h2.y : h2.x) + __shfl_xor(up8 ? h2.x : h2.y, 8);
            h1 += __shfl_xor(h1, 4); h1 += __shfl_xor(h1, 2); h1 += __shfl_xor(h1, 1);
            float lg[8];
#pragma unroll
            for (int e = 0; e < 8; ++e) lg[e] = __builtin_bit_cast(float, __builtin_amdgcn_readlane(__builtin_bit_cast(int, h1), 8 * e));
            int e0 = 0; float v0 = lg[0];
#pragma unroll
            for (int e = 1; e < 8; ++e) if (lg[e] > v0) { v0 = lg[e]; e0 = e; }
            int e1 = -1; float v1 = -INFINITY;
#pragma unroll
            for (int e = 0; e < 8; ++e) if (e != e0 && lg[e] > v1) { v1 = lg[e]; e1 = e; }
            if (F.lane == 0) {
                const float w0 = 1.0f / (1.0f + __expf(v1 - v0));
                toke[2 * t] = e0; toke[2 * t + 1] = e1; tokw[2 * t] = w0; tokw[2 * t + 1] = 1.0f - w0;
                __hip_atomic_fetch_add((LAS int*)&hist[e0], 1, __ATOMIC_RELAXED, __HIP_MEMORY_SCOPE_WORKGROUP); __hip_atomic_fetch_add((LAS int*)&hist[e1], 1, __ATOMIC_RELAXED, __HIP_MEMORY_SCOPE_WORKGROUP);
            }
        }
        __syncthreads();
        if (F.tid < 8) cntg[c * 8 + F.tid] = hist[F.tid];
        __syncthreads();
    }
}
__device__ __forceinline__ void moe_assign_phase(Frame& F, bool i8) {
    const bf16_t* H = (const bf16_t*)(F.ws + WS_H); bf16_t* AS = (bf16_t*)(F.ws + WS_R + R_ASORT);
    const float* hsc = (const float*)(F.ws + WS_MISC + MS_HSC); float* asc = (float*)(F.ws + WS_MISC + MS_ASC);
    const int* toke = (const int*)(F.ws + WS_MISC + MS_TOKE); int* slot = (int*)(F.ws + WS_MISC + MS_SLOT); const int* cntg = (const int*)(F.ws + WS_MISC + MS_CNT);
    int* texp = (int*)(F.ws + WS_MISC + MS_TEXP);
    volatile LAS int* tot = (volatile LAS int*)(F.lds + LDSCTL_OFF + 1024);
    volatile LAS int* pre = tot + 8;
    volatile LAS int* wcnt = tot + 16;
    for (int c = F.vcu; c < T / 128; c += F.G) {
        if (F.tid < 16) tot[F.tid] = 0;
        __syncthreads();
        { const int cc = F.tid >> 1, h = F.tid & 1; const i32x4 v = *(const i32x4*)(cntg + cc * 8 + 4 * h);
#pragma unroll
          for (int k = 0; k < 4; ++k) { __hip_atomic_fetch_add((LAS int*)&tot[4 * h + k], v[k], __ATOMIC_RELAXED, __HIP_MEMORY_SCOPE_WORKGROUP); if (cc < c) __hip_atomic_fetch_add((LAS int*)&pre[4 * h + k], v[k], __ATOMIC_RELAXED, __HIP_MEMORY_SCOPE_WORKGROUP); } }
        const int t = c * 128 + F.wave * 16 + ((F.lane & 31) >> 1);
        const int my_e = (F.lane < 32) ? toke[2 * t + (F.lane & 1)] : -1;
        int rank = 0;
#pragma unroll
        for (int e = 0; e < 8; ++e) { const unsigned long long m = __ballot(my_e == e); if (my_e == e) rank = __popcll(m & ((1ull << F.lane) - 1ull)); if (F.lane == 0) wcnt[F.wave * 8 + e] = __popcll(m); }
        __syncthreads();
        int myslot = 0;
        if (F.lane < 32) {
            int ts = 0;
#pragma unroll
            for (int e = 0; e < 8; ++e) ts += (e < my_e) ? ((tot[e] + 255) >> 8) : 0;
            int wp = 0; for (int w = 0; w < F.wave; ++w) wp += wcnt[w * 8 + my_e];
            myslot = ts * 256 + pre[my_e] + wp + rank;
            slot[2 * t + (F.lane & 1)] = myslot;
        }
        if (c == 0 && F.tid == 0) { int ts = 0; for (int e = 0; e < 8; ++e) { const int n = (tot[e] + 255) >> 8; for (int k = 0; k < n; ++k) texp[ts + k] = e; ts += n; } for (int k = ts; k < MAXRT; ++k) texp[k] = 0; texp[MAXRT] = ts; }
        if (i8) {
            const float myh = hsc[t];
#pragma unroll 1
            for (int a0 = 0; a0 < 32; a0 += 8) {
                u32x4 x[4];
#pragma unroll
                for (int k = 0; k < 4; ++k) x[k] = *((const u32x4*)((const signed char*)H + (size_t)(c * 128 + F.wave * 16 + ((a0 + 2 * k) >> 1)) * DM) + F.lane);
#pragma unroll
                for (int k = 0; k < 8; ++k) { const int s = __builtin_amdgcn_readlane(myslot, a0 + k); *((u32x4*)((signed char*)AS + (size_t)s * DM) + F.lane) = x[k >> 1]; }
            }
            if (F.lane < 32) asc[myslot] = myh;
        } else {
            for (int a = 0; a < 32; ++a) {
                const int s = __builtin_amdgcn_readlane(myslot, a); const int ta = c * 128 + F.wave * 16 + (a >> 1);
                const u32x4* srcp = (const u32x4*)(H + (size_t)ta * DM) + F.lane; u32x4* dstp = (u32x4*)(AS + (size_t)s * DM) + F.lane;
                const u32x4 x0 = srcp[0], x1 = srcp[64]; dstp[0] = x0; dstp[64] = x1; }
        }
        __syncthreads();
    }
}

using pg8::Unit;
typedef f32x4 AccT[2][2][4][2];

struct ProbSimple { int K; unsigned lda, ldb; const char* A; const char* B;
    __device__ __forceinline__ const char* a_ptr(const Unit& u) const { return A + (size_t)u.pm * 256 * lda; }
    __device__ __forceinline__ const char* b_ptr(const Unit& u) const { return B + (size_t)u.pn * 256 * ldb; } };
struct ProbUp { int K; unsigned lda, ldb; const char* A; const char* B;
    __device__ __forceinline__ const char* a_ptr(const Unit& u) const { return A + (size_t)u.pm * 256 * lda + (u.pn >= 3 ? 256 : 0); }
    __device__ __forceinline__ const char* b_ptr(const Unit& u) const { return B + (size_t)u.pn * 256 * ldb; } };
struct ProbMoe { int K; unsigned lda, ldb; const char* A; const char* B; int a_lo;
    __device__ __forceinline__ const char* a_ptr(const Unit& u) const { return A + (size_t)(u.pm - a_lo) * 256 * lda; }
    __device__ __forceinline__ const char* b_ptr(const Unit& u) const { return B + (size_t)u.aux * WF_STRIDE + (size_t)u.pn * 256 * ldb; } };

struct MoeOrder { pg8::StaticOrder base; int lo; const int* texp;
    __device__ bool next(int i, Unit& u) const { if (!base.next(i, u)) return false; u.pm += lo; u.aux = __builtin_amdgcn_readfirstlane(texp[u.pm]); return true; } };

__device__ __forceinline__ u32x4 pack8(const f32x4 a, const f32x4 b) { u32x4 w; w.x = cvtpk(a[0], a[1]); w.y = cvtpk(a[2], a[3]); w.z = cvtpk(b[0], b[1]); w.w = cvtpk(b[2], b[3]); return w; }
__device__ __forceinline__ u32x2 pack4(const f32x4 a) { u32x2 w; w.x = cvtpk(a[0], a[1]); w.y = cvtpk(a[2], a[3]); return w; }

struct EpiNoStage { __device__ __forceinline__ void stage(LAS unsigned char*, const Unit&, int, int) const {} };
__device__ __forceinline__ void stage1k(const void* src, LAS unsigned char* dst, int lane) { __builtin_amdgcn_global_load_lds((const unsigned*)((const char*)src + lane * 16), (LAS unsigned*)dst, 16, 0, 0); }
__device__ __forceinline__ f32x4 deq(const f32x4& a, float, const f32x4&) { return a; }
__device__ __forceinline__ f32x4 deq(const i32x4& a, float rs, const f32x4& cs) { return __builtin_convertvector(a, f32x4) * rs * cs; }
struct EpiInproj {
    static constexpr bool MID = false;
    bf16_t* P; bf16_t* G; float* ssq; const int* pos; const float* rsc; const float* csc;
    __device__ __forceinline__ void stage(LAS unsigned char* d, const Unit& u, int wid, int lane) const {
        if (wid == 0) { stage1k(rsc + u.pm * 256, d, lane); stage1k(csc + u.pn * 256, d + 1024, lane); stage1k(pos + u.pm * 256, d + 2048, lane); } }
    template <class AV> __device__ __forceinline__ void operator()(const AV (&acc)[2][2][4][2], const Unit& u, int wr, int wc, int fr, int fq, const LAS unsigned char* esc) const {
        const int pn = u.pn, row0 = u.pm * 256 + wr * 64 + fr;
        f32x4 cs[2][2];
#pragma unroll
        for (int bj = 0; bj < 2; ++bj)
#pragma unroll
            for (int n = 0; n < 2; ++n) cs[bj][n] = *(const LAS f32x4*)(esc + 1024 + (bj * 128 + wc * 32 + n * 16 + fq * 4) * 4);
        float rs8[2][4], pf8[2][4];
#pragma unroll
        for (int ai = 0; ai < 2; ++ai)
#pragma unroll
            for (int m = 0; m < 4; ++m) { const int rl = ai * 128 + wr * 64 + m * 16 + fr; rs8[ai][m] = *(const LAS float*)(esc + rl * 4); pf8[ai][m] = (float)*(const LAS int*)(esc + 2048 + rl * 4); }
#define DQ(ai, bj, m, n) deq(acc[ai][bj][m][n], rs, cs[bj][n])
        if (pn >= 7) {
#pragma unroll
            for (int ai = 0; ai < 2; ++ai)
#pragma unroll
                for (int m = 0; m < 4; ++m) { const int row = row0 + ai * 128 + m * 16; const float rs = rs8[ai][m]; u32x4 w;
#pragma unroll
                    for (int bj = 0; bj < 2; ++bj) { f32x4 a = DQ(ai, bj, m, 0), b = DQ(ai, bj, m, 1);
#pragma unroll
                        for (int j = 0; j < 4; ++j) { a[j] = fast_sigmoid(a[j]) * 255.0f; b[j] = fast_sigmoid(b[j]) * 255.0f; }
                        const unsigned wa_ = (unsigned)__float2int_rn(a[0]) | ((unsigned)__float2int_rn(a[1]) << 8) | ((unsigned)__float2int_rn(a[2]) << 16) | ((unsigned)__float2int_rn(a[3]) << 24);
                        const unsigned wb_ = (unsigned)__float2int_rn(b[0]) | ((unsigned)__float2int_rn(b[1]) << 8) | ((unsigned)__float2int_rn(b[2]) << 16) | ((unsigned)__float2int_rn(b[3]) << 24);
                        if (bj == 0) { w.x = wa_; w.y = wb_; } else { w.z = wa_; w.w = wb_; } }
                    *(u32x4*)((unsigned char*)G + (size_t)row * GW + (pn - 7) * 256 + wc * 64 + fq * 16) = w; }
        } else if (pn >= 5 || pn == 3) {
            const float sc = (pn == 3) ? 1.0f : C_M;
#pragma unroll
            for (int ai = 0; ai < 2; ++ai)
#pragma unroll
                for (int m = 0; m < 4; ++m) { const int row = row0 + ai * 128 + m * 16; const float rs = rs8[ai][m]; float s = 0.f;
#pragma unroll
                    for (int bj = 0; bj < 2; ++bj) { const f32x4 a = DQ(ai, bj, m, 0) * sc, b = DQ(ai, bj, m, 1) * sc;
                        s += (a[0] * a[0] + a[1] * a[1]) + (a[2] * a[2] + a[3] * a[3]) + (b[0] * b[0] + b[1] * b[1]) + (b[2] * b[2] + b[3] * b[3]);
                        *(u32x4*)(P + (size_t)row * PW + pn * 256 + bj * 128 + wc * 32 + fq * 8) = pack8(a, b); }
                    if (pn == 3) { s += __shfl_xor(s, 16); s += __shfl_xor(s, 32); if (fq == 0) ssq[(size_t)row * 8 + wc] = s; } }
        } else if (pn == 4) {
#pragma unroll
            for (int ai = 0; ai < 2; ++ai)
#pragma unroll
                for (int m = 0; m < 4; ++m) { const int row = row0 + ai * 128 + m * 16; const float rs = rs8[ai][m];
                    { const f32x4 a = DQ(ai, 0, m, 0), b = DQ(ai, 0, m, 1);
                      float s = (a[0] * a[0] + a[1] * a[1]) + (a[2] * a[2] + a[3] * a[3]) + (b[0] * b[0] + b[1] * b[1]) + (b[2] * b[2] + b[3] * b[3]);
                      *(u32x4*)(P + (size_t)row * PW + P_CKV + wc * 32 + fq * 8) = pack8(a, b);
                      s += __shfl_xor(s, 16); s += __shfl_xor(s, 32); if (fq == 0) ssq[(size_t)row * 8 + 4 + wc] = s; }
                    if (wc == 0) { const f32x4 x1 = DQ(ai, 1, m, 0), x2 = DQ(ai, 1, m, 1); const float pf = pf8[ai][m]; f32x4 o1, o2;
#pragma unroll
                        for (int j = 0; j < 4; ++j) { float c, s; rot_cs(pf, 2 * (4 * fq + j), c, s); o1[j] = x1[j] * c - x2[j] * s; o2[j] = x2[j] * c + x1[j] * s; }
                        *(u32x2*)(P + (size_t)row * PW + P_KR + 4 * fq) = pack4(o1); *(u32x2*)(P + (size_t)row * PW + P_KR + 16 + 4 * fq) = pack4(o2); } }
        } else {
            const float sc = (pn < 2) ? C_A : 1.0f; const int i0 = 16 * (wc & 1) + 4 * fq;
#pragma unroll
            for (int ai = 0; ai < 2; ++ai)
#pragma unroll
                for (int m = 0; m < 4; ++m) { const int row = row0 + ai * 128 + m * 16; const float rs = rs8[ai][m]; const float pf = pf8[ai][m]; f32x4 c, s;
#pragma unroll
                    for (int j = 0; j < 4; ++j) { float cc, ss; rot_cs(pf, i0 + j, cc, ss); c[j] = cc * sc; s[j] = ss * sc; }
#pragma unroll
                    for (int bj = 0; bj < 2; ++bj) { const f32x4 x1 = DQ(ai, bj, m, 0), x2 = DQ(ai, bj, m, 1);
                        if (pn == 2 && bj == 1) { *(u32x4*)(P + (size_t)row * PW + P_VA + wc * 32 + fq * 8) = pack8(x1, x2); }
                        else { const f32x4 o1 = x1 * c - x2 * s, o2 = x2 * c + x1 * s; bf16_t* d = P + (size_t)row * PW + pn * 256 + 64 * (2 * bj + (wc >> 1)) + i0;
                            *(u32x2*)d = pack4(o1); *(u32x2*)(d + 32) = pack4(o2); } } }
        }
#undef DQ
    }
};
struct EpiUp {
    static constexpr bool MID = false;
    __device__ __forceinline__ void stage(LAS unsigned char*, const Unit&, int, int) const {}
    bf16_t* QB; bf16_t* KVB; const float* ssq; const int* pos;
    __device__ __forceinline__ void operator()(const AccT& acc, const Unit& u, int wr, int wc, int fr, int fq, const LAS unsigned char*) const {
        const int pn = u.pn, row0 = u.pm * 256 + wr * 64 + fr;
        float rs8[2][4], pf8[2][4];
#pragma unroll
        for (int ai = 0; ai < 2; ++ai)
#pragma unroll
            for (int m = 0; m < 4; ++m) { const int row = row0 + ai * 128 + m * 16; const f32x4 sv = *(const f32x4*)(ssq + (size_t)row * 8 + (pn < 3 ? 0 : 4));
                rs8[ai][m] = (pn < 3 ? C_B : 1.0f) / sqrtf(((sv[0] + sv[1]) + (sv[2] + sv[3])) * (pn < 3 ? 1.0f / 256.0f : 1.0f / 128.0f) + EPS); pf8[ai][m] = (pn < 3) ? (float)pos[row] : 0.f; }
#pragma unroll
        for (int ai = 0; ai < 2; ++ai)
#pragma unroll
            for (int m = 0; m < 4; ++m) { const int row = row0 + ai * 128 + m * 16; const float rs = rs8[ai][m];
                if (pn < 3) {
#pragma unroll
                    for (int bj = 0; bj < 2; ++bj) { const int gg = 8 * pn + 4 * bj + wc; const f32x4 x1 = acc[ai][bj][m][0] * rs, x2 = acc[ai][bj][m][1] * rs;
                        if (gg % 3 == 2) { const float pf = pf8[ai][m]; f32x4 o1, o2;
#pragma unroll
                            for (int j = 0; j < 4; ++j) { float c, s; rot_cs(pf, 2 * (4 * fq + j), c, s); o1[j] = x1[j] * c - x2[j] * s; o2[j] = x2[j] * c + x1[j] * s; }
                            bf16_t* d = QB + (size_t)row * QBW + 32 * gg + 4 * fq; *(u32x2*)d = pack4(o1); *(u32x2*)(d + 16) = pack4(o2); }
                        else *(u32x4*)(QB + (size_t)row * QBW + 32 * gg + 8 * fq) = pack8(x1, x2); }
                } else {
#pragma unroll
                    for (int bj = 0; bj < 2; ++bj) *(u32x4*)(KVB + (size_t)row * KVW + (pn - 3) * 256 + bj * 128 + wc * 32 + fq * 8) = pack8(acc[ai][bj][m][0] * rs, acc[ai][bj][m][1] * rs);
                } }
    }
};
struct EpiPlain {
    static constexpr bool MID = false;
    __device__ __forceinline__ void stage(LAS unsigned char*, const Unit&, int, int) const {}
    bf16_t* O; int ldo;
    __device__ __forceinline__ void operator()(const AccT& acc, const Unit& u, int wr, int wc, int fr, int fq, const LAS unsigned char*) const {
        const int row0 = u.pm * 256 + wr * 64 + fr;
#pragma unroll
        for (int ai = 0; ai < 2; ++ai)
#pragma unroll
            for (int m = 0; m < 4; ++m)
#pragma unroll
                for (int bj = 0; bj < 2; ++bj) *(u32x4*)(O + (size_t)(row0 + ai * 128 + m * 16) * ldo + u.pn * 256 + bj * 128 + wc * 32 + fq * 8) = pack8(acc[ai][bj][m][0], acc[ai][bj][m][1]);
    }
};
struct EpiBranch {
    static constexpr bool MID = true;
    const unsigned char* G; bf16_t* MIXED;
    __device__ __forceinline__ void stage(LAS unsigned char*, const Unit&, int, int) const {}
    static __device__ __forceinline__ float gq(unsigned w, int b) { const float f = (float)((w >> (8 * b)) & 255u); return fmaxf(f, 2.55e-4f); }
    __device__ __forceinline__ void mid(AccT& acc, const Unit& u, int seg  , int wr, int wc, int fr, int fq) const {
        const int row0 = opq_v(u.pm * 256 + wr * 64 + fr);
#pragma unroll
        for (int ai = 0; ai < 2; ++ai) {
            u32x4 ga[4], gb[4];
#pragma unroll
            for (int m = 0; m < 4; ++m) { const unsigned char* gp = G + (size_t)(row0 + ai * 128 + m * 16) * GW + u.pn * 256 + wc * 64 + fq * 16;
                ga[m] = *(const u32x4*)(gp + (seg - 1) * 1024); gb[m] = *(const u32x4*)(gp + seg * 1024); }
#pragma unroll
            for (int m = 0; m < 4; ++m) {
#pragma unroll
                for (int j = 0; j < 4; ++j) {
                    acc[ai][0][m][0][j] *= gq(ga[m].x, j) * __builtin_amdgcn_rcpf(gq(gb[m].x, j)); acc[ai][0][m][1][j] *= gq(ga[m].y, j) * __builtin_amdgcn_rcpf(gq(gb[m].y, j));
                    acc[ai][1][m][0][j] *= gq(ga[m].z, j) * __builtin_amdgcn_rcpf(gq(gb[m].z, j)); acc[ai][1][m][1][j] *= gq(ga[m].w, j) * __builtin_amdgcn_rcpf(gq(gb[m].w, j)); } }
            asm volatile("" ::: "memory"); }
    }
    __device__ __forceinline__ void operator()(const AccT& acc, const Unit& u, int wr, int wc, int fr, int fq, const LAS unsigned char*) const {
        const int row0 = u.pm * 256 + wr * 64 + fr;
#pragma unroll
        for (int ai = 0; ai < 2; ++ai) {
            u32x4 gw[4];
#pragma unroll
            for (int m = 0; m < 4; ++m) gw[m] = *(const u32x4*)(G + (size_t)(row0 + ai * 128 + m * 16) * GW + 2048 + u.pn * 256 + wc * 64 + fq * 16);
#pragma unroll
            for (int m = 0; m < 4; ++m) { f32x4 a0 = acc[ai][0][m][0], b0 = acc[ai][0][m][1], a1 = acc[ai][1][m][0], b1 = acc[ai][1][m][1];
#pragma unroll
                for (int j = 0; j < 4; ++j) { a0[j] *= gq(gw[m].x, j) * (1.0f / 255.0f); b0[j] *= gq(gw[m].y, j) * (1.0f / 255.0f); a1[j] *= gq(gw[m].z, j) * (1.0f / 255.0f); b1[j] *= gq(gw[m].w, j) * (1.0f / 255.0f); }
                bf16_t* d = MIXED + (size_t)(row0 + ai * 128 + m * 16) * DM + u.pn * 256 + wc * 64 + fq * 16;
                *(u32x4*)d = pack8(a0, b0); *(u32x4*)(d + 8) = pack8(a1, b1); }
            asm volatile("" ::: "memory"); }
    }
};
struct EpiResid {
    static constexpr bool MID = false;
    __device__ __forceinline__ void stage(LAS unsigned char*, const Unit&, int, int) const {}
    const float* Xf; bf16_t* X;
    __device__ __forceinline__ void operator()(const AccT& acc, const Unit& u, int wr, int wc, int fr, int fq, const LAS unsigned char*) const {
        const int row0 = u.pm * 256 + wr * 64 + fr;
#pragma unroll
        for (int ai = 0; ai < 2; ++ai) {
            f32x4 xa[4][2], xb[4][2];
#pragma unroll
            for (int m = 0; m < 4; ++m)
#pragma unroll
                for (int bj = 0; bj < 2; ++bj) { const size_t o = (size_t)(row0 + ai * 128 + m * 16) * DM + u.pn * 256 + bj * 128 + wc * 32 + fq * 8;
                    if (Xf) { xa[m][bj] = *(const f32x4*)(Xf + o); xb[m][bj] = *(const f32x4*)(Xf + o + 4); }
                    else { const u32x4 q = *(const u32x4*)(X + o); xa[m][bj] = (f32x4){bflo(q.x), bfhi(q.x), bflo(q.y), bfhi(q.y)}; xb[m][bj] = (f32x4){bflo(q.z), bfhi(q.z), bflo(q.w), bfhi(q.w)}; } }
#pragma unroll
            for (int m = 0; m < 4; ++m)
#pragma unroll
                for (int bj = 0; bj < 2; ++bj) *(u32x4*)(X + (size_t)(row0 + ai * 128 + m * 16) * DM + u.pn * 256 + bj * 128 + wc * 32 + fq * 8) = pack8(xa[m][bj] + acc[ai][bj][m][0], xb[m][bj] + acc[ai][bj][m][1]);
            asm volatile("" ::: "memory"); }
    }
};
struct EpiSwiglu {
    static constexpr bool MID = false;
    bf16_t* ACT; int lo; const float* rsc; const float* csc;
    __device__ __forceinline__ void stage(LAS unsigned char* d, const Unit& u, int wid, int lane) const {
        if (wid == 0) { stage1k(rsc + u.pm * 256, d, lane); stage1k(csc + (size_t)u.aux * 2 * DFF + u.pn * 256, d + 1024, lane); } }
    template <class AV> __device__ __forceinline__ void operator()(const AV (&acc)[2][2][4][2], const Unit& u, int wr, int wc, int fr, int fq, const LAS unsigned char* esc) const {
        const int row0 = (u.pm - lo) * 256 + wr * 64 + fr;
        f32x4 cs[2][2];
#pragma unroll
        for (int bj = 0; bj < 2; ++bj)
#pragma unroll
            for (int n = 0; n < 2; ++n) cs[bj][n] = *(const LAS f32x4*)(esc + 1024 + (bj * 128 + wc * 32 + n * 16 + fq * 4) * 4);
        float rs8[2][4];
#pragma unroll
        for (int ai = 0; ai < 2; ++ai)
#pragma unroll
            for (int m = 0; m < 4; ++m) rs8[ai][m] = *(const LAS float*)(esc + (ai * 128 + wr * 64 + m * 16 + fr) * 4);
#pragma unroll
        for (int ai = 0; ai < 2; ++ai)
#pragma unroll
            for (int m = 0; m < 4; ++m) { const float rs = rs8[ai][m]; f32x4 a, b;
                const f32x4 g0 = deq(acc[ai][0][m][0], rs, cs[0][0]), g1 = deq(acc[ai][0][m][1], rs, cs[0][1]), u0 = deq(acc[ai][1][m][0], rs, cs[1][0]), u1 = deq(acc[ai][1][m][1], rs, cs[1][1]);
#pragma unroll
                for (int j = 0; j < 4; ++j) { a[j] = g0[j] * fast_sigmoid(g0[j]) * u0[j]; b[j] = g1[j] * fast_sigmoid(g1[j]) * u1[j]; }
                *(u32x4*)(ACT + (size_t)(row0 + ai * 128 + m * 16) * DFF + u.pn * 128 + wc * 32 + fq * 8) = pack8(a, b); }
    }
};
struct EpiYout {
    static constexpr bool MID = false;
    __device__ __forceinline__ void stage(LAS unsigned char*, const Unit&, int, int) const {}
    bf16_t* Y;
    __device__ __forceinline__ void operator()(const AccT& acc, const Unit& u, int wr, int wc, int fr, int fq, const LAS unsigned char*) const {
        const int row0 = u.pm * 256 + wr * 64 + fr;
#pragma unroll
        for (int ai = 0; ai < 2; ++ai)
#pragma unroll
            for (int m = 0; m < 4; ++m)
#pragma unroll
                for (int bj = 0; bj < 2; ++bj) *(u32x4*)(Y + (size_t)(row0 + ai * 128 + m * 16) * DM + u.pn * 256 + bj * 128 + wc * 32 + fq * 8) = pack8(acc[ai][bj][m][0], acc[ai][bj][m][1]);
    }
};

namespace att {
__device__ __forceinline__ int crow(int r, int hi) { return (r & 3) + 8 * (r >> 2) + 4 * hi; }
__device__ __forceinline__ void glds16(const void* gsrc, unsigned lds_dst) { unsigned keep;
    asm volatile("s_mov_b32 %0, m0\n\ts_mov_b32 m0, %2\n\ts_nop 0\n\tglobal_load_lds_dwordx4 %1, off\n\ts_mov_b32 m0, %0" : "=&s"(keep) : "v"(gsrc), "s"(lds_dst) : "memory"); }
__device__ __forceinline__ float swapmax(float m) { auto rr = __builtin_amdgcn_permlane32_swap(__float_as_uint(m), __float_as_uint(m), false, false); return fmaxf(__uint_as_float(rr[0]), __uint_as_float(rr[1])); }
__device__ __forceinline__ float swapsum(float m) { auto rr = __builtin_amdgcn_permlane32_swap(__float_as_uint(m), __float_as_uint(m), false, false); return __uint_as_float(rr[0]) + __uint_as_float(rr[1]); }
__device__ __forceinline__ s16x4 vtr(unsigned addr) { s16x4 r; asm volatile("ds_read_b64_tr_b16 %0, %1" : "=&v"(r) : "v"(addr) : "memory"); return r; }
#define VTRO(dst, base, off) asm volatile("ds_read_b64_tr_b16 %0, %1 offset:%c2" : "=&v"(dst) : "v"(base), "i"(off) : "memory")

struct Src {
    const bf16_t* q; int qpitch;
    const bf16_t* k0; int k0pitch;
    const bf16_t* k1; int k1pitch;
    const bf16_t* v; int vpitch;
    bf16_t* o; int opitch;
};
template <int NKC, int NVB, int RD = 4>
__device__ __forceinline__ void dma_tile(const Src& S, int t, int slot, unsigned lds0, int wid, int lane) {
    constexpr int KS = NKC * 1024, VS = NVB * 4096, LDS_K = 0, LDS_V = RD * KS;
#pragma unroll
    for (int c = 0; c < (NKC + 7) / 8; ++c) { const int ch = wid + 8 * c; if (ch < NKC) {
        const bf16_t* src = (ch < 8) ? S.k0 + (size_t)(t * 64 + lane) * S.k0pitch + ch * 8 : S.k1 + (size_t)(t * 64 + lane) * S.k1pitch + (ch - 8) * 8;
        glds16(src, (unsigned)__builtin_amdgcn_readfirstlane(lds0 + LDS_K + slot * KS + ch * 1024)); } }
#pragma unroll
    for (int c = 0; c < (NVB * 4 + 7) / 8; ++c) { const int p = wid + 8 * c; if (p < NVB * 4) {
        const bf16_t* src = S.v + (size_t)(t * 64 + 16 * (p & 3) + (lane >> 2)) * S.vpitch + (p >> 2) * 32 + (lane & 3) * 8;
        glds16(src, (unsigned)__builtin_amdgcn_readfirstlane(lds0 + LDS_V + slot * VS + p * 1024)); } }
}
__device__ __forceinline__ void wait_vm_bar(int n) {
    if (n >= 4) asm volatile("s_waitcnt vmcnt(4) lgkmcnt(0)\n\ts_barrier" ::: "memory");
    else if (n == 3) asm volatile("s_waitcnt vmcnt(3) lgkmcnt(0)\n\ts_barrier" ::: "memory");
    else if (n == 2) asm volatile("s_waitcnt vmcnt(2) lgkmcnt(0)\n\ts_barrier" ::: "memory");
    else if (n == 1) asm volatile("s_waitcnt vmcnt(1) lgkmcnt(0)\n\ts_barrier" ::: "memory");
    else asm volatile("s_waitcnt vmcnt(0) lgkmcnt(0)\n\ts_barrier" ::: "memory");
}
template <int NKC, int NVB, int MODE>
__device__ __forceinline__ void unit(LAS unsigned char* lds, const Src& S, int t_lo, int t_hi, int qpos0  , float sink_l2) {
    constexpr int KS = NKC * 1024, VS = NVB * 4096, RD = 4, LDS_K = 0, LDS_V = RD * KS;
    const int tid = opq_v((int)threadIdx.x), lane = tid & 63, r32 = lane & 31, hi = lane >> 5; const int wid = __builtin_amdgcn_readfirstlane(tid >> 6), grp = wid >> 2;
    const unsigned lds0 = (unsigned)(uintptr_t)lds;
    const int ops = (NKC + 7 - wid) / 8 + (NVB * 4) / 8;
    bf16x8 qr[NKC / 2];
#pragma unroll
    for (int d0 = 0; d0 < NKC / 2; ++d0) qr[d0] = *(const bf16x8*)(S.q + (size_t)r32 * S.qpitch + d0 * 16 + hi * 8);
    float m_run = (MODE == 0) ? sink_l2 : -INFINITY, l_run = (MODE == 0 && hi == 0) ? 1.0f : 0.0f;
    f32x16 o[NVB];
#pragma unroll
    for (int d = 0; d < NVB; ++d) o[d] = f32x16{};
    const int qi = qpos0 + wid * 32 + r32, qw0 = qpos0 + wid * 32;
    f32x16 p0 = f32x16{}, p1 = f32x16{};
#define AT_ACTIVE(t) ((MODE != 0) || ((64 * (t) + 63 >= qw0 - 128) && (64 * (t) <= qw0 + 31 + 128)))
#define AT_QK(t) do { const LAS unsigned char* kb_ = lds + LDS_K + (((t) - t_lo) % RD) * KS + hi * 1024 + r32 * 16; p0 = f32x16{}; p1 = f32x16{}; \
        _Pragma("unroll") for (int d0 = 0; d0 < NKC / 2; ++d0) { const bf16x8 b0_ = *(const LAS bf16x8*)(kb_ + d0 * 2048), b1_ = *(const LAS bf16x8*)(kb_ + d0 * 2048 + 512); \
            p0 = __builtin_amdgcn_mfma_f32_32x32x16_bf16(b0_, qr[d0], p0, 0, 0, 0); p1 = __builtin_amdgcn_mfma_f32_32x32x16_bf16(b1_, qr[d0], p1, 0, 0, 0); } } while (0)
#define AT_SMPV(t) do { \
        if (MODE == 0) { _Pragma("unroll") for (int r = 0; r < 16; ++r) { const int kv_ = 64 * (t) + crow(r, hi); int e0_ = kv_ - qi; e0_ = e0_ < 0 ? -e0_ : e0_; int e1_ = kv_ + 32 - qi; e1_ = e1_ < 0 ? -e1_ : e1_; \
            if (e0_ > 128) p0[r] = -INFINITY; if (e1_ > 128) p1[r] = -INFINITY; } } \
        float mx_[8]; _Pragma("unroll") for (int r = 0; r < 8; ++r) mx_[r] = fmaxf(fmaxf(p0[r], p0[r + 8]), fmaxf(p1[r], p1[r + 8])); \
        float rm_ = fmaxf(fmaxf(fmaxf(mx_[0], mx_[1]), fmaxf(mx_[2], mx_[3])), fmaxf(fmaxf(mx_[4], mx_[5]), fmaxf(mx_[6], mx_[7]))); rm_ = swapmax(rm_); \
        if (__any(rm_ > m_run)) { const float mn_ = fmaxf(m_run, rm_), alpha_ = __builtin_amdgcn_exp2f(m_run - mn_); m_run = mn_; l_run *= alpha_; \
            _Pragma("unroll") for (int d = 0; d < NVB; ++d) _Pragma("unroll") for (int r = 0; r < 16; ++r) o[d][r] *= alpha_; } \
        float sm_[4] = {0.f, 0.f, 0.f, 0.f}; \
        _Pragma("unroll") for (int r = 0; r < 16; ++r) { p0[r] = __builtin_amdgcn_exp2f(p0[r] - m_run); p1[r] = __builtin_amdgcn_exp2f(p1[r] - m_run); sm_[r & 3] += p0[r] + p1[r]; } \
        l_run += (sm_[0] + sm_[1]) + (sm_[2] + sm_[3]); \
        u32x4 pw_[4]; \
        pw_[0] = (u32x4){cvtpk(p0[0], p0[1]), cvtpk(p0[2], p0[3]), cvtpk(p0[4], p0[5]), cvtpk(p0[6], p0[7])}; pw_[1] = (u32x4){cvtpk(p0[8], p0[9]), cvtpk(p0[10], p0[11]), cvtpk(p0[12], p0[13]), cvtpk(p0[14], p0[15])}; \
        pw_[2] = (u32x4){cvtpk(p1[0], p1[1]), cvtpk(p1[2], p1[3]), cvtpk(p1[4], p1[5]), cvtpk(p1[6], p1[7])}; pw_[3] = (u32x4){cvtpk(p1[8], p1[9]), cvtpk(p1[10], p1[11]), cvtpk(p1[12], p1[13]), cvtpk(p1[14], p1[15])}; \
        const unsigned vb_ = lds0 + LDS_V + (((t) - t_lo) % RD) * VS + ((lane >> 4) & 1) * 32 + (lane & 3) * 8 + (4 * hi + ((lane & 15) >> 2)) * 64; \
        _Pragma("unroll") for (int dp = 0; dp < NVB; dp += 2) { s16x4 lo_[2][4], hh_[2][4]; \
            _Pragma("unroll") for (int dd = 0; dd < 2; ++dd) _Pragma("unroll") for (int ks = 0; ks < 4; ++ks) { lo_[dd][ks] = vtr(vb_ + (dp + dd) * 4096 + ks * 1024); hh_[dd][ks] = vtr(vb_ + (dp + dd) * 4096 + ks * 1024 + 512); } \
            asm volatile("s_waitcnt lgkmcnt(0)" ::: "memory"); __builtin_amdgcn_sched_barrier(0); \
            _Pragma("unroll") for (int ks = 0; ks < 4; ++ks) _Pragma("unroll") for (int dd = 0; dd < 2; ++dd) { \
                const bf16x8 vf_ = (bf16x8){lo_[dd][ks][0], lo_[dd][ks][1], lo_[dd][ks][2], lo_[dd][ks][3], hh_[dd][ks][0], hh_[dd][ks][1], hh_[dd][ks][2], hh_[dd][ks][3]}; \
                o[dp + dd] = __builtin_amdgcn_mfma_f32_32x32x16_bf16(vf_, __builtin_bit_cast(bf16x8, pw_[ks]), o[dp + dd], 0, 0, 0); } } } while (0)
    dma_tile<NKC, NVB>(S, t_lo, 0, lds0, wid, lane);
    if (t_lo + 1 < t_hi) dma_tile<NKC, NVB>(S, t_lo + 1, 1, lds0, wid, lane);
    for (int t = t_lo; t < t_hi; ++t) {
        wait_vm_bar((t + 1 < t_hi) ? ops : 0);
        if (t + 2 < t_hi) dma_tile<NKC, NVB>(S, t + 2, (t + 2 - t_lo) % RD, lds0, wid, lane);
        if (grp == 0) { if (AT_ACTIVE(t)) { AT_QK(t); AT_SMPV(t); } }
        else { if (t > t_lo && AT_ACTIVE(t - 1)) AT_SMPV(t - 1); if (AT_ACTIVE(t)) AT_QK(t); }
    }
    if (grp == 1 && AT_ACTIVE(t_hi - 1)) AT_SMPV(t_hi - 1);
    const float linv = 1.0f / swapsum(l_run);
#pragma unroll
    for (int d = 0; d < NVB; ++d)
#pragma unroll
        for (int r4 = 0; r4 < 4; ++r4) { f32x4 v = {o[d][4 * r4] * linv, o[d][4 * r4 + 1] * linv, o[d][4 * r4 + 2] * linv, o[d][4 * r4 + 3] * linv};
            *(u32x2*)(S.o + (size_t)r32 * S.opitch + 32 * d + 8 * r4 + 4 * hi) = pack4(v); }
    asm volatile("s_waitcnt lgkmcnt(0)\n\ts_barrier" ::: "memory");
#undef AT_ACTIVE
#undef AT_QK
#undef AT_SMPV
}

template <int NKC, int NVB>
__device__ __forceinline__ void unit_q64(LAS unsigned char* lds, const Src& S, int t_lo, int t_hi) {
    constexpr int KS = NKC * 1024, VS = NVB * 4096, RD = 4, LDS_K = 0, LDS_V = RD * KS;
    const int tid = opq_v((int)threadIdx.x), lane = tid & 63, r32 = lane & 31, hi = lane >> 5; const int wid = __builtin_amdgcn_readfirstlane(tid >> 6);
    const unsigned lds0 = (unsigned)(uintptr_t)lds;
    const int ops = (NKC + 7 - wid) / 8 + (NVB * 4) / 8;
    bf16x8 qa[NKC / 2], qb[NKC / 2];
#pragma unroll
    for (int d0 = 0; d0 < NKC / 2; ++d0) { qa[d0] = *(const bf16x8*)(S.q + (size_t)r32 * S.qpitch + d0 * 16 + hi * 8); qb[d0] = *(const bf16x8*)(S.q + (size_t)(32 + r32) * S.qpitch + d0 * 16 + hi * 8); }
    float ma = -INFINITY, la = 0.f, mb = -INFINITY, lb = 0.f;
    f32x16 oa[NVB], ob[NVB];
#pragma unroll
    for (int d = 0; d < NVB; ++d) { oa[d] = f32x16{}; ob[d] = f32x16{}; }
#define Q64_SM(P0, P1, M, L, O, PW) do { \
        float mx_[8]; _Pragma("unroll") for (int r = 0; r < 8; ++r) mx_[r] = fmaxf(fmaxf(P0[r], P0[r + 8]), fmaxf(P1[r], P1[r + 8])); \
        float rm_ = fmaxf(fmaxf(fmaxf(mx_[0], mx_[1]), fmaxf(mx_[2], mx_[3])), fmaxf(fmaxf(mx_[4], mx_[5]), fmaxf(mx_[6], mx_[7]))); rm_ = swapmax(rm_); \
        if (__any(rm_ > M)) { const float mn_ = fmaxf(M, rm_), alpha_ = __builtin_amdgcn_exp2f(M - mn_); M = mn_; L *= alpha_; \
            _Pragma("unroll") for (int d = 0; d < NVB; ++d) _Pragma("unroll") for (int r = 0; r < 16; ++r) O[d][r] *= alpha_; } \
        float sm_[4] = {0.f, 0.f, 0.f, 0.f}; \
        _Pragma("unroll") for (int r = 0; r < 16; ++r) { P0[r] = __builtin_amdgcn_exp2f(P0[r] - M); P1[r] = __builtin_amdgcn_exp2f(P1[r] - M); sm_[r & 3] += P0[r] + P1[r]; } \
        L += (sm_[0] + sm_[1]) + (sm_[2] + sm_[3]); \
        PW[0] = (u32x4){cvtpk(P0[0], P0[1]), cvtpk(P0[2], P0[3]), cvtpk(P0[4], P0[5]), cvtpk(P0[6], P0[7])}; PW[1] = (u32x4){cvtpk(P0[8], P0[9]), cvtpk(P0[10], P0[11]), cvtpk(P0[12], P0[13]), cvtpk(P0[14], P0[15])}; \
        PW[2] = (u32x4){cvtpk(P1[0], P1[1]), cvtpk(P1[2], P1[3]), cvtpk(P1[4], P1[5]), cvtpk(P1[6], P1[7])}; PW[3] = (u32x4){cvtpk(P1[8], P1[9]), cvtpk(P1[10], P1[11]), cvtpk(P1[12], P1[13]), cvtpk(P1[14], P1[15])}; \
        __builtin_amdgcn_sched_barrier(0); } while (0)
#define Q64_SM_NB(P0, P1, M, L, O, PW) do { \
        float mx_[8]; _Pragma("unroll") for (int r = 0; r < 8; ++r) mx_[r] = fmaxf(fmaxf(P0[r], P0[r + 8]), fmaxf(P1[r], P1[r + 8])); \
        float rm_ = fmaxf(fmaxf(fmaxf(mx_[0], mx_[1]), fmaxf(mx_[2], mx_[3])), fmaxf(fmaxf(mx_[4], mx_[5]), fmaxf(mx_[6], mx_[7]))); rm_ = swapmax(rm_); \
        if (__any(rm_ > M)) { const float mn_ = fmaxf(M, rm_), alpha_ = __builtin_amdgcn_exp2f(M - mn_); M = mn_; L *= alpha_; \
            _Pragma("unroll") for (int d = 0; d < NVB; ++d) _Pragma("unroll") for (int r = 0; r < 16; ++r) O[d][r] *= alpha_; } \
        float sm_[4] = {0.f, 0.f, 0.f, 0.f}; \
        _Pragma("unroll") for (int r = 0; r < 16; ++r) { P0[r] = __builtin_amdgcn_exp2f(P0[r] - M); P1[r] = __builtin_amdgcn_exp2f(P1[r] - M); sm_[r & 3] += P0[r] + P1[r]; } \
        L += (sm_[0] + sm_[1]) + (sm_[2] + sm_[3]); \
        PW[0] = (u32x4){cvtpk(P0[0], P0[1]), cvtpk(P0[2], P0[3]), cvtpk(P0[4], P0[5]), cvtpk(P0[6], P0[7])}; PW[1] = (u32x4){cvtpk(P0[8], P0[9]), cvtpk(P0[10], P0[11]), cvtpk(P0[12], P0[13]), cvtpk(P0[14], P0[15])}; \
        PW[2] = (u32x4){cvtpk(P1[0], P1[1]), cvtpk(P1[2], P1[3]), cvtpk(P1[4], P1[5]), cvtpk(P1[6], P1[7])}; PW[3] = (u32x4){cvtpk(P1[8], P1[9]), cvtpk(P1[10], P1[11]), cvtpk(P1[12], P1[13]), cvtpk(P1[14], P1[15])}; \
        } while (0)
    dma_tile<NKC, NVB, RD>(S, t_lo, 0, lds0, wid, lane);
    if (t_lo + 1 < t_hi) dma_tile<NKC, NVB, RD>(S, t_lo + 1, 1, lds0, wid, lane);
    for (int t = t_lo; t < t_hi; ++t) {
        const int slot = (t - t_lo) % RD;
        wait_vm_bar((t + 1 < t_hi) ? ops : 0);
        if (t + 2 < t_hi) dma_tile<NKC, NVB, RD>(S, t + 2, (t + 2 - t_lo) % RD, lds0, wid, lane);
        const LAS unsigned char* kb = lds + LDS_K + slot * KS + hi * 1024 + r32 * 16;
        f32x16 s0a = f32x16{}, s0b = f32x16{}, s1a = f32x16{}, s1b = f32x16{};
#pragma unroll
        for (int d0 = 0; d0 < NKC / 2; ++d0) {
            const bf16x8 b0 = *(const LAS bf16x8*)(kb + d0 * 2048), b1 = *(const LAS bf16x8*)(kb + d0 * 2048 + 512);
            s0a = __builtin_amdgcn_mfma_f32_32x32x16_bf16(b0, qa[d0], s0a, 0, 0, 0); s0b = __builtin_amdgcn_mfma_f32_32x32x16_bf16(b1, qa[d0], s0b, 0, 0, 0);
            s1a = __builtin_amdgcn_mfma_f32_32x32x16_bf16(b0, qb[d0], s1a, 0, 0, 0); s1b = __builtin_amdgcn_mfma_f32_32x32x16_bf16(b1, qb[d0], s1b, 0, 0, 0); }
        __builtin_amdgcn_sched_barrier(0);
        u32x4 pwa[4], pwb[4];
        const unsigned vb = lds0 + LDS_V + slot * VS + ((lane >> 4) & 1) * 32 + (lane & 3) * 8 + (4 * hi + ((lane & 15) >> 2)) * 64;
        s16x4 lo[NVB][4], hh[NVB][4];
#pragma unroll
        for (int d = 0; d < NVB; ++d)
#pragma unroll
            for (int ks = 0; ks < 4; ++ks) { VTRO(lo[d][ks], vb, d * 4096 + ks * 1024); VTRO(hh[d][ks], vb, d * 4096 + ks * 1024 + 512); }
        __builtin_amdgcn_sched_barrier(0);
        Q64_SM(s0a, s0b, ma, la, oa, pwa);
        asm volatile("s_waitcnt lgkmcnt(0)" ::: "memory"); __builtin_amdgcn_sched_barrier(0);
#pragma unroll
        for (int ks = 0; ks < 4; ++ks)
#pragma unroll
            for (int d = 0; d < NVB; ++d) { const bf16x8 vf = (bf16x8){lo[d][ks][0], lo[d][ks][1], lo[d][ks][2], lo[d][ks][3], hh[d][ks][0], hh[d][ks][1], hh[d][ks][2], hh[d][ks][3]};
                oa[d] = __builtin_amdgcn_mfma_f32_32x32x16_bf16(vf, __builtin_bit_cast(bf16x8, pwa[ks]), oa[d], 0, 0, 0); }
        Q64_SM_NB(s1a, s1b, mb, lb, ob, pwb);
#pragma unroll
        for (int i = 0; i < 8; ++i) { __builtin_amdgcn_sched_group_barrier(0x008, 1, 0); __builtin_amdgcn_sched_group_barrier(0x002, 12, 0); }
        __builtin_amdgcn_sched_barrier(0);
#pragma unroll
        for (int ks = 0; ks < 4; ++ks)
#pragma unroll
            for (int d = 0; d < NVB; ++d) { const bf16x8 vf = (bf16x8){lo[d][ks][0], lo[d][ks][1], lo[d][ks][2], lo[d][ks][3], hh[d][ks][0], hh[d][ks][1], hh[d][ks][2], hh[d][ks][3]};
                ob[d] = __builtin_amdgcn_mfma_f32_32x32x16_bf16(vf, __builtin_bit_cast(bf16x8, pwb[ks]), ob[d], 0, 0, 0); }
        __builtin_amdgcn_sched_barrier(0);
    }
    const float lia = 1.0f / swapsum(la), lib = 1.0f / swapsum(lb);
#pragma unroll
    for (int d = 0; d < NVB; ++d)
#pragma unroll
        for (int r4 = 0; r4 < 4; ++r4) {
            f32x4 va = {oa[d][4 * r4] * lia, oa[d][4 * r4 + 1] * lia, oa[d][4 * r4 + 2] * lia, oa[d][4 * r4 + 3] * lia}, vb4 = {ob[d][4 * r4] * lib, ob[d][4 * r4 + 1] * lib, ob[d][4 * r4 + 2] * lib, ob[d][4 * r4 + 3] * lib};
            *(u32x2*)(S.o + (size_t)r32 * S.opitch + 32 * d + 8 * r4 + 4 * hi) = pack4(va); *(u32x2*)(S.o + (size_t)(32 + r32) * S.opitch + 32 * d + 8 * r4 + 4 * hi) = pack4(vb4); }
    asm volatile("s_waitcnt lgkmcnt(0)\n\ts_barrier" ::: "memory");
#undef Q64_SM
#undef Q64_SM_NB
}

}
#define SC_AFTER_PROLOGUE() do {} while (0)
#define SC_AFTER_INPROJ(l) do {} while (0)
#define SC_AFTER_UP(l) do {} while (0)
#define SC_AFTER_MLA(l) do {} while (0)
#define SC_AFTER_BRANCH(l) do {} while (0)
#define SC_AFTER_WOUT(l) do {} while (0)
#define SC_AFTER_NORM2(l) do {} while (0)
#define SC_AFTER_GU(l) do {} while (0)
#define SC_AFTER_DOWN(l) do {} while (0)
#define SC_AFTER_ROUTE(l) do {} while (0)
#define SC_AFTER_MOEGU(l, h) do {} while (0)
#define SC_AFTER_MOED(l, h) do {} while (0)
#define SC_FINAL() do {} while (0)

struct Args { const float* in[23]; float* out; unsigned char* ws; };
#define WSP(type, off) ((type*)(F.ws + (off)))
#define PHASE() Frame Fp = F; Fp.ws = opq_p(F.ws); Fp.in = opq_p(F.in); Fp.out = opq_p(F.out); Fp.tid = opq_v((int)threadIdx.x); Fp.lane = Fp.tid & 63; Fp.wave = __builtin_amdgcn_readfirstlane(Fp.tid >> 6); (void)Fp
#define FWS(type, off) ((type*)(Fp.ws + (off)))
#define X_ FWS(bf16_t, WS_XB)
#define H_ FWS(bf16_t, WS_H)
#define Pb_ FWS(bf16_t, WS_R + R_P)
#define Gb_ FWS(bf16_t, WS_R + R_G)
#define QB_ FWS(bf16_t, WS_R + R_QB)
#define KVB_ FWS(bf16_t, WS_R + R_KVB)
#define Yb_ FWS(bf16_t, WS_R + R_Y)
#define MEMN_ FWS(bf16_t, WS_MEMN)
#define MEMKV_ FWS(bf16_t, WS_MEMKV)
#define ACT_ FWS(bf16_t, WS_R + R_ACT)
#define ASORT_ FWS(bf16_t, WS_R + R_ASORT)
#define YOUT_ FWS(bf16_t, WS_R + R_YOUT)
#define SSQ_ FWS(float, WS_MISC + MS_SSQ)
#define TEXP_ FWS(const int, WS_MISC + MS_TEXP)
#define POS_ ((const int*)Fp.in[I_POS])
#define HSC_ FWS(float, WS_MISC + MS_HSC)
#define ASC_ FWS(float, WS_MISC + MS_ASC)
#define WSIN_ FWS(float, WS_MISC + MS_WSIN)
#define WSGU_ FWS(float, WS_MISC + MS_WSGU)

#define GRID_BAR() xcd_barrier(bar)
#ifndef WGM_GU
#define WGM_GU 4
#endif
#ifndef WGM_IN
#define WGM_IN 4
#endif
template <int l> __device__ __forceinline__ void layer_body(const Frame& F, const XcdBarrier& bar, const int bx) {
        if (l > 0) {
            PHASE();
            prep_ffn_weights(Fp, l);
            if ((l & 1) != 0) norm_phase(Fp, nullptr, X_, Fp.in[I_GMIX] + l * DM, false, true);
            if ((l & 1) == 0) norm_phase(Fp, nullptr, X_, Fp.in[I_GMIX] + l * DM, true, true);
            GRID_BAR();
        }
        {   PHASE();
            ProbSimple p{DM, DM, DM, (const char*)H_, (const char*)wmix(Fp, l, WL_IN)}; pg8::StaticOrder S; S.init(T / 256, NT_IN, Fp.G, bx, 0, WGM_IN);
            EpiInproj E{Pb_, Gb_, SSQ_, POS_, HSC_, WSIN_ + l * NT_IN * 256}; pg8::gemm_phase<true>(Fp.lds, p, S, E); }
        if (l == 0) { PHASE();
            ProbSimple p{DM, DM * 2, DM * 2, (const char*)MEMN_, (const char*)FWS(bf16_t, WS_WMKV)}; pg8::StaticOrder S; S.init(NB * MEML / 256, 16, Fp.G, bx);
            EpiPlain E{MEMKV_, 4096}; pg8::gemm_phase(Fp.lds, p, S, E); }
        GRID_BAR();
        SC_AFTER_INPROJ(l);
        {   PHASE();
            ProbUp p{UPK, PW * 2, UPK * 2, (const char*)(Pb_ + P_CQ), (const char*)wmix(Fp, l, WL_UP)}; pg8::StaticOrder S; S.init(T / 256, UPN / 256, Fp.G, bx);
            EpiUp E{QB_, KVB_, SSQ_, POS_}; pg8::gemm_phase(Fp.lds, p, S, E); }
        {   PHASE();
            for (int i = Fp.vcu; i < 1024; i += Fp.G) {
                const int hl = i & 3, qb = (i >> 2) & 15, kvh = (i >> 6) & 1, b = i >> 7, h = kvh * 4 + hl; const size_t rowb = (size_t)b * SEQ; const int q0 = qb * 256;
                att::Src s; s.q = Pb_ + (rowb + q0 + Fp.wave * 32) * PW + P_QA + h * 64; s.qpitch = PW; s.k0 = Pb_ + rowb * PW + P_KA + kvh * 64; s.k0pitch = PW; s.k1 = s.k0; s.k1pitch = PW;
                s.v = Pb_ + rowb * PW + P_VA + kvh * 64; s.vpitch = PW; s.o = Yb_ + (rowb + q0 + Fp.wave * 32) * YW + h * 64; s.opitch = YW;
                const int t_lo = (q0 / 64 - 2) < 0 ? 0 : (q0 / 64 - 2), t_hi = (q0 / 64 + 6) > SEQ / 64 ? SEQ / 64 : (q0 / 64 + 6);
                att::unit<8, 2, 0>(Fp.lds, s, t_lo, t_hi, q0, Fp.in[I_SINK][l * 8 + h] * LOG2E);
            } }
        {   PHASE();
            for (int i = Fp.vcu; i < 512; i += Fp.G) {
                const int qb = i & 15, h = (i >> 4) & 3, b = i >> 6; const size_t rowq = (size_t)b * SEQ + qb * 256 + Fp.wave * 32;
                att::Src s; s.q = Pb_ + rowq * PW + P_QM + h * 128; s.qpitch = PW; s.k0 = MEMKV_ + (size_t)b * MEML * 4096 + l * 1024 + h * 128; s.k0pitch = 4096; s.k1 = s.k0 + 64; s.k1pitch = 4096;
                s.v = MEMKV_ + (size_t)b * MEML * 4096 + l * 1024 + 512 + h * 128; s.vpitch = 4096; s.o = Yb_ + rowq * YW + 1024 + h * 128; s.opitch = YW;
                att::unit<16, 4, 1>(Fp.lds, s, 0, MEML / 64, 0, 0.f);
            } }
        GRID_BAR();
        SC_AFTER_UP(l);
        {   PHASE();
            for (int i = Fp.vcu; i < 512; i += Fp.G) {
                const int qb = i & 7, h = (i >> 3) & 7, b = i >> 6; const size_t rowb = (size_t)b * SEQ, rowq = rowb + qb * 512 + Fp.wave * 64;
                att::Src s; s.q = QB_ + rowq * QBW + h * 96; s.qpitch = QBW; s.k0 = KVB_ + rowb * KVW + h * 128; s.k0pitch = KVW; s.k1 = Pb_ + rowb * PW + P_KR; s.k1pitch = PW;
                s.v = KVB_ + rowb * KVW + h * 128 + 64; s.vpitch = KVW; s.o = Yb_ + rowq * YW + 512 + h * 64; s.opitch = YW;
                att::unit_q64<12, 2>(Fp.lds, s, 0, SEQ / 64);
            } }
        GRID_BAR();
        SC_AFTER_MLA(l);
        {   PHASE();
            ProbSimple p{1536, YW * 2, 1536 * 2, (const char*)Yb_, (const char*)wmix(Fp, l, WL_BR)}; pg8::StaticOrder S; S.init(T / 256, DM / 256, Fp.G, bx);
            EpiBranch E{(const unsigned char*)Gb_, H_}; pg8::gemm_phase(Fp.lds, p, S, E); }
        GRID_BAR();
        SC_AFTER_BRANCH(l);
        if (l == 0) {   PHASE();
            ProbSimple p{DM, DM * 2, DM * 2, (const char*)H_, (const char*)wmix(Fp, l, WL_OUT)}; pg8::StaticOrder S; S.init(T / 256, DM / 256, Fp.G, bx);
            EpiResid E{Fp.in[I_X], X_}; pg8::gemm_phase(Fp.lds, p, S, E); }
        if (l != 0) {   PHASE();
            ProbSimple p{DM, DM * 2, DM * 2, (const char*)H_, (const char*)wmix(Fp, l, WL_OUT)}; pg8::StaticOrder S; S.init(T / 256, DM / 256, Fp.G, bx);
            EpiResid E{nullptr, X_}; pg8::gemm_phase(Fp.lds, p, S, E); }
        GRID_BAR();
        SC_AFTER_WOUT(l);
        if ((l & 1) == 0) {
            {   PHASE(); norm_phase(Fp, nullptr, X_, Fp.in[I_GFFN] + l * DM, false, GU_I8(l) != 0); }
            GRID_BAR();
            SC_AFTER_NORM2(l);
            {   PHASE();
                constexpr bool i8 = GU_I8(l) != 0; constexpr unsigned eb = i8 ? 1 : 2;
                ProbSimple p{DM, DM * eb, DM * eb, (const char*)H_, (const char*)FWS(bf16_t, WS_WFFN + WF_GU)}; pg8::StaticOrder S; S.init(T / 256, 2 * DFF / 256, Fp.G, bx, 0, WGM_GU);
                EpiSwiglu E{ACT_, 0, HSC_, WSGU_}; pg8::gemm_phase<i8>(Fp.lds, p, S, E); }
            GRID_BAR();
            SC_AFTER_GU(l);
            {   PHASE();
                ProbSimple p{DFF, DFF * 2, DFF * 2, (const char*)ACT_, (const char*)FWS(bf16_t, WS_WFFN + WF_D)}; pg8::StaticOrder S; S.init(T / 256, DM / 256, Fp.G, bx, 1);
                EpiResid E{nullptr, X_}; pg8::gemm_phase(Fp.lds, p, S, E); }
            GRID_BAR();
            SC_AFTER_DOWN(l);
        } else {
            {   PHASE(); norm_router_phase(Fp, X_, Fp.in[I_GFFN] + l * DM, Fp.in[I_WR] + (size_t)(l >> 1) * DM * NE, GU_I8(l) != 0); }
            GRID_BAR();
            {   PHASE(); moe_assign_phase(Fp, GU_I8(l) != 0); }
            GRID_BAR();
            SC_AFTER_ROUTE(l);
            {   constexpr int half = 0; (void)half;
                {   PHASE();
                    const int nrt = __builtin_amdgcn_readfirstlane(TEXP_[MAXRT]);
                    constexpr bool i8 = GU_I8(l) != 0; constexpr unsigned eb = i8 ? 1 : 2;
                    ProbMoe p{DM, DM * eb, DM * eb, (const char*)ASORT_, (const char*)FWS(bf16_t, WS_WFFN + WF_GU), 0}; MoeOrder S; S.base.init(nrt, 2 * DFF / 256, Fp.G, bx, 0, WGM_GU); S.lo = 0; S.texp = TEXP_;
                    EpiSwiglu E{ACT_, 0, ASC_, WSGU_}; pg8::gemm_phase<i8>(Fp.lds, p, S, E); }
                GRID_BAR();
                SC_AFTER_MOEGU(l, half);
                {   PHASE();
                    const int nrt = __builtin_amdgcn_readfirstlane(TEXP_[MAXRT]);
                    ProbMoe p{DFF, DFF * 2, DFF * 2, (const char*)ACT_, (const char*)FWS(bf16_t, WS_WFFN + WF_D), 0}; MoeOrder S; S.base.init(nrt, DM / 256, Fp.G, bx, 1); S.lo = 0; S.texp = TEXP_;
                    EpiYout E{YOUT_}; pg8::gemm_phase(Fp.lds, p, S, E); }
                GRID_BAR();
                SC_AFTER_MOED(l, half);
            }
        }
    }

__global__ void __launch_bounds__(NWAVES * 64, 2) fwd(Args args) {
    extern __shared__ __attribute__((aligned(16))) unsigned char lds_raw[];
    Frame F;
    F.lds = (LAS unsigned char*)lds_raw;
    F.MISC = (volatile LAS unsigned*)(F.lds + LDSCTL_OFF);
    F.tid = threadIdx.x; F.lane = F.tid & 63; F.wave = __builtin_amdgcn_readfirstlane(F.tid >> 6);
    F.G = gridDim.x; { const int bx = blockIdx.x; F.vcu = (F.G % 8 == 0) ? (bx % 8) * (F.G / 8) + bx / 8 : bx; }
    F.ws = args.ws; F.ctl = (gu32*)(args.ws + WS_CTL); F.out = args.out;
    F.in = (const float* const*)__builtin_amdgcn_kernarg_segment_ptr();
    for (int u = F.tid; u < (LDS_BYTES - LDSCTL_OFF) / 4; u += NWAVES * 64) ((LAS unsigned*)(F.lds + LDSCTL_OFF))[u] = 0u;
    __syncthreads();
    XcdBarrier bar = xcd_barrier_post((unsigned*)(F.ctl + CW_BAR), F.MISC + 8);

    const int bx = (int)blockIdx.x;

    {   PHASE();
        prep_mixer_weights(Fp);
        memnorm_phase(Fp);
        prep_ffn_weights(Fp, 0);
        norm_phase(Fp, Fp.in[I_X], nullptr, Fp.in[I_GMIX], false, true); }
    GRID_BAR();
    SC_AFTER_PROLOGUE();

    layer_body<0>(F, bar, bx); layer_body<1>(F, bar, bx); layer_body<2>(F, bar, bx); layer_body<3>(F, bar, bx);
    {   PHASE(); final_norm_phase(Fp, X_, Fp.out, Fp.in[I_GFIN], true); }
    SC_FINAL();
}

extern "C" void kernel_launch(void* const* d_in, const int* in_sizes, int n_in, void* d_out, int out_size, void* d_ws, size_t ws_size, hipStream_t stream) {
    static int grid = 0;
    if (grid == 0) {
        if (n_in != 23 || out_size != T * DM || ws_size < WS_END) { fprintf(stderr, "kernel_launch: unexpected problem (n_in %d, out %d, ws %zu < %zu)\n", n_in, out_size, ws_size, (size_t)WS_END); grid = -1; return; }
        int dev = 0, cus = 0;
        if (hipGetDevice(&dev) != hipSuccess || hipDeviceGetAttribute(&cus, hipDeviceAttributeMultiprocessorCount, dev) != hipSuccess) { grid = -1; return; }
        if (hipFuncSetAttribute((const void*)fwd, hipFuncAttributeMaxDynamicSharedMemorySize, LDS_BYTES) != hipSuccess) { fprintf(stderr, "kernel_launch: hipFuncSetAttribute failed\n"); grid = -1; return; }
        int per_cu = 0;
        if (hipOccupancyMaxActiveBlocksPerMultiprocessor(&per_cu, (const void*)fwd, NWAVES * 64, LDS_BYTES) != hipSuccess || per_cu < 1) fprintf(stderr, "kernel_launch: occupancy query says %d\n", per_cu);
        (void)hipGetLastError();
        grid = cus;
    }
    if (grid < 0) return;
    if (hipMemsetAsync((char*)d_ws + WS_CTL, 0, CTL_ZERO_BYTES, stream) != hipSuccess) return;
    Args a{};
    for (int i = 0; i < 23; ++i) a.in[i] = (const float*)d_in[i];
    a.out = (float*)d_out; a.ws = (unsigned char*)d_ws;
    hipLaunchKernelGGL(fwd, dim3(grid), dim3(NWAVES * 64), LDS_BYTES, stream, a);
}
```

```cpp
#include <hip/hip_runtime.h>
#include <cstdio>
#include <cstdint>

#ifndef SELFCHECK
#define SELFCHECK 0
#endif
#ifndef GU_I8_MASK
#define GU_I8_MASK 0xF
#endif
#define GU_I8(l) ((((unsigned)GU_I8_MASK) >> (l)) & 1u)

#define GAS __attribute__((address_space(1)))
#define LAS __attribute__((address_space(3)))
typedef unsigned short bf16_t;
typedef short bf16x8 __attribute__((ext_vector_type(8)));
typedef short s16x4 __attribute__((ext_vector_type(4)));
typedef short v4i16_t __attribute__((ext_vector_type(4)));
typedef float f32x2 __attribute__((ext_vector_type(2)));
typedef float f32x4 __attribute__((ext_vector_type(4)));
typedef float f32x16 __attribute__((ext_vector_type(16)));
typedef unsigned u32x2 __attribute__((ext_vector_type(2)));
typedef unsigned u32x4 __attribute__((ext_vector_type(4)));
typedef int i32x4 __attribute__((ext_vector_type(4)));
typedef GAS unsigned gu32;
#define RLX_AGENT __ATOMIC_RELAXED, __HIP_MEMORY_SCOPE_AGENT

constexpr int NB = 8, SEQ = 4096, T = NB * SEQ, DM = 1024, DEPTH = 4, MEML = 256, DFF = 3584, NE = 8;
constexpr int INW = 4768;
constexpr int PW = 1792;
constexpr int GW = 3072;
constexpr int QBW = 768, KVW = 1024, YW = 1536;
constexpr int NT_IN = 19;
constexpr int P_QA = 0, P_KA = 512, P_VA = 640, P_CQ = 768, P_CKV = 1024, P_KR = 1152, P_QM = 1280;
constexpr int UPK = 256, UPN = 1792;
constexpr int MAXSLOT = 67584;
constexpr int MAXRT = MAXSLOT / 256;
constexpr float EPS = 1e-6f;
constexpr float LOG2E = 1.4426950408889634f;
constexpr float C_A = 0.125f * LOG2E;
constexpr float C_B = 0.10206207261596575f * LOG2E;
constexpr float C_M = 0.08838834764831845f * LOG2E;

constexpr size_t MiB = 1u << 20;
constexpr size_t WS_CTL = 0, CTL_ZERO_BYTES = 1 * MiB;
constexpr size_t WS_MISC = 1 * MiB;
constexpr size_t WL_IN = 0, WL_UP = (size_t)NT_IN * 256 * DM * 2, WL_BR = WL_UP + (size_t)UPN * UPK * 2, WL_OUT = WL_BR + (size_t)3 * DM * 512 * 2, WL_SIZE = WL_OUT + (size_t)DM * DM * 2;
constexpr size_t WS_WMIX = 8 * MiB;
constexpr size_t WS_WMKV = WS_WMIX + 4 * ((WL_SIZE + MiB - 1) / MiB) * MiB;
constexpr size_t WL_STRIDE = ((WL_SIZE + MiB - 1) / MiB) * MiB;
constexpr size_t WS_WFFN = WS_WMKV + 8 * MiB;
constexpr size_t WF_GU = 0, WF_D = (size_t)2 * DFF * DM * 2, WF_STRIDE = WF_D + (size_t)DM * DFF * 2;
constexpr size_t WS_H = WS_WFFN + 8 * WF_STRIDE;
constexpr size_t WS_MEMN = WS_H + (size_t)T * DM * 2;
constexpr size_t WS_MEMKV = WS_MEMN + (size_t)NB * MEML * DM * 2;
constexpr size_t WS_R = WS_MEMKV + (size_t)NB * MEML * 4096 * 2;
constexpr size_t R_P = 0, R_G = R_P + (size_t)T * PW * 2, R_QB = R_G + (size_t)T * GW * 2, R_KVB = R_QB + (size_t)T * QBW * 2, R_Y = R_KVB + (size_t)T * KVW * 2, R_END_MIX = R_Y + (size_t)T * YW * 2;
constexpr size_t R_ACT = 0;
constexpr size_t R_ASORT = (size_t)MAXSLOT * DFF * 2;
constexpr size_t R_YOUT = R_ASORT;
constexpr size_t R_END_FFN = R_YOUT + (size_t)MAXSLOT * DM * 2;
constexpr size_t R_SIZE = R_END_MIX > R_END_FFN ? R_END_MIX : R_END_FFN;
constexpr size_t WS_XB = WS_R + R_SIZE;
constexpr size_t WS_END = WS_XB + (size_t)T * DM * 2;
static_assert(WS_END < 1020ull * MiB, "workspace budget");
constexpr size_t MS_TOKE = 0;
constexpr size_t MS_TOKW = MS_TOKE + (size_t)T * 8;
constexpr size_t MS_SLOT = MS_TOKW + (size_t)T * 8;
constexpr size_t MS_CNT = MS_SLOT + (size_t)T * 8;
constexpr size_t MS_TEXP = MS_CNT + 256 * 8 * 4;
constexpr size_t MS_SSQ = MS_TEXP + 2048;
constexpr size_t MS_SNAP = MS_SSQ + (size_t)T * 32;
constexpr size_t MS_HSC = MS_SNAP + 64 * 1024 * 4;
constexpr size_t MS_ASC = MS_HSC + (size_t)T * 4;
constexpr size_t MS_WSIN = MS_ASC + (size_t)MAXSLOT * 4;
constexpr size_t MS_WSGU = MS_WSIN + (size_t)4 * NT_IN * 256 * 4;
constexpr size_t MS_END = MS_WSGU + (size_t)8 * 2 * DFF * 4;
static_assert(MS_END <= 7 * MiB, "misc map");
constexpr int CW_BAR = 4096;
constexpr int CW_DIAG = 16384;
constexpr int CW_CODE = 16384 + 512;

constexpr int RING_BYTES = 131072;
constexpr int LDSCTL_OFF = RING_BYTES;
constexpr int LDS_BYTES = 147456;
constexpr int NWAVES = 8;

#define LDS_WAIT() asm volatile("s_waitcnt lgkmcnt(0)" ::: "memory")
#define VM_WAIT() asm volatile("s_waitcnt vmcnt(0)" ::: "memory")

__device__ __forceinline__ unsigned f2bf(float f) { unsigned u = __builtin_bit_cast(unsigned, f); return (u + 0x7fffu + ((u >> 16) & 1u)) >> 16; }
__device__ __forceinline__ unsigned pk2(float lo, float hi) { return f2bf(lo) | (f2bf(hi) << 16); }
__device__ __forceinline__ float bf2f(unsigned short b) { return __builtin_bit_cast(float, (unsigned)b << 16); }
__device__ __forceinline__ float bflo(unsigned w) { return __builtin_bit_cast(float, w << 16); }
__device__ __forceinline__ float bfhi(unsigned w) { return __builtin_bit_cast(float, w & 0xffff0000u); }
typedef __bf16 bf16x2_t __attribute__((ext_vector_type(2)));
__device__ __forceinline__ unsigned cvtpk(float lo, float hi) { f32x2 v = {lo, hi}; bf16x2_t b = __builtin_convertvector(v, bf16x2_t); return __builtin_bit_cast(unsigned, b); }
__device__ __forceinline__ float wave_sum(float v) {
#pragma unroll
    for (int o = 1; o < 64; o <<= 1) v += __shfl_xor(v, o);
    return v;
}
__device__ __forceinline__ float fast_sigmoid(float x) { return __builtin_amdgcn_rcpf(1.0f + __builtin_amdgcn_exp2f(-x * LOG2E)); }


__device__ __forceinline__ int opq_v(int x) { asm volatile("" : "+v"(x)); return x; }
__device__ __forceinline__ int opq_s(int x) { asm volatile("" : "+s"(x)); return x; }
template <class Tp> __device__ __forceinline__ Tp* opq_p(Tp* p) { const unsigned long long u = (unsigned long long)p; unsigned lo = __builtin_amdgcn_readfirstlane((unsigned)u), hi = __builtin_amdgcn_readfirstlane((unsigned)(u >> 32)); asm volatile("" : "+s"(lo), "+s"(hi)); return (Tp*)(((unsigned long long)hi << 32) | lo); }

__constant__ float IFR_HI[32] = {1.591549367e-01f, 1.193493679e-01f, 8.949939907e-02f, 6.711508334e-02f, 5.032921210e-02f, 3.774158657e-02f, 2.830219641e-02f, 2.122365311e-02f, 1.591549441e-02f, 1.193493698e-02f, 8.949940093e-03f, 6.711508147e-03f, 5.032921210e-03f, 3.774158424e-03f, 2.830219688e-03f, 2.122365171e-03f, 1.591549488e-03f, 1.193493721e-03f, 8.949940093e-04f, 6.711508031e-04f, 5.032921326e-04f, 3.774158540e-04f, 2.830219455e-04f, 2.122365258e-04f, 1.591549371e-04f, 1.193493736e-04f, 8.949940093e-05f, 6.711508468e-05f, 5.032921035e-05f, 3.774158540e-05f, 2.830219637e-05f, 2.122365186e-05f};
__constant__ float IFR_LO[32] = {6.420638243e-09f, 2.294664903e-09f, 2.542919653e-09f, -3.316028840e-10f, 5.173299289e-12f, -1.848551645e-09f, -5.826552019e-10f, -3.431038786e-10f, -1.029942243e-10f, 4.320196978e-11f, 6.802745173e-11f, 1.531042237e-10f, 5.173301024e-13f, 4.797548470e-11f, -1.048316434e-10f, 1.053879969e-10f, -5.686555046e-11f, -1.896286773e-11f, 6.802744999e-12f, 2.695195456e-11f, -1.158979943e-11f, -6.843983713e-12f, 1.279990003e-11f, 1.807650600e-12f, 5.954976963e-12f, -3.351478166e-12f, 6.802745216e-13f, -1.670379113e-12f, 1.751403167e-12f, -6.843983930e-13f, -5.389994549e-13f, 9.083608431e-13f};
__device__ __forceinline__ void rot_cs(float posf, int idx, float& c, float& s) {
    const float ch = IFR_HI[idx], cl = IFR_LO[idx];
    const float p = posf * ch, e = __builtin_fmaf(posf, ch, -p);
    const float fr = __builtin_amdgcn_fractf(p) + (e + posf * cl);
    s = __builtin_amdgcn_sinf(fr); c = __builtin_amdgcn_cosf(fr);
}

#define XB_TMO      128
#define XB_XCNT(j)  (256  + 64 * (j))
#define XB_XSUB(j)  (1280 + 64 * (j))
#define XB_XGEN(j)  (2304 + 64 * (j))
#define XB_TOP      3328
#define XB_TOPGEN   3392
#define XCD_BAR_WORDS 3456
#define XB_SPIN_CAP (1u << 20)

__device__ __forceinline__ unsigned xb_ld(unsigned* p)              { return __hip_atomic_load(p, __ATOMIC_RELAXED, __HIP_MEMORY_SCOPE_AGENT); }
__device__ __forceinline__ unsigned xb_add(unsigned* p, unsigned v) { return __hip_atomic_fetch_add(p, v, __ATOMIC_RELAXED, __HIP_MEMORY_SCOPE_AGENT); }
__device__ __forceinline__ unsigned xb_xcc_id() { return (unsigned)__builtin_amdgcn_s_getreg((3 << 11) | 20) & 0xFu; }
#define XB_SPIN(cond, bar) do { unsigned _sp = 0; while (cond) { __builtin_amdgcn_s_sleep(1); \
    if ((++_sp & 255u) == 0u) { if (xb_ld(&(bar)[XB_TMO])) break; if (_sp > XB_SPIN_CAP) { atomicAdd(&(bar)[XB_TMO], 1u); break; } } } } while (0)

struct XcdBarrier { unsigned* bar; unsigned x; volatile LAS unsigned* st; };

__device__ __forceinline__ XcdBarrier xcd_barrier_post(unsigned* bar, volatile LAS unsigned* st) {
    XcdBarrier b; b.bar = bar; b.x = xb_xcc_id(); b.st = st;
    if (threadIdx.x == 0) (void)xb_add(&bar[XB_XCNT(b.x)], 1u);
    return b;
}
__device__ __forceinline__ void xcd_barrier_complete(unsigned* bar, unsigned x, unsigned& nloc, unsigned& nx) {
    const unsigned G = gridDim.x * gridDim.y * gridDim.z;
    unsigned sum, cnt, mine, sp = 0u;
    for (;;) {
        sum = 0u; cnt = 0u; mine = 0u;
#pragma unroll
        for (unsigned j = 0; j < 16; ++j) { const unsigned c = xb_ld(&bar[XB_XCNT(j)]); sum += c; cnt += (c > 0u) ? 1u : 0u; mine = (j == x) ? c : mine; }
        if (sum == G) break;
        __builtin_amdgcn_s_sleep(1);
        if ((++sp & 255u) == 0u) { if (xb_ld(&bar[XB_TMO])) break; if (sp > XB_SPIN_CAP) { atomicAdd(&bar[XB_TMO], 1u); break; } }
    }
    nloc = mine > 0u ? mine : 1u; nx = cnt > 0u ? cnt : 1u;
}
__device__ __forceinline__ void xcd_barrier(const XcdBarrier& b) {
    asm volatile("s_waitcnt vmcnt(0)" ::: "memory");
    __syncthreads();
    if (threadIdx.x == 0) {
        unsigned* bar = b.bar;
        __builtin_amdgcn_s_waitcnt(0);
        unsigned nloc = b.st[0], nx = b.st[1];
        if (nloc == 0u) { xcd_barrier_complete(bar, b.x, nloc, nx); b.st[0] = nloc; b.st[1] = nx; }
        const unsigned old = xb_add(&bar[XB_XSUB(b.x)], 1u);
        const unsigned gen = old / nloc;
        if (old + 1u == (gen + 1u) * nloc) {
            __builtin_amdgcn_fence(__ATOMIC_RELEASE, "agent");
            asm volatile("s_waitcnt vmcnt(0)" ::: "memory");
            const unsigned og = xb_add(&bar[XB_TOP], 1u);
            const unsigned tg = og / nx;
            if (og + 1u == (tg + 1u) * nx) xb_add(&bar[XB_TOPGEN], 1u);
            else XB_SPIN(xb_ld(&bar[XB_TOPGEN]) == tg, bar);
            __builtin_amdgcn_fence(__ATOMIC_ACQUIRE, "agent");
            xb_add(&bar[XB_XGEN(b.x)], 1u);
            asm volatile("s_waitcnt vmcnt(0)" ::: "memory");
        } else {
            XB_SPIN(xb_ld(&bar[XB_XGEN(b.x)]) == gen, bar);
            __builtin_amdgcn_fence(__ATOMIC_ACQUIRE, "agent");
            asm volatile("s_waitcnt vmcnt(0)" ::: "memory");
        }
    }
    __syncthreads();
}

namespace pg8 {
constexpr int BM = 256, BK = 64, HALF = 128, HTB = HALF * BK * 2, STAGE_BYTES = 8 * HTB, NXCD = 8, WGM = 4;
constexpr int ESC_OFF = 131072 + 4096, ESC_SLOT = 3072;
__host__ __device__ __forceinline__ int lds_byte(int r, int c) { const int st = (r >> 4) * 2 + (c >> 5), rr = r & 15, cc = c & 31, ob = rr * 64 + cc * 2; return st * 1024 + (ob ^ (((ob >> 9) & 1) << 5)); }
__host__ __device__ __forceinline__ void stage_rc(int b, int& R, int& C) { const int st = b / 1024, sb = b % 1024, swz = sb ^ (((sb >> 9) & 1) << 5); R = (st >> 1) * 16 + swz / 64; C = (st & 1) * 32 + (swz % 64) / 2; }

struct Unit { int pm, pn, aux; };

struct StaticOrder {
    int nM, nN, nwg, G, c, rev, wgm;
    __device__ void init(int nM_, int nN_, int G_, int c_, int rev_ = 0, int wgm_ = WGM) { nM = nM_; nN = nN_; nwg = nM * nN; G = G_; c = c_; rev = rev_; wgm = wgm_; }
    __device__ bool next(int i, Unit& u) const {
        const long L = (long)i * G + c; if (L >= nwg) return false;
        int wgid = (int)L; { const int q = nwg / NXCD, r = nwg % NXCD, xcd = wgid % NXCD, off = wgid / NXCD; wgid = (xcd < r ? xcd * (q + 1) : r * (q + 1) + (xcd - r) * q) + off; }
        const int nig = wgm * nN, gid = wgid / nig, fm = gid * wgm, gsz = (nM - fm) < wgm ? (nM - fm) : wgm;
        u.pm = fm + ((wgid % nig) % gsz); u.pn = (wgid % nig) / gsz; u.aux = 0; if (rev) u.pm = nM - 1 - u.pm; return true;
    }
};

template <bool I8> struct AccVec { typedef f32x4 type; };
template <> struct AccVec<true> { typedef i32x4 type; };
template <bool I8 = false, class Prob, class Sched, class Epi>
__device__ __forceinline__ void gemm_phase(LAS unsigned char* lds, const Prob& P, const Sched& S, const Epi& E) {
    const int tid = opq_v((int)threadIdx.x), wid = __builtin_amdgcn_readfirstlane(tid >> 6), lane = tid & 63, wr = wid >> 2, wc = wid & 3, fr = lane & 15, fq = lane >> 4;
    typedef typename AccVec<I8>::type accv_t;
    const int K = P.K, nt = K / (I8 ? 2 * BK : BK);
    unsigned voffA[2], voffB[2];
#pragma unroll
    for (int i = 0; i < 2; ++i) { int R, C; stage_rc(tid * 16 + i * 8192, R, C); voffA[i] = (unsigned)R * P.lda + (unsigned)C * 2u; voffB[i] = (unsigned)R * P.ldb + (unsigned)C * 2u; }
    const size_t kstep = (size_t)(BK * 2);
    const size_t hstepA = (size_t)HALF * P.lda, hstepB = (size_t)HALF * P.ldb;
    const unsigned ldsw = (unsigned)wid * 1024u;
    const int aoff = lds_byte(wr * 64 + fr, fq * 8), boff = lds_byte(wc * 32 + fr, fq * 8);
#define PG8_SA(b, h) (((b) * 2 + (h)) * HTB)
#define PG8_SB(b, h) ((4 + (b) * 2 + (h)) * HTB)
#define PG8_STAGE(bufoff, gbase, voff) do { _Pragma("unroll") for (int _i = 0; _i < 2; ++_i) \
        __builtin_amdgcn_global_load_lds((const unsigned*)((const char*)(gbase) + (voff)[_i]), (LAS unsigned*)(lds + (bufoff) + ldsw + _i * 8192), 16, 0, 0); } while (0)
#define PG8_LDA(dst, b, h) do { _Pragma("unroll") for (int m = 0; m < 4; ++m) _Pragma("unroll") for (int k = 0; k < 2; ++k) dst[m][k] = *(const LAS bf16x8*)(lds + PG8_SA(b, h) + aoff + m * 2048 + k * 1024); } while (0)
#define PG8_LDB(dst, b, h) do { _Pragma("unroll") for (int n = 0; n < 2; ++n) _Pragma("unroll") for (int k = 0; k < 2; ++k) dst[n][k] = *(const LAS bf16x8*)(lds + PG8_SB(b, h) + boff + n * 2048 + k * 1024); } while (0)
#define PG8_MMA(ai, bj, At, Bt) do { __builtin_amdgcn_s_setprio(1); _Pragma("unroll") for (int m = 0; m < 4; ++m) _Pragma("unroll") for (int n = 0; n < 2; ++n) _Pragma("unroll") for (int k = 0; k < 2; ++k) \
        { if constexpr (I8) acc[ai][bj][m][n] = __builtin_amdgcn_mfma_i32_16x16x64_i8(__builtin_bit_cast(i32x4, Bt[n][k]), __builtin_bit_cast(i32x4, At[m][k]), acc[ai][bj][m][n], 0, 0, 0); \
          else acc[ai][bj][m][n] = __builtin_amdgcn_mfma_f32_16x16x32_bf16(Bt[n][k], At[m][k], acc[ai][bj][m][n], 0, 0, 0); } __builtin_amdgcn_s_setprio(0); } while (0)
#define PG8_WAIT_V(n) asm volatile("s_waitcnt vmcnt(" #n ")" ::: "memory")
#define PG8_WAIT_L(n) asm volatile("s_waitcnt lgkmcnt(" #n ")" ::: "memory")
#define PG8_BAR __builtin_amdgcn_s_barrier()
#define PG8_SCHED __builtin_amdgcn_sched_barrier(0)
    Unit cur, nxt; int ui = 0;
    if (!S.next(0, cur)) return;
    accv_t acc[2][2][4][2];
#pragma unroll
    for (int a = 0; a < 2; ++a)
#pragma unroll
        for (int b = 0; b < 2; ++b)
#pragma unroll
            for (int m = 0; m < 4; ++m)
#pragma unroll
                for (int n = 0; n < 2; ++n) acc[a][b][m][n] = accv_t{};
    bf16x8 At[4][2], B0[2][2], B1[2][2];
    const char* cA = P.a_ptr(cur); const char* cB = P.b_ptr(cur);
    int eslot = 0;
    E.stage(lds + ESC_OFF, cur, wid, lane);
    PG8_STAGE(PG8_SB(0, 0), cB, voffB); PG8_STAGE(PG8_SB(0, 1), cB + hstepB, voffB); PG8_STAGE(PG8_SA(0, 0), cA, voffA); PG8_STAGE(PG8_SA(0, 1), cA + hstepA, voffA);
    if (wr == 1) PG8_BAR;
    PG8_WAIT_V(2); PG8_BAR;
    PG8_STAGE(PG8_SB(1, 0), cB + kstep, voffB); PG8_STAGE(PG8_SA(1, 0), cA + kstep, voffA); PG8_STAGE(PG8_SB(1, 1), cB + hstepB + kstep, voffB);
    PG8_WAIT_V(6); PG8_BAR;
    for (;;) {
        const bool has_next = S.next(ui + 1, nxt);
        const char* nA = has_next ? P.a_ptr(nxt) : cA; const char* nB = has_next ? P.b_ptr(nxt) : cB;
        for (int t = 0; t < nt; t += 2) {
            if constexpr (Epi::MID) { if (t == 8 || t == 16) E.mid(acc, cur, t >> 3, wr, wc, fr, fq); }
            const bool last = (t == nt - 2);
            if (last && has_next) E.stage(lds + ESC_OFF + (eslot ^ 1) * ESC_SLOT, nxt, wid, lane);
            const char* a1 = cA + (size_t)(t + 1) * kstep;
            const char* a2 = last ? nA : cA + (size_t)(t + 2) * kstep; const char* b2 = last ? nB : cB + (size_t)(t + 2) * kstep;
            const char* a3 = a2 + kstep; const char* b3 = b2 + kstep;
            PG8_LDB(B0, 0, 0); PG8_LDB(B1, 0, 1); PG8_SCHED; PG8_LDA(At, 0, 0); PG8_STAGE(PG8_SA(1, 1), a1 + hstepA, voffA);
            PG8_WAIT_V(8); PG8_WAIT_L(0); PG8_BAR; PG8_MMA(0, 0, At, B0); PG8_MMA(0, 1, At, B1); PG8_BAR; PG8_SCHED;
            PG8_LDA(At, 0, 1); PG8_STAGE(PG8_SB(0, 0), b2, voffB); PG8_STAGE(PG8_SB(0, 1), b2 + hstepB, voffB); PG8_STAGE(PG8_SA(0, 0), a2, voffA);
            PG8_WAIT_V(8); PG8_WAIT_L(0); PG8_BAR; PG8_MMA(1, 0, At, B0); PG8_MMA(1, 1, At, B1); PG8_BAR; PG8_SCHED;
            PG8_LDB(B0, 1, 0); PG8_LDB(B1, 1, 1); PG8_SCHED; PG8_LDA(At, 1, 0); PG8_STAGE(PG8_SA(0, 1), a2 + hstepA, voffA);
            PG8_WAIT_V(8); PG8_WAIT_L(0); PG8_BAR; PG8_MMA(0, 0, At, B0); PG8_MMA(0, 1, At, B1); PG8_BAR; PG8_SCHED;
            PG8_LDA(At, 1, 1); PG8_STAGE(PG8_SB(1, 0), b3, voffB); PG8_STAGE(PG8_SB(1, 1), b3 + hstepB, voffB); PG8_STAGE(PG8_SA(1, 0), a3, voffA);
            PG8_WAIT_V(8); PG8_WAIT_L(0); PG8_BAR; PG8_MMA(1, 0, At, B0); PG8_MMA(1, 1, At, B1); PG8_BAR; PG8_SCHED;
        }
        if (wr == 0) PG8_BAR;
        E(acc, cur, wr, wc, fr, fq, lds + ESC_OFF + eslot * ESC_SLOT);
        if (!has_next) break;
#pragma unroll
        for (int a = 0; a < 2; ++a)
#pragma unroll
            for (int b = 0; b < 2; ++b)
#pragma unroll
                for (int m = 0; m < 4; ++m)
#pragma unroll
                    for (int n = 0; n < 2; ++n) acc[a][b][m][n] = accv_t{};
        cur = nxt; cA = nA; cB = nB; ++ui; eslot ^= 1;
        if (wr == 1) PG8_BAR;
    }
    PG8_WAIT_V(0);
    PG8_BAR;
#undef PG8_SA
#undef PG8_SB
#undef PG8_STAGE
#undef PG8_LDA
#undef PG8_LDB
#undef PG8_MMA
#undef PG8_WAIT_V
#undef PG8_WAIT_L
#undef PG8_BAR
#undef PG8_SCHED
}
}

struct Frame {
    LAS unsigned char* lds;
    volatile LAS unsigned* MISC;
    gu32* ctl;
    unsigned char* ws;
    int tid, lane, wave, vcu, G;
    const float* const* in; float* out;
};
enum { I_X = 0, I_MEM, I_POS, I_GMIX, I_WIN, I_GQ, I_WUQ, I_GKV, I_WUKV, I_SINK, I_WMKV, I_WBR, I_WOUT, I_GFFN, I_WGD, I_WUD, I_WDD, I_WR, I_WGE, I_WUE, I_WDE, I_GMEM, I_GFIN };

__device__ __forceinline__ int sem_plain(int g) { return (g & ~31) + 8 * ((g >> 2) & 3) + 4 * ((g >> 4) & 1) + (g & 3); }
__device__ __forceinline__ int sem_rot64(int g) { return (g & ~63) + 32 * ((g >> 4) & 1) + 16 * ((g >> 5) & 1) + 4 * ((g >> 2) & 3) + (g & 3); }
__device__ __forceinline__ int sem_p16(int g) { const int c = g & 255; return (g & ~255) + 64 * ((c >> 5) & 3) + 16 * ((c >> 2) & 3) + 8 * (c >> 7) + 4 * ((c >> 4) & 1) + (c & 3); }
__device__ __forceinline__ int inproj_src(int n) {
    const int pn = n >> 8, c = n & 255;
    if (pn < 2) return pn * 256 + sem_rot64(c);
    if (pn == 2) return c < 128 ? 512 + sem_rot64(c) : 640 + sem_plain(c - 128);
    if (pn == 3) return 768 + sem_plain(c);
    if (pn == 4) return c < 128 ? 1024 + sem_plain(c) : (c < 160 ? 1152 + (c - 128) : -1);
    if (pn < 7) return 1184 + (pn - 5) * 256 + sem_plain(c);
    return 1696 + (pn - 7) * 256 + sem_p16(c);
}

struct MapInproj { const float* W; __device__ __forceinline__ float load(int k, int n) const { const int s = inproj_src(n); return s >= 0 ? W[(size_t)k * INW + s] : 0.f; }
    __device__ __forceinline__ f32x4 load4(int k, int n) const { const int s = inproj_src(n); return s >= 0 ? *(const f32x4*)(W + (size_t)k * INW + s) : (f32x4){0.f, 0.f, 0.f, 0.f}; } };
struct MapUp { const float *Wq, *Wkv, *gq, *gkv;
    __device__ __forceinline__ f32x4 load4(int k, int n) const {
        if (n < 768) { const int gg = n >> 5; const int s = (gg % 3 == 2) ? n : sem_plain(n); return *(const f32x4*)(Wq + (size_t)k * 768 + s) * gq[k]; }
        if (k < 128) return (f32x4){0.f, 0.f, 0.f, 0.f}; const int s = sem_plain(n - 768); return *(const f32x4*)(Wkv + (size_t)(k - 128) * 1024 + s) * gkv[k - 128]; }
    __device__ __forceinline__ float load(int k, int n) const {
        if (n < 768) { const int gg = n >> 5; const int s = (gg % 3 == 2) ? n : sem_plain(n); return gq[k] * Wq[(size_t)k * 768 + s]; }
        if (k < 128) return 0.f; const int s = sem_plain(n - 768); return gkv[k - 128] * Wkv[(size_t)(k - 128) * 1024 + s]; } };
struct MapPlain { const float* W; int ldw; __device__ __forceinline__ float load(int k, int n) const { return W[(size_t)k * ldw + sem_plain(n)]; }
    __device__ __forceinline__ f32x4 load4(int k, int n) const { return *(const f32x4*)(W + (size_t)k * ldw + sem_plain(n)); } };
struct MapNat { const float* W; int ldw; __device__ __forceinline__ float load(int k, int n) const { return W[(size_t)k * ldw + n]; }
    __device__ __forceinline__ f32x4 load4(int k, int n) const { return *(const f32x4*)(W + (size_t)k * ldw + n); } };
struct MapBr { const float* W;
    __device__ __forceinline__ float load(int k, int n) const { return W[(size_t)k * DM + sem_p16(n)]; }
    __device__ __forceinline__ f32x4 load4(int k, int n) const { return *(const f32x4*)(W + (size_t)k * DM + sem_p16(n)); } };
struct MapMemkv { const float* W; __device__ __forceinline__ float load(int k, int n) const { const int l = n >> 10, c = n & 1023; return W[((size_t)l * DM + k) * 1024 + sem_plain(c)]; }
    __device__ __forceinline__ f32x4 load4(int k, int n) const { const int l = n >> 10, c = n & 1023; return *(const f32x4*)(W + ((size_t)l * DM + k) * 1024 + sem_plain(c)); } };
struct MapGU { const float *Wg, *Wu; __device__ __forceinline__ float load(int k, int n) const { const int pn = n >> 8, c = n & 255; const int ch = 128 * pn + sem_plain(c & 127);
    const unsigned long long a = (unsigned long long)Wg, b = (unsigned long long)Wu, w = a ^ ((a ^ b) & (0ull - (unsigned long long)(c >> 7))); return ((const float*)w)[(size_t)k * DFF + ch]; }
    __device__ __forceinline__ f32x4 load4(int k, int n) const { const int pn = n >> 8, c = n & 255; const int ch = 128 * pn + sem_plain(c & 127);
        const unsigned long long a = (unsigned long long)Wg, b = (unsigned long long)Wu, w = a ^ ((a ^ b) & (0ull - (unsigned long long)(c >> 7))); return *(const f32x4*)((const float*)w + (size_t)k * DFF + ch); } };

template <class M> __device__ __forceinline__ void prep_item(const M& m, bf16_t* dst, int Kd, int nblk, LAS float* scr, int item, int lane) {
    const int kb = item / nblk, nb = item % nblk, k0 = 64 * kb, n0 = 32 * nb;
#pragma unroll 8
    for (int i = 0; i < 32; ++i) { const int kk = 2 * i + (lane >> 5); scr[kk * 33 + (lane & 31)] = m.load(k0 + kk, n0 + (lane & 31)); }
    LDS_WAIT(); asm volatile("" ::: "memory");
    const int c = lane & 7;
#pragma unroll
    for (int j = 0; j < 4; ++j) { const int n = (lane >> 3) + 8 * j; const LAS float* s = scr + (8 * c) * 33 + n;
        u32x4 o; o.x = pk2(s[0 * 33], s[1 * 33]); o.y = pk2(s[2 * 33], s[3 * 33]); o.z = pk2(s[4 * 33], s[5 * 33]); o.w = pk2(s[6 * 33], s[7 * 33]);
        *(u32x4*)(dst + (size_t)(n0 + n) * Kd + k0 + 8 * c) = o; }
    LDS_WAIT(); asm volatile("" ::: "memory");
}
template <class M> __device__ __forceinline__ void prep_tile(const M& m, bf16_t* dst, int Kd, int nblk, LAS unsigned char* tile, int item, int lane) {
    const int kb = item / nblk, nb = item % nblk, k0 = 128 * kb, n0 = 32 * nb, ng = lane & 7, kr = lane >> 3;
    f32x4 v[16];
#pragma unroll
    for (int i = 0; i < 16; ++i) v[i] = m.load4(k0 + 8 * i + kr, n0 + 4 * ng);
#pragma unroll
    for (int i = 0; i < 16; ++i)
#pragma unroll
        for (int c = 0; c < 4; ++c) *(LAS unsigned short*)(tile + (4 * ng + c) * 272 + (8 * i + kr) * 2) = (unsigned short)f2bf(v[i][c]);
    LDS_WAIT(); asm volatile("" ::: "memory");
#pragma unroll
    for (int j = 0; j < 8; ++j) { const int p = lane + 64 * j, n = p >> 4, kc = p & 15;
        *(u32x4*)(dst + (size_t)(n0 + n) * Kd + k0 + 8 * kc) = *(const LAS u32x4*)(tile + n * 272 + 16 * kc); }
    LDS_WAIT(); asm volatile("" ::: "memory");
}
template <class M> __device__ __forceinline__ void prep_matrix(Frame& F, const M& m, bf16_t* dst, int N, int K) {
    LAS unsigned char* tile = F.lds + F.wave * 16384;
    const int gw = F.vcu * NWAVES + F.wave, NGW = F.G * NWAVES, nblk = N / 32, nitems = (K / 128) * nblk;
    for (int it = gw; it < nitems; it += NGW) prep_tile(m, dst, K, nblk, tile, it, F.lane);
}

template <class M> __device__ __forceinline__ void prep_strip_i8(Frame& F, const M& m, signed char* dst, float* scl, int strip) {
    const int lane = F.lane, w = F.wave, n0 = strip * 32, k0 = w * 128, ng = lane & 7, kr = lane >> 3;
    LAS unsigned char* tile = F.lds + w * 16384;
    LAS float* amt = (LAS float*)(F.lds + LDSCTL_OFF + 2048);
    f32x4 v[16];
#pragma unroll
    for (int i = 0; i < 16; ++i) v[i] = m.load4(k0 + 8 * i + kr, n0 + 4 * ng);
    f32x4 am = __builtin_elementwise_abs(v[0]);
#pragma unroll
    for (int i = 1; i < 16; ++i) am = __builtin_elementwise_max(am, __builtin_elementwise_abs(v[i]));
#pragma unroll
    for (int c = 0; c < 4; ++c) { float a = am[c]; a = fmaxf(a, __shfl_xor(a, 8)); a = fmaxf(a, __shfl_xor(a, 16)); a = fmaxf(a, __shfl_xor(a, 32)); am[c] = a; }
    if (kr == 0) *(LAS f32x4*)(amt + w * 32 + 4 * ng) = am;
    __syncthreads();
    f32x4 cm = *(const LAS f32x4*)(amt + 4 * ng);
#pragma unroll
    for (int ww = 1; ww < 8; ++ww) cm = __builtin_elementwise_max(cm, *(const LAS f32x4*)(amt + ww * 32 + 4 * ng));
    f32x4 inv;
#pragma unroll
    for (int c = 0; c < 4; ++c) inv[c] = cm[c] > 0.f ? 127.0f / cm[c] : 0.f;
    if (w == 0 && kr == 0) *(f32x4*)(scl + n0 + 4 * ng) = cm * (1.0f / 127.0f);
#pragma unroll
    for (int i = 0; i < 16; ++i)
#pragma unroll
        for (int c = 0; c < 4; ++c) tile[(4 * ng + c) * 144 + 8 * i + kr] = (unsigned char)(signed char)__float2int_rn(v[i][c] * inv[c]);
    LDS_WAIT(); asm volatile("" ::: "memory");
#pragma unroll
    for (int j = 0; j < 4; ++j) { const int p = lane + 64 * j, n = p >> 3, kc = p & 7;
        *(u32x4*)(dst + (size_t)(n0 + n) * DM + k0 + 16 * kc) = *(const LAS u32x4*)(tile + n * 144 + 16 * kc); }
    LDS_WAIT();
    __syncthreads();
}
__device__ __forceinline__ bf16_t* wmix(Frame& F, int l, size_t off) { return (bf16_t*)(F.ws + WS_WMIX + (size_t)l * WL_STRIDE + off); }

__device__ __forceinline__ void prep_mixer_weights(Frame& F) {
    for (int l = 0; l < DEPTH; ++l) {
        { MapInproj m{F.in[I_WIN] + (size_t)l * DM * INW}; for (int s = F.vcu; s < NT_IN * 8; s += F.G) prep_strip_i8(F, m, (signed char*)wmix(F, l, WL_IN), (float*)(F.ws + WS_MISC + MS_WSIN) + l * NT_IN * 256, s); }
        { MapUp m{F.in[I_WUQ] + (size_t)l * 256 * 768, F.in[I_WUKV] + (size_t)l * 128 * 1024, F.in[I_GQ] + l * 256, F.in[I_GKV] + l * 128}; prep_matrix(F, m, wmix(F, l, WL_UP), UPN, UPK); }
        { MapBr m{F.in[I_WBR] + (size_t)l * 3 * 512 * DM}; prep_matrix(F, m, wmix(F, l, WL_BR), DM, 1536); }
        { MapPlain m{F.in[I_WOUT] + (size_t)l * DM * DM, DM}; prep_matrix(F, m, wmix(F, l, WL_OUT), DM, DM); }
    }
    { MapMemkv m{F.in[I_WMKV]}; prep_matrix(F, m, (bf16_t*)(F.ws + WS_WMKV), 4096, DM); }
}
__device__ __forceinline__ void prep_ffn_weights(Frame& F, int l) {
    const int i = l >> 1; const bool moe = (l & 1) != 0;
    LAS float* scr = (LAS float*)(F.lds + F.wave * 16384);
    const int gw = F.vcu * NWAVES + F.wave, NGW = F.G * NWAVES;
    constexpr int IGU = (DM / 64) * (2 * DFF / 32), ID = (DFF / 64) * (DM / 32), NSTRIP = 2 * DFF / 32;
    const int ne = moe ? NE : 1;
    const float* Wg = moe ? F.in[I_WGE] : F.in[I_WGD]; const float* Wu = moe ? F.in[I_WUE] : F.in[I_WUD]; const float* Wd = moe ? F.in[I_WDE] : F.in[I_WDD];
    if (GU_I8(l)) {
        for (int s = F.vcu; s < ne * NSTRIP; s += F.G) { const int e = s / NSTRIP, ss = s % NSTRIP; const size_t eo = ((size_t)i * ne + e) * DM * DFF;
            MapGU m{Wg + eo, Wu + eo}; prep_strip_i8(F, m, (signed char*)(F.ws + WS_WFFN + (size_t)e * WF_STRIDE), (float*)(F.ws + WS_MISC + MS_WSGU) + e * 2 * DFF, ss); }
    } else {
        for (int it = gw; it < ne * IGU; it += NGW) { const int e = it / IGU, r = it % IGU; const size_t eo = ((size_t)i * ne + e) * DM * DFF;
            MapGU m{Wg + eo, Wu + eo}; prep_item(m, (bf16_t*)(F.ws + WS_WFFN + (size_t)e * WF_STRIDE), DM, 2 * DFF / 32, scr, r, F.lane); }
    }
    constexpr int IDT = (DFF / 128) * (DM / 32);
    for (int it = gw; it < ne * IDT; it += NGW) { const int e = it / IDT, r = it % IDT; const size_t eo = ((size_t)i * ne + e) * DM * DFF;
        MapPlain m{Wd + eo, DM}; prep_tile(m, (bf16_t*)(F.ws + WS_WFFN + (size_t)e * WF_STRIDE + WF_D), DFF, DM / 32, F.lds + F.wave * 16384, r, F.lane); }
}

struct RowV { f32x4 v[4]; };
__device__ __forceinline__ void row_load(RowV& r, const float* p, int lane) { const f32x4* x = (const f32x4*)p + lane;
#pragma unroll
    for (int j = 0; j < 4; ++j) r.v[j] = x[64 * j]; }
__device__ __forceinline__ void row_store(const RowV& r, float* p, int lane) { f32x4* x = (f32x4*)p + lane;
#pragma unroll
    for (int j = 0; j < 4; ++j) x[64 * j] = r.v[j]; }
__device__ __forceinline__ void row_add_bf16(RowV& r, const bf16_t* p, float w, int lane) { const u32x2* x = (const u32x2*)p + lane;
#pragma unroll
    for (int j = 0; j < 4; ++j) { const u32x2 q = x[64 * j]; r.v[j].x += w * bflo(q.x); r.v[j].y += w * bfhi(q.x); r.v[j].z += w * bflo(q.y); r.v[j].w += w * bfhi(q.y); } }
__device__ __forceinline__ void row_load_bf16(RowV& r, const bf16_t* p, int lane) { const u32x2* x = (const u32x2*)p + lane;
#pragma unroll
    for (int j = 0; j < 4; ++j) { const u32x2 q = x[64 * j]; r.v[j].x = bflo(q.x); r.v[j].y = bfhi(q.x); r.v[j].z = bflo(q.y); r.v[j].w = bfhi(q.y); } }
__device__ __forceinline__ void row_round_bf16(RowV& r) {
#pragma unroll
    for (int j = 0; j < 4; ++j) { r.v[j].x = bf2f((unsigned short)f2bf(r.v[j].x)); r.v[j].y = bf2f((unsigned short)f2bf(r.v[j].y)); r.v[j].z = bf2f((unsigned short)f2bf(r.v[j].z)); r.v[j].w = bf2f((unsigned short)f2bf(r.v[j].w)); } }
__device__ __forceinline__ float row_rstd(const RowV& r) { float s = 0.f;
#pragma unroll
    for (int j = 0; j < 4; ++j) s += (r.v[j].x * r.v[j].x + r.v[j].y * r.v[j].y) + (r.v[j].z * r.v[j].z + r.v[j].w * r.v[j].w);
    return 1.0f / sqrtf(wave_sum(s) * (1.0f / DM) + EPS); }
__device__ __forceinline__ void row_scale(RowV& r, float rstd, const float* g, int lane) { const f32x4* gg = (const f32x4*)g + lane;
#pragma unroll
    for (int j = 0; j < 4; ++j) r.v[j] = r.v[j] * rstd * gg[64 * j]; }
__device__ __forceinline__ void row_store_bf16(const RowV& r, bf16_t* p, int lane) { u32x2* o = (u32x2*)p + lane;
#pragma unroll
    for (int j = 0; j < 4; ++j) { u32x2 w; w.x = pk2(r.v[j].x, r.v[j].y); w.y = pk2(r.v[j].z, r.v[j].w); o[64 * j] = w; } }

__device__ __forceinline__ float row_store_i8(const RowV& r, signed char* p, int lane) {
    float am = 0.f;
#pragma unroll
    for (int j = 0; j < 4; ++j) am = fmaxf(am, fmaxf(fmaxf(fabsf(r.v[j].x), fabsf(r.v[j].y)), fmaxf(fabsf(r.v[j].z), fabsf(r.v[j].w))));
#pragma unroll
    for (int o = 1; o < 64; o <<= 1) am = fmaxf(am, __shfl_xor(am, o));
    const float inv = am > 0.f ? 127.0f / am : 0.f; unsigned* o4 = (unsigned*)p + lane;
#pragma unroll
    for (int j = 0; j < 4; ++j) { const unsigned a = (unsigned)__float2int_rn(r.v[j].x * inv) & 255u, b = (unsigned)__float2int_rn(r.v[j].y * inv) & 255u, c = (unsigned)__float2int_rn(r.v[j].z * inv) & 255u, d = (unsigned)__float2int_rn(r.v[j].w * inv) & 255u;
        o4[64 * j] = a | (b << 8) | (c << 16) | (d << 24); }
    return am * (1.0f / 127.0f);
}
__device__ __forceinline__ void row_combine(Frame& F, RowV& r, int t) {
    const int* sl = (const int*)(F.ws + WS_MISC + MS_SLOT) + 2 * t; const float* tw = (const float*)(F.ws + WS_MISC + MS_TOKW) + 2 * t;
    const bf16_t* Y = (const bf16_t*)(F.ws + WS_R + R_YOUT);
    const int s0 = sl[0], s1 = sl[1]; const float w0 = tw[0], w1 = tw[1];
    row_add_bf16(r, Y + (size_t)s0 * DM, w0, F.lane); row_add_bf16(r, Y + (size_t)s1 * DM, w1, F.lane);
}

__device__ __forceinline__ void norm_phase(Frame& F, const float* srcf, bf16_t* X, const float* g, bool combine, bool out_i8) {
    bf16_t* H = (bf16_t*)(F.ws + WS_H); signed char* Hq = (signed char*)(F.ws + WS_H); float* hsc = (float*)(F.ws + WS_MISC + MS_HSC);
    const int gw = F.vcu * NWAVES + F.wave, NGW = F.G * NWAVES;
    for (int t = gw; t < T; t += 2 * NGW) {
        const int t2 = t + NGW;
        RowV r, q;
        if (srcf) { row_load(r, srcf + (size_t)t * DM, F.lane); row_load(q, srcf + (size_t)t2 * DM, F.lane); }
        else { row_load_bf16(r, X + (size_t)t * DM, F.lane); row_load_bf16(q, X + (size_t)t2 * DM, F.lane); }
        if (combine) { row_combine(F, r, t); row_combine(F, q, t2); row_store_bf16(r, X + (size_t)t * DM, F.lane); row_store_bf16(q, X + (size_t)t2 * DM, F.lane);
            row_round_bf16(r); row_round_bf16(q); }
        const float rstd = row_rstd(r), qstd = row_rstd(q); row_scale(r, rstd, g, F.lane); row_scale(q, qstd, g, F.lane);
        if (out_i8) { const float sc = row_store_i8(r, Hq + (size_t)t * DM, F.lane), sq = row_store_i8(q, Hq + (size_t)t2 * DM, F.lane); if (F.lane == 0) { hsc[t] = sc; hsc[t2] = sq; } }
        else { row_store_bf16(r, H + (size_t)t * DM, F.lane); row_store_bf16(q, H + (size_t)t2 * DM, F.lane); }
    }
}
__device__ __forceinline__ void final_norm_phase(Frame& F, const bf16_t* X, float* out, const float* g, bool combine) {
    const int gw = F.vcu * NWAVES + F.wave, NGW = F.G * NWAVES;
    for (int t = gw; t < T; t += 2 * NGW) {
        const int t2 = t + NGW;
        RowV r, q; row_load_bf16(r, X + (size_t)t * DM, F.lane); row_load_bf16(q, X + (size_t)t2 * DM, F.lane);
        if (combine) { row_combine(F, r, t); row_combine(F, q, t2); }
        const float rstd = row_rstd(r), qstd = row_rstd(q); row_scale(r, rstd, g, F.lane); row_scale(q, qstd, g, F.lane);
        row_store(r, out + (size_t)t * DM, F.lane); row_store(q, out + (size_t)t2 * DM, F.lane);
    }
}
__device__ __forceinline__ void memnorm_phase(Frame& F) {
    bf16_t* MN = (bf16_t*)(F.ws + WS_MEMN);
    const int gw = F.vcu * NWAVES + F.wave, NGW = F.G * NWAVES;
    for (int t = gw; t < NB * MEML; t += NGW) {
        RowV r; row_load(r, F.in[I_MEM] + (size_t)t * DM, F.lane);
        const float rstd = row_rstd(r); row_scale(r, rstd, F.in[I_GMEM], F.lane);
        row_store_bf16(r, MN + (size_t)t * DM, F.lane);
    }
}

__device__ __forceinline__ void norm_router_phase(Frame& F, const bf16_t* X, const float* g, const float* Wr  , bool out_i8) {
    bf16_t* H = (bf16_t*)(F.ws + WS_H); signed char* Hq = (signed char*)(F.ws + WS_H); float* hsc = (float*)(F.ws + WS_MISC + MS_HSC);
    int* toke = (int*)(F.ws + WS_MISC + MS_TOKE); float* tokw = (float*)(F.ws + WS_MISC + MS_TOKW); int* cntg = (int*)(F.ws + WS_MISC + MS_CNT);
    volatile LAS int* hist = (volatile LAS int*)(F.lds + LDSCTL_OFF + 1024);
    f32x4 wa[4][4], wb[4][4];
#pragma unroll
    for (int j = 0; j < 4; ++j)
#pragma unroll
        for (int k = 0; k < 4; ++k) { const int d = 256 * j + 4 * F.lane + k; wa[j][k] = *(const f32x4*)(Wr + (size_t)d * 8); wb[j][k] = *(const f32x4*)(Wr + (size_t)d * 8 + 4); }
    const bool up32 = (F.lane & 32) != 0, up16 = (F.lane & 16) != 0, up8 = (F.lane & 8) != 0;
    for (int c = F.vcu; c < T / 128; c += F.G) {
        if (F.tid < 8) hist[F.tid] = 0;
        __syncthreads();
        for (int q = 0; q < 16; ++q) {
            const int t = c * 128 + F.wave * 16 + q;
            RowV r; row_load_bf16(r, X + (size_t)t * DM, F.lane);
            const float rstd = row_rstd(r); row_scale(r, rstd, g, F.lane);
            if (out_i8) { const float sc = row_store_i8(r, Hq + (size_t)t * DM, F.lane); if (F.lane == 0) hsc[t] = sc; }
            else row_store_bf16(r, H + (size_t)t * DM, F.lane);
            f32x4 la = {0.f, 0.f, 0.f, 0.f}, lb = {0.f, 0.f, 0.f, 0.f};
#pragma unroll
            for (int j = 0; j < 4; ++j)
#pragma unroll
                for (int k = 0; k < 4; ++k) { const float x = r.v[j][k]; la += wa[j][k] * x; lb += wb[j][k] * x; }
            f32x4 h4; { const f32x4 keep = up32 ? lb : la, send = up32 ? la : lb;
#pragma unroll
                for (int i = 0; i < 4; ++i) h4[i] = keep[i] + __shfl_xor(send[i], 32); }
            f32x2 h2; { const float k0 = up16 ? h4[2] : h4[0], k1 = up16 ? h4[3] : h4[1], s0 = up16 ? h4[0] : h4[2], s1 = up16 ? h4[1] : h4[3]; h2.x = k0 + __shfl_xor(s0, 16); h2.y = k1 + __shfl_xor(s1, 16); }
            float h1 = (up8 ? h2.y : h2.x) + __shfl_xor(up8 ? h2.x : h2.y, 8);
            h1 += __shfl_xor(h1, 4); h1 += __shfl_xor(h1, 2); h1 += __shfl_xor(h1, 1);
            float lg[8];
#pragma unroll
            for (int e = 0; e < 8; ++e) lg[e] = __builtin_bit_cast(float, __builtin_amdgcn_readlane(__builtin_bit_cast(int, h1), 8 * e));
            int e0 = 0; float v0 = lg[0];
#pragma unroll
            for (int e = 1; e < 8; ++e) if (lg[e] > v0) { v0 = lg[e]; e0 = e; }
            int e1 = -1; float v1 = -INFINITY;
#pragma unroll
            for (int e = 0; e < 8; ++e) if (e != e0 && lg[e] > v1) { v1 = lg[e]; e1 = e; }
            if (F.lane == 0) {
                const float w0 = 1.0f / (1.0f + __expf(v1 - v0));
                toke[2 * t] = e0; toke[2 * t + 1] = e1; tokw[2 * t] = w0; tokw[2 * t + 1] = 1.0f - w0;
                __hip_atomic_fetch_add((LAS int*)&hist[e0], 1, __ATOMIC_RELAXED, __HIP_MEMORY_SCOPE_WORKGROUP); __hip_atomic_fetch_add((LAS int*)&hist[e1], 1, __ATOMIC_RELAXED, __HIP_MEMORY_SCOPE_WORKGROUP);
            }
        }
        __syncthreads();
        if (F.tid < 8) cntg[c * 8 + F.tid] = hist[F.tid];
        __syncthreads();
    }
}
__device__ __forceinline__ void moe_assign_phase(Frame& F, bool i8) {
    const bf16_t* H = (const bf16_t*)(F.ws + WS_H); bf16_t* AS = (bf16_t*)(F.ws + WS_R + R_ASORT);
    const float* hsc = (const float*)(F.ws + WS_MISC + MS_HSC); float* asc = (float*)(F.ws + WS_MISC + MS_ASC);
    const int* toke = (const int*)(F.ws + WS_MISC + MS_TOKE); int* slot = (int*)(F.ws + WS_MISC + MS_SLOT); const int* cntg = (const int*)(F.ws + WS_MISC + MS_CNT);
    int* texp = (int*)(F.ws + WS_MISC + MS_TEXP);
    volatile LAS int* tot = (volatile LAS int*)(F.lds + LDSCTL_OFF + 1024);
    volatile LAS int* pre = tot + 8;
    volatile LAS int* wcnt = tot + 16;
    for (int c = F.vcu; c < T / 128; c += F.G) {
        if (F.tid < 16) tot[F.tid] = 0;
        __syncthreads();
        { const int cc = F.tid >> 1, h = F.tid & 1; const i32x4 v = *(const i32x4*)(cntg + cc * 8 + 4 * h);
#pragma unroll
          for (int k = 0; k < 4; ++k) { __hip_atomic_fetch_add((LAS int*)&tot[4 * h + k], v[k], __ATOMIC_RELAXED, __HIP_MEMORY_SCOPE_WORKGROUP); if (cc < c) __hip_atomic_fetch_add((LAS int*)&pre[4 * h + k], v[k], __ATOMIC_RELAXED, __HIP_MEMORY_SCOPE_WORKGROUP); } }
        const int t = c * 128 + F.wave * 16 + ((F.lane & 31) >> 1);
        const int my_e = (F.lane < 32) ? toke[2 * t + (F.lane & 1)] : -1;
        int rank = 0;
#pragma unroll
        for (int e = 0; e < 8; ++e) { const unsigned long long m = __ballot(my_e == e); if (my_e == e) rank = __popcll(m & ((1ull << F.lane) - 1ull)); if (F.lane == 0) wcnt[F.wave * 8 + e] = __popcll(m); }
        __syncthreads();
        int myslot = 0;
        if (F.lane < 32) {
            int ts = 0;
#pragma unroll
            for (int e = 0; e < 8; ++e) ts += (e < my_e) ? ((tot[e] + 255) >> 8) : 0;
            int wp = 0; for (int w = 0; w < F.wave; ++w) wp += wcnt[w * 8 + my_e];
            myslot = ts * 256 + pre[my_e] + wp + rank;
            slot[2 * t + (F.lane & 1)] = myslot;
        }
        if (c == 0 && F.tid == 0) { int ts = 0; for (int e = 0; e < 8; ++e) { const int n = (tot[e] + 255) >> 8; for (int k = 0; k < n; ++k) texp[ts + k] = e; ts += n; } for (int k = ts; k < MAXRT; ++k) texp[k] = 0; texp[MAXRT] = ts; }
        if (i8) {
            const float myh = hsc[t];
#pragma unroll 1
            for (int a0 = 0; a0 < 32; a0 += 8) {
                u32x4 x[4];
#pragma unroll
                for (int k = 0; k < 4; ++k) x[k] = *((const u32x4*)((const signed char*)H + (size_t)(c * 128 + F.wave * 16 + ((a0 + 2 * k) >> 1)) * DM) + F.lane);
#pragma unroll
                for (int k = 0; k < 8; ++k) { const int s = __builtin_amdgcn_readlane(myslot, a0 + k); *((u32x4*)((signed char*)AS + (size_t)s * DM) + F.lane) = x[k >> 1]; }
            }
            if (F.lane < 32) asc[myslot] = myh;
        } else {
            for (int a = 0; a < 32; ++a) {
                const int s = __builtin_amdgcn_readlane(myslot, a); const int ta = c * 128 + F.wave * 16 + (a >> 1);
                const u32x4* srcp = (const u32x4*)(H + (size_t)ta * DM) + F.lane; u32x4* dstp = (u32x4*)(AS + (size_t)s * DM) + F.lane;
                const u32x4 x0 = srcp[0], x1 = srcp[64]; dstp[0] = x0; dstp[64] = x1; }
        }
        __syncthreads();
    }
}

using pg8::Unit;
typedef f32x4 AccT[2][2][4][2];

struct ProbSimple { int K; unsigned lda, ldb; const char* A; const char* B;
    __device__ __forceinline__ const char* a_ptr(const Unit& u) const { return A + (size_t)u.pm * 256 * lda; }
    __device__ __forceinline__ const char* b_ptr(const Unit& u) const { return B + (size_t)u.pn * 256 * ldb; } };
struct ProbUp { int K; unsigned lda, ldb; const char* A; const char* B;
    __device__ __forceinline__ const char* a_ptr(const Unit& u) const { return A + (size_t)u.pm * 256 * lda + (u.pn >= 3 ? 256 : 0); }
    __device__ __forceinline__ const char* b_ptr(const Unit& u) const { return B + (size_t)u.pn * 256 * ldb; } };
struct ProbMoe { int K; unsigned lda, ldb; const char* A; const char* B; int a_lo;
    __device__ __forceinline__ const char* a_ptr(const Unit& u) const { return A + (size_t)(u.pm - a_lo) * 256 * lda; }
    __device__ __forceinline__ const char* b_ptr(const Unit& u) const { return B + (size_t)u.aux * WF_STRIDE + (size_t)u.pn * 256 * ldb; } };

struct MoeOrder { pg8::StaticOrder base; int lo; const int* texp;
    __device__ bool next(int i, Unit& u) const { if (!base.next(i, u)) return false; u.pm += lo; u.aux = __builtin_amdgcn_readfirstlane(texp[u.pm]); return true; } };

__device__ __forceinline__ u32x4 pack8(const f32x4 a, const f32x4 b) { u32x4 w; w.x = cvtpk(a[0], a[1]); w.y = cvtpk(a[2], a[3]); w.z = cvtpk(b[0], b[1]); w.w = cvtpk(b[2], b[3]); return w; }
__device__ __forceinline__ u32x2 pack4(const f32x4 a) { u32x2 w; w.x = cvtpk(a[0], a[1]); w.y = cvtpk(a[2], a[3]); return w; }

struct EpiNoStage { __device__ __forceinline__ void stage(LAS unsigned char*, const Unit&, int, int) const {} };
__device__ __forceinline__ void stage1k(const void* src, LAS unsigned char* dst, int lane) { __builtin_amdgcn_global_load_lds((const unsigned*)((const char*)src + lane * 16), (LAS unsigned*)dst, 16, 0, 0); }
__device__ __forceinline__ f32x4 deq(const f32x4& a, float, const f32x4&) { return a; }
__device__ __forceinline__ f32x4 deq(const i32x4& a, float rs, const f32x4& cs) { return __builtin_convertvector(a, f32x4) * rs * cs; }
struct EpiInproj {
    static constexpr bool MID = false;
    bf16_t* P; bf16_t* G; float* ssq; const int* pos; const float* rsc; const float* csc;
    __device__ __forceinline__ void stage(LAS unsigned char* d, const Unit& u, int wid, int lane) const {
        if (wid == 0) { stage1k(rsc + u.pm * 256, d, lane); stage1k(csc + u.pn * 256, d + 1024, lane); stage1k(pos + u.pm * 256, d + 2048, lane); } }
    template <class AV> __device__ __forceinline__ void operator()(const AV (&acc)[2][2][4][2], const Unit& u, int wr, int wc, int fr, int fq, const LAS unsigned char* esc) const {
        const int pn = u.pn, row0 = u.pm * 256 + wr * 64 + fr;
        f32x4 cs[2][2];
#pragma unroll
        for (int bj = 0; bj < 2; ++bj)
#pragma unroll
            for (int n = 0; n < 2; ++n) cs[bj][n] = *(const LAS f32x4*)(esc + 1024 + (bj * 128 + wc * 32 + n * 16 + fq * 4) * 4);
        float rs8[2][4], pf8[2][4];
#pragma unroll
        for (int ai = 0; ai < 2; ++ai)
#pragma unroll
            for (int m = 0; m < 4; ++m) { const int rl = ai * 128 + wr * 64 + m * 16 + fr; rs8[ai][m] = *(const LAS float*)(esc + rl * 4); pf8[ai][m] = (float)*(const LAS int*)(esc + 2048 + rl * 4); }
#define DQ(ai, bj, m, n) deq(acc[ai][bj][m][n], rs, cs[bj][n])
        if (pn >= 7) {
#pragma unroll
            for (int ai = 0; ai < 2; ++ai)
#pragma unroll
                for (int m = 0; m < 4; ++m) { const int row = row0 + ai * 128 + m * 16; const float rs = rs8[ai][m]; u32x4 w;
#pragma unroll
                    for (int bj = 0; bj < 2; ++bj) { f32x4 a = DQ(ai, bj, m, 0), b = DQ(ai, bj, m, 1);
#pragma unroll
                        for (int j = 0; j < 4; ++j) { a[j] = fast_sigmoid(a[j]) * 255.0f; b[j] = fast_sigmoid(b[j]) * 255.0f; }
                        const unsigned wa_ = (unsigned)__float2int_rn(a[0]) | ((unsigned)__float2int_rn(a[1]) << 8) | ((unsigned)__float2int_rn(a[2]) << 16) | ((unsigned)__float2int_rn(a[3]) << 24);
                        const unsigned wb_ = (unsigned)__float2int_rn(b[0]) | ((unsigned)__float2int_rn(b[1]) << 8) | ((unsigned)__float2int_rn(b[2]) << 16) | ((unsigned)__float2int_rn(b[3]) << 24);
                        if (bj == 0) { w.x = wa_; w.y = wb_; } else { w.z = wa_; w.w = wb_; } }
                    *(u32x4*)((unsigned char*)G + (size_t)row * GW + (pn - 7) * 256 + wc * 64 + fq * 16) = w; }
        } else if (pn >= 5 || pn == 3) {
            const float sc = (pn == 3) ? 1.0f : C_M;
#pragma unroll
            for (int ai = 0; ai < 2; ++ai)
#pragma unroll
                for (int m = 0; m < 4; ++m) { const int row = row0 + ai * 128 + m * 16; const float rs = rs8[ai][m]; float s = 0.f;
#pragma unroll
                    for (int bj = 0; bj < 2; ++bj) { const f32x4 a = DQ(ai, bj, m, 0) * sc, b = DQ(ai, bj, m, 1) * sc;
                        s += (a[0] * a[0] + a[1] * a[1]) + (a[2] * a[2] + a[3] * a[3]) + (b[0] * b[0] + b[1] * b[1]) + (b[2] * b[2] + b[3] * b[3]);
                        *(u32x4*)(P + (size_t)row * PW + pn * 256 + bj * 128 + wc * 32 + fq * 8) = pack8(a, b); }
                    if (pn == 3) { s += __shfl_xor(s, 16); s += __shfl_xor(s, 32); if (fq == 0) ssq[(size_t)row * 8 + wc] = s; } }
        } else if (pn == 4) {
#pragma unroll
            for (int ai = 0; ai < 2; ++ai)
#pragma unroll
                for (int m = 0; m < 4; ++m) { const int row = row0 + ai * 128 + m * 16; const float rs = rs8[ai][m];
                    { const f32x4 a = DQ(ai, 0, m, 0), b = DQ(ai, 0, m, 1);
                      float s = (a[0] * a[0] + a[1] * a[1]) + (a[2] * a[2] + a[3] * a[3]) + (b[0] * b[0] + b[1] * b[1]) + (b[2] * b[2] + b[3] * b[3]);
                      *(u32x4*)(P + (size_t)row * PW + P_CKV + wc * 32 + fq * 8) = pack8(a, b);
                      s += __shfl_xor(s, 16); s += __shfl_xor(s, 32); if (fq == 0) ssq[(size_t)row * 8 + 4 + wc] = s; }
                    if (wc == 0) { const f32x4 x1 = DQ(ai, 1, m, 0), x2 = DQ(ai, 1, m, 1); const float pf = pf8[ai][m]; f32x4 o1, o2;
#pragma unroll
                        for (int j = 0; j < 4; ++j) { float c, s; rot_cs(pf, 2 * (4 * fq + j), c, s); o1[j] = x1[j] * c - x2[j] * s; o2[j] = x2[j] * c + x1[j] * s; }
                        *(u32x2*)(P + (size_t)row * PW + P_KR + 4 * fq) = pack4(o1); *(u32x2*)(P + (size_t)row * PW + P_KR + 16 + 4 * fq) = pack4(o2); } }
        } else {
            const float sc = (pn < 2) ? C_A : 1.0f; const int i0 = 16 * (wc & 1) + 4 * fq;
#pragma unroll
            for (int ai = 0; ai < 2; ++ai)
#pragma unroll
                for (int m = 0; m < 4; ++m) { const int row = row0 + ai * 128 + m * 16; const float rs = rs8[ai][m]; const float pf = pf8[ai][m]; f32x4 c, s;
#pragma unroll
                    for (int j = 0; j < 4; ++j) { float cc, ss; rot_cs(pf, i0 + j, cc, ss); c[j] = cc * sc; s[j] = ss * sc; }
#pragma unroll
                    for (int bj = 0; bj < 2; ++bj) { const f32x4 x1 = DQ(ai, bj, m, 0), x2 = DQ(ai, bj, m, 1);
                        if (pn == 2 && bj == 1) { *(u32x4*)(P + (size_t)row * PW + P_VA + wc * 32 + fq * 8) = pack8(x1, x2); }
                        else { const f32x4 o1 = x1 * c - x2 * s, o2 = x2 * c + x1 * s; bf16_t* d = P + (size_t)row * PW + pn * 256 + 64 * (2 * bj + (wc >> 1)) + i0;
                            *(u32x2*)d = pack4(o1); *(u32x2*)(d + 32) = pack4(o2); } } }
        }
#undef DQ
    }
};
struct EpiUp {
    static constexpr bool MID = false;
    __device__ __forceinline__ void stage(LAS unsigned char*, const Unit&, int, int) const {}
    bf16_t* QB; bf16_t* KVB; const float* ssq; const int* pos;
    __device__ __forceinline__ void operator()(const AccT& acc, const Unit& u, int wr, int wc, int fr, int fq, const LAS unsigned char*) const {
        const int pn = u.pn, row0 = u.pm * 256 + wr * 64 + fr;
        float rs8[2][4], pf8[2][4];
#pragma unroll
        for (int ai = 0; ai < 2; ++ai)
#pragma unroll
            for (int m = 0; m < 4; ++m) { const int row = row0 + ai * 128 + m * 16; const f32x4 sv = *(const f32x4*)(ssq + (size_t)row * 8 + (pn < 3 ? 0 : 4));
                rs8[ai][m] = (pn < 3 ? C_B : 1.0f) / sqrtf(((sv[0] + sv[1]) + (sv[2] + sv[3])) * (pn < 3 ? 1.0f / 256.0f : 1.0f / 128.0f) + EPS); pf8[ai][m] = (pn < 3) ? (float)pos[row] : 0.f; }
#pragma unroll
        for (int ai = 0; ai < 2; ++ai)
#pragma unroll
            for (int m = 0; m < 4; ++m) { const int row = row0 + ai * 128 + m * 16; const float rs = rs8[ai][m];
                if (pn < 3) {
#pragma unroll
                    for (int bj = 0; bj < 2; ++bj) { const int gg = 8 * pn + 4 * bj + wc; const f32x4 x1 = acc[ai][bj][m][0] * rs, x2 = acc[ai][bj][m][1] * rs;
                        if (gg % 3 == 2) { const float pf = pf8[ai][m]; f32x4 o1, o2;
#pragma unroll
                            for (int j = 0; j < 4; ++j) { float c, s; rot_cs(pf, 2 * (4 * fq + j), c, s); o1[j] = x1[j] * c - x2[j] * s; o2[j] = x2[j] * c + x1[j] * s; }
                            bf16_t* d = QB + (size_t)row * QBW + 32 * gg + 4 * fq; *(u32x2*)d = pack4(o1); *(u32x2*)(d + 16) = pack4(o2); }
                        else *(u32x4*)(QB + (size_t)row * QBW + 32 * gg + 8 * fq) = pack8(x1, x2); }
                } else {
#pragma unroll
                    for (int bj = 0; bj < 2; ++bj) *(u32x4*)(KVB + (size_t)row * KVW + (pn - 3) * 256 + bj * 128 + wc * 32 + fq * 8) = pack8(acc[ai][bj][m][0] * rs, acc[ai][bj][m][1] * rs);
                } }
    }
};
struct EpiPlain {
    static constexpr bool MID = false;
    __device__ __forceinline__ void stage(LAS unsigned char*, const Unit&, int, int) const {}
    bf16_t* O; int ldo;
    __device__ __forceinline__ void operator()(const AccT& acc, const Unit& u, int wr, int wc, int fr, int fq, const LAS unsigned char*) const {
        const int row0 = u.pm * 256 + wr * 64 + fr;
#pragma unroll
        for (int ai = 0; ai < 2; ++ai)
#pragma unroll
            for (int m = 0; m < 4; ++m)
#pragma unroll
                for (int bj = 0; bj < 2; ++bj) *(u32x4*)(O + (size_t)(row0 + ai * 128 + m * 16) * ldo + u.pn * 256 + bj * 128 + wc * 32 + fq * 8) = pack8(acc[ai][bj][m][0], acc[ai][bj][m][1]);
    }
};
struct EpiBranch {
    static constexpr bool MID = true;
    const unsigned char* G; bf16_t* MIXED;
    __device__ __forceinline__ void stage(LAS unsigned char*, const Unit&, int, int) const {}
    static __device__ __forceinline__ float gq(unsigned w, int b) { const float f = (float)((w >> (8 * b)) & 255u); return fmaxf(f, 2.55e-4f); }
    __device__ __forceinline__ void mid(AccT& acc, const Unit& u, int seg  , int wr, int wc, int fr, int fq) const {
        const int row0 = opq_v(u.pm * 256 + wr * 64 + fr);
#pragma unroll
        for (int ai = 0; ai < 2; ++ai) {
            u32x4 ga[4], gb[4];
#pragma unroll
            for (int m = 0; m < 4; ++m) { const unsigned char* gp = G + (size_t)(row0 + ai * 128 + m * 16) * GW + u.pn * 256 + wc * 64 + fq * 16;
                ga[m] = *(const u32x4*)(gp + (seg - 1) * 1024); gb[m] = *(const u32x4*)(gp + seg * 1024); }
#pragma unroll
            for (int m = 0; m < 4; ++m) {
#pragma unroll
                for (int j = 0; j < 4; ++j) {
                    acc[ai][0][m][0][j] *= gq(ga[m].x, j) * __builtin_amdgcn_rcpf(gq(gb[m].x, j)); acc[ai][0][m][1][j] *= gq(ga[m].y, j) * __builtin_amdgcn_rcpf(gq(gb[m].y, j));
                    acc[ai][1][m][0][j] *= gq(ga[m].z, j) * __builtin_amdgcn_rcpf(gq(gb[m].z, j)); acc[ai][1][m][1][j] *= gq(ga[m].w, j) * __builtin_amdgcn_rcpf(gq(gb[m].w, j)); } }
            asm volatile("" ::: "memory"); }
    }
    __device__ __forceinline__ void operator()(const AccT& acc, const Unit& u, int wr, int wc, int fr, int fq, const LAS unsigned char*) const {
        const int row0 = u.pm * 256 + wr * 64 + fr;
#pragma unroll
        for (int ai = 0; ai < 2; ++ai) {
            u32x4 gw[4];
#pragma unroll
            for (int m = 0; m < 4; ++m) gw[m] = *(const u32x4*)(G + (size_t)(row0 + ai * 128 + m * 16) * GW + 2048 + u.pn * 256 + wc * 64 + fq * 16);
#pragma unroll
            for (int m = 0; m < 4; ++m) { f32x4 a0 = acc[ai][0][m][0], b0 = acc[ai][0][m][1], a1 = acc[ai][1][m][0], b1 = acc[ai][1][m][1];
#pragma unroll
                for (int j = 0; j < 4; ++j) { a0[j] *= gq(gw[m].x, j) * (1.0f / 255.0f); b0[j] *= gq(gw[m].y, j) * (1.0f / 255.0f); a1[j] *= gq(gw[m].z, j) * (1.0f / 255.0f); b1[j] *= gq(gw[m].w, j) * (1.0f / 255.0f); }
                bf16_t* d = MIXED + (size_t)(row0 + ai * 128 + m * 16) * DM + u.pn * 256 + wc * 64 + fq * 16;
                *(u32x4*)d = pack8(a0, b0); *(u32x4*)(d + 8) = pack8(a1, b1); }
            asm volatile("" ::: "memory"); }
    }
};
struct EpiResid {
    static constexpr bool MID = false;
    __device__ __forceinline__ void stage(LAS unsigned char*, const Unit&, int, int) const {}
    const float* Xf; bf16_t* X;
    __device__ __forceinline__ void operator()(const AccT& acc, const Unit& u, int wr, int wc, int fr, int fq, const LAS unsigned char*) const {
        const int row0 = u.pm * 256 + wr * 64 + fr;
#pragma unroll
        for (int ai = 0; ai < 2; ++ai) {
            f32x4 xa[4][2], xb[4][2];
#pragma unroll
            for (int m = 0; m < 4; ++m)
#pragma unroll
                for (int bj = 0; bj < 2; ++bj) { const size_t o = (size_t)(row0 + ai * 128 + m * 16) * DM + u.pn * 256 + bj * 128 + wc * 32 + fq * 8;
                    if (Xf) { xa[m][bj] = *(const f32x4*)(Xf + o); xb[m][bj] = *(const f32x4*)(Xf + o + 4); }
                    else { const u32x4 q = *(const u32x4*)(X + o); xa[m][bj] = (f32x4){bflo(q.x), bfhi(q.x), bflo(q.y), bfhi(q.y)}; xb[m][bj] = (f32x4){bflo(q.z), bfhi(q.z), bflo(q.w), bfhi(q.w)}; } }
#pragma unroll
            for (int m = 0; m < 4; ++m)
#pragma unroll
                for (int bj = 0; bj < 2; ++bj) *(u32x4*)(X + (size_t)(row0 + ai * 128 + m * 16) * DM + u.pn * 256 + bj * 128 + wc * 32 + fq * 8) = pack8(xa[m][bj] + acc[ai][bj][m][0], xb[m][bj] + acc[ai][bj][m][1]);
            asm volatile("" ::: "memory"); }
    }
};
struct EpiSwiglu {
    static constexpr bool MID = false;
    bf16_t* ACT; int lo; const float* rsc; const float* csc;
    __device__ __forceinline__ void stage(LAS unsigned char* d, const Unit& u, int wid, int lane) const {
        if (wid == 0) { stage1k(rsc + u.pm * 256, d, lane); stage1k(csc + (size_t)u.aux * 2 * DFF + u.pn * 256, d + 1024, lane); } }
    template <class AV> __device__ __forceinline__ void operator()(const AV (&acc)[2][2][4][2], const Unit& u, int wr, int wc, int fr, int fq, const LAS unsigned char* esc) const {
        const int row0 = (u.pm - lo) * 256 + wr * 64 + fr;
        f32x4 cs[2][2];
#pragma unroll
        for (int bj = 0; bj < 2; ++bj)
#pragma unroll
            for (int n = 0; n < 2; ++n) cs[bj][n] = *(const LAS f32x4*)(esc + 1024 + (bj * 128 + wc * 32 + n * 16 + fq * 4) * 4);
        float rs8[2][4];
#pragma unroll
        for (int ai = 0; ai < 2; ++ai)
#pragma unroll
            for (int m = 0; m < 4; ++m) rs8[ai][m] = *(const LAS float*)(esc + (ai * 128 + wr * 64 + m * 16 + fr) * 4);
#pragma unroll
        for (int ai = 0; ai < 2; ++ai)
#pragma unroll
            for (int m = 0; m < 4; ++m) { const float rs = rs8[ai][m]; f32x4 a, b;
                const f32x4 g0 = deq(acc[ai][0][m][0], rs, cs[0][0]), g1 = deq(acc[ai][0][m][1], rs, cs[0][1]), u0 = deq(acc[ai][1][m][0], rs, cs[1][0]), u1 = deq(acc[ai][1][m][1], rs, cs[1][1]);
#pragma unroll
                for (int j = 0; j < 4; ++j) { a[j] = g0[j] * fast_sigmoid(g0[j]) * u0[j]; b[j] = g1[j] * fast_sigmoid(g1[j]) * u1[j]; }
                *(u32x4*)(ACT + (size_t)(row0 + ai * 128 + m * 16) * DFF + u.pn * 128 + wc * 32 + fq * 8) = pack8(a, b); }
    }
};
struct EpiYout {
    static constexpr bool MID = false;
    __device__ __forceinline__ void stage(LAS unsigned char*, const Unit&, int, int) const {}
    bf16_t* Y;
    __device__ __forceinline__ void operator()(const AccT& acc, const Unit& u, int wr, int wc, int fr, int fq, const LAS unsigned char*) const {
        const int row0 = u.pm * 256 + wr * 64 + fr;
#pragma unroll
        for (int ai = 0; ai < 2; ++ai)
#pragma unroll
            for (int m = 0; m < 4; ++m)
#pragma unroll
                for (int bj = 0; bj < 2; ++bj) *(u32x4*)(Y + (size_t)(row0 + ai * 128 + m * 16) * DM + u.pn * 256 + bj * 128 + wc * 32 + fq * 8) = pack8(acc[ai][bj][m][0], acc[ai][bj][m][1]);
    }
};

namespace att {
__device__ __forceinline__ int crow(int r, int hi) { return (r & 3) + 8 * (r >> 2) + 4 * hi; }
__device__ __forceinline__ void glds16(const void* gsrc, unsigned lds_dst) { unsigned keep;
    asm volatile("s_mov_b32 %0, m0\n\ts_mov_b32 m0, %2\n\ts_nop 0\n\tglobal_load_lds_dwordx4 %1, off\n\ts_mov_b32 m0, %0" : "=&s"(keep) : "v"(gsrc), "s"(lds_dst) : "memory"); }
__device__ __forceinline__ float swapmax(float m) { auto rr = __builtin_amdgcn_permlane32_swap(__float_as_uint(m), __float_as_uint(m), false, false); return fmaxf(__uint_as_float(rr[0]), __uint_as_float(rr[1])); }
__device__ __forceinline__ float swapsum(float m) { auto rr = __builtin_amdgcn_permlane32_swap(__float_as_uint(m), __float_as_uint(m), false, false); return __uint_as_float(rr[0]) + __uint_as_float(rr[1]); }
__device__ __forceinline__ void store_o_block(const f32x16& o, float linv, bf16_t* rowp  , int hi) {
#pragma unroll
    for (int rp = 0; rp < 2; ++rp) {
        const u32x2 X = pack4((f32x4){o[8 * rp] * linv, o[8 * rp + 1] * linv, o[8 * rp + 2] * linv, o[8 * rp + 3] * linv});
        const u32x2 Y = pack4((f32x4){o[8 * rp + 4] * linv, o[8 * rp + 5] * linv, o[8 * rp + 6] * linv, o[8 * rp + 7] * linv});
        const auto s0 = __builtin_amdgcn_permlane32_swap(X.x, Y.x, false, false), s1 = __builtin_amdgcn_permlane32_swap(X.y, Y.y, false, false);
        const u32x4 w = {s0[0], s1[0], s0[1], s1[1]};
        *(u32x4*)(rowp + 8 * (2 * rp + hi)) = w; }
}
__device__ __forceinline__ s16x4 vtr(unsigned addr) { s16x4 r; asm volatile("ds_read_b64_tr_b16 %0, %1" : "=&v"(r) : "v"(addr) : "memory"); return r; }
#define VTRO(dst, base, off) asm volatile("ds_read_b64_tr_b16 %0, %1 offset:%c2" : "=&v"(dst) : "v"(base), "i"(off) : "memory")

struct Src {
    const bf16_t* q; int qpitch;
    const bf16_t* k0; int k0pitch;
    const bf16_t* k1; int k1pitch;
    const bf16_t* v; int vpitch;
    bf16_t* o; int opitch;
};
template <int NKC, int NVB, int RD = 4>
__device__ __forceinline__ void dma_tile(const Src& S, int t, int slot, unsigned lds0, int wid, int lane) {
    constexpr int KS = NKC * 1024, VS = NVB * 4096, LDS_K = 0, LDS_V = RD * KS;
#pragma unroll
    for (int c = 0; c < (NKC + 7) / 8; ++c) { const int ch = wid + 8 * c; if (ch < NKC) {
        const bf16_t* src = (ch < 8) ? S.k0 + (size_t)(t * 64 + lane) * S.k0pitch + ch * 8 : S.k1 + (size_t)(t * 64 + lane) * S.k1pitch + (ch - 8) * 8;
        glds16(src, (unsigned)__builtin_amdgcn_readfirstlane(lds0 + LDS_K + slot * KS + ch * 1024)); } }
#pragma unroll
    for (int c = 0; c < (NVB * 4 + 7) / 8; ++c) { const int p = wid + 8 * c; if (p < NVB * 4) {
        const bf16_t* src = S.v + (size_t)(t * 64 + 16 * (p & 3) + (lane >> 2)) * S.vpitch + (p >> 2) * 32 + (lane & 3) * 8;
        glds16(src, (unsigned)__builtin_amdgcn_readfirstlane(lds0 + LDS_V + slot * VS + p * 1024)); } }
}
__device__ __forceinline__ void wait_vm_bar(int n) {
    if (n >= 4) asm volatile("s_waitcnt vmcnt(4) lgkmcnt(0)\n\ts_barrier" ::: "memory");
    else if (n == 3) asm volatile("s_waitcnt vmcnt(3) lgkmcnt(0)\n\ts_barrier" ::: "memory");
    else if (n == 2) asm volatile("s_waitcnt vmcnt(2) lgkmcnt(0)\n\ts_barrier" ::: "memory");
    else if (n == 1) asm volatile("s_waitcnt vmcnt(1) lgkmcnt(0)\n\ts_barrier" ::: "memory");
    else asm volatile("s_waitcnt vmcnt(0) lgkmcnt(0)\n\ts_barrier" ::: "memory");
}
template <int NKC, int NVB, int MODE>
__device__ __forceinline__ void unit(LAS unsigned char* lds, const Src& S, int t_lo, int t_hi, int qpos0  , float sink_l2) {
    constexpr int KS = NKC * 1024, VS = NVB * 4096, RD = 4, LDS_K = 0, LDS_V = RD * KS;
    const int tid = opq_v((int)threadIdx.x), lane = tid & 63, r32 = lane & 31, hi = lane >> 5; const int wid = __builtin_amdgcn_readfirstlane(tid >> 6), grp = wid >> 2;
    const unsigned lds0 = (unsigned)(uintptr_t)lds;
    const int ops = (NKC + 7 - wid) / 8 + (NVB * 4) / 8;
    bf16x8 qr[NKC / 2];
#pragma unroll
    for (int d0 = 0; d0 < NKC / 2; ++d0) qr[d0] = *(const bf16x8*)(S.q + (size_t)r32 * S.qpitch + d0 * 16 + hi * 8);
    float m_run = (MODE == 0) ? sink_l2 : -INFINITY, l_run = (MODE == 0 && hi == 0) ? 1.0f : 0.0f;
    f32x16 o[NVB];
#pragma unroll
    for (int d = 0; d < NVB; ++d) o[d] = f32x16{};
    const int qi = qpos0 + wid * 32 + r32, qw0 = qpos0 + wid * 32;
    f32x16 p0 = f32x16{}, p1 = f32x16{};
#define AT_ACTIVE(t) ((MODE != 0) || ((64 * (t) + 63 >= qw0 - 128) && (64 * (t) <= qw0 + 31 + 128)))
#define AT_QK(t) do { const LAS unsigned char* kb_ = lds + LDS_K + (((t) - t_lo) % RD) * KS + hi * 1024 + r32 * 16; p0 = f32x16{}; p1 = f32x16{}; \
        _Pragma("unroll") for (int d0 = 0; d0 < NKC / 2; ++d0) { const bf16x8 b0_ = *(const LAS bf16x8*)(kb_ + d0 * 2048), b1_ = *(const LAS bf16x8*)(kb_ + d0 * 2048 + 512); \
            p0 = __builtin_amdgcn_mfma_f32_32x32x16_bf16(b0_, qr[d0], p0, 0, 0, 0); p1 = __builtin_amdgcn_mfma_f32_32x32x16_bf16(b1_, qr[d0], p1, 0, 0, 0); } } while (0)
#define AT_SMPV(t) do { \
        if (MODE == 0) { _Pragma("unroll") for (int r = 0; r < 16; ++r) { const int kv_ = 64 * (t) + crow(r, hi); int e0_ = kv_ - qi; e0_ = e0_ < 0 ? -e0_ : e0_; int e1_ = kv_ + 32 - qi; e1_ = e1_ < 0 ? -e1_ : e1_; \
            if (e0_ > 128) p0[r] = -INFINITY; if (e1_ > 128) p1[r] = -INFINITY; } } \
        float mx_[8]; _Pragma("unroll") for (int r = 0; r < 8; ++r) mx_[r] = fmaxf(fmaxf(p0[r], p0[r + 8]), fmaxf(p1[r], p1[r + 8])); \
        float rm_ = fmaxf(fmaxf(fmaxf(mx_[0], mx_[1]), fmaxf(mx_[2], mx_[3])), fmaxf(fmaxf(mx_[4], mx_[5]), fmaxf(mx_[6], mx_[7]))); rm_ = swapmax(rm_); \
        if (__any(rm_ > m_run)) { const float mn_ = fmaxf(m_run, rm_), alpha_ = __builtin_amdgcn_exp2f(m_run - mn_); m_run = mn_; l_run *= alpha_; \
            _Pragma("unroll") for (int d = 0; d < NVB; ++d) _Pragma("unroll") for (int r = 0; r < 16; ++r) o[d][r] *= alpha_; } \
        float sm_[4] = {0.f, 0.f, 0.f, 0.f}; \
        _Pragma("unroll") for (int r = 0; r < 16; ++r) { p0[r] = __builtin_amdgcn_exp2f(p0[r] - m_run); p1[r] = __builtin_amdgcn_exp2f(p1[r] - m_run); sm_[r & 3] += p0[r] + p1[r]; } \
        l_run += (sm_[0] + sm_[1]) + (sm_[2] + sm_[3]); \
        u32x4 pw_[4]; \
        pw_[0] = (u32x4){cvtpk(p0[0], p0[1]), cvtpk(p0[2], p0[3]), cvtpk(p0[4], p0[5]), cvtpk(p0[6], p0[7])}; pw_[1] = (u32x4){cvtpk(p0[8], p0[9]), cvtpk(p0[10], p0[11]), cvtpk(p0[12], p0[13]), cvtpk(p0[14], p0[15])}; \
        pw_[2] = (u32x4){cvtpk(p1[0], p1[1]), cvtpk(p1[2], p1[3]), cvtpk(p1[4], p1[5]), cvtpk(p1[6], p1[7])}; pw_[3] = (u32x4){cvtpk(p1[8], p1[9]), cvtpk(p1[10], p1[11]), cvtpk(p1[12], p1[13]), cvtpk(p1[14], p1[15])}; \
        const unsigned vb_ = lds0 + LDS_V + (((t) - t_lo) % RD) * VS + ((lane >> 4) & 1) * 32 + (lane & 3) * 8 + (4 * hi + ((lane & 15) >> 2)) * 64; \
        _Pragma("unroll") for (int dp = 0; dp < NVB; dp += 2) { s16x4 lo_[2][4], hh_[2][4]; \
            _Pragma("unroll") for (int dd = 0; dd < 2; ++dd) _Pragma("unroll") for (int ks = 0; ks < 4; ++ks) { lo_[dd][ks] = vtr(vb_ + (dp + dd) * 4096 + ks * 1024); hh_[dd][ks] = vtr(vb_ + (dp + dd) * 4096 + ks * 1024 + 512); } \
            asm volatile("s_waitcnt lgkmcnt(0)" ::: "memory"); __builtin_amdgcn_sched_barrier(0); \
            _Pragma("unroll") for (int ks = 0; ks < 4; ++ks) _Pragma("unroll") for (int dd = 0; dd < 2; ++dd) { \
                const bf16x8 vf_ = (bf16x8){lo_[dd][ks][0], lo_[dd][ks][1], lo_[dd][ks][2], lo_[dd][ks][3], hh_[dd][ks][0], hh_[dd][ks][1], hh_[dd][ks][2], hh_[dd][ks][3]}; \
                o[dp + dd] = __builtin_amdgcn_mfma_f32_32x32x16_bf16(vf_, __builtin_bit_cast(bf16x8, pw_[ks]), o[dp + dd], 0, 0, 0); } } } while (0)
    dma_tile<NKC, NVB>(S, t_lo, 0, lds0, wid, lane);
    if (t_lo + 1 < t_hi) dma_tile<NKC, NVB>(S, t_lo + 1, 1, lds0, wid, lane);
    for (int t = t_lo; t < t_hi; ++t) {
        wait_vm_bar((t + 1 < t_hi) ? ops : 0);
        if (t + 2 < t_hi) dma_tile<NKC, NVB>(S, t + 2, (t + 2 - t_lo) % RD, lds0, wid, lane);
        if (grp == 0) { if (AT_ACTIVE(t)) { AT_QK(t); AT_SMPV(t); } }
        else { if (t > t_lo && AT_ACTIVE(t - 1)) AT_SMPV(t - 1); if (AT_ACTIVE(t)) AT_QK(t); }
    }
    if (grp == 1 && AT_ACTIVE(t_hi - 1)) AT_SMPV(t_hi - 1);
    const float linv = 1.0f / swapsum(l_run);
#pragma unroll
    for (int d = 0; d < NVB; ++d) store_o_block(o[d], linv, S.o + (size_t)r32 * S.opitch + 32 * d, hi);
    asm volatile("s_waitcnt lgkmcnt(0)\n\ts_barrier" ::: "memory");
#undef AT_ACTIVE
#undef AT_QK
#undef AT_SMPV
}

template <int NKC, int NVB>
__device__ __forceinline__ void unit_q64(LAS unsigned char* lds, const Src& S, int t_lo, int t_hi) {
    constexpr int KS = NKC * 1024, VS = NVB * 4096, RD = 4, LDS_K = 0, LDS_V = RD * KS;
    const int tid = opq_v((int)threadIdx.x), lane = tid & 63, r32 = lane & 31, hi = lane >> 5; const int wid = __builtin_amdgcn_readfirstlane(tid >> 6);
    const unsigned lds0 = (unsigned)(uintptr_t)lds;
    const int ops = (NKC + 7 - wid) / 8 + (NVB * 4) / 8;
    bf16x8 qa[NKC / 2], qb[NKC / 2];
#pragma unroll
    for (int d0 = 0; d0 < NKC / 2; ++d0) { qa[d0] = *(const bf16x8*)(S.q + (size_t)r32 * S.qpitch + d0 * 16 + hi * 8); qb[d0] = *(const bf16x8*)(S.q + (size_t)(32 + r32) * S.qpitch + d0 * 16 + hi * 8); }
    float ma = -INFINITY, la = 0.f, mb = -INFINITY, lb = 0.f;
    f32x16 oa[NVB], ob[NVB];
#pragma unroll
    for (int d = 0; d < NVB; ++d) { oa[d] = f32x16{}; ob[d] = f32x16{}; }
#define Q64_SM(P0, P1, M, L, O, PW) do { \
        float mx_[8]; _Pragma("unroll") for (int r = 0; r < 8; ++r) mx_[r] = fmaxf(fmaxf(P0[r], P0[r + 8]), fmaxf(P1[r], P1[r + 8])); \
        float rm_ = fmaxf(fmaxf(fmaxf(mx_[0], mx_[1]), fmaxf(mx_[2], mx_[3])), fmaxf(fmaxf(mx_[4], mx_[5]), fmaxf(mx_[6], mx_[7]))); rm_ = swapmax(rm_); \
        if (__any(rm_ > M)) { const float mn_ = fmaxf(M, rm_), alpha_ = __builtin_amdgcn_exp2f(M - mn_); M = mn_; L *= alpha_; \
            _Pragma("unroll") for (int d = 0; d < NVB; ++d) _Pragma("unroll") for (int r = 0; r < 16; ++r) O[d][r] *= alpha_; } \
        float sm_[4] = {0.f, 0.f, 0.f, 0.f}; \
        _Pragma("unroll") for (int r = 0; r < 16; ++r) { P0[r] = __builtin_amdgcn_exp2f(P0[r] - M); P1[r] = __builtin_amdgcn_exp2f(P1[r] - M); sm_[r & 3] += P0[r] + P1[r]; } \
        L += (sm_[0] + sm_[1]) + (sm_[2] + sm_[3]); \
        PW[0] = (u32x4){cvtpk(P0[0], P0[1]), cvtpk(P0[2], P0[3]), cvtpk(P0[4], P0[5]), cvtpk(P0[6], P0[7])}; PW[1] = (u32x4){cvtpk(P0[8], P0[9]), cvtpk(P0[10], P0[11]), cvtpk(P0[12], P0[13]), cvtpk(P0[14], P0[15])}; \
        PW[2] = (u32x4){cvtpk(P1[0], P1[1]), cvtpk(P1[2], P1[3]), cvtpk(P1[4], P1[5]), cvtpk(P1[6], P1[7])}; PW[3] = (u32x4){cvtpk(P1[8], P1[9]), cvtpk(P1[10], P1[11]), cvtpk(P1[12], P1[13]), cvtpk(P1[14], P1[15])}; \
        __builtin_amdgcn_sched_barrier(0); } while (0)
#define Q64_SM_NB(P0, P1, M, L, O, PW) do { \
        float mx_[8]; _Pragma("unroll") for (int r = 0; r < 8; ++r) mx_[r] = fmaxf(fmaxf(P0[r], P0[r + 8]), fmaxf(P1[r], P1[r + 8])); \
        float rm_ = fmaxf(fmaxf(fmaxf(mx_[0], mx_[1]), fmaxf(mx_[2], mx_[3])), fmaxf(fmaxf(mx_[4], mx_[5]), fmaxf(mx_[6], mx_[7]))); rm_ = swapmax(rm_); \
        if (__any(rm_ > M)) { const float mn_ = fmaxf(M, rm_), alpha_ = __builtin_amdgcn_exp2f(M - mn_); M = mn_; L *= alpha_; \
            _Pragma("unroll") for (int d = 0; d < NVB; ++d) _Pragma("unroll") for (int r = 0; r < 16; ++r) O[d][r] *= alpha_; } \
        float sm_[4] = {0.f, 0.f, 0.f, 0.f}; \
        _Pragma("unroll") for (int r = 0; r < 16; ++r) { P0[r] = __builtin_amdgcn_exp2f(P0[r] - M); P1[r] = __builtin_amdgcn_exp2f(P1[r] - M); sm_[r & 3] += P0[r] + P1[r]; } \
        L += (sm_[0] + sm_[1]) + (sm_[2] + sm_[3]); \
        PW[0] = (u32x4){cvtpk(P0[0], P0[1]), cvtpk(P0[2], P0[3]), cvtpk(P0[4], P0[5]), cvtpk(P0[6], P0[7])}; PW[1] = (u32x4){cvtpk(P0[8], P0[9]), cvtpk(P0[10], P0[11]), cvtpk(P0[12], P0[13]), cvtpk(P0[14], P0[15])}; \
        PW[2] = (u32x4){cvtpk(P1[0], P1[1]), cvtpk(P1[2], P1[3]), cvtpk(P1[4], P1[5]), cvtpk(P1[6], P1[7])}; PW[3] = (u32x4){cvtpk(P1[8], P1[9]), cvtpk(P1[10], P1[11]), cvtpk(P1[12], P1[13]), cvtpk(P1[14], P1[15])}; \
        } while (0)
    dma_tile<NKC, NVB, RD>(S, t_lo, 0, lds0, wid, lane);
    if (t_lo + 1 < t_hi) dma_tile<NKC, NVB, RD>(S, t_lo + 1, 1, lds0, wid, lane);
    for (int t = t_lo; t < t_hi; ++t) {
        const int slot = (t - t_lo) % RD;
        wait_vm_bar((t + 1 < t_hi) ? ops : 0);
        if (t + 2 < t_hi) dma_tile<NKC, NVB, RD>(S, t + 2, (t + 2 - t_lo) % RD, lds0, wid, lane);
        const LAS unsigned char* kb = lds + LDS_K + slot * KS + hi * 1024 + r32 * 16;
        f32x16 s0a = f32x16{}, s0b = f32x16{}, s1a = f32x16{}, s1b = f32x16{};
#pragma unroll
        for (int d0 = 0; d0 < NKC / 2; ++d0) {
            const bf16x8 b0 = *(const LAS bf16x8*)(kb + d0 * 2048), b1 = *(const LAS bf16x8*)(kb + d0 * 2048 + 512);
            s0a = __builtin_amdgcn_mfma_f32_32x32x16_bf16(b0, qa[d0], s0a, 0, 0, 0); s0b = __builtin_amdgcn_mfma_f32_32x32x16_bf16(b1, qa[d0], s0b, 0, 0, 0);
            s1a = __builtin_amdgcn_mfma_f32_32x32x16_bf16(b0, qb[d0], s1a, 0, 0, 0); s1b = __builtin_amdgcn_mfma_f32_32x32x16_bf16(b1, qb[d0], s1b, 0, 0, 0); }
        __builtin_amdgcn_sched_barrier(0);
        u32x4 pwa[4], pwb[4];
        const unsigned vb = lds0 + LDS_V + slot * VS + ((lane >> 4) & 1) * 32 + (lane & 3) * 8 + (4 * hi + ((lane & 15) >> 2)) * 64;
        s16x4 lo[NVB][4], hh[NVB][4];
#pragma unroll
        for (int d = 0; d < NVB; ++d)
#pragma unroll
            for (int ks = 0; ks < 4; ++ks) { VTRO(lo[d][ks], vb, d * 4096 + ks * 1024); VTRO(hh[d][ks], vb, d * 4096 + ks * 1024 + 512); }
        __builtin_amdgcn_sched_barrier(0);
        Q64_SM(s0a, s0b, ma, la, oa, pwa);
        asm volatile("s_waitcnt lgkmcnt(0)" ::: "memory"); __builtin_amdgcn_sched_barrier(0);
#pragma unroll
        for (int ks = 0; ks < 4; ++ks)
#pragma unroll
            for (int d = 0; d < NVB; ++d) { const bf16x8 vf = (bf16x8){lo[d][ks][0], lo[d][ks][1], lo[d][ks][2], lo[d][ks][3], hh[d][ks][0], hh[d][ks][1], hh[d][ks][2], hh[d][ks][3]};
                oa[d] = __builtin_amdgcn_mfma_f32_32x32x16_bf16(vf, __builtin_bit_cast(bf16x8, pwa[ks]), oa[d], 0, 0, 0); }
        Q64_SM_NB(s1a, s1b, mb, lb, ob, pwb);
#pragma unroll
        for (int i = 0; i < 8; ++i) { __builtin_amdgcn_sched_group_barrier(0x008, 1, 0); __builtin_amdgcn_sched_group_barrier(0x002, 12, 0); }
        __builtin_amdgcn_sched_barrier(0);
#pragma unroll
        for (int ks = 0; ks < 4; ++ks)
#pragma unroll
            for (int d = 0; d < NVB; ++d) { const bf16x8 vf = (bf16x8){lo[d][ks][0], lo[d][ks][1], lo[d][ks][2], lo[d][ks][3], hh[d][ks][0], hh[d][ks][1], hh[d][ks][2], hh[d][ks][3]};
                ob[d] = __builtin_amdgcn_mfma_f32_32x32x16_bf16(vf, __builtin_bit_cast(bf16x8, pwb[ks]), ob[d], 0, 0, 0); }
        __builtin_amdgcn_sched_barrier(0);
    }
    const float lia = 1.0f / swapsum(la), lib = 1.0f / swapsum(lb);
#pragma unroll
    for (int d = 0; d < NVB; ++d) { store_o_block(oa[d], lia, S.o + (size_t)r32 * S.opitch + 32 * d, hi); store_o_block(ob[d], lib, S.o + (size_t)(32 + r32) * S.opitch + 32 * d, hi); }
    asm volatile("s_waitcnt lgkmcnt(0)\n\ts_barrier" ::: "memory");
#undef Q64_SM
#undef Q64_SM_NB
}

}
#define SC_AFTER_PROLOGUE() do {} while (0)
#define SC_AFTER_INPROJ(l) do {} while (0)
#define SC_AFTER_UP(l) do {} while (0)
#define SC_AFTER_MLA(l) do {} while (0)
#define SC_AFTER_BRANCH(l) do {} while (0)
#define SC_AFTER_WOUT(l) do {} while (0)
#define SC_AFTER_NORM2(l) do {} while (0)
#define SC_AFTER_GU(l) do {} while (0)
#define SC_AFTER_DOWN(l) do {} while (0)
#define SC_AFTER_ROUTE(l) do {} while (0)
#define SC_AFTER_MOEGU(l, h) do {} while (0)
#define SC_AFTER_MOED(l, h) do {} while (0)
#define SC_FINAL() do {} while (0)

struct Args { const float* in[23]; float* out; unsigned char* ws; };
#define WSP(type, off) ((type*)(F.ws + (off)))
#define PHASE() Frame Fp = F; Fp.ws = opq_p(F.ws); Fp.in = opq_p(F.in); Fp.out = opq_p(F.out); Fp.tid = opq_v((int)threadIdx.x); Fp.lane = Fp.tid & 63; Fp.wave = __builtin_amdgcn_readfirstlane(Fp.tid >> 6); (void)Fp
#define FWS(type, off) ((type*)(Fp.ws + (off)))
#define X_ FWS(bf16_t, WS_XB)
#define H_ FWS(bf16_t, WS_H)
#define Pb_ FWS(bf16_t, WS_R + R_P)
#define Gb_ FWS(bf16_t, WS_R + R_G)
#define QB_ FWS(bf16_t, WS_R + R_QB)
#define KVB_ FWS(bf16_t, WS_R + R_KVB)
#define Yb_ FWS(bf16_t, WS_R + R_Y)
#define MEMN_ FWS(bf16_t, WS_MEMN)
#define MEMKV_ FWS(bf16_t, WS_MEMKV)
#define ACT_ FWS(bf16_t, WS_R + R_ACT)
#define ASORT_ FWS(bf16_t, WS_R + R_ASORT)
#define YOUT_ FWS(bf16_t, WS_R + R_YOUT)
#define SSQ_ FWS(float, WS_MISC + MS_SSQ)
#define TEXP_ FWS(const int, WS_MISC + MS_TEXP)
#define POS_ ((const int*)Fp.in[I_POS])
#define HSC_ FWS(float, WS_MISC + MS_HSC)
#define ASC_ FWS(float, WS_MISC + MS_ASC)
#define WSIN_ FWS(float, WS_MISC + MS_WSIN)
#define WSGU_ FWS(float, WS_MISC + MS_WSGU)

#define GRID_BAR() xcd_barrier(bar)
#ifndef WGM_GU
#define WGM_GU 4
#endif
#ifndef WGM_IN
#define WGM_IN 4
#endif
template <int l> __device__ __forceinline__ void layer_body(const Frame& F, const XcdBarrier& bar, const int bx) {
        if (l > 0) {
            PHASE();
            prep_ffn_weights(Fp, l);
            if ((l & 1) != 0) norm_phase(Fp, nullptr, X_, Fp.in[I_GMIX] + l * DM, false, true);
            if ((l & 1) == 0) norm_phase(Fp, nullptr, X_, Fp.in[I_GMIX] + l * DM, true, true);
            GRID_BAR();
        }
        {   PHASE();
            ProbSimple p{DM, DM, DM, (const char*)H_, (const char*)wmix(Fp, l, WL_IN)}; pg8::StaticOrder S; S.init(T / 256, NT_IN, Fp.G, bx, 0, WGM_IN);
            EpiInproj E{Pb_, Gb_, SSQ_, POS_, HSC_, WSIN_ + l * NT_IN * 256}; pg8::gemm_phase<true>(Fp.lds, p, S, E); }
        if (l == 0) { PHASE();
            ProbSimple p{DM, DM * 2, DM * 2, (const char*)MEMN_, (const char*)FWS(bf16_t, WS_WMKV)}; pg8::StaticOrder S; S.init(NB * MEML / 256, 16, Fp.G, bx);
            EpiPlain E{MEMKV_, 4096}; pg8::gemm_phase(Fp.lds, p, S, E); }
        GRID_BAR();
        SC_AFTER_INPROJ(l);
        {   PHASE();
            ProbUp p{UPK, PW * 2, UPK * 2, (const char*)(Pb_ + P_CQ), (const char*)wmix(Fp, l, WL_UP)}; pg8::StaticOrder S; S.init(T / 256, UPN / 256, Fp.G, bx);
            EpiUp E{QB_, KVB_, SSQ_, POS_}; pg8::gemm_phase(Fp.lds, p, S, E); }
        {   PHASE();
            for (int i = Fp.vcu; i < 1024; i += Fp.G) {
                const int hl = i & 3, qb = (i >> 2) & 15, kvh = (i >> 6) & 1, b = i >> 7, h = kvh * 4 + hl; const size_t rowb = (size_t)b * SEQ; const int q0 = qb * 256;
                att::Src s; s.q = Pb_ + (rowb + q0 + Fp.wave * 32) * PW + P_QA + h * 64; s.qpitch = PW; s.k0 = Pb_ + rowb * PW + P_KA + kvh * 64; s.k0pitch = PW; s.k1 = s.k0; s.k1pitch = PW;
                s.v = Pb_ + rowb * PW + P_VA + kvh * 64; s.vpitch = PW; s.o = Yb_ + (rowb + q0 + Fp.wave * 32) * YW + h * 64; s.opitch = YW;
                const int t_lo = (q0 / 64 - 2) < 0 ? 0 : (q0 / 64 - 2), t_hi = (q0 / 64 + 6) > SEQ / 64 ? SEQ / 64 : (q0 / 64 + 6);
                att::unit<8, 2, 0>(Fp.lds, s, t_lo, t_hi, q0, Fp.in[I_SINK][l * 8 + h] * LOG2E);
            } }
        {   PHASE();
            for (int i = Fp.vcu; i < 512; i += Fp.G) {
                const int qb = i & 15, h = (i >> 4) & 3, b = i >> 6; const size_t rowq = (size_t)b * SEQ + qb * 256 + Fp.wave * 32;
                att::Src s; s.q = Pb_ + rowq * PW + P_QM + h * 128; s.qpitch = PW; s.k0 = MEMKV_ + (size_t)b * MEML * 4096 + l * 1024 + h * 128; s.k0pitch = 4096; s.k1 = s.k0 + 64; s.k1pitch = 4096;
                s.v = MEMKV_ + (size_t)b * MEML * 4096 + l * 1024 + 512 + h * 128; s.vpitch = 4096; s.o = Yb_ + rowq * YW + 1024 + h * 128; s.opitch = YW;
                att::unit<16, 4, 1>(Fp.lds, s, 0, MEML / 64, 0, 0.f);
            } }
        GRID_BAR();
        SC_AFTER_UP(l);
        {   PHASE();
            for (int i = Fp.vcu; i < 512; i += Fp.G) {
                const int qb = i & 7, h = (i >> 3) & 7, b = i >> 6; const size_t rowb = (size_t)b * SEQ, rowq = rowb + qb * 512 + Fp.wave * 64;
                att::Src s; s.q = QB_ + rowq * QBW + h * 96; s.qpitch = QBW; s.k0 = KVB_ + rowb * KVW + h * 128; s.k0pitch = KVW; s.k1 = Pb_ + rowb * PW + P_KR; s.k1pitch = PW;
                s.v = KVB_ + rowb * KVW + h * 128 + 64; s.vpitch = KVW; s.o = Yb_ + rowq * YW + 512 + h * 64; s.opitch = YW;
                att::unit_q64<12, 2>(Fp.lds, s, 0, SEQ / 64);
            } }
        GRID_BAR();
        SC_AFTER_MLA(l);
        {   PHASE();
            ProbSimple p{1536, YW * 2, 1536 * 2, (const char*)Yb_, (const char*)wmix(Fp, l, WL_BR)}; pg8::StaticOrder S; S.init(T / 256, DM / 256, Fp.G, bx);
            EpiBranch E{(const unsigned char*)Gb_, H_}; pg8::gemm_phase(Fp.lds, p, S, E); }
        GRID_BAR();
        SC_AFTER_BRANCH(l);
        if (l == 0) {   PHASE();
            ProbSimple p{DM, DM * 2, DM * 2, (const char*)H_, (const char*)wmix(Fp, l, WL_OUT)}; pg8::StaticOrder S; S.init(T / 256, DM / 256, Fp.G, bx);
            EpiResid E{Fp.in[I_X], X_}; pg8::gemm_phase(Fp.lds, p, S, E); }
        if (l != 0) {   PHASE();
            ProbSimple p{DM, DM * 2, DM * 2, (const char*)H_, (const char*)wmix(Fp, l, WL_OUT)}; pg8::StaticOrder S; S.init(T / 256, DM / 256, Fp.G, bx);
            EpiResid E{nullptr, X_}; pg8::gemm_phase(Fp.lds, p, S, E); }
        GRID_BAR();
        SC_AFTER_WOUT(l);
        if ((l & 1) == 0) {
            {   PHASE(); norm_phase(Fp, nullptr, X_, Fp.in[I_GFFN] + l * DM, false, GU_I8(l) != 0); }
            GRID_BAR();
            SC_AFTER_NORM2(l);
            {   PHASE();
                constexpr bool i8 = GU_I8(l) != 0; constexpr unsigned eb = i8 ? 1 : 2;
                ProbSimple p{DM, DM * eb, DM * eb, (const char*)H_, (const char*)FWS(bf16_t, WS_WFFN + WF_GU)}; pg8::StaticOrder S; S.init(T / 256, 2 * DFF / 256, Fp.G, bx, 0, WGM_GU);
                EpiSwiglu E{ACT_, 0, HSC_, WSGU_}; pg8::gemm_phase<i8>(Fp.lds, p, S, E); }
            GRID_BAR();
            SC_AFTER_GU(l);
            {   PHASE();
                ProbSimple p{DFF, DFF * 2, DFF * 2, (const char*)ACT_, (const char*)FWS(bf16_t, WS_WFFN + WF_D)}; pg8::StaticOrder S; S.init(T / 256, DM / 256, Fp.G, bx, 1);
                EpiResid E{nullptr, X_}; pg8::gemm_phase(Fp.lds, p, S, E); }
            GRID_BAR();
            SC_AFTER_DOWN(l);
        } else {
            {   PHASE(); norm_router_phase(Fp, X_, Fp.in[I_GFFN] + l * DM, Fp.in[I_WR] + (size_t)(l >> 1) * DM * NE, GU_I8(l) != 0); }
            GRID_BAR();
            {   PHASE(); moe_assign_phase(Fp, GU_I8(l) != 0); }
            GRID_BAR();
            SC_AFTER_ROUTE(l);
            {   constexpr int half = 0; (void)half;
                {   PHASE();
                    const int nrt = __builtin_amdgcn_readfirstlane(TEXP_[MAXRT]);
                    constexpr bool i8 = GU_I8(l) != 0; constexpr unsigned eb = i8 ? 1 : 2;
                    ProbMoe p{DM, DM * eb, DM * eb, (const char*)ASORT_, (const char*)FWS(bf16_t, WS_WFFN + WF_GU), 0}; MoeOrder S; S.base.init(nrt, 2 * DFF / 256, Fp.G, bx, 0, WGM_GU); S.lo = 0; S.texp = TEXP_;
                    EpiSwiglu E{ACT_, 0, ASC_, WSGU_}; pg8::gemm_phase<i8>(Fp.lds, p, S, E); }
                GRID_BAR();
                SC_AFTER_MOEGU(l, half);
                {   PHASE();
                    const int nrt = __builtin_amdgcn_readfirstlane(TEXP_[MAXRT]);
                    ProbMoe p{DFF, DFF * 2, DFF * 2, (const char*)ACT_, (const char*)FWS(bf16_t, WS_WFFN + WF_D), 0}; MoeOrder S; S.base.init(nrt, DM / 256, Fp.G, bx, 1); S.lo = 0; S.texp = TEXP_;
                    EpiYout E{YOUT_}; pg8::gemm_phase(Fp.lds, p, S, E); }
                GRID_BAR();
                SC_AFTER_MOED(l, half);
            }
        }
    }

__global__ void __launch_bounds__(NWAVES * 64, 2) fwd(Args args) {
    extern __shared__ __attribute__((aligned(16))) unsigned char lds_raw[];
    Frame F;
    F.lds = (LAS unsigned char*)lds_raw;
    F.MISC = (volatile LAS unsigned*)(F.lds + LDSCTL_OFF);
    F.tid = threadIdx.x; F.lane = F.tid & 63; F.wave = __builtin_amdgcn_readfirstlane(F.tid >> 6);
    F.G = gridDim.x; { const int bx = blockIdx.x; F.vcu = (F.G % 8 == 0) ? (bx % 8) * (F.G / 8) + bx / 8 : bx; }
    F.ws = args.ws; F.ctl = (gu32*)(args.ws + WS_CTL); F.out = args.out;
    F.in = (const float* const*)__builtin_amdgcn_kernarg_segment_ptr();
    for (int u = F.tid; u < (LDS_BYTES - LDSCTL_OFF) / 4; u += NWAVES * 64) ((LAS unsigned*)(F.lds + LDSCTL_OFF))[u] = 0u;
    __syncthreads();
    XcdBarrier bar = xcd_barrier_post((unsigned*)(F.ctl + CW_BAR), F.MISC + 8);

    const int bx = (int)blockIdx.x;

    {   PHASE();
        prep_mixer_weights(Fp);
        memnorm_phase(Fp);
        prep_ffn_weights(Fp, 0);
        norm_phase(Fp, Fp.in[I_X], nullptr, Fp.in[I_GMIX], false, true); }
    GRID_BAR();
    SC_AFTER_PROLOGUE();

    layer_body<0>(F, bar, bx); layer_body<1>(F, bar, bx); layer_body<2>(F, bar, bx); layer_body<3>(F, bar, bx);
    {   PHASE(); final_norm_phase(Fp, X_, Fp.out, Fp.in[I_GFIN], true); }
    SC_FINAL();
}

extern "C" void kernel_launch(void* const* d_in, const int* in_sizes, int n_in, void* d_out, int out_size, void* d_ws, size_t ws_size, hipStream_t stream) {
    static int grid = 0;
    if (grid == 0) {
        if (n_in != 23 || out_size != T * DM || ws_size < WS_END) { fprintf(stderr, "kernel_launch: unexpected problem (n_in %d, out %d, ws %zu < %zu)\n", n_in, out_size, ws_size, (size_t)WS_END); grid = -1; return; }
        int dev = 0, cus = 0;
        if (hipGetDevice(&dev) != hipSuccess || hipDeviceGetAttribute(&cus, hipDeviceAttributeMultiprocessorCount, dev) != hipSuccess) { grid = -1; return; }
        if (hipFuncSetAttribute((const void*)fwd, hipFuncAttributeMaxDynamicSharedMemorySize, LDS_BYTES) != hipSuccess) { fprintf(stderr, "kernel_launch: hipFuncSetAttribute failed\n"); grid = -1; return; }
        int per_cu = 0;
        if (hipOccupancyMaxActiveBlocksPerMultiprocessor(&per_cu, (const void*)fwd, NWAVES * 64, LDS_BYTES) != hipSuccess || per_cu < 1) fprintf(stderr, "kernel_launch: occupancy query says %d\n", per_cu);
        (void)hipGetLastError();
        grid = cus;
    }
    if (grid < 0) return;
    if (hipMemsetAsync((char*)d_ws + WS_CTL, 0, CTL_ZERO_BYTES, stream) != hipSuccess) return;
    Args a{};
    for (int i = 0; i < 23; ++i) a.in[i] = (const float*)d_in[i];
    a.out = (float*)d_out; a.ws = (unsigned char*)d_ws;
    hipLaunchKernelGGL(fwd, dim3(grid), dim3(NWAVES * 64), LDS_BYTES, stream, a);
}
```

```cpp
#include <hip/hip_runtime.h>
#include <cstdio>
#include <cstdint>

#ifndef SELFCHECK
#define SELFCHECK 0
#endif
#ifndef GU_I8_MASK
#define GU_I8_MASK 0xF
#endif
#define GU_I8(l) ((((unsigned)GU_I8_MASK) >> (l)) & 1u)

#define GAS __attribute__((address_space(1)))
#define LAS __attribute__((address_space(3)))
typedef unsigned short bf16_t;
typedef short bf16x8 __attribute__((ext_vector_type(8)));
typedef short s16x4 __attribute__((ext_vector_type(4)));
typedef short v4i16_t __attribute__((ext_vector_type(4)));
typedef float f32x2 __attribute__((ext_vector_type(2)));
typedef float f32x4 __attribute__((ext_vector_type(4)));
typedef float f32x16 __attribute__((ext_vector_type(16)));
typedef unsigned u32x2 __attribute__((ext_vector_type(2)));
typedef unsigned u32x4 __attribute__((ext_vector_type(4)));
typedef int i32x4 __attribute__((ext_vector_type(4)));
typedef GAS unsigned gu32;
#define RLX_AGENT __ATOMIC_RELAXED, __HIP_MEMORY_SCOPE_AGENT

constexpr int NB = 8, SEQ = 4096, T = NB * SEQ, DM = 1024, DEPTH = 4, MEML = 256, DFF = 3584, NE = 8;
constexpr int INW = 4768;
constexpr int PW = 1792;
constexpr int GW = 3072;
constexpr int QBW = 768, KVW = 1024, YW = 1536;
constexpr int NT_IN = 19;
constexpr int P_QA = 0, P_KA = 512, P_VA = 640, P_CQ = 768, P_CKV = 1024, P_KR = 1152, P_QM = 1280;
constexpr int UPK = 256, UPN = 1792;
constexpr int MAXSLOT = 67584;
constexpr int MAXRT = MAXSLOT / 256;
constexpr float EPS = 1e-6f;
constexpr float LOG2E = 1.4426950408889634f;
constexpr float C_A = 0.125f * LOG2E;
constexpr float C_B = 0.10206207261596575f * LOG2E;
constexpr float C_M = 0.08838834764831845f * LOG2E;

constexpr size_t MiB = 1u << 20;
constexpr size_t WS_CTL = 0, CTL_ZERO_BYTES = 1 * MiB;
constexpr size_t WS_MISC = 1 * MiB;
constexpr size_t WL_IN = 0, WL_UP = (size_t)NT_IN * 256 * DM * 2, WL_BR = WL_UP + (size_t)UPN * UPK * 2, WL_OUT = WL_BR + (size_t)3 * DM * 512 * 2, WL_SIZE = WL_OUT + (size_t)DM * DM * 2;
constexpr size_t WS_WMIX = 8 * MiB;
constexpr size_t WS_WMKV = WS_WMIX + 4 * ((WL_SIZE + MiB - 1) / MiB) * MiB;
constexpr size_t WL_STRIDE = ((WL_SIZE + MiB - 1) / MiB) * MiB;
constexpr size_t WS_WFFN = WS_WMKV + 8 * MiB;
constexpr size_t WF_GU = 0, WF_D = (size_t)2 * DFF * DM * 2, WF_STRIDE = WF_D + (size_t)DM * DFF * 2;
constexpr size_t WS_H = WS_WFFN + 8 * WF_STRIDE;
constexpr size_t WS_MEMN = WS_H + (size_t)T * DM * 2;
constexpr size_t WS_MEMKV = WS_MEMN + (size_t)NB * MEML * DM * 2;
constexpr size_t WS_R = WS_MEMKV + (size_t)NB * MEML * 4096 * 2;
constexpr size_t R_P = 0, R_G = R_P + (size_t)T * PW * 2, R_QB = R_G + (size_t)T * GW * 2, R_KVB = R_QB + (size_t)T * QBW * 2, R_Y = R_KVB + (size_t)T * KVW * 2, R_END_MIX = R_Y + (size_t)T * YW * 2;
constexpr size_t R_ACT = 0;
constexpr size_t R_ASORT = (size_t)MAXSLOT * DFF * 2;
constexpr size_t R_YOUT = R_ASORT;
constexpr size_t R_END_FFN = R_YOUT + (size_t)MAXSLOT * DM * 2;
constexpr size_t R_SIZE = R_END_MIX > R_END_FFN ? R_END_MIX : R_END_FFN;
constexpr size_t WS_XB = WS_R + R_SIZE;
constexpr size_t WS_END = WS_XB + (size_t)T * DM * 2;
static_assert(WS_END < 1020ull * MiB, "workspace budget");
constexpr size_t MS_TOKE = 0;
constexpr size_t MS_TOKW = MS_TOKE + (size_t)T * 8;
constexpr size_t MS_SLOT = MS_TOKW + (size_t)T * 8;
constexpr size_t MS_CNT = MS_SLOT + (size_t)T * 8;
constexpr size_t MS_TEXP = MS_CNT + 256 * 8 * 4;
constexpr size_t MS_SSQ = MS_TEXP + 2048;
constexpr size_t MS_SNAP = MS_SSQ + (size_t)T * 32;
constexpr size_t MS_HSC = MS_SNAP + 64 * 1024 * 4;
constexpr size_t MS_ASC = MS_HSC + (size_t)T * 4;
constexpr size_t MS_WSIN = MS_ASC + (size_t)MAXSLOT * 4;
constexpr size_t MS_WSGU = MS_WSIN + (size_t)4 * NT_IN * 256 * 4;
constexpr size_t MS_END = MS_WSGU + (size_t)8 * 2 * DFF * 4;
static_assert(MS_END <= 7 * MiB, "misc map");
constexpr int CW_BAR = 4096;
constexpr int CW_DIAG = 16384;
constexpr int CW_CODE = 16384 + 512;

constexpr int RING_BYTES = 131072;
constexpr int LDSCTL_OFF = RING_BYTES;
constexpr int LDS_BYTES = 147456;
constexpr int NWAVES = 8;

#define LDS_WAIT() asm volatile("s_waitcnt lgkmcnt(0)" ::: "memory")
#define VM_WAIT() asm volatile("s_waitcnt vmcnt(0)" ::: "memory")

__device__ __forceinline__ unsigned f2bf(float f) { unsigned u = __builtin_bit_cast(unsigned, f); return (u + 0x7fffu + ((u >> 16) & 1u)) >> 16; }
__device__ __forceinline__ unsigned pk2(float lo, float hi) { return f2bf(lo) | (f2bf(hi) << 16); }
__device__ __forceinline__ float bf2f(unsigned short b) { return __builtin_bit_cast(float, (unsigned)b << 16); }
__device__ __forceinline__ float bflo(unsigned w) { return __builtin_bit_cast(float, w << 16); }
__device__ __forceinline__ float bfhi(unsigned w) { return __builtin_bit_cast(float, w & 0xffff0000u); }
typedef __bf16 bf16x2_t __attribute__((ext_vector_type(2)));
__device__ __forceinline__ unsigned cvtpk(float lo, float hi) { f32x2 v = {lo, hi}; bf16x2_t b = __builtin_convertvector(v, bf16x2_t); return __builtin_bit_cast(unsigned, b); }
__device__ __forceinline__ float wave_sum(float v) {
#pragma unroll
    for (int o = 1; o < 64; o <<= 1) v += __shfl_xor(v, o);
    return v;
}
__device__ __forceinline__ float fast_sigmoid(float x) { return __builtin_amdgcn_rcpf(1.0f + __builtin_amdgcn_exp2f(-x * LOG2E)); }


__device__ __forceinline__ int opq_v(int x) { asm volatile("" : "+v"(x)); return x; }
__device__ __forceinline__ int opq_s(int x) { asm volatile("" : "+s"(x)); return x; }
template <class Tp> __device__ __forceinline__ Tp* opq_p(Tp* p) { const unsigned long long u = (unsigned long long)p; unsigned lo = __builtin_amdgcn_readfirstlane((unsigned)u), hi = __builtin_amdgcn_readfirstlane((unsigned)(u >> 32)); asm volatile("" : "+s"(lo), "+s"(hi)); return (Tp*)(((unsigned long long)hi << 32) | lo); }

__constant__ float IFR_HI[32] = {1.591549367e-01f, 1.193493679e-01f, 8.949939907e-02f, 6.711508334e-02f, 5.032921210e-02f, 3.774158657e-02f, 2.830219641e-02f, 2.122365311e-02f, 1.591549441e-02f, 1.193493698e-02f, 8.949940093e-03f, 6.711508147e-03f, 5.032921210e-03f, 3.774158424e-03f, 2.830219688e-03f, 2.122365171e-03f, 1.591549488e-03f, 1.193493721e-03f, 8.949940093e-04f, 6.711508031e-04f, 5.032921326e-04f, 3.774158540e-04f, 2.830219455e-04f, 2.122365258e-04f, 1.591549371e-04f, 1.193493736e-04f, 8.949940093e-05f, 6.711508468e-05f, 5.032921035e-05f, 3.774158540e-05f, 2.830219637e-05f, 2.122365186e-05f};
__constant__ float IFR_LO[32] = {6.420638243e-09f, 2.294664903e-09f, 2.542919653e-09f, -3.316028840e-10f, 5.173299289e-12f, -1.848551645e-09f, -5.826552019e-10f, -3.431038786e-10f, -1.029942243e-10f, 4.320196978e-11f, 6.802745173e-11f, 1.531042237e-10f, 5.173301024e-13f, 4.797548470e-11f, -1.048316434e-10f, 1.053879969e-10f, -5.686555046e-11f, -1.896286773e-11f, 6.802744999e-12f, 2.695195456e-11f, -1.158979943e-11f, -6.843983713e-12f, 1.279990003e-11f, 1.807650600e-12f, 5.954976963e-12f, -3.351478166e-12f, 6.802745216e-13f, -1.670379113e-12f, 1.751403167e-12f, -6.843983930e-13f, -5.389994549e-13f, 9.083608431e-13f};
__device__ __forceinline__ void rot_cs(float posf, int idx, float& c, float& s) {
    const float ch = IFR_HI[idx], cl = IFR_LO[idx];
    const float p = posf * ch, e = __builtin_fmaf(posf, ch, -p);
    const float fr = __builtin_amdgcn_fractf(p) + (e + posf * cl);
    s = __builtin_amdgcn_sinf(fr); c = __builtin_amdgcn_cosf(fr);
}

#define XB_TMO      128
#define XB_XCNT(j)  (256  + 64 * (j))
#define XB_XSUB(j)  (1280 + 64 * (j))
#define XB_XGEN(j)  (2304 + 64 * (j))
#define XB_TOP      3328
#define XB_TOPGEN   3392
#define XCD_BAR_WORDS 3456
#define XB_SPIN_CAP (1u << 20)

__device__ __forceinline__ unsigned xb_ld(unsigned* p)              { return __hip_atomic_load(p, __ATOMIC_RELAXED, __HIP_MEMORY_SCOPE_AGENT); }
__device__ __forceinline__ unsigned xb_add(unsigned* p, unsigned v) { return __hip_atomic_fetch_add(p, v, __ATOMIC_RELAXED, __HIP_MEMORY_SCOPE_AGENT); }
__device__ __forceinline__ unsigned xb_xcc_id() { return (unsigned)__builtin_amdgcn_s_getreg((3 << 11) | 20) & 0xFu; }
#define XB_SPIN(cond, bar) do { unsigned _sp = 0; while (cond) { __builtin_amdgcn_s_sleep(1); \
    if ((++_sp & 255u) == 0u) { if (xb_ld(&(bar)[XB_TMO])) break; if (_sp > XB_SPIN_CAP) { atomicAdd(&(bar)[XB_TMO], 1u); break; } } } } while (0)

struct XcdBarrier { unsigned* bar; unsigned x; volatile LAS unsigned* st; };

__device__ __forceinline__ XcdBarrier xcd_barrier_post(unsigned* bar, volatile LAS unsigned* st) {
    XcdBarrier b; b.bar = bar; b.x = xb_xcc_id(); b.st = st;
    if (threadIdx.x == 0) (void)xb_add(&bar[XB_XCNT(b.x)], 1u);
    return b;
}
__device__ __forceinline__ void xcd_barrier_complete(unsigned* bar, unsigned x, unsigned& nloc, unsigned& nx) {
    const unsigned G = gridDim.x * gridDim.y * gridDim.z;
    unsigned sum, cnt, mine, sp = 0u;
    for (;;) {
        sum = 0u; cnt = 0u; mine = 0u;
#pragma unroll
        for (unsigned j = 0; j < 16; ++j) { const unsigned c = xb_ld(&bar[XB_XCNT(j)]); sum += c; cnt += (c > 0u) ? 1u : 0u; mine = (j == x) ? c : mine; }
        if (sum == G) break;
        __builtin_amdgcn_s_sleep(1);
        if ((++sp & 255u) == 0u) { if (xb_ld(&bar[XB_TMO])) break; if (sp > XB_SPIN_CAP) { atomicAdd(&bar[XB_TMO], 1u); break; } }
    }
    nloc = mine > 0u ? mine : 1u; nx = cnt > 0u ? cnt : 1u;
}
__device__ __forceinline__ void xcd_barrier(const XcdBarrier& b) {
    asm volatile("s_waitcnt vmcnt(0)" ::: "memory");
    __syncthreads();
    if (threadIdx.x == 0) {
        unsigned* bar = b.bar;
        __builtin_amdgcn_s_waitcnt(0);
        unsigned nloc = b.st[0], nx = b.st[1];
        if (nloc == 0u) { xcd_barrier_complete(bar, b.x, nloc, nx); b.st[0] = nloc; b.st[1] = nx; }
        const unsigned old = xb_add(&bar[XB_XSUB(b.x)], 1u);
        const unsigned gen = old / nloc;
        if (old + 1u == (gen + 1u) * nloc) {
            __builtin_amdgcn_fence(__ATOMIC_RELEASE, "agent");
            asm volatile("s_waitcnt vmcnt(0)" ::: "memory");
            const unsigned og = xb_add(&bar[XB_TOP], 1u);
            const unsigned tg = og / nx;
            if (og + 1u == (tg + 1u) * nx) xb_add(&bar[XB_TOPGEN], 1u);
            else XB_SPIN(xb_ld(&bar[XB_TOPGEN]) == tg, bar);
            __builtin_amdgcn_fence(__ATOMIC_ACQUIRE, "agent");
            xb_add(&bar[XB_XGEN(b.x)], 1u);
            asm volatile("s_waitcnt vmcnt(0)" ::: "memory");
        } else {
            XB_SPIN(xb_ld(&bar[XB_XGEN(b.x)]) == gen, bar);
            __builtin_amdgcn_fence(__ATOMIC_ACQUIRE, "agent");
            asm volatile("s_waitcnt vmcnt(0)" ::: "memory");
        }
    }
    __syncthreads();
}

namespace pg8 {
constexpr int BM = 256, BK = 64, HALF = 128, HTB = HALF * BK * 2, STAGE_BYTES = 8 * HTB, NXCD = 8, WGM = 4;
constexpr int ESC_OFF = 131072 + 4096, ESC_SLOT = 3072;
__host__ __device__ __forceinline__ int lds_byte(int r, int c) { const int st = (r >> 4) * 2 + (c >> 5), rr = r & 15, cc = c & 31, ob = rr * 64 + cc * 2; return st * 1024 + (ob ^ (((ob >> 9) & 1) << 5)); }
__host__ __device__ __forceinline__ void stage_rc(int b, int& R, int& C) { const int st = b / 1024, sb = b % 1024, swz = sb ^ (((sb >> 9) & 1) << 5); R = (st >> 1) * 16 + swz / 64; C = (st & 1) * 32 + (swz % 64) / 2; }

struct Unit { int pm, pn, aux; };

struct StaticOrder {
    int nM, nN, nwg, G, c, rev, wgm;
    __device__ void init(int nM_, int nN_, int G_, int c_, int rev_ = 0, int wgm_ = WGM) { nM = nM_; nN = nN_; nwg = nM * nN; G = G_; c = c_; rev = rev_; wgm = wgm_; }
    __device__ bool next(int i, Unit& u) const {
        const long L = (long)i * G + c; if (L >= nwg) return false;
        int wgid = (int)L; { const int q = nwg / NXCD, r = nwg % NXCD, xcd = wgid % NXCD, off = wgid / NXCD; wgid = (xcd < r ? xcd * (q + 1) : r * (q + 1) + (xcd - r) * q) + off; }
        const int nig = wgm * nN, gid = wgid / nig, fm = gid * wgm, gsz = (nM - fm) < wgm ? (nM - fm) : wgm;
        u.pm = fm + ((wgid % nig) % gsz); u.pn = (wgid % nig) / gsz; u.aux = 0; if (rev) u.pm = nM - 1 - u.pm; return true;
    }
};

template <bool I8> struct AccVec { typedef f32x4 type; };
template <> struct AccVec<true> { typedef i32x4 type; };
template <bool I8 = false, class Prob, class Sched, class Epi>
__device__ __forceinline__ void gemm_phase(LAS unsigned char* lds, const Prob& P, const Sched& S, const Epi& E) {
    const int tid = opq_v((int)threadIdx.x), wid = __builtin_amdgcn_readfirstlane(tid >> 6), lane = tid & 63, wr = wid >> 2, wc = wid & 3, fr = lane & 15, fq = lane >> 4;
    typedef typename AccVec<I8>::type accv_t;
    const int K = P.K, nt = K / (I8 ? 2 * BK : BK);
    unsigned voffA[2], voffB[2];
#pragma unroll
    for (int i = 0; i < 2; ++i) { int R, C; stage_rc(tid * 16 + i * 8192, R, C); voffA[i] = (unsigned)R * P.lda + (unsigned)C * 2u; voffB[i] = (unsigned)R * P.ldb + (unsigned)C * 2u; }
    const size_t kstep = (size_t)(BK * 2);
    const size_t hstepA = (size_t)HALF * P.lda, hstepB = (size_t)HALF * P.ldb;
    const unsigned ldsw = (unsigned)wid * 1024u;
    const int aoff = lds_byte(wr * 64 + fr, fq * 8), boff = lds_byte(wc * 32 + fr, fq * 8);
#define PG8_SA(b, h) (((b) * 2 + (h)) * HTB)
#define PG8_SB(b, h) ((4 + (b) * 2 + (h)) * HTB)
#define PG8_STAGE(bufoff, gbase, voff) do { _Pragma("unroll") for (int _i = 0; _i < 2; ++_i) \
        __builtin_amdgcn_global_load_lds((const unsigned*)((const char*)(gbase) + (voff)[_i]), (LAS unsigned*)(lds + (bufoff) + ldsw + _i * 8192), 16, 0, 0); } while (0)
#define PG8_LDA(dst, b, h) do { _Pragma("unroll") for (int m = 0; m < 4; ++m) _Pragma("unroll") for (int k = 0; k < 2; ++k) dst[m][k] = *(const LAS bf16x8*)(lds + PG8_SA(b, h) + aoff + m * 2048 + k * 1024); } while (0)
#define PG8_LDB(dst, b, h) do { _Pragma("unroll") for (int n = 0; n < 2; ++n) _Pragma("unroll") for (int k = 0; k < 2; ++k) dst[n][k] = *(const LAS bf16x8*)(lds + PG8_SB(b, h) + boff + n * 2048 + k * 1024); } while (0)
#define PG8_MMA(ai, bj, At, Bt) do { __builtin_amdgcn_s_setprio(1); _Pragma("unroll") for (int m = 0; m < 4; ++m) _Pragma("unroll") for (int n = 0; n < 2; ++n) _Pragma("unroll") for (int k = 0; k < 2; ++k) \
        { if constexpr (I8) acc[ai][bj][m][n] = __builtin_amdgcn_mfma_i32_16x16x64_i8(__builtin_bit_cast(i32x4, Bt[n][k]), __builtin_bit_cast(i32x4, At[m][k]), acc[ai][bj][m][n], 0, 0, 0); \
          else acc[ai][bj][m][n] = __builtin_amdgcn_mfma_f32_16x16x32_bf16(Bt[n][k], At[m][k], acc[ai][bj][m][n], 0, 0, 0); } __builtin_amdgcn_s_setprio(0); } while (0)
#define PG8_WAIT_V(n) asm volatile("s_waitcnt vmcnt(" #n ")" ::: "memory")
#define PG8_WAIT_L(n) asm volatile("s_waitcnt lgkmcnt(" #n ")" ::: "memory")
#define PG8_BAR __builtin_amdgcn_s_barrier()
#define PG8_SCHED __builtin_amdgcn_sched_barrier(0)
    Unit cur, nxt; int ui = 0;
    if (!S.next(0, cur)) return;
    accv_t acc[2][2][4][2];
#pragma unroll
    for (int a = 0; a < 2; ++a)
#pragma unroll
        for (int b = 0; b < 2; ++b)
#pragma unroll
            for (int m = 0; m < 4; ++m)
#pragma unroll
                for (int n = 0; n < 2; ++n) acc[a][b][m][n] = accv_t{};
    bf16x8 At[4][2], B0[2][2], B1[2][2];
    const char* cA = P.a_ptr(cur); const char* cB = P.b_ptr(cur);
    int eslot = 0;
    E.stage(lds + ESC_OFF, cur, wid, lane);
    PG8_STAGE(PG8_SB(0, 0), cB, voffB); PG8_STAGE(PG8_SB(0, 1), cB + hstepB, voffB); PG8_STAGE(PG8_SA(0, 0), cA, voffA); PG8_STAGE(PG8_SA(0, 1), cA + hstepA, voffA);
    if (wr == 1) PG8_BAR;
    PG8_WAIT_V(2); PG8_BAR;
    PG8_STAGE(PG8_SB(1, 0), cB + kstep, voffB); PG8_STAGE(PG8_SA(1, 0), cA + kstep, voffA); PG8_STAGE(PG8_SB(1, 1), cB + hstepB + kstep, voffB);
    PG8_WAIT_V(6); PG8_BAR;
    for (;;) {
        const bool has_next = S.next(ui + 1, nxt);
        const char* nA = has_next ? P.a_ptr(nxt) : cA; const char* nB = has_next ? P.b_ptr(nxt) : cB;
        for (int t = 0; t < nt; t += 2) {
            if constexpr (Epi::MID) { if (t == 8 || t == 16) E.mid(acc, cur, t >> 3, wr, wc, fr, fq); }
            const bool last = (t == nt - 2);
            if (last && has_next) E.stage(lds + ESC_OFF + (eslot ^ 1) * ESC_SLOT, nxt, wid, lane);
            const char* a1 = cA + (size_t)(t + 1) * kstep;
            const char* a2 = last ? nA : cA + (size_t)(t + 2) * kstep; const char* b2 = last ? nB : cB + (size_t)(t + 2) * kstep;
            const char* a3 = a2 + kstep; const char* b3 = b2 + kstep;
            PG8_LDB(B0, 0, 0); PG8_LDB(B1, 0, 1); PG8_SCHED; PG8_LDA(At, 0, 0); PG8_STAGE(PG8_SA(1, 1), a1 + hstepA, voffA);
            PG8_WAIT_V(8); PG8_WAIT_L(0); PG8_BAR; PG8_MMA(0, 0, At, B0); PG8_MMA(0, 1, At, B1); PG8_BAR; PG8_SCHED;
            PG8_LDA(At, 0, 1); PG8_STAGE(PG8_SB(0, 0), b2, voffB); PG8_STAGE(PG8_SB(0, 1), b2 + hstepB, voffB); PG8_STAGE(PG8_SA(0, 0), a2, voffA);
            PG8_WAIT_V(8); PG8_WAIT_L(0); PG8_BAR; PG8_MMA(1, 0, At, B0); PG8_MMA(1, 1, At, B1); PG8_BAR; PG8_SCHED;
            PG8_LDB(B0, 1, 0); PG8_LDB(B1, 1, 1); PG8_SCHED; PG8_LDA(At, 1, 0); PG8_STAGE(PG8_SA(0, 1), a2 + hstepA, voffA);
            PG8_WAIT_V(8); PG8_WAIT_L(0); PG8_BAR; PG8_MMA(0, 0, At, B0); PG8_MMA(0, 1, At, B1); PG8_BAR; PG8_SCHED;
            PG8_LDA(At, 1, 1); PG8_STAGE(PG8_SB(1, 0), b3, voffB); PG8_STAGE(PG8_SB(1, 1), b3 + hstepB, voffB); PG8_STAGE(PG8_SA(1, 0), a3, voffA);
            PG8_WAIT_V(8); PG8_WAIT_L(0); PG8_BAR; PG8_MMA(1, 0, At, B0); PG8_MMA(1, 1, At, B1); PG8_BAR; PG8_SCHED;
        }
        if (wr == 0) PG8_BAR;
        E(acc, cur, wr, wc, fr, fq, lds + ESC_OFF + eslot * ESC_SLOT);
        if (!has_next) break;
#pragma unroll
        for (int a = 0; a < 2; ++a)
#pragma unroll
            for (int b = 0; b < 2; ++b)
#pragma unroll
                for (int m = 0; m < 4; ++m)
#pragma unroll
                    for (int n = 0; n < 2; ++n) acc[a][b][m][n] = accv_t{};
        cur = nxt; cA = nA; cB = nB; ++ui; eslot ^= 1;
        if (wr == 1) PG8_BAR;
    }
    PG8_WAIT_V(0);
    PG8_BAR;
#undef PG8_SA
#undef PG8_SB
#undef PG8_STAGE
#undef PG8_LDA
#undef PG8_LDB
#undef PG8_MMA
#undef PG8_WAIT_V
#undef PG8_WAIT_L
#undef PG8_BAR
#undef PG8_SCHED
}
}

struct Frame {
    LAS unsigned char* lds;
    volatile LAS unsigned* MISC;
    gu32* ctl;
    unsigned char* ws;
    int tid, lane, wave, vcu, G;
    const float* const* in; float* out;
};
enum { I_X = 0, I_MEM, I_POS, I_GMIX, I_WIN, I_GQ, I_WUQ, I_GKV, I_WUKV, I_SINK, I_WMKV, I_WBR, I_WOUT, I_GFFN, I_WGD, I_WUD, I_WDD, I_WR, I_WGE, I_WUE, I_WDE, I_GMEM, I_GFIN };

__device__ __forceinline__ int sem_plain(int g) { return (g & ~31) + 8 * ((g >> 2) & 3) + 4 * ((g >> 4) & 1) + (g & 3); }
__device__ __forceinline__ int sem_rot64(int g) { return (g & ~63) + 32 * ((g >> 4) & 1) + 16 * ((g >> 5) & 1) + 4 * ((g >> 2) & 3) + (g & 3); }
__device__ __forceinline__ int sem_p16(int g) { const int c = g & 255; return (g & ~255) + 64 * ((c >> 5) & 3) + 16 * ((c >> 2) & 3) + 8 * (c >> 7) + 4 * ((c >> 4) & 1) + (c & 3); }
__device__ __forceinline__ int inproj_src(int n) {
    const int pn = n >> 8, c = n & 255;
    if (pn < 2) return pn * 256 + sem_rot64(c);
    if (pn == 2) return c < 128 ? 512 + sem_rot64(c) : 640 + sem_plain(c - 128);
    if (pn == 3) return 768 + sem_plain(c);
    if (pn == 4) return c < 128 ? 1024 + sem_plain(c) : (c < 160 ? 1152 + (c - 128) : -1);
    if (pn < 7) return 1184 + (pn - 5) * 256 + sem_plain(c);
    return 1696 + (pn - 7) * 256 + sem_p16(c);
}

struct MapInproj { const float* W; __device__ __forceinline__ float load(int k, int n) const { const int s = inproj_src(n); return s >= 0 ? W[(size_t)k * INW + s] : 0.f; }
    __device__ __forceinline__ f32x4 load4(int k, int n) const { const int s = inproj_src(n); return s >= 0 ? *(const f32x4*)(W + (size_t)k * INW + s) : (f32x4){0.f, 0.f, 0.f, 0.f}; } };
struct MapUp { const float *Wq, *Wkv, *gq, *gkv;
    __device__ __forceinline__ f32x4 load4(int k, int n) const {
        if (n < 768) { const int gg = n >> 5; const int s = (gg % 3 == 2) ? n : sem_plain(n); return *(const f32x4*)(Wq + (size_t)k * 768 + s) * gq[k]; }
        if (k < 128) return (f32x4){0.f, 0.f, 0.f, 0.f}; const int s = sem_plain(n - 768); return *(const f32x4*)(Wkv + (size_t)(k - 128) * 1024 + s) * gkv[k - 128]; }
    __device__ __forceinline__ float load(int k, int n) const {
        if (n < 768) { const int gg = n >> 5; const int s = (gg % 3 == 2) ? n : sem_plain(n); return gq[k] * Wq[(size_t)k * 768 + s]; }
        if (k < 128) return 0.f; const int s = sem_plain(n - 768); return gkv[k - 128] * Wkv[(size_t)(k - 128) * 1024 + s]; } };
struct MapPlain { const float* W; int ldw; __device__ __forceinline__ float load(int k, int n) const { return W[(size_t)k * ldw + sem_plain(n)]; }
    __device__ __forceinline__ f32x4 load4(int k, int n) const { return *(const f32x4*)(W + (size_t)k * ldw + sem_plain(n)); } };
struct MapNat { const float* W; int ldw; __device__ __forceinline__ float load(int k, int n) const { return W[(size_t)k * ldw + n]; }
    __device__ __forceinline__ f32x4 load4(int k, int n) const { return *(const f32x4*)(W + (size_t)k * ldw + n); } };
struct MapBr { const float* W;
    __device__ __forceinline__ float load(int k, int n) const { return W[(size_t)k * DM + sem_p16(n)]; }
    __device__ __forceinline__ f32x4 load4(int k, int n) const { return *(const f32x4*)(W + (size_t)k * DM + sem_p16(n)); } };
struct MapMemkv { const float* W; __device__ __forceinline__ float load(int k, int n) const { const int l = n >> 10, c = n & 1023; return W[((size_t)l * DM + k) * 1024 + sem_plain(c)]; }
    __device__ __forceinline__ f32x4 load4(int k, int n) const { const int l = n >> 10, c = n & 1023; return *(const f32x4*)(W + ((size_t)l * DM + k) * 1024 + sem_plain(c)); } };
struct MapGU { const float *Wg, *Wu; __device__ __forceinline__ float load(int k, int n) const { const int pn = n >> 8, c = n & 255; const int ch = 128 * pn + sem_plain(c & 127);
    const unsigned long long a = (unsigned long long)Wg, b = (unsigned long long)Wu, w = a ^ ((a ^ b) & (0ull - (unsigned long long)(c >> 7))); return ((const float*)w)[(size_t)k * DFF + ch]; }
    __device__ __forceinline__ f32x4 load4(int k, int n) const { const int pn = n >> 8, c = n & 255; const int ch = 128 * pn + sem_plain(c & 127);
        const unsigned long long a = (unsigned long long)Wg, b = (unsigned long long)Wu, w = a ^ ((a ^ b) & (0ull - (unsigned long long)(c >> 7))); return *(const f32x4*)((const float*)w + (size_t)k * DFF + ch); } };

template <class M> __device__ __forceinline__ void prep_item(const M& m, bf16_t* dst, int Kd, int nblk, LAS float* scr, int item, int lane) {
    const int kb = item / nblk, nb = item % nblk, k0 = 64 * kb, n0 = 32 * nb;
#pragma unroll 8
    for (int i = 0; i < 32; ++i) { const int kk = 2 * i + (lane >> 5); scr[kk * 33 + (lane & 31)] = m.load(k0 + kk, n0 + (lane & 31)); }
    LDS_WAIT(); asm volatile("" ::: "memory");
    const int c = lane & 7;
#pragma unroll
    for (int j = 0; j < 4; ++j) { const int n = (lane >> 3) + 8 * j; const LAS float* s = scr + (8 * c) * 33 + n;
        u32x4 o; o.x = pk2(s[0 * 33], s[1 * 33]); o.y = pk2(s[2 * 33], s[3 * 33]); o.z = pk2(s[4 * 33], s[5 * 33]); o.w = pk2(s[6 * 33], s[7 * 33]);
        *(u32x4*)(dst + (size_t)(n0 + n) * Kd + k0 + 8 * c) = o; }
    LDS_WAIT(); asm volatile("" ::: "memory");
}
template <class M> __device__ __forceinline__ void prep_tile(const M& m, bf16_t* dst, int Kd, int nblk, LAS unsigned char* tile, int item, int lane) {
    const int kb = item / nblk, nb = item % nblk, k0 = 128 * kb, n0 = 32 * nb, ng = lane & 7, kr = lane >> 3;
    f32x4 v[16];
#pragma unroll
    for (int i = 0; i < 16; ++i) v[i] = m.load4(k0 + 8 * i + kr, n0 + 4 * ng);
#pragma unroll
    for (int i = 0; i < 16; ++i)
#pragma unroll
        for (int c = 0; c < 4; ++c) *(LAS unsigned short*)(tile + (4 * ng + c) * 272 + (8 * i + kr) * 2) = (unsigned short)f2bf(v[i][c]);
    LDS_WAIT(); asm volatile("" ::: "memory");
#pragma unroll
    for (int j = 0; j < 8; ++j) { const int p = lane + 64 * j, n = p >> 4, kc = p & 15;
        *(u32x4*)(dst + (size_t)(n0 + n) * Kd + k0 + 8 * kc) = *(const LAS u32x4*)(tile + n * 272 + 16 * kc); }
    LDS_WAIT(); asm volatile("" ::: "memory");
}
template <class M> __device__ __forceinline__ void prep_matrix(Frame& F, const M& m, bf16_t* dst, int N, int K) {
    LAS unsigned char* tile = F.lds + F.wave * 16384;
    const int gw = F.vcu * NWAVES + F.wave, NGW = F.G * NWAVES, nblk = N / 32, nitems = (K / 128) * nblk;
    for (int it = gw; it < nitems; it += NGW) prep_tile(m, dst, K, nblk, tile, it, F.lane);
}

template <class M> __device__ __forceinline__ void prep_strip_i8(Frame& F, const M& m, signed char* dst, float* scl, int strip) {
    const int lane = F.lane, w = F.wave, n0 = strip * 32, k0 = w * 128, ng = lane & 7, kr = lane >> 3;
    LAS unsigned char* tile = F.lds + w * 16384;
    LAS float* amt = (LAS float*)(F.lds + LDSCTL_OFF + 2048);
    f32x4 v[16];
#pragma unroll
    for (int i = 0; i < 16; ++i) v[i] = m.load4(k0 + 8 * i + kr, n0 + 4 * ng);
    f32x4 am = __builtin_elementwise_abs(v[0]);
#pragma unroll
    for (int i = 1; i < 16; ++i) am = __builtin_elementwise_max(am, __builtin_elementwise_abs(v[i]));
#pragma unroll
    for (int c = 0; c < 4; ++c) { float a = am[c]; a = fmaxf(a, __shfl_xor(a, 8)); a = fmaxf(a, __shfl_xor(a, 16)); a = fmaxf(a, __shfl_xor(a, 32)); am[c] = a; }
    if (kr == 0) *(LAS f32x4*)(amt + w * 32 + 4 * ng) = am;
    __syncthreads();
    f32x4 cm = *(const LAS f32x4*)(amt + 4 * ng);
#pragma unroll
    for (int ww = 1; ww < 8; ++ww) cm = __builtin_elementwise_max(cm, *(const LAS f32x4*)(amt + ww * 32 + 4 * ng));
    f32x4 inv;
#pragma unroll
    for (int c = 0; c < 4; ++c) inv[c] = cm[c] > 0.f ? 127.0f / cm[c] : 0.f;
    if (w == 0 && kr == 0) *(f32x4*)(scl + n0 + 4 * ng) = cm * (1.0f / 127.0f);
#pragma unroll
    for (int i = 0; i < 16; ++i)
#pragma unroll
        for (int c = 0; c < 4; ++c) tile[(4 * ng + c) * 144 + 8 * i + kr] = (unsigned char)(signed char)__float2int_rn(v[i][c] * inv[c]);
    LDS_WAIT(); asm volatile("" ::: "memory");
#pragma unroll
    for (int j = 0; j < 4; ++j) { const int p = lane + 64 * j, n = p >> 3, kc = p & 7;
        *(u32x4*)(dst + (size_t)(n0 + n) * DM + k0 + 16 * kc) = *(const LAS u32x4*)(tile + n * 144 + 16 * kc); }
    LDS_WAIT();
    __syncthreads();
}
__device__ __forceinline__ bf16_t* wmix(Frame& F, int l, size_t off) { return (bf16_t*)(F.ws + WS_WMIX + (size_t)l * WL_STRIDE + off); }

__device__ __forceinline__ void prep_mixer_weights(Frame& F) {
    for (int l = 0; l < DEPTH; ++l) {
        { MapInproj m{F.in[I_WIN] + (size_t)l * DM * INW}; for (int s = F.vcu; s < NT_IN * 8; s += F.G) prep_strip_i8(F, m, (signed char*)wmix(F, l, WL_IN), (float*)(F.ws + WS_MISC + MS_WSIN) + l * NT_IN * 256, s); }
        { MapUp m{F.in[I_WUQ] + (size_t)l * 256 * 768, F.in[I_WUKV] + (size_t)l * 128 * 1024, F.in[I_GQ] + l * 256, F.in[I_GKV] + l * 128}; prep_matrix(F, m, wmix(F, l, WL_UP), UPN, UPK); }
        { MapBr m{F.in[I_WBR] + (size_t)l * 3 * 512 * DM}; prep_matrix(F, m, wmix(F, l, WL_BR), DM, 1536); }
        { MapPlain m{F.in[I_WOUT] + (size_t)l * DM * DM, DM}; prep_matrix(F, m, wmix(F, l, WL_OUT), DM, DM); }
    }
    { MapMemkv m{F.in[I_WMKV]}; prep_matrix(F, m, (bf16_t*)(F.ws + WS_WMKV), 4096, DM); }
}
__device__ __forceinline__ void prep_ffn_weights(Frame& F, int l) {
    const int i = l >> 1; const bool moe = (l & 1) != 0;
    LAS float* scr = (LAS float*)(F.lds + F.wave * 16384);
    const int gw = F.vcu * NWAVES + F.wave, NGW = F.G * NWAVES;
    constexpr int IGU = (DM / 64) * (2 * DFF / 32), ID = (DFF / 64) * (DM / 32), NSTRIP = 2 * DFF / 32;
    const int ne = moe ? NE : 1;
    const float* Wg = moe ? F.in[I_WGE] : F.in[I_WGD]; const float* Wu = moe ? F.in[I_WUE] : F.in[I_WUD]; const float* Wd = moe ? F.in[I_WDE] : F.in[I_WDD];
    if (GU_I8(l)) {
        for (int s = F.vcu; s < ne * NSTRIP; s += F.G) { const int e = s / NSTRIP, ss = s % NSTRIP; const size_t eo = ((size_t)i * ne + e) * DM * DFF;
            MapGU m{Wg + eo, Wu + eo}; prep_strip_i8(F, m, (signed char*)(F.ws + WS_WFFN + (size_t)e * WF_STRIDE), (float*)(F.ws + WS_MISC + MS_WSGU) + e * 2 * DFF, ss); }
    } else {
        for (int it = gw; it < ne * IGU; it += NGW) { const int e = it / IGU, r = it % IGU; const size_t eo = ((size_t)i * ne + e) * DM * DFF;
            MapGU m{Wg + eo, Wu + eo}; prep_item(m, (bf16_t*)(F.ws + WS_WFFN + (size_t)e * WF_STRIDE), DM, 2 * DFF / 32, scr, r, F.lane); }
    }
    constexpr int IDT = (DFF / 128) * (DM / 32);
    for (int it = gw; it < ne * IDT; it += NGW) { const int e = it / IDT, r = it % IDT; const size_t eo = ((size_t)i * ne + e) * DM * DFF;
        MapPlain m{Wd + eo, DM}; prep_tile(m, (bf16_t*)(F.ws + WS_WFFN + (size_t)e * WF_STRIDE + WF_D), DFF, DM / 32, F.lds + F.wave * 16384, r, F.lane); }
}

struct RowV { f32x4 v[4]; };
__device__ __forceinline__ void row_load(RowV& r, const float* p, int lane) { const f32x4* x = (const f32x4*)p + lane;
#pragma unroll
    for (int j = 0; j < 4; ++j) r.v[j] = x[64 * j]; }
__device__ __forceinline__ void row_store(const RowV& r, float* p, int lane) { f32x4* x = (f32x4*)p + lane;
#pragma unroll
    for (int j = 0; j < 4; ++j) x[64 * j] = r.v[j]; }
__device__ __forceinline__ void row_add_bf16(RowV& r, const bf16_t* p, float w, int lane) { const u32x2* x = (const u32x2*)p + lane;
#pragma unroll
    for (int j = 0; j < 4; ++j) { const u32x2 q = x[64 * j]; r.v[j].x += w * bflo(q.x); r.v[j].y += w * bfhi(q.x); r.v[j].z += w * bflo(q.y); r.v[j].w += w * bfhi(q.y); } }
__device__ __forceinline__ void row_load_bf16(RowV& r, const bf16_t* p, int lane) { const u32x2* x = (const u32x2*)p + lane;
#pragma unroll
    for (int j = 0; j < 4; ++j) { const u32x2 q = x[64 * j]; r.v[j].x = bflo(q.x); r.v[j].y = bfhi(q.x); r.v[j].z = bflo(q.y); r.v[j].w = bfhi(q.y); } }
__device__ __forceinline__ void row_round_bf16(RowV& r) {
#pragma unroll
    for (int j = 0; j < 4; ++j) { r.v[j].x = bf2f((unsigned short)f2bf(r.v[j].x)); r.v[j].y = bf2f((unsigned short)f2bf(r.v[j].y)); r.v[j].z = bf2f((unsigned short)f2bf(r.v[j].z)); r.v[j].w = bf2f((unsigned short)f2bf(r.v[j].w)); } }
__device__ __forceinline__ float row_rstd(const RowV& r) { float s = 0.f;
#pragma unroll
    for (int j = 0; j < 4; ++j) s += (r.v[j].x * r.v[j].x + r.v[j].y * r.v[j].y) + (r.v[j].z * r.v[j].z + r.v[j].w * r.v[j].w);
    return 1.0f / sqrtf(wave_sum(s) * (1.0f / DM) + EPS); }
__device__ __forceinline__ void row_scale(RowV& r, float rstd, const float* g, int lane) { const f32x4* gg = (const f32x4*)g + lane;
#pragma unroll
    for (int j = 0; j < 4; ++j) r.v[j] = r.v[j] * rstd * gg[64 * j]; }
__device__ __forceinline__ void row_store_bf16(const RowV& r, bf16_t* p, int lane) { u32x2* o = (u32x2*)p + lane;
#pragma unroll
    for (int j = 0; j < 4; ++j) { u32x2 w; w.x = pk2(r.v[j].x, r.v[j].y); w.y = pk2(r.v[j].z, r.v[j].w); o[64 * j] = w; } }

__device__ __forceinline__ float row_store_i8(const RowV& r, signed char* p, int lane) {
    float am = 0.f;
#pragma unroll
    for (int j = 0; j < 4; ++j) am = fmaxf(am, fmaxf(fmaxf(fabsf(r.v[j].x), fabsf(r.v[j].y)), fmaxf(fabsf(r.v[j].z), fabsf(r.v[j].w))));
#pragma unroll
    for (int o = 1; o < 64; o <<= 1) am = fmaxf(am, __shfl_xor(am, o));
    const float inv = am > 0.f ? 127.0f / am : 0.f; unsigned* o4 = (unsigned*)p + lane;
#pragma unroll
    for (int j = 0; j < 4; ++j) { const unsigned a = (unsigned)__float2int_rn(r.v[j].x * inv) & 255u, b = (unsigned)__float2int_rn(r.v[j].y * inv) & 255u, c = (unsigned)__float2int_rn(r.v[j].z * inv) & 255u, d = (unsigned)__float2int_rn(r.v[j].w * inv) & 255u;
        o4[64 * j] = a | (b << 8) | (c << 16) | (d << 24); }
    return am * (1.0f / 127.0f);
}
__device__ __forceinline__ void row_combine(Frame& F, RowV& r, int t) {
    const int* sl = (const int*)(F.ws + WS_MISC + MS_SLOT) + 2 * t; const float* tw = (const float*)(F.ws + WS_MISC + MS_TOKW) + 2 * t;
    const bf16_t* Y = (const bf16_t*)(F.ws + WS_R + R_YOUT);
    const int s0 = sl[0], s1 = sl[1]; const float w0 = tw[0], w1 = tw[1];
    row_add_bf16(r, Y + (size_t)s0 * DM, w0, F.lane); row_add_bf16(r, Y + (size_t)s1 * DM, w1, F.lane);
}

__device__ __forceinline__ void norm_phase(Frame& F, const float* srcf, bf16_t* X, const float* g, bool combine, bool out_i8) {
    bf16_t* H = (bf16_t*)(F.ws + WS_H); signed char* Hq = (signed char*)(F.ws + WS_H); float* hsc = (float*)(F.ws + WS_MISC + MS_HSC);
    const int gw = F.vcu * NWAVES + F.wave, NGW = F.G * NWAVES;
    for (int t = gw; t < T; t += 2 * NGW) {
        const int t2 = (t + NGW < T) ? t + NGW : t;
        RowV r, q;
        if (srcf) { row_load(r, srcf + (size_t)t * DM, F.lane); row_load(q, srcf + (size_t)t2 * DM, F.lane); }
        else { row_load_bf16(r, X + (size_t)t * DM, F.lane); row_load_bf16(q, X + (size_t)t2 * DM, F.lane); }
        if (combine) { row_combine(F, r, t); row_combine(F, q, t2); row_store_bf16(r, X + (size_t)t * DM, F.lane); row_store_bf16(q, X + (size_t)t2 * DM, F.lane);
            row_round_bf16(r); row_round_bf16(q); }
        const float rstd = row_rstd(r), qstd = row_rstd(q); row_scale(r, rstd, g, F.lane); row_scale(q, qstd, g, F.lane);
        if (out_i8) { const float sc = row_store_i8(r, Hq + (size_t)t * DM, F.lane), sq = row_store_i8(q, Hq + (size_t)t2 * DM, F.lane); if (F.lane == 0) { hsc[t] = sc; hsc[t2] = sq; } }
        else { row_store_bf16(r, H + (size_t)t * DM, F.lane); row_store_bf16(q, H + (size_t)t2 * DM, F.lane); }
    }
}
__device__ __forceinline__ void final_norm_phase(Frame& F, const bf16_t* X, float* out, const float* g, bool combine) {
    const int gw = F.vcu * NWAVES + F.wave, NGW = F.G * NWAVES;
    for (int t = gw; t < T; t += 2 * NGW) {
        const int t2 = (t + NGW < T) ? t + NGW : t;
        RowV r, q; row_load_bf16(r, X + (size_t)t * DM, F.lane); row_load_bf16(q, X + (size_t)t2 * DM, F.lane);
        if (combine) { row_combine(F, r, t); row_combine(F, q, t2); }
        const float rstd = row_rstd(r), qstd = row_rstd(q); row_scale(r, rstd, g, F.lane); row_scale(q, qstd, g, F.lane);
        row_store(r, out + (size_t)t * DM, F.lane); row_store(q, out + (size_t)t2 * DM, F.lane);
    }
}
__device__ __forceinline__ void memnorm_phase(Frame& F) {
    bf16_t* MN = (bf16_t*)(F.ws + WS_MEMN);
    const int gw = F.vcu * NWAVES + F.wave, NGW = F.G * NWAVES;
    for (int t = gw; t < NB * MEML; t += NGW) {
        RowV r; row_load(r, F.in[I_MEM] + (size_t)t * DM, F.lane);
        const float rstd = row_rstd(r); row_scale(r, rstd, F.in[I_GMEM], F.lane);
        row_store_bf16(r, MN + (size_t)t * DM, F.lane);
    }
}

__device__ __forceinline__ void norm_router_phase(Frame& F, const bf16_t* X, const float* g, const float* Wr  , bool out_i8) {
    bf16_t* H = (bf16_t*)(F.ws + WS_H); signed char* Hq = (signed char*)(F.ws + WS_H); float* hsc = (float*)(F.ws + WS_MISC + MS_HSC);
    int* toke = (int*)(F.ws + WS_MISC + MS_TOKE); float* tokw = (float*)(F.ws + WS_MISC + MS_TOKW); int* cntg = (int*)(F.ws + WS_MISC + MS_CNT);
    volatile LAS int* hist = (volatile LAS int*)(F.lds + LDSCTL_OFF + 1024);
    f32x4 wa[4][4], wb[4][4];
#pragma unroll
    for (int j = 0; j < 4; ++j)
#pragma unroll
        for (int k = 0; k < 4; ++k) { const int d = 256 * j + 4 * F.lane + k; wa[j][k] = *(const f32x4*)(Wr + (size_t)d * 8); wb[j][k] = *(const f32x4*)(Wr + (size_t)d * 8 + 4); }
    const bool up32 = (F.lane & 32) != 0, up16 = (F.lane & 16) != 0, up8 = (F.lane & 8) != 0;
    for (int c = F.vcu; c < T / 128; c += F.G) {
        if (F.tid < 8) hist[F.tid] = 0;
        __syncthreads();
        for (int q = 0; q < 16; ++q) {
            const int t = c * 128 + F.wave * 16 + q;
            RowV r; row_load_bf16(r, X + (size_t)t * DM, F.lane);
            const float rstd = row_rstd(r); row_scale(r, rstd, g, F.lane);
            if (out_i8) { const float sc = row_store_i8(r, Hq + (size_t)t * DM, F.lane); if (F.lane == 0) hsc[t] = sc; }
            else row_store_bf16(r, H + (size_t)t * DM, F.lane);
            f32x4 la = {0.f, 0.f, 0.f, 0.f}, lb = {0.f, 0.f, 0.f, 0.f};
#pragma unroll
            for (int j = 0; j < 4; ++j)
#pragma unroll
                for (int k = 0; k < 4; ++k) { const float x = r.v[j][k]; la += wa[j][k] * x; lb += wb[j][k] * x; }
            f32x4 h4; { const f32x4 keep = up32 ? lb : la, send = up32 ? la : lb;
#pragma unroll
                for (int i = 0; i < 4; ++i) h4[i] = keep[i] + __shfl_xor(send[i], 32); }
            f32x2 h2; { const float k0 = up16 ? h4[2] : h4[0], k1 = up16 ? h4[3] : h4[1], s0 = up16 ? h4[0] : h4[2], s1 = up16 ? h4[1] : h4[3]; h2.x = k0 + __shfl_xor(s0, 16); h2.y = k1 + __shfl_xor(s1, 16); }
            float h1 = (up8 ? h2.y : h2.x) + __shfl_xor(up8 ? h2.x : h2.y, 8);
            h1 += __shfl_xor(h1, 4); h1 += __shfl_xor(h1, 2); h1 += __shfl_xor(h1, 1);
            float lg[8];
#pragma unroll
            for (int e = 0; e < 8; ++e) lg[e] = __builtin_bit_cast(float, __builtin_amdgcn_readlane(__builtin_bit_cast(int, h1), 8 * e));
            int e0 = 0; float v0 = lg[0];
#pragma unroll
            for (int e = 1; e < 8; ++e) if (lg[e] > v0) { v0 = lg[e]; e0 = e; }
            int e1 = -1; float v1 = -INFINITY;
#pragma unroll
            for (int e = 0; e < 8; ++e) if (e != e0 && lg[e] > v1) { v1 = lg[e]; e1 = e; }
            if (F.lane == 0) {
                const float w0 = 1.0f / (1.0f + __expf(v1 - v0));
                toke[2 * t] = e0; toke[2 * t + 1] = e1; tokw[2 * t] = w0; tokw[2 * t + 1] = 1.0f - w0;
                __hip_atomic_fetch_add((LAS int*)&hist[e0], 1, __ATOMIC_RELAXED, __HIP_MEMORY_SCOPE_WORKGROUP); __hip_atomic_fetch_add((LAS int*)&hist[e1], 1, __ATOMIC_RELAXED, __HIP_MEMORY_SCOPE_WORKGROUP);
            }
        }
        __syncthreads();
        if (F.tid < 8) cntg[c * 8 + F.tid] = hist[F.tid];
        __syncthreads();
    }
}
__device__ __forceinline__ void moe_assign_phase(Frame& F, bool i8) {
    const bf16_t* H = (const bf16_t*)(F.ws + WS_H); bf16_t* AS = (bf16_t*)(F.ws + WS_R + R_ASORT);
    const float* hsc = (const float*)(F.ws + WS_MISC + MS_HSC); float* asc = (float*)(F.ws + WS_MISC + MS_ASC);
    const int* toke = (const int*)(F.ws + WS_MISC + MS_TOKE); int* slot = (int*)(F.ws + WS_MISC + MS_SLOT); const int* cntg = (const int*)(F.ws + WS_MISC + MS_CNT);
    int* texp = (int*)(F.ws + WS_MISC + MS_TEXP);
    volatile LAS int* tot = (volatile LAS int*)(F.lds + LDSCTL_OFF + 1024);
    volatile LAS int* pre = tot + 8;
    volatile LAS int* wcnt = tot + 16;
    for (int c = F.vcu; c < T / 128; c += F.G) {
        if (F.tid < 16) tot[F.tid] = 0;
        __syncthreads();
        { const int cc = F.tid >> 1, h = F.tid & 1; const i32x4 v = *(const i32x4*)(cntg + cc * 8 + 4 * h);
#pragma unroll
          for (int k = 0; k < 4; ++k) { __hip_atomic_fetch_add((LAS int*)&tot[4 * h + k], v[k], __ATOMIC_RELAXED, __HIP_MEMORY_SCOPE_WORKGROUP); if (cc < c) __hip_atomic_fetch_add((LAS int*)&pre[4 * h + k], v[k], __ATOMIC_RELAXED, __HIP_MEMORY_SCOPE_WORKGROUP); } }
        const int t = c * 128 + F.wave * 16 + ((F.lane & 31) >> 1);
        const int my_e = (F.lane < 32) ? toke[2 * t + (F.lane & 1)] : -1;
        int rank = 0;
#pragma unroll
        for (int e = 0; e < 8; ++e) { const unsigned long long m = __ballot(my_e == e); if (my_e == e) rank = __popcll(m & ((1ull << F.lane) - 1ull)); if (F.lane == 0) wcnt[F.wave * 8 + e] = __popcll(m); }
        __syncthreads();
        int myslot = 0;
        if (F.lane < 32) {
            int ts = 0;
#pragma unroll
            for (int e = 0; e < 8; ++e) ts += (e < my_e) ? ((tot[e] + 255) >> 8) : 0;
            int wp = 0; for (int w = 0; w < F.wave; ++w) wp += wcnt[w * 8 + my_e];
            myslot = ts * 256 + pre[my_e] + wp + rank;
            slot[2 * t + (F.lane & 1)] = myslot;
        }
        if (c == 0 && F.tid == 0) { int ts = 0; for (int e = 0; e < 8; ++e) { const int n = (tot[e] + 255) >> 8; for (int k = 0; k < n; ++k) texp[ts + k] = e; ts += n; } for (int k = ts; k < MAXRT; ++k) texp[k] = 0; texp[MAXRT] = ts; }
        if (i8) {
            const float myh = hsc[t];
#pragma unroll 1
            for (int a0 = 0; a0 < 32; a0 += 8) {
                u32x4 x[4];
#pragma unroll
                for (int k = 0; k < 4; ++k) x[k] = *((const u32x4*)((const signed char*)H + (size_t)(c * 128 + F.wave * 16 + ((a0 + 2 * k) >> 1)) * DM) + F.lane);
#pragma unroll
                for (int k = 0; k < 8; ++k) { const int s = __builtin_amdgcn_readlane(myslot, a0 + k); *((u32x4*)((signed char*)AS + (size_t)s * DM) + F.lane) = x[k >> 1]; }
            }
            if (F.lane < 32) asc[myslot] = myh;
        } else {
            for (int a = 0; a < 32; ++a) {
                const int s = __builtin_amdgcn_readlane(myslot, a); const int ta = c * 128 + F.wave * 16 + (a >> 1);
                const u32x4* srcp = (const u32x4*)(H + (size_t)ta * DM) + F.lane; u32x4* dstp = (u32x4*)(AS + (size_t)s * DM) + F.lane;
                const u32x4 x0 = srcp[0], x1 = srcp[64]; dstp[0] = x0; dstp[64] = x1; }
        }
        __syncthreads();
    }
}

using pg8::Unit;
typedef f32x4 AccT[2][2][4][2];

struct ProbSimple { int K; unsigned lda, ldb; const char* A; const char* B;
    __device__ __forceinline__ const char* a_ptr(const Unit& u) const { return A + (size_t)u.pm * 256 * lda; }
    __device__ __forceinline__ const char* b_ptr(const Unit& u) const { return B + (size_t)u.pn * 256 * ldb; } };
struct ProbUp { int K; unsigned lda, ldb; const char* A; const char* B;
    __device__ __forceinline__ const char* a_ptr(const Unit& u) const { return A + (size_t)u.pm * 256 * lda + (u.pn >= 3 ? 256 : 0); }
    __device__ __forceinline__ const char* b_ptr(const Unit& u) const { return B + (size_t)u.pn * 256 * ldb; } };
struct ProbMoe { int K; unsigned lda, ldb; const char* A; const char* B; int a_lo;
    __device__ __forceinline__ const char* a_ptr(const Unit& u) const { return A + (size_t)(u.pm - a_lo) * 256 * lda; }
    __device__ __forceinline__ const char* b_ptr(const Unit& u) const { return B + (size_t)u.aux * WF_STRIDE + (size_t)u.pn * 256 * ldb; } };

struct MoeOrder { pg8::StaticOrder base; int lo; const int* texp;
    __device__ bool next(int i, Unit& u) const { if (!base.next(i, u)) return false; u.pm += lo; u.aux = __builtin_amdgcn_readfirstlane(texp[u.pm]); return true; } };

__device__ __forceinline__ u32x4 pack8(const f32x4 a, const f32x4 b) { u32x4 w; w.x = cvtpk(a[0], a[1]); w.y = cvtpk(a[2], a[3]); w.z = cvtpk(b[0], b[1]); w.w = cvtpk(b[2], b[3]); return w; }
__device__ __forceinline__ u32x2 pack4(const f32x4 a) { u32x2 w; w.x = cvtpk(a[0], a[1]); w.y = cvtpk(a[2], a[3]); return w; }

struct EpiNoStage { __device__ __forceinline__ void stage(LAS unsigned char*, const Unit&, int, int) const {} };
__device__ __forceinline__ void stage1k(const void* src, LAS unsigned char* dst, int lane) { __builtin_amdgcn_global_load_lds((const unsigned*)((const char*)src + lane * 16), (LAS unsigned*)dst, 16, 0, 0); }
__device__ __forceinline__ f32x4 deq(const f32x4& a, float, const f32x4&) { return a; }
__device__ __forceinline__ f32x4 deq(const i32x4& a, float rs, const f32x4& cs) { return __builtin_convertvector(a, f32x4) * rs * cs; }
struct EpiInproj {
    static constexpr bool MID = false;
    bf16_t* P; bf16_t* G; float* ssq; const int* pos; const float* rsc; const float* csc;
    __device__ __forceinline__ void stage(LAS unsigned char* d, const Unit& u, int wid, int lane) const {
        if (wid == 0) { stage1k(rsc + u.pm * 256, d, lane); stage1k(csc + u.pn * 256, d + 1024, lane); stage1k(pos + u.pm * 256, d + 2048, lane); } }
    template <class AV> __device__ __forceinline__ void operator()(const AV (&acc)[2][2][4][2], const Unit& u, int wr, int wc, int fr, int fq, const LAS unsigned char* esc) const {
        const int pn = u.pn, row0 = u.pm * 256 + wr * 64 + fr;
        f32x4 cs[2][2];
#pragma unroll
        for (int bj = 0; bj < 2; ++bj)
#pragma unroll
            for (int n = 0; n < 2; ++n) cs[bj][n] = *(const LAS f32x4*)(esc + 1024 + (bj * 128 + wc * 32 + n * 16 + fq * 4) * 4);
        float rs8[2][4], pf8[2][4];
#pragma unroll
        for (int ai = 0; ai < 2; ++ai)
#pragma unroll
            for (int m = 0; m < 4; ++m) { const int rl = ai * 128 + wr * 64 + m * 16 + fr; rs8[ai][m] = *(const LAS float*)(esc + rl * 4); pf8[ai][m] = (float)*(const LAS int*)(esc + 2048 + rl * 4); }
#define DQ(ai, bj, m, n) deq(acc[ai][bj][m][n], rs, cs[bj][n])
        if (pn >= 7) {
#pragma unroll
            for (int ai = 0; ai < 2; ++ai)
#pragma unroll
                for (int m = 0; m < 4; ++m) { const int row = row0 + ai * 128 + m * 16; const float rs = rs8[ai][m]; u32x4 w;
#pragma unroll
                    for (int bj = 0; bj < 2; ++bj) { f32x4 a = DQ(ai, bj, m, 0), b = DQ(ai, bj, m, 1);
#pragma unroll
                        for (int j = 0; j < 4; ++j) { a[j] = fast_sigmoid(a[j]) * 255.0f; b[j] = fast_sigmoid(b[j]) * 255.0f; }
                        const unsigned wa_ = (unsigned)__float2int_rn(a[0]) | ((unsigned)__float2int_rn(a[1]) << 8) | ((unsigned)__float2int_rn(a[2]) << 16) | ((unsigned)__float2int_rn(a[3]) << 24);
                        const unsigned wb_ = (unsigned)__float2int_rn(b[0]) | ((unsigned)__float2int_rn(b[1]) << 8) | ((unsigned)__float2int_rn(b[2]) << 16) | ((unsigned)__float2int_rn(b[3]) << 24);
                        if (bj == 0) { w.x = wa_; w.y = wb_; } else { w.z = wa_; w.w = wb_; } }
                    *(u32x4*)((unsigned char*)G + (size_t)row * GW + (pn - 7) * 256 + wc * 64 + fq * 16) = w; }
        } else if (pn >= 5 || pn == 3) {
            const float sc = (pn == 3) ? 1.0f : C_M;
#pragma unroll
            for (int ai = 0; ai < 2; ++ai)
#pragma unroll
                for (int m = 0; m < 4; ++m) { const int row = row0 + ai * 128 + m * 16; const float rs = rs8[ai][m]; float s = 0.f;
#pragma unroll
                    for (int bj = 0; bj < 2; ++bj) { const f32x4 a = DQ(ai, bj, m, 0) * sc, b = DQ(ai, bj, m, 1) * sc;
                        s += (a[0] * a[0] + a[1] * a[1]) + (a[2] * a[2] + a[3] * a[3]) + (b[0] * b[0] + b[1] * b[1]) + (b[2] * b[2] + b[3] * b[3]);
                        *(u32x4*)(P + (size_t)row * PW + pn * 256 + bj * 128 + wc * 32 + fq * 8) = pack8(a, b); }
                    if (pn == 3) { s += __shfl_xor(s, 16); s += __shfl_xor(s, 32); if (fq == 0) ssq[(size_t)row * 8 + wc] = s; } }
        } else if (pn == 4) {
#pragma unroll
            for (int ai = 0; ai < 2; ++ai)
#pragma unroll
                for (int m = 0; m < 4; ++m) { const int row = row0 + ai * 128 + m * 16; const float rs = rs8[ai][m];
                    { const f32x4 a = DQ(ai, 0, m, 0), b = DQ(ai, 0, m, 1);
                      float s = (a[0] * a[0] + a[1] * a[1]) + (a[2] * a[2] + a[3] * a[3]) + (b[0] * b[0] + b[1] * b[1]) + (b[2] * b[2] + b[3] * b[3]);
                      *(u32x4*)(P + (size_t)row * PW + P_CKV + wc * 32 + fq * 8) = pack8(a, b);
                      s += __shfl_xor(s, 16); s += __shfl_xor(s, 32); if (fq == 0) ssq[(size_t)row * 8 + 4 + wc] = s; }
                    if (wc == 0) { const f32x4 x1 = DQ(ai, 1, m, 0), x2 = DQ(ai, 1, m, 1); const float pf = pf8[ai][m]; f32x4 o1, o2;
#pragma unroll
                        for (int j = 0; j < 4; ++j) { float c, s; rot_cs(pf, 2 * (4 * fq + j), c, s); o1[j] = x1[j] * c - x2[j] * s; o2[j] = x2[j] * c + x1[j] * s; }
                        *(u32x2*)(P + (size_t)row * PW + P_KR + 4 * fq) = pack4(o1); *(u32x2*)(P + (size_t)row * PW + P_KR + 16 + 4 * fq) = pack4(o2); } }
        } else {
            const float sc = (pn < 2) ? C_A : 1.0f; const int i0 = 16 * (wc & 1) + 4 * fq;
#pragma unroll
            for (int ai = 0; ai < 2; ++ai)
#pragma unroll
                for (int m = 0; m < 4; ++m) { const int row = row0 + ai * 128 + m * 16; const float rs = rs8[ai][m]; const float pf = pf8[ai][m]; f32x4 c, s;
#pragma unroll
                    for (int j = 0; j < 4; ++j) { float cc, ss; rot_cs(pf, i0 + j, cc, ss); c[j] = cc * sc; s[j] = ss * sc; }
#pragma unroll
                    for (int bj = 0; bj < 2; ++bj) { const f32x4 x1 = DQ(ai, bj, m, 0), x2 = DQ(ai, bj, m, 1);
                        if (pn == 2 && bj == 1) { *(u32x4*)(P + (size_t)row * PW + P_VA + wc * 32 + fq * 8) = pack8(x1, x2); }
                        else { const f32x4 o1 = x1 * c - x2 * s, o2 = x2 * c + x1 * s; bf16_t* d = P + (size_t)row * PW + pn * 256 + 64 * (2 * bj + (wc >> 1)) + i0;
                            *(u32x2*)d = pack4(o1); *(u32x2*)(d + 32) = pack4(o2); } } }
        }
#undef DQ
    }
};
struct EpiUp {
    static constexpr bool MID = false;
    __device__ __forceinline__ void stage(LAS unsigned char*, const Unit&, int, int) const {}
    bf16_t* QB; bf16_t* KVB; const float* ssq; const int* pos;
    __device__ __forceinline__ void operator()(const AccT& acc, const Unit& u, int wr, int wc, int fr, int fq, const LAS unsigned char*) const {
        const int pn = u.pn, row0 = u.pm * 256 + wr * 64 + fr;
        float rs8[2][4], pf8[2][4];
#pragma unroll
        for (int ai = 0; ai < 2; ++ai)
#pragma unroll
            for (int m = 0; m < 4; ++m) { const int row = row0 + ai * 128 + m * 16; const f32x4 sv = *(const f32x4*)(ssq + (size_t)row * 8 + (pn < 3 ? 0 : 4));
                rs8[ai][m] = (pn < 3 ? C_B : 1.0f) / sqrtf(((sv[0] + sv[1]) + (sv[2] + sv[3])) * (pn < 3 ? 1.0f / 256.0f : 1.0f / 128.0f) + EPS); pf8[ai][m] = (pn < 3) ? (float)pos[row] : 0.f; }
#pragma unroll
        for (int ai = 0; ai < 2; ++ai)
#pragma unroll
            for (int m = 0; m < 4; ++m) { const int row = row0 + ai * 128 + m * 16; const float rs = rs8[ai][m];
                if (pn < 3) {
#pragma unroll
                    for (int bj = 0; bj < 2; ++bj) { const int gg = 8 * pn + 4 * bj + wc; const f32x4 x1 = acc[ai][bj][m][0] * rs, x2 = acc[ai][bj][m][1] * rs;
                        if (gg % 3 == 2) { const float pf = pf8[ai][m]; f32x4 o1, o2;
#pragma unroll
                            for (int j = 0; j < 4; ++j) { float c, s; rot_cs(pf, 2 * (4 * fq + j), c, s); o1[j] = x1[j] * c - x2[j] * s; o2[j] = x2[j] * c + x1[j] * s; }
                            bf16_t* d = QB + (size_t)row * QBW + 32 * gg + 4 * fq; *(u32x2*)d = pack4(o1); *(u32x2*)(d + 16) = pack4(o2); }
                        else *(u32x4*)(QB + (size_t)row * QBW + 32 * gg + 8 * fq) = pack8(x1, x2); }
                } else {
#pragma unroll
                    for (int bj = 0; bj < 2; ++bj) *(u32x4*)(KVB + (size_t)row * KVW + (pn - 3) * 256 + bj * 128 + wc * 32 + fq * 8) = pack8(acc[ai][bj][m][0] * rs, acc[ai][bj][m][1] * rs);
                } }
    }
};
struct EpiPlain {
    static constexpr bool MID = false;
    __device__ __forceinline__ void stage(LAS unsigned char*, const Unit&, int, int) const {}
    bf16_t* O; int ldo;
    __device__ __forceinline__ void operator()(const AccT& acc, const Unit& u, int wr, int wc, int fr, int fq, const LAS unsigned char*) const {
        const int row0 = u.pm * 256 + wr * 64 + fr;
#pragma unroll
        for (int ai = 0; ai < 2; ++ai)
#pragma unroll
            for (int m = 0; m < 4; ++m)
#pragma unroll
                for (int bj = 0; bj < 2; ++bj) *(u32x4*)(O + (size_t)(row0 + ai * 128 + m * 16) * ldo + u.pn * 256 + bj * 128 + wc * 32 + fq * 8) = pack8(acc[ai][bj][m][0], acc[ai][bj][m][1]);
    }
};
struct EpiBranch {
    static constexpr bool MID = true;
    const unsigned char* G; bf16_t* MIXED;
    __device__ __forceinline__ void stage(LAS unsigned char*, const Unit&, int, int) const {}
    static __device__ __forceinline__ float gq(unsigned w, int b) { const float f = (float)((w >> (8 * b)) & 255u); return fmaxf(f, 2.55e-4f); }
    __device__ __forceinline__ void mid(AccT& acc, const Unit& u, int seg  , int wr, int wc, int fr, int fq) const {
        const int row0 = opq_v(u.pm * 256 + wr * 64 + fr);
#pragma unroll
        for (int ai = 0; ai < 2; ++ai) {
            u32x4 ga[4], gb[4];
#pragma unroll
            for (int m = 0; m < 4; ++m) { const unsigned char* gp = G + (size_t)(row0 + ai * 128 + m * 16) * GW + u.pn * 256 + wc * 64 + fq * 16;
                ga[m] = *(const u32x4*)(gp + (seg - 1) * 1024); gb[m] = *(const u32x4*)(gp + seg * 1024); }
#pragma unroll
            for (int m = 0; m < 4; ++m) {
#pragma unroll
                for (int j = 0; j < 4; ++j) {
                    acc[ai][0][m][0][j] *= gq(ga[m].x, j) * __builtin_amdgcn_rcpf(gq(gb[m].x, j)); acc[ai][0][m][1][j] *= gq(ga[m].y, j) * __builtin_amdgcn_rcpf(gq(gb[m].y, j));
                    acc[ai][1][m][0][j] *= gq(ga[m].z, j) * __builtin_amdgcn_rcpf(gq(gb[m].z, j)); acc[ai][1][m][1][j] *= gq(ga[m].w, j) * __builtin_amdgcn_rcpf(gq(gb[m].w, j)); } }
            asm volatile("" ::: "memory"); }
    }
    __device__ __forceinline__ void operator()(const AccT& acc, const Unit& u, int wr, int wc, int fr, int fq, const LAS unsigned char*) const {
        const int row0 = u.pm * 256 + wr * 64 + fr;
#pragma unroll
        for (int ai = 0; ai < 2; ++ai) {
            u32x4 gw[4];
#pragma unroll
            for (int m = 0; m < 4; ++m) gw[m] = *(const u32x4*)(G + (size_t)(row0 + ai * 128 + m * 16) * GW + 2048 + u.pn * 256 + wc * 64 + fq * 16);
#pragma unroll
            for (int m = 0; m < 4; ++m) { f32x4 a0 = acc[ai][0][m][0], b0 = acc[ai][0][m][1], a1 = acc[ai][1][m][0], b1 = acc[ai][1][m][1];
#pragma unroll
                for (int j = 0; j < 4; ++j) { a0[j] *= gq(gw[m].x, j) * (1.0f / 255.0f); b0[j] *= gq(gw[m].y, j) * (1.0f / 255.0f); a1[j] *= gq(gw[m].z, j) * (1.0f / 255.0f); b1[j] *= gq(gw[m].w, j) * (1.0f / 255.0f); }
                bf16_t* d = MIXED + (size_t)(row0 + ai * 128 + m * 16) * DM + u.pn * 256 + wc * 64 + fq * 16;
                *(u32x4*)d = pack8(a0, b0); *(u32x4*)(d + 8) = pack8(a1, b1); }
            asm volatile("" ::: "memory"); }
    }
};
struct EpiResid {
    static constexpr bool MID = false;
    __device__ __forceinline__ void stage(LAS unsigned char*, const Unit&, int, int) const {}
    const float* Xf; bf16_t* X;
    __device__ __forceinline__ void operator()(const AccT& acc, const Unit& u, int wr, int wc, int fr, int fq, const LAS unsigned char*) const {
        const int row0 = u.pm * 256 + wr * 64 + fr;
#pragma unroll
        for (int ai = 0; ai < 2; ++ai) {
            f32x4 xa[4][2], xb[4][2];
#pragma unroll
            for (int m = 0; m < 4; ++m)
#pragma unroll
                for (int bj = 0; bj < 2; ++bj) { const size_t o = (size_t)(row0 + ai * 128 + m * 16) * DM + u.pn * 256 + bj * 128 + wc * 32 + fq * 8;
                    if (Xf) { xa[m][bj] = *(const f32x4*)(Xf + o); xb[m][bj] = *(const f32x4*)(Xf + o + 4); }
                    else { const u32x4 q = *(const u32x4*)(X + o); xa[m][bj] = (f32x4){bflo(q.x), bfhi(q.x), bflo(q.y), bfhi(q.y)}; xb[m][bj] = (f32x4){bflo(q.z), bfhi(q.z), bflo(q.w), bfhi(q.w)}; } }
#pragma unroll
            for (int m = 0; m < 4; ++m)
#pragma unroll
                for (int bj = 0; bj < 2; ++bj) *(u32x4*)(X + (size_t)(row0 + ai * 128 + m * 16) * DM + u.pn * 256 + bj * 128 + wc * 32 + fq * 8) = pack8(xa[m][bj] + acc[ai][bj][m][0], xb[m][bj] + acc[ai][bj][m][1]);
            asm volatile("" ::: "memory"); }
    }
};
struct EpiSwiglu {
    static constexpr bool MID = false;
    bf16_t* ACT; int lo; const float* rsc; const float* csc;
    __device__ __forceinline__ void stage(LAS unsigned char* d, const Unit& u, int wid, int lane) const {
        if (wid == 0) { stage1k(rsc + u.pm * 256, d, lane); stage1k(csc + (size_t)u.aux * 2 * DFF + u.pn * 256, d + 1024, lane); } }
    template <class AV> __device__ __forceinline__ void operator()(const AV (&acc)[2][2][4][2], const Unit& u, int wr, int wc, int fr, int fq, const LAS unsigned char* esc) const {
        const int row0 = (u.pm - lo) * 256 + wr * 64 + fr;
        f32x4 cs[2][2];
#pragma unroll
        for (int bj = 0; bj < 2; ++bj)
#pragma unroll
            for (int n = 0; n < 2; ++n) cs[bj][n] = *(const LAS f32x4*)(esc + 1024 + (bj * 128 + wc * 32 + n * 16 + fq * 4) * 4);
        float rs8[2][4];
#pragma unroll
        for (int ai = 0; ai < 2; ++ai)
#pragma unroll
            for (int m = 0; m < 4; ++m) rs8[ai][m] = *(const LAS float*)(esc + (ai * 128 + wr * 64 + m * 16 + fr) * 4);
#pragma unroll
        for (int ai = 0; ai < 2; ++ai)
#pragma unroll
            for (int m = 0; m < 4; ++m) { const float rs = rs8[ai][m]; f32x4 a, b;
                const f32x4 g0 = deq(acc[ai][0][m][0], rs, cs[0][0]), g1 = deq(acc[ai][0][m][1], rs, cs[0][1]), u0 = deq(acc[ai][1][m][0], rs, cs[1][0]), u1 = deq(acc[ai][1][m][1], rs, cs[1][1]);
#pragma unroll
                for (int j = 0; j < 4; ++j) { a[j] = g0[j] * fast_sigmoid(g0[j]) * u0[j]; b[j] = g1[j] * fast_sigmoid(g1[j]) * u1[j]; }
                *(u32x4*)(ACT + (size_t)(row0 + ai * 128 + m * 16) * DFF + u.pn * 128 + wc * 32 + fq * 8) = pack8(a, b); }
    }
};
struct EpiYout {
    static constexpr bool MID = false;
    __device__ __forceinline__ void stage(LAS unsigned char*, const Unit&, int, int) const {}
    bf16_t* Y;
    __device__ __forceinline__ void operator()(const AccT& acc, const Unit& u, int wr, int wc, int fr, int fq, const LAS unsigned char*) const {
        const int row0 = u.pm * 256 + wr * 64 + fr;
#pragma unroll
        for (int ai = 0; ai < 2; ++ai)
#pragma unroll
            for (int m = 0; m < 4; ++m)
#pragma unroll
                for (int bj = 0; bj < 2; ++bj) *(u32x4*)(Y + (size_t)(row0 + ai * 128 + m * 16) * DM + u.pn * 256 + bj * 128 + wc * 32 + fq * 8) = pack8(acc[ai][bj][m][0], acc[ai][bj][m][1]);
    }
};

namespace att {
__device__ __forceinline__ int crow(int r, int hi) { return (r & 3) + 8 * (r >> 2) + 4 * hi; }
__device__ __forceinline__ void glds16(const void* gsrc, unsigned lds_dst) { unsigned keep;
    asm volatile("s_mov_b32 %0, m0\n\ts_mov_b32 m0, %2\n\ts_nop 0\n\tglobal_load_lds_dwordx4 %1, off\n\ts_mov_b32 m0, %0" : "=&s"(keep) : "v"(gsrc), "s"(lds_dst) : "memory"); }
__device__ __forceinline__ float swapmax(float m) { auto rr = __builtin_amdgcn_permlane32_swap(__float_as_uint(m), __float_as_uint(m), false, false); return fmaxf(__uint_as_float(rr[0]), __uint_as_float(rr[1])); }
__device__ __forceinline__ float swapsum(float m) { auto rr = __builtin_amdgcn_permlane32_swap(__float_as_uint(m), __float_as_uint(m), false, false); return __uint_as_float(rr[0]) + __uint_as_float(rr[1]); }
__device__ __forceinline__ void store_o_block(const f32x16& o, float linv, bf16_t* rowp  , int hi) {
#pragma unroll
    for (int rp = 0; rp < 2; ++rp) {
        const u32x2 X = pack4((f32x4){o[8 * rp] * linv, o[8 * rp + 1] * linv, o[8 * rp + 2] * linv, o[8 * rp + 3] * linv});
        const u32x2 Y = pack4((f32x4){o[8 * rp + 4] * linv, o[8 * rp + 5] * linv, o[8 * rp + 6] * linv, o[8 * rp + 7] * linv});
        const auto s0 = __builtin_amdgcn_permlane32_swap(X.x, Y.x, false, false), s1 = __builtin_amdgcn_permlane32_swap(X.y, Y.y, false, false);
        const u32x4 w = {s0[0], s1[0], s0[1], s1[1]};
        *(u32x4*)(rowp + 8 * (2 * rp + hi)) = w; }
}
__device__ __forceinline__ s16x4 vtr(unsigned addr) { s16x4 r; asm volatile("ds_read_b64_tr_b16 %0, %1" : "=&v"(r) : "v"(addr) : "memory"); return r; }
#define VTRO(dst, base, off) asm volatile("ds_read_b64_tr_b16 %0, %1 offset:%c2" : "=&v"(dst) : "v"(base), "i"(off) : "memory")

struct Src {
    const bf16_t* q; int qpitch;
    const bf16_t* k0; int k0pitch;
    const bf16_t* k1; int k1pitch;
    const bf16_t* v; int vpitch;
    bf16_t* o; int opitch;
};
template <int NKC, int NVB, int RD = 4>
__device__ __forceinline__ void dma_tile(const Src& S, int t, int slot, unsigned lds0, int wid, int lane) {
    constexpr int KS = NKC * 1024, VS = NVB * 4096, LDS_K = 0, LDS_V = RD * KS;
#pragma unroll
    for (int c = 0; c < (NKC + 7) / 8; ++c) { const int ch = wid + 8 * c; if (ch < NKC) {
        const bf16_t* src = (ch < 8) ? S.k0 + (size_t)(t * 64 + lane) * S.k0pitch + ch * 8 : S.k1 + (size_t)(t * 64 + lane) * S.k1pitch + (ch - 8) * 8;
        glds16(src, (unsigned)__builtin_amdgcn_readfirstlane(lds0 + LDS_K + slot * KS + ch * 1024)); } }
#pragma unroll
    for (int c = 0; c < (NVB * 4 + 7) / 8; ++c) { const int p = wid + 8 * c; if (p < NVB * 4) {
        const bf16_t* src = S.v + (size_t)(t * 64 + 16 * (p & 3) + (lane >> 2)) * S.vpitch + (p >> 2) * 32 + (lane & 3) * 8;
        glds16(src, (unsigned)__builtin_amdgcn_readfirstlane(lds0 + LDS_V + slot * VS + p * 1024)); } }
}
__device__ __forceinline__ void wait_vm_bar(int n) {
    if (n >= 4) asm volatile("s_waitcnt vmcnt(4) lgkmcnt(0)\n\ts_barrier" ::: "memory");
    else if (n == 3) asm volatile("s_waitcnt vmcnt(3) lgkmcnt(0)\n\ts_barrier" ::: "memory");
    else if (n == 2) asm volatile("s_waitcnt vmcnt(2) lgkmcnt(0)\n\ts_barrier" ::: "memory");
    else if (n == 1) asm volatile("s_waitcnt vmcnt(1) lgkmcnt(0)\n\ts_barrier" ::: "memory");
    else asm volatile("s_waitcnt vmcnt(0) lgkmcnt(0)\n\ts_barrier" ::: "memory");
}
template <int NKC, int NVB, int MODE>
__device__ __forceinline__ void unit(LAS unsigned char* lds, const Src& S, int t_lo, int t_hi, int qpos0  , float sink_l2) {
    constexpr int KS = NKC * 1024, VS = NVB * 4096, RD = 4, LDS_K = 0, LDS_V = RD * KS;
    const int tid = opq_v((int)threadIdx.x), lane = tid & 63, r32 = lane & 31, hi = lane >> 5; const int wid = __builtin_amdgcn_readfirstlane(tid >> 6), grp = wid >> 2;
    const unsigned lds0 = (unsigned)(uintptr_t)lds;
    const int ops = (NKC + 7 - wid) / 8 + (NVB * 4) / 8;
    bf16x8 qr[NKC / 2];
#pragma unroll
    for (int d0 = 0; d0 < NKC / 2; ++d0) qr[d0] = *(const bf16x8*)(S.q + (size_t)r32 * S.qpitch + d0 * 16 + hi * 8);
    float m_run = (MODE == 0) ? sink_l2 : -INFINITY, l_run = (MODE == 0 && hi == 0) ? 1.0f : 0.0f;
    f32x16 o[NVB];
#pragma unroll
    for (int d = 0; d < NVB; ++d) o[d] = f32x16{};
    const int qi = qpos0 + wid * 32 + r32, qw0 = qpos0 + wid * 32;
    f32x16 p0 = f32x16{}, p1 = f32x16{};
#define AT_ACTIVE(t) ((MODE != 0) || ((64 * (t) + 63 >= qw0 - 128) && (64 * (t) <= qw0 + 31 + 128)))
#define AT_QK(t) do { const LAS unsigned char* kb_ = lds + LDS_K + (((t) - t_lo) % RD) * KS + hi * 1024 + r32 * 16; p0 = f32x16{}; p1 = f32x16{}; \
        _Pragma("unroll") for (int d0 = 0; d0 < NKC / 2; ++d0) { const bf16x8 b0_ = *(const LAS bf16x8*)(kb_ + d0 * 2048), b1_ = *(const LAS bf16x8*)(kb_ + d0 * 2048 + 512); \
            p0 = __builtin_amdgcn_mfma_f32_32x32x16_bf16(b0_, qr[d0], p0, 0, 0, 0); p1 = __builtin_amdgcn_mfma_f32_32x32x16_bf16(b1_, qr[d0], p1, 0, 0, 0); } } while (0)
#define AT_SMPV(t) do { \
        if (MODE == 0) { _Pragma("unroll") for (int r = 0; r < 16; ++r) { const int kv_ = 64 * (t) + crow(r, hi); int e0_ = kv_ - qi; e0_ = e0_ < 0 ? -e0_ : e0_; int e1_ = kv_ + 32 - qi; e1_ = e1_ < 0 ? -e1_ : e1_; \
            if (e0_ > 128) p0[r] = -INFINITY; if (e1_ > 128) p1[r] = -INFINITY; } } \
        float mx_[8]; _Pragma("unroll") for (int r = 0; r < 8; ++r) mx_[r] = fmaxf(fmaxf(p0[r], p0[r + 8]), fmaxf(p1[r], p1[r + 8])); \
        float rm_ = fmaxf(fmaxf(fmaxf(mx_[0], mx_[1]), fmaxf(mx_[2], mx_[3])), fmaxf(fmaxf(mx_[4], mx_[5]), fmaxf(mx_[6], mx_[7]))); rm_ = swapmax(rm_); \
        if (__any(rm_ > m_run)) { const float mn_ = fmaxf(m_run, rm_), alpha_ = __builtin_amdgcn_exp2f(m_run - mn_); m_run = mn_; l_run *= alpha_; \
            _Pragma("unroll") for (int d = 0; d < NVB; ++d) _Pragma("unroll") for (int r = 0; r < 16; ++r) o[d][r] *= alpha_; } \
        float sm_[4] = {0.f, 0.f, 0.f, 0.f}; \
        _Pragma("unroll") for (int r = 0; r < 16; ++r) { p0[r] = __builtin_amdgcn_exp2f(p0[r] - m_run); p1[r] = __builtin_amdgcn_exp2f(p1[r] - m_run); sm_[r & 3] += p0[r] + p1[r]; } \
        l_run += (sm_[0] + sm_[1]) + (sm_[2] + sm_[3]); \
        u32x4 pw_[4]; \
        pw_[0] = (u32x4){cvtpk(p0[0], p0[1]), cvtpk(p0[2], p0[3]), cvtpk(p0[4], p0[5]), cvtpk(p0[6], p0[7])}; pw_[1] = (u32x4){cvtpk(p0[8], p0[9]), cvtpk(p0[10], p0[11]), cvtpk(p0[12], p0[13]), cvtpk(p0[14], p0[15])}; \
        pw_[2] = (u32x4){cvtpk(p1[0], p1[1]), cvtpk(p1[2], p1[3]), cvtpk(p1[4], p1[5]), cvtpk(p1[6], p1[7])}; pw_[3] = (u32x4){cvtpk(p1[8], p1[9]), cvtpk(p1[10], p1[11]), cvtpk(p1[12], p1[13]), cvtpk(p1[14], p1[15])}; \
        const unsigned vb_ = lds0 + LDS_V + (((t) - t_lo) % RD) * VS + ((lane >> 4) & 1) * 32 + (lane & 3) * 8 + (4 * hi + ((lane & 15) >> 2)) * 64; \
        _Pragma("unroll") for (int dp = 0; dp < NVB; dp += 2) { s16x4 lo_[2][4], hh_[2][4]; \
            _Pragma("unroll") for (int dd = 0; dd < 2; ++dd) _Pragma("unroll") for (int ks = 0; ks < 4; ++ks) { lo_[dd][ks] = vtr(vb_ + (dp + dd) * 4096 + ks * 1024); hh_[dd][ks] = vtr(vb_ + (dp + dd) * 4096 + ks * 1024 + 512); } \
            asm volatile("s_waitcnt lgkmcnt(0)" ::: "memory"); __builtin_amdgcn_sched_barrier(0); \
            _Pragma("unroll") for (int ks = 0; ks < 4; ++ks) _Pragma("unroll") for (int dd = 0; dd < 2; ++dd) { \
                const bf16x8 vf_ = (bf16x8){lo_[dd][ks][0], lo_[dd][ks][1], lo_[dd][ks][2], lo_[dd][ks][3], hh_[dd][ks][0], hh_[dd][ks][1], hh_[dd][ks][2], hh_[dd][ks][3]}; \
                o[dp + dd] = __builtin_amdgcn_mfma_f32_32x32x16_bf16(vf_, __builtin_bit_cast(bf16x8, pw_[ks]), o[dp + dd], 0, 0, 0); } } } while (0)
    dma_tile<NKC, NVB>(S, t_lo, 0, lds0, wid, lane);
    if (t_lo + 1 < t_hi) dma_tile<NKC, NVB>(S, t_lo + 1, 1, lds0, wid, lane);
    for (int t = t_lo; t < t_hi; ++t) {
        wait_vm_bar((t + 1 < t_hi) ? ops : 0);
        if (t + 2 < t_hi) dma_tile<NKC, NVB>(S, t + 2, (t + 2 - t_lo) % RD, lds0, wid, lane);
        if (grp == 0) { if (AT_ACTIVE(t)) { AT_QK(t); AT_SMPV(t); } }
        else { if (t > t_lo && AT_ACTIVE(t - 1)) AT_SMPV(t - 1); if (AT_ACTIVE(t)) AT_QK(t); }
    }
    if (grp == 1 && AT_ACTIVE(t_hi - 1)) AT_SMPV(t_hi - 1);
    const float linv = 1.0f / swapsum(l_run);
#pragma unroll
    for (int d = 0; d < NVB; ++d) store_o_block(o[d], linv, S.o + (size_t)r32 * S.opitch + 32 * d, hi);
    asm volatile("s_waitcnt lgkmcnt(0)\n\ts_barrier" ::: "memory");
#undef AT_ACTIVE
#undef AT_QK
#undef AT_SMPV
}

template <int NKC, int NVB>
__device__ __forceinline__ void unit_q64(LAS unsigned char* lds, const Src& S, int t_lo, int t_hi) {
    constexpr int KS = NKC * 1024, VS = NVB * 4096, RD = 4, LDS_K = 0, LDS_V = RD * KS;
    const int tid = opq_v((int)threadIdx.x), lane = tid & 63, r32 = lane & 31, hi = lane >> 5; const int wid = __builtin_amdgcn_readfirstlane(tid >> 6);
    const unsigned lds0 = (unsigned)(uintptr_t)lds;
    const int ops = (NKC + 7 - wid) / 8 + (NVB * 4) / 8;
    bf16x8 qa[NKC / 2], qb[NKC / 2];
#pragma unroll
    for (int d0 = 0; d0 < NKC / 2; ++d0) { qa[d0] = *(const bf16x8*)(S.q + (size_t)r32 * S.qpitch + d0 * 16 + hi * 8); qb[d0] = *(const bf16x8*)(S.q + (size_t)(32 + r32) * S.qpitch + d0 * 16 + hi * 8); }
    float ma = -INFINITY, la = 0.f, mb = -INFINITY, lb = 0.f;
    f32x16 oa[NVB], ob[NVB];
#pragma unroll
    for (int d = 0; d < NVB; ++d) { oa[d] = f32x16{}; ob[d] = f32x16{}; }
#define Q64_SM(P0, P1, M, L, O, PW) do { \
        float mx_[8]; _Pragma("unroll") for (int r = 0; r < 8; ++r) mx_[r] = fmaxf(fmaxf(P0[r], P0[r + 8]), fmaxf(P1[r], P1[r + 8])); \
        float rm_ = fmaxf(fmaxf(fmaxf(mx_[0], mx_[1]), fmaxf(mx_[2], mx_[3])), fmaxf(fmaxf(mx_[4], mx_[5]), fmaxf(mx_[6], mx_[7]))); rm_ = swapmax(rm_); \
        if (__any(rm_ > M)) { const float mn_ = fmaxf(M, rm_), alpha_ = __builtin_amdgcn_exp2f(M - mn_); M = mn_; L *= alpha_; \
            _Pragma("unroll") for (int d = 0; d < NVB; ++d) _Pragma("unroll") for (int r = 0; r < 16; ++r) O[d][r] *= alpha_; } \
        float sm_[4] = {0.f, 0.f, 0.f, 0.f}; \
        _Pragma("unroll") for (int r = 0; r < 16; ++r) { P0[r] = __builtin_amdgcn_exp2f(P0[r] - M); P1[r] = __builtin_amdgcn_exp2f(P1[r] - M); sm_[r & 3] += P0[r] + P1[r]; } \
        L += (sm_[0] + sm_[1]) + (sm_[2] + sm_[3]); \
        PW[0] = (u32x4){cvtpk(P0[0], P0[1]), cvtpk(P0[2], P0[3]), cvtpk(P0[4], P0[5]), cvtpk(P0[6], P0[7])}; PW[1] = (u32x4){cvtpk(P0[8], P0[9]), cvtpk(P0[10], P0[11]), cvtpk(P0[12], P0[13]), cvtpk(P0[14], P0[15])}; \
        PW[2] = (u32x4){cvtpk(P1[0], P1[1]), cvtpk(P1[2], P1[3]), cvtpk(P1[4], P1[5]), cvtpk(P1[6], P1[7])}; PW[3] = (u32x4){cvtpk(P1[8], P1[9]), cvtpk(P1[10], P1[11]), cvtpk(P1[12], P1[13]), cvtpk(P1[14], P1[15])}; \
        __builtin_amdgcn_sched_barrier(0); } while (0)
#define Q64_SM_NB(P0, P1, M, L, O, PW) do { \
        float mx_[8]; _Pragma("unroll") for (int r = 0; r < 8; ++r) mx_[r] = fmaxf(fmaxf(P0[r], P0[r + 8]), fmaxf(P1[r], P1[r + 8])); \
        float rm_ = fmaxf(fmaxf(fmaxf(mx_[0], mx_[1]), fmaxf(mx_[2], mx_[3])), fmaxf(fmaxf(mx_[4], mx_[5]), fmaxf(mx_[6], mx_[7]))); rm_ = swapmax(rm_); \
        if (__any(rm_ > M)) { const float mn_ = fmaxf(M, rm_), alpha_ = __builtin_amdgcn_exp2f(M - mn_); M = mn_; L *= alpha_; \
            _Pragma("unroll") for (int d = 0; d < NVB; ++d) _Pragma("unroll") for (int r = 0; r < 16; ++r) O[d][r] *= alpha_; } \
        float sm_[4] = {0.f, 0.f, 0.f, 0.f}; \
        _Pragma("unroll") for (int r = 0; r < 16; ++r) { P0[r] = __builtin_amdgcn_exp2f(P0[r] - M); P1[r] = __builtin_amdgcn_exp2f(P1[r] - M); sm_[r & 3] += P0[r] + P1[r]; } \
        L += (sm_[0] + sm_[1]) + (sm_[2] + sm_[3]); \
        PW[0] = (u32x4){cvtpk(P0[0], P0[1]), cvtpk(P0[2], P0[3]), cvtpk(P0[4], P0[5]), cvtpk(P0[6], P0[7])}; PW[1] = (u32x4){cvtpk(P0[8], P0[9]), cvtpk(P0[10], P0[11]), cvtpk(P0[12], P0[13]), cvtpk(P0[14], P0[15])}; \
        PW[2] = (u32x4){cvtpk(P1[0], P1[1]), cvtpk(P1[2], P1[3]), cvtpk(P1[4], P1[5]), cvtpk(P1[6], P1[7])}; PW[3] = (u32x4){cvtpk(P1[8], P1[9]), cvtpk(P1[10], P1[11]), cvtpk(P1[12], P1[13]), cvtpk(P1[14], P1[15])}; \
        } while (0)
    dma_tile<NKC, NVB, RD>(S, t_lo, 0, lds0, wid, lane);
    if (t_lo + 1 < t_hi) dma_tile<NKC, NVB, RD>(S, t_lo + 1, 1, lds0, wid, lane);
    for (int t = t_lo; t < t_hi; ++t) {
        const int slot = (t - t_lo) % RD;
        wait_vm_bar((t + 1 < t_hi) ? ops : 0);
        if (t + 2 < t_hi) dma_tile<NKC, NVB, RD>(S, t + 2, (t + 2 - t_lo) % RD, lds0, wid, lane);
        const LAS unsigned char* kb = lds + LDS_K + slot * KS + hi * 1024 + r32 * 16;
        f32x16 s0a = f32x16{}, s0b = f32x16{}, s1a = f32x16{}, s1b = f32x16{};
#pragma unroll
        for (int d0 = 0; d0 < NKC / 2; ++d0) {
            const bf16x8 b0 = *(const LAS bf16x8*)(kb + d0 * 2048), b1 = *(const LAS bf16x8*)(kb + d0 * 2048 + 512);
            s0a = __builtin_amdgcn_mfma_f32_32x32x16_bf16(b0, qa[d0], s0a, 0, 0, 0); s0b = __builtin_amdgcn_mfma_f32_32x32x16_bf16(b1, qa[d0], s0b, 0, 0, 0);
            s1a = __builtin_amdgcn_mfma_f32_32x32x16_bf16(b0, qb[d0], s1a, 0, 0, 0); s1b = __builtin_amdgcn_mfma_f32_32x32x16_bf16(b1, qb[d0], s1b, 0, 0, 0); }
        __builtin_amdgcn_sched_barrier(0);
        u32x4 pwa[4], pwb[4];
        const unsigned vb = lds0 + LDS_V + slot * VS + ((lane >> 4) & 1) * 32 + (lane & 3) * 8 + (4 * hi + ((lane & 15) >> 2)) * 64;
        s16x4 lo[NVB][4], hh[NVB][4];
#pragma unroll
        for (int d = 0; d < NVB; ++d)
#pragma unroll
            for (int ks = 0; ks < 4; ++ks) { VTRO(lo[d][ks], vb, d * 4096 + ks * 1024); VTRO(hh[d][ks], vb, d * 4096 + ks * 1024 + 512); }
        __builtin_amdgcn_sched_barrier(0);
        Q64_SM(s0a, s0b, ma, la, oa, pwa);
        asm volatile("s_waitcnt lgkmcnt(0)" ::: "memory"); __builtin_amdgcn_sched_barrier(0);
#pragma unroll
        for (int ks = 0; ks < 4; ++ks)
#pragma unroll
            for (int d = 0; d < NVB; ++d) { const bf16x8 vf = (bf16x8){lo[d][ks][0], lo[d][ks][1], lo[d][ks][2], lo[d][ks][3], hh[d][ks][0], hh[d][ks][1], hh[d][ks][2], hh[d][ks][3]};
                oa[d] = __builtin_amdgcn_mfma_f32_32x32x16_bf16(vf, __builtin_bit_cast(bf16x8, pwa[ks]), oa[d], 0, 0, 0); }
        Q64_SM_NB(s1a, s1b, mb, lb, ob, pwb);
#pragma unroll
        for (int i = 0; i < 8; ++i) { __builtin_amdgcn_sched_group_barrier(0x008, 1, 0); __builtin_amdgcn_sched_group_barrier(0x002, 12, 0); }
        __builtin_amdgcn_sched_barrier(0);
#pragma unroll
        for (int ks = 0; ks < 4; ++ks)
#pragma unroll
            for (int d = 0; d < NVB; ++d) { const bf16x8 vf = (bf16x8){lo[d][ks][0], lo[d][ks][1], lo[d][ks][2], lo[d][ks][3], hh[d][ks][0], hh[d][ks][1], hh[d][ks][2], hh[d][ks][3]};
                ob[d] = __builtin_amdgcn_mfma_f32_32x32x16_bf16(vf, __builtin_bit_cast(bf16x8, pwb[ks]), ob[d], 0, 0, 0); }
        __builtin_amdgcn_sched_barrier(0);
    }
    const float lia = 1.0f / swapsum(la), lib = 1.0f / swapsum(lb);
#pragma unroll
    for (int d = 0; d < NVB; ++d) { store_o_block(oa[d], lia, S.o + (size_t)r32 * S.opitch + 32 * d, hi); store_o_block(ob[d], lib, S.o + (size_t)(32 + r32) * S.opitch + 32 * d, hi); }
    asm volatile("s_waitcnt lgkmcnt(0)\n\ts_barrier" ::: "memory");
#undef Q64_SM
#undef Q64_SM_NB
}

}
#define SC_AFTER_PROLOGUE() do {} while (0)
#define SC_AFTER_INPROJ(l) do {} while (0)
#define SC_AFTER_UP(l) do {} while (0)
#define SC_AFTER_MLA(l) do {} while (0)
#define SC_AFTER_BRANCH(l) do {} while (0)
#define SC_AFTER_WOUT(l) do {} while (0)
#define SC_AFTER_NORM2(l) do {} while (0)
#define SC_AFTER_GU(l) do {} while (0)
#define SC_AFTER_DOWN(l) do {} while (0)
#define SC_AFTER_ROUTE(l) do {} while (0)
#define SC_AFTER_MOEGU(l, h) do {} while (0)
#define SC_AFTER_MOED(l, h) do {} while (0)
#define SC_FINAL() do {} while (0)

struct Args { const float* in[23]; float* out; unsigned char* ws; };
#define WSP(type, off) ((type*)(F.ws + (off)))
#define PHASE() Frame Fp = F; Fp.ws = opq_p(F.ws); Fp.in = opq_p(F.in); Fp.out = opq_p(F.out); Fp.tid = opq_v((int)threadIdx.x); Fp.lane = Fp.tid & 63; Fp.wave = __builtin_amdgcn_readfirstlane(Fp.tid >> 6); (void)Fp
#define FWS(type, off) ((type*)(Fp.ws + (off)))
#define X_ FWS(bf16_t, WS_XB)
#define H_ FWS(bf16_t, WS_H)
#define Pb_ FWS(bf16_t, WS_R + R_P)
#define Gb_ FWS(bf16_t, WS_R + R_G)
#define QB_ FWS(bf16_t, WS_R + R_QB)
#define KVB_ FWS(bf16_t, WS_R + R_KVB)
#define Yb_ FWS(bf16_t, WS_R + R_Y)
#define MEMN_ FWS(bf16_t, WS_MEMN)
#define MEMKV_ FWS(bf16_t, WS_MEMKV)
#define ACT_ FWS(bf16_t, WS_R + R_ACT)
#define ASORT_ FWS(bf16_t, WS_R + R_ASORT)
#define YOUT_ FWS(bf16_t, WS_R + R_YOUT)
#define SSQ_ FWS(float, WS_MISC + MS_SSQ)
#define TEXP_ FWS(const int, WS_MISC + MS_TEXP)
#define POS_ ((const int*)Fp.in[I_POS])
#define HSC_ FWS(float, WS_MISC + MS_HSC)
#define ASC_ FWS(float, WS_MISC + MS_ASC)
#define WSIN_ FWS(float, WS_MISC + MS_WSIN)
#define WSGU_ FWS(float, WS_MISC + MS_WSGU)

#define GRID_BAR() xcd_barrier(bar)
#ifndef WGM_GU
#define WGM_GU 4
#endif
#ifndef WGM_IN
#define WGM_IN 4
#endif
template <int l> __device__ __forceinline__ void layer_body(const Frame& F, const XcdBarrier& bar, const int bx) {
        if (l > 0) {
            PHASE();
            prep_ffn_weights(Fp, l);
            if ((l & 1) != 0) norm_phase(Fp, nullptr, X_, Fp.in[I_GMIX] + l * DM, false, true);
            if ((l & 1) == 0) norm_phase(Fp, nullptr, X_, Fp.in[I_GMIX] + l * DM, true, true);
            GRID_BAR();
        }
        {   PHASE();
            ProbSimple p{DM, DM, DM, (const char*)H_, (const char*)wmix(Fp, l, WL_IN)}; pg8::StaticOrder S; S.init(T / 256, NT_IN, Fp.G, bx, 0, WGM_IN);
            EpiInproj E{Pb_, Gb_, SSQ_, POS_, HSC_, WSIN_ + l * NT_IN * 256}; pg8::gemm_phase<true>(Fp.lds, p, S, E); }
        if (l == 0) { PHASE();
            ProbSimple p{DM, DM * 2, DM * 2, (const char*)MEMN_, (const char*)FWS(bf16_t, WS_WMKV)}; pg8::StaticOrder S; S.init(NB * MEML / 256, 16, Fp.G, bx);
            EpiPlain E{MEMKV_, 4096}; pg8::gemm_phase(Fp.lds, p, S, E); }
        GRID_BAR();
        SC_AFTER_INPROJ(l);
        {   PHASE();
            ProbUp p{UPK, PW * 2, UPK * 2, (const char*)(Pb_ + P_CQ), (const char*)wmix(Fp, l, WL_UP)}; pg8::StaticOrder S; S.init(T / 256, UPN / 256, Fp.G, bx);
            EpiUp E{QB_, KVB_, SSQ_, POS_}; pg8::gemm_phase(Fp.lds, p, S, E); }
        {   PHASE();
            for (int i = Fp.vcu; i < 1024; i += Fp.G) {
                const int hl = i & 3, qb = (i >> 2) & 15, kvh = (i >> 6) & 1, b = i >> 7, h = kvh * 4 + hl; const size_t rowb = (size_t)b * SEQ; const int q0 = qb * 256;
                att::Src s; s.q = Pb_ + (rowb + q0 + Fp.wave * 32) * PW + P_QA + h * 64; s.qpitch = PW; s.k0 = Pb_ + rowb * PW + P_KA + kvh * 64; s.k0pitch = PW; s.k1 = s.k0; s.k1pitch = PW;
                s.v = Pb_ + rowb * PW + P_VA + kvh * 64; s.vpitch = PW; s.o = Yb_ + (rowb + q0 + Fp.wave * 32) * YW + h * 64; s.opitch = YW;
                const int t_lo = (q0 / 64 - 2) < 0 ? 0 : (q0 / 64 - 2), t_hi = (q0 / 64 + 6) > SEQ / 64 ? SEQ / 64 : (q0 / 64 + 6);
                att::unit<8, 2, 0>(Fp.lds, s, t_lo, t_hi, q0, Fp.in[I_SINK][l * 8 + h] * LOG2E);
            } }
        {   PHASE();
            for (int i = Fp.vcu; i < 512; i += Fp.G) {
                const int qb = i & 15, h = (i >> 4) & 3, b = i >> 6; const size_t rowq = (size_t)b * SEQ + qb * 256 + Fp.wave * 32;
                att::Src s; s.q = Pb_ + rowq * PW + P_QM + h * 128; s.qpitch = PW; s.k0 = MEMKV_ + (size_t)b * MEML * 4096 + l * 1024 + h * 128; s.k0pitch = 4096; s.k1 = s.k0 + 64; s.k1pitch = 4096;
                s.v = MEMKV_ + (size_t)b * MEML * 4096 + l * 1024 + 512 + h * 128; s.vpitch = 4096; s.o = Yb_ + rowq * YW + 1024 + h * 128; s.opitch = YW;
                att::unit<16, 4, 1>(Fp.lds, s, 0, MEML / 64, 0, 0.f);
            } }
        GRID_BAR();
        SC_AFTER_UP(l);
        {   PHASE();
            for (int i = Fp.vcu; i < 512; i += Fp.G) {
                const int qb = i & 7, h = (i >> 3) & 7, b = i >> 6; const size_t rowb = (size_t)b * SEQ, rowq = rowb + qb * 512 + Fp.wave * 64;
                att::Src s; s.q = QB_ + rowq * QBW + h * 96; s.qpitch = QBW; s.k0 = KVB_ + rowb * KVW + h * 128; s.k0pitch = KVW; s.k1 = Pb_ + rowb * PW + P_KR; s.k1pitch = PW;
                s.v = KVB_ + rowb * KVW + h * 128 + 64; s.vpitch = KVW; s.o = Yb_ + rowq * YW + 512 + h * 64; s.opitch = YW;
                att::unit_q64<12, 2>(Fp.lds, s, 0, SEQ / 64);
            } }
        GRID_BAR();
        SC_AFTER_MLA(l);
        {   PHASE();
            ProbSimple p{1536, YW * 2, 1536 * 2, (const char*)Yb_, (const char*)wmix(Fp, l, WL_BR)}; pg8::StaticOrder S; S.init(T / 256, DM / 256, Fp.G, bx);
            EpiBranch E{(const unsigned char*)Gb_, H_}; pg8::gemm_phase(Fp.lds, p, S, E); }
        GRID_BAR();
        SC_AFTER_BRANCH(l);
        if (l == 0) {   PHASE();
            ProbSimple p{DM, DM * 2, DM * 2, (const char*)H_, (const char*)wmix(Fp, l, WL_OUT)}; pg8::StaticOrder S; S.init(T / 256, DM / 256, Fp.G, bx);
            EpiResid E{Fp.in[I_X], X_}; pg8::gemm_phase(Fp.lds, p, S, E); }
        if (l != 0) {   PHASE();
            ProbSimple p{DM, DM * 2, DM * 2, (const char*)H_, (const char*)wmix(Fp, l, WL_OUT)}; pg8::StaticOrder S; S.init(T / 256, DM / 256, Fp.G, bx);
            EpiResid E{nullptr, X_}; pg8::gemm_phase(Fp.lds, p, S, E); }
        GRID_BAR();
        SC_AFTER_WOUT(l);
        if ((l & 1) == 0) {
            {   PHASE(); norm_phase(Fp, nullptr, X_, Fp.in[I_GFFN] + l * DM, false, GU_I8(l) != 0); }
            GRID_BAR();
            SC_AFTER_NORM2(l);
            {   PHASE();
                constexpr bool i8 = GU_I8(l) != 0; constexpr unsigned eb = i8 ? 1 : 2;
                ProbSimple p{DM, DM * eb, DM * eb, (const char*)H_, (const char*)FWS(bf16_t, WS_WFFN + WF_GU)}; pg8::StaticOrder S; S.init(T / 256, 2 * DFF / 256, Fp.G, bx, 0, WGM_GU);
                EpiSwiglu E{ACT_, 0, HSC_, WSGU_}; pg8::gemm_phase<i8>(Fp.lds, p, S, E); }
            GRID_BAR();
            SC_AFTER_GU(l);
            {   PHASE();
                ProbSimple p{DFF, DFF * 2, DFF * 2, (const char*)ACT_, (const char*)FWS(bf16_t, WS_WFFN + WF_D)}; pg8::StaticOrder S; S.init(T / 256, DM / 256, Fp.G, bx, 1);
                EpiResid E{nullptr, X_}; pg8::gemm_phase(Fp.lds, p, S, E); }
            GRID_BAR();
            SC_AFTER_DOWN(l);
        } else {
            {   PHASE(); norm_router_phase(Fp, X_, Fp.in[I_GFFN] + l * DM, Fp.in[I_WR] + (size_t)(l >> 1) * DM * NE, GU_I8(l) != 0); }
            GRID_BAR();
            {   PHASE(); moe_assign_phase(Fp, GU_I8(l) != 0); }
            GRID_BAR();
            SC_AFTER_ROUTE(l);
            {   constexpr int half = 0; (void)half;
                {   PHASE();
                    const int nrt = __builtin_amdgcn_readfirstlane(TEXP_[MAXRT]);
                    constexpr bool i8 = GU_I8(l) != 0; constexpr unsigned eb = i8 ? 1 : 2;
                    ProbMoe p{DM, DM * eb, DM * eb, (const char*)ASORT_, (const char*)FWS(bf16_t, WS_WFFN + WF_GU), 0}; MoeOrder S; S.base.init(nrt, 2 * DFF / 256, Fp.G, bx, 0, WGM_GU); S.lo = 0; S.texp = TEXP_;
                    EpiSwiglu E{ACT_, 0, ASC_, WSGU_}; pg8::gemm_phase<i8>(Fp.lds, p, S, E); }
                GRID_BAR();
                SC_AFTER_MOEGU(l, half);
                {   PHASE();
                    const int nrt = __builtin_amdgcn_readfirstlane(TEXP_[MAXRT]);
                    ProbMoe p{DFF, DFF * 2, DFF * 2, (const char*)ACT_, (const char*)FWS(bf16_t, WS_WFFN + WF_D), 0}; MoeOrder S; S.base.init(nrt, DM / 256, Fp.G, bx, 1); S.lo = 0; S.texp = TEXP_;
                    EpiYout E{YOUT_}; pg8::gemm_phase(Fp.lds, p, S, E); }
                GRID_BAR();
                SC_AFTER_MOED(l, half);
            }
        }
    }

__global__ void __launch_bounds__(NWAVES * 64, 2) fwd(Args args) {
    extern __shared__ __attribute__((aligned(16))) unsigned char lds_raw[];
    Frame F;
    F.lds = (LAS unsigned char*)lds_raw;
    F.MISC = (volatile LAS unsigned*)(F.lds + LDSCTL_OFF);
    F.tid = threadIdx.x; F.lane = F.tid & 63; F.wave = __builtin_amdgcn_readfirstlane(F.tid >> 6);
    F.G = gridDim.x; { const int bx = blockIdx.x; F.vcu = (F.G % 8 == 0) ? (bx % 8) * (F.G / 8) + bx / 8 : bx; }
    F.ws = args.ws; F.ctl = (gu32*)(args.ws + WS_CTL); F.out = args.out;
    F.in = (const float* const*)__builtin_amdgcn_kernarg_segment_ptr();
    for (int u = F.tid; u < (LDS_BYTES - LDSCTL_OFF) / 4; u += NWAVES * 64) ((LAS unsigned*)(F.lds + LDSCTL_OFF))[u] = 0u;
    __syncthreads();
    XcdBarrier bar = xcd_barrier_post((unsigned*)(F.ctl + CW_BAR), F.MISC + 8);

    const int bx = (int)blockIdx.x;

    {   PHASE();
        prep_mixer_weights(Fp);
        memnorm_phase(Fp);
        prep_ffn_weights(Fp, 0);
        norm_phase(Fp, Fp.in[I_X], nullptr, Fp.in[I_GMIX], false, true); }
    GRID_BAR();
    SC_AFTER_PROLOGUE();

    layer_body<0>(F, bar, bx); layer_body<1>(F, bar, bx); layer_body<2>(F, bar, bx); layer_body<3>(F, bar, bx);
    {   PHASE(); final_norm_phase(Fp, X_, Fp.out, Fp.in[I_GFIN], true); }
    SC_FINAL();
}

extern "C" void kernel_launch(void* const* d_in, const int* in_sizes, int n_in, void* d_out, int out_size, void* d_ws, size_t ws_size, hipStream_t stream) {
    static int grid = 0;
    if (grid == 0) {
        if (n_in != 23 || out_size != T * DM || ws_size < WS_END) { fprintf(stderr, "kernel_launch: unexpected problem (n_in %d, out %d, ws %zu < %zu)\n", n_in, out_size, ws_size, (size_t)WS_END); grid = -1; return; }
        int dev = 0, cus = 0;
        if (hipGetDevice(&dev) != hipSuccess || hipDeviceGetAttribute(&cus, hipDeviceAttributeMultiprocessorCount, dev) != hipSuccess) { grid = -1; return; }
        if (hipFuncSetAttribute((const void*)fwd, hipFuncAttributeMaxDynamicSharedMemorySize, LDS_BYTES) != hipSuccess) { fprintf(stderr, "kernel_launch: hipFuncSetAttribute failed\n"); grid = -1; return; }
        int per_cu = 0;
        if (hipOccupancyMaxActiveBlocksPerMultiprocessor(&per_cu, (const void*)fwd, NWAVES * 64, LDS_BYTES) != hipSuccess || per_cu < 1) fprintf(stderr, "kernel_launch: occupancy query says %d\n", per_cu);
        (void)hipGetLastError();
        grid = cus;
    }
    if (grid < 0) return;
    if (hipMemsetAsync((char*)d_ws + WS_CTL, 0, CTL_ZERO_BYTES, stream) != hipSuccess) return;
    Args a{};
    for (int i = 0; i < 23; ++i) a.in[i] = (const float*)d_in[i];
    a.out = (float*)d_out; a.ws = (unsigned char*)d_ws;
    hipLaunchKernelGGL(fwd, dim3(grid), dim3(NWAVES * 64), LDS_BYTES, stream, a);
}
```

```cpp
#include <hip/hip_runtime.h>
#include <cstdio>
#include <cstdint>

#ifndef SELFCHECK
#define SELFCHECK 0
#endif
#ifndef GU_I8_MASK
#define GU_I8_MASK 0xF
#endif
#define GU_I8(l) ((((unsigned)GU_I8_MASK) >> (l)) & 1u)

#define GAS __attribute__((address_space(1)))
#define LAS __attribute__((address_space(3)))
typedef unsigned short bf16_t;
typedef short bf16x8 __attribute__((ext_vector_type(8)));
typedef short s16x4 __attribute__((ext_vector_type(4)));
typedef short v4i16_t __attribute__((ext_vector_type(4)));
typedef float f32x2 __attribute__((ext_vector_type(2)));
typedef float f32x4 __attribute__((ext_vector_type(4)));
typedef float f32x16 __attribute__((ext_vector_type(16)));
typedef unsigned u32x2 __attribute__((ext_vector_type(2)));
typedef unsigned u32x4 __attribute__((ext_vector_type(4)));
typedef int i32x4 __attribute__((ext_vector_type(4)));
typedef GAS unsigned gu32;
#define RLX_AGENT __ATOMIC_RELAXED, __HIP_MEMORY_SCOPE_AGENT

constexpr int NB = 8, SEQ = 4096, T = NB * SEQ, DM = 1024, DEPTH = 4, MEML = 256, DFF = 3584, NE = 8;
constexpr int INW = 4768;
constexpr int PW = 1792;
constexpr int GW = 3072;
constexpr int QBW = 768, KVW = 1024, YW = 1536;
constexpr int NT_IN = 19;
constexpr int P_QA = 0, P_KA = 512, P_VA = 640, P_CQ = 768, P_CKV = 1024, P_KR = 1152, P_QM = 1280;
constexpr int UPK = 256, UPN = 1792;
constexpr int MAXSLOT = 67584;
constexpr int MAXRT = MAXSLOT / 256;
constexpr float EPS = 1e-6f;
constexpr float LOG2E = 1.4426950408889634f;
constexpr float C_A = 0.125f * LOG2E;
constexpr float C_B = 0.10206207261596575f * LOG2E;
constexpr float C_M = 0.08838834764831845f * LOG2E;

constexpr size_t MiB = 1u << 20;
constexpr size_t WS_CTL = 0, CTL_ZERO_BYTES = 1 * MiB;
constexpr size_t WS_MISC = 1 * MiB;
constexpr size_t WL_IN = 0, WL_UP = (size_t)NT_IN * 256 * DM * 2, WL_BR = WL_UP + (size_t)UPN * UPK * 2, WL_OUT = WL_BR + (size_t)3 * DM * 512 * 2, WL_SIZE = WL_OUT + (size_t)DM * DM * 2;
constexpr size_t WS_WMIX = 8 * MiB;
constexpr size_t WS_WMKV = WS_WMIX + 4 * ((WL_SIZE + MiB - 1) / MiB) * MiB;
constexpr size_t WL_STRIDE = ((WL_SIZE + MiB - 1) / MiB) * MiB;
constexpr size_t WS_WFFN = WS_WMKV + 8 * MiB;
constexpr size_t WF_GU = 0, WF_D = (size_t)2 * DFF * DM * 2, WF_STRIDE = WF_D + (size_t)DM * DFF * 2;
constexpr size_t WS_H = WS_WFFN + 8 * WF_STRIDE;
constexpr size_t WS_MEMN = WS_H + (size_t)T * DM * 2;
constexpr size_t WS_MEMKV = WS_MEMN + (size_t)NB * MEML * DM * 2;
constexpr size_t WS_R = WS_MEMKV + (size_t)NB * MEML * 4096 * 2;
constexpr size_t R_P = 0, R_G = R_P + (size_t)T * PW * 2, R_QB = R_G + (size_t)T * GW * 2, R_KVB = R_QB + (size_t)T * QBW * 2, R_Y = R_KVB + (size_t)T * KVW * 2, R_END_MIX = R_Y + (size_t)T * YW * 2;
constexpr size_t R_ACT = 0;
constexpr size_t R_ASORT = (size_t)MAXSLOT * DFF * 2;
constexpr size_t R_YOUT = R_ASORT;
constexpr size_t R_END_FFN = R_YOUT + (size_t)MAXSLOT * DM * 2;
constexpr size_t R_SIZE = R_END_MIX > R_END_FFN ? R_END_MIX : R_END_FFN;
constexpr size_t WS_XB = WS_R + R_SIZE;
constexpr size_t WS_END = WS_XB + (size_t)T * DM * 2;
static_assert(WS_END < 1020ull * MiB, "workspace budget");
constexpr size_t MS_TOKE = 0;
constexpr size_t MS_TOKW = MS_TOKE + (size_t)T * 8;
constexpr size_t MS_SLOT = MS_TOKW + (size_t)T * 8;
constexpr size_t MS_CNT = MS_SLOT + (size_t)T * 8;
constexpr size_t MS_TEXP = MS_CNT + 256 * 8 * 4;
constexpr size_t MS_SSQ = MS_TEXP + 2048;
constexpr size_t MS_SNAP = MS_SSQ + (size_t)T * 32;
constexpr size_t MS_HSC = MS_SNAP + 64 * 1024 * 4;
constexpr size_t MS_ASC = MS_HSC + (size_t)T * 4;
constexpr size_t MS_WSIN = MS_ASC + (size_t)MAXSLOT * 4;
constexpr size_t MS_WSGU = MS_WSIN + (size_t)4 * NT_IN * 256 * 4;
constexpr size_t MS_END = MS_WSGU + (size_t)8 * 2 * DFF * 4;
static_assert(MS_END <= 7 * MiB, "misc map");
constexpr int CW_BAR = 4096;
constexpr int CW_DIAG = 16384;
constexpr int CW_CODE = 16384 + 512;

constexpr int RING_BYTES = 131072;
constexpr int LDSCTL_OFF = RING_BYTES;
constexpr int LDS_BYTES = 147456;
constexpr int NWAVES = 8;

#define LDS_WAIT() asm volatile("s_waitcnt lgkmcnt(0)" ::: "memory")
#define VM_WAIT() asm volatile("s_waitcnt vmcnt(0)" ::: "memory")

__device__ __forceinline__ unsigned f2bf(float f) { unsigned u = __builtin_bit_cast(unsigned, f); return (u + 0x7fffu + ((u >> 16) & 1u)) >> 16; }
__device__ __forceinline__ unsigned pk2(float lo, float hi) { return f2bf(lo) | (f2bf(hi) << 16); }
__device__ __forceinline__ float bf2f(unsigned short b) { return __builtin_bit_cast(float, (unsigned)b << 16); }
__device__ __forceinline__ float bflo(unsigned w) { return __builtin_bit_cast(float, w << 16); }
__device__ __forceinline__ float bfhi(unsigned w) { return __builtin_bit_cast(float, w & 0xffff0000u); }
typedef __bf16 bf16x2_t __attribute__((ext_vector_type(2)));
__device__ __forceinline__ unsigned cvtpk(float lo, float hi) { f32x2 v = {lo, hi}; bf16x2_t b = __builtin_convertvector(v, bf16x2_t); return __builtin_bit_cast(unsigned, b); }
__device__ __forceinline__ float wave_sum(float v) {
#pragma unroll
    for (int o = 1; o < 64; o <<= 1) v += __shfl_xor(v, o);
    return v;
}
__device__ __forceinline__ float fast_sigmoid(float x) { return __builtin_amdgcn_rcpf(1.0f + __builtin_amdgcn_exp2f(-x * LOG2E)); }


__device__ __forceinline__ int opq_v(int x) { asm volatile("" : "+v"(x)); return x; }
__device__ __forceinline__ int opq_s(int x) { asm volatile("" : "+s"(x)); return x; }
template <class Tp> __device__ __forceinline__ Tp* opq_p(Tp* p) { const unsigned long long u = (unsigned long long)p; unsigned lo = __builtin_amdgcn_readfirstlane((unsigned)u), hi = __builtin_amdgcn_readfirstlane((unsigned)(u >> 32)); asm volatile("" : "+s"(lo), "+s"(hi)); return (Tp*)(((unsigned long long)hi << 32) | lo); }

__constant__ float IFR_HI[32] = {1.591549367e-01f, 1.193493679e-01f, 8.949939907e-02f, 6.711508334e-02f, 5.032921210e-02f, 3.774158657e-02f, 2.830219641e-02f, 2.122365311e-02f, 1.591549441e-02f, 1.193493698e-02f, 8.949940093e-03f, 6.711508147e-03f, 5.032921210e-03f, 3.774158424e-03f, 2.830219688e-03f, 2.122365171e-03f, 1.591549488e-03f, 1.193493721e-03f, 8.949940093e-04f, 6.711508031e-04f, 5.032921326e-04f, 3.774158540e-04f, 2.830219455e-04f, 2.122365258e-04f, 1.591549371e-04f, 1.193493736e-04f, 8.949940093e-05f, 6.711508468e-05f, 5.032921035e-05f, 3.774158540e-05f, 2.830219637e-05f, 2.122365186e-05f};
__constant__ float IFR_LO[32] = {6.420638243e-09f, 2.294664903e-09f, 2.542919653e-09f, -3.316028840e-10f, 5.173299289e-12f, -1.848551645e-09f, -5.826552019e-10f, -3.431038786e-10f, -1.029942243e-10f, 4.320196978e-11f, 6.802745173e-11f, 1.531042237e-10f, 5.173301024e-13f, 4.797548470e-11f, -1.048316434e-10f, 1.053879969e-10f, -5.686555046e-11f, -1.896286773e-11f, 6.802744999e-12f, 2.695195456e-11f, -1.158979943e-11f, -6.843983713e-12f, 1.279990003e-11f, 1.807650600e-12f, 5.954976963e-12f, -3.351478166e-12f, 6.802745216e-13f, -1.670379113e-12f, 1.751403167e-12f, -6.843983930e-13f, -5.389994549e-13f, 9.083608431e-13f};
__device__ __forceinline__ void rot_cs(float posf, int idx, float& c, float& s) {
    const float ch = IFR_HI[idx], cl = IFR_LO[idx];
    const float p = posf * ch, e = __builtin_fmaf(posf, ch, -p);
    const float fr = __builtin_amdgcn_fractf(p) + (e + posf * cl);
    s = __builtin_amdgcn_sinf(fr); c = __builtin_amdgcn_cosf(fr);
}

#define XB_TMO      128
#define XB_XCNT(j)  (256  + 64 * (j))
#define XB_XSUB(j)  (1280 + 64 * (j))
#define XB_XGEN(j)  (2304 + 64 * (j))
#define XB_TOP      3328
#define XB_TOPGEN   3392
#define XCD_BAR_WORDS 3456
#define XB_SPIN_CAP (1u << 20)

__device__ __forceinline__ unsigned xb_ld(unsigned* p)              { return __hip_atomic_load(p, __ATOMIC_RELAXED, __HIP_MEMORY_SCOPE_AGENT); }
__device__ __forceinline__ unsigned xb_add(unsigned* p, unsigned v) { return __hip_atomic_fetch_add(p, v, __ATOMIC_RELAXED, __HIP_MEMORY_SCOPE_AGENT); }
__device__ __forceinline__ unsigned xb_xcc_id() { return (unsigned)__builtin_amdgcn_s_getreg((3 << 11) | 20) & 0xFu; }
#define XB_SPIN(cond, bar) do { unsigned _sp = 0; while (cond) { __builtin_amdgcn_s_sleep(1); \
    if ((++_sp & 255u) == 0u) { if (xb_ld(&(bar)[XB_TMO])) break; if (_sp > XB_SPIN_CAP) { atomicAdd(&(bar)[XB_TMO], 1u); break; } } } } while (0)

struct XcdBarrier { unsigned* bar; unsigned x; volatile LAS unsigned* st; };

__device__ __forceinline__ XcdBarrier xcd_barrier_post(unsigned* bar, volatile LAS unsigned* st) {
    XcdBarrier b; b.bar = bar; b.x = xb_xcc_id(); b.st = st;
    if (threadIdx.x == 0) (void)xb_add(&bar[XB_XCNT(b.x)], 1u);
    return b;
}
__device__ __forceinline__ void xcd_barrier_complete(unsigned* bar, unsigned x, unsigned& nloc, unsigned& nx) {
    const unsigned G = gridDim.x * gridDim.y * gridDim.z;
    unsigned sum, cnt, mine, sp = 0u;
    for (;;) {
        sum = 0u; cnt = 0u; mine = 0u;
#pragma unroll
        for (unsigned j = 0; j < 16; ++j) { const unsigned c = xb_ld(&bar[XB_XCNT(j)]); sum += c; cnt += (c > 0u) ? 1u : 0u; mine = (j == x) ? c : mine; }
        if (sum == G) break;
        __builtin_amdgcn_s_sleep(1);
        if ((++sp & 255u) == 0u) { if (xb_ld(&bar[XB_TMO])) break; if (sp > XB_SPIN_CAP) { atomicAdd(&bar[XB_TMO], 1u); break; } }
    }
    nloc = mine > 0u ? mine : 1u; nx = cnt > 0u ? cnt : 1u;
}
__device__ __forceinline__ void xcd_barrier(const XcdBarrier& b) {
    asm volatile("s_waitcnt vmcnt(0)" ::: "memory");
    __syncthreads();
    if (threadIdx.x == 0) {
        unsigned* bar = b.bar;
        __builtin_amdgcn_s_waitcnt(0);
        unsigned nloc = b.st[0], nx = b.st[1];
        if (nloc == 0u) { xcd_barrier_complete(bar, b.x, nloc, nx); b.st[0] = nloc; b.st[1] = nx; }
        const unsigned old = xb_add(&bar[XB_XSUB(b.x)], 1u);
        const unsigned gen = old / nloc;
        if (old + 1u == (gen + 1u) * nloc) {
            __builtin_amdgcn_fence(__ATOMIC_RELEASE, "agent");
            asm volatile("s_waitcnt vmcnt(0)" ::: "memory");
            const unsigned og = xb_add(&bar[XB_TOP], 1u);
            const unsigned tg = og / nx;
            if (og + 1u == (tg + 1u) * nx) xb_add(&bar[XB_TOPGEN], 1u);
            else XB_SPIN(xb_ld(&bar[XB_TOPGEN]) == tg, bar);
            __builtin_amdgcn_fence(__ATOMIC_ACQUIRE, "agent");
            xb_add(&bar[XB_XGEN(b.x)], 1u);
            asm volatile("s_waitcnt vmcnt(0)" ::: "memory");
        } else {
            XB_SPIN(xb_ld(&bar[XB_XGEN(b.x)]) == gen, bar);
            __builtin_amdgcn_fence(__ATOMIC_ACQUIRE, "agent");
            asm volatile("s_waitcnt vmcnt(0)" ::: "memory");
        }
    }
    __syncthreads();
}

namespace pg8 {
constexpr int BM = 256, BK = 64, HALF = 128, HTB = HALF * BK * 2, STAGE_BYTES = 8 * HTB, NXCD = 8, WGM = 4;
constexpr int ESC_OFF = 131072 + 4096, ESC_SLOT = 3072;
__host__ __device__ __forceinline__ int lds_byte(int r, int c) { const int st = (r >> 4) * 2 + (c >> 5), rr = r & 15, cc = c & 31, ob = rr * 64 + cc * 2; return st * 1024 + (ob ^ (((ob >> 9) & 1) << 5)); }
__host__ __device__ __forceinline__ void stage_rc(int b, int& R, int& C) { const int st = b / 1024, sb = b % 1024, swz = sb ^ (((sb >> 9) & 1) << 5); R = (st >> 1) * 16 + swz / 64; C = (st & 1) * 32 + (swz % 64) / 2; }

struct Unit { int pm, pn, aux; };

struct StaticOrder {
    int nM, nN, nwg, G, c, rev, wgm;
    __device__ void init(int nM_, int nN_, int G_, int c_, int rev_ = 0, int wgm_ = WGM) { nM = nM_; nN = nN_; nwg = nM * nN; G = G_; c = c_; rev = rev_; wgm = wgm_; }
    __device__ bool next(int i, Unit& u) const {
        const long L = (long)i * G + c; if (L >= nwg) return false;
        int wgid = (int)L; { const int q = nwg / NXCD, r = nwg % NXCD, xcd = wgid % NXCD, off = wgid / NXCD; wgid = (xcd < r ? xcd * (q + 1) : r * (q + 1) + (xcd - r) * q) + off; }
        const int nig = wgm * nN, gid = wgid / nig, fm = gid * wgm, gsz = (nM - fm) < wgm ? (nM - fm) : wgm;
        u.pm = fm + ((wgid % nig) % gsz); u.pn = (wgid % nig) / gsz; u.aux = 0; if (rev) u.pm = nM - 1 - u.pm; return true;
    }
};

template <bool I8> struct AccVec { typedef f32x4 type; };
template <> struct AccVec<true> { typedef i32x4 type; };
template <bool I8 = false, class Prob, class Sched, class Epi>
__device__ __forceinline__ void gemm_phase(LAS unsigned char* lds, const Prob& P, const Sched& S, const Epi& E) {
    const int tid = opq_v((int)threadIdx.x), wid = __builtin_amdgcn_readfirstlane(tid >> 6), lane = tid & 63, wr = wid >> 2, wc = wid & 3, fr = lane & 15, fq = lane >> 4;
    typedef typename AccVec<I8>::type accv_t;
    const int K = P.K, nt = K / (I8 ? 2 * BK : BK);
    unsigned voffA[2], voffB[2];
#pragma unroll
    for (int i = 0; i < 2; ++i) { int R, C; stage_rc(tid * 16 + i * 8192, R, C); voffA[i] = (unsigned)R * P.lda + (unsigned)C * 2u; voffB[i] = (unsigned)R * P.ldb + (unsigned)C * 2u; }
    const size_t kstep = (size_t)(BK * 2);
    const size_t hstepA = (size_t)HALF * P.lda, hstepB = (size_t)HALF * P.ldb;
    const unsigned ldsw = (unsigned)wid * 1024u;
    const int aoff = lds_byte(wr * 64 + fr, fq * 8), boff = lds_byte(wc * 32 + fr, fq * 8);
#define PG8_SA(b, h) (((b) * 2 + (h)) * HTB)
#define PG8_SB(b, h) ((4 + (b) * 2 + (h)) * HTB)
#define PG8_STAGE(bufoff, gbase, voff) do { _Pragma("unroll") for (int _i = 0; _i < 2; ++_i) \
        __builtin_amdgcn_global_load_lds((const unsigned*)((const char*)(gbase) + (voff)[_i]), (LAS unsigned*)(lds + (bufoff) + ldsw + _i * 8192), 16, 0, 0); } while (0)
#define PG8_LDA(dst, b, h) do { _Pragma("unroll") for (int m = 0; m < 4; ++m) _Pragma("unroll") for (int k = 0; k < 2; ++k) dst[m][k] = *(const LAS bf16x8*)(lds + PG8_SA(b, h) + aoff + m * 2048 + k * 1024); } while (0)
#define PG8_LDB(dst, b, h) do { _Pragma("unroll") for (int n = 0; n < 2; ++n) _Pragma("unroll") for (int k = 0; k < 2; ++k) dst[n][k] = *(const LAS bf16x8*)(lds + PG8_SB(b, h) + boff + n * 2048 + k * 1024); } while (0)
#define PG8_MMA(ai, bj, At, Bt) do { __builtin_amdgcn_s_setprio(1); _Pragma("unroll") for (int m = 0; m < 4; ++m) _Pragma("unroll") for (int n = 0; n < 2; ++n) _Pragma("unroll") for (int k = 0; k < 2; ++k) \
        { if constexpr (I8) acc[ai][bj][m][n] = __builtin_amdgcn_mfma_i32_16x16x64_i8(__builtin_bit_cast(i32x4, Bt[n][k]), __builtin_bit_cast(i32x4, At[m][k]), acc[ai][bj][m][n], 0, 0, 0); \
          else acc[ai][bj][m][n] = __builtin_amdgcn_mfma_f32_16x16x32_bf16(Bt[n][k], At[m][k], acc[ai][bj][m][n], 0, 0, 0); } __builtin_amdgcn_s_setprio(0); } while (0)
#define PG8_WAIT_V(n) asm volatile("s_waitcnt vmcnt(" #n ")" ::: "memory")
#define PG8_WAIT_L(n) asm volatile("s_waitcnt lgkmcnt(" #n ")" ::: "memory")
#define PG8_BAR __builtin_amdgcn_s_barrier()
#define PG8_SCHED __builtin_amdgcn_sched_barrier(0)
    Unit cur, nxt; int ui = 0;
    if (!S.next(0, cur)) return;
    accv_t acc[2][2][4][2];
#pragma unroll
    for (int a = 0; a < 2; ++a)
#pragma unroll
        for (int b = 0; b < 2; ++b)
#pragma unroll
            for (int m = 0; m < 4; ++m)
#pragma unroll
                for (int n = 0; n < 2; ++n) acc[a][b][m][n] = accv_t{};
    bf16x8 At[4][2], B0[2][2], B1[2][2];
    const char* cA = P.a_ptr(cur); const char* cB = P.b_ptr(cur);
    int eslot = 0;
    E.stage(lds + ESC_OFF, cur, wid, lane);
    PG8_STAGE(PG8_SB(0, 0), cB, voffB); PG8_STAGE(PG8_SB(0, 1), cB + hstepB, voffB); PG8_STAGE(PG8_SA(0, 0), cA, voffA); PG8_STAGE(PG8_SA(0, 1), cA + hstepA, voffA);
    if (wr == 1) PG8_BAR;
    PG8_WAIT_V(2); PG8_BAR;
    PG8_STAGE(PG8_SB(1, 0), cB + kstep, voffB); PG8_STAGE(PG8_SA(1, 0), cA + kstep, voffA); PG8_STAGE(PG8_SB(1, 1), cB + hstepB + kstep, voffB);
    PG8_WAIT_V(6); PG8_BAR;
    for (;;) {
        const bool has_next = S.next(ui + 1, nxt);
        const char* nA = has_next ? P.a_ptr(nxt) : cA; const char* nB = has_next ? P.b_ptr(nxt) : cB;
        for (int t = 0; t < nt; t += 2) {
            if constexpr (Epi::MID) { if (t == 8 || t == 16) E.mid(acc, cur, t >> 3, wr, wc, fr, fq); }
            const bool last = (t == nt - 2);
            if (last && has_next) E.stage(lds + ESC_OFF + (eslot ^ 1) * ESC_SLOT, nxt, wid, lane);
            const char* a1 = cA + (size_t)(t + 1) * kstep;
            const char* a2 = last ? nA : cA + (size_t)(t + 2) * kstep; const char* b2 = last ? nB : cB + (size_t)(t + 2) * kstep;
            const char* a3 = a2 + kstep; const char* b3 = b2 + kstep;
            PG8_LDB(B0, 0, 0); PG8_LDB(B1, 0, 1); PG8_SCHED; PG8_LDA(At, 0, 0); PG8_STAGE(PG8_SA(1, 1), a1 + hstepA, voffA);
            PG8_WAIT_V(8); PG8_WAIT_L(0); PG8_BAR; PG8_MMA(0, 0, At, B0); PG8_MMA(0, 1, At, B1); PG8_BAR; PG8_SCHED;
            PG8_LDA(At, 0, 1); PG8_STAGE(PG8_SB(0, 0), b2, voffB); PG8_STAGE(PG8_SB(0, 1), b2 + hstepB, voffB); PG8_STAGE(PG8_SA(0, 0), a2, voffA);
            PG8_WAIT_V(8); PG8_WAIT_L(0); PG8_BAR; PG8_MMA(1, 0, At, B0); PG8_MMA(1, 1, At, B1); PG8_BAR; PG8_SCHED;
            PG8_LDB(B0, 1, 0); PG8_LDB(B1, 1, 1); PG8_SCHED; PG8_LDA(At, 1, 0); PG8_STAGE(PG8_SA(0, 1), a2 + hstepA, voffA);
            PG8_WAIT_V(8); PG8_WAIT_L(0); PG8_BAR; PG8_MMA(0, 0, At, B0); PG8_MMA(0, 1, At, B1); PG8_BAR; PG8_SCHED;
            PG8_LDA(At, 1, 1); PG8_STAGE(PG8_SB(1, 0), b3, voffB); PG8_STAGE(PG8_SB(1, 1), b3 + hstepB, voffB); PG8_STAGE(PG8_SA(1, 0), a3, voffA);
            PG8_WAIT_V(8); PG8_WAIT_L(0); PG8_BAR; PG8_MMA(1, 0, At, B0); PG8_MMA(1, 1, At, B1); PG8_BAR; PG8_SCHED;
        }
        if (wr == 0) PG8_BAR;
        E(acc, cur, wr, wc, fr, fq, lds + ESC_OFF + eslot * ESC_SLOT);
        if (!has_next) break;
#pragma unroll
        for (int a = 0; a < 2; ++a)
#pragma unroll
            for (int b = 0; b < 2; ++b)
#pragma unroll
                for (int m = 0; m < 4; ++m)
#pragma unroll
                    for (int n = 0; n < 2; ++n) acc[a][b][m][n] = accv_t{};
        cur = nxt; cA = nA; cB = nB; ++ui; eslot ^= 1;
        if (wr == 1) PG8_BAR;
    }
    PG8_WAIT_V(0);
    PG8_BAR;
#undef PG8_SA
#undef PG8_SB
#undef PG8_STAGE
#undef PG8_LDA
#undef PG8_LDB
#undef PG8_MMA
#undef PG8_WAIT_V
#undef PG8_WAIT_L
#undef PG8_BAR
#undef PG8_SCHED
}
}

struct Frame {
    LAS unsigned char* lds;
    volatile LAS unsigned* MISC;
    gu32* ctl;
    unsigned char* ws;
    int tid, lane, wave, vcu, G;
    const float* const* in; float* out;
};
enum { I_X = 0, I_MEM, I_POS, I_GMIX, I_WIN, I_GQ, I_WUQ, I_GKV, I_WUKV, I_SINK, I_WMKV, I_WBR, I_WOUT, I_GFFN, I_WGD, I_WUD, I_WDD, I_WR, I_WGE, I_WUE, I_WDE, I_GMEM, I_GFIN };

__device__ __forceinline__ int sem_plain(int g) { return (g & ~31) + 8 * ((g >> 2) & 3) + 4 * ((g >> 4) & 1) + (g & 3); }
__device__ __forceinline__ int sem_rot64(int g) { return (g & ~63) + 32 * ((g >> 4) & 1) + 16 * ((g >> 5) & 1) + 4 * ((g >> 2) & 3) + (g & 3); }
__device__ __forceinline__ int sem_p16(int g) { const int c = g & 255; return (g & ~255) + 64 * ((c >> 5) & 3) + 16 * ((c >> 2) & 3) + 8 * (c >> 7) + 4 * ((c >> 4) & 1) + (c & 3); }
__device__ __forceinline__ int inproj_src(int n) {
    const int pn = n >> 8, c = n & 255;
    if (pn < 2) return pn * 256 + sem_rot64(c);
    if (pn == 2) return c < 128 ? 512 + sem_rot64(c) : 640 + sem_plain(c - 128);
    if (pn == 3) return 768 + sem_plain(c);
    if (pn == 4) return c < 128 ? 1024 + sem_plain(c) : (c < 160 ? 1152 + (c - 128) : -1);
    if (pn < 7) return 1184 + (pn - 5) * 256 + sem_plain(c);
    return 1696 + (pn - 7) * 256 + sem_p16(c);
}

struct MapInproj { const float* W; __device__ __forceinline__ float load(int k, int n) const { const int s = inproj_src(n); return s >= 0 ? W[(size_t)k * INW + s] : 0.f; }
    __device__ __forceinline__ f32x4 load4(int k, int n) const { const int s = inproj_src(n); return s >= 0 ? *(const f32x4*)(W + (size_t)k * INW + s) : (f32x4){0.f, 0.f, 0.f, 0.f}; } };
struct MapUp { const float *Wq, *Wkv, *gq, *gkv;
    __device__ __forceinline__ f32x4 load4(int k, int n) const {
        if (n < 768) { const int gg = n >> 5; const int s = (gg % 3 == 2) ? n : sem_plain(n); return *(const f32x4*)(Wq + (size_t)k * 768 + s) * gq[k]; }
        if (k < 128) return (f32x4){0.f, 0.f, 0.f, 0.f}; const int s = sem_plain(n - 768); return *(const f32x4*)(Wkv + (size_t)(k - 128) * 1024 + s) * gkv[k - 128]; }
    __device__ __forceinline__ float load(int k, int n) const {
        if (n < 768) { const int gg = n >> 5; const int s = (gg % 3 == 2) ? n : sem_plain(n); return gq[k] * Wq[(size_t)k * 768 + s]; }
        if (k < 128) return 0.f; const int s = sem_plain(n - 768); return gkv[k - 128] * Wkv[(size_t)(k - 128) * 1024 + s]; } };
struct MapPlain { const float* W; int ldw; __device__ __forceinline__ float load(int k, int n) const { return W[(size_t)k * ldw + sem_plain(n)]; }
    __device__ __forceinline__ f32x4 load4(int k, int n) const { return *(const f32x4*)(W + (size_t)k * ldw + sem_plain(n)); } };
struct MapNat { const float* W; int ldw; __device__ __forceinline__ float load(int k, int n) const { return W[(size_t)k * ldw + n]; }
    __device__ __forceinline__ f32x4 load4(int k, int n) const { return *(const f32x4*)(W + (size_t)k * ldw + n); } };
struct MapBr { const float* W;
    __device__ __forceinline__ float load(int k, int n) const { return W[(size_t)k * DM + sem_p16(n)]; }
    __device__ __forceinline__ f32x4 load4(int k, int n) const { return *(const f32x4*)(W + (size_t)k * DM + sem_p16(n)); } };
struct MapMemkv { const float* W; __device__ __forceinline__ float load(int k, int n) const { const int l = n >> 10, c = n & 1023; return W[((size_t)l * DM + k) * 1024 + sem_plain(c)]; }
    __device__ __forceinline__ f32x4 load4(int k, int n) const { const int l = n >> 10, c = n & 1023; return *(const f32x4*)(W + ((size_t)l * DM + k) * 1024 + sem_plain(c)); } };
struct MapGU { const float *Wg, *Wu; __device__ __forceinline__ float load(int k, int n) const { const int pn = n >> 8, c = n & 255; const int ch = 128 * pn + sem_plain(c & 127);
    const unsigned long long a = (unsigned long long)Wg, b = (unsigned long long)Wu, w = a ^ ((a ^ b) & (0ull - (unsigned long long)(c >> 7))); return ((const float*)w)[(size_t)k * DFF + ch]; }
    __device__ __forceinline__ f32x4 load4(int k, int n) const { const int pn = n >> 8, c = n & 255; const int ch = 128 * pn + sem_plain(c & 127);
        const unsigned long long a = (unsigned long long)Wg, b = (unsigned long long)Wu, w = a ^ ((a ^ b) & (0ull - (unsigned long long)(c >> 7))); return *(const f32x4*)((const float*)w + (size_t)k * DFF + ch); } };

template <class M> __device__ __forceinline__ void prep_item(const M& m, bf16_t* dst, int Kd, int nblk, LAS float* scr, int item, int lane) {
    const int kb = item / nblk, nb = item % nblk, k0 = 64 * kb, n0 = 32 * nb;
#pragma unroll 8
    for (int i = 0; i < 32; ++i) { const int kk = 2 * i + (lane >> 5); scr[kk * 33 + (lane & 31)] = m.load(k0 + kk, n0 + (lane & 31)); }
    LDS_WAIT(); asm volatile("" ::: "memory");
    const int c = lane & 7;
#pragma unroll
    for (int j = 0; j < 4; ++j) { const int n = (lane >> 3) + 8 * j; const LAS float* s = scr + (8 * c) * 33 + n;
        u32x4 o; o.x = pk2(s[0 * 33], s[1 * 33]); o.y = pk2(s[2 * 33], s[3 * 33]); o.z = pk2(s[4 * 33], s[5 * 33]); o.w = pk2(s[6 * 33], s[7 * 33]);
        *(u32x4*)(dst + (size_t)(n0 + n) * Kd + k0 + 8 * c) = o; }
    LDS_WAIT(); asm volatile("" ::: "memory");
}
template <class M> __device__ __forceinline__ void prep_tile(const M& m, bf16_t* dst, int Kd, int nblk, LAS unsigned char* tile, int item, int lane) {
    const int kb = item / nblk, nb = item % nblk, k0 = 128 * kb, n0 = 32 * nb, ng = lane & 7, kr = lane >> 3;
    f32x4 v[16];
#pragma unroll
    for (int i = 0; i < 16; ++i) v[i] = m.load4(k0 + 8 * i + kr, n0 + 4 * ng);
#pragma unroll
    for (int i = 0; i < 16; ++i)
#pragma unroll
        for (int c = 0; c < 4; ++c) *(LAS unsigned short*)(tile + (4 * ng + c) * 272 + (8 * i + kr) * 2) = (unsigned short)f2bf(v[i][c]);
    LDS_WAIT(); asm volatile("" ::: "memory");
#pragma unroll
    for (int j = 0; j < 8; ++j) { const int p = lane + 64 * j, n = p >> 4, kc = p & 15;
        *(u32x4*)(dst + (size_t)(n0 + n) * Kd + k0 + 8 * kc) = *(const LAS u32x4*)(tile + n * 272 + 16 * kc); }
    LDS_WAIT(); asm volatile("" ::: "memory");
}
template <class M> __device__ __forceinline__ void prep_matrix(Frame& F, const M& m, bf16_t* dst, int N, int K) {
    LAS unsigned char* tile = F.lds + F.wave * 16384;
    const int gw = F.vcu * NWAVES + F.wave, NGW = F.G * NWAVES, nblk = N / 32, nitems = (K / 128) * nblk;
    for (int it = gw; it < nitems; it += NGW) prep_tile(m, dst, K, nblk, tile, it, F.lane);
}

template <class M> __device__ __forceinline__ void prep_strip_i8(Frame& F, const M& m, signed char* dst, float* scl, int strip) {
    const int lane = F.lane, w = F.wave, n0 = strip * 32, k0 = w * 128, ng = lane & 7, kr = lane >> 3;
    LAS unsigned char* tile = F.lds + w * 16384;
    LAS float* amt = (LAS float*)(F.lds + LDSCTL_OFF + 2048);
    f32x4 v[16];
#pragma unroll
    for (int i = 0; i < 16; ++i) v[i] = m.load4(k0 + 8 * i + kr, n0 + 4 * ng);
    f32x4 am = __builtin_elementwise_abs(v[0]);
#pragma unroll
    for (int i = 1; i < 16; ++i) am = __builtin_elementwise_max(am, __builtin_elementwise_abs(v[i]));
#pragma unroll
    for (int c = 0; c < 4; ++c) { float a = am[c]; a = fmaxf(a, __shfl_xor(a, 8)); a = fmaxf(a, __shfl_xor(a, 16)); a = fmaxf(a, __shfl_xor(a, 32)); am[c] = a; }
    if (kr == 0) *(LAS f32x4*)(amt + w * 32 + 4 * ng) = am;
    __syncthreads();
    f32x4 cm = *(const LAS f32x4*)(amt + 4 * ng);
#pragma unroll
    for (int ww = 1; ww < 8; ++ww) cm = __builtin_elementwise_max(cm, *(const LAS f32x4*)(amt + ww * 32 + 4 * ng));
    f32x4 inv;
#pragma unroll
    for (int c = 0; c < 4; ++c) inv[c] = cm[c] > 0.f ? 127.0f / cm[c] : 0.f;
    if (w == 0 && kr == 0) *(f32x4*)(scl + n0 + 4 * ng) = cm * (1.0f / 127.0f);
#pragma unroll
    for (int i = 0; i < 16; ++i)
#pragma unroll
        for (int c = 0; c < 4; ++c) tile[(4 * ng + c) * 144 + 8 * i + kr] = (unsigned char)(signed char)__float2int_rn(v[i][c] * inv[c]);
    LDS_WAIT(); asm volatile("" ::: "memory");
#pragma unroll
    for (int j = 0; j < 4; ++j) { const int p = lane + 64 * j, n = p >> 3, kc = p & 7;
        *(u32x4*)(dst + (size_t)(n0 + n) * DM + k0 + 16 * kc) = *(const LAS u32x4*)(tile + n * 144 + 16 * kc); }
    LDS_WAIT();
    __syncthreads();
}
__device__ __forceinline__ bf16_t* wmix(Frame& F, int l, size_t off) { return (bf16_t*)(F.ws + WS_WMIX + (size_t)l * WL_STRIDE + off); }

__device__ __forceinline__ void prep_mixer_weights(Frame& F) {
    for (int l = 0; l < DEPTH; ++l) {
        { MapInproj m{F.in[I_WIN] + (size_t)l * DM * INW}; for (int s = F.vcu; s < NT_IN * 8; s += F.G) prep_strip_i8(F, m, (signed char*)wmix(F, l, WL_IN), (float*)(F.ws + WS_MISC + MS_WSIN) + l * NT_IN * 256, s); }
        { MapUp m{F.in[I_WUQ] + (size_t)l * 256 * 768, F.in[I_WUKV] + (size_t)l * 128 * 1024, F.in[I_GQ] + l * 256, F.in[I_GKV] + l * 128}; prep_matrix(F, m, wmix(F, l, WL_UP), UPN, UPK); }
        { MapBr m{F.in[I_WBR] + (size_t)l * 3 * 512 * DM}; prep_matrix(F, m, wmix(F, l, WL_BR), DM, 1536); }
        { MapPlain m{F.in[I_WOUT] + (size_t)l * DM * DM, DM}; prep_matrix(F, m, wmix(F, l, WL_OUT), DM, DM); }
    }
    { MapMemkv m{F.in[I_WMKV]}; prep_matrix(F, m, (bf16_t*)(F.ws + WS_WMKV), 4096, DM); }
}
__device__ __forceinline__ void prep_ffn_weights(Frame& F, int l) {
    const int i = l >> 1; const bool moe = (l & 1) != 0;
    LAS float* scr = (LAS float*)(F.lds + F.wave * 16384);
    const int gw = F.vcu * NWAVES + F.wave, NGW = F.G * NWAVES;
    constexpr int IGU = (DM / 64) * (2 * DFF / 32), ID = (DFF / 64) * (DM / 32), NSTRIP = 2 * DFF / 32;
    const int ne = moe ? NE : 1;
    const float* Wg = moe ? F.in[I_WGE] : F.in[I_WGD]; const float* Wu = moe ? F.in[I_WUE] : F.in[I_WUD]; const float* Wd = moe ? F.in[I_WDE] : F.in[I_WDD];
    if (GU_I8(l)) {
        for (int s = F.vcu; s < ne * NSTRIP; s += F.G) { const int e = s / NSTRIP, ss = s % NSTRIP; const size_t eo = ((size_t)i * ne + e) * DM * DFF;
            MapGU m{Wg + eo, Wu + eo}; prep_strip_i8(F, m, (signed char*)(F.ws + WS_WFFN + (size_t)e * WF_STRIDE), (float*)(F.ws + WS_MISC + MS_WSGU) + e * 2 * DFF, ss); }
    } else {
        for (int it = gw; it < ne * IGU; it += NGW) { const int e = it / IGU, r = it % IGU; const size_t eo = ((size_t)i * ne + e) * DM * DFF;
            MapGU m{Wg + eo, Wu + eo}; prep_item(m, (bf16_t*)(F.ws + WS_WFFN + (size_t)e * WF_STRIDE), DM, 2 * DFF / 32, scr, r, F.lane); }
    }
    constexpr int IDT = (DFF / 128) * (DM / 32);
    for (int it = gw; it < ne * IDT; it += NGW) { const int e = it / IDT, r = it % IDT; const size_t eo = ((size_t)i * ne + e) * DM * DFF;
        MapPlain m{Wd + eo, DM}; prep_tile(m, (bf16_t*)(F.ws + WS_WFFN + (size_t)e * WF_STRIDE + WF_D), DFF, DM / 32, F.lds + F.wave * 16384, r, F.lane); }
}

struct RowV { f32x4 v[4]; };
__device__ __forceinline__ void row_load(RowV& r, const float* p, int lane) { const f32x4* x = (const f32x4*)p + lane;
#pragma unroll
    for (int j = 0; j < 4; ++j) r.v[j] = x[64 * j]; }
__device__ __forceinline__ void row_store(const RowV& r, float* p, int lane) { f32x4* x = (f32x4*)p + lane;
#pragma unroll
    for (int j = 0; j < 4; ++j) x[64 * j] = r.v[j]; }
__device__ __forceinline__ void row_add_bf16(RowV& r, const bf16_t* p, float w, int lane) { const u32x2* x = (const u32x2*)p + lane;
#pragma unroll
    for (int j = 0; j < 4; ++j) { const u32x2 q = x[64 * j]; r.v[j].x += w * bflo(q.x); r.v[j].y += w * bfhi(q.x); r.v[j].z += w * bflo(q.y); r.v[j].w += w * bfhi(q.y); } }
__device__ __forceinline__ void row_load_bf16(RowV& r, const bf16_t* p, int lane) { const u32x2* x = (const u32x2*)p + lane;
#pragma unroll
    for (int j = 0; j < 4; ++j) { const u32x2 q = x[64 * j]; r.v[j].x = bflo(q.x); r.v[j].y = bfhi(q.x); r.v[j].z = bflo(q.y); r.v[j].w = bfhi(q.y); } }
__device__ __forceinline__ void row_round_bf16(RowV& r) {
#pragma unroll
    for (int j = 0; j < 4; ++j) { r.v[j].x = bf2f((unsigned short)f2bf(r.v[j].x)); r.v[j].y = bf2f((unsigned short)f2bf(r.v[j].y)); r.v[j].z = bf2f((unsigned short)f2bf(r.v[j].z)); r.v[j].w = bf2f((unsigned short)f2bf(r.v[j].w)); } }
__device__ __forceinline__ float row_rstd(const RowV& r) { float s = 0.f;
#pragma unroll
    for (int j = 0; j < 4; ++j) s += (r.v[j].x * r.v[j].x + r.v[j].y * r.v[j].y) + (r.v[j].z * r.v[j].z + r.v[j].w * r.v[j].w);
    return 1.0f / sqrtf(wave_sum(s) * (1.0f / DM) + EPS); }
__device__ __forceinline__ void row_scale(RowV& r, float rstd, const float* g, int lane) { const f32x4* gg = (const f32x4*)g + lane;
#pragma unroll
    for (int j = 0; j < 4; ++j) r.v[j] = r.v[j] * rstd * gg[64 * j]; }
__device__ __forceinline__ void row_store_bf16(const RowV& r, bf16_t* p, int lane) { u32x2* o = (u32x2*)p + lane;
#pragma unroll
    for (int j = 0; j < 4; ++j) { u32x2 w; w.x = pk2(r.v[j].x, r.v[j].y); w.y = pk2(r.v[j].z, r.v[j].w); o[64 * j] = w; } }

__device__ __forceinline__ float row_store_i8(const RowV& r, signed char* p, int lane) {
    float am = 0.f;
#pragma unroll
    for (int j = 0; j < 4; ++j) am = fmaxf(am, fmaxf(fmaxf(fabsf(r.v[j].x), fabsf(r.v[j].y)), fmaxf(fabsf(r.v[j].z), fabsf(r.v[j].w))));
#pragma unroll
    for (int o = 1; o < 64; o <<= 1) am = fmaxf(am, __shfl_xor(am, o));
    const float inv = am > 0.f ? 127.0f / am : 0.f; unsigned* o4 = (unsigned*)p + lane;
#pragma unroll
    for (int j = 0; j < 4; ++j) { const unsigned a = (unsigned)__float2int_rn(r.v[j].x * inv) & 255u, b = (unsigned)__float2int_rn(r.v[j].y * inv) & 255u, c = (unsigned)__float2int_rn(r.v[j].z * inv) & 255u, d = (unsigned)__float2int_rn(r.v[j].w * inv) & 255u;
        o4[64 * j] = a | (b << 8) | (c << 16) | (d << 24); }
    return am * (1.0f / 127.0f);
}
__device__ __forceinline__ void row_combine(Frame& F, RowV& r, int t) {
    const int* sl = (const int*)(F.ws + WS_MISC + MS_SLOT) + 2 * t; const float* tw = (const float*)(F.ws + WS_MISC + MS_TOKW) + 2 * t;
    const bf16_t* Y = (const bf16_t*)(F.ws + WS_R + R_YOUT);
    const int s0 = sl[0], s1 = sl[1]; const float w0 = tw[0], w1 = tw[1];
    row_add_bf16(r, Y + (size_t)s0 * DM, w0, F.lane); row_add_bf16(r, Y + (size_t)s1 * DM, w1, F.lane);
}

__device__ __forceinline__ void norm_phase(Frame& F, const float* srcf, bf16_t* X, const float* g, bool combine, bool out_i8) {
    bf16_t* H = (bf16_t*)(F.ws + WS_H); signed char* Hq = (signed char*)(F.ws + WS_H); float* hsc = (float*)(F.ws + WS_MISC + MS_HSC);
    const int gw = F.vcu * NWAVES + F.wave, NGW = F.G * NWAVES;
    for (int t = gw; t < T; t += 2 * NGW) {
        const int t2 = (t + NGW < T) ? t + NGW : t;
        RowV r, q;
        if (srcf) { row_load(r, srcf + (size_t)t * DM, F.lane); row_load(q, srcf + (size_t)t2 * DM, F.lane); }
        else { row_load_bf16(r, X + (size_t)t * DM, F.lane); row_load_bf16(q, X + (size_t)t2 * DM, F.lane); }
        if (combine) { row_combine(F, r, t); row_combine(F, q, t2); row_store_bf16(r, X + (size_t)t * DM, F.lane); row_store_bf16(q, X + (size_t)t2 * DM, F.lane);
            row_round_bf16(r); row_round_bf16(q); }
        const float rstd = row_rstd(r), qstd = row_rstd(q); row_scale(r, rstd, g, F.lane); row_scale(q, qstd, g, F.lane);
        if (out_i8) { const float sc = row_store_i8(r, Hq + (size_t)t * DM, F.lane), sq = row_store_i8(q, Hq + (size_t)t2 * DM, F.lane); if (F.lane == 0) { hsc[t] = sc; hsc[t2] = sq; } }
        else { row_store_bf16(r, H + (size_t)t * DM, F.lane); row_store_bf16(q, H + (size_t)t2 * DM, F.lane); }
    }
}
__device__ __forceinline__ void final_norm_phase(Frame& F, const bf16_t* X, float* out, const float* g, bool combine) {
    const int gw = F.vcu * NWAVES + F.wave, NGW = F.G * NWAVES;
    for (int t = gw; t < T; t += 2 * NGW) {
        const int t2 = (t + NGW < T) ? t + NGW : t;
        RowV r, q; row_load_bf16(r, X + (size_t)t * DM, F.lane); row_load_bf16(q, X + (size_t)t2 * DM, F.lane);
        if (combine) { row_combine(F, r, t); row_combine(F, q, t2); }
        const float rstd = row_rstd(r), qstd = row_rstd(q); row_scale(r, rstd, g, F.lane); row_scale(q, qstd, g, F.lane);
        row_store(r, out + (size_t)t * DM, F.lane); row_store(q, out + (size_t)t2 * DM, F.lane);
    }
}
__device__ __forceinline__ void memnorm_phase(Frame& F) {
    bf16_t* MN = (bf16_t*)(F.ws + WS_MEMN);
    const int gw = F.vcu * NWAVES + F.wave, NGW = F.G * NWAVES;
    for (int t = gw; t < NB * MEML; t += NGW) {
        RowV r; row_load(r, F.in[I_MEM] + (size_t)t * DM, F.lane);
        const float rstd = row_rstd(r); row_scale(r, rstd, F.in[I_GMEM], F.lane);
        row_store_bf16(r, MN + (size_t)t * DM, F.lane);
    }
}

__device__ __forceinline__ void norm_router_phase(Frame& F, const bf16_t* X, const float* g, const float* Wr  , bool out_i8) {
    bf16_t* H = (bf16_t*)(F.ws + WS_H); signed char* Hq = (signed char*)(F.ws + WS_H); float* hsc = (float*)(F.ws + WS_MISC + MS_HSC);
    int* toke = (int*)(F.ws + WS_MISC + MS_TOKE); float* tokw = (float*)(F.ws + WS_MISC + MS_TOKW); int* cntg = (int*)(F.ws + WS_MISC + MS_CNT);
    volatile LAS int* hist = (volatile LAS int*)(F.lds + LDSCTL_OFF + 1024);
    f32x4 wa[4][4], wb[4][4];
#pragma unroll
    for (int j = 0; j < 4; ++j)
#pragma unroll
        for (int k = 0; k < 4; ++k) { const int d = 256 * j + 4 * F.lane + k; wa[j][k] = *(const f32x4*)(Wr + (size_t)d * 8); wb[j][k] = *(const f32x4*)(Wr + (size_t)d * 8 + 4); }
    const bool up32 = (F.lane & 32) != 0, up16 = (F.lane & 16) != 0, up8 = (F.lane & 8) != 0;
    for (int c = F.vcu; c < T / 128; c += F.G) {
        if (F.tid < 8) hist[F.tid] = 0;
        __syncthreads();
        for (int q = 0; q < 16; ++q) {
            const int t = c * 128 + F.wave * 16 + q;
            RowV r; row_load_bf16(r, X + (size_t)t * DM, F.lane);
            const float rstd = row_rstd(r); row_scale(r, rstd, g, F.lane);
            if (out_i8) { const float sc = row_store_i8(r, Hq + (size_t)t * DM, F.lane); if (F.lane == 0) hsc[t] = sc; }
            else row_store_bf16(r, H + (size_t)t * DM, F.lane);
            f32x4 la = {0.f, 0.f, 0.f, 0.f}, lb = {0.f, 0.f, 0.f, 0.f};
#pragma unroll
            for (int j = 0; j < 4; ++j)
#pragma unroll
                for (int k = 0; k < 4; ++k) { const float x = r.v[j][k]; la += wa[j][k] * x; lb += wb[j][k] * x; }
            f32x4 h4; { const f32x4 keep = up32 ? lb : la, send = up32 ? la : lb;
#pragma unroll
                for (int i = 0; i < 4; ++i) h4[i] = keep[i] + __shfl_xor(send[i], 32); }
            f32x2 h2; { const float k0 = up16 ? h4[2] : h4[0], k1 = up16 ? h4[3] : h4[1], s0 = up16 ? h4[0] : h4[2], s1 = up16 ? h4[1] : h4[3]; h2.x = k0 + __shfl_xor(s0, 16); h2.y = k1 + __shfl_xor(s1, 16); }
            float h1 = (up8 ? h2.y : h2.x) + __shfl_xor(up8 ? h2.x : h2.y, 8);
            h1 += __shfl_xor(h1, 4); h1 += __shfl_xor(h1, 2); h1 += __shfl_xor(h1, 1);
            float lg[8];
#pragma unroll
            for (int e = 0; e < 8; ++e) lg[e] = __builtin_bit_cast(float, __builtin_amdgcn_readlane(__builtin_bit_cast(int, h1), 8 * e));
            int e0 = 0; float v0 = lg[0];
#pragma unroll
            for (int e = 1; e < 8; ++e) if (lg[e] > v0) { v0 = lg[e]; e0 = e; }
            int e1 = -1; float v1 = -INFINITY;
#pragma unroll
            for (int e = 0; e < 8; ++e) if (e != e0 && lg[e] > v1) { v1 = lg[e]; e1 = e; }
            if (F.lane == 0) {
                const float w0 = 1.0f / (1.0f + __expf(v1 - v0));
                toke[2 * t] = e0; toke[2 * t + 1] = e1; tokw[2 * t] = w0; tokw[2 * t + 1] = 1.0f - w0;
                __hip_atomic_fetch_add((LAS int*)&hist[e0], 1, __ATOMIC_RELAXED, __HIP_MEMORY_SCOPE_WORKGROUP); __hip_atomic_fetch_add((LAS int*)&hist[e1], 1, __ATOMIC_RELAXED, __HIP_MEMORY_SCOPE_WORKGROUP);
            }
        }
        __syncthreads();
        if (F.tid < 8) cntg[c * 8 + F.tid] = hist[F.tid];
        __syncthreads();
    }
}
__device__ __forceinline__ void moe_assign_phase(Frame& F, bool i8) {
    const bf16_t* H = (const bf16_t*)(F.ws + WS_H); bf16_t* AS = (bf16_t*)(F.ws + WS_R + R_ASORT);
    const float* hsc = (const float*)(F.ws + WS_MISC + MS_HSC); float* asc = (float*)(F.ws + WS_MISC + MS_ASC);
    const int* toke = (const int*)(F.ws + WS_MISC + MS_TOKE); int* slot = (int*)(F.ws + WS_MISC + MS_SLOT); const int* cntg = (const int*)(F.ws + WS_MISC + MS_CNT);
    int* texp = (int*)(F.ws + WS_MISC + MS_TEXP);
    volatile LAS int* tot = (volatile LAS int*)(F.lds + LDSCTL_OFF + 1024);
    volatile LAS int* pre = tot + 8;
    volatile LAS int* wcnt = tot + 16;
    for (int c = F.vcu; c < T / 128; c += F.G) {
        if (F.tid < 16) tot[F.tid] = 0;
        __syncthreads();
        { const int cc = F.tid >> 1, h = F.tid & 1; const i32x4 v = *(const i32x4*)(cntg + cc * 8 + 4 * h);
#pragma unroll
          for (int k = 0; k < 4; ++k) { __hip_atomic_fetch_add((LAS int*)&tot[4 * h + k], v[k], __ATOMIC_RELAXED, __HIP_MEMORY_SCOPE_WORKGROUP); if (cc < c) __hip_atomic_fetch_add((LAS int*)&pre[4 * h + k], v[k], __ATOMIC_RELAXED, __HIP_MEMORY_SCOPE_WORKGROUP); } }
        const int t = c * 128 + F.wave * 16 + ((F.lane & 31) >> 1);
        const int my_e = (F.lane < 32) ? toke[2 * t + (F.lane & 1)] : -1;
        int rank = 0;
#pragma unroll
        for (int e = 0; e < 8; ++e) { const unsigned long long m = __ballot(my_e == e); if (my_e == e) rank = __popcll(m & ((1ull << F.lane) - 1ull)); if (F.lane == 0) wcnt[F.wave * 8 + e] = __popcll(m); }
        __syncthreads();
        int myslot = 0;
        if (F.lane < 32) {
            int ts = 0;
#pragma unroll
            for (int e = 0; e < 8; ++e) ts += (e < my_e) ? ((tot[e] + 255) >> 8) : 0;
            int wp = 0; for (int w = 0; w < F.wave; ++w) wp += wcnt[w * 8 + my_e];
            myslot = ts * 256 + pre[my_e] + wp + rank;
            slot[2 * t + (F.lane & 1)] = myslot;
        }
        if (c == 0 && F.tid == 0) { int ts = 0; for (int e = 0; e < 8; ++e) { const int n = (tot[e] + 255) >> 8; for (int k = 0; k < n; ++k) texp[ts + k] = e; ts += n; } for (int k = ts; k < MAXRT; ++k) texp[k] = 0; texp[MAXRT] = ts; }
        if (i8) {
            const float myh = hsc[t];
#pragma unroll 1
            for (int a0 = 0; a0 < 32; a0 += 8) {
                u32x4 x[4];
#pragma unroll
                for (int k = 0; k < 4; ++k) x[k] = *((const u32x4*)((const signed char*)H + (size_t)(c * 128 + F.wave * 16 + ((a0 + 2 * k) >> 1)) * DM) + F.lane);
#pragma unroll
                for (int k = 0; k < 8; ++k) { const int s = __builtin_amdgcn_readlane(myslot, a0 + k); *((u32x4*)((signed char*)AS + (size_t)s * DM) + F.lane) = x[k >> 1]; }
            }
            if (F.lane < 32) asc[myslot] = myh;
        } else {
            for (int a = 0; a < 32; ++a) {
                const int s = __builtin_amdgcn_readlane(myslot, a); const int ta = c * 128 + F.wave * 16 + (a >> 1);
                const u32x4* srcp = (const u32x4*)(H + (size_t)ta * DM) + F.lane; u32x4* dstp = (u32x4*)(AS + (size_t)s * DM) + F.lane;
                const u32x4 x0 = srcp[0], x1 = srcp[64]; dstp[0] = x0; dstp[64] = x1; }
        }
        __syncthreads();
    }
}

using pg8::Unit;
typedef f32x4 AccT[2][2][4][2];

struct ProbSimple { int K; unsigned lda, ldb; const char* A; const char* B;
    __device__ __forceinline__ const char* a_ptr(const Unit& u) const { return A + (size_t)u.pm * 256 * lda; }
    __device__ __forceinline__ const char* b_ptr(const Unit& u) const { return B + (size_t)u.pn * 256 * ldb; } };
struct ProbUp { int K; unsigned lda, ldb; const char* A; const char* B;
    __device__ __forceinline__ const char* a_ptr(const Unit& u) const { return A + (size_t)u.pm * 256 * lda + (u.pn >= 3 ? 256 : 0); }
    __device__ __forceinline__ const char* b_ptr(const Unit& u) const { return B + (size_t)u.pn * 256 * ldb; } };
struct ProbMoe { int K; unsigned lda, ldb; const char* A; const char* B; int a_lo;
    __device__ __forceinline__ const char* a_ptr(const Unit& u) const { return A + (size_t)(u.pm - a_lo) * 256 * lda; }
    __device__ __forceinline__ const char* b_ptr(const Unit& u) const { return B + (size_t)u.aux * WF_STRIDE + (size_t)u.pn * 256 * ldb; } };

struct MoeOrder { pg8::StaticOrder base; int lo; const int* texp;
    __device__ bool next(int i, Unit& u) const { if (!base.next(i, u)) return false; u.pm += lo; u.aux = __builtin_amdgcn_readfirstlane(texp[u.pm]); return true; } };

__device__ __forceinline__ u32x4 pack8(const f32x4 a, const f32x4 b) { u32x4 w; w.x = cvtpk(a[0], a[1]); w.y = cvtpk(a[2], a[3]); w.z = cvtpk(b[0], b[1]); w.w = cvtpk(b[2], b[3]); return w; }
__device__ __forceinline__ u32x2 pack4(const f32x4 a) { u32x2 w; w.x = cvtpk(a[0], a[1]); w.y = cvtpk(a[2], a[3]); return w; }

struct EpiNoStage { __device__ __forceinline__ void stage(LAS unsigned char*, const Unit&, int, int) const {} };
__device__ __forceinline__ void stage1k(const void* src, LAS unsigned char* dst, int lane) { __builtin_amdgcn_global_load_lds((const unsigned*)((const char*)src + lane * 16), (LAS unsigned*)dst, 16, 0, 0); }
__device__ __forceinline__ f32x4 deq(const f32x4& a, float, const f32x4&) { return a; }
__device__ __forceinline__ f32x4 deq(const i32x4& a, float rs, const f32x4& cs) { return __builtin_convertvector(a, f32x4) * rs * cs; }
struct EpiInproj {
    static constexpr bool MID = false;
    bf16_t* P; bf16_t* G; float* ssq; const int* pos; const float* rsc; const float* csc;
    __device__ __forceinline__ void stage(LAS unsigned char* d, const Unit& u, int wid, int lane) const {
        if (wid == 0) { stage1k(rsc + u.pm * 256, d, lane); stage1k(csc + u.pn * 256, d + 1024, lane); stage1k(pos + u.pm * 256, d + 2048, lane); } }
    template <class AV> __device__ __forceinline__ void operator()(const AV (&acc)[2][2][4][2], const Unit& u, int wr, int wc, int fr, int fq, const LAS unsigned char* esc) const {
        const int pn = u.pn, row0 = u.pm * 256 + wr * 64 + fr;
        f32x4 cs[2][2];
#pragma unroll
        for (int bj = 0; bj < 2; ++bj)
#pragma unroll
            for (int n = 0; n < 2; ++n) cs[bj][n] = *(const LAS f32x4*)(esc + 1024 + (bj * 128 + wc * 32 + n * 16 + fq * 4) * 4);
        float rs8[2][4], pf8[2][4];
#pragma unroll
        for (int ai = 0; ai < 2; ++ai)
#pragma unroll
            for (int m = 0; m < 4; ++m) { const int rl = ai * 128 + wr * 64 + m * 16 + fr; rs8[ai][m] = *(const LAS float*)(esc + rl * 4); pf8[ai][m] = (float)*(const LAS int*)(esc + 2048 + rl * 4); }
#define DQ(ai, bj, m, n) deq(acc[ai][bj][m][n], rs, cs[bj][n])
        if (pn >= 7) {
#pragma unroll
            for (int ai = 0; ai < 2; ++ai)
#pragma unroll
                for (int m = 0; m < 4; ++m) { const int row = row0 + ai * 128 + m * 16; const float rs = rs8[ai][m]; u32x4 w;
#pragma unroll
                    for (int bj = 0; bj < 2; ++bj) { f32x4 a = DQ(ai, bj, m, 0), b = DQ(ai, bj, m, 1);
#pragma unroll
                        for (int j = 0; j < 4; ++j) { a[j] = fast_sigmoid(a[j]) * 255.0f; b[j] = fast_sigmoid(b[j]) * 255.0f; }
                        const unsigned wa_ = (unsigned)__float2int_rn(a[0]) | ((unsigned)__float2int_rn(a[1]) << 8) | ((unsigned)__float2int_rn(a[2]) << 16) | ((unsigned)__float2int_rn(a[3]) << 24);
                        const unsigned wb_ = (unsigned)__float2int_rn(b[0]) | ((unsigned)__float2int_rn(b[1]) << 8) | ((unsigned)__float2int_rn(b[2]) << 16) | ((unsigned)__float2int_rn(b[3]) << 24);
                        if (bj == 0) { w.x = wa_; w.y = wb_; } else { w.z = wa_; w.w = wb_; } }
                    *(u32x4*)((unsigned char*)G + (size_t)row * GW + (pn - 7) * 256 + wc * 64 + fq * 16) = w; }
        } else if (pn >= 5 || pn == 3) {
            const float sc = (pn == 3) ? 1.0f : C_M;
#pragma unroll
            for (int ai = 0; ai < 2; ++ai)
#pragma unroll
                for (int m = 0; m < 4; ++m) { const int row = row0 + ai * 128 + m * 16; const float rs = rs8[ai][m]; float s = 0.f;
#pragma unroll
                    for (int bj = 0; bj < 2; ++bj) { const f32x4 a = DQ(ai, bj, m, 0) * sc, b = DQ(ai, bj, m, 1) * sc;
                        s += (a[0] * a[0] + a[1] * a[1]) + (a[2] * a[2] + a[3] * a[3]) + (b[0] * b[0] + b[1] * b[1]) + (b[2] * b[2] + b[3] * b[3]);
                        *(u32x4*)(P + (size_t)row * PW + pn * 256 + bj * 128 + wc * 32 + fq * 8) = pack8(a, b); }
                    if (pn == 3) { s += __shfl_xor(s, 16); s += __shfl_xor(s, 32); if (fq == 0) ssq[(size_t)row * 8 + wc] = s; } }
        } else if (pn == 4) {
#pragma unroll
            for (int ai = 0; ai < 2; ++ai)
#pragma unroll
                for (int m = 0; m < 4; ++m) { const int row = row0 + ai * 128 + m * 16; const float rs = rs8[ai][m];
                    { const f32x4 a = DQ(ai, 0, m, 0), b = DQ(ai, 0, m, 1);
                      float s = (a[0] * a[0] + a[1] * a[1]) + (a[2] * a[2] + a[3] * a[3]) + (b[0] * b[0] + b[1] * b[1]) + (b[2] * b[2] + b[3] * b[3]);
                      *(u32x4*)(P + (size_t)row * PW + P_CKV + wc * 32 + fq * 8) = pack8(a, b);
                      s += __shfl_xor(s, 16); s += __shfl_xor(s, 32); if (fq == 0) ssq[(size_t)row * 8 + 4 + wc] = s; }
                    if (wc == 0) { const f32x4 x1 = DQ(ai, 1, m, 0), x2 = DQ(ai, 1, m, 1); const float pf = pf8[ai][m]; f32x4 o1, o2;
#pragma unroll
                        for (int j = 0; j < 4; ++j) { float c, s; rot_cs(pf, 2 * (4 * fq + j), c, s); o1[j] = x1[j] * c - x2[j] * s; o2[j] = x2[j] * c + x1[j] * s; }
                        *(u32x2*)(P + (size_t)row * PW + P_KR + 4 * fq) = pack4(o1); *(u32x2*)(P + (size_t)row * PW + P_KR + 16 + 4 * fq) = pack4(o2); } }
        } else {
            const float sc = (pn < 2) ? C_A : 1.0f; const int i0 = 16 * (wc & 1) + 4 * fq;
#pragma unroll
            for (int ai = 0; ai < 2; ++ai)
#pragma unroll
                for (int m = 0; m < 4; ++m) { const int row = row0 + ai * 128 + m * 16; const float rs = rs8[ai][m]; const float pf = pf8[ai][m]; f32x4 c, s;
#pragma unroll
                    for (int j = 0; j < 4; ++j) { float cc, ss; rot_cs(pf, i0 + j, cc, ss); c[j] = cc * sc; s[j] = ss * sc; }
#pragma unroll
                    for (int bj = 0; bj < 2; ++bj) { const f32x4 x1 = DQ(ai, bj, m, 0), x2 = DQ(ai, bj, m, 1);
                        if (pn == 2 && bj == 1) { *(u32x4*)(P + (size_t)row * PW + P_VA + wc * 32 + fq * 8) = pack8(x1, x2); }
                        else { const f32x4 o1 = x1 * c - x2 * s, o2 = x2 * c + x1 * s; bf16_t* d = P + (size_t)row * PW + pn * 256 + 64 * (2 * bj + (wc >> 1)) + i0;
                            *(u32x2*)d = pack4(o1); *(u32x2*)(d + 32) = pack4(o2); } } }
        }
#undef DQ
    }
};
struct EpiUp {
    static constexpr bool MID = false;
    __device__ __forceinline__ void stage(LAS unsigned char*, const Unit&, int, int) const {}
    bf16_t* QB; bf16_t* KVB; const float* ssq; const int* pos;
    __device__ __forceinline__ void operator()(const AccT& acc, const Unit& u, int wr, int wc, int fr, int fq, const LAS unsigned char*) const {
        const int pn = u.pn, row0 = u.pm * 256 + wr * 64 + fr;
        float rs8[2][4], pf8[2][4];
#pragma unroll
        for (int ai = 0; ai < 2; ++ai)
#pragma unroll
            for (int m = 0; m < 4; ++m) { const int row = row0 + ai * 128 + m * 16; const f32x4 sv = *(const f32x4*)(ssq + (size_t)row * 8 + (pn < 3 ? 0 : 4));
                rs8[ai][m] = (pn < 3 ? C_B : 1.0f) / sqrtf(((sv[0] + sv[1]) + (sv[2] + sv[3])) * (pn < 3 ? 1.0f / 256.0f : 1.0f / 128.0f) + EPS); pf8[ai][m] = (pn < 3) ? (float)pos[row] : 0.f; }
#pragma unroll
        for (int ai = 0; ai < 2; ++ai)
#pragma unroll
            for (int m = 0; m < 4; ++m) { const int row = row0 + ai * 128 + m * 16; const float rs = rs8[ai][m];
                if (pn < 3) {
#pragma unroll
                    for (int bj = 0; bj < 2; ++bj) { const int gg = 8 * pn + 4 * bj + wc; const f32x4 x1 = acc[ai][bj][m][0] * rs, x2 = acc[ai][bj][m][1] * rs;
                        if (gg % 3 == 2) { const float pf = pf8[ai][m]; f32x4 o1, o2;
#pragma unroll
                            for (int j = 0; j < 4; ++j) { float c, s; rot_cs(pf, 2 * (4 * fq + j), c, s); o1[j] = x1[j] * c - x2[j] * s; o2[j] = x2[j] * c + x1[j] * s; }
                            bf16_t* d = QB + (size_t)row * QBW + 32 * gg + 4 * fq; *(u32x2*)d = pack4(o1); *(u32x2*)(d + 16) = pack4(o2); }
                        else *(u32x4*)(QB + (size_t)row * QBW + 32 * gg + 8 * fq) = pack8(x1, x2); }
                } else {
#pragma unroll
                    for (int bj = 0; bj < 2; ++bj) *(u32x4*)(KVB + (size_t)row * KVW + (pn - 3) * 256 + bj * 128 + wc * 32 + fq * 8) = pack8(acc[ai][bj][m][0] * rs, acc[ai][bj][m][1] * rs);
                } }
    }
};
struct EpiPlain {
    static constexpr bool MID = false;
    __device__ __forceinline__ void stage(LAS unsigned char*, const Unit&, int, int) const {}
    bf16_t* O; int ldo;
    __device__ __forceinline__ void operator()(const AccT& acc, const Unit& u, int wr, int wc, int fr, int fq, const LAS unsigned char*) const {
        const int row0 = u.pm * 256 + wr * 64 + fr;
#pragma unroll
        for (int ai = 0; ai < 2; ++ai)
#pragma unroll
            for (int m = 0; m < 4; ++m)
#pragma unroll
                for (int bj = 0; bj < 2; ++bj) *(u32x4*)(O + (size_t)(row0 + ai * 128 + m * 16) * ldo + u.pn * 256 + bj * 128 + wc * 32 + fq * 8) = pack8(acc[ai][bj][m][0], acc[ai][bj][m][1]);
    }
};
struct EpiBranch {
    static constexpr bool MID = true;
    const unsigned char* G; bf16_t* MIXED;
    __device__ __forceinline__ void stage(LAS unsigned char*, const Unit&, int, int) const {}
    static __device__ __forceinline__ float gq(unsigned w, int b) { const float f = (float)((w >> (8 * b)) & 255u); return fmaxf(f, 2.55e-4f); }
    __device__ __forceinline__ void mid(AccT& acc, const Unit& u, int seg  , int wr, int wc, int fr, int fq) const {
        const int row0 = opq_v(u.pm * 256 + wr * 64 + fr);
#pragma unroll
        for (int ai = 0; ai < 2; ++ai) {
            u32x4 ga[4], gb[4];
#pragma unroll
            for (int m = 0; m < 4; ++m) { const unsigned char* gp = G + (size_t)(row0 + ai * 128 + m * 16) * GW + u.pn * 256 + wc * 64 + fq * 16;
                ga[m] = *(const u32x4*)(gp + (seg - 1) * 1024); gb[m] = *(const u32x4*)(gp + seg * 1024); }
#pragma unroll
            for (int m = 0; m < 4; ++m) {
#pragma unroll
                for (int j = 0; j < 4; ++j) {
                    acc[ai][0][m][0][j] *= gq(ga[m].x, j) * __builtin_amdgcn_rcpf(gq(gb[m].x, j)); acc[ai][0][m][1][j] *= gq(ga[m].y, j) * __builtin_amdgcn_rcpf(gq(gb[m].y, j));
                    acc[ai][1][m][0][j] *= gq(ga[m].z, j) * __builtin_amdgcn_rcpf(gq(gb[m].z, j)); acc[ai][1][m][1][j] *= gq(ga[m].w, j) * __builtin_amdgcn_rcpf(gq(gb[m].w, j)); } }
            asm volatile("" ::: "memory"); }
    }
    __device__ __forceinline__ void operator()(const AccT& acc, const Unit& u, int wr, int wc, int fr, int fq, const LAS unsigned char*) const {
        const int row0 = u.pm * 256 + wr * 64 + fr;
#pragma unroll
        for (int ai = 0; ai < 2; ++ai) {
            u32x4 gw[4];
#pragma unroll
            for (int m = 0; m < 4; ++m) gw[m] = *(const u32x4*)(G + (size_t)(row0 + ai * 128 + m * 16) * GW + 2048 + u.pn * 256 + wc * 64 + fq * 16);
#pragma unroll
            for (int m = 0; m < 4; ++m) { f32x4 a0 = acc[ai][0][m][0], b0 = acc[ai][0][m][1], a1 = acc[ai][1][m][0], b1 = acc[ai][1][m][1];
#pragma unroll
                for (int j = 0; j < 4; ++j) { a0[j] *= gq(gw[m].x, j) * (1.0f / 255.0f); b0[j] *= gq(gw[m].y, j) * (1.0f / 255.0f); a1[j] *= gq(gw[m].z, j) * (1.0f / 255.0f); b1[j] *= gq(gw[m].w, j) * (1.0f / 255.0f); }
                bf16_t* d = MIXED + (size_t)(row0 + ai * 128 + m * 16) * DM + u.pn * 256 + wc * 64 + fq * 16;
                *(u32x4*)d = pack8(a0, b0); *(u32x4*)(d + 8) = pack8(a1, b1); }
            asm volatile("" ::: "memory"); }
    }
};
struct EpiResid {
    static constexpr bool MID = false;
    __device__ __forceinline__ void stage(LAS unsigned char*, const Unit&, int, int) const {}
    const float* Xf; bf16_t* X;
    __device__ __forceinline__ void operator()(const AccT& acc, const Unit& u, int wr, int wc, int fr, int fq, const LAS unsigned char*) const {
        const int row0 = u.pm * 256 + wr * 64 + fr;
#pragma unroll
        for (int ai = 0; ai < 2; ++ai) {
            f32x4 xa[4][2], xb[4][2];
#pragma unroll
            for (int m = 0; m < 4; ++m)
#pragma unroll
                for (int bj = 0; bj < 2; ++bj) { const size_t o = (size_t)(row0 + ai * 128 + m * 16) * DM + u.pn * 256 + bj * 128 + wc * 32 + fq * 8;
                    if (Xf) { xa[m][bj] = *(const f32x4*)(Xf + o); xb[m][bj] = *(const f32x4*)(Xf + o + 4); }
                    else { const u32x4 q = *(const u32x4*)(X + o); xa[m][bj] = (f32x4){bflo(q.x), bfhi(q.x), bflo(q.y), bfhi(q.y)}; xb[m][bj] = (f32x4){bflo(q.z), bfhi(q.z), bflo(q.w), bfhi(q.w)}; } }
#pragma unroll
            for (int m = 0; m < 4; ++m)
#pragma unroll
                for (int bj = 0; bj < 2; ++bj) *(u32x4*)(X + (size_t)(row0 + ai * 128 + m * 16) * DM + u.pn * 256 + bj * 128 + wc * 32 + fq * 8) = pack8(xa[m][bj] + acc[ai][bj][m][0], xb[m][bj] + acc[ai][bj][m][1]);
            asm volatile("" ::: "memory"); }
    }
};
struct EpiSwiglu {
    static constexpr bool MID = false;
    bf16_t* ACT; int lo; const float* rsc; const float* csc;
    __device__ __forceinline__ void stage(LAS unsigned char* d, const Unit& u, int wid, int lane) const {
        if (wid == 0) { stage1k(rsc + u.pm * 256, d, lane); stage1k(csc + (size_t)u.aux * 2 * DFF + u.pn * 256, d + 1024, lane); } }
    template <class AV> __device__ __forceinline__ void operator()(const AV (&acc)[2][2][4][2], const Unit& u, int wr, int wc, int fr, int fq, const LAS unsigned char* esc) const {
        const int row0 = (u.pm - lo) * 256 + wr * 64 + fr;
        f32x4 cs[2][2];
#pragma unroll
        for (int bj = 0; bj < 2; ++bj)
#pragma unroll
            for (int n = 0; n < 2; ++n) cs[bj][n] = *(const LAS f32x4*)(esc + 1024 + (bj * 128 + wc * 32 + n * 16 + fq * 4) * 4);
        float rs8[2][4];
#pragma unroll
        for (int ai = 0; ai < 2; ++ai)
#pragma unroll
            for (int m = 0; m < 4; ++m) rs8[ai][m] = *(const LAS float*)(esc + (ai * 128 + wr * 64 + m * 16 + fr) * 4);
#pragma unroll
        for (int ai = 0; ai < 2; ++ai)
#pragma unroll
            for (int m = 0; m < 4; ++m) { const float rs = rs8[ai][m]; f32x4 a, b;
                const f32x4 g0 = deq(acc[ai][0][m][0], rs, cs[0][0]), g1 = deq(acc[ai][0][m][1], rs, cs[0][1]), u0 = deq(acc[ai][1][m][0], rs, cs[1][0]), u1 = deq(acc[ai][1][m][1], rs, cs[1][1]);
#pragma unroll
                for (int j = 0; j < 4; ++j) { a[j] = g0[j] * fast_sigmoid(g0[j]) * u0[j]; b[j] = g1[j] * fast_sigmoid(g1[j]) * u1[j]; }
                *(u32x4*)(ACT + (size_t)(row0 + ai * 128 + m * 16) * DFF + u.pn * 128 + wc * 32 + fq * 8) = pack8(a, b); }
    }
};
struct EpiYout {
    static constexpr bool MID = false;
    __device__ __forceinline__ void stage(LAS unsigned char*, const Unit&, int, int) const {}
    bf16_t* Y;
    __device__ __forceinline__ void operator()(const AccT& acc, const Unit& u, int wr, int wc, int fr, int fq, const LAS unsigned char*) const {
        const int row0 = u.pm * 256 + wr * 64 + fr;
#pragma unroll
        for (int ai = 0; ai < 2; ++ai)
#pragma unroll
            for (int m = 0; m < 4; ++m)
#pragma unroll
                for (int bj = 0; bj < 2; ++bj) *(u32x4*)(Y + (size_t)(row0 + ai * 128 + m * 16) * DM + u.pn * 256 + bj * 128 + wc * 32 + fq * 8) = pack8(acc[ai][bj][m][0], acc[ai][bj][m][1]);
    }
};

namespace att {
__device__ __forceinline__ int crow(int r, int hi) { return (r & 3) + 8 * (r >> 2) + 4 * hi; }
__device__ __forceinline__ void glds16(const void* gsrc, unsigned lds_dst) { unsigned keep;
    asm volatile("s_mov_b32 %0, m0\n\ts_mov_b32 m0, %2\n\ts_nop 0\n\tglobal_load_lds_dwordx4 %1, off\n\ts_mov_b32 m0, %0" : "=&s"(keep) : "v"(gsrc), "s"(lds_dst) : "memory"); }
__device__ __forceinline__ float swapmax(float m) { auto rr = __builtin_amdgcn_permlane32_swap(__float_as_uint(m), __float_as_uint(m), false, false); return fmaxf(__uint_as_float(rr[0]), __uint_as_float(rr[1])); }
__device__ __forceinline__ float swapsum(float m) { auto rr = __builtin_amdgcn_permlane32_swap(__float_as_uint(m), __float_as_uint(m), false, false); return __uint_as_float(rr[0]) + __uint_as_float(rr[1]); }
__device__ __forceinline__ void store_o_block(const f32x16& o, float linv, bf16_t* rowp  , int hi) {
#pragma unroll
    for (int rp = 0; rp < 2; ++rp) {
        const u32x2 X = pack4((f32x4){o[8 * rp] * linv, o[8 * rp + 1] * linv, o[8 * rp + 2] * linv, o[8 * rp + 3] * linv});
        const u32x2 Y = pack4((f32x4){o[8 * rp + 4] * linv, o[8 * rp + 5] * linv, o[8 * rp + 6] * linv, o[8 * rp + 7] * linv});
        const auto s0 = __builtin_amdgcn_permlane32_swap(X.x, Y.x, false, false), s1 = __builtin_amdgcn_permlane32_swap(X.y, Y.y, false, false);
        const u32x4 w = {s0[0], s1[0], s0[1], s1[1]};
        *(u32x4*)(rowp + 8 * (2 * rp + hi)) = w; }
}
__device__ __forceinline__ s16x4 vtr(unsigned addr) { s16x4 r; asm volatile("ds_read_b64_tr_b16 %0, %1" : "=&v"(r) : "v"(addr) : "memory"); return r; }
#define VTRO(dst, base, off) asm volatile("ds_read_b64_tr_b16 %0, %1 offset:%c2" : "=&v"(dst) : "v"(base), "i"(off) : "memory")

struct Src {
    const bf16_t* q; int qpitch;
    const bf16_t* k0; int k0pitch;
    const bf16_t* k1; int k1pitch;
    const bf16_t* v; int vpitch;
    bf16_t* o; int opitch;
};
template <int NKC, int NVB, int RD = 4>
__device__ __forceinline__ void dma_tile(const Src& S, int t, int slot, unsigned lds0, int wid, int lane) {
    constexpr int KS = NKC * 1024, VS = NVB * 4096, LDS_K = 0, LDS_V = RD * KS;
#pragma unroll
    for (int c = 0; c < (NKC + 7) / 8; ++c) { const int ch = wid + 8 * c; if (ch < NKC) {
        const bf16_t* src = (ch < 8) ? S.k0 + (size_t)(t * 64 + lane) * S.k0pitch + ch * 8 : S.k1 + (size_t)(t * 64 + lane) * S.k1pitch + (ch - 8) * 8;
        glds16(src, (unsigned)__builtin_amdgcn_readfirstlane(lds0 + LDS_K + slot * KS + ch * 1024)); } }
#pragma unroll
    for (int c = 0; c < (NVB * 4 + 7) / 8; ++c) { const int p = wid + 8 * c; if (p < NVB * 4) {
        const bf16_t* src = S.v + (size_t)(t * 64 + 16 * (p & 3) + (lane >> 2)) * S.vpitch + (p >> 2) * 32 + (lane & 3) * 8;
        glds16(src, (unsigned)__builtin_amdgcn_readfirstlane(lds0 + LDS_V + slot * VS + p * 1024)); } }
}
__device__ __forceinline__ void wait_vm_bar(int n) {
    if (n >= 4) asm volatile("s_waitcnt vmcnt(4) lgkmcnt(0)\n\ts_barrier" ::: "memory");
    else if (n == 3) asm volatile("s_waitcnt vmcnt(3) lgkmcnt(0)\n\ts_barrier" ::: "memory");
    else if (n == 2) asm volatile("s_waitcnt vmcnt(2) lgkmcnt(0)\n\ts_barrier" ::: "memory");
    else if (n == 1) asm volatile("s_waitcnt vmcnt(1) lgkmcnt(0)\n\ts_barrier" ::: "memory");
    else asm volatile("s_waitcnt vmcnt(0) lgkmcnt(0)\n\ts_barrier" ::: "memory");
}
template <int NKC, int NVB, int MODE>
__device__ __forceinline__ void unit(LAS unsigned char* lds, const Src& S, int t_lo, int t_hi, int qpos0  , float sink_l2) {
    constexpr int KS = NKC * 1024, VS = NVB * 4096, RD = 4, LDS_K = 0, LDS_V = RD * KS;
    const int tid = opq_v((int)threadIdx.x), lane = tid & 63, r32 = lane & 31, hi = lane >> 5; const int wid = __builtin_amdgcn_readfirstlane(tid >> 6), grp = wid >> 2;
    const unsigned lds0 = (unsigned)(uintptr_t)lds;
    const int ops = (NKC + 7 - wid) / 8 + (NVB * 4) / 8;
    bf16x8 qr[NKC / 2];
#pragma unroll
    for (int d0 = 0; d0 < NKC / 2; ++d0) qr[d0] = *(const bf16x8*)(S.q + (size_t)r32 * S.qpitch + d0 * 16 + hi * 8);
    float m_run = (MODE == 0) ? sink_l2 : 0.0f, l_run = (MODE == 0 && hi == 0) ? 1.0f : 0.0f; bool first = (MODE != 0);
    f32x16 o[NVB];
#pragma unroll
    for (int d = 0; d < NVB; ++d) o[d] = f32x16{};
    const int qi = qpos0 + wid * 32 + r32, qw0 = qpos0 + wid * 32;
    f32x16 p0 = f32x16{}, p1 = f32x16{};
#define AT_ACTIVE(t) ((MODE != 0) || ((64 * (t) + 63 >= qw0 - 128) && (64 * (t) <= qw0 + 31 + 128)))
#define AT_QK(t) do { const LAS unsigned char* kb_ = lds + LDS_K + (((t) - t_lo) % RD) * KS + hi * 1024 + r32 * 16; p0 = f32x16{}; p1 = f32x16{}; \
        _Pragma("unroll") for (int d0 = 0; d0 < NKC / 2; ++d0) { const bf16x8 b0_ = *(const LAS bf16x8*)(kb_ + d0 * 2048), b1_ = *(const LAS bf16x8*)(kb_ + d0 * 2048 + 512); \
            p0 = __builtin_amdgcn_mfma_f32_32x32x16_bf16(b0_, qr[d0], p0, 0, 0, 0); p1 = __builtin_amdgcn_mfma_f32_32x32x16_bf16(b1_, qr[d0], p1, 0, 0, 0); } } while (0)
#define AT_SMPV(t) do { \
        if (MODE == 0) { _Pragma("unroll") for (int r = 0; r < 16; ++r) { const int kv_ = 64 * (t) + crow(r, hi); int e0_ = kv_ - qi; e0_ = e0_ < 0 ? -e0_ : e0_; int e1_ = kv_ + 32 - qi; e1_ = e1_ < 0 ? -e1_ : e1_; \
            if (e0_ > 128) p0[r] = -INFINITY; if (e1_ > 128) p1[r] = -INFINITY; } } \
        if (first) {   \
            float mx_[8]; _Pragma("unroll") for (int r = 0; r < 8; ++r) mx_[r] = fmaxf(fmaxf(p0[r], p0[r + 8]), fmaxf(p1[r], p1[r + 8])); \
            float rm_ = fmaxf(fmaxf(fmaxf(mx_[0], mx_[1]), fmaxf(mx_[2], mx_[3])), fmaxf(fmaxf(mx_[4], mx_[5]), fmaxf(mx_[6], mx_[7]))); m_run = swapmax(rm_); first = false; } \
        float sm_[4] = {0.f, 0.f, 0.f, 0.f}; \
        _Pragma("unroll") for (int r = 0; r < 16; ++r) { p0[r] = __builtin_amdgcn_exp2f(p0[r] - m_run); p1[r] = __builtin_amdgcn_exp2f(p1[r] - m_run); sm_[r & 3] += p0[r] + p1[r]; } \
        float ts_ = (sm_[0] + sm_[1]) + (sm_[2] + sm_[3]); \
        { const float tot_ = swapsum(ts_); \
          if (__any(tot_ > 1.0e12f)) { const float dl_ = tot_ > 1.0e12f ? ceilf(__builtin_amdgcn_logf(tot_)) : 0.f, sc_ = __builtin_amdgcn_exp2f(-dl_); m_run += dl_; l_run *= sc_; ts_ *= sc_; \
              _Pragma("unroll") for (int r = 0; r < 16; ++r) { p0[r] *= sc_; p1[r] *= sc_; } \
              _Pragma("unroll") for (int d = 0; d < NVB; ++d) _Pragma("unroll") for (int r = 0; r < 16; ++r) o[d][r] *= sc_; } } \
        l_run += ts_; \
        u32x4 pw_[4]; \
        pw_[0] = (u32x4){cvtpk(p0[0], p0[1]), cvtpk(p0[2], p0[3]), cvtpk(p0[4], p0[5]), cvtpk(p0[6], p0[7])}; pw_[1] = (u32x4){cvtpk(p0[8], p0[9]), cvtpk(p0[10], p0[11]), cvtpk(p0[12], p0[13]), cvtpk(p0[14], p0[15])}; \
        pw_[2] = (u32x4){cvtpk(p1[0], p1[1]), cvtpk(p1[2], p1[3]), cvtpk(p1[4], p1[5]), cvtpk(p1[6], p1[7])}; pw_[3] = (u32x4){cvtpk(p1[8], p1[9]), cvtpk(p1[10], p1[11]), cvtpk(p1[12], p1[13]), cvtpk(p1[14], p1[15])}; \
        const unsigned vb_ = lds0 + LDS_V + (((t) - t_lo) % RD) * VS + ((lane >> 4) & 1) * 32 + (lane & 3) * 8 + (4 * hi + ((lane & 15) >> 2)) * 64; \
        _Pragma("unroll") for (int dp = 0; dp < NVB; dp += 2) { s16x4 lo_[2][4], hh_[2][4]; \
            _Pragma("unroll") for (int dd = 0; dd < 2; ++dd) _Pragma("unroll") for (int ks = 0; ks < 4; ++ks) { lo_[dd][ks] = vtr(vb_ + (dp + dd) * 4096 + ks * 1024); hh_[dd][ks] = vtr(vb_ + (dp + dd) * 4096 + ks * 1024 + 512); } \
            asm volatile("s_waitcnt lgkmcnt(0)" ::: "memory"); __builtin_amdgcn_sched_barrier(0); \
            _Pragma("unroll") for (int ks = 0; ks < 4; ++ks) _Pragma("unroll") for (int dd = 0; dd < 2; ++dd) { \
                const bf16x8 vf_ = (bf16x8){lo_[dd][ks][0], lo_[dd][ks][1], lo_[dd][ks][2], lo_[dd][ks][3], hh_[dd][ks][0], hh_[dd][ks][1], hh_[dd][ks][2], hh_[dd][ks][3]}; \
                o[dp + dd] = __builtin_amdgcn_mfma_f32_32x32x16_bf16(vf_, __builtin_bit_cast(bf16x8, pw_[ks]), o[dp + dd], 0, 0, 0); } } } while (0)
    dma_tile<NKC, NVB>(S, t_lo, 0, lds0, wid, lane);
    if (t_lo + 1 < t_hi) dma_tile<NKC, NVB>(S, t_lo + 1, 1, lds0, wid, lane);
    for (int t = t_lo; t < t_hi; ++t) {
        wait_vm_bar((t + 1 < t_hi) ? ops : 0);
        if (t + 2 < t_hi) dma_tile<NKC, NVB>(S, t + 2, (t + 2 - t_lo) % RD, lds0, wid, lane);
        if (grp == 0) { if (AT_ACTIVE(t)) { AT_QK(t); AT_SMPV(t); } }
        else { if (t > t_lo && AT_ACTIVE(t - 1)) AT_SMPV(t - 1); if (AT_ACTIVE(t)) AT_QK(t); }
    }
    if (grp == 1 && AT_ACTIVE(t_hi - 1)) AT_SMPV(t_hi - 1);
    const float linv = 1.0f / swapsum(l_run);
#pragma unroll
    for (int d = 0; d < NVB; ++d) store_o_block(o[d], linv, S.o + (size_t)r32 * S.opitch + 32 * d, hi);
    asm volatile("s_waitcnt lgkmcnt(0)\n\ts_barrier" ::: "memory");
#undef AT_ACTIVE
#undef AT_QK
#undef AT_SMPV
}

template <int NKC, int NVB>
__device__ __forceinline__ void unit_q64(LAS unsigned char* lds, const Src& S, int t_lo, int t_hi) {
    constexpr int KS = NKC * 1024, VS = NVB * 4096, RD = 4, LDS_K = 0, LDS_V = RD * KS;
    const int tid = opq_v((int)threadIdx.x), lane = tid & 63, r32 = lane & 31, hi = lane >> 5; const int wid = __builtin_amdgcn_readfirstlane(tid >> 6);
    const unsigned lds0 = (unsigned)(uintptr_t)lds;
    const int ops = (NKC + 7 - wid) / 8 + (NVB * 4) / 8;
    bf16x8 qa[NKC / 2], qb[NKC / 2];
#pragma unroll
    for (int d0 = 0; d0 < NKC / 2; ++d0) { qa[d0] = *(const bf16x8*)(S.q + (size_t)r32 * S.qpitch + d0 * 16 + hi * 8); qb[d0] = *(const bf16x8*)(S.q + (size_t)(32 + r32) * S.qpitch + d0 * 16 + hi * 8); }
    float ma = 0.f, la = 0.f, mb = 0.f, lb = 0.f; bool first = true;
    f32x16 oa[NVB], ob[NVB];
#pragma unroll
    for (int d = 0; d < NVB; ++d) { oa[d] = f32x16{}; ob[d] = f32x16{}; }
#define Q64_SM(P0, P1, M, L, O, PW) do { \
        if (first) {   \
            float mx_[8]; _Pragma("unroll") for (int r = 0; r < 8; ++r) mx_[r] = fmaxf(fmaxf(P0[r], P0[r + 8]), fmaxf(P1[r], P1[r + 8])); \
            float rm_ = fmaxf(fmaxf(fmaxf(mx_[0], mx_[1]), fmaxf(mx_[2], mx_[3])), fmaxf(fmaxf(mx_[4], mx_[5]), fmaxf(mx_[6], mx_[7]))); M = swapmax(rm_); } \
        float sm_[4] = {0.f, 0.f, 0.f, 0.f}; \
        _Pragma("unroll") for (int r = 0; r < 16; ++r) { P0[r] = __builtin_amdgcn_exp2f(P0[r] - M); P1[r] = __builtin_amdgcn_exp2f(P1[r] - M); sm_[r & 3] += P0[r] + P1[r]; } \
        float ts_ = (sm_[0] + sm_[1]) + (sm_[2] + sm_[3]); \
        { const float tot_ = swapsum(ts_); \
          if (__any(tot_ > 1.0e12f)) { const float dl_ = tot_ > 1.0e12f ? ceilf(__builtin_amdgcn_logf(tot_)) : 0.f, sc_ = __builtin_amdgcn_exp2f(-dl_); M += dl_; L *= sc_; ts_ *= sc_; \
              _Pragma("unroll") for (int r = 0; r < 16; ++r) { P0[r] *= sc_; P1[r] *= sc_; } \
              _Pragma("unroll") for (int d = 0; d < NVB; ++d) _Pragma("unroll") for (int r = 0; r < 16; ++r) O[d][r] *= sc_; } } \
        L += ts_; \
        PW[0] = (u32x4){cvtpk(P0[0], P0[1]), cvtpk(P0[2], P0[3]), cvtpk(P0[4], P0[5]), cvtpk(P0[6], P0[7])}; PW[1] = (u32x4){cvtpk(P0[8], P0[9]), cvtpk(P0[10], P0[11]), cvtpk(P0[12], P0[13]), cvtpk(P0[14], P0[15])}; \
        PW[2] = (u32x4){cvtpk(P1[0], P1[1]), cvtpk(P1[2], P1[3]), cvtpk(P1[4], P1[5]), cvtpk(P1[6], P1[7])}; PW[3] = (u32x4){cvtpk(P1[8], P1[9]), cvtpk(P1[10], P1[11]), cvtpk(P1[12], P1[13]), cvtpk(P1[14], P1[15])}; \
        __builtin_amdgcn_sched_barrier(0); } while (0)
#define Q64_SM_NB(P0, P1, M, L, O, PW) do { \
        if (first) {   \
            float mx_[8]; _Pragma("unroll") for (int r = 0; r < 8; ++r) mx_[r] = fmaxf(fmaxf(P0[r], P0[r + 8]), fmaxf(P1[r], P1[r + 8])); \
            float rm_ = fmaxf(fmaxf(fmaxf(mx_[0], mx_[1]), fmaxf(mx_[2], mx_[3])), fmaxf(fmaxf(mx_[4], mx_[5]), fmaxf(mx_[6], mx_[7]))); M = swapmax(rm_); } \
        float sm_[4] = {0.f, 0.f, 0.f, 0.f}; \
        _Pragma("unroll") for (int r = 0; r < 16; ++r) { P0[r] = __builtin_amdgcn_exp2f(P0[r] - M); P1[r] = __builtin_amdgcn_exp2f(P1[r] - M); sm_[r & 3] += P0[r] + P1[r]; } \
        float ts_ = (sm_[0] + sm_[1]) + (sm_[2] + sm_[3]); \
        { const float tot_ = swapsum(ts_); \
          if (__any(tot_ > 1.0e12f)) { const float dl_ = tot_ > 1.0e12f ? ceilf(__builtin_amdgcn_logf(tot_)) : 0.f, sc_ = __builtin_amdgcn_exp2f(-dl_); M += dl_; L *= sc_; ts_ *= sc_; \
              _Pragma("unroll") for (int r = 0; r < 16; ++r) { P0[r] *= sc_; P1[r] *= sc_; } \
              _Pragma("unroll") for (int d = 0; d < NVB; ++d) _Pragma("unroll") for (int r = 0; r < 16; ++r) O[d][r] *= sc_; } } \
        L += ts_; \
        PW[0] = (u32x4){cvtpk(P0[0], P0[1]), cvtpk(P0[2], P0[3]), cvtpk(P0[4], P0[5]), cvtpk(P0[6], P0[7])}; PW[1] = (u32x4){cvtpk(P0[8], P0[9]), cvtpk(P0[10], P0[11]), cvtpk(P0[12], P0[13]), cvtpk(P0[14], P0[15])}; \
        PW[2] = (u32x4){cvtpk(P1[0], P1[1]), cvtpk(P1[2], P1[3]), cvtpk(P1[4], P1[5]), cvtpk(P1[6], P1[7])}; PW[3] = (u32x4){cvtpk(P1[8], P1[9]), cvtpk(P1[10], P1[11]), cvtpk(P1[12], P1[13]), cvtpk(P1[14], P1[15])}; \
        } while (0)
    dma_tile<NKC, NVB, RD>(S, t_lo, 0, lds0, wid, lane);
    if (t_lo + 1 < t_hi) dma_tile<NKC, NVB, RD>(S, t_lo + 1, 1, lds0, wid, lane);
    for (int t = t_lo; t < t_hi; ++t) {
        const int slot = (t - t_lo) % RD;
        wait_vm_bar((t + 1 < t_hi) ? ops : 0);
        if (t + 2 < t_hi) dma_tile<NKC, NVB, RD>(S, t + 2, (t + 2 - t_lo) % RD, lds0, wid, lane);
        const LAS unsigned char* kb = lds + LDS_K + slot * KS + hi * 1024 + r32 * 16;
        f32x16 s0a = f32x16{}, s0b = f32x16{}, s1a = f32x16{}, s1b = f32x16{};
#pragma unroll
        for (int d0 = 0; d0 < NKC / 2; ++d0) {
            const bf16x8 b0 = *(const LAS bf16x8*)(kb + d0 * 2048), b1 = *(const LAS bf16x8*)(kb + d0 * 2048 + 512);
            s0a = __builtin_amdgcn_mfma_f32_32x32x16_bf16(b0, qa[d0], s0a, 0, 0, 0); s0b = __builtin_amdgcn_mfma_f32_32x32x16_bf16(b1, qa[d0], s0b, 0, 0, 0);
            s1a = __builtin_amdgcn_mfma_f32_32x32x16_bf16(b0, qb[d0], s1a, 0, 0, 0); s1b = __builtin_amdgcn_mfma_f32_32x32x16_bf16(b1, qb[d0], s1b, 0, 0, 0); }
        __builtin_amdgcn_sched_barrier(0);
        u32x4 pwa[4], pwb[4];
        const unsigned vb = lds0 + LDS_V + slot * VS + ((lane >> 4) & 1) * 32 + (lane & 3) * 8 + (4 * hi + ((lane & 15) >> 2)) * 64;
        s16x4 lo[NVB][4], hh[NVB][4];
#pragma unroll
        for (int d = 0; d < NVB; ++d)
#pragma unroll
            for (int ks = 0; ks < 4; ++ks) { VTRO(lo[d][ks], vb, d * 4096 + ks * 1024); VTRO(hh[d][ks], vb, d * 4096 + ks * 1024 + 512); }
        __builtin_amdgcn_sched_barrier(0);
        Q64_SM(s0a, s0b, ma, la, oa, pwa);
        asm volatile("s_waitcnt lgkmcnt(0)" ::: "memory"); __builtin_amdgcn_sched_barrier(0);
#pragma unroll
        for (int ks = 0; ks < 4; ++ks)
#pragma unroll
            for (int d = 0; d < NVB; ++d) { const bf16x8 vf = (bf16x8){lo[d][ks][0], lo[d][ks][1], lo[d][ks][2], lo[d][ks][3], hh[d][ks][0], hh[d][ks][1], hh[d][ks][2], hh[d][ks][3]};
                oa[d] = __builtin_amdgcn_mfma_f32_32x32x16_bf16(vf, __builtin_bit_cast(bf16x8, pwa[ks]), oa[d], 0, 0, 0); }
        Q64_SM_NB(s1a, s1b, mb, lb, ob, pwb);
#pragma unroll
        for (int i = 0; i < 8; ++i) { __builtin_amdgcn_sched_group_barrier(0x008, 1, 0); __builtin_amdgcn_sched_group_barrier(0x002, 12, 0); }
        __builtin_amdgcn_sched_barrier(0);
#pragma unroll
        for (int ks = 0; ks < 4; ++ks)
#pragma unroll
            for (int d = 0; d < NVB; ++d) { const bf16x8 vf = (bf16x8){lo[d][ks][0], lo[d][ks][1], lo[d][ks][2], lo[d][ks][3], hh[d][ks][0], hh[d][ks][1], hh[d][ks][2], hh[d][ks][3]};
                ob[d] = __builtin_amdgcn_mfma_f32_32x32x16_bf16(vf, __builtin_bit_cast(bf16x8, pwb[ks]), ob[d], 0, 0, 0); }
        __builtin_amdgcn_sched_barrier(0);
        first = false;
    }
    const float lia = 1.0f / swapsum(la), lib = 1.0f / swapsum(lb);
#pragma unroll
    for (int d = 0; d < NVB; ++d) { store_o_block(oa[d], lia, S.o + (size_t)r32 * S.opitch + 32 * d, hi); store_o_block(ob[d], lib, S.o + (size_t)(32 + r32) * S.opitch + 32 * d, hi); }
    asm volatile("s_waitcnt lgkmcnt(0)\n\ts_barrier" ::: "memory");
#undef Q64_SM
#undef Q64_SM_NB
}

}
#define SC_AFTER_PROLOGUE() do {} while (0)
#define SC_AFTER_INPROJ(l) do {} while (0)
#define SC_AFTER_UP(l) do {} while (0)
#define SC_AFTER_MLA(l) do {} while (0)
#define SC_AFTER_BRANCH(l) do {} while (0)
#define SC_AFTER_WOUT(l) do {} while (0)
#define SC_AFTER_NORM2(l) do {} while (0)
#define SC_AFTER_GU(l) do {} while (0)
#define SC_AFTER_DOWN(l) do {} while (0)
#define SC_AFTER_ROUTE(l) do {} while (0)
#define SC_AFTER_MOEGU(l, h) do {} while (0)
#define SC_AFTER_MOED(l, h) do {} while (0)
#define SC_FINAL() do {} while (0)

struct Args { const float* in[23]; float* out; unsigned char* ws; };
#define WSP(type, off) ((type*)(F.ws + (off)))
#define PHASE() Frame Fp = F; Fp.ws = opq_p(F.ws); Fp.in = opq_p(F.in); Fp.out = opq_p(F.out); Fp.tid = opq_v((int)threadIdx.x); Fp.lane = Fp.tid & 63; Fp.wave = __builtin_amdgcn_readfirstlane(Fp.tid >> 6); (void)Fp
#define FWS(type, off) ((type*)(Fp.ws + (off)))
#define X_ FWS(bf16_t, WS_XB)
#define H_ FWS(bf16_t, WS_H)
#define Pb_ FWS(bf16_t, WS_R + R_P)
#define Gb_ FWS(bf16_t, WS_R + R_G)
#define QB_ FWS(bf16_t, WS_R + R_QB)
#define KVB_ FWS(bf16_t, WS_R + R_KVB)
#define Yb_ FWS(bf16_t, WS_R + R_Y)
#define MEMN_ FWS(bf16_t, WS_MEMN)
#define MEMKV_ FWS(bf16_t, WS_MEMKV)
#define ACT_ FWS(bf16_t, WS_R + R_ACT)
#define ASORT_ FWS(bf16_t, WS_R + R_ASORT)
#define YOUT_ FWS(bf16_t, WS_R + R_YOUT)
#define SSQ_ FWS(float, WS_MISC + MS_SSQ)
#define TEXP_ FWS(const int, WS_MISC + MS_TEXP)
#define POS_ ((const int*)Fp.in[I_POS])
#define HSC_ FWS(float, WS_MISC + MS_HSC)
#define ASC_ FWS(float, WS_MISC + MS_ASC)
#define WSIN_ FWS(float, WS_MISC + MS_WSIN)
#define WSGU_ FWS(float, WS_MISC + MS_WSGU)

#define GRID_BAR() xcd_barrier(bar)
#ifndef WGM_GU
#define WGM_GU 4
#endif
#ifndef WGM_IN
#define WGM_IN 4
#endif
template <int l> __device__ __forceinline__ void layer_body(const Frame& F, const XcdBarrier& bar, const int bx) {
        if (l > 0) {
            PHASE();
            prep_ffn_weights(Fp, l);
            if ((l & 1) != 0) norm_phase(Fp, nullptr, X_, Fp.in[I_GMIX] + l * DM, false, true);
            if ((l & 1) == 0) norm_phase(Fp, nullptr, X_, Fp.in[I_GMIX] + l * DM, true, true);
            GRID_BAR();
        }
        {   PHASE();
            ProbSimple p{DM, DM, DM, (const char*)H_, (const char*)wmix(Fp, l, WL_IN)}; pg8::StaticOrder S; S.init(T / 256, NT_IN, Fp.G, bx, 0, WGM_IN);
            EpiInproj E{Pb_, Gb_, SSQ_, POS_, HSC_, WSIN_ + l * NT_IN * 256}; pg8::gemm_phase<true>(Fp.lds, p, S, E); }
        if (l == 0) { PHASE();
            ProbSimple p{DM, DM * 2, DM * 2, (const char*)MEMN_, (const char*)FWS(bf16_t, WS_WMKV)}; pg8::StaticOrder S; S.init(NB * MEML / 256, 16, Fp.G, bx);
            EpiPlain E{MEMKV_, 4096}; pg8::gemm_phase(Fp.lds, p, S, E); }
        GRID_BAR();
        SC_AFTER_INPROJ(l);
        {   PHASE();
            ProbUp p{UPK, PW * 2, UPK * 2, (const char*)(Pb_ + P_CQ), (const char*)wmix(Fp, l, WL_UP)}; pg8::StaticOrder S; S.init(T / 256, UPN / 256, Fp.G, bx);
            EpiUp E{QB_, KVB_, SSQ_, POS_}; pg8::gemm_phase(Fp.lds, p, S, E); }
        {   PHASE();
            for (int i = Fp.vcu; i < 1024; i += Fp.G) {
                const int hl = i & 3, qb = (i >> 2) & 15, kvh = (i >> 6) & 1, b = i >> 7, h = kvh * 4 + hl; const size_t rowb = (size_t)b * SEQ; const int q0 = qb * 256;
                att::Src s; s.q = Pb_ + (rowb + q0 + Fp.wave * 32) * PW + P_QA + h * 64; s.qpitch = PW; s.k0 = Pb_ + rowb * PW + P_KA + kvh * 64; s.k0pitch = PW; s.k1 = s.k0; s.k1pitch = PW;
                s.v = Pb_ + rowb * PW + P_VA + kvh * 64; s.vpitch = PW; s.o = Yb_ + (rowb + q0 + Fp.wave * 32) * YW + h * 64; s.opitch = YW;
                const int t_lo = (q0 / 64 - 2) < 0 ? 0 : (q0 / 64 - 2), t_hi = (q0 / 64 + 6) > SEQ / 64 ? SEQ / 64 : (q0 / 64 + 6);
                att::unit<8, 2, 0>(Fp.lds, s, t_lo, t_hi, q0, Fp.in[I_SINK][l * 8 + h] * LOG2E);
            } }
        {   PHASE();
            for (int i = Fp.vcu; i < 512; i += Fp.G) {
                const int qb = i & 15, h = (i >> 4) & 3, b = i >> 6; const size_t rowq = (size_t)b * SEQ + qb * 256 + Fp.wave * 32;
                att::Src s; s.q = Pb_ + rowq * PW + P_QM + h * 128; s.qpitch = PW; s.k0 = MEMKV_ + (size_t)b * MEML * 4096 + l * 1024 + h * 128; s.k0pitch = 4096; s.k1 = s.k0 + 64; s.k1pitch = 4096;
                s.v = MEMKV_ + (size_t)b * MEML * 4096 + l * 1024 + 512 + h * 128; s.vpitch = 4096; s.o = Yb_ + rowq * YW + 1024 + h * 128; s.opitch = YW;
                att::unit<16, 4, 1>(Fp.lds, s, 0, MEML / 64, 0, 0.f);
            } }
        GRID_BAR();
        SC_AFTER_UP(l);
        {   PHASE();
            for (int i = Fp.vcu; i < 512; i += Fp.G) {
                const int qb = i & 7, h = (i >> 3) & 7, b = i >> 6; const size_t rowb = (size_t)b * SEQ, rowq = rowb + qb * 512 + Fp.wave * 64;
                att::Src s; s.q = QB_ + rowq * QBW + h * 96; s.qpitch = QBW; s.k0 = KVB_ + rowb * KVW + h * 128; s.k0pitch = KVW; s.k1 = Pb_ + rowb * PW + P_KR; s.k1pitch = PW;
                s.v = KVB_ + rowb * KVW + h * 128 + 64; s.vpitch = KVW; s.o = Yb_ + rowq * YW + 512 + h * 64; s.opitch = YW;
                att::unit_q64<12, 2>(Fp.lds, s, 0, SEQ / 64);
            } }
        GRID_BAR();
        SC_AFTER_MLA(l);
        {   PHASE();
            ProbSimple p{1536, YW * 2, 1536 * 2, (const char*)Yb_, (const char*)wmix(Fp, l, WL_BR)}; pg8::StaticOrder S; S.init(T / 256, DM / 256, Fp.G, bx);
            EpiBranch E{(const unsigned char*)Gb_, H_}; pg8::gemm_phase(Fp.lds, p, S, E); }
        GRID_BAR();
        SC_AFTER_BRANCH(l);
        if (l == 0) {   PHASE();
            ProbSimple p{DM, DM * 2, DM * 2, (const char*)H_, (const char*)wmix(Fp, l, WL_OUT)}; pg8::StaticOrder S; S.init(T / 256, DM / 256, Fp.G, bx);
            EpiResid E{Fp.in[I_X], X_}; pg8::gemm_phase(Fp.lds, p, S, E); }
        if (l != 0) {   PHASE();
            ProbSimple p{DM, DM * 2, DM * 2, (const char*)H_, (const char*)wmix(Fp, l, WL_OUT)}; pg8::StaticOrder S; S.init(T / 256, DM / 256, Fp.G, bx);
            EpiResid E{nullptr, X_}; pg8::gemm_phase(Fp.lds, p, S, E); }
        GRID_BAR();
        SC_AFTER_WOUT(l);
        if ((l & 1) == 0) {
            {   PHASE(); norm_phase(Fp, nullptr, X_, Fp.in[I_GFFN] + l * DM, false, GU_I8(l) != 0); }
            GRID_BAR();
            SC_AFTER_NORM2(l);
            {   PHASE();
                constexpr bool i8 = GU_I8(l) != 0; constexpr unsigned eb = i8 ? 1 : 2;
                ProbSimple p{DM, DM * eb, DM * eb, (const char*)H_, (const char*)FWS(bf16_t, WS_WFFN + WF_GU)}; pg8::StaticOrder S; S.init(T / 256, 2 * DFF / 256, Fp.G, bx, 0, WGM_GU);
                EpiSwiglu E{ACT_, 0, HSC_, WSGU_}; pg8::gemm_phase<i8>(Fp.lds, p, S, E); }
            GRID_BAR();
            SC_AFTER_GU(l);
            {   PHASE();
                ProbSimple p{DFF, DFF * 2, DFF * 2, (const char*)ACT_, (const char*)FWS(bf16_t, WS_WFFN + WF_D)}; pg8::StaticOrder S; S.init(T / 256, DM / 256, Fp.G, bx, 1);
                EpiResid E{nullptr, X_}; pg8::gemm_phase(Fp.lds, p, S, E); }
            GRID_BAR();
            SC_AFTER_DOWN(l);
        } else {
            {   PHASE(); norm_router_phase(Fp, X_, Fp.in[I_GFFN] + l * DM, Fp.in[I_WR] + (size_t)(l >> 1) * DM * NE, GU_I8(l) != 0); }
            GRID_BAR();
            {   PHASE(); moe_assign_phase(Fp, GU_I8(l) != 0); }
            GRID_BAR();
            SC_AFTER_ROUTE(l);
            {   constexpr int half = 0; (void)half;
                {   PHASE();
                    const int nrt = __builtin_amdgcn_readfirstlane(TEXP_[MAXRT]);
                    constexpr bool i8 = GU_I8(l) != 0; constexpr unsigned eb = i8 ? 1 : 2;
                    ProbMoe p{DM, DM * eb, DM * eb, (const char*)ASORT_, (const char*)FWS(bf16_t, WS_WFFN + WF_GU), 0}; MoeOrder S; S.base.init(nrt, 2 * DFF / 256, Fp.G, bx, 0, WGM_GU); S.lo = 0; S.texp = TEXP_;
                    EpiSwiglu E{ACT_, 0, ASC_, WSGU_}; pg8::gemm_phase<i8>(Fp.lds, p, S, E); }
                GRID_BAR();
                SC_AFTER_MOEGU(l, half);
                {   PHASE();
                    const int nrt = __builtin_amdgcn_readfirstlane(TEXP_[MAXRT]);
                    ProbMoe p{DFF, DFF * 2, DFF * 2, (const char*)ACT_, (const char*)FWS(bf16_t, WS_WFFN + WF_D), 0}; MoeOrder S; S.base.init(nrt, DM / 256, Fp.G, bx, 1); S.lo = 0; S.texp = TEXP_;
                    EpiYout E{YOUT_}; pg8::gemm_phase(Fp.lds, p, S, E); }
                GRID_BAR();
                SC_AFTER_MOED(l, half);
            }
        }
    }

__global__ void __launch_bounds__(NWAVES * 64, 2) fwd(Args args) {
    extern __shared__ __attribute__((aligned(16))) unsigned char lds_raw[];
    Frame F;
    F.lds = (LAS unsigned char*)lds_raw;
    F.MISC = (volatile LAS unsigned*)(F.lds + LDSCTL_OFF);
    F.tid = threadIdx.x; F.lane = F.tid & 63; F.wave = __builtin_amdgcn_readfirstlane(F.tid >> 6);
    F.G = gridDim.x; { const int bx = blockIdx.x; F.vcu = (F.G % 8 == 0) ? (bx % 8) * (F.G / 8) + bx / 8 : bx; }
    F.ws = args.ws; F.ctl = (gu32*)(args.ws + WS_CTL); F.out = args.out;
    F.in = (const float* const*)__builtin_amdgcn_kernarg_segment_ptr();
    for (int u = F.tid; u < (LDS_BYTES - LDSCTL_OFF) / 4; u += NWAVES * 64) ((LAS unsigned*)(F.lds + LDSCTL_OFF))[u] = 0u;
    __syncthreads();
    XcdBarrier bar = xcd_barrier_post((unsigned*)(F.ctl + CW_BAR), F.MISC + 8);

    const int bx = (int)blockIdx.x;

    {   PHASE();
        prep_mixer_weights(Fp);
        memnorm_phase(Fp);
        prep_ffn_weights(Fp, 0);
        norm_phase(Fp, Fp.in[I_X], nullptr, Fp.in[I_GMIX], false, true); }
    GRID_BAR();
    SC_AFTER_PROLOGUE();

    layer_body<0>(F, bar, bx); layer_body<1>(F, bar, bx); layer_body<2>(F, bar, bx); layer_body<3>(F, bar, bx);
    {   PHASE(); final_norm_phase(Fp, X_, Fp.out, Fp.in[I_GFIN], true); }
    SC_FINAL();
}

extern "C" void kernel_launch(void* const* d_in, const int* in_sizes, int n_in, void* d_out, int out_size, void* d_ws, size_t ws_size, hipStream_t stream) {
    static int grid = 0;
    if (grid == 0) {
        if (n_in != 23 || out_size != T * DM || ws_size < WS_END) { fprintf(stderr, "kernel_launch: unexpected problem (n_in %d, out %d, ws %zu < %zu)\n", n_in, out_size, ws_size, (size_t)WS_END); grid = -1; return; }
        int dev = 0, cus = 0;
        if (hipGetDevice(&dev) != hipSuccess || hipDeviceGetAttribute(&cus, hipDeviceAttributeMultiprocessorCount, dev) != hipSuccess) { grid = -1; return; }
        if (hipFuncSetAttribute((const void*)fwd, hipFuncAttributeMaxDynamicSharedMemorySize, LDS_BYTES) != hipSuccess) { fprintf(stderr, "kernel_launch: hipFuncSetAttribute failed\n"); grid = -1; return; }
        int per_cu = 0;
        if (hipOccupancyMaxActiveBlocksPerMultiprocessor(&per_cu, (const void*)fwd, NWAVES * 64, LDS_BYTES) != hipSuccess || per_cu < 1) fprintf(stderr, "kernel_launch: occupancy query says %d\n", per_cu);
        (void)hipGetLastError();
        grid = cus;
    }
    if (grid < 0) return;
    if (hipMemsetAsync((char*)d_ws + WS_CTL, 0, CTL_ZERO_BYTES, stream) != hipSuccess) return;
    Args a{};
    for (int i = 0; i < 23; ++i) a.in[i] = (const float*)d_in[i];
    a.out = (float*)d_out; a.ws = (unsigned char*)d_ws;
    hipLaunchKernelGGL(fwd, dim3(grid), dim3(NWAVES * 64), LDS_BYTES, stream, a);
}
```

```cpp
#include <hip/hip_runtime.h>
#include <cstdio>
#include <cstdint>

#ifndef SELFCHECK
#define SELFCHECK 0
#endif
#ifndef GU_I8_MASK
#define GU_I8_MASK 0xF
#endif
#define GU_I8(l) ((((unsigned)GU_I8_MASK) >> (l)) & 1u)

#define GAS __attribute__((address_space(1)))
#define LAS __attribute__((address_space(3)))
typedef unsigned short bf16_t;
typedef short bf16x8 __attribute__((ext_vector_type(8)));
typedef short s16x4 __attribute__((ext_vector_type(4)));
typedef short v4i16_t __attribute__((ext_vector_type(4)));
typedef float f32x2 __attribute__((ext_vector_type(2)));
typedef float f32x4 __attribute__((ext_vector_type(4)));
typedef float f32x16 __attribute__((ext_vector_type(16)));
typedef unsigned u32x2 __attribute__((ext_vector_type(2)));
typedef unsigned u32x4 __attribute__((ext_vector_type(4)));
typedef int i32x4 __attribute__((ext_vector_type(4)));
typedef GAS unsigned gu32;
#define RLX_AGENT __ATOMIC_RELAXED, __HIP_MEMORY_SCOPE_AGENT

constexpr int NB = 8, SEQ = 4096, T = NB * SEQ, DM = 1024, DEPTH = 4, MEML = 256, DFF = 3584, NE = 8;
constexpr int INW = 4768;
constexpr int PW = 1792;
constexpr int GW = 3072;
constexpr int QBW = 768, KVW = 1024, YW = 1536;
constexpr int NT_IN = 19;
constexpr int P_QA = 0, P_KA = 512, P_VA = 640, P_CQ = 768, P_CKV = 1024, P_KR = 1152, P_QM = 1280;
constexpr int UPK = 256, UPN = 1792;
constexpr int MAXSLOT = 67584;
constexpr int MAXRT = MAXSLOT / 256;
constexpr float EPS = 1e-6f;
constexpr float LOG2E = 1.4426950408889634f;
constexpr float C_A = 0.125f * LOG2E;
constexpr float C_B = 0.10206207261596575f * LOG2E;
constexpr float C_M = 0.08838834764831845f * LOG2E;

constexpr size_t MiB = 1u << 20;
constexpr size_t WS_CTL = 0, CTL_ZERO_BYTES = 1 * MiB;
constexpr size_t WS_MISC = 1 * MiB;
constexpr size_t WL_IN = 0, WL_UP = (size_t)NT_IN * 256 * DM * 2, WL_BR = WL_UP + (size_t)UPN * UPK * 2, WL_OUT = WL_BR + (size_t)3 * DM * 512 * 2, WL_SIZE = WL_OUT + (size_t)DM * DM * 2;
constexpr size_t WS_WMIX = 8 * MiB;
constexpr size_t WS_WMKV = WS_WMIX + 4 * ((WL_SIZE + MiB - 1) / MiB) * MiB;
constexpr size_t WL_STRIDE = ((WL_SIZE + MiB - 1) / MiB) * MiB;
constexpr size_t WS_WFFN = WS_WMKV + 8 * MiB;
constexpr size_t WF_GU = 0, WF_D = (size_t)2 * DFF * DM * 2, WF_STRIDE = WF_D + (size_t)DM * DFF * 2;
constexpr size_t WS_H = WS_WFFN + 8 * WF_STRIDE;
constexpr size_t WS_MEMN = WS_H + (size_t)T * DM * 2;
constexpr size_t WS_MEMKV = WS_MEMN + (size_t)NB * MEML * DM * 2;
constexpr size_t WS_R = WS_MEMKV + (size_t)NB * MEML * 4096 * 2;
constexpr size_t R_P = 0, R_G = R_P + (size_t)T * PW * 2, R_QB = R_G + (size_t)T * GW * 2, R_KVB = R_QB + (size_t)T * QBW * 2, R_Y = R_KVB + (size_t)T * KVW * 2, R_END_MIX = R_Y + (size_t)T * YW * 2;
constexpr size_t R_ACT = 0;
constexpr size_t R_ASORT = (size_t)MAXSLOT * DFF * 2;
constexpr size_t R_YOUT = R_ASORT;
constexpr size_t R_END_FFN = R_YOUT + (size_t)MAXSLOT * DM * 2;
constexpr size_t R_SIZE = R_END_MIX > R_END_FFN ? R_END_MIX : R_END_FFN;
constexpr size_t WS_XB = WS_R + R_SIZE;
constexpr size_t WS_END = WS_XB + (size_t)T * DM * 2;
static_assert(WS_END < 1020ull * MiB, "workspace budget");
constexpr size_t MS_TOKE = 0;
constexpr size_t MS_TOKW = MS_TOKE + (size_t)T * 8;
constexpr size_t MS_SLOT = MS_TOKW + (size_t)T * 8;
constexpr size_t MS_CNT = MS_SLOT + (size_t)T * 8;
constexpr size_t MS_TEXP = MS_CNT + 256 * 8 * 4;
constexpr size_t MS_SSQ = MS_TEXP + 2048;
constexpr size_t MS_SNAP = MS_SSQ + (size_t)T * 32;
constexpr size_t MS_HSC = MS_SNAP + 64 * 1024 * 4;
constexpr size_t MS_ASC = MS_HSC + (size_t)T * 4;
constexpr size_t MS_WSIN = MS_ASC + (size_t)MAXSLOT * 4;
constexpr size_t MS_WSGU = MS_WSIN + (size_t)4 * NT_IN * 256 * 4;
constexpr size_t MS_END = MS_WSGU + (size_t)8 * 2 * DFF * 4;
static_assert(MS_END <= 7 * MiB, "misc map");
constexpr int CW_BAR = 4096;
constexpr int CW_DIAG = 16384;
constexpr int CW_CODE = 16384 + 512;

constexpr int RING_BYTES = 131072;
constexpr int LDSCTL_OFF = RING_BYTES;
constexpr int LDS_BYTES = 147456;
constexpr int NWAVES = 8;

#define LDS_WAIT() asm volatile("s_waitcnt lgkmcnt(0)" ::: "memory")
#define VM_WAIT() asm volatile("s_waitcnt vmcnt(0)" ::: "memory")

__device__ __forceinline__ unsigned f2bf(float f) { unsigned u = __builtin_bit_cast(unsigned, f); return (u + 0x7fffu + ((u >> 16) & 1u)) >> 16; }
__device__ __forceinline__ unsigned pk2(float lo, float hi) { return f2bf(lo) | (f2bf(hi) << 16); }
__device__ __forceinline__ float bf2f(unsigned short b) { return __builtin_bit_cast(float, (unsigned)b << 16); }
__device__ __forceinline__ float bflo(unsigned w) { return __builtin_bit_cast(float, w << 16); }
__device__ __forceinline__ float bfhi(unsigned w) { return __builtin_bit_cast(float, w & 0xffff0000u); }
typedef __bf16 bf16x2_t __attribute__((ext_vector_type(2)));
__device__ __forceinline__ unsigned cvtpk(float lo, float hi) { f32x2 v = {lo, hi}; bf16x2_t b = __builtin_convertvector(v, bf16x2_t); return __builtin_bit_cast(unsigned, b); }
__device__ __forceinline__ float wave_sum(float v) {
#pragma unroll
    for (int o = 1; o < 64; o <<= 1) v += __shfl_xor(v, o);
    return v;
}
__device__ __forceinline__ float fast_sigmoid(float x) { return __builtin_amdgcn_rcpf(1.0f + __builtin_amdgcn_exp2f(-x * LOG2E)); }


__device__ __forceinline__ int opq_v(int x) { asm volatile("" : "+v"(x)); return x; }
__device__ __forceinline__ int opq_s(int x) { asm volatile("" : "+s"(x)); return x; }
template <class Tp> __device__ __forceinline__ Tp* opq_p(Tp* p) { const unsigned long long u = (unsigned long long)p; unsigned lo = __builtin_amdgcn_readfirstlane((unsigned)u), hi = __builtin_amdgcn_readfirstlane((unsigned)(u >> 32)); asm volatile("" : "+s"(lo), "+s"(hi)); return (Tp*)(((unsigned long long)hi << 32) | lo); }

__constant__ float IFR_HI[32] = {1.591549367e-01f, 1.193493679e-01f, 8.949939907e-02f, 6.711508334e-02f, 5.032921210e-02f, 3.774158657e-02f, 2.830219641e-02f, 2.122365311e-02f, 1.591549441e-02f, 1.193493698e-02f, 8.949940093e-03f, 6.711508147e-03f, 5.032921210e-03f, 3.774158424e-03f, 2.830219688e-03f, 2.122365171e-03f, 1.591549488e-03f, 1.193493721e-03f, 8.949940093e-04f, 6.711508031e-04f, 5.032921326e-04f, 3.774158540e-04f, 2.830219455e-04f, 2.122365258e-04f, 1.591549371e-04f, 1.193493736e-04f, 8.949940093e-05f, 6.711508468e-05f, 5.032921035e-05f, 3.774158540e-05f, 2.830219637e-05f, 2.122365186e-05f};
__constant__ float IFR_LO[32] = {6.420638243e-09f, 2.294664903e-09f, 2.542919653e-09f, -3.316028840e-10f, 5.173299289e-12f, -1.848551645e-09f, -5.826552019e-10f, -3.431038786e-10f, -1.029942243e-10f, 4.320196978e-11f, 6.802745173e-11f, 1.531042237e-10f, 5.173301024e-13f, 4.797548470e-11f, -1.048316434e-10f, 1.053879969e-10f, -5.686555046e-11f, -1.896286773e-11f, 6.802744999e-12f, 2.695195456e-11f, -1.158979943e-11f, -6.843983713e-12f, 1.279990003e-11f, 1.807650600e-12f, 5.954976963e-12f, -3.351478166e-12f, 6.802745216e-13f, -1.670379113e-12f, 1.751403167e-12f, -6.843983930e-13f, -5.389994549e-13f, 9.083608431e-13f};
__device__ __forceinline__ void rot_cs(float posf, int idx, float& c, float& s) {
    const float ch = IFR_HI[idx], cl = IFR_LO[idx];
    const float p = posf * ch, e = __builtin_fmaf(posf, ch, -p);
    const float fr = __builtin_amdgcn_fractf(p) + (e + posf * cl);
    s = __builtin_amdgcn_sinf(fr); c = __builtin_amdgcn_cosf(fr);
}

#define XB_TMO      128
#define XB_XCNT(j)  (256  + 64 * (j))
#define XB_XSUB(j)  (1280 + 64 * (j))
#define XB_XGEN(j)  (2304 + 64 * (j))
#define XB_TOP      3328
#define XB_TOPGEN   3392
#define XCD_BAR_WORDS 3456
#define XB_SPIN_CAP (1u << 20)

__device__ __forceinline__ unsigned xb_ld(unsigned* p)              { return __hip_atomic_load(p, __ATOMIC_RELAXED, __HIP_MEMORY_SCOPE_AGENT); }
__device__ __forceinline__ unsigned xb_add(unsigned* p, unsigned v) { return __hip_atomic_fetch_add(p, v, __ATOMIC_RELAXED, __HIP_MEMORY_SCOPE_AGENT); }
__device__ __forceinline__ unsigned xb_xcc_id() { return (unsigned)__builtin_amdgcn_s_getreg((3 << 11) | 20) & 0xFu; }
#define XB_SPIN(cond, bar) do { unsigned _sp = 0; while (cond) { __builtin_amdgcn_s_sleep(1); \
    if ((++_sp & 255u) == 0u) { if (xb_ld(&(bar)[XB_TMO])) break; if (_sp > XB_SPIN_CAP) { atomicAdd(&(bar)[XB_TMO], 1u); break; } } } } while (0)

struct XcdBarrier { unsigned* bar; unsigned x; volatile LAS unsigned* st; };

__device__ __forceinline__ XcdBarrier xcd_barrier_post(unsigned* bar, volatile LAS unsigned* st) {
    XcdBarrier b; b.bar = bar; b.x = xb_xcc_id(); b.st = st;
    if (threadIdx.x == 0) (void)xb_add(&bar[XB_XCNT(b.x)], 1u);
    return b;
}
__device__ __forceinline__ void xcd_barrier_complete(unsigned* bar, unsigned x, unsigned& nloc, unsigned& nx) {
    const unsigned G = gridDim.x * gridDim.y * gridDim.z;
    unsigned sum, cnt, mine, sp = 0u;
    for (;;) {
        sum = 0u; cnt = 0u; mine = 0u;
#pragma unroll
        for (unsigned j = 0; j < 16; ++j) { const unsigned c = xb_ld(&bar[XB_XCNT(j)]); sum += c; cnt += (c > 0u) ? 1u : 0u; mine = (j == x) ? c : mine; }
        if (sum == G) break;
        __builtin_amdgcn_s_sleep(1);
        if ((++sp & 255u) == 0u) { if (xb_ld(&bar[XB_TMO])) break; if (sp > XB_SPIN_CAP) { atomicAdd(&bar[XB_TMO], 1u); break; } }
    }
    nloc = mine > 0u ? mine : 1u; nx = cnt > 0u ? cnt : 1u;
}
__device__ __forceinline__ void xcd_barrier(const XcdBarrier& b) {
    asm volatile("s_waitcnt vmcnt(0)" ::: "memory");
    __syncthreads();
    if (threadIdx.x == 0) {
        unsigned* bar = b.bar;
        __builtin_amdgcn_s_waitcnt(0);
        unsigned nloc = b.st[0], nx = b.st[1];
        if (nloc == 0u) { xcd_barrier_complete(bar, b.x, nloc, nx); b.st[0] = nloc; b.st[1] = nx; }
        const unsigned old = xb_add(&bar[XB_XSUB(b.x)], 1u);
        const unsigned gen = old / nloc;
        if (old + 1u == (gen + 1u) * nloc) {
            __builtin_amdgcn_fence(__ATOMIC_RELEASE, "agent");
            asm volatile("s_waitcnt vmcnt(0)" ::: "memory");
            const unsigned og = xb_add(&bar[XB_TOP], 1u);
            const unsigned tg = og / nx;
            if (og + 1u == (tg + 1u) * nx) xb_add(&bar[XB_TOPGEN], 1u);
            else XB_SPIN(xb_ld(&bar[XB_TOPGEN]) == tg, bar);
            __builtin_amdgcn_fence(__ATOMIC_ACQUIRE, "agent");
            xb_add(&bar[XB_XGEN(b.x)], 1u);
            asm volatile("s_waitcnt vmcnt(0)" ::: "memory");
        } else {
            XB_SPIN(xb_ld(&bar[XB_XGEN(b.x)]) == gen, bar);
            __builtin_amdgcn_fence(__ATOMIC_ACQUIRE, "agent");
            asm volatile("s_waitcnt vmcnt(0)" ::: "memory");
        }
    }
    __syncthreads();
}

namespace pg8 {
constexpr int BM = 256, BK = 64, HALF = 128, HTB = HALF * BK * 2, STAGE_BYTES = 8 * HTB, NXCD = 8, WGM = 4;
constexpr int ESC_OFF = 131072 + 4096, ESC_SLOT = 3072;
__host__ __device__ __forceinline__ int lds_byte(int r, int c) { const int st = (r >> 4) * 2 + (c >> 5), rr = r & 15, cc = c & 31, ob = rr * 64 + cc * 2; return st * 1024 + (ob ^ (((ob >> 9) & 1) << 5)); }
__host__ __device__ __forceinline__ void stage_rc(int b, int& R, int& C) { const int st = b / 1024, sb = b % 1024, swz = sb ^ (((sb >> 9) & 1) << 5); R = (st >> 1) * 16 + swz / 64; C = (st & 1) * 32 + (swz % 64) / 2; }

struct Unit { int pm, pn, aux; };

struct StaticOrder {
    int nM, nN, nwg, G, c, rev, wgm;
    __device__ void init(int nM_, int nN_, int G_, int c_, int rev_ = 0, int wgm_ = WGM) { nM = nM_; nN = nN_; nwg = nM * nN; G = G_; c = c_; rev = rev_; wgm = wgm_; }
    __device__ bool next(int i, Unit& u) const {
        const long L = (long)i * G + c; if (L >= nwg) return false;
        int wgid = (int)L; { const int q = nwg / NXCD, r = nwg % NXCD, xcd = wgid % NXCD, off = wgid / NXCD; wgid = (xcd < r ? xcd * (q + 1) : r * (q + 1) + (xcd - r) * q) + off; }
        const int nig = wgm * nN, gid = wgid / nig, fm = gid * wgm, gsz = (nM - fm) < wgm ? (nM - fm) : wgm;
        u.pm = fm + ((wgid % nig) % gsz); u.pn = (wgid % nig) / gsz; u.aux = 0; if (rev) u.pm = nM - 1 - u.pm; return true;
    }
};

template <bool I8> struct AccVec { typedef f32x4 type; };
template <> struct AccVec<true> { typedef i32x4 type; };
template <bool I8 = false, class Prob, class Sched, class Epi>
__device__ __forceinline__ void gemm_phase(LAS unsigned char* lds, const Prob& P, const Sched& S, const Epi& E) {
    const int tid = opq_v((int)threadIdx.x), wid = __builtin_amdgcn_readfirstlane(tid >> 6), lane = tid & 63, wr = wid >> 2, wc = wid & 3, fr = lane & 15, fq = lane >> 4;
    typedef typename AccVec<I8>::type accv_t;
    const int K = P.K, nt = K / (I8 ? 2 * BK : BK);
    unsigned voffA[2], voffB[2];
#pragma unroll
    for (int i = 0; i < 2; ++i) { int R, C; stage_rc(tid * 16 + i * 8192, R, C); voffA[i] = (unsigned)R * P.lda + (unsigned)C * 2u; voffB[i] = (unsigned)R * P.ldb + (unsigned)C * 2u; }
    const size_t kstep = (size_t)(BK * 2);
    const size_t hstepA = (size_t)HALF * P.lda, hstepB = (size_t)HALF * P.ldb;
    const unsigned ldsw = (unsigned)wid * 1024u;
    const int aoff = lds_byte(wr * 64 + fr, fq * 8), boff = lds_byte(wc * 32 + fr, fq * 8);
#define PG8_SA(b, h) (((b) * 2 + (h)) * HTB)
#define PG8_SB(b, h) ((4 + (b) * 2 + (h)) * HTB)
#define PG8_STAGE(bufoff, gbase, voff) do { _Pragma("unroll") for (int _i = 0; _i < 2; ++_i) \
        __builtin_amdgcn_global_load_lds((const unsigned*)((const char*)(gbase) + (voff)[_i]), (LAS unsigned*)(lds + (bufoff) + ldsw + _i * 8192), 16, 0, 0); } while (0)
#define PG8_LDA(dst, b, h) do { _Pragma("unroll") for (int m = 0; m < 4; ++m) _Pragma("unroll") for (int k = 0; k < 2; ++k) dst[m][k] = *(const LAS bf16x8*)(lds + PG8_SA(b, h) + aoff + m * 2048 + k * 1024); } while (0)
#define PG8_LDB(dst, b, h) do { _Pragma("unroll") for (int n = 0; n < 2; ++n) _Pragma("unroll") for (int k = 0; k < 2; ++k) dst[n][k] = *(const LAS bf16x8*)(lds + PG8_SB(b, h) + boff + n * 2048 + k * 1024); } while (0)
#define PG8_MMA(ai, bj, At, Bt) do { __builtin_amdgcn_s_setprio(1); _Pragma("unroll") for (int m = 0; m < 4; ++m) _Pragma("unroll") for (int n = 0; n < 2; ++n) _Pragma("unroll") for (int k = 0; k < 2; ++k) \
        { if constexpr (I8) acc[ai][bj][m][n] = __builtin_amdgcn_mfma_i32_16x16x64_i8(__builtin_bit_cast(i32x4, Bt[n][k]), __builtin_bit_cast(i32x4, At[m][k]), acc[ai][bj][m][n], 0, 0, 0); \
          else acc[ai][bj][m][n] = __builtin_amdgcn_mfma_f32_16x16x32_bf16(Bt[n][k], At[m][k], acc[ai][bj][m][n], 0, 0, 0); } __builtin_amdgcn_s_setprio(0); } while (0)
#define PG8_WAIT_V(n) asm volatile("s_waitcnt vmcnt(" #n ")" ::: "memory")
#define PG8_WAIT_L(n) asm volatile("s_waitcnt lgkmcnt(" #n ")" ::: "memory")
#define PG8_BAR __builtin_amdgcn_s_barrier()
#define PG8_SCHED __builtin_amdgcn_sched_barrier(0)
    Unit cur, nxt; int ui = 0;
    if (!S.next(0, cur)) return;
    accv_t acc[2][2][4][2];
#pragma unroll
    for (int a = 0; a < 2; ++a)
#pragma unroll
        for (int b = 0; b < 2; ++b)
#pragma unroll
            for (int m = 0; m < 4; ++m)
#pragma unroll
                for (int n = 0; n < 2; ++n) acc[a][b][m][n] = accv_t{};
    bf16x8 At[4][2], B0[2][2], B1[2][2];
    const char* cA = P.a_ptr(cur); const char* cB = P.b_ptr(cur);
    int eslot = 0;
    E.stage(lds + ESC_OFF, cur, wid, lane);
    PG8_STAGE(PG8_SB(0, 0), cB, voffB); PG8_STAGE(PG8_SB(0, 1), cB + hstepB, voffB); PG8_STAGE(PG8_SA(0, 0), cA, voffA); PG8_STAGE(PG8_SA(0, 1), cA + hstepA, voffA);
    if (wr == 1) PG8_BAR;
    PG8_WAIT_V(2); PG8_BAR;
    PG8_STAGE(PG8_SB(1, 0), cB + kstep, voffB); PG8_STAGE(PG8_SA(1, 0), cA + kstep, voffA); PG8_STAGE(PG8_SB(1, 1), cB + hstepB + kstep, voffB);
    PG8_WAIT_V(6); PG8_BAR;
    for (;;) {
        const bool has_next = S.next(ui + 1, nxt);
        const char* nA = has_next ? P.a_ptr(nxt) : cA; const char* nB = has_next ? P.b_ptr(nxt) : cB;
        for (int t = 0; t < nt; t += 2) {
            if constexpr (Epi::MID) { if (t == 8 || t == 16) E.mid(acc, cur, t >> 3, wr, wc, fr, fq); }
            const bool last = (t == nt - 2);
            if (last && has_next) E.stage(lds + ESC_OFF + (eslot ^ 1) * ESC_SLOT, nxt, wid, lane);
            const char* a1 = cA + (size_t)(t + 1) * kstep;
            const char* a2 = last ? nA : cA + (size_t)(t + 2) * kstep; const char* b2 = last ? nB : cB + (size_t)(t + 2) * kstep;
            const char* a3 = a2 + kstep; const char* b3 = b2 + kstep;
            PG8_LDB(B0, 0, 0); PG8_LDB(B1, 0, 1); PG8_SCHED; PG8_LDA(At, 0, 0); PG8_STAGE(PG8_SA(1, 1), a1 + hstepA, voffA);
            PG8_WAIT_V(8); PG8_WAIT_L(0); PG8_BAR; PG8_MMA(0, 0, At, B0); PG8_MMA(0, 1, At, B1); PG8_BAR; PG8_SCHED;
            PG8_LDA(At, 0, 1); PG8_STAGE(PG8_SB(0, 0), b2, voffB); PG8_STAGE(PG8_SB(0, 1), b2 + hstepB, voffB); PG8_STAGE(PG8_SA(0, 0), a2, voffA);
            PG8_WAIT_V(8); PG8_WAIT_L(0); PG8_BAR; PG8_MMA(1, 0, At, B0); PG8_MMA(1, 1, At, B1); PG8_BAR; PG8_SCHED;
            PG8_LDB(B0, 1, 0); PG8_LDB(B1, 1, 1); PG8_SCHED; PG8_LDA(At, 1, 0); PG8_STAGE(PG8_SA(0, 1), a2 + hstepA, voffA);
            PG8_WAIT_V(8); PG8_WAIT_L(0); PG8_BAR; PG8_MMA(0, 0, At, B0); PG8_MMA(0, 1, At, B1); PG8_BAR; PG8_SCHED;
            PG8_LDA(At, 1, 1); PG8_STAGE(PG8_SB(1, 0), b3, voffB); PG8_STAGE(PG8_SB(1, 1), b3 + hstepB, voffB); PG8_STAGE(PG8_SA(1, 0), a3, voffA);
            PG8_WAIT_V(8); PG8_WAIT_L(0); PG8_BAR; PG8_MMA(1, 0, At, B0); PG8_MMA(1, 1, At, B1); PG8_BAR; PG8_SCHED;
        }
        if (wr == 0) PG8_BAR;
        E(acc, cur, wr, wc, fr, fq, lds + ESC_OFF + eslot * ESC_SLOT);
        if (!has_next) break;
#pragma unroll
        for (int a = 0; a < 2; ++a)
#pragma unroll
            for (int b = 0; b < 2; ++b)
#pragma unroll
                for (int m = 0; m < 4; ++m)
#pragma unroll
                    for (int n = 0; n < 2; ++n) acc[a][b][m][n] = accv_t{};
        cur = nxt; cA = nA; cB = nB; ++ui; eslot ^= 1;
        if (wr == 1) PG8_BAR;
    }
    PG8_WAIT_V(0);
    PG8_BAR;
#undef PG8_SA
#undef PG8_SB
#undef PG8_STAGE
#undef PG8_LDA
#undef PG8_LDB
#undef PG8_MMA
#undef PG8_WAIT_V
#undef PG8_WAIT_L
#undef PG8_BAR
#undef PG8_SCHED
}
}

struct Frame {
    LAS unsigned char* lds;
    volatile LAS unsigned* MISC;
    gu32* ctl;
    unsigned char* ws;
    int tid, lane, wave, vcu, G;
    const float* const* in; float* out;
};
enum { I_X = 0, I_MEM, I_POS, I_GMIX, I_WIN, I_GQ, I_WUQ, I_GKV, I_WUKV, I_SINK, I_WMKV, I_WBR, I_WOUT, I_GFFN, I_WGD, I_WUD, I_WDD, I_WR, I_WGE, I_WUE, I_WDE, I_GMEM, I_GFIN };

__device__ __forceinline__ int sem_plain(int g) { return (g & ~31) + 8 * ((g >> 2) & 3) + 4 * ((g >> 4) & 1) + (g & 3); }
__device__ __forceinline__ int sem_rot64(int g) { return (g & ~63) + 32 * ((g >> 4) & 1) + 16 * ((g >> 5) & 1) + 4 * ((g >> 2) & 3) + (g & 3); }
__device__ __forceinline__ int sem_p16(int g) { const int c = g & 255; return (g & ~255) + 64 * ((c >> 5) & 3) + 16 * ((c >> 2) & 3) + 8 * (c >> 7) + 4 * ((c >> 4) & 1) + (c & 3); }
__device__ __forceinline__ int inproj_src(int n) {
    const int pn = n >> 8, c = n & 255;
    if (pn < 2) return pn * 256 + sem_rot64(c);
    if (pn == 2) return c < 128 ? 512 + sem_rot64(c) : 640 + sem_plain(c - 128);
    if (pn == 3) return 768 + sem_plain(c);
    if (pn == 4) return c < 128 ? 1024 + sem_plain(c) : (c < 160 ? 1152 + (c - 128) : -1);
    if (pn < 7) return 1184 + (pn - 5) * 256 + sem_plain(c);
    return 1696 + (pn - 7) * 256 + sem_p16(c);
}

struct MapInproj { const float* W; __device__ __forceinline__ float load(int k, int n) const { const int s = inproj_src(n); return s >= 0 ? W[(size_t)k * INW + s] : 0.f; }
    __device__ __forceinline__ f32x4 load4(int k, int n) const { const int s = inproj_src(n); return s >= 0 ? *(const f32x4*)(W + (size_t)k * INW + s) : (f32x4){0.f, 0.f, 0.f, 0.f}; } };
struct MapUp { const float *Wq, *Wkv, *gq, *gkv;
    __device__ __forceinline__ f32x4 load4(int k, int n) const {
        if (n < 768) { const int gg = n >> 5; const int s = (gg % 3 == 2) ? n : sem_plain(n); return *(const f32x4*)(Wq + (size_t)k * 768 + s) * gq[k]; }
        if (k < 128) return (f32x4){0.f, 0.f, 0.f, 0.f}; const int s = sem_plain(n - 768); return *(const f32x4*)(Wkv + (size_t)(k - 128) * 1024 + s) * gkv[k - 128]; }
    __device__ __forceinline__ float load(int k, int n) const {
        if (n < 768) { const int gg = n >> 5; const int s = (gg % 3 == 2) ? n : sem_plain(n); return gq[k] * Wq[(size_t)k * 768 + s]; }
        if (k < 128) return 0.f; const int s = sem_plain(n - 768); return gkv[k - 128] * Wkv[(size_t)(k - 128) * 1024 + s]; } };
struct MapPlain { const float* W; int ldw; __device__ __forceinline__ float load(int k, int n) const { return W[(size_t)k * ldw + sem_plain(n)]; }
    __device__ __forceinline__ f32x4 load4(int k, int n) const { return *(const f32x4*)(W + (size_t)k * ldw + sem_plain(n)); } };
struct MapNat { const float* W; int ldw; __device__ __forceinline__ float load(int k, int n) const { return W[(size_t)k * ldw + n]; }
    __device__ __forceinline__ f32x4 load4(int k, int n) const { return *(const f32x4*)(W + (size_t)k * ldw + n); } };
struct MapBr { const float* W;
    __device__ __forceinline__ float load(int k, int n) const { return W[(size_t)k * DM + sem_p16(n)]; }
    __device__ __forceinline__ f32x4 load4(int k, int n) const { return *(const f32x4*)(W + (size_t)k * DM + sem_p16(n)); } };
struct MapMemkv { const float* W; __device__ __forceinline__ float load(int k, int n) const { const int l = n >> 10, c = n & 1023; return W[((size_t)l * DM + k) * 1024 + sem_plain(c)]; }
    __device__ __forceinline__ f32x4 load4(int k, int n) const { const int l = n >> 10, c = n & 1023; return *(const f32x4*)(W + ((size_t)l * DM + k) * 1024 + sem_plain(c)); } };
struct MapGU { const float *Wg, *Wu; __device__ __forceinline__ float load(int k, int n) const { const int pn = n >> 8, c = n & 255; const int ch = 128 * pn + sem_plain(c & 127);
    const unsigned long long a = (unsigned long long)Wg, b = (unsigned long long)Wu, w = a ^ ((a ^ b) & (0ull - (unsigned long long)(c >> 7))); return ((const float*)w)[(size_t)k * DFF + ch]; }
    __device__ __forceinline__ f32x4 load4(int k, int n) const { const int pn = n >> 8, c = n & 255; const int ch = 128 * pn + sem_plain(c & 127);
        const unsigned long long a = (unsigned long long)Wg, b = (unsigned long long)Wu, w = a ^ ((a ^ b) & (0ull - (unsigned long long)(c >> 7))); return *(const f32x4*)((const float*)w + (size_t)k * DFF + ch); } };

template <class M> __device__ __forceinline__ void prep_item(const M& m, bf16_t* dst, int Kd, int nblk, LAS float* scr, int item, int lane) {
    const int kb = item / nblk, nb = item % nblk, k0 = 64 * kb, n0 = 32 * nb;
#pragma unroll 8
    for (int i = 0; i < 32; ++i) { const int kk = 2 * i + (lane >> 5); scr[kk * 33 + (lane & 31)] = m.load(k0 + kk, n0 + (lane & 31)); }
    LDS_WAIT(); asm volatile("" ::: "memory");
    const int c = lane & 7;
#pragma unroll
    for (int j = 0; j < 4; ++j) { const int n = (lane >> 3) + 8 * j; const LAS float* s = scr + (8 * c) * 33 + n;
        u32x4 o; o.x = pk2(s[0 * 33], s[1 * 33]); o.y = pk2(s[2 * 33], s[3 * 33]); o.z = pk2(s[4 * 33], s[5 * 33]); o.w = pk2(s[6 * 33], s[7 * 33]);
        *(u32x4*)(dst + (size_t)(n0 + n) * Kd + k0 + 8 * c) = o; }
    LDS_WAIT(); asm volatile("" ::: "memory");
}
template <class M> __device__ __forceinline__ void prep_tile(const M& m, bf16_t* dst, int Kd, int nblk, LAS unsigned char* tile, int item, int lane) {
    const int kb = item / nblk, nb = item % nblk, k0 = 128 * kb, n0 = 32 * nb, ng = lane & 7, kr = lane >> 3;
    f32x4 v[16];
#pragma unroll
    for (int i = 0; i < 16; ++i) v[i] = m.load4(k0 + 8 * i + kr, n0 + 4 * ng);
#pragma unroll
    for (int i = 0; i < 16; ++i)
#pragma unroll
        for (int c = 0; c < 4; ++c) *(LAS unsigned short*)(tile + (4 * ng + c) * 272 + (8 * i + kr) * 2) = (unsigned short)f2bf(v[i][c]);
    LDS_WAIT(); asm volatile("" ::: "memory");
#pragma unroll
    for (int j = 0; j < 8; ++j) { const int p = lane + 64 * j, n = p >> 4, kc = p & 15;
        *(u32x4*)(dst + (size_t)(n0 + n) * Kd + k0 + 8 * kc) = *(const LAS u32x4*)(tile + n * 272 + 16 * kc); }
    LDS_WAIT(); asm volatile("" ::: "memory");
}
template <class M> __device__ __forceinline__ void prep_matrix(Frame& F, const M& m, bf16_t* dst, int N, int K) {
    LAS unsigned char* tile = F.lds + F.wave * 16384;
    const int gw = F.vcu * NWAVES + F.wave, NGW = F.G * NWAVES, nblk = N / 32, nitems = (K / 128) * nblk;
    for (int it = gw; it < nitems; it += NGW) prep_tile(m, dst, K, nblk, tile, it, F.lane);
}

template <class M> __device__ __forceinline__ void prep_strip_i8(Frame& F, const M& m, signed char* dst, float* scl, int strip) {
    const int lane = F.lane, w = F.wave, n0 = strip * 32, k0 = w * 128, ng = lane & 7, kr = lane >> 3;
    LAS unsigned char* tile = F.lds + w * 16384;
    LAS float* amt = (LAS float*)(F.lds + LDSCTL_OFF + 2048);
    f32x4 v[16];
#pragma unroll
    for (int i = 0; i < 16; ++i) v[i] = m.load4(k0 + 8 * i + kr, n0 + 4 * ng);
    f32x4 am = __builtin_elementwise_abs(v[0]);
#pragma unroll
    for (int i = 1; i < 16; ++i) am = __builtin_elementwise_max(am, __builtin_elementwise_abs(v[i]));
#pragma unroll
    for (int c = 0; c < 4; ++c) { float a = am[c]; a = fmaxf(a, __shfl_xor(a, 8)); a = fmaxf(a, __shfl_xor(a, 16)); a = fmaxf(a, __shfl_xor(a, 32)); am[c] = a; }
    if (kr == 0) *(LAS f32x4*)(amt + w * 32 + 4 * ng) = am;
    __syncthreads();
    f32x4 cm = *(const LAS f32x4*)(amt + 4 * ng);
#pragma unroll
    for (int ww = 1; ww < 8; ++ww) cm = __builtin_elementwise_max(cm, *(const LAS f32x4*)(amt + ww * 32 + 4 * ng));
    f32x4 inv;
#pragma unroll
    for (int c = 0; c < 4; ++c) inv[c] = cm[c] > 0.f ? 127.0f / cm[c] : 0.f;
    if (w == 0 && kr == 0) *(f32x4*)(scl + n0 + 4 * ng) = cm * (1.0f / 127.0f);
#pragma unroll
    for (int i = 0; i < 16; ++i)
#pragma unroll
        for (int c = 0; c < 4; ++c) tile[(4 * ng + c) * 144 + 8 * i + kr] = (unsigned char)(signed char)__float2int_rn(v[i][c] * inv[c]);
    LDS_WAIT(); asm volatile("" ::: "memory");
#pragma unroll
    for (int j = 0; j < 4; ++j) { const int p = lane + 64 * j, n = p >> 3, kc = p & 7;
        *(u32x4*)(dst + (size_t)(n0 + n) * DM + k0 + 16 * kc) = *(const LAS u32x4*)(tile + n * 144 + 16 * kc); }
    LDS_WAIT();
    __syncthreads();
}
__device__ __forceinline__ bf16_t* wmix(Frame& F, int l, size_t off) { return (bf16_t*)(F.ws + WS_WMIX + (size_t)l * WL_STRIDE + off); }

__device__ __forceinline__ void prep_mixer_weights(Frame& F) {
    for (int l = 0; l < DEPTH; ++l) {
        { MapInproj m{F.in[I_WIN] + (size_t)l * DM * INW}; for (int s = F.vcu; s < NT_IN * 8; s += F.G) prep_strip_i8(F, m, (signed char*)wmix(F, l, WL_IN), (float*)(F.ws + WS_MISC + MS_WSIN) + l * NT_IN * 256, s); }
        { MapUp m{F.in[I_WUQ] + (size_t)l * 256 * 768, F.in[I_WUKV] + (size_t)l * 128 * 1024, F.in[I_GQ] + l * 256, F.in[I_GKV] + l * 128}; prep_matrix(F, m, wmix(F, l, WL_UP), UPN, UPK); }
        { MapBr m{F.in[I_WBR] + (size_t)l * 3 * 512 * DM}; prep_matrix(F, m, wmix(F, l, WL_BR), DM, 1536); }
        { MapPlain m{F.in[I_WOUT] + (size_t)l * DM * DM, DM}; prep_matrix(F, m, wmix(F, l, WL_OUT), DM, DM); }
    }
    { MapMemkv m{F.in[I_WMKV]}; prep_matrix(F, m, (bf16_t*)(F.ws + WS_WMKV), 4096, DM); }
}
__device__ __forceinline__ void prep_ffn_weights(Frame& F, int l) {
    const int i = l >> 1; const bool moe = (l & 1) != 0;
    LAS float* scr = (LAS float*)(F.lds + F.wave * 16384);
    const int gw = F.vcu * NWAVES + F.wave, NGW = F.G * NWAVES;
    constexpr int IGU = (DM / 64) * (2 * DFF / 32), ID = (DFF / 64) * (DM / 32), NSTRIP = 2 * DFF / 32;
    const int ne = moe ? NE : 1;
    const float* Wg = moe ? F.in[I_WGE] : F.in[I_WGD]; const float* Wu = moe ? F.in[I_WUE] : F.in[I_WUD]; const float* Wd = moe ? F.in[I_WDE] : F.in[I_WDD];
    if (GU_I8(l)) {
        for (int s = F.vcu; s < ne * NSTRIP; s += F.G) { const int e = s / NSTRIP, ss = s % NSTRIP; const size_t eo = ((size_t)i * ne + e) * DM * DFF;
            MapGU m{Wg + eo, Wu + eo}; prep_strip_i8(F, m, (signed char*)(F.ws + WS_WFFN + (size_t)e * WF_STRIDE), (float*)(F.ws + WS_MISC + MS_WSGU) + e * 2 * DFF, ss); }
    } else {
        for (int it = gw; it < ne * IGU; it += NGW) { const int e = it / IGU, r = it % IGU; const size_t eo = ((size_t)i * ne + e) * DM * DFF;
            MapGU m{Wg + eo, Wu + eo}; prep_item(m, (bf16_t*)(F.ws + WS_WFFN + (size_t)e * WF_STRIDE), DM, 2 * DFF / 32, scr, r, F.lane); }
    }
    constexpr int IDT = (DFF / 128) * (DM / 32);
    for (int it = gw; it < ne * IDT; it += NGW) { const int e = it / IDT, r = it % IDT; const size_t eo = ((size_t)i * ne + e) * DM * DFF;
        MapPlain m{Wd + eo, DM}; prep_tile(m, (bf16_t*)(F.ws + WS_WFFN + (size_t)e * WF_STRIDE + WF_D), DFF, DM / 32, F.lds + F.wave * 16384, r, F.lane); }
}

struct RowV { f32x4 v[4]; };
__device__ __forceinline__ void row_load(RowV& r, const float* p, int lane) { const f32x4* x = (const f32x4*)p + lane;
#pragma unroll
    for (int j = 0; j < 4; ++j) r.v[j] = x[64 * j]; }
__device__ __forceinline__ void row_store(const RowV& r, float* p, int lane) { f32x4* x = (f32x4*)p + lane;
#pragma unroll
    for (int j = 0; j < 4; ++j) x[64 * j] = r.v[j]; }
__device__ __forceinline__ void row_add_bf16(RowV& r, const bf16_t* p, float w, int lane) { const u32x2* x = (const u32x2*)p + lane;
#pragma unroll
    for (int j = 0; j < 4; ++j) { const u32x2 q = x[64 * j]; r.v[j].x += w * bflo(q.x); r.v[j].y += w * bfhi(q.x); r.v[j].z += w * bflo(q.y); r.v[j].w += w * bfhi(q.y); } }
__device__ __forceinline__ void row_load_bf16(RowV& r, const bf16_t* p, int lane) { const u32x2* x = (const u32x2*)p + lane;
#pragma unroll
    for (int j = 0; j < 4; ++j) { const u32x2 q = x[64 * j]; r.v[j].x = bflo(q.x); r.v[j].y = bfhi(q.x); r.v[j].z = bflo(q.y); r.v[j].w = bfhi(q.y); } }
__device__ __forceinline__ void row_round_bf16(RowV& r) {
#pragma unroll
    for (int j = 0; j < 4; ++j) { r.v[j].x = bf2f((unsigned short)f2bf(r.v[j].x)); r.v[j].y = bf2f((unsigned short)f2bf(r.v[j].y)); r.v[j].z = bf2f((unsigned short)f2bf(r.v[j].z)); r.v[j].w = bf2f((unsigned short)f2bf(r.v[j].w)); } }
__device__ __forceinline__ float row_rstd(const RowV& r) { float s = 0.f;
#pragma unroll
    for (int j = 0; j < 4; ++j) s += (r.v[j].x * r.v[j].x + r.v[j].y * r.v[j].y) + (r.v[j].z * r.v[j].z + r.v[j].w * r.v[j].w);
    return 1.0f / sqrtf(wave_sum(s) * (1.0f / DM) + EPS); }
__device__ __forceinline__ void row_scale(RowV& r, float rstd, const float* g, int lane) { const f32x4* gg = (const f32x4*)g + lane;
#pragma unroll
    for (int j = 0; j < 4; ++j) r.v[j] = r.v[j] * rstd * gg[64 * j]; }
__device__ __forceinline__ void row_store_bf16(const RowV& r, bf16_t* p, int lane) { u32x2* o = (u32x2*)p + lane;
#pragma unroll
    for (int j = 0; j < 4; ++j) { u32x2 w; w.x = pk2(r.v[j].x, r.v[j].y); w.y = pk2(r.v[j].z, r.v[j].w); o[64 * j] = w; } }

__device__ __forceinline__ float row_store_i8(const RowV& r, signed char* p, int lane) {
    float am = 0.f;
#pragma unroll
    for (int j = 0; j < 4; ++j) am = fmaxf(am, fmaxf(fmaxf(fabsf(r.v[j].x), fabsf(r.v[j].y)), fmaxf(fabsf(r.v[j].z), fabsf(r.v[j].w))));
#pragma unroll
    for (int o = 1; o < 64; o <<= 1) am = fmaxf(am, __shfl_xor(am, o));
    const float inv = am > 0.f ? 127.0f / am : 0.f; unsigned* o4 = (unsigned*)p + lane;
#pragma unroll
    for (int j = 0; j < 4; ++j) { const unsigned a = (unsigned)__float2int_rn(r.v[j].x * inv) & 255u, b = (unsigned)__float2int_rn(r.v[j].y * inv) & 255u, c = (unsigned)__float2int_rn(r.v[j].z * inv) & 255u, d = (unsigned)__float2int_rn(r.v[j].w * inv) & 255u;
        o4[64 * j] = a | (b << 8) | (c << 16) | (d << 24); }
    return am * (1.0f / 127.0f);
}
__device__ __forceinline__ void row_combine(Frame& F, RowV& r, int t) {
    const int* sl = (const int*)(F.ws + WS_MISC + MS_SLOT) + 2 * t; const float* tw = (const float*)(F.ws + WS_MISC + MS_TOKW) + 2 * t;
    const bf16_t* Y = (const bf16_t*)(F.ws + WS_R + R_YOUT);
    const int s0 = sl[0], s1 = sl[1]; const float w0 = tw[0], w1 = tw[1];
    row_add_bf16(r, Y + (size_t)s0 * DM, w0, F.lane); row_add_bf16(r, Y + (size_t)s1 * DM, w1, F.lane);
}

__device__ __forceinline__ void norm_phase(Frame& F, const float* srcf, bf16_t* X, const float* g, bool combine, bool out_i8) {
    bf16_t* H = (bf16_t*)(F.ws + WS_H); signed char* Hq = (signed char*)(F.ws + WS_H); float* hsc = (float*)(F.ws + WS_MISC + MS_HSC);
    const int gw = F.vcu * NWAVES + F.wave, NGW = F.G * NWAVES;
    for (int t = gw; t < T; t += 2 * NGW) {
        const int t2 = (t + NGW < T) ? t + NGW : t;
        RowV r, q;
        if (srcf) { row_load(r, srcf + (size_t)t * DM, F.lane); row_load(q, srcf + (size_t)t2 * DM, F.lane); }
        else { row_load_bf16(r, X + (size_t)t * DM, F.lane); row_load_bf16(q, X + (size_t)t2 * DM, F.lane); }
        if (combine) { row_combine(F, r, t); row_combine(F, q, t2); row_store_bf16(r, X + (size_t)t * DM, F.lane); row_store_bf16(q, X + (size_t)t2 * DM, F.lane);
            row_round_bf16(r); row_round_bf16(q); }
        const float rstd = row_rstd(r), qstd = row_rstd(q); row_scale(r, rstd, g, F.lane); row_scale(q, qstd, g, F.lane);
        if (out_i8) { const float sc = row_store_i8(r, Hq + (size_t)t * DM, F.lane), sq = row_store_i8(q, Hq + (size_t)t2 * DM, F.lane); if (F.lane == 0) { hsc[t] = sc; hsc[t2] = sq; } }
        else { row_store_bf16(r, H + (size_t)t * DM, F.lane); row_store_bf16(q, H + (size_t)t2 * DM, F.lane); }
    }
}
__device__ __forceinline__ void final_norm_phase(Frame& F, const bf16_t* X, float* out, const float* g, bool combine) {
    const int gw = F.vcu * NWAVES + F.wave, NGW = F.G * NWAVES;
    for (int t = gw; t < T; t += 2 * NGW) {
        const int t2 = (t + NGW < T) ? t + NGW : t;
        RowV r, q; row_load_bf16(r, X + (size_t)t * DM, F.lane); row_load_bf16(q, X + (size_t)t2 * DM, F.lane);
        if (combine) { row_combine(F, r, t); row_combine(F, q, t2); }
        const float rstd = row_rstd(r), qstd = row_rstd(q); row_scale(r, rstd, g, F.lane); row_scale(q, qstd, g, F.lane);
        row_store(r, out + (size_t)t * DM, F.lane); row_store(q, out + (size_t)t2 * DM, F.lane);
    }
}
__device__ __forceinline__ void memnorm_phase(Frame& F) {
    bf16_t* MN = (bf16_t*)(F.ws + WS_MEMN);
    const int gw = F.vcu * NWAVES + F.wave, NGW = F.G * NWAVES;
    for (int t = gw; t < NB * MEML; t += NGW) {
        RowV r; row_load(r, F.in[I_MEM] + (size_t)t * DM, F.lane);
        const float rstd = row_rstd(r); row_scale(r, rstd, F.in[I_GMEM], F.lane);
        row_store_bf16(r, MN + (size_t)t * DM, F.lane);
    }
}

__device__ __forceinline__ void norm_router_phase(Frame& F, const bf16_t* X, const float* g, const float* Wr  , bool out_i8) {
    bf16_t* H = (bf16_t*)(F.ws + WS_H); signed char* Hq = (signed char*)(F.ws + WS_H); float* hsc = (float*)(F.ws + WS_MISC + MS_HSC);
    int* toke = (int*)(F.ws + WS_MISC + MS_TOKE); float* tokw = (float*)(F.ws + WS_MISC + MS_TOKW); int* cntg = (int*)(F.ws + WS_MISC + MS_CNT);
    volatile LAS int* hist = (volatile LAS int*)(F.lds + LDSCTL_OFF + 1024);
    f32x4 wa[4][4], wb[4][4];
#pragma unroll
    for (int j = 0; j < 4; ++j)
#pragma unroll
        for (int k = 0; k < 4; ++k) { const int d = 256 * j + 4 * F.lane + k; wa[j][k] = *(const f32x4*)(Wr + (size_t)d * 8); wb[j][k] = *(const f32x4*)(Wr + (size_t)d * 8 + 4); }
    const bool up32 = (F.lane & 32) != 0, up16 = (F.lane & 16) != 0, up8 = (F.lane & 8) != 0;
    for (int c = F.vcu; c < T / 128; c += F.G) {
        if (F.tid < 8) hist[F.tid] = 0;
        __syncthreads();
        for (int q = 0; q < 16; ++q) {
            const int t = c * 128 + F.wave * 16 + q;
            RowV r; row_load_bf16(r, X + (size_t)t * DM, F.lane);
            const float rstd = row_rstd(r); row_scale(r, rstd, g, F.lane);
            if (out_i8) { const float sc = row_store_i8(r, Hq + (size_t)t * DM, F.lane); if (F.lane == 0) hsc[t] = sc; }
            else row_store_bf16(r, H + (size_t)t * DM, F.lane);
            f32x4 la = {0.f, 0.f, 0.f, 0.f}, lb = {0.f, 0.f, 0.f, 0.f};
#pragma unroll
            for (int j = 0; j < 4; ++j)
#pragma unroll
                for (int k = 0; k < 4; ++k) { const float x = r.v[j][k]; la += wa[j][k] * x; lb += wb[j][k] * x; }
            f32x4 h4; { const f32x4 keep = up32 ? lb : la, send = up32 ? la : lb;
#pragma unroll
                for (int i = 0; i < 4; ++i) h4[i] = keep[i] + __shfl_xor(send[i], 32); }
            f32x2 h2; { const float k0 = up16 ? h4[2] : h4[0], k1 = up16 ? h4[3] : h4[1], s0 = up16 ? h4[0] : h4[2], s1 = up16 ? h4[1] : h4[3]; h2.x = k0 + __shfl_xor(s0, 16); h2.y = k1 + __shfl_xor(s1, 16); }
            float h1 = (up8 ? h2.y : h2.x) + __shfl_xor(up8 ? h2.x : h2.y, 8);
            h1 += __shfl_xor(h1, 4); h1 += __shfl_xor(h1, 2); h1 += __shfl_xor(h1, 1);
            float lg[8];
#pragma unroll
            for (int e = 0; e < 8; ++e) lg[e] = __builtin_bit_cast(float, __builtin_amdgcn_readlane(__builtin_bit_cast(int, h1), 8 * e));
            int e0 = 0; float v0 = lg[0];
#pragma unroll
            for (int e = 1; e < 8; ++e) if (lg[e] > v0) { v0 = lg[e]; e0 = e; }
            int e1 = -1; float v1 = -INFINITY;
#pragma unroll
            for (int e = 0; e < 8; ++e) if (e != e0 && lg[e] > v1) { v1 = lg[e]; e1 = e; }
            if (F.lane == 0) {
                const float w0 = 1.0f / (1.0f + __expf(v1 - v0));
                toke[2 * t] = e0; toke[2 * t + 1] = e1; tokw[2 * t] = w0; tokw[2 * t + 1] = 1.0f - w0;
                __hip_atomic_fetch_add((LAS int*)&hist[e0], 1, __ATOMIC_RELAXED, __HIP_MEMORY_SCOPE_WORKGROUP); __hip_atomic_fetch_add((LAS int*)&hist[e1], 1, __ATOMIC_RELAXED, __HIP_MEMORY_SCOPE_WORKGROUP);
            }
        }
        __syncthreads();
        if (F.tid < 8) cntg[c * 8 + F.tid] = hist[F.tid];
        __syncthreads();
    }
}
__device__ __forceinline__ void moe_assign_phase(Frame& F, bool i8) {
    const bf16_t* H = (const bf16_t*)(F.ws + WS_H); bf16_t* AS = (bf16_t*)(F.ws + WS_R + R_ASORT);
    const float* hsc = (const float*)(F.ws + WS_MISC + MS_HSC); float* asc = (float*)(F.ws + WS_MISC + MS_ASC);
    const int* toke = (const int*)(F.ws + WS_MISC + MS_TOKE); int* slot = (int*)(F.ws + WS_MISC + MS_SLOT); const int* cntg = (const int*)(F.ws + WS_MISC + MS_CNT);
    int* texp = (int*)(F.ws + WS_MISC + MS_TEXP);
    volatile LAS int* tot = (volatile LAS int*)(F.lds + LDSCTL_OFF + 1024);
    volatile LAS int* pre = tot + 8;
    volatile LAS int* wcnt = tot + 16;
    for (int c = F.vcu; c < T / 128; c += F.G) {
        if (F.tid < 16) tot[F.tid] = 0;
        __syncthreads();
        { const int cc = F.tid >> 1, h = F.tid & 1; const i32x4 v = *(const i32x4*)(cntg + cc * 8 + 4 * h);
#pragma unroll
          for (int k = 0; k < 4; ++k) { __hip_atomic_fetch_add((LAS int*)&tot[4 * h + k], v[k], __ATOMIC_RELAXED, __HIP_MEMORY_SCOPE_WORKGROUP); if (cc < c) __hip_atomic_fetch_add((LAS int*)&pre[4 * h + k], v[k], __ATOMIC_RELAXED, __HIP_MEMORY_SCOPE_WORKGROUP); } }
        const int t = c * 128 + F.wave * 16 + ((F.lane & 31) >> 1);
        const int my_e = (F.lane < 32) ? toke[2 * t + (F.lane & 1)] : -1;
        int rank = 0;
#pragma unroll
        for (int e = 0; e < 8; ++e) { const unsigned long long m = __ballot(my_e == e); if (my_e == e) rank = __popcll(m & ((1ull << F.lane) - 1ull)); if (F.lane == 0) wcnt[F.wave * 8 + e] = __popcll(m); }
        __syncthreads();
        int myslot = 0;
        if (F.lane < 32) {
            int ts = 0;
#pragma unroll
            for (int e = 0; e < 8; ++e) ts += (e < my_e) ? ((tot[e] + 255) >> 8) : 0;
            int wp = 0; for (int w = 0; w < F.wave; ++w) wp += wcnt[w * 8 + my_e];
            myslot = ts * 256 + pre[my_e] + wp + rank;
            slot[2 * t + (F.lane & 1)] = myslot;
        }
        if (c == 0 && F.tid == 0) { int ts = 0; for (int e = 0; e < 8; ++e) { const int n = (tot[e] + 255) >> 8; for (int k = 0; k < n; ++k) texp[ts + k] = e; ts += n; } for (int k = ts; k < MAXRT; ++k) texp[k] = 0; texp[MAXRT] = ts; }
        if (i8) {
            const float myh = hsc[t];
#pragma unroll 1
            for (int a0 = 0; a0 < 32; a0 += 8) {
                u32x4 x[4];
#pragma unroll
                for (int k = 0; k < 4; ++k) x[k] = *((const u32x4*)((const signed char*)H + (size_t)(c * 128 + F.wave * 16 + ((a0 + 2 * k) >> 1)) * DM) + F.lane);
#pragma unroll
                for (int k = 0; k < 8; ++k) { const int s = __builtin_amdgcn_readlane(myslot, a0 + k); *((u32x4*)((signed char*)AS + (size_t)s * DM) + F.lane) = x[k >> 1]; }
            }
            if (F.lane < 32) asc[myslot] = myh;
        } else {
            for (int a = 0; a < 32; ++a) {
                const int s = __builtin_amdgcn_readlane(myslot, a); const int ta = c * 128 + F.wave * 16 + (a >> 1);
                const u32x4* srcp = (const u32x4*)(H + (size_t)ta * DM) + F.lane; u32x4* dstp = (u32x4*)(AS + (size_t)s * DM) + F.lane;
                const u32x4 x0 = srcp[0], x1 = srcp[64]; dstp[0] = x0; dstp[64] = x1; }
        }
        __syncthreads();
    }
}

using pg8::Unit;
typedef f32x4 AccT[2][2][4][2];

struct ProbSimple { int K; unsigned lda, ldb; const char* A; const char* B;
    __device__ __forceinline__ const char* a_ptr(const Unit& u) const { return A + (size_t)u.pm * 256 * lda; }
    __device__ __forceinline__ const char* b_ptr(const Unit& u) const { return B + (size_t)u.pn * 256 * ldb; } };
struct ProbUp { int K; unsigned lda, ldb; const char* A; const char* B;
    __device__ __forceinline__ const char* a_ptr(const Unit& u) const { return A + (size_t)u.pm * 256 * lda + (u.pn >= 3 ? 256 : 0); }
    __device__ __forceinline__ const char* b_ptr(const Unit& u) const { return B + (size_t)u.pn * 256 * ldb; } };
struct ProbMoe { int K; unsigned lda, ldb; const char* A; const char* B; int a_lo;
    __device__ __forceinline__ const char* a_ptr(const Unit& u) const { return A + (size_t)(u.pm - a_lo) * 256 * lda; }
    __device__ __forceinline__ const char* b_ptr(const Unit& u) const { return B + (size_t)u.aux * WF_STRIDE + (size_t)u.pn * 256 * ldb; } };

struct MoeOrder { pg8::StaticOrder base; int lo; const int* texp;
    __device__ bool next(int i, Unit& u) const { if (!base.next(i, u)) return false; u.pm += lo; u.aux = __builtin_amdgcn_readfirstlane(texp[u.pm]); return true; } };

__device__ __forceinline__ u32x4 pack8(const f32x4 a, const f32x4 b) { u32x4 w; w.x = cvtpk(a[0], a[1]); w.y = cvtpk(a[2], a[3]); w.z = cvtpk(b[0], b[1]); w.w = cvtpk(b[2], b[3]); return w; }
__device__ __forceinline__ u32x2 pack4(const f32x4 a) { u32x2 w; w.x = cvtpk(a[0], a[1]); w.y = cvtpk(a[2], a[3]); return w; }

struct EpiNoStage { __device__ __forceinline__ void stage(LAS unsigned char*, const Unit&, int, int) const {} };
__device__ __forceinline__ void stage1k(const void* src, LAS unsigned char* dst, int lane) { __builtin_amdgcn_global_load_lds((const unsigned*)((const char*)src + lane * 16), (LAS unsigned*)dst, 16, 0, 0); }
__device__ __forceinline__ f32x4 deq(const f32x4& a, float, const f32x4&) { return a; }
__device__ __forceinline__ f32x4 deq(const i32x4& a, float rs, const f32x4& cs) { return __builtin_convertvector(a, f32x4) * rs * cs; }
struct EpiInproj {
    static constexpr bool MID = false;
    bf16_t* P; bf16_t* G; float* ssq; const int* pos; const float* rsc; const float* csc;
    __device__ __forceinline__ void stage(LAS unsigned char* d, const Unit& u, int wid, int lane) const {
        if (wid == 0) { stage1k(rsc + u.pm * 256, d, lane); stage1k(csc + u.pn * 256, d + 1024, lane); stage1k(pos + u.pm * 256, d + 2048, lane); } }
    template <class AV> __device__ __forceinline__ void operator()(const AV (&acc)[2][2][4][2], const Unit& u, int wr, int wc, int fr, int fq, const LAS unsigned char* esc) const {
        const int pn = u.pn, row0 = u.pm * 256 + wr * 64 + fr;
        f32x4 cs[2][2];
#pragma unroll
        for (int bj = 0; bj < 2; ++bj)
#pragma unroll
            for (int n = 0; n < 2; ++n) cs[bj][n] = *(const LAS f32x4*)(esc + 1024 + (bj * 128 + wc * 32 + n * 16 + fq * 4) * 4);
        float rs8[2][4], pf8[2][4];
#pragma unroll
        for (int ai = 0; ai < 2; ++ai)
#pragma unroll
            for (int m = 0; m < 4; ++m) { const int rl = ai * 128 + wr * 64 + m * 16 + fr; rs8[ai][m] = *(const LAS float*)(esc + rl * 4); pf8[ai][m] = (float)*(const LAS int*)(esc + 2048 + rl * 4); }
#define DQ(ai, bj, m, n) deq(acc[ai][bj][m][n], rs, cs[bj][n])
        if (pn >= 7) {
#pragma unroll
            for (int ai = 0; ai < 2; ++ai)
#pragma unroll
                for (int m = 0; m < 4; ++m) { const int row = row0 + ai * 128 + m * 16; const float rs = rs8[ai][m]; u32x4 w;
#pragma unroll
                    for (int bj = 0; bj < 2; ++bj) { f32x4 a = DQ(ai, bj, m, 0), b = DQ(ai, bj, m, 1);
#pragma unroll
                        for (int j = 0; j < 4; ++j) { a[j] = fast_sigmoid(a[j]) * 255.0f; b[j] = fast_sigmoid(b[j]) * 255.0f; }
                        const unsigned wa_ = (unsigned)__float2int_rn(a[0]) | ((unsigned)__float2int_rn(a[1]) << 8) | ((unsigned)__float2int_rn(a[2]) << 16) | ((unsigned)__float2int_rn(a[3]) << 24);
                        const unsigned wb_ = (unsigned)__float2int_rn(b[0]) | ((unsigned)__float2int_rn(b[1]) << 8) | ((unsigned)__float2int_rn(b[2]) << 16) | ((unsigned)__float2int_rn(b[3]) << 24);
                        if (bj == 0) { w.x = wa_; w.y = wb_; } else { w.z = wa_; w.w = wb_; } }
                    *(u32x4*)((unsigned char*)G + (size_t)row * GW + (pn - 7) * 256 + wc * 64 + fq * 16) = w; }
        } else if (pn >= 5 || pn == 3) {
            const float sc = (pn == 3) ? 1.0f : C_M;
#pragma unroll
            for (int ai = 0; ai < 2; ++ai)
#pragma unroll
                for (int m = 0; m < 4; ++m) { const int row = row0 + ai * 128 + m * 16; const float rs = rs8[ai][m]; float s = 0.f;
#pragma unroll
                    for (int bj = 0; bj < 2; ++bj) { const f32x4 a = DQ(ai, bj, m, 0) * sc, b = DQ(ai, bj, m, 1) * sc;
                        s += (a[0] * a[0] + a[1] * a[1]) + (a[2] * a[2] + a[3] * a[3]) + (b[0] * b[0] + b[1] * b[1]) + (b[2] * b[2] + b[3] * b[3]);
                        *(u32x4*)(P + (size_t)row * PW + pn * 256 + bj * 128 + wc * 32 + fq * 8) = pack8(a, b); }
                    if (pn == 3) { s += __shfl_xor(s, 16); s += __shfl_xor(s, 32); if (fq == 0) ssq[(size_t)row * 8 + wc] = s; } }
        } else if (pn == 4) {
#pragma unroll
            for (int ai = 0; ai < 2; ++ai)
#pragma unroll
                for (int m = 0; m < 4; ++m) { const int row = row0 + ai * 128 + m * 16; const float rs = rs8[ai][m];
                    { const f32x4 a = DQ(ai, 0, m, 0), b = DQ(ai, 0, m, 1);
                      float s = (a[0] * a[0] + a[1] * a[1]) + (a[2] * a[2] + a[3] * a[3]) + (b[0] * b[0] + b[1] * b[1]) + (b[2] * b[2] + b[3] * b[3]);
                      *(u32x4*)(P + (size_t)row * PW + P_CKV + wc * 32 + fq * 8) = pack8(a, b);
                      s += __shfl_xor(s, 16); s += __shfl_xor(s, 32); if (fq == 0) ssq[(size_t)row * 8 + 4 + wc] = s; }
                    if (wc == 0) { const f32x4 x1 = DQ(ai, 1, m, 0), x2 = DQ(ai, 1, m, 1); const float pf = pf8[ai][m]; f32x4 o1, o2;
#pragma unroll
                        for (int j = 0; j < 4; ++j) { float c, s; rot_cs(pf, 2 * (4 * fq + j), c, s); o1[j] = x1[j] * c - x2[j] * s; o2[j] = x2[j] * c + x1[j] * s; }
                        *(u32x2*)(P + (size_t)row * PW + P_KR + 4 * fq) = pack4(o1); *(u32x2*)(P + (size_t)row * PW + P_KR + 16 + 4 * fq) = pack4(o2); } }
        } else {
            const float sc = (pn < 2) ? C_A : 1.0f; const int i0 = 16 * (wc & 1) + 4 * fq;
#pragma unroll
            for (int ai = 0; ai < 2; ++ai)
#pragma unroll
                for (int m = 0; m < 4; ++m) { const int row = row0 + ai * 128 + m * 16; const float rs = rs8[ai][m]; const float pf = pf8[ai][m]; f32x4 c, s;
#pragma unroll
                    for (int j = 0; j < 4; ++j) { float cc, ss; rot_cs(pf, i0 + j, cc, ss); c[j] = cc * sc; s[j] = ss * sc; }
#pragma unroll
                    for (int bj = 0; bj < 2; ++bj) { const f32x4 x1 = DQ(ai, bj, m, 0), x2 = DQ(ai, bj, m, 1);
                        if (pn == 2 && bj == 1) { *(u32x4*)(P + (size_t)row * PW + P_VA + wc * 32 + fq * 8) = pack8(x1, x2); }
                        else { const f32x4 o1 = x1 * c - x2 * s, o2 = x2 * c + x1 * s; bf16_t* d = P + (size_t)row * PW + pn * 256 + 64 * (2 * bj + (wc >> 1)) + i0;
                            *(u32x2*)d = pack4(o1); *(u32x2*)(d + 32) = pack4(o2); } } }
        }
#undef DQ
    }
};
struct EpiUp {
    static constexpr bool MID = false;
    __device__ __forceinline__ void stage(LAS unsigned char*, const Unit&, int, int) const {}
    bf16_t* QB; bf16_t* KVB; const float* ssq; const int* pos;
    __device__ __forceinline__ void operator()(const AccT& acc, const Unit& u, int wr, int wc, int fr, int fq, const LAS unsigned char*) const {
        const int pn = u.pn, row0 = u.pm * 256 + wr * 64 + fr;
        float rs8[2][4], pf8[2][4];
#pragma unroll
        for (int ai = 0; ai < 2; ++ai)
#pragma unroll
            for (int m = 0; m < 4; ++m) { const int row = row0 + ai * 128 + m * 16; const f32x4 sv = *(const f32x4*)(ssq + (size_t)row * 8 + (pn < 3 ? 0 : 4));
                rs8[ai][m] = (pn < 3 ? C_B : 1.0f) / sqrtf(((sv[0] + sv[1]) + (sv[2] + sv[3])) * (pn < 3 ? 1.0f / 256.0f : 1.0f / 128.0f) + EPS); pf8[ai][m] = (pn < 3) ? (float)pos[row] : 0.f; }
#pragma unroll
        for (int ai = 0; ai < 2; ++ai)
#pragma unroll
            for (int m = 0; m < 4; ++m) { const int row = row0 + ai * 128 + m * 16; const float rs = rs8[ai][m];
                if (pn < 3) {
#pragma unroll
                    for (int bj = 0; bj < 2; ++bj) { const int gg = 8 * pn + 4 * bj + wc; const f32x4 x1 = acc[ai][bj][m][0] * rs, x2 = acc[ai][bj][m][1] * rs;
                        if (gg % 3 == 2) { const float pf = pf8[ai][m]; f32x4 o1, o2;
#pragma unroll
                            for (int j = 0; j < 4; ++j) { float c, s; rot_cs(pf, 2 * (4 * fq + j), c, s); o1[j] = x1[j] * c - x2[j] * s; o2[j] = x2[j] * c + x1[j] * s; }
                            bf16_t* d = QB + (size_t)row * QBW + 32 * gg + 4 * fq; *(u32x2*)d = pack4(o1); *(u32x2*)(d + 16) = pack4(o2); }
                        else *(u32x4*)(QB + (size_t)row * QBW + 32 * gg + 8 * fq) = pack8(x1, x2); }
                } else {
#pragma unroll
                    for (int bj = 0; bj < 2; ++bj) *(u32x4*)(KVB + (size_t)row * KVW + (pn - 3) * 256 + bj * 128 + wc * 32 + fq * 8) = pack8(acc[ai][bj][m][0] * rs, acc[ai][bj][m][1] * rs);
                } }
    }
};
struct EpiPlain {
    static constexpr bool MID = false;
    __device__ __forceinline__ void stage(LAS unsigned char*, const Unit&, int, int) const {}
    bf16_t* O; int ldo;
    __device__ __forceinline__ void operator()(const AccT& acc, const Unit& u, int wr, int wc, int fr, int fq, const LAS unsigned char*) const {
        const int row0 = u.pm * 256 + wr * 64 + fr;
#pragma unroll
        for (int ai = 0; ai < 2; ++ai)
#pragma unroll
            for (int m = 0; m < 4; ++m)
#pragma unroll
                for (int bj = 0; bj < 2; ++bj) *(u32x4*)(O + (size_t)(row0 + ai * 128 + m * 16) * ldo + u.pn * 256 + bj * 128 + wc * 32 + fq * 8) = pack8(acc[ai][bj][m][0], acc[ai][bj][m][1]);
    }
};
struct EpiBranch {
    static constexpr bool MID = true;
    const unsigned char* G; bf16_t* MIXED;
    __device__ __forceinline__ void stage(LAS unsigned char*, const Unit&, int, int) const {}
    static __device__ __forceinline__ float gq(unsigned w, int b) { const float f = (float)((w >> (8 * b)) & 255u); return fmaxf(f, 2.55e-4f); }
    __device__ __forceinline__ void mid(AccT& acc, const Unit& u, int seg  , int wr, int wc, int fr, int fq) const {
        const int row0 = opq_v(u.pm * 256 + wr * 64 + fr);
#pragma unroll
        for (int ai = 0; ai < 2; ++ai) {
            u32x4 ga[4], gb[4];
#pragma unroll
            for (int m = 0; m < 4; ++m) { const unsigned char* gp = G + (size_t)(row0 + ai * 128 + m * 16) * GW + u.pn * 256 + wc * 64 + fq * 16;
                ga[m] = *(const u32x4*)(gp + (seg - 1) * 1024); gb[m] = *(const u32x4*)(gp + seg * 1024); }
#pragma unroll
            for (int m = 0; m < 4; ++m) {
#pragma unroll
                for (int j = 0; j < 4; ++j) {
                    acc[ai][0][m][0][j] *= gq(ga[m].x, j) * __builtin_amdgcn_rcpf(gq(gb[m].x, j)); acc[ai][0][m][1][j] *= gq(ga[m].y, j) * __builtin_amdgcn_rcpf(gq(gb[m].y, j));
                    acc[ai][1][m][0][j] *= gq(ga[m].z, j) * __builtin_amdgcn_rcpf(gq(gb[m].z, j)); acc[ai][1][m][1][j] *= gq(ga[m].w, j) * __builtin_amdgcn_rcpf(gq(gb[m].w, j)); } }
            asm volatile("" ::: "memory"); }
    }
    __device__ __forceinline__ void operator()(const AccT& acc, const Unit& u, int wr, int wc, int fr, int fq, const LAS unsigned char*) const {
        const int row0 = u.pm * 256 + wr * 64 + fr;
#pragma unroll
        for (int ai = 0; ai < 2; ++ai) {
            u32x4 gw[4];
#pragma unroll
            for (int m = 0; m < 4; ++m) gw[m] = *(const u32x4*)(G + (size_t)(row0 + ai * 128 + m * 16) * GW + 2048 + u.pn * 256 + wc * 64 + fq * 16);
#pragma unroll
            for (int m = 0; m < 4; ++m) { f32x4 a0 = acc[ai][0][m][0], b0 = acc[ai][0][m][1], a1 = acc[ai][1][m][0], b1 = acc[ai][1][m][1];
#pragma unroll
                for (int j = 0; j < 4; ++j) { a0[j] *= gq(gw[m].x, j) * (1.0f / 255.0f); b0[j] *= gq(gw[m].y, j) * (1.0f / 255.0f); a1[j] *= gq(gw[m].z, j) * (1.0f / 255.0f); b1[j] *= gq(gw[m].w, j) * (1.0f / 255.0f); }
                bf16_t* d = MIXED + (size_t)(row0 + ai * 128 + m * 16) * DM + u.pn * 256 + wc * 64 + fq * 16;
                *(u32x4*)d = pack8(a0, b0); *(u32x4*)(d + 8) = pack8(a1, b1); }
            asm volatile("" ::: "memory"); }
    }
};
struct EpiResid {
    static constexpr bool MID = false;
    __device__ __forceinline__ void stage(LAS unsigned char*, const Unit&, int, int) const {}
    const float* Xf; bf16_t* X;
    __device__ __forceinline__ void operator()(const AccT& acc, const Unit& u, int wr, int wc, int fr, int fq, const LAS unsigned char*) const {
        const int row0 = u.pm * 256 + wr * 64 + fr;
#pragma unroll
        for (int ai = 0; ai < 2; ++ai) {
            f32x4 xa[4][2], xb[4][2];
#pragma unroll
            for (int m = 0; m < 4; ++m)
#pragma unroll
                for (int bj = 0; bj < 2; ++bj) { const size_t o = (size_t)(row0 + ai * 128 + m * 16) * DM + u.pn * 256 + bj * 128 + wc * 32 + fq * 8;
                    if (Xf) { xa[m][bj] = *(const f32x4*)(Xf + o); xb[m][bj] = *(const f32x4*)(Xf + o + 4); }
                    else { const u32x4 q = *(const u32x4*)(X + o); xa[m][bj] = (f32x4){bflo(q.x), bfhi(q.x), bflo(q.y), bfhi(q.y)}; xb[m][bj] = (f32x4){bflo(q.z), bfhi(q.z), bflo(q.w), bfhi(q.w)}; } }
#pragma unroll
            for (int m = 0; m < 4; ++m)
#pragma unroll
                for (int bj = 0; bj < 2; ++bj) *(u32x4*)(X + (size_t)(row0 + ai * 128 + m * 16) * DM + u.pn * 256 + bj * 128 + wc * 32 + fq * 8) = pack8(xa[m][bj] + acc[ai][bj][m][0], xb[m][bj] + acc[ai][bj][m][1]);
            asm volatile("" ::: "memory"); }
    }
};
struct EpiSwiglu {
    static constexpr bool MID = false;
    bf16_t* ACT; int lo; const float* rsc; const float* csc;
    __device__ __forceinline__ void stage(LAS unsigned char* d, const Unit& u, int wid, int lane) const {
        if (wid == 0) { stage1k(rsc + u.pm * 256, d, lane); stage1k(csc + (size_t)u.aux * 2 * DFF + u.pn * 256, d + 1024, lane); } }
    template <class AV> __device__ __forceinline__ void operator()(const AV (&acc)[2][2][4][2], const Unit& u, int wr, int wc, int fr, int fq, const LAS unsigned char* esc) const {
        const int row0 = (u.pm - lo) * 256 + wr * 64 + fr;
        f32x4 cs[2][2];
#pragma unroll
        for (int bj = 0; bj < 2; ++bj)
#pragma unroll
            for (int n = 0; n < 2; ++n) cs[bj][n] = *(const LAS f32x4*)(esc + 1024 + (bj * 128 + wc * 32 + n * 16 + fq * 4) * 4);
        float rs8[2][4];
#pragma unroll
        for (int ai = 0; ai < 2; ++ai)
#pragma unroll
            for (int m = 0; m < 4; ++m) rs8[ai][m] = *(const LAS float*)(esc + (ai * 128 + wr * 64 + m * 16 + fr) * 4);
#pragma unroll
        for (int ai = 0; ai < 2; ++ai)
#pragma unroll
            for (int m = 0; m < 4; ++m) { const float rs = rs8[ai][m]; f32x4 a, b;
                const f32x4 g0 = deq(acc[ai][0][m][0], rs, cs[0][0]), g1 = deq(acc[ai][0][m][1], rs, cs[0][1]), u0 = deq(acc[ai][1][m][0], rs, cs[1][0]), u1 = deq(acc[ai][1][m][1], rs, cs[1][1]);
#pragma unroll
                for (int j = 0; j < 4; ++j) { a[j] = g0[j] * fast_sigmoid(g0[j]) * u0[j]; b[j] = g1[j] * fast_sigmoid(g1[j]) * u1[j]; }
                *(u32x4*)(ACT + (size_t)(row0 + ai * 128 + m * 16) * DFF + u.pn * 128 + wc * 32 + fq * 8) = pack8(a, b); }
    }
};
struct EpiYout {
    static constexpr bool MID = false;
    __device__ __forceinline__ void stage(LAS unsigned char*, const Unit&, int, int) const {}
    bf16_t* Y;
    __device__ __forceinline__ void operator()(const AccT& acc, const Unit& u, int wr, int wc, int fr, int fq, const LAS unsigned char*) const {
        const int row0 = u.pm * 256 + wr * 64 + fr;
#pragma unroll
        for (int ai = 0; ai < 2; ++ai)
#pragma unroll
            for (int m = 0; m < 4; ++m)
#pragma unroll
                for (int bj = 0; bj < 2; ++bj) *(u32x4*)(Y + (size_t)(row0 + ai * 128 + m * 16) * DM + u.pn * 256 + bj * 128 + wc * 32 + fq * 8) = pack8(acc[ai][bj][m][0], acc[ai][bj][m][1]);
    }
};

namespace att {
__device__ __forceinline__ int crow(int r, int hi) { return (r & 3) + 8 * (r >> 2) + 4 * hi; }
__device__ __forceinline__ void glds16(const void* gsrc, unsigned lds_dst) { unsigned keep;
    asm volatile("s_mov_b32 %0, m0\n\ts_mov_b32 m0, %2\n\ts_nop 0\n\tglobal_load_lds_dwordx4 %1, off\n\ts_mov_b32 m0, %0" : "=&s"(keep) : "v"(gsrc), "s"(lds_dst) : "memory"); }
__device__ __forceinline__ float swapmax(float m) { auto rr = __builtin_amdgcn_permlane32_swap(__float_as_uint(m), __float_as_uint(m), false, false); return fmaxf(__uint_as_float(rr[0]), __uint_as_float(rr[1])); }
__device__ __forceinline__ float swapsum(float m) { auto rr = __builtin_amdgcn_permlane32_swap(__float_as_uint(m), __float_as_uint(m), false, false); return __uint_as_float(rr[0]) + __uint_as_float(rr[1]); }
__device__ __forceinline__ void store_o_block(const f32x16& o, float linv, bf16_t* rowp  , int hi) {
#pragma unroll
    for (int rp = 0; rp < 2; ++rp) {
        const u32x2 X = pack4((f32x4){o[8 * rp] * linv, o[8 * rp + 1] * linv, o[8 * rp + 2] * linv, o[8 * rp + 3] * linv});
        const u32x2 Y = pack4((f32x4){o[8 * rp + 4] * linv, o[8 * rp + 5] * linv, o[8 * rp + 6] * linv, o[8 * rp + 7] * linv});
        const auto s0 = __builtin_amdgcn_permlane32_swap(X.x, Y.x, false, false), s1 = __builtin_amdgcn_permlane32_swap(X.y, Y.y, false, false);
        const u32x4 w = {s0[0], s1[0], s0[1], s1[1]};
        *(u32x4*)(rowp + 8 * (2 * rp + hi)) = w; }
}
__device__ __forceinline__ s16x4 vtr(unsigned addr) { s16x4 r; asm volatile("ds_read_b64_tr_b16 %0, %1" : "=&v"(r) : "v"(addr) : "memory"); return r; }
#define VTRO(dst, base, off) asm volatile("ds_read_b64_tr_b16 %0, %1 offset:%c2" : "=&v"(dst) : "v"(base), "i"(off) : "memory")

struct Src {
    const bf16_t* q; int qpitch;
    const bf16_t* k0; int k0pitch;
    const bf16_t* k1; int k1pitch;
    const bf16_t* v; int vpitch;
    bf16_t* o; int opitch;
};
template <int NKC, int NVB, int RD = 4>
__device__ __forceinline__ void dma_tile(const Src& S, int t, int slot, unsigned lds0, int wid, int lane) {
    constexpr int KS = NKC * 1024, VS = NVB * 4096, LDS_K = 0, LDS_V = RD * KS;
#pragma unroll
    for (int c = 0; c < (NKC + 7) / 8; ++c) { const int ch = wid + 8 * c; if (ch < NKC) {
        const bf16_t* src = (ch < 8) ? S.k0 + (size_t)(t * 64 + lane) * S.k0pitch + ch * 8 : S.k1 + (size_t)(t * 64 + lane) * S.k1pitch + (ch - 8) * 8;
        glds16(src, (unsigned)__builtin_amdgcn_readfirstlane(lds0 + LDS_K + slot * KS + ch * 1024)); } }
#pragma unroll
    for (int c = 0; c < (NVB * 4 + 7) / 8; ++c) { const int p = wid + 8 * c; if (p < NVB * 4) {
        const bf16_t* src = S.v + (size_t)(t * 64 + 16 * (p & 3) + (lane >> 2)) * S.vpitch + (p >> 2) * 32 + (lane & 3) * 8;
        glds16(src, (unsigned)__builtin_amdgcn_readfirstlane(lds0 + LDS_V + slot * VS + p * 1024)); } }
}
__device__ __forceinline__ void wait_vm_bar(int n) {
    if (n >= 4) asm volatile("s_waitcnt vmcnt(4) lgkmcnt(0)\n\ts_barrier" ::: "memory");
    else if (n == 3) asm volatile("s_waitcnt vmcnt(3) lgkmcnt(0)\n\ts_barrier" ::: "memory");
    else if (n == 2) asm volatile("s_waitcnt vmcnt(2) lgkmcnt(0)\n\ts_barrier" ::: "memory");
    else if (n == 1) asm volatile("s_waitcnt vmcnt(1) lgkmcnt(0)\n\ts_barrier" ::: "memory");
    else asm volatile("s_waitcnt vmcnt(0) lgkmcnt(0)\n\ts_barrier" ::: "memory");
}
template <int NKC, int NVB, int MODE>
__device__ __forceinline__ void unit(LAS unsigned char* lds, const Src& S, int t_lo, int t_hi, int qpos0  , float sink_l2) {
    constexpr int KS = NKC * 1024, VS = NVB * 4096, RD = 4, LDS_K = 0, LDS_V = RD * KS;
    const int tid = opq_v((int)threadIdx.x), lane = tid & 63, r32 = lane & 31, hi = lane >> 5; const int wid = __builtin_amdgcn_readfirstlane(tid >> 6), grp = wid >> 2;
    const unsigned lds0 = (unsigned)(uintptr_t)lds;
    const int ops = (NKC + 7 - wid) / 8 + (NVB * 4) / 8;
    bf16x8 qr[NKC / 2];
#pragma unroll
    for (int d0 = 0; d0 < NKC / 2; ++d0) qr[d0] = *(const bf16x8*)(S.q + (size_t)r32 * S.qpitch + d0 * 16 + hi * 8);
    float m_run = (MODE == 0) ? sink_l2 : 0.0f, l_run = (MODE == 0 && hi == 0) ? 1.0f : 0.0f; bool first = (MODE != 0);
    f32x16 o[NVB];
#pragma unroll
    for (int d = 0; d < NVB; ++d) o[d] = f32x16{};
    const int qi = qpos0 + wid * 32 + r32, qw0 = qpos0 + wid * 32;
    f32x16 p0 = f32x16{}, p1 = f32x16{};
#define AT_ACTIVE(t) ((MODE != 0) || ((64 * (t) + 63 >= qw0 - 128) && (64 * (t) <= qw0 + 31 + 128)))
#define AT_QK(t) do { const LAS unsigned char* kb_ = lds + LDS_K + (((t) - t_lo) % RD) * KS + hi * 1024 + r32 * 16; p0 = f32x16{}; p1 = f32x16{}; \
        _Pragma("unroll") for (int d0 = 0; d0 < NKC / 2; ++d0) { const bf16x8 b0_ = *(const LAS bf16x8*)(kb_ + d0 * 2048), b1_ = *(const LAS bf16x8*)(kb_ + d0 * 2048 + 512); \
            p0 = __builtin_amdgcn_mfma_f32_32x32x16_bf16(b0_, qr[d0], p0, 0, 0, 0); p1 = __builtin_amdgcn_mfma_f32_32x32x16_bf16(b1_, qr[d0], p1, 0, 0, 0); } } while (0)
#define AT_SMPV(t) do { \
        if (MODE == 0 && !((64 * (t) >= qw0 + 31 - 128) && (64 * (t) + 63 <= qw0 + 128))) {   \
            _Pragma("unroll") for (int r = 0; r < 16; ++r) { const int kv_ = 64 * (t) + crow(r, hi); int e0_ = kv_ - qi; e0_ = e0_ < 0 ? -e0_ : e0_; int e1_ = kv_ + 32 - qi; e1_ = e1_ < 0 ? -e1_ : e1_; \
            if (e0_ > 128) p0[r] = -INFINITY; if (e1_ > 128) p1[r] = -INFINITY; } } \
        if (first) {   \
            float mx_[8]; _Pragma("unroll") for (int r = 0; r < 8; ++r) mx_[r] = fmaxf(fmaxf(p0[r], p0[r + 8]), fmaxf(p1[r], p1[r + 8])); \
            float rm_ = fmaxf(fmaxf(fmaxf(mx_[0], mx_[1]), fmaxf(mx_[2], mx_[3])), fmaxf(fmaxf(mx_[4], mx_[5]), fmaxf(mx_[6], mx_[7]))); m_run = swapmax(rm_); first = false; } \
        else { const float tot_ = swapsum(l_run);   \
          if (__any(tot_ > 1.0e12f)) { const float dl_ = tot_ > 1.0e12f ? ceilf(__builtin_amdgcn_logf(tot_)) : 0.f, sc_ = __builtin_amdgcn_exp2f(-dl_); m_run += dl_; l_run *= sc_; \
              _Pragma("unroll") for (int d = 0; d < NVB; ++d) _Pragma("unroll") for (int r = 0; r < 16; ++r) o[d][r] *= sc_; } } \
        float sm_[4] = {0.f, 0.f, 0.f, 0.f}; \
        _Pragma("unroll") for (int r = 0; r < 16; ++r) { p0[r] = __builtin_amdgcn_exp2f(p0[r] - m_run); p1[r] = __builtin_amdgcn_exp2f(p1[r] - m_run); sm_[r & 3] += p0[r] + p1[r]; } \
        l_run += (sm_[0] + sm_[1]) + (sm_[2] + sm_[3]); \
        u32x4 pw_[4]; \
        pw_[0] = (u32x4){cvtpk(p0[0], p0[1]), cvtpk(p0[2], p0[3]), cvtpk(p0[4], p0[5]), cvtpk(p0[6], p0[7])}; pw_[1] = (u32x4){cvtpk(p0[8], p0[9]), cvtpk(p0[10], p0[11]), cvtpk(p0[12], p0[13]), cvtpk(p0[14], p0[15])}; \
        pw_[2] = (u32x4){cvtpk(p1[0], p1[1]), cvtpk(p1[2], p1[3]), cvtpk(p1[4], p1[5]), cvtpk(p1[6], p1[7])}; pw_[3] = (u32x4){cvtpk(p1[8], p1[9]), cvtpk(p1[10], p1[11]), cvtpk(p1[12], p1[13]), cvtpk(p1[14], p1[15])}; \
        const unsigned vb_ = lds0 + LDS_V + (((t) - t_lo) % RD) * VS + ((lane >> 4) & 1) * 32 + (lane & 3) * 8 + (4 * hi + ((lane & 15) >> 2)) * 64; \
        _Pragma("unroll") for (int dp = 0; dp < NVB; dp += 2) { s16x4 lo_[2][4], hh_[2][4]; \
            _Pragma("unroll") for (int dd = 0; dd < 2; ++dd) _Pragma("unroll") for (int ks = 0; ks < 4; ++ks) { lo_[dd][ks] = vtr(vb_ + (dp + dd) * 4096 + ks * 1024); hh_[dd][ks] = vtr(vb_ + (dp + dd) * 4096 + ks * 1024 + 512); } \
            asm volatile("s_waitcnt lgkmcnt(0)" ::: "memory"); __builtin_amdgcn_sched_barrier(0); \
            _Pragma("unroll") for (int ks = 0; ks < 4; ++ks) _Pragma("unroll") for (int dd = 0; dd < 2; ++dd) { \
                const bf16x8 vf_ = (bf16x8){lo_[dd][ks][0], lo_[dd][ks][1], lo_[dd][ks][2], lo_[dd][ks][3], hh_[dd][ks][0], hh_[dd][ks][1], hh_[dd][ks][2], hh_[dd][ks][3]}; \
                o[dp + dd] = __builtin_amdgcn_mfma_f32_32x32x16_bf16(vf_, __builtin_bit_cast(bf16x8, pw_[ks]), o[dp + dd], 0, 0, 0); } } } while (0)
    dma_tile<NKC, NVB>(S, t_lo, 0, lds0, wid, lane);
    if (t_lo + 1 < t_hi) dma_tile<NKC, NVB>(S, t_lo + 1, 1, lds0, wid, lane);
    for (int t = t_lo; t < t_hi; ++t) {
        wait_vm_bar((t + 1 < t_hi) ? ops : 0);
        if (t + 2 < t_hi) dma_tile<NKC, NVB>(S, t + 2, (t + 2 - t_lo) % RD, lds0, wid, lane);
        if (grp == 0) { if (AT_ACTIVE(t)) { AT_QK(t); AT_SMPV(t); } }
        else { if (t > t_lo && AT_ACTIVE(t - 1)) AT_SMPV(t - 1); if (AT_ACTIVE(t)) AT_QK(t); }
    }
    if (grp == 1 && AT_ACTIVE(t_hi - 1)) AT_SMPV(t_hi - 1);
    const float linv = 1.0f / swapsum(l_run);
#pragma unroll
    for (int d = 0; d < NVB; ++d) store_o_block(o[d], linv, S.o + (size_t)r32 * S.opitch + 32 * d, hi);
    asm volatile("s_waitcnt lgkmcnt(0)\n\ts_barrier" ::: "memory");
#undef AT_ACTIVE
#undef AT_QK
#undef AT_SMPV
}

template <int NKC, int NVB>
__device__ __forceinline__ void unit_q64(LAS unsigned char* lds, const Src& S, int t_lo, int t_hi) {
    constexpr int KS = NKC * 1024, VS = NVB * 4096, RD = 4, LDS_K = 0, LDS_V = RD * KS;
    const int tid = opq_v((int)threadIdx.x), lane = tid & 63, r32 = lane & 31, hi = lane >> 5; const int wid = __builtin_amdgcn_readfirstlane(tid >> 6);
    const unsigned lds0 = (unsigned)(uintptr_t)lds;
    const int ops = (NKC + 7 - wid) / 8 + (NVB * 4) / 8;
    bf16x8 qa[NKC / 2], qb[NKC / 2];
#pragma unroll
    for (int d0 = 0; d0 < NKC / 2; ++d0) { qa[d0] = *(const bf16x8*)(S.q + (size_t)r32 * S.qpitch + d0 * 16 + hi * 8); qb[d0] = *(const bf16x8*)(S.q + (size_t)(32 + r32) * S.qpitch + d0 * 16 + hi * 8); }
    float ma = 0.f, la = 0.f, mb = 0.f, lb = 0.f; bool first = true;
    f32x16 oa[NVB], ob[NVB];
#pragma unroll
    for (int d = 0; d < NVB; ++d) { oa[d] = f32x16{}; ob[d] = f32x16{}; }
#define Q64_SM(P0, P1, M, L, O, PW) do { \
        if (first) {   \
            float mx_[8]; _Pragma("unroll") for (int r = 0; r < 8; ++r) mx_[r] = fmaxf(fmaxf(P0[r], P0[r + 8]), fmaxf(P1[r], P1[r + 8])); \
            float rm_ = fmaxf(fmaxf(fmaxf(mx_[0], mx_[1]), fmaxf(mx_[2], mx_[3])), fmaxf(fmaxf(mx_[4], mx_[5]), fmaxf(mx_[6], mx_[7]))); M = swapmax(rm_); } \
        else { const float tot_ = swapsum(L);   \
          if (__any(tot_ > 1.0e12f)) { const float dl_ = tot_ > 1.0e12f ? ceilf(__builtin_amdgcn_logf(tot_)) : 0.f, sc_ = __builtin_amdgcn_exp2f(-dl_); M += dl_; L *= sc_; \
              _Pragma("unroll") for (int d = 0; d < NVB; ++d) _Pragma("unroll") for (int r = 0; r < 16; ++r) O[d][r] *= sc_; } } \
        float sm_[4] = {0.f, 0.f, 0.f, 0.f}; \
        _Pragma("unroll") for (int r = 0; r < 16; ++r) { P0[r] = __builtin_amdgcn_exp2f(P0[r] - M); P1[r] = __builtin_amdgcn_exp2f(P1[r] - M); sm_[r & 3] += P0[r] + P1[r]; } \
        L += (sm_[0] + sm_[1]) + (sm_[2] + sm_[3]); \
        PW[0] = (u32x4){cvtpk(P0[0], P0[1]), cvtpk(P0[2], P0[3]), cvtpk(P0[4], P0[5]), cvtpk(P0[6], P0[7])}; PW[1] = (u32x4){cvtpk(P0[8], P0[9]), cvtpk(P0[10], P0[11]), cvtpk(P0[12], P0[13]), cvtpk(P0[14], P0[15])}; \
        PW[2] = (u32x4){cvtpk(P1[0], P1[1]), cvtpk(P1[2], P1[3]), cvtpk(P1[4], P1[5]), cvtpk(P1[6], P1[7])}; PW[3] = (u32x4){cvtpk(P1[8], P1[9]), cvtpk(P1[10], P1[11]), cvtpk(P1[12], P1[13]), cvtpk(P1[14], P1[15])}; \
        __builtin_amdgcn_sched_barrier(0); } while (0)
#define Q64_SM_NB(P0, P1, M, L, O, PW) do { \
        if (first) {   \
            float mx_[8]; _Pragma("unroll") for (int r = 0; r < 8; ++r) mx_[r] = fmaxf(fmaxf(P0[r], P0[r + 8]), fmaxf(P1[r], P1[r + 8])); \
            float rm_ = fmaxf(fmaxf(fmaxf(mx_[0], mx_[1]), fmaxf(mx_[2], mx_[3])), fmaxf(fmaxf(mx_[4], mx_[5]), fmaxf(mx_[6], mx_[7]))); M = swapmax(rm_); } \
        else { const float tot_ = swapsum(L);   \
          if (__any(tot_ > 1.0e12f)) { const float dl_ = tot_ > 1.0e12f ? ceilf(__builtin_amdgcn_logf(tot_)) : 0.f, sc_ = __builtin_amdgcn_exp2f(-dl_); M += dl_; L *= sc_; \
              _Pragma("unroll") for (int d = 0; d < NVB; ++d) _Pragma("unroll") for (int r = 0; r < 16; ++r) O[d][r] *= sc_; } } \
        float sm_[4] = {0.f, 0.f, 0.f, 0.f}; \
        _Pragma("unroll") for (int r = 0; r < 16; ++r) { P0[r] = __builtin_amdgcn_exp2f(P0[r] - M); P1[r] = __builtin_amdgcn_exp2f(P1[r] - M); sm_[r & 3] += P0[r] + P1[r]; } \
        L += (sm_[0] + sm_[1]) + (sm_[2] + sm_[3]); \
        PW[0] = (u32x4){cvtpk(P0[0], P0[1]), cvtpk(P0[2], P0[3]), cvtpk(P0[4], P0[5]), cvtpk(P0[6], P0[7])}; PW[1] = (u32x4){cvtpk(P0[8], P0[9]), cvtpk(P0[10], P0[11]), cvtpk(P0[12], P0[13]), cvtpk(P0[14], P0[15])}; \
        PW[2] = (u32x4){cvtpk(P1[0], P1[1]), cvtpk(P1[2], P1[3]), cvtpk(P1[4], P1[5]), cvtpk(P1[6], P1[7])}; PW[3] = (u32x4){cvtpk(P1[8], P1[9]), cvtpk(P1[10], P1[11]), cvtpk(P1[12], P1[13]), cvtpk(P1[14], P1[15])}; \
        } while (0)
    dma_tile<NKC, NVB, RD>(S, t_lo, 0, lds0, wid, lane);
    if (t_lo + 1 < t_hi) dma_tile<NKC, NVB, RD>(S, t_lo + 1, 1, lds0, wid, lane);
    for (int t = t_lo; t < t_hi; ++t) {
        const int slot = (t - t_lo) % RD;
        wait_vm_bar((t + 1 < t_hi) ? ops : 0);
        if (t + 2 < t_hi) dma_tile<NKC, NVB, RD>(S, t + 2, (t + 2 - t_lo) % RD, lds0, wid, lane);
        const LAS unsigned char* kb = lds + LDS_K + slot * KS + hi * 1024 + r32 * 16;
        f32x16 s0a = f32x16{}, s0b = f32x16{}, s1a = f32x16{}, s1b = f32x16{};
#pragma unroll
        for (int d0 = 0; d0 < NKC / 2; ++d0) {
            const bf16x8 b0 = *(const LAS bf16x8*)(kb + d0 * 2048), b1 = *(const LAS bf16x8*)(kb + d0 * 2048 + 512);
            s0a = __builtin_amdgcn_mfma_f32_32x32x16_bf16(b0, qa[d0], s0a, 0, 0, 0); s0b = __builtin_amdgcn_mfma_f32_32x32x16_bf16(b1, qa[d0], s0b, 0, 0, 0);
            s1a = __builtin_amdgcn_mfma_f32_32x32x16_bf16(b0, qb[d0], s1a, 0, 0, 0); s1b = __builtin_amdgcn_mfma_f32_32x32x16_bf16(b1, qb[d0], s1b, 0, 0, 0); }
        __builtin_amdgcn_sched_barrier(0);
        u32x4 pwa[4], pwb[4];
        const unsigned vb = lds0 + LDS_V + slot * VS + ((lane >> 4) & 1) * 32 + (lane & 3) * 8 + (4 * hi + ((lane & 15) >> 2)) * 64;
        s16x4 lo[NVB][4], hh[NVB][4];
#pragma unroll
        for (int d = 0; d < NVB; ++d)
#pragma unroll
            for (int ks = 0; ks < 4; ++ks) { VTRO(lo[d][ks], vb, d * 4096 + ks * 1024); VTRO(hh[d][ks], vb, d * 4096 + ks * 1024 + 512); }
        __builtin_amdgcn_sched_barrier(0);
        Q64_SM(s0a, s0b, ma, la, oa, pwa);
        asm volatile("s_waitcnt lgkmcnt(0)" ::: "memory"); __builtin_amdgcn_sched_barrier(0);
#pragma unroll
        for (int ks = 0; ks < 4; ++ks)
#pragma unroll
            for (int d = 0; d < NVB; ++d) { const bf16x8 vf = (bf16x8){lo[d][ks][0], lo[d][ks][1], lo[d][ks][2], lo[d][ks][3], hh[d][ks][0], hh[d][ks][1], hh[d][ks][2], hh[d][ks][3]};
                oa[d] = __builtin_amdgcn_mfma_f32_32x32x16_bf16(vf, __builtin_bit_cast(bf16x8, pwa[ks]), oa[d], 0, 0, 0); }
        Q64_SM_NB(s1a, s1b, mb, lb, ob, pwb);
#pragma unroll
        for (int i = 0; i < 8; ++i) { __builtin_amdgcn_sched_group_barrier(0x008, 1, 0); __builtin_amdgcn_sched_group_barrier(0x002, 12, 0); }
        __builtin_amdgcn_sched_barrier(0);
#pragma unroll
        for (int ks = 0; ks < 4; ++ks)
#pragma unroll
            for (int d = 0; d < NVB; ++d) { const bf16x8 vf = (bf16x8){lo[d][ks][0], lo[d][ks][1], lo[d][ks][2], lo[d][ks][3], hh[d][ks][0], hh[d][ks][1], hh[d][ks][2], hh[d][ks][3]};
                ob[d] = __builtin_amdgcn_mfma_f32_32x32x16_bf16(vf, __builtin_bit_cast(bf16x8, pwb[ks]), ob[d], 0, 0, 0); }
        __builtin_amdgcn_sched_barrier(0);
        first = false;
    }
    const float lia = 1.0f / swapsum(la), lib = 1.0f / swapsum(lb);
#pragma unroll
    for (int d = 0; d < NVB; ++d) { store_o_block(oa[d], lia, S.o + (size_t)r32 * S.opitch + 32 * d, hi); store_o_block(ob[d], lib, S.o + (size_t)(32 + r32) * S.opitch + 32 * d, hi); }
    asm volatile("s_waitcnt lgkmcnt(0)\n\ts_barrier" ::: "memory");
#undef Q64_SM
#undef Q64_SM_NB
}

}
#define SC_AFTER_PROLOGUE() do {} while (0)
#define SC_AFTER_INPROJ(l) do {} while (0)
#define SC_AFTER_UP(l) do {} while (0)
#define SC_AFTER_MLA(l) do {} while (0)
#define SC_AFTER_BRANCH(l) do {} while (0)
#define SC_AFTER_WOUT(l) do {} while (0)
#define SC_AFTER_NORM2(l) do {} while (0)
#define SC_AFTER_GU(l) do {} while (0)
#define SC_AFTER_DOWN(l) do {} while (0)
#define SC_AFTER_ROUTE(l) do {} while (0)
#define SC_AFTER_MOEGU(l, h) do {} while (0)
#define SC_AFTER_MOED(l, h) do {} while (0)
#define SC_FINAL() do {} while (0)

struct Args { const float* in[23]; float* out; unsigned char* ws; };
#define WSP(type, off) ((type*)(F.ws + (off)))
#define PHASE() Frame Fp = F; Fp.ws = opq_p(F.ws); Fp.in = opq_p(F.in); Fp.out = opq_p(F.out); Fp.tid = opq_v((int)threadIdx.x); Fp.lane = Fp.tid & 63; Fp.wave = __builtin_amdgcn_readfirstlane(Fp.tid >> 6); (void)Fp
#define FWS(type, off) ((type*)(Fp.ws + (off)))
#define X_ FWS(bf16_t, WS_XB)
#define H_ FWS(bf16_t, WS_H)
#define Pb_ FWS(bf16_t, WS_R + R_P)
#define Gb_ FWS(bf16_t, WS_R + R_G)
#define QB_ FWS(bf16_t, WS_R + R_QB)
#define KVB_ FWS(bf16_t, WS_R + R_KVB)
#define Yb_ FWS(bf16_t, WS_R + R_Y)
#define MEMN_ FWS(bf16_t, WS_MEMN)
#define MEMKV_ FWS(bf16_t, WS_MEMKV)
#define ACT_ FWS(bf16_t, WS_R + R_ACT)
#define ASORT_ FWS(bf16_t, WS_R + R_ASORT)
#define YOUT_ FWS(bf16_t, WS_R + R_YOUT)
#define SSQ_ FWS(float, WS_MISC + MS_SSQ)
#define TEXP_ FWS(const int, WS_MISC + MS_TEXP)
#define POS_ ((const int*)Fp.in[I_POS])
#define HSC_ FWS(float, WS_MISC + MS_HSC)
#define ASC_ FWS(float, WS_MISC + MS_ASC)
#define WSIN_ FWS(float, WS_MISC + MS_WSIN)
#define WSGU_ FWS(float, WS_MISC + MS_WSGU)

#define GRID_BAR() xcd_barrier(bar)
#ifndef WGM_GU
#define WGM_GU 4
#endif
#ifndef WGM_IN
#define WGM_IN 4
#endif
template <int l> __device__ __forceinline__ void layer_body(const Frame& F, const XcdBarrier& bar, const int bx) {
        if (l > 0) {
            PHASE();
            prep_ffn_weights(Fp, l);
            if ((l & 1) != 0) norm_phase(Fp, nullptr, X_, Fp.in[I_GMIX] + l * DM, false, true);
            if ((l & 1) == 0) norm_phase(Fp, nullptr, X_, Fp.in[I_GMIX] + l * DM, true, true);
            GRID_BAR();
        }
        {   PHASE();
            ProbSimple p{DM, DM, DM, (const char*)H_, (const char*)wmix(Fp, l, WL_IN)}; pg8::StaticOrder S; S.init(T / 256, NT_IN, Fp.G, bx, 0, WGM_IN);
            EpiInproj E{Pb_, Gb_, SSQ_, POS_, HSC_, WSIN_ + l * NT_IN * 256}; pg8::gemm_phase<true>(Fp.lds, p, S, E); }
        if (l == 0) { PHASE();
            ProbSimple p{DM, DM * 2, DM * 2, (const char*)MEMN_, (const char*)FWS(bf16_t, WS_WMKV)}; pg8::StaticOrder S; S.init(NB * MEML / 256, 16, Fp.G, bx);
            EpiPlain E{MEMKV_, 4096}; pg8::gemm_phase(Fp.lds, p, S, E); }
        GRID_BAR();
        SC_AFTER_INPROJ(l);
        {   PHASE();
            ProbUp p{UPK, PW * 2, UPK * 2, (const char*)(Pb_ + P_CQ), (const char*)wmix(Fp, l, WL_UP)}; pg8::StaticOrder S; S.init(T / 256, UPN / 256, Fp.G, bx);
            EpiUp E{QB_, KVB_, SSQ_, POS_}; pg8::gemm_phase(Fp.lds, p, S, E); }
        {   PHASE();
            for (int i = Fp.vcu; i < 1024; i += Fp.G) {
                const int hl = i & 3, qb = (i >> 2) & 15, kvh = (i >> 6) & 1, b = i >> 7, h = kvh * 4 + hl; const size_t rowb = (size_t)b * SEQ; const int q0 = qb * 256;
                att::Src s; s.q = Pb_ + (rowb + q0 + Fp.wave * 32) * PW + P_QA + h * 64; s.qpitch = PW; s.k0 = Pb_ + rowb * PW + P_KA + kvh * 64; s.k0pitch = PW; s.k1 = s.k0; s.k1pitch = PW;
                s.v = Pb_ + rowb * PW + P_VA + kvh * 64; s.vpitch = PW; s.o = Yb_ + (rowb + q0 + Fp.wave * 32) * YW + h * 64; s.opitch = YW;
                const int t_lo = (q0 / 64 - 2) < 0 ? 0 : (q0 / 64 - 2), t_hi = (q0 / 64 + 6) > SEQ / 64 ? SEQ / 64 : (q0 / 64 + 6);
                att::unit<8, 2, 0>(Fp.lds, s, t_lo, t_hi, q0, Fp.in[I_SINK][l * 8 + h] * LOG2E);
            } }
        {   PHASE();
            for (int i = Fp.vcu; i < 512; i += Fp.G) {
                const int qb = i & 15, h = (i >> 4) & 3, b = i >> 6; const size_t rowq = (size_t)b * SEQ + qb * 256 + Fp.wave * 32;
                att::Src s; s.q = Pb_ + rowq * PW + P_QM + h * 128; s.qpitch = PW; s.k0 = MEMKV_ + (size_t)b * MEML * 4096 + l * 1024 + h * 128; s.k0pitch = 4096; s.k1 = s.k0 + 64; s.k1pitch = 4096;
                s.v = MEMKV_ + (size_t)b * MEML * 4096 + l * 1024 + 512 + h * 128; s.vpitch = 4096; s.o = Yb_ + rowq * YW + 1024 + h * 128; s.opitch = YW;
                att::unit<16, 4, 1>(Fp.lds, s, 0, MEML / 64, 0, 0.f);
            } }
        GRID_BAR();
        SC_AFTER_UP(l);
        {   PHASE();
            for (int i = Fp.vcu; i < 512; i += Fp.G) {
                const int qb = i & 7, h = (i >> 3) & 7, b = i >> 6; const size_t rowb = (size_t)b * SEQ, rowq = rowb + qb * 512 + Fp.wave * 64;
                att::Src s; s.q = QB_ + rowq * QBW + h * 96; s.qpitch = QBW; s.k0 = KVB_ + rowb * KVW + h * 128; s.k0pitch = KVW; s.k1 = Pb_ + rowb * PW + P_KR; s.k1pitch = PW;
                s.v = KVB_ + rowb * KVW + h * 128 + 64; s.vpitch = KVW; s.o = Yb_ + rowq * YW + 512 + h * 64; s.opitch = YW;
                att::unit_q64<12, 2>(Fp.lds, s, 0, SEQ / 64);
            } }
        GRID_BAR();
        SC_AFTER_MLA(l);
        {   PHASE();
            ProbSimple p{1536, YW * 2, 1536 * 2, (const char*)Yb_, (const char*)wmix(Fp, l, WL_BR)}; pg8::StaticOrder S; S.init(T / 256, DM / 256, Fp.G, bx);
            EpiBranch E{(const unsigned char*)Gb_, H_}; pg8::gemm_phase(Fp.lds, p, S, E); }
        GRID_BAR();
        SC_AFTER_BRANCH(l);
        if (l == 0) {   PHASE();
            ProbSimple p{DM, DM * 2, DM * 2, (const char*)H_, (const char*)wmix(Fp, l, WL_OUT)}; pg8::StaticOrder S; S.init(T / 256, DM / 256, Fp.G, bx);
            EpiResid E{Fp.in[I_X], X_}; pg8::gemm_phase(Fp.lds, p, S, E); }
        if (l != 0) {   PHASE();
            ProbSimple p{DM, DM * 2, DM * 2, (const char*)H_, (const char*)wmix(Fp, l, WL_OUT)}; pg8::StaticOrder S; S.init(T / 256, DM / 256, Fp.G, bx);
            EpiResid E{nullptr, X_}; pg8::gemm_phase(Fp.lds, p, S, E); }
        GRID_BAR();
        SC_AFTER_WOUT(l);
        if ((l & 1) == 0) {
            {   PHASE(); norm_phase(Fp, nullptr, X_, Fp.in[I_GFFN] + l * DM, false, GU_I8(l) != 0); }
            GRID_BAR();
            SC_AFTER_NORM2(l);
            {   PHASE();
                constexpr bool i8 = GU_I8(l) != 0; constexpr unsigned eb = i8 ? 1 : 2;
                ProbSimple p{DM, DM * eb, DM * eb, (const char*)H_, (const char*)FWS(bf16_t, WS_WFFN + WF_GU)}; pg8::StaticOrder S; S.init(T / 256, 2 * DFF / 256, Fp.G, bx, 0, WGM_GU);
                EpiSwiglu E{ACT_, 0, HSC_, WSGU_}; pg8::gemm_phase<i8>(Fp.lds, p, S, E); }
            GRID_BAR();
            SC_AFTER_GU(l);
            {   PHASE();
                ProbSimple p{DFF, DFF * 2, DFF * 2, (const char*)ACT_, (const char*)FWS(bf16_t, WS_WFFN + WF_D)}; pg8::StaticOrder S; S.init(T / 256, DM / 256, Fp.G, bx, 1);
                EpiResid E{nullptr, X_}; pg8::gemm_phase(Fp.lds, p, S, E); }
            GRID_BAR();
            SC_AFTER_DOWN(l);
        } else {
            {   PHASE(); norm_router_phase(Fp, X_, Fp.in[I_GFFN] + l * DM, Fp.in[I_WR] + (size_t)(l >> 1) * DM * NE, GU_I8(l) != 0); }
            GRID_BAR();
            {   PHASE(); moe_assign_phase(Fp, GU_I8(l) != 0); }
            GRID_BAR();
            SC_AFTER_ROUTE(l);
            {   constexpr int half = 0; (void)half;
                {   PHASE();
                    const int nrt = __builtin_amdgcn_readfirstlane(TEXP_[MAXRT]);
                    constexpr bool i8 = GU_I8(l) != 0; constexpr unsigned eb = i8 ? 1 : 2;
                    ProbMoe p{DM, DM * eb, DM * eb, (const char*)ASORT_, (const char*)FWS(bf16_t, WS_WFFN + WF_GU), 0}; MoeOrder S; S.base.init(nrt, 2 * DFF / 256, Fp.G, bx, 0, WGM_GU); S.lo = 0; S.texp = TEXP_;
                    EpiSwiglu E{ACT_, 0, ASC_, WSGU_}; pg8::gemm_phase<i8>(Fp.lds, p, S, E); }
                GRID_BAR();
                SC_AFTER_MOEGU(l, half);
                {   PHASE();
                    const int nrt = __builtin_amdgcn_readfirstlane(TEXP_[MAXRT]);
                    ProbMoe p{DFF, DFF * 2, DFF * 2, (const char*)ACT_, (const char*)FWS(bf16_t, WS_WFFN + WF_D), 0}; MoeOrder S; S.base.init(nrt, DM / 256, Fp.G, bx, 1); S.lo = 0; S.texp = TEXP_;
                    EpiYout E{YOUT_}; pg8::gemm_phase(Fp.lds, p, S, E); }
                GRID_BAR();
                SC_AFTER_MOED(l, half);
            }
        }
    }

__global__ void __launch_bounds__(NWAVES * 64, 2) fwd(Args args) {
    extern __shared__ __attribute__((aligned(16))) unsigned char lds_raw[];
    Frame F;
    F.lds = (LAS unsigned char*)lds_raw;
    F.MISC = (volatile LAS unsigned*)(F.lds + LDSCTL_OFF);
    F.tid = threadIdx.x; F.lane = F.tid & 63; F.wave = __builtin_amdgcn_readfirstlane(F.tid >> 6);
    F.G = gridDim.x; { const int bx = blockIdx.x; F.vcu = (F.G % 8 == 0) ? (bx % 8) * (F.G / 8) + bx / 8 : bx; }
    F.ws = args.ws; F.ctl = (gu32*)(args.ws + WS_CTL); F.out = args.out;
    F.in = (const float* const*)__builtin_amdgcn_kernarg_segment_ptr();
    for (int u = F.tid; u < (LDS_BYTES - LDSCTL_OFF) / 4; u += NWAVES * 64) ((LAS unsigned*)(F.lds + LDSCTL_OFF))[u] = 0u;
    __syncthreads();
    XcdBarrier bar = xcd_barrier_post((unsigned*)(F.ctl + CW_BAR), F.MISC + 8);

    const int bx = (int)blockIdx.x;

    {   PHASE();
        prep_mixer_weights(Fp);
        memnorm_phase(Fp);
        prep_ffn_weights(Fp, 0);
        norm_phase(Fp, Fp.in[I_X], nullptr, Fp.in[I_GMIX], false, true); }
    GRID_BAR();
    SC_AFTER_PROLOGUE();

    layer_body<0>(F, bar, bx); layer_body<1>(F, bar, bx); layer_body<2>(F, bar, bx); layer_body<3>(F, bar, bx);
    {   PHASE(); final_norm_phase(Fp, X_, Fp.out, Fp.in[I_GFIN], true); }
    SC_FINAL();
}

extern "C" void kernel_launch(void* const* d_in, const int* in_sizes, int n_in, void* d_out, int out_size, void* d_ws, size_t ws_size, hipStream_t stream) {
    static int grid = 0;
    if (grid == 0) {
        if (n_in != 23 || out_size != T * DM || ws_size < WS_END) { fprintf(stderr, "kernel_launch: unexpected problem (n_in %d, out %d, ws %zu < %zu)\n", n_in, out_size, ws_size, (size_t)WS_END); grid = -1; return; }
        int dev = 0, cus = 0;
        if (hipGetDevice(&dev) != hipSuccess || hipDeviceGetAttribute(&cus, hipDeviceAttributeMultiprocessorCount, dev) != hipSuccess) { grid = -1; return; }
        if (hipFuncSetAttribute((const void*)fwd, hipFuncAttributeMaxDynamicSharedMemorySize, LDS_BYTES) != hipSuccess) { fprintf(stderr, "kernel_launch: hipFuncSetAttribute failed\n"); grid = -1; return; }
        int per_cu = 0;
        if (hipOccupancyMaxActiveBlocksPerMultiprocessor(&per_cu, (const void*)fwd, NWAVES * 64, LDS_BYTES) != hipSuccess || per_cu < 1) fprintf(stderr, "kernel_launch: occupancy query says %d\n", per_cu);
        (void)hipGetLastError();
        grid = cus;
    }
    if (grid < 0) return;
    if (hipMemsetAsync((char*)d_ws + WS_CTL, 0, CTL_ZERO_BYTES, stream) != hipSuccess) return;
    Args a{};
    for (int i = 0; i < 23; ++i) a.in[i] = (const float*)d_in[i];
    a.out = (float*)d_out; a.ws = (unsigned char*)d_ws;
    hipLaunchKernelGGL(fwd, dim3(grid), dim3(NWAVES * 64), LDS_BYTES, stream, a);
}
```

```cpp
#include <hip/hip_runtime.h>
#include <cstdio>
#include <cstdint>

#ifndef SELFCHECK
#define SELFCHECK 0
#endif
#ifndef GU_I8_MASK
#define GU_I8_MASK 0xF
#endif
#define GU_I8(l) ((((unsigned)GU_I8_MASK) >> (l)) & 1u)

#define GAS __attribute__((address_space(1)))
#define LAS __attribute__((address_space(3)))
typedef unsigned short bf16_t;
typedef short bf16x8 __attribute__((ext_vector_type(8)));
typedef short s16x4 __attribute__((ext_vector_type(4)));
typedef short v4i16_t __attribute__((ext_vector_type(4)));
typedef float f32x2 __attribute__((ext_vector_type(2)));
typedef float f32x4 __attribute__((ext_vector_type(4)));
typedef float f32x16 __attribute__((ext_vector_type(16)));
typedef unsigned u32x2 __attribute__((ext_vector_type(2)));
typedef unsigned u32x4 __attribute__((ext_vector_type(4)));
typedef int i32x4 __attribute__((ext_vector_type(4)));
typedef GAS unsigned gu32;
#define RLX_AGENT __ATOMIC_RELAXED, __HIP_MEMORY_SCOPE_AGENT

constexpr int NB = 8, SEQ = 4096, T = NB * SEQ, DM = 1024, DEPTH = 4, MEML = 256, DFF = 3584, NE = 8;
constexpr int INW = 4768;
constexpr int PW = 1792;
constexpr int GW = 3072;
constexpr int QBW = 768, KVW = 1024, YW = 1536;
constexpr int NT_IN = 19;
constexpr int P_QA = 0, P_KA = 512, P_VA = 640, P_CQ = 768, P_CKV = 1024, P_KR = 1152, P_QM = 1280;
constexpr int UPK = 256, UPN = 1792;
constexpr int MAXSLOT = 67584;
constexpr int MAXRT = MAXSLOT / 256;
constexpr float EPS = 1e-6f;
constexpr float LOG2E = 1.4426950408889634f;
constexpr float C_A = 0.125f * LOG2E;
constexpr float C_B = 0.10206207261596575f * LOG2E;
constexpr float C_M = 0.08838834764831845f * LOG2E;

constexpr size_t MiB = 1u << 20;
constexpr size_t WS_CTL = 0, CTL_ZERO_BYTES = 1 * MiB;
constexpr size_t WS_MISC = 1 * MiB;
constexpr size_t WL_IN = 0, WL_UP = (size_t)NT_IN * 256 * DM * 2, WL_BR = WL_UP + (size_t)UPN * UPK * 2, WL_OUT = WL_BR + (size_t)3 * DM * 512 * 2, WL_SIZE = WL_OUT + (size_t)DM * DM * 2;
constexpr size_t WS_WMIX = 8 * MiB;
constexpr int TAIL_KS = 4;
constexpr size_t WS_SLAB = WS_WMIX;
constexpr size_t WS_WMKV = WS_WMIX + 4 * ((WL_SIZE + MiB - 1) / MiB) * MiB;
constexpr size_t WL_STRIDE = ((WL_SIZE + MiB - 1) / MiB) * MiB;
constexpr size_t WS_WFFN = WS_WMKV + 8 * MiB;
constexpr size_t WF_GU = 0, WF_D = (size_t)2 * DFF * DM * 2, WF_STRIDE = WF_D + (size_t)DM * DFF * 2;
constexpr size_t WS_H = WS_WFFN + 8 * WF_STRIDE;
constexpr size_t WS_MEMN = WS_H + (size_t)T * DM * 2;
constexpr size_t WS_MEMKV = WS_MEMN + (size_t)NB * MEML * DM * 2;
constexpr size_t WS_R = WS_MEMKV + (size_t)NB * MEML * 4096 * 2;
constexpr size_t R_P = 0, R_G = R_P + (size_t)T * PW * 2, R_QB = R_G + (size_t)T * GW * 2, R_KVB = R_QB + (size_t)T * QBW * 2, R_Y = R_KVB + (size_t)T * KVW * 2, R_END_MIX = R_Y + (size_t)T * YW * 2;
constexpr size_t R_ACT = 0;
constexpr size_t R_ASORT = (size_t)MAXSLOT * DFF * 2;
constexpr size_t R_YOUT = R_ASORT;
constexpr size_t R_END_FFN = R_YOUT + (size_t)MAXSLOT * DM * 2;
constexpr size_t R_SIZE = R_END_MIX > R_END_FFN ? R_END_MIX : R_END_FFN;
constexpr size_t WS_XB = WS_R + R_SIZE;
constexpr size_t WS_END = WS_XB + (size_t)T * DM * 2;
static_assert(WS_END < 1020ull * MiB, "workspace budget");
static_assert((size_t)8 * 4 * TAIL_KS * 256 * 256 * 4 <= 2 * WL_STRIDE, "tail slabs fit two layers' mixer weights");
constexpr size_t MS_TOKE = 0;
constexpr size_t MS_TOKW = MS_TOKE + (size_t)T * 8;
constexpr size_t MS_SLOT = MS_TOKW + (size_t)T * 8;
constexpr size_t MS_CNT = MS_SLOT + (size_t)T * 8;
constexpr size_t MS_TEXP = MS_CNT + 256 * 8 * 4;
constexpr size_t MS_SSQ = MS_TEXP + 2048;
constexpr size_t MS_SNAP = MS_SSQ + (size_t)T * 32;
constexpr size_t MS_HSC = MS_SNAP + 64 * 1024 * 4;
constexpr size_t MS_ASC = MS_HSC + (size_t)T * 4;
constexpr size_t MS_WSIN = MS_ASC + (size_t)MAXSLOT * 4;
constexpr size_t MS_WSGU = MS_WSIN + (size_t)4 * NT_IN * 256 * 4;
constexpr size_t MS_END = MS_WSGU + (size_t)8 * 2 * DFF * 4;
static_assert(MS_END <= 7 * MiB, "misc map");
constexpr int CW_BAR = 4096;
constexpr int CW_DIAG = 16384;
constexpr int CW_CODE = 16384 + 512;

constexpr int RING_BYTES = 131072;
constexpr int LDSCTL_OFF = RING_BYTES;
constexpr int LDS_BYTES = 147456;
constexpr int NWAVES = 8;

#define LDS_WAIT() asm volatile("s_waitcnt lgkmcnt(0)" ::: "memory")
#define VM_WAIT() asm volatile("s_waitcnt vmcnt(0)" ::: "memory")

__device__ __forceinline__ unsigned f2bf(float f) { unsigned u = __builtin_bit_cast(unsigned, f); return (u + 0x7fffu + ((u >> 16) & 1u)) >> 16; }
__device__ __forceinline__ unsigned pk2(float lo, float hi) { return f2bf(lo) | (f2bf(hi) << 16); }
__device__ __forceinline__ float bf2f(unsigned short b) { return __builtin_bit_cast(float, (unsigned)b << 16); }
__device__ __forceinline__ float bflo(unsigned w) { return __builtin_bit_cast(float, w << 16); }
__device__ __forceinline__ float bfhi(unsigned w) { return __builtin_bit_cast(float, w & 0xffff0000u); }
typedef __bf16 bf16x2_t __attribute__((ext_vector_type(2)));
__device__ __forceinline__ unsigned cvtpk(float lo, float hi) { f32x2 v = {lo, hi}; bf16x2_t b = __builtin_convertvector(v, bf16x2_t); return __builtin_bit_cast(unsigned, b); }
__device__ __forceinline__ float wave_sum(float v) {
#pragma unroll
    for (int o = 1; o < 64; o <<= 1) v += __shfl_xor(v, o);
    return v;
}
__device__ __forceinline__ float fast_sigmoid(float x) { return __builtin_amdgcn_rcpf(1.0f + __builtin_amdgcn_exp2f(-x * LOG2E)); }


__device__ __forceinline__ int opq_v(int x) { asm volatile("" : "+v"(x)); return x; }
__device__ __forceinline__ int opq_s(int x) { asm volatile("" : "+s"(x)); return x; }
template <class Tp> __device__ __forceinline__ Tp* opq_p(Tp* p) { const unsigned long long u = (unsigned long long)p; unsigned lo = __builtin_amdgcn_readfirstlane((unsigned)u), hi = __builtin_amdgcn_readfirstlane((unsigned)(u >> 32)); asm volatile("" : "+s"(lo), "+s"(hi)); return (Tp*)(((unsigned long long)hi << 32) | lo); }

__constant__ float IFR_HI[32] = {1.591549367e-01f, 1.193493679e-01f, 8.949939907e-02f, 6.711508334e-02f, 5.032921210e-02f, 3.774158657e-02f, 2.830219641e-02f, 2.122365311e-02f, 1.591549441e-02f, 1.193493698e-02f, 8.949940093e-03f, 6.711508147e-03f, 5.032921210e-03f, 3.774158424e-03f, 2.830219688e-03f, 2.122365171e-03f, 1.591549488e-03f, 1.193493721e-03f, 8.949940093e-04f, 6.711508031e-04f, 5.032921326e-04f, 3.774158540e-04f, 2.830219455e-04f, 2.122365258e-04f, 1.591549371e-04f, 1.193493736e-04f, 8.949940093e-05f, 6.711508468e-05f, 5.032921035e-05f, 3.774158540e-05f, 2.830219637e-05f, 2.122365186e-05f};
__constant__ float IFR_LO[32] = {6.420638243e-09f, 2.294664903e-09f, 2.542919653e-09f, -3.316028840e-10f, 5.173299289e-12f, -1.848551645e-09f, -5.826552019e-10f, -3.431038786e-10f, -1.029942243e-10f, 4.320196978e-11f, 6.802745173e-11f, 1.531042237e-10f, 5.173301024e-13f, 4.797548470e-11f, -1.048316434e-10f, 1.053879969e-10f, -5.686555046e-11f, -1.896286773e-11f, 6.802744999e-12f, 2.695195456e-11f, -1.158979943e-11f, -6.843983713e-12f, 1.279990003e-11f, 1.807650600e-12f, 5.954976963e-12f, -3.351478166e-12f, 6.802745216e-13f, -1.670379113e-12f, 1.751403167e-12f, -6.843983930e-13f, -5.389994549e-13f, 9.083608431e-13f};
__device__ __forceinline__ void rot_cs(float posf, int idx, float& c, float& s) {
    const float ch = IFR_HI[idx], cl = IFR_LO[idx];
    const float p = posf * ch, e = __builtin_fmaf(posf, ch, -p);
    const float fr = __builtin_amdgcn_fractf(p) + (e + posf * cl);
    s = __builtin_amdgcn_sinf(fr); c = __builtin_amdgcn_cosf(fr);
}

#define XB_TMO      128
#define XB_XCNT(j)  (256  + 64 * (j))
#define XB_XSUB(j)  (1280 + 64 * (j))
#define XB_XGEN(j)  (2304 + 64 * (j))
#define XB_TOP      3328
#define XB_TOPGEN   3392
#define XCD_BAR_WORDS 3456
#define XB_SPIN_CAP (1u << 20)

__device__ __forceinline__ unsigned xb_ld(unsigned* p)              { return __hip_atomic_load(p, __ATOMIC_RELAXED, __HIP_MEMORY_SCOPE_AGENT); }
__device__ __forceinline__ unsigned xb_add(unsigned* p, unsigned v) { return __hip_atomic_fetch_add(p, v, __ATOMIC_RELAXED, __HIP_MEMORY_SCOPE_AGENT); }
__device__ __forceinline__ unsigned xb_xcc_id() { return (unsigned)__builtin_amdgcn_s_getreg((3 << 11) | 20) & 0xFu; }
#define XB_SPIN(cond, bar) do { unsigned _sp = 0; while (cond) { __builtin_amdgcn_s_sleep(1); \
    if ((++_sp & 255u) == 0u) { if (xb_ld(&(bar)[XB_TMO])) break; if (_sp > XB_SPIN_CAP) { atomicAdd(&(bar)[XB_TMO], 1u); break; } } } } while (0)

struct XcdBarrier { unsigned* bar; unsigned x; volatile LAS unsigned* st; };

__device__ __forceinline__ XcdBarrier xcd_barrier_post(unsigned* bar, volatile LAS unsigned* st) {
    XcdBarrier b; b.bar = bar; b.x = xb_xcc_id(); b.st = st;
    if (threadIdx.x == 0) (void)xb_add(&bar[XB_XCNT(b.x)], 1u);
    return b;
}
__device__ __forceinline__ void xcd_barrier_complete(unsigned* bar, unsigned x, unsigned& nloc, unsigned& nx) {
    const unsigned G = gridDim.x * gridDim.y * gridDim.z;
    unsigned sum, cnt, mine, sp = 0u;
    for (;;) {
        sum = 0u; cnt = 0u; mine = 0u;
#pragma unroll
        for (unsigned j = 0; j < 16; ++j) { const unsigned c = xb_ld(&bar[XB_XCNT(j)]); sum += c; cnt += (c > 0u) ? 1u : 0u; mine = (j == x) ? c : mine; }
        if (sum == G) break;
        __builtin_amdgcn_s_sleep(1);
        if ((++sp & 255u) == 0u) { if (xb_ld(&bar[XB_TMO])) break; if (sp > XB_SPIN_CAP) { atomicAdd(&bar[XB_TMO], 1u); break; } }
    }
    nloc = mine > 0u ? mine : 1u; nx = cnt > 0u ? cnt : 1u;
}
__device__ __forceinline__ void xcd_barrier(const XcdBarrier& b) {
    asm volatile("s_waitcnt vmcnt(0)" ::: "memory");
    __syncthreads();
    if (threadIdx.x == 0) {
        unsigned* bar = b.bar;
        __builtin_amdgcn_s_waitcnt(0);
        unsigned nloc = b.st[0], nx = b.st[1];
        if (nloc == 0u) { xcd_barrier_complete(bar, b.x, nloc, nx); b.st[0] = nloc; b.st[1] = nx; }
        const unsigned old = xb_add(&bar[XB_XSUB(b.x)], 1u);
        const unsigned gen = old / nloc;
        if (old + 1u == (gen + 1u) * nloc) {
            __builtin_amdgcn_fence(__ATOMIC_RELEASE, "agent");
            asm volatile("s_waitcnt vmcnt(0)" ::: "memory");
            const unsigned og = xb_add(&bar[XB_TOP], 1u);
            const unsigned tg = og / nx;
            if (og + 1u == (tg + 1u) * nx) xb_add(&bar[XB_TOPGEN], 1u);
            else XB_SPIN(xb_ld(&bar[XB_TOPGEN]) == tg, bar);
            __builtin_amdgcn_fence(__ATOMIC_ACQUIRE, "agent");
            xb_add(&bar[XB_XGEN(b.x)], 1u);
            asm volatile("s_waitcnt vmcnt(0)" ::: "memory");
        } else {
            XB_SPIN(xb_ld(&bar[XB_XGEN(b.x)]) == gen, bar);
            __builtin_amdgcn_fence(__ATOMIC_ACQUIRE, "agent");
            asm volatile("s_waitcnt vmcnt(0)" ::: "memory");
        }
    }
    __syncthreads();
}

namespace pg8 {
constexpr int BM = 256, BK = 64, HALF = 128, HTB = HALF * BK * 2, STAGE_BYTES = 8 * HTB, NXCD = 8, WGM = 4;
constexpr int ESC_OFF = 131072 + 4096, ESC_SLOT = 3072;
__host__ __device__ __forceinline__ int lds_byte(int r, int c) { const int st = (r >> 4) * 2 + (c >> 5), rr = r & 15, cc = c & 31, ob = rr * 64 + cc * 2; return st * 1024 + (ob ^ (((ob >> 9) & 1) << 5)); }
__host__ __device__ __forceinline__ void stage_rc(int b, int& R, int& C) { const int st = b / 1024, sb = b % 1024, swz = sb ^ (((sb >> 9) & 1) << 5); R = (st >> 1) * 16 + swz / 64; C = (st & 1) * 32 + (swz % 64) / 2; }

struct Unit { int pm, pn, aux; };

struct StaticOrder {
    int nM, nN, nwg, G, c, rev, wgm;
    __device__ void init(int nM_, int nN_, int G_, int c_, int rev_ = 0, int wgm_ = WGM) { nM = nM_; nN = nN_; nwg = nM * nN; G = G_; c = c_; rev = rev_; wgm = wgm_; }
    __device__ bool next(int i, Unit& u) const {
        const long L = (long)i * G + c; if (L >= nwg) return false;
        int wgid = (int)L; { const int q = nwg / NXCD, r = nwg % NXCD, xcd = wgid % NXCD, off = wgid / NXCD; wgid = (xcd < r ? xcd * (q + 1) : r * (q + 1) + (xcd - r) * q) + off; }
        const int nig = wgm * nN, gid = wgid / nig, fm = gid * wgm, gsz = (nM - fm) < wgm ? (nM - fm) : wgm;
        u.pm = fm + ((wgid % nig) % gsz); u.pn = (wgid % nig) / gsz; u.aux = 0; if (rev) u.pm = nM - 1 - u.pm; return true;
    }
};

template <bool I8> struct AccVec { typedef f32x4 type; };
template <> struct AccVec<true> { typedef i32x4 type; };
template <bool I8 = false, class Prob, class Sched, class Epi>
__device__ __forceinline__ void gemm_phase(LAS unsigned char* lds, const Prob& P, const Sched& S, const Epi& E) {
    const int tid = opq_v((int)threadIdx.x), wid = __builtin_amdgcn_readfirstlane(tid >> 6), lane = tid & 63, wr = wid >> 2, wc = wid & 3, fr = lane & 15, fq = lane >> 4;
    typedef typename AccVec<I8>::type accv_t;
    const int K = P.K, nt = K / (I8 ? 2 * BK : BK);
    unsigned voffA[2], voffB[2];
#pragma unroll
    for (int i = 0; i < 2; ++i) { int R, C; stage_rc(tid * 16 + i * 8192, R, C); voffA[i] = (unsigned)R * P.lda + (unsigned)C * 2u; voffB[i] = (unsigned)R * P.ldb + (unsigned)C * 2u; }
    const size_t kstep = (size_t)(BK * 2);
    const size_t hstepA = (size_t)HALF * P.lda, hstepB = (size_t)HALF * P.ldb;
    const unsigned ldsw = (unsigned)wid * 1024u;
    const int aoff = lds_byte(wr * 64 + fr, fq * 8), boff = lds_byte(wc * 32 + fr, fq * 8);
#define PG8_SA(b, h) (((b) * 2 + (h)) * HTB)
#define PG8_SB(b, h) ((4 + (b) * 2 + (h)) * HTB)
#define PG8_STAGE(bufoff, gbase, voff) do { _Pragma("unroll") for (int _i = 0; _i < 2; ++_i) \
        __builtin_amdgcn_global_load_lds((const unsigned*)((const char*)(gbase) + (voff)[_i]), (LAS unsigned*)(lds + (bufoff) + ldsw + _i * 8192), 16, 0, 0); } while (0)
#define PG8_LDA(dst, b, h) do { _Pragma("unroll") for (int m = 0; m < 4; ++m) _Pragma("unroll") for (int k = 0; k < 2; ++k) dst[m][k] = *(const LAS bf16x8*)(lds + PG8_SA(b, h) + aoff + m * 2048 + k * 1024); } while (0)
#define PG8_LDB(dst, b, h) do { _Pragma("unroll") for (int n = 0; n < 2; ++n) _Pragma("unroll") for (int k = 0; k < 2; ++k) dst[n][k] = *(const LAS bf16x8*)(lds + PG8_SB(b, h) + boff + n * 2048 + k * 1024); } while (0)
#define PG8_MMA(ai, bj, At, Bt) do { __builtin_amdgcn_s_setprio(1); _Pragma("unroll") for (int m = 0; m < 4; ++m) _Pragma("unroll") for (int n = 0; n < 2; ++n) _Pragma("unroll") for (int k = 0; k < 2; ++k) \
        { if constexpr (I8) acc[ai][bj][m][n] = __builtin_amdgcn_mfma_i32_16x16x64_i8(__builtin_bit_cast(i32x4, Bt[n][k]), __builtin_bit_cast(i32x4, At[m][k]), acc[ai][bj][m][n], 0, 0, 0); \
          else acc[ai][bj][m][n] = __builtin_amdgcn_mfma_f32_16x16x32_bf16(Bt[n][k], At[m][k], acc[ai][bj][m][n], 0, 0, 0); } __builtin_amdgcn_s_setprio(0); } while (0)
#define PG8_WAIT_V(n) asm volatile("s_waitcnt vmcnt(" #n ")" ::: "memory")
#define PG8_WAIT_L(n) asm volatile("s_waitcnt lgkmcnt(" #n ")" ::: "memory")
#define PG8_BAR __builtin_amdgcn_s_barrier()
#define PG8_SCHED __builtin_amdgcn_sched_barrier(0)
    Unit cur, nxt; int ui = 0;
    if (!S.next(0, cur)) return;
    accv_t acc[2][2][4][2];
#pragma unroll
    for (int a = 0; a < 2; ++a)
#pragma unroll
        for (int b = 0; b < 2; ++b)
#pragma unroll
            for (int m = 0; m < 4; ++m)
#pragma unroll
                for (int n = 0; n < 2; ++n) acc[a][b][m][n] = accv_t{};
    bf16x8 At[4][2], B0[2][2], B1[2][2];
    const char* cA = P.a_ptr(cur); const char* cB = P.b_ptr(cur);
    int eslot = 0;
    E.stage(lds + ESC_OFF, cur, wid, lane);
    PG8_STAGE(PG8_SB(0, 0), cB, voffB); PG8_STAGE(PG8_SB(0, 1), cB + hstepB, voffB); PG8_STAGE(PG8_SA(0, 0), cA, voffA); PG8_STAGE(PG8_SA(0, 1), cA + hstepA, voffA);
    if (wr == 1) PG8_BAR;
    PG8_WAIT_V(2); PG8_BAR;
    PG8_STAGE(PG8_SB(1, 0), cB + kstep, voffB); PG8_STAGE(PG8_SA(1, 0), cA + kstep, voffA); PG8_STAGE(PG8_SB(1, 1), cB + hstepB + kstep, voffB);
    PG8_WAIT_V(6); PG8_BAR;
    for (;;) {
        const bool has_next = S.next(ui + 1, nxt);
        const char* nA = has_next ? P.a_ptr(nxt) : cA; const char* nB = has_next ? P.b_ptr(nxt) : cB;
        for (int t = 0; t < nt; t += 2) {
            if constexpr (Epi::MID) { if (t == 8 || t == 16) E.mid(acc, cur, t >> 3, wr, wc, fr, fq); }
            const bool last = (t == nt - 2);
            if (last && has_next) E.stage(lds + ESC_OFF + (eslot ^ 1) * ESC_SLOT, nxt, wid, lane);
            const char* a1 = cA + (size_t)(t + 1) * kstep;
            const char* a2 = last ? nA : cA + (size_t)(t + 2) * kstep; const char* b2 = last ? nB : cB + (size_t)(t + 2) * kstep;
            const char* a3 = a2 + kstep; const char* b3 = b2 + kstep;
            PG8_LDB(B0, 0, 0); PG8_LDB(B1, 0, 1); PG8_SCHED; PG8_LDA(At, 0, 0); PG8_STAGE(PG8_SA(1, 1), a1 + hstepA, voffA);
            PG8_WAIT_V(8); PG8_WAIT_L(0); PG8_BAR; PG8_MMA(0, 0, At, B0); PG8_MMA(0, 1, At, B1); PG8_BAR; PG8_SCHED;
            PG8_LDA(At, 0, 1); PG8_STAGE(PG8_SB(0, 0), b2, voffB); PG8_STAGE(PG8_SB(0, 1), b2 + hstepB, voffB); PG8_STAGE(PG8_SA(0, 0), a2, voffA);
            PG8_WAIT_V(8); PG8_WAIT_L(0); PG8_BAR; PG8_MMA(1, 0, At, B0); PG8_MMA(1, 1, At, B1); PG8_BAR; PG8_SCHED;
            PG8_LDB(B0, 1, 0); PG8_LDB(B1, 1, 1); PG8_SCHED; PG8_LDA(At, 1, 0); PG8_STAGE(PG8_SA(0, 1), a2 + hstepA, voffA);
            PG8_WAIT_V(8); PG8_WAIT_L(0); PG8_BAR; PG8_MMA(0, 0, At, B0); PG8_MMA(0, 1, At, B1); PG8_BAR; PG8_SCHED;
            PG8_LDA(At, 1, 1); PG8_STAGE(PG8_SB(1, 0), b3, voffB); PG8_STAGE(PG8_SB(1, 1), b3 + hstepB, voffB); PG8_STAGE(PG8_SA(1, 0), a3, voffA);
            PG8_WAIT_V(8); PG8_WAIT_L(0); PG8_BAR; PG8_MMA(1, 0, At, B0); PG8_MMA(1, 1, At, B1); PG8_BAR; PG8_SCHED;
        }
        if (wr == 0) PG8_BAR;
        E(acc, cur, wr, wc, fr, fq, lds + ESC_OFF + eslot * ESC_SLOT);
        if (!has_next) break;
#pragma unroll
        for (int a = 0; a < 2; ++a)
#pragma unroll
            for (int b = 0; b < 2; ++b)
#pragma unroll
                for (int m = 0; m < 4; ++m)
#pragma unroll
                    for (int n = 0; n < 2; ++n) acc[a][b][m][n] = accv_t{};
        cur = nxt; cA = nA; cB = nB; ++ui; eslot ^= 1;
        if (wr == 1) PG8_BAR;
    }
    PG8_WAIT_V(0);
    PG8_BAR;
#undef PG8_SA
#undef PG8_SB
#undef PG8_STAGE
#undef PG8_LDA
#undef PG8_LDB
#undef PG8_MMA
#undef PG8_WAIT_V
#undef PG8_WAIT_L
#undef PG8_BAR
#undef PG8_SCHED
}
}

struct Frame {
    LAS unsigned char* lds;
    volatile LAS unsigned* MISC;
    gu32* ctl;
    unsigned char* ws;
    int tid, lane, wave, vcu, G;
    const float* const* in; float* out;
};
enum { I_X = 0, I_MEM, I_POS, I_GMIX, I_WIN, I_GQ, I_WUQ, I_GKV, I_WUKV, I_SINK, I_WMKV, I_WBR, I_WOUT, I_GFFN, I_WGD, I_WUD, I_WDD, I_WR, I_WGE, I_WUE, I_WDE, I_GMEM, I_GFIN };

__device__ __forceinline__ int sem_plain(int g) { return (g & ~31) + 8 * ((g >> 2) & 3) + 4 * ((g >> 4) & 1) + (g & 3); }
__device__ __forceinline__ int sem_rot64(int g) { return (g & ~63) + 32 * ((g >> 4) & 1) + 16 * ((g >> 5) & 1) + 4 * ((g >> 2) & 3) + (g & 3); }
__device__ __forceinline__ int sem_p16(int g) { const int c = g & 255; return (g & ~255) + 64 * ((c >> 5) & 3) + 16 * ((c >> 2) & 3) + 8 * (c >> 7) + 4 * ((c >> 4) & 1) + (c & 3); }
__device__ __forceinline__ int inproj_src(int n) {
    const int pn = n >> 8, c = n & 255;
    if (pn < 2) return pn * 256 + sem_rot64(c);
    if (pn == 2) return c < 128 ? 512 + sem_rot64(c) : 640 + sem_plain(c - 128);
    if (pn == 3) return 768 + sem_plain(c);
    if (pn == 4) return c < 128 ? 1024 + sem_plain(c) : (c < 160 ? 1152 + (c - 128) : -1);
    if (pn < 7) return 1184 + (pn - 5) * 256 + sem_plain(c);
    return 1696 + (pn - 7) * 256 + sem_p16(c);
}

struct MapInproj { const float* W; __device__ __forceinline__ float load(int k, int n) const { const int s = inproj_src(n); return s >= 0 ? W[(size_t)k * INW + s] : 0.f; }
    __device__ __forceinline__ f32x4 load4(int k, int n) const { const int s = inproj_src(n); return s >= 0 ? *(const f32x4*)(W + (size_t)k * INW + s) : (f32x4){0.f, 0.f, 0.f, 0.f}; } };
struct MapUp { const float *Wq, *Wkv, *gq, *gkv;
    __device__ __forceinline__ f32x4 load4(int k, int n) const {
        if (n < 768) { const int gg = n >> 5; const int s = (gg % 3 == 2) ? n : sem_plain(n); return *(const f32x4*)(Wq + (size_t)k * 768 + s) * gq[k]; }
        if (k < 128) return (f32x4){0.f, 0.f, 0.f, 0.f}; const int s = sem_plain(n - 768); return *(const f32x4*)(Wkv + (size_t)(k - 128) * 1024 + s) * gkv[k - 128]; }
    __device__ __forceinline__ float load(int k, int n) const {
        if (n < 768) { const int gg = n >> 5; const int s = (gg % 3 == 2) ? n : sem_plain(n); return gq[k] * Wq[(size_t)k * 768 + s]; }
        if (k < 128) return 0.f; const int s = sem_plain(n - 768); return gkv[k - 128] * Wkv[(size_t)(k - 128) * 1024 + s]; } };
struct MapPlain { const float* W; int ldw; __device__ __forceinline__ float load(int k, int n) const { return W[(size_t)k * ldw + sem_plain(n)]; }
    __device__ __forceinline__ f32x4 load4(int k, int n) const { return *(const f32x4*)(W + (size_t)k * ldw + sem_plain(n)); } };
struct MapNat { const float* W; int ldw; __device__ __forceinline__ float load(int k, int n) const { return W[(size_t)k * ldw + n]; }
    __device__ __forceinline__ f32x4 load4(int k, int n) const { return *(const f32x4*)(W + (size_t)k * ldw + n); } };
struct MapBr { const float* W;
    __device__ __forceinline__ float load(int k, int n) const { return W[(size_t)k * DM + sem_p16(n)]; }
    __device__ __forceinline__ f32x4 load4(int k, int n) const { return *(const f32x4*)(W + (size_t)k * DM + sem_p16(n)); } };
struct MapMemkv { const float* W; __device__ __forceinline__ float load(int k, int n) const { const int l = n >> 10, c = n & 1023; return W[((size_t)l * DM + k) * 1024 + sem_plain(c)]; }
    __device__ __forceinline__ f32x4 load4(int k, int n) const { const int l = n >> 10, c = n & 1023; return *(const f32x4*)(W + ((size_t)l * DM + k) * 1024 + sem_plain(c)); } };
struct MapGU { const float *Wg, *Wu; __device__ __forceinline__ float load(int k, int n) const { const int pn = n >> 8, c = n & 255; const int ch = 128 * pn + sem_plain(c & 127);
    const unsigned long long a = (unsigned long long)Wg, b = (unsigned long long)Wu, w = a ^ ((a ^ b) & (0ull - (unsigned long long)(c >> 7))); return ((const float*)w)[(size_t)k * DFF + ch]; }
    __device__ __forceinline__ f32x4 load4(int k, int n) const { const int pn = n >> 8, c = n & 255; const int ch = 128 * pn + sem_plain(c & 127);
        const unsigned long long a = (unsigned long long)Wg, b = (unsigned long long)Wu, w = a ^ ((a ^ b) & (0ull - (unsigned long long)(c >> 7))); return *(const f32x4*)((const float*)w + (size_t)k * DFF + ch); } };

template <class M> __device__ __forceinline__ void prep_item(const M& m, bf16_t* dst, int Kd, int nblk, LAS float* scr, int item, int lane) {
    const int kb = item / nblk, nb = item % nblk, k0 = 64 * kb, n0 = 32 * nb;
#pragma unroll 8
    for (int i = 0; i < 32; ++i) { const int kk = 2 * i + (lane >> 5); scr[kk * 33 + (lane & 31)] = m.load(k0 + kk, n0 + (lane & 31)); }
    LDS_WAIT(); asm volatile("" ::: "memory");
    const int c = lane & 7;
#pragma unroll
    for (int j = 0; j < 4; ++j) { const int n = (lane >> 3) + 8 * j; const LAS float* s = scr + (8 * c) * 33 + n;
        u32x4 o; o.x = pk2(s[0 * 33], s[1 * 33]); o.y = pk2(s[2 * 33], s[3 * 33]); o.z = pk2(s[4 * 33], s[5 * 33]); o.w = pk2(s[6 * 33], s[7 * 33]);
        *(u32x4*)(dst + (size_t)(n0 + n) * Kd + k0 + 8 * c) = o; }
    LDS_WAIT(); asm volatile("" ::: "memory");
}
template <class M> __device__ __forceinline__ void prep_tile(const M& m, bf16_t* dst, int Kd, int nblk, LAS unsigned char* tile, int item, int lane) {
    const int kb = item / nblk, nb = item % nblk, k0 = 128 * kb, n0 = 32 * nb, ng = lane & 7, kr = lane >> 3;
    f32x4 v[16];
#pragma unroll
    for (int i = 0; i < 16; ++i) v[i] = m.load4(k0 + 8 * i + kr, n0 + 4 * ng);
#pragma unroll
    for (int i = 0; i < 16; ++i)
#pragma unroll
        for (int c = 0; c < 4; ++c) *(LAS unsigned short*)(tile + (4 * ng + c) * 272 + (8 * i + kr) * 2) = (unsigned short)f2bf(v[i][c]);
    LDS_WAIT(); asm volatile("" ::: "memory");
#pragma unroll
    for (int j = 0; j < 8; ++j) { const int p = lane + 64 * j, n = p >> 4, kc = p & 15;
        *(u32x4*)(dst + (size_t)(n0 + n) * Kd + k0 + 8 * kc) = *(const LAS u32x4*)(tile + n * 272 + 16 * kc); }
    LDS_WAIT(); asm volatile("" ::: "memory");
}
template <class M> __device__ __forceinline__ void prep_matrix(Frame& F, const M& m, bf16_t* dst, int N, int K) {
    LAS unsigned char* tile = F.lds + F.wave * 16384;
    const int gw = F.vcu * NWAVES + F.wave, NGW = F.G * NWAVES, nblk = N / 32, nitems = (K / 128) * nblk;
    for (int it = gw; it < nitems; it += NGW) prep_tile(m, dst, K, nblk, tile, it, F.lane);
}

template <class M> __device__ __forceinline__ void prep_strip_i8(Frame& F, const M& m, signed char* dst, float* scl, int strip) {
    const int lane = F.lane, w = F.wave, n0 = strip * 32, k0 = w * 128, ng = lane & 7, kr = lane >> 3;
    LAS unsigned char* tile = F.lds + w * 16384;
    LAS float* amt = (LAS float*)(F.lds + LDSCTL_OFF + 2048);
    f32x4 v[16];
#pragma unroll
    for (int i = 0; i < 16; ++i) v[i] = m.load4(k0 + 8 * i + kr, n0 + 4 * ng);
    f32x4 am = __builtin_elementwise_abs(v[0]);
#pragma unroll
    for (int i = 1; i < 16; ++i) am = __builtin_elementwise_max(am, __builtin_elementwise_abs(v[i]));
#pragma unroll
    for (int c = 0; c < 4; ++c) { float a = am[c]; a = fmaxf(a, __shfl_xor(a, 8)); a = fmaxf(a, __shfl_xor(a, 16)); a = fmaxf(a, __shfl_xor(a, 32)); am[c] = a; }
    if (kr == 0) *(LAS f32x4*)(amt + w * 32 + 4 * ng) = am;
    __syncthreads();
    f32x4 cm = *(const LAS f32x4*)(amt + 4 * ng);
#pragma unroll
    for (int ww = 1; ww < 8; ++ww) cm = __builtin_elementwise_max(cm, *(const LAS f32x4*)(amt + ww * 32 + 4 * ng));
    f32x4 inv;
#pragma unroll
    for (int c = 0; c < 4; ++c) inv[c] = cm[c] > 0.f ? 127.0f / cm[c] : 0.f;
    if (w == 0 && kr == 0) *(f32x4*)(scl + n0 + 4 * ng) = cm * (1.0f / 127.0f);
#pragma unroll
    for (int i = 0; i < 16; ++i)
#pragma unroll
        for (int c = 0; c < 4; ++c) tile[(4 * ng + c) * 144 + 8 * i + kr] = (unsigned char)(signed char)__float2int_rn(v[i][c] * inv[c]);
    LDS_WAIT(); asm volatile("" ::: "memory");
#pragma unroll
    for (int j = 0; j < 4; ++j) { const int p = lane + 64 * j, n = p >> 3, kc = p & 7;
        *(u32x4*)(dst + (size_t)(n0 + n) * DM + k0 + 16 * kc) = *(const LAS u32x4*)(tile + n * 144 + 16 * kc); }
    LDS_WAIT();
    __syncthreads();
}
__device__ __forceinline__ bf16_t* wmix(Frame& F, int l, size_t off) { return (bf16_t*)(F.ws + WS_WMIX + (size_t)l * WL_STRIDE + off); }

__device__ __forceinline__ void prep_mixer_weights(Frame& F) {
    for (int l = 0; l < DEPTH; ++l) {
        { MapInproj m{F.in[I_WIN] + (size_t)l * DM * INW}; for (int s = F.vcu; s < NT_IN * 8; s += F.G) prep_strip_i8(F, m, (signed char*)wmix(F, l, WL_IN), (float*)(F.ws + WS_MISC + MS_WSIN) + l * NT_IN * 256, s); }
        { MapUp m{F.in[I_WUQ] + (size_t)l * 256 * 768, F.in[I_WUKV] + (size_t)l * 128 * 1024, F.in[I_GQ] + l * 256, F.in[I_GKV] + l * 128}; prep_matrix(F, m, wmix(F, l, WL_UP), UPN, UPK); }
        { MapBr m{F.in[I_WBR] + (size_t)l * 3 * 512 * DM}; prep_matrix(F, m, wmix(F, l, WL_BR), DM, 1536); }
        { MapPlain m{F.in[I_WOUT] + (size_t)l * DM * DM, DM}; prep_matrix(F, m, wmix(F, l, WL_OUT), DM, DM); }
    }
    { MapMemkv m{F.in[I_WMKV]}; prep_matrix(F, m, (bf16_t*)(F.ws + WS_WMKV), 4096, DM); }
}
__device__ __forceinline__ void prep_ffn_weights(Frame& F, int l) {
    const int i = l >> 1; const bool moe = (l & 1) != 0;
    LAS float* scr = (LAS float*)(F.lds + F.wave * 16384);
    const int gw = F.vcu * NWAVES + F.wave, NGW = F.G * NWAVES;
    constexpr int IGU = (DM / 64) * (2 * DFF / 32), ID = (DFF / 64) * (DM / 32), NSTRIP = 2 * DFF / 32;
    const int ne = moe ? NE : 1;
    const float* Wg = moe ? F.in[I_WGE] : F.in[I_WGD]; const float* Wu = moe ? F.in[I_WUE] : F.in[I_WUD]; const float* Wd = moe ? F.in[I_WDE] : F.in[I_WDD];
    if (GU_I8(l)) {
        for (int s = F.vcu; s < ne * NSTRIP; s += F.G) { const int e = s / NSTRIP, ss = s % NSTRIP; const size_t eo = ((size_t)i * ne + e) * DM * DFF;
            MapGU m{Wg + eo, Wu + eo}; prep_strip_i8(F, m, (signed char*)(F.ws + WS_WFFN + (size_t)e * WF_STRIDE), (float*)(F.ws + WS_MISC + MS_WSGU) + e * 2 * DFF, ss); }
    } else {
        for (int it = gw; it < ne * IGU; it += NGW) { const int e = it / IGU, r = it % IGU; const size_t eo = ((size_t)i * ne + e) * DM * DFF;
            MapGU m{Wg + eo, Wu + eo}; prep_item(m, (bf16_t*)(F.ws + WS_WFFN + (size_t)e * WF_STRIDE), DM, 2 * DFF / 32, scr, r, F.lane); }
    }
    constexpr int IDT = (DFF / 128) * (DM / 32);
    for (int it = gw; it < ne * IDT; it += NGW) { const int e = it / IDT, r = it % IDT; const size_t eo = ((size_t)i * ne + e) * DM * DFF;
        MapPlain m{Wd + eo, DM}; prep_tile(m, (bf16_t*)(F.ws + WS_WFFN + (size_t)e * WF_STRIDE + WF_D), DFF, DM / 32, F.lds + F.wave * 16384, r, F.lane); }
}

struct RowV { f32x4 v[4]; };
__device__ __forceinline__ void row_load(RowV& r, const float* p, int lane) { const f32x4* x = (const f32x4*)p + lane;
#pragma unroll
    for (int j = 0; j < 4; ++j) r.v[j] = x[64 * j]; }
__device__ __forceinline__ void row_store(const RowV& r, float* p, int lane) { f32x4* x = (f32x4*)p + lane;
#pragma unroll
    for (int j = 0; j < 4; ++j) x[64 * j] = r.v[j]; }
__device__ __forceinline__ void row_add_bf16(RowV& r, const bf16_t* p, float w, int lane) { const u32x2* x = (const u32x2*)p + lane;
#pragma unroll
    for (int j = 0; j < 4; ++j) { const u32x2 q = x[64 * j]; r.v[j].x += w * bflo(q.x); r.v[j].y += w * bfhi(q.x); r.v[j].z += w * bflo(q.y); r.v[j].w += w * bfhi(q.y); } }
__device__ __forceinline__ void row_load_bf16(RowV& r, const bf16_t* p, int lane) { const u32x2* x = (const u32x2*)p + lane;
#pragma unroll
    for (int j = 0; j < 4; ++j) { const u32x2 q = x[64 * j]; r.v[j].x = bflo(q.x); r.v[j].y = bfhi(q.x); r.v[j].z = bflo(q.y); r.v[j].w = bfhi(q.y); } }
__device__ __forceinline__ void row_round_bf16(RowV& r) {
#pragma unroll
    for (int j = 0; j < 4; ++j) { r.v[j].x = bf2f((unsigned short)f2bf(r.v[j].x)); r.v[j].y = bf2f((unsigned short)f2bf(r.v[j].y)); r.v[j].z = bf2f((unsigned short)f2bf(r.v[j].z)); r.v[j].w = bf2f((unsigned short)f2bf(r.v[j].w)); } }
__device__ __forceinline__ float row_rstd(const RowV& r) { float s = 0.f;
#pragma unroll
    for (int j = 0; j < 4; ++j) s += (r.v[j].x * r.v[j].x + r.v[j].y * r.v[j].y) + (r.v[j].z * r.v[j].z + r.v[j].w * r.v[j].w);
    return 1.0f / sqrtf(wave_sum(s) * (1.0f / DM) + EPS); }
__device__ __forceinline__ void row_scale(RowV& r, float rstd, const float* g, int lane) { const f32x4* gg = (const f32x4*)g + lane;
#pragma unroll
    for (int j = 0; j < 4; ++j) r.v[j] = r.v[j] * rstd * gg[64 * j]; }
__device__ __forceinline__ void row_store_bf16(const RowV& r, bf16_t* p, int lane) { u32x2* o = (u32x2*)p + lane;
#pragma unroll
    for (int j = 0; j < 4; ++j) { u32x2 w; w.x = pk2(r.v[j].x, r.v[j].y); w.y = pk2(r.v[j].z, r.v[j].w); o[64 * j] = w; } }

__device__ __forceinline__ float row_store_i8(const RowV& r, signed char* p, int lane) {
    float am = 0.f;
#pragma unroll
    for (int j = 0; j < 4; ++j) am = fmaxf(am, fmaxf(fmaxf(fabsf(r.v[j].x), fabsf(r.v[j].y)), fmaxf(fabsf(r.v[j].z), fabsf(r.v[j].w))));
#pragma unroll
    for (int o = 1; o < 64; o <<= 1) am = fmaxf(am, __shfl_xor(am, o));
    const float inv = am > 0.f ? 127.0f / am : 0.f; unsigned* o4 = (unsigned*)p + lane;
#pragma unroll
    for (int j = 0; j < 4; ++j) { const unsigned a = (unsigned)__float2int_rn(r.v[j].x * inv) & 255u, b = (unsigned)__float2int_rn(r.v[j].y * inv) & 255u, c = (unsigned)__float2int_rn(r.v[j].z * inv) & 255u, d = (unsigned)__float2int_rn(r.v[j].w * inv) & 255u;
        o4[64 * j] = a | (b << 8) | (c << 16) | (d << 24); }
    return am * (1.0f / 127.0f);
}
__device__ __forceinline__ void row_add_slot(Frame& F, RowV& r, int s, float w, int lane) {
    if ((s >> 8) < 256) { row_add_bf16(r, (const bf16_t*)(F.ws + WS_R + R_YOUT) + (size_t)s * DM, w, lane); return; }
    const float* slab = (const float*)(F.ws + WS_SLAB) + (size_t)((s >> 8) - 256) * 4 * TAIL_KS * 65536 + (size_t)(s & 255) * 256 + 4 * lane;
#pragma unroll
    for (int j = 0; j < 4; ++j)
#pragma unroll
        for (int ks = 0; ks < TAIL_KS; ++ks) r.v[j] += *(const f32x4*)(slab + (size_t)(j * TAIL_KS + ks) * 65536) * w;
}
__device__ __forceinline__ void row_combine(Frame& F, RowV& r, int t) {
    const int* sl = (const int*)(F.ws + WS_MISC + MS_SLOT) + 2 * t; const float* tw = (const float*)(F.ws + WS_MISC + MS_TOKW) + 2 * t;
    const int s0 = __builtin_amdgcn_readfirstlane(sl[0]), s1 = __builtin_amdgcn_readfirstlane(sl[1]); const float w0 = tw[0], w1 = tw[1];
    row_add_slot(F, r, s0, w0, F.lane); row_add_slot(F, r, s1, w1, F.lane);
}

__device__ __forceinline__ void norm_phase(Frame& F, const float* srcf, bf16_t* X, const float* g, bool combine, bool out_i8) {
    bf16_t* H = (bf16_t*)(F.ws + WS_H); signed char* Hq = (signed char*)(F.ws + WS_H); float* hsc = (float*)(F.ws + WS_MISC + MS_HSC);
    const int gw = F.vcu * NWAVES + F.wave, NGW = F.G * NWAVES;
    for (int t = gw; t < T; t += 2 * NGW) {
        const int t2 = (t + NGW < T) ? t + NGW : t;
        RowV r, q;
        if (srcf) { row_load(r, srcf + (size_t)t * DM, F.lane); row_load(q, srcf + (size_t)t2 * DM, F.lane); }
        else { row_load_bf16(r, X + (size_t)t * DM, F.lane); row_load_bf16(q, X + (size_t)t2 * DM, F.lane); }
        if (combine) { row_combine(F, r, t); row_combine(F, q, t2); row_store_bf16(r, X + (size_t)t * DM, F.lane); row_store_bf16(q, X + (size_t)t2 * DM, F.lane);
            row_round_bf16(r); row_round_bf16(q); }
        const float rstd = row_rstd(r), qstd = row_rstd(q); row_scale(r, rstd, g, F.lane); row_scale(q, qstd, g, F.lane);
        if (out_i8) { const float sc = row_store_i8(r, Hq + (size_t)t * DM, F.lane), sq = row_store_i8(q, Hq + (size_t)t2 * DM, F.lane); if (F.lane == 0) { hsc[t] = sc; hsc[t2] = sq; } }
        else { row_store_bf16(r, H + (size_t)t * DM, F.lane); row_store_bf16(q, H + (size_t)t2 * DM, F.lane); }
    }
}
__device__ __forceinline__ void final_norm_phase(Frame& F, const bf16_t* X, float* out, const float* g, bool combine) {
    const int gw = F.vcu * NWAVES + F.wave, NGW = F.G * NWAVES;
    for (int t = gw; t < T; t += 2 * NGW) {
        const int t2 = (t + NGW < T) ? t + NGW : t;
        RowV r, q; row_load_bf16(r, X + (size_t)t * DM, F.lane); row_load_bf16(q, X + (size_t)t2 * DM, F.lane);
        if (combine) { row_combine(F, r, t); row_combine(F, q, t2); }
        const float rstd = row_rstd(r), qstd = row_rstd(q); row_scale(r, rstd, g, F.lane); row_scale(q, qstd, g, F.lane);
        row_store(r, out + (size_t)t * DM, F.lane); row_store(q, out + (size_t)t2 * DM, F.lane);
    }
}
__device__ __forceinline__ void memnorm_phase(Frame& F) {
    bf16_t* MN = (bf16_t*)(F.ws + WS_MEMN);
    const int gw = F.vcu * NWAVES + F.wave, NGW = F.G * NWAVES;
    for (int t = gw; t < NB * MEML; t += NGW) {
        RowV r; row_load(r, F.in[I_MEM] + (size_t)t * DM, F.lane);
        const float rstd = row_rstd(r); row_scale(r, rstd, F.in[I_GMEM], F.lane);
        row_store_bf16(r, MN + (size_t)t * DM, F.lane);
    }
}

__device__ __forceinline__ void norm_router_phase(Frame& F, const bf16_t* X, const float* g, const float* Wr  , bool out_i8) {
    bf16_t* H = (bf16_t*)(F.ws + WS_H); signed char* Hq = (signed char*)(F.ws + WS_H); float* hsc = (float*)(F.ws + WS_MISC + MS_HSC);
    int* toke = (int*)(F.ws + WS_MISC + MS_TOKE); float* tokw = (float*)(F.ws + WS_MISC + MS_TOKW); int* cntg = (int*)(F.ws + WS_MISC + MS_CNT);
    volatile LAS int* hist = (volatile LAS int*)(F.lds + LDSCTL_OFF + 1024);
    f32x4 wa[4][4], wb[4][4];
#pragma unroll
    for (int j = 0; j < 4; ++j)
#pragma unroll
        for (int k = 0; k < 4; ++k) { const int d = 256 * j + 4 * F.lane + k; wa[j][k] = *(const f32x4*)(Wr + (size_t)d * 8); wb[j][k] = *(const f32x4*)(Wr + (size_t)d * 8 + 4); }
    const bool up32 = (F.lane & 32) != 0, up16 = (F.lane & 16) != 0, up8 = (F.lane & 8) != 0;
    for (int c = F.vcu; c < T / 128; c += F.G) {
        if (F.tid < 8) hist[F.tid] = 0;
        __syncthreads();
        for (int q = 0; q < 16; ++q) {
            const int t = c * 128 + F.wave * 16 + q;
            RowV r; row_load_bf16(r, X + (size_t)t * DM, F.lane);
            const float rstd = row_rstd(r); row_scale(r, rstd, g, F.lane);
            if (out_i8) { const float sc = row_store_i8(r, Hq + (size_t)t * DM, F.lane); if (F.lane == 0) hsc[t] = sc; }
            else row_store_bf16(r, H + (size_t)t * DM, F.lane);
            f32x4 la = {0.f, 0.f, 0.f, 0.f}, lb = {0.f, 0.f, 0.f, 0.f};
#pragma unroll
            for (int j = 0; j < 4; ++j)
#pragma unroll
                for (int k = 0; k < 4; ++k) { const float x = r.v[j][k]; la += wa[j][k] * x; lb += wb[j][k] * x; }
            f32x4 h4; { const f32x4 keep = up32 ? lb : la, send = up32 ? la : lb;
#pragma unroll
                for (int i = 0; i < 4; ++i) h4[i] = keep[i] + __shfl_xor(send[i], 32); }
            f32x2 h2; { const float k0 = up16 ? h4[2] : h4[0], k1 = up16 ? h4[3] : h4[1], s0 = up16 ? h4[0] : h4[2], s1 = up16 ? h4[1] : h4[3]; h2.x = k0 + __shfl_xor(s0, 16); h2.y = k1 + __shfl_xor(s1, 16); }
            float h1 = (up8 ? h2.y : h2.x) + __shfl_xor(up8 ? h2.x : h2.y, 8);
            h1 += __shfl_xor(h1, 4); h1 += __shfl_xor(h1, 2); h1 += __shfl_xor(h1, 1);
            float lg[8];
#pragma unroll
            for (int e = 0; e < 8; ++e) lg[e] = __builtin_bit_cast(float, __builtin_amdgcn_readlane(__builtin_bit_cast(int, h1), 8 * e));
            int e0 = 0; float v0 = lg[0];
#pragma unroll
            for (int e = 1; e < 8; ++e) if (lg[e] > v0) { v0 = lg[e]; e0 = e; }
            int e1 = -1; float v1 = -INFINITY;
#pragma unroll
            for (int e = 0; e < 8; ++e) if (e != e0 && lg[e] > v1) { v1 = lg[e]; e1 = e; }
            if (F.lane == 0) {
                const float w0 = 1.0f / (1.0f + __expf(v1 - v0));
                toke[2 * t] = e0; toke[2 * t + 1] = e1; tokw[2 * t] = w0; tokw[2 * t + 1] = 1.0f - w0;
                __hip_atomic_fetch_add((LAS int*)&hist[e0], 1, __ATOMIC_RELAXED, __HIP_MEMORY_SCOPE_WORKGROUP); __hip_atomic_fetch_add((LAS int*)&hist[e1], 1, __ATOMIC_RELAXED, __HIP_MEMORY_SCOPE_WORKGROUP);
            }
        }
        __syncthreads();
        if (F.tid < 8) cntg[c * 8 + F.tid] = hist[F.tid];
        __syncthreads();
    }
}
__device__ __forceinline__ void moe_assign_phase(Frame& F, bool i8) {
    const bf16_t* H = (const bf16_t*)(F.ws + WS_H); bf16_t* AS = (bf16_t*)(F.ws + WS_R + R_ASORT);
    const float* hsc = (const float*)(F.ws + WS_MISC + MS_HSC); float* asc = (float*)(F.ws + WS_MISC + MS_ASC);
    const int* toke = (const int*)(F.ws + WS_MISC + MS_TOKE); int* slot = (int*)(F.ws + WS_MISC + MS_SLOT); const int* cntg = (const int*)(F.ws + WS_MISC + MS_CNT);
    int* texp = (int*)(F.ws + WS_MISC + MS_TEXP);
    volatile LAS int* tot = (volatile LAS int*)(F.lds + LDSCTL_OFF + 1024);
    volatile LAS int* pre = tot + 8;
    volatile LAS int* wcnt = tot + 16;
    for (int c = F.vcu; c < T / 128; c += F.G) {
        if (F.tid < 16) tot[F.tid] = 0;
        __syncthreads();
        { const int cc = F.tid >> 1, h = F.tid & 1; const i32x4 v = *(const i32x4*)(cntg + cc * 8 + 4 * h);
#pragma unroll
          for (int k = 0; k < 4; ++k) { __hip_atomic_fetch_add((LAS int*)&tot[4 * h + k], v[k], __ATOMIC_RELAXED, __HIP_MEMORY_SCOPE_WORKGROUP); if (cc < c) __hip_atomic_fetch_add((LAS int*)&pre[4 * h + k], v[k], __ATOMIC_RELAXED, __HIP_MEMORY_SCOPE_WORKGROUP); } }
        const int t = c * 128 + F.wave * 16 + ((F.lane & 31) >> 1);
        const int my_e = (F.lane < 32) ? toke[2 * t + (F.lane & 1)] : -1;
        int rank = 0;
#pragma unroll
        for (int e = 0; e < 8; ++e) { const unsigned long long m = __ballot(my_e == e); if (my_e == e) rank = __popcll(m & ((1ull << F.lane) - 1ull)); if (F.lane == 0) wcnt[F.wave * 8 + e] = __popcll(m); }
        __syncthreads();
        int myslot = 0;
        if (F.lane < 32) {
            int ts = 0;
#pragma unroll
            for (int e = 0; e < 8; ++e) ts += (e < my_e) ? ((tot[e] + 255) >> 8) : 0;
            int wp = 0; for (int w = 0; w < F.wave; ++w) wp += wcnt[w * 8 + my_e];
            myslot = ts * 256 + pre[my_e] + wp + rank;
            slot[2 * t + (F.lane & 1)] = myslot;
        }
        if (c == 0 && F.tid == 0) { int ts = 0; for (int e = 0; e < 8; ++e) { const int n = (tot[e] + 255) >> 8; for (int k = 0; k < n; ++k) texp[ts + k] = e; ts += n; } for (int k = ts; k < MAXRT; ++k) texp[k] = 0; texp[MAXRT] = ts; }
        if (i8) {
            const float myh = hsc[t];
#pragma unroll 1
            for (int a0 = 0; a0 < 32; a0 += 8) {
                u32x4 x[4];
#pragma unroll
                for (int k = 0; k < 4; ++k) x[k] = *((const u32x4*)((const signed char*)H + (size_t)(c * 128 + F.wave * 16 + ((a0 + 2 * k) >> 1)) * DM) + F.lane);
#pragma unroll
                for (int k = 0; k < 8; ++k) { const int s = __builtin_amdgcn_readlane(myslot, a0 + k); *((u32x4*)((signed char*)AS + (size_t)s * DM) + F.lane) = x[k >> 1]; }
            }
            if (F.lane < 32) asc[myslot] = myh;
        } else {
            for (int a = 0; a < 32; ++a) {
                const int s = __builtin_amdgcn_readlane(myslot, a); const int ta = c * 128 + F.wave * 16 + (a >> 1);
                const u32x4* srcp = (const u32x4*)(H + (size_t)ta * DM) + F.lane; u32x4* dstp = (u32x4*)(AS + (size_t)s * DM) + F.lane;
                const u32x4 x0 = srcp[0], x1 = srcp[64]; dstp[0] = x0; dstp[64] = x1; }
        }
        __syncthreads();
    }
}

using pg8::Unit;
typedef f32x4 AccT[2][2][4][2];

struct ProbSimple { int K; unsigned lda, ldb; const char* A; const char* B;
    __device__ __forceinline__ const char* a_ptr(const Unit& u) const { return A + (size_t)u.pm * 256 * lda; }
    __device__ __forceinline__ const char* b_ptr(const Unit& u) const { return B + (size_t)u.pn * 256 * ldb; } };
struct ProbUp { int K; unsigned lda, ldb; const char* A; const char* B;
    __device__ __forceinline__ const char* a_ptr(const Unit& u) const { return A + (size_t)u.pm * 256 * lda + (u.pn >= 3 ? 256 : 0); }
    __device__ __forceinline__ const char* b_ptr(const Unit& u) const { return B + (size_t)u.pn * 256 * ldb; } };
struct ProbMoe { int K; unsigned lda, ldb; const char* A; const char* B; int a_lo;
    __device__ __forceinline__ const char* a_ptr(const Unit& u) const { return A + (size_t)(u.pm - a_lo) * 256 * lda; }
    __device__ __forceinline__ const char* b_ptr(const Unit& u) const { return B + (size_t)u.aux * WF_STRIDE + (size_t)u.pn * 256 * ldb; } };

struct ProbTail { int K; unsigned lda, ldb; const char* A; const char* B;
    __device__ __forceinline__ const char* a_ptr(const Unit& u) const { return A + (size_t)u.pm * 256 * lda + (size_t)(u.aux >> 8) * (DFF / TAIL_KS) * 2; }
    __device__ __forceinline__ const char* b_ptr(const Unit& u) const { return B + (size_t)(u.aux & 255) * WF_STRIDE + (size_t)u.pn * 256 * ldb + (size_t)(u.aux >> 8) * (DFF / TAIL_KS) * 2; } };
struct TailOrder { int ntail, G, c; const int* texp;
    __device__ bool next(int i, Unit& u) const { const int L = i * G + c; if (L >= ntail) return false;
        u.pm = 256 + L / (4 * TAIL_KS); u.pn = (L / TAIL_KS) & 3; u.aux = __builtin_amdgcn_readfirstlane(texp[u.pm]) | ((L % TAIL_KS) << 8); return true; } };
struct MoeOrder { pg8::StaticOrder base; int lo; const int* texp;
    __device__ bool next(int i, Unit& u) const { if (!base.next(i, u)) return false; u.pm += lo; u.aux = __builtin_amdgcn_readfirstlane(texp[u.pm]); return true; } };

__device__ __forceinline__ u32x4 pack8(const f32x4 a, const f32x4 b) { u32x4 w; w.x = cvtpk(a[0], a[1]); w.y = cvtpk(a[2], a[3]); w.z = cvtpk(b[0], b[1]); w.w = cvtpk(b[2], b[3]); return w; }
__device__ __forceinline__ u32x2 pack4(const f32x4 a) { u32x2 w; w.x = cvtpk(a[0], a[1]); w.y = cvtpk(a[2], a[3]); return w; }

struct EpiNoStage { __device__ __forceinline__ void stage(LAS unsigned char*, const Unit&, int, int) const {} };
__device__ __forceinline__ void stage1k(const void* src, LAS unsigned char* dst, int lane) { __builtin_amdgcn_global_load_lds((const unsigned*)((const char*)src + lane * 16), (LAS unsigned*)dst, 16, 0, 0); }
__device__ __forceinline__ f32x4 deq(const f32x4& a, float, const f32x4&) { return a; }
__device__ __forceinline__ f32x4 deq(const i32x4& a, float rs, const f32x4& cs) { return __builtin_convertvector(a, f32x4) * rs * cs; }
struct EpiInproj {
    static constexpr bool MID = false;
    bf16_t* P; bf16_t* G; float* ssq; const int* pos; const float* rsc; const float* csc;
    __device__ __forceinline__ void stage(LAS unsigned char* d, const Unit& u, int wid, int lane) const {
        if (wid == 0) { stage1k(rsc + u.pm * 256, d, lane); stage1k(csc + u.pn * 256, d + 1024, lane); stage1k(pos + u.pm * 256, d + 2048, lane); } }
    template <class AV> __device__ __forceinline__ void operator()(const AV (&acc)[2][2][4][2], const Unit& u, int wr, int wc, int fr, int fq, const LAS unsigned char* esc) const {
        const int pn = u.pn, row0 = u.pm * 256 + wr * 64 + fr;
        f32x4 cs[2][2];
#pragma unroll
        for (int bj = 0; bj < 2; ++bj)
#pragma unroll
            for (int n = 0; n < 2; ++n) cs[bj][n] = *(const LAS f32x4*)(esc + 1024 + (bj * 128 + wc * 32 + n * 16 + fq * 4) * 4);
        float rs8[2][4], pf8[2][4];
#pragma unroll
        for (int ai = 0; ai < 2; ++ai)
#pragma unroll
            for (int m = 0; m < 4; ++m) { const int rl = ai * 128 + wr * 64 + m * 16 + fr; rs8[ai][m] = *(const LAS float*)(esc + rl * 4); pf8[ai][m] = (float)*(const LAS int*)(esc + 2048 + rl * 4); }
#define DQ(ai, bj, m, n) deq(acc[ai][bj][m][n], rs, cs[bj][n])
        if (pn >= 7) {
#pragma unroll
            for (int ai = 0; ai < 2; ++ai)
#pragma unroll
                for (int m = 0; m < 4; ++m) { const int row = row0 + ai * 128 + m * 16; const float rs = rs8[ai][m]; u32x4 w;
#pragma unroll
                    for (int bj = 0; bj < 2; ++bj) { f32x4 a = DQ(ai, bj, m, 0), b = DQ(ai, bj, m, 1);
#pragma unroll
                        for (int j = 0; j < 4; ++j) { a[j] = fast_sigmoid(a[j]) * 255.0f; b[j] = fast_sigmoid(b[j]) * 255.0f; }
                        const unsigned wa_ = (unsigned)__float2int_rn(a[0]) | ((unsigned)__float2int_rn(a[1]) << 8) | ((unsigned)__float2int_rn(a[2]) << 16) | ((unsigned)__float2int_rn(a[3]) << 24);
                        const unsigned wb_ = (unsigned)__float2int_rn(b[0]) | ((unsigned)__float2int_rn(b[1]) << 8) | ((unsigned)__float2int_rn(b[2]) << 16) | ((unsigned)__float2int_rn(b[3]) << 24);
                        if (bj == 0) { w.x = wa_; w.y = wb_; } else { w.z = wa_; w.w = wb_; } }
                    *(u32x4*)((unsigned char*)G + (size_t)row * GW + (pn - 7) * 256 + wc * 64 + fq * 16) = w; }
        } else if (pn >= 5 || pn == 3) {
            const float sc = (pn == 3) ? 1.0f : C_M;
#pragma unroll
            for (int ai = 0; ai < 2; ++ai)
#pragma unroll
                for (int m = 0; m < 4; ++m) { const int row = row0 + ai * 128 + m * 16; const float rs = rs8[ai][m]; float s = 0.f;
#pragma unroll
                    for (int bj = 0; bj < 2; ++bj) { const f32x4 a = DQ(ai, bj, m, 0) * sc, b = DQ(ai, bj, m, 1) * sc;
                        s += (a[0] * a[0] + a[1] * a[1]) + (a[2] * a[2] + a[3] * a[3]) + (b[0] * b[0] + b[1] * b[1]) + (b[2] * b[2] + b[3] * b[3]);
                        *(u32x4*)(P + (size_t)row * PW + pn * 256 + bj * 128 + wc * 32 + fq * 8) = pack8(a, b); }
                    if (pn == 3) { s += __shfl_xor(s, 16); s += __shfl_xor(s, 32); if (fq == 0) ssq[(size_t)row * 8 + wc] = s; } }
        } else if (pn == 4) {
#pragma unroll
            for (int ai = 0; ai < 2; ++ai)
#pragma unroll
                for (int m = 0; m < 4; ++m) { const int row = row0 + ai * 128 + m * 16; const float rs = rs8[ai][m];
                    { const f32x4 a = DQ(ai, 0, m, 0), b = DQ(ai, 0, m, 1);
                      float s = (a[0] * a[0] + a[1] * a[1]) + (a[2] * a[2] + a[3] * a[3]) + (b[0] * b[0] + b[1] * b[1]) + (b[2] * b[2] + b[3] * b[3]);
                      *(u32x4*)(P + (size_t)row * PW + P_CKV + wc * 32 + fq * 8) = pack8(a, b);
                      s += __shfl_xor(s, 16); s += __shfl_xor(s, 32); if (fq == 0) ssq[(size_t)row * 8 + 4 + wc] = s; }
                    if (wc == 0) { const f32x4 x1 = DQ(ai, 1, m, 0), x2 = DQ(ai, 1, m, 1); const float pf = pf8[ai][m]; f32x4 o1, o2;
#pragma unroll
                        for (int j = 0; j < 4; ++j) { float c, s; rot_cs(pf, 2 * (4 * fq + j), c, s); o1[j] = x1[j] * c - x2[j] * s; o2[j] = x2[j] * c + x1[j] * s; }
                        *(u32x2*)(P + (size_t)row * PW + P_KR + 4 * fq) = pack4(o1); *(u32x2*)(P + (size_t)row * PW + P_KR + 16 + 4 * fq) = pack4(o2); } }
        } else {
            const float sc = (pn < 2) ? C_A : 1.0f; const int i0 = 16 * (wc & 1) + 4 * fq;
#pragma unroll
            for (int ai = 0; ai < 2; ++ai)
#pragma unroll
                for (int m = 0; m < 4; ++m) { const int row = row0 + ai * 128 + m * 16; const float rs = rs8[ai][m]; const float pf = pf8[ai][m]; f32x4 c, s;
#pragma unroll
                    for (int j = 0; j < 4; ++j) { float cc, ss; rot_cs(pf, i0 + j, cc, ss); c[j] = cc * sc; s[j] = ss * sc; }
#pragma unroll
                    for (int bj = 0; bj < 2; ++bj) { const f32x4 x1 = DQ(ai, bj, m, 0), x2 = DQ(ai, bj, m, 1);
                        if (pn == 2 && bj == 1) { *(u32x4*)(P + (size_t)row * PW + P_VA + wc * 32 + fq * 8) = pack8(x1, x2); }
                        else { const f32x4 o1 = x1 * c - x2 * s, o2 = x2 * c + x1 * s; bf16_t* d = P + (size_t)row * PW + pn * 256 + 64 * (2 * bj + (wc >> 1)) + i0;
                            *(u32x2*)d = pack4(o1); *(u32x2*)(d + 32) = pack4(o2); } } }
        }
#undef DQ
    }
};
struct EpiUp {
    static constexpr bool MID = false;
    __device__ __forceinline__ void stage(LAS unsigned char*, const Unit&, int, int) const {}
    bf16_t* QB; bf16_t* KVB; const float* ssq; const int* pos;
    __device__ __forceinline__ void operator()(const AccT& acc, const Unit& u, int wr, int wc, int fr, int fq, const LAS unsigned char*) const {
        const int pn = u.pn, row0 = u.pm * 256 + wr * 64 + fr;
        float rs8[2][4], pf8[2][4];
#pragma unroll
        for (int ai = 0; ai < 2; ++ai)
#pragma unroll
            for (int m = 0; m < 4; ++m) { const int row = row0 + ai * 128 + m * 16; const f32x4 sv = *(const f32x4*)(ssq + (size_t)row * 8 + (pn < 3 ? 0 : 4));
                rs8[ai][m] = (pn < 3 ? C_B : 1.0f) / sqrtf(((sv[0] + sv[1]) + (sv[2] + sv[3])) * (pn < 3 ? 1.0f / 256.0f : 1.0f / 128.0f) + EPS); pf8[ai][m] = (pn < 3) ? (float)pos[row] : 0.f; }
#pragma unroll
        for (int ai = 0; ai < 2; ++ai)
#pragma unroll
            for (int m = 0; m < 4; ++m) { const int row = row0 + ai * 128 + m * 16; const float rs = rs8[ai][m];
                if (pn < 3) {
#pragma unroll
                    for (int bj = 0; bj < 2; ++bj) { const int gg = 8 * pn + 4 * bj + wc; const f32x4 x1 = acc[ai][bj][m][0] * rs, x2 = acc[ai][bj][m][1] * rs;
                        if (gg % 3 == 2) { const float pf = pf8[ai][m]; f32x4 o1, o2;
#pragma unroll
                            for (int j = 0; j < 4; ++j) { float c, s; rot_cs(pf, 2 * (4 * fq + j), c, s); o1[j] = x1[j] * c - x2[j] * s; o2[j] = x2[j] * c + x1[j] * s; }
                            bf16_t* d = QB + (size_t)row * QBW + 32 * gg + 4 * fq; *(u32x2*)d = pack4(o1); *(u32x2*)(d + 16) = pack4(o2); }
                        else *(u32x4*)(QB + (size_t)row * QBW + 32 * gg + 8 * fq) = pack8(x1, x2); }
                } else {
#pragma unroll
                    for (int bj = 0; bj < 2; ++bj) *(u32x4*)(KVB + (size_t)row * KVW + (pn - 3) * 256 + bj * 128 + wc * 32 + fq * 8) = pack8(acc[ai][bj][m][0] * rs, acc[ai][bj][m][1] * rs);
                } }
    }
};
struct EpiPlain {
    static constexpr bool MID = false;
    __device__ __forceinline__ void stage(LAS unsigned char*, const Unit&, int, int) const {}
    bf16_t* O; int ldo;
    __device__ __forceinline__ void operator()(const AccT& acc, const Unit& u, int wr, int wc, int fr, int fq, const LAS unsigned char*) const {
        const int row0 = u.pm * 256 + wr * 64 + fr;
#pragma unroll
        for (int ai = 0; ai < 2; ++ai)
#pragma unroll
            for (int m = 0; m < 4; ++m)
#pragma unroll
                for (int bj = 0; bj < 2; ++bj) *(u32x4*)(O + (size_t)(row0 + ai * 128 + m * 16) * ldo + u.pn * 256 + bj * 128 + wc * 32 + fq * 8) = pack8(acc[ai][bj][m][0], acc[ai][bj][m][1]);
    }
};
struct EpiBranch {
    static constexpr bool MID = true;
    const unsigned char* G; bf16_t* MIXED;
    __device__ __forceinline__ void stage(LAS unsigned char*, const Unit&, int, int) const {}
    static __device__ __forceinline__ float gq(unsigned w, int b) { const float f = (float)((w >> (8 * b)) & 255u); return fmaxf(f, 2.55e-4f); }
    __device__ __forceinline__ void mid(AccT& acc, const Unit& u, int seg  , int wr, int wc, int fr, int fq) const {
        const int row0 = opq_v(u.pm * 256 + wr * 64 + fr);
#pragma unroll
        for (int ai = 0; ai < 2; ++ai) {
            u32x4 ga[4], gb[4];
#pragma unroll
            for (int m = 0; m < 4; ++m) { const unsigned char* gp = G + (size_t)(row0 + ai * 128 + m * 16) * GW + u.pn * 256 + wc * 64 + fq * 16;
                ga[m] = *(const u32x4*)(gp + (seg - 1) * 1024); gb[m] = *(const u32x4*)(gp + seg * 1024); }
#pragma unroll
            for (int m = 0; m < 4; ++m) {
#pragma unroll
                for (int j = 0; j < 4; ++j) {
                    acc[ai][0][m][0][j] *= gq(ga[m].x, j) * __builtin_amdgcn_rcpf(gq(gb[m].x, j)); acc[ai][0][m][1][j] *= gq(ga[m].y, j) * __builtin_amdgcn_rcpf(gq(gb[m].y, j));
                    acc[ai][1][m][0][j] *= gq(ga[m].z, j) * __builtin_amdgcn_rcpf(gq(gb[m].z, j)); acc[ai][1][m][1][j] *= gq(ga[m].w, j) * __builtin_amdgcn_rcpf(gq(gb[m].w, j)); } }
            asm volatile("" ::: "memory"); }
    }
    __device__ __forceinline__ void operator()(const AccT& acc, const Unit& u, int wr, int wc, int fr, int fq, const LAS unsigned char*) const {
        const int row0 = u.pm * 256 + wr * 64 + fr;
#pragma unroll
        for (int ai = 0; ai < 2; ++ai) {
            u32x4 gw[4];
#pragma unroll
            for (int m = 0; m < 4; ++m) gw[m] = *(const u32x4*)(G + (size_t)(row0 + ai * 128 + m * 16) * GW + 2048 + u.pn * 256 + wc * 64 + fq * 16);
#pragma unroll
            for (int m = 0; m < 4; ++m) { f32x4 a0 = acc[ai][0][m][0], b0 = acc[ai][0][m][1], a1 = acc[ai][1][m][0], b1 = acc[ai][1][m][1];
#pragma unroll
                for (int j = 0; j < 4; ++j) { a0[j] *= gq(gw[m].x, j) * (1.0f / 255.0f); b0[j] *= gq(gw[m].y, j) * (1.0f / 255.0f); a1[j] *= gq(gw[m].z, j) * (1.0f / 255.0f); b1[j] *= gq(gw[m].w, j) * (1.0f / 255.0f); }
                bf16_t* d = MIXED + (size_t)(row0 + ai * 128 + m * 16) * DM + u.pn * 256 + wc * 64 + fq * 16;
                *(u32x4*)d = pack8(a0, b0); *(u32x4*)(d + 8) = pack8(a1, b1); }
            asm volatile("" ::: "memory"); }
    }
};
struct EpiResid {
    static constexpr bool MID = false;
    __device__ __forceinline__ void stage(LAS unsigned char*, const Unit&, int, int) const {}
    const float* Xf; bf16_t* X;
    __device__ __forceinline__ void operator()(const AccT& acc, const Unit& u, int wr, int wc, int fr, int fq, const LAS unsigned char*) const {
        const int row0 = u.pm * 256 + wr * 64 + fr;
#pragma unroll
        for (int ai = 0; ai < 2; ++ai) {
            f32x4 xa[4][2], xb[4][2];
#pragma unroll
            for (int m = 0; m < 4; ++m)
#pragma unroll
                for (int bj = 0; bj < 2; ++bj) { const size_t o = (size_t)(row0 + ai * 128 + m * 16) * DM + u.pn * 256 + bj * 128 + wc * 32 + fq * 8;
                    if (Xf) { xa[m][bj] = *(const f32x4*)(Xf + o); xb[m][bj] = *(const f32x4*)(Xf + o + 4); }
                    else { const u32x4 q = *(const u32x4*)(X + o); xa[m][bj] = (f32x4){bflo(q.x), bfhi(q.x), bflo(q.y), bfhi(q.y)}; xb[m][bj] = (f32x4){bflo(q.z), bfhi(q.z), bflo(q.w), bfhi(q.w)}; } }
#pragma unroll
            for (int m = 0; m < 4; ++m)
#pragma unroll
                for (int bj = 0; bj < 2; ++bj) *(u32x4*)(X + (size_t)(row0 + ai * 128 + m * 16) * DM + u.pn * 256 + bj * 128 + wc * 32 + fq * 8) = pack8(xa[m][bj] + acc[ai][bj][m][0], xb[m][bj] + acc[ai][bj][m][1]);
            asm volatile("" ::: "memory"); }
    }
};
struct EpiSwiglu {
    static constexpr bool MID = false;
    bf16_t* ACT; int lo; const float* rsc; const float* csc;
    __device__ __forceinline__ void stage(LAS unsigned char* d, const Unit& u, int wid, int lane) const {
        if (wid == 0) { stage1k(rsc + u.pm * 256, d, lane); stage1k(csc + (size_t)u.aux * 2 * DFF + u.pn * 256, d + 1024, lane); } }
    template <class AV> __device__ __forceinline__ void operator()(const AV (&acc)[2][2][4][2], const Unit& u, int wr, int wc, int fr, int fq, const LAS unsigned char* esc) const {
        const int row0 = (u.pm - lo) * 256 + wr * 64 + fr;
        f32x4 cs[2][2];
#pragma unroll
        for (int bj = 0; bj < 2; ++bj)
#pragma unroll
            for (int n = 0; n < 2; ++n) cs[bj][n] = *(const LAS f32x4*)(esc + 1024 + (bj * 128 + wc * 32 + n * 16 + fq * 4) * 4);
        float rs8[2][4];
#pragma unroll
        for (int ai = 0; ai < 2; ++ai)
#pragma unroll
            for (int m = 0; m < 4; ++m) rs8[ai][m] = *(const LAS float*)(esc + (ai * 128 + wr * 64 + m * 16 + fr) * 4);
#pragma unroll
        for (int ai = 0; ai < 2; ++ai)
#pragma unroll
            for (int m = 0; m < 4; ++m) { const float rs = rs8[ai][m]; f32x4 a, b;
                const f32x4 g0 = deq(acc[ai][0][m][0], rs, cs[0][0]), g1 = deq(acc[ai][0][m][1], rs, cs[0][1]), u0 = deq(acc[ai][1][m][0], rs, cs[1][0]), u1 = deq(acc[ai][1][m][1], rs, cs[1][1]);
#pragma unroll
                for (int j = 0; j < 4; ++j) { a[j] = g0[j] * fast_sigmoid(g0[j]) * u0[j]; b[j] = g1[j] * fast_sigmoid(g1[j]) * u1[j]; }
                *(u32x4*)(ACT + (size_t)(row0 + ai * 128 + m * 16) * DFF + u.pn * 128 + wc * 32 + fq * 8) = pack8(a, b); }
    }
};
struct EpiYout {
    static constexpr bool MID = false;
    __device__ __forceinline__ void stage(LAS unsigned char*, const Unit&, int, int) const {}
    bf16_t* Y;
    __device__ __forceinline__ void operator()(const AccT& acc, const Unit& u, int wr, int wc, int fr, int fq, const LAS unsigned char*) const {
        const int row0 = u.pm * 256 + wr * 64 + fr;
#pragma unroll
        for (int ai = 0; ai < 2; ++ai)
#pragma unroll
            for (int m = 0; m < 4; ++m)
#pragma unroll
                for (int bj = 0; bj < 2; ++bj) *(u32x4*)(Y + (size_t)(row0 + ai * 128 + m * 16) * DM + u.pn * 256 + bj * 128 + wc * 32 + fq * 8) = pack8(acc[ai][bj][m][0], acc[ai][bj][m][1]);
    }
};
struct EpiSlab {
    static constexpr bool MID = false;
    __device__ __forceinline__ void stage(LAS unsigned char*, const Unit&, int, int) const {}
    float* slab;
    __device__ __forceinline__ void operator()(const AccT& acc, const Unit& u, int wr, int wc, int fr, int fq, const LAS unsigned char*) const {
        float* base = slab + (size_t)(((u.pm - 256) * 4 + u.pn) * TAIL_KS + (u.aux >> 8)) * 65536;
#pragma unroll
        for (int ai = 0; ai < 2; ++ai)
#pragma unroll
            for (int m = 0; m < 4; ++m)
#pragma unroll
                for (int bj = 0; bj < 2; ++bj) { float* d = base + (size_t)(ai * 128 + wr * 64 + m * 16 + fr) * 256 + bj * 128 + wc * 32 + fq * 8; *(f32x4*)d = acc[ai][bj][m][0]; *(f32x4*)(d + 4) = acc[ai][bj][m][1]; }
    }
};

namespace att {
__device__ __forceinline__ int crow(int r, int hi) { return (r & 3) + 8 * (r >> 2) + 4 * hi; }
__device__ __forceinline__ void glds16(const void* gsrc, unsigned lds_dst) { unsigned keep;
    asm volatile("s_mov_b32 %0, m0\n\ts_mov_b32 m0, %2\n\ts_nop 0\n\tglobal_load_lds_dwordx4 %1, off\n\ts_mov_b32 m0, %0" : "=&s"(keep) : "v"(gsrc), "s"(lds_dst) : "memory"); }
__device__ __forceinline__ float swapmax(float m) { auto rr = __builtin_amdgcn_permlane32_swap(__float_as_uint(m), __float_as_uint(m), false, false); return fmaxf(__uint_as_float(rr[0]), __uint_as_float(rr[1])); }
__device__ __forceinline__ float swapsum(float m) { auto rr = __builtin_amdgcn_permlane32_swap(__float_as_uint(m), __float_as_uint(m), false, false); return __uint_as_float(rr[0]) + __uint_as_float(rr[1]); }
__device__ __forceinline__ void store_o_block(const f32x16& o, float linv, bf16_t* rowp  , int hi) {
#pragma unroll
    for (int rp = 0; rp < 2; ++rp) {
        const u32x2 X = pack4((f32x4){o[8 * rp] * linv, o[8 * rp + 1] * linv, o[8 * rp + 2] * linv, o[8 * rp + 3] * linv});
        const u32x2 Y = pack4((f32x4){o[8 * rp + 4] * linv, o[8 * rp + 5] * linv, o[8 * rp + 6] * linv, o[8 * rp + 7] * linv});
        const auto s0 = __builtin_amdgcn_permlane32_swap(X.x, Y.x, false, false), s1 = __builtin_amdgcn_permlane32_swap(X.y, Y.y, false, false);
        const u32x4 w = {s0[0], s1[0], s0[1], s1[1]};
        *(u32x4*)(rowp + 8 * (2 * rp + hi)) = w; }
}
__device__ __forceinline__ s16x4 vtr(unsigned addr) { s16x4 r; asm volatile("ds_read_b64_tr_b16 %0, %1" : "=&v"(r) : "v"(addr) : "memory"); return r; }
#define VTRO(dst, base, off) asm volatile("ds_read_b64_tr_b16 %0, %1 offset:%c2" : "=&v"(dst) : "v"(base), "i"(off) : "memory")

struct Src {
    const bf16_t* q; int qpitch;
    const bf16_t* k0; int k0pitch;
    const bf16_t* k1; int k1pitch;
    const bf16_t* v; int vpitch;
    bf16_t* o; int opitch;
};
template <int NKC, int NVB, int RD = 4>
__device__ __forceinline__ void dma_tile(const Src& S, int t, int slot, unsigned lds0, int wid, int lane) {
    constexpr int KS = NKC * 1024, VS = NVB * 4096, LDS_K = 0, LDS_V = RD * KS;
#pragma unroll
    for (int c = 0; c < (NKC + 7) / 8; ++c) { const int ch = wid + 8 * c; if (ch < NKC) {
        const bf16_t* src = (ch < 8) ? S.k0 + (size_t)(t * 64 + lane) * S.k0pitch + ch * 8 : S.k1 + (size_t)(t * 64 + lane) * S.k1pitch + (ch - 8) * 8;
        glds16(src, (unsigned)__builtin_amdgcn_readfirstlane(lds0 + LDS_K + slot * KS + ch * 1024)); } }
#pragma unroll
    for (int c = 0; c < (NVB * 4 + 7) / 8; ++c) { const int p = wid + 8 * c; if (p < NVB * 4) {
        const bf16_t* src = S.v + (size_t)(t * 64 + 16 * (p & 3) + (lane >> 2)) * S.vpitch + (p >> 2) * 32 + (lane & 3) * 8;
        glds16(src, (unsigned)__builtin_amdgcn_readfirstlane(lds0 + LDS_V + slot * VS + p * 1024)); } }
}
__device__ __forceinline__ void wait_vm_bar(int n) {
    if (n >= 4) asm volatile("s_waitcnt vmcnt(4) lgkmcnt(0)\n\ts_barrier" ::: "memory");
    else if (n == 3) asm volatile("s_waitcnt vmcnt(3) lgkmcnt(0)\n\ts_barrier" ::: "memory");
    else if (n == 2) asm volatile("s_waitcnt vmcnt(2) lgkmcnt(0)\n\ts_barrier" ::: "memory");
    else if (n == 1) asm volatile("s_waitcnt vmcnt(1) lgkmcnt(0)\n\ts_barrier" ::: "memory");
    else asm volatile("s_waitcnt vmcnt(0) lgkmcnt(0)\n\ts_barrier" ::: "memory");
}
template <int NKC, int NVB, int MODE>
__device__ __forceinline__ void unit(LAS unsigned char* lds, const Src& S, int t_lo, int t_hi, int qpos0  , float sink_l2) {
    constexpr int KS = NKC * 1024, VS = NVB * 4096, RD = 4, LDS_K = 0, LDS_V = RD * KS;
    const int tid = opq_v((int)threadIdx.x), lane = tid & 63, r32 = lane & 31, hi = lane >> 5; const int wid = __builtin_amdgcn_readfirstlane(tid >> 6), grp = wid >> 2;
    const unsigned lds0 = (unsigned)(uintptr_t)lds;
    const int ops = (NKC + 7 - wid) / 8 + (NVB * 4) / 8;
    bf16x8 qr[NKC / 2];
#pragma unroll
    for (int d0 = 0; d0 < NKC / 2; ++d0) qr[d0] = *(const bf16x8*)(S.q + (size_t)r32 * S.qpitch + d0 * 16 + hi * 8);
    float m_run = (MODE == 0) ? sink_l2 : 0.0f, l_run = (MODE == 0 && hi == 0) ? 1.0f : 0.0f; bool first = (MODE != 0);
    f32x16 o[NVB];
#pragma unroll
    for (int d = 0; d < NVB; ++d) o[d] = f32x16{};
    const int qi = qpos0 + wid * 32 + r32, qw0 = qpos0 + wid * 32;
    f32x16 p0 = f32x16{}, p1 = f32x16{};
#define AT_ACTIVE(t) ((MODE != 0) || ((64 * (t) + 63 >= qw0 - 128) && (64 * (t) <= qw0 + 31 + 128)))
#define AT_QK(t) do { const LAS unsigned char* kb_ = lds + LDS_K + (((t) - t_lo) % RD) * KS + hi * 1024 + r32 * 16; p0 = f32x16{}; p1 = f32x16{}; \
        _Pragma("unroll") for (int d0 = 0; d0 < NKC / 2; ++d0) { const bf16x8 b0_ = *(const LAS bf16x8*)(kb_ + d0 * 2048), b1_ = *(const LAS bf16x8*)(kb_ + d0 * 2048 + 512); \
            p0 = __builtin_amdgcn_mfma_f32_32x32x16_bf16(b0_, qr[d0], p0, 0, 0, 0); p1 = __builtin_amdgcn_mfma_f32_32x32x16_bf16(b1_, qr[d0], p1, 0, 0, 0); } } while (0)
#define AT_SMPV(t) do { \
        if (MODE == 0 && !((64 * (t) >= qw0 + 31 - 128) && (64 * (t) + 63 <= qw0 + 128))) {   \
            _Pragma("unroll") for (int r = 0; r < 16; ++r) { const int kv_ = 64 * (t) + crow(r, hi); int e0_ = kv_ - qi; e0_ = e0_ < 0 ? -e0_ : e0_; int e1_ = kv_ + 32 - qi; e1_ = e1_ < 0 ? -e1_ : e1_; \
            if (e0_ > 128) p0[r] = -INFINITY; if (e1_ > 128) p1[r] = -INFINITY; } } \
        if (first) {   \
            float mx_[8]; _Pragma("unroll") for (int r = 0; r < 8; ++r) mx_[r] = fmaxf(fmaxf(p0[r], p0[r + 8]), fmaxf(p1[r], p1[r + 8])); \
            float rm_ = fmaxf(fmaxf(fmaxf(mx_[0], mx_[1]), fmaxf(mx_[2], mx_[3])), fmaxf(fmaxf(mx_[4], mx_[5]), fmaxf(mx_[6], mx_[7]))); m_run = swapmax(rm_); first = false; } \
        else { const float tot_ = swapsum(l_run);   \
          if (__any(tot_ > 1.0e12f)) { const float dl_ = tot_ > 1.0e12f ? ceilf(__builtin_amdgcn_logf(tot_)) : 0.f, sc_ = __builtin_amdgcn_exp2f(-dl_); m_run += dl_; l_run *= sc_; \
              _Pragma("unroll") for (int d = 0; d < NVB; ++d) _Pragma("unroll") for (int r = 0; r < 16; ++r) o[d][r] *= sc_; } } \
        float sm_[4] = {0.f, 0.f, 0.f, 0.f}; \
        _Pragma("unroll") for (int r = 0; r < 16; ++r) { p0[r] = __builtin_amdgcn_exp2f(p0[r] - m_run); p1[r] = __builtin_amdgcn_exp2f(p1[r] - m_run); sm_[r & 3] += p0[r] + p1[r]; } \
        l_run += (sm_[0] + sm_[1]) + (sm_[2] + sm_[3]); \
        u32x4 pw_[4]; \
        pw_[0] = (u32x4){cvtpk(p0[0], p0[1]), cvtpk(p0[2], p0[3]), cvtpk(p0[4], p0[5]), cvtpk(p0[6], p0[7])}; pw_[1] = (u32x4){cvtpk(p0[8], p0[9]), cvtpk(p0[10], p0[11]), cvtpk(p0[12], p0[13]), cvtpk(p0[14], p0[15])}; \
        pw_[2] = (u32x4){cvtpk(p1[0], p1[1]), cvtpk(p1[2], p1[3]), cvtpk(p1[4], p1[5]), cvtpk(p1[6], p1[7])}; pw_[3] = (u32x4){cvtpk(p1[8], p1[9]), cvtpk(p1[10], p1[11]), cvtpk(p1[12], p1[13]), cvtpk(p1[14], p1[15])}; \
        const unsigned vb_ = lds0 + LDS_V + (((t) - t_lo) % RD) * VS + ((lane >> 4) & 1) * 32 + (lane & 3) * 8 + (4 * hi + ((lane & 15) >> 2)) * 64; \
        _Pragma("unroll") for (int dp = 0; dp < NVB; dp += 2) { s16x4 lo_[2][4], hh_[2][4]; \
            _Pragma("unroll") for (int dd = 0; dd < 2; ++dd) _Pragma("unroll") for (int ks = 0; ks < 4; ++ks) { lo_[dd][ks] = vtr(vb_ + (dp + dd) * 4096 + ks * 1024); hh_[dd][ks] = vtr(vb_ + (dp + dd) * 4096 + ks * 1024 + 512); } \
            asm volatile("s_waitcnt lgkmcnt(0)" ::: "memory"); __builtin_amdgcn_sched_barrier(0); \
            _Pragma("unroll") for (int ks = 0; ks < 4; ++ks) _Pragma("unroll") for (int dd = 0; dd < 2; ++dd) { \
                const bf16x8 vf_ = (bf16x8){lo_[dd][ks][0], lo_[dd][ks][1], lo_[dd][ks][2], lo_[dd][ks][3], hh_[dd][ks][0], hh_[dd][ks][1], hh_[dd][ks][2], hh_[dd][ks][3]}; \
                o[dp + dd] = __builtin_amdgcn_mfma_f32_32x32x16_bf16(vf_, __builtin_bit_cast(bf16x8, pw_[ks]), o[dp + dd], 0, 0, 0); } } } while (0)
    dma_tile<NKC, NVB>(S, t_lo, 0, lds0, wid, lane);
    if (t_lo + 1 < t_hi) dma_tile<NKC, NVB>(S, t_lo + 1, 1, lds0, wid, lane);
    for (int t = t_lo; t < t_hi; ++t) {
        wait_vm_bar((t + 1 < t_hi) ? ops : 0);
        if (t + 2 < t_hi) dma_tile<NKC, NVB>(S, t + 2, (t + 2 - t_lo) % RD, lds0, wid, lane);
        if (grp == 0) { if (AT_ACTIVE(t)) { AT_QK(t); AT_SMPV(t); } }
        else { if (t > t_lo && AT_ACTIVE(t - 1)) AT_SMPV(t - 1); if (AT_ACTIVE(t)) AT_QK(t); }
    }
    if (grp == 1 && AT_ACTIVE(t_hi - 1)) AT_SMPV(t_hi - 1);
    const float linv = 1.0f / swapsum(l_run);
#pragma unroll
    for (int d = 0; d < NVB; ++d) store_o_block(o[d], linv, S.o + (size_t)r32 * S.opitch + 32 * d, hi);
    asm volatile("s_waitcnt lgkmcnt(0)\n\ts_barrier" ::: "memory");
#undef AT_ACTIVE
#undef AT_QK
#undef AT_SMPV
}

template <int NKC, int NVB>
__device__ __forceinline__ void unit_q64(LAS unsigned char* lds, const Src& S, int t_lo, int t_hi) {
    constexpr int KS = NKC * 1024, VS = NVB * 4096, RD = 4, LDS_K = 0, LDS_V = RD * KS;
    const int tid = opq_v((int)threadIdx.x), lane = tid & 63, r32 = lane & 31, hi = lane >> 5; const int wid = __builtin_amdgcn_readfirstlane(tid >> 6);
    const unsigned lds0 = (unsigned)(uintptr_t)lds;
    const int ops = (NKC + 7 - wid) / 8 + (NVB * 4) / 8;
    bf16x8 qa[NKC / 2], qb[NKC / 2];
#pragma unroll
    for (int d0 = 0; d0 < NKC / 2; ++d0) { qa[d0] = *(const bf16x8*)(S.q + (size_t)r32 * S.qpitch + d0 * 16 + hi * 8); qb[d0] = *(const bf16x8*)(S.q + (size_t)(32 + r32) * S.qpitch + d0 * 16 + hi * 8); }
    float ma = 0.f, la = 0.f, mb = 0.f, lb = 0.f; bool first = true;
    f32x16 oa[NVB], ob[NVB];
#pragma unroll
    for (int d = 0; d < NVB; ++d) { oa[d] = f32x16{}; ob[d] = f32x16{}; }
#define Q64_SM(P0, P1, M, L, O, PW) do { \
        if (first) {   \
            float mx_[8]; _Pragma("unroll") for (int r = 0; r < 8; ++r) mx_[r] = fmaxf(fmaxf(P0[r], P0[r + 8]), fmaxf(P1[r], P1[r + 8])); \
            float rm_ = fmaxf(fmaxf(fmaxf(mx_[0], mx_[1]), fmaxf(mx_[2], mx_[3])), fmaxf(fmaxf(mx_[4], mx_[5]), fmaxf(mx_[6], mx_[7]))); M = swapmax(rm_); } \
        else { const float tot_ = swapsum(L);   \
          if (__any(tot_ > 1.0e12f)) { const float dl_ = tot_ > 1.0e12f ? ceilf(__builtin_amdgcn_logf(tot_)) : 0.f, sc_ = __builtin_amdgcn_exp2f(-dl_); M += dl_; L *= sc_; \
              _Pragma("unroll") for (int d = 0; d < NVB; ++d) _Pragma("unroll") for (int r = 0; r < 16; ++r) O[d][r] *= sc_; } } \
        float sm_[4] = {0.f, 0.f, 0.f, 0.f}; \
        _Pragma("unroll") for (int r = 0; r < 16; ++r) { P0[r] = __builtin_amdgcn_exp2f(P0[r] - M); P1[r] = __builtin_amdgcn_exp2f(P1[r] - M); sm_[r & 3] += P0[r] + P1[r]; } \
        L += (sm_[0] + sm_[1]) + (sm_[2] + sm_[3]); \
        PW[0] = (u32x4){cvtpk(P0[0], P0[1]), cvtpk(P0[2], P0[3]), cvtpk(P0[4], P0[5]), cvtpk(P0[6], P0[7])}; PW[1] = (u32x4){cvtpk(P0[8], P0[9]), cvtpk(P0[10], P0[11]), cvtpk(P0[12], P0[13]), cvtpk(P0[14], P0[15])}; \
        PW[2] = (u32x4){cvtpk(P1[0], P1[1]), cvtpk(P1[2], P1[3]), cvtpk(P1[4], P1[5]), cvtpk(P1[6], P1[7])}; PW[3] = (u32x4){cvtpk(P1[8], P1[9]), cvtpk(P1[10], P1[11]), cvtpk(P1[12], P1[13]), cvtpk(P1[14], P1[15])}; \
        __builtin_amdgcn_sched_barrier(0); } while (0)
#define Q64_SM_NB(P0, P1, M, L, O, PW) do { \
        if (first) {   \
            float mx_[8]; _Pragma("unroll") for (int r = 0; r < 8; ++r) mx_[r] = fmaxf(fmaxf(P0[r], P0[r + 8]), fmaxf(P1[r], P1[r + 8])); \
            float rm_ = fmaxf(fmaxf(fmaxf(mx_[0], mx_[1]), fmaxf(mx_[2], mx_[3])), fmaxf(fmaxf(mx_[4], mx_[5]), fmaxf(mx_[6], mx_[7]))); M = swapmax(rm_); } \
        else { const float tot_ = swapsum(L);   \
          if (__any(tot_ > 1.0e12f)) { const float dl_ = tot_ > 1.0e12f ? ceilf(__builtin_amdgcn_logf(tot_)) : 0.f, sc_ = __builtin_amdgcn_exp2f(-dl_); M += dl_; L *= sc_; \
              _Pragma("unroll") for (int d = 0; d < NVB; ++d) _Pragma("unroll") for (int r = 0; r < 16; ++r) O[d][r] *= sc_; } } \
        float sm_[4] = {0.f, 0.f, 0.f, 0.f}; \
        _Pragma("unroll") for (int r = 0; r < 16; ++r) { P0[r] = __builtin_amdgcn_exp2f(P0[r] - M); P1[r] = __builtin_amdgcn_exp2f(P1[r] - M); sm_[r & 3] += P0[r] + P1[r]; } \
        L += (sm_[0] + sm_[1]) + (sm_[2] + sm_[3]); \
        PW[0] = (u32x4){cvtpk(P0[0], P0[1]), cvtpk(P0[2], P0[3]), cvtpk(P0[4], P0[5]), cvtpk(P0[6], P0[7])}; PW[1] = (u32x4){cvtpk(P0[8], P0[9]), cvtpk(P0[10], P0[11]), cvtpk(P0[12], P0[13]), cvtpk(P0[14], P0[15])}; \
        PW[2] = (u32x4){cvtpk(P1[0], P1[1]), cvtpk(P1[2], P1[3]), cvtpk(P1[4], P1[5]), cvtpk(P1[6], P1[7])}; PW[3] = (u32x4){cvtpk(P1[8], P1[9]), cvtpk(P1[10], P1[11]), cvtpk(P1[12], P1[13]), cvtpk(P1[14], P1[15])}; \
        } while (0)
    dma_tile<NKC, NVB, RD>(S, t_lo, 0, lds0, wid, lane);
    if (t_lo + 1 < t_hi) dma_tile<NKC, NVB, RD>(S, t_lo + 1, 1, lds0, wid, lane);
    for (int t = t_lo; t < t_hi; ++t) {
        const int slot = (t - t_lo) % RD;
        wait_vm_bar((t + 1 < t_hi) ? ops : 0);
        if (t + 2 < t_hi) dma_tile<NKC, NVB, RD>(S, t + 2, (t + 2 - t_lo) % RD, lds0, wid, lane);
        const LAS unsigned char* kb = lds + LDS_K + slot * KS + hi * 1024 + r32 * 16;
        f32x16 s0a = f32x16{}, s0b = f32x16{}, s1a = f32x16{}, s1b = f32x16{};
#pragma unroll
        for (int d0 = 0; d0 < NKC / 2; ++d0) {
            const bf16x8 b0 = *(const LAS bf16x8*)(kb + d0 * 2048), b1 = *(const LAS bf16x8*)(kb + d0 * 2048 + 512);
            s0a = __builtin_amdgcn_mfma_f32_32x32x16_bf16(b0, qa[d0], s0a, 0, 0, 0); s0b = __builtin_amdgcn_mfma_f32_32x32x16_bf16(b1, qa[d0], s0b, 0, 0, 0);
            s1a = __builtin_amdgcn_mfma_f32_32x32x16_bf16(b0, qb[d0], s1a, 0, 0, 0); s1b = __builtin_amdgcn_mfma_f32_32x32x16_bf16(b1, qb[d0], s1b, 0, 0, 0); }
        __builtin_amdgcn_sched_barrier(0);
        u32x4 pwa[4], pwb[4];
        const unsigned vb = lds0 + LDS_V + slot * VS + ((lane >> 4) & 1) * 32 + (lane & 3) * 8 + (4 * hi + ((lane & 15) >> 2)) * 64;
        s16x4 lo[NVB][4], hh[NVB][4];
#pragma unroll
        for (int d = 0; d < NVB; ++d)
#pragma unroll
            for (int ks = 0; ks < 4; ++ks) { VTRO(lo[d][ks], vb, d * 4096 + ks * 1024); VTRO(hh[d][ks], vb, d * 4096 + ks * 1024 + 512); }
        __builtin_amdgcn_sched_barrier(0);
        Q64_SM(s0a, s0b, ma, la, oa, pwa);
        asm volatile("s_waitcnt lgkmcnt(0)" ::: "memory"); __builtin_amdgcn_sched_barrier(0);
#pragma unroll
        for (int ks = 0; ks < 4; ++ks)
#pragma unroll
            for (int d = 0; d < NVB; ++d) { const bf16x8 vf = (bf16x8){lo[d][ks][0], lo[d][ks][1], lo[d][ks][2], lo[d][ks][3], hh[d][ks][0], hh[d][ks][1], hh[d][ks][2], hh[d][ks][3]};
                oa[d] = __builtin_amdgcn_mfma_f32_32x32x16_bf16(vf, __builtin_bit_cast(bf16x8, pwa[ks]), oa[d], 0, 0, 0); }
        Q64_SM_NB(s1a, s1b, mb, lb, ob, pwb);
#pragma unroll
        for (int i = 0; i < 8; ++i) { __builtin_amdgcn_sched_group_barrier(0x008, 1, 0); __builtin_amdgcn_sched_group_barrier(0x002, 12, 0); }
        __builtin_amdgcn_sched_barrier(0);
#pragma unroll
        for (int ks = 0; ks < 4; ++ks)
#pragma unroll
            for (int d = 0; d < NVB; ++d) { const bf16x8 vf = (bf16x8){lo[d][ks][0], lo[d][ks][1], lo[d][ks][2], lo[d][ks][3], hh[d][ks][0], hh[d][ks][1], hh[d][ks][2], hh[d][ks][3]};
                ob[d] = __builtin_amdgcn_mfma_f32_32x32x16_bf16(vf, __builtin_bit_cast(bf16x8, pwb[ks]), ob[d], 0, 0, 0); }
        __builtin_amdgcn_sched_barrier(0);
        first = false;
    }
    const float lia = 1.0f / swapsum(la), lib = 1.0f / swapsum(lb);
#pragma unroll
    for (int d = 0; d < NVB; ++d) { store_o_block(oa[d], lia, S.o + (size_t)r32 * S.opitch + 32 * d, hi); store_o_block(ob[d], lib, S.o + (size_t)(32 + r32) * S.opitch + 32 * d, hi); }
    asm volatile("s_waitcnt lgkmcnt(0)\n\ts_barrier" ::: "memory");
#undef Q64_SM
#undef Q64_SM_NB
}

}
#define SC_AFTER_PROLOGUE() do {} while (0)
#define SC_AFTER_INPROJ(l) do {} while (0)
#define SC_AFTER_UP(l) do {} while (0)
#define SC_AFTER_MLA(l) do {} while (0)
#define SC_AFTER_BRANCH(l) do {} while (0)
#define SC_AFTER_WOUT(l) do {} while (0)
#define SC_AFTER_NORM2(l) do {} while (0)
#define SC_AFTER_GU(l) do {} while (0)
#define SC_AFTER_DOWN(l) do {} while (0)
#define SC_AFTER_ROUTE(l) do {} while (0)
#define SC_AFTER_MOEGU(l, h) do {} while (0)
#define SC_AFTER_MOED(l, h) do {} while (0)
#define SC_FINAL() do {} while (0)

struct Args { const float* in[23]; float* out; unsigned char* ws; };
#define WSP(type, off) ((type*)(F.ws + (off)))
#define PHASE() Frame Fp = F; Fp.ws = opq_p(F.ws); Fp.in = opq_p(F.in); Fp.out = opq_p(F.out); Fp.tid = opq_v((int)threadIdx.x); Fp.lane = Fp.tid & 63; Fp.wave = __builtin_amdgcn_readfirstlane(Fp.tid >> 6); (void)Fp
#define FWS(type, off) ((type*)(Fp.ws + (off)))
#define X_ FWS(bf16_t, WS_XB)
#define H_ FWS(bf16_t, WS_H)
#define Pb_ FWS(bf16_t, WS_R + R_P)
#define Gb_ FWS(bf16_t, WS_R + R_G)
#define QB_ FWS(bf16_t, WS_R + R_QB)
#define KVB_ FWS(bf16_t, WS_R + R_KVB)
#define Yb_ FWS(bf16_t, WS_R + R_Y)
#define MEMN_ FWS(bf16_t, WS_MEMN)
#define MEMKV_ FWS(bf16_t, WS_MEMKV)
#define ACT_ FWS(bf16_t, WS_R + R_ACT)
#define ASORT_ FWS(bf16_t, WS_R + R_ASORT)
#define YOUT_ FWS(bf16_t, WS_R + R_YOUT)
#define SSQ_ FWS(float, WS_MISC + MS_SSQ)
#define TEXP_ FWS(const int, WS_MISC + MS_TEXP)
#define POS_ ((const int*)Fp.in[I_POS])
#define HSC_ FWS(float, WS_MISC + MS_HSC)
#define ASC_ FWS(float, WS_MISC + MS_ASC)
#define WSIN_ FWS(float, WS_MISC + MS_WSIN)
#define WSGU_ FWS(float, WS_MISC + MS_WSGU)

#define GRID_BAR() xcd_barrier(bar)
#ifndef WGM_GU
#define WGM_GU 4
#endif
#ifndef WGM_IN
#define WGM_IN 4
#endif
template <int l> __device__ __forceinline__ void layer_body(const Frame& F, const XcdBarrier& bar, const int bx) {
        if (l > 0) {
            PHASE();
            prep_ffn_weights(Fp, l);
            if ((l & 1) != 0) norm_phase(Fp, nullptr, X_, Fp.in[I_GMIX] + l * DM, false, true);
            if ((l & 1) == 0) norm_phase(Fp, nullptr, X_, Fp.in[I_GMIX] + l * DM, true, true);
            GRID_BAR();
        }
        {   PHASE();
            ProbSimple p{DM, DM, DM, (const char*)H_, (const char*)wmix(Fp, l, WL_IN)}; pg8::StaticOrder S; S.init(T / 256, NT_IN, Fp.G, bx, 0, WGM_IN);
            EpiInproj E{Pb_, Gb_, SSQ_, POS_, HSC_, WSIN_ + l * NT_IN * 256}; pg8::gemm_phase<true>(Fp.lds, p, S, E); }
        if (l == 0) { PHASE();
            ProbSimple p{DM, DM * 2, DM * 2, (const char*)MEMN_, (const char*)FWS(bf16_t, WS_WMKV)}; pg8::StaticOrder S; S.init(NB * MEML / 256, 16, Fp.G, bx);
            EpiPlain E{MEMKV_, 4096}; pg8::gemm_phase(Fp.lds, p, S, E); }
        GRID_BAR();
        SC_AFTER_INPROJ(l);
        {   PHASE();
            ProbUp p{UPK, PW * 2, UPK * 2, (const char*)(Pb_ + P_CQ), (const char*)wmix(Fp, l, WL_UP)}; pg8::StaticOrder S; S.init(T / 256, UPN / 256, Fp.G, bx);
            EpiUp E{QB_, KVB_, SSQ_, POS_}; pg8::gemm_phase(Fp.lds, p, S, E); }
        {   PHASE();
            for (int i = Fp.vcu; i < 1024; i += Fp.G) {
                const int hl = i & 3, qb = (i >> 2) & 15, kvh = (i >> 6) & 1, b = i >> 7, h = kvh * 4 + hl; const size_t rowb = (size_t)b * SEQ; const int q0 = qb * 256;
                att::Src s; s.q = Pb_ + (rowb + q0 + Fp.wave * 32) * PW + P_QA + h * 64; s.qpitch = PW; s.k0 = Pb_ + rowb * PW + P_KA + kvh * 64; s.k0pitch = PW; s.k1 = s.k0; s.k1pitch = PW;
                s.v = Pb_ + rowb * PW + P_VA + kvh * 64; s.vpitch = PW; s.o = Yb_ + (rowb + q0 + Fp.wave * 32) * YW + h * 64; s.opitch = YW;
                const int t_lo = (q0 / 64 - 2) < 0 ? 0 : (q0 / 64 - 2), t_hi = (q0 / 64 + 6) > SEQ / 64 ? SEQ / 64 : (q0 / 64 + 6);
                att::unit<8, 2, 0>(Fp.lds, s, t_lo, t_hi, q0, Fp.in[I_SINK][l * 8 + h] * LOG2E);
            } }
        {   PHASE();
            for (int i = Fp.vcu; i < 512; i += Fp.G) {
                const int qb = i & 15, h = (i >> 4) & 3, b = i >> 6; const size_t rowq = (size_t)b * SEQ + qb * 256 + Fp.wave * 32;
                att::Src s; s.q = Pb_ + rowq * PW + P_QM + h * 128; s.qpitch = PW; s.k0 = MEMKV_ + (size_t)b * MEML * 4096 + l * 1024 + h * 128; s.k0pitch = 4096; s.k1 = s.k0 + 64; s.k1pitch = 4096;
                s.v = MEMKV_ + (size_t)b * MEML * 4096 + l * 1024 + 512 + h * 128; s.vpitch = 4096; s.o = Yb_ + rowq * YW + 1024 + h * 128; s.opitch = YW;
                att::unit<16, 4, 1>(Fp.lds, s, 0, MEML / 64, 0, 0.f);
            } }
        GRID_BAR();
        SC_AFTER_UP(l);
        {   PHASE();
            for (int i = Fp.vcu; i < 512; i += Fp.G) {
                const int qb = i & 7, h = (i >> 3) & 7, b = i >> 6; const size_t rowb = (size_t)b * SEQ, rowq = rowb + qb * 512 + Fp.wave * 64;
                att::Src s; s.q = QB_ + rowq * QBW + h * 96; s.qpitch = QBW; s.k0 = KVB_ + rowb * KVW + h * 128; s.k0pitch = KVW; s.k1 = Pb_ + rowb * PW + P_KR; s.k1pitch = PW;
                s.v = KVB_ + rowb * KVW + h * 128 + 64; s.vpitch = KVW; s.o = Yb_ + rowq * YW + 512 + h * 64; s.opitch = YW;
                att::unit_q64<12, 2>(Fp.lds, s, 0, SEQ / 64);
            } }
        GRID_BAR();
        SC_AFTER_MLA(l);
        {   PHASE();
            ProbSimple p{1536, YW * 2, 1536 * 2, (const char*)Yb_, (const char*)wmix(Fp, l, WL_BR)}; pg8::StaticOrder S; S.init(T / 256, DM / 256, Fp.G, bx);
            EpiBranch E{(const unsigned char*)Gb_, H_}; pg8::gemm_phase(Fp.lds, p, S, E); }
        GRID_BAR();
        SC_AFTER_BRANCH(l);
        if (l == 0) {   PHASE();
            ProbSimple p{DM, DM * 2, DM * 2, (const char*)H_, (const char*)wmix(Fp, l, WL_OUT)}; pg8::StaticOrder S; S.init(T / 256, DM / 256, Fp.G, bx);
            EpiResid E{Fp.in[I_X], X_}; pg8::gemm_phase(Fp.lds, p, S, E); }
        if (l != 0) {   PHASE();
            ProbSimple p{DM, DM * 2, DM * 2, (const char*)H_, (const char*)wmix(Fp, l, WL_OUT)}; pg8::StaticOrder S; S.init(T / 256, DM / 256, Fp.G, bx);
            EpiResid E{nullptr, X_}; pg8::gemm_phase(Fp.lds, p, S, E); }
        GRID_BAR();
        SC_AFTER_WOUT(l);
        if ((l & 1) == 0) {
            {   PHASE(); norm_phase(Fp, nullptr, X_, Fp.in[I_GFFN] + l * DM, false, GU_I8(l) != 0); }
            GRID_BAR();
            SC_AFTER_NORM2(l);
            {   PHASE();
                constexpr bool i8 = GU_I8(l) != 0; constexpr unsigned eb = i8 ? 1 : 2;
                ProbSimple p{DM, DM * eb, DM * eb, (const char*)H_, (const char*)FWS(bf16_t, WS_WFFN + WF_GU)}; pg8::StaticOrder S; S.init(T / 256, 2 * DFF / 256, Fp.G, bx, 0, WGM_GU);
                EpiSwiglu E{ACT_, 0, HSC_, WSGU_}; pg8::gemm_phase<i8>(Fp.lds, p, S, E); }
            GRID_BAR();
            SC_AFTER_GU(l);
            {   PHASE();
                ProbSimple p{DFF, DFF * 2, DFF * 2, (const char*)ACT_, (const char*)FWS(bf16_t, WS_WFFN + WF_D)}; pg8::StaticOrder S; S.init(T / 256, DM / 256, Fp.G, bx, 1);
                EpiResid E{nullptr, X_}; pg8::gemm_phase(Fp.lds, p, S, E); }
            GRID_BAR();
            SC_AFTER_DOWN(l);
        } else {
            {   PHASE(); norm_router_phase(Fp, X_, Fp.in[I_GFFN] + l * DM, Fp.in[I_WR] + (size_t)(l >> 1) * DM * NE, GU_I8(l) != 0); }
            GRID_BAR();
            {   PHASE(); moe_assign_phase(Fp, GU_I8(l) != 0); }
            GRID_BAR();
            SC_AFTER_ROUTE(l);
            {   constexpr int half = 0; (void)half;
                {   PHASE();
                    const int nrt = __builtin_amdgcn_readfirstlane(TEXP_[MAXRT]);
                    constexpr bool i8 = GU_I8(l) != 0; constexpr unsigned eb = i8 ? 1 : 2;
                    ProbMoe p{DM, DM * eb, DM * eb, (const char*)ASORT_, (const char*)FWS(bf16_t, WS_WFFN + WF_GU), 0}; MoeOrder S; S.base.init(nrt, 2 * DFF / 256, Fp.G, bx, 0, WGM_GU); S.lo = 0; S.texp = TEXP_;
                    EpiSwiglu E{ACT_, 0, ASC_, WSGU_}; pg8::gemm_phase<i8>(Fp.lds, p, S, E); }
                GRID_BAR();
                SC_AFTER_MOEGU(l, half);
                {   PHASE();
                    const int nrt = __builtin_amdgcn_readfirstlane(TEXP_[MAXRT]); const int nmain = nrt < 256 ? nrt : 256;
                    ProbMoe p{DFF, DFF * 2, DFF * 2, (const char*)ACT_, (const char*)FWS(bf16_t, WS_WFFN + WF_D), 0}; MoeOrder S; S.base.init(nmain, DM / 256, Fp.G, bx, 1); S.lo = 0; S.texp = TEXP_;
                    EpiYout E{YOUT_}; pg8::gemm_phase(Fp.lds, p, S, E); }
                {   PHASE();
                    const int nrt = __builtin_amdgcn_readfirstlane(TEXP_[MAXRT]);
                    ProbTail p{DFF / TAIL_KS, DFF * 2, DFF * 2, (const char*)ACT_, (const char*)FWS(bf16_t, WS_WFFN + WF_D)}; TailOrder S{(nrt > 256 ? nrt - 256 : 0) * 4 * TAIL_KS, Fp.G, Fp.vcu, TEXP_};
                    EpiSlab E{FWS(float, WS_SLAB)}; pg8::gemm_phase(Fp.lds, p, S, E); }
                GRID_BAR();
                SC_AFTER_MOED(l, half);
            }
        }
    }

__global__ void __launch_bounds__(NWAVES * 64, 2) fwd(Args args) {
    extern __shared__ __attribute__((aligned(16))) unsigned char lds_raw[];
    Frame F;
    F.lds = (LAS unsigned char*)lds_raw;
    F.MISC = (volatile LAS unsigned*)(F.lds + LDSCTL_OFF);
    F.tid = threadIdx.x; F.lane = F.tid & 63; F.wave = __builtin_amdgcn_readfirstlane(F.tid >> 6);
    F.G = gridDim.x; { const int bx = blockIdx.x; F.vcu = (F.G % 8 == 0) ? (bx % 8) * (F.G / 8) + bx / 8 : bx; }
    F.ws = args.ws; F.ctl = (gu32*)(args.ws + WS_CTL); F.out = args.out;
    F.in = (const float* const*)__builtin_amdgcn_kernarg_segment_ptr();
    for (int u = F.tid; u < (LDS_BYTES - LDSCTL_OFF) / 4; u += NWAVES * 64) ((LAS unsigned*)(F.lds + LDSCTL_OFF))[u] = 0u;
    __syncthreads();
    XcdBarrier bar = xcd_barrier_post((unsigned*)(F.ctl + CW_BAR), F.MISC + 8);

    const int bx = (int)blockIdx.x;

    {   PHASE();
        prep_mixer_weights(Fp);
        memnorm_phase(Fp);
        prep_ffn_weights(Fp, 0);
        norm_phase(Fp, Fp.in[I_X], nullptr, Fp.in[I_GMIX], false, true); }
    GRID_BAR();
    SC_AFTER_PROLOGUE();

    layer_body<0>(F, bar, bx); layer_body<1>(F, bar, bx); layer_body<2>(F, bar, bx); layer_body<3>(F, bar, bx);
    {   PHASE(); final_norm_phase(Fp, X_, Fp.out, Fp.in[I_GFIN], true); }
    SC_FINAL();
}

extern "C" void kernel_launch(void* const* d_in, const int* in_sizes, int n_in, void* d_out, int out_size, void* d_ws, size_t ws_size, hipStream_t stream) {
    static int grid = 0;
    if (grid == 0) {
        if (n_in != 23 || out_size != T * DM || ws_size < WS_END) { fprintf(stderr, "kernel_launch: unexpected problem (n_in %d, out %d, ws %zu < %zu)\n", n_in, out_size, ws_size, (size_t)WS_END); grid = -1; return; }
        int dev = 0, cus = 0;
        if (hipGetDevice(&dev) != hipSuccess || hipDeviceGetAttribute(&cus, hipDeviceAttributeMultiprocessorCount, dev) != hipSuccess) { grid = -1; return; }
        if (hipFuncSetAttribute((const void*)fwd, hipFuncAttributeMaxDynamicSharedMemorySize, LDS_BYTES) != hipSuccess) { fprintf(stderr, "kernel_launch: hipFuncSetAttribute failed\n"); grid = -1; return; }
        int per_cu = 0;
        if (hipOccupancyMaxActiveBlocksPerMultiprocessor(&per_cu, (const void*)fwd, NWAVES * 64, LDS_BYTES) != hipSuccess || per_cu < 1) fprintf(stderr, "kernel_launch: occupancy query says %d\n", per_cu);
        (void)hipGetLastError();
        grid = cus;
    }
    if (grid < 0) return;
    if (hipMemsetAsync((char*)d_ws + WS_CTL, 0, CTL_ZERO_BYTES, stream) != hipSuccess) return;
    Args a{};
    for (int i = 0; i < 23; ++i) a.in[i] = (const float*)d_in[i];
    a.out = (float*)d_out; a.ws = (unsigned char*)d_ws;
    hipLaunchKernelGGL(fwd, dim3(grid), dim3(NWAVES * 64), LDS_BYTES, stream, a);
}
```

```cpp
#include <hip/hip_runtime.h>
#include <cstdio>
#include <cstdint>

#ifndef SELFCHECK
#define SELFCHECK 0
#endif
#ifndef GU_I8_MASK
#define GU_I8_MASK 0xF
#endif
#define GU_I8(l) ((((unsigned)GU_I8_MASK) >> (l)) & 1u)

#define GAS __attribute__((address_space(1)))
#define LAS __attribute__((address_space(3)))
typedef unsigned short bf16_t;
typedef short bf16x8 __attribute__((ext_vector_type(8)));
typedef short s16x4 __attribute__((ext_vector_type(4)));
typedef short v4i16_t __attribute__((ext_vector_type(4)));
typedef float f32x2 __attribute__((ext_vector_type(2)));
typedef float f32x4 __attribute__((ext_vector_type(4)));
typedef float f32x16 __attribute__((ext_vector_type(16)));
typedef unsigned u32x2 __attribute__((ext_vector_type(2)));
typedef unsigned u32x4 __attribute__((ext_vector_type(4)));
typedef int i32x4 __attribute__((ext_vector_type(4)));
typedef GAS unsigned gu32;
#define RLX_AGENT __ATOMIC_RELAXED, __HIP_MEMORY_SCOPE_AGENT

constexpr int NB = 8, SEQ = 4096, T = NB * SEQ, DM = 1024, DEPTH = 4, MEML = 256, DFF = 3584, NE = 8;
constexpr int INW = 4768;
constexpr int PW = 1792;
constexpr int GW = 3072;
constexpr int QBW = 768, KVW = 1024, YW = 1536;
constexpr int NT_IN = 19;
constexpr int P_QA = 0, P_KA = 512, P_VA = 640, P_CQ = 768, P_CKV = 1024, P_KR = 1152, P_QM = 1280;
constexpr int UPK = 256, UPN = 1792;
constexpr int MAXSLOT = 67584;
constexpr int MAXRT = MAXSLOT / 256;
constexpr float EPS = 1e-6f;
constexpr float LOG2E = 1.4426950408889634f;
constexpr float C_A = 0.125f * LOG2E;
constexpr float C_B = 0.10206207261596575f * LOG2E;
constexpr float C_M = 0.08838834764831845f * LOG2E;

constexpr size_t MiB = 1u << 20;
constexpr size_t WS_CTL = 0, CTL_ZERO_BYTES = 1 * MiB;
constexpr size_t WS_MISC = 1 * MiB;
constexpr size_t WL_IN = 0, WL_UP = (size_t)NT_IN * 256 * DM * 2, WL_BR = WL_UP + (size_t)UPN * UPK * 2, WL_OUT = WL_BR + (size_t)3 * DM * 512 * 2, WL_SIZE = WL_OUT + (size_t)DM * DM * 2;
constexpr size_t WS_WMIX = 8 * MiB;
constexpr int TAIL_KS = 4;
constexpr size_t WS_SLAB = WS_WMIX;
constexpr size_t WS_WMKV = WS_WMIX + 4 * ((WL_SIZE + MiB - 1) / MiB) * MiB;
constexpr size_t WL_STRIDE = ((WL_SIZE + MiB - 1) / MiB) * MiB;
constexpr size_t WS_WFFN = WS_WMKV + 8 * MiB;
constexpr size_t WF_GU = 0, WF_D = (size_t)2 * DFF * DM * 2, WF_STRIDE = WF_D + (size_t)DM * DFF * 2;
constexpr size_t WS_H = WS_WFFN + 8 * WF_STRIDE;
constexpr size_t WS_MEMN = WS_H + (size_t)T * DM * 2;
constexpr size_t WS_MEMKV = WS_MEMN + (size_t)NB * MEML * DM * 2;
constexpr size_t WS_R = WS_MEMKV + (size_t)NB * MEML * 4096 * 2;
constexpr size_t R_P = 0, R_G = R_P + (size_t)T * PW * 2, R_QB = R_G + (size_t)T * GW * 2, R_KVB = R_QB + (size_t)T * QBW * 2, R_Y = R_KVB + (size_t)T * KVW * 2, R_END_MIX = R_Y + (size_t)T * YW * 2;
constexpr size_t R_ACT = 0;
constexpr size_t R_ASORT = (size_t)MAXSLOT * DFF * 2;
constexpr size_t R_YOUT = R_ASORT;
constexpr size_t R_END_FFN = R_YOUT + (size_t)MAXSLOT * DM * 2;
constexpr size_t R_SIZE = R_END_MIX > R_END_FFN ? R_END_MIX : R_END_FFN;
constexpr size_t WS_XB = WS_R + R_SIZE;
constexpr size_t WS_END = WS_XB + (size_t)T * DM * 2;
static_assert(WS_END < 1020ull * MiB, "workspace budget");
static_assert((size_t)8 * 4 * TAIL_KS * 256 * 256 * 4 <= 2 * WL_STRIDE, "tail slabs fit two layers' mixer weights");
constexpr size_t MS_TOKE = 0;
constexpr size_t MS_TOKW = MS_TOKE + (size_t)T * 8;
constexpr size_t MS_SLOT = MS_TOKW + (size_t)T * 8;
constexpr size_t MS_CNT = MS_SLOT + (size_t)T * 8;
constexpr size_t MS_TEXP = MS_CNT + 256 * 8 * 4;
constexpr size_t MS_SSQ = MS_TEXP + 2048;
constexpr size_t MS_SNAP = MS_SSQ + (size_t)T * 32;
constexpr size_t MS_HSC = MS_SNAP + 64 * 1024 * 4;
constexpr size_t MS_ASC = MS_HSC + (size_t)T * 4;
constexpr size_t MS_WSIN = MS_ASC + (size_t)MAXSLOT * 4;
constexpr size_t MS_WSGU = MS_WSIN + (size_t)4 * NT_IN * 256 * 4;
constexpr size_t MS_END = MS_WSGU + (size_t)8 * 2 * DFF * 4;
static_assert(MS_END <= 7 * MiB, "misc map");
constexpr int CW_BAR = 4096;
constexpr int CW_DIAG = 16384;
constexpr int CW_CODE = 16384 + 512;

constexpr int RING_BYTES = 131072;
constexpr int LDSCTL_OFF = RING_BYTES;
constexpr int LDS_BYTES = 147456;
constexpr int NWAVES = 8;

#define LDS_WAIT() asm volatile("s_waitcnt lgkmcnt(0)" ::: "memory")
#define VM_WAIT() asm volatile("s_waitcnt vmcnt(0)" ::: "memory")

__device__ __forceinline__ unsigned f2bf(float f) { unsigned u = __builtin_bit_cast(unsigned, f); return (u + 0x7fffu + ((u >> 16) & 1u)) >> 16; }
__device__ __forceinline__ unsigned pk2(float lo, float hi) { return f2bf(lo) | (f2bf(hi) << 16); }
__device__ __forceinline__ float bf2f(unsigned short b) { return __builtin_bit_cast(float, (unsigned)b << 16); }
__device__ __forceinline__ float bflo(unsigned w) { return __builtin_bit_cast(float, w << 16); }
__device__ __forceinline__ float bfhi(unsigned w) { return __builtin_bit_cast(float, w & 0xffff0000u); }
typedef __bf16 bf16x2_t __attribute__((ext_vector_type(2)));
__device__ __forceinline__ unsigned cvtpk(float lo, float hi) { f32x2 v = {lo, hi}; bf16x2_t b = __builtin_convertvector(v, bf16x2_t); return __builtin_bit_cast(unsigned, b); }
__device__ __forceinline__ float wave_sum(float v) {
#pragma unroll
    for (int o = 1; o < 64; o <<= 1) v += __shfl_xor(v, o);
    return v;
}
__device__ __forceinline__ float fast_sigmoid(float x) { return __builtin_amdgcn_rcpf(1.0f + __builtin_amdgcn_exp2f(-x * LOG2E)); }


__device__ __forceinline__ int opq_v(int x) { asm volatile("" : "+v"(x)); return x; }
__device__ __forceinline__ int opq_s(int x) { asm volatile("" : "+s"(x)); return x; }
template <class Tp> __device__ __forceinline__ Tp* opq_p(Tp* p) { const unsigned long long u = (unsigned long long)p; unsigned lo = __builtin_amdgcn_readfirstlane((unsigned)u), hi = __builtin_amdgcn_readfirstlane((unsigned)(u >> 32)); asm volatile("" : "+s"(lo), "+s"(hi)); return (Tp*)(((unsigned long long)hi << 32) | lo); }

__constant__ float IFR_HI[32] = {1.591549367e-01f, 1.193493679e-01f, 8.949939907e-02f, 6.711508334e-02f, 5.032921210e-02f, 3.774158657e-02f, 2.830219641e-02f, 2.122365311e-02f, 1.591549441e-02f, 1.193493698e-02f, 8.949940093e-03f, 6.711508147e-03f, 5.032921210e-03f, 3.774158424e-03f, 2.830219688e-03f, 2.122365171e-03f, 1.591549488e-03f, 1.193493721e-03f, 8.949940093e-04f, 6.711508031e-04f, 5.032921326e-04f, 3.774158540e-04f, 2.830219455e-04f, 2.122365258e-04f, 1.591549371e-04f, 1.193493736e-04f, 8.949940093e-05f, 6.711508468e-05f, 5.032921035e-05f, 3.774158540e-05f, 2.830219637e-05f, 2.122365186e-05f};
__constant__ float IFR_LO[32] = {6.420638243e-09f, 2.294664903e-09f, 2.542919653e-09f, -3.316028840e-10f, 5.173299289e-12f, -1.848551645e-09f, -5.826552019e-10f, -3.431038786e-10f, -1.029942243e-10f, 4.320196978e-11f, 6.802745173e-11f, 1.531042237e-10f, 5.173301024e-13f, 4.797548470e-11f, -1.048316434e-10f, 1.053879969e-10f, -5.686555046e-11f, -1.896286773e-11f, 6.802744999e-12f, 2.695195456e-11f, -1.158979943e-11f, -6.843983713e-12f, 1.279990003e-11f, 1.807650600e-12f, 5.954976963e-12f, -3.351478166e-12f, 6.802745216e-13f, -1.670379113e-12f, 1.751403167e-12f, -6.843983930e-13f, -5.389994549e-13f, 9.083608431e-13f};
__device__ __forceinline__ void rot_cs(float posf, int idx, float& c, float& s) {
    const float ch = IFR_HI[idx], cl = IFR_LO[idx];
    const float p = posf * ch, e = __builtin_fmaf(posf, ch, -p);
    const float fr = __builtin_amdgcn_fractf(p) + (e + posf * cl);
    s = __builtin_amdgcn_sinf(fr); c = __builtin_amdgcn_cosf(fr);
}

#define XB_TMO      128
#define XB_XCNT(j)  (256  + 64 * (j))
#define XB_XSUB(j)  (1280 + 64 * (j))
#define XB_XGEN(j)  (2304 + 64 * (j))
#define XB_TOP      3328
#define XB_TOPGEN   3392
#define XCD_BAR_WORDS 3456
#define XB_SPIN_CAP (1u << 20)

__device__ __forceinline__ unsigned xb_ld(unsigned* p)              { return __hip_atomic_load(p, __ATOMIC_RELAXED, __HIP_MEMORY_SCOPE_AGENT); }
__device__ __forceinline__ unsigned xb_add(unsigned* p, unsigned v) { return __hip_atomic_fetch_add(p, v, __ATOMIC_RELAXED, __HIP_MEMORY_SCOPE_AGENT); }
__device__ __forceinline__ unsigned xb_xcc_id() { return (unsigned)__builtin_amdgcn_s_getreg((3 << 11) | 20) & 0xFu; }
#define XB_SPIN(cond, bar) do { unsigned _sp = 0; while (cond) { __builtin_amdgcn_s_sleep(1); \
    if ((++_sp & 255u) == 0u) { if (xb_ld(&(bar)[XB_TMO])) break; if (_sp > XB_SPIN_CAP) { atomicAdd(&(bar)[XB_TMO], 1u); break; } } } } while (0)

struct XcdBarrier { unsigned* bar; unsigned x; volatile LAS unsigned* st; };

__device__ __forceinline__ XcdBarrier xcd_barrier_post(unsigned* bar, volatile LAS unsigned* st) {
    XcdBarrier b; b.bar = bar; b.x = xb_xcc_id(); b.st = st;
    if (threadIdx.x == 0) (void)xb_add(&bar[XB_XCNT(b.x)], 1u);
    return b;
}
__device__ __forceinline__ void xcd_barrier_complete(unsigned* bar, unsigned x, unsigned& nloc, unsigned& nx) {
    const unsigned G = gridDim.x * gridDim.y * gridDim.z;
    unsigned sum, cnt, mine, sp = 0u;
    for (;;) {
        sum = 0u; cnt = 0u; mine = 0u;
#pragma unroll
        for (unsigned j = 0; j < 16; ++j) { const unsigned c = xb_ld(&bar[XB_XCNT(j)]); sum += c; cnt += (c > 0u) ? 1u : 0u; mine = (j == x) ? c : mine; }
        if (sum == G) break;
        __builtin_amdgcn_s_sleep(1);
        if ((++sp & 255u) == 0u) { if (xb_ld(&bar[XB_TMO])) break; if (sp > XB_SPIN_CAP) { atomicAdd(&bar[XB_TMO], 1u); break; } }
    }
    nloc = mine > 0u ? mine : 1u; nx = cnt > 0u ? cnt : 1u;
}
__device__ __forceinline__ void xcd_barrier(const XcdBarrier& b) {
    asm volatile("s_waitcnt vmcnt(0)" ::: "memory");
    __syncthreads();
    if (threadIdx.x == 0) {
        unsigned* bar = b.bar;
        __builtin_amdgcn_s_waitcnt(0);
        unsigned nloc = b.st[0], nx = b.st[1];
        if (nloc == 0u) { xcd_barrier_complete(bar, b.x, nloc, nx); b.st[0] = nloc; b.st[1] = nx; }
        const unsigned old = xb_add(&bar[XB_XSUB(b.x)], 1u);
        const unsigned gen = old / nloc;
        if (old + 1u == (gen + 1u) * nloc) {
            __builtin_amdgcn_fence(__ATOMIC_RELEASE, "agent");
            asm volatile("s_waitcnt vmcnt(0)" ::: "memory");
            const unsigned og = xb_add(&bar[XB_TOP], 1u);
            const unsigned tg = og / nx;
            if (og + 1u == (tg + 1u) * nx) xb_add(&bar[XB_TOPGEN], 1u);
            else XB_SPIN(xb_ld(&bar[XB_TOPGEN]) == tg, bar);
            __builtin_amdgcn_fence(__ATOMIC_ACQUIRE, "agent");
            xb_add(&bar[XB_XGEN(b.x)], 1u);
            asm volatile("s_waitcnt vmcnt(0)" ::: "memory");
        } else {
            XB_SPIN(xb_ld(&bar[XB_XGEN(b.x)]) == gen, bar);
            __builtin_amdgcn_fence(__ATOMIC_ACQUIRE, "agent");
            asm volatile("s_waitcnt vmcnt(0)" ::: "memory");
        }
    }
    __syncthreads();
}

namespace pg8 {
constexpr int BM = 256, BK = 64, HALF = 128, HTB = HALF * BK * 2, STAGE_BYTES = 8 * HTB, NXCD = 8, WGM = 4;
constexpr int ESC_OFF = 131072 + 4096, ESC_SLOT = 3072;
__host__ __device__ __forceinline__ int lds_byte(int r, int c) { const int st = (r >> 4) * 2 + (c >> 5), rr = r & 15, cc = c & 31, ob = rr * 64 + cc * 2; return st * 1024 + (ob ^ (((ob >> 9) & 1) << 5)); }
__host__ __device__ __forceinline__ void stage_rc(int b, int& R, int& C) { const int st = b / 1024, sb = b % 1024, swz = sb ^ (((sb >> 9) & 1) << 5); R = (st >> 1) * 16 + swz / 64; C = (st & 1) * 32 + (swz % 64) / 2; }

struct Unit { int pm, pn, aux; };

struct StaticOrder {
    int nM, nN, nwg, G, c, rev, wgm;
    __device__ void init(int nM_, int nN_, int G_, int c_, int rev_ = 0, int wgm_ = WGM) { nM = nM_; nN = nN_; nwg = nM * nN; G = G_; c = c_; rev = rev_; wgm = wgm_; }
    __device__ bool next(int i, Unit& u) const {
        const long L = (long)i * G + c; if (L >= nwg) return false;
        int wgid = (int)L; { const int q = nwg / NXCD, r = nwg % NXCD, xcd = wgid % NXCD, off = wgid / NXCD; wgid = (xcd < r ? xcd * (q + 1) : r * (q + 1) + (xcd - r) * q) + off; }
        const int nig = wgm * nN, gid = wgid / nig, fm = gid * wgm, gsz = (nM - fm) < wgm ? (nM - fm) : wgm;
        u.pm = fm + ((wgid % nig) % gsz); u.pn = (wgid % nig) / gsz; u.aux = 0; if (rev) u.pm = nM - 1 - u.pm; return true;
    }
};

template <bool I8> struct AccVec { typedef f32x4 type; };
template <> struct AccVec<true> { typedef i32x4 type; };
template <bool I8 = false, class Prob, class Sched, class Epi>
__device__ __forceinline__ void gemm_phase(LAS unsigned char* lds, const Prob& P, const Sched& S, const Epi& E) {
    const int tid = opq_v((int)threadIdx.x), wid = __builtin_amdgcn_readfirstlane(tid >> 6), lane = tid & 63, wr = wid >> 2, wc = wid & 3, fr = lane & 15, fq = lane >> 4;
    typedef typename AccVec<I8>::type accv_t;
    const int K = P.K, nt = K / (I8 ? 2 * BK : BK);
    unsigned voffA[2], voffB[2];
#pragma unroll
    for (int i = 0; i < 2; ++i) { int R, C; stage_rc(tid * 16 + i * 8192, R, C); voffA[i] = (unsigned)R * P.lda + (unsigned)C * 2u; voffB[i] = (unsigned)R * P.ldb + (unsigned)C * 2u; }
    const size_t kstep = (size_t)(BK * 2);
    const size_t hstepA = (size_t)HALF * P.lda, hstepB = (size_t)HALF * P.ldb;
    const unsigned ldsw = (unsigned)wid * 1024u;
    const int aoff = lds_byte(wr * 64 + fr, fq * 8), boff = lds_byte(wc * 32 + fr, fq * 8);
#define PG8_SA(b, h) (((b) * 2 + (h)) * HTB)
#define PG8_SB(b, h) ((4 + (b) * 2 + (h)) * HTB)
#define PG8_STAGE(bufoff, gbase, voff) do { _Pragma("unroll") for (int _i = 0; _i < 2; ++_i) \
        __builtin_amdgcn_global_load_lds((const unsigned*)((const char*)(gbase) + (voff)[_i]), (LAS unsigned*)(lds + (bufoff) + ldsw + _i * 8192), 16, 0, 0); } while (0)
#define PG8_LDA(dst, b, h) do { _Pragma("unroll") for (int m = 0; m < 4; ++m) _Pragma("unroll") for (int k = 0; k < 2; ++k) dst[m][k] = *(const LAS bf16x8*)(lds + PG8_SA(b, h) + aoff + m * 2048 + k * 1024); } while (0)
#define PG8_LDB(dst, b, h) do { _Pragma("unroll") for (int n = 0; n < 2; ++n) _Pragma("unroll") for (int k = 0; k < 2; ++k) dst[n][k] = *(const LAS bf16x8*)(lds + PG8_SB(b, h) + boff + n * 2048 + k * 1024); } while (0)
#define PG8_MMA(ai, bj, At, Bt) do { __builtin_amdgcn_s_setprio(1); _Pragma("unroll") for (int m = 0; m < 4; ++m) _Pragma("unroll") for (int n = 0; n < 2; ++n) _Pragma("unroll") for (int k = 0; k < 2; ++k) \
        { if constexpr (I8) acc[ai][bj][m][n] = __builtin_amdgcn_mfma_i32_16x16x64_i8(__builtin_bit_cast(i32x4, Bt[n][k]), __builtin_bit_cast(i32x4, At[m][k]), acc[ai][bj][m][n], 0, 0, 0); \
          else acc[ai][bj][m][n] = __builtin_amdgcn_mfma_f32_16x16x32_bf16(Bt[n][k], At[m][k], acc[ai][bj][m][n], 0, 0, 0); } __builtin_amdgcn_s_setprio(0); } while (0)
#define PG8_WAIT_V(n) asm volatile("s_waitcnt vmcnt(" #n ")" ::: "memory")
#define PG8_WAIT_L(n) asm volatile("s_waitcnt lgkmcnt(" #n ")" ::: "memory")
#define PG8_BAR __builtin_amdgcn_s_barrier()
#define PG8_SCHED __builtin_amdgcn_sched_barrier(0)
    Unit cur, nxt; int ui = 0;
    if (!S.next(0, cur)) return;
    accv_t acc[2][2][4][2];
#pragma unroll
    for (int a = 0; a < 2; ++a)
#pragma unroll
        for (int b = 0; b < 2; ++b)
#pragma unroll
            for (int m = 0; m < 4; ++m)
#pragma unroll
                for (int n = 0; n < 2; ++n) acc[a][b][m][n] = accv_t{};
    bf16x8 At[4][2], B0[2][2], B1[2][2];
    const char* cA = P.a_ptr(cur); const char* cB = P.b_ptr(cur);
    int eslot = 0;
    E.stage(lds + ESC_OFF, cur, wid, lane);
    PG8_STAGE(PG8_SB(0, 0), cB, voffB); PG8_STAGE(PG8_SB(0, 1), cB + hstepB, voffB); PG8_STAGE(PG8_SA(0, 0), cA, voffA); PG8_STAGE(PG8_SA(0, 1), cA + hstepA, voffA);
    if (wr == 1) PG8_BAR;
    PG8_WAIT_V(2); PG8_BAR;
    PG8_STAGE(PG8_SB(1, 0), cB + kstep, voffB); PG8_STAGE(PG8_SA(1, 0), cA + kstep, voffA); PG8_STAGE(PG8_SB(1, 1), cB + hstepB + kstep, voffB);
    PG8_WAIT_V(6); PG8_BAR;
    for (;;) {
        const bool has_next = S.next(ui + 1, nxt);
        const char* nA = has_next ? P.a_ptr(nxt) : cA; const char* nB = has_next ? P.b_ptr(nxt) : cB;
        for (int t = 0; t < nt; t += 2) {
            if constexpr (Epi::MID) { if (t == 8 || t == 16) E.mid(acc, cur, t >> 3, wr, wc, fr, fq); }
            const bool last = (t == nt - 2);
            if (last && has_next) E.stage(lds + ESC_OFF + (eslot ^ 1) * ESC_SLOT, nxt, wid, lane);
            const char* a1 = cA + (size_t)(t + 1) * kstep;
            const char* a2 = last ? nA : cA + (size_t)(t + 2) * kstep; const char* b2 = last ? nB : cB + (size_t)(t + 2) * kstep;
            const char* a3 = a2 + kstep; const char* b3 = b2 + kstep;
            PG8_LDB(B0, 0, 0); PG8_LDB(B1, 0, 1); PG8_SCHED; PG8_LDA(At, 0, 0); PG8_STAGE(PG8_SA(1, 1), a1 + hstepA, voffA);
            PG8_WAIT_V(8); PG8_WAIT_L(0); PG8_BAR; PG8_MMA(0, 0, At, B0); PG8_MMA(0, 1, At, B1); PG8_BAR; PG8_SCHED;
            PG8_LDA(At, 0, 1); PG8_STAGE(PG8_SB(0, 0), b2, voffB); PG8_STAGE(PG8_SB(0, 1), b2 + hstepB, voffB); PG8_STAGE(PG8_SA(0, 0), a2, voffA);
            PG8_WAIT_V(8); PG8_WAIT_L(0); PG8_BAR; PG8_MMA(1, 0, At, B0); PG8_MMA(1, 1, At, B1); PG8_BAR; PG8_SCHED;
            PG8_LDB(B0, 1, 0); PG8_LDB(B1, 1, 1); PG8_SCHED; PG8_LDA(At, 1, 0); PG8_STAGE(PG8_SA(0, 1), a2 + hstepA, voffA);
            PG8_WAIT_V(8); PG8_WAIT_L(0); PG8_BAR; PG8_MMA(0, 0, At, B0); PG8_MMA(0, 1, At, B1); PG8_BAR; PG8_SCHED;
            PG8_LDA(At, 1, 1); PG8_STAGE(PG8_SB(1, 0), b3, voffB); PG8_STAGE(PG8_SB(1, 1), b3 + hstepB, voffB); PG8_STAGE(PG8_SA(1, 0), a3, voffA);
            PG8_WAIT_V(8); PG8_WAIT_L(0); PG8_BAR; PG8_MMA(1, 0, At, B0); PG8_MMA(1, 1, At, B1); PG8_BAR; PG8_SCHED;
        }
        if (wr == 0) PG8_BAR;
        E(acc, cur, wr, wc, fr, fq, lds + ESC_OFF + eslot * ESC_SLOT);
        if (!has_next) break;
#pragma unroll
        for (int a = 0; a < 2; ++a)
#pragma unroll
            for (int b = 0; b < 2; ++b)
#pragma unroll
                for (int m = 0; m < 4; ++m)
#pragma unroll
                    for (int n = 0; n < 2; ++n) acc[a][b][m][n] = accv_t{};
        cur = nxt; cA = nA; cB = nB; ++ui; eslot ^= 1;
        if (wr == 1) PG8_BAR;
    }
    PG8_WAIT_V(0);
    PG8_BAR;
#undef PG8_SA
#undef PG8_SB
#undef PG8_STAGE
#undef PG8_LDA
#undef PG8_LDB
#undef PG8_MMA
#undef PG8_WAIT_V
#undef PG8_WAIT_L
#undef PG8_BAR
#undef PG8_SCHED
}
}

struct Frame {
    LAS unsigned char* lds;
    volatile LAS unsigned* MISC;
    gu32* ctl;
    unsigned char* ws;
    int tid, lane, wave, vcu, G;
    const float* const* in; float* out;
};
enum { I_X = 0, I_MEM, I_POS, I_GMIX, I_WIN, I_GQ, I_WUQ, I_GKV, I_WUKV, I_SINK, I_WMKV, I_WBR, I_WOUT, I_GFFN, I_WGD, I_WUD, I_WDD, I_WR, I_WGE, I_WUE, I_WDE, I_GMEM, I_GFIN };

__device__ __forceinline__ int sem_plain(int g) { return (g & ~31) + 8 * ((g >> 2) & 3) + 4 * ((g >> 4) & 1) + (g & 3); }
__device__ __forceinline__ int sem_rot64(int g) { return (g & ~63) + 32 * ((g >> 4) & 1) + 16 * ((g >> 5) & 1) + 4 * ((g >> 2) & 3) + (g & 3); }
__device__ __forceinline__ int sem_p16(int g) { const int c = g & 255; return (g & ~255) + 64 * ((c >> 5) & 3) + 16 * ((c >> 2) & 3) + 8 * (c >> 7) + 4 * ((c >> 4) & 1) + (c & 3); }
__device__ __forceinline__ int inproj_src(int n) {
    const int pn = n >> 8, c = n & 255;
    if (pn < 2) return pn * 256 + sem_rot64(c);
    if (pn == 2) return c < 128 ? 512 + sem_rot64(c) : 640 + sem_plain(c - 128);
    if (pn == 3) return 768 + sem_plain(c);
    if (pn == 4) return c < 128 ? 1024 + sem_plain(c) : (c < 160 ? 1152 + (c - 128) : -1);
    if (pn < 7) return 1184 + (pn - 5) * 256 + sem_plain(c);
    return 1696 + (pn - 7) * 256 + sem_p16(c);
}

struct MapInproj { const float* W; __device__ __forceinline__ float load(int k, int n) const { const int s = inproj_src(n); return s >= 0 ? W[(size_t)k * INW + s] : 0.f; }
    __device__ __forceinline__ f32x4 load4(int k, int n) const { const int s = inproj_src(n); return s >= 0 ? *(const f32x4*)(W + (size_t)k * INW + s) : (f32x4){0.f, 0.f, 0.f, 0.f}; } };
struct MapUp { const float *Wq, *Wkv, *gq, *gkv;
    __device__ __forceinline__ f32x4 load4(int k, int n) const {
        if (n < 768) { const int gg = n >> 5; const int s = (gg % 3 == 2) ? n : sem_plain(n); return *(const f32x4*)(Wq + (size_t)k * 768 + s) * gq[k]; }
        if (k < 128) return (f32x4){0.f, 0.f, 0.f, 0.f}; const int s = sem_plain(n - 768); return *(const f32x4*)(Wkv + (size_t)(k - 128) * 1024 + s) * gkv[k - 128]; }
    __device__ __forceinline__ float load(int k, int n) const {
        if (n < 768) { const int gg = n >> 5; const int s = (gg % 3 == 2) ? n : sem_plain(n); return gq[k] * Wq[(size_t)k * 768 + s]; }
        if (k < 128) return 0.f; const int s = sem_plain(n - 768); return gkv[k - 128] * Wkv[(size_t)(k - 128) * 1024 + s]; } };
struct MapPlain { const float* W; int ldw; __device__ __forceinline__ float load(int k, int n) const { return W[(size_t)k * ldw + sem_plain(n)]; }
    __device__ __forceinline__ f32x4 load4(int k, int n) const { return *(const f32x4*)(W + (size_t)k * ldw + sem_plain(n)); } };
struct MapNat { const float* W; int ldw; __device__ __forceinline__ float load(int k, int n) const { return W[(size_t)k * ldw + n]; }
    __device__ __forceinline__ f32x4 load4(int k, int n) const { return *(const f32x4*)(W + (size_t)k * ldw + n); } };
struct MapBr { const float* W;
    __device__ __forceinline__ float load(int k, int n) const { return W[(size_t)k * DM + sem_p16(n)]; }
    __device__ __forceinline__ f32x4 load4(int k, int n) const { return *(const f32x4*)(W + (size_t)k * DM + sem_p16(n)); } };
struct MapMemkv { const float* W; __device__ __forceinline__ float load(int k, int n) const { const int l = n >> 10, c = n & 1023; return W[((size_t)l * DM + k) * 1024 + sem_plain(c)]; }
    __device__ __forceinline__ f32x4 load4(int k, int n) const { const int l = n >> 10, c = n & 1023; return *(const f32x4*)(W + ((size_t)l * DM + k) * 1024 + sem_plain(c)); } };
struct MapGU { const float *Wg, *Wu; __device__ __forceinline__ float load(int k, int n) const { const int pn = n >> 8, c = n & 255; const int ch = 128 * pn + sem_plain(c & 127);
    const unsigned long long a = (unsigned long long)Wg, b = (unsigned long long)Wu, w = a ^ ((a ^ b) & (0ull - (unsigned long long)(c >> 7))); return ((const float*)w)[(size_t)k * DFF + ch]; }
    __device__ __forceinline__ f32x4 load4(int k, int n) const { const int pn = n >> 8, c = n & 255; const int ch = 128 * pn + sem_plain(c & 127);
        const unsigned long long a = (unsigned long long)Wg, b = (unsigned long long)Wu, w = a ^ ((a ^ b) & (0ull - (unsigned long long)(c >> 7))); return *(const f32x4*)((const float*)w + (size_t)k * DFF + ch); } };

template <class M> __device__ __forceinline__ void prep_item(const M& m, bf16_t* dst, int Kd, int nblk, LAS float* scr, int item, int lane) {
    const int kb = item / nblk, nb = item % nblk, k0 = 64 * kb, n0 = 32 * nb;
#pragma unroll 8
    for (int i = 0; i < 32; ++i) { const int kk = 2 * i + (lane >> 5); scr[kk * 33 + (lane & 31)] = m.load(k0 + kk, n0 + (lane & 31)); }
    LDS_WAIT(); asm volatile("" ::: "memory");
    const int c = lane & 7;
#pragma unroll
    for (int j = 0; j < 4; ++j) { const int n = (lane >> 3) + 8 * j; const LAS float* s = scr + (8 * c) * 33 + n;
        u32x4 o; o.x = pk2(s[0 * 33], s[1 * 33]); o.y = pk2(s[2 * 33], s[3 * 33]); o.z = pk2(s[4 * 33], s[5 * 33]); o.w = pk2(s[6 * 33], s[7 * 33]);
        *(u32x4*)(dst + (size_t)(n0 + n) * Kd + k0 + 8 * c) = o; }
    LDS_WAIT(); asm volatile("" ::: "memory");
}
template <class M> __device__ __forceinline__ void prep_tile(const M& m, bf16_t* dst, int Kd, int nblk, LAS unsigned char* tile, int item, int lane) {
    const int kb = item / nblk, nb = item % nblk, k0 = 128 * kb, n0 = 32 * nb, ng = lane & 7, kr = lane >> 3;
    f32x4 v[16];
#pragma unroll
    for (int i = 0; i < 16; ++i) v[i] = m.load4(k0 + 8 * i + kr, n0 + 4 * ng);
#pragma unroll
    for (int i = 0; i < 16; ++i)
#pragma unroll
        for (int c = 0; c < 4; ++c) *(LAS unsigned short*)(tile + (4 * ng + c) * 272 + (8 * i + kr) * 2) = (unsigned short)f2bf(v[i][c]);
    LDS_WAIT(); asm volatile("" ::: "memory");
#pragma unroll
    for (int j = 0; j < 8; ++j) { const int p = lane + 64 * j, n = p >> 4, kc = p & 15;
        *(u32x4*)(dst + (size_t)(n0 + n) * Kd + k0 + 8 * kc) = *(const LAS u32x4*)(tile + n * 272 + 16 * kc); }
    LDS_WAIT(); asm volatile("" ::: "memory");
}
template <class M> __device__ __forceinline__ void prep_matrix(Frame& F, const M& m, bf16_t* dst, int N, int K) {
    LAS unsigned char* tile = F.lds + F.wave * 16384;
    const int gw = F.vcu * NWAVES + F.wave, NGW = F.G * NWAVES, nblk = N / 32, nitems = (K / 128) * nblk;
    for (int it = gw; it < nitems; it += NGW) prep_tile(m, dst, K, nblk, tile, it, F.lane);
}

template <class M> __device__ __forceinline__ void prep_strip_i8(Frame& F, const M& m, signed char* dst, float* scl, int strip) {
    const int lane = F.lane, w = F.wave, n0 = strip * 32, k0 = w * 128, ng = lane & 7, kr = lane >> 3;
    LAS unsigned char* tile = F.lds + w * 16384;
    LAS float* amt = (LAS float*)(F.lds + LDSCTL_OFF + 2048);
    f32x4 v[16];
#pragma unroll
    for (int i = 0; i < 16; ++i) v[i] = m.load4(k0 + 8 * i + kr, n0 + 4 * ng);
    f32x4 am = __builtin_elementwise_abs(v[0]);
#pragma unroll
    for (int i = 1; i < 16; ++i) am = __builtin_elementwise_max(am, __builtin_elementwise_abs(v[i]));
#pragma unroll
    for (int c = 0; c < 4; ++c) { float a = am[c]; a = fmaxf(a, __shfl_xor(a, 8)); a = fmaxf(a, __shfl_xor(a, 16)); a = fmaxf(a, __shfl_xor(a, 32)); am[c] = a; }
    if (kr == 0) *(LAS f32x4*)(amt + w * 32 + 4 * ng) = am;
    __syncthreads();
    f32x4 cm = *(const LAS f32x4*)(amt + 4 * ng);
#pragma unroll
    for (int ww = 1; ww < 8; ++ww) cm = __builtin_elementwise_max(cm, *(const LAS f32x4*)(amt + ww * 32 + 4 * ng));
    f32x4 inv;
#pragma unroll
    for (int c = 0; c < 4; ++c) inv[c] = cm[c] > 0.f ? 127.0f / cm[c] : 0.f;
    if (w == 0 && kr == 0) *(f32x4*)(scl + n0 + 4 * ng) = cm * (1.0f / 127.0f);
#pragma unroll
    for (int i = 0; i < 16; ++i)
#pragma unroll
        for (int c = 0; c < 4; ++c) tile[(4 * ng + c) * 144 + 8 * i + kr] = (unsigned char)(signed char)__float2int_rn(v[i][c] * inv[c]);
    LDS_WAIT(); asm volatile("" ::: "memory");
#pragma unroll
    for (int j = 0; j < 4; ++j) { const int p = lane + 64 * j, n = p >> 3, kc = p & 7;
        *(u32x4*)(dst + (size_t)(n0 + n) * DM + k0 + 16 * kc) = *(const LAS u32x4*)(tile + n * 144 + 16 * kc); }
    LDS_WAIT();
    __syncthreads();
}
__device__ __forceinline__ bf16_t* wmix(Frame& F, int l, size_t off) { return (bf16_t*)(F.ws + WS_WMIX + (size_t)l * WL_STRIDE + off); }

__device__ __forceinline__ void prep_mixer_weights(Frame& F) {
    for (int l = 0; l < DEPTH; ++l) {
        { MapInproj m{F.in[I_WIN] + (size_t)l * DM * INW}; for (int s = F.vcu; s < NT_IN * 8; s += F.G) prep_strip_i8(F, m, (signed char*)wmix(F, l, WL_IN), (float*)(F.ws + WS_MISC + MS_WSIN) + l * NT_IN * 256, s); }
        { MapUp m{F.in[I_WUQ] + (size_t)l * 256 * 768, F.in[I_WUKV] + (size_t)l * 128 * 1024, F.in[I_GQ] + l * 256, F.in[I_GKV] + l * 128}; prep_matrix(F, m, wmix(F, l, WL_UP), UPN, UPK); }
        { MapBr m{F.in[I_WBR] + (size_t)l * 3 * 512 * DM}; prep_matrix(F, m, wmix(F, l, WL_BR), DM, 1536); }
        { MapPlain m{F.in[I_WOUT] + (size_t)l * DM * DM, DM}; prep_matrix(F, m, wmix(F, l, WL_OUT), DM, DM); }
    }
    { MapMemkv m{F.in[I_WMKV]}; prep_matrix(F, m, (bf16_t*)(F.ws + WS_WMKV), 4096, DM); }
}
__device__ __forceinline__ void prep_ffn_weights(Frame& F, int l) {
    const int i = l >> 1; const bool moe = (l & 1) != 0;
    LAS float* scr = (LAS float*)(F.lds + F.wave * 16384);
    const int gw = F.vcu * NWAVES + F.wave, NGW = F.G * NWAVES;
    constexpr int IGU = (DM / 64) * (2 * DFF / 32), ID = (DFF / 64) * (DM / 32), NSTRIP = 2 * DFF / 32;
    const int ne = moe ? NE : 1;
    const float* Wg = moe ? F.in[I_WGE] : F.in[I_WGD]; const float* Wu = moe ? F.in[I_WUE] : F.in[I_WUD]; const float* Wd = moe ? F.in[I_WDE] : F.in[I_WDD];
    if (GU_I8(l)) {
        for (int s = F.vcu; s < ne * NSTRIP; s += F.G) { const int e = s / NSTRIP, ss = s % NSTRIP; const size_t eo = ((size_t)i * ne + e) * DM * DFF;
            MapGU m{Wg + eo, Wu + eo}; prep_strip_i8(F, m, (signed char*)(F.ws + WS_WFFN + (size_t)e * WF_STRIDE), (float*)(F.ws + WS_MISC + MS_WSGU) + e * 2 * DFF, ss); }
    } else {
        for (int it = gw; it < ne * IGU; it += NGW) { const int e = it / IGU, r = it % IGU; const size_t eo = ((size_t)i * ne + e) * DM * DFF;
            MapGU m{Wg + eo, Wu + eo}; prep_item(m, (bf16_t*)(F.ws + WS_WFFN + (size_t)e * WF_STRIDE), DM, 2 * DFF / 32, scr, r, F.lane); }
    }
    constexpr int IDT = (DFF / 128) * (DM / 32);
    for (int it = gw; it < ne * IDT; it += NGW) { const int e = it / IDT, r = it % IDT; const size_t eo = ((size_t)i * ne + e) * DM * DFF;
        MapPlain m{Wd + eo, DM}; prep_tile(m, (bf16_t*)(F.ws + WS_WFFN + (size_t)e * WF_STRIDE + WF_D), DFF, DM / 32, F.lds + F.wave * 16384, r, F.lane); }
}

struct RowV { f32x4 v[4]; };
__device__ __forceinline__ void row_load(RowV& r, const float* p, int lane) { const f32x4* x = (const f32x4*)p + lane;
#pragma unroll
    for (int j = 0; j < 4; ++j) r.v[j] = x[64 * j]; }
__device__ __forceinline__ void row_store(const RowV& r, float* p, int lane) { f32x4* x = (f32x4*)p + lane;
#pragma unroll
    for (int j = 0; j < 4; ++j) x[64 * j] = r.v[j]; }
__device__ __forceinline__ void row_add_bf16(RowV& r, const bf16_t* p, float w, int lane) { const u32x2* x = (const u32x2*)p + lane;
#pragma unroll
    for (int j = 0; j < 4; ++j) { const u32x2 q = x[64 * j]; r.v[j].x += w * bflo(q.x); r.v[j].y += w * bfhi(q.x); r.v[j].z += w * bflo(q.y); r.v[j].w += w * bfhi(q.y); } }
__device__ __forceinline__ void row_load_bf16(RowV& r, const bf16_t* p, int lane) { const u32x2* x = (const u32x2*)p + lane;
#pragma unroll
    for (int j = 0; j < 4; ++j) { const u32x2 q = x[64 * j]; r.v[j].x = bflo(q.x); r.v[j].y = bfhi(q.x); r.v[j].z = bflo(q.y); r.v[j].w = bfhi(q.y); } }
__device__ __forceinline__ void row_round_bf16(RowV& r) {
#pragma unroll
    for (int j = 0; j < 4; ++j) { r.v[j].x = bf2f((unsigned short)f2bf(r.v[j].x)); r.v[j].y = bf2f((unsigned short)f2bf(r.v[j].y)); r.v[j].z = bf2f((unsigned short)f2bf(r.v[j].z)); r.v[j].w = bf2f((unsigned short)f2bf(r.v[j].w)); } }
__device__ __forceinline__ float row_rstd(const RowV& r) { float s = 0.f;
#pragma unroll
    for (int j = 0; j < 4; ++j) s += (r.v[j].x * r.v[j].x + r.v[j].y * r.v[j].y) + (r.v[j].z * r.v[j].z + r.v[j].w * r.v[j].w);
    return 1.0f / sqrtf(wave_sum(s) * (1.0f / DM) + EPS); }
__device__ __forceinline__ void row_scale(RowV& r, float rstd, const float* g, int lane) { const f32x4* gg = (const f32x4*)g + lane;
#pragma unroll
    for (int j = 0; j < 4; ++j) r.v[j] = r.v[j] * rstd * gg[64 * j]; }
__device__ __forceinline__ void row_store_bf16(const RowV& r, bf16_t* p, int lane) { u32x2* o = (u32x2*)p + lane;
#pragma unroll
    for (int j = 0; j < 4; ++j) { u32x2 w; w.x = pk2(r.v[j].x, r.v[j].y); w.y = pk2(r.v[j].z, r.v[j].w); o[64 * j] = w; } }

__device__ __forceinline__ float row_store_i8(const RowV& r, signed char* p, int lane) {
    float am = 0.f;
#pragma unroll
    for (int j = 0; j < 4; ++j) am = fmaxf(am, fmaxf(fmaxf(fabsf(r.v[j].x), fabsf(r.v[j].y)), fmaxf(fabsf(r.v[j].z), fabsf(r.v[j].w))));
#pragma unroll
    for (int o = 1; o < 64; o <<= 1) am = fmaxf(am, __shfl_xor(am, o));
    const float inv = am > 0.f ? 127.0f / am : 0.f; unsigned* o4 = (unsigned*)p + lane;
#pragma unroll
    for (int j = 0; j < 4; ++j) { const unsigned a = (unsigned)__float2int_rn(r.v[j].x * inv) & 255u, b = (unsigned)__float2int_rn(r.v[j].y * inv) & 255u, c = (unsigned)__float2int_rn(r.v[j].z * inv) & 255u, d = (unsigned)__float2int_rn(r.v[j].w * inv) & 255u;
        o4[64 * j] = a | (b << 8) | (c << 16) | (d << 24); }
    return am * (1.0f / 127.0f);
}
__device__ __forceinline__ void row_add_slot(Frame& F, RowV& r, int s, float w, int lane) {
    if ((s >> 8) < 256) { row_add_bf16(r, (const bf16_t*)(F.ws + WS_R + R_YOUT) + (size_t)s * DM, w, lane); return; }
    const float* slab = (const float*)(F.ws + WS_SLAB) + (size_t)((s >> 8) - 256) * 4 * TAIL_KS * 65536 + (size_t)(s & 255) * 256 + 4 * lane;
#pragma unroll
    for (int j = 0; j < 4; ++j)
#pragma unroll
        for (int ks = 0; ks < TAIL_KS; ++ks) r.v[j] += *(const f32x4*)(slab + (size_t)(j * TAIL_KS + ks) * 65536) * w;
}
__device__ __forceinline__ void row_combine(Frame& F, RowV& r, int t) {
    const int* sl = (const int*)(F.ws + WS_MISC + MS_SLOT) + 2 * t; const float* tw = (const float*)(F.ws + WS_MISC + MS_TOKW) + 2 * t;
    const int s0 = __builtin_amdgcn_readfirstlane(sl[0]), s1 = __builtin_amdgcn_readfirstlane(sl[1]); const float w0 = tw[0], w1 = tw[1];
    row_add_slot(F, r, s0, w0, F.lane); row_add_slot(F, r, s1, w1, F.lane);
}

__device__ __forceinline__ void norm_phase(Frame& F, const float* srcf, bf16_t* X, const float* g, bool combine, bool out_i8) {
    bf16_t* H = (bf16_t*)(F.ws + WS_H); signed char* Hq = (signed char*)(F.ws + WS_H); float* hsc = (float*)(F.ws + WS_MISC + MS_HSC);
    const int gw = F.vcu * NWAVES + F.wave, NGW = F.G * NWAVES;
    for (int t = gw; t < T; t += 2 * NGW) {
        const int t2 = (t + NGW < T) ? t + NGW : t;
        RowV r, q;
        if (srcf) { row_load(r, srcf + (size_t)t * DM, F.lane); row_load(q, srcf + (size_t)t2 * DM, F.lane); }
        else { row_load_bf16(r, X + (size_t)t * DM, F.lane); row_load_bf16(q, X + (size_t)t2 * DM, F.lane); }
        if (combine) { row_combine(F, r, t); row_combine(F, q, t2); row_store_bf16(r, X + (size_t)t * DM, F.lane); row_store_bf16(q, X + (size_t)t2 * DM, F.lane);
            row_round_bf16(r); row_round_bf16(q); }
        const float rstd = row_rstd(r), qstd = row_rstd(q); row_scale(r, rstd, g, F.lane); row_scale(q, qstd, g, F.lane);
        if (out_i8) { const float sc = row_store_i8(r, Hq + (size_t)t * DM, F.lane), sq = row_store_i8(q, Hq + (size_t)t2 * DM, F.lane); if (F.lane == 0) { hsc[t] = sc; hsc[t2] = sq; } }
        else { row_store_bf16(r, H + (size_t)t * DM, F.lane); row_store_bf16(q, H + (size_t)t2 * DM, F.lane); }
    }
}
__device__ __forceinline__ void final_norm_phase(Frame& F, const bf16_t* X, float* out, const float* g, bool combine) {
    const int gw = F.vcu * NWAVES + F.wave, NGW = F.G * NWAVES;
    for (int t = gw; t < T; t += 2 * NGW) {
        const int t2 = (t + NGW < T) ? t + NGW : t;
        RowV r, q; row_load_bf16(r, X + (size_t)t * DM, F.lane); row_load_bf16(q, X + (size_t)t2 * DM, F.lane);
        if (combine) { row_combine(F, r, t); row_combine(F, q, t2); }
        const float rstd = row_rstd(r), qstd = row_rstd(q); row_scale(r, rstd, g, F.lane); row_scale(q, qstd, g, F.lane);
        row_store(r, out + (size_t)t * DM, F.lane); row_store(q, out + (size_t)t2 * DM, F.lane);
    }
}
__device__ __forceinline__ void memnorm_phase(Frame& F) {
    bf16_t* MN = (bf16_t*)(F.ws + WS_MEMN);
    const int gw = F.vcu * NWAVES + F.wave, NGW = F.G * NWAVES;
    for (int t = gw; t < NB * MEML; t += NGW) {
        RowV r; row_load(r, F.in[I_MEM] + (size_t)t * DM, F.lane);
        const float rstd = row_rstd(r); row_scale(r, rstd, F.in[I_GMEM], F.lane);
        row_store_bf16(r, MN + (size_t)t * DM, F.lane);
    }
}

__device__ __forceinline__ void norm_router_phase(Frame& F, const bf16_t* X, const float* g, const float* Wr  , bool out_i8) {
    bf16_t* H = (bf16_t*)(F.ws + WS_H); signed char* Hq = (signed char*)(F.ws + WS_H); float* hsc = (float*)(F.ws + WS_MISC + MS_HSC);
    int* toke = (int*)(F.ws + WS_MISC + MS_TOKE); float* tokw = (float*)(F.ws + WS_MISC + MS_TOKW); int* cntg = (int*)(F.ws + WS_MISC + MS_CNT);
    volatile LAS int* hist = (volatile LAS int*)(F.lds + LDSCTL_OFF + 1024);
    f32x4 wa[4][4], wb[4][4];
#pragma unroll
    for (int j = 0; j < 4; ++j)
#pragma unroll
        for (int k = 0; k < 4; ++k) { const int d = 256 * j + 4 * F.lane + k; wa[j][k] = *(const f32x4*)(Wr + (size_t)d * 8); wb[j][k] = *(const f32x4*)(Wr + (size_t)d * 8 + 4); }
    const bool up32 = (F.lane & 32) != 0, up16 = (F.lane & 16) != 0, up8 = (F.lane & 8) != 0;
    for (int c = F.vcu; c < T / 128; c += F.G) {
        if (F.tid < 8) hist[F.tid] = 0;
        __syncthreads();
        for (int q = 0; q < 16; ++q) {
            const int t = c * 128 + F.wave * 16 + q;
            RowV r; row_load_bf16(r, X + (size_t)t * DM, F.lane);
            const float rstd = row_rstd(r); row_scale(r, rstd, g, F.lane);
            if (out_i8) { const float sc = row_store_i8(r, Hq + (size_t)t * DM, F.lane); if (F.lane == 0) hsc[t] = sc; }
            else row_store_bf16(r, H + (size_t)t * DM, F.lane);
            f32x4 la = {0.f, 0.f, 0.f, 0.f}, lb = {0.f, 0.f, 0.f, 0.f};
#pragma unroll
            for (int j = 0; j < 4; ++j)
#pragma unroll
                for (int k = 0; k < 4; ++k) { const float x = r.v[j][k]; la += wa[j][k] * x; lb += wb[j][k] * x; }
            f32x4 h4; { const f32x4 keep = up32 ? lb : la, send = up32 ? la : lb;
#pragma unroll
                for (int i = 0; i < 4; ++i) h4[i] = keep[i] + __shfl_xor(send[i], 32); }
            f32x2 h2; { const float k0 = up16 ? h4[2] : h4[0], k1 = up16 ? h4[3] : h4[1], s0 = up16 ? h4[0] : h4[2], s1 = up16 ? h4[1] : h4[3]; h2.x = k0 + __shfl_xor(s0, 16); h2.y = k1 + __shfl_xor(s1, 16); }
            float h1 = (up8 ? h2.y : h2.x) + __shfl_xor(up8 ? h2.x : h2.y, 8);
            h1 += __shfl_xor(h1, 4); h1 += __shfl_xor(h1, 2); h1 += __shfl_xor(h1, 1);
            float lg[8];
#pragma unroll
            for (int e = 0; e < 8; ++e) lg[e] = __builtin_bit_cast(float, __builtin_amdgcn_readlane(__builtin_bit_cast(int, h1), 8 * e));
            int e0 = 0; float v0 = lg[0];
#pragma unroll
            for (int e = 1; e < 8; ++e) if (lg[e] > v0) { v0 = lg[e]; e0 = e; }
            int e1 = -1; float v1 = -INFINITY;
#pragma unroll
            for (int e = 0; e < 8; ++e) if (e != e0 && lg[e] > v1) { v1 = lg[e]; e1 = e; }
            if (F.lane == 0) {
                const float w0 = 1.0f / (1.0f + __expf(v1 - v0));
                toke[2 * t] = e0; toke[2 * t + 1] = e1; tokw[2 * t] = w0; tokw[2 * t + 1] = 1.0f - w0;
                __hip_atomic_fetch_add((LAS int*)&hist[e0], 1, __ATOMIC_RELAXED, __HIP_MEMORY_SCOPE_WORKGROUP); __hip_atomic_fetch_add((LAS int*)&hist[e1], 1, __ATOMIC_RELAXED, __HIP_MEMORY_SCOPE_WORKGROUP);
            }
        }
        __syncthreads();
        if (F.tid < 8) cntg[c * 8 + F.tid] = hist[F.tid];
        __syncthreads();
    }
}
__device__ __forceinline__ void moe_assign_phase(Frame& F, bool i8) {
    const bf16_t* H = (const bf16_t*)(F.ws + WS_H); bf16_t* AS = (bf16_t*)(F.ws + WS_R + R_ASORT);
    const float* hsc = (const float*)(F.ws + WS_MISC + MS_HSC); float* asc = (float*)(F.ws + WS_MISC + MS_ASC);
    const int* toke = (const int*)(F.ws + WS_MISC + MS_TOKE); int* slot = (int*)(F.ws + WS_MISC + MS_SLOT); const int* cntg = (const int*)(F.ws + WS_MISC + MS_CNT);
    int* texp = (int*)(F.ws + WS_MISC + MS_TEXP);
    volatile LAS int* tot = (volatile LAS int*)(F.lds + LDSCTL_OFF + 1024);
    volatile LAS int* pre = tot + 8;
    volatile LAS int* wcnt = tot + 16;
    for (int c = F.vcu; c < T / 128; c += F.G) {
        if (F.tid < 16) tot[F.tid] = 0;
        __syncthreads();
        { const int cc = F.tid >> 1, h = F.tid & 1; const i32x4 v = *(const i32x4*)(cntg + cc * 8 + 4 * h);
#pragma unroll
          for (int k = 0; k < 4; ++k) { __hip_atomic_fetch_add((LAS int*)&tot[4 * h + k], v[k], __ATOMIC_RELAXED, __HIP_MEMORY_SCOPE_WORKGROUP); if (cc < c) __hip_atomic_fetch_add((LAS int*)&pre[4 * h + k], v[k], __ATOMIC_RELAXED, __HIP_MEMORY_SCOPE_WORKGROUP); } }
        const int t = c * 128 + F.wave * 16 + ((F.lane & 31) >> 1);
        const int my_e = (F.lane < 32) ? toke[2 * t + (F.lane & 1)] : -1;
        int rank = 0;
#pragma unroll
        for (int e = 0; e < 8; ++e) { const unsigned long long m = __ballot(my_e == e); if (my_e == e) rank = __popcll(m & ((1ull << F.lane) - 1ull)); if (F.lane == 0) wcnt[F.wave * 8 + e] = __popcll(m); }
        __syncthreads();
        int myslot = 0;
        if (F.lane < 32) {
            int ts = 0;
#pragma unroll
            for (int e = 0; e < 8; ++e) ts += (e < my_e) ? ((tot[e] + 255) >> 8) : 0;
            int wp = 0; for (int w = 0; w < F.wave; ++w) wp += wcnt[w * 8 + my_e];
            myslot = ts * 256 + pre[my_e] + wp + rank;
            slot[2 * t + (F.lane & 1)] = myslot;
        }
        if (c == 0 && F.tid == 0) { int ts = 0; for (int e = 0; e < 8; ++e) { const int n = (tot[e] + 255) >> 8; for (int k = 0; k < n; ++k) texp[ts + k] = e; ts += n; } for (int k = ts; k < MAXRT; ++k) texp[k] = 0; texp[MAXRT] = ts; }
        if (i8) {
            const float myh = hsc[t];
#pragma unroll 1
            for (int a0 = 0; a0 < 32; a0 += 8) {
                u32x4 x[4];
#pragma unroll
                for (int k = 0; k < 4; ++k) x[k] = *((const u32x4*)((const signed char*)H + (size_t)(c * 128 + F.wave * 16 + ((a0 + 2 * k) >> 1)) * DM) + F.lane);
#pragma unroll
                for (int k = 0; k < 8; ++k) { const int s = __builtin_amdgcn_readlane(myslot, a0 + k); *((u32x4*)((signed char*)AS + (size_t)s * DM) + F.lane) = x[k >> 1]; }
            }
            if (F.lane < 32) asc[myslot] = myh;
        } else {
            for (int a = 0; a < 32; ++a) {
                const int s = __builtin_amdgcn_readlane(myslot, a); const int ta = c * 128 + F.wave * 16 + (a >> 1);
                const u32x4* srcp = (const u32x4*)(H + (size_t)ta * DM) + F.lane; u32x4* dstp = (u32x4*)(AS + (size_t)s * DM) + F.lane;
                const u32x4 x0 = srcp[0], x1 = srcp[64]; dstp[0] = x0; dstp[64] = x1; }
        }
        __syncthreads();
    }
}

using pg8::Unit;
typedef f32x4 AccT[2][2][4][2];

struct ProbSimple { int K; unsigned lda, ldb; const char* A; const char* B;
    __device__ __forceinline__ const char* a_ptr(const Unit& u) const { return A + (size_t)u.pm * 256 * lda; }
    __device__ __forceinline__ const char* b_ptr(const Unit& u) const { return B + (size_t)u.pn * 256 * ldb; } };
struct ProbUp { int K; unsigned lda, ldb; const char* A; const char* B;
    __device__ __forceinline__ const char* a_ptr(const Unit& u) const { return A + (size_t)u.pm * 256 * lda + (u.pn >= 3 ? 256 : 0); }
    __device__ __forceinline__ const char* b_ptr(const Unit& u) const { return B + (size_t)u.pn * 256 * ldb; } };
struct ProbMoe { int K; unsigned lda, ldb; const char* A; const char* B; int a_lo;
    __device__ __forceinline__ const char* a_ptr(const Unit& u) const { return A + (size_t)(u.pm - a_lo) * 256 * lda; }
    __device__ __forceinline__ const char* b_ptr(const Unit& u) const { return B + (size_t)u.aux * WF_STRIDE + (size_t)u.pn * 256 * ldb; } };

struct ProbTail { int K; unsigned lda, ldb; const char* A; const char* B;
    __device__ __forceinline__ const char* a_ptr(const Unit& u) const { return A + (size_t)u.pm * 256 * lda + (size_t)(u.aux >> 8) * (DFF / TAIL_KS) * 2; }
    __device__ __forceinline__ const char* b_ptr(const Unit& u) const { return B + (size_t)(u.aux & 255) * WF_STRIDE + (size_t)u.pn * 256 * ldb + (size_t)(u.aux >> 8) * (DFF / TAIL_KS) * 2; } };
struct TailOrder { int ntail, G, c; const int* texp;
    __device__ bool next(int i, Unit& u) const { const int L = i * G + c; if (L >= ntail) return false;
        u.pm = 256 + L / (4 * TAIL_KS); u.pn = (L / TAIL_KS) & 3; u.aux = __builtin_amdgcn_readfirstlane(texp[u.pm]) | ((L % TAIL_KS) << 8); return true; } };
struct MoeOrder { pg8::StaticOrder base; int lo; const int* texp;
    __device__ bool next(int i, Unit& u) const { if (!base.next(i, u)) return false; u.pm += lo; u.aux = __builtin_amdgcn_readfirstlane(texp[u.pm]); return true; } };

__device__ __forceinline__ u32x4 pack8(const f32x4 a, const f32x4 b) { u32x4 w; w.x = cvtpk(a[0], a[1]); w.y = cvtpk(a[2], a[3]); w.z = cvtpk(b[0], b[1]); w.w = cvtpk(b[2], b[3]); return w; }
__device__ __forceinline__ u32x2 pack4(const f32x4 a) { u32x2 w; w.x = cvtpk(a[0], a[1]); w.y = cvtpk(a[2], a[3]); return w; }

struct EpiNoStage { __device__ __forceinline__ void stage(LAS unsigned char*, const Unit&, int, int) const {} };
__device__ __forceinline__ void stage1k(const void* src, LAS unsigned char* dst, int lane) { __builtin_amdgcn_global_load_lds((const unsigned*)((const char*)src + lane * 16), (LAS unsigned*)dst, 16, 0, 0); }
__device__ __forceinline__ f32x4 deq(const f32x4& a, float, const f32x4&) { return a; }
__device__ __forceinline__ f32x4 deq(const i32x4& a, float rs, const f32x4& cs) { return __builtin_convertvector(a, f32x4) * rs * cs; }
struct EpiInproj {
    static constexpr bool MID = false;
    bf16_t* P; bf16_t* G; float* ssq; const int* pos; const float* rsc; const float* csc;
    __device__ __forceinline__ void stage(LAS unsigned char* d, const Unit& u, int wid, int lane) const {
        if (wid == 0) { stage1k(rsc + u.pm * 256, d, lane); stage1k(csc + u.pn * 256, d + 1024, lane); stage1k(pos + u.pm * 256, d + 2048, lane); } }
    template <class AV> __device__ __forceinline__ void operator()(const AV (&acc)[2][2][4][2], const Unit& u, int wr, int wc, int fr, int fq, const LAS unsigned char* esc) const {
        const int pn = u.pn, row0 = u.pm * 256 + wr * 64 + fr;
        f32x4 cs[2][2];
#pragma unroll
        for (int bj = 0; bj < 2; ++bj)
#pragma unroll
            for (int n = 0; n < 2; ++n) cs[bj][n] = *(const LAS f32x4*)(esc + 1024 + (bj * 128 + wc * 32 + n * 16 + fq * 4) * 4);
        float rs8[2][4], pf8[2][4];
#pragma unroll
        for (int ai = 0; ai < 2; ++ai)
#pragma unroll
            for (int m = 0; m < 4; ++m) { const int rl = ai * 128 + wr * 64 + m * 16 + fr; rs8[ai][m] = *(const LAS float*)(esc + rl * 4); pf8[ai][m] = (float)*(const LAS int*)(esc + 2048 + rl * 4); }
#define DQ(ai, bj, m, n) deq(acc[ai][bj][m][n], rs, cs[bj][n])
        if (pn >= 7) {
#pragma unroll
            for (int ai = 0; ai < 2; ++ai)
#pragma unroll
                for (int m = 0; m < 4; ++m) { const int row = row0 + ai * 128 + m * 16; const float rs = rs8[ai][m]; u32x4 w;
#pragma unroll
                    for (int bj = 0; bj < 2; ++bj) { f32x4 a = DQ(ai, bj, m, 0), b = DQ(ai, bj, m, 1);
#pragma unroll
                        for (int j = 0; j < 4; ++j) { a[j] = fast_sigmoid(a[j]) * 255.0f; b[j] = fast_sigmoid(b[j]) * 255.0f; }
                        const unsigned wa_ = (unsigned)__float2int_rn(a[0]) | ((unsigned)__float2int_rn(a[1]) << 8) | ((unsigned)__float2int_rn(a[2]) << 16) | ((unsigned)__float2int_rn(a[3]) << 24);
                        const unsigned wb_ = (unsigned)__float2int_rn(b[0]) | ((unsigned)__float2int_rn(b[1]) << 8) | ((unsigned)__float2int_rn(b[2]) << 16) | ((unsigned)__float2int_rn(b[3]) << 24);
                        if (bj == 0) { w.x = wa_; w.y = wb_; } else { w.z = wa_; w.w = wb_; } }
                    *(u32x4*)((unsigned char*)G + (size_t)row * GW + (pn - 7) * 256 + wc * 64 + fq * 16) = w; }
        } else if (pn >= 5 || pn == 3) {
            const float sc = (pn == 3) ? 1.0f : C_M;
#pragma unroll
            for (int ai = 0; ai < 2; ++ai)
#pragma unroll
                for (int m = 0; m < 4; ++m) { const int row = row0 + ai * 128 + m * 16; const float rs = rs8[ai][m]; float s = 0.f;
#pragma unroll
                    for (int bj = 0; bj < 2; ++bj) { const f32x4 a = DQ(ai, bj, m, 0) * sc, b = DQ(ai, bj, m, 1) * sc;
                        s += (a[0] * a[0] + a[1] * a[1]) + (a[2] * a[2] + a[3] * a[3]) + (b[0] * b[0] + b[1] * b[1]) + (b[2] * b[2] + b[3] * b[3]);
                        *(u32x4*)(P + (size_t)row * PW + pn * 256 + bj * 128 + wc * 32 + fq * 8) = pack8(a, b); }
                    if (pn == 3) { s += __shfl_xor(s, 16); s += __shfl_xor(s, 32); if (fq == 0) ssq[(size_t)row * 8 + wc] = s; } }
        } else if (pn == 4) {
#pragma unroll
            for (int ai = 0; ai < 2; ++ai)
#pragma unroll
                for (int m = 0; m < 4; ++m) { const int row = row0 + ai * 128 + m * 16; const float rs = rs8[ai][m];
                    { const f32x4 a = DQ(ai, 0, m, 0), b = DQ(ai, 0, m, 1);
                      float s = (a[0] * a[0] + a[1] * a[1]) + (a[2] * a[2] + a[3] * a[3]) + (b[0] * b[0] + b[1] * b[1]) + (b[2] * b[2] + b[3] * b[3]);
                      *(u32x4*)(P + (size_t)row * PW + P_CKV + wc * 32 + fq * 8) = pack8(a, b);
                      s += __shfl_xor(s, 16); s += __shfl_xor(s, 32); if (fq == 0) ssq[(size_t)row * 8 + 4 + wc] = s; }
                    if (wc == 0) { const f32x4 x1 = DQ(ai, 1, m, 0), x2 = DQ(ai, 1, m, 1); const float pf = pf8[ai][m]; f32x4 o1, o2;
#pragma unroll
                        for (int j = 0; j < 4; ++j) { float c, s; rot_cs(pf, 2 * (4 * fq + j), c, s); o1[j] = x1[j] * c - x2[j] * s; o2[j] = x2[j] * c + x1[j] * s; }
                        *(u32x2*)(P + (size_t)row * PW + P_KR + 4 * fq) = pack4(o1); *(u32x2*)(P + (size_t)row * PW + P_KR + 16 + 4 * fq) = pack4(o2); } }
        } else {
            const float sc = (pn < 2) ? C_A : 1.0f; const int i0 = 16 * (wc & 1) + 4 * fq;
#pragma unroll
            for (int ai = 0; ai < 2; ++ai)
#pragma unroll
                for (int m = 0; m < 4; ++m) { const int row = row0 + ai * 128 + m * 16; const float rs = rs8[ai][m]; const float pf = pf8[ai][m]; f32x4 c, s;
#pragma unroll
                    for (int j = 0; j < 4; ++j) { float cc, ss; rot_cs(pf, i0 + j, cc, ss); c[j] = cc * sc; s[j] = ss * sc; }
#pragma unroll
                    for (int bj = 0; bj < 2; ++bj) { const f32x4 x1 = DQ(ai, bj, m, 0), x2 = DQ(ai, bj, m, 1);
                        if (pn == 2 && bj == 1) { *(u32x4*)(P + (size_t)row * PW + P_VA + wc * 32 + fq * 8) = pack8(x1, x2); }
                        else { const f32x4 o1 = x1 * c - x2 * s, o2 = x2 * c + x1 * s; bf16_t* d = P + (size_t)row * PW + pn * 256 + 64 * (2 * bj + (wc >> 1)) + i0;
                            *(u32x2*)d = pack4(o1); *(u32x2*)(d + 32) = pack4(o2); } } }
        }
#undef DQ
    }
};
struct EpiUp {
    static constexpr bool MID = false;
    __device__ __forceinline__ void stage(LAS unsigned char*, const Unit&, int, int) const {}
    bf16_t* QB; bf16_t* KVB; const float* ssq; const int* pos;
    __device__ __forceinline__ void operator()(const AccT& acc, const Unit& u, int wr, int wc, int fr, int fq, const LAS unsigned char*) const {
        const int pn = u.pn, row0 = u.pm * 256 + wr * 64 + fr;
        float rs8[2][4], pf8[2][4];
#pragma unroll
        for (int ai = 0; ai < 2; ++ai)
#pragma unroll
            for (int m = 0; m < 4; ++m) { const int row = row0 + ai * 128 + m * 16; const f32x4 sv = *(const f32x4*)(ssq + (size_t)row * 8 + (pn < 3 ? 0 : 4));
                rs8[ai][m] = (pn < 3 ? C_B : 1.0f) / sqrtf(((sv[0] + sv[1]) + (sv[2] + sv[3])) * (pn < 3 ? 1.0f / 256.0f : 1.0f / 128.0f) + EPS); pf8[ai][m] = (pn < 3) ? (float)pos[row] : 0.f; }
#pragma unroll
        for (int ai = 0; ai < 2; ++ai)
#pragma unroll
            for (int m = 0; m < 4; ++m) { const int row = row0 + ai * 128 + m * 16; const float rs = rs8[ai][m];
                if (pn < 3) {
#pragma unroll
                    for (int bj = 0; bj < 2; ++bj) { const int gg = 8 * pn + 4 * bj + wc; const f32x4 x1 = acc[ai][bj][m][0] * rs, x2 = acc[ai][bj][m][1] * rs;
                        if (gg % 3 == 2) { const float pf = pf8[ai][m]; f32x4 o1, o2;
#pragma unroll
                            for (int j = 0; j < 4; ++j) { float c, s; rot_cs(pf, 2 * (4 * fq + j), c, s); o1[j] = x1[j] * c - x2[j] * s; o2[j] = x2[j] * c + x1[j] * s; }
                            bf16_t* d = QB + (size_t)row * QBW + 32 * gg + 4 * fq; *(u32x2*)d = pack4(o1); *(u32x2*)(d + 16) = pack4(o2); }
                        else *(u32x4*)(QB + (size_t)row * QBW + 32 * gg + 8 * fq) = pack8(x1, x2); }
                } else {
#pragma unroll
                    for (int bj = 0; bj < 2; ++bj) *(u32x4*)(KVB + (size_t)row * KVW + (pn - 3) * 256 + bj * 128 + wc * 32 + fq * 8) = pack8(acc[ai][bj][m][0] * rs, acc[ai][bj][m][1] * rs);
                } }
    }
};
struct EpiPlain {
    static constexpr bool MID = false;
    __device__ __forceinline__ void stage(LAS unsigned char*, const Unit&, int, int) const {}
    bf16_t* O; int ldo;
    __device__ __forceinline__ void operator()(const AccT& acc, const Unit& u, int wr, int wc, int fr, int fq, const LAS unsigned char*) const {
        const int row0 = u.pm * 256 + wr * 64 + fr;
#pragma unroll
        for (int ai = 0; ai < 2; ++ai)
#pragma unroll
            for (int m = 0; m < 4; ++m)
#pragma unroll
                for (int bj = 0; bj < 2; ++bj) *(u32x4*)(O + (size_t)(row0 + ai * 128 + m * 16) * ldo + u.pn * 256 + bj * 128 + wc * 32 + fq * 8) = pack8(acc[ai][bj][m][0], acc[ai][bj][m][1]);
    }
};
struct EpiBranch {
    static constexpr bool MID = true;
    const unsigned char* G; bf16_t* MIXED;
    __device__ __forceinline__ void stage(LAS unsigned char*, const Unit&, int, int) const {}
    static __device__ __forceinline__ float gq(unsigned w, int b) { const float f = (float)((w >> (8 * b)) & 255u); return fmaxf(f, 2.55e-4f); }
    __device__ __forceinline__ void mid(AccT& acc, const Unit& u, int seg  , int wr, int wc, int fr, int fq) const {
        const int row0 = opq_v(u.pm * 256 + wr * 64 + fr);
#pragma unroll
        for (int ai = 0; ai < 2; ++ai) {
            u32x4 ga[4], gb[4];
#pragma unroll
            for (int m = 0; m < 4; ++m) { const unsigned char* gp = G + (size_t)(row0 + ai * 128 + m * 16) * GW + u.pn * 256 + wc * 64 + fq * 16;
                ga[m] = *(const u32x4*)(gp + (seg - 1) * 1024); gb[m] = *(const u32x4*)(gp + seg * 1024); }
#pragma unroll
            for (int m = 0; m < 4; ++m) {
#pragma unroll
                for (int j = 0; j < 4; ++j) {
                    acc[ai][0][m][0][j] *= gq(ga[m].x, j) * __builtin_amdgcn_rcpf(gq(gb[m].x, j)); acc[ai][0][m][1][j] *= gq(ga[m].y, j) * __builtin_amdgcn_rcpf(gq(gb[m].y, j));
                    acc[ai][1][m][0][j] *= gq(ga[m].z, j) * __builtin_amdgcn_rcpf(gq(gb[m].z, j)); acc[ai][1][m][1][j] *= gq(ga[m].w, j) * __builtin_amdgcn_rcpf(gq(gb[m].w, j)); } }
            asm volatile("" ::: "memory"); }
    }
    __device__ __forceinline__ void operator()(const AccT& acc, const Unit& u, int wr, int wc, int fr, int fq, const LAS unsigned char*) const {
        const int row0 = u.pm * 256 + wr * 64 + fr;
#pragma unroll
        for (int ai = 0; ai < 2; ++ai) {
            u32x4 gw[4];
#pragma unroll
            for (int m = 0; m < 4; ++m) gw[m] = *(const u32x4*)(G + (size_t)(row0 + ai * 128 + m * 16) * GW + 2048 + u.pn * 256 + wc * 64 + fq * 16);
#pragma unroll
            for (int m = 0; m < 4; ++m) { f32x4 a0 = acc[ai][0][m][0], b0 = acc[ai][0][m][1], a1 = acc[ai][1][m][0], b1 = acc[ai][1][m][1];
#pragma unroll
                for (int j = 0; j < 4; ++j) { a0[j] *= gq(gw[m].x, j) * (1.0f / 255.0f); b0[j] *= gq(gw[m].y, j) * (1.0f / 255.0f); a1[j] *= gq(gw[m].z, j) * (1.0f / 255.0f); b1[j] *= gq(gw[m].w, j) * (1.0f / 255.0f); }
                bf16_t* d = MIXED + (size_t)(row0 + ai * 128 + m * 16) * DM + u.pn * 256 + wc * 64 + fq * 16;
                *(u32x4*)d = pack8(a0, b0); *(u32x4*)(d + 8) = pack8(a1, b1); }
            asm volatile("" ::: "memory"); }
    }
};
struct EpiResid {
    static constexpr bool MID = false;
    __device__ __forceinline__ void stage(LAS unsigned char*, const Unit&, int, int) const {}
    const float* Xf; bf16_t* X;
    __device__ __forceinline__ void operator()(const AccT& acc, const Unit& u, int wr, int wc, int fr, int fq, const LAS unsigned char*) const {
        const int row0 = u.pm * 256 + wr * 64 + fr;
#pragma unroll
        for (int ai = 0; ai < 2; ++ai) {
            f32x4 xa[4][2], xb[4][2];
#pragma unroll
            for (int m = 0; m < 4; ++m)
#pragma unroll
                for (int bj = 0; bj < 2; ++bj) { const size_t o = (size_t)(row0 + ai * 128 + m * 16) * DM + u.pn * 256 + bj * 128 + wc * 32 + fq * 8;
                    if (Xf) { xa[m][bj] = *(const f32x4*)(Xf + o); xb[m][bj] = *(const f32x4*)(Xf + o + 4); }
                    else { const u32x4 q = *(const u32x4*)(X + o); xa[m][bj] = (f32x4){bflo(q.x), bfhi(q.x), bflo(q.y), bfhi(q.y)}; xb[m][bj] = (f32x4){bflo(q.z), bfhi(q.z), bflo(q.w), bfhi(q.w)}; } }
#pragma unroll
            for (int m = 0; m < 4; ++m)
#pragma unroll
                for (int bj = 0; bj < 2; ++bj) *(u32x4*)(X + (size_t)(row0 + ai * 128 + m * 16) * DM + u.pn * 256 + bj * 128 + wc * 32 + fq * 8) = pack8(xa[m][bj] + acc[ai][bj][m][0], xb[m][bj] + acc[ai][bj][m][1]);
            asm volatile("" ::: "memory"); }
    }
};
struct EpiSwiglu {
    static constexpr bool MID = false;
    bf16_t* ACT; int lo; const float* rsc; const float* csc;
    __device__ __forceinline__ void stage(LAS unsigned char* d, const Unit& u, int wid, int lane) const {
        if (wid == 0) { stage1k(rsc + u.pm * 256, d, lane); stage1k(csc + (size_t)u.aux * 2 * DFF + u.pn * 256, d + 1024, lane); } }
    template <class AV> __device__ __forceinline__ void operator()(const AV (&acc)[2][2][4][2], const Unit& u, int wr, int wc, int fr, int fq, const LAS unsigned char* esc) const {
        const int row0 = (u.pm - lo) * 256 + wr * 64 + fr;
        f32x4 cs[2][2];
#pragma unroll
        for (int bj = 0; bj < 2; ++bj)
#pragma unroll
            for (int n = 0; n < 2; ++n) cs[bj][n] = *(const LAS f32x4*)(esc + 1024 + (bj * 128 + wc * 32 + n * 16 + fq * 4) * 4);
        float rs8[2][4];
#pragma unroll
        for (int ai = 0; ai < 2; ++ai)
#pragma unroll
            for (int m = 0; m < 4; ++m) rs8[ai][m] = *(const LAS float*)(esc + (ai * 128 + wr * 64 + m * 16 + fr) * 4);
#pragma unroll
        for (int ai = 0; ai < 2; ++ai)
#pragma unroll
            for (int m = 0; m < 4; ++m) { const float rs = rs8[ai][m]; f32x4 a, b;
                const f32x4 g0 = deq(acc[ai][0][m][0], rs, cs[0][0]), g1 = deq(acc[ai][0][m][1], rs, cs[0][1]), u0 = deq(acc[ai][1][m][0], rs, cs[1][0]), u1 = deq(acc[ai][1][m][1], rs, cs[1][1]);
#pragma unroll
                for (int j = 0; j < 4; ++j) { a[j] = g0[j] * fast_sigmoid(g0[j]) * u0[j]; b[j] = g1[j] * fast_sigmoid(g1[j]) * u1[j]; }
                *(u32x4*)(ACT + (size_t)(row0 + ai * 128 + m * 16) * DFF + u.pn * 128 + wc * 32 + fq * 8) = pack8(a, b); }
    }
};
struct EpiYout {
    static constexpr bool MID = false;
    __device__ __forceinline__ void stage(LAS unsigned char*, const Unit&, int, int) const {}
    bf16_t* Y;
    __device__ __forceinline__ void operator()(const AccT& acc, const Unit& u, int wr, int wc, int fr, int fq, const LAS unsigned char*) const {
        const int row0 = u.pm * 256 + wr * 64 + fr;
#pragma unroll
        for (int ai = 0; ai < 2; ++ai)
#pragma unroll
            for (int m = 0; m < 4; ++m)
#pragma unroll
                for (int bj = 0; bj < 2; ++bj) *(u32x4*)(Y + (size_t)(row0 + ai * 128 + m * 16) * DM + u.pn * 256 + bj * 128 + wc * 32 + fq * 8) = pack8(acc[ai][bj][m][0], acc[ai][bj][m][1]);
    }
};
struct EpiSlab {
    static constexpr bool MID = false;
    __device__ __forceinline__ void stage(LAS unsigned char*, const Unit&, int, int) const {}
    float* slab;
    __device__ __forceinline__ void operator()(const AccT& acc, const Unit& u, int wr, int wc, int fr, int fq, const LAS unsigned char*) const {
        float* base = slab + (size_t)(((u.pm - 256) * 4 + u.pn) * TAIL_KS + (u.aux >> 8)) * 65536;
#pragma unroll
        for (int ai = 0; ai < 2; ++ai)
#pragma unroll
            for (int m = 0; m < 4; ++m)
#pragma unroll
                for (int bj = 0; bj < 2; ++bj) { float* d = base + (size_t)(ai * 128 + wr * 64 + m * 16 + fr) * 256 + bj * 128 + wc * 32 + fq * 8; *(f32x4*)d = acc[ai][bj][m][0]; *(f32x4*)(d + 4) = acc[ai][bj][m][1]; }
    }
};

namespace att {
__device__ __forceinline__ int crow(int r, int hi) { return (r & 3) + 8 * (r >> 2) + 4 * hi; }
__device__ __forceinline__ void glds16(const void* gsrc, unsigned lds_dst) { unsigned keep;
    asm volatile("s_mov_b32 %0, m0\n\ts_mov_b32 m0, %2\n\ts_nop 0\n\tglobal_load_lds_dwordx4 %1, off\n\ts_mov_b32 m0, %0" : "=&s"(keep) : "v"(gsrc), "s"(lds_dst) : "memory"); }
__device__ __forceinline__ float swapmax(float m) { auto rr = __builtin_amdgcn_permlane32_swap(__float_as_uint(m), __float_as_uint(m), false, false); return fmaxf(__uint_as_float(rr[0]), __uint_as_float(rr[1])); }
__device__ __forceinline__ float swapsum(float m) { auto rr = __builtin_amdgcn_permlane32_swap(__float_as_uint(m), __float_as_uint(m), false, false); return __uint_as_float(rr[0]) + __uint_as_float(rr[1]); }
__device__ __forceinline__ void store_o_block(const f32x16& o, float linv, bf16_t* rowp  , int hi) {
#pragma unroll
    for (int rp = 0; rp < 2; ++rp) {
        const u32x2 X = pack4((f32x4){o[8 * rp] * linv, o[8 * rp + 1] * linv, o[8 * rp + 2] * linv, o[8 * rp + 3] * linv});
        const u32x2 Y = pack4((f32x4){o[8 * rp + 4] * linv, o[8 * rp + 5] * linv, o[8 * rp + 6] * linv, o[8 * rp + 7] * linv});
        const auto s0 = __builtin_amdgcn_permlane32_swap(X.x, Y.x, false, false), s1 = __builtin_amdgcn_permlane32_swap(X.y, Y.y, false, false);
        const u32x4 w = {s0[0], s1[0], s0[1], s1[1]};
        *(u32x4*)(rowp + 8 * (2 * rp + hi)) = w; }
}
__device__ __forceinline__ s16x4 vtr(unsigned addr) { s16x4 r; asm volatile("ds_read_b64_tr_b16 %0, %1" : "=&v"(r) : "v"(addr) : "memory"); return r; }
#define VTRO(dst, base, off) asm volatile("ds_read_b64_tr_b16 %0, %1 offset:%c2" : "=&v"(dst) : "v"(base), "i"(off) : "memory")

struct Src {
    const bf16_t* q; int qpitch;
    const bf16_t* k0; int k0pitch;
    const bf16_t* k1; int k1pitch;
    const bf16_t* v; int vpitch;
    bf16_t* o; int opitch;
};
template <int NKC, int NVB, int RD = 4>
__device__ __forceinline__ void dma_tile(const Src& S, int t, int slot, unsigned lds0, int wid, int lane) {
    constexpr int KS = NKC * 1024, VS = NVB * 4096, LDS_K = 0, LDS_V = RD * KS;
#pragma unroll
    for (int c = 0; c < (NKC + 7) / 8; ++c) { const int ch = wid + 8 * c; if (ch < NKC) {
        const bf16_t* src = (ch < 8) ? S.k0 + (size_t)(t * 64 + lane) * S.k0pitch + ch * 8 : S.k1 + (size_t)(t * 64 + lane) * S.k1pitch + (ch - 8) * 8;
        glds16(src, (unsigned)__builtin_amdgcn_readfirstlane(lds0 + LDS_K + slot * KS + ch * 1024)); } }
#pragma unroll
    for (int c = 0; c < (NVB * 4 + 7) / 8; ++c) { const int p = wid + 8 * c; if (p < NVB * 4) {
        const bf16_t* src = S.v + (size_t)(t * 64 + 16 * (p & 3) + (lane >> 2)) * S.vpitch + (p >> 2) * 32 + (lane & 3) * 8;
        glds16(src, (unsigned)__builtin_amdgcn_readfirstlane(lds0 + LDS_V + slot * VS + p * 1024)); } }
}
__device__ __forceinline__ void wait_vm_bar(int n) {
    if (n >= 4) asm volatile("s_waitcnt vmcnt(4) lgkmcnt(0)\n\ts_barrier" ::: "memory");
    else if (n == 3) asm volatile("s_waitcnt vmcnt(3) lgkmcnt(0)\n\ts_barrier" ::: "memory");
    else if (n == 2) asm volatile("s_waitcnt vmcnt(2) lgkmcnt(0)\n\ts_barrier" ::: "memory");
    else if (n == 1) asm volatile("s_waitcnt vmcnt(1) lgkmcnt(0)\n\ts_barrier" ::: "memory");
    else asm volatile("s_waitcnt vmcnt(0) lgkmcnt(0)\n\ts_barrier" ::: "memory");
}
template <int NKC, int NVB, int MODE>
__device__ __forceinline__ void unit(LAS unsigned char* lds, const Src& S, int t_lo, int t_hi, int qpos0  , float sink_l2) {
    constexpr int KS = NKC * 1024, VS = NVB * 4096, RD = 4, LDS_K = 0, LDS_V = RD * KS;
    const int tid = opq_v((int)threadIdx.x), lane = tid & 63, r32 = lane & 31, hi = lane >> 5; const int wid = __builtin_amdgcn_readfirstlane(tid >> 6), grp = wid >> 2;
    const unsigned lds0 = (unsigned)(uintptr_t)lds;
    const int ops = (NKC + 7 - wid) / 8 + (NVB * 4) / 8;
    bf16x8 qr[NKC / 2];
#pragma unroll
    for (int d0 = 0; d0 < NKC / 2; ++d0) qr[d0] = *(const bf16x8*)(S.q + (size_t)r32 * S.qpitch + d0 * 16 + hi * 8);
    float m_run = (MODE == 0) ? sink_l2 : 0.0f, l_run = (MODE == 0 && hi == 0) ? 1.0f : 0.0f; bool first = (MODE != 0);
    f32x16 o[NVB];
#pragma unroll
    for (int d = 0; d < NVB; ++d) o[d] = f32x16{};
    const int qi = qpos0 + wid * 32 + r32, qw0 = qpos0 + wid * 32;
    f32x16 p0 = f32x16{}, p1 = f32x16{};
#define AT_ACTIVE(t) ((MODE != 0) || ((64 * (t) + 63 >= qw0 - 128) && (64 * (t) <= qw0 + 31 + 128)))
#define AT_QK(t) do { const LAS unsigned char* kb_ = lds + LDS_K + (((t) - t_lo) % RD) * KS + hi * 1024 + r32 * 16; p0 = f32x16{}; p1 = f32x16{}; \
        _Pragma("unroll") for (int d0 = 0; d0 < NKC / 2; ++d0) { const bf16x8 b0_ = *(const LAS bf16x8*)(kb_ + d0 * 2048), b1_ = *(const LAS bf16x8*)(kb_ + d0 * 2048 + 512); \
            p0 = __builtin_amdgcn_mfma_f32_32x32x16_bf16(b0_, qr[d0], p0, 0, 0, 0); p1 = __builtin_amdgcn_mfma_f32_32x32x16_bf16(b1_, qr[d0], p1, 0, 0, 0); } } while (0)
#define AT_SMPV(t) do { \
        if (MODE == 0 && !((64 * (t) >= qw0 + 31 - 128) && (64 * (t) + 63 <= qw0 + 128))) {   \
            _Pragma("unroll") for (int r = 0; r < 16; ++r) { const int kv_ = 64 * (t) + crow(r, hi); int e0_ = kv_ - qi; e0_ = e0_ < 0 ? -e0_ : e0_; int e1_ = kv_ + 32 - qi; e1_ = e1_ < 0 ? -e1_ : e1_; \
            if (e0_ > 128) p0[r] = -INFINITY; if (e1_ > 128) p1[r] = -INFINITY; } } \
        if (first) {   \
            float mx_[8]; _Pragma("unroll") for (int r = 0; r < 8; ++r) mx_[r] = fmaxf(fmaxf(p0[r], p0[r + 8]), fmaxf(p1[r], p1[r + 8])); \
            float rm_ = fmaxf(fmaxf(fmaxf(mx_[0], mx_[1]), fmaxf(mx_[2], mx_[3])), fmaxf(fmaxf(mx_[4], mx_[5]), fmaxf(mx_[6], mx_[7]))); m_run = swapmax(rm_); first = false; } \
        else { const float tot_ = swapsum(l_run);   \
          if (__any(tot_ > 1.0e12f)) { const float dl_ = tot_ > 1.0e12f ? ceilf(__builtin_amdgcn_logf(tot_)) : 0.f, sc_ = __builtin_amdgcn_exp2f(-dl_); m_run += dl_; l_run *= sc_; \
              _Pragma("unroll") for (int d = 0; d < NVB; ++d) _Pragma("unroll") for (int r = 0; r < 16; ++r) o[d][r] *= sc_; } } \
        float sm_[4] = {0.f, 0.f, 0.f, 0.f}; \
        _Pragma("unroll") for (int r = 0; r < 16; ++r) { p0[r] = __builtin_amdgcn_exp2f(p0[r] - m_run); p1[r] = __builtin_amdgcn_exp2f(p1[r] - m_run); sm_[r & 3] += p0[r] + p1[r]; } \
        l_run += (sm_[0] + sm_[1]) + (sm_[2] + sm_[3]); \
        u32x4 pw_[4]; \
        pw_[0] = (u32x4){cvtpk(p0[0], p0[1]), cvtpk(p0[2], p0[3]), cvtpk(p0[4], p0[5]), cvtpk(p0[6], p0[7])}; pw_[1] = (u32x4){cvtpk(p0[8], p0[9]), cvtpk(p0[10], p0[11]), cvtpk(p0[12], p0[13]), cvtpk(p0[14], p0[15])}; \
        pw_[2] = (u32x4){cvtpk(p1[0], p1[1]), cvtpk(p1[2], p1[3]), cvtpk(p1[4], p1[5]), cvtpk(p1[6], p1[7])}; pw_[3] = (u32x4){cvtpk(p1[8], p1[9]), cvtpk(p1[10], p1[11]), cvtpk(p1[12], p1[13]), cvtpk(p1[14], p1[15])}; \
        const unsigned vb_ = lds0 + LDS_V + (((t) - t_lo) % RD) * VS + ((lane >> 4) & 1) * 32 + (lane & 3) * 8 + (4 * hi + ((lane & 15) >> 2)) * 64; \
        _Pragma("unroll") for (int dp = 0; dp < NVB; dp += 2) { s16x4 lo_[2][4], hh_[2][4]; \
            _Pragma("unroll") for (int dd = 0; dd < 2; ++dd) _Pragma("unroll") for (int ks = 0; ks < 4; ++ks) { lo_[dd][ks] = vtr(vb_ + (dp + dd) * 4096 + ks * 1024); hh_[dd][ks] = vtr(vb_ + (dp + dd) * 4096 + ks * 1024 + 512); } \
            asm volatile("s_waitcnt lgkmcnt(0)" ::: "memory"); __builtin_amdgcn_sched_barrier(0); \
            _Pragma("unroll") for (int ks = 0; ks < 4; ++ks) _Pragma("unroll") for (int dd = 0; dd < 2; ++dd) { \
                const bf16x8 vf_ = (bf16x8){lo_[dd][ks][0], lo_[dd][ks][1], lo_[dd][ks][2], lo_[dd][ks][3], hh_[dd][ks][0], hh_[dd][ks][1], hh_[dd][ks][2], hh_[dd][ks][3]}; \
                o[dp + dd] = __builtin_amdgcn_mfma_f32_32x32x16_bf16(vf_, __builtin_bit_cast(bf16x8, pw_[ks]), o[dp + dd], 0, 0, 0); } } } while (0)
    dma_tile<NKC, NVB>(S, t_lo, 0, lds0, wid, lane);
    if (t_lo + 1 < t_hi) dma_tile<NKC, NVB>(S, t_lo + 1, 1, lds0, wid, lane);
    for (int t = t_lo; t < t_hi; ++t) {
        wait_vm_bar((t + 1 < t_hi) ? ops : 0);
        if (t + 2 < t_hi) dma_tile<NKC, NVB>(S, t + 2, (t + 2 - t_lo) % RD, lds0, wid, lane);
        if (grp == 0) { if (AT_ACTIVE(t)) { AT_QK(t); AT_SMPV(t); } }
        else { if (t > t_lo && AT_ACTIVE(t - 1)) AT_SMPV(t - 1); if (AT_ACTIVE(t)) AT_QK(t); }
    }
    if (grp == 1 && AT_ACTIVE(t_hi - 1)) AT_SMPV(t_hi - 1);
    const float linv = 1.0f / swapsum(l_run);
#pragma unroll
    for (int d = 0; d < NVB; ++d) store_o_block(o[d], linv, S.o + (size_t)r32 * S.opitch + 32 * d, hi);
    asm volatile("s_waitcnt lgkmcnt(0)\n\ts_barrier" ::: "memory");
#undef AT_ACTIVE
#undef AT_QK
#undef AT_SMPV
}

template <int NKC, int NVB>
__device__ __forceinline__ void unit_q64(LAS unsigned char* lds, const Src& S, int t_lo, int t_hi) {
    constexpr int KS = NKC * 1024, VS = NVB * 4096, RD = 4, LDS_K = 0, LDS_V = RD * KS;
    const int tid = opq_v((int)threadIdx.x), lane = tid & 63, r32 = lane & 31, hi = lane >> 5; const int wid = __builtin_amdgcn_readfirstlane(tid >> 6);
    const unsigned lds0 = (unsigned)(uintptr_t)lds;
    const int ops = (NKC + 7 - wid) / 8 + (NVB * 4) / 8;
    bf16x8 qa[NKC / 2], qb[NKC / 2];
#pragma unroll
    for (int d0 = 0; d0 < NKC / 2; ++d0) { qa[d0] = *(const bf16x8*)(S.q + (size_t)r32 * S.qpitch + d0 * 16 + hi * 8); qb[d0] = *(const bf16x8*)(S.q + (size_t)(32 + r32) * S.qpitch + d0 * 16 + hi * 8); }
    float ma = 0.f, la = 0.f, mb = 0.f, lb = 0.f; bool first = true;
    f32x16 oa[NVB], ob[NVB];
#pragma unroll
    for (int d = 0; d < NVB; ++d) { oa[d] = f32x16{}; ob[d] = f32x16{}; }
#define Q64_SM_(P0, P1, M, L, O, PW, QE) \
        if (first) {   \
            float mx_[8]; _Pragma("unroll") for (int r = 0; r < 8; ++r) mx_[r] = fmaxf(fmaxf(P0[r], P0[r + 8]), fmaxf(P1[r], P1[r + 8])); \
            float rm_ = fmaxf(fmaxf(fmaxf(mx_[0], mx_[1]), fmaxf(mx_[2], mx_[3])), fmaxf(fmaxf(mx_[4], mx_[5]), fmaxf(mx_[6], mx_[7]))); M = swapmax(rm_); QE = hi ? 0.f : -M; \
            _Pragma("unroll") for (int r = 0; r < 16; ++r) { P0[r] -= M; P1[r] -= M; } } \
        else { const float tot_ = swapsum(L);   \
          if (__any(tot_ > 1.0e12f)) { const float dl_ = tot_ > 1.0e12f ? ceilf(__builtin_amdgcn_logf(tot_)) : 0.f, sc_ = __builtin_amdgcn_exp2f(-dl_); M += dl_; QE = hi ? 0.f : -M; L *= sc_; \
              _Pragma("unroll") for (int r = 0; r < 16; ++r) { P0[r] -= dl_; P1[r] -= dl_; } \
              _Pragma("unroll") for (int d = 0; d < NVB; ++d) _Pragma("unroll") for (int r = 0; r < 16; ++r) O[d][r] *= sc_; } } \
        float sm_[4] = {0.f, 0.f, 0.f, 0.f}; \
        _Pragma("unroll") for (int r = 0; r < 16; ++r) { P0[r] = __builtin_amdgcn_exp2f(P0[r]); P1[r] = __builtin_amdgcn_exp2f(P1[r]); sm_[r & 3] += P0[r] + P1[r]; } \
        L += (sm_[0] + sm_[1]) + (sm_[2] + sm_[3]); \
        PW[0] = (u32x4){cvtpk(P0[0], P0[1]), cvtpk(P0[2], P0[3]), cvtpk(P0[4], P0[5]), cvtpk(P0[6], P0[7])}; PW[1] = (u32x4){cvtpk(P0[8], P0[9]), cvtpk(P0[10], P0[11]), cvtpk(P0[12], P0[13]), cvtpk(P0[14], P0[15])}; \
        PW[2] = (u32x4){cvtpk(P1[0], P1[1]), cvtpk(P1[2], P1[3]), cvtpk(P1[4], P1[5]), cvtpk(P1[6], P1[7])}; PW[3] = (u32x4){cvtpk(P1[8], P1[9]), cvtpk(P1[10], P1[11]), cvtpk(P1[12], P1[13]), cvtpk(P1[14], P1[15])};
#define Q64_SM(P0, P1, M, L, O, PW, QE) do { Q64_SM_(P0, P1, M, L, O, PW, QE) __builtin_amdgcn_sched_barrier(0); } while (0)
#define Q64_SM_NB(P0, P1, M, L, O, PW, QE) do { Q64_SM_(P0, P1, M, L, O, PW, QE) } while (0)
    const float kext = hi ? 0.f : 1.f; float qea = 0.f, qeb = 0.f;
    dma_tile<NKC, NVB, RD>(S, t_lo, 0, lds0, wid, lane);
    if (t_lo + 1 < t_hi) dma_tile<NKC, NVB, RD>(S, t_lo + 1, 1, lds0, wid, lane);
    for (int t = t_lo; t < t_hi; ++t) {
        const int slot = (t - t_lo) % RD;
        wait_vm_bar((t + 1 < t_hi) ? ops : 0);
        if (t + 2 < t_hi) dma_tile<NKC, NVB, RD>(S, t + 2, (t + 2 - t_lo) % RD, lds0, wid, lane);
        const LAS unsigned char* kb = lds + LDS_K + slot * KS + hi * 1024 + r32 * 16;
        f32x16 s0a = __builtin_amdgcn_mfma_f32_32x32x2f32(kext, qea, f32x16{}, 0, 0, 0), s0b = __builtin_amdgcn_mfma_f32_32x32x2f32(kext, qea, f32x16{}, 0, 0, 0);
        f32x16 s1a = __builtin_amdgcn_mfma_f32_32x32x2f32(kext, qeb, f32x16{}, 0, 0, 0), s1b = __builtin_amdgcn_mfma_f32_32x32x2f32(kext, qeb, f32x16{}, 0, 0, 0);
#pragma unroll
        for (int d0 = 0; d0 < NKC / 2; ++d0) {
            const bf16x8 b0 = *(const LAS bf16x8*)(kb + d0 * 2048), b1 = *(const LAS bf16x8*)(kb + d0 * 2048 + 512);
            s0a = __builtin_amdgcn_mfma_f32_32x32x16_bf16(b0, qa[d0], s0a, 0, 0, 0); s0b = __builtin_amdgcn_mfma_f32_32x32x16_bf16(b1, qa[d0], s0b, 0, 0, 0);
            s1a = __builtin_amdgcn_mfma_f32_32x32x16_bf16(b0, qb[d0], s1a, 0, 0, 0); s1b = __builtin_amdgcn_mfma_f32_32x32x16_bf16(b1, qb[d0], s1b, 0, 0, 0); }
        __builtin_amdgcn_sched_barrier(0);
        u32x4 pwa[4], pwb[4];
        const unsigned vb = lds0 + LDS_V + slot * VS + ((lane >> 4) & 1) * 32 + (lane & 3) * 8 + (4 * hi + ((lane & 15) >> 2)) * 64;
        s16x4 lo[NVB][4], hh[NVB][4];
#pragma unroll
        for (int d = 0; d < NVB; ++d)
#pragma unroll
            for (int ks = 0; ks < 4; ++ks) { VTRO(lo[d][ks], vb, d * 4096 + ks * 1024); VTRO(hh[d][ks], vb, d * 4096 + ks * 1024 + 512); }
        __builtin_amdgcn_sched_barrier(0);
        Q64_SM(s0a, s0b, ma, la, oa, pwa, qea);
        asm volatile("s_waitcnt lgkmcnt(0)" ::: "memory"); __builtin_amdgcn_sched_barrier(0);
#pragma unroll
        for (int ks = 0; ks < 4; ++ks)
#pragma unroll
            for (int d = 0; d < NVB; ++d) { const bf16x8 vf = (bf16x8){lo[d][ks][0], lo[d][ks][1], lo[d][ks][2], lo[d][ks][3], hh[d][ks][0], hh[d][ks][1], hh[d][ks][2], hh[d][ks][3]};
                oa[d] = __builtin_amdgcn_mfma_f32_32x32x16_bf16(vf, __builtin_bit_cast(bf16x8, pwa[ks]), oa[d], 0, 0, 0); }
        Q64_SM_NB(s1a, s1b, mb, lb, ob, pwb, qeb);
#pragma unroll
        for (int i = 0; i < 8; ++i) { __builtin_amdgcn_sched_group_barrier(0x008, 1, 0); __builtin_amdgcn_sched_group_barrier(0x002, 12, 0); }
        __builtin_amdgcn_sched_barrier(0);
#pragma unroll
        for (int ks = 0; ks < 4; ++ks)
#pragma unroll
            for (int d = 0; d < NVB; ++d) { const bf16x8 vf = (bf16x8){lo[d][ks][0], lo[d][ks][1], lo[d][ks][2], lo[d][ks][3], hh[d][ks][0], hh[d][ks][1], hh[d][ks][2], hh[d][ks][3]};
                ob[d] = __builtin_amdgcn_mfma_f32_32x32x16_bf16(vf, __builtin_bit_cast(bf16x8, pwb[ks]), ob[d], 0, 0, 0); }
        __builtin_amdgcn_sched_barrier(0);
        first = false;
    }
    const float lia = 1.0f / swapsum(la), lib = 1.0f / swapsum(lb);
#pragma unroll
    for (int d = 0; d < NVB; ++d) { store_o_block(oa[d], lia, S.o + (size_t)r32 * S.opitch + 32 * d, hi); store_o_block(ob[d], lib, S.o + (size_t)(32 + r32) * S.opitch + 32 * d, hi); }
    asm volatile("s_waitcnt lgkmcnt(0)\n\ts_barrier" ::: "memory");
#undef Q64_SM
#undef Q64_SM_
#undef Q64_SM_NB
}

}
#define SC_AFTER_PROLOGUE() do {} while (0)
#define SC_AFTER_INPROJ(l) do {} while (0)
#define SC_AFTER_UP(l) do {} while (0)
#define SC_AFTER_MLA(l) do {} while (0)
#define SC_AFTER_BRANCH(l) do {} while (0)
#define SC_AFTER_WOUT(l) do {} while (0)
#define SC_AFTER_NORM2(l) do {} while (0)
#define SC_AFTER_GU(l) do {} while (0)
#define SC_AFTER_DOWN(l) do {} while (0)
#define SC_AFTER_ROUTE(l) do {} while (0)
#define SC_AFTER_MOEGU(l, h) do {} while (0)
#define SC_AFTER_MOED(l, h) do {} while (0)
#define SC_FINAL() do {} while (0)

struct Args { const float* in[23]; float* out; unsigned char* ws; };
#define WSP(type, off) ((type*)(F.ws + (off)))
#define PHASE() Frame Fp = F; Fp.ws = opq_p(F.ws); Fp.in = opq_p(F.in); Fp.out = opq_p(F.out); Fp.tid = opq_v((int)threadIdx.x); Fp.lane = Fp.tid & 63; Fp.wave = __builtin_amdgcn_readfirstlane(Fp.tid >> 6); (void)Fp
#define FWS(type, off) ((type*)(Fp.ws + (off)))
#define X_ FWS(bf16_t, WS_XB)
#define H_ FWS(bf16_t, WS_H)
#define Pb_ FWS(bf16_t, WS_R + R_P)
#define Gb_ FWS(bf16_t, WS_R + R_G)
#define QB_ FWS(bf16_t, WS_R + R_QB)
#define KVB_ FWS(bf16_t, WS_R + R_KVB)
#define Yb_ FWS(bf16_t, WS_R + R_Y)
#define MEMN_ FWS(bf16_t, WS_MEMN)
#define MEMKV_ FWS(bf16_t, WS_MEMKV)
#define ACT_ FWS(bf16_t, WS_R + R_ACT)
#define ASORT_ FWS(bf16_t, WS_R + R_ASORT)
#define YOUT_ FWS(bf16_t, WS_R + R_YOUT)
#define SSQ_ FWS(float, WS_MISC + MS_SSQ)
#define TEXP_ FWS(const int, WS_MISC + MS_TEXP)
#define POS_ ((const int*)Fp.in[I_POS])
#define HSC_ FWS(float, WS_MISC + MS_HSC)
#define ASC_ FWS(float, WS_MISC + MS_ASC)
#define WSIN_ FWS(float, WS_MISC + MS_WSIN)
#define WSGU_ FWS(float, WS_MISC + MS_WSGU)

#define GRID_BAR() xcd_barrier(bar)
#ifndef WGM_GU
#define WGM_GU 4
#endif
#ifndef WGM_IN
#define WGM_IN 4
#endif
template <int l> __device__ __forceinline__ void layer_body(const Frame& F, const XcdBarrier& bar, const int bx) {
        if (l > 0) {
            PHASE();
            prep_ffn_weights(Fp, l);
            if ((l & 1) != 0) norm_phase(Fp, nullptr, X_, Fp.in[I_GMIX] + l * DM, false, true);
            if ((l & 1) == 0) norm_phase(Fp, nullptr, X_, Fp.in[I_GMIX] + l * DM, true, true);
            GRID_BAR();
        }
        {   PHASE();
            ProbSimple p{DM, DM, DM, (const char*)H_, (const char*)wmix(Fp, l, WL_IN)}; pg8::StaticOrder S; S.init(T / 256, NT_IN, Fp.G, bx, 0, WGM_IN);
            EpiInproj E{Pb_, Gb_, SSQ_, POS_, HSC_, WSIN_ + l * NT_IN * 256}; pg8::gemm_phase<true>(Fp.lds, p, S, E); }
        if (l == 0) { PHASE();
            ProbSimple p{DM, DM * 2, DM * 2, (const char*)MEMN_, (const char*)FWS(bf16_t, WS_WMKV)}; pg8::StaticOrder S; S.init(NB * MEML / 256, 16, Fp.G, (bx + Fp.G / 2) % Fp.G);
            EpiPlain E{MEMKV_, 4096}; pg8::gemm_phase(Fp.lds, p, S, E); }
        GRID_BAR();
        SC_AFTER_INPROJ(l);
        {   PHASE();
            ProbUp p{UPK, PW * 2, UPK * 2, (const char*)(Pb_ + P_CQ), (const char*)wmix(Fp, l, WL_UP)}; pg8::StaticOrder S; S.init(T / 256, UPN / 256, Fp.G, bx);
            EpiUp E{QB_, KVB_, SSQ_, POS_}; pg8::gemm_phase(Fp.lds, p, S, E); }
        {   PHASE();
            for (int i = Fp.vcu; i < 1024; i += Fp.G) {
                const int hl = i & 3, qb = (i >> 2) & 15, kvh = (i >> 6) & 1, b = i >> 7, h = kvh * 4 + hl; const size_t rowb = (size_t)b * SEQ; const int q0 = qb * 256;
                att::Src s; s.q = Pb_ + (rowb + q0 + Fp.wave * 32) * PW + P_QA + h * 64; s.qpitch = PW; s.k0 = Pb_ + rowb * PW + P_KA + kvh * 64; s.k0pitch = PW; s.k1 = s.k0; s.k1pitch = PW;
                s.v = Pb_ + rowb * PW + P_VA + kvh * 64; s.vpitch = PW; s.o = Yb_ + (rowb + q0 + Fp.wave * 32) * YW + h * 64; s.opitch = YW;
                const int t_lo = (q0 / 64 - 2) < 0 ? 0 : (q0 / 64 - 2), t_hi = (q0 / 64 + 6) > SEQ / 64 ? SEQ / 64 : (q0 / 64 + 6);
                att::unit<8, 2, 0>(Fp.lds, s, t_lo, t_hi, q0, Fp.in[I_SINK][l * 8 + h] * LOG2E);
            } }
        {   PHASE();
            for (int i = Fp.vcu; i < 512; i += Fp.G) {
                const int qb = i & 15, h = (i >> 4) & 3, b = i >> 6; const size_t rowq = (size_t)b * SEQ + qb * 256 + Fp.wave * 32;
                att::Src s; s.q = Pb_ + rowq * PW + P_QM + h * 128; s.qpitch = PW; s.k0 = MEMKV_ + (size_t)b * MEML * 4096 + l * 1024 + h * 128; s.k0pitch = 4096; s.k1 = s.k0 + 64; s.k1pitch = 4096;
                s.v = MEMKV_ + (size_t)b * MEML * 4096 + l * 1024 + 512 + h * 128; s.vpitch = 4096; s.o = Yb_ + rowq * YW + 1024 + h * 128; s.opitch = YW;
                att::unit<16, 4, 1>(Fp.lds, s, 0, MEML / 64, 0, 0.f);
            } }
        GRID_BAR();
        SC_AFTER_UP(l);
        {   PHASE();
            for (int i = Fp.vcu; i < 512; i += Fp.G) {
                const int qb = i & 7, h = (i >> 3) & 7, b = i >> 6; const size_t rowb = (size_t)b * SEQ, rowq = rowb + qb * 512 + Fp.wave * 64;
                att::Src s; s.q = QB_ + rowq * QBW + h * 96; s.qpitch = QBW; s.k0 = KVB_ + rowb * KVW + h * 128; s.k0pitch = KVW; s.k1 = Pb_ + rowb * PW + P_KR; s.k1pitch = PW;
                s.v = KVB_ + rowb * KVW + h * 128 + 64; s.vpitch = KVW; s.o = Yb_ + rowq * YW + 512 + h * 64; s.opitch = YW;
                att::unit_q64<12, 2>(Fp.lds, s, 0, SEQ / 64);
            } }
        GRID_BAR();
        SC_AFTER_MLA(l);
        {   PHASE();
            ProbSimple p{1536, YW * 2, 1536 * 2, (const char*)Yb_, (const char*)wmix(Fp, l, WL_BR)}; pg8::StaticOrder S; S.init(T / 256, DM / 256, Fp.G, bx);
            EpiBranch E{(const unsigned char*)Gb_, H_}; pg8::gemm_phase(Fp.lds, p, S, E); }
        GRID_BAR();
        SC_AFTER_BRANCH(l);
        if (l == 0) {   PHASE();
            ProbSimple p{DM, DM * 2, DM * 2, (const char*)H_, (const char*)wmix(Fp, l, WL_OUT)}; pg8::StaticOrder S; S.init(T / 256, DM / 256, Fp.G, bx);
            EpiResid E{Fp.in[I_X], X_}; pg8::gemm_phase(Fp.lds, p, S, E); }
        if (l != 0) {   PHASE();
            ProbSimple p{DM, DM * 2, DM * 2, (const char*)H_, (const char*)wmix(Fp, l, WL_OUT)}; pg8::StaticOrder S; S.init(T / 256, DM / 256, Fp.G, bx);
            EpiResid E{nullptr, X_}; pg8::gemm_phase(Fp.lds, p, S, E); }
        GRID_BAR();
        SC_AFTER_WOUT(l);
        if ((l & 1) == 0) {
            {   PHASE(); norm_phase(Fp, nullptr, X_, Fp.in[I_GFFN] + l * DM, false, GU_I8(l) != 0); }
            GRID_BAR();
            SC_AFTER_NORM2(l);
            {   PHASE();
                constexpr bool i8 = GU_I8(l) != 0; constexpr unsigned eb = i8 ? 1 : 2;
                ProbSimple p{DM, DM * eb, DM * eb, (const char*)H_, (const char*)FWS(bf16_t, WS_WFFN + WF_GU)}; pg8::StaticOrder S; S.init(T / 256, 2 * DFF / 256, Fp.G, bx, 0, WGM_GU);
                EpiSwiglu E{ACT_, 0, HSC_, WSGU_}; pg8::gemm_phase<i8>(Fp.lds, p, S, E); }
            GRID_BAR();
            SC_AFTER_GU(l);
            {   PHASE();
                ProbSimple p{DFF, DFF * 2, DFF * 2, (const char*)ACT_, (const char*)FWS(bf16_t, WS_WFFN + WF_D)}; pg8::StaticOrder S; S.init(T / 256, DM / 256, Fp.G, bx, 1);
                EpiResid E{nullptr, X_}; pg8::gemm_phase(Fp.lds, p, S, E); }
            GRID_BAR();
            SC_AFTER_DOWN(l);
        } else {
            {   PHASE(); norm_router_phase(Fp, X_, Fp.in[I_GFFN] + l * DM, Fp.in[I_WR] + (size_t)(l >> 1) * DM * NE, GU_I8(l) != 0); }
            GRID_BAR();
            {   PHASE(); moe_assign_phase(Fp, GU_I8(l) != 0); }
            GRID_BAR();
            SC_AFTER_ROUTE(l);
            {   constexpr int half = 0; (void)half;
                {   PHASE();
                    const int nrt = __builtin_amdgcn_readfirstlane(TEXP_[MAXRT]);
                    constexpr bool i8 = GU_I8(l) != 0; constexpr unsigned eb = i8 ? 1 : 2;
                    ProbMoe p{DM, DM * eb, DM * eb, (const char*)ASORT_, (const char*)FWS(bf16_t, WS_WFFN + WF_GU), 0}; MoeOrder S; S.base.init(nrt, 2 * DFF / 256, Fp.G, bx, 0, WGM_GU); S.lo = 0; S.texp = TEXP_;
                    EpiSwiglu E{ACT_, 0, ASC_, WSGU_}; pg8::gemm_phase<i8>(Fp.lds, p, S, E); }
                GRID_BAR();
                SC_AFTER_MOEGU(l, half);
                {   PHASE();
                    const int nrt = __builtin_amdgcn_readfirstlane(TEXP_[MAXRT]); const int nmain = nrt < 256 ? nrt : 256;
                    ProbMoe p{DFF, DFF * 2, DFF * 2, (const char*)ACT_, (const char*)FWS(bf16_t, WS_WFFN + WF_D), 0}; MoeOrder S; S.base.init(nmain, DM / 256, Fp.G, bx, 1); S.lo = 0; S.texp = TEXP_;
                    EpiYout E{YOUT_}; pg8::gemm_phase(Fp.lds, p, S, E); }
                {   PHASE();
                    const int nrt = __builtin_amdgcn_readfirstlane(TEXP_[MAXRT]);
                    ProbTail p{DFF / TAIL_KS, DFF * 2, DFF * 2, (const char*)ACT_, (const char*)FWS(bf16_t, WS_WFFN + WF_D)}; TailOrder S{(nrt > 256 ? nrt - 256 : 0) * 4 * TAIL_KS, Fp.G, Fp.vcu, TEXP_};
                    EpiSlab E{FWS(float, WS_SLAB)}; pg8::gemm_phase(Fp.lds, p, S, E); }
                GRID_BAR();
                SC_AFTER_MOED(l, half);
            }
        }
    }

__global__ void __launch_bounds__(NWAVES * 64, 2) fwd(Args args) {
    extern __shared__ __attribute__((aligned(16))) unsigned char lds_raw[];
    Frame F;
    F.lds = (LAS unsigned char*)lds_raw;
    F.MISC = (volatile LAS unsigned*)(F.lds + LDSCTL_OFF);
    F.tid = threadIdx.x; F.lane = F.tid & 63; F.wave = __builtin_amdgcn_readfirstlane(F.tid >> 6);
    F.G = gridDim.x; { const int bx = blockIdx.x; F.vcu = (F.G % 8 == 0) ? (bx % 8) * (F.G / 8) + bx / 8 : bx; }
    F.ws = args.ws; F.ctl = (gu32*)(args.ws + WS_CTL); F.out = args.out;
    F.in = (const float* const*)__builtin_amdgcn_kernarg_segment_ptr();
    for (int u = F.tid; u < (LDS_BYTES - LDSCTL_OFF) / 4; u += NWAVES * 64) ((LAS unsigned*)(F.lds + LDSCTL_OFF))[u] = 0u;
    __syncthreads();
    XcdBarrier bar = xcd_barrier_post((unsigned*)(F.ctl + CW_BAR), F.MISC + 8);

    const int bx = (int)blockIdx.x;

    {   PHASE();
        prep_mixer_weights(Fp);
        memnorm_phase(Fp);
        prep_ffn_weights(Fp, 0);
        norm_phase(Fp, Fp.in[I_X], nullptr, Fp.in[I_GMIX], false, true); }
    GRID_BAR();
    SC_AFTER_PROLOGUE();

    layer_body<0>(F, bar, bx); layer_body<1>(F, bar, bx); layer_body<2>(F, bar, bx); layer_body<3>(F, bar, bx);
    {   PHASE(); final_norm_phase(Fp, X_, Fp.out, Fp.in[I_GFIN], true); }
    SC_FINAL();
}

extern "C" void kernel_launch(void* const* d_in, const int* in_sizes, int n_in, void* d_out, int out_size, void* d_ws, size_t ws_size, hipStream_t stream) {
    static int grid = 0;
    if (grid == 0) {
        if (n_in != 23 || out_size != T * DM || ws_size < WS_END) { fprintf(stderr, "kernel_launch: unexpected problem (n_in %d, out %d, ws %zu < %zu)\n", n_in, out_size, ws_size, (size_t)WS_END); grid = -1; return; }
        int dev = 0, cus = 0;
        if (hipGetDevice(&dev) != hipSuccess || hipDeviceGetAttribute(&cus, hipDeviceAttributeMultiprocessorCount, dev) != hipSuccess) { grid = -1; return; }
        if (hipFuncSetAttribute((const void*)fwd, hipFuncAttributeMaxDynamicSharedMemorySize, LDS_BYTES) != hipSuccess) { fprintf(stderr, "kernel_launch: hipFuncSetAttribute failed\n"); grid = -1; return; }
        int per_cu = 0;
        if (hipOccupancyMaxActiveBlocksPerMultiprocessor(&per_cu, (const void*)fwd, NWAVES * 64, LDS_BYTES) != hipSuccess || per_cu < 1) fprintf(stderr, "kernel_launch: occupancy query says %d\n", per_cu);
        (void)hipGetLastError();
        grid = cus;
    }
    if (grid < 0) return;
    if (hipMemsetAsync((char*)d_ws + WS_CTL, 0, CTL_ZERO_BYTES, stream) != hipSuccess) return;
    Args a{};
    for (int i = 0; i < 23; ++i) a.in[i] = (const float*)d_in[i];
    a.out = (float*)d_out; a.ws = (unsigned char*)d_ws;
    hipLaunchKernelGGL(fwd, dim3(grid), dim3(NWAVES * 64), LDS_BYTES, stream, a);
}
```

```cpp
#include <hip/hip_runtime.h>
#include <cstdio>
#include <cstdint>

#ifndef SELFCHECK
#define SELFCHECK 0
#endif
#ifndef GU_I8_MASK
#define GU_I8_MASK 0xF
#endif
#define GU_I8(l) ((((unsigned)GU_I8_MASK) >> (l)) & 1u)

#define GAS __attribute__((address_space(1)))
#define LAS __attribute__((address_space(3)))
typedef unsigned short bf16_t;
typedef short bf16x8 __attribute__((ext_vector_type(8)));
typedef short s16x4 __attribute__((ext_vector_type(4)));
typedef short v4i16_t __attribute__((ext_vector_type(4)));
typedef float f32x2 __attribute__((ext_vector_type(2)));
typedef float f32x4 __attribute__((ext_vector_type(4)));
typedef float f32x16 __attribute__((ext_vector_type(16)));
typedef unsigned u32x2 __attribute__((ext_vector_type(2)));
typedef unsigned u32x4 __attribute__((ext_vector_type(4)));
typedef int i32x4 __attribute__((ext_vector_type(4)));
typedef GAS unsigned gu32;
#define RLX_AGENT __ATOMIC_RELAXED, __HIP_MEMORY_SCOPE_AGENT

constexpr int NB = 8, SEQ = 4096, T = NB * SEQ, DM = 1024, DEPTH = 4, MEML = 256, DFF = 3584, NE = 8;
constexpr int INW = 4768;
constexpr int PW = 1792;
constexpr int GW = 3072;
constexpr int QBW = 768, KVW = 1024, YW = 1536;
constexpr int NT_IN = 19;
constexpr int P_QA = 0, P_KA = 512, P_VA = 640, P_CQ = 768, P_CKV = 1024, P_KR = 1152, P_QM = 1280;
constexpr int UPK = 256, UPN = 1792;
constexpr int MAXSLOT = 67584;
constexpr int MAXRT = MAXSLOT / 256;
constexpr float EPS = 1e-6f;
constexpr float LOG2E = 1.4426950408889634f;
constexpr float C_A = 0.125f * LOG2E;
constexpr float C_B = 0.10206207261596575f * LOG2E;
constexpr float C_M = 0.08838834764831845f * LOG2E;

constexpr size_t MiB = 1u << 20;
constexpr size_t WS_CTL = 0, CTL_ZERO_BYTES = 1 * MiB;
constexpr size_t WS_MISC = 1 * MiB;
constexpr size_t WL_IN = 0, WL_UP = (size_t)NT_IN * 256 * DM * 2, WL_BR = WL_UP + (size_t)UPN * UPK * 2, WL_OUT = WL_BR + (size_t)3 * DM * 512 * 2, WL_SIZE = WL_OUT + (size_t)DM * DM * 2;
constexpr size_t WS_WMIX = 8 * MiB;
constexpr int TAIL_KS = 4;
constexpr size_t WS_SLAB = WS_WMIX;
constexpr size_t WS_WMKV = WS_WMIX + 4 * ((WL_SIZE + MiB - 1) / MiB) * MiB;
constexpr size_t WL_STRIDE = ((WL_SIZE + MiB - 1) / MiB) * MiB;
constexpr size_t WS_WFFN = WS_WMKV + 8 * MiB;
constexpr size_t WF_GU = 0, WF_D = (size_t)2 * DFF * DM * 2, WF_STRIDE = WF_D + (size_t)DM * DFF * 2;
constexpr size_t WS_H = WS_WFFN + 8 * WF_STRIDE;
constexpr size_t WS_MEMN = WS_H + (size_t)T * DM * 2;
constexpr size_t WS_MEMKV = WS_MEMN + (size_t)NB * MEML * DM * 2;
constexpr size_t WS_R = WS_MEMKV + (size_t)NB * MEML * 4096 * 2;
constexpr size_t R_P = 0, R_G = R_P + (size_t)T * PW * 2, R_QB = R_G + (size_t)T * GW * 2, R_KVB = R_QB + (size_t)T * QBW * 2, R_Y = R_KVB + (size_t)T * KVW * 2, R_END_MIX = R_Y + (size_t)T * YW * 2;
constexpr size_t R_ACT = 0;
constexpr size_t R_ASORT = (size_t)MAXSLOT * DFF * 2;
constexpr size_t R_YOUT = R_ASORT;
constexpr size_t R_END_FFN = R_YOUT + (size_t)MAXSLOT * DM * 2;
constexpr size_t R_SIZE = R_END_MIX > R_END_FFN ? R_END_MIX : R_END_FFN;
constexpr size_t WS_XB = WS_R + R_SIZE;
constexpr size_t WS_END = WS_XB + (size_t)T * DM * 2;
static_assert(WS_END < 1020ull * MiB, "workspace budget");
static_assert((size_t)8 * 4 * TAIL_KS * 256 * 256 * 4 <= 2 * WL_STRIDE, "tail slabs fit two layers' mixer weights");
constexpr size_t MS_TOKE = 0;
constexpr size_t MS_TOKW = MS_TOKE + (size_t)T * 8;
constexpr size_t MS_SLOT = MS_TOKW + (size_t)T * 8;
constexpr size_t MS_CNT = MS_SLOT + (size_t)T * 8;
constexpr size_t MS_TEXP = MS_CNT + 256 * 8 * 4;
constexpr size_t MS_SSQ = MS_TEXP + 2048;
constexpr size_t MS_SNAP = MS_SSQ + (size_t)T * 32;
constexpr size_t MS_HSC = MS_SNAP + 64 * 1024 * 4;
constexpr size_t MS_ASC = MS_HSC + (size_t)T * 4;
constexpr size_t MS_WSIN = MS_ASC + (size_t)MAXSLOT * 4;
constexpr size_t MS_WSGU = MS_WSIN + (size_t)4 * NT_IN * 256 * 4;
constexpr size_t MS_END = MS_WSGU + (size_t)8 * 2 * DFF * 4;
static_assert(MS_END <= 7 * MiB, "misc map");
constexpr int CW_BAR = 4096;
constexpr int CW_DIAG = 16384;
constexpr int CW_CODE = 16384 + 512;

constexpr int RING_BYTES = 131072;
constexpr int LDSCTL_OFF = RING_BYTES;
constexpr int LDS_BYTES = 147456;
constexpr int NWAVES = 8;

#define LDS_WAIT() asm volatile("s_waitcnt lgkmcnt(0)" ::: "memory")
#define VM_WAIT() asm volatile("s_waitcnt vmcnt(0)" ::: "memory")

__device__ __forceinline__ unsigned f2bf(float f) { unsigned u = __builtin_bit_cast(unsigned, f); return (u + 0x7fffu + ((u >> 16) & 1u)) >> 16; }
__device__ __forceinline__ unsigned pk2(float lo, float hi) { return f2bf(lo) | (f2bf(hi) << 16); }
__device__ __forceinline__ float bf2f(unsigned short b) { return __builtin_bit_cast(float, (unsigned)b << 16); }
__device__ __forceinline__ float bflo(unsigned w) { return __builtin_bit_cast(float, w << 16); }
__device__ __forceinline__ float bfhi(unsigned w) { return __builtin_bit_cast(float, w & 0xffff0000u); }
typedef __bf16 bf16x2_t __attribute__((ext_vector_type(2)));
__device__ __forceinline__ unsigned cvtpk(float lo, float hi) { f32x2 v = {lo, hi}; bf16x2_t b = __builtin_convertvector(v, bf16x2_t); return __builtin_bit_cast(unsigned, b); }
__device__ __forceinline__ float wave_sum(float v) {
#pragma unroll
    for (int o = 1; o < 64; o <<= 1) v += __shfl_xor(v, o);
    return v;
}
__device__ __forceinline__ float fast_sigmoid(float x) { return __builtin_amdgcn_rcpf(1.0f + __builtin_amdgcn_exp2f(-x * LOG2E)); }


__device__ __forceinline__ int opq_v(int x) { asm volatile("" : "+v"(x)); return x; }
__device__ __forceinline__ int opq_s(int x) { asm volatile("" : "+s"(x)); return x; }
template <class Tp> __device__ __forceinline__ Tp* opq_p(Tp* p) { const unsigned long long u = (unsigned long long)p; unsigned lo = __builtin_amdgcn_readfirstlane((unsigned)u), hi = __builtin_amdgcn_readfirstlane((unsigned)(u >> 32)); asm volatile("" : "+s"(lo), "+s"(hi)); return (Tp*)(((unsigned long long)hi << 32) | lo); }

__constant__ float IFR_HI[32] = {1.591549367e-01f, 1.193493679e-01f, 8.949939907e-02f, 6.711508334e-02f, 5.032921210e-02f, 3.774158657e-02f, 2.830219641e-02f, 2.122365311e-02f, 1.591549441e-02f, 1.193493698e-02f, 8.949940093e-03f, 6.711508147e-03f, 5.032921210e-03f, 3.774158424e-03f, 2.830219688e-03f, 2.122365171e-03f, 1.591549488e-03f, 1.193493721e-03f, 8.949940093e-04f, 6.711508031e-04f, 5.032921326e-04f, 3.774158540e-04f, 2.830219455e-04f, 2.122365258e-04f, 1.591549371e-04f, 1.193493736e-04f, 8.949940093e-05f, 6.711508468e-05f, 5.032921035e-05f, 3.774158540e-05f, 2.830219637e-05f, 2.122365186e-05f};
__constant__ float IFR_LO[32] = {6.420638243e-09f, 2.294664903e-09f, 2.542919653e-09f, -3.316028840e-10f, 5.173299289e-12f, -1.848551645e-09f, -5.826552019e-10f, -3.431038786e-10f, -1.029942243e-10f, 4.320196978e-11f, 6.802745173e-11f, 1.531042237e-10f, 5.173301024e-13f, 4.797548470e-11f, -1.048316434e-10f, 1.053879969e-10f, -5.686555046e-11f, -1.896286773e-11f, 6.802744999e-12f, 2.695195456e-11f, -1.158979943e-11f, -6.843983713e-12f, 1.279990003e-11f, 1.807650600e-12f, 5.954976963e-12f, -3.351478166e-12f, 6.802745216e-13f, -1.670379113e-12f, 1.751403167e-12f, -6.843983930e-13f, -5.389994549e-13f, 9.083608431e-13f};
__device__ __forceinline__ void rot_cs(float posf, int idx, float& c, float& s) {
    const float ch = IFR_HI[idx], cl = IFR_LO[idx];
    const float p = posf * ch, e = __builtin_fmaf(posf, ch, -p);
    const float fr = __builtin_amdgcn_fractf(p) + (e + posf * cl);
    s = __builtin_amdgcn_sinf(fr); c = __builtin_amdgcn_cosf(fr);
}

#define XB_TMO      128
#define XB_XCNT(j)  (256  + 64 * (j))
#define XB_XSUB(j)  (1280 + 64 * (j))
#define XB_XGEN(j)  (2304 + 64 * (j))
#define XB_TOP      3328
#define XB_TOPGEN   3392
#define XCD_BAR_WORDS 3456
#define XB_SPIN_CAP (1u << 20)

__device__ __forceinline__ unsigned xb_ld(unsigned* p)              { return __hip_atomic_load(p, __ATOMIC_RELAXED, __HIP_MEMORY_SCOPE_AGENT); }
__device__ __forceinline__ unsigned xb_add(unsigned* p, unsigned v) { return __hip_atomic_fetch_add(p, v, __ATOMIC_RELAXED, __HIP_MEMORY_SCOPE_AGENT); }
__device__ __forceinline__ unsigned xb_xcc_id() { return (unsigned)__builtin_amdgcn_s_getreg((3 << 11) | 20) & 0xFu; }
#define XB_SPIN(cond, bar) do { unsigned _sp = 0; while (cond) { __builtin_amdgcn_s_sleep(1); \
    if ((++_sp & 255u) == 0u) { if (xb_ld(&(bar)[XB_TMO])) break; if (_sp > XB_SPIN_CAP) { atomicAdd(&(bar)[XB_TMO], 1u); break; } } } } while (0)

struct XcdBarrier { unsigned* bar; unsigned x; volatile LAS unsigned* st; };

__device__ __forceinline__ XcdBarrier xcd_barrier_post(unsigned* bar, volatile LAS unsigned* st) {
    XcdBarrier b; b.bar = bar; b.x = xb_xcc_id(); b.st = st;
    if (threadIdx.x == 0) (void)xb_add(&bar[XB_XCNT(b.x)], 1u);
    return b;
}
__device__ __forceinline__ void xcd_barrier_complete(unsigned* bar, unsigned x, unsigned& nloc, unsigned& nx) {
    const unsigned G = gridDim.x * gridDim.y * gridDim.z;
    unsigned sum, cnt, mine, sp = 0u;
    for (;;) {
        sum = 0u; cnt = 0u; mine = 0u;
#pragma unroll
        for (unsigned j = 0; j < 16; ++j) { const unsigned c = xb_ld(&bar[XB_XCNT(j)]); sum += c; cnt += (c > 0u) ? 1u : 0u; mine = (j == x) ? c : mine; }
        if (sum == G) break;
        __builtin_amdgcn_s_sleep(1);
        if ((++sp & 255u) == 0u) { if (xb_ld(&bar[XB_TMO])) break; if (sp > XB_SPIN_CAP) { atomicAdd(&bar[XB_TMO], 1u); break; } }
    }
    nloc = mine > 0u ? mine : 1u; nx = cnt > 0u ? cnt : 1u;
}
__device__ __forceinline__ void xcd_barrier(const XcdBarrier& b) {
    asm volatile("s_waitcnt vmcnt(0)" ::: "memory");
    __syncthreads();
    if (threadIdx.x == 0) {
        unsigned* bar = b.bar;
        __builtin_amdgcn_s_waitcnt(0);
        unsigned nloc = b.st[0], nx = b.st[1];
        if (nloc == 0u) { xcd_barrier_complete(bar, b.x, nloc, nx); b.st[0] = nloc; b.st[1] = nx; }
        const unsigned old = xb_add(&bar[XB_XSUB(b.x)], 1u);
        const unsigned gen = old / nloc;
        if (old + 1u == (gen + 1u) * nloc) {
            __builtin_amdgcn_fence(__ATOMIC_RELEASE, "agent");
            asm volatile("s_waitcnt vmcnt(0)" ::: "memory");
            const unsigned og = xb_add(&bar[XB_TOP], 1u);
            const unsigned tg = og / nx;
            if (og + 1u == (tg + 1u) * nx) xb_add(&bar[XB_TOPGEN], 1u);
            else XB_SPIN(xb_ld(&bar[XB_TOPGEN]) == tg, bar);
            __builtin_amdgcn_fence(__ATOMIC_ACQUIRE, "agent");
            xb_add(&bar[XB_XGEN(b.x)], 1u);
            asm volatile("s_waitcnt vmcnt(0)" ::: "memory");
        } else {
            XB_SPIN(xb_ld(&bar[XB_XGEN(b.x)]) == gen, bar);
            __builtin_amdgcn_fence(__ATOMIC_ACQUIRE, "agent");
            asm volatile("s_waitcnt vmcnt(0)" ::: "memory");
        }
    }
    __syncthreads();
}

namespace pg8 {
constexpr int BM = 256, BK = 64, HALF = 128, HTB = HALF * BK * 2, STAGE_BYTES = 8 * HTB, NXCD = 8, WGM = 4;
constexpr int ESC_OFF = 131072 + 4096, ESC_SLOT = 3072;
__host__ __device__ __forceinline__ int lds_byte(int r, int c) { const int st = (r >> 4) * 2 + (c >> 5), rr = r & 15, cc = c & 31, ob = rr * 64 + cc * 2; return st * 1024 + (ob ^ (((ob >> 9) & 1) << 5)); }
__host__ __device__ __forceinline__ void stage_rc(int b, int& R, int& C) { const int st = b / 1024, sb = b % 1024, swz = sb ^ (((sb >> 9) & 1) << 5); R = (st >> 1) * 16 + swz / 64; C = (st & 1) * 32 + (swz % 64) / 2; }

struct Unit { int pm, pn, aux; };

struct StaticOrder {
    int nM, nN, nwg, G, c, rev, wgm;
    __device__ void init(int nM_, int nN_, int G_, int c_, int rev_ = 0, int wgm_ = WGM) { nM = nM_; nN = nN_; nwg = nM * nN; G = G_; c = c_; rev = rev_; wgm = wgm_; }
    __device__ bool next(int i, Unit& u) const {
        const long L = (long)i * G + c; if (L >= nwg) return false;
        int wgid = (int)L; { const int q = nwg / NXCD, r = nwg % NXCD, xcd = wgid % NXCD, off = wgid / NXCD; wgid = (xcd < r ? xcd * (q + 1) : r * (q + 1) + (xcd - r) * q) + off; }
        const int nig = wgm * nN, gid = wgid / nig, fm = gid * wgm, gsz = (nM - fm) < wgm ? (nM - fm) : wgm;
        u.pm = fm + ((wgid % nig) % gsz); u.pn = (wgid % nig) / gsz; u.aux = 0; if (rev) u.pm = nM - 1 - u.pm; return true;
    }
};

template <bool I8> struct AccVec { typedef f32x4 type; };
template <> struct AccVec<true> { typedef i32x4 type; };
template <bool I8 = false, class Prob, class Sched, class Epi>
__device__ __forceinline__ void gemm_phase(LAS unsigned char* lds, const Prob& P, const Sched& S, const Epi& E) {
    const int tid = opq_v((int)threadIdx.x), wid = __builtin_amdgcn_readfirstlane(tid >> 6), lane = tid & 63, wr = wid >> 2, wc = wid & 3, fr = lane & 15, fq = lane >> 4;
    typedef typename AccVec<I8>::type accv_t;
    const int K = P.K, nt = K / (I8 ? 2 * BK : BK);
    unsigned voffA[2], voffB[2];
#pragma unroll
    for (int i = 0; i < 2; ++i) { int R, C; stage_rc(tid * 16 + i * 8192, R, C); voffA[i] = (unsigned)R * P.lda + (unsigned)C * 2u; voffB[i] = (unsigned)R * P.ldb + (unsigned)C * 2u; }
    const size_t kstep = (size_t)(BK * 2);
    const size_t hstepA = (size_t)HALF * P.lda, hstepB = (size_t)HALF * P.ldb;
    const unsigned ldsw = (unsigned)wid * 1024u;
    const int aoff = lds_byte(wr * 64 + fr, fq * 8), boff = lds_byte(wc * 32 + fr, fq * 8);
#define PG8_SA(b, h) (((b) * 2 + (h)) * HTB)
#define PG8_SB(b, h) ((4 + (b) * 2 + (h)) * HTB)
#define PG8_STAGE(bufoff, gbase, voff) do { _Pragma("unroll") for (int _i = 0; _i < 2; ++_i) \
        __builtin_amdgcn_global_load_lds((const unsigned*)((const char*)(gbase) + (voff)[_i]), (LAS unsigned*)(lds + (bufoff) + ldsw + _i * 8192), 16, 0, 0); } while (0)
#define PG8_LDA(dst, b, h) do { _Pragma("unroll") for (int m = 0; m < 4; ++m) _Pragma("unroll") for (int k = 0; k < 2; ++k) dst[m][k] = *(const LAS bf16x8*)(lds + PG8_SA(b, h) + aoff + m * 2048 + k * 1024); } while (0)
#define PG8_LDB(dst, b, h) do { _Pragma("unroll") for (int n = 0; n < 2; ++n) _Pragma("unroll") for (int k = 0; k < 2; ++k) dst[n][k] = *(const LAS bf16x8*)(lds + PG8_SB(b, h) + boff + n * 2048 + k * 1024); } while (0)
#define PG8_MMA(ai, bj, At, Bt) do { __builtin_amdgcn_s_setprio(1); _Pragma("unroll") for (int m = 0; m < 4; ++m) _Pragma("unroll") for (int n = 0; n < 2; ++n) _Pragma("unroll") for (int k = 0; k < 2; ++k) \
        { if constexpr (I8) acc[ai][bj][m][n] = __builtin_amdgcn_mfma_i32_16x16x64_i8(__builtin_bit_cast(i32x4, Bt[n][k]), __builtin_bit_cast(i32x4, At[m][k]), acc[ai][bj][m][n], 0, 0, 0); \
          else acc[ai][bj][m][n] = __builtin_amdgcn_mfma_f32_16x16x32_bf16(Bt[n][k], At[m][k], acc[ai][bj][m][n], 0, 0, 0); } __builtin_amdgcn_s_setprio(0); } while (0)
#define PG8_WAIT_V(n) asm volatile("s_waitcnt vmcnt(" #n ")" ::: "memory")
#define PG8_WAIT_L(n) asm volatile("s_waitcnt lgkmcnt(" #n ")" ::: "memory")
#define PG8_BAR __builtin_amdgcn_s_barrier()
#define PG8_SCHED __builtin_amdgcn_sched_barrier(0)
    Unit cur, nxt; int ui = 0;
    if (!S.next(0, cur)) return;
    accv_t acc[2][2][4][2];
#pragma unroll
    for (int a = 0; a < 2; ++a)
#pragma unroll
        for (int b = 0; b < 2; ++b)
#pragma unroll
            for (int m = 0; m < 4; ++m)
#pragma unroll
                for (int n = 0; n < 2; ++n) acc[a][b][m][n] = accv_t{};
    bf16x8 At[4][2], B0[2][2], B1[2][2];
    const char* cA = P.a_ptr(cur); const char* cB = P.b_ptr(cur);
    int eslot = 0;
    E.stage(lds + ESC_OFF, cur, wid, lane);
    PG8_STAGE(PG8_SB(0, 0), cB, voffB); PG8_STAGE(PG8_SB(0, 1), cB + hstepB, voffB); PG8_STAGE(PG8_SA(0, 0), cA, voffA); PG8_STAGE(PG8_SA(0, 1), cA + hstepA, voffA);
    if (wr == 1) PG8_BAR;
    PG8_WAIT_V(2); PG8_BAR;
    PG8_STAGE(PG8_SB(1, 0), cB + kstep, voffB); PG8_STAGE(PG8_SA(1, 0), cA + kstep, voffA); PG8_STAGE(PG8_SB(1, 1), cB + hstepB + kstep, voffB);
    PG8_WAIT_V(6); PG8_BAR;
    for (;;) {
        const bool has_next = S.next(ui + 1, nxt);
        const char* nA = has_next ? P.a_ptr(nxt) : cA; const char* nB = has_next ? P.b_ptr(nxt) : cB;
        for (int t = 0; t < nt; t += 2) {
            if constexpr (Epi::MID) { if (t == 8 || t == 16) E.mid(acc, cur, t >> 3, wr, wc, fr, fq); }
            const bool last = (t == nt - 2);
            if (last && has_next) E.stage(lds + ESC_OFF + (eslot ^ 1) * ESC_SLOT, nxt, wid, lane);
            const char* a1 = cA + (size_t)(t + 1) * kstep;
            const char* a2 = last ? nA : cA + (size_t)(t + 2) * kstep; const char* b2 = last ? nB : cB + (size_t)(t + 2) * kstep;
            const char* a3 = a2 + kstep; const char* b3 = b2 + kstep;
            PG8_LDB(B0, 0, 0); PG8_LDB(B1, 0, 1); PG8_SCHED; PG8_LDA(At, 0, 0); PG8_STAGE(PG8_SA(1, 1), a1 + hstepA, voffA);
            PG8_WAIT_V(8); PG8_WAIT_L(0); PG8_BAR; PG8_MMA(0, 0, At, B0); PG8_MMA(0, 1, At, B1); PG8_BAR; PG8_SCHED;
            PG8_LDA(At, 0, 1); PG8_STAGE(PG8_SB(0, 0), b2, voffB); PG8_STAGE(PG8_SB(0, 1), b2 + hstepB, voffB); PG8_STAGE(PG8_SA(0, 0), a2, voffA);
            PG8_WAIT_V(8); PG8_WAIT_L(0); PG8_BAR; PG8_MMA(1, 0, At, B0); PG8_MMA(1, 1, At, B1); PG8_BAR; PG8_SCHED;
            PG8_LDB(B0, 1, 0); PG8_LDB(B1, 1, 1); PG8_SCHED; PG8_LDA(At, 1, 0); PG8_STAGE(PG8_SA(0, 1), a2 + hstepA, voffA);
            PG8_WAIT_V(8); PG8_WAIT_L(0); PG8_BAR; PG8_MMA(0, 0, At, B0); PG8_MMA(0, 1, At, B1); PG8_BAR; PG8_SCHED;
            PG8_LDA(At, 1, 1); PG8_STAGE(PG8_SB(1, 0), b3, voffB); PG8_STAGE(PG8_SB(1, 1), b3 + hstepB, voffB); PG8_STAGE(PG8_SA(1, 0), a3, voffA);
            PG8_WAIT_V(8); PG8_WAIT_L(0); PG8_BAR; PG8_MMA(1, 0, At, B0); PG8_MMA(1, 1, At, B1); PG8_BAR; PG8_SCHED;
        }
        if (wr == 0) PG8_BAR;
        E(acc, cur, wr, wc, fr, fq, lds + ESC_OFF + eslot * ESC_SLOT);
        if (!has_next) break;
#pragma unroll
        for (int a = 0; a < 2; ++a)
#pragma unroll
            for (int b = 0; b < 2; ++b)
#pragma unroll
                for (int m = 0; m < 4; ++m)
#pragma unroll
                    for (int n = 0; n < 2; ++n) acc[a][b][m][n] = accv_t{};
        cur = nxt; cA = nA; cB = nB; ++ui; eslot ^= 1;
        if (wr == 1) PG8_BAR;
    }
    PG8_WAIT_V(0);
    PG8_BAR;
#undef PG8_SA
#undef PG8_SB
#undef PG8_STAGE
#undef PG8_LDA
#undef PG8_LDB
#undef PG8_MMA
#undef PG8_WAIT_V
#undef PG8_WAIT_L
#undef PG8_BAR
#undef PG8_SCHED
}
}

struct Frame {
    LAS unsigned char* lds;
    volatile LAS unsigned* MISC;
    gu32* ctl;
    unsigned char* ws;
    int tid, lane, wave, vcu, G;
    const float* const* in; float* out;
};
enum { I_X = 0, I_MEM, I_POS, I_GMIX, I_WIN, I_GQ, I_WUQ, I_GKV, I_WUKV, I_SINK, I_WMKV, I_WBR, I_WOUT, I_GFFN, I_WGD, I_WUD, I_WDD, I_WR, I_WGE, I_WUE, I_WDE, I_GMEM, I_GFIN };

__device__ __forceinline__ int sem_plain(int g) { return (g & ~31) + 8 * ((g >> 2) & 3) + 4 * ((g >> 4) & 1) + (g & 3); }
__device__ __forceinline__ int sem_rot64(int g) { return (g & ~63) + 32 * ((g >> 4) & 1) + 16 * ((g >> 5) & 1) + 4 * ((g >> 2) & 3) + (g & 3); }
__device__ __forceinline__ int sem_p16(int g) { const int c = g & 255; return (g & ~255) + 64 * ((c >> 5) & 3) + 16 * ((c >> 2) & 3) + 8 * (c >> 7) + 4 * ((c >> 4) & 1) + (c & 3); }
__device__ __forceinline__ int inproj_src(int n) {
    const int pn = n >> 8, c = n & 255;
    if (pn < 2) return pn * 256 + sem_rot64(c);
    if (pn == 2) return c < 128 ? 512 + sem_rot64(c) : 640 + sem_plain(c - 128);
    if (pn == 3) return 768 + sem_plain(c);
    if (pn == 4) return c < 128 ? 1024 + sem_plain(c) : (c < 160 ? 1152 + (c - 128) : -1);
    if (pn < 7) return 1184 + (pn - 5) * 256 + sem_plain(c);
    return 1696 + (pn - 7) * 256 + sem_p16(c);
}

struct MapInproj { const float* W; __device__ __forceinline__ float load(int k, int n) const { const int s = inproj_src(n); return s >= 0 ? W[(size_t)k * INW + s] : 0.f; }
    __device__ __forceinline__ f32x4 load4(int k, int n) const { const int s = inproj_src(n); return s >= 0 ? *(const f32x4*)(W + (size_t)k * INW + s) : (f32x4){0.f, 0.f, 0.f, 0.f}; } };
struct MapUp { const float *Wq, *Wkv, *gq, *gkv;
    __device__ __forceinline__ f32x4 load4(int k, int n) const {
        if (n < 768) { const int gg = n >> 5; const int s = (gg % 3 == 2) ? n : sem_plain(n); return *(const f32x4*)(Wq + (size_t)k * 768 + s) * gq[k]; }
        if (k < 128) return (f32x4){0.f, 0.f, 0.f, 0.f}; const int s = sem_plain(n - 768); return *(const f32x4*)(Wkv + (size_t)(k - 128) * 1024 + s) * gkv[k - 128]; }
    __device__ __forceinline__ float load(int k, int n) const {
        if (n < 768) { const int gg = n >> 5; const int s = (gg % 3 == 2) ? n : sem_plain(n); return gq[k] * Wq[(size_t)k * 768 + s]; }
        if (k < 128) return 0.f; const int s = sem_plain(n - 768); return gkv[k - 128] * Wkv[(size_t)(k - 128) * 1024 + s]; } };
struct MapPlain { const float* W; int ldw; __device__ __forceinline__ float load(int k, int n) const { return W[(size_t)k * ldw + sem_plain(n)]; }
    __device__ __forceinline__ f32x4 load4(int k, int n) const { return *(const f32x4*)(W + (size_t)k * ldw + sem_plain(n)); } };
struct MapNat { const float* W; int ldw; __device__ __forceinline__ float load(int k, int n) const { return W[(size_t)k * ldw + n]; }
    __device__ __forceinline__ f32x4 load4(int k, int n) const { return *(const f32x4*)(W + (size_t)k * ldw + n); } };
struct MapBr { const float* W;
    __device__ __forceinline__ float load(int k, int n) const { return W[(size_t)k * DM + sem_p16(n)]; }
    __device__ __forceinline__ f32x4 load4(int k, int n) const { return *(const f32x4*)(W + (size_t)k * DM + sem_p16(n)); } };
struct MapMemkv { const float* W; __device__ __forceinline__ float load(int k, int n) const { const int l = n >> 10, c = n & 1023; return W[((size_t)l * DM + k) * 1024 + sem_plain(c)]; }
    __device__ __forceinline__ f32x4 load4(int k, int n) const { const int l = n >> 10, c = n & 1023; return *(const f32x4*)(W + ((size_t)l * DM + k) * 1024 + sem_plain(c)); } };
struct MapGU { const float *Wg, *Wu; __device__ __forceinline__ float load(int k, int n) const { const int pn = n >> 8, c = n & 255; const int ch = 128 * pn + sem_plain(c & 127);
    const unsigned long long a = (unsigned long long)Wg, b = (unsigned long long)Wu, w = a ^ ((a ^ b) & (0ull - (unsigned long long)(c >> 7))); return ((const float*)w)[(size_t)k * DFF + ch]; }
    __device__ __forceinline__ f32x4 load4(int k, int n) const { const int pn = n >> 8, c = n & 255; const int ch = 128 * pn + sem_plain(c & 127);
        const unsigned long long a = (unsigned long long)Wg, b = (unsigned long long)Wu, w = a ^ ((a ^ b) & (0ull - (unsigned long long)(c >> 7))); return *(const f32x4*)((const float*)w + (size_t)k * DFF + ch); } };

template <class M> __device__ __forceinline__ void prep_item(const M& m, bf16_t* dst, int Kd, int nblk, LAS float* scr, int item, int lane) {
    const int kb = item / nblk, nb = item % nblk, k0 = 64 * kb, n0 = 32 * nb;
#pragma unroll 8
    for (int i = 0; i < 32; ++i) { const int kk = 2 * i + (lane >> 5); scr[kk * 33 + (lane & 31)] = m.load(k0 + kk, n0 + (lane & 31)); }
    LDS_WAIT(); asm volatile("" ::: "memory");
    const int c = lane & 7;
#pragma unroll
    for (int j = 0; j < 4; ++j) { const int n = (lane >> 3) + 8 * j; const LAS float* s = scr + (8 * c) * 33 + n;
        u32x4 o; o.x = pk2(s[0 * 33], s[1 * 33]); o.y = pk2(s[2 * 33], s[3 * 33]); o.z = pk2(s[4 * 33], s[5 * 33]); o.w = pk2(s[6 * 33], s[7 * 33]);
        *(u32x4*)(dst + (size_t)(n0 + n) * Kd + k0 + 8 * c) = o; }
    LDS_WAIT(); asm volatile("" ::: "memory");
}
template <class M> __device__ __forceinline__ void prep_tile(const M& m, bf16_t* dst, int Kd, int nblk, LAS unsigned char* tile, int item, int lane) {
    const int kb = item / nblk, nb = item % nblk, k0 = 128 * kb, n0 = 32 * nb, ng = lane & 7, kr = lane >> 3;
    f32x4 v[16];
#pragma unroll
    for (int i = 0; i < 16; ++i) v[i] = m.load4(k0 + 8 * i + kr, n0 + 4 * ng);
#pragma unroll
    for (int i = 0; i < 16; ++i)
#pragma unroll
        for (int c = 0; c < 4; ++c) *(LAS unsigned short*)(tile + (4 * ng + c) * 272 + (8 * i + kr) * 2) = (unsigned short)f2bf(v[i][c]);
    LDS_WAIT(); asm volatile("" ::: "memory");
#pragma unroll
    for (int j = 0; j < 8; ++j) { const int p = lane + 64 * j, n = p >> 4, kc = p & 15;
        *(u32x4*)(dst + (size_t)(n0 + n) * Kd + k0 + 8 * kc) = *(const LAS u32x4*)(tile + n * 272 + 16 * kc); }
    LDS_WAIT(); asm volatile("" ::: "memory");
}
template <class M> __device__ __forceinline__ void prep_matrix(Frame& F, const M& m, bf16_t* dst, int N, int K) {
    LAS unsigned char* tile = F.lds + F.wave * 16384;
    const int gw = F.vcu * NWAVES + F.wave, NGW = F.G * NWAVES, nblk = N / 32, nitems = (K / 128) * nblk;
    for (int it = gw; it < nitems; it += NGW) prep_tile(m, dst, K, nblk, tile, it, F.lane);
}

template <class M> __device__ __forceinline__ void prep_strip_i8(Frame& F, const M& m, signed char* dst, float* scl, int strip) {
    const int lane = F.lane, w = F.wave, n0 = strip * 32, k0 = w * 128, ng = lane & 7, kr = lane >> 3;
    LAS unsigned char* tile = F.lds + w * 16384;
    LAS float* amt = (LAS float*)(F.lds + LDSCTL_OFF + 2048);
    f32x4 v[16];
#pragma unroll
    for (int i = 0; i < 16; ++i) v[i] = m.load4(k0 + 8 * i + kr, n0 + 4 * ng);
    f32x4 am = __builtin_elementwise_abs(v[0]);
#pragma unroll
    for (int i = 1; i < 16; ++i) am = __builtin_elementwise_max(am, __builtin_elementwise_abs(v[i]));
#pragma unroll
    for (int c = 0; c < 4; ++c) { float a = am[c]; a = fmaxf(a, __shfl_xor(a, 8)); a = fmaxf(a, __shfl_xor(a, 16)); a = fmaxf(a, __shfl_xor(a, 32)); am[c] = a; }
    if (kr == 0) *(LAS f32x4*)(amt + w * 32 + 4 * ng) = am;
    __syncthreads();
    f32x4 cm = *(const LAS f32x4*)(amt + 4 * ng);
#pragma unroll
    for (int ww = 1; ww < 8; ++ww) cm = __builtin_elementwise_max(cm, *(const LAS f32x4*)(amt + ww * 32 + 4 * ng));
    f32x4 inv;
#pragma unroll
    for (int c = 0; c < 4; ++c) inv[c] = cm[c] > 0.f ? 127.0f / cm[c] : 0.f;
    if (w == 0 && kr == 0) *(f32x4*)(scl + n0 + 4 * ng) = cm * (1.0f / 127.0f);
#pragma unroll
    for (int i = 0; i < 16; ++i)
#pragma unroll
        for (int c = 0; c < 4; ++c) tile[(4 * ng + c) * 144 + 8 * i + kr] = (unsigned char)(signed char)__float2int_rn(v[i][c] * inv[c]);
    LDS_WAIT(); asm volatile("" ::: "memory");
#pragma unroll
    for (int j = 0; j < 4; ++j) { const int p = lane + 64 * j, n = p >> 3, kc = p & 7;
        *(u32x4*)(dst + (size_t)(n0 + n) * DM + k0 + 16 * kc) = *(const LAS u32x4*)(tile + n * 144 + 16 * kc); }
    LDS_WAIT();
    __syncthreads();
}
__device__ __forceinline__ bf16_t* wmix(Frame& F, int l, size_t off) { return (bf16_t*)(F.ws + WS_WMIX + (size_t)l * WL_STRIDE + off); }

__device__ __forceinline__ void prep_mixer_weights(Frame& F) {
    for (int l = 0; l < DEPTH; ++l) {
        { MapInproj m{F.in[I_WIN] + (size_t)l * DM * INW}; for (int s = F.vcu; s < NT_IN * 8; s += F.G) prep_strip_i8(F, m, (signed char*)wmix(F, l, WL_IN), (float*)(F.ws + WS_MISC + MS_WSIN) + l * NT_IN * 256, s); }
        { MapUp m{F.in[I_WUQ] + (size_t)l * 256 * 768, F.in[I_WUKV] + (size_t)l * 128 * 1024, F.in[I_GQ] + l * 256, F.in[I_GKV] + l * 128}; prep_matrix(F, m, wmix(F, l, WL_UP), UPN, UPK); }
        { MapBr m{F.in[I_WBR] + (size_t)l * 3 * 512 * DM}; prep_matrix(F, m, wmix(F, l, WL_BR), DM, 1536); }
        { MapPlain m{F.in[I_WOUT] + (size_t)l * DM * DM, DM}; prep_matrix(F, m, wmix(F, l, WL_OUT), DM, DM); }
    }
    { MapMemkv m{F.in[I_WMKV]}; prep_matrix(F, m, (bf16_t*)(F.ws + WS_WMKV), 4096, DM); }
}
__device__ __forceinline__ void prep_ffn_weights(Frame& F, int l) {
    const int i = l >> 1; const bool moe = (l & 1) != 0;
    LAS float* scr = (LAS float*)(F.lds + F.wave * 16384);
    const int gw = F.vcu * NWAVES + F.wave, NGW = F.G * NWAVES;
    constexpr int IGU = (DM / 64) * (2 * DFF / 32), ID = (DFF / 64) * (DM / 32), NSTRIP = 2 * DFF / 32;
    const int ne = moe ? NE : 1;
    const float* Wg = moe ? F.in[I_WGE] : F.in[I_WGD]; const float* Wu = moe ? F.in[I_WUE] : F.in[I_WUD]; const float* Wd = moe ? F.in[I_WDE] : F.in[I_WDD];
    if (GU_I8(l)) {
        for (int s = F.vcu; s < ne * NSTRIP; s += F.G) { const int e = s / NSTRIP, ss = s % NSTRIP; const size_t eo = ((size_t)i * ne + e) * DM * DFF;
            MapGU m{Wg + eo, Wu + eo}; prep_strip_i8(F, m, (signed char*)(F.ws + WS_WFFN + (size_t)e * WF_STRIDE), (float*)(F.ws + WS_MISC + MS_WSGU) + e * 2 * DFF, ss); }
    } else {
        for (int it = gw; it < ne * IGU; it += NGW) { const int e = it / IGU, r = it % IGU; const size_t eo = ((size_t)i * ne + e) * DM * DFF;
            MapGU m{Wg + eo, Wu + eo}; prep_item(m, (bf16_t*)(F.ws + WS_WFFN + (size_t)e * WF_STRIDE), DM, 2 * DFF / 32, scr, r, F.lane); }
    }
    constexpr int IDT = (DFF / 128) * (DM / 32);
    for (int it = gw; it < ne * IDT; it += NGW) { const int e = it / IDT, r = it % IDT; const size_t eo = ((size_t)i * ne + e) * DM * DFF;
        MapPlain m{Wd + eo, DM}; prep_tile(m, (bf16_t*)(F.ws + WS_WFFN + (size_t)e * WF_STRIDE + WF_D), DFF, DM / 32, F.lds + F.wave * 16384, r, F.lane); }
}

struct RowV { f32x4 v[4]; };
__device__ __forceinline__ void row_load(RowV& r, const float* p, int lane) { const f32x4* x = (const f32x4*)p + lane;
#pragma unroll
    for (int j = 0; j < 4; ++j) r.v[j] = x[64 * j]; }
__device__ __forceinline__ void row_store(const RowV& r, float* p, int lane) { f32x4* x = (f32x4*)p + lane;
#pragma unroll
    for (int j = 0; j < 4; ++j) x[64 * j] = r.v[j]; }
__device__ __forceinline__ void row_add_bf16(RowV& r, const bf16_t* p, float w, int lane) { const u32x2* x = (const u32x2*)p + lane;
#pragma unroll
    for (int j = 0; j < 4; ++j) { const u32x2 q = x[64 * j]; r.v[j].x += w * bflo(q.x); r.v[j].y += w * bfhi(q.x); r.v[j].z += w * bflo(q.y); r.v[j].w += w * bfhi(q.y); } }
__device__ __forceinline__ void row_load_bf16(RowV& r, const bf16_t* p, int lane) { const u32x2* x = (const u32x2*)p + lane;
#pragma unroll
    for (int j = 0; j < 4; ++j) { const u32x2 q = x[64 * j]; r.v[j].x = bflo(q.x); r.v[j].y = bfhi(q.x); r.v[j].z = bflo(q.y); r.v[j].w = bfhi(q.y); } }
__device__ __forceinline__ void row_round_bf16(RowV& r) {
#pragma unroll
    for (int j = 0; j < 4; ++j) { r.v[j].x = bf2f((unsigned short)f2bf(r.v[j].x)); r.v[j].y = bf2f((unsigned short)f2bf(r.v[j].y)); r.v[j].z = bf2f((unsigned short)f2bf(r.v[j].z)); r.v[j].w = bf2f((unsigned short)f2bf(r.v[j].w)); } }
__device__ __forceinline__ float row_rstd(const RowV& r) { float s = 0.f;
#pragma unroll
    for (int j = 0; j < 4; ++j) s += (r.v[j].x * r.v[j].x + r.v[j].y * r.v[j].y) + (r.v[j].z * r.v[j].z + r.v[j].w * r.v[j].w);
    return 1.0f / sqrtf(wave_sum(s) * (1.0f / DM) + EPS); }
__device__ __forceinline__ void row_scale(RowV& r, float rstd, const float* g, int lane) { const f32x4* gg = (const f32x4*)g + lane;
#pragma unroll
    for (int j = 0; j < 4; ++j) r.v[j] = r.v[j] * rstd * gg[64 * j]; }
__device__ __forceinline__ void row_store_bf16(const RowV& r, bf16_t* p, int lane) { u32x2* o = (u32x2*)p + lane;
#pragma unroll
    for (int j = 0; j < 4; ++j) { u32x2 w; w.x = pk2(r.v[j].x, r.v[j].y); w.y = pk2(r.v[j].z, r.v[j].w); o[64 * j] = w; } }

__device__ __forceinline__ float row_store_i8(const RowV& r, signed char* p, int lane) {
    float am = 0.f;
#pragma unroll
    for (int j = 0; j < 4; ++j) am = fmaxf(am, fmaxf(fmaxf(fabsf(r.v[j].x), fabsf(r.v[j].y)), fmaxf(fabsf(r.v[j].z), fabsf(r.v[j].w))));
#pragma unroll
    for (int o = 1; o < 64; o <<= 1) am = fmaxf(am, __shfl_xor(am, o));
    const float inv = am > 0.f ? 127.0f / am : 0.f; unsigned* o4 = (unsigned*)p + lane;
#pragma unroll
    for (int j = 0; j < 4; ++j) { const unsigned a = (unsigned)__float2int_rn(r.v[j].x * inv) & 255u, b = (unsigned)__float2int_rn(r.v[j].y * inv) & 255u, c = (unsigned)__float2int_rn(r.v[j].z * inv) & 255u, d = (unsigned)__float2int_rn(r.v[j].w * inv) & 255u;
        o4[64 * j] = a | (b << 8) | (c << 16) | (d << 24); }
    return am * (1.0f / 127.0f);
}
__device__ __forceinline__ void row_add_slot(Frame& F, RowV& r, int s, float w, int lane) {
    if ((s >> 8) < 256) { row_add_bf16(r, (const bf16_t*)(F.ws + WS_R + R_YOUT) + (size_t)s * DM, w, lane); return; }
    const float* slab = (const float*)(F.ws + WS_SLAB) + (size_t)((s >> 8) - 256) * 4 * TAIL_KS * 65536 + (size_t)(s & 255) * 256 + 4 * lane;
#pragma unroll
    for (int j = 0; j < 4; ++j)
#pragma unroll
        for (int ks = 0; ks < TAIL_KS; ++ks) r.v[j] += *(const f32x4*)(slab + (size_t)(j * TAIL_KS + ks) * 65536) * w;
}
__device__ __forceinline__ void row_combine(Frame& F, RowV& r, int t) {
    const int* sl = (const int*)(F.ws + WS_MISC + MS_SLOT) + 2 * t; const float* tw = (const float*)(F.ws + WS_MISC + MS_TOKW) + 2 * t;
    const int s0 = __builtin_amdgcn_readfirstlane(sl[0]), s1 = __builtin_amdgcn_readfirstlane(sl[1]); const float w0 = tw[0], w1 = tw[1];
    row_add_slot(F, r, s0, w0, F.lane); row_add_slot(F, r, s1, w1, F.lane);
}

__device__ __forceinline__ void norm_phase(Frame& F, const float* srcf, bf16_t* X, const float* g, bool combine, bool out_i8) {
    bf16_t* H = (bf16_t*)(F.ws + WS_H); signed char* Hq = (signed char*)(F.ws + WS_H); float* hsc = (float*)(F.ws + WS_MISC + MS_HSC);
    const int gw = F.vcu * NWAVES + F.wave, NGW = F.G * NWAVES;
    for (int t = gw; t < T; t += 2 * NGW) {
        const int t2 = (t + NGW < T) ? t + NGW : t;
        RowV r, q;
        if (srcf) { row_load(r, srcf + (size_t)t * DM, F.lane); row_load(q, srcf + (size_t)t2 * DM, F.lane); }
        else { row_load_bf16(r, X + (size_t)t * DM, F.lane); row_load_bf16(q, X + (size_t)t2 * DM, F.lane); }
        if (combine) { row_combine(F, r, t); row_combine(F, q, t2); row_store_bf16(r, X + (size_t)t * DM, F.lane); row_store_bf16(q, X + (size_t)t2 * DM, F.lane);
            row_round_bf16(r); row_round_bf16(q); }
        const float rstd = row_rstd(r), qstd = row_rstd(q); row_scale(r, rstd, g, F.lane); row_scale(q, qstd, g, F.lane);
        if (out_i8) { const float sc = row_store_i8(r, Hq + (size_t)t * DM, F.lane), sq = row_store_i8(q, Hq + (size_t)t2 * DM, F.lane); if (F.lane == 0) { hsc[t] = sc; hsc[t2] = sq; } }
        else { row_store_bf16(r, H + (size_t)t * DM, F.lane); row_store_bf16(q, H + (size_t)t2 * DM, F.lane); }
    }
}
__device__ __forceinline__ void final_norm_phase(Frame& F, const bf16_t* X, float* out, const float* g, bool combine) {
    const int gw = F.vcu * NWAVES + F.wave, NGW = F.G * NWAVES;
    for (int t = gw; t < T; t += 2 * NGW) {
        const int t2 = (t + NGW < T) ? t + NGW : t;
        RowV r, q; row_load_bf16(r, X + (size_t)t * DM, F.lane); row_load_bf16(q, X + (size_t)t2 * DM, F.lane);
        if (combine) { row_combine(F, r, t); row_combine(F, q, t2); }
        const float rstd = row_rstd(r), qstd = row_rstd(q); row_scale(r, rstd, g, F.lane); row_scale(q, qstd, g, F.lane);
        row_store(r, out + (size_t)t * DM, F.lane); row_store(q, out + (size_t)t2 * DM, F.lane);
    }
}
__device__ __forceinline__ void memnorm_phase(Frame& F) {
    bf16_t* MN = (bf16_t*)(F.ws + WS_MEMN);
    const int gw = F.vcu * NWAVES + F.wave, NGW = F.G * NWAVES;
    for (int t = gw; t < NB * MEML; t += NGW) {
        RowV r; row_load(r, F.in[I_MEM] + (size_t)t * DM, F.lane);
        const float rstd = row_rstd(r); row_scale(r, rstd, F.in[I_GMEM], F.lane);
        row_store_bf16(r, MN + (size_t)t * DM, F.lane);
    }
}

__device__ __forceinline__ void norm_router_phase(Frame& F, const bf16_t* X, const float* g, const float* Wr  , bool out_i8) {
    bf16_t* H = (bf16_t*)(F.ws + WS_H); signed char* Hq = (signed char*)(F.ws + WS_H); float* hsc = (float*)(F.ws + WS_MISC + MS_HSC);
    int* toke = (int*)(F.ws + WS_MISC + MS_TOKE); float* tokw = (float*)(F.ws + WS_MISC + MS_TOKW); int* cntg = (int*)(F.ws + WS_MISC + MS_CNT);
    volatile LAS int* hist = (volatile LAS int*)(F.lds + LDSCTL_OFF + 1024);
    f32x4 wa[4][4], wb[4][4];
#pragma unroll
    for (int j = 0; j < 4; ++j)
#pragma unroll
        for (int k = 0; k < 4; ++k) { const int d = 256 * j + 4 * F.lane + k; wa[j][k] = *(const f32x4*)(Wr + (size_t)d * 8); wb[j][k] = *(const f32x4*)(Wr + (size_t)d * 8 + 4); }
    const bool up32 = (F.lane & 32) != 0, up16 = (F.lane & 16) != 0, up8 = (F.lane & 8) != 0;
    for (int c = F.vcu; c < T / 128; c += F.G) {
        if (F.tid < 8) hist[F.tid] = 0;
        __syncthreads();
        for (int q = 0; q < 16; ++q) {
            const int t = c * 128 + F.wave * 16 + q;
            RowV r; row_load_bf16(r, X + (size_t)t * DM, F.lane);
            const float rstd = row_rstd(r); row_scale(r, rstd, g, F.lane);
            if (out_i8) { const float sc = row_store_i8(r, Hq + (size_t)t * DM, F.lane); if (F.lane == 0) hsc[t] = sc; }
            else row_store_bf16(r, H + (size_t)t * DM, F.lane);
            f32x4 la = {0.f, 0.f, 0.f, 0.f}, lb = {0.f, 0.f, 0.f, 0.f};
#pragma unroll
            for (int j = 0; j < 4; ++j)
#pragma unroll
                for (int k = 0; k < 4; ++k) { const float x = r.v[j][k]; la += wa[j][k] * x; lb += wb[j][k] * x; }
            f32x4 h4; { const f32x4 keep = up32 ? lb : la, send = up32 ? la : lb;
#pragma unroll
                for (int i = 0; i < 4; ++i) h4[i] = keep[i] + __shfl_xor(send[i], 32); }
            f32x2 h2; { const float k0 = up16 ? h4[2] : h4[0], k1 = up16 ? h4[3] : h4[1], s0 = up16 ? h4[0] : h4[2], s1 = up16 ? h4[1] : h4[3]; h2.x = k0 + __shfl_xor(s0, 16); h2.y = k1 + __shfl_xor(s1, 16); }
            float h1 = (up8 ? h2.y : h2.x) + __shfl_xor(up8 ? h2.x : h2.y, 8);
            h1 += __shfl_xor(h1, 4); h1 += __shfl_xor(h1, 2); h1 += __shfl_xor(h1, 1);
            float lg[8];
#pragma unroll
            for (int e = 0; e < 8; ++e) lg[e] = __builtin_bit_cast(float, __builtin_amdgcn_readlane(__builtin_bit_cast(int, h1), 8 * e));
            int e0 = 0; float v0 = lg[0];
#pragma unroll
            for (int e = 1; e < 8; ++e) if (lg[e] > v0) { v0 = lg[e]; e0 = e; }
            int e1 = -1; float v1 = -INFINITY;
#pragma unroll
            for (int e = 0; e < 8; ++e) if (e != e0 && lg[e] > v1) { v1 = lg[e]; e1 = e; }
            if (F.lane == 0) {
                const float w0 = 1.0f / (1.0f + __expf(v1 - v0));
                toke[2 * t] = e0; toke[2 * t + 1] = e1; tokw[2 * t] = w0; tokw[2 * t + 1] = 1.0f - w0;
                __hip_atomic_fetch_add((LAS int*)&hist[e0], 1, __ATOMIC_RELAXED, __HIP_MEMORY_SCOPE_WORKGROUP); __hip_atomic_fetch_add((LAS int*)&hist[e1], 1, __ATOMIC_RELAXED, __HIP_MEMORY_SCOPE_WORKGROUP);
            }
        }
        __syncthreads();
        if (F.tid < 8) cntg[c * 8 + F.tid] = hist[F.tid];
        __syncthreads();
    }
}
__device__ __forceinline__ void moe_assign_phase(Frame& F, bool i8) {
    const bf16_t* H = (const bf16_t*)(F.ws + WS_H); bf16_t* AS = (bf16_t*)(F.ws + WS_R + R_ASORT);
    const float* hsc = (const float*)(F.ws + WS_MISC + MS_HSC); float* asc = (float*)(F.ws + WS_MISC + MS_ASC);
    const int* toke = (const int*)(F.ws + WS_MISC + MS_TOKE); int* slot = (int*)(F.ws + WS_MISC + MS_SLOT); const int* cntg = (const int*)(F.ws + WS_MISC + MS_CNT);
    int* texp = (int*)(F.ws + WS_MISC + MS_TEXP);
    volatile LAS int* tot = (volatile LAS int*)(F.lds + LDSCTL_OFF + 1024);
    volatile LAS int* pre = tot + 8;
    volatile LAS int* wcnt = tot + 16;
    for (int c = F.vcu; c < T / 128; c += F.G) {
        if (F.tid < 16) tot[F.tid] = 0;
        __syncthreads();
        { const int cc = F.tid >> 1, h = F.tid & 1; const i32x4 v = *(const i32x4*)(cntg + cc * 8 + 4 * h);
#pragma unroll
          for (int k = 0; k < 4; ++k) { __hip_atomic_fetch_add((LAS int*)&tot[4 * h + k], v[k], __ATOMIC_RELAXED, __HIP_MEMORY_SCOPE_WORKGROUP); if (cc < c) __hip_atomic_fetch_add((LAS int*)&pre[4 * h + k], v[k], __ATOMIC_RELAXED, __HIP_MEMORY_SCOPE_WORKGROUP); } }
        const int t = c * 128 + F.wave * 16 + ((F.lane & 31) >> 1);
        const int my_e = (F.lane < 32) ? toke[2 * t + (F.lane & 1)] : -1;
        int rank = 0;
#pragma unroll
        for (int e = 0; e < 8; ++e) { const unsigned long long m = __ballot(my_e == e); if (my_e == e) rank = __popcll(m & ((1ull << F.lane) - 1ull)); if (F.lane == 0) wcnt[F.wave * 8 + e] = __popcll(m); }
        __syncthreads();
        int myslot = 0;
        if (F.lane < 32) {
            int ts = 0;
#pragma unroll
            for (int e = 0; e < 8; ++e) ts += (e < my_e) ? ((tot[e] + 255) >> 8) : 0;
            int wp = 0; for (int w = 0; w < F.wave; ++w) wp += wcnt[w * 8 + my_e];
            myslot = ts * 256 + pre[my_e] + wp + rank;
            slot[2 * t + (F.lane & 1)] = myslot;
        }
        if (c == 0 && F.tid == 0) { int ts = 0; for (int e = 0; e < 8; ++e) { const int n = (tot[e] + 255) >> 8; for (int k = 0; k < n; ++k) texp[ts + k] = e; ts += n; } for (int k = ts; k < MAXRT; ++k) texp[k] = 0; texp[MAXRT] = ts; }
        if (i8) {
            const float myh = hsc[t];
#pragma unroll 1
            for (int a0 = 0; a0 < 32; a0 += 8) {
                u32x4 x[4];
#pragma unroll
                for (int k = 0; k < 4; ++k) x[k] = *((const u32x4*)((const signed char*)H + (size_t)(c * 128 + F.wave * 16 + ((a0 + 2 * k) >> 1)) * DM) + F.lane);
#pragma unroll
                for (int k = 0; k < 8; ++k) { const int s = __builtin_amdgcn_readlane(myslot, a0 + k); *((u32x4*)((signed char*)AS + (size_t)s * DM) + F.lane) = x[k >> 1]; }
            }
            if (F.lane < 32) asc[myslot] = myh;
        } else {
            for (int a = 0; a < 32; ++a) {
                const int s = __builtin_amdgcn_readlane(myslot, a); const int ta = c * 128 + F.wave * 16 + (a >> 1);
                const u32x4* srcp = (const u32x4*)(H + (size_t)ta * DM) + F.lane; u32x4* dstp = (u32x4*)(AS + (size_t)s * DM) + F.lane;
                const u32x4 x0 = srcp[0], x1 = srcp[64]; dstp[0] = x0; dstp[64] = x1; }
        }
        __syncthreads();
    }
}

using pg8::Unit;
typedef f32x4 AccT[2][2][4][2];

struct ProbSimple { int K; unsigned lda, ldb; const char* A; const char* B;
    __device__ __forceinline__ const char* a_ptr(const Unit& u) const { return A + (size_t)u.pm * 256 * lda; }
    __device__ __forceinline__ const char* b_ptr(const Unit& u) const { return B + (size_t)u.pn * 256 * ldb; } };
struct ProbUp { int K; unsigned lda, ldb; const char* A; const char* B;
    __device__ __forceinline__ const char* a_ptr(const Unit& u) const { return A + (size_t)u.pm * 256 * lda + (u.pn >= 3 ? 256 : 0); }
    __device__ __forceinline__ const char* b_ptr(const Unit& u) const { return B + (size_t)u.pn * 256 * ldb; } };
struct ProbMoe { int K; unsigned lda, ldb; const char* A; const char* B; int a_lo;
    __device__ __forceinline__ const char* a_ptr(const Unit& u) const { return A + (size_t)(u.pm - a_lo) * 256 * lda; }
    __device__ __forceinline__ const char* b_ptr(const Unit& u) const { return B + (size_t)u.aux * WF_STRIDE + (size_t)u.pn * 256 * ldb; } };

struct ProbTail { int K; unsigned lda, ldb; const char* A; const char* B;
    __device__ __forceinline__ const char* a_ptr(const Unit& u) const { return A + (size_t)u.pm * 256 * lda + (size_t)(u.aux >> 8) * (DFF / TAIL_KS) * 2; }
    __device__ __forceinline__ const char* b_ptr(const Unit& u) const { return B + (size_t)(u.aux & 255) * WF_STRIDE + (size_t)u.pn * 256 * ldb + (size_t)(u.aux >> 8) * (DFF / TAIL_KS) * 2; } };
struct TailOrder { int ntail, G, c; const int* texp;
    __device__ bool next(int i, Unit& u) const { const int L = i * G + c; if (L >= ntail) return false;
        u.pm = 256 + L / (4 * TAIL_KS); u.pn = (L / TAIL_KS) & 3; u.aux = __builtin_amdgcn_readfirstlane(texp[u.pm]) | ((L % TAIL_KS) << 8); return true; } };
struct MoeOrder { pg8::StaticOrder base; int lo; const int* texp;
    __device__ bool next(int i, Unit& u) const { if (!base.next(i, u)) return false; u.pm += lo; u.aux = __builtin_amdgcn_readfirstlane(texp[u.pm]); return true; } };

__device__ __forceinline__ u32x4 pack8(const f32x4 a, const f32x4 b) { u32x4 w; w.x = cvtpk(a[0], a[1]); w.y = cvtpk(a[2], a[3]); w.z = cvtpk(b[0], b[1]); w.w = cvtpk(b[2], b[3]); return w; }
__device__ __forceinline__ u32x2 pack4(const f32x4 a) { u32x2 w; w.x = cvtpk(a[0], a[1]); w.y = cvtpk(a[2], a[3]); return w; }

struct EpiNoStage { __device__ __forceinline__ void stage(LAS unsigned char*, const Unit&, int, int) const {} };
__device__ __forceinline__ void stage1k(const void* src, LAS unsigned char* dst, int lane) { __builtin_amdgcn_global_load_lds((const unsigned*)((const char*)src + lane * 16), (LAS unsigned*)dst, 16, 0, 0); }
__device__ __forceinline__ f32x4 deq(const f32x4& a, float, const f32x4&) { return a; }
__device__ __forceinline__ f32x4 deq(const i32x4& a, float rs, const f32x4& cs) { return __builtin_convertvector(a, f32x4) * rs * cs; }
struct EpiInproj {
    static constexpr bool MID = false;
    bf16_t* P; bf16_t* G; float* ssq; const int* pos; const float* rsc; const float* csc;
    __device__ __forceinline__ void stage(LAS unsigned char* d, const Unit& u, int wid, int lane) const {
        if (wid == 0) { stage1k(rsc + u.pm * 256, d, lane); stage1k(csc + u.pn * 256, d + 1024, lane); stage1k(pos + u.pm * 256, d + 2048, lane); } }
    template <class AV> __device__ __forceinline__ void operator()(const AV (&acc)[2][2][4][2], const Unit& u, int wr, int wc, int fr, int fq, const LAS unsigned char* esc) const {
        const int pn = u.pn, row0 = u.pm * 256 + wr * 64 + fr;
        f32x4 cs[2][2];
#pragma unroll
        for (int bj = 0; bj < 2; ++bj)
#pragma unroll
            for (int n = 0; n < 2; ++n) cs[bj][n] = *(const LAS f32x4*)(esc + 1024 + (bj * 128 + wc * 32 + n * 16 + fq * 4) * 4);
        float rs8[2][4], pf8[2][4];
#pragma unroll
        for (int ai = 0; ai < 2; ++ai)
#pragma unroll
            for (int m = 0; m < 4; ++m) { const int rl = ai * 128 + wr * 64 + m * 16 + fr; rs8[ai][m] = *(const LAS float*)(esc + rl * 4); pf8[ai][m] = (float)*(const LAS int*)(esc + 2048 + rl * 4); }
#define DQ(ai, bj, m, n) deq(acc[ai][bj][m][n], rs, cs[bj][n])
        if (pn >= 7) {
#pragma unroll
            for (int ai = 0; ai < 2; ++ai)
#pragma unroll
                for (int m = 0; m < 4; ++m) { const int row = row0 + ai * 128 + m * 16; const float rs = rs8[ai][m]; u32x4 w;
#pragma unroll
                    for (int bj = 0; bj < 2; ++bj) { f32x4 a = DQ(ai, bj, m, 0), b = DQ(ai, bj, m, 1);
#pragma unroll
                        for (int j = 0; j < 4; ++j) { a[j] = fast_sigmoid(a[j]) * 255.0f; b[j] = fast_sigmoid(b[j]) * 255.0f; }
                        const unsigned wa_ = (unsigned)__float2int_rn(a[0]) | ((unsigned)__float2int_rn(a[1]) << 8) | ((unsigned)__float2int_rn(a[2]) << 16) | ((unsigned)__float2int_rn(a[3]) << 24);
                        const unsigned wb_ = (unsigned)__float2int_rn(b[0]) | ((unsigned)__float2int_rn(b[1]) << 8) | ((unsigned)__float2int_rn(b[2]) << 16) | ((unsigned)__float2int_rn(b[3]) << 24);
                        if (bj == 0) { w.x = wa_; w.y = wb_; } else { w.z = wa_; w.w = wb_; } }
                    *(u32x4*)((unsigned char*)G + (size_t)row * GW + (pn - 7) * 256 + wc * 64 + fq * 16) = w; }
        } else if (pn >= 5 || pn == 3) {
            const float sc = (pn == 3) ? 1.0f : C_M;
#pragma unroll
            for (int ai = 0; ai < 2; ++ai)
#pragma unroll
                for (int m = 0; m < 4; ++m) { const int row = row0 + ai * 128 + m * 16; const float rs = rs8[ai][m]; float s = 0.f;
#pragma unroll
                    for (int bj = 0; bj < 2; ++bj) { const f32x4 a = DQ(ai, bj, m, 0) * sc, b = DQ(ai, bj, m, 1) * sc;
                        s += (a[0] * a[0] + a[1] * a[1]) + (a[2] * a[2] + a[3] * a[3]) + (b[0] * b[0] + b[1] * b[1]) + (b[2] * b[2] + b[3] * b[3]);
                        *(u32x4*)(P + (size_t)row * PW + pn * 256 + bj * 128 + wc * 32 + fq * 8) = pack8(a, b); }
                    if (pn == 3) { s += __shfl_xor(s, 16); s += __shfl_xor(s, 32); if (fq == 0) ssq[(size_t)row * 8 + wc] = s; } }
        } else if (pn == 4) {
#pragma unroll
            for (int ai = 0; ai < 2; ++ai)
#pragma unroll
                for (int m = 0; m < 4; ++m) { const int row = row0 + ai * 128 + m * 16; const float rs = rs8[ai][m];
                    { const f32x4 a = DQ(ai, 0, m, 0), b = DQ(ai, 0, m, 1);
                      float s = (a[0] * a[0] + a[1] * a[1]) + (a[2] * a[2] + a[3] * a[3]) + (b[0] * b[0] + b[1] * b[1]) + (b[2] * b[2] + b[3] * b[3]);
                      *(u32x4*)(P + (size_t)row * PW + P_CKV + wc * 32 + fq * 8) = pack8(a, b);
                      s += __shfl_xor(s, 16); s += __shfl_xor(s, 32); if (fq == 0) ssq[(size_t)row * 8 + 4 + wc] = s; }
                    if (wc == 0) { const f32x4 x1 = DQ(ai, 1, m, 0), x2 = DQ(ai, 1, m, 1); const float pf = pf8[ai][m]; f32x4 o1, o2;
#pragma unroll
                        for (int j = 0; j < 4; ++j) { float c, s; rot_cs(pf, 2 * (4 * fq + j), c, s); o1[j] = x1[j] * c - x2[j] * s; o2[j] = x2[j] * c + x1[j] * s; }
                        *(u32x2*)(P + (size_t)row * PW + P_KR + 4 * fq) = pack4(o1); *(u32x2*)(P + (size_t)row * PW + P_KR + 16 + 4 * fq) = pack4(o2); } }
        } else {
            const float sc = (pn < 2) ? C_A : 1.0f; const int i0 = 16 * (wc & 1) + 4 * fq;
#pragma unroll
            for (int ai = 0; ai < 2; ++ai)
#pragma unroll
                for (int m = 0; m < 4; ++m) { const int row = row0 + ai * 128 + m * 16; const float rs = rs8[ai][m]; const float pf = pf8[ai][m]; f32x4 c, s;
#pragma unroll
                    for (int j = 0; j < 4; ++j) { float cc, ss; rot_cs(pf, i0 + j, cc, ss); c[j] = cc * sc; s[j] = ss * sc; }
#pragma unroll
                    for (int bj = 0; bj < 2; ++bj) { const f32x4 x1 = DQ(ai, bj, m, 0), x2 = DQ(ai, bj, m, 1);
                        if (pn == 2 && bj == 1) { *(u32x4*)(P + (size_t)row * PW + P_VA + wc * 32 + fq * 8) = pack8(x1, x2); }
                        else { const f32x4 o1 = x1 * c - x2 * s, o2 = x2 * c + x1 * s; bf16_t* d = P + (size_t)row * PW + pn * 256 + 64 * (2 * bj + (wc >> 1)) + i0;
                            *(u32x2*)d = pack4(o1); *(u32x2*)(d + 32) = pack4(o2); } } }
        }
#undef DQ
    }
};
struct EpiUp {
    static constexpr bool MID = false;
    __device__ __forceinline__ void stage(LAS unsigned char*, const Unit&, int, int) const {}
    bf16_t* QB; bf16_t* KVB; const float* ssq; const int* pos;
    __device__ __forceinline__ void operator()(const AccT& acc, const Unit& u, int wr, int wc, int fr, int fq, const LAS unsigned char*) const {
        const int pn = u.pn, row0 = u.pm * 256 + wr * 64 + fr;
        float rs8[2][4], pf8[2][4];
#pragma unroll
        for (int ai = 0; ai < 2; ++ai)
#pragma unroll
            for (int m = 0; m < 4; ++m) { const int row = row0 + ai * 128 + m * 16; const f32x4 sv = *(const f32x4*)(ssq + (size_t)row * 8 + (pn < 3 ? 0 : 4));
                rs8[ai][m] = (pn < 3 ? C_B : 1.0f) / sqrtf(((sv[0] + sv[1]) + (sv[2] + sv[3])) * (pn < 3 ? 1.0f / 256.0f : 1.0f / 128.0f) + EPS); pf8[ai][m] = (pn < 3) ? (float)pos[row] : 0.f; }
#pragma unroll
        for (int ai = 0; ai < 2; ++ai)
#pragma unroll
            for (int m = 0; m < 4; ++m) { const int row = row0 + ai * 128 + m * 16; const float rs = rs8[ai][m];
                if (pn < 3) {
#pragma unroll
                    for (int bj = 0; bj < 2; ++bj) { const int gg = 8 * pn + 4 * bj + wc; const f32x4 x1 = acc[ai][bj][m][0] * rs, x2 = acc[ai][bj][m][1] * rs;
                        if (gg % 3 == 2) { const float pf = pf8[ai][m]; f32x4 o1, o2;
#pragma unroll
                            for (int j = 0; j < 4; ++j) { float c, s; rot_cs(pf, 2 * (4 * fq + j), c, s); o1[j] = x1[j] * c - x2[j] * s; o2[j] = x2[j] * c + x1[j] * s; }
                            bf16_t* d = QB + (size_t)row * QBW + 32 * gg + 4 * fq; *(u32x2*)d = pack4(o1); *(u32x2*)(d + 16) = pack4(o2); }
                        else *(u32x4*)(QB + (size_t)row * QBW + 32 * gg + 8 * fq) = pack8(x1, x2); }
                } else {
#pragma unroll
                    for (int bj = 0; bj < 2; ++bj) *(u32x4*)(KVB + (size_t)row * KVW + (pn - 3) * 256 + bj * 128 + wc * 32 + fq * 8) = pack8(acc[ai][bj][m][0] * rs, acc[ai][bj][m][1] * rs);
                } }
    }
};
struct EpiPlain {
    static constexpr bool MID = false;
    __device__ __forceinline__ void stage(LAS unsigned char*, const Unit&, int, int) const {}
    bf16_t* O; int ldo;
    __device__ __forceinline__ void operator()(const AccT& acc, const Unit& u, int wr, int wc, int fr, int fq, const LAS unsigned char*) const {
        const int row0 = u.pm * 256 + wr * 64 + fr;
#pragma unroll
        for (int ai = 0; ai < 2; ++ai)
#pragma unroll
            for (int m = 0; m < 4; ++m)
#pragma unroll
                for (int bj = 0; bj < 2; ++bj) *(u32x4*)(O + (size_t)(row0 + ai * 128 + m * 16) * ldo + u.pn * 256 + bj * 128 + wc * 32 + fq * 8) = pack8(acc[ai][bj][m][0], acc[ai][bj][m][1]);
    }
};
struct EpiBranch {
    static constexpr bool MID = true;
    const unsigned char* G; bf16_t* MIXED;
    __device__ __forceinline__ void stage(LAS unsigned char*, const Unit&, int, int) const {}
    static __device__ __forceinline__ float gq(unsigned w, int b) { const float f = (float)((w >> (8 * b)) & 255u); return fmaxf(f, 2.55e-4f); }
    __device__ __forceinline__ void mid(AccT& acc, const Unit& u, int seg  , int wr, int wc, int fr, int fq) const {
        const int row0 = opq_v(u.pm * 256 + wr * 64 + fr);
#pragma unroll
        for (int ai = 0; ai < 2; ++ai) {
            u32x4 ga[4], gb[4];
#pragma unroll
            for (int m = 0; m < 4; ++m) { const unsigned char* gp = G + (size_t)(row0 + ai * 128 + m * 16) * GW + u.pn * 256 + wc * 64 + fq * 16;
                ga[m] = *(const u32x4*)(gp + (seg - 1) * 1024); gb[m] = *(const u32x4*)(gp + seg * 1024); }
#pragma unroll
            for (int m = 0; m < 4; ++m) {
#pragma unroll
                for (int j = 0; j < 4; ++j) {
                    acc[ai][0][m][0][j] *= gq(ga[m].x, j) * __builtin_amdgcn_rcpf(gq(gb[m].x, j)); acc[ai][0][m][1][j] *= gq(ga[m].y, j) * __builtin_amdgcn_rcpf(gq(gb[m].y, j));
                    acc[ai][1][m][0][j] *= gq(ga[m].z, j) * __builtin_amdgcn_rcpf(gq(gb[m].z, j)); acc[ai][1][m][1][j] *= gq(ga[m].w, j) * __builtin_amdgcn_rcpf(gq(gb[m].w, j)); } }
            asm volatile("" ::: "memory"); }
    }
    __device__ __forceinline__ void operator()(const AccT& acc, const Unit& u, int wr, int wc, int fr, int fq, const LAS unsigned char*) const {
        const int row0 = u.pm * 256 + wr * 64 + fr;
#pragma unroll
        for (int ai = 0; ai < 2; ++ai) {
            u32x4 gw[4];
#pragma unroll
            for (int m = 0; m < 4; ++m) gw[m] = *(const u32x4*)(G + (size_t)(row0 + ai * 128 + m * 16) * GW + 2048 + u.pn * 256 + wc * 64 + fq * 16);
#pragma unroll
            for (int m = 0; m < 4; ++m) { f32x4 a0 = acc[ai][0][m][0], b0 = acc[ai][0][m][1], a1 = acc[ai][1][m][0], b1 = acc[ai][1][m][1];
#pragma unroll
                for (int j = 0; j < 4; ++j) { a0[j] *= gq(gw[m].x, j) * (1.0f / 255.0f); b0[j] *= gq(gw[m].y, j) * (1.0f / 255.0f); a1[j] *= gq(gw[m].z, j) * (1.0f / 255.0f); b1[j] *= gq(gw[m].w, j) * (1.0f / 255.0f); }
                bf16_t* d = MIXED + (size_t)(row0 + ai * 128 + m * 16) * DM + u.pn * 256 + wc * 64 + fq * 16;
                *(u32x4*)d = pack8(a0, b0); *(u32x4*)(d + 8) = pack8(a1, b1); }
            asm volatile("" ::: "memory"); }
    }
};
struct EpiResid {
    static constexpr bool MID = false;
    __device__ __forceinline__ void stage(LAS unsigned char*, const Unit&, int, int) const {}
    const float* Xf; bf16_t* X;
    __device__ __forceinline__ void operator()(const AccT& acc, const Unit& u, int wr, int wc, int fr, int fq, const LAS unsigned char*) const {
        const int row0 = u.pm * 256 + wr * 64 + fr;
#pragma unroll
        for (int ai = 0; ai < 2; ++ai) {
            f32x4 xa[4][2], xb[4][2];
#pragma unroll
            for (int m = 0; m < 4; ++m)
#pragma unroll
                for (int bj = 0; bj < 2; ++bj) { const size_t o = (size_t)(row0 + ai * 128 + m * 16) * DM + u.pn * 256 + bj * 128 + wc * 32 + fq * 8;
                    if (Xf) { xa[m][bj] = *(const f32x4*)(Xf + o); xb[m][bj] = *(const f32x4*)(Xf + o + 4); }
                    else { const u32x4 q = *(const u32x4*)(X + o); xa[m][bj] = (f32x4){bflo(q.x), bfhi(q.x), bflo(q.y), bfhi(q.y)}; xb[m][bj] = (f32x4){bflo(q.z), bfhi(q.z), bflo(q.w), bfhi(q.w)}; } }
#pragma unroll
            for (int m = 0; m < 4; ++m)
#pragma unroll
                for (int bj = 0; bj < 2; ++bj) *(u32x4*)(X + (size_t)(row0 + ai * 128 + m * 16) * DM + u.pn * 256 + bj * 128 + wc * 32 + fq * 8) = pack8(xa[m][bj] + acc[ai][bj][m][0], xb[m][bj] + acc[ai][bj][m][1]);
            asm volatile("" ::: "memory"); }
    }
};
struct EpiSwiglu {
    static constexpr bool MID = false;
    bf16_t* ACT; int lo; const float* rsc; const float* csc;
    __device__ __forceinline__ void stage(LAS unsigned char* d, const Unit& u, int wid, int lane) const {
        if (wid == 0) { stage1k(rsc + u.pm * 256, d, lane); stage1k(csc + (size_t)u.aux * 2 * DFF + u.pn * 256, d + 1024, lane); } }
    template <class AV> __device__ __forceinline__ void operator()(const AV (&acc)[2][2][4][2], const Unit& u, int wr, int wc, int fr, int fq, const LAS unsigned char* esc) const {
        const int row0 = (u.pm - lo) * 256 + wr * 64 + fr;
        f32x4 cs[2][2];
#pragma unroll
        for (int bj = 0; bj < 2; ++bj)
#pragma unroll
            for (int n = 0; n < 2; ++n) cs[bj][n] = *(const LAS f32x4*)(esc + 1024 + (bj * 128 + wc * 32 + n * 16 + fq * 4) * 4);
        float rs8[2][4];
#pragma unroll
        for (int ai = 0; ai < 2; ++ai)
#pragma unroll
            for (int m = 0; m < 4; ++m) rs8[ai][m] = *(const LAS float*)(esc + (ai * 128 + wr * 64 + m * 16 + fr) * 4);
#pragma unroll
        for (int ai = 0; ai < 2; ++ai)
#pragma unroll
            for (int m = 0; m < 4; ++m) { const float rs = rs8[ai][m]; f32x4 a, b;
                const f32x4 g0 = deq(acc[ai][0][m][0], rs, cs[0][0]), g1 = deq(acc[ai][0][m][1], rs, cs[0][1]), u0 = deq(acc[ai][1][m][0], rs, cs[1][0]), u1 = deq(acc[ai][1][m][1], rs, cs[1][1]);
#pragma unroll
                for (int j = 0; j < 4; ++j) { a[j] = g0[j] * fast_sigmoid(g0[j]) * u0[j]; b[j] = g1[j] * fast_sigmoid(g1[j]) * u1[j]; }
                *(u32x4*)(ACT + (size_t)(row0 + ai * 128 + m * 16) * DFF + u.pn * 128 + wc * 32 + fq * 8) = pack8(a, b); }
    }
};
struct EpiYout {
    static constexpr bool MID = false;
    __device__ __forceinline__ void stage(LAS unsigned char*, const Unit&, int, int) const {}
    bf16_t* Y;
    __device__ __forceinline__ void operator()(const AccT& acc, const Unit& u, int wr, int wc, int fr, int fq, const LAS unsigned char*) const {
        const int row0 = u.pm * 256 + wr * 64 + fr;
#pragma unroll
        for (int ai = 0; ai < 2; ++ai)
#pragma unroll
            for (int m = 0; m < 4; ++m)
#pragma unroll
                for (int bj = 0; bj < 2; ++bj) *(u32x4*)(Y + (size_t)(row0 + ai * 128 + m * 16) * DM + u.pn * 256 + bj * 128 + wc * 32 + fq * 8) = pack8(acc[ai][bj][m][0], acc[ai][bj][m][1]);
    }
};
struct EpiSlab {
    static constexpr bool MID = false;
    __device__ __forceinline__ void stage(LAS unsigned char*, const Unit&, int, int) const {}
    float* slab;
    __device__ __forceinline__ void operator()(const AccT& acc, const Unit& u, int wr, int wc, int fr, int fq, const LAS unsigned char*) const {
        float* base = slab + (size_t)(((u.pm - 256) * 4 + u.pn) * TAIL_KS + (u.aux >> 8)) * 65536;
#pragma unroll
        for (int ai = 0; ai < 2; ++ai)
#pragma unroll
            for (int m = 0; m < 4; ++m)
#pragma unroll
                for (int bj = 0; bj < 2; ++bj) { float* d = base + (size_t)(ai * 128 + wr * 64 + m * 16 + fr) * 256 + bj * 128 + wc * 32 + fq * 8; *(f32x4*)d = acc[ai][bj][m][0]; *(f32x4*)(d + 4) = acc[ai][bj][m][1]; }
    }
};

namespace att {
__device__ __forceinline__ int crow(int r, int hi) { return (r & 3) + 8 * (r >> 2) + 4 * hi; }
__device__ __forceinline__ void glds16(const void* gsrc, unsigned lds_dst) { unsigned keep;
    asm volatile("s_mov_b32 %0, m0\n\ts_mov_b32 m0, %2\n\ts_nop 0\n\tglobal_load_lds_dwordx4 %1, off\n\ts_mov_b32 m0, %0" : "=&s"(keep) : "v"(gsrc), "s"(lds_dst) : "memory"); }
__device__ __forceinline__ float swapmax(float m) { auto rr = __builtin_amdgcn_permlane32_swap(__float_as_uint(m), __float_as_uint(m), false, false); return fmaxf(__uint_as_float(rr[0]), __uint_as_float(rr[1])); }
__device__ __forceinline__ float swapsum(float m) { auto rr = __builtin_amdgcn_permlane32_swap(__float_as_uint(m), __float_as_uint(m), false, false); return __uint_as_float(rr[0]) + __uint_as_float(rr[1]); }
__device__ __forceinline__ void store_o_block(const f32x16& o, float linv, bf16_t* rowp  , int hi) {
#pragma unroll
    for (int rp = 0; rp < 2; ++rp) {
        const u32x2 X = pack4((f32x4){o[8 * rp] * linv, o[8 * rp + 1] * linv, o[8 * rp + 2] * linv, o[8 * rp + 3] * linv});
        const u32x2 Y = pack4((f32x4){o[8 * rp + 4] * linv, o[8 * rp + 5] * linv, o[8 * rp + 6] * linv, o[8 * rp + 7] * linv});
        const auto s0 = __builtin_amdgcn_permlane32_swap(X.x, Y.x, false, false), s1 = __builtin_amdgcn_permlane32_swap(X.y, Y.y, false, false);
        const u32x4 w = {s0[0], s1[0], s0[1], s1[1]};
        *(u32x4*)(rowp + 8 * (2 * rp + hi)) = w; }
}
__device__ __forceinline__ s16x4 vtr(unsigned addr) { s16x4 r; asm volatile("ds_read_b64_tr_b16 %0, %1" : "=&v"(r) : "v"(addr) : "memory"); return r; }
#define VTRO(dst, base, off) asm volatile("ds_read_b64_tr_b16 %0, %1 offset:%c2" : "=&v"(dst) : "v"(base), "i"(off) : "memory")

struct Src {
    const bf16_t* q; int qpitch;
    const bf16_t* k0; int k0pitch;
    const bf16_t* k1; int k1pitch;
    const bf16_t* v; int vpitch;
    bf16_t* o; int opitch;
};
template <int NKC, int NVB, int RD = 4>
__device__ __forceinline__ void dma_tile(const Src& S, int t, int slot, unsigned lds0, int wid, int lane) {
    constexpr int KS = NKC * 1024, VS = NVB * 4096, LDS_K = 0, LDS_V = RD * KS;
#pragma unroll
    for (int c = 0; c < (NKC + 7) / 8; ++c) { const int ch = wid + 8 * c; if (ch < NKC) {
        const bf16_t* src = (ch < 8) ? S.k0 + (size_t)(t * 64 + lane) * S.k0pitch + ch * 8 : S.k1 + (size_t)(t * 64 + lane) * S.k1pitch + (ch - 8) * 8;
        glds16(src, (unsigned)__builtin_amdgcn_readfirstlane(lds0 + LDS_K + slot * KS + ch * 1024)); } }
#pragma unroll
    for (int c = 0; c < (NVB * 4 + 7) / 8; ++c) { const int p = wid + 8 * c; if (p < NVB * 4) {
        const bf16_t* src = S.v + (size_t)(t * 64 + 16 * (p & 3) + (lane >> 2)) * S.vpitch + (p >> 2) * 32 + (lane & 3) * 8;
        glds16(src, (unsigned)__builtin_amdgcn_readfirstlane(lds0 + LDS_V + slot * VS + p * 1024)); } }
}
__device__ __forceinline__ void wait_vm_bar(int n) {
    if (n >= 4) asm volatile("s_waitcnt vmcnt(4) lgkmcnt(0)\n\ts_barrier" ::: "memory");
    else if (n == 3) asm volatile("s_waitcnt vmcnt(3) lgkmcnt(0)\n\ts_barrier" ::: "memory");
    else if (n == 2) asm volatile("s_waitcnt vmcnt(2) lgkmcnt(0)\n\ts_barrier" ::: "memory");
    else if (n == 1) asm volatile("s_waitcnt vmcnt(1) lgkmcnt(0)\n\ts_barrier" ::: "memory");
    else asm volatile("s_waitcnt vmcnt(0) lgkmcnt(0)\n\ts_barrier" ::: "memory");
}
template <int NKC, int NVB, int MODE>
__device__ __forceinline__ void unit(LAS unsigned char* lds, const Src& S, int t_lo, int t_hi, int qpos0  , float sink_l2) {
    constexpr int KS = NKC * 1024, VS = NVB * 4096, RD = 4, LDS_K = 0, LDS_V = RD * KS;
    const int tid = opq_v((int)threadIdx.x), lane = tid & 63, r32 = lane & 31, hi = lane >> 5; const int wid = __builtin_amdgcn_readfirstlane(tid >> 6), grp = wid >> 2;
    const unsigned lds0 = (unsigned)(uintptr_t)lds;
    const int ops = (NKC + 7 - wid) / 8 + (NVB * 4) / 8;
    bf16x8 qr[NKC / 2];
#pragma unroll
    for (int d0 = 0; d0 < NKC / 2; ++d0) qr[d0] = *(const bf16x8*)(S.q + (size_t)r32 * S.qpitch + d0 * 16 + hi * 8);
    float m_run = (MODE == 0) ? sink_l2 : 0.0f, l_run = (MODE == 0 && hi == 0) ? 1.0f : 0.0f; bool first = (MODE != 0);
    f32x16 o[NVB];
#pragma unroll
    for (int d = 0; d < NVB; ++d) o[d] = f32x16{};
    const int qi = qpos0 + wid * 32 + r32, qw0 = qpos0 + wid * 32;
    f32x16 p0 = f32x16{}, p1 = f32x16{};
#define AT_ACTIVE(t) ((MODE != 0) || ((64 * (t) + 63 >= qw0 - 128) && (64 * (t) <= qw0 + 31 + 128)))
#define AT_QK(t) do { const LAS unsigned char* kb_ = lds + LDS_K + (((t) - t_lo) % RD) * KS + hi * 1024 + r32 * 16; p0 = f32x16{}; p1 = f32x16{}; \
        _Pragma("unroll") for (int d0 = 0; d0 < NKC / 2; ++d0) { const bf16x8 b0_ = *(const LAS bf16x8*)(kb_ + d0 * 2048), b1_ = *(const LAS bf16x8*)(kb_ + d0 * 2048 + 512); \
            p0 = __builtin_amdgcn_mfma_f32_32x32x16_bf16(b0_, qr[d0], p0, 0, 0, 0); p1 = __builtin_amdgcn_mfma_f32_32x32x16_bf16(b1_, qr[d0], p1, 0, 0, 0); } } while (0)
#define AT_SMPV(t) do { \
        if (MODE == 0 && !((64 * (t) >= qw0 + 31 - 128) && (64 * (t) + 63 <= qw0 + 128))) {   \
            _Pragma("unroll") for (int r = 0; r < 16; ++r) { const int kv_ = 64 * (t) + crow(r, hi); int e0_ = kv_ - qi; e0_ = e0_ < 0 ? -e0_ : e0_; int e1_ = kv_ + 32 - qi; e1_ = e1_ < 0 ? -e1_ : e1_; \
            if (e0_ > 128) p0[r] = -INFINITY; if (e1_ > 128) p1[r] = -INFINITY; } } \
        if (first) {   \
            float mx_[8]; _Pragma("unroll") for (int r = 0; r < 8; ++r) mx_[r] = fmaxf(fmaxf(p0[r], p0[r + 8]), fmaxf(p1[r], p1[r + 8])); \
            float rm_ = fmaxf(fmaxf(fmaxf(mx_[0], mx_[1]), fmaxf(mx_[2], mx_[3])), fmaxf(fmaxf(mx_[4], mx_[5]), fmaxf(mx_[6], mx_[7]))); m_run = swapmax(rm_); first = false; } \
        else { const float tot_ = swapsum(l_run);   \
          if (__any(tot_ > 1.0e12f)) { const float dl_ = tot_ > 1.0e12f ? ceilf(__builtin_amdgcn_logf(tot_)) : 0.f, sc_ = __builtin_amdgcn_exp2f(-dl_); m_run += dl_; l_run *= sc_; \
              _Pragma("unroll") for (int d = 0; d < NVB; ++d) _Pragma("unroll") for (int r = 0; r < 16; ++r) o[d][r] *= sc_; } } \
        float sm_[4] = {0.f, 0.f, 0.f, 0.f}; \
        _Pragma("unroll") for (int r = 0; r < 16; ++r) { p0[r] = __builtin_amdgcn_exp2f(p0[r] - m_run); p1[r] = __builtin_amdgcn_exp2f(p1[r] - m_run); sm_[r & 3] += p0[r] + p1[r]; } \
        l_run += (sm_[0] + sm_[1]) + (sm_[2] + sm_[3]); \
        u32x4 pw_[4]; \
        pw_[0] = (u32x4){cvtpk(p0[0], p0[1]), cvtpk(p0[2], p0[3]), cvtpk(p0[4], p0[5]), cvtpk(p0[6], p0[7])}; pw_[1] = (u32x4){cvtpk(p0[8], p0[9]), cvtpk(p0[10], p0[11]), cvtpk(p0[12], p0[13]), cvtpk(p0[14], p0[15])}; \
        pw_[2] = (u32x4){cvtpk(p1[0], p1[1]), cvtpk(p1[2], p1[3]), cvtpk(p1[4], p1[5]), cvtpk(p1[6], p1[7])}; pw_[3] = (u32x4){cvtpk(p1[8], p1[9]), cvtpk(p1[10], p1[11]), cvtpk(p1[12], p1[13]), cvtpk(p1[14], p1[15])}; \
        const unsigned vb_ = lds0 + LDS_V + (((t) - t_lo) % RD) * VS + ((lane >> 4) & 1) * 32 + (lane & 3) * 8 + (4 * hi + ((lane & 15) >> 2)) * 64; \
        _Pragma("unroll") for (int dp = 0; dp < NVB; dp += 2) { s16x4 lo_[2][4], hh_[2][4]; \
            _Pragma("unroll") for (int dd = 0; dd < 2; ++dd) _Pragma("unroll") for (int ks = 0; ks < 4; ++ks) { lo_[dd][ks] = vtr(vb_ + (dp + dd) * 4096 + ks * 1024); hh_[dd][ks] = vtr(vb_ + (dp + dd) * 4096 + ks * 1024 + 512); } \
            asm volatile("s_waitcnt lgkmcnt(0)" ::: "memory"); __builtin_amdgcn_sched_barrier(0); \
            _Pragma("unroll") for (int ks = 0; ks < 4; ++ks) _Pragma("unroll") for (int dd = 0; dd < 2; ++dd) { \
                const bf16x8 vf_ = (bf16x8){lo_[dd][ks][0], lo_[dd][ks][1], lo_[dd][ks][2], lo_[dd][ks][3], hh_[dd][ks][0], hh_[dd][ks][1], hh_[dd][ks][2], hh_[dd][ks][3]}; \
                o[dp + dd] = __builtin_amdgcn_mfma_f32_32x32x16_bf16(vf_, __builtin_bit_cast(bf16x8, pw_[ks]), o[dp + dd], 0, 0, 0); } } } while (0)
    dma_tile<NKC, NVB>(S, t_lo, 0, lds0, wid, lane);
    if (t_lo + 1 < t_hi) dma_tile<NKC, NVB>(S, t_lo + 1, 1, lds0, wid, lane);
    for (int t = t_lo; t < t_hi; ++t) {
        wait_vm_bar((t + 1 < t_hi) ? ops : 0);
        if (t + 2 < t_hi) dma_tile<NKC, NVB>(S, t + 2, (t + 2 - t_lo) % RD, lds0, wid, lane);
        if (grp == 0) { if (AT_ACTIVE(t)) { AT_QK(t); AT_SMPV(t); } }
        else { if (t > t_lo && AT_ACTIVE(t - 1)) AT_SMPV(t - 1); if (AT_ACTIVE(t)) AT_QK(t); }
    }
    if (grp == 1 && AT_ACTIVE(t_hi - 1)) AT_SMPV(t_hi - 1);
    const float linv = 1.0f / swapsum(l_run);
#pragma unroll
    for (int d = 0; d < NVB; ++d) store_o_block(o[d], linv, S.o + (size_t)r32 * S.opitch + 32 * d, hi);
    asm volatile("s_waitcnt lgkmcnt(0)\n\ts_barrier" ::: "memory");
#undef AT_ACTIVE
#undef AT_QK
#undef AT_SMPV
}

template <int NKC, int NVB>
__device__ __forceinline__ void unit_q64(LAS unsigned char* lds, const Src& S, int t_lo, int t_hi) {
    constexpr int KS = NKC * 1024, VS = NVB * 4096, RD = 4, LDS_K = 0, LDS_V = RD * KS;
    const int tid = opq_v((int)threadIdx.x), lane = tid & 63, r32 = lane & 31, hi = lane >> 5; const int wid = __builtin_amdgcn_readfirstlane(tid >> 6);
    const unsigned lds0 = (unsigned)(uintptr_t)lds;
    const int ops = (NKC + 7 - wid) / 8 + (NVB * 4) / 8;
    bf16x8 qa[NKC / 2], qb[NKC / 2];
#pragma unroll
    for (int d0 = 0; d0 < NKC / 2; ++d0) { qa[d0] = *(const bf16x8*)(S.q + (size_t)r32 * S.qpitch + d0 * 16 + hi * 8); qb[d0] = *(const bf16x8*)(S.q + (size_t)(32 + r32) * S.qpitch + d0 * 16 + hi * 8); }
    float ma = 0.f, la = 0.f, mb = 0.f, lb = 0.f; bool first = true;
    f32x16 oa[NVB], ob[NVB];
#pragma unroll
    for (int d = 0; d < NVB; ++d) { oa[d] = f32x16{}; ob[d] = f32x16{}; }
#define Q64_SM_(P0, P1, M, L, O, PW, QE) \
        if (first) {   \
            float mx_[8]; _Pragma("unroll") for (int r = 0; r < 8; ++r) mx_[r] = fmaxf(fmaxf(P0[r], P0[r + 8]), fmaxf(P1[r], P1[r + 8])); \
            float rm_ = fmaxf(fmaxf(fmaxf(mx_[0], mx_[1]), fmaxf(mx_[2], mx_[3])), fmaxf(fmaxf(mx_[4], mx_[5]), fmaxf(mx_[6], mx_[7]))); M = swapmax(rm_); QE = hi ? 0.f : -M; \
            _Pragma("unroll") for (int r = 0; r < 16; ++r) { P0[r] -= M; P1[r] -= M; } } \
        else { const float tot_ = swapsum(L);   \
          if (__any(tot_ > 1.0e12f)) { const float dl_ = tot_ > 1.0e12f ? ceilf(__builtin_amdgcn_logf(tot_)) : 0.f, sc_ = __builtin_amdgcn_exp2f(-dl_); M += dl_; QE = hi ? 0.f : -M; L *= sc_; \
              _Pragma("unroll") for (int r = 0; r < 16; ++r) { P0[r] -= dl_; P1[r] -= dl_; } \
              _Pragma("unroll") for (int d = 0; d < NVB; ++d) _Pragma("unroll") for (int r = 0; r < 16; ++r) O[d][r] *= sc_; } } \
        float sm_[4] = {0.f, 0.f, 0.f, 0.f}; \
        _Pragma("unroll") for (int r = 0; r < 16; ++r) { P0[r] = __builtin_amdgcn_exp2f(P0[r]); P1[r] = __builtin_amdgcn_exp2f(P1[r]); sm_[r & 3] += P0[r] + P1[r]; } \
        L += (sm_[0] + sm_[1]) + (sm_[2] + sm_[3]); \
        PW[0] = (u32x4){cvtpk(P0[0], P0[1]), cvtpk(P0[2], P0[3]), cvtpk(P0[4], P0[5]), cvtpk(P0[6], P0[7])}; PW[1] = (u32x4){cvtpk(P0[8], P0[9]), cvtpk(P0[10], P0[11]), cvtpk(P0[12], P0[13]), cvtpk(P0[14], P0[15])}; \
        PW[2] = (u32x4){cvtpk(P1[0], P1[1]), cvtpk(P1[2], P1[3]), cvtpk(P1[4], P1[5]), cvtpk(P1[6], P1[7])}; PW[3] = (u32x4){cvtpk(P1[8], P1[9]), cvtpk(P1[10], P1[11]), cvtpk(P1[12], P1[13]), cvtpk(P1[14], P1[15])};
#define Q64_SM(P0, P1, M, L, O, PW, QE) do { Q64_SM_(P0, P1, M, L, O, PW, QE) __builtin_amdgcn_sched_barrier(0); } while (0)
#define Q64_SM_NB(P0, P1, M, L, O, PW, QE) do { Q64_SM_(P0, P1, M, L, O, PW, QE) } while (0)
    const float kext = hi ? 0.f : 1.f; float qea = 0.f, qeb = 0.f;
    dma_tile<NKC, NVB, RD>(S, t_lo, 0, lds0, wid, lane);
    if (t_lo + 1 < t_hi) dma_tile<NKC, NVB, RD>(S, t_lo + 1, 1, lds0, wid, lane);
    for (int t = t_lo; t < t_hi; ++t) {
        const int slot = (t - t_lo) % RD;
        wait_vm_bar((t + 1 < t_hi) ? ops : 0);
        if (t + 2 < t_hi) dma_tile<NKC, NVB, RD>(S, t + 2, (t + 2 - t_lo) % RD, lds0, wid, lane);
        const LAS unsigned char* kb = lds + LDS_K + slot * KS + hi * 1024 + r32 * 16;
        f32x16 s0a = __builtin_amdgcn_mfma_f32_32x32x2f32(kext, qea, f32x16{}, 0, 0, 0), s0b = __builtin_amdgcn_mfma_f32_32x32x2f32(kext, qea, f32x16{}, 0, 0, 0);
        f32x16 s1a = __builtin_amdgcn_mfma_f32_32x32x2f32(kext, qeb, f32x16{}, 0, 0, 0), s1b = __builtin_amdgcn_mfma_f32_32x32x2f32(kext, qeb, f32x16{}, 0, 0, 0);
        bf16x8 kf0 = *(const LAS bf16x8*)(kb), kf1 = *(const LAS bf16x8*)(kb + 512);
#pragma unroll
        for (int d0 = 0; d0 < NKC / 2; ++d0) {
            bf16x8 n0 = kf0, n1 = kf1;
            if (d0 + 1 < NKC / 2) { n0 = *(const LAS bf16x8*)(kb + (d0 + 1) * 2048); n1 = *(const LAS bf16x8*)(kb + (d0 + 1) * 2048 + 512); }
            s0a = __builtin_amdgcn_mfma_f32_32x32x16_bf16(kf0, qa[d0], s0a, 0, 0, 0); s0b = __builtin_amdgcn_mfma_f32_32x32x16_bf16(kf1, qa[d0], s0b, 0, 0, 0);
            s1a = __builtin_amdgcn_mfma_f32_32x32x16_bf16(kf0, qb[d0], s1a, 0, 0, 0); s1b = __builtin_amdgcn_mfma_f32_32x32x16_bf16(kf1, qb[d0], s1b, 0, 0, 0);
            if (d0 + 1 < NKC / 2) __builtin_amdgcn_sched_group_barrier(0x100, 2, 0);
            __builtin_amdgcn_sched_group_barrier(0x008, 4, 0);
            __builtin_amdgcn_sched_barrier(0);
            kf0 = n0; kf1 = n1; }
        __builtin_amdgcn_sched_barrier(0);
        u32x4 pwa[4], pwb[4];
        const unsigned vb = lds0 + LDS_V + slot * VS + ((lane >> 4) & 1) * 32 + (lane & 3) * 8 + (4 * hi + ((lane & 15) >> 2)) * 64;
        s16x4 lo[NVB][4], hh[NVB][4];
#pragma unroll
        for (int d = 0; d < NVB; ++d)
#pragma unroll
            for (int ks = 0; ks < 4; ++ks) { VTRO(lo[d][ks], vb, d * 4096 + ks * 1024); VTRO(hh[d][ks], vb, d * 4096 + ks * 1024 + 512); }
        __builtin_amdgcn_sched_barrier(0);
        Q64_SM(s0a, s0b, ma, la, oa, pwa, qea);
        asm volatile("s_waitcnt lgkmcnt(0)" ::: "memory"); __builtin_amdgcn_sched_barrier(0);
#pragma unroll
        for (int ks = 0; ks < 4; ++ks)
#pragma unroll
            for (int d = 0; d < NVB; ++d) { const bf16x8 vf = (bf16x8){lo[d][ks][0], lo[d][ks][1], lo[d][ks][2], lo[d][ks][3], hh[d][ks][0], hh[d][ks][1], hh[d][ks][2], hh[d][ks][3]};
                oa[d] = __builtin_amdgcn_mfma_f32_32x32x16_bf16(vf, __builtin_bit_cast(bf16x8, pwa[ks]), oa[d], 0, 0, 0); }
        Q64_SM_NB(s1a, s1b, mb, lb, ob, pwb, qeb);
#pragma unroll
        for (int i = 0; i < 8; ++i) { __builtin_amdgcn_sched_group_barrier(0x008, 1, 0); __builtin_amdgcn_sched_group_barrier(0x002, 12, 0); }
        __builtin_amdgcn_sched_barrier(0);
#pragma unroll
        for (int ks = 0; ks < 4; ++ks)
#pragma unroll
            for (int d = 0; d < NVB; ++d) { const bf16x8 vf = (bf16x8){lo[d][ks][0], lo[d][ks][1], lo[d][ks][2], lo[d][ks][3], hh[d][ks][0], hh[d][ks][1], hh[d][ks][2], hh[d][ks][3]};
                ob[d] = __builtin_amdgcn_mfma_f32_32x32x16_bf16(vf, __builtin_bit_cast(bf16x8, pwb[ks]), ob[d], 0, 0, 0); }
        __builtin_amdgcn_sched_barrier(0);
        first = false;
    }
    const float lia = 1.0f / swapsum(la), lib = 1.0f / swapsum(lb);
#pragma unroll
    for (int d = 0; d < NVB; ++d) { store_o_block(oa[d], lia, S.o + (size_t)r32 * S.opitch + 32 * d, hi); store_o_block(ob[d], lib, S.o + (size_t)(32 + r32) * S.opitch + 32 * d, hi); }
    asm volatile("s_waitcnt lgkmcnt(0)\n\ts_barrier" ::: "memory");
#undef Q64_SM
#undef Q64_SM_
#undef Q64_SM_NB
}

}
#define SC_AFTER_PROLOGUE() do {} while (0)
#define SC_AFTER_INPROJ(l) do {} while (0)
#define SC_AFTER_UP(l) do {} while (0)
#define SC_AFTER_MLA(l) do {} while (0)
#define SC_AFTER_BRANCH(l) do {} while (0)
#define SC_AFTER_WOUT(l) do {} while (0)
#define SC_AFTER_NORM2(l) do {} while (0)
#define SC_AFTER_GU(l) do {} while (0)
#define SC_AFTER_DOWN(l) do {} while (0)
#define SC_AFTER_ROUTE(l) do {} while (0)
#define SC_AFTER_MOEGU(l, h) do {} while (0)
#define SC_AFTER_MOED(l, h) do {} while (0)
#define SC_FINAL() do {} while (0)

struct Args { const float* in[23]; float* out; unsigned char* ws; };
#define WSP(type, off) ((type*)(F.ws + (off)))
#define PHASE() Frame Fp = F; Fp.ws = opq_p(F.ws); Fp.in = opq_p(F.in); Fp.out = opq_p(F.out); Fp.tid = opq_v((int)threadIdx.x); Fp.lane = Fp.tid & 63; Fp.wave = __builtin_amdgcn_readfirstlane(Fp.tid >> 6); (void)Fp
#define FWS(type, off) ((type*)(Fp.ws + (off)))
#define X_ FWS(bf16_t, WS_XB)
#define H_ FWS(bf16_t, WS_H)
#define Pb_ FWS(bf16_t, WS_R + R_P)
#define Gb_ FWS(bf16_t, WS_R + R_G)
#define QB_ FWS(bf16_t, WS_R + R_QB)
#define KVB_ FWS(bf16_t, WS_R + R_KVB)
#define Yb_ FWS(bf16_t, WS_R + R_Y)
#define MEMN_ FWS(bf16_t, WS_MEMN)
#define MEMKV_ FWS(bf16_t, WS_MEMKV)
#define ACT_ FWS(bf16_t, WS_R + R_ACT)
#define ASORT_ FWS(bf16_t, WS_R + R_ASORT)
#define YOUT_ FWS(bf16_t, WS_R + R_YOUT)
#define SSQ_ FWS(float, WS_MISC + MS_SSQ)
#define TEXP_ FWS(const int, WS_MISC + MS_TEXP)
#define POS_ ((const int*)Fp.in[I_POS])
#define HSC_ FWS(float, WS_MISC + MS_HSC)
#define ASC_ FWS(float, WS_MISC + MS_ASC)
#define WSIN_ FWS(float, WS_MISC + MS_WSIN)
#define WSGU_ FWS(float, WS_MISC + MS_WSGU)

#define GRID_BAR() xcd_barrier(bar)
#ifndef WGM_GU
#define WGM_GU 4
#endif
#ifndef WGM_IN
#define WGM_IN 4
#endif
template <int l> __device__ __forceinline__ void layer_body(const Frame& F, const XcdBarrier& bar, const int bx) {
        if (l > 0) {
            PHASE();
            prep_ffn_weights(Fp, l);
            if ((l & 1) != 0) norm_phase(Fp, nullptr, X_, Fp.in[I_GMIX] + l * DM, false, true);
            if ((l & 1) == 0) norm_phase(Fp, nullptr, X_, Fp.in[I_GMIX] + l * DM, true, true);
            GRID_BAR();
        }
        {   PHASE();
            ProbSimple p{DM, DM, DM, (const char*)H_, (const char*)wmix(Fp, l, WL_IN)}; pg8::StaticOrder S; S.init(T / 256, NT_IN, Fp.G, bx, 0, WGM_IN);
            EpiInproj E{Pb_, Gb_, SSQ_, POS_, HSC_, WSIN_ + l * NT_IN * 256}; pg8::gemm_phase<true>(Fp.lds, p, S, E); }
        if (l == 0) { PHASE();
            ProbSimple p{DM, DM * 2, DM * 2, (const char*)MEMN_, (const char*)FWS(bf16_t, WS_WMKV)}; pg8::StaticOrder S; S.init(NB * MEML / 256, 16, Fp.G, (bx + Fp.G / 2) % Fp.G);
            EpiPlain E{MEMKV_, 4096}; pg8::gemm_phase(Fp.lds, p, S, E); }
        GRID_BAR();
        SC_AFTER_INPROJ(l);
        {   PHASE();
            ProbUp p{UPK, PW * 2, UPK * 2, (const char*)(Pb_ + P_CQ), (const char*)wmix(Fp, l, WL_UP)}; pg8::StaticOrder S; S.init(T / 256, UPN / 256, Fp.G, bx);
            EpiUp E{QB_, KVB_, SSQ_, POS_}; pg8::gemm_phase(Fp.lds, p, S, E); }
        {   PHASE();
            for (int i = Fp.vcu; i < 1024; i += Fp.G) {
                const int hl = i & 3, qb = (i >> 2) & 15, kvh = (i >> 6) & 1, b = i >> 7, h = kvh * 4 + hl; const size_t rowb = (size_t)b * SEQ; const int q0 = qb * 256;
                att::Src s; s.q = Pb_ + (rowb + q0 + Fp.wave * 32) * PW + P_QA + h * 64; s.qpitch = PW; s.k0 = Pb_ + rowb * PW + P_KA + kvh * 64; s.k0pitch = PW; s.k1 = s.k0; s.k1pitch = PW;
                s.v = Pb_ + rowb * PW + P_VA + kvh * 64; s.vpitch = PW; s.o = Yb_ + (rowb + q0 + Fp.wave * 32) * YW + h * 64; s.opitch = YW;
                const int t_lo = (q0 / 64 - 2) < 0 ? 0 : (q0 / 64 - 2), t_hi = (q0 / 64 + 6) > SEQ / 64 ? SEQ / 64 : (q0 / 64 + 6);
                att::unit<8, 2, 0>(Fp.lds, s, t_lo, t_hi, q0, Fp.in[I_SINK][l * 8 + h] * LOG2E);
            } }
        {   PHASE();
            for (int i = Fp.vcu; i < 512; i += Fp.G) {
                const int qb = i & 15, h = (i >> 4) & 3, b = i >> 6; const size_t rowq = (size_t)b * SEQ + qb * 256 + Fp.wave * 32;
                att::Src s; s.q = Pb_ + rowq * PW + P_QM + h * 128; s.qpitch = PW; s.k0 = MEMKV_ + (size_t)b * MEML * 4096 + l * 1024 + h * 128; s.k0pitch = 4096; s.k1 = s.k0 + 64; s.k1pitch = 4096;
                s.v = MEMKV_ + (size_t)b * MEML * 4096 + l * 1024 + 512 + h * 128; s.vpitch = 4096; s.o = Yb_ + rowq * YW + 1024 + h * 128; s.opitch = YW;
                att::unit<16, 4, 1>(Fp.lds, s, 0, MEML / 64, 0, 0.f);
            } }
        GRID_BAR();
        SC_AFTER_UP(l);
        {   PHASE();
            for (int i = Fp.vcu; i < 512; i += Fp.G) {
                const int qb = i & 7, h = (i >> 3) & 7, b = i >> 6; const size_t rowb = (size_t)b * SEQ, rowq = rowb + qb * 512 + Fp.wave * 64;
                att::Src s; s.q = QB_ + rowq * QBW + h * 96; s.qpitch = QBW; s.k0 = KVB_ + rowb * KVW + h * 128; s.k0pitch = KVW; s.k1 = Pb_ + rowb * PW + P_KR; s.k1pitch = PW;
                s.v = KVB_ + rowb * KVW + h * 128 + 64; s.vpitch = KVW; s.o = Yb_ + rowq * YW + 512 + h * 64; s.opitch = YW;
                att::unit_q64<12, 2>(Fp.lds, s, 0, SEQ / 64);
            } }
        GRID_BAR();
        SC_AFTER_MLA(l);
        {   PHASE();
            ProbSimple p{1536, YW * 2, 1536 * 2, (const char*)Yb_, (const char*)wmix(Fp, l, WL_BR)}; pg8::StaticOrder S; S.init(T / 256, DM / 256, Fp.G, bx);
            EpiBranch E{(const unsigned char*)Gb_, H_}; pg8::gemm_phase(Fp.lds, p, S, E); }
        GRID_BAR();
        SC_AFTER_BRANCH(l);
        if (l == 0) {   PHASE();
            ProbSimple p{DM, DM * 2, DM * 2, (const char*)H_, (const char*)wmix(Fp, l, WL_OUT)}; pg8::StaticOrder S; S.init(T / 256, DM / 256, Fp.G, bx);
            EpiResid E{Fp.in[I_X], X_}; pg8::gemm_phase(Fp.lds, p, S, E); }
        if (l != 0) {   PHASE();
            ProbSimple p{DM, DM * 2, DM * 2, (const char*)H_, (const char*)wmix(Fp, l, WL_OUT)}; pg8::StaticOrder S; S.init(T / 256, DM / 256, Fp.G, bx);
            EpiResid E{nullptr, X_}; pg8::gemm_phase(Fp.lds, p, S, E); }
        GRID_BAR();
        SC_AFTER_WOUT(l);
        if ((l & 1) == 0) {
            {   PHASE(); norm_phase(Fp, nullptr, X_, Fp.in[I_GFFN] + l * DM, false, GU_I8(l) != 0); }
            GRID_BAR();
            SC_AFTER_NORM2(l);
            {   PHASE();
                constexpr bool i8 = GU_I8(l) != 0; constexpr unsigned eb = i8 ? 1 : 2;
                ProbSimple p{DM, DM * eb, DM * eb, (const char*)H_, (const char*)FWS(bf16_t, WS_WFFN + WF_GU)}; pg8::StaticOrder S; S.init(T / 256, 2 * DFF / 256, Fp.G, bx, 0, WGM_GU);
                EpiSwiglu E{ACT_, 0, HSC_, WSGU_}; pg8::gemm_phase<i8>(Fp.lds, p, S, E); }
            GRID_BAR();
            SC_AFTER_GU(l);
            {   PHASE();
                ProbSimple p{DFF, DFF * 2, DFF * 2, (const char*)ACT_, (const char*)FWS(bf16_t, WS_WFFN + WF_D)}; pg8::StaticOrder S; S.init(T / 256, DM / 256, Fp.G, bx, 1);
                EpiResid E{nullptr, X_}; pg8::gemm_phase(Fp.lds, p, S, E); }
            GRID_BAR();
            SC_AFTER_DOWN(l);
        } else {
            {   PHASE(); norm_router_phase(Fp, X_, Fp.in[I_GFFN] + l * DM, Fp.in[I_WR] + (size_t)(l >> 1) * DM * NE, GU_I8(l) != 0); }
            GRID_BAR();
            {   PHASE(); moe_assign_phase(Fp, GU_I8(l) != 0); }
            GRID_BAR();
            SC_AFTER_ROUTE(l);
            {   constexpr int half = 0; (void)half;
                {   PHASE();
                    const int nrt = __builtin_amdgcn_readfirstlane(TEXP_[MAXRT]);
                    constexpr bool i8 = GU_I8(l) != 0; constexpr unsigned eb = i8 ? 1 : 2;
                    ProbMoe p{DM, DM * eb, DM * eb, (const char*)ASORT_, (const char*)FWS(bf16_t, WS_WFFN + WF_GU), 0}; MoeOrder S; S.base.init(nrt, 2 * DFF / 256, Fp.G, bx, 0, WGM_GU); S.lo = 0; S.texp = TEXP_;
                    EpiSwiglu E{ACT_, 0, ASC_, WSGU_}; pg8::gemm_phase<i8>(Fp.lds, p, S, E); }
                GRID_BAR();
                SC_AFTER_MOEGU(l, half);
                {   PHASE();
                    const int nrt = __builtin_amdgcn_readfirstlane(TEXP_[MAXRT]); const int nmain = nrt < 256 ? nrt : 256;
                    ProbMoe p{DFF, DFF * 2, DFF * 2, (const char*)ACT_, (const char*)FWS(bf16_t, WS_WFFN + WF_D), 0}; MoeOrder S; S.base.init(nmain, DM / 256, Fp.G, bx, 1); S.lo = 0; S.texp = TEXP_;
                    EpiYout E{YOUT_}; pg8::gemm_phase(Fp.lds, p, S, E); }
                {   PHASE();
                    const int nrt = __builtin_amdgcn_readfirstlane(TEXP_[MAXRT]);
                    ProbTail p{DFF / TAIL_KS, DFF * 2, DFF * 2, (const char*)ACT_, (const char*)FWS(bf16_t, WS_WFFN + WF_D)}; TailOrder S{(nrt > 256 ? nrt - 256 : 0) * 4 * TAIL_KS, Fp.G, Fp.vcu, TEXP_};
                    EpiSlab E{FWS(float, WS_SLAB)}; pg8::gemm_phase(Fp.lds, p, S, E); }
                GRID_BAR();
                SC_AFTER_MOED(l, half);
            }
        }
    }

__global__ void __launch_bounds__(NWAVES * 64, 2) fwd(Args args) {
    extern __shared__ __attribute__((aligned(16))) unsigned char lds_raw[];
    Frame F;
    F.lds = (LAS unsigned char*)lds_raw;
    F.MISC = (volatile LAS unsigned*)(F.lds + LDSCTL_OFF);
    F.tid = threadIdx.x; F.lane = F.tid & 63; F.wave = __builtin_amdgcn_readfirstlane(F.tid >> 6);
    F.G = gridDim.x; { const int bx = blockIdx.x; F.vcu = (F.G % 8 == 0) ? (bx % 8) * (F.G / 8) + bx / 8 : bx; }
    F.ws = args.ws; F.ctl = (gu32*)(args.ws + WS_CTL); F.out = args.out;
    F.in = (const float* const*)__builtin_amdgcn_kernarg_segment_ptr();
    for (int u = F.tid; u < (LDS_BYTES - LDSCTL_OFF) / 4; u += NWAVES * 64) ((LAS unsigned*)(F.lds + LDSCTL_OFF))[u] = 0u;
    __syncthreads();
    XcdBarrier bar = xcd_barrier_post((unsigned*)(F.ctl + CW_BAR), F.MISC + 8);

    const int bx = (int)blockIdx.x;

    {   PHASE();
        prep_mixer_weights(Fp);
        memnorm_phase(Fp);
        prep_ffn_weights(Fp, 0);
        norm_phase(Fp, Fp.in[I_X], nullptr, Fp.in[I_GMIX], false, true); }
    GRID_BAR();
    SC_AFTER_PROLOGUE();

    layer_body<0>(F, bar, bx); layer_body<1>(F, bar, bx); layer_body<2>(F, bar, bx); layer_body<3>(F, bar, bx);
    {   PHASE(); final_norm_phase(Fp, X_, Fp.out, Fp.in[I_GFIN], true); }
    SC_FINAL();
}

extern "C" void kernel_launch(void* const* d_in, const int* in_sizes, int n_in, void* d_out, int out_size, void* d_ws, size_t ws_size, hipStream_t stream) {
    static int grid = 0;
    if (grid == 0) {
        if (n_in != 23 || out_size != T * DM || ws_size < WS_END) { fprintf(stderr, "kernel_launch: unexpected problem (n_in %d, out %d, ws %zu < %zu)\n", n_in, out_size, ws_size, (size_t)WS_END); grid = -1; return; }
        int dev = 0, cus = 0;
        if (hipGetDevice(&dev) != hipSuccess || hipDeviceGetAttribute(&cus, hipDeviceAttributeMultiprocessorCount, dev) != hipSuccess) { grid = -1; return; }
        if (hipFuncSetAttribute((const void*)fwd, hipFuncAttributeMaxDynamicSharedMemorySize, LDS_BYTES) != hipSuccess) { fprintf(stderr, "kernel_launch: hipFuncSetAttribute failed\n"); grid = -1; return; }
        int per_cu = 0;
        if (hipOccupancyMaxActiveBlocksPerMultiprocessor(&per_cu, (const void*)fwd, NWAVES * 64, LDS_BYTES) != hipSuccess || per_cu < 1) fprintf(stderr, "kernel_launch: occupancy query says %d\n", per_cu);
        (void)hipGetLastError();
        grid = cus;
    }
    if (grid < 0) return;
    if (hipMemsetAsync((char*)d_ws + WS_CTL, 0, CTL_ZERO_BYTES, stream) != hipSuccess) return;
    Args a{};
    for (int i = 0; i < 23; ++i) a.in[i] = (const float*)d_in[i];
    a.out = (float*)d_out; a.ws = (unsigned char*)d_ws;
    hipLaunchKernelGGL(fwd, dim3(grid), dim3(NWAVES * 64), LDS_BYTES, stream, a);
}
```

```cpp
#include <hip/hip_runtime.h>
#include <cstdio>
#include <cstdint>

#ifndef SELFCHECK
#define SELFCHECK 0
#endif
#ifndef GU_I8_MASK
#define GU_I8_MASK 0xF
#endif
#define GU_I8(l) ((((unsigned)GU_I8_MASK) >> (l)) & 1u)

#define GAS __attribute__((address_space(1)))
#define LAS __attribute__((address_space(3)))
typedef unsigned short bf16_t;
typedef short bf16x8 __attribute__((ext_vector_type(8)));
typedef short s16x4 __attribute__((ext_vector_type(4)));
typedef short v4i16_t __attribute__((ext_vector_type(4)));
typedef float f32x2 __attribute__((ext_vector_type(2)));
typedef float f32x4 __attribute__((ext_vector_type(4)));
typedef float f32x16 __attribute__((ext_vector_type(16)));
typedef unsigned u32x2 __attribute__((ext_vector_type(2)));
typedef unsigned u32x4 __attribute__((ext_vector_type(4)));
typedef int i32x4 __attribute__((ext_vector_type(4)));
typedef GAS unsigned gu32;
#define RLX_AGENT __ATOMIC_RELAXED, __HIP_MEMORY_SCOPE_AGENT

constexpr int NB = 8, SEQ = 4096, T = NB * SEQ, DM = 1024, DEPTH = 4, MEML = 256, DFF = 3584, NE = 8;
constexpr int INW = 4768;
constexpr int PW = 1792;
constexpr int GW = 3072;
constexpr int QBW = 768, KVW = 1024, YW = 1536;
constexpr int NT_IN = 19;
constexpr int P_QA = 0, P_KA = 512, P_VA = 640, P_CQ = 768, P_CKV = 1024, P_KR = 1152, P_QM = 1280;
constexpr int UPK = 256, UPN = 1792;
constexpr int MAXSLOT = 67584;
constexpr int MAXRT = MAXSLOT / 256;
constexpr float EPS = 1e-6f;
constexpr float LOG2E = 1.4426950408889634f;
constexpr float C_A = 0.125f * LOG2E;
constexpr float C_B = 0.10206207261596575f * LOG2E;
constexpr float C_M = 0.08838834764831845f * LOG2E;

constexpr size_t MiB = 1u << 20;
constexpr size_t WS_CTL = 0, CTL_ZERO_BYTES = 1 * MiB;
constexpr size_t WS_MISC = 1 * MiB;
constexpr size_t WL_IN = 0, WL_UP = (size_t)NT_IN * 256 * DM * 2, WL_BR = WL_UP + (size_t)UPN * UPK * 2, WL_OUT = WL_BR + (size_t)3 * DM * 512 * 2, WL_SIZE = WL_OUT + (size_t)DM * DM * 2;
constexpr size_t WS_WMIX = 8 * MiB;
constexpr int TAIL_KS = 4;
constexpr size_t WS_SLAB = WS_WMIX;
constexpr size_t WS_WMKV = WS_WMIX + 4 * ((WL_SIZE + MiB - 1) / MiB) * MiB;
constexpr size_t WL_STRIDE = ((WL_SIZE + MiB - 1) / MiB) * MiB;
constexpr size_t WS_WFFN = WS_WMKV + 8 * MiB;
constexpr size_t WF_GU = 0, WF_D = (size_t)2 * DFF * DM * 2, WF_STRIDE = WF_D + (size_t)DM * DFF * 2;
constexpr size_t WS_H = WS_WFFN + 8 * WF_STRIDE;
constexpr size_t WS_MEMN = WS_H + (size_t)T * DM * 2;
constexpr size_t WS_MEMKV = WS_MEMN + (size_t)NB * MEML * DM * 2;
constexpr size_t WS_R = WS_MEMKV + (size_t)NB * MEML * 4096 * 2;
constexpr size_t R_P = 0, R_G = R_P + (size_t)T * PW * 2, R_QB = R_G + (size_t)T * GW * 2, R_KVB = R_QB + (size_t)T * QBW * 2, R_Y = R_KVB + (size_t)T * KVW * 2, R_END_MIX = R_Y + (size_t)T * YW * 2;
constexpr size_t R_ACT = 0;
constexpr size_t R_ASORT = (size_t)MAXSLOT * DFF * 2;
constexpr size_t R_YOUT = R_ASORT;
constexpr size_t R_END_FFN = R_YOUT + (size_t)MAXSLOT * DM * 2;
constexpr size_t R_SIZE = R_END_MIX > R_END_FFN ? R_END_MIX : R_END_FFN;
constexpr size_t WS_XB = WS_R + R_SIZE;
constexpr size_t WS_END = WS_XB + (size_t)T * DM * 2;
static_assert(WS_END < 1020ull * MiB, "workspace budget");
static_assert((size_t)8 * 4 * TAIL_KS * 256 * 256 * 4 <= 2 * WL_STRIDE, "tail slabs fit two layers' mixer weights");
constexpr size_t MS_TOKE = 0;
constexpr size_t MS_TOKW = MS_TOKE + (size_t)T * 8;
constexpr size_t MS_SLOT = MS_TOKW + (size_t)T * 8;
constexpr size_t MS_CNT = MS_SLOT + (size_t)T * 8;
constexpr size_t MS_TEXP = MS_CNT + 256 * 8 * 4;
constexpr size_t MS_SSQ = MS_TEXP + 2048;
constexpr size_t MS_SNAP = MS_SSQ + (size_t)T * 32;
constexpr size_t MS_HSC = MS_SNAP + 64 * 1024 * 4;
constexpr size_t MS_ASC = MS_HSC + (size_t)T * 4;
constexpr size_t MS_WSIN = MS_ASC + (size_t)MAXSLOT * 4;
constexpr size_t MS_WSGU = MS_WSIN + (size_t)4 * NT_IN * 256 * 4;
constexpr size_t MS_END = MS_WSGU + (size_t)8 * 2 * DFF * 4;
static_assert(MS_END <= 7 * MiB, "misc map");
constexpr int CW_BAR = 4096;
constexpr int CW_DIAG = 16384;
constexpr int CW_CODE = 16384 + 512;

constexpr int RING_BYTES = 131072;
constexpr int LDSCTL_OFF = RING_BYTES;
constexpr int LDS_BYTES = 147456;
constexpr int NWAVES = 8;

#define LDS_WAIT() asm volatile("s_waitcnt lgkmcnt(0)" ::: "memory")
#define VM_WAIT() asm volatile("s_waitcnt vmcnt(0)" ::: "memory")

__device__ __forceinline__ unsigned f2bf(float f) { unsigned u = __builtin_bit_cast(unsigned, f); return (u + 0x7fffu + ((u >> 16) & 1u)) >> 16; }
__device__ __forceinline__ unsigned pk2(float lo, float hi) { return f2bf(lo) | (f2bf(hi) << 16); }
__device__ __forceinline__ float bf2f(unsigned short b) { return __builtin_bit_cast(float, (unsigned)b << 16); }
__device__ __forceinline__ float bflo(unsigned w) { return __builtin_bit_cast(float, w << 16); }
__device__ __forceinline__ float bfhi(unsigned w) { return __builtin_bit_cast(float, w & 0xffff0000u); }
typedef __bf16 bf16x2_t __attribute__((ext_vector_type(2)));
__device__ __forceinline__ unsigned cvtpk(float lo, float hi) { f32x2 v = {lo, hi}; bf16x2_t b = __builtin_convertvector(v, bf16x2_t); return __builtin_bit_cast(unsigned, b); }
__device__ __forceinline__ float wave_sum(float v) {
#pragma unroll
    for (int o = 1; o < 64; o <<= 1) v += __shfl_xor(v, o);
    return v;
}
__device__ __forceinline__ float fast_sigmoid(float x) { return __builtin_amdgcn_rcpf(1.0f + __builtin_amdgcn_exp2f(-x * LOG2E)); }


__device__ __forceinline__ int opq_v(int x) { asm volatile("" : "+v"(x)); return x; }
__device__ __forceinline__ int opq_s(int x) { asm volatile("" : "+s"(x)); return x; }
template <class Tp> __device__ __forceinline__ Tp* opq_p(Tp* p) { const unsigned long long u = (unsigned long long)p; unsigned lo = __builtin_amdgcn_readfirstlane((unsigned)u), hi = __builtin_amdgcn_readfirstlane((unsigned)(u >> 32)); asm volatile("" : "+s"(lo), "+s"(hi)); return (Tp*)(((unsigned long long)hi << 32) | lo); }

__constant__ float IFR_HI[32] = {1.591549367e-01f, 1.193493679e-01f, 8.949939907e-02f, 6.711508334e-02f, 5.032921210e-02f, 3.774158657e-02f, 2.830219641e-02f, 2.122365311e-02f, 1.591549441e-02f, 1.193493698e-02f, 8.949940093e-03f, 6.711508147e-03f, 5.032921210e-03f, 3.774158424e-03f, 2.830219688e-03f, 2.122365171e-03f, 1.591549488e-03f, 1.193493721e-03f, 8.949940093e-04f, 6.711508031e-04f, 5.032921326e-04f, 3.774158540e-04f, 2.830219455e-04f, 2.122365258e-04f, 1.591549371e-04f, 1.193493736e-04f, 8.949940093e-05f, 6.711508468e-05f, 5.032921035e-05f, 3.774158540e-05f, 2.830219637e-05f, 2.122365186e-05f};
__constant__ float IFR_LO[32] = {6.420638243e-09f, 2.294664903e-09f, 2.542919653e-09f, -3.316028840e-10f, 5.173299289e-12f, -1.848551645e-09f, -5.826552019e-10f, -3.431038786e-10f, -1.029942243e-10f, 4.320196978e-11f, 6.802745173e-11f, 1.531042237e-10f, 5.173301024e-13f, 4.797548470e-11f, -1.048316434e-10f, 1.053879969e-10f, -5.686555046e-11f, -1.896286773e-11f, 6.802744999e-12f, 2.695195456e-11f, -1.158979943e-11f, -6.843983713e-12f, 1.279990003e-11f, 1.807650600e-12f, 5.954976963e-12f, -3.351478166e-12f, 6.802745216e-13f, -1.670379113e-12f, 1.751403167e-12f, -6.843983930e-13f, -5.389994549e-13f, 9.083608431e-13f};
__device__ __forceinline__ void rot_cs(float posf, int idx, float& c, float& s) {
    const float ch = IFR_HI[idx], cl = IFR_LO[idx];
    const float p = posf * ch, e = __builtin_fmaf(posf, ch, -p);
    const float fr = __builtin_amdgcn_fractf(p) + (e + posf * cl);
    s = __builtin_amdgcn_sinf(fr); c = __builtin_amdgcn_cosf(fr);
}

#define XB_TMO      128
#define XB_XCNT(j)  (256  + 64 * (j))
#define XB_XSUB(j)  (1280 + 64 * (j))
#define XB_XGEN(j)  (2304 + 64 * (j))
#define XB_TOP      3328
#define XB_TOPGEN   3392
#define XCD_BAR_WORDS 3456
#define XB_SPIN_CAP (1u << 20)

__device__ __forceinline__ unsigned xb_ld(unsigned* p)              { return __hip_atomic_load(p, __ATOMIC_RELAXED, __HIP_MEMORY_SCOPE_AGENT); }
__device__ __forceinline__ unsigned xb_add(unsigned* p, unsigned v) { return __hip_atomic_fetch_add(p, v, __ATOMIC_RELAXED, __HIP_MEMORY_SCOPE_AGENT); }
__device__ __forceinline__ unsigned xb_xcc_id() { return (unsigned)__builtin_amdgcn_s_getreg((3 << 11) | 20) & 0xFu; }
#define XB_SPIN(cond, bar) do { unsigned _sp = 0; while (cond) { __builtin_amdgcn_s_sleep(1); \
    if ((++_sp & 255u) == 0u) { if (xb_ld(&(bar)[XB_TMO])) break; if (_sp > XB_SPIN_CAP) { atomicAdd(&(bar)[XB_TMO], 1u); break; } } } } while (0)

struct XcdBarrier { unsigned* bar; unsigned x; volatile LAS unsigned* st; };

__device__ __forceinline__ XcdBarrier xcd_barrier_post(unsigned* bar, volatile LAS unsigned* st) {
    XcdBarrier b; b.bar = bar; b.x = xb_xcc_id(); b.st = st;
    if (threadIdx.x == 0) (void)xb_add(&bar[XB_XCNT(b.x)], 1u);
    return b;
}
__device__ __forceinline__ void xcd_barrier_complete(unsigned* bar, unsigned x, unsigned& nloc, unsigned& nx) {
    const unsigned G = gridDim.x * gridDim.y * gridDim.z;
    unsigned sum, cnt, mine, sp = 0u;
    for (;;) {
        sum = 0u; cnt = 0u; mine = 0u;
#pragma unroll
        for (unsigned j = 0; j < 16; ++j) { const unsigned c = xb_ld(&bar[XB_XCNT(j)]); sum += c; cnt += (c > 0u) ? 1u : 0u; mine = (j == x) ? c : mine; }
        if (sum == G) break;
        __builtin_amdgcn_s_sleep(1);
        if ((++sp & 255u) == 0u) { if (xb_ld(&bar[XB_TMO])) break; if (sp > XB_SPIN_CAP) { atomicAdd(&bar[XB_TMO], 1u); break; } }
    }
    nloc = mine > 0u ? mine : 1u; nx = cnt > 0u ? cnt : 1u;
}
__device__ __forceinline__ void xcd_barrier(const XcdBarrier& b) {
    asm volatile("s_waitcnt vmcnt(0)" ::: "memory");
    __syncthreads();
    if (threadIdx.x == 0) {
        unsigned* bar = b.bar;
        __builtin_amdgcn_s_waitcnt(0);
        unsigned nloc = b.st[0], nx = b.st[1];
        if (nloc == 0u) { xcd_barrier_complete(bar, b.x, nloc, nx); b.st[0] = nloc; b.st[1] = nx; }
        const unsigned old = xb_add(&bar[XB_XSUB(b.x)], 1u);
        const unsigned gen = old / nloc;
        if (old + 1u == (gen + 1u) * nloc) {
            __builtin_amdgcn_fence(__ATOMIC_RELEASE, "agent");
            asm volatile("s_waitcnt vmcnt(0)" ::: "memory");
            const unsigned og = xb_add(&bar[XB_TOP], 1u);
            const unsigned tg = og / nx;
            if (og + 1u == (tg + 1u) * nx) xb_add(&bar[XB_TOPGEN], 1u);
            else XB_SPIN(xb_ld(&bar[XB_TOPGEN]) == tg, bar);
            __builtin_amdgcn_fence(__ATOMIC_ACQUIRE, "agent");
            xb_add(&bar[XB_XGEN(b.x)], 1u);
            asm volatile("s_waitcnt vmcnt(0)" ::: "memory");
        } else {
            XB_SPIN(xb_ld(&bar[XB_XGEN(b.x)]) == gen, bar);
            __builtin_amdgcn_fence(__ATOMIC_ACQUIRE, "agent");
            asm volatile("s_waitcnt vmcnt(0)" ::: "memory");
        }
    }
    __syncthreads();
}

namespace pg8 {
constexpr int BM = 256, BK = 64, HALF = 128, HTB = HALF * BK * 2, STAGE_BYTES = 8 * HTB, NXCD = 8, WGM = 4;
constexpr int ESC_OFF = 131072 + 4096, ESC_SLOT = 3072;
__host__ __device__ __forceinline__ int lds_byte(int r, int c) { const int st = (r >> 4) * 2 + (c >> 5), rr = r & 15, cc = c & 31, ob = rr * 64 + cc * 2; return st * 1024 + (ob ^ (((ob >> 9) & 1) << 5)); }
__host__ __device__ __forceinline__ void stage_rc(int b, int& R, int& C) { const int st = b / 1024, sb = b % 1024, swz = sb ^ (((sb >> 9) & 1) << 5); R = (st >> 1) * 16 + swz / 64; C = (st & 1) * 32 + (swz % 64) / 2; }

struct Unit { int pm, pn, aux; };

struct StaticOrder {
    int nM, nN, nwg, G, c, rev, wgm;
    __device__ void init(int nM_, int nN_, int G_, int c_, int rev_ = 0, int wgm_ = WGM) { nM = nM_; nN = nN_; nwg = nM * nN; G = G_; c = c_; rev = rev_; wgm = wgm_; }
    __device__ bool next(int i, Unit& u) const {
        const long L = (long)i * G + c; if (L >= nwg) return false;
        int wgid = (int)L; { const int q = nwg / NXCD, r = nwg % NXCD, xcd = wgid % NXCD, off = wgid / NXCD; wgid = (xcd < r ? xcd * (q + 1) : r * (q + 1) + (xcd - r) * q) + off; }
        const int nig = wgm * nN, gid = wgid / nig, fm = gid * wgm, gsz = (nM - fm) < wgm ? (nM - fm) : wgm;
        u.pm = fm + ((wgid % nig) % gsz); u.pn = (wgid % nig) / gsz; u.aux = 0; if (rev) u.pm = nM - 1 - u.pm; return true;
    }
};

template <bool I8> struct AccVec { typedef f32x4 type; };
template <> struct AccVec<true> { typedef i32x4 type; };
template <bool I8 = false, class Prob, class Sched, class Epi>
__device__ __forceinline__ void gemm_phase(LAS unsigned char* lds, const Prob& P, const Sched& S, const Epi& E) {
    const int tid = opq_v((int)threadIdx.x), wid = __builtin_amdgcn_readfirstlane(tid >> 6), lane = tid & 63, wr = wid >> 2, wc = wid & 3, fr = lane & 15, fq = lane >> 4;
    typedef typename AccVec<I8>::type accv_t;
    const int K = P.K, nt = K / (I8 ? 2 * BK : BK);
    unsigned voffA[2], voffB[2];
#pragma unroll
    for (int i = 0; i < 2; ++i) { int R, C; stage_rc(tid * 16 + i * 8192, R, C); voffA[i] = (unsigned)R * P.lda + (unsigned)C * 2u; voffB[i] = (unsigned)R * P.ldb + (unsigned)C * 2u; }
    const size_t kstep = (size_t)(BK * 2);
    const size_t hstepA = (size_t)HALF * P.lda, hstepB = (size_t)HALF * P.ldb;
    const unsigned ldsw = (unsigned)wid * 1024u;
    const int aoff = lds_byte(wr * 64 + fr, fq * 8), boff = lds_byte(wc * 32 + fr, fq * 8);
#define PG8_SA(b, h) (((b) * 2 + (h)) * HTB)
#define PG8_SB(b, h) ((4 + (b) * 2 + (h)) * HTB)
#define PG8_STAGE(bufoff, gbase, voff) do { _Pragma("unroll") for (int _i = 0; _i < 2; ++_i) \
        __builtin_amdgcn_global_load_lds((const unsigned*)((const char*)(gbase) + (voff)[_i]), (LAS unsigned*)(lds + (bufoff) + ldsw + _i * 8192), 16, 0, 0); } while (0)
#define PG8_LDA(dst, b, h) do { _Pragma("unroll") for (int m = 0; m < 4; ++m) _Pragma("unroll") for (int k = 0; k < 2; ++k) dst[m][k] = *(const LAS bf16x8*)(lds + PG8_SA(b, h) + aoff + m * 2048 + k * 1024); } while (0)
#define PG8_LDB(dst, b, h) do { _Pragma("unroll") for (int n = 0; n < 2; ++n) _Pragma("unroll") for (int k = 0; k < 2; ++k) dst[n][k] = *(const LAS bf16x8*)(lds + PG8_SB(b, h) + boff + n * 2048 + k * 1024); } while (0)
#define PG8_MMA(ai, bj, At, Bt) do { __builtin_amdgcn_s_setprio(1); _Pragma("unroll") for (int m = 0; m < 4; ++m) _Pragma("unroll") for (int n = 0; n < 2; ++n) _Pragma("unroll") for (int k = 0; k < 2; ++k) \
        { if constexpr (I8) acc[ai][bj][m][n] = __builtin_amdgcn_mfma_i32_16x16x64_i8(__builtin_bit_cast(i32x4, Bt[n][k]), __builtin_bit_cast(i32x4, At[m][k]), acc[ai][bj][m][n], 0, 0, 0); \
          else acc[ai][bj][m][n] = __builtin_amdgcn_mfma_f32_16x16x32_bf16(Bt[n][k], At[m][k], acc[ai][bj][m][n], 0, 0, 0); } __builtin_amdgcn_s_setprio(0); } while (0)
#define PG8_WAIT_V(n) asm volatile("s_waitcnt vmcnt(" #n ")" ::: "memory")
#define PG8_WAIT_L(n) asm volatile("s_waitcnt lgkmcnt(" #n ")" ::: "memory")
#define PG8_BAR __builtin_amdgcn_s_barrier()
#define PG8_SCHED __builtin_amdgcn_sched_barrier(0)
    Unit cur, nxt; int ui = 0;
    if (!S.next(0, cur)) return;
    accv_t acc[2][2][4][2];
#pragma unroll
    for (int a = 0; a < 2; ++a)
#pragma unroll
        for (int b = 0; b < 2; ++b)
#pragma unroll
            for (int m = 0; m < 4; ++m)
#pragma unroll
                for (int n = 0; n < 2; ++n) acc[a][b][m][n] = accv_t{};
    bf16x8 At[4][2], B0[2][2], B1[2][2];
    const char* cA = P.a_ptr(cur); const char* cB = P.b_ptr(cur);
    int eslot = 0;
    E.stage(lds + ESC_OFF, cur, wid, lane);
    PG8_STAGE(PG8_SB(0, 0), cB, voffB); PG8_STAGE(PG8_SB(0, 1), cB + hstepB, voffB); PG8_STAGE(PG8_SA(0, 0), cA, voffA); PG8_STAGE(PG8_SA(0, 1), cA + hstepA, voffA);
    if (wr == 1) PG8_BAR;
    PG8_WAIT_V(2); PG8_BAR;
    PG8_STAGE(PG8_SB(1, 0), cB + kstep, voffB); PG8_STAGE(PG8_SA(1, 0), cA + kstep, voffA); PG8_STAGE(PG8_SB(1, 1), cB + hstepB + kstep, voffB);
    PG8_WAIT_V(6); PG8_BAR;
    for (;;) {
        const bool has_next = S.next(ui + 1, nxt);
        const char* nA = has_next ? P.a_ptr(nxt) : cA; const char* nB = has_next ? P.b_ptr(nxt) : cB;
        for (int t = 0; t < nt; t += 2) {
            if constexpr (Epi::MID) { if (t == 8 || t == 16) E.mid(acc, cur, t >> 3, wr, wc, fr, fq); }
            const bool last = (t == nt - 2);
            if (last && has_next) E.stage(lds + ESC_OFF + (eslot ^ 1) * ESC_SLOT, nxt, wid, lane);
            const char* a1 = cA + (size_t)(t + 1) * kstep;
            const char* a2 = last ? nA : cA + (size_t)(t + 2) * kstep; const char* b2 = last ? nB : cB + (size_t)(t + 2) * kstep;
            const char* a3 = a2 + kstep; const char* b3 = b2 + kstep;
            PG8_LDB(B0, 0, 0); PG8_LDB(B1, 0, 1); PG8_SCHED; PG8_LDA(At, 0, 0); PG8_STAGE(PG8_SA(1, 1), a1 + hstepA, voffA);
            PG8_WAIT_V(8); PG8_WAIT_L(0); PG8_BAR; PG8_MMA(0, 0, At, B0); PG8_MMA(0, 1, At, B1); PG8_BAR; PG8_SCHED;
            PG8_LDA(At, 0, 1); PG8_STAGE(PG8_SB(0, 0), b2, voffB); PG8_STAGE(PG8_SB(0, 1), b2 + hstepB, voffB); PG8_STAGE(PG8_SA(0, 0), a2, voffA);
            PG8_WAIT_V(8); PG8_WAIT_L(0); PG8_BAR; PG8_MMA(1, 0, At, B0); PG8_MMA(1, 1, At, B1); PG8_BAR; PG8_SCHED;
            PG8_LDB(B0, 1, 0); PG8_LDB(B1, 1, 1); PG8_SCHED; PG8_LDA(At, 1, 0); PG8_STAGE(PG8_SA(0, 1), a2 + hstepA, voffA);
            PG8_WAIT_V(8); PG8_WAIT_L(0); PG8_BAR; PG8_MMA(0, 0, At, B0); PG8_MMA(0, 1, At, B1); PG8_BAR; PG8_SCHED;
            PG8_LDA(At, 1, 1); PG8_STAGE(PG8_SB(1, 0), b3, voffB); PG8_STAGE(PG8_SB(1, 1), b3 + hstepB, voffB); PG8_STAGE(PG8_SA(1, 0), a3, voffA);
            PG8_WAIT_V(8); PG8_WAIT_L(0); PG8_BAR; PG8_MMA(1, 0, At, B0); PG8_MMA(1, 1, At, B1); PG8_BAR; PG8_SCHED;
        }
        if (wr == 0) PG8_BAR;
        E(acc, cur, wr, wc, fr, fq, lds + ESC_OFF + eslot * ESC_SLOT);
        if (!has_next) break;
#pragma unroll
        for (int a = 0; a < 2; ++a)
#pragma unroll
            for (int b = 0; b < 2; ++b)
#pragma unroll
                for (int m = 0; m < 4; ++m)
#pragma unroll
                    for (int n = 0; n < 2; ++n) acc[a][b][m][n] = accv_t{};
        cur = nxt; cA = nA; cB = nB; ++ui; eslot ^= 1;
        if (wr == 1) PG8_BAR;
    }
    PG8_WAIT_V(0);
    PG8_BAR;
#undef PG8_SA
#undef PG8_SB
#undef PG8_STAGE
#undef PG8_LDA
#undef PG8_LDB
#undef PG8_MMA
#undef PG8_WAIT_V
#undef PG8_WAIT_L
#undef PG8_BAR
#undef PG8_SCHED
}
}

struct Frame {
    LAS unsigned char* lds;
    volatile LAS unsigned* MISC;
    gu32* ctl;
    unsigned char* ws;
    int tid, lane, wave, vcu, G;
    const float* const* in; float* out;
};
enum { I_X = 0, I_MEM, I_POS, I_GMIX, I_WIN, I_GQ, I_WUQ, I_GKV, I_WUKV, I_SINK, I_WMKV, I_WBR, I_WOUT, I_GFFN, I_WGD, I_WUD, I_WDD, I_WR, I_WGE, I_WUE, I_WDE, I_GMEM, I_GFIN };

__device__ __forceinline__ int sem_plain(int g) { return (g & ~31) + 8 * ((g >> 2) & 3) + 4 * ((g >> 4) & 1) + (g & 3); }
__device__ __forceinline__ int sem_rot64(int g) { return (g & ~63) + 32 * ((g >> 4) & 1) + 16 * ((g >> 5) & 1) + 4 * ((g >> 2) & 3) + (g & 3); }
__device__ __forceinline__ int sem_p16(int g) { const int c = g & 255; return (g & ~255) + 64 * ((c >> 5) & 3) + 16 * ((c >> 2) & 3) + 8 * (c >> 7) + 4 * ((c >> 4) & 1) + (c & 3); }
__device__ __forceinline__ int inproj_src(int n) {
    const int pn = n >> 8, c = n & 255;
    if (pn < 2) return pn * 256 + sem_rot64(c);
    if (pn == 2) return c < 128 ? 512 + sem_rot64(c) : 640 + sem_plain(c - 128);
    if (pn == 3) return 768 + sem_plain(c);
    if (pn == 4) return c < 128 ? 1024 + sem_plain(c) : (c < 160 ? 1152 + (c - 128) : -1);
    if (pn < 7) return 1184 + (pn - 5) * 256 + sem_plain(c);
    return 1696 + (pn - 7) * 256 + sem_p16(c);
}

struct MapInproj { const float* W; __device__ __forceinline__ float load(int k, int n) const { const int s = inproj_src(n); return s >= 0 ? W[(size_t)k * INW + s] : 0.f; }
    __device__ __forceinline__ f32x4 load4(int k, int n) const { const int s = inproj_src(n); return s >= 0 ? *(const f32x4*)(W + (size_t)k * INW + s) : (f32x4){0.f, 0.f, 0.f, 0.f}; } };
struct MapUp { const float *Wq, *Wkv, *gq, *gkv;
    __device__ __forceinline__ f32x4 load4(int k, int n) const {
        if (n < 768) { const int gg = n >> 5; const int s = (gg % 3 == 2) ? n : sem_plain(n); return *(const f32x4*)(Wq + (size_t)k * 768 + s) * gq[k]; }
        if (k < 128) return (f32x4){0.f, 0.f, 0.f, 0.f}; const int s = sem_plain(n - 768); return *(const f32x4*)(Wkv + (size_t)(k - 128) * 1024 + s) * gkv[k - 128]; }
    __device__ __forceinline__ float load(int k, int n) const {
        if (n < 768) { const int gg = n >> 5; const int s = (gg % 3 == 2) ? n : sem_plain(n); return gq[k] * Wq[(size_t)k * 768 + s]; }
        if (k < 128) return 0.f; const int s = sem_plain(n - 768); return gkv[k - 128] * Wkv[(size_t)(k - 128) * 1024 + s]; } };
struct MapPlain { const float* W; int ldw; __device__ __forceinline__ float load(int k, int n) const { return W[(size_t)k * ldw + sem_plain(n)]; }
    __device__ __forceinline__ f32x4 load4(int k, int n) const { return *(const f32x4*)(W + (size_t)k * ldw + sem_plain(n)); } };
struct MapNat { const float* W; int ldw; __device__ __forceinline__ float load(int k, int n) const { return W[(size_t)k * ldw + n]; }
    __device__ __forceinline__ f32x4 load4(int k, int n) const { return *(const f32x4*)(W + (size_t)k * ldw + n); } };
struct MapBr { const float* W;
    __device__ __forceinline__ float load(int k, int n) const { return W[(size_t)k * DM + sem_p16(n)]; }
    __device__ __forceinline__ f32x4 load4(int k, int n) const { return *(const f32x4*)(W + (size_t)k * DM + sem_p16(n)); } };
struct MapMemkv { const float* W; __device__ __forceinline__ float load(int k, int n) const { const int l = n >> 10, c = n & 1023; return W[((size_t)l * DM + k) * 1024 + sem_plain(c)]; }
    __device__ __forceinline__ f32x4 load4(int k, int n) const { const int l = n >> 10, c = n & 1023; return *(const f32x4*)(W + ((size_t)l * DM + k) * 1024 + sem_plain(c)); } };
struct MapGU { const float *Wg, *Wu; __device__ __forceinline__ float load(int k, int n) const { const int pn = n >> 8, c = n & 255; const int ch = 128 * pn + sem_plain(c & 127);
    const unsigned long long a = (unsigned long long)Wg, b = (unsigned long long)Wu, w = a ^ ((a ^ b) & (0ull - (unsigned long long)(c >> 7))); return ((const float*)w)[(size_t)k * DFF + ch]; }
    __device__ __forceinline__ f32x4 load4(int k, int n) const { const int pn = n >> 8, c = n & 255; const int ch = 128 * pn + sem_plain(c & 127);
        const unsigned long long a = (unsigned long long)Wg, b = (unsigned long long)Wu, w = a ^ ((a ^ b) & (0ull - (unsigned long long)(c >> 7))); return *(const f32x4*)((const float*)w + (size_t)k * DFF + ch); } };

template <class M> __device__ __forceinline__ void prep_item(const M& m, bf16_t* dst, int Kd, int nblk, LAS float* scr, int item, int lane) {
    const int kb = item / nblk, nb = item % nblk, k0 = 64 * kb, n0 = 32 * nb;
#pragma unroll 8
    for (int i = 0; i < 32; ++i) { const int kk = 2 * i + (lane >> 5); scr[kk * 33 + (lane & 31)] = m.load(k0 + kk, n0 + (lane & 31)); }
    LDS_WAIT(); asm volatile("" ::: "memory");
    const int c = lane & 7;
#pragma unroll
    for (int j = 0; j < 4; ++j) { const int n = (lane >> 3) + 8 * j; const LAS float* s = scr + (8 * c) * 33 + n;
        u32x4 o; o.x = pk2(s[0 * 33], s[1 * 33]); o.y = pk2(s[2 * 33], s[3 * 33]); o.z = pk2(s[4 * 33], s[5 * 33]); o.w = pk2(s[6 * 33], s[7 * 33]);
        *(u32x4*)(dst + (size_t)(n0 + n) * Kd + k0 + 8 * c) = o; }
    LDS_WAIT(); asm volatile("" ::: "memory");
}
template <class M> __device__ __forceinline__ void prep_tile(const M& m, bf16_t* dst, int Kd, int nblk, LAS unsigned char* tile, int item, int lane) {
    const int kb = item / nblk, nb = item % nblk, k0 = 128 * kb, n0 = 32 * nb, ng = lane & 7, kr = lane >> 3;
    f32x4 v[16];
#pragma unroll
    for (int i = 0; i < 16; ++i) v[i] = m.load4(k0 + 8 * i + kr, n0 + 4 * ng);
#pragma unroll
    for (int i = 0; i < 16; ++i)
#pragma unroll
        for (int c = 0; c < 4; ++c) *(LAS unsigned short*)(tile + (4 * ng + c) * 272 + (8 * i + kr) * 2) = (unsigned short)f2bf(v[i][c]);
    LDS_WAIT(); asm volatile("" ::: "memory");
#pragma unroll
    for (int j = 0; j < 8; ++j) { const int p = lane + 64 * j, n = p >> 4, kc = p & 15;
        *(u32x4*)(dst + (size_t)(n0 + n) * Kd + k0 + 8 * kc) = *(const LAS u32x4*)(tile + n * 272 + 16 * kc); }
    LDS_WAIT(); asm volatile("" ::: "memory");
}
template <class M> __device__ __forceinline__ void prep_matrix(Frame& F, const M& m, bf16_t* dst, int N, int K) {
    LAS unsigned char* tile = F.lds + F.wave * 16384;
    const int gw = F.vcu * NWAVES + F.wave, NGW = F.G * NWAVES, nblk = N / 32, nitems = (K / 128) * nblk;
    for (int it = gw; it < nitems; it += NGW) prep_tile(m, dst, K, nblk, tile, it, F.lane);
}

template <class M> __device__ __forceinline__ void prep_strip_i8(Frame& F, const M& m, signed char* dst, float* scl, int strip) {
    const int lane = F.lane, w = F.wave, n0 = strip * 32, k0 = w * 128, ng = lane & 7, kr = lane >> 3;
    LAS unsigned char* tile = F.lds + w * 16384;
    LAS float* amt = (LAS float*)(F.lds + LDSCTL_OFF + 2048);
    f32x4 v[16];
#pragma unroll
    for (int i = 0; i < 16; ++i) v[i] = m.load4(k0 + 8 * i + kr, n0 + 4 * ng);
    f32x4 am = __builtin_elementwise_abs(v[0]);
#pragma unroll
    for (int i = 1; i < 16; ++i) am = __builtin_elementwise_max(am, __builtin_elementwise_abs(v[i]));
#pragma unroll
    for (int c = 0; c < 4; ++c) { float a = am[c]; a = fmaxf(a, __shfl_xor(a, 8)); a = fmaxf(a, __shfl_xor(a, 16)); a = fmaxf(a, __shfl_xor(a, 32)); am[c] = a; }
    if (kr == 0) *(LAS f32x4*)(amt + w * 32 + 4 * ng) = am;
    __syncthreads();
    f32x4 cm = *(const LAS f32x4*)(amt + 4 * ng);
#pragma unroll
    for (int ww = 1; ww < 8; ++ww) cm = __builtin_elementwise_max(cm, *(const LAS f32x4*)(amt + ww * 32 + 4 * ng));
    f32x4 inv;
#pragma unroll
    for (int c = 0; c < 4; ++c) inv[c] = cm[c] > 0.f ? 127.0f / cm[c] : 0.f;
    if (w == 0 && kr == 0) *(f32x4*)(scl + n0 + 4 * ng) = cm * (1.0f / 127.0f);
#pragma unroll
    for (int i = 0; i < 16; ++i)
#pragma unroll
        for (int c = 0; c < 4; ++c) tile[(4 * ng + c) * 144 + 8 * i + kr] = (unsigned char)(signed char)__float2int_rn(v[i][c] * inv[c]);
    LDS_WAIT(); asm volatile("" ::: "memory");
#pragma unroll
    for (int j = 0; j < 4; ++j) { const int p = lane + 64 * j, n = p >> 3, kc = p & 7;
        *(u32x4*)(dst + (size_t)(n0 + n) * DM + k0 + 16 * kc) = *(const LAS u32x4*)(tile + n * 144 + 16 * kc); }
    LDS_WAIT();
    __syncthreads();
}
__device__ __forceinline__ bf16_t* wmix(Frame& F, int l, size_t off) { return (bf16_t*)(F.ws + WS_WMIX + (size_t)l * WL_STRIDE + off); }

__device__ __forceinline__ void prep_mixer_weights(Frame& F, int l_lo, int l_hi, bool memkv) {
    for (int l = l_lo; l < l_hi; ++l) {
        { MapInproj m{F.in[I_WIN] + (size_t)l * DM * INW}; for (int s = F.vcu; s < NT_IN * 8; s += F.G) prep_strip_i8(F, m, (signed char*)wmix(F, l, WL_IN), (float*)(F.ws + WS_MISC + MS_WSIN) + l * NT_IN * 256, s); }
        { MapUp m{F.in[I_WUQ] + (size_t)l * 256 * 768, F.in[I_WUKV] + (size_t)l * 128 * 1024, F.in[I_GQ] + l * 256, F.in[I_GKV] + l * 128}; prep_matrix(F, m, wmix(F, l, WL_UP), UPN, UPK); }
        { MapBr m{F.in[I_WBR] + (size_t)l * 3 * 512 * DM}; prep_matrix(F, m, wmix(F, l, WL_BR), DM, 1536); }
        { MapPlain m{F.in[I_WOUT] + (size_t)l * DM * DM, DM}; prep_matrix(F, m, wmix(F, l, WL_OUT), DM, DM); }
    }
    if (memkv) { MapMemkv m{F.in[I_WMKV]}; prep_matrix(F, m, (bf16_t*)(F.ws + WS_WMKV), 4096, DM); }
}
__device__ __forceinline__ void prep_ffn_weights(Frame& F, int l) {
    const int i = l >> 1; const bool moe = (l & 1) != 0;
    LAS float* scr = (LAS float*)(F.lds + F.wave * 16384);
    const int gw = F.vcu * NWAVES + F.wave, NGW = F.G * NWAVES;
    constexpr int IGU = (DM / 64) * (2 * DFF / 32), ID = (DFF / 64) * (DM / 32), NSTRIP = 2 * DFF / 32;
    const int ne = moe ? NE : 1;
    const float* Wg = moe ? F.in[I_WGE] : F.in[I_WGD]; const float* Wu = moe ? F.in[I_WUE] : F.in[I_WUD]; const float* Wd = moe ? F.in[I_WDE] : F.in[I_WDD];
    if (GU_I8(l)) {
        for (int s = F.vcu; s < ne * NSTRIP; s += F.G) { const int e = s / NSTRIP, ss = s % NSTRIP; const size_t eo = ((size_t)i * ne + e) * DM * DFF;
            MapGU m{Wg + eo, Wu + eo}; prep_strip_i8(F, m, (signed char*)(F.ws + WS_WFFN + (size_t)e * WF_STRIDE), (float*)(F.ws + WS_MISC + MS_WSGU) + e * 2 * DFF, ss); }
    } else {
        for (int it = gw; it < ne * IGU; it += NGW) { const int e = it / IGU, r = it % IGU; const size_t eo = ((size_t)i * ne + e) * DM * DFF;
            MapGU m{Wg + eo, Wu + eo}; prep_item(m, (bf16_t*)(F.ws + WS_WFFN + (size_t)e * WF_STRIDE), DM, 2 * DFF / 32, scr, r, F.lane); }
    }
    constexpr int IDT = (DFF / 128) * (DM / 32);
    for (int it = gw; it < ne * IDT; it += NGW) { const int e = it / IDT, r = it % IDT; const size_t eo = ((size_t)i * ne + e) * DM * DFF;
        MapPlain m{Wd + eo, DM}; prep_tile(m, (bf16_t*)(F.ws + WS_WFFN + (size_t)e * WF_STRIDE + WF_D), DFF, DM / 32, F.lds + F.wave * 16384, r, F.lane); }
}

struct RowV { f32x4 v[4]; };
__device__ __forceinline__ void row_load(RowV& r, const float* p, int lane) { const f32x4* x = (const f32x4*)p + lane;
#pragma unroll
    for (int j = 0; j < 4; ++j) r.v[j] = x[64 * j]; }
__device__ __forceinline__ void row_store(const RowV& r, float* p, int lane) { f32x4* x = (f32x4*)p + lane;
#pragma unroll
    for (int j = 0; j < 4; ++j) __builtin_nontemporal_store(r.v[j], &x[64 * j]); }
__device__ __forceinline__ void row_add_bf16(RowV& r, const bf16_t* p, float w, int lane) { const u32x2* x = (const u32x2*)p + lane;
#pragma unroll
    for (int j = 0; j < 4; ++j) { const u32x2 q = x[64 * j]; r.v[j].x += w * bflo(q.x); r.v[j].y += w * bfhi(q.x); r.v[j].z += w * bflo(q.y); r.v[j].w += w * bfhi(q.y); } }
__device__ __forceinline__ void row_load_bf16(RowV& r, const bf16_t* p, int lane) { const u32x2* x = (const u32x2*)p + lane;
#pragma unroll
    for (int j = 0; j < 4; ++j) { const u32x2 q = x[64 * j]; r.v[j].x = bflo(q.x); r.v[j].y = bfhi(q.x); r.v[j].z = bflo(q.y); r.v[j].w = bfhi(q.y); } }
__device__ __forceinline__ void row_round_bf16(RowV& r) {
#pragma unroll
    for (int j = 0; j < 4; ++j) { r.v[j].x = bf2f((unsigned short)f2bf(r.v[j].x)); r.v[j].y = bf2f((unsigned short)f2bf(r.v[j].y)); r.v[j].z = bf2f((unsigned short)f2bf(r.v[j].z)); r.v[j].w = bf2f((unsigned short)f2bf(r.v[j].w)); } }
__device__ __forceinline__ float row_rstd(const RowV& r) { float s = 0.f;
#pragma unroll
    for (int j = 0; j < 4; ++j) s += (r.v[j].x * r.v[j].x + r.v[j].y * r.v[j].y) + (r.v[j].z * r.v[j].z + r.v[j].w * r.v[j].w);
    return 1.0f / sqrtf(wave_sum(s) * (1.0f / DM) + EPS); }
__device__ __forceinline__ void row_scale(RowV& r, float rstd, const float* g, int lane) { const f32x4* gg = (const f32x4*)g + lane;
#pragma unroll
    for (int j = 0; j < 4; ++j) r.v[j] = r.v[j] * rstd * gg[64 * j]; }
__device__ __forceinline__ void row_store_bf16(const RowV& r, bf16_t* p, int lane) { u32x2* o = (u32x2*)p + lane;
#pragma unroll
    for (int j = 0; j < 4; ++j) { u32x2 w; w.x = pk2(r.v[j].x, r.v[j].y); w.y = pk2(r.v[j].z, r.v[j].w); o[64 * j] = w; } }

__device__ __forceinline__ float row_store_i8(const RowV& r, signed char* p, int lane) {
    float am = 0.f;
#pragma unroll
    for (int j = 0; j < 4; ++j) am = fmaxf(am, fmaxf(fmaxf(fabsf(r.v[j].x), fabsf(r.v[j].y)), fmaxf(fabsf(r.v[j].z), fabsf(r.v[j].w))));
#pragma unroll
    for (int o = 1; o < 64; o <<= 1) am = fmaxf(am, __shfl_xor(am, o));
    const float inv = am > 0.f ? 127.0f / am : 0.f; unsigned* o4 = (unsigned*)p + lane;
#pragma unroll
    for (int j = 0; j < 4; ++j) { const unsigned a = (unsigned)__float2int_rn(r.v[j].x * inv) & 255u, b = (unsigned)__float2int_rn(r.v[j].y * inv) & 255u, c = (unsigned)__float2int_rn(r.v[j].z * inv) & 255u, d = (unsigned)__float2int_rn(r.v[j].w * inv) & 255u;
        o4[64 * j] = a | (b << 8) | (c << 16) | (d << 24); }
    return am * (1.0f / 127.0f);
}
__device__ __forceinline__ void row_add_slot(Frame& F, RowV& r, int s, float w, int lane) {
    if ((s >> 8) < 256) { row_add_bf16(r, (const bf16_t*)(F.ws + WS_R + R_YOUT) + (size_t)s * DM, w, lane); return; }
    const float* slab = (const float*)(F.ws + WS_SLAB) + (size_t)((s >> 8) - 256) * 4 * TAIL_KS * 65536 + (size_t)(s & 255) * 256 + 4 * lane;
#pragma unroll
    for (int j = 0; j < 4; ++j)
#pragma unroll
        for (int ks = 0; ks < TAIL_KS; ++ks) r.v[j] += *(const f32x4*)(slab + (size_t)(j * TAIL_KS + ks) * 65536) * w;
}
__device__ __forceinline__ void row_combine(Frame& F, RowV& r, int t) {
    const int* sl = (const int*)(F.ws + WS_MISC + MS_SLOT) + 2 * t; const float* tw = (const float*)(F.ws + WS_MISC + MS_TOKW) + 2 * t;
    const int s0 = __builtin_amdgcn_readfirstlane(sl[0]), s1 = __builtin_amdgcn_readfirstlane(sl[1]); const float w0 = tw[0], w1 = tw[1];
    row_add_slot(F, r, s0, w0, F.lane); row_add_slot(F, r, s1, w1, F.lane);
}

__device__ __forceinline__ void norm_phase(Frame& F, const float* srcf, bf16_t* X, const float* g, bool combine, bool out_i8) {
    bf16_t* H = (bf16_t*)(F.ws + WS_H); signed char* Hq = (signed char*)(F.ws + WS_H); float* hsc = (float*)(F.ws + WS_MISC + MS_HSC);
    const int gw = F.vcu * NWAVES + F.wave, NGW = F.G * NWAVES;
    for (int t = gw; t < T; t += 2 * NGW) {
        const int t2 = (t + NGW < T) ? t + NGW : t;
        RowV r, q;
        if (srcf) { row_load(r, srcf + (size_t)t * DM, F.lane); row_load(q, srcf + (size_t)t2 * DM, F.lane); }
        else { row_load_bf16(r, X + (size_t)t * DM, F.lane); row_load_bf16(q, X + (size_t)t2 * DM, F.lane); }
        if (combine) { row_combine(F, r, t); row_combine(F, q, t2); row_store_bf16(r, X + (size_t)t * DM, F.lane); row_store_bf16(q, X + (size_t)t2 * DM, F.lane);
            row_round_bf16(r); row_round_bf16(q); }
        const float rstd = row_rstd(r), qstd = row_rstd(q); row_scale(r, rstd, g, F.lane); row_scale(q, qstd, g, F.lane);
        if (out_i8) { const float sc = row_store_i8(r, Hq + (size_t)t * DM, F.lane), sq = row_store_i8(q, Hq + (size_t)t2 * DM, F.lane); if (F.lane == 0) { hsc[t] = sc; hsc[t2] = sq; } }
        else { row_store_bf16(r, H + (size_t)t * DM, F.lane); row_store_bf16(q, H + (size_t)t2 * DM, F.lane); }
    }
}
__device__ __forceinline__ void final_norm_phase(Frame& F, const bf16_t* X, float* out, const float* g, bool combine) {
    const int gw = F.vcu * NWAVES + F.wave, NGW = F.G * NWAVES;
    for (int t = gw; t < T; t += 2 * NGW) {
        const int t2 = (t + NGW < T) ? t + NGW : t;
        RowV r, q; row_load_bf16(r, X + (size_t)t * DM, F.lane); row_load_bf16(q, X + (size_t)t2 * DM, F.lane);
        if (combine) { row_combine(F, r, t); row_combine(F, q, t2); }
        const float rstd = row_rstd(r), qstd = row_rstd(q); row_scale(r, rstd, g, F.lane); row_scale(q, qstd, g, F.lane);
        row_store(r, out + (size_t)t * DM, F.lane); row_store(q, out + (size_t)t2 * DM, F.lane);
    }
}
__device__ __forceinline__ void memnorm_phase(Frame& F) {
    bf16_t* MN = (bf16_t*)(F.ws + WS_MEMN);
    const int gw = F.vcu * NWAVES + F.wave, NGW = F.G * NWAVES;
    for (int t = gw; t < NB * MEML; t += NGW) {
        RowV r; row_load(r, F.in[I_MEM] + (size_t)t * DM, F.lane);
        const float rstd = row_rstd(r); row_scale(r, rstd, F.in[I_GMEM], F.lane);
        row_store_bf16(r, MN + (size_t)t * DM, F.lane);
    }
}

__device__ __forceinline__ void norm_router_phase(Frame& F, const bf16_t* X, const float* g, const float* Wr  , bool out_i8) {
    bf16_t* H = (bf16_t*)(F.ws + WS_H); signed char* Hq = (signed char*)(F.ws + WS_H); float* hsc = (float*)(F.ws + WS_MISC + MS_HSC);
    int* toke = (int*)(F.ws + WS_MISC + MS_TOKE); float* tokw = (float*)(F.ws + WS_MISC + MS_TOKW); int* cntg = (int*)(F.ws + WS_MISC + MS_CNT);
    volatile LAS int* hist = (volatile LAS int*)(F.lds + LDSCTL_OFF + 1024);
    f32x4 wa[4][4], wb[4][4];
#pragma unroll
    for (int j = 0; j < 4; ++j)
#pragma unroll
        for (int k = 0; k < 4; ++k) { const int d = 256 * j + 4 * F.lane + k; wa[j][k] = *(const f32x4*)(Wr + (size_t)d * 8); wb[j][k] = *(const f32x4*)(Wr + (size_t)d * 8 + 4); }
    const bool up32 = (F.lane & 32) != 0, up16 = (F.lane & 16) != 0, up8 = (F.lane & 8) != 0;
    for (int c = F.vcu; c < T / 128; c += F.G) {
        if (F.tid < 8) hist[F.tid] = 0;
        __syncthreads();
        for (int q = 0; q < 16; ++q) {
            const int t = c * 128 + F.wave * 16 + q;
            RowV r; row_load_bf16(r, X + (size_t)t * DM, F.lane);
            const float rstd = row_rstd(r); row_scale(r, rstd, g, F.lane);
            if (out_i8) { const float sc = row_store_i8(r, Hq + (size_t)t * DM, F.lane); if (F.lane == 0) hsc[t] = sc; }
            else row_store_bf16(r, H + (size_t)t * DM, F.lane);
            f32x4 la = {0.f, 0.f, 0.f, 0.f}, lb = {0.f, 0.f, 0.f, 0.f};
#pragma unroll
            for (int j = 0; j < 4; ++j)
#pragma unroll
                for (int k = 0; k < 4; ++k) { const float x = r.v[j][k]; la += wa[j][k] * x; lb += wb[j][k] * x; }
            f32x4 h4; { const f32x4 keep = up32 ? lb : la, send = up32 ? la : lb;
#pragma unroll
                for (int i = 0; i < 4; ++i) h4[i] = keep[i] + __shfl_xor(send[i], 32); }
            f32x2 h2; { const float k0 = up16 ? h4[2] : h4[0], k1 = up16 ? h4[3] : h4[1], s0 = up16 ? h4[0] : h4[2], s1 = up16 ? h4[1] : h4[3]; h2.x = k0 + __shfl_xor(s0, 16); h2.y = k1 + __shfl_xor(s1, 16); }
            float h1 = (up8 ? h2.y : h2.x) + __shfl_xor(up8 ? h2.x : h2.y, 8);
            h1 += __shfl_xor(h1, 4); h1 += __shfl_xor(h1, 2); h1 += __shfl_xor(h1, 1);
            float lg[8];
#pragma unroll
            for (int e = 0; e < 8; ++e) lg[e] = __builtin_bit_cast(float, __builtin_amdgcn_readlane(__builtin_bit_cast(int, h1), 8 * e));
            int e0 = 0; float v0 = lg[0];
#pragma unroll
            for (int e = 1; e < 8; ++e) if (lg[e] > v0) { v0 = lg[e]; e0 = e; }
            int e1 = -1; float v1 = -INFINITY;
#pragma unroll
            for (int e = 0; e < 8; ++e) if (e != e0 && lg[e] > v1) { v1 = lg[e]; e1 = e; }
            if (F.lane == 0) {
                const float w0 = 1.0f / (1.0f + __expf(v1 - v0));
                toke[2 * t] = e0; toke[2 * t + 1] = e1; tokw[2 * t] = w0; tokw[2 * t + 1] = 1.0f - w0;
                __hip_atomic_fetch_add((LAS int*)&hist[e0], 1, __ATOMIC_RELAXED, __HIP_MEMORY_SCOPE_WORKGROUP); __hip_atomic_fetch_add((LAS int*)&hist[e1], 1, __ATOMIC_RELAXED, __HIP_MEMORY_SCOPE_WORKGROUP);
            }
        }
        __syncthreads();
        if (F.tid < 8) cntg[c * 8 + F.tid] = hist[F.tid];
        __syncthreads();
    }
}
__device__ __forceinline__ void moe_assign_phase(Frame& F, bool i8) {
    const bf16_t* H = (const bf16_t*)(F.ws + WS_H); bf16_t* AS = (bf16_t*)(F.ws + WS_R + R_ASORT);
    const float* hsc = (const float*)(F.ws + WS_MISC + MS_HSC); float* asc = (float*)(F.ws + WS_MISC + MS_ASC);
    const int* toke = (const int*)(F.ws + WS_MISC + MS_TOKE); int* slot = (int*)(F.ws + WS_MISC + MS_SLOT); const int* cntg = (const int*)(F.ws + WS_MISC + MS_CNT);
    int* texp = (int*)(F.ws + WS_MISC + MS_TEXP);
    volatile LAS int* tot = (volatile LAS int*)(F.lds + LDSCTL_OFF + 1024);
    volatile LAS int* pre = tot + 8;
    volatile LAS int* wcnt = tot + 16;
    for (int c = F.vcu; c < T / 128; c += F.G) {
        if (F.tid < 16) tot[F.tid] = 0;
        __syncthreads();
        { const int cc = F.tid >> 1, h = F.tid & 1; const i32x4 v = *(const i32x4*)(cntg + cc * 8 + 4 * h);
#pragma unroll
          for (int k = 0; k < 4; ++k) { __hip_atomic_fetch_add((LAS int*)&tot[4 * h + k], v[k], __ATOMIC_RELAXED, __HIP_MEMORY_SCOPE_WORKGROUP); if (cc < c) __hip_atomic_fetch_add((LAS int*)&pre[4 * h + k], v[k], __ATOMIC_RELAXED, __HIP_MEMORY_SCOPE_WORKGROUP); } }
        const int t = c * 128 + F.wave * 16 + ((F.lane & 31) >> 1);
        const int my_e = (F.lane < 32) ? toke[2 * t + (F.lane & 1)] : -1;
        int rank = 0;
#pragma unroll
        for (int e = 0; e < 8; ++e) { const unsigned long long m = __ballot(my_e == e); if (my_e == e) rank = __popcll(m & ((1ull << F.lane) - 1ull)); if (F.lane == 0) wcnt[F.wave * 8 + e] = __popcll(m); }
        __syncthreads();
        int myslot = 0;
        if (F.lane < 32) {
            int ts = 0;
#pragma unroll
            for (int e = 0; e < 8; ++e) ts += (e < my_e) ? ((tot[e] + 255) >> 8) : 0;
            int wp = 0; for (int w = 0; w < F.wave; ++w) wp += wcnt[w * 8 + my_e];
            myslot = ts * 256 + pre[my_e] + wp + rank;
            slot[2 * t + (F.lane & 1)] = myslot;
        }
        if (c == 0 && F.tid == 0) { int ts = 0; for (int e = 0; e < 8; ++e) { const int n = (tot[e] + 255) >> 8; for (int k = 0; k < n; ++k) texp[ts + k] = e; ts += n; } for (int k = ts; k < MAXRT; ++k) texp[k] = 0; texp[MAXRT] = ts; }
        if (i8) {
            const float myh = hsc[t];
#pragma unroll 1
            for (int a0 = 0; a0 < 32; a0 += 8) {
                u32x4 x[4];
#pragma unroll
                for (int k = 0; k < 4; ++k) x[k] = *((const u32x4*)((const signed char*)H + (size_t)(c * 128 + F.wave * 16 + ((a0 + 2 * k) >> 1)) * DM) + F.lane);
#pragma unroll
                for (int k = 0; k < 8; ++k) { const int s = __builtin_amdgcn_readlane(myslot, a0 + k); *((u32x4*)((signed char*)AS + (size_t)s * DM) + F.lane) = x[k >> 1]; }
            }
            if (F.lane < 32) asc[myslot] = myh;
        } else {
            for (int a = 0; a < 32; ++a) {
                const int s = __builtin_amdgcn_readlane(myslot, a); const int ta = c * 128 + F.wave * 16 + (a >> 1);
                const u32x4* srcp = (const u32x4*)(H + (size_t)ta * DM) + F.lane; u32x4* dstp = (u32x4*)(AS + (size_t)s * DM) + F.lane;
                const u32x4 x0 = srcp[0], x1 = srcp[64]; dstp[0] = x0; dstp[64] = x1; }
        }
        __syncthreads();
    }
}

using pg8::Unit;
typedef f32x4 AccT[2][2][4][2];

struct ProbSimple { int K; unsigned lda, ldb; const char* A; const char* B;
    __device__ __forceinline__ const char* a_ptr(const Unit& u) const { return A + (size_t)u.pm * 256 * lda; }
    __device__ __forceinline__ const char* b_ptr(const Unit& u) const { return B + (size_t)u.pn * 256 * ldb; } };
struct ProbUp { int K; unsigned lda, ldb; const char* A; const char* B;
    __device__ __forceinline__ const char* a_ptr(const Unit& u) const { return A + (size_t)u.pm * 256 * lda + (u.pn >= 3 ? 256 : 0); }
    __device__ __forceinline__ const char* b_ptr(const Unit& u) const { return B + (size_t)u.pn * 256 * ldb; } };
struct ProbMoe { int K; unsigned lda, ldb; const char* A; const char* B; int a_lo;
    __device__ __forceinline__ const char* a_ptr(const Unit& u) const { return A + (size_t)(u.pm - a_lo) * 256 * lda; }
    __device__ __forceinline__ const char* b_ptr(const Unit& u) const { return B + (size_t)u.aux * WF_STRIDE + (size_t)u.pn * 256 * ldb; } };

struct ProbTail { int K; unsigned lda, ldb; const char* A; const char* B;
    __device__ __forceinline__ const char* a_ptr(const Unit& u) const { return A + (size_t)u.pm * 256 * lda + (size_t)(u.aux >> 8) * (DFF / TAIL_KS) * 2; }
    __device__ __forceinline__ const char* b_ptr(const Unit& u) const { return B + (size_t)(u.aux & 255) * WF_STRIDE + (size_t)u.pn * 256 * ldb + (size_t)(u.aux >> 8) * (DFF / TAIL_KS) * 2; } };
struct TailOrder { int ntail, G, c; const int* texp;
    __device__ bool next(int i, Unit& u) const { const int L = i * G + c; if (L >= ntail) return false;
        u.pm = 256 + L / (4 * TAIL_KS); u.pn = (L / TAIL_KS) & 3; u.aux = __builtin_amdgcn_readfirstlane(texp[u.pm]) | ((L % TAIL_KS) << 8); return true; } };
struct ColOrder { int n, pn, G, c;
    __device__ bool next(int i, Unit& u) const { const int L = i * G + c; if (L >= n) return false; u.pm = L; u.pn = pn; u.aux = 0; return true; } };
struct MoeOrder { pg8::StaticOrder base; int lo; const int* texp;
    __device__ bool next(int i, Unit& u) const { if (!base.next(i, u)) return false; u.pm += lo; u.aux = __builtin_amdgcn_readfirstlane(texp[u.pm]); return true; } };

__device__ __forceinline__ u32x4 pack8(const f32x4 a, const f32x4 b) { u32x4 w; w.x = cvtpk(a[0], a[1]); w.y = cvtpk(a[2], a[3]); w.z = cvtpk(b[0], b[1]); w.w = cvtpk(b[2], b[3]); return w; }
__device__ __forceinline__ u32x2 pack4(const f32x4 a) { u32x2 w; w.x = cvtpk(a[0], a[1]); w.y = cvtpk(a[2], a[3]); return w; }

struct EpiNoStage { __device__ __forceinline__ void stage(LAS unsigned char*, const Unit&, int, int) const {} };
__device__ __forceinline__ void stage1k(const void* src, LAS unsigned char* dst, int lane) { __builtin_amdgcn_global_load_lds((const unsigned*)((const char*)src + lane * 16), (LAS unsigned*)dst, 16, 0, 0); }
__device__ __forceinline__ f32x4 deq(const f32x4& a, float, const f32x4&) { return a; }
__device__ __forceinline__ f32x4 deq(const i32x4& a, float rs, const f32x4& cs) { return __builtin_convertvector(a, f32x4) * rs * cs; }
struct EpiInproj {
    static constexpr bool MID = false;
    bf16_t* P; bf16_t* G; float* ssq; const int* pos; const float* rsc; const float* csc;
    __device__ __forceinline__ void stage(LAS unsigned char* d, const Unit& u, int wid, int lane) const {
        if (wid == 0) { stage1k(rsc + u.pm * 256, d, lane); stage1k(csc + u.pn * 256, d + 1024, lane); stage1k(pos + u.pm * 256, d + 2048, lane); } }
    template <class AV> __device__ __forceinline__ void operator()(const AV (&acc)[2][2][4][2], const Unit& u, int wr, int wc, int fr, int fq, const LAS unsigned char* esc) const {
        const int pn = u.pn, row0 = u.pm * 256 + wr * 64 + fr;
        f32x4 cs[2][2];
#pragma unroll
        for (int bj = 0; bj < 2; ++bj)
#pragma unroll
            for (int n = 0; n < 2; ++n) cs[bj][n] = *(const LAS f32x4*)(esc + 1024 + (bj * 128 + wc * 32 + n * 16 + fq * 4) * 4);
        float rs8[2][4], pf8[2][4];
#pragma unroll
        for (int ai = 0; ai < 2; ++ai)
#pragma unroll
            for (int m = 0; m < 4; ++m) { const int rl = ai * 128 + wr * 64 + m * 16 + fr; rs8[ai][m] = *(const LAS float*)(esc + rl * 4); pf8[ai][m] = (float)*(const LAS int*)(esc + 2048 + rl * 4); }
#define DQ(ai, bj, m, n) deq(acc[ai][bj][m][n], rs, cs[bj][n])
        if (pn >= 7) {
#pragma unroll
            for (int ai = 0; ai < 2; ++ai)
#pragma unroll
                for (int m = 0; m < 4; ++m) { const int row = row0 + ai * 128 + m * 16; const float rs = rs8[ai][m]; u32x4 w;
#pragma unroll
                    for (int bj = 0; bj < 2; ++bj) { f32x4 a = DQ(ai, bj, m, 0), b = DQ(ai, bj, m, 1);
#pragma unroll
                        for (int j = 0; j < 4; ++j) { a[j] = fast_sigmoid(a[j]) * 255.0f; b[j] = fast_sigmoid(b[j]) * 255.0f; }
                        const unsigned wa_ = (unsigned)__float2int_rn(a[0]) | ((unsigned)__float2int_rn(a[1]) << 8) | ((unsigned)__float2int_rn(a[2]) << 16) | ((unsigned)__float2int_rn(a[3]) << 24);
                        const unsigned wb_ = (unsigned)__float2int_rn(b[0]) | ((unsigned)__float2int_rn(b[1]) << 8) | ((unsigned)__float2int_rn(b[2]) << 16) | ((unsigned)__float2int_rn(b[3]) << 24);
                        if (bj == 0) { w.x = wa_; w.y = wb_; } else { w.z = wa_; w.w = wb_; } }
                    *(u32x4*)((unsigned char*)G + (size_t)row * GW + (pn - 7) * 256 + wc * 64 + fq * 16) = w; }
        } else if (pn >= 5 || pn == 3) {
            const float sc = (pn == 3) ? 1.0f : C_M;
#pragma unroll
            for (int ai = 0; ai < 2; ++ai)
#pragma unroll
                for (int m = 0; m < 4; ++m) { const int row = row0 + ai * 128 + m * 16; const float rs = rs8[ai][m]; float s = 0.f;
#pragma unroll
                    for (int bj = 0; bj < 2; ++bj) { const f32x4 a = DQ(ai, bj, m, 0) * sc, b = DQ(ai, bj, m, 1) * sc;
                        s += (a[0] * a[0] + a[1] * a[1]) + (a[2] * a[2] + a[3] * a[3]) + (b[0] * b[0] + b[1] * b[1]) + (b[2] * b[2] + b[3] * b[3]);
                        *(u32x4*)(P + (size_t)row * PW + pn * 256 + bj * 128 + wc * 32 + fq * 8) = pack8(a, b); }
                    if (pn == 3) { s += __shfl_xor(s, 16); s += __shfl_xor(s, 32); if (fq == 0) ssq[(size_t)row * 8 + wc] = s; } }
        } else if (pn == 4) {
#pragma unroll
            for (int ai = 0; ai < 2; ++ai)
#pragma unroll
                for (int m = 0; m < 4; ++m) { const int row = row0 + ai * 128 + m * 16; const float rs = rs8[ai][m];
                    { const f32x4 a = DQ(ai, 0, m, 0), b = DQ(ai, 0, m, 1);
                      float s = (a[0] * a[0] + a[1] * a[1]) + (a[2] * a[2] + a[3] * a[3]) + (b[0] * b[0] + b[1] * b[1]) + (b[2] * b[2] + b[3] * b[3]);
                      *(u32x4*)(P + (size_t)row * PW + P_CKV + wc * 32 + fq * 8) = pack8(a, b);
                      s += __shfl_xor(s, 16); s += __shfl_xor(s, 32); if (fq == 0) ssq[(size_t)row * 8 + 4 + wc] = s; }
                    if (wc == 0) { const f32x4 x1 = DQ(ai, 1, m, 0), x2 = DQ(ai, 1, m, 1); const float pf = pf8[ai][m]; f32x4 o1, o2;
#pragma unroll
                        for (int j = 0; j < 4; ++j) { float c, s; rot_cs(pf, 2 * (4 * fq + j), c, s); o1[j] = x1[j] * c - x2[j] * s; o2[j] = x2[j] * c + x1[j] * s; }
                        *(u32x2*)(P + (size_t)row * PW + P_KR + 4 * fq) = pack4(o1); *(u32x2*)(P + (size_t)row * PW + P_KR + 16 + 4 * fq) = pack4(o2); } }
        } else {
            const float sc = (pn < 2) ? C_A : 1.0f; const int i0 = 16 * (wc & 1) + 4 * fq;
#pragma unroll
            for (int ai = 0; ai < 2; ++ai)
#pragma unroll
                for (int m = 0; m < 4; ++m) { const int row = row0 + ai * 128 + m * 16; const float rs = rs8[ai][m]; const float pf = pf8[ai][m]; f32x4 c, s;
#pragma unroll
                    for (int j = 0; j < 4; ++j) { float cc, ss; rot_cs(pf, i0 + j, cc, ss); c[j] = cc * sc; s[j] = ss * sc; }
#pragma unroll
                    for (int bj = 0; bj < 2; ++bj) { const f32x4 x1 = DQ(ai, bj, m, 0), x2 = DQ(ai, bj, m, 1);
                        if (pn == 2 && bj == 1) { *(u32x4*)(P + (size_t)row * PW + P_VA + wc * 32 + fq * 8) = pack8(x1, x2); }
                        else { const f32x4 o1 = x1 * c - x2 * s, o2 = x2 * c + x1 * s; bf16_t* d = P + (size_t)row * PW + pn * 256 + 64 * (2 * bj + (wc >> 1)) + i0;
                            *(u32x2*)d = pack4(o1); *(u32x2*)(d + 32) = pack4(o2); } } }
        }
#undef DQ
    }
};
struct EpiUp {
    static constexpr bool MID = false;
    __device__ __forceinline__ void stage(LAS unsigned char*, const Unit&, int, int) const {}
    bf16_t* QB; bf16_t* KVB; const float* ssq; const int* pos;
    __device__ __forceinline__ void operator()(const AccT& acc, const Unit& u, int wr, int wc, int fr, int fq, const LAS unsigned char*) const {
        const int pn = u.pn, row0 = u.pm * 256 + wr * 64 + fr;
        float rs8[2][4], pf8[2][4];
#pragma unroll
        for (int ai = 0; ai < 2; ++ai)
#pragma unroll
            for (int m = 0; m < 4; ++m) { const int row = row0 + ai * 128 + m * 16; const f32x4 sv = *(const f32x4*)(ssq + (size_t)row * 8 + (pn < 3 ? 0 : 4));
                rs8[ai][m] = (pn < 3 ? C_B : 1.0f) / sqrtf(((sv[0] + sv[1]) + (sv[2] + sv[3])) * (pn < 3 ? 1.0f / 256.0f : 1.0f / 128.0f) + EPS); pf8[ai][m] = (pn < 3) ? (float)pos[row] : 0.f; }
#pragma unroll
        for (int ai = 0; ai < 2; ++ai)
#pragma unroll
            for (int m = 0; m < 4; ++m) { const int row = row0 + ai * 128 + m * 16; const float rs = rs8[ai][m];
                if (pn < 3) {
#pragma unroll
                    for (int bj = 0; bj < 2; ++bj) { const int gg = 8 * pn + 4 * bj + wc; const f32x4 x1 = acc[ai][bj][m][0] * rs, x2 = acc[ai][bj][m][1] * rs;
                        if (gg % 3 == 2) { const float pf = pf8[ai][m]; f32x4 o1, o2;
#pragma unroll
                            for (int j = 0; j < 4; ++j) { float c, s; rot_cs(pf, 2 * (4 * fq + j), c, s); o1[j] = x1[j] * c - x2[j] * s; o2[j] = x2[j] * c + x1[j] * s; }
                            bf16_t* d = QB + (size_t)row * QBW + 32 * gg + 4 * fq; *(u32x2*)d = pack4(o1); *(u32x2*)(d + 16) = pack4(o2); }
                        else *(u32x4*)(QB + (size_t)row * QBW + 32 * gg + 8 * fq) = pack8(x1, x2); }
                } else {
#pragma unroll
                    for (int bj = 0; bj < 2; ++bj) *(u32x4*)(KVB + (size_t)row * KVW + (pn - 3) * 256 + bj * 128 + wc * 32 + fq * 8) = pack8(acc[ai][bj][m][0] * rs, acc[ai][bj][m][1] * rs);
                } }
    }
};
struct EpiPlain {
    static constexpr bool MID = false;
    __device__ __forceinline__ void stage(LAS unsigned char*, const Unit&, int, int) const {}
    bf16_t* O; int ldo;
    __device__ __forceinline__ void operator()(const AccT& acc, const Unit& u, int wr, int wc, int fr, int fq, const LAS unsigned char*) const {
        const int row0 = u.pm * 256 + wr * 64 + fr;
#pragma unroll
        for (int ai = 0; ai < 2; ++ai)
#pragma unroll
            for (int m = 0; m < 4; ++m)
#pragma unroll
                for (int bj = 0; bj < 2; ++bj) *(u32x4*)(O + (size_t)(row0 + ai * 128 + m * 16) * ldo + u.pn * 256 + bj * 128 + wc * 32 + fq * 8) = pack8(acc[ai][bj][m][0], acc[ai][bj][m][1]);
    }
};
struct EpiBranch {
    static constexpr bool MID = true;
    const unsigned char* G; bf16_t* MIXED;
    __device__ __forceinline__ void stage(LAS unsigned char*, const Unit&, int, int) const {}
    static __device__ __forceinline__ float gq(unsigned w, int b) { const float f = (float)((w >> (8 * b)) & 255u); return fmaxf(f, 2.55e-4f); }
    __device__ __forceinline__ void mid(AccT& acc, const Unit& u, int seg  , int wr, int wc, int fr, int fq) const {
        const int row0 = opq_v(u.pm * 256 + wr * 64 + fr);
#pragma unroll
        for (int ai = 0; ai < 2; ++ai) {
            u32x4 ga[4], gb[4];
#pragma unroll
            for (int m = 0; m < 4; ++m) { const unsigned char* gp = G + (size_t)(row0 + ai * 128 + m * 16) * GW + u.pn * 256 + wc * 64 + fq * 16;
                ga[m] = *(const u32x4*)(gp + (seg - 1) * 1024); gb[m] = *(const u32x4*)(gp + seg * 1024); }
#pragma unroll
            for (int m = 0; m < 4; ++m) {
#pragma unroll
                for (int j = 0; j < 4; ++j) {
                    acc[ai][0][m][0][j] *= gq(ga[m].x, j) * __builtin_amdgcn_rcpf(gq(gb[m].x, j)); acc[ai][0][m][1][j] *= gq(ga[m].y, j) * __builtin_amdgcn_rcpf(gq(gb[m].y, j));
                    acc[ai][1][m][0][j] *= gq(ga[m].z, j) * __builtin_amdgcn_rcpf(gq(gb[m].z, j)); acc[ai][1][m][1][j] *= gq(ga[m].w, j) * __builtin_amdgcn_rcpf(gq(gb[m].w, j)); } }
            asm volatile("" ::: "memory"); }
    }
    __device__ __forceinline__ void operator()(const AccT& acc, const Unit& u, int wr, int wc, int fr, int fq, const LAS unsigned char*) const {
        const int row0 = u.pm * 256 + wr * 64 + fr;
#pragma unroll
        for (int ai = 0; ai < 2; ++ai) {
            u32x4 gw[4];
#pragma unroll
            for (int m = 0; m < 4; ++m) gw[m] = *(const u32x4*)(G + (size_t)(row0 + ai * 128 + m * 16) * GW + 2048 + u.pn * 256 + wc * 64 + fq * 16);
#pragma unroll
            for (int m = 0; m < 4; ++m) { f32x4 a0 = acc[ai][0][m][0], b0 = acc[ai][0][m][1], a1 = acc[ai][1][m][0], b1 = acc[ai][1][m][1];
#pragma unroll
                for (int j = 0; j < 4; ++j) { a0[j] *= gq(gw[m].x, j) * (1.0f / 255.0f); b0[j] *= gq(gw[m].y, j) * (1.0f / 255.0f); a1[j] *= gq(gw[m].z, j) * (1.0f / 255.0f); b1[j] *= gq(gw[m].w, j) * (1.0f / 255.0f); }
                bf16_t* d = MIXED + (size_t)(row0 + ai * 128 + m * 16) * DM + u.pn * 256 + wc * 64 + fq * 16;
                *(u32x4*)d = pack8(a0, b0); *(u32x4*)(d + 8) = pack8(a1, b1); }
            asm volatile("" ::: "memory"); }
    }
};
struct EpiResid {
    static constexpr bool MID = false;
    __device__ __forceinline__ void stage(LAS unsigned char*, const Unit&, int, int) const {}
    const float* Xf; bf16_t* X;
    __device__ __forceinline__ void operator()(const AccT& acc, const Unit& u, int wr, int wc, int fr, int fq, const LAS unsigned char*) const {
        const int row0 = u.pm * 256 + wr * 64 + fr;
#pragma unroll
        for (int ai = 0; ai < 2; ++ai) {
            f32x4 xa[4][2], xb[4][2];
#pragma unroll
            for (int m = 0; m < 4; ++m)
#pragma unroll
                for (int bj = 0; bj < 2; ++bj) { const size_t o = (size_t)(row0 + ai * 128 + m * 16) * DM + u.pn * 256 + bj * 128 + wc * 32 + fq * 8;
                    if (Xf) { xa[m][bj] = *(const f32x4*)(Xf + o); xb[m][bj] = *(const f32x4*)(Xf + o + 4); }
                    else { const u32x4 q = *(const u32x4*)(X + o); xa[m][bj] = (f32x4){bflo(q.x), bfhi(q.x), bflo(q.y), bfhi(q.y)}; xb[m][bj] = (f32x4){bflo(q.z), bfhi(q.z), bflo(q.w), bfhi(q.w)}; } }
#pragma unroll
            for (int m = 0; m < 4; ++m)
#pragma unroll
                for (int bj = 0; bj < 2; ++bj) *(u32x4*)(X + (size_t)(row0 + ai * 128 + m * 16) * DM + u.pn * 256 + bj * 128 + wc * 32 + fq * 8) = pack8(xa[m][bj] + acc[ai][bj][m][0], xb[m][bj] + acc[ai][bj][m][1]);
            asm volatile("" ::: "memory"); }
    }
};
struct EpiSwiglu {
    static constexpr bool MID = false;
    bf16_t* ACT; int lo; const float* rsc; const float* csc;
    __device__ __forceinline__ void stage(LAS unsigned char* d, const Unit& u, int wid, int lane) const {
        if (wid == 0) { stage1k(rsc + u.pm * 256, d, lane); stage1k(csc + (size_t)u.aux * 2 * DFF + u.pn * 256, d + 1024, lane); } }
    template <class AV> __device__ __forceinline__ void operator()(const AV (&acc)[2][2][4][2], const Unit& u, int wr, int wc, int fr, int fq, const LAS unsigned char* esc) const {
        const int row0 = (u.pm - lo) * 256 + wr * 64 + fr;
        f32x4 cs[2][2];
#pragma unroll
        for (int bj = 0; bj < 2; ++bj)
#pragma unroll
            for (int n = 0; n < 2; ++n) cs[bj][n] = *(const LAS f32x4*)(esc + 1024 + (bj * 128 + wc * 32 + n * 16 + fq * 4) * 4);
        float rs8[2][4];
#pragma unroll
        for (int ai = 0; ai < 2; ++ai)
#pragma unroll
            for (int m = 0; m < 4; ++m) rs8[ai][m] = *(const LAS float*)(esc + (ai * 128 + wr * 64 + m * 16 + fr) * 4);
#pragma unroll
        for (int ai = 0; ai < 2; ++ai)
#pragma unroll
            for (int m = 0; m < 4; ++m) { const float rs = rs8[ai][m]; f32x4 a, b;
                const f32x4 g0 = deq(acc[ai][0][m][0], rs, cs[0][0]), g1 = deq(acc[ai][0][m][1], rs, cs[0][1]), u0 = deq(acc[ai][1][m][0], rs, cs[1][0]), u1 = deq(acc[ai][1][m][1], rs, cs[1][1]);
#pragma unroll
                for (int j = 0; j < 4; ++j) { a[j] = g0[j] * fast_sigmoid(g0[j]) * u0[j]; b[j] = g1[j] * fast_sigmoid(g1[j]) * u1[j]; }
                *(u32x4*)(ACT + (size_t)(row0 + ai * 128 + m * 16) * DFF + u.pn * 128 + wc * 32 + fq * 8) = pack8(a, b); }
    }
};
struct EpiYout {
    static constexpr bool MID = false;
    __device__ __forceinline__ void stage(LAS unsigned char*, const Unit&, int, int) const {}
    bf16_t* Y;
    __device__ __forceinline__ void operator()(const AccT& acc, const Unit& u, int wr, int wc, int fr, int fq, const LAS unsigned char*) const {
        const int row0 = u.pm * 256 + wr * 64 + fr;
#pragma unroll
        for (int ai = 0; ai < 2; ++ai)
#pragma unroll
            for (int m = 0; m < 4; ++m)
#pragma unroll
                for (int bj = 0; bj < 2; ++bj) *(u32x4*)(Y + (size_t)(row0 + ai * 128 + m * 16) * DM + u.pn * 256 + bj * 128 + wc * 32 + fq * 8) = pack8(acc[ai][bj][m][0], acc[ai][bj][m][1]);
    }
};
struct EpiSlab {
    static constexpr bool MID = false;
    __device__ __forceinline__ void stage(LAS unsigned char*, const Unit&, int, int) const {}
    float* slab;
    __device__ __forceinline__ void operator()(const AccT& acc, const Unit& u, int wr, int wc, int fr, int fq, const LAS unsigned char*) const {
        float* base = slab + (size_t)(((u.pm - 256) * 4 + u.pn) * TAIL_KS + (u.aux >> 8)) * 65536;
#pragma unroll
        for (int ai = 0; ai < 2; ++ai)
#pragma unroll
            for (int m = 0; m < 4; ++m)
#pragma unroll
                for (int bj = 0; bj < 2; ++bj) { float* d = base + (size_t)(ai * 128 + wr * 64 + m * 16 + fr) * 256 + bj * 128 + wc * 32 + fq * 8; *(f32x4*)d = acc[ai][bj][m][0]; *(f32x4*)(d + 4) = acc[ai][bj][m][1]; }
    }
};

namespace att {
__device__ __forceinline__ int crow(int r, int hi) { return (r & 3) + 8 * (r >> 2) + 4 * hi; }
__device__ __forceinline__ void glds16(const void* gsrc, unsigned lds_dst) { unsigned keep;
    asm volatile("s_mov_b32 %0, m0\n\ts_mov_b32 m0, %2\n\ts_nop 0\n\tglobal_load_lds_dwordx4 %1, off\n\ts_mov_b32 m0, %0" : "=&s"(keep) : "v"(gsrc), "s"(lds_dst) : "memory"); }
__device__ __forceinline__ float swapmax(float m) { auto rr = __builtin_amdgcn_permlane32_swap(__float_as_uint(m), __float_as_uint(m), false, false); return fmaxf(__uint_as_float(rr[0]), __uint_as_float(rr[1])); }
__device__ __forceinline__ float swapsum(float m) { auto rr = __builtin_amdgcn_permlane32_swap(__float_as_uint(m), __float_as_uint(m), false, false); return __uint_as_float(rr[0]) + __uint_as_float(rr[1]); }
__device__ __forceinline__ void store_o_block(const f32x16& o, float linv, bf16_t* rowp  , int hi) {
#pragma unroll
    for (int rp = 0; rp < 2; ++rp) {
        const u32x2 X = pack4((f32x4){o[8 * rp] * linv, o[8 * rp + 1] * linv, o[8 * rp + 2] * linv, o[8 * rp + 3] * linv});
        const u32x2 Y = pack4((f32x4){o[8 * rp + 4] * linv, o[8 * rp + 5] * linv, o[8 * rp + 6] * linv, o[8 * rp + 7] * linv});
        const auto s0 = __builtin_amdgcn_permlane32_swap(X.x, Y.x, false, false), s1 = __builtin_amdgcn_permlane32_swap(X.y, Y.y, false, false);
        const u32x4 w = {s0[0], s1[0], s0[1], s1[1]};
        *(u32x4*)(rowp + 8 * (2 * rp + hi)) = w; }
}
__device__ __forceinline__ s16x4 vtr(unsigned addr) { s16x4 r; asm volatile("ds_read_b64_tr_b16 %0, %1" : "=&v"(r) : "v"(addr) : "memory"); return r; }
#define VTRO(dst, base, off) asm volatile("ds_read_b64_tr_b16 %0, %1 offset:%c2" : "=&v"(dst) : "v"(base), "i"(off) : "memory")

struct Src {
    const bf16_t* q; int qpitch;
    const bf16_t* k0; int k0pitch;
    const bf16_t* k1; int k1pitch;
    const bf16_t* v; int vpitch;
    bf16_t* o; int opitch;
};
template <int NKC, int NVB, int RD = 4>
__device__ __forceinline__ void dma_tile(const Src& S, int t, int slot, unsigned lds0, int wid, int lane) {
    constexpr int KS = NKC * 1024, VS = NVB * 4096, LDS_K = 0, LDS_V = RD * KS;
#pragma unroll
    for (int c = 0; c < (NKC + 7) / 8; ++c) { const int ch = wid + 8 * c; if (ch < NKC) {
        const bf16_t* src = (ch < 8) ? S.k0 + (size_t)(t * 64 + lane) * S.k0pitch + ch * 8 : S.k1 + (size_t)(t * 64 + lane) * S.k1pitch + (ch - 8) * 8;
        glds16(src, (unsigned)__builtin_amdgcn_readfirstlane(lds0 + LDS_K + slot * KS + ch * 1024)); } }
#pragma unroll
    for (int c = 0; c < (NVB * 4 + 7) / 8; ++c) { const int p = wid + 8 * c; if (p < NVB * 4) {
        const bf16_t* src = S.v + (size_t)(t * 64 + 16 * (p & 3) + (lane >> 2)) * S.vpitch + (p >> 2) * 32 + (lane & 3) * 8;
        glds16(src, (unsigned)__builtin_amdgcn_readfirstlane(lds0 + LDS_V + slot * VS + p * 1024)); } }
}
__device__ __forceinline__ void wait_vm_bar(int n) {
    if (n >= 4) asm volatile("s_waitcnt vmcnt(4) lgkmcnt(0)\n\ts_barrier" ::: "memory");
    else if (n == 3) asm volatile("s_waitcnt vmcnt(3) lgkmcnt(0)\n\ts_barrier" ::: "memory");
    else if (n == 2) asm volatile("s_waitcnt vmcnt(2) lgkmcnt(0)\n\ts_barrier" ::: "memory");
    else if (n == 1) asm volatile("s_waitcnt vmcnt(1) lgkmcnt(0)\n\ts_barrier" ::: "memory");
    else asm volatile("s_waitcnt vmcnt(0) lgkmcnt(0)\n\ts_barrier" ::: "memory");
}
template <int NKC, int NVB, int MODE>
__device__ __forceinline__ void unit(LAS unsigned char* lds, const Src& S, int t_lo, int t_hi, int qpos0  , float sink_l2) {
    constexpr int KS = NKC * 1024, VS = NVB * 4096, RD = 4, LDS_K = 0, LDS_V = RD * KS;
    const int tid = opq_v((int)threadIdx.x), lane = tid & 63, r32 = lane & 31, hi = lane >> 5; const int wid = __builtin_amdgcn_readfirstlane(tid >> 6), grp = wid >> 2;
    const unsigned lds0 = (unsigned)(uintptr_t)lds;
    const int ops = (NKC + 7 - wid) / 8 + (NVB * 4) / 8;
    bf16x8 qr[NKC / 2];
#pragma unroll
    for (int d0 = 0; d0 < NKC / 2; ++d0) qr[d0] = *(const bf16x8*)(S.q + (size_t)r32 * S.qpitch + d0 * 16 + hi * 8);
    float m_run = (MODE == 0) ? sink_l2 : 0.0f, l_run = (MODE == 0 && hi == 0) ? 1.0f : 0.0f; bool first = (MODE != 0);
    f32x16 o[NVB];
#pragma unroll
    for (int d = 0; d < NVB; ++d) o[d] = f32x16{};
    const int qi = qpos0 + wid * 32 + r32, qw0 = qpos0 + wid * 32;
    f32x16 p0 = f32x16{}, p1 = f32x16{};
#define AT_ACTIVE(t) ((MODE != 0) || ((64 * (t) + 63 >= qw0 - 128) && (64 * (t) <= qw0 + 31 + 128)))
#define AT_QK(t) do { const LAS unsigned char* kb_ = lds + LDS_K + (((t) - t_lo) % RD) * KS + hi * 1024 + r32 * 16; p0 = f32x16{}; p1 = f32x16{}; \
        _Pragma("unroll") for (int d0 = 0; d0 < NKC / 2; ++d0) { const bf16x8 b0_ = *(const LAS bf16x8*)(kb_ + d0 * 2048), b1_ = *(const LAS bf16x8*)(kb_ + d0 * 2048 + 512); \
            p0 = __builtin_amdgcn_mfma_f32_32x32x16_bf16(b0_, qr[d0], p0, 0, 0, 0); p1 = __builtin_amdgcn_mfma_f32_32x32x16_bf16(b1_, qr[d0], p1, 0, 0, 0); } } while (0)
#define AT_SMPV(t) do { \
        if (MODE == 0 && !((64 * (t) >= qw0 + 31 - 128) && (64 * (t) + 63 <= qw0 + 128))) {   \
            _Pragma("unroll") for (int r = 0; r < 16; ++r) { const int kv_ = 64 * (t) + crow(r, hi); int e0_ = kv_ - qi; e0_ = e0_ < 0 ? -e0_ : e0_; int e1_ = kv_ + 32 - qi; e1_ = e1_ < 0 ? -e1_ : e1_; \
            if (e0_ > 128) p0[r] = -INFINITY; if (e1_ > 128) p1[r] = -INFINITY; } } \
        if (first) {   \
            float mx_[8]; _Pragma("unroll") for (int r = 0; r < 8; ++r) mx_[r] = fmaxf(fmaxf(p0[r], p0[r + 8]), fmaxf(p1[r], p1[r + 8])); \
            float rm_ = fmaxf(fmaxf(fmaxf(mx_[0], mx_[1]), fmaxf(mx_[2], mx_[3])), fmaxf(fmaxf(mx_[4], mx_[5]), fmaxf(mx_[6], mx_[7]))); m_run = swapmax(rm_); first = false; } \
        else { const float tot_ = swapsum(l_run);   \
          if (__any(tot_ > 1.0e12f)) { const float dl_ = tot_ > 1.0e12f ? ceilf(__builtin_amdgcn_logf(tot_)) : 0.f, sc_ = __builtin_amdgcn_exp2f(-dl_); m_run += dl_; l_run *= sc_; \
              _Pragma("unroll") for (int d = 0; d < NVB; ++d) _Pragma("unroll") for (int r = 0; r < 16; ++r) o[d][r] *= sc_; } } \
        float sm_[4] = {0.f, 0.f, 0.f, 0.f}; \
        _Pragma("unroll") for (int r = 0; r < 16; ++r) { p0[r] = __builtin_amdgcn_exp2f(p0[r] - m_run); p1[r] = __builtin_amdgcn_exp2f(p1[r] - m_run); sm_[r & 3] += p0[r] + p1[r]; } \
        l_run += (sm_[0] + sm_[1]) + (sm_[2] + sm_[3]); \
        u32x4 pw_[4]; \
        pw_[0] = (u32x4){cvtpk(p0[0], p0[1]), cvtpk(p0[2], p0[3]), cvtpk(p0[4], p0[5]), cvtpk(p0[6], p0[7])}; pw_[1] = (u32x4){cvtpk(p0[8], p0[9]), cvtpk(p0[10], p0[11]), cvtpk(p0[12], p0[13]), cvtpk(p0[14], p0[15])}; \
        pw_[2] = (u32x4){cvtpk(p1[0], p1[1]), cvtpk(p1[2], p1[3]), cvtpk(p1[4], p1[5]), cvtpk(p1[6], p1[7])}; pw_[3] = (u32x4){cvtpk(p1[8], p1[9]), cvtpk(p1[10], p1[11]), cvtpk(p1[12], p1[13]), cvtpk(p1[14], p1[15])}; \
        const unsigned vb_ = lds0 + LDS_V + (((t) - t_lo) % RD) * VS + ((lane >> 4) & 1) * 32 + (lane & 3) * 8 + (4 * hi + ((lane & 15) >> 2)) * 64; \
        _Pragma("unroll") for (int dp = 0; dp < NVB; dp += 2) { s16x4 lo_[2][4], hh_[2][4]; \
            _Pragma("unroll") for (int dd = 0; dd < 2; ++dd) _Pragma("unroll") for (int ks = 0; ks < 4; ++ks) { lo_[dd][ks] = vtr(vb_ + (dp + dd) * 4096 + ks * 1024); hh_[dd][ks] = vtr(vb_ + (dp + dd) * 4096 + ks * 1024 + 512); } \
            asm volatile("s_waitcnt lgkmcnt(0)" ::: "memory"); __builtin_amdgcn_sched_barrier(0); \
            _Pragma("unroll") for (int ks = 0; ks < 4; ++ks) _Pragma("unroll") for (int dd = 0; dd < 2; ++dd) { \
                const bf16x8 vf_ = (bf16x8){lo_[dd][ks][0], lo_[dd][ks][1], lo_[dd][ks][2], lo_[dd][ks][3], hh_[dd][ks][0], hh_[dd][ks][1], hh_[dd][ks][2], hh_[dd][ks][3]}; \
                o[dp + dd] = __builtin_amdgcn_mfma_f32_32x32x16_bf16(vf_, __builtin_bit_cast(bf16x8, pw_[ks]), o[dp + dd], 0, 0, 0); } } } while (0)
    dma_tile<NKC, NVB>(S, t_lo, 0, lds0, wid, lane);
    if (t_lo + 1 < t_hi) dma_tile<NKC, NVB>(S, t_lo + 1, 1, lds0, wid, lane);
    for (int t = t_lo; t < t_hi; ++t) {
        wait_vm_bar((t + 1 < t_hi) ? ops : 0);
        if (t + 2 < t_hi) dma_tile<NKC, NVB>(S, t + 2, (t + 2 - t_lo) % RD, lds0, wid, lane);
        if (grp == 0) { if (AT_ACTIVE(t)) { AT_QK(t); AT_SMPV(t); } }
        else { if (t > t_lo && AT_ACTIVE(t - 1)) AT_SMPV(t - 1); if (AT_ACTIVE(t)) AT_QK(t); }
    }
    if (grp == 1 && AT_ACTIVE(t_hi - 1)) AT_SMPV(t_hi - 1);
    const float linv = 1.0f / swapsum(l_run);
#pragma unroll
    for (int d = 0; d < NVB; ++d) store_o_block(o[d], linv, S.o + (size_t)r32 * S.opitch + 32 * d, hi);
    asm volatile("s_waitcnt lgkmcnt(0)\n\ts_barrier" ::: "memory");
#undef AT_ACTIVE
#undef AT_QK
#undef AT_SMPV
}

template <int NKC, int NVB>
__device__ __forceinline__ void unit_q64(LAS unsigned char* lds, const Src& S, int t_lo, int t_hi) {
    constexpr int KS = NKC * 1024, VS = NVB * 4096, RD = 4, LDS_K = 0, LDS_V = RD * KS;
    const int tid = opq_v((int)threadIdx.x), lane = tid & 63, r32 = lane & 31, hi = lane >> 5; const int wid = __builtin_amdgcn_readfirstlane(tid >> 6);
    const unsigned lds0 = (unsigned)(uintptr_t)lds;
    const int ops = (NKC + 7 - wid) / 8 + (NVB * 4) / 8;
    bf16x8 qa[NKC / 2], qb[NKC / 2];
#pragma unroll
    for (int d0 = 0; d0 < NKC / 2; ++d0) { qa[d0] = *(const bf16x8*)(S.q + (size_t)r32 * S.qpitch + d0 * 16 + hi * 8); qb[d0] = *(const bf16x8*)(S.q + (size_t)(32 + r32) * S.qpitch + d0 * 16 + hi * 8); }
    float ma = 0.f, la = 0.f, mb = 0.f, lb = 0.f; bool first = true;
    f32x16 oa[NVB], ob[NVB];
#pragma unroll
    for (int d = 0; d < NVB; ++d) { oa[d] = f32x16{}; ob[d] = f32x16{}; }
#define Q64_SM_(P0, P1, M, L, O, PW, QE) \
        if (first) {   \
            float mx_[8]; _Pragma("unroll") for (int r = 0; r < 8; ++r) mx_[r] = fmaxf(fmaxf(P0[r], P0[r + 8]), fmaxf(P1[r], P1[r + 8])); \
            float rm_ = fmaxf(fmaxf(fmaxf(mx_[0], mx_[1]), fmaxf(mx_[2], mx_[3])), fmaxf(fmaxf(mx_[4], mx_[5]), fmaxf(mx_[6], mx_[7]))); M = swapmax(rm_); QE = hi ? 0.f : -M; \
            _Pragma("unroll") for (int r = 0; r < 16; ++r) { P0[r] -= M; P1[r] -= M; } } \
        else { const float tot_ = swapsum(L);   \
          if (__any(tot_ > 1.0e12f)) { const float dl_ = tot_ > 1.0e12f ? ceilf(__builtin_amdgcn_logf(tot_)) : 0.f, sc_ = __builtin_amdgcn_exp2f(-dl_); M += dl_; QE = hi ? 0.f : -M; L *= sc_; \
              _Pragma("unroll") for (int r = 0; r < 16; ++r) { P0[r] -= dl_; P1[r] -= dl_; } \
              _Pragma("unroll") for (int d = 0; d < NVB; ++d) _Pragma("unroll") for (int r = 0; r < 16; ++r) O[d][r] *= sc_; } } \
        float sm_[4] = {0.f, 0.f, 0.f, 0.f}; \
        _Pragma("unroll") for (int r = 0; r < 16; ++r) { P0[r] = __builtin_amdgcn_exp2f(P0[r]); P1[r] = __builtin_amdgcn_exp2f(P1[r]); sm_[r & 3] += P0[r] + P1[r]; } \
        L += (sm_[0] + sm_[1]) + (sm_[2] + sm_[3]); \
        PW[0] = (u32x4){cvtpk(P0[0], P0[1]), cvtpk(P0[2], P0[3]), cvtpk(P0[4], P0[5]), cvtpk(P0[6], P0[7])}; PW[1] = (u32x4){cvtpk(P0[8], P0[9]), cvtpk(P0[10], P0[11]), cvtpk(P0[12], P0[13]), cvtpk(P0[14], P0[15])}; \
        PW[2] = (u32x4){cvtpk(P1[0], P1[1]), cvtpk(P1[2], P1[3]), cvtpk(P1[4], P1[5]), cvtpk(P1[6], P1[7])}; PW[3] = (u32x4){cvtpk(P1[8], P1[9]), cvtpk(P1[10], P1[11]), cvtpk(P1[12], P1[13]), cvtpk(P1[14], P1[15])};
#define Q64_SM(P0, P1, M, L, O, PW, QE) do { Q64_SM_(P0, P1, M, L, O, PW, QE) __builtin_amdgcn_sched_barrier(0); } while (0)
#define Q64_SM_NB(P0, P1, M, L, O, PW, QE) do { Q64_SM_(P0, P1, M, L, O, PW, QE) } while (0)
    const float kext = hi ? 0.f : 1.f; float qea = 0.f, qeb = 0.f;
    dma_tile<NKC, NVB, RD>(S, t_lo, 0, lds0, wid, lane);
    if (t_lo + 1 < t_hi) dma_tile<NKC, NVB, RD>(S, t_lo + 1, 1, lds0, wid, lane);
    for (int t = t_lo; t < t_hi; ++t) {
        const int slot = (t - t_lo) % RD;
        if (((t - t_lo) & 1) == 0) asm volatile("s_waitcnt vmcnt(0)\n\ts_barrier" ::: "memory");
        if (t + 2 < t_hi) dma_tile<NKC, NVB, RD>(S, t + 2, (t + 2 - t_lo) % RD, lds0, wid, lane);
        const LAS unsigned char* kb = lds + LDS_K + slot * KS + hi * 1024 + r32 * 16;
        f32x16 s0a = __builtin_amdgcn_mfma_f32_32x32x2f32(kext, qea, f32x16{}, 0, 0, 0), s0b = __builtin_amdgcn_mfma_f32_32x32x2f32(kext, qea, f32x16{}, 0, 0, 0);
        f32x16 s1a = __builtin_amdgcn_mfma_f32_32x32x2f32(kext, qeb, f32x16{}, 0, 0, 0), s1b = __builtin_amdgcn_mfma_f32_32x32x2f32(kext, qeb, f32x16{}, 0, 0, 0);
        bf16x8 kf0 = *(const LAS bf16x8*)(kb), kf1 = *(const LAS bf16x8*)(kb + 512);
#pragma unroll
        for (int d0 = 0; d0 < NKC / 2; ++d0) {
            bf16x8 n0 = kf0, n1 = kf1;
            if (d0 + 1 < NKC / 2) { n0 = *(const LAS bf16x8*)(kb + (d0 + 1) * 2048); n1 = *(const LAS bf16x8*)(kb + (d0 + 1) * 2048 + 512); }
            s0a = __builtin_amdgcn_mfma_f32_32x32x16_bf16(kf0, qa[d0], s0a, 0, 0, 0); s0b = __builtin_amdgcn_mfma_f32_32x32x16_bf16(kf1, qa[d0], s0b, 0, 0, 0);
            s1a = __builtin_amdgcn_mfma_f32_32x32x16_bf16(kf0, qb[d0], s1a, 0, 0, 0); s1b = __builtin_amdgcn_mfma_f32_32x32x16_bf16(kf1, qb[d0], s1b, 0, 0, 0);
            if (d0 + 1 < NKC / 2) __builtin_amdgcn_sched_group_barrier(0x100, 2, 0);
            __builtin_amdgcn_sched_group_barrier(0x008, 4, 0);
            __builtin_amdgcn_sched_barrier(0);
            kf0 = n0; kf1 = n1; }
        __builtin_amdgcn_sched_barrier(0);
        u32x4 pwa[4], pwb[4];
        const unsigned vb = lds0 + LDS_V + slot * VS + ((lane >> 4) & 1) * 32 + (lane & 3) * 8 + (4 * hi + ((lane & 15) >> 2)) * 64;
        s16x4 lo[NVB][4], hh[NVB][4];
#pragma unroll
        for (int d = 0; d < NVB; ++d)
#pragma unroll
            for (int ks = 0; ks < 4; ++ks) { VTRO(lo[d][ks], vb, d * 4096 + ks * 1024); VTRO(hh[d][ks], vb, d * 4096 + ks * 1024 + 512); }
        __builtin_amdgcn_sched_barrier(0);
        Q64_SM(s0a, s0b, ma, la, oa, pwa, qea);
        asm volatile("s_waitcnt lgkmcnt(0)" ::: "memory"); __builtin_amdgcn_sched_barrier(0);
#pragma unroll
        for (int ks = 0; ks < 4; ++ks)
#pragma unroll
            for (int d = 0; d < NVB; ++d) { const bf16x8 vf = (bf16x8){lo[d][ks][0], lo[d][ks][1], lo[d][ks][2], lo[d][ks][3], hh[d][ks][0], hh[d][ks][1], hh[d][ks][2], hh[d][ks][3]};
                oa[d] = __builtin_amdgcn_mfma_f32_32x32x16_bf16(vf, __builtin_bit_cast(bf16x8, pwa[ks]), oa[d], 0, 0, 0); }
        Q64_SM_NB(s1a, s1b, mb, lb, ob, pwb, qeb);
#pragma unroll
        for (int i = 0; i < 8; ++i) { __builtin_amdgcn_sched_group_barrier(0x008, 1, 0); __builtin_amdgcn_sched_group_barrier(0x002, 12, 0); }
        __builtin_amdgcn_sched_barrier(0);
#pragma unroll
        for (int ks = 0; ks < 4; ++ks)
#pragma unroll
            for (int d = 0; d < NVB; ++d) { const bf16x8 vf = (bf16x8){lo[d][ks][0], lo[d][ks][1], lo[d][ks][2], lo[d][ks][3], hh[d][ks][0], hh[d][ks][1], hh[d][ks][2], hh[d][ks][3]};
                ob[d] = __builtin_amdgcn_mfma_f32_32x32x16_bf16(vf, __builtin_bit_cast(bf16x8, pwb[ks]), ob[d], 0, 0, 0); }
        __builtin_amdgcn_sched_barrier(0);
        first = false;
    }
    const float lia = 1.0f / swapsum(la), lib = 1.0f / swapsum(lb);
#pragma unroll
    for (int d = 0; d < NVB; ++d) { store_o_block(oa[d], lia, S.o + (size_t)r32 * S.opitch + 32 * d, hi); store_o_block(ob[d], lib, S.o + (size_t)(32 + r32) * S.opitch + 32 * d, hi); }
    asm volatile("s_waitcnt lgkmcnt(0)\n\ts_barrier" ::: "memory");
#undef Q64_SM
#undef Q64_SM_
#undef Q64_SM_NB
}

}
#define SC_AFTER_PROLOGUE() do {} while (0)
#define SC_AFTER_INPROJ(l) do {} while (0)
#define SC_AFTER_UP(l) do {} while (0)
#define SC_AFTER_MLA(l) do {} while (0)
#define SC_AFTER_BRANCH(l) do {} while (0)
#define SC_AFTER_WOUT(l) do {} while (0)
#define SC_AFTER_NORM2(l) do {} while (0)
#define SC_AFTER_GU(l) do {} while (0)
#define SC_AFTER_DOWN(l) do {} while (0)
#define SC_AFTER_ROUTE(l) do {} while (0)
#define SC_AFTER_MOEGU(l, h) do {} while (0)
#define SC_AFTER_MOED(l, h) do {} while (0)
#define SC_FINAL() do {} while (0)

struct Args { const float* in[23]; float* out; unsigned char* ws; };
#define WSP(type, off) ((type*)(F.ws + (off)))
#define PHASE() Frame Fp = F; Fp.ws = opq_p(F.ws); Fp.in = opq_p(F.in); Fp.out = opq_p(F.out); Fp.tid = opq_v((int)threadIdx.x); Fp.lane = Fp.tid & 63; Fp.wave = __builtin_amdgcn_readfirstlane(Fp.tid >> 6); (void)Fp
#define FWS(type, off) ((type*)(Fp.ws + (off)))
#define X_ FWS(bf16_t, WS_XB)
#define H_ FWS(bf16_t, WS_H)
#define Pb_ FWS(bf16_t, WS_R + R_P)
#define Gb_ FWS(bf16_t, WS_R + R_G)
#define QB_ FWS(bf16_t, WS_R + R_QB)
#define KVB_ FWS(bf16_t, WS_R + R_KVB)
#define Yb_ FWS(bf16_t, WS_R + R_Y)
#define MEMN_ FWS(bf16_t, WS_MEMN)
#define MEMKV_ FWS(bf16_t, WS_MEMKV)
#define ACT_ FWS(bf16_t, WS_R + R_ACT)
#define ASORT_ FWS(bf16_t, WS_R + R_ASORT)
#define YOUT_ FWS(bf16_t, WS_R + R_YOUT)
#define SSQ_ FWS(float, WS_MISC + MS_SSQ)
#define TEXP_ FWS(const int, WS_MISC + MS_TEXP)
#define POS_ ((const int*)Fp.in[I_POS])
#define HSC_ FWS(float, WS_MISC + MS_HSC)
#define ASC_ FWS(float, WS_MISC + MS_ASC)
#define WSIN_ FWS(float, WS_MISC + MS_WSIN)
#define WSGU_ FWS(float, WS_MISC + MS_WSGU)

#define GRID_BAR() xcd_barrier(bar)
#ifndef WGM_GU
#define WGM_GU 4
#endif
#ifndef WGM_IN
#define WGM_IN 4
#endif
template <int l> __device__ __forceinline__ void layer_body(const Frame& F, const XcdBarrier& bar, const int bx) {
        if (l > 0) {
            PHASE();
            if ((l & 1) != 0) norm_phase(Fp, nullptr, X_, Fp.in[I_GMIX] + l * DM, false, true);
            if ((l & 1) == 0) norm_phase(Fp, nullptr, X_, Fp.in[I_GMIX] + l * DM, true, true);
            GRID_BAR();
        }
        {   PHASE();
            ProbSimple p{DM, DM, DM, (const char*)H_, (const char*)wmix(Fp, l, WL_IN)}; pg8::StaticOrder S; S.init(T / 256, l > 0 ? NT_IN - 1 : NT_IN, Fp.G, bx, 0, WGM_IN);
            EpiInproj E{Pb_, Gb_, SSQ_, POS_, HSC_, WSIN_ + l * NT_IN * 256}; pg8::gemm_phase<true>(Fp.lds, p, S, E); }
        if (l == 0) { PHASE();
            ProbSimple p{DM, DM * 2, DM * 2, (const char*)MEMN_, (const char*)FWS(bf16_t, WS_WMKV)}; pg8::StaticOrder S; S.init(NB * MEML / 256, 16, Fp.G, (bx + Fp.G / 2) % Fp.G);
            EpiPlain E{MEMKV_, 4096}; pg8::gemm_phase(Fp.lds, p, S, E); }
        GRID_BAR();
        SC_AFTER_INPROJ(l);
        if (l > 0) { PHASE();
            ProbSimple p{DM, DM, DM, (const char*)H_, (const char*)wmix(Fp, l, WL_IN)}; ColOrder S{T / 256, NT_IN - 1, Fp.G, (bx + Fp.G / 2) % Fp.G};
            EpiInproj E{Pb_, Gb_, SSQ_, POS_, HSC_, WSIN_ + l * NT_IN * 256}; pg8::gemm_phase<true>(Fp.lds, p, S, E); }
        {   PHASE();
            ProbUp p{UPK, PW * 2, UPK * 2, (const char*)(Pb_ + P_CQ), (const char*)wmix(Fp, l, WL_UP)}; pg8::StaticOrder S; S.init(T / 256, UPN / 256, Fp.G, bx);
            EpiUp E{QB_, KVB_, SSQ_, POS_}; pg8::gemm_phase(Fp.lds, p, S, E); }
        {   PHASE();
            for (int i = Fp.vcu; i < 1024; i += Fp.G) {
                const int hl = i & 3, qb = (i >> 2) & 15, kvh = (i >> 6) & 1, b = i >> 7, h = kvh * 4 + hl; const size_t rowb = (size_t)b * SEQ; const int q0 = qb * 256;
                att::Src s; s.q = Pb_ + (rowb + q0 + Fp.wave * 32) * PW + P_QA + h * 64; s.qpitch = PW; s.k0 = Pb_ + rowb * PW + P_KA + kvh * 64; s.k0pitch = PW; s.k1 = s.k0; s.k1pitch = PW;
                s.v = Pb_ + rowb * PW + P_VA + kvh * 64; s.vpitch = PW; s.o = Yb_ + (rowb + q0 + Fp.wave * 32) * YW + h * 64; s.opitch = YW;
                const int t_lo = (q0 / 64 - 2) < 0 ? 0 : (q0 / 64 - 2), t_hi = (q0 / 64 + 6) > SEQ / 64 ? SEQ / 64 : (q0 / 64 + 6);
                att::unit<8, 2, 0>(Fp.lds, s, t_lo, t_hi, q0, Fp.in[I_SINK][l * 8 + h] * LOG2E);
            } }
        {   PHASE();
            for (int i = Fp.vcu; i < 512; i += Fp.G) {
                const int qb = i & 15, h = (i >> 4) & 3, b = i >> 6; const size_t rowq = (size_t)b * SEQ + qb * 256 + Fp.wave * 32;
                att::Src s; s.q = Pb_ + rowq * PW + P_QM + h * 128; s.qpitch = PW; s.k0 = MEMKV_ + (size_t)b * MEML * 4096 + l * 1024 + h * 128; s.k0pitch = 4096; s.k1 = s.k0 + 64; s.k1pitch = 4096;
                s.v = MEMKV_ + (size_t)b * MEML * 4096 + l * 1024 + 512 + h * 128; s.vpitch = 4096; s.o = Yb_ + rowq * YW + 1024 + h * 128; s.opitch = YW;
                att::unit<16, 4, 1>(Fp.lds, s, 0, MEML / 64, 0, 0.f);
            } }
        GRID_BAR();
        SC_AFTER_UP(l);
        {   PHASE();
            const bool prep_first = (Fp.vcu & 1) == 0;
            if (prep_first) { prep_ffn_weights(Fp, l); if (l == 0) prep_mixer_weights(Fp, 1, DEPTH, false); __syncthreads(); }
            for (int i = Fp.vcu; i < 512; i += Fp.G) {
                const int qb = i & 7, h = (i >> 3) & 7, b = i >> 6; const size_t rowb = (size_t)b * SEQ, rowq = rowb + qb * 512 + Fp.wave * 64;
                att::Src s; s.q = QB_ + rowq * QBW + h * 96; s.qpitch = QBW; s.k0 = KVB_ + rowb * KVW + h * 128; s.k0pitch = KVW; s.k1 = Pb_ + rowb * PW + P_KR; s.k1pitch = PW;
                s.v = KVB_ + rowb * KVW + h * 128 + 64; s.vpitch = KVW; s.o = Yb_ + rowq * YW + 512 + h * 64; s.opitch = YW;
                att::unit_q64<12, 2>(Fp.lds, s, 0, SEQ / 64);
            }
            if (!prep_first) { __syncthreads(); prep_ffn_weights(Fp, l); if (l == 0) prep_mixer_weights(Fp, 1, DEPTH, false); } }
        GRID_BAR();
        SC_AFTER_MLA(l);
        {   PHASE();
            ProbSimple p{1536, YW * 2, 1536 * 2, (const char*)Yb_, (const char*)wmix(Fp, l, WL_BR)}; pg8::StaticOrder S; S.init(T / 256, DM / 256, Fp.G, bx);
            EpiBranch E{(const unsigned char*)Gb_, H_}; pg8::gemm_phase(Fp.lds, p, S, E); }
        GRID_BAR();
        SC_AFTER_BRANCH(l);
        if (l == 0) {   PHASE();
            ProbSimple p{DM, DM * 2, DM * 2, (const char*)H_, (const char*)wmix(Fp, l, WL_OUT)}; pg8::StaticOrder S; S.init(T / 256, DM / 256, Fp.G, bx);
            EpiResid E{Fp.in[I_X], X_}; pg8::gemm_phase(Fp.lds, p, S, E); }
        if (l != 0) {   PHASE();
            ProbSimple p{DM, DM * 2, DM * 2, (const char*)H_, (const char*)wmix(Fp, l, WL_OUT)}; pg8::StaticOrder S; S.init(T / 256, DM / 256, Fp.G, bx);
            EpiResid E{nullptr, X_}; pg8::gemm_phase(Fp.lds, p, S, E); }
        GRID_BAR();
        SC_AFTER_WOUT(l);
        if ((l & 1) == 0) {
            {   PHASE(); norm_phase(Fp, nullptr, X_, Fp.in[I_GFFN] + l * DM, false, GU_I8(l) != 0); }
            GRID_BAR();
            SC_AFTER_NORM2(l);
            {   PHASE();
                constexpr bool i8 = GU_I8(l) != 0; constexpr unsigned eb = i8 ? 1 : 2;
                ProbSimple p{DM, DM * eb, DM * eb, (const char*)H_, (const char*)FWS(bf16_t, WS_WFFN + WF_GU)}; pg8::StaticOrder S; S.init(T / 256, 2 * DFF / 256, Fp.G, bx, 0, WGM_GU);
                EpiSwiglu E{ACT_, 0, HSC_, WSGU_}; pg8::gemm_phase<i8>(Fp.lds, p, S, E); }
            GRID_BAR();
            SC_AFTER_GU(l);
            {   PHASE();
                ProbSimple p{DFF, DFF * 2, DFF * 2, (const char*)ACT_, (const char*)FWS(bf16_t, WS_WFFN + WF_D)}; pg8::StaticOrder S; S.init(T / 256, DM / 256, Fp.G, bx, 1);
                EpiResid E{nullptr, X_}; pg8::gemm_phase(Fp.lds, p, S, E); }
            GRID_BAR();
            SC_AFTER_DOWN(l);
        } else {
            {   PHASE(); norm_router_phase(Fp, X_, Fp.in[I_GFFN] + l * DM, Fp.in[I_WR] + (size_t)(l >> 1) * DM * NE, GU_I8(l) != 0); }
            GRID_BAR();
            {   PHASE(); moe_assign_phase(Fp, GU_I8(l) != 0); }
            GRID_BAR();
            SC_AFTER_ROUTE(l);
            {   constexpr int half = 0; (void)half;
                {   PHASE();
                    const int nrt = __builtin_amdgcn_readfirstlane(TEXP_[MAXRT]);
                    constexpr bool i8 = GU_I8(l) != 0; constexpr unsigned eb = i8 ? 1 : 2;
                    ProbMoe p{DM, DM * eb, DM * eb, (const char*)ASORT_, (const char*)FWS(bf16_t, WS_WFFN + WF_GU), 0}; MoeOrder S; S.base.init(nrt, 2 * DFF / 256, Fp.G, bx, 0, WGM_GU); S.lo = 0; S.texp = TEXP_;
                    EpiSwiglu E{ACT_, 0, ASC_, WSGU_}; pg8::gemm_phase<i8>(Fp.lds, p, S, E); }
                GRID_BAR();
                SC_AFTER_MOEGU(l, half);
                {   PHASE();
                    const int nrt = __builtin_amdgcn_readfirstlane(TEXP_[MAXRT]); const int nmain = nrt < 256 ? nrt : 256;
                    ProbMoe p{DFF, DFF * 2, DFF * 2, (const char*)ACT_, (const char*)FWS(bf16_t, WS_WFFN + WF_D), 0}; MoeOrder S; S.base.init(nmain, DM / 256, Fp.G, bx, 1); S.lo = 0; S.texp = TEXP_;
                    EpiYout E{YOUT_}; pg8::gemm_phase(Fp.lds, p, S, E); }
                {   PHASE();
                    const int nrt = __builtin_amdgcn_readfirstlane(TEXP_[MAXRT]);
                    ProbTail p{DFF / TAIL_KS, DFF * 2, DFF * 2, (const char*)ACT_, (const char*)FWS(bf16_t, WS_WFFN + WF_D)}; TailOrder S{(nrt > 256 ? nrt - 256 : 0) * 4 * TAIL_KS, Fp.G, Fp.vcu, TEXP_};
                    EpiSlab E{FWS(float, WS_SLAB)}; pg8::gemm_phase(Fp.lds, p, S, E); }
                GRID_BAR();
                SC_AFTER_MOED(l, half);
            }
        }
    }

__global__ void __launch_bounds__(NWAVES * 64, 2) fwd(Args args) {
    extern __shared__ __attribute__((aligned(16))) unsigned char lds_raw[];
    Frame F;
    F.lds = (LAS unsigned char*)lds_raw;
    F.MISC = (volatile LAS unsigned*)(F.lds + LDSCTL_OFF);
    F.tid = threadIdx.x; F.lane = F.tid & 63; F.wave = __builtin_amdgcn_readfirstlane(F.tid >> 6);
    F.G = gridDim.x; { const int bx = blockIdx.x; F.vcu = (F.G % 8 == 0) ? (bx % 8) * (F.G / 8) + bx / 8 : bx; }
    F.ws = args.ws; F.ctl = (gu32*)(args.ws + WS_CTL); F.out = args.out;
    F.in = (const float* const*)__builtin_amdgcn_kernarg_segment_ptr();
    for (int u = F.tid; u < (LDS_BYTES - LDSCTL_OFF) / 4; u += NWAVES * 64) ((LAS unsigned*)(F.lds + LDSCTL_OFF))[u] = 0u;
    __syncthreads();
    XcdBarrier bar = xcd_barrier_post((unsigned*)(F.ctl + CW_BAR), F.MISC + 8);

    const int bx = (int)blockIdx.x;

    {   PHASE();
        prep_mixer_weights(Fp, 0, 1, true);
        memnorm_phase(Fp);
        norm_phase(Fp, Fp.in[I_X], nullptr, Fp.in[I_GMIX], false, true); }
    GRID_BAR();
    SC_AFTER_PROLOGUE();

    layer_body<0>(F, bar, bx); layer_body<1>(F, bar, bx); layer_body<2>(F, bar, bx); layer_body<3>(F, bar, bx);
    {   PHASE(); final_norm_phase(Fp, X_, Fp.out, Fp.in[I_GFIN], true); }
    SC_FINAL();
}

extern "C" void kernel_launch(void* const* d_in, const int* in_sizes, int n_in, void* d_out, int out_size, void* d_ws, size_t ws_size, hipStream_t stream) {
    static int grid = 0;
    if (grid == 0) {
        if (n_in != 23 || out_size != T * DM || ws_size < WS_END) { fprintf(stderr, "kernel_launch: unexpected problem (n_in %d, out %d, ws %zu < %zu)\n", n_in, out_size, ws_size, (size_t)WS_END); grid = -1; return; }
        int dev = 0, cus = 0;
        if (hipGetDevice(&dev) != hipSuccess || hipDeviceGetAttribute(&cus, hipDeviceAttributeMultiprocessorCount, dev) != hipSuccess) { grid = -1; return; }
        if (hipFuncSetAttribute((const void*)fwd, hipFuncAttributeMaxDynamicSharedMemorySize, LDS_BYTES) != hipSuccess) { fprintf(stderr, "kernel_launch: hipFuncSetAttribute failed\n"); grid = -1; return; }
        int per_cu = 0;
        if (hipOccupancyMaxActiveBlocksPerMultiprocessor(&per_cu, (const void*)fwd, NWAVES * 64, LDS_BYTES) != hipSuccess || per_cu < 1) fprintf(stderr, "kernel_launch: occupancy query says %d\n", per_cu);
        (void)hipGetLastError();
        grid = cus;
    }
    if (grid < 0) return;
    if (hipMemsetAsync((char*)d_ws + WS_CTL, 0, CTL_ZERO_BYTES, stream) != hipSuccess) return;
    Args a{};
    for (int i = 0; i < 23; ++i) a.in[i] = (const float*)d_in[i];
    a.out = (float*)d_out; a.ws = (unsigned char*)d_ws;
    hipLaunchKernelGGL(fwd, dim3(grid), dim3(NWAVES * 64), LDS_BYTES, stream, a);
}
```
